# Optimizing an MI355X kernel written in HIP

```python
import jax
import jax.numpy as jnp
from jax import lax
import numpy as np

D_MODEL = 1024
BATCH = 1
SEQ = 16384
DEPTH = 2

GRID_W = 64
CTX_LEN = 256
EPS = 1e-6
HEAD_DIM = 64
N_Q_HEADS = 8
N_KV_HEADS = 2
Q_PER_KV = N_Q_HEADS // N_KV_HEADS
ATTN_WIDTH = N_Q_HEADS * HEAD_DIM
KV_WIDTH = N_KV_HEADS * HEAD_DIM
WINDOW = 128
ATTN_BLOCK = 128
ROPE_THETA = 10000.0
AXIS_DIM = HEAD_DIM // 2
HG_HEADS = 4
HG_K = 64
HG_V = 64
HG_WIDTH = HG_HEADS * HG_V
HG_CHUNK = 64
GM_GROUPS = 4
GM_DIM = 64
GM_WIDTH = GM_GROUPS * GM_DIM
GM_CHUNK = 128
MIX_WIDTH = ATTN_WIDTH + HG_WIDTH + GM_WIDTH
IN_SPLITS = (ATTN_WIDTH, KV_WIDTH, KV_WIDTH, HG_WIDTH, HG_WIDTH, HG_WIDTH, HG_WIDTH, HG_WIDTH, GM_WIDTH, GM_WIDTH)
IN_WIDTH = ATTN_WIDTH + 2 * KV_WIDTH + 5 * HG_WIDTH + 2 * GM_WIDTH
FFN_DIM = 2816
N_EXPERTS = 8
TOP_K = 2
EXPERT_DIM = 3584
N_DENSE = (DEPTH + 1) // 2
N_MOE = DEPTH // 2

kernel_name = 'hybrid_hgrn2_swa_gmlp_moe_dit_block'


def _rms(x):
    xf = x.astype(jnp.float32)
    return (xf * lax.rsqrt(jnp.mean(xf * xf, axis=-1, keepdims=True) + EPS)).astype(x.dtype)


def _heads(t, n):
    return t.reshape(t.shape[:-1] + (n, t.shape[-1] // n))


def _split_cols(p):
    out, start = [], 0
    for w in IN_SPLITS:
        out.append(p[..., start:start + w])
        start += w
    return out


def _axial_rope_tables(rows, dtype):
    row = jnp.repeat(jnp.arange(rows, dtype=jnp.float32), GRID_W, total_repeat_length=rows * GRID_W)
    col = jnp.tile(jnp.arange(GRID_W, dtype=jnp.float32), rows)
    inv_freq = ROPE_THETA ** (-jnp.arange(0, AXIS_DIM, 2, dtype=jnp.float32) / AXIS_DIM)
    ang_r = row[:, None] * inv_freq
    ang_c = col[:, None] * inv_freq
    return tuple(t.astype(dtype) for t in (jnp.cos(ang_r), jnp.sin(ang_r), jnp.cos(ang_c), jnp.sin(ang_c)))


def _rope_half(x, cos, sin):
    x1, x2 = jnp.split(x, 2, axis=-1)
    cos = cos[:, None, :]
    sin = sin[:, None, :]
    return jnp.concatenate([x1 * cos - x2 * sin, x1 * sin + x2 * cos], axis=-1)


def _apply_axial_rope(x, tables):
    cos_r, sin_r, cos_c, sin_c = tables
    return jnp.concatenate([_rope_half(x[..., :AXIS_DIM], cos_r, sin_r),
                            _rope_half(x[..., AXIS_DIM:], cos_c, sin_c)], axis=-1)


def _window_attention(q, k, v, k_ctx, v_ctx, sink):
    b, s = q.shape[:2]
    nb = s // ATTN_BLOCK
    qb = q.reshape(b, nb, ATTN_BLOCK, N_KV_HEADS, Q_PER_KV, HEAD_DIM) * (HEAD_DIM ** -0.5)
    pad = ((0, 0), (ATTN_BLOCK, ATTN_BLOCK), (0, 0), (0, 0))

    def band_blocks(t):
        tp = jnp.pad(t, pad).reshape(b, nb + 2, ATTN_BLOCK, N_KV_HEADS, HEAD_DIM)
        return jnp.concatenate([tp[:, :-2], tp[:, 1:-1], tp[:, 2:]], axis=2)

    kw, vw = band_blocks(k), band_blocks(v)
    s_win = jnp.einsum('bnqhgd,bnkhd->bnhgqk', qb, kw).astype(jnp.float32)
    a = jnp.arange(ATTN_BLOCK)[:, None]
    r = jnp.arange(3 * ATTN_BLOCK)[None, :]
    band = jnp.abs(a + ATTN_BLOCK - r) <= WINDOW
    key_pos = jnp.arange(nb)[:, None] * ATTN_BLOCK - ATTN_BLOCK + jnp.arange(3 * ATTN_BLOCK)[None, :]
    in_range = (key_pos >= 0) & (key_pos < s)
    valid = band[None] & in_range[:, None, :]
    s_win = jnp.where(valid[None, :, None, None], s_win, -jnp.inf)
    s_ctx = jnp.einsum('bnqhgd,bchd->bnhgqc', qb, k_ctx).astype(jnp.float32)
    s_sink = jnp.broadcast_to(sink.astype(jnp.float32).reshape(N_KV_HEADS, Q_PER_KV)[None, None, :, :, None, None],
                              s_win.shape[:-1] + (1,))
    p = jax.nn.softmax(jnp.concatenate([s_win, s_ctx, s_sink], axis=-1), axis=-1)
    n_win = 3 * ATTN_BLOCK
    n_ctx = k_ctx.shape[1]
    p_win = p[..., :n_win].astype(v.dtype)
    p_ctx = p[..., n_win:n_win + n_ctx].astype(v.dtype)
    o = (jnp.einsum('bnhgqk,bnkhd->bnqhgd', p_win, vw)
         + jnp.einsum('bnhgqc,bchd->bnqhgd', p_ctx, v_ctx))
    return o.reshape(b, s, ATTN_WIDTH)


def _context_attention(q, k, v, sink):
    b, n = q.shape[:2]
    qg = q.reshape(b, n, N_KV_HEADS, Q_PER_KV, HEAD_DIM) * (HEAD_DIM ** -0.5)
    sc = jnp.einsum('bqhgd,bkhd->bhgqk', qg, k).astype(jnp.float32)
    sk = jnp.broadcast_to(sink.astype(jnp.float32).reshape(N_KV_HEADS, Q_PER_KV)[None, :, :, None, None],
                          sc.shape[:-1] + (1,))
    p = jax.nn.softmax(jnp.concatenate([sc, sk], axis=-1), axis=-1)[..., :-1]
    o = jnp.einsum('bhgqk,bkhd->bqhgd', p.astype(v.dtype), v)
    return o.reshape(b, n, ATTN_WIDTH)


def _to_chunks(t, chunk):
    b, n, h, d = t.shape
    return t.reshape(b, n // chunk, chunk, h, d).transpose(1, 0, 3, 2, 4)


def _hgrn_scan(q, k, v, log_f, s0):
    qc, kc, vc, gc = (_to_chunks(t.astype(jnp.float32), HG_CHUNK) for t in (q, k, v, log_f))
    tri = jnp.tril(jnp.ones((HG_CHUNK, HG_CHUNK), dtype=bool))[:, :, None]

    def step(state, blk):
        qb, kb, vb, gb = blk
        cum = jnp.cumsum(gb, axis=2)
        o_inter = jnp.einsum('bhtk,bhkv->bhtv', qb * jnp.exp(cum), state)
        diff = cum[:, :, :, None, :] - cum[:, :, None, :, :]
        decay = jnp.exp(jnp.where(tri, diff, -jnp.inf))
        scores = jnp.einsum('bhtk,bhsk,bhtsk->bhts', qb, kb, decay)
        o_intra = jnp.einsum('bhts,bhsv->bhtv', scores, vb)
        last = cum[:, :, -1:, :]
        new_state = (jnp.exp(last[:, :, 0, :])[..., None] * state
                     + jnp.einsum('bhsk,bhsv->bhkv', kb * jnp.exp(last - cum), vb))
        return new_state, o_inter + o_intra

    final, out = lax.scan(step, s0, (qc, kc, vc, gc))
    b, n, h = q.shape[:3]
    out = out.transpose(1, 0, 3, 2, 4).reshape(b, n, h, v.shape[-1])
    return out.astype(v.dtype), final


def _hgrn_direction(q, f_logit, lower_bound, v, s0):
    f = lower_bound + (1.0 - lower_bound) * jax.nn.sigmoid(f_logit.astype(jnp.float32))
    return _hgrn_scan(q, 1.0 - f, v, jnp.log(f), s0)


def _hgrn_bidir(hq, hff, hfb, hi, lb_f, lb_b, s0_f, s0_b):
    q = jax.nn.silu(_heads(hq, HG_HEADS)) * (HG_K ** -0.5)
    v = _heads(hi, HG_HEADS)
    o_f, st_f = _hgrn_direction(q, _heads(hff, HG_HEADS), lb_f, v, s0_f)
    o_b, st_b = _hgrn_direction(jnp.flip(q, 1), jnp.flip(_heads(hfb, HG_HEADS), 1), lb_b, jnp.flip(v, 1), s0_b)
    return o_f + jnp.flip(o_b, 1), st_f, st_b


def _hgrn_out(o, g, gain):
    y = _rms(o) * gain * jax.nn.silu(_heads(g, HG_HEADS))
    return y.reshape(y.shape[:-2] + (HG_WIDTH,))


def _chunk_gmlp(u, v, w_s, b_s, norm_gain):
    b, n, _ = u.shape
    nc = n // GM_CHUNK
    u = jax.nn.gelu(u, approximate=False)
    v = _rms(_heads(jax.nn.gelu(v, approximate=False), GM_GROUPS)) * norm_gain.reshape(GM_GROUPS, GM_DIM)
    vc = v.reshape(b, nc, GM_CHUNK, GM_GROUPS, GM_DIM)
    mixed = jnp.einsum('gts,bnsgc->bntgc', w_s, vc) + b_s.T[:, :, None]
    return u * mixed.reshape(b, n, GM_WIDTH)


def _swiglu(h, w_gate, w_up, w_down):
    return (jax.nn.silu(h @ w_gate) * (h @ w_up)) @ w_down


def _moe(h, router, w_gate, w_up, w_down):
    shape = h.shape
    t = h.reshape(-1, shape[-1])
    logits = (t @ router).astype(jnp.float32)
    top_val, top_idx = lax.top_k(logits, TOP_K)
    top_w = jax.nn.softmax(top_val, axis=-1)
    gate = jnp.sum(jax.nn.one_hot(top_idx, N_EXPERTS, dtype=jnp.float32) * top_w[..., None], axis=1).astype(t.dtype)
    out = jnp.zeros_like(t)
    for e in range(N_EXPERTS):
        out = out + gate[:, e:e + 1] * _swiglu(t, w_gate[e], w_up[e], w_down[e])
    return out.reshape(shape)


def _channel_mixer(h, layer, ffn_w_gate, ffn_w_up, ffn_w_down, moe_router, moe_w_gate, moe_w_up, moe_w_down):
    i = layer // 2
    if layer % 2 == 0:
        return _swiglu(h, ffn_w_gate[i], ffn_w_up[i], ffn_w_down[i])
    return _moe(h, moe_router[i], moe_w_gate[i], moe_w_up[i], moe_w_down[i])


def setup_inputs(seed: int = 0) -> dict:
    key = jax.random.key(seed)
    ks = jax.random.split(key, 24)
    D = D_MODEL

    def nrm(k, shape, s):
        return jax.random.normal(k, shape, jnp.float32) * s

    return {
        'x': nrm(ks[0], (BATCH, SEQ, D), 1.0),
        'c': nrm(ks[1], (BATCH, D), 1.0),
        'ctx': nrm(ks[2], (BATCH, CTX_LEN, D), 1.0),
        'c_ctx': nrm(ks[3], (D,), 1.0),
        'w_ada': nrm(ks[4], (DEPTH, D, 6 * D), 0.5 * D ** -0.5),
        'b_ada': nrm(ks[5], (DEPTH, 6 * D), 0.02),
        'w_in': nrm(ks[6], (DEPTH, D, IN_WIDTH), D ** -0.5),
        'w_out': nrm(ks[7], (DEPTH, MIX_WIDTH, D), MIX_WIDTH ** -0.5),
        'q_norm_gain': 1.0 + nrm(ks[8], (DEPTH, HEAD_DIM), 0.02),
        'k_norm_gain': 1.0 + nrm(ks[9], (DEPTH, HEAD_DIM), 0.02),
        'attn_sink': nrm(ks[10], (DEPTH, N_Q_HEADS), 0.5),
        'hgrn_lower_bound': nrm(ks[11], (2, DEPTH, HG_WIDTH), 1.0),
        'hgrn_out_gain': 1.0 + nrm(ks[12], (DEPTH, HG_V), 0.02),
        'gmlp_w_s': nrm(ks[13], (DEPTH, GM_GROUPS, GM_CHUNK, GM_CHUNK), GM_CHUNK ** -0.5),
        'gmlp_b_s': 1.0 + nrm(ks[14], (DEPTH, GM_GROUPS, GM_CHUNK), 0.02),
        'gmlp_norm_gain': 1.0 + nrm(ks[15], (DEPTH, GM_WIDTH), 0.02),
        'ffn_w_gate': nrm(ks[16], (N_DENSE, D, FFN_DIM), D ** -0.5),
        'ffn_w_up': nrm(ks[17], (N_DENSE, D, FFN_DIM), D ** -0.5),
        'ffn_w_down': nrm(ks[18], (N_DENSE, FFN_DIM, D), FFN_DIM ** -0.5),
        'moe_router': nrm(ks[19], (N_MOE, D, N_EXPERTS), D ** -0.5),
        'moe_w_gate': nrm(ks[20], (N_MOE, N_EXPERTS, D, EXPERT_DIM), D ** -0.5),
        'moe_w_up': nrm(ks[21], (N_MOE, N_EXPERTS, D, EXPERT_DIM), D ** -0.5),
        'moe_w_down': nrm(ks[22], (N_MOE, N_EXPERTS, EXPERT_DIM, D), EXPERT_DIM ** -0.5),
    }


def reference(x, c, ctx, c_ctx, w_ada, b_ada, w_in, w_out, q_norm_gain, k_norm_gain, attn_sink,
              hgrn_lower_bound, hgrn_out_gain, gmlp_w_s, gmlp_b_s, gmlp_norm_gain,
              ffn_w_gate, ffn_w_up, ffn_w_down, moe_router, moe_w_gate, moe_w_up, moe_w_down):
    bsz, n_lat = x.shape[:2]
    rows = n_lat // GRID_W
    rope = _axial_rope_tables(rows, x.dtype)
    lb_soft = jax.nn.softmax(hgrn_lower_bound.astype(jnp.float32), axis=1)
    lower_bounds = jnp.cumsum(lb_soft, axis=1) - lb_soft[:, :1]
    zero_state = jnp.zeros((bsz, HG_HEADS, HG_K, HG_V), jnp.float32)

    for layer in range(DEPTH):
        last = layer == DEPTH - 1
        mod = jax.nn.silu(c) @ w_ada[layer] + b_ada[layer]
        mod_c = jax.nn.silu(c_ctx) @ w_ada[layer] + b_ada[layer]
        sh_a, sc_a, g_a, sh_f, sc_f, g_f = jnp.split(mod[:, None, :], 6, axis=-1)
        csh_a, csc_a, cg_a, csh_f, csc_f, cg_f = jnp.split(mod_c, 6)

        h = _rms(x) * (1.0 + sc_a) + sh_a
        hc = _rms(ctx) * (1.0 + csc_a) + csh_a
        aq, ak, av, hq, hff, hfb, hi, hg, gu, gv = _split_cols(h @ w_in[layer])
        caq, cak, cav, chq, chff, chfb, chi, chg, cgu, cgv = _split_cols(hc @ w_in[layer])

        qg, kg = q_norm_gain[layer], k_norm_gain[layer]
        q = _apply_axial_rope(_rms(_heads(aq, N_Q_HEADS)) * qg, rope)
        k = _apply_axial_rope(_rms(_heads(ak, N_KV_HEADS)) * kg, rope)
        v = _heads(av, N_KV_HEADS)
        k_c = _rms(_heads(cak, N_KV_HEADS)) * kg
        v_c = _heads(cav, N_KV_HEADS)
        attn_lat = _window_attention(q, k, v, k_c, v_c, attn_sink[layer])

        lb_f = lower_bounds[0, layer].reshape(HG_HEADS, HG_K)
        lb_b = lower_bounds[1, layer].reshape(HG_HEADS, HG_K)
        o_hc, st_f, st_b = _hgrn_bidir(chq, chff, chfb, chi, lb_f, lb_b, zero_state, zero_state)
        o_hl, _, _ = _hgrn_bidir(hq, hff, hfb, hi, lb_f, lb_b, st_f, st_b)
        hg_lat = _hgrn_out(o_hl, hg, hgrn_out_gain[layer])

        gm_lat = _chunk_gmlp(gu, gv, gmlp_w_s[layer], gmlp_b_s[layer], gmlp_norm_gain[layer])

        mix = jnp.concatenate([attn_lat, hg_lat, gm_lat], axis=-1)
        x = x + g_a * (mix @ w_out[layer])
        if not last:
            q_c = _rms(_heads(caq, N_Q_HEADS)) * qg
            attn_ctx = _context_attention(q_c, k_c, v_c, attn_sink[layer])
            hg_ctx = _hgrn_out(o_hc, chg, hgrn_out_gain[layer])
            gm_ctx = _chunk_gmlp(cgu, cgv, gmlp_w_s[layer], gmlp_b_s[layer], gmlp_norm_gain[layer])
            mix_c = jnp.concatenate([attn_ctx, hg_ctx, gm_ctx], axis=-1)
            ctx = ctx + cg_a * (mix_c @ w_out[layer])

        h = _rms(x) * (1.0 + sc_f) + sh_f
        x = x + g_f * _channel_mixer(h, layer, ffn_w_gate, ffn_w_up, ffn_w_down,
                                     moe_router, moe_w_gate, moe_w_up, moe_w_down)
        if not last:
            hc = _rms(ctx) * (1.0 + csc_f) + csh_f
            ctx = ctx + cg_f * _channel_mixer(hc, layer, ffn_w_gate, ffn_w_up, ffn_w_down,
                                              moe_router, moe_w_gate, moe_w_up, moe_w_down)
    return x
```

```cpp
#include <hip/hip_runtime.h>
#include <cstdio>
#include <cstdint>
#include <cmath>
#ifndef ONE_LAUNCH
#define ONE_LAUNCH 1
#endif
namespace pg8 {
#define PG8_LAS __attribute__((address_space(3)))
typedef unsigned short bf16_t;
typedef short bf16x8 __attribute__((ext_vector_type(8)));
typedef float f32x4 __attribute__((ext_vector_type(4)));
typedef unsigned u32x4 __attribute__((ext_vector_type(4)));
constexpr int BM = 256, BK = 64, HALF = 128, HTB = HALF * BK * 2  , STAGE_BYTES = 8 * HTB, NXCD = 8, WGM = 8;

__host__ __device__ __forceinline__ int lds_byte(int r, int c) { const int st = (r >> 4) * 2 + (c >> 5), rr = r & 15, cc = c & 31, ob = rr * 64 + cc * 2; return st * 1024 + (ob ^ (((ob >> 9) & 1) << 5)); }
__host__ __device__ __forceinline__ void stage_rc(int b, int& R, int& C) { const int st = b / 1024, sb = b % 1024, swz = sb ^ (((sb >> 9) & 1) << 5); R = (st >> 1) * 16 + swz / 64; C = (st & 1) * 32 + (swz % 64) / 2; }
__host__ __device__ __forceinline__ int perm32(int rho) { const int n = rho >> 4, i = rho & 15; return 8 * (i >> 2) + 4 * n + (i & 3); }

struct Unit { int pm, pn, eb; };
struct Gemm { const bf16_t* A; const bf16_t* Bt; int M, N, K; size_t bstride; };

struct StaticOrder {
    int nM, nN, nwg, G, c;
    __host__ __device__ void init(int M, int N, int G_, int c_) { nM = M / BM; nN = N / BM; nwg = nM * nN; G = G_; c = c_; }
    __host__ __device__ bool next(int i, Unit& u) const {
        const long L = (long)i * G + c; if (L >= nwg) return false;
        int wgid = (int)L; { const int q = nwg / NXCD, r = nwg % NXCD, xcd = wgid % NXCD, off = wgid / NXCD; wgid = (xcd < r ? xcd * (q + 1) : r * (q + 1) + (xcd - r) * q) + off; }
        const int nig = WGM * nN, gid = wgid / nig, fm = gid * WGM, gsz = (nM - fm) < WGM ? (nM - fm) : WGM;
        u.pm = fm + ((wgid % nig) % gsz); u.pn = (wgid % nig) / gsz; u.eb = 0; return true;
    }
    __device__ __forceinline__ void a_ready(const Unit&) const {}
    __device__ __forceinline__ void done(const Unit&) const {}
};

__device__ __forceinline__ unsigned cvt_pk_bf16(float lo, float hi) { unsigned r; asm volatile("v_cvt_pk_bf16_f32 %0, %1, %2" : "=v"(r) : "v"(lo), "v"(hi)); return r; }
typedef float f32x2 __attribute__((ext_vector_type(2)));
__device__ __forceinline__ f32x2 gelu_pk(f32x2 v) {
    const f32x2 av = __builtin_elementwise_abs(v), d = av * 0.2316418882f + 1.0f;
    f32x2 t; t.x = __builtin_amdgcn_rcpf(d.x); t.y = __builtin_amdgcn_rcpf(d.y);
    f32x2 q = t * 0.5307027145f + (-0.7265760135f); q = q * t + 0.7107068705f; q = q * t + (-0.142248368f); q = q * t + 0.127414796f; q = q * t;
    const f32x2 s = (v * v) * (-0.72134752044f);
    f32x2 e; e.x = __builtin_amdgcn_exp2f(s.x); e.y = __builtin_amdgcn_exp2f(s.y);
    const f32x2 m = v * (q * e), r = v - m;
    f32x2 o; o.x = v.x < 0.f ? m.x : r.x; o.y = v.y < 0.f ? m.y : r.y; return o;
}

template <int ACT  > struct EpiBf16 {
    static constexpr bool PERM = true, AFTER_DRAIN = false; static_assert(ACT == 0 || ACT == 1, "EpiBf16: ACT is 0 (none) or 1 (gelu_pk)");
    bf16_t* O; int ldc; const float* bias; int split_cols; size_t split_stride; float scale0;
    __device__ __forceinline__ void operator()(const f32x4 (&acc)[2][2][4][2], const Unit& u, int wr, int wc, int fr, int fq) const {
        const int row0 = u.pm * BM + wr * 64 + fr; int colt = u.pn * BM; bf16_t* base = O;
        float sc = 1.f; if (split_cols) { const int t = colt / split_cols; base += (size_t)t * split_stride; colt -= t * split_cols; if (t == 0) sc = scale0; }
        const int col0 = colt + wc * 32 + 8 * fq, bcol0 = u.pn * BM + wc * 32 + 8 * fq;
        f32x4 bv[2][2];
#pragma unroll
        for (int bj = 0; bj < 2; ++bj)
#pragma unroll
            for (int n = 0; n < 2; ++n) bv[bj][n] = bias ? *(const f32x4*)(bias + bcol0 + bj * HALF + 4 * n) : (f32x4){0.f, 0.f, 0.f, 0.f};
#pragma unroll
        for (int ai = 0; ai < 2; ++ai)
#pragma unroll
            for (int m = 0; m < 4; ++m) { bf16_t* rowp = base + (size_t)(row0 + ai * HALF + m * 16) * ldc + col0;
#pragma unroll
                for (int bj = 0; bj < 2; ++bj) { f32x4 v0 = acc[ai][bj][m][0] + bv[bj][0], v1 = acc[ai][bj][m][1] + bv[bj][1];
                    if (ACT == 1) { f32x2 a = gelu_pk((f32x2){v0[0], v0[1]}), b = gelu_pk((f32x2){v0[2], v0[3]}), c = gelu_pk((f32x2){v1[0], v1[1]}), d = gelu_pk((f32x2){v1[2], v1[3]});
                        v0 = (f32x4){a.x, a.y, b.x, b.y}; v1 = (f32x4){c.x, c.y, d.x, d.y}; }
                    v0 = v0 * sc; v1 = v1 * sc; u32x4 w; w.x = cvt_pk_bf16(v0[0], v0[1]); w.y = cvt_pk_bf16(v0[2], v0[3]); w.z = cvt_pk_bf16(v1[0], v1[1]); w.w = cvt_pk_bf16(v1[2], v1[3]);
                    *(u32x4*)(rowp + bj * HALF) = w; } }
    }
};

__device__ __forceinline__ float silu_f(float x) { return x * __builtin_amdgcn_rcpf(1.0f + __builtin_amdgcn_exp2f(-1.4426950408889634f * x)); }
struct EpiResid {
    static constexpr bool PERM = false, AFTER_DRAIN = false;
    const float* base; float* out; const float* gate; const float* cbase; float* cout; const float* cgate; int mlat; int ldc;
    __device__ __forceinline__ void operator()(const f32x4 (&acc)[2][2][4][2], const Unit& u, int wr, int wc, int fr, int fq) const {
        const bool isc = u.pm >= mlat;
        const float* b = isc ? cbase : base; float* o = isc ? cout : out; const float* g = isc ? cgate : gate;
        const int row0 = (isc ? (u.pm - mlat) : u.pm) * BM + wr * 64 + fr, col0 = u.pn * BM + wc * 32 + 4 * fq;
        f32x4 gv[2][2];
#pragma unroll
        for (int bj = 0; bj < 2; ++bj)
#pragma unroll
            for (int n = 0; n < 2; ++n) gv[bj][n] = *(const f32x4*)(g + col0 + bj * HALF + n * 16);
#pragma unroll
        for (int ai = 0; ai < 2; ++ai)
#pragma unroll
            for (int m = 0; m < 4; ++m) { const size_t off = (size_t)(row0 + ai * HALF + m * 16) * ldc + col0;
#pragma unroll
                for (int bj = 0; bj < 2; ++bj)
#pragma unroll
                    for (int n = 0; n < 2; ++n) { const f32x4 bs = *(const f32x4*)(b + off + bj * HALF + n * 16); *(f32x4*)(o + off + bj * HALF + n * 16) = bs + gv[bj][n] * acc[ai][bj][m][n]; }
                if (m & 1) asm volatile("" ::: "memory"); }
    }
};
struct EpiSwiGLU {
    static constexpr bool PERM = true, AFTER_DRAIN = false;
    bf16_t* O; int ldc;
    __device__ __forceinline__ void operator()(const f32x4 (&acc)[2][2][4][2], const Unit& u, int wr, int wc, int fr, int fq) const {
        const int row0 = u.pm * BM + wr * 64 + fr, col0 = u.pn * HALF + wc * 32 + 8 * fq;
#pragma unroll
        for (int ai = 0; ai < 2; ++ai)
#pragma unroll
            for (int m = 0; m < 4; ++m) { bf16_t* rowp = O + (size_t)(row0 + ai * HALF + m * 16) * ldc + col0;
                const f32x4 g0 = acc[ai][0][m][0], g1 = acc[ai][0][m][1], u0 = acc[ai][1][m][0], u1 = acc[ai][1][m][1];
                f32x4 h0, h1;
#pragma unroll
                for (int j = 0; j < 4; ++j) { h0[j] = silu_f(g0[j]) * u0[j]; h1[j] = silu_f(g1[j]) * u1[j]; }
                u32x4 w; w.x = cvt_pk_bf16(h0[0], h0[1]); w.y = cvt_pk_bf16(h0[2], h0[3]); w.z = cvt_pk_bf16(h1[0], h1[1]); w.w = cvt_pk_bf16(h1[2], h1[3]);
                *(u32x4*)rowp = w; }
    }
};
struct MoeOrder : StaticOrder {
    const int* tile_e;
    __device__ __forceinline__ bool next(int i, Unit& u) const { if (!StaticOrder::next(i, u)) return false; u.eb = __builtin_amdgcn_readfirstlane(tile_e[u.pm]); return true; }
};

template <class Epi, class Sched, bool ALIGN_EPI = false, bool SP2 = false>
__device__ __forceinline__ void gemm_phase(PG8_LAS unsigned char* lds, const Gemm g, const Sched& S, const Epi& E) {
    int tid_ = threadIdx.x; asm volatile("" : "+v"(tid_));
    const int tid = tid_, wid = __builtin_amdgcn_readfirstlane(tid >> 6), lane = tid & 63, wr = wid >> 2, wc = wid & 3, fr = lane & 15, fq = lane >> 4;
    const int K = g.K, nt = K / BK;
    unsigned voffA[2], voffB[2];
#pragma unroll
    for (int i = 0; i < 2; ++i) { int R, C; stage_rc(tid * 16 + i * 8192, R, C); const int Rb = Epi::PERM ? ((R & ~31) + perm32(R & 31)) : R;
        voffA[i] = (unsigned)(R * K + C) * 2u; voffB[i] = (unsigned)(Rb * K + C) * 2u; }
    const size_t kstep = (size_t)(BK * 2);
    const size_t hstep = (size_t)HALF * K * 2;
    const size_t tstep = 2 * hstep;
    const unsigned ldsw = (unsigned)wid * 1024u;
    const int aoff = lds_byte(wr * 64 + fr, fq * 8), boff = lds_byte(wc * 32 + fr, fq * 8);
#define PG8_SA(b, h) (((b) * 2 + (h)) * HTB)
#define PG8_SB(b, h) ((4 + (b) * 2 + (h)) * HTB)
#define PG8_STAGE(bufoff, gbase, voff) do { _Pragma("unroll") for (int _i = 0; _i < 2; ++_i) \
        __builtin_amdgcn_global_load_lds((const unsigned*)((const char*)(gbase) + (voff)[_i]), (PG8_LAS unsigned*)(lds + (bufoff) + ldsw + _i * 8192), 16, 0, 0); } while (0)
#define PG8_LDA(dst, b, h) do { _Pragma("unroll") for (int m = 0; m < 4; ++m) _Pragma("unroll") for (int k = 0; k < 2; ++k) dst[m][k] = *(const PG8_LAS bf16x8*)(lds + PG8_SA(b, h) + aoff + m * 2048 + k * 1024); } while (0)
#define PG8_LDB(dst, b, h) do { _Pragma("unroll") for (int n = 0; n < 2; ++n) _Pragma("unroll") for (int k = 0; k < 2; ++k) dst[n][k] = *(const PG8_LAS bf16x8*)(lds + PG8_SB(b, h) + boff + n * 2048 + k * 1024); } while (0)
#define PG8_MMA(ai, bj, At, Bt) do { __builtin_amdgcn_s_setprio(1); _Pragma("unroll") for (int m = 0; m < 4; ++m) _Pragma("unroll") for (int n = 0; n < 2; ++n) _Pragma("unroll") for (int k = 0; k < 2; ++k) \
        acc[ai][bj][m][n] = __builtin_amdgcn_mfma_f32_16x16x32_bf16(Bt[n][k], At[m][k], acc[ai][bj][m][n], 0, 0, 0); __builtin_amdgcn_s_setprio(0); } while (0)
#define PG8_WAIT_V(n) asm volatile("s_waitcnt vmcnt(" #n ")" ::: "memory")
#define PG8_WAIT_L(n) asm volatile("s_waitcnt lgkmcnt(" #n ")" ::: "memory")
#define PG8_BAR __builtin_amdgcn_s_barrier()
#define PG8_SCHED __builtin_amdgcn_sched_barrier(0)
    Unit cur, nxt; int ui = 0;
    if (!S.next(0, cur)) return;
    f32x4 acc[2][2][4][2];
#pragma unroll
    for (int a = 0; a < 2; ++a)
#pragma unroll
        for (int b = 0; b < 2; ++b)
#pragma unroll
            for (int m = 0; m < 4; ++m)
#pragma unroll
                for (int n = 0; n < 2; ++n) acc[a][b][m][n] = (f32x4){0.f, 0.f, 0.f, 0.f};
    bf16x8 At[4][2], B0[2][2], B1[2][2];
    const char* cA = (const char*)g.A + (size_t)cur.pm * tstep; const char* cB = (const char*)g.Bt + (size_t)cur.eb * g.bstride + (size_t)cur.pn * tstep;
    S.a_ready(cur);
    if constexpr (SP2) {
        PG8_STAGE(PG8_SB(0, 0), cB, voffB); PG8_STAGE(PG8_SB(0, 1), cB + hstep, voffB); PG8_STAGE(PG8_SA(0, 0), cA, voffA); PG8_STAGE(PG8_SA(0, 1), cA + hstep, voffA);
        if (wr == 1) PG8_BAR;
        PG8_WAIT_V(2); PG8_BAR;
        PG8_STAGE(PG8_SB(1, 0), cB + kstep, voffB); PG8_STAGE(PG8_SA(1, 0), cA + kstep, voffA); PG8_STAGE(PG8_SB(1, 1), cB + hstep + kstep, voffB);
        PG8_WAIT_V(6); PG8_BAR;
    } else {
        PG8_STAGE(PG8_SB(0, 0), cB, voffB); PG8_STAGE(PG8_SA(0, 0), cA, voffA); PG8_STAGE(PG8_SB(0, 1), cB + hstep, voffB); PG8_STAGE(PG8_SA(0, 1), cA + hstep, voffA);
        if (wr == 1) PG8_BAR;
        PG8_WAIT_V(4); PG8_BAR;
        PG8_STAGE(PG8_SB(1, 0), cB + kstep, voffB); PG8_STAGE(PG8_SA(1, 0), cA + kstep, voffA); PG8_STAGE(PG8_SB(1, 1), cB + hstep + kstep, voffB);
        PG8_WAIT_V(6); PG8_BAR;
    }
    for (;;) {
        const bool has_next = S.next(ui + 1, nxt);
        const char* nA = has_next ? (const char*)g.A + (size_t)nxt.pm * tstep : cA; const char* nB = has_next ? (const char*)g.Bt + (size_t)nxt.eb * g.bstride + (size_t)nxt.pn * tstep : cB;
        for (int t = 0; t < nt; t += 2) {
            const bool last = (t == nt - 2);
            const char* a1 = cA + (size_t)(t + 1) * kstep;
            const char* a2 = last ? nA : cA + (size_t)(t + 2) * kstep; const char* b2 = last ? nB : cB + (size_t)(t + 2) * kstep;
            const char* a3 = a2 + kstep; const char* b3 = b2 + kstep;
            if (last && has_next) S.a_ready(nxt);
            if constexpr (SP2) {
            PG8_LDB(B0, 0, 0); PG8_LDB(B1, 0, 1); PG8_SCHED; PG8_LDA(At, 0, 0); PG8_STAGE(PG8_SA(1, 1), a1 + hstep, voffA);
            PG8_WAIT_V(8); PG8_WAIT_L(0); PG8_BAR; PG8_MMA(0, 0, At, B0); PG8_MMA(0, 1, At, B1); PG8_BAR; PG8_SCHED;
            PG8_LDA(At, 0, 1); PG8_STAGE(PG8_SB(0, 0), b2, voffB); PG8_STAGE(PG8_SB(0, 1), b2 + hstep, voffB); PG8_STAGE(PG8_SA(0, 0), a2, voffA);
            PG8_WAIT_V(8); PG8_WAIT_L(0); PG8_BAR; PG8_MMA(1, 0, At, B0); PG8_MMA(1, 1, At, B1); PG8_BAR; PG8_SCHED;
            PG8_LDB(B0, 1, 0); PG8_LDB(B1, 1, 1); PG8_SCHED; PG8_LDA(At, 1, 0); PG8_STAGE(PG8_SA(0, 1), a2 + hstep, voffA);
            PG8_WAIT_V(8); PG8_WAIT_L(0); PG8_BAR; PG8_MMA(0, 0, At, B0); PG8_MMA(0, 1, At, B1); PG8_BAR; PG8_SCHED;
            PG8_LDA(At, 1, 1); PG8_STAGE(PG8_SB(1, 0), b3, voffB); PG8_STAGE(PG8_SB(1, 1), b3 + hstep, voffB); PG8_STAGE(PG8_SA(1, 0), a3, voffA);
            PG8_WAIT_V(8); PG8_WAIT_L(0); PG8_BAR; PG8_MMA(1, 0, At, B0); PG8_MMA(1, 1, At, B1); PG8_BAR; PG8_SCHED;
            } else {
            PG8_LDB(B0, 0, 0); PG8_SCHED; PG8_LDA(At, 0, 0); PG8_STAGE(PG8_SA(1, 1), a1 + hstep, voffA);
            PG8_WAIT_L(8); PG8_BAR; PG8_WAIT_L(0); PG8_MMA(0, 0, At, B0); PG8_BAR; PG8_SCHED;
            PG8_LDB(B1, 0, 1); PG8_STAGE(PG8_SB(0, 0), b2, voffB);
            PG8_BAR; PG8_WAIT_L(0); PG8_MMA(0, 1, At, B1); PG8_BAR;
            PG8_LDA(At, 0, 1); PG8_STAGE(PG8_SA(0, 0), a2, voffA);
            PG8_BAR; PG8_WAIT_L(0); PG8_MMA(1, 0, At, B0); PG8_BAR; PG8_SCHED;
            PG8_STAGE(PG8_SB(0, 1), b2 + hstep, voffB);
            PG8_WAIT_V(6); PG8_BAR; PG8_MMA(1, 1, At, B1); PG8_BAR;
            PG8_LDB(B0, 1, 0); PG8_SCHED; PG8_LDA(At, 1, 0); PG8_STAGE(PG8_SA(0, 1), a2 + hstep, voffA);
            PG8_WAIT_L(8); PG8_BAR; PG8_WAIT_L(0); PG8_MMA(0, 0, At, B0); PG8_BAR; PG8_SCHED;
            PG8_LDB(B1, 1, 1); PG8_STAGE(PG8_SB(1, 0), b3, voffB);
            PG8_BAR; PG8_WAIT_L(0); PG8_MMA(0, 1, At, B1); PG8_BAR;
            PG8_LDA(At, 1, 1); PG8_STAGE(PG8_SA(1, 0), a3, voffA);
            PG8_BAR; PG8_WAIT_L(0); PG8_MMA(1, 0, At, B0); PG8_BAR; PG8_SCHED;
            PG8_STAGE(PG8_SB(1, 1), b3 + hstep, voffB);
            PG8_WAIT_V(6); PG8_BAR; PG8_MMA(1, 1, At, B1); PG8_BAR;
            }
        }
        if constexpr (ALIGN_EPI) { if (wr == 0) PG8_BAR; }
        if constexpr (!Epi::AFTER_DRAIN) { E(acc, cur, wr, wc, fr, fq); S.done(cur); }
        if (!has_next) break;
#pragma unroll
        for (int a = 0; a < 2; ++a)
#pragma unroll
            for (int b = 0; b < 2; ++b)
#pragma unroll
                for (int m = 0; m < 4; ++m)
#pragma unroll
                    for (int n = 0; n < 2; ++n) acc[a][b][m][n] = (f32x4){0.f, 0.f, 0.f, 0.f};
        cur = nxt; cA = nA; cB = nB; ++ui;
        if constexpr (ALIGN_EPI) { if (wr == 1) PG8_BAR; }
    }
    PG8_WAIT_V(0);
    if constexpr (!ALIGN_EPI) { if (wr == 0) PG8_BAR; }
    PG8_BAR;
    if constexpr (Epi::AFTER_DRAIN) { E.fused(acc, cur, wr, wc, fr, fq, lds, wid, lane); S.done(cur); }
#undef PG8_SA
#undef PG8_SB
#undef PG8_STAGE
#undef PG8_LDA
#undef PG8_LDB
#undef PG8_MMA
#undef PG8_WAIT_V
#undef PG8_WAIT_L
#undef PG8_BAR
#undef PG8_SCHED
}
}


constexpr int S_LAT = 16384, C_CTX = 256, R_ALL = S_LAT + C_CTX, DM = 1024;
constexpr int INW = 2560, FFN = 2816, EXD = 3584, NEXP = 8;
constexpr int COL_AQ = 0, COL_AK = 512, COL_AV = 640, COL_HQ = 768, COL_HFF = 1024, COL_HFB = 1280, COL_HI = 1536, COL_HG = 1792, COL_GU = 2048, COL_GV = 2304;
constexpr int MIX_AT = 0, MIX_HG = 512, MIX_GM = 768;
constexpr int MOE_MAXROWS = 34816;
constexpr float EPS = 1e-6f;
constexpr int NWAVES = 8, NTHR = 512;
constexpr int NPH = 21;

constexpr size_t MiB = 1u << 20;
constexpr size_t WS_CTL = 0, CTL_ZERO_BYTES = 1 * MiB;
constexpr size_t WS_VEC = 1 * MiB;
constexpr size_t WS_TOK = 2 * MiB;
constexpr size_t WS_WIN = 3 * MiB;
constexpr size_t WS_WOUT = 13 * MiB;
constexpr size_t WS_WGU = 17 * MiB;
constexpr size_t WS_WD = 28 * MiB;
constexpr size_t WS_MGU = 34 * MiB;
constexpr size_t WS_MD = 146 * MiB;
constexpr size_t WS_H = 202 * MiB;
constexpr size_t WS_PROJ = 235 * MiB;
constexpr size_t WS_MIX = 317 * MiB;
constexpr size_t WS_HGO = 350 * MiB;
constexpr size_t WS_CTXR = 383 * MiB;
constexpr size_t WS_HID = WS_PROJ;
constexpr size_t WS_AS = 202 * MiB;
constexpr size_t WS_HIDM = 270 * MiB;
constexpr size_t WS_H2B = 440 * MiB;
constexpr size_t WS_Y = WS_MGU;
constexpr size_t WS_END = 508 * MiB;
static_assert(WS_HID + (size_t)R_ALL * FFN * 2 <= WS_HGO && WS_AS + (size_t)MOE_MAXROWS * DM * 2 <= WS_HIDM && WS_HIDM + (size_t)MOE_MAXROWS * EXD * 2 <= WS_END, "ws map");
static_assert(WS_H2B >= WS_HIDM && WS_H2B + (size_t)S_LAT * DM * 2 <= WS_END && WS_H + (size_t)R_ALL * DM * 2 <= WS_PROJ && WS_PROJ + (size_t)R_ALL * INW * 2 <= WS_MIX && WS_MIX + (size_t)R_ALL * DM * 2 <= WS_HGO && WS_HGO + (size_t)2 * R_ALL * 256 * 4 <= WS_CTXR, "ws map 2");
constexpr int VO_MOD = 0;
constexpr int VO_ROPE = 32768;
constexpr int VO_MOE = 65536;
constexpr int CW_BAR = 4096;
constexpr int CW_MOECNT = 1024;

constexpr int RING_BYTES = 131072;
constexpr int LDSCTL_OFF = RING_BYTES, MISC_OFF = LDSCTL_OFF + 320;
constexpr int LDS_BYTES = 147456;

#define GAS __attribute__((address_space(1)))
#define LAS __attribute__((address_space(3)))
typedef unsigned short bf16;
typedef unsigned v4u __attribute__((ext_vector_type(4)));
typedef unsigned v2u __attribute__((ext_vector_type(2)));
typedef float f32x4 __attribute__((ext_vector_type(4)));
typedef GAS unsigned gu32;
#define RLX_AGENT __ATOMIC_RELAXED, __HIP_MEMORY_SCOPE_AGENT
#define LDS_WAIT() asm volatile("s_waitcnt lgkmcnt(0)" ::: "memory")
__device__ __forceinline__ unsigned f2bf(float f) { unsigned u = __builtin_bit_cast(unsigned, f); return (u + 0x7fffu + ((u >> 16) & 1u)) >> 16; }
__device__ __forceinline__ unsigned pk2(float lo, float hi) { return f2bf(lo) | (f2bf(hi) << 16); }
__device__ __forceinline__ float bflo(unsigned w) { return __builtin_bit_cast(float, w << 16); }
__device__ __forceinline__ float bfhi(unsigned w) { return __builtin_bit_cast(float, w & 0xffff0000u); }
__device__ __forceinline__ float silu1(float x) { return x / (1.0f + __expf(-x)); }
__device__ __forceinline__ float sigm1(float x) { return 1.0f / (1.0f + __expf(-x)); }
__device__ __forceinline__ float gelu1(float x) { return 0.5f * x * (1.0f + erff(x * 0.70710678118654752f)); }
__device__ __forceinline__ float wave_sum(float v) {
#pragma unroll
    for (int o = 1; o < 64; o <<= 1) v += __shfl_xor(v, o);
    return v;
}
__device__ __forceinline__ void unpack8(const v4u w, float* f) { f[0] = bflo(w.x); f[1] = bfhi(w.x); f[2] = bflo(w.y); f[3] = bfhi(w.y); f[4] = bflo(w.z); f[5] = bfhi(w.z); f[6] = bflo(w.w); f[7] = bfhi(w.w); }

#define XB_TMO      128
#define XB_XCNT(j)  (256  + 64 * (j))
#define XB_XSUB(j)  (1280 + 64 * (j))
#define XB_XGEN(j)  (2304 + 64 * (j))
#define XB_TOP      3328
#define XB_TOPGEN   3392
#define XCD_BAR_WORDS 3456
#define XB_SPIN_CAP (1u << 18)

__device__ __forceinline__ unsigned xb_ld(unsigned* p)              { return __hip_atomic_load(p, __ATOMIC_RELAXED, __HIP_MEMORY_SCOPE_AGENT); }
__device__ __forceinline__ unsigned xb_add(unsigned* p, unsigned v) { return __hip_atomic_fetch_add(p, v, __ATOMIC_RELAXED, __HIP_MEMORY_SCOPE_AGENT); }
__device__ __forceinline__ unsigned xb_xcc_id() { return (unsigned)__builtin_amdgcn_s_getreg((3 << 11) | 20) & 0xFu; }
#define XB_SPIN(cond, bar) do { unsigned _sp = 0; while (cond) { __builtin_amdgcn_s_sleep(1); \
    if ((++_sp & 255u) == 0u) { if (xb_ld(&(bar)[XB_TMO])) break; if (_sp > XB_SPIN_CAP) { atomicAdd(&(bar)[XB_TMO], 1u); break; } } } } while (0)

struct XcdBarrier {
    unsigned* bar; unsigned x;
    volatile LAS unsigned* st;
};

__device__ __forceinline__ XcdBarrier xcd_barrier_post(unsigned* bar, volatile LAS unsigned* st) {
    XcdBarrier b; b.bar = bar; b.x = xb_xcc_id(); b.st = st;
    if (threadIdx.x == 0) (void)xb_add(&bar[XB_XCNT(b.x)], 1u);
    return b;
}
__device__ __forceinline__ void xcd_barrier_complete(unsigned* bar, unsigned x, unsigned& nloc, unsigned& nx) {
    const unsigned G = gridDim.x * gridDim.y * gridDim.z;
    unsigned sum, cnt, mine, sp = 0u;
    for (;;) {
        sum = 0u; cnt = 0u; mine = 0u;
#pragma unroll
        for (unsigned j = 0; j < 16; ++j) { const unsigned c = xb_ld(&bar[XB_XCNT(j)]); sum += c; cnt += (c > 0u) ? 1u : 0u; mine = (j == x) ? c : mine; }
        if (sum == G) break;
        __builtin_amdgcn_s_sleep(1);
        if ((++sp & 255u) == 0u) { if (xb_ld(&bar[XB_TMO])) break; if (sp > XB_SPIN_CAP) { atomicAdd(&bar[XB_TMO], 1u); break; } }
    }
    nloc = mine > 0u ? mine : 1u; nx = cnt > 0u ? cnt : 1u;
}

__device__ __forceinline__ void xcd_barrier(const XcdBarrier& b) {
    asm volatile("s_waitcnt vmcnt(0)" ::: "memory");
    __syncthreads();
    if (threadIdx.x == 0) {
        unsigned* bar = b.bar;
        __builtin_amdgcn_s_waitcnt(0);
        unsigned nloc = b.st[0], nx = b.st[1];
        if (nloc == 0u) { xcd_barrier_complete(bar, b.x, nloc, nx); b.st[0] = nloc; b.st[1] = nx; }
        const unsigned old = xb_add(&bar[XB_XSUB(b.x)], 1u);
        const unsigned gen = old / nloc;
        if (old + 1u == (gen + 1u) * nloc) {
            __builtin_amdgcn_fence(__ATOMIC_RELEASE, "agent");
            asm volatile("s_waitcnt vmcnt(0)" ::: "memory");
            const unsigned og = xb_add(&bar[XB_TOP], 1u);
            const unsigned tg = og / nx;
            if (og + 1u == (tg + 1u) * nx) xb_add(&bar[XB_TOPGEN], 1u);
            else XB_SPIN(xb_ld(&bar[XB_TOPGEN]) == tg, bar);
            __builtin_amdgcn_fence(__ATOMIC_ACQUIRE, "agent");
            xb_add(&bar[XB_XGEN(b.x)], 1u);
            asm volatile("s_waitcnt vmcnt(0)" ::: "memory");
        } else {
            XB_SPIN(xb_ld(&bar[XB_XGEN(b.x)]) == gen, bar);
            __builtin_amdgcn_fence(__ATOMIC_ACQUIRE, "agent");
            asm volatile("s_waitcnt vmcnt(0)" ::: "memory");
        }
    }
    __syncthreads();
}


struct Args { const float* in[23]; float* out; unsigned char* ws; int ph_lo, ph_hi; };
typedef const __attribute__((address_space(4))) Args* KA;
#define KARGS() ({ KA p_ = (KA)__builtin_amdgcn_kernarg_segment_ptr(); asm volatile("" : "+s"(p_)); p_; })
enum { I_X = 0, I_C, I_CTX, I_CCTX, I_WADA, I_BADA, I_WIN, I_WOUT, I_QG, I_KG, I_SINK, I_HLB, I_HGAIN, I_GWS, I_GBS, I_GNG, I_FG, I_FU, I_FD, I_ROUTER, I_MG, I_MU, I_MDN };

__device__ __forceinline__ void transpose_item(const float* W, int K, int N, bf16* WT, int mode, LAS float* scr, int item, int lane) {
    const int nblk = N / 32, kb = item / nblk, nb = item % nblk, k0 = 64 * kb, n0 = 32 * nb;
#pragma unroll 8
    for (int i = 0; i < 32; ++i) { const int kk = 2 * i + (lane >> 5); scr[kk * 33 + (lane & 31)] = W[(size_t)(k0 + kk) * N + n0 + (lane & 31)]; }
    LDS_WAIT(); asm volatile("" ::: "memory");
    const int c = lane & 7;
#pragma unroll
    for (int j = 0; j < 4; ++j) { const int n = (lane >> 3) + 8 * j; const LAS float* s = scr + (8 * c) * 33 + n;
        v4u o; o.x = pk2(s[0 * 33], s[1 * 33]); o.y = pk2(s[2 * 33], s[3 * 33]); o.z = pk2(s[4 * 33], s[5 * 33]); o.w = pk2(s[6 * 33], s[7 * 33]);
        const int ng = n0 + n; const int drow = (mode == 0) ? ng : (ng + 128 * (ng / 128) + (mode == 2 ? 128 : 0));
        *(GAS v4u*)(WT + (size_t)drow * K + k0 + 8 * c) = o; }
    LDS_WAIT(); asm volatile("" ::: "memory");
}
__device__ __forceinline__ void p0_prologue(KA a, LAS unsigned char* lds, int tid, int lane, int wave, int G, int bid) {
    unsigned char* ws = a->ws;
    LAS float* scr = (LAS float*)(lds + wave * 8704);
    const int gw = bid * NWAVES + wave, NGW = G * NWAVES;
    constexpr int I_IN = 16 * 80, I_OUT = 16 * 32, I_F = 16 * 88, I_FDN = 44 * 32, I_M = 16 * 112;
    constexpr int NIT = 2 * I_IN + 2 * I_OUT + 2 * I_F + I_FDN + 24 * I_M;
    for (int it0 = gw; it0 < NIT; it0 += NGW) {
        int it = it0;
        if (it < 2 * I_IN) { const int l = it / I_IN, r = it % I_IN; transpose_item(a->in[I_WIN] + (size_t)l * DM * INW, DM, INW, (bf16*)(ws + WS_WIN) + (size_t)l * INW * DM, 0, scr, r, lane); continue; } it -= 2 * I_IN;
        if (it < 2 * I_OUT) { const int l = it / I_OUT, r = it % I_OUT; transpose_item(a->in[I_WOUT] + (size_t)l * DM * DM, DM, DM, (bf16*)(ws + WS_WOUT) + (size_t)l * DM * DM, 0, scr, r, lane); continue; } it -= 2 * I_OUT;
        if (it < I_F) { transpose_item(a->in[I_FG], DM, FFN, (bf16*)(ws + WS_WGU), 1, scr, it, lane); continue; } it -= I_F;
        if (it < I_F) { transpose_item(a->in[I_FU], DM, FFN, (bf16*)(ws + WS_WGU), 2, scr, it, lane); continue; } it -= I_F;
        if (it < I_FDN) { transpose_item(a->in[I_FD], FFN, DM, (bf16*)(ws + WS_WD), 0, scr, it, lane); continue; } it -= I_FDN;
        { const int idx = it / I_M, r = it % I_M;
          if (idx < 8) transpose_item(a->in[I_MG] + (size_t)idx * DM * EXD, DM, EXD, (bf16*)(ws + WS_MGU) + (size_t)idx * 2 * EXD * DM, 1, scr, r, lane);
          else if (idx < 16) transpose_item(a->in[I_MU] + (size_t)(idx - 8) * DM * EXD, DM, EXD, (bf16*)(ws + WS_MGU) + (size_t)(idx - 8) * 2 * EXD * DM, 2, scr, r, lane);
          else transpose_item(a->in[I_MDN] + (size_t)(idx - 16) * EXD * DM, EXD, DM, (bf16*)(ws + WS_MD) + (size_t)(idx - 16) * DM * EXD, 0, scr, r, lane); }
    }
    LAS float* sil = (LAS float*)(lds + 69632);
    LAS float* part = (LAS float*)(lds + 69632 + 8192);
    float* vec = (float*)(ws + WS_VEC);
    if (bid < 192) {
        for (int i = tid; i < 2048; i += NTHR) { const float v = (i < 1024) ? a->in[I_C][i] : a->in[I_CCTX][i - 1024]; sil[i] = silu1(v); }
        __syncthreads();
        for (int item = bid; item < 192; item += G) {
            const int l = item / 96, cb = item % 96, col = cb * 64 + lane;
            const float* w = a->in[I_WADA] + (size_t)l * DM * 6144 + col;
            float a0 = 0.f, a1 = 0.f;
#pragma unroll 8
            for (int k = wave * 128; k < wave * 128 + 128; ++k) { const float wv = w[(size_t)k * 6144]; a0 += sil[k] * wv; a1 += sil[1024 + k] * wv; }
            part[(wave * 2 + 0) * 64 + lane] = a0; part[(wave * 2 + 1) * 64 + lane] = a1;
            __syncthreads();
            if (wave == 0) { float s0 = 0.f, s1 = 0.f;
#pragma unroll
                for (int w8 = 0; w8 < 8; ++w8) { s0 += part[(w8 * 2 + 0) * 64 + lane]; s1 += part[(w8 * 2 + 1) * 64 + lane]; }
                const float b = a->in[I_BADA][l * 6144 + col];
                vec[VO_MOD + (l * 2 + 0) * 6144 + col] = s0 + b; vec[VO_MOD + (l * 2 + 1) * 6144 + col] = s1 + b; }
            __syncthreads();
        }
    }
    if (bid == G - 1) {
        for (int idx = tid; idx < 5120; idx += NTHR) {
            const int isc = idx >= 4096, j = isc ? idx - 4096 : idx, pos = j / 16, i = j % 16;
            const float inv = exp2f(-(float)i * 0.83048202372184059f);
            const float ang = (float)pos * inv;
            double r = (double)ang * 0.15915494309189535; r -= floor(r);
            const float rf = (float)r;
            const float cs = __builtin_amdgcn_cosf(rf), sn = __builtin_amdgcn_sinf(rf);
            float* t = vec + VO_ROPE + (isc ? 8192 : 0);
            const int n = isc ? 1024 : 4096;
            t[j] = cs; t[n + j] = sn;
        }
    }
}

__device__ __forceinline__ void norm_row(const float* xrow, const float* sc, const float* sh, bf16* orow, int lane, f32x4 (&h)[4]) {
    const GAS f32x4* xr = (const GAS f32x4*)xrow + lane;
    f32x4 v[4]; float s = 0.f;
#pragma unroll
    for (int j = 0; j < 4; ++j) { v[j] = xr[64 * j]; s += (v[j].x * v[j].x + v[j].y * v[j].y) + (v[j].z * v[j].z + v[j].w * v[j].w); }
    const float rstd = __builtin_amdgcn_rsqf(wave_sum(s) * (1.0f / DM) + EPS);
    GAS v2u* o8 = (GAS v2u*)orow + lane;
#pragma unroll
    for (int j = 0; j < 4; ++j) { const f32x4 scv = *(const f32x4*)(sc + 4 * lane + 256 * j), shv = *(const f32x4*)(sh + 4 * lane + 256 * j);
        h[j] = v[j] * rstd * (scv + 1.0f) + shv;
        v2u w; w.x = pk2(h[j].x, h[j].y); w.y = pk2(h[j].z, h[j].w); o8[64 * j] = w; }
}
__device__ __forceinline__ void phase_norm(KA a, int l, int which, int nrows, bf16* H, int lane, int wave, int G, int bid) {
    const float* vec = (const float*)(a->ws + WS_VEC);
    const float* xl = (l == 0 && which == 0) ? a->in[I_X] : a->out;
    const float* xc = (l == 0 && which == 0) ? a->in[I_CTX] : (const float*)(a->ws + WS_CTXR);
    const float* ml = vec + VO_MOD + (l * 2 + 0) * 6144 + which * 3072;
    const float* mc = vec + VO_MOD + (l * 2 + 1) * 6144 + which * 3072;
    const int gw = bid * NWAVES + wave, NGW = G * NWAVES;
    for (int r = gw; r < nrows; r += NGW) {
        const bool isc = r >= S_LAT; f32x4 h[4];
        norm_row(isc ? xc + (size_t)(r - S_LAT) * DM : xl + (size_t)r * DM, (isc ? mc : ml) + 1024, isc ? mc : ml, H + (size_t)r * DM, lane, h);
    }
}
__device__ __forceinline__ void phase_norm_route(KA a, LAS unsigned char* lds, int tid, int lane, int wave, int G, int bid) {
    const int l = 1;
    const float* vec = (const float*)(a->ws + WS_VEC);
    const float* ml = vec + VO_MOD + (l * 2 + 0) * 6144 + 3072;
    bf16* H = (bf16*)(a->ws + WS_H2B);
    LAS float* rt = (LAS float*)lds;
    for (int i = tid; i < 8192; i += NTHR) rt[i] = a->in[I_ROUTER][i];
    __syncthreads();
    int* tokinfo = (int*)(a->ws + WS_TOK);
    unsigned* cnt = (unsigned*)(a->ws + WS_CTL) + CW_MOECNT;
    const int gw = bid * NWAVES + wave, NGW = G * NWAVES;
    for (int r = gw; r < S_LAT; r += NGW) {
        f32x4 h[4];
        norm_row(a->out + (size_t)r * DM, ml + 1024, ml, H + (size_t)r * DM, lane, h);
        float lg[8];
#pragma unroll
        for (int e = 0; e < 8; ++e) lg[e] = 0.f;
#pragma unroll
        for (int j = 0; j < 4; ++j)
#pragma unroll
            for (int i = 0; i < 4; ++i) { const int d = 4 * lane + 256 * j + i; const f32x4 r0 = *(const LAS f32x4*)(rt + d * 8), r1 = *(const LAS f32x4*)(rt + d * 8 + 4); const float hv = h[j][i];
                lg[0] += hv * r0.x; lg[1] += hv * r0.y; lg[2] += hv * r0.z; lg[3] += hv * r0.w; lg[4] += hv * r1.x; lg[5] += hv * r1.y; lg[6] += hv * r1.z; lg[7] += hv * r1.w; }
#pragma unroll
        for (int e = 0; e < 8; ++e) lg[e] = wave_sum(lg[e]);
        int i1 = 0; float v1 = lg[0];
#pragma unroll
        for (int e = 1; e < 8; ++e) if (lg[e] > v1) { v1 = lg[e]; i1 = e; }
        int i2 = -1; float v2 = -INFINITY;
#pragma unroll
        for (int e = 0; e < 8; ++e) if (e != i1 && lg[e] > v2) { v2 = lg[e]; i2 = e; }
        const float w1 = 1.0f / (1.0f + __expf(v2 - v1)), w2 = 1.0f - w1;
        if (lane == 0) {
            const unsigned r1 = __hip_atomic_fetch_add(cnt + i1, 1u, RLX_AGENT), r2 = __hip_atomic_fetch_add(cnt + i2, 1u, RLX_AGENT);
            int* ti = tokinfo + (size_t)r * 8;
            ti[0] = i1; ti[1] = i2; ti[2] = (int)r1; ti[3] = (int)r2; ti[4] = __builtin_bit_cast(int, w1); ti[5] = __builtin_bit_cast(int, w2);
        }
    }
}

__device__ __forceinline__ void qk_prep(KA a, int l, int first_thread, int nthreads) {
    bf16* PROJ = (bf16*)(a->ws + WS_PROJ);
    const float* rope = (const float*)(a->ws + WS_VEC) + VO_ROPE;
    for (int i = first_thread; i < R_ALL * 10; i += nthreads) {
        const int row = i / 10, hh = i % 10; const bool isq = hh < 8;
        bf16* p = PROJ + (size_t)row * INW + (isq ? hh * 64 : COL_AK + (hh - 8) * 64);
        const float* gain = (isq ? a->in[I_QG] : a->in[I_KG]) + l * 64;
        float x[64]; float ss = 0.f;
#pragma unroll
        for (int c = 0; c < 8; ++c) { const v4u w = *(const GAS v4u*)(p + 8 * c); unpack8(w, x + 8 * c); }
#pragma unroll
        for (int d = 0; d < 64; ++d) ss += x[d] * x[d];
        const float rstd = __builtin_amdgcn_rsqf(ss * (1.0f / 64.0f) + EPS);
#pragma unroll
        for (int d = 0; d < 64; ++d) x[d] = x[d] * rstd * gain[d];
        if (row < S_LAT) {
            const int gr = row >> 6, gc = row & 63;
            const float* cr = rope + gr * 16, * sr = rope + 4096 + gr * 16, * cc = rope + 8192 + gc * 16, * sc = rope + 8192 + 1024 + gc * 16;
#pragma unroll
            for (int j = 0; j < 16; ++j) { const float x1 = x[j], x2 = x[16 + j], c = cr[j], s = sr[j]; x[j] = x1 * c - x2 * s; x[16 + j] = x1 * s + x2 * c; }
#pragma unroll
            for (int j = 0; j < 16; ++j) { const float x1 = x[32 + j], x2 = x[48 + j], c = cc[j], s = sc[j]; x[32 + j] = x1 * c - x2 * s; x[48 + j] = x1 * s + x2 * c; }
        }
        const float qs = isq ? 0.125f * 1.4426950408889634f : 1.0f;
#pragma unroll
        for (int c = 0; c < 8; ++c) { v4u w; w.x = pk2(x[8 * c] * qs, x[8 * c + 1] * qs); w.y = pk2(x[8 * c + 2] * qs, x[8 * c + 3] * qs); w.z = pk2(x[8 * c + 4] * qs, x[8 * c + 5] * qs); w.w = pk2(x[8 * c + 6] * qs, x[8 * c + 7] * qs);
            *(GAS v4u*)(p + 8 * c) = w; }
    }
}
__device__ __forceinline__ void gmlp_unit(KA a, int l, int chunk, int g, LAS unsigned char* lds, int tid, int lane, int wave) {
    const bf16* PROJ = (const bf16*)(a->ws + WS_PROJ); bf16* MIX = (bf16*)(a->ws + WS_MIX);
    const int row0 = (chunk < 128) ? chunk * 128 : S_LAT + (chunk - 128) * 128;
    LAS float* vn = (LAS float*)lds;
    { const int pos = tid >> 2, part = tid & 3;
      const bf16* p = PROJ + (size_t)(row0 + pos) * INW + COL_GV + g * 64 + part * 16;
      float x[16]; unpack8(*(const GAS v4u*)p, x); unpack8(*(const GAS v4u*)(p + 8), x + 8);
      float ss = 0.f;
#pragma unroll
      for (int d = 0; d < 16; ++d) { x[d] = gelu1(x[d]); ss += x[d] * x[d]; }
      ss += __shfl_xor(ss, 1); ss += __shfl_xor(ss, 2);
      const float rstd = __builtin_amdgcn_rsqf(ss * (1.0f / 64.0f) + EPS);
      const float* gn = a->in[I_GNG] + l * 256 + g * 64 + part * 16;
#pragma unroll
      for (int d = 0; d < 16; ++d) vn[pos * 64 + part * 16 + d] = x[d] * rstd * gn[d]; }
    __syncthreads();
    const int c = lane, t0 = wave * 16;
    const float* W = a->in[I_GWS] + ((size_t)(l * 4 + g) * 128 + t0) * 128;
    float acc[16];
#pragma unroll
    for (int i = 0; i < 16; ++i) acc[i] = 0.f;
    for (int s = 0; s < 128; ++s) { const float v = vn[s * 64 + c];
#pragma unroll
        for (int i = 0; i < 16; ++i) acc[i] += W[i * 128 + s] * v; }
    const float* bs = a->in[I_GBS] + (l * 4 + g) * 128 + t0;
#pragma unroll
    for (int i = 0; i < 16; ++i) { const int row = row0 + t0 + i;
        const float u = gelu1(bflo((unsigned)PROJ[(size_t)row * INW + COL_GU + g * 64 + c]));
        MIX[(size_t)row * DM + MIX_GM + g * 64 + c] = (bf16)f2bf(u * (acc[i] + bs[i])); }
    __syncthreads();
}
__device__ __forceinline__ void hgrn_naive(KA a, int l, int dir, int head, LAS unsigned char* lds, int tid, int lane, int wave) {
    const bf16* PROJ = (const bf16*)(a->ws + WS_PROJ);
    float* HGO = (float*)(a->ws + WS_HGO) + (size_t)dir * R_ALL * 256;
    LAS float* Qs = (LAS float*)lds;
    LAS float* Fs = Qs + 4096; LAS float* Vs = Fs + 4096; LAS float* part = Vs + 4096;
    const int v = lane, kg = wave;
    float S[8];
#pragma unroll
    for (int i = 0; i < 8; ++i) S[i] = 0.f;
    const int tl = tid >> 3, c8 = tid & 7;
    float lb[8];
#pragma unroll
    for (int j = 0; j < 8; ++j) { float b = 0.f; if (l == 1) { const float p0 = a->in[I_HLB][dir * 512 + head * 64 + c8 * 8 + j], p1 = a->in[I_HLB][dir * 512 + 256 + head * 64 + c8 * 8 + j]; b = 1.0f / (1.0f + __expf(p0 - p1)); } lb[j] = b; }
    const int fcol = (dir == 0 ? COL_HFF : COL_HFB) + head * 64 + c8 * 8;
    for (int n0 = 0; n0 < R_ALL; n0 += 64) {
        { const int n = n0 + tl; int row;
          if (dir == 0) row = (n < C_CTX) ? S_LAT + n : n - C_CTX; else row = (n < C_CTX) ? S_LAT + (C_CTX - 1 - n) : (S_LAT - 1) - (n - C_CTX);
          const bf16* pr = PROJ + (size_t)row * INW;
          float q[8], f[8], vv[8];
          unpack8(*(const GAS v4u*)(pr + COL_HQ + head * 64 + c8 * 8), q); unpack8(*(const GAS v4u*)(pr + fcol), f); unpack8(*(const GAS v4u*)(pr + COL_HI + head * 64 + c8 * 8), vv);
#pragma unroll
          for (int j = 0; j < 8; ++j) { Qs[tl * 64 + c8 * 8 + j] = silu1(q[j]) * 0.125f; Fs[tl * 64 + c8 * 8 + j] = lb[j] + (1.0f - lb[j]) * sigm1(f[j]); Vs[tl * 64 + c8 * 8 + j] = vv[j]; } }
        __syncthreads();
        for (int t = 0; t < 64; ++t) {
            const float vt = Vs[t * 64 + v]; float po = 0.f;
#pragma unroll
            for (int i = 0; i < 8; ++i) { const float f = Fs[t * 64 + kg * 8 + i], q = Qs[t * 64 + kg * 8 + i]; S[i] = f * S[i] + (1.0f - f) * vt; po += S[i] * q; }
            part[((t & 1) * 8 + kg) * 64 + v] = po;
            __syncthreads();
            if (wave == 0) { float o = 0.f;
#pragma unroll
                for (int w8 = 0; w8 < 8; ++w8) o += part[((t & 1) * 8 + w8) * 64 + v];
                const int n = n0 + t; int row;
                if (dir == 0) row = (n < C_CTX) ? S_LAT + n : n - C_CTX; else row = (n < C_CTX) ? S_LAT + (C_CTX - 1 - n) : (S_LAT - 1) - (n - C_CTX);
                HGO[(size_t)row * 256 + head * 64 + v] = o; }
        }
        __syncthreads();
    }
}
__device__ __forceinline__ void attn_naive(KA a, int l, int nrows, int lane, int wave, int G, int bid) {
    const bf16* PROJ = (const bf16*)(a->ws + WS_PROJ); bf16* MIX = (bf16*)(a->ws + WS_MIX);
    const int gw = bid * NWAVES + wave, NGW = G * NWAVES;
    for (int pair = gw; pair < nrows * 2; pair += NGW) {
        const int row = pair >> 1, hk = pair & 1; const bool isctx = row >= S_LAT;
        float q[4], o[4], m[4], ls[4];
#pragma unroll
        for (int g = 0; g < 4; ++g) { q[g] = bflo((unsigned)PROJ[(size_t)row * INW + (hk * 4 + g) * 64 + lane]); o[g] = 0.f; ls[g] = 1.0f; m[g] = a->in[I_SINK][l * 8 + hk * 4 + g] * 1.4426950408889634f; }
        int j0 = 0, j1 = -1;
        if (!isctx) { j0 = row - 128 < 0 ? 0 : row - 128; j1 = row + 128 > S_LAT - 1 ? S_LAT - 1 : row + 128; }
        const int nwin = j1 - j0 + 1;
        const int nk = nwin + C_CTX;
#pragma unroll 4
        for (int t = 0; t < nk; ++t) {
            const int krow = (t < nwin) ? j0 + t : S_LAT + (t - nwin);
            const float k = bflo((unsigned)PROJ[(size_t)krow * INW + COL_AK + hk * 64 + lane]);
            const float v = bflo((unsigned)PROJ[(size_t)krow * INW + COL_AV + hk * 64 + lane]);
#pragma unroll
            for (int g = 0; g < 4; ++g) { const float s = wave_sum(q[g] * k); const float mn = fmaxf(m[g], s);
                const float c = __builtin_amdgcn_exp2f(m[g] - mn), p = __builtin_amdgcn_exp2f(s - mn);
                ls[g] = ls[g] * c + p; o[g] = o[g] * c + p * v; m[g] = mn; }
        }
#pragma unroll
        for (int g = 0; g < 4; ++g) MIX[(size_t)row * DM + MIX_AT + (hk * 4 + g) * 64 + lane] = (bf16)f2bf(o[g] / ls[g]);
    }
}
__device__ __forceinline__ void hgrn_combine(KA a, int l, int nrows, int lane, int wave, int G, int bid) {
    const bf16* PROJ = (const bf16*)(a->ws + WS_PROJ); bf16* MIX = (bf16*)(a->ws + WS_MIX);
    const float* O0 = (const float*)(a->ws + WS_HGO); const float* O1 = O0 + (size_t)R_ALL * 256;
    const f32x4 gn = *(const f32x4*)(a->in[I_HGAIN] + l * 64 + (lane & 15) * 4);
    const int gw = bid * NWAVES + wave, NGW = G * NWAVES;
    for (int r = gw; r < nrows; r += NGW) {
        const f32x4 o = *(const GAS f32x4*)(O0 + (size_t)r * 256 + 4 * lane) + *(const GAS f32x4*)(O1 + (size_t)r * 256 + 4 * lane);
        float ss = (o.x * o.x + o.y * o.y) + (o.z * o.z + o.w * o.w);
        ss += __shfl_xor(ss, 1); ss += __shfl_xor(ss, 2); ss += __shfl_xor(ss, 4); ss += __shfl_xor(ss, 8);
        const float rstd = __builtin_amdgcn_rsqf(ss * (1.0f / 64.0f) + EPS);
        const v2u gw2 = *(const GAS v2u*)(PROJ + (size_t)r * INW + COL_HG + 4 * lane);
        const float g0 = bflo(gw2.x), g1 = bfhi(gw2.x), g2 = bflo(gw2.y), g3 = bfhi(gw2.y);
        v2u w; w.x = pk2(o.x * rstd * gn.x * silu1(g0), o.y * rstd * gn.y * silu1(g1)); w.y = pk2(o.z * rstd * gn.z * silu1(g2), o.w * rstd * gn.w * silu1(g3));
        *(GAS v2u*)(MIX + (size_t)r * DM + MIX_HG + 4 * lane) = w;
    }
}
__device__ __forceinline__ void moe_gather(KA a, LAS unsigned char* lds, int tid, int lane, int wave, int G, int bid) {
    LAS int* sb = (LAS int*)lds;
    const unsigned* cnt = (const unsigned*)(a->ws + WS_CTL) + CW_MOECNT;
    int* mi = (int*)(a->ws + WS_VEC) + VO_MOE;
    if (tid == 0) { int b = 0;
        for (int e = 0; e < 8; ++e) { const int c = (int)__hip_atomic_load(cnt + e, RLX_AGENT); sb[e] = b; sb[16 + e] = c;
            const int nt = (c + 255) >> 8;
            if (bid == 0) for (int t = 0; t < nt; ++t) mi[16 + (b >> 8) + t] = e;
            b += nt << 8; }
        sb[8] = b; if (bid == 0) mi[0] = b >> 8; }
    __syncthreads();
    const bf16* H = (const bf16*)(a->ws + WS_H2B); bf16* AS = (bf16*)(a->ws + WS_AS);
    const int* tokinfo = (const int*)(a->ws + WS_TOK); int* tokslot = (int*)(a->ws + WS_TOK) + S_LAT * 8;
    const int gw = bid * NWAVES + wave, NGW = G * NWAVES;
    for (int t = gw; t < S_LAT; t += NGW) {
        const int* ti = tokinfo + (size_t)t * 8;
        const int e1 = ti[0], e2 = ti[1], r1 = ti[2], r2 = ti[3];
        const int s1 = sb[e1] + r1, s2 = sb[e2] + r2;
        const GAS v4u* src = (const GAS v4u*)(H + (size_t)t * DM) + lane;
        const v4u x0 = src[0], x1 = src[64];
        GAS v4u* d1 = (GAS v4u*)(AS + (size_t)s1 * DM) + lane; GAS v4u* d2 = (GAS v4u*)(AS + (size_t)s2 * DM) + lane;
        d1[0] = x0; d1[64] = x1; d2[0] = x0; d2[64] = x1;
        if (lane == 0) { int* ts = tokslot + (size_t)t * 4; ts[0] = s1; ts[1] = s2; ts[2] = ti[4]; ts[3] = ti[5]; }
    }
    for (int e = 0; e < 8; ++e) { const int c = sb[16 + e], pe = (c + 255) & ~255, b = sb[e];
        for (int j = c + gw; j < pe; j += NGW) { GAS v4u* d = (GAS v4u*)(AS + (size_t)(b + j) * DM) + lane; const v4u z = {0u, 0u, 0u, 0u}; d[0] = z; d[64] = z; } }
}
__device__ __forceinline__ void moe_combine(KA a, int lane, int wave, int G, int bid) {
    const float* gf = (const float*)(a->ws + WS_VEC) + VO_MOD + (1 * 2 + 0) * 6144 + 5 * 1024;
    const bf16* Y = (const bf16*)(a->ws + WS_Y); const int* tokslot = (const int*)(a->ws + WS_TOK) + S_LAT * 8;
    const int gw = bid * NWAVES + wave, NGW = G * NWAVES;
    for (int t = gw; t < S_LAT; t += NGW) {
        const int* ts = tokslot + (size_t)t * 4; const int s1 = ts[0], s2 = ts[1]; const float w1 = __builtin_bit_cast(float, ts[2]), w2 = __builtin_bit_cast(float, ts[3]);
        GAS f32x4* xr = (GAS f32x4*)(a->out + (size_t)t * DM) + lane;
        const GAS v2u* y1 = (const GAS v2u*)(Y + (size_t)s1 * DM) + lane; const GAS v2u* y2 = (const GAS v2u*)(Y + (size_t)s2 * DM) + lane;
#pragma unroll
        for (int j = 0; j < 4; ++j) { const v2u p = y1[64 * j], q = y2[64 * j]; const f32x4 g = *(const f32x4*)(gf + 4 * lane + 256 * j); f32x4 x = xr[64 * j];
            x.x += g.x * (w1 * bflo(p.x) + w2 * bflo(q.x)); x.y += g.y * (w1 * bfhi(p.x) + w2 * bfhi(q.x)); x.z += g.z * (w1 * bflo(p.y) + w2 * bflo(q.y)); x.w += g.w * (w1 * bfhi(p.y) + w2 * bfhi(q.y));
            xr[64 * j] = x; }
    }
}

__global__ void __launch_bounds__(NTHR, 2) fwd_kernel(Args a_unused) {
    extern __shared__ __attribute__((aligned(16))) unsigned char lds_raw[];
    LAS unsigned char* lds = (LAS unsigned char*)lds_raw;
    const int tid0 = threadIdx.x;
    for (int u = tid0; u < (LDS_BYTES - LDSCTL_OFF) / 4; u += NTHR) ((LAS unsigned*)(lds + LDSCTL_OFF))[u] = 0u;
    __syncthreads();
    const int lo = KARGS()->ph_lo, hi = KARGS()->ph_hi;
    const bool fusedl = (hi - lo) > 1;
    if (fusedl) (void)xcd_barrier_post((unsigned*)(KARGS()->ws + WS_CTL) + CW_BAR, (volatile LAS unsigned*)(lds + MISC_OFF) + 8);
#ifndef PHMASK
#define PHMASK 0xffffffffu
#endif
#define IN(k) (lo <= (k) && (k) < hi && ((PHMASK >> ((k) > 10 ? (k) - 10 : (k))) & 1u))
#define GRIDBAR() do { XcdBarrier b2_; b2_.bar = (unsigned*)(KARGS()->ws + WS_CTL) + CW_BAR; b2_.x = xb_xcc_id(); b2_.st = (volatile LAS unsigned*)(lds + MISC_OFF) + 8; xcd_barrier(b2_); } while (0)
#define SEAM(k) do { if (IN(k) && IN((k) + 1)) GRIDBAR(); } while (0)
#define PHASE_ROOTS() KA a = KARGS(); unsigned char* ws = a->ws; const float* vec = (const float*)(ws + WS_VEC); (void)vec; int bid = blockIdx.x, G = gridDim.x; asm volatile("" : "+s"(bid), "+s"(G)); int tid = threadIdx.x; asm volatile("" : "+v"(tid)); const int lane = tid & 63, wave = __builtin_amdgcn_readfirstlane(tid >> 6); (void)lane; (void)wave

    if (IN(0)) { PHASE_ROOTS(); p0_prologue(a, lds, tid, lane, wave, G, bid); SEAM(0); }

    for (int l = 0; l < 2; ++l) {
        const int pb = 1 + 10 * l;
        if (IN(pb + 0)) { PHASE_ROOTS(); phase_norm(a, l, 0, R_ALL, (bf16*)(ws + WS_H), lane, wave, G, bid); SEAM(pb + 0); }
        if (IN(pb + 1)) {
            PHASE_ROOTS();
            pg8::Gemm g{(const pg8::bf16_t*)(ws + WS_H), (const pg8::bf16_t*)(ws + WS_WIN) + (size_t)l * INW * DM, R_ALL, INW, DM, 0};
            pg8::StaticOrder S; S.init(R_ALL, INW, G, bid);
            pg8::EpiBf16<0> E{(pg8::bf16_t*)(ws + WS_PROJ), INW, nullptr, 0, 0, 1.f};
            pg8::gemm_phase<pg8::EpiBf16<0>, pg8::StaticOrder, true, true>(lds, g, S, E);
            SEAM(pb + 1);
        }
        if (IN(pb + 2)) {
            PHASE_ROOTS();
            if (bid < 8) hgrn_naive(a, l, bid >> 2, bid & 3, lds, tid, lane, wave);
            else {
                const int nb = G - 8, b = bid - 8;
                qk_prep(a, l, b * NTHR + tid, nb * NTHR);
                const int nch = (l == 0) ? 130 : 128;
                for (int it = b; it < nch * 4; it += nb) gmlp_unit(a, l, it >> 2, it & 3, lds, tid, lane, wave);
            }
            SEAM(pb + 2);
        }
        if (IN(pb + 3)) {
            PHASE_ROOTS();
            attn_naive(a, l, (l == 0) ? R_ALL : S_LAT, lane, wave, G, bid);
            hgrn_combine(a, l, (l == 0) ? R_ALL : S_LAT, lane, wave, G, bid);
            SEAM(pb + 3);
        }
        if (IN(pb + 4)) {
            PHASE_ROOTS();
            const float* modl = vec + VO_MOD + (l * 2 + 0) * 6144; const float* modc = vec + VO_MOD + (l * 2 + 1) * 6144;
            const int M = (l == 0) ? R_ALL : S_LAT;
            pg8::Gemm g{(const pg8::bf16_t*)(ws + WS_MIX), (const pg8::bf16_t*)(ws + WS_WOUT) + (size_t)l * DM * DM, M, DM, DM, 0};
            pg8::StaticOrder S; S.init(M, DM, G, bid);
            pg8::EpiResid E{(l == 0) ? a->in[I_X] : a->out, a->out, modl + 2048, a->in[I_CTX], (float*)(ws + WS_CTXR), modc + 2048, S_LAT / 256, DM};
            pg8::gemm_phase<pg8::EpiResid, pg8::StaticOrder, true, true>(lds, g, S, E);
            SEAM(pb + 4);
        }
        if (l == 0) {
            if (IN(pb + 5)) { PHASE_ROOTS(); phase_norm(a, l, 1, R_ALL, (bf16*)(ws + WS_H), lane, wave, G, bid); SEAM(pb + 5); }
            if (IN(pb + 6)) {
                PHASE_ROOTS();
                pg8::Gemm g{(const pg8::bf16_t*)(ws + WS_H), (const pg8::bf16_t*)(ws + WS_WGU), R_ALL, 2 * FFN, DM, 0};
                pg8::StaticOrder S; S.init(R_ALL, 2 * FFN, G, bid);
                pg8::EpiSwiGLU E{(pg8::bf16_t*)(ws + WS_HID), FFN};
                pg8::gemm_phase<pg8::EpiSwiGLU, pg8::StaticOrder, true, true>(lds, g, S, E);
                SEAM(pb + 6);
            }
            if (IN(pb + 7)) {
                PHASE_ROOTS();
                const float* modl = vec + VO_MOD + (l * 2 + 0) * 6144; const float* modc = vec + VO_MOD + (l * 2 + 1) * 6144;
                pg8::Gemm g{(const pg8::bf16_t*)(ws + WS_HID), (const pg8::bf16_t*)(ws + WS_WD), R_ALL, DM, FFN, 0};
                pg8::StaticOrder S; S.init(R_ALL, DM, G, bid);
                pg8::EpiResid E{a->out, a->out, modl + 5120, (const float*)(ws + WS_CTXR), (float*)(ws + WS_CTXR), modc + 5120, S_LAT / 256, DM};
                pg8::gemm_phase<pg8::EpiResid, pg8::StaticOrder, true, true>(lds, g, S, E);
                if (IN(pb + 7) && IN(pb + 10)) GRIDBAR();
            }
        } else {
            if (IN(pb + 5)) { PHASE_ROOTS(); phase_norm_route(a, lds, tid, lane, wave, G, bid); SEAM(pb + 5); }
            if (IN(pb + 6)) { PHASE_ROOTS(); moe_gather(a, lds, tid, lane, wave, G, bid); SEAM(pb + 6); }
            if (IN(pb + 7)) {
                PHASE_ROOTS();
                const int* mi = (const int*)(ws + WS_VEC) + VO_MOE; const int nt = __builtin_amdgcn_readfirstlane(mi[0]);
                pg8::Gemm g{(const pg8::bf16_t*)(ws + WS_AS), (const pg8::bf16_t*)(ws + WS_MGU), nt * 256, 2 * EXD, DM, (size_t)2 * EXD * DM * 2};
                pg8::MoeOrder S; S.init(nt * 256, 2 * EXD, G, bid); S.tile_e = mi + 16;
                pg8::EpiSwiGLU E{(pg8::bf16_t*)(ws + WS_HIDM), EXD};
                pg8::gemm_phase<pg8::EpiSwiGLU, pg8::MoeOrder, true, true>(lds, g, S, E);
                SEAM(pb + 7);
            }
            if (IN(pb + 8)) {
                PHASE_ROOTS();
                const int* mi = (const int*)(ws + WS_VEC) + VO_MOE; const int nt = __builtin_amdgcn_readfirstlane(mi[0]);
                pg8::Gemm g{(const pg8::bf16_t*)(ws + WS_HIDM), (const pg8::bf16_t*)(ws + WS_MD), nt * 256, DM, EXD, (size_t)DM * EXD * 2};
                pg8::MoeOrder S; S.init(nt * 256, DM, G, bid); S.tile_e = mi + 16;
                pg8::EpiBf16<0> E{(pg8::bf16_t*)(ws + WS_Y), DM, nullptr, 0, 0, 1.f};
                pg8::gemm_phase<pg8::EpiBf16<0>, pg8::MoeOrder, true, true>(lds, g, S, E);
                SEAM(pb + 8);
            }
            if (IN(pb + 9)) { PHASE_ROOTS(); moe_combine(a, lane, wave, G, bid); }
        }
    }
#undef IN
#undef SEAM
}

extern "C" void kernel_launch(void* const* d_in, const int* in_sizes, int n_in, void* d_out, int out_size, void* d_ws, size_t ws_size, hipStream_t stream) {
    static int grid = 0;
    if (grid == 0) {
        if (n_in != 23 || in_sizes[0] != S_LAT * DM || out_size != S_LAT * DM || ws_size < WS_END) { fprintf(stderr, "kernel_launch: unexpected shapes / workspace (n_in %d, ws %zu, need %zu)\n", n_in, ws_size, (size_t)WS_END); grid = -1; return; }
        int dev = 0, cus = 0;
        if (hipGetDevice(&dev) != hipSuccess || hipDeviceGetAttribute(&cus, hipDeviceAttributeMultiprocessorCount, dev) != hipSuccess) { grid = -1; return; }
        if (hipFuncSetAttribute((const void*)fwd_kernel, hipFuncAttributeMaxDynamicSharedMemorySize, LDS_BYTES) != hipSuccess) { grid = -1; return; }
        int per_cu = 0;
        (void)hipOccupancyMaxActiveBlocksPerMultiprocessor(&per_cu, (const void*)fwd_kernel, NTHR, LDS_BYTES);
        (void)hipGetLastError();
        grid = cus;
    }
    if (grid < 0) return;
    if (hipMemsetAsync((char*)d_ws + WS_CTL, 0, CTL_ZERO_BYTES, stream) != hipSuccess) return;
    Args a{};
    for (int i = 0; i < 23; ++i) a.in[i] = (const float*)d_in[i];
    a.out = (float*)d_out; a.ws = (unsigned char*)d_ws;
#if ONE_LAUNCH
    a.ph_lo = 0; a.ph_hi = NPH;
    hipLaunchKernelGGL(fwd_kernel, dim3(grid), dim3(NTHR), LDS_BYTES, stream, a);
#else
    for (int p = 0; p < NPH; ++p) {
        if (p == 9 || p == 10) continue;
        a.ph_lo = p; a.ph_hi = p + 1;
        hipLaunchKernelGGL(fwd_kernel, dim3(grid), dim3(NTHR), LDS_BYTES, stream, a);
    }
#endif
}
```

```cpp
#include <hip/hip_runtime.h>
#include <cstdio>
#include <cstdint>
#include <cmath>
#ifndef ONE_LAUNCH
#define ONE_LAUNCH 1
#endif
namespace pg8 {
#define PG8_LAS __attribute__((address_space(3)))
typedef unsigned short bf16_t;
typedef short bf16x8 __attribute__((ext_vector_type(8)));
typedef float f32x4 __attribute__((ext_vector_type(4)));
typedef unsigned u32x4 __attribute__((ext_vector_type(4)));
constexpr int BM = 256, BK = 64, HALF = 128, HTB = HALF * BK * 2  , STAGE_BYTES = 8 * HTB, NXCD = 8, WGM = 8;

__host__ __device__ __forceinline__ int lds_byte(int r, int c) { const int st = (r >> 4) * 2 + (c >> 5), rr = r & 15, cc = c & 31, ob = rr * 64 + cc * 2; return st * 1024 + (ob ^ (((ob >> 9) & 1) << 5)); }
__host__ __device__ __forceinline__ void stage_rc(int b, int& R, int& C) { const int st = b / 1024, sb = b % 1024, swz = sb ^ (((sb >> 9) & 1) << 5); R = (st >> 1) * 16 + swz / 64; C = (st & 1) * 32 + (swz % 64) / 2; }
__host__ __device__ __forceinline__ int perm32(int rho) { const int n = rho >> 4, i = rho & 15; return 8 * (i >> 2) + 4 * n + (i & 3); }

struct Unit { int pm, pn, eb; };
struct Gemm { const bf16_t* A; const bf16_t* Bt; int M, N, K; size_t bstride; };

struct StaticOrder {
    int nM, nN, nwg, G, c;
    __host__ __device__ void init(int M, int N, int G_, int c_) { nM = M / BM; nN = N / BM; nwg = nM * nN; G = G_; c = c_; }
    __host__ __device__ bool next(int i, Unit& u) const {
        const long L = (long)i * G + c; if (L >= nwg) return false;
        int wgid = (int)L; { const int q = nwg / NXCD, r = nwg % NXCD, xcd = wgid % NXCD, off = wgid / NXCD; wgid = (xcd < r ? xcd * (q + 1) : r * (q + 1) + (xcd - r) * q) + off; }
        const int nig = WGM * nN, gid = wgid / nig, fm = gid * WGM, gsz = (nM - fm) < WGM ? (nM - fm) : WGM;
        u.pm = fm + ((wgid % nig) % gsz); u.pn = (wgid % nig) / gsz; u.eb = 0; return true;
    }
    __device__ __forceinline__ void a_ready(const Unit&) const {}
    __device__ __forceinline__ void done(const Unit&) const {}
};

__device__ __forceinline__ unsigned cvt_pk_bf16(float lo, float hi) { unsigned r; asm volatile("v_cvt_pk_bf16_f32 %0, %1, %2" : "=v"(r) : "v"(lo), "v"(hi)); return r; }
typedef float f32x2 __attribute__((ext_vector_type(2)));
__device__ __forceinline__ f32x2 gelu_pk(f32x2 v) {
    const f32x2 av = __builtin_elementwise_abs(v), d = av * 0.2316418882f + 1.0f;
    f32x2 t; t.x = __builtin_amdgcn_rcpf(d.x); t.y = __builtin_amdgcn_rcpf(d.y);
    f32x2 q = t * 0.5307027145f + (-0.7265760135f); q = q * t + 0.7107068705f; q = q * t + (-0.142248368f); q = q * t + 0.127414796f; q = q * t;
    const f32x2 s = (v * v) * (-0.72134752044f);
    f32x2 e; e.x = __builtin_amdgcn_exp2f(s.x); e.y = __builtin_amdgcn_exp2f(s.y);
    const f32x2 m = v * (q * e), r = v - m;
    f32x2 o; o.x = v.x < 0.f ? m.x : r.x; o.y = v.y < 0.f ? m.y : r.y; return o;
}

template <int ACT  > struct EpiBf16 {
    static constexpr bool PERM = true, AFTER_DRAIN = false; static_assert(ACT == 0 || ACT == 1, "EpiBf16: ACT is 0 (none) or 1 (gelu_pk)");
    bf16_t* O; int ldc; const float* bias; int split_cols; size_t split_stride; float scale0;
    __device__ __forceinline__ void operator()(const f32x4 (&acc)[2][2][4][2], const Unit& u, int wr, int wc, int fr, int fq) const {
        const int row0 = u.pm * BM + wr * 64 + fr; int colt = u.pn * BM; bf16_t* base = O;
        float sc = 1.f; if (split_cols) { const int t = colt / split_cols; base += (size_t)t * split_stride; colt -= t * split_cols; if (t == 0) sc = scale0; }
        const int col0 = colt + wc * 32 + 8 * fq, bcol0 = u.pn * BM + wc * 32 + 8 * fq;
        f32x4 bv[2][2];
#pragma unroll
        for (int bj = 0; bj < 2; ++bj)
#pragma unroll
            for (int n = 0; n < 2; ++n) bv[bj][n] = bias ? *(const f32x4*)(bias + bcol0 + bj * HALF + 4 * n) : (f32x4){0.f, 0.f, 0.f, 0.f};
#pragma unroll
        for (int ai = 0; ai < 2; ++ai)
#pragma unroll
            for (int m = 0; m < 4; ++m) { bf16_t* rowp = base + (size_t)(row0 + ai * HALF + m * 16) * ldc + col0;
#pragma unroll
                for (int bj = 0; bj < 2; ++bj) { f32x4 v0 = acc[ai][bj][m][0] + bv[bj][0], v1 = acc[ai][bj][m][1] + bv[bj][1];
                    if (ACT == 1) { f32x2 a = gelu_pk((f32x2){v0[0], v0[1]}), b = gelu_pk((f32x2){v0[2], v0[3]}), c = gelu_pk((f32x2){v1[0], v1[1]}), d = gelu_pk((f32x2){v1[2], v1[3]});
                        v0 = (f32x4){a.x, a.y, b.x, b.y}; v1 = (f32x4){c.x, c.y, d.x, d.y}; }
                    v0 = v0 * sc; v1 = v1 * sc; u32x4 w; w.x = cvt_pk_bf16(v0[0], v0[1]); w.y = cvt_pk_bf16(v0[2], v0[3]); w.z = cvt_pk_bf16(v1[0], v1[1]); w.w = cvt_pk_bf16(v1[2], v1[3]);
                    *(u32x4*)(rowp + bj * HALF) = w; } }
    }
};

__device__ __forceinline__ float silu_f(float x) { return x * __builtin_amdgcn_rcpf(1.0f + __builtin_amdgcn_exp2f(-1.4426950408889634f * x)); }
struct EpiResid {
    static constexpr bool PERM = false, AFTER_DRAIN = false;
    const float* base; float* out; const float* gate; const float* cbase; float* cout; const float* cgate; int mlat; int ldc;
    __device__ __forceinline__ void operator()(const f32x4 (&acc)[2][2][4][2], const Unit& u, int wr, int wc, int fr, int fq) const {
        const bool isc = u.pm >= mlat;
        const float* b = isc ? cbase : base; float* o = isc ? cout : out; const float* g = isc ? cgate : gate;
        const int row0 = (isc ? (u.pm - mlat) : u.pm) * BM + wr * 64 + fr, col0 = u.pn * BM + wc * 32 + 4 * fq;
        f32x4 gv[2][2];
#pragma unroll
        for (int bj = 0; bj < 2; ++bj)
#pragma unroll
            for (int n = 0; n < 2; ++n) gv[bj][n] = *(const f32x4*)(g + col0 + bj * HALF + n * 16);
#pragma unroll
        for (int ai = 0; ai < 2; ++ai)
#pragma unroll
            for (int m = 0; m < 4; ++m) { const size_t off = (size_t)(row0 + ai * HALF + m * 16) * ldc + col0;
#pragma unroll
                for (int bj = 0; bj < 2; ++bj)
#pragma unroll
                    for (int n = 0; n < 2; ++n) { const f32x4 bs = *(const f32x4*)(b + off + bj * HALF + n * 16); *(f32x4*)(o + off + bj * HALF + n * 16) = bs + gv[bj][n] * acc[ai][bj][m][n]; }
                if (m & 1) asm volatile("" ::: "memory"); }
    }
};
struct EpiSwiGLU {
    static constexpr bool PERM = true, AFTER_DRAIN = false;
    bf16_t* O; int ldc;
    __device__ __forceinline__ void operator()(const f32x4 (&acc)[2][2][4][2], const Unit& u, int wr, int wc, int fr, int fq) const {
        const int row0 = u.pm * BM + wr * 64 + fr, col0 = u.pn * HALF + wc * 32 + 8 * fq;
#pragma unroll
        for (int ai = 0; ai < 2; ++ai)
#pragma unroll
            for (int m = 0; m < 4; ++m) { bf16_t* rowp = O + (size_t)(row0 + ai * HALF + m * 16) * ldc + col0;
                const f32x4 g0 = acc[ai][0][m][0], g1 = acc[ai][0][m][1], u0 = acc[ai][1][m][0], u1 = acc[ai][1][m][1];
                f32x4 h0, h1;
#pragma unroll
                for (int j = 0; j < 4; ++j) { h0[j] = silu_f(g0[j]) * u0[j]; h1[j] = silu_f(g1[j]) * u1[j]; }
                u32x4 w; w.x = cvt_pk_bf16(h0[0], h0[1]); w.y = cvt_pk_bf16(h0[2], h0[3]); w.z = cvt_pk_bf16(h1[0], h1[1]); w.w = cvt_pk_bf16(h1[2], h1[3]);
                *(u32x4*)rowp = w; }
    }
};
struct MoeOrder : StaticOrder {
    const int* tile_e;
    __device__ __forceinline__ bool next(int i, Unit& u) const { if (!StaticOrder::next(i, u)) return false; u.eb = __builtin_amdgcn_readfirstlane(tile_e[u.pm]); return true; }
};

template <class Epi, class Sched, bool ALIGN_EPI = false, bool SP2 = false>
__device__ __forceinline__ void gemm_phase(PG8_LAS unsigned char* lds, const Gemm g, const Sched& S, const Epi& E) {
    int tid_ = threadIdx.x; asm volatile("" : "+v"(tid_));
    const int tid = tid_, wid = __builtin_amdgcn_readfirstlane(tid >> 6), lane = tid & 63, wr = wid >> 2, wc = wid & 3, fr = lane & 15, fq = lane >> 4;
    const int K = g.K, nt = K / BK;
    unsigned voffA[2], voffB[2];
#pragma unroll
    for (int i = 0; i < 2; ++i) { int R, C; stage_rc(tid * 16 + i * 8192, R, C); const int Rb = Epi::PERM ? ((R & ~31) + perm32(R & 31)) : R;
        voffA[i] = (unsigned)(R * K + C) * 2u; voffB[i] = (unsigned)(Rb * K + C) * 2u; }
    const size_t kstep = (size_t)(BK * 2);
    const size_t hstep = (size_t)HALF * K * 2;
    const size_t tstep = 2 * hstep;
    const unsigned ldsw = (unsigned)wid * 1024u;
    const int aoff = lds_byte(wr * 64 + fr, fq * 8), boff = lds_byte(wc * 32 + fr, fq * 8);
#define PG8_SA(b, h) (((b) * 2 + (h)) * HTB)
#define PG8_SB(b, h) ((4 + (b) * 2 + (h)) * HTB)
#define PG8_STAGE(bufoff, gbase, voff) do { _Pragma("unroll") for (int _i = 0; _i < 2; ++_i) \
        __builtin_amdgcn_global_load_lds((const unsigned*)((const char*)(gbase) + (voff)[_i]), (PG8_LAS unsigned*)(lds + (bufoff) + ldsw + _i * 8192), 16, 0, 0); } while (0)
#define PG8_LDA(dst, b, h) do { _Pragma("unroll") for (int m = 0; m < 4; ++m) _Pragma("unroll") for (int k = 0; k < 2; ++k) dst[m][k] = *(const PG8_LAS bf16x8*)(lds + PG8_SA(b, h) + aoff + m * 2048 + k * 1024); } while (0)
#define PG8_LDB(dst, b, h) do { _Pragma("unroll") for (int n = 0; n < 2; ++n) _Pragma("unroll") for (int k = 0; k < 2; ++k) dst[n][k] = *(const PG8_LAS bf16x8*)(lds + PG8_SB(b, h) + boff + n * 2048 + k * 1024); } while (0)
#define PG8_MMA(ai, bj, At, Bt) do { __builtin_amdgcn_s_setprio(1); _Pragma("unroll") for (int m = 0; m < 4; ++m) _Pragma("unroll") for (int n = 0; n < 2; ++n) _Pragma("unroll") for (int k = 0; k < 2; ++k) \
        acc[ai][bj][m][n] = __builtin_amdgcn_mfma_f32_16x16x32_bf16(Bt[n][k], At[m][k], acc[ai][bj][m][n], 0, 0, 0); __builtin_amdgcn_s_setprio(0); } while (0)
#define PG8_WAIT_V(n) asm volatile("s_waitcnt vmcnt(" #n ")" ::: "memory")
#define PG8_WAIT_L(n) asm volatile("s_waitcnt lgkmcnt(" #n ")" ::: "memory")
#define PG8_BAR __builtin_amdgcn_s_barrier()
#define PG8_SCHED __builtin_amdgcn_sched_barrier(0)
    Unit cur, nxt; int ui = 0;
    if (!S.next(0, cur)) return;
    f32x4 acc[2][2][4][2];
#pragma unroll
    for (int a = 0; a < 2; ++a)
#pragma unroll
        for (int b = 0; b < 2; ++b)
#pragma unroll
            for (int m = 0; m < 4; ++m)
#pragma unroll
                for (int n = 0; n < 2; ++n) acc[a][b][m][n] = (f32x4){0.f, 0.f, 0.f, 0.f};
    bf16x8 At[4][2], B0[2][2], B1[2][2];
    const char* cA = (const char*)g.A + (size_t)cur.pm * tstep; const char* cB = (const char*)g.Bt + (size_t)cur.eb * g.bstride + (size_t)cur.pn * tstep;
    S.a_ready(cur);
    if constexpr (SP2) {
        PG8_STAGE(PG8_SB(0, 0), cB, voffB); PG8_STAGE(PG8_SB(0, 1), cB + hstep, voffB); PG8_STAGE(PG8_SA(0, 0), cA, voffA); PG8_STAGE(PG8_SA(0, 1), cA + hstep, voffA);
        if (wr == 1) PG8_BAR;
        PG8_WAIT_V(2); PG8_BAR;
        PG8_STAGE(PG8_SB(1, 0), cB + kstep, voffB); PG8_STAGE(PG8_SA(1, 0), cA + kstep, voffA); PG8_STAGE(PG8_SB(1, 1), cB + hstep + kstep, voffB);
        PG8_WAIT_V(6); PG8_BAR;
    } else {
        PG8_STAGE(PG8_SB(0, 0), cB, voffB); PG8_STAGE(PG8_SA(0, 0), cA, voffA); PG8_STAGE(PG8_SB(0, 1), cB + hstep, voffB); PG8_STAGE(PG8_SA(0, 1), cA + hstep, voffA);
        if (wr == 1) PG8_BAR;
        PG8_WAIT_V(4); PG8_BAR;
        PG8_STAGE(PG8_SB(1, 0), cB + kstep, voffB); PG8_STAGE(PG8_SA(1, 0), cA + kstep, voffA); PG8_STAGE(PG8_SB(1, 1), cB + hstep + kstep, voffB);
        PG8_WAIT_V(6); PG8_BAR;
    }
    for (;;) {
        const bool has_next = S.next(ui + 1, nxt);
        const char* nA = has_next ? (const char*)g.A + (size_t)nxt.pm * tstep : cA; const char* nB = has_next ? (const char*)g.Bt + (size_t)nxt.eb * g.bstride + (size_t)nxt.pn * tstep : cB;
        for (int t = 0; t < nt; t += 2) {
            const bool last = (t == nt - 2);
            const char* a1 = cA + (size_t)(t + 1) * kstep;
            const char* a2 = last ? nA : cA + (size_t)(t + 2) * kstep; const char* b2 = last ? nB : cB + (size_t)(t + 2) * kstep;
            const char* a3 = a2 + kstep; const char* b3 = b2 + kstep;
            if (last && has_next) S.a_ready(nxt);
            if constexpr (SP2) {
            PG8_LDB(B0, 0, 0); PG8_LDB(B1, 0, 1); PG8_SCHED; PG8_LDA(At, 0, 0); PG8_STAGE(PG8_SA(1, 1), a1 + hstep, voffA);
            PG8_WAIT_V(8); PG8_WAIT_L(0); PG8_BAR; PG8_MMA(0, 0, At, B0); PG8_MMA(0, 1, At, B1); PG8_BAR; PG8_SCHED;
            PG8_LDA(At, 0, 1); PG8_STAGE(PG8_SB(0, 0), b2, voffB); PG8_STAGE(PG8_SB(0, 1), b2 + hstep, voffB); PG8_STAGE(PG8_SA(0, 0), a2, voffA);
            PG8_WAIT_V(8); PG8_WAIT_L(0); PG8_BAR; PG8_MMA(1, 0, At, B0); PG8_MMA(1, 1, At, B1); PG8_BAR; PG8_SCHED;
            PG8_LDB(B0, 1, 0); PG8_LDB(B1, 1, 1); PG8_SCHED; PG8_LDA(At, 1, 0); PG8_STAGE(PG8_SA(0, 1), a2 + hstep, voffA);
            PG8_WAIT_V(8); PG8_WAIT_L(0); PG8_BAR; PG8_MMA(0, 0, At, B0); PG8_MMA(0, 1, At, B1); PG8_BAR; PG8_SCHED;
            PG8_LDA(At, 1, 1); PG8_STAGE(PG8_SB(1, 0), b3, voffB); PG8_STAGE(PG8_SB(1, 1), b3 + hstep, voffB); PG8_STAGE(PG8_SA(1, 0), a3, voffA);
            PG8_WAIT_V(8); PG8_WAIT_L(0); PG8_BAR; PG8_MMA(1, 0, At, B0); PG8_MMA(1, 1, At, B1); PG8_BAR; PG8_SCHED;
            } else {
            PG8_LDB(B0, 0, 0); PG8_SCHED; PG8_LDA(At, 0, 0); PG8_STAGE(PG8_SA(1, 1), a1 + hstep, voffA);
            PG8_WAIT_L(8); PG8_BAR; PG8_WAIT_L(0); PG8_MMA(0, 0, At, B0); PG8_BAR; PG8_SCHED;
            PG8_LDB(B1, 0, 1); PG8_STAGE(PG8_SB(0, 0), b2, voffB);
            PG8_BAR; PG8_WAIT_L(0); PG8_MMA(0, 1, At, B1); PG8_BAR;
            PG8_LDA(At, 0, 1); PG8_STAGE(PG8_SA(0, 0), a2, voffA);
            PG8_BAR; PG8_WAIT_L(0); PG8_MMA(1, 0, At, B0); PG8_BAR; PG8_SCHED;
            PG8_STAGE(PG8_SB(0, 1), b2 + hstep, voffB);
            PG8_WAIT_V(6); PG8_BAR; PG8_MMA(1, 1, At, B1); PG8_BAR;
            PG8_LDB(B0, 1, 0); PG8_SCHED; PG8_LDA(At, 1, 0); PG8_STAGE(PG8_SA(0, 1), a2 + hstep, voffA);
            PG8_WAIT_L(8); PG8_BAR; PG8_WAIT_L(0); PG8_MMA(0, 0, At, B0); PG8_BAR; PG8_SCHED;
            PG8_LDB(B1, 1, 1); PG8_STAGE(PG8_SB(1, 0), b3, voffB);
            PG8_BAR; PG8_WAIT_L(0); PG8_MMA(0, 1, At, B1); PG8_BAR;
            PG8_LDA(At, 1, 1); PG8_STAGE(PG8_SA(1, 0), a3, voffA);
            PG8_BAR; PG8_WAIT_L(0); PG8_MMA(1, 0, At, B0); PG8_BAR; PG8_SCHED;
            PG8_STAGE(PG8_SB(1, 1), b3 + hstep, voffB);
            PG8_WAIT_V(6); PG8_BAR; PG8_MMA(1, 1, At, B1); PG8_BAR;
            }
        }
        if constexpr (ALIGN_EPI) { if (wr == 0) PG8_BAR; }
        if constexpr (!Epi::AFTER_DRAIN) { E(acc, cur, wr, wc, fr, fq); S.done(cur); }
        if (!has_next) break;
#pragma unroll
        for (int a = 0; a < 2; ++a)
#pragma unroll
            for (int b = 0; b < 2; ++b)
#pragma unroll
                for (int m = 0; m < 4; ++m)
#pragma unroll
                    for (int n = 0; n < 2; ++n) acc[a][b][m][n] = (f32x4){0.f, 0.f, 0.f, 0.f};
        cur = nxt; cA = nA; cB = nB; ++ui;
        if constexpr (ALIGN_EPI) { if (wr == 1) PG8_BAR; }
    }
    PG8_WAIT_V(0);
    if constexpr (!ALIGN_EPI) { if (wr == 0) PG8_BAR; }
    PG8_BAR;
    if constexpr (Epi::AFTER_DRAIN) { E.fused(acc, cur, wr, wc, fr, fq, lds, wid, lane); S.done(cur); }
#undef PG8_SA
#undef PG8_SB
#undef PG8_STAGE
#undef PG8_LDA
#undef PG8_LDB
#undef PG8_MMA
#undef PG8_WAIT_V
#undef PG8_WAIT_L
#undef PG8_BAR
#undef PG8_SCHED
}
}


constexpr int S_LAT = 16384, C_CTX = 256, R_ALL = S_LAT + C_CTX, DM = 1024;
constexpr int INW = 2560, FFN = 2816, EXD = 3584, NEXP = 8;
constexpr int COL_AQ = 0, COL_AK = 512, COL_AV = 640, COL_HQ = 768, COL_HFF = 1024, COL_HFB = 1280, COL_HI = 1536, COL_HG = 1792, COL_GU = 2048, COL_GV = 2304;
constexpr int MIX_AT = 0, MIX_HG = 512, MIX_GM = 768;
constexpr int MOE_MAXROWS = 34816;
constexpr float EPS = 1e-6f;
constexpr int NWAVES = 8, NTHR = 512;
constexpr int NPH = 23;

constexpr size_t MiB = 1u << 20;
constexpr size_t WS_CTL = 0, CTL_ZERO_BYTES = 1 * MiB;
constexpr size_t WS_VEC = 1 * MiB;
constexpr size_t WS_TOK = 2 * MiB;
constexpr size_t WS_WIN = 3 * MiB;
constexpr size_t WS_WOUT = 13 * MiB;
constexpr size_t WS_WGU = 17 * MiB;
constexpr size_t WS_WD = 28 * MiB;
constexpr size_t WS_MGU = 34 * MiB;
constexpr size_t WS_MD = 146 * MiB;
constexpr size_t WS_H = 202 * MiB;
constexpr size_t WS_PROJ = 235 * MiB;
constexpr size_t WS_MIX = 317 * MiB;
constexpr size_t WS_HGO = 350 * MiB;
constexpr size_t WS_CTXR = 383 * MiB;
constexpr size_t WS_HLT = WS_HGO;
constexpr size_t WS_HSP = 384 * MiB;
constexpr size_t WS_HDG = 402 * MiB;
constexpr size_t WS_VT = 403 * MiB;
constexpr size_t WS_HID = WS_PROJ;
constexpr size_t WS_AS = 202 * MiB;
constexpr size_t WS_HIDM = 270 * MiB;
constexpr size_t WS_H2B = 440 * MiB;
constexpr size_t WS_Y = WS_MGU;
constexpr size_t WS_END = 508 * MiB;
static_assert(WS_HID + (size_t)R_ALL * FFN * 2 <= WS_HGO && WS_AS + (size_t)MOE_MAXROWS * DM * 2 <= WS_HIDM && WS_HIDM + (size_t)MOE_MAXROWS * EXD * 2 <= WS_END, "ws map");
static_assert(WS_H2B >= WS_HIDM && WS_H2B + (size_t)S_LAT * DM * 2 <= WS_END && WS_H + (size_t)R_ALL * DM * 2 <= WS_PROJ && WS_PROJ + (size_t)R_ALL * INW * 2 <= WS_MIX && WS_MIX + (size_t)R_ALL * DM * 2 <= WS_HGO && WS_HGO + (size_t)2 * R_ALL * 256 * 4 <= WS_CTXR, "ws map 2");
constexpr int VO_MOD = 0;
constexpr int VO_ROPE = 32768;
constexpr int VO_MOE = 65536;
constexpr int CW_BAR = 4096;
constexpr int CW_MOECNT = 1024;

constexpr int RING_BYTES = 131072;
constexpr int LDSCTL_OFF = 159744, MISC_OFF = LDSCTL_OFF + 320;
constexpr int LDS_BYTES = 163840;

#define GAS __attribute__((address_space(1)))
#define LAS __attribute__((address_space(3)))
typedef unsigned short bf16;
typedef unsigned v4u __attribute__((ext_vector_type(4)));
typedef unsigned v2u __attribute__((ext_vector_type(2)));
typedef float f32x4 __attribute__((ext_vector_type(4)));
typedef GAS unsigned gu32;
#define RLX_AGENT __ATOMIC_RELAXED, __HIP_MEMORY_SCOPE_AGENT
#define LDS_WAIT() asm volatile("s_waitcnt lgkmcnt(0)" ::: "memory")
__device__ __forceinline__ unsigned f2bf(float f) { unsigned u = __builtin_bit_cast(unsigned, f); return (u + 0x7fffu + ((u >> 16) & 1u)) >> 16; }
__device__ __forceinline__ unsigned pk2(float lo, float hi) { return f2bf(lo) | (f2bf(hi) << 16); }
__device__ __forceinline__ float bflo(unsigned w) { return __builtin_bit_cast(float, w << 16); }
__device__ __forceinline__ float bfhi(unsigned w) { return __builtin_bit_cast(float, w & 0xffff0000u); }
__device__ __forceinline__ float silu1(float x) { return x / (1.0f + __expf(-x)); }
__device__ __forceinline__ float sigm1(float x) { return 1.0f / (1.0f + __expf(-x)); }
__device__ __forceinline__ float gelu1(float x) { return 0.5f * x * (1.0f + erff(x * 0.70710678118654752f)); }
template <int X> __device__ __forceinline__ float sx(float v) { return __shfl_xor(v, X); }
__device__ __forceinline__ float sx32_add(float v) { return v + __shfl_xor(v, 32); }
__device__ __forceinline__ float sx32_max(float v) { return fmaxf(v, __shfl_xor(v, 32)); }
__device__ __forceinline__ float wave_sum(float v) { v += sx<1>(v); v += sx<2>(v); v += sx<4>(v); v += sx<8>(v); v += sx<16>(v); return sx32_add(v); }
__device__ __forceinline__ void unpack8(const v4u w, float* f) { f[0] = bflo(w.x); f[1] = bfhi(w.x); f[2] = bflo(w.y); f[3] = bfhi(w.y); f[4] = bflo(w.z); f[5] = bfhi(w.z); f[6] = bflo(w.w); f[7] = bfhi(w.w); }

#define XB_TMO      128
#define XB_XCNT(j)  (256  + 64 * (j))
#define XB_XSUB(j)  (1280 + 64 * (j))
#define XB_XGEN(j)  (2304 + 64 * (j))
#define XB_TOP      3328
#define XB_TOPGEN   3392
#define XCD_BAR_WORDS 3456
#define XB_SPIN_CAP (1u << 18)

__device__ __forceinline__ unsigned xb_ld(unsigned* p)              { return __hip_atomic_load(p, __ATOMIC_RELAXED, __HIP_MEMORY_SCOPE_AGENT); }
__device__ __forceinline__ unsigned xb_add(unsigned* p, unsigned v) { return __hip_atomic_fetch_add(p, v, __ATOMIC_RELAXED, __HIP_MEMORY_SCOPE_AGENT); }
__device__ __forceinline__ unsigned xb_xcc_id() { return (unsigned)__builtin_amdgcn_s_getreg((3 << 11) | 20) & 0xFu; }
#define XB_SPIN(cond, bar) do { unsigned _sp = 0; while (cond) { __builtin_amdgcn_s_sleep(1); \
    if ((++_sp & 255u) == 0u) { if (xb_ld(&(bar)[XB_TMO])) break; if (_sp > XB_SPIN_CAP) { atomicAdd(&(bar)[XB_TMO], 1u); break; } } } } while (0)

struct XcdBarrier {
    unsigned* bar; unsigned x;
    volatile LAS unsigned* st;
};

__device__ __forceinline__ XcdBarrier xcd_barrier_post(unsigned* bar, volatile LAS unsigned* st) {
    XcdBarrier b; b.bar = bar; b.x = xb_xcc_id(); b.st = st;
    if (threadIdx.x == 0) (void)xb_add(&bar[XB_XCNT(b.x)], 1u);
    return b;
}
__device__ __forceinline__ void xcd_barrier_complete(unsigned* bar, unsigned x, unsigned& nloc, unsigned& nx) {
    const unsigned G = gridDim.x * gridDim.y * gridDim.z;
    unsigned sum, cnt, mine, sp = 0u;
    for (;;) {
        sum = 0u; cnt = 0u; mine = 0u;
#pragma unroll
        for (unsigned j = 0; j < 16; ++j) { const unsigned c = xb_ld(&bar[XB_XCNT(j)]); sum += c; cnt += (c > 0u) ? 1u : 0u; mine = (j == x) ? c : mine; }
        if (sum == G) break;
        __builtin_amdgcn_s_sleep(1);
        if ((++sp & 255u) == 0u) { if (xb_ld(&bar[XB_TMO])) break; if (sp > XB_SPIN_CAP) { atomicAdd(&bar[XB_TMO], 1u); break; } }
    }
    nloc = mine > 0u ? mine : 1u; nx = cnt > 0u ? cnt : 1u;
}

__device__ __forceinline__ void xcd_barrier(const XcdBarrier& b) {
    asm volatile("s_waitcnt vmcnt(0)" ::: "memory");
    __syncthreads();
    if (threadIdx.x == 0) {
        unsigned* bar = b.bar;
        __builtin_amdgcn_s_waitcnt(0);
        unsigned nloc = b.st[0], nx = b.st[1];
        if (nloc == 0u) { xcd_barrier_complete(bar, b.x, nloc, nx); b.st[0] = nloc; b.st[1] = nx; }
        const unsigned old = xb_add(&bar[XB_XSUB(b.x)], 1u);
        const unsigned gen = old / nloc;
        if (old + 1u == (gen + 1u) * nloc) {
            __builtin_amdgcn_fence(__ATOMIC_RELEASE, "agent");
            asm volatile("s_waitcnt vmcnt(0)" ::: "memory");
            const unsigned og = xb_add(&bar[XB_TOP], 1u);
            const unsigned tg = og / nx;
            if (og + 1u == (tg + 1u) * nx) xb_add(&bar[XB_TOPGEN], 1u);
            else XB_SPIN(xb_ld(&bar[XB_TOPGEN]) == tg, bar);
            __builtin_amdgcn_fence(__ATOMIC_ACQUIRE, "agent");
            xb_add(&bar[XB_XGEN(b.x)], 1u);
            asm volatile("s_waitcnt vmcnt(0)" ::: "memory");
        } else {
            XB_SPIN(xb_ld(&bar[XB_XGEN(b.x)]) == gen, bar);
            __builtin_amdgcn_fence(__ATOMIC_ACQUIRE, "agent");
            asm volatile("s_waitcnt vmcnt(0)" ::: "memory");
        }
    }
    __syncthreads();
}


struct Args { const float* in[23]; float* out; unsigned char* ws; int ph_lo, ph_hi; };
typedef const __attribute__((address_space(4))) Args* KA;
#define KARGS() ({ KA p_ = (KA)__builtin_amdgcn_kernarg_segment_ptr(); asm volatile("" : "+s"(p_)); p_; })
enum { I_X = 0, I_C, I_CTX, I_CCTX, I_WADA, I_BADA, I_WIN, I_WOUT, I_QG, I_KG, I_SINK, I_HLB, I_HGAIN, I_GWS, I_GBS, I_GNG, I_FG, I_FU, I_FD, I_ROUTER, I_MG, I_MU, I_MDN };

__device__ __forceinline__ void transpose_item(const float* W, int K, int N, bf16* WT, int mode, LAS float* scr, int item, int lane) {
    const int nblk = N / 32, kb = item / nblk, nb = item % nblk, k0 = 64 * kb, n0 = 32 * nb;
#pragma unroll 8
    for (int i = 0; i < 32; ++i) { const int kk = 2 * i + (lane >> 5); scr[kk * 33 + (lane & 31)] = W[(size_t)(k0 + kk) * N + n0 + (lane & 31)]; }
    LDS_WAIT(); asm volatile("" ::: "memory");
    const int c = lane & 7;
#pragma unroll
    for (int j = 0; j < 4; ++j) { const int n = (lane >> 3) + 8 * j; const LAS float* s = scr + (8 * c) * 33 + n;
        v4u o; o.x = pk2(s[0 * 33], s[1 * 33]); o.y = pk2(s[2 * 33], s[3 * 33]); o.z = pk2(s[4 * 33], s[5 * 33]); o.w = pk2(s[6 * 33], s[7 * 33]);
        const int ng = n0 + n; const int drow = (mode == 0) ? ng : (ng + 128 * (ng / 128) + (mode == 2 ? 128 : 0));
        *(GAS v4u*)(WT + (size_t)drow * K + k0 + 8 * c) = o; }
    LDS_WAIT(); asm volatile("" ::: "memory");
}
__device__ __forceinline__ void p0_prologue(KA a, LAS unsigned char* lds, int tid, int lane, int wave, int G, int bid) {
    unsigned char* ws = a->ws;
    LAS float* scr = (LAS float*)(lds + wave * 8704);
    const int gw = bid * NWAVES + wave, NGW = G * NWAVES;
    constexpr int I_IN = 16 * 80, I_OUT = 16 * 32, I_F = 16 * 88, I_FDN = 44 * 32, I_M = 16 * 112;
    constexpr int NIT = 2 * I_IN + 2 * I_OUT + 2 * I_F + I_FDN + 24 * I_M;
    for (int it0 = gw; it0 < NIT; it0 += NGW) {
        int it = it0;
        if (it < 2 * I_IN) { const int l = it / I_IN, r = it % I_IN; transpose_item(a->in[I_WIN] + (size_t)l * DM * INW, DM, INW, (bf16*)(ws + WS_WIN) + (size_t)l * INW * DM, 0, scr, r, lane); continue; } it -= 2 * I_IN;
        if (it < 2 * I_OUT) { const int l = it / I_OUT, r = it % I_OUT; transpose_item(a->in[I_WOUT] + (size_t)l * DM * DM, DM, DM, (bf16*)(ws + WS_WOUT) + (size_t)l * DM * DM, 0, scr, r, lane); continue; } it -= 2 * I_OUT;
        if (it < I_F) { transpose_item(a->in[I_FG], DM, FFN, (bf16*)(ws + WS_WGU), 1, scr, it, lane); continue; } it -= I_F;
        if (it < I_F) { transpose_item(a->in[I_FU], DM, FFN, (bf16*)(ws + WS_WGU), 2, scr, it, lane); continue; } it -= I_F;
        if (it < I_FDN) { transpose_item(a->in[I_FD], FFN, DM, (bf16*)(ws + WS_WD), 0, scr, it, lane); continue; } it -= I_FDN;
        { const int idx = it / I_M, r = it % I_M;
          if (idx < 8) transpose_item(a->in[I_MG] + (size_t)idx * DM * EXD, DM, EXD, (bf16*)(ws + WS_MGU) + (size_t)idx * 2 * EXD * DM, 1, scr, r, lane);
          else if (idx < 16) transpose_item(a->in[I_MU] + (size_t)(idx - 8) * DM * EXD, DM, EXD, (bf16*)(ws + WS_MGU) + (size_t)(idx - 8) * 2 * EXD * DM, 2, scr, r, lane);
          else transpose_item(a->in[I_MDN] + (size_t)(idx - 16) * EXD * DM, EXD, DM, (bf16*)(ws + WS_MD) + (size_t)(idx - 16) * DM * EXD, 0, scr, r, lane); }
    }
    LAS float* sil = (LAS float*)(lds + 69632);
    LAS float* part = (LAS float*)(lds + 69632 + 8192);
    float* vec = (float*)(ws + WS_VEC);
    if (bid < 192) {
        for (int i = tid; i < 2048; i += NTHR) { const float v = (i < 1024) ? a->in[I_C][i] : a->in[I_CCTX][i - 1024]; sil[i] = silu1(v); }
        __syncthreads();
        for (int item = bid; item < 192; item += G) {
            const int l = item / 96, cb = item % 96, col = cb * 64 + lane;
            const float* w = a->in[I_WADA] + (size_t)l * DM * 6144 + col;
            float a0 = 0.f, a1 = 0.f;
#pragma unroll 8
            for (int k = wave * 128; k < wave * 128 + 128; ++k) { const float wv = w[(size_t)k * 6144]; a0 += sil[k] * wv; a1 += sil[1024 + k] * wv; }
            part[(wave * 2 + 0) * 64 + lane] = a0; part[(wave * 2 + 1) * 64 + lane] = a1;
            __syncthreads();
            if (wave == 0) { float s0 = 0.f, s1 = 0.f;
#pragma unroll
                for (int w8 = 0; w8 < 8; ++w8) { s0 += part[(w8 * 2 + 0) * 64 + lane]; s1 += part[(w8 * 2 + 1) * 64 + lane]; }
                const float b = a->in[I_BADA][l * 6144 + col];
                vec[VO_MOD + (l * 2 + 0) * 6144 + col] = s0 + b; vec[VO_MOD + (l * 2 + 1) * 6144 + col] = s1 + b; }
            __syncthreads();
        }
    }
    if (bid == G - 1) {
        for (int idx = tid; idx < 5120; idx += NTHR) {
            const int isc = idx >= 4096, j = isc ? idx - 4096 : idx, pos = j / 16, i = j % 16;
            const float inv = exp2f(-(float)i * 0.83048202372184059f);
            const float ang = (float)pos * inv;
            double r = (double)ang * 0.15915494309189535; r -= floor(r);
            const float rf = (float)r;
            const float cs = __builtin_amdgcn_cosf(rf), sn = __builtin_amdgcn_sinf(rf);
            float* t = vec + VO_ROPE + (isc ? 8192 : 0);
            const int n = isc ? 1024 : 4096;
            t[j] = cs; t[n + j] = sn;
        }
    }
}

__device__ __forceinline__ void norm_row(const float* xrow, const float* sc, const float* sh, bf16* orow, int lane, f32x4 (&h)[4]) {
    const GAS f32x4* xr = (const GAS f32x4*)xrow + lane;
    f32x4 v[4]; float s = 0.f;
#pragma unroll
    for (int j = 0; j < 4; ++j) { v[j] = xr[64 * j]; s += (v[j].x * v[j].x + v[j].y * v[j].y) + (v[j].z * v[j].z + v[j].w * v[j].w); }
    const float rstd = __builtin_amdgcn_rsqf(wave_sum(s) * (1.0f / DM) + EPS);
    GAS v2u* o8 = (GAS v2u*)orow + lane;
#pragma unroll
    for (int j = 0; j < 4; ++j) { const f32x4 scv = *(const f32x4*)(sc + 4 * lane + 256 * j), shv = *(const f32x4*)(sh + 4 * lane + 256 * j);
        h[j] = v[j] * rstd * (scv + 1.0f) + shv;
        v2u w; w.x = pk2(h[j].x, h[j].y); w.y = pk2(h[j].z, h[j].w); o8[64 * j] = w; }
}
__device__ __forceinline__ void phase_norm(KA a, int l, int which, int nrows, bf16* H, int lane, int wave, int G, int bid) {
    const float* vec = (const float*)(a->ws + WS_VEC);
    const float* xl = (l == 0 && which == 0) ? a->in[I_X] : a->out;
    const float* xc = (l == 0 && which == 0) ? a->in[I_CTX] : (const float*)(a->ws + WS_CTXR);
    const float* ml = vec + VO_MOD + (l * 2 + 0) * 6144 + which * 3072;
    const float* mc = vec + VO_MOD + (l * 2 + 1) * 6144 + which * 3072;
    const int gw = bid * NWAVES + wave, NGW = G * NWAVES;
    for (int r = gw; r < nrows; r += NGW) {
        const bool isc = r >= S_LAT; f32x4 h[4];
        norm_row(isc ? xc + (size_t)(r - S_LAT) * DM : xl + (size_t)r * DM, (isc ? mc : ml) + 1024, isc ? mc : ml, H + (size_t)r * DM, lane, h);
    }
}
__device__ __forceinline__ void phase_norm_route(KA a, LAS unsigned char* lds, int tid, int lane, int wave, int G, int bid) {
    const int l = 1;
    const float* vec = (const float*)(a->ws + WS_VEC);
    const float* ml = vec + VO_MOD + (l * 2 + 0) * 6144 + 3072;
    bf16* H = (bf16*)(a->ws + WS_H2B);
    LAS float* rt = (LAS float*)lds;
    for (int i = tid; i < 8192; i += NTHR) rt[i] = a->in[I_ROUTER][i];
    __syncthreads();
    int* tokinfo = (int*)(a->ws + WS_TOK);
    unsigned* cnt = (unsigned*)(a->ws + WS_CTL) + CW_MOECNT;
    const int gw = bid * NWAVES + wave, NGW = G * NWAVES;
    for (int r = gw; r < S_LAT; r += NGW) {
        f32x4 h[4];
        norm_row(a->out + (size_t)r * DM, ml + 1024, ml, H + (size_t)r * DM, lane, h);
        float lg[8];
#pragma unroll
        for (int e = 0; e < 8; ++e) lg[e] = 0.f;
#pragma unroll
        for (int j = 0; j < 4; ++j)
#pragma unroll
            for (int i = 0; i < 4; ++i) { const int d = 4 * lane + 256 * j + i; const f32x4 r0 = *(const LAS f32x4*)(rt + d * 8), r1 = *(const LAS f32x4*)(rt + d * 8 + 4); const float hv = h[j][i];
                lg[0] += hv * r0.x; lg[1] += hv * r0.y; lg[2] += hv * r0.z; lg[3] += hv * r0.w; lg[4] += hv * r1.x; lg[5] += hv * r1.y; lg[6] += hv * r1.z; lg[7] += hv * r1.w; }
#pragma unroll
        for (int e = 0; e < 8; ++e) lg[e] = wave_sum(lg[e]);
        int i1 = 0; float v1 = lg[0];
#pragma unroll
        for (int e = 1; e < 8; ++e) if (lg[e] > v1) { v1 = lg[e]; i1 = e; }
        int i2 = -1; float v2 = -INFINITY;
#pragma unroll
        for (int e = 0; e < 8; ++e) if (e != i1 && lg[e] > v2) { v2 = lg[e]; i2 = e; }
        const float w1 = 1.0f / (1.0f + __expf(v2 - v1)), w2 = 1.0f - w1;
        if (lane == 0) {
            const unsigned r1 = __hip_atomic_fetch_add(cnt + i1, 1u, RLX_AGENT), r2 = __hip_atomic_fetch_add(cnt + i2, 1u, RLX_AGENT);
            int* ti = tokinfo + (size_t)r * 8;
            ti[0] = i1; ti[1] = i2; ti[2] = (int)r1; ti[3] = (int)r2; ti[4] = __builtin_bit_cast(int, w1); ti[5] = __builtin_bit_cast(int, w2);
        }
    }
}

__device__ __forceinline__ void qk_prep(KA a, int l, int first_thread, int nthreads) {
    bf16* PROJ = (bf16*)(a->ws + WS_PROJ);
    const float* rope = (const float*)(a->ws + WS_VEC) + VO_ROPE;
    for (int i = first_thread; i < R_ALL * 10; i += nthreads) {
        const int row = i / 10, hh = i % 10; const bool isq = hh < 8;
        bf16* p = PROJ + (size_t)row * INW + (isq ? hh * 64 : COL_AK + (hh - 8) * 64);
        const float* gain = (isq ? a->in[I_QG] : a->in[I_KG]) + l * 64;
        float x[64]; float ss = 0.f;
#pragma unroll
        for (int c = 0; c < 8; ++c) { const v4u w = *(const GAS v4u*)(p + 8 * c); unpack8(w, x + 8 * c); }
#pragma unroll
        for (int d = 0; d < 64; ++d) ss += x[d] * x[d];
        const float rstd = __builtin_amdgcn_rsqf(ss * (1.0f / 64.0f) + EPS);
#pragma unroll
        for (int d = 0; d < 64; ++d) x[d] = x[d] * rstd * gain[d];
        if (row < S_LAT) {
            const int gr = row >> 6, gc = row & 63;
            const float* cr = rope + gr * 16, * sr = rope + 4096 + gr * 16, * cc = rope + 8192 + gc * 16, * sc = rope + 8192 + 1024 + gc * 16;
#pragma unroll
            for (int j = 0; j < 16; ++j) { const float x1 = x[j], x2 = x[16 + j], c = cr[j], s = sr[j]; x[j] = x1 * c - x2 * s; x[16 + j] = x1 * s + x2 * c; }
#pragma unroll
            for (int j = 0; j < 16; ++j) { const float x1 = x[32 + j], x2 = x[48 + j], c = cc[j], s = sc[j]; x[32 + j] = x1 * c - x2 * s; x[48 + j] = x1 * s + x2 * c; }
        }
        const float qs = isq ? 0.125f * 1.4426950408889634f : 1.0f;
#pragma unroll
        for (int c = 0; c < 8; ++c) { v4u w; w.x = pk2(x[8 * c] * qs, x[8 * c + 1] * qs); w.y = pk2(x[8 * c + 2] * qs, x[8 * c + 3] * qs); w.z = pk2(x[8 * c + 4] * qs, x[8 * c + 5] * qs); w.w = pk2(x[8 * c + 6] * qs, x[8 * c + 7] * qs);
            *(GAS v4u*)(p + 8 * c) = w; }
    }
}
__device__ __forceinline__ void gmlp_unit(KA a, int l, int chunk, int g, LAS unsigned char* lds, int tid, int lane, int wave) {
    const bf16* PROJ = (const bf16*)(a->ws + WS_PROJ); bf16* MIX = (bf16*)(a->ws + WS_MIX);
    const int row0 = (chunk < 128) ? chunk * 128 : S_LAT + (chunk - 128) * 128;
    LAS float* vn = (LAS float*)lds;
    { const int pos = tid >> 2, part = tid & 3;
      const bf16* p = PROJ + (size_t)(row0 + pos) * INW + COL_GV + g * 64 + part * 16;
      float x[16]; unpack8(*(const GAS v4u*)p, x); unpack8(*(const GAS v4u*)(p + 8), x + 8);
      float ss = 0.f;
#pragma unroll
      for (int d = 0; d < 16; ++d) { x[d] = gelu1(x[d]); ss += x[d] * x[d]; }
      ss += sx<1>(ss); ss += sx<2>(ss);
      const float rstd = __builtin_amdgcn_rsqf(ss * (1.0f / 64.0f) + EPS);
      const float* gn = a->in[I_GNG] + l * 256 + g * 64 + part * 16;
#pragma unroll
      for (int d = 0; d < 16; ++d) vn[pos * 64 + part * 16 + d] = x[d] * rstd * gn[d]; }
    __syncthreads();
    const int c = lane, t0 = wave * 16;
    const float* W = a->in[I_GWS] + ((size_t)(l * 4 + g) * 128 + t0) * 128;
    float acc[16];
#pragma unroll
    for (int i = 0; i < 16; ++i) acc[i] = 0.f;
    for (int s = 0; s < 128; ++s) { const float v = vn[s * 64 + c];
#pragma unroll
        for (int i = 0; i < 16; ++i) acc[i] += W[i * 128 + s] * v; }
    const float* bs = a->in[I_GBS] + (l * 4 + g) * 128 + t0;
#pragma unroll
    for (int i = 0; i < 16; ++i) { const int row = row0 + t0 + i;
        const float u = gelu1(bflo((unsigned)PROJ[(size_t)row * INW + COL_GU + g * 64 + c]));
        MIX[(size_t)row * DM + MIX_GM + g * 64 + c] = (bf16)f2bf(u * (acc[i] + bs[i])); }
    __syncthreads();
}
__device__ __forceinline__ void hgrn_naive(KA a, int l, int dir, int head, LAS unsigned char* lds, int tid, int lane, int wave) {
    const bf16* PROJ = (const bf16*)(a->ws + WS_PROJ);
    float* HGO = (float*)(a->ws + WS_HGO) + (size_t)dir * R_ALL * 256;
    LAS float* Qs = (LAS float*)lds;
    LAS float* Fs = Qs + 4096; LAS float* Vs = Fs + 4096; LAS float* part = Vs + 4096;
    const int v = lane, kg = wave;
    float S[8];
#pragma unroll
    for (int i = 0; i < 8; ++i) S[i] = 0.f;
    const int tl = tid >> 3, c8 = tid & 7;
    float lb[8];
#pragma unroll
    for (int j = 0; j < 8; ++j) { float b = 0.f; if (l == 1) { const float p0 = a->in[I_HLB][dir * 512 + head * 64 + c8 * 8 + j], p1 = a->in[I_HLB][dir * 512 + 256 + head * 64 + c8 * 8 + j]; b = 1.0f / (1.0f + __expf(p0 - p1)); } lb[j] = b; }
    const int fcol = (dir == 0 ? COL_HFF : COL_HFB) + head * 64 + c8 * 8;
    for (int n0 = 0; n0 < R_ALL; n0 += 64) {
        { const int n = n0 + tl; int row;
          if (dir == 0) row = (n < C_CTX) ? S_LAT + n : n - C_CTX; else row = (n < C_CTX) ? S_LAT + (C_CTX - 1 - n) : (S_LAT - 1) - (n - C_CTX);
          const bf16* pr = PROJ + (size_t)row * INW;
          float q[8], f[8], vv[8];
          unpack8(*(const GAS v4u*)(pr + COL_HQ + head * 64 + c8 * 8), q); unpack8(*(const GAS v4u*)(pr + fcol), f); unpack8(*(const GAS v4u*)(pr + COL_HI + head * 64 + c8 * 8), vv);
#pragma unroll
          for (int j = 0; j < 8; ++j) { Qs[tl * 64 + c8 * 8 + j] = silu1(q[j]) * 0.125f; Fs[tl * 64 + c8 * 8 + j] = lb[j] + (1.0f - lb[j]) * sigm1(f[j]); Vs[tl * 64 + c8 * 8 + j] = vv[j]; } }
        __syncthreads();
        for (int t = 0; t < 64; ++t) {
            const float vt = Vs[t * 64 + v]; float po = 0.f;
#pragma unroll
            for (int i = 0; i < 8; ++i) { const float f = Fs[t * 64 + kg * 8 + i], q = Qs[t * 64 + kg * 8 + i]; S[i] = f * S[i] + (1.0f - f) * vt; po += S[i] * q; }
            part[((t & 1) * 8 + kg) * 64 + v] = po;
            __syncthreads();
            if (wave == 0) { float o = 0.f;
#pragma unroll
                for (int w8 = 0; w8 < 8; ++w8) o += part[((t & 1) * 8 + w8) * 64 + v];
                const int n = n0 + t; int row;
                if (dir == 0) row = (n < C_CTX) ? S_LAT + n : n - C_CTX; else row = (n < C_CTX) ? S_LAT + (C_CTX - 1 - n) : (S_LAT - 1) - (n - C_CTX);
                HGO[(size_t)row * 256 + head * 64 + v] = o; }
        }
        __syncthreads();
    }
}

typedef short bf16x8v __attribute__((ext_vector_type(8)));
constexpr int HST = 72;
__device__ __forceinline__ f32x4 mma16(const LAS bf16* MA, const LAS bf16* MBt, int k0, f32x4 c, int lane) {
    const bf16x8v av = *(const LAS bf16x8v*)(MA + (lane & 15) * HST + k0 + 8 * (lane >> 4));
    const bf16x8v bv = *(const LAS bf16x8v*)(MBt + (lane & 15) * HST + k0 + 8 * (lane >> 4));
    return __builtin_amdgcn_mfma_f32_16x16x32_bf16(av, bv, c, 0, 0, 0);
}
__device__ __forceinline__ int hg_base_row(int cpos) { return cpos < 256 ? 64 * cpos : S_LAT + 64 * (cpos - 256); }
__device__ __forceinline__ int hg_scan_idx(int dir, int cpos) { return dir == 0 ? (cpos < 256 ? 4 + cpos : cpos - 256) : (cpos < 256 ? 4 + (255 - cpos) : 3 - (cpos - 256)); }
__device__ __forceinline__ float hg_lb(KA a, int l, int dir, int head, int k) {
    if (l == 0) return 0.f;
    const float p0 = a->in[I_HLB][dir * 512 + head * 64 + k], p1 = a->in[I_HLB][dir * 512 + 256 + head * 64 + k];
    return 1.0f / (1.0f + __expf(p0 - p1));
}
__device__ __forceinline__ void hgrn_stepA(KA a, int l, int cpos, int head, LAS unsigned char* lds, int lane, int wave) {
    const bf16* PROJ = (const bf16*)(a->ws + WS_PROJ);
    const int dir = wave >> 2, I = wave & 3, base = hg_base_row(cpos), ci = hg_scan_idx(dir, cpos);
    LAS float* TOT = (LAS float*)lds;
    LAS bf16* KLT = (LAS bf16*)(lds + 2048) + dir * 64 * HST;
    LAS bf16* VT = (LAS bf16*)(lds + 2048 + 2 * 64 * HST * 2) + dir * 64 * HST;
    const float lb = hg_lb(a, l, dir, head, lane);
    const int fcol = (dir == 0 ? COL_HFF : COL_HFB) + head * 64 + lane, vcol = COL_HI + head * 64 + lane;
    float kk[16], cl[16]; float run = 0.f;
#pragma unroll
    for (int i = 0; i < 16; ++i) { const int n = 16 * I + i, row = base + (dir ? 63 - n : n);
        const float fl = bflo((unsigned)PROJ[(size_t)row * INW + fcol]);
        const unsigned short vb = PROJ[(size_t)row * INW + vcol];
        const float f = lb + (1.0f - lb) * sigm1(fl);
        run += __logf(f); cl[i] = run; kk[i] = 1.0f - f;
        VT[lane * HST + n] = vb; }
    TOT[(dir * 4 + I) * 64 + lane] = run;
    __syncthreads();
    float post = 0.f, all = 0.f;
#pragma unroll
    for (int J = 0; J < 4; ++J) { const float t = TOT[(dir * 4 + J) * 64 + lane]; all += t; if (J > I) post += t; }
#pragma unroll
    for (int i = 0; i < 16; ++i) KLT[lane * HST + 16 * I + i] = (bf16)f2bf(kk[i] * __expf(run - cl[i] + post));
    if (I == 0) ((float*)(a->ws + WS_HDG))[((size_t)(dir * 4 + head) * 260 + ci) * 64 + lane] = __expf(all);
    __syncthreads();
    float* LT = (float*)(a->ws + WS_HLT) + ((size_t)(dir * 4 + head) * 260 + ci) * 4096;
    float z0 = 0.f; asm volatile("" : "+v"(z0));
#pragma unroll
    for (int kb = 0; kb < 4; ++kb) { f32x4 acc = {z0, z0, z0, z0};
        acc = mma16(VT + 16 * I * HST, KLT + 16 * kb * HST, 0, acc, lane); acc = mma16(VT + 16 * I * HST, KLT + 16 * kb * HST, 32, acc, lane);
#pragma unroll
        for (int r = 0; r < 4; ++r) LT[(16 * I + 4 * (lane >> 4) + r) * 64 + 16 * kb + (lane & 15)] = acc[r]; }
    __syncthreads();
}
__device__ __forceinline__ void hgrn_stepB(KA a, int item, int tid) {
    const int dh = item >> 3, vb = item & 7, v = vb * 8 + (tid >> 6), k = tid & 63;
    const float* LT = (const float*)(a->ws + WS_HLT) + (size_t)dh * 260 * 4096 + v * 64 + k;
    const float* DG = (const float*)(a->ws + WS_HDG) + (size_t)dh * 260 * 64 + k;
    bf16* SP = (bf16*)(a->ws + WS_HSP) + (size_t)dh * 260 * 4096 + v * 64 + k;
    float S = 0.f;
    for (int c0 = 0; c0 < 260; c0 += 10) {
        float lt[10], dg[10];
#pragma unroll
        for (int j = 0; j < 10; ++j) { lt[j] = LT[(size_t)(c0 + j) * 4096]; dg[j] = DG[(c0 + j) * 64]; }
#pragma unroll
        for (int j = 0; j < 10; ++j) { SP[(size_t)(c0 + j) * 4096] = (bf16)f2bf(S); S = dg[j] * S + lt[j]; }
    }
}
__device__ __forceinline__ void hgrn_stepC(KA a, int l, int cpos, int head, LAS unsigned char* lds, int tid, int lane, int wave) {
    const bf16* PROJ = (const bf16*)(a->ws + WS_PROJ); bf16* MIX = (bf16*)(a->ws + WS_MIX);
    const int dir = wave >> 2, I = wave & 3, base = hg_base_row(cpos), ci = hg_scan_idx(dir, cpos);
    constexpr int MSZ = 64 * HST;
    LAS float* TOT = (LAS float*)lds;
    LAS bf16* img = (LAS bf16*)(lds + 2048);
    LAS bf16* QT = img + dir * MSZ;
    LAS bf16* QD = img + 2 * MSZ + dir * MSZ;
    LAS bf16* VT = img + 4 * MSZ + dir * MSZ;
    LAS bf16* ST = img + 6 * MSZ + dir * MSZ;
    LAS bf16* AS = img + 8 * MSZ + dir * MSZ + I * 16 * HST;
    LAS bf16* KT = img + 10 * MSZ + dir * (10 * 16 * HST);
    LAS float* OS = (LAS float*)(img + 10 * MSZ);
    const float lb = hg_lb(a, l, dir, head, lane);
    const int fcol = (dir == 0 ? COL_HFF : COL_HFB) + head * 64 + lane, qcol = COL_HQ + head * 64 + lane, vcol = COL_HI + head * 64 + lane;
    { const bf16* SP = (const bf16*)(a->ws + WS_HSP) + ((size_t)(dir * 4 + head) * 260 + ci) * 4096;
#pragma unroll
      for (int h2 = 0; h2 < 2; ++h2) { const int e = ((I * 2 + h2) * 64 + lane) * 8, vv = e >> 6, kk0 = e & 63;
          *(LAS v4u*)(ST + vv * HST + kk0) = *(const GAS v4u*)(SP + e); } }
    float kk[16], cl[16], qv[16]; float run = 0.f;
#pragma unroll
    for (int i = 0; i < 16; ++i) { const int n = 16 * I + i, row = base + (dir ? 63 - n : n);
        const float fl = bflo((unsigned)PROJ[(size_t)row * INW + fcol]), ql = bflo((unsigned)PROJ[(size_t)row * INW + qcol]);
        const unsigned short vb = PROJ[(size_t)row * INW + vcol];
        const float f = lb + (1.0f - lb) * sigm1(fl);
        run += __logf(f); cl[i] = run; kk[i] = 1.0f - f; qv[i] = silu1(ql) * 0.125f;
        VT[lane * HST + n] = vb; }
    TOT[(dir * 4 + I) * 64 + lane] = run;
    __syncthreads();
    float tj[4];
#pragma unroll
    for (int J = 0; J < 4; ++J) tj[J] = TOT[(dir * 4 + J) * 64 + lane];
    float pre = 0.f;
#pragma unroll
    for (int J = 0; J < 4; ++J) if (J < I) pre += tj[J];
#pragma unroll
    for (int i = 0; i < 16; ++i) { const float e = __expf(cl[i]); QT[(16 * I + i) * HST + lane] = (bf16)f2bf(qv[i] * e); QD[(16 * I + i) * HST + lane] = (bf16)f2bf(qv[i] * e * __expf(pre)); }
    float eoff = 0.f;
#pragma unroll
    for (int I2 = 0; I2 < 4; ++I2) {
        if (I2 >= I) {
            if (I2 == I) eoff = 0.f; else if (I2 == I + 1) eoff = run; else eoff += tj[I2 - 1];
            LAS bf16* blk = KT + (I2 * (I2 + 1) / 2 + I) * 16 * HST;
#pragma unroll
            for (int i = 0; i < 16; ++i) blk[i * HST + lane] = (bf16)f2bf(kk[i] * __expf(fminf(eoff - cl[i], 80.0f)));
        }
    }
    __syncthreads();
    float z0 = 0.f; asm volatile("" : "+v"(z0));
    f32x4 sc[4];
#pragma unroll
    for (int J = 0; J < 4; ++J) { sc[J] = (f32x4){z0, z0, z0, z0};
        if (J <= I) { const LAS bf16* kb = KT + (I * (I + 1) / 2 + J) * 16 * HST;
            sc[J] = mma16(QT + 16 * I * HST, kb, 0, sc[J], lane); sc[J] = mma16(QT + 16 * I * HST, kb, 32, sc[J], lane);
            if (J == I) {
#pragma unroll
                for (int r = 0; r < 4; ++r) if ((lane & 15) > 4 * (lane >> 4) + r) sc[J][r] = z0; } } }
#pragma unroll
    for (int J = 0; J < 4; ++J)
#pragma unroll
        for (int r = 0; r < 4; ++r) AS[(4 * (lane >> 4) + r) * HST + 16 * J + (lane & 15)] = (bf16)f2bf(sc[J][r]);
    asm volatile("s_waitcnt lgkmcnt(0)" ::: "memory");
    f32x4 acc[4];
#pragma unroll
    for (int vb = 0; vb < 4; ++vb) { acc[vb] = (f32x4){z0, z0, z0, z0};
        acc[vb] = mma16(AS, VT + 16 * vb * HST, 0, acc[vb], lane); acc[vb] = mma16(AS, VT + 16 * vb * HST, 32, acc[vb], lane);
        acc[vb] = mma16(QD + 16 * I * HST, ST + 16 * vb * HST, 0, acc[vb], lane); acc[vb] = mma16(QD + 16 * I * HST, ST + 16 * vb * HST, 32, acc[vb], lane); }
    __syncthreads();
#pragma unroll
    for (int vb = 0; vb < 4; ++vb)
#pragma unroll
        for (int r = 0; r < 4; ++r) { const int n = 16 * I + 4 * (lane >> 4) + r, rl = dir ? 63 - n : n; OS[(dir * 64 + rl) * 68 + 16 * vb + (lane & 15)] = acc[vb][r]; }
    __syncthreads();
    { const int rl = tid >> 3, v8 = (tid & 7) * 8, row = base + rl;
      float o[8]; float ss = 0.f;
#pragma unroll
      for (int j = 0; j < 8; ++j) { o[j] = OS[rl * 68 + v8 + j] + OS[(64 + rl) * 68 + v8 + j]; ss += o[j] * o[j]; }
      ss += sx<1>(ss); ss += sx<2>(ss); ss += sx<4>(ss);
      const float rstd = __builtin_amdgcn_rsqf(ss * (1.0f / 64.0f) + EPS);
      float gt[8]; unpack8(*(const GAS v4u*)(PROJ + (size_t)row * INW + COL_HG + head * 64 + v8), gt);
      const float* gn = a->in[I_HGAIN] + l * 64 + v8;
      float y[8];
#pragma unroll
      for (int j = 0; j < 8; ++j) y[j] = o[j] * rstd * gn[j] * silu1(gt[j]);
      v4u w; w.x = pk2(y[0], y[1]); w.y = pk2(y[2], y[3]); w.z = pk2(y[4], y[5]); w.w = pk2(y[6], y[7]);
      *(GAS v4u*)(MIX + (size_t)row * DM + MIX_HG + head * 64 + v8) = w; }
    __syncthreads();
}

__device__ __forceinline__ void vt_item(KA a, int item, int lane) {
    const bf16* PROJ = (const bf16*)(a->ws + WS_PROJ); bf16* VTg = (bf16*)(a->ws + WS_VT);
    const int rb = item >> 1, hk = item & 1, row = rb * 64 + lane;
    const bf16* p = PROJ + (size_t)row * INW + COL_AV + hk * 64;
    unsigned w[32];
#pragma unroll
    for (int c = 0; c < 8; ++c) { const v4u t = *(const GAS v4u*)(p + 8 * c); w[4 * c] = t.x; w[4 * c + 1] = t.y; w[4 * c + 2] = t.z; w[4 * c + 3] = t.w; }
    bf16* o = VTg + (size_t)hk * 64 * R_ALL + row;
#pragma unroll
    for (int d2 = 0; d2 < 32; ++d2) { o[(size_t)(2 * d2) * R_ALL] = (bf16)(w[d2] & 0xffffu); o[(size_t)(2 * d2 + 1) * R_ALL] = (bf16)(w[d2] >> 16); }
}
__device__ __forceinline__ void attn_unit(KA a, int l, int u, LAS unsigned char* lds, int tid, int lane, int wave) {
    asm volatile("" : "+v"(tid), "+v"(lane));
    const bf16* PROJ = (const bf16*)(a->ws + WS_PROJ); const bf16* VTg = (const bf16*)(a->ws + WS_VT); bf16* MIX = (bf16*)(a->ws + WS_MIX);
    const bool isctx = u >= 256; const int uu = isctx ? u - 256 : u; const int n = uu >> 1, hk = uu & 1;
    const int qh = hk * 4 + (wave >> 1), half = wave & 1;
    const int qbase = (isctx ? S_LAT : 0) + n * 128 + half * 64, qpos0 = n * 128 + half * 64;
    const int c = lane & 15, g = lane >> 4;
    LAS bf16* Kt = (LAS bf16*)lds; LAS bf16* Vt = Kt + 64 * HST; LAS bf16* Qw = Vt + 64 * HST + wave * 64 * HST;
#pragma unroll
    for (int j = 0; j < 8; ++j) { const int qr = 8 * j + (lane >> 3), qc = (lane & 7) * 8;
        *(LAS v4u*)(Qw + qr * HST + qc) = *(const GAS v4u*)(PROJ + (size_t)(qbase + qr) * INW + qh * 64 + qc); }
    float z0 = 0.f; asm volatile("" : "+v"(z0));
    f32x4 o[4][4]; float m[4], ls[4];
    const float sink = a->in[I_SINK][l * 8 + qh] * 1.4426950408889634f;
#pragma unroll
    for (int qt = 0; qt < 4; ++qt) { m[qt] = sink; ls[qt] = (g == 0) ? 1.0f : z0;
#pragma unroll
        for (int dt = 0; dt < 4; ++dt) o[qt][dt] = (f32x4){z0, z0, z0, z0}; }
    const int first = (!isctx && n == 0) ? 2 : 0, nwin = isctx ? 0 : ((n == 0 || n == 127) ? 4 : 6), nt = nwin + 4;
    const int lr = tid >> 3, lc = (tid & 7) * 8;
    v4u kreg, vreg;
#define ATT_LOADT(i) do { const bool ct_ = (i) >= nwin; const int kb_ = ct_ ? S_LAT + 64 * ((i) - nwin) : (n - 1) * 128 + 64 * (first + (i)); \
        kreg = *(const GAS v4u*)(PROJ + (size_t)(kb_ + lr) * INW + COL_AK + hk * 64 + lc); vreg = *(const GAS v4u*)(VTg + ((size_t)hk * 64 + lr) * R_ALL + kb_ + lc); } while (0)
    ATT_LOADT(0);
#pragma unroll 1
    for (int i = 0; i < nt; ++i) {
        __syncthreads();
        *(LAS v4u*)(Kt + lr * HST + lc) = kreg; *(LAS v4u*)(Vt + lr * HST + lc) = vreg;
        __syncthreads();
        if (i + 1 < nt) ATT_LOADT(i + 1);
        const bool win = i < nwin; const int kb = (n - 1) * 128 + 64 * (first + i);
        bf16x8v kf[4][2], vf[4][2];
#pragma unroll
        for (int kt = 0; kt < 4; ++kt)
#pragma unroll
            for (int ks = 0; ks < 2; ++ks) kf[kt][ks] = *(const LAS bf16x8v*)(Kt + (16 * kt + c) * HST + 32 * ks + 8 * g);
#pragma unroll
        for (int dt = 0; dt < 4; ++dt)
#pragma unroll
            for (int s2 = 0; s2 < 2; ++s2) { const v2u lo = *(const LAS v2u*)(Vt + (16 * dt + c) * HST + 32 * s2 + 4 * g), hi = *(const LAS v2u*)(Vt + (16 * dt + c) * HST + 32 * s2 + 16 + 4 * g);
                const v4u t = {lo.x, lo.y, hi.x, hi.y}; vf[dt][s2] = __builtin_bit_cast(bf16x8v, t); }
#pragma unroll
        for (int qt = 0; qt < 4; ++qt) {
            f32x4 s[4];
            const bf16x8v q0 = *(const LAS bf16x8v*)(Qw + (16 * qt + c) * HST + 8 * g), q1 = *(const LAS bf16x8v*)(Qw + (16 * qt + c) * HST + 32 + 8 * g);
#pragma unroll
            for (int kt = 0; kt < 4; ++kt) { s[kt] = (f32x4){z0, z0, z0, z0};
                s[kt] = __builtin_amdgcn_mfma_f32_16x16x32_bf16(kf[kt][0], q0, s[kt], 0, 0, 0); s[kt] = __builtin_amdgcn_mfma_f32_16x16x32_bf16(kf[kt][1], q1, s[kt], 0, 0, 0); }
            if (win) { const int dq = qpos0 + 16 * qt + c - kb - 4 * g;
#pragma unroll
                for (int kt = 0; kt < 4; ++kt)
#pragma unroll
                    for (int r = 0; r < 4; ++r) { const int dl = dq - 16 * kt - r; if (dl > 128 || dl < -128) s[kt][r] = -INFINITY; } }
            float tm = fmaxf(fmaxf(s[0][0], s[0][1]), fmaxf(s[0][2], s[0][3]));
#pragma unroll
            for (int kt = 1; kt < 4; ++kt) tm = fmaxf(tm, fmaxf(fmaxf(s[kt][0], s[kt][1]), fmaxf(s[kt][2], s[kt][3])));
            tm = fmaxf(tm, sx<16>(tm)); tm = sx32_max(tm);
            const float mn = fmaxf(m[qt], tm), corr = __builtin_amdgcn_exp2f(m[qt] - mn); m[qt] = mn;
            float ps = 0.f;
#pragma unroll
            for (int kt = 0; kt < 4; ++kt)
#pragma unroll
                for (int r = 0; r < 4; ++r) { s[kt][r] = __builtin_amdgcn_exp2f(s[kt][r] - mn); ps += s[kt][r]; }
            ls[qt] = ls[qt] * corr + ps;
#pragma unroll
            for (int dt = 0; dt < 4; ++dt) o[qt][dt] = o[qt][dt] * corr;
            bf16x8v pb[2];
#pragma unroll
            for (int s2 = 0; s2 < 2; ++s2) { const v4u t = {pk2(s[2 * s2][0], s[2 * s2][1]), pk2(s[2 * s2][2], s[2 * s2][3]), pk2(s[2 * s2 + 1][0], s[2 * s2 + 1][1]), pk2(s[2 * s2 + 1][2], s[2 * s2 + 1][3])};
                pb[s2] = __builtin_bit_cast(bf16x8v, t); }
#pragma unroll
            for (int dt = 0; dt < 4; ++dt) { o[qt][dt] = __builtin_amdgcn_mfma_f32_16x16x32_bf16(vf[dt][0], pb[0], o[qt][dt], 0, 0, 0); o[qt][dt] = __builtin_amdgcn_mfma_f32_16x16x32_bf16(vf[dt][1], pb[1], o[qt][dt], 0, 0, 0); }
        }
    }
#undef ATT_LOADT
    int c2 = lane & 15, g2 = lane >> 4; asm volatile("" : "+v"(c2), "+v"(g2));
#pragma unroll
    for (int qt = 0; qt < 4; ++qt) { float lt = ls[qt]; lt += sx<16>(lt); lt = sx32_add(lt); const float inv = 1.0f / lt;
        bf16* op = (bf16*)(a->ws + WS_MIX) + (size_t)(qbase + 16 * qt + c2) * DM + MIX_AT + qh * 64 + 4 * g2;
#pragma unroll
        for (int dt = 0; dt < 4; ++dt) { v2u w; w.x = pk2(o[qt][dt][0] * inv, o[qt][dt][1] * inv); w.y = pk2(o[qt][dt][2] * inv, o[qt][dt][3] * inv); *(GAS v2u*)(op + 16 * dt) = w; } }
}
__device__ __forceinline__ void attn_naive(KA a, int l, int nrows, int lane, int wave, int G, int bid) {
    const bf16* PROJ = (const bf16*)(a->ws + WS_PROJ); bf16* MIX = (bf16*)(a->ws + WS_MIX);
    const int gw = bid * NWAVES + wave, NGW = G * NWAVES;
    for (int pair = gw; pair < nrows * 2; pair += NGW) {
        const int row = pair >> 1, hk = pair & 1; const bool isctx = row >= S_LAT;
        float q[4], o[4], m[4], ls[4];
#pragma unroll
        for (int g = 0; g < 4; ++g) { q[g] = bflo((unsigned)PROJ[(size_t)row * INW + (hk * 4 + g) * 64 + lane]); o[g] = 0.f; ls[g] = 1.0f; m[g] = a->in[I_SINK][l * 8 + hk * 4 + g] * 1.4426950408889634f; }
        int j0 = 0, j1 = -1;
        if (!isctx) { j0 = row - 128 < 0 ? 0 : row - 128; j1 = row + 128 > S_LAT - 1 ? S_LAT - 1 : row + 128; }
        const int nwin = j1 - j0 + 1;
        const int nk = nwin + C_CTX;
#pragma unroll 4
        for (int t = 0; t < nk; ++t) {
            const int krow = (t < nwin) ? j0 + t : S_LAT + (t - nwin);
            const float k = bflo((unsigned)PROJ[(size_t)krow * INW + COL_AK + hk * 64 + lane]);
            const float v = bflo((unsigned)PROJ[(size_t)krow * INW + COL_AV + hk * 64 + lane]);
#pragma unroll
            for (int g = 0; g < 4; ++g) { const float s = wave_sum(q[g] * k); const float mn = fmaxf(m[g], s);
                const float c = __builtin_amdgcn_exp2f(m[g] - mn), p = __builtin_amdgcn_exp2f(s - mn);
                ls[g] = ls[g] * c + p; o[g] = o[g] * c + p * v; m[g] = mn; }
        }
#pragma unroll
        for (int g = 0; g < 4; ++g) MIX[(size_t)row * DM + MIX_AT + (hk * 4 + g) * 64 + lane] = (bf16)f2bf(o[g] / ls[g]);
    }
}
__device__ __forceinline__ void hgrn_combine(KA a, int l, int nrows, int lane, int wave, int G, int bid) {
    const bf16* PROJ = (const bf16*)(a->ws + WS_PROJ); bf16* MIX = (bf16*)(a->ws + WS_MIX);
    const float* O0 = (const float*)(a->ws + WS_HGO); const float* O1 = O0 + (size_t)R_ALL * 256;
    const f32x4 gn = *(const f32x4*)(a->in[I_HGAIN] + l * 64 + (lane & 15) * 4);
    const int gw = bid * NWAVES + wave, NGW = G * NWAVES;
    for (int r = gw; r < nrows; r += NGW) {
        const f32x4 o = *(const GAS f32x4*)(O0 + (size_t)r * 256 + 4 * lane) + *(const GAS f32x4*)(O1 + (size_t)r * 256 + 4 * lane);
        float ss = (o.x * o.x + o.y * o.y) + (o.z * o.z + o.w * o.w);
        ss += sx<1>(ss); ss += sx<2>(ss); ss += sx<4>(ss); ss += sx<8>(ss);
        const float rstd = __builtin_amdgcn_rsqf(ss * (1.0f / 64.0f) + EPS);
        const v2u gw2 = *(const GAS v2u*)(PROJ + (size_t)r * INW + COL_HG + 4 * lane);
        const float g0 = bflo(gw2.x), g1 = bfhi(gw2.x), g2 = bflo(gw2.y), g3 = bfhi(gw2.y);
        v2u w; w.x = pk2(o.x * rstd * gn.x * silu1(g0), o.y * rstd * gn.y * silu1(g1)); w.y = pk2(o.z * rstd * gn.z * silu1(g2), o.w * rstd * gn.w * silu1(g3));
        *(GAS v2u*)(MIX + (size_t)r * DM + MIX_HG + 4 * lane) = w;
    }
}
__device__ __forceinline__ void moe_gather(KA a, LAS unsigned char* lds, int tid, int lane, int wave, int G, int bid) {
    LAS int* sb = (LAS int*)lds;
    const unsigned* cnt = (const unsigned*)(a->ws + WS_CTL) + CW_MOECNT;
    int* mi = (int*)(a->ws + WS_VEC) + VO_MOE;
    if (tid == 0) { int b = 0;
        for (int e = 0; e < 8; ++e) { const int c = (int)__hip_atomic_load(cnt + e, RLX_AGENT); sb[e] = b; sb[16 + e] = c;
            const int nt = (c + 255) >> 8;
            if (bid == 0) for (int t = 0; t < nt; ++t) mi[16 + (b >> 8) + t] = e;
            b += nt << 8; }
        sb[8] = b; if (bid == 0) mi[0] = b >> 8; }
    __syncthreads();
    const bf16* H = (const bf16*)(a->ws + WS_H2B); bf16* AS = (bf16*)(a->ws + WS_AS);
    const int* tokinfo = (const int*)(a->ws + WS_TOK); int* tokslot = (int*)(a->ws + WS_TOK) + S_LAT * 8;
    const int gw = bid * NWAVES + wave, NGW = G * NWAVES;
    for (int t = gw; t < S_LAT; t += NGW) {
        const int* ti = tokinfo + (size_t)t * 8;
        const int e1 = ti[0], e2 = ti[1], r1 = ti[2], r2 = ti[3];
        const int s1 = sb[e1] + r1, s2 = sb[e2] + r2;
        const GAS v4u* src = (const GAS v4u*)(H + (size_t)t * DM) + lane;
        const v4u x0 = src[0], x1 = src[64];
        GAS v4u* d1 = (GAS v4u*)(AS + (size_t)s1 * DM) + lane; GAS v4u* d2 = (GAS v4u*)(AS + (size_t)s2 * DM) + lane;
        d1[0] = x0; d1[64] = x1; d2[0] = x0; d2[64] = x1;
        if (lane == 0) { int* ts = tokslot + (size_t)t * 4; ts[0] = s1; ts[1] = s2; ts[2] = ti[4]; ts[3] = ti[5]; }
    }
    for (int e = 0; e < 8; ++e) { const int c = sb[16 + e], pe = (c + 255) & ~255, b = sb[e];
        for (int j = c + gw; j < pe; j += NGW) { GAS v4u* d = (GAS v4u*)(AS + (size_t)(b + j) * DM) + lane; const v4u z = {0u, 0u, 0u, 0u}; d[0] = z; d[64] = z; } }
}
__device__ __forceinline__ void moe_combine(KA a, int lane, int wave, int G, int bid) {
    const float* gf = (const float*)(a->ws + WS_VEC) + VO_MOD + (1 * 2 + 0) * 6144 + 5 * 1024;
    const bf16* Y = (const bf16*)(a->ws + WS_Y); const int* tokslot = (const int*)(a->ws + WS_TOK) + S_LAT * 8;
    const int gw = bid * NWAVES + wave, NGW = G * NWAVES;
    for (int t = gw; t < S_LAT; t += NGW) {
        const int* ts = tokslot + (size_t)t * 4; const int s1 = ts[0], s2 = ts[1]; const float w1 = __builtin_bit_cast(float, ts[2]), w2 = __builtin_bit_cast(float, ts[3]);
        GAS f32x4* xr = (GAS f32x4*)(a->out + (size_t)t * DM) + lane;
        const GAS v2u* y1 = (const GAS v2u*)(Y + (size_t)s1 * DM) + lane; const GAS v2u* y2 = (const GAS v2u*)(Y + (size_t)s2 * DM) + lane;
#pragma unroll
        for (int j = 0; j < 4; ++j) { const v2u p = y1[64 * j], q = y2[64 * j]; const f32x4 g = *(const f32x4*)(gf + 4 * lane + 256 * j); f32x4 x = xr[64 * j];
            x.x += g.x * (w1 * bflo(p.x) + w2 * bflo(q.x)); x.y += g.y * (w1 * bfhi(p.x) + w2 * bfhi(q.x)); x.z += g.z * (w1 * bflo(p.y) + w2 * bflo(q.y)); x.w += g.w * (w1 * bfhi(p.y) + w2 * bfhi(q.y));
            xr[64 * j] = x; }
    }
}

#define IN(k) (lo <= (k) && (k) < hi)
#define GRIDBAR() do { XcdBarrier b2_; b2_.bar = (unsigned*)(KARGS()->ws + WS_CTL) + CW_BAR; b2_.x = xb_xcc_id(); b2_.st = (volatile LAS unsigned*)(lds + MISC_OFF) + 8; xcd_barrier(b2_); } while (0)
#define SEAM(k) do { if (IN(k) && IN((k) + 1)) GRIDBAR(); } while (0)
#define PHASE_ROOTS() KA a = KARGS(); unsigned char* ws = a->ws; const float* vec = (const float*)(ws + WS_VEC); (void)vec; int bid = blockIdx.x, G = gridDim.x; asm volatile("" : "+s"(bid), "+s"(G)); int tid = threadIdx.x; asm volatile("" : "+v"(tid)); const int lane = tid & 63, wave = __builtin_amdgcn_readfirstlane(tid >> 6); (void)lane; (void)wave

template <int l> __device__ __forceinline__ void layer_body(const int lo, const int hi, LAS unsigned char* lds) {
        const int pb = 1 + 11 * l;
        if (IN(pb + 0)) { PHASE_ROOTS(); phase_norm(a, l, 0, R_ALL, (bf16*)(ws + WS_H), lane, wave, G, bid); SEAM(pb + 0); }
        if (IN(pb + 1)) {
            PHASE_ROOTS();
            pg8::Gemm g{(const pg8::bf16_t*)(ws + WS_H), (const pg8::bf16_t*)(ws + WS_WIN) + (size_t)l * INW * DM, R_ALL, INW, DM, 0};
            pg8::StaticOrder S; S.init(R_ALL, INW, G, bid);
            pg8::EpiBf16<0> E{(pg8::bf16_t*)(ws + WS_PROJ), INW, nullptr, 0, 0, 1.f};
            pg8::gemm_phase<pg8::EpiBf16<0>, pg8::StaticOrder, true, true>(lds, g, S, E);
            SEAM(pb + 1);
        }
        if (IN(pb + 2)) {
            PHASE_ROOTS();
            qk_prep(a, l, bid * NTHR + tid, G * NTHR);
            for (int it = bid * NWAVES + wave; it < 520; it += G * NWAVES) vt_item(a, it, lane);
            for (int it = bid; it < 1040; it += G) hgrn_stepA(a, l, it >> 2, it & 3, lds, lane, wave);
            const int nch = (l == 0) ? 130 : 128;
            for (int it = bid; it < nch * 4; it += G) gmlp_unit(a, l, it >> 2, it & 3, lds, tid, lane, wave);
            SEAM(pb + 2);
        }
        if (IN(pb + 3)) {
            PHASE_ROOTS();
            if (bid < 64) hgrn_stepB(a, bid, tid);
            { const int nu = (l == 0) ? 260 : 256; for (int u = bid; u < nu; u += G) { attn_unit(a, l, u, lds, tid, lane, wave); __syncthreads(); } }
            SEAM(pb + 3);
        }
        if (IN(pb + 4)) {
            PHASE_ROOTS();
            const int nit = (l == 0) ? 1040 : 1024;
            for (int it = bid; it < nit; it += G) hgrn_stepC(a, l, it >> 2, it & 3, lds, tid, lane, wave);
            SEAM(pb + 4);
        }
        if (IN(pb + 5)) {
            PHASE_ROOTS();
            const float* modl = vec + VO_MOD + (l * 2 + 0) * 6144; const float* modc = vec + VO_MOD + (l * 2 + 1) * 6144;
            const int M = (l == 0) ? R_ALL : S_LAT;
            pg8::Gemm g{(const pg8::bf16_t*)(ws + WS_MIX), (const pg8::bf16_t*)(ws + WS_WOUT) + (size_t)l * DM * DM, M, DM, DM, 0};
            pg8::StaticOrder S; S.init(M, DM, G, bid);
            pg8::EpiResid E{(l == 0) ? a->in[I_X] : a->out, a->out, modl + 2048, a->in[I_CTX], (float*)(ws + WS_CTXR), modc + 2048, S_LAT / 256, DM};
            pg8::gemm_phase<pg8::EpiResid, pg8::StaticOrder, true, true>(lds, g, S, E);
            SEAM(pb + 5);
        }
        if (l == 0) {
            if (IN(pb + 6)) { PHASE_ROOTS(); phase_norm(a, l, 1, R_ALL, (bf16*)(ws + WS_H), lane, wave, G, bid); SEAM(pb + 6); }
            if (IN(pb + 7)) {
                PHASE_ROOTS();
                pg8::Gemm g{(const pg8::bf16_t*)(ws + WS_H), (const pg8::bf16_t*)(ws + WS_WGU), R_ALL, 2 * FFN, DM, 0};
                pg8::StaticOrder S; S.init(R_ALL, 2 * FFN, G, bid);
                pg8::EpiSwiGLU E{(pg8::bf16_t*)(ws + WS_HID), FFN};
                pg8::gemm_phase<pg8::EpiSwiGLU, pg8::StaticOrder, true, true>(lds, g, S, E);
                SEAM(pb + 7);
            }
            if (IN(pb + 8)) {
                PHASE_ROOTS();
                const float* modl = vec + VO_MOD + (l * 2 + 0) * 6144; const float* modc = vec + VO_MOD + (l * 2 + 1) * 6144;
                pg8::Gemm g{(const pg8::bf16_t*)(ws + WS_HID), (const pg8::bf16_t*)(ws + WS_WD), R_ALL, DM, FFN, 0};
                pg8::StaticOrder S; S.init(R_ALL, DM, G, bid);
                pg8::EpiResid E{a->out, a->out, modl + 5120, (const float*)(ws + WS_CTXR), (float*)(ws + WS_CTXR), modc + 5120, S_LAT / 256, DM};
                pg8::gemm_phase<pg8::EpiResid, pg8::StaticOrder, true, true>(lds, g, S, E);
                if (IN(pb + 8) && IN(pb + 11)) GRIDBAR();
            }
        } else {
            if (IN(pb + 6)) { PHASE_ROOTS(); phase_norm_route(a, lds, tid, lane, wave, G, bid); SEAM(pb + 6); }
            if (IN(pb + 7)) { PHASE_ROOTS(); moe_gather(a, lds, tid, lane, wave, G, bid); SEAM(pb + 7); }
            if (IN(pb + 8)) {
                PHASE_ROOTS();
                const int* mi = (const int*)(ws + WS_VEC) + VO_MOE; const int nt = __builtin_amdgcn_readfirstlane(mi[0]);
                pg8::Gemm g{(const pg8::bf16_t*)(ws + WS_AS), (const pg8::bf16_t*)(ws + WS_MGU), nt * 256, 2 * EXD, DM, (size_t)2 * EXD * DM * 2};
                pg8::MoeOrder S; S.init(nt * 256, 2 * EXD, G, bid); S.tile_e = mi + 16;
                pg8::EpiSwiGLU E{(pg8::bf16_t*)(ws + WS_HIDM), EXD};
                pg8::gemm_phase<pg8::EpiSwiGLU, pg8::MoeOrder, true, true>(lds, g, S, E);
                SEAM(pb + 8);
            }
            if (IN(pb + 9)) {
                PHASE_ROOTS();
                const int* mi = (const int*)(ws + WS_VEC) + VO_MOE; const int nt = __builtin_amdgcn_readfirstlane(mi[0]);
                pg8::Gemm g{(const pg8::bf16_t*)(ws + WS_HIDM), (const pg8::bf16_t*)(ws + WS_MD), nt * 256, DM, EXD, (size_t)DM * EXD * 2};
                pg8::MoeOrder S; S.init(nt * 256, DM, G, bid); S.tile_e = mi + 16;
                pg8::EpiBf16<0> E{(pg8::bf16_t*)(ws + WS_Y), DM, nullptr, 0, 0, 1.f};
                pg8::gemm_phase<pg8::EpiBf16<0>, pg8::MoeOrder, true, true>(lds, g, S, E);
                SEAM(pb + 9);
            }
            if (IN(pb + 10)) { PHASE_ROOTS(); moe_combine(a, lane, wave, G, bid); }
        }
    }
__global__ void __launch_bounds__(NTHR, 2) fwd_kernel(Args a_unused) {
    extern __shared__ __attribute__((aligned(16))) unsigned char lds_raw[];
    LAS unsigned char* lds = (LAS unsigned char*)lds_raw;
    const int tid0 = threadIdx.x;
    for (int u = tid0; u < (LDS_BYTES - LDSCTL_OFF) / 4; u += NTHR) ((LAS unsigned*)(lds + LDSCTL_OFF))[u] = 0u;
    __syncthreads();
    const int lo = KARGS()->ph_lo, hi = KARGS()->ph_hi;
    const bool fusedl = (hi - lo) > 1;
    if (fusedl) (void)xcd_barrier_post((unsigned*)(KARGS()->ws + WS_CTL) + CW_BAR, (volatile LAS unsigned*)(lds + MISC_OFF) + 8);
    if (IN(0)) { PHASE_ROOTS(); p0_prologue(a, lds, tid, lane, wave, G, bid); SEAM(0); }

    layer_body<0>(lo, hi, lds);
    layer_body<1>(lo, hi, lds);
}

extern "C" void kernel_launch(void* const* d_in, const int* in_sizes, int n_in, void* d_out, int out_size, void* d_ws, size_t ws_size, hipStream_t stream) {
    static int grid = 0;
    if (grid == 0) {
        if (n_in != 23 || in_sizes[0] != S_LAT * DM || out_size != S_LAT * DM || ws_size < WS_END) { fprintf(stderr, "kernel_launch: unexpected shapes / workspace (n_in %d, ws %zu, need %zu)\n", n_in, ws_size, (size_t)WS_END); grid = -1; return; }
        int dev = 0, cus = 0;
        if (hipGetDevice(&dev) != hipSuccess || hipDeviceGetAttribute(&cus, hipDeviceAttributeMultiprocessorCount, dev) != hipSuccess) { grid = -1; return; }
        if (hipFuncSetAttribute((const void*)fwd_kernel, hipFuncAttributeMaxDynamicSharedMemorySize, LDS_BYTES) != hipSuccess) { grid = -1; return; }
        int per_cu = 0;
        (void)hipOccupancyMaxActiveBlocksPerMultiprocessor(&per_cu, (const void*)fwd_kernel, NTHR, LDS_BYTES);
        (void)hipGetLastError();
        grid = cus;
    }
    if (grid < 0) return;
    if (hipMemsetAsync((char*)d_ws + WS_CTL, 0, CTL_ZERO_BYTES, stream) != hipSuccess) return;
    Args a{};
    for (int i = 0; i < 23; ++i) a.in[i] = (const float*)d_in[i];
    a.out = (float*)d_out; a.ws = (unsigned char*)d_ws;
#if ONE_LAUNCH
    a.ph_lo = 0; a.ph_hi = NPH;
    hipLaunchKernelGGL(fwd_kernel, dim3(grid), dim3(NTHR), LDS_BYTES, stream, a);
#else
    for (int p = 0; p < NPH; ++p) {
        if (p == 10 || p == 11) continue;
        a.ph_lo = p; a.ph_hi = p + 1;
        hipLaunchKernelGGL(fwd_kernel, dim3(grid), dim3(NTHR), LDS_BYTES, stream, a);
    }
#endif
}
```

```cpp
#include <hip/hip_runtime.h>
#include <cstdio>
#include <cstdint>
#include <cmath>
#ifndef ONE_LAUNCH
#define ONE_LAUNCH 1
#endif
namespace pg8 {
#define PG8_LAS __attribute__((address_space(3)))
typedef unsigned short bf16_t;
typedef short bf16x8 __attribute__((ext_vector_type(8)));
typedef float f32x4 __attribute__((ext_vector_type(4)));
typedef unsigned u32x4 __attribute__((ext_vector_type(4)));
constexpr int BM = 256, BK = 64, HALF = 128, HTB = HALF * BK * 2  , STAGE_BYTES = 8 * HTB, NXCD = 8, WGM = 8;

__host__ __device__ __forceinline__ int lds_byte(int r, int c) { const int st = (r >> 4) * 2 + (c >> 5), rr = r & 15, cc = c & 31, ob = rr * 64 + cc * 2; return st * 1024 + (ob ^ (((ob >> 9) & 1) << 5)); }
__host__ __device__ __forceinline__ void stage_rc(int b, int& R, int& C) { const int st = b / 1024, sb = b % 1024, swz = sb ^ (((sb >> 9) & 1) << 5); R = (st >> 1) * 16 + swz / 64; C = (st & 1) * 32 + (swz % 64) / 2; }
__host__ __device__ __forceinline__ int perm32(int rho) { const int n = rho >> 4, i = rho & 15; return 8 * (i >> 2) + 4 * n + (i & 3); }

struct Unit { int pm, pn, eb, ko; };
struct Gemm { const bf16_t* A; const bf16_t* Bt; int M, N, K; size_t bstride; int ld; };

struct StaticOrder {
    int nM, nN, nwg, G, c;
    __host__ __device__ void init(int M, int N, int G_, int c_) { nM = M / BM; nN = N / BM; nwg = nM * nN; G = G_; c = c_; }
    __host__ __device__ bool next(int i, Unit& u) const {
        const long L = (long)i * G + c; if (L >= nwg) return false;
        int wgid = (int)L; { const int q = nwg / NXCD, r = nwg % NXCD, xcd = wgid % NXCD, off = wgid / NXCD; wgid = (xcd < r ? xcd * (q + 1) : r * (q + 1) + (xcd - r) * q) + off; }
        const int nig = WGM * nN, gid = wgid / nig, fm = gid * WGM, gsz = (nM - fm) < WGM ? (nM - fm) : WGM;
        u.pm = fm + ((wgid % nig) % gsz); u.pn = (wgid % nig) / gsz; u.eb = 0; u.ko = 0; return true;
    }
    __device__ __forceinline__ void a_ready(const Unit&) const {}
    __device__ __forceinline__ void done(const Unit&) const {}
};

__device__ __forceinline__ unsigned cvt_pk_bf16(float lo, float hi) { unsigned r; asm volatile("v_cvt_pk_bf16_f32 %0, %1, %2" : "=v"(r) : "v"(lo), "v"(hi)); return r; }
typedef float f32x2 __attribute__((ext_vector_type(2)));
__device__ __forceinline__ f32x2 gelu_pk(f32x2 v) {
    const f32x2 av = __builtin_elementwise_abs(v), d = av * 0.2316418882f + 1.0f;
    f32x2 t; t.x = __builtin_amdgcn_rcpf(d.x); t.y = __builtin_amdgcn_rcpf(d.y);
    f32x2 q = t * 0.5307027145f + (-0.7265760135f); q = q * t + 0.7107068705f; q = q * t + (-0.142248368f); q = q * t + 0.127414796f; q = q * t;
    const f32x2 s = (v * v) * (-0.72134752044f);
    f32x2 e; e.x = __builtin_amdgcn_exp2f(s.x); e.y = __builtin_amdgcn_exp2f(s.y);
    const f32x2 m = v * (q * e), r = v - m;
    f32x2 o; o.x = v.x < 0.f ? m.x : r.x; o.y = v.y < 0.f ? m.y : r.y; return o;
}

template <int ACT  > struct EpiBf16 {
    static constexpr bool PERM = true, AFTER_DRAIN = false; static_assert(ACT == 0 || ACT == 1, "EpiBf16: ACT is 0 (none) or 1 (gelu_pk)");
    bf16_t* O; int ldc; const float* bias; int split_cols; size_t split_stride; float scale0;
    __device__ __forceinline__ void operator()(const f32x4 (&acc)[2][2][4][2], const Unit& u, int wr, int wc, int fr, int fq) const {
        const int row0 = u.pm * BM + wr * 64 + fr; int colt = u.pn * BM; bf16_t* base = O;
        float sc = 1.f; if (split_cols) { const int t = colt / split_cols; base += (size_t)t * split_stride; colt -= t * split_cols; if (t == 0) sc = scale0; }
        const int col0 = colt + wc * 32 + 8 * fq, bcol0 = u.pn * BM + wc * 32 + 8 * fq;
        f32x4 bv[2][2];
#pragma unroll
        for (int bj = 0; bj < 2; ++bj)
#pragma unroll
            for (int n = 0; n < 2; ++n) bv[bj][n] = bias ? *(const f32x4*)(bias + bcol0 + bj * HALF + 4 * n) : (f32x4){0.f, 0.f, 0.f, 0.f};
#pragma unroll
        for (int ai = 0; ai < 2; ++ai)
#pragma unroll
            for (int m = 0; m < 4; ++m) { bf16_t* rowp = base + (size_t)(row0 + ai * HALF + m * 16) * ldc + col0;
#pragma unroll
                for (int bj = 0; bj < 2; ++bj) { f32x4 v0 = acc[ai][bj][m][0] + bv[bj][0], v1 = acc[ai][bj][m][1] + bv[bj][1];
                    if (ACT == 1) { f32x2 a = gelu_pk((f32x2){v0[0], v0[1]}), b = gelu_pk((f32x2){v0[2], v0[3]}), c = gelu_pk((f32x2){v1[0], v1[1]}), d = gelu_pk((f32x2){v1[2], v1[3]});
                        v0 = (f32x4){a.x, a.y, b.x, b.y}; v1 = (f32x4){c.x, c.y, d.x, d.y}; }
                    v0 = v0 * sc; v1 = v1 * sc; u32x4 w; w.x = cvt_pk_bf16(v0[0], v0[1]); w.y = cvt_pk_bf16(v0[2], v0[3]); w.z = cvt_pk_bf16(v1[0], v1[1]); w.w = cvt_pk_bf16(v1[2], v1[3]);
                    *(u32x4*)(rowp + bj * HALF) = w; } }
    }
};

__device__ __forceinline__ float silu_f(float x) { return x * __builtin_amdgcn_rcpf(1.0f + __builtin_amdgcn_exp2f(-1.4426950408889634f * x)); }
struct EpiResid {
    static constexpr bool PERM = false, AFTER_DRAIN = false;
    const float* base; float* out; const float* gate; const float* cbase; float* cout; const float* cgate; int mlat; int ldc;
    __device__ __forceinline__ void operator()(const f32x4 (&acc)[2][2][4][2], const Unit& u, int wr, int wc, int fr, int fq) const {
        const bool isc = u.pm >= mlat;
        const float* b = isc ? cbase : base; float* o = isc ? cout : out; const float* g = isc ? cgate : gate;
        const int row0 = (isc ? (u.pm - mlat) : u.pm) * BM + wr * 64 + fr, col0 = u.pn * BM + wc * 32 + 4 * fq;
        f32x4 gv[2][2];
#pragma unroll
        for (int bj = 0; bj < 2; ++bj)
#pragma unroll
            for (int n = 0; n < 2; ++n) gv[bj][n] = *(const f32x4*)(g + col0 + bj * HALF + n * 16);
#pragma unroll
        for (int ai = 0; ai < 2; ++ai)
#pragma unroll
            for (int m = 0; m < 4; ++m) { const size_t off = (size_t)(row0 + ai * HALF + m * 16) * ldc + col0;
#pragma unroll
                for (int bj = 0; bj < 2; ++bj)
#pragma unroll
                    for (int n = 0; n < 2; ++n) { const f32x4 bs = *(const f32x4*)(b + off + bj * HALF + n * 16); *(f32x4*)(o + off + bj * HALF + n * 16) = bs + gv[bj][n] * acc[ai][bj][m][n]; }
                if (m & 1) asm volatile("" ::: "memory"); }
    }
};
struct EpiSwiGLU {
    static constexpr bool PERM = true, AFTER_DRAIN = false;
    bf16_t* O; int ldc;
    __device__ __forceinline__ void operator()(const f32x4 (&acc)[2][2][4][2], const Unit& u, int wr, int wc, int fr, int fq) const {
        const int row0 = u.pm * BM + wr * 64 + fr, col0 = u.pn * HALF + wc * 32 + 8 * fq;
#pragma unroll
        for (int ai = 0; ai < 2; ++ai)
#pragma unroll
            for (int m = 0; m < 4; ++m) { bf16_t* rowp = O + (size_t)(row0 + ai * HALF + m * 16) * ldc + col0;
                const f32x4 g0 = acc[ai][0][m][0], g1 = acc[ai][0][m][1], u0 = acc[ai][1][m][0], u1 = acc[ai][1][m][1];
                f32x4 h0, h1;
#pragma unroll
                for (int j = 0; j < 4; ++j) { h0[j] = silu_f(g0[j]) * u0[j]; h1[j] = silu_f(g1[j]) * u1[j]; }
                u32x4 w; w.x = cvt_pk_bf16(h0[0], h0[1]); w.y = cvt_pk_bf16(h0[2], h0[3]); w.z = cvt_pk_bf16(h1[0], h1[1]); w.w = cvt_pk_bf16(h1[2], h1[3]);
                *(u32x4*)rowp = w; }
    }
};
struct MoeOrder : StaticOrder {
    const int* tile_e;
    __device__ __forceinline__ bool next(int i, Unit& u) const { if (!StaticOrder::next(i, u)) return false; u.eb = __builtin_amdgcn_readfirstlane(tile_e[u.pm]); return true; }
};

struct SplitKOrder {
    int pm0, nN, P, kp, total, c; const int* tile_e;
    __device__ __forceinline__ bool next(int i, Unit& u) const {
        if (i != 0 || c >= total) return false;
        const int p = c % P, t = c / P; u.pn = t % nN; u.pm = pm0 + t / nN; u.ko = p * kp; u.eb = tile_e ? __builtin_amdgcn_readfirstlane(tile_e[u.pm]) : 0; return true; }
    __device__ __forceinline__ void a_ready(const Unit&) const {}
    __device__ __forceinline__ void done(const Unit&) const {}
};
struct EpiAtomic {
    static constexpr bool PERM = false, AFTER_DRAIN = true;
    float* out; const float* scale; int pm_sub; int ldc;
    __device__ __forceinline__ void fused(f32x4 (&acc)[2][2][4][2], const Unit& u, int wr, int wc, int fr, int fq, PG8_LAS unsigned char* lds, int wid, int lane) const {
        PG8_LAS float* scr = (PG8_LAS float*)(lds + wid * 16384);
        const int rr = lane >> 5, cc = lane & 31;
#pragma unroll
        for (int ai = 0; ai < 2; ++ai)
#pragma unroll
            for (int bj = 0; bj < 2; ++bj) {
#pragma unroll
                for (int m = 0; m < 4; ++m)
#pragma unroll
                    for (int n = 0; n < 2; ++n) *(PG8_LAS f32x4*)(scr + (m * 16 + fr) * 36 + n * 16 + 4 * fq) = acc[ai][bj][m][n];
                asm volatile("s_waitcnt lgkmcnt(0)" ::: "memory");
                const int colg = u.pn * BM + bj * HALF + wc * 32 + cc; const float sc = scale ? scale[colg] : 1.0f;
                float* op = out + (size_t)((u.pm - pm_sub) * BM + ai * HALF + wr * 64 + rr) * ldc + colg;
#pragma unroll 8
                for (int i = 0; i < 32; ++i) { const float v = scr[(2 * i + rr) * 36 + cc]; __hip_atomic_fetch_add(op + (size_t)(2 * i) * ldc, v * sc, __ATOMIC_RELAXED, __HIP_MEMORY_SCOPE_AGENT); }
                asm volatile("s_waitcnt lgkmcnt(0)" ::: "memory");
            }
    }
};

template <class Epi, class Sched, bool ALIGN_EPI = false, bool SP2 = false>
__device__ __forceinline__ void gemm_phase(PG8_LAS unsigned char* lds, const Gemm g, const Sched& S, const Epi& E) {
    int tid_ = threadIdx.x; asm volatile("" : "+v"(tid_));
    const int tid = tid_, wid = __builtin_amdgcn_readfirstlane(tid >> 6), lane = tid & 63, wr = wid >> 2, wc = wid & 3, fr = lane & 15, fq = lane >> 4;
    const int K = g.K, nt = K / BK, ld = g.ld;
    unsigned voffA[2], voffB[2];
#pragma unroll
    for (int i = 0; i < 2; ++i) { int R, C; stage_rc(tid * 16 + i * 8192, R, C); const int Rb = Epi::PERM ? ((R & ~31) + perm32(R & 31)) : R;
        voffA[i] = (unsigned)(R * ld + C) * 2u; voffB[i] = (unsigned)(Rb * ld + C) * 2u; }
    const size_t kstep = (size_t)(BK * 2);
    const size_t hstep = (size_t)HALF * ld * 2;
    const size_t tstep = 2 * hstep;
    const unsigned ldsw = (unsigned)wid * 1024u;
    const int aoff = lds_byte(wr * 64 + fr, fq * 8), boff = lds_byte(wc * 32 + fr, fq * 8);
#define PG8_SA(b, h) (((b) * 2 + (h)) * HTB)
#define PG8_SB(b, h) ((4 + (b) * 2 + (h)) * HTB)
#define PG8_STAGE(bufoff, gbase, voff) do { _Pragma("unroll") for (int _i = 0; _i < 2; ++_i) \
        __builtin_amdgcn_global_load_lds((const unsigned*)((const char*)(gbase) + (voff)[_i]), (PG8_LAS unsigned*)(lds + (bufoff) + ldsw + _i * 8192), 16, 0, 0); } while (0)
#define PG8_LDA(dst, b, h) do { _Pragma("unroll") for (int m = 0; m < 4; ++m) _Pragma("unroll") for (int k = 0; k < 2; ++k) dst[m][k] = *(const PG8_LAS bf16x8*)(lds + PG8_SA(b, h) + aoff + m * 2048 + k * 1024); } while (0)
#define PG8_LDB(dst, b, h) do { _Pragma("unroll") for (int n = 0; n < 2; ++n) _Pragma("unroll") for (int k = 0; k < 2; ++k) dst[n][k] = *(const PG8_LAS bf16x8*)(lds + PG8_SB(b, h) + boff + n * 2048 + k * 1024); } while (0)
#define PG8_MMA(ai, bj, At, Bt) do { __builtin_amdgcn_s_setprio(1); _Pragma("unroll") for (int m = 0; m < 4; ++m) _Pragma("unroll") for (int n = 0; n < 2; ++n) _Pragma("unroll") for (int k = 0; k < 2; ++k) \
        acc[ai][bj][m][n] = __builtin_amdgcn_mfma_f32_16x16x32_bf16(Bt[n][k], At[m][k], acc[ai][bj][m][n], 0, 0, 0); __builtin_amdgcn_s_setprio(0); } while (0)
#define PG8_WAIT_V(n) asm volatile("s_waitcnt vmcnt(" #n ")" ::: "memory")
#define PG8_WAIT_L(n) asm volatile("s_waitcnt lgkmcnt(" #n ")" ::: "memory")
#define PG8_BAR __builtin_amdgcn_s_barrier()
#define PG8_SCHED __builtin_amdgcn_sched_barrier(0)
    Unit cur, nxt; int ui = 0;
    if (!S.next(0, cur)) return;
    f32x4 acc[2][2][4][2];
#pragma unroll
    for (int a = 0; a < 2; ++a)
#pragma unroll
        for (int b = 0; b < 2; ++b)
#pragma unroll
            for (int m = 0; m < 4; ++m)
#pragma unroll
                for (int n = 0; n < 2; ++n) acc[a][b][m][n] = (f32x4){0.f, 0.f, 0.f, 0.f};
    bf16x8 At[4][2], B0[2][2], B1[2][2];
    const char* cA = (const char*)g.A + (size_t)cur.pm * tstep + (size_t)cur.ko * 2; const char* cB = (const char*)g.Bt + (size_t)cur.eb * g.bstride + (size_t)cur.pn * tstep + (size_t)cur.ko * 2;
    S.a_ready(cur);
    if constexpr (SP2) {
        PG8_STAGE(PG8_SB(0, 0), cB, voffB); PG8_STAGE(PG8_SB(0, 1), cB + hstep, voffB); PG8_STAGE(PG8_SA(0, 0), cA, voffA); PG8_STAGE(PG8_SA(0, 1), cA + hstep, voffA);
        if (wr == 1) PG8_BAR;
        PG8_WAIT_V(2); PG8_BAR;
        PG8_STAGE(PG8_SB(1, 0), cB + kstep, voffB); PG8_STAGE(PG8_SA(1, 0), cA + kstep, voffA); PG8_STAGE(PG8_SB(1, 1), cB + hstep + kstep, voffB);
        PG8_WAIT_V(6); PG8_BAR;
    } else {
        PG8_STAGE(PG8_SB(0, 0), cB, voffB); PG8_STAGE(PG8_SA(0, 0), cA, voffA); PG8_STAGE(PG8_SB(0, 1), cB + hstep, voffB); PG8_STAGE(PG8_SA(0, 1), cA + hstep, voffA);
        if (wr == 1) PG8_BAR;
        PG8_WAIT_V(4); PG8_BAR;
        PG8_STAGE(PG8_SB(1, 0), cB + kstep, voffB); PG8_STAGE(PG8_SA(1, 0), cA + kstep, voffA); PG8_STAGE(PG8_SB(1, 1), cB + hstep + kstep, voffB);
        PG8_WAIT_V(6); PG8_BAR;
    }
    for (;;) {
        const bool has_next = S.next(ui + 1, nxt);
        const char* nA = has_next ? (const char*)g.A + (size_t)nxt.pm * tstep + (size_t)nxt.ko * 2 : cA; const char* nB = has_next ? (const char*)g.Bt + (size_t)nxt.eb * g.bstride + (size_t)nxt.pn * tstep + (size_t)nxt.ko * 2 : cB;
        for (int t = 0; t < nt; t += 2) {
            const bool last = (t == nt - 2);
            const char* a1 = cA + (size_t)(t + 1) * kstep;
            const char* a2 = last ? nA : cA + (size_t)(t + 2) * kstep; const char* b2 = last ? nB : cB + (size_t)(t + 2) * kstep;
            const char* a3 = a2 + kstep; const char* b3 = b2 + kstep;
            if (last && has_next) S.a_ready(nxt);
            if constexpr (SP2) {
            PG8_LDB(B0, 0, 0); PG8_LDB(B1, 0, 1); PG8_SCHED; PG8_LDA(At, 0, 0); PG8_STAGE(PG8_SA(1, 1), a1 + hstep, voffA);
            PG8_WAIT_V(8); PG8_WAIT_L(0); PG8_BAR; PG8_MMA(0, 0, At, B0); PG8_MMA(0, 1, At, B1); PG8_BAR; PG8_SCHED;
            PG8_LDA(At, 0, 1); PG8_STAGE(PG8_SB(0, 0), b2, voffB); PG8_STAGE(PG8_SB(0, 1), b2 + hstep, voffB); PG8_STAGE(PG8_SA(0, 0), a2, voffA);
            PG8_WAIT_V(8); PG8_WAIT_L(0); PG8_BAR; PG8_MMA(1, 0, At, B0); PG8_MMA(1, 1, At, B1); PG8_BAR; PG8_SCHED;
            PG8_LDB(B0, 1, 0); PG8_LDB(B1, 1, 1); PG8_SCHED; PG8_LDA(At, 1, 0); PG8_STAGE(PG8_SA(0, 1), a2 + hstep, voffA);
            PG8_WAIT_V(8); PG8_WAIT_L(0); PG8_BAR; PG8_MMA(0, 0, At, B0); PG8_MMA(0, 1, At, B1); PG8_BAR; PG8_SCHED;
            PG8_LDA(At, 1, 1); PG8_STAGE(PG8_SB(1, 0), b3, voffB); PG8_STAGE(PG8_SB(1, 1), b3 + hstep, voffB); PG8_STAGE(PG8_SA(1, 0), a3, voffA);
            PG8_WAIT_V(8); PG8_WAIT_L(0); PG8_BAR; PG8_MMA(1, 0, At, B0); PG8_MMA(1, 1, At, B1); PG8_BAR; PG8_SCHED;
            } else {
            PG8_LDB(B0, 0, 0); PG8_SCHED; PG8_LDA(At, 0, 0); PG8_STAGE(PG8_SA(1, 1), a1 + hstep, voffA);
            PG8_WAIT_L(8); PG8_BAR; PG8_WAIT_L(0); PG8_MMA(0, 0, At, B0); PG8_BAR; PG8_SCHED;
            PG8_LDB(B1, 0, 1); PG8_STAGE(PG8_SB(0, 0), b2, voffB);
            PG8_BAR; PG8_WAIT_L(0); PG8_MMA(0, 1, At, B1); PG8_BAR;
            PG8_LDA(At, 0, 1); PG8_STAGE(PG8_SA(0, 0), a2, voffA);
            PG8_BAR; PG8_WAIT_L(0); PG8_MMA(1, 0, At, B0); PG8_BAR; PG8_SCHED;
            PG8_STAGE(PG8_SB(0, 1), b2 + hstep, voffB);
            PG8_WAIT_V(6); PG8_BAR; PG8_MMA(1, 1, At, B1); PG8_BAR;
            PG8_LDB(B0, 1, 0); PG8_SCHED; PG8_LDA(At, 1, 0); PG8_STAGE(PG8_SA(0, 1), a2 + hstep, voffA);
            PG8_WAIT_L(8); PG8_BAR; PG8_WAIT_L(0); PG8_MMA(0, 0, At, B0); PG8_BAR; PG8_SCHED;
            PG8_LDB(B1, 1, 1); PG8_STAGE(PG8_SB(1, 0), b3, voffB);
            PG8_BAR; PG8_WAIT_L(0); PG8_MMA(0, 1, At, B1); PG8_BAR;
            PG8_LDA(At, 1, 1); PG8_STAGE(PG8_SA(1, 0), a3, voffA);
            PG8_BAR; PG8_WAIT_L(0); PG8_MMA(1, 0, At, B0); PG8_BAR; PG8_SCHED;
            PG8_STAGE(PG8_SB(1, 1), b3 + hstep, voffB);
            PG8_WAIT_V(6); PG8_BAR; PG8_MMA(1, 1, At, B1); PG8_BAR;
            }
        }
        if constexpr (ALIGN_EPI) { if (wr == 0) PG8_BAR; }
        if constexpr (!Epi::AFTER_DRAIN) { E(acc, cur, wr, wc, fr, fq); S.done(cur); }
        if (!has_next) break;
#pragma unroll
        for (int a = 0; a < 2; ++a)
#pragma unroll
            for (int b = 0; b < 2; ++b)
#pragma unroll
                for (int m = 0; m < 4; ++m)
#pragma unroll
                    for (int n = 0; n < 2; ++n) acc[a][b][m][n] = (f32x4){0.f, 0.f, 0.f, 0.f};
        cur = nxt; cA = nA; cB = nB; ++ui;
        if constexpr (ALIGN_EPI) { if (wr == 1) PG8_BAR; }
    }
    PG8_WAIT_V(0);
    if constexpr (!ALIGN_EPI) { if (wr == 0) PG8_BAR; }
    PG8_BAR;
    if constexpr (Epi::AFTER_DRAIN) { E.fused(acc, cur, wr, wc, fr, fq, lds, wid, lane); S.done(cur); }
#undef PG8_SA
#undef PG8_SB
#undef PG8_STAGE
#undef PG8_LDA
#undef PG8_LDB
#undef PG8_MMA
#undef PG8_WAIT_V
#undef PG8_WAIT_L
#undef PG8_BAR
#undef PG8_SCHED
}
}


constexpr int S_LAT = 16384, C_CTX = 256, R_ALL = S_LAT + C_CTX, DM = 1024;
constexpr int INW = 2560, FFN = 2816, EXD = 3584, NEXP = 8;
constexpr int COL_AQ = 0, COL_AK = 512, COL_AV = 640, COL_HQ = 768, COL_HFF = 1024, COL_HFB = 1280, COL_HI = 1536, COL_HG = 1792, COL_GU = 2048, COL_GV = 2304;
constexpr int MIX_AT = 0, MIX_HG = 512, MIX_GM = 768;
constexpr int MOE_MAXROWS = 34816;
constexpr float EPS = 1e-6f;
constexpr int NWAVES = 8, NTHR = 512;
constexpr int NPH = 23;

constexpr size_t MiB = 1u << 20;
constexpr size_t WS_CTL = 0, CTL_ZERO_BYTES = 1 * MiB;
constexpr size_t WS_VEC = 1 * MiB;
constexpr size_t WS_TOK = 2 * MiB;
constexpr size_t WS_WIN = 3 * MiB;
constexpr size_t WS_WOUT = 13 * MiB;
constexpr size_t WS_WGU = 17 * MiB;
constexpr size_t WS_WD = 28 * MiB;
constexpr size_t WS_MGU = 34 * MiB;
constexpr size_t WS_MD = 146 * MiB;
constexpr size_t WS_H = 202 * MiB;
constexpr size_t WS_PROJ = 235 * MiB;
constexpr size_t WS_MIX = 317 * MiB;
constexpr size_t WS_HGO = 350 * MiB;
constexpr size_t WS_CTXR = 383 * MiB;
constexpr size_t WS_HLT = WS_HGO;
constexpr size_t WS_HSP = 384 * MiB;
constexpr size_t WS_HDG = 402 * MiB;
constexpr size_t WS_VT = 403 * MiB;
constexpr size_t WS_HID = WS_PROJ;
constexpr size_t WS_AS = 202 * MiB;
constexpr size_t WS_HIDM = 270 * MiB;
constexpr size_t WS_H2B = 440 * MiB;
constexpr size_t WS_YF = WS_WIN;
constexpr size_t WS_Y = WS_MGU;
constexpr size_t WS_END = 508 * MiB;
static_assert(WS_HID + (size_t)R_ALL * FFN * 2 <= WS_HGO && WS_AS + (size_t)MOE_MAXROWS * DM * 2 <= WS_HIDM && WS_HIDM + (size_t)MOE_MAXROWS * EXD * 2 <= WS_END, "ws map");
static_assert(WS_H2B >= WS_HIDM && WS_H2B + (size_t)S_LAT * DM * 2 <= WS_END && WS_H + (size_t)R_ALL * DM * 2 <= WS_PROJ && WS_PROJ + (size_t)R_ALL * INW * 2 <= WS_MIX && WS_MIX + (size_t)R_ALL * DM * 2 <= WS_HGO && WS_HGO + (size_t)2 * R_ALL * 256 * 4 <= WS_CTXR, "ws map 2");
constexpr int VO_MOD = 0;
constexpr int VO_ROPE = 32768;
constexpr int VO_MOE = 65536;
constexpr int CW_BAR = 4096;
constexpr int CW_MOECNT = 1024;

constexpr int RING_BYTES = 131072;
constexpr int LDSCTL_OFF = 159744, MISC_OFF = LDSCTL_OFF + 320;
constexpr int LDS_BYTES = 163840;

#define GAS __attribute__((address_space(1)))
#define LAS __attribute__((address_space(3)))
typedef unsigned short bf16;
typedef unsigned v4u __attribute__((ext_vector_type(4)));
typedef unsigned v2u __attribute__((ext_vector_type(2)));
typedef float f32x4 __attribute__((ext_vector_type(4)));
typedef GAS unsigned gu32;
#define RLX_AGENT __ATOMIC_RELAXED, __HIP_MEMORY_SCOPE_AGENT
#define LDS_WAIT() asm volatile("s_waitcnt lgkmcnt(0)" ::: "memory")
__device__ __forceinline__ unsigned f2bf(float f) { unsigned u = __builtin_bit_cast(unsigned, f); return (u + 0x7fffu + ((u >> 16) & 1u)) >> 16; }
__device__ __forceinline__ unsigned pk2(float lo, float hi) { return f2bf(lo) | (f2bf(hi) << 16); }
__device__ __forceinline__ float bflo(unsigned w) { return __builtin_bit_cast(float, w << 16); }
__device__ __forceinline__ float bfhi(unsigned w) { return __builtin_bit_cast(float, w & 0xffff0000u); }
__device__ __forceinline__ float silu1(float x) { return x / (1.0f + __expf(-x)); }
__device__ __forceinline__ float sigm1(float x) { return 1.0f / (1.0f + __expf(-x)); }
__device__ __forceinline__ float gelu1(float x) { return 0.5f * x * (1.0f + erff(x * 0.70710678118654752f)); }
template <int X> __device__ __forceinline__ float sx(float v) { return __shfl_xor(v, X); }
__device__ __forceinline__ float sx32_add(float v) { return v + __shfl_xor(v, 32); }
__device__ __forceinline__ float sx32_max(float v) { return fmaxf(v, __shfl_xor(v, 32)); }
__device__ __forceinline__ float wave_sum(float v) { v += sx<1>(v); v += sx<2>(v); v += sx<4>(v); v += sx<8>(v); v += sx<16>(v); return sx32_add(v); }
__device__ __forceinline__ void unpack8(const v4u w, float* f) { f[0] = bflo(w.x); f[1] = bfhi(w.x); f[2] = bflo(w.y); f[3] = bfhi(w.y); f[4] = bflo(w.z); f[5] = bfhi(w.z); f[6] = bflo(w.w); f[7] = bfhi(w.w); }

#define XB_TMO      128
#define XB_XCNT(j)  (256  + 64 * (j))
#define XB_XSUB(j)  (1280 + 64 * (j))
#define XB_XGEN(j)  (2304 + 64 * (j))
#define XB_TOP      3328
#define XB_TOPGEN   3392
#define XCD_BAR_WORDS 3456
#define XB_SPIN_CAP (1u << 18)

__device__ __forceinline__ unsigned xb_ld(unsigned* p)              { return __hip_atomic_load(p, __ATOMIC_RELAXED, __HIP_MEMORY_SCOPE_AGENT); }
__device__ __forceinline__ unsigned xb_add(unsigned* p, unsigned v) { return __hip_atomic_fetch_add(p, v, __ATOMIC_RELAXED, __HIP_MEMORY_SCOPE_AGENT); }
__device__ __forceinline__ unsigned xb_xcc_id() { return (unsigned)__builtin_amdgcn_s_getreg((3 << 11) | 20) & 0xFu; }
#define XB_SPIN(cond, bar) do { unsigned _sp = 0; while (cond) { __builtin_amdgcn_s_sleep(1); \
    if ((++_sp & 255u) == 0u) { if (xb_ld(&(bar)[XB_TMO])) break; if (_sp > XB_SPIN_CAP) { atomicAdd(&(bar)[XB_TMO], 1u); break; } } } } while (0)

struct XcdBarrier {
    unsigned* bar; unsigned x;
    volatile LAS unsigned* st;
};

__device__ __forceinline__ XcdBarrier xcd_barrier_post(unsigned* bar, volatile LAS unsigned* st) {
    XcdBarrier b; b.bar = bar; b.x = xb_xcc_id(); b.st = st;
    if (threadIdx.x == 0) (void)xb_add(&bar[XB_XCNT(b.x)], 1u);
    return b;
}
__device__ __forceinline__ void xcd_barrier_complete(unsigned* bar, unsigned x, unsigned& nloc, unsigned& nx) {
    const unsigned G = gridDim.x * gridDim.y * gridDim.z;
    unsigned sum, cnt, mine, sp = 0u;
    for (;;) {
        sum = 0u; cnt = 0u; mine = 0u;
#pragma unroll
        for (unsigned j = 0; j < 16; ++j) { const unsigned c = xb_ld(&bar[XB_XCNT(j)]); sum += c; cnt += (c > 0u) ? 1u : 0u; mine = (j == x) ? c : mine; }
        if (sum == G) break;
        __builtin_amdgcn_s_sleep(1);
        if ((++sp & 255u) == 0u) { if (xb_ld(&bar[XB_TMO])) break; if (sp > XB_SPIN_CAP) { atomicAdd(&bar[XB_TMO], 1u); break; } }
    }
    nloc = mine > 0u ? mine : 1u; nx = cnt > 0u ? cnt : 1u;
}

__device__ __forceinline__ void xcd_barrier(const XcdBarrier& b) {
    asm volatile("s_waitcnt vmcnt(0)" ::: "memory");
    __syncthreads();
    if (threadIdx.x == 0) {
        unsigned* bar = b.bar;
        __builtin_amdgcn_s_waitcnt(0);
        unsigned nloc = b.st[0], nx = b.st[1];
        if (nloc == 0u) { xcd_barrier_complete(bar, b.x, nloc, nx); b.st[0] = nloc; b.st[1] = nx; }
        const unsigned old = xb_add(&bar[XB_XSUB(b.x)], 1u);
        const unsigned gen = old / nloc;
        if (old + 1u == (gen + 1u) * nloc) {
            __builtin_amdgcn_fence(__ATOMIC_RELEASE, "agent");
            asm volatile("s_waitcnt vmcnt(0)" ::: "memory");
            const unsigned og = xb_add(&bar[XB_TOP], 1u);
            const unsigned tg = og / nx;
            if (og + 1u == (tg + 1u) * nx) xb_add(&bar[XB_TOPGEN], 1u);
            else XB_SPIN(xb_ld(&bar[XB_TOPGEN]) == tg, bar);
            __builtin_amdgcn_fence(__ATOMIC_ACQUIRE, "agent");
            xb_add(&bar[XB_XGEN(b.x)], 1u);
            asm volatile("s_waitcnt vmcnt(0)" ::: "memory");
        } else {
            XB_SPIN(xb_ld(&bar[XB_XGEN(b.x)]) == gen, bar);
            __builtin_amdgcn_fence(__ATOMIC_ACQUIRE, "agent");
            asm volatile("s_waitcnt vmcnt(0)" ::: "memory");
        }
    }
    __syncthreads();
}


struct Args { const float* in[23]; float* out; unsigned char* ws; int ph_lo, ph_hi; };
typedef const __attribute__((address_space(4))) Args* KA;
#define KARGS() ({ KA p_ = (KA)__builtin_amdgcn_kernarg_segment_ptr(); asm volatile("" : "+s"(p_)); p_; })
enum { I_X = 0, I_C, I_CTX, I_CCTX, I_WADA, I_BADA, I_WIN, I_WOUT, I_QG, I_KG, I_SINK, I_HLB, I_HGAIN, I_GWS, I_GBS, I_GNG, I_FG, I_FU, I_FD, I_ROUTER, I_MG, I_MU, I_MDN };

__device__ __forceinline__ void transpose_item(const float* W, int K, int N, bf16* WT, int mode, LAS float* scr, int item, int lane) {
    const int nblk = N / 32, kb = item / nblk, nb = item % nblk, k0 = 64 * kb, n0 = 32 * nb;
#pragma unroll 8
    for (int i = 0; i < 32; ++i) { const int kk = 2 * i + (lane >> 5); scr[kk * 33 + (lane & 31)] = W[(size_t)(k0 + kk) * N + n0 + (lane & 31)]; }
    LDS_WAIT(); asm volatile("" ::: "memory");
    const int c = lane & 7;
#pragma unroll
    for (int j = 0; j < 4; ++j) { const int n = (lane >> 3) + 8 * j; const LAS float* s = scr + (8 * c) * 33 + n;
        v4u o; o.x = pk2(s[0 * 33], s[1 * 33]); o.y = pk2(s[2 * 33], s[3 * 33]); o.z = pk2(s[4 * 33], s[5 * 33]); o.w = pk2(s[6 * 33], s[7 * 33]);
        const int ng = n0 + n; const int drow = (mode == 0) ? ng : (ng + 128 * (ng / 128) + (mode == 2 ? 128 : 0));
        *(GAS v4u*)(WT + (size_t)drow * K + k0 + 8 * c) = o; }
    LDS_WAIT(); asm volatile("" ::: "memory");
}
__device__ __forceinline__ void p0_prologue(KA a, LAS unsigned char* lds, int tid, int lane, int wave, int G, int bid) {
    unsigned char* ws = a->ws;
    LAS float* scr = (LAS float*)(lds + wave * 8704);
    const int gw = bid * NWAVES + wave, NGW = G * NWAVES;
    constexpr int I_IN = 16 * 80, I_OUT = 16 * 32, I_F = 16 * 88, I_FDN = 44 * 32, I_M = 16 * 112;
    constexpr int NIT = 2 * I_IN + 2 * I_OUT + 2 * I_F + I_FDN + 24 * I_M;
    for (int it0 = gw; it0 < NIT; it0 += NGW) {
        int it = it0;
        if (it < 2 * I_IN) { const int l = it / I_IN, r = it % I_IN; transpose_item(a->in[I_WIN] + (size_t)l * DM * INW, DM, INW, (bf16*)(ws + WS_WIN) + (size_t)l * INW * DM, 0, scr, r, lane); continue; } it -= 2 * I_IN;
        if (it < 2 * I_OUT) { const int l = it / I_OUT, r = it % I_OUT; transpose_item(a->in[I_WOUT] + (size_t)l * DM * DM, DM, DM, (bf16*)(ws + WS_WOUT) + (size_t)l * DM * DM, 0, scr, r, lane); continue; } it -= 2 * I_OUT;
        if (it < I_F) { transpose_item(a->in[I_FG], DM, FFN, (bf16*)(ws + WS_WGU), 1, scr, it, lane); continue; } it -= I_F;
        if (it < I_F) { transpose_item(a->in[I_FU], DM, FFN, (bf16*)(ws + WS_WGU), 2, scr, it, lane); continue; } it -= I_F;
        if (it < I_FDN) { transpose_item(a->in[I_FD], FFN, DM, (bf16*)(ws + WS_WD), 0, scr, it, lane); continue; } it -= I_FDN;
        { const int idx = it / I_M, r = it % I_M;
          if (idx < 8) transpose_item(a->in[I_MG] + (size_t)idx * DM * EXD, DM, EXD, (bf16*)(ws + WS_MGU) + (size_t)idx * 2 * EXD * DM, 1, scr, r, lane);
          else if (idx < 16) transpose_item(a->in[I_MU] + (size_t)(idx - 8) * DM * EXD, DM, EXD, (bf16*)(ws + WS_MGU) + (size_t)(idx - 8) * 2 * EXD * DM, 2, scr, r, lane);
          else transpose_item(a->in[I_MDN] + (size_t)(idx - 16) * EXD * DM, EXD, DM, (bf16*)(ws + WS_MD) + (size_t)(idx - 16) * DM * EXD, 0, scr, r, lane); }
    }
    LAS float* sil = (LAS float*)(lds + 69632);
    LAS float* part = (LAS float*)(lds + 69632 + 8192);
    float* vec = (float*)(ws + WS_VEC);
    if (bid < 192) {
        for (int i = tid; i < 2048; i += NTHR) { const float v = (i < 1024) ? a->in[I_C][i] : a->in[I_CCTX][i - 1024]; sil[i] = silu1(v); }
        __syncthreads();
        for (int item = bid; item < 192; item += G) {
            const int l = item / 96, cb = item % 96, col = cb * 64 + lane;
            const float* w = a->in[I_WADA] + (size_t)l * DM * 6144 + col;
            float a0 = 0.f, a1 = 0.f;
#pragma unroll 8
            for (int k = wave * 128; k < wave * 128 + 128; ++k) { const float wv = w[(size_t)k * 6144]; a0 += sil[k] * wv; a1 += sil[1024 + k] * wv; }
            part[(wave * 2 + 0) * 64 + lane] = a0; part[(wave * 2 + 1) * 64 + lane] = a1;
            __syncthreads();
            if (wave == 0) { float s0 = 0.f, s1 = 0.f;
#pragma unroll
                for (int w8 = 0; w8 < 8; ++w8) { s0 += part[(w8 * 2 + 0) * 64 + lane]; s1 += part[(w8 * 2 + 1) * 64 + lane]; }
                const float b = a->in[I_BADA][l * 6144 + col];
                vec[VO_MOD + (l * 2 + 0) * 6144 + col] = s0 + b; vec[VO_MOD + (l * 2 + 1) * 6144 + col] = s1 + b; }
            __syncthreads();
        }
    }
    for (int i = bid * NTHR + tid; i < C_CTX * DM / 4; i += G * NTHR) ((GAS f32x4*)(ws + WS_CTXR))[i] = ((const GAS f32x4*)a->in[I_CTX])[i];
    if (bid == G - 1) {
        for (int idx = tid; idx < 5120; idx += NTHR) {
            const int isc = idx >= 4096, j = isc ? idx - 4096 : idx, pos = j / 16, i = j % 16;
            const float inv = exp2f(-(float)i * 0.83048202372184059f);
            const float ang = (float)pos * inv;
            double r = (double)ang * 0.15915494309189535; r -= floor(r);
            const float rf = (float)r;
            const float cs = __builtin_amdgcn_cosf(rf), sn = __builtin_amdgcn_sinf(rf);
            float* t = vec + VO_ROPE + (isc ? 8192 : 0);
            const int n = isc ? 1024 : 4096;
            t[j] = cs; t[n + j] = sn;
        }
    }
}

__device__ __forceinline__ void norm_row(const float* xrow, const float* sc, const float* sh, bf16* orow, int lane, f32x4 (&h)[4]) {
    const GAS f32x4* xr = (const GAS f32x4*)xrow + lane;
    f32x4 v[4]; float s = 0.f;
#pragma unroll
    for (int j = 0; j < 4; ++j) { v[j] = xr[64 * j]; s += (v[j].x * v[j].x + v[j].y * v[j].y) + (v[j].z * v[j].z + v[j].w * v[j].w); }
    const float rstd = __builtin_amdgcn_rsqf(wave_sum(s) * (1.0f / DM) + EPS);
    GAS v2u* o8 = (GAS v2u*)orow + lane;
#pragma unroll
    for (int j = 0; j < 4; ++j) { const f32x4 scv = *(const f32x4*)(sc + 4 * lane + 256 * j), shv = *(const f32x4*)(sh + 4 * lane + 256 * j);
        h[j] = v[j] * rstd * (scv + 1.0f) + shv;
        v2u w; w.x = pk2(h[j].x, h[j].y); w.y = pk2(h[j].z, h[j].w); o8[64 * j] = w; }
}
__device__ __forceinline__ void phase_norm(KA a, int l, int which, int nrows, bf16* H, int lane, int wave, int G, int bid) {
    const float* vec = (const float*)(a->ws + WS_VEC);
    const float* xl = (l == 0 && which == 0) ? a->in[I_X] : a->out;
    const float* xc = (l == 0 && which == 0) ? a->in[I_CTX] : (const float*)(a->ws + WS_CTXR);
    const float* ml = vec + VO_MOD + (l * 2 + 0) * 6144 + which * 3072;
    const float* mc = vec + VO_MOD + (l * 2 + 1) * 6144 + which * 3072;
    const int gw = bid * NWAVES + wave, NGW = G * NWAVES;
    for (int r = gw; r < nrows; r += NGW) {
        const bool isc = r >= S_LAT; f32x4 h[4];
        norm_row(isc ? xc + (size_t)(r - S_LAT) * DM : xl + (size_t)r * DM, (isc ? mc : ml) + 1024, isc ? mc : ml, H + (size_t)r * DM, lane, h);
    }
}
__device__ __forceinline__ void phase_norm_route(KA a, LAS unsigned char* lds, int tid, int lane, int wave, int G, int bid) {
    const int l = 1;
    const float* vec = (const float*)(a->ws + WS_VEC);
    const float* ml = vec + VO_MOD + (l * 2 + 0) * 6144 + 3072;
    bf16* H = (bf16*)(a->ws + WS_H2B);
    LAS float* rt = (LAS float*)lds;
    for (int i = tid; i < 8192; i += NTHR) rt[i] = a->in[I_ROUTER][i];
    __syncthreads();
    int* tokinfo = (int*)(a->ws + WS_TOK);
    unsigned* cnt = (unsigned*)(a->ws + WS_CTL) + CW_MOECNT;
    const int gw = bid * NWAVES + wave, NGW = G * NWAVES;
    for (int r = gw; r < S_LAT; r += NGW) {
        f32x4 h[4];
        norm_row(a->out + (size_t)r * DM, ml + 1024, ml, H + (size_t)r * DM, lane, h);
        float lg[8];
#pragma unroll
        for (int e = 0; e < 8; ++e) lg[e] = 0.f;
#pragma unroll
        for (int j = 0; j < 4; ++j)
#pragma unroll
            for (int i = 0; i < 4; ++i) { const int d = 4 * lane + 256 * j + i; const f32x4 r0 = *(const LAS f32x4*)(rt + d * 8), r1 = *(const LAS f32x4*)(rt + d * 8 + 4); const float hv = h[j][i];
                lg[0] += hv * r0.x; lg[1] += hv * r0.y; lg[2] += hv * r0.z; lg[3] += hv * r0.w; lg[4] += hv * r1.x; lg[5] += hv * r1.y; lg[6] += hv * r1.z; lg[7] += hv * r1.w; }
#pragma unroll
        for (int e = 0; e < 8; ++e) lg[e] = wave_sum(lg[e]);
        int i1 = 0; float v1 = lg[0];
#pragma unroll
        for (int e = 1; e < 8; ++e) if (lg[e] > v1) { v1 = lg[e]; i1 = e; }
        int i2 = -1; float v2 = -INFINITY;
#pragma unroll
        for (int e = 0; e < 8; ++e) if (e != i1 && lg[e] > v2) { v2 = lg[e]; i2 = e; }
        const float w1 = 1.0f / (1.0f + __expf(v2 - v1)), w2 = 1.0f - w1;
        if (lane == 0) {
            const unsigned r1 = __hip_atomic_fetch_add(cnt + i1, 1u, RLX_AGENT), r2 = __hip_atomic_fetch_add(cnt + i2, 1u, RLX_AGENT);
            int* ti = tokinfo + (size_t)r * 8;
            ti[0] = i1; ti[1] = i2; ti[2] = (int)r1; ti[3] = (int)r2; ti[4] = __builtin_bit_cast(int, w1); ti[5] = __builtin_bit_cast(int, w2);
        }
    }
}

__device__ __forceinline__ void qk_prep(KA a, int l, int first_thread, int nthreads) {
    bf16* PROJ = (bf16*)(a->ws + WS_PROJ);
    const float* rope = (const float*)(a->ws + WS_VEC) + VO_ROPE;
    for (int i = first_thread; i < R_ALL * 10; i += nthreads) {
        const int row = i / 10, hh = i % 10; const bool isq = hh < 8;
        bf16* p = PROJ + (size_t)row * INW + (isq ? hh * 64 : COL_AK + (hh - 8) * 64);
        const float* gain = (isq ? a->in[I_QG] : a->in[I_KG]) + l * 64;
        float x[64]; float ss = 0.f;
#pragma unroll
        for (int c = 0; c < 8; ++c) { const v4u w = *(const GAS v4u*)(p + 8 * c); unpack8(w, x + 8 * c); }
#pragma unroll
        for (int d = 0; d < 64; ++d) ss += x[d] * x[d];
        const float rstd = __builtin_amdgcn_rsqf(ss * (1.0f / 64.0f) + EPS);
#pragma unroll
        for (int d = 0; d < 64; ++d) x[d] = x[d] * rstd * gain[d];
        if (row < S_LAT) {
            const int gr = row >> 6, gc = row & 63;
            const float* cr = rope + gr * 16, * sr = rope + 4096 + gr * 16, * cc = rope + 8192 + gc * 16, * sc = rope + 8192 + 1024 + gc * 16;
#pragma unroll
            for (int j = 0; j < 16; ++j) { const float x1 = x[j], x2 = x[16 + j], c = cr[j], s = sr[j]; x[j] = x1 * c - x2 * s; x[16 + j] = x1 * s + x2 * c; }
#pragma unroll
            for (int j = 0; j < 16; ++j) { const float x1 = x[32 + j], x2 = x[48 + j], c = cc[j], s = sc[j]; x[32 + j] = x1 * c - x2 * s; x[48 + j] = x1 * s + x2 * c; }
        }
        const float qs = isq ? 0.125f * 1.4426950408889634f : 1.0f;
#pragma unroll
        for (int c = 0; c < 8; ++c) { v4u w; w.x = pk2(x[8 * c] * qs, x[8 * c + 1] * qs); w.y = pk2(x[8 * c + 2] * qs, x[8 * c + 3] * qs); w.z = pk2(x[8 * c + 4] * qs, x[8 * c + 5] * qs); w.w = pk2(x[8 * c + 6] * qs, x[8 * c + 7] * qs);
            *(GAS v4u*)(p + 8 * c) = w; }
    }
}
__device__ __forceinline__ void gmlp_unit(KA a, int l, int chunk, int g, LAS unsigned char* lds, int tid, int lane, int wave) {
    const bf16* PROJ = (const bf16*)(a->ws + WS_PROJ); bf16* MIX = (bf16*)(a->ws + WS_MIX);
    const int row0 = (chunk < 128) ? chunk * 128 : S_LAT + (chunk - 128) * 128;
    LAS float* vn = (LAS float*)lds;
    { const int pos = tid >> 2, part = tid & 3;
      const bf16* p = PROJ + (size_t)(row0 + pos) * INW + COL_GV + g * 64 + part * 16;
      float x[16]; unpack8(*(const GAS v4u*)p, x); unpack8(*(const GAS v4u*)(p + 8), x + 8);
      float ss = 0.f;
#pragma unroll
      for (int d = 0; d < 16; ++d) { x[d] = gelu1(x[d]); ss += x[d] * x[d]; }
      ss += sx<1>(ss); ss += sx<2>(ss);
      const float rstd = __builtin_amdgcn_rsqf(ss * (1.0f / 64.0f) + EPS);
      const float* gn = a->in[I_GNG] + l * 256 + g * 64 + part * 16;
#pragma unroll
      for (int d = 0; d < 16; ++d) vn[pos * 64 + part * 16 + d] = x[d] * rstd * gn[d]; }
    __syncthreads();
    const int c = lane, t0 = wave * 16;
    const float* W = a->in[I_GWS] + ((size_t)(l * 4 + g) * 128 + t0) * 128;
    float acc[16];
#pragma unroll
    for (int i = 0; i < 16; ++i) acc[i] = 0.f;
    for (int s = 0; s < 128; ++s) { const float v = vn[s * 64 + c];
#pragma unroll
        for (int i = 0; i < 16; ++i) acc[i] += W[i * 128 + s] * v; }
    const float* bs = a->in[I_GBS] + (l * 4 + g) * 128 + t0;
#pragma unroll
    for (int i = 0; i < 16; ++i) { const int row = row0 + t0 + i;
        const float u = gelu1(bflo((unsigned)PROJ[(size_t)row * INW + COL_GU + g * 64 + c]));
        MIX[(size_t)row * DM + MIX_GM + g * 64 + c] = (bf16)f2bf(u * (acc[i] + bs[i])); }
    __syncthreads();
}
__device__ __forceinline__ void hgrn_naive(KA a, int l, int dir, int head, LAS unsigned char* lds, int tid, int lane, int wave) {
    const bf16* PROJ = (const bf16*)(a->ws + WS_PROJ);
    float* HGO = (float*)(a->ws + WS_HGO) + (size_t)dir * R_ALL * 256;
    LAS float* Qs = (LAS float*)lds;
    LAS float* Fs = Qs + 4096; LAS float* Vs = Fs + 4096; LAS float* part = Vs + 4096;
    const int v = lane, kg = wave;
    float S[8];
#pragma unroll
    for (int i = 0; i < 8; ++i) S[i] = 0.f;
    const int tl = tid >> 3, c8 = tid & 7;
    float lb[8];
#pragma unroll
    for (int j = 0; j < 8; ++j) { float b = 0.f; if (l == 1) { const float p0 = a->in[I_HLB][dir * 512 + head * 64 + c8 * 8 + j], p1 = a->in[I_HLB][dir * 512 + 256 + head * 64 + c8 * 8 + j]; b = 1.0f / (1.0f + __expf(p0 - p1)); } lb[j] = b; }
    const int fcol = (dir == 0 ? COL_HFF : COL_HFB) + head * 64 + c8 * 8;
    for (int n0 = 0; n0 < R_ALL; n0 += 64) {
        { const int n = n0 + tl; int row;
          if (dir == 0) row = (n < C_CTX) ? S_LAT + n : n - C_CTX; else row = (n < C_CTX) ? S_LAT + (C_CTX - 1 - n) : (S_LAT - 1) - (n - C_CTX);
          const bf16* pr = PROJ + (size_t)row * INW;
          float q[8], f[8], vv[8];
          unpack8(*(const GAS v4u*)(pr + COL_HQ + head * 64 + c8 * 8), q); unpack8(*(const GAS v4u*)(pr + fcol), f); unpack8(*(const GAS v4u*)(pr + COL_HI + head * 64 + c8 * 8), vv);
#pragma unroll
          for (int j = 0; j < 8; ++j) { Qs[tl * 64 + c8 * 8 + j] = silu1(q[j]) * 0.125f; Fs[tl * 64 + c8 * 8 + j] = lb[j] + (1.0f - lb[j]) * sigm1(f[j]); Vs[tl * 64 + c8 * 8 + j] = vv[j]; } }
        __syncthreads();
        for (int t = 0; t < 64; ++t) {
            const float vt = Vs[t * 64 + v]; float po = 0.f;
#pragma unroll
            for (int i = 0; i < 8; ++i) { const float f = Fs[t * 64 + kg * 8 + i], q = Qs[t * 64 + kg * 8 + i]; S[i] = f * S[i] + (1.0f - f) * vt; po += S[i] * q; }
            part[((t & 1) * 8 + kg) * 64 + v] = po;
            __syncthreads();
            if (wave == 0) { float o = 0.f;
#pragma unroll
                for (int w8 = 0; w8 < 8; ++w8) o += part[((t & 1) * 8 + w8) * 64 + v];
                const int n = n0 + t; int row;
                if (dir == 0) row = (n < C_CTX) ? S_LAT + n : n - C_CTX; else row = (n < C_CTX) ? S_LAT + (C_CTX - 1 - n) : (S_LAT - 1) - (n - C_CTX);
                HGO[(size_t)row * 256 + head * 64 + v] = o; }
        }
        __syncthreads();
    }
}

typedef short bf16x8v __attribute__((ext_vector_type(8)));
constexpr int HST = 72;
__device__ __forceinline__ f32x4 mma16(const LAS bf16* MA, const LAS bf16* MBt, int k0, f32x4 c, int lane) {
    const bf16x8v av = *(const LAS bf16x8v*)(MA + (lane & 15) * HST + k0 + 8 * (lane >> 4));
    const bf16x8v bv = *(const LAS bf16x8v*)(MBt + (lane & 15) * HST + k0 + 8 * (lane >> 4));
    return __builtin_amdgcn_mfma_f32_16x16x32_bf16(av, bv, c, 0, 0, 0);
}
__device__ __forceinline__ int hg_base_row(int cpos) { return cpos < 256 ? 64 * cpos : S_LAT + 64 * (cpos - 256); }
__device__ __forceinline__ int hg_scan_idx(int dir, int cpos) { return dir == 0 ? (cpos < 256 ? 4 + cpos : cpos - 256) : (cpos < 256 ? 4 + (255 - cpos) : 3 - (cpos - 256)); }
__device__ __forceinline__ float hg_lb(KA a, int l, int dir, int head, int k) {
    if (l == 0) return 0.f;
    const float p0 = a->in[I_HLB][dir * 512 + head * 64 + k], p1 = a->in[I_HLB][dir * 512 + 256 + head * 64 + k];
    return 1.0f / (1.0f + __expf(p0 - p1));
}
__device__ __forceinline__ void hgrn_stepA(KA a, int l, int cpos, int head, LAS unsigned char* lds, int lane, int wave) {
    const bf16* PROJ = (const bf16*)(a->ws + WS_PROJ);
    const int dir = wave >> 2, I = wave & 3, base = hg_base_row(cpos), ci = hg_scan_idx(dir, cpos);
    LAS float* TOT = (LAS float*)lds;
    LAS bf16* KLT = (LAS bf16*)(lds + 2048) + dir * 64 * HST;
    LAS bf16* VT = (LAS bf16*)(lds + 2048 + 2 * 64 * HST * 2) + dir * 64 * HST;
    const float lb = hg_lb(a, l, dir, head, lane);
    const int fcol = (dir == 0 ? COL_HFF : COL_HFB) + head * 64 + lane, vcol = COL_HI + head * 64 + lane;
    float kk[16], cl[16]; float run = 0.f;
#pragma unroll
    for (int i = 0; i < 16; ++i) { const int n = 16 * I + i, row = base + (dir ? 63 - n : n);
        const float fl = bflo((unsigned)PROJ[(size_t)row * INW + fcol]);
        const unsigned short vb = PROJ[(size_t)row * INW + vcol];
        const float f = lb + (1.0f - lb) * sigm1(fl);
        run += __logf(f); cl[i] = run; kk[i] = 1.0f - f;
        VT[lane * HST + n] = vb; }
    TOT[(dir * 4 + I) * 64 + lane] = run;
    __syncthreads();
    float post = 0.f, all = 0.f;
#pragma unroll
    for (int J = 0; J < 4; ++J) { const float t = TOT[(dir * 4 + J) * 64 + lane]; all += t; if (J > I) post += t; }
#pragma unroll
    for (int i = 0; i < 16; ++i) KLT[lane * HST + 16 * I + i] = (bf16)f2bf(kk[i] * __expf(run - cl[i] + post));
    if (I == 0) ((float*)(a->ws + WS_HDG))[((size_t)(dir * 4 + head) * 260 + ci) * 64 + lane] = __expf(all);
    __syncthreads();
    float* LT = (float*)(a->ws + WS_HLT) + ((size_t)(dir * 4 + head) * 260 + ci) * 4096;
    float z0 = 0.f; asm volatile("" : "+v"(z0));
#pragma unroll
    for (int kb = 0; kb < 4; ++kb) { f32x4 acc = {z0, z0, z0, z0};
        acc = mma16(VT + 16 * I * HST, KLT + 16 * kb * HST, 0, acc, lane); acc = mma16(VT + 16 * I * HST, KLT + 16 * kb * HST, 32, acc, lane);
#pragma unroll
        for (int r = 0; r < 4; ++r) LT[(16 * I + 4 * (lane >> 4) + r) * 64 + 16 * kb + (lane & 15)] = acc[r]; }
    __syncthreads();
}
__device__ __forceinline__ void hgrn_stepB(KA a, int item, int tid) {
    const int dh = item >> 3, vb = item & 7, v = vb * 8 + (tid >> 6), k = tid & 63;
    const float* LT = (const float*)(a->ws + WS_HLT) + (size_t)dh * 260 * 4096 + v * 64 + k;
    const float* DG = (const float*)(a->ws + WS_HDG) + (size_t)dh * 260 * 64 + k;
    bf16* SP = (bf16*)(a->ws + WS_HSP) + (size_t)dh * 260 * 4096 + v * 64 + k;
    float S = 0.f;
#pragma unroll 1
    for (int c0 = 0; c0 < 260; c0 += 26) {
        float lt[26], dg[26];
#pragma unroll
        for (int j = 0; j < 26; ++j) { lt[j] = LT[(size_t)(c0 + j) * 4096]; dg[j] = DG[(c0 + j) * 64]; }
#pragma unroll
        for (int j = 0; j < 26; ++j) { SP[(size_t)(c0 + j) * 4096] = (bf16)f2bf(S); S = dg[j] * S + lt[j]; }
    }
}
__device__ __forceinline__ void hgrn_stepC(KA a, int l, int cpos, int head, LAS unsigned char* lds, int tid, int lane, int wave) {
    const bf16* PROJ = (const bf16*)(a->ws + WS_PROJ); bf16* MIX = (bf16*)(a->ws + WS_MIX);
    const int dir = wave >> 2, I = wave & 3, base = hg_base_row(cpos), ci = hg_scan_idx(dir, cpos);
    constexpr int MSZ = 64 * HST;
    LAS float* TOT = (LAS float*)lds;
    LAS bf16* img = (LAS bf16*)(lds + 2048);
    LAS bf16* QT = img + dir * MSZ;
    LAS bf16* QD = img + 2 * MSZ + dir * MSZ;
    LAS bf16* VT = img + 4 * MSZ + dir * MSZ;
    LAS bf16* ST = img + 6 * MSZ + dir * MSZ;
    LAS bf16* AS = img + 8 * MSZ + dir * MSZ + I * 16 * HST;
    LAS bf16* KT = img + 10 * MSZ + dir * (10 * 16 * HST);
    LAS float* OS = (LAS float*)(img + 10 * MSZ);
    const float lb = hg_lb(a, l, dir, head, lane);
    const int fcol = (dir == 0 ? COL_HFF : COL_HFB) + head * 64 + lane, qcol = COL_HQ + head * 64 + lane, vcol = COL_HI + head * 64 + lane;
    { const bf16* SP = (const bf16*)(a->ws + WS_HSP) + ((size_t)(dir * 4 + head) * 260 + ci) * 4096;
#pragma unroll
      for (int h2 = 0; h2 < 2; ++h2) { const int e = ((I * 2 + h2) * 64 + lane) * 8, vv = e >> 6, kk0 = e & 63;
          *(LAS v4u*)(ST + vv * HST + kk0) = *(const GAS v4u*)(SP + e); } }
    float kk[16], cl[16], qv[16]; float run = 0.f;
#pragma unroll
    for (int i = 0; i < 16; ++i) { const int n = 16 * I + i, row = base + (dir ? 63 - n : n);
        const float fl = bflo((unsigned)PROJ[(size_t)row * INW + fcol]), ql = bflo((unsigned)PROJ[(size_t)row * INW + qcol]);
        const unsigned short vb = PROJ[(size_t)row * INW + vcol];
        const float f = lb + (1.0f - lb) * sigm1(fl);
        run += __logf(f); cl[i] = run; kk[i] = 1.0f - f; qv[i] = silu1(ql) * 0.125f;
        VT[lane * HST + n] = vb; }
    TOT[(dir * 4 + I) * 64 + lane] = run;
    __syncthreads();
    float tj[4];
#pragma unroll
    for (int J = 0; J < 4; ++J) tj[J] = TOT[(dir * 4 + J) * 64 + lane];
    float pre = 0.f;
#pragma unroll
    for (int J = 0; J < 4; ++J) if (J < I) pre += tj[J];
#pragma unroll
    for (int i = 0; i < 16; ++i) { const float e = __expf(cl[i]); QT[(16 * I + i) * HST + lane] = (bf16)f2bf(qv[i] * e); QD[(16 * I + i) * HST + lane] = (bf16)f2bf(qv[i] * e * __expf(pre)); }
    float eoff = 0.f;
#pragma unroll
    for (int I2 = 0; I2 < 4; ++I2) {
        if (I2 >= I) {
            if (I2 == I) eoff = 0.f; else if (I2 == I + 1) eoff = run; else eoff += tj[I2 - 1];
            LAS bf16* blk = KT + (I2 * (I2 + 1) / 2 + I) * 16 * HST;
#pragma unroll
            for (int i = 0; i < 16; ++i) blk[i * HST + lane] = (bf16)f2bf(kk[i] * __expf(fminf(eoff - cl[i], 80.0f)));
        }
    }
    __syncthreads();
    float z0 = 0.f; asm volatile("" : "+v"(z0));
    f32x4 sc[4];
#pragma unroll
    for (int J = 0; J < 4; ++J) { sc[J] = (f32x4){z0, z0, z0, z0};
        if (J <= I) { const LAS bf16* kb = KT + (I * (I + 1) / 2 + J) * 16 * HST;
            sc[J] = mma16(QT + 16 * I * HST, kb, 0, sc[J], lane); sc[J] = mma16(QT + 16 * I * HST, kb, 32, sc[J], lane);
            if (J == I) {
#pragma unroll
                for (int r = 0; r < 4; ++r) if ((lane & 15) > 4 * (lane >> 4) + r) sc[J][r] = z0; } } }
#pragma unroll
    for (int J = 0; J < 4; ++J)
#pragma unroll
        for (int r = 0; r < 4; ++r) AS[(4 * (lane >> 4) + r) * HST + 16 * J + (lane & 15)] = (bf16)f2bf(sc[J][r]);
    asm volatile("s_waitcnt lgkmcnt(0)" ::: "memory");
    f32x4 acc[4];
#pragma unroll
    for (int vb = 0; vb < 4; ++vb) { acc[vb] = (f32x4){z0, z0, z0, z0};
        acc[vb] = mma16(AS, VT + 16 * vb * HST, 0, acc[vb], lane); acc[vb] = mma16(AS, VT + 16 * vb * HST, 32, acc[vb], lane);
        acc[vb] = mma16(QD + 16 * I * HST, ST + 16 * vb * HST, 0, acc[vb], lane); acc[vb] = mma16(QD + 16 * I * HST, ST + 16 * vb * HST, 32, acc[vb], lane); }
    __syncthreads();
#pragma unroll
    for (int vb = 0; vb < 4; ++vb)
#pragma unroll
        for (int r = 0; r < 4; ++r) { const int n = 16 * I + 4 * (lane >> 4) + r, rl = dir ? 63 - n : n; OS[(dir * 64 + rl) * 68 + 16 * vb + (lane & 15)] = acc[vb][r]; }
    __syncthreads();
    { const int rl = tid >> 3, v8 = (tid & 7) * 8, row = base + rl;
      float o[8]; float ss = 0.f;
#pragma unroll
      for (int j = 0; j < 8; ++j) { o[j] = OS[rl * 68 + v8 + j] + OS[(64 + rl) * 68 + v8 + j]; ss += o[j] * o[j]; }
      ss += sx<1>(ss); ss += sx<2>(ss); ss += sx<4>(ss);
      const float rstd = __builtin_amdgcn_rsqf(ss * (1.0f / 64.0f) + EPS);
      float gt[8]; unpack8(*(const GAS v4u*)(PROJ + (size_t)row * INW + COL_HG + head * 64 + v8), gt);
      const float* gn = a->in[I_HGAIN] + l * 64 + v8;
      float y[8];
#pragma unroll
      for (int j = 0; j < 8; ++j) y[j] = o[j] * rstd * gn[j] * silu1(gt[j]);
      v4u w; w.x = pk2(y[0], y[1]); w.y = pk2(y[2], y[3]); w.z = pk2(y[4], y[5]); w.w = pk2(y[6], y[7]);
      *(GAS v4u*)(MIX + (size_t)row * DM + MIX_HG + head * 64 + v8) = w; }
    __syncthreads();
}

__device__ __forceinline__ void vt_item(KA a, int item, int lane) {
    const bf16* PROJ = (const bf16*)(a->ws + WS_PROJ); bf16* VTg = (bf16*)(a->ws + WS_VT);
    const int rb = item >> 1, hk = item & 1, row = rb * 64 + lane;
    const bf16* p = PROJ + (size_t)row * INW + COL_AV + hk * 64;
    unsigned w[32];
#pragma unroll
    for (int c = 0; c < 8; ++c) { const v4u t = *(const GAS v4u*)(p + 8 * c); w[4 * c] = t.x; w[4 * c + 1] = t.y; w[4 * c + 2] = t.z; w[4 * c + 3] = t.w; }
    bf16* o = VTg + (size_t)hk * 64 * R_ALL + row;
#pragma unroll
    for (int d2 = 0; d2 < 32; ++d2) { o[(size_t)(2 * d2) * R_ALL] = (bf16)(w[d2] & 0xffffu); o[(size_t)(2 * d2 + 1) * R_ALL] = (bf16)(w[d2] >> 16); }
}
__device__ __forceinline__ void attn_unit(KA a, int l, int u, LAS unsigned char* lds, int tid, int lane, int wave) {
    asm volatile("" : "+v"(tid), "+v"(lane));
    const bf16* PROJ = (const bf16*)(a->ws + WS_PROJ); const bf16* VTg = (const bf16*)(a->ws + WS_VT); bf16* MIX = (bf16*)(a->ws + WS_MIX);
    const bool isctx = u >= 256; const int uu = isctx ? u - 256 : u; const int n = uu >> 1, hk = uu & 1;
    const int qh = hk * 4 + (wave >> 1), half = wave & 1;
    const int qbase = (isctx ? S_LAT : 0) + n * 128 + half * 64, qpos0 = n * 128 + half * 64;
    const int c = lane & 15, g = lane >> 4;
    LAS bf16* Kt = (LAS bf16*)lds; LAS bf16* Vt = Kt + 64 * HST; LAS bf16* Qw = Vt + 64 * HST + wave * 64 * HST;
#pragma unroll
    for (int j = 0; j < 8; ++j) { const int qr = 8 * j + (lane >> 3), qc = (lane & 7) * 8;
        *(LAS v4u*)(Qw + qr * HST + qc) = *(const GAS v4u*)(PROJ + (size_t)(qbase + qr) * INW + qh * 64 + qc); }
    float z0 = 0.f; asm volatile("" : "+v"(z0));
    f32x4 o[4][4]; float ls[4];
    float gq = 0.f, gk = 0.f;
#pragma unroll 8
    for (int d = 0; d < 64; ++d) { gq = fmaxf(gq, fabsf(a->in[I_QG][l * 64 + d])); gk = fmaxf(gk, fabsf(a->in[I_KG][l * 64 + d])); }
    const float nbnd = -(8.0f * 1.4426950408889634f) * gq * gk;
    const float sink = a->in[I_SINK][l * 8 + qh] * 1.4426950408889634f;
#pragma unroll
    for (int qt = 0; qt < 4; ++qt) { ls[qt] = (g == 0) ? __builtin_amdgcn_exp2f(sink + nbnd) : z0;
#pragma unroll
        for (int dt = 0; dt < 4; ++dt) o[qt][dt] = (f32x4){z0, z0, z0, z0}; }
    const int first = (!isctx && n == 0) ? 2 : 0, nwin = isctx ? 0 : ((n == 0 || n == 127) ? 4 : 6), nt = nwin + 4;
    const int lr = tid >> 3, lc = (tid & 7) * 8;
    v4u kreg, vreg;
#define ATT_LOADT(i) do { const bool ct_ = (i) >= nwin; const int kb_ = ct_ ? S_LAT + 64 * ((i) - nwin) : (n - 1) * 128 + 64 * (first + (i)); \
        kreg = *(const GAS v4u*)(PROJ + (size_t)(kb_ + lr) * INW + COL_AK + hk * 64 + lc); vreg = *(const GAS v4u*)(VTg + ((size_t)hk * 64 + lr) * R_ALL + kb_ + lc); } while (0)
    ATT_LOADT(0);
#pragma unroll 1
    for (int i = 0; i < nt; ++i) {
        __syncthreads();
        *(LAS v4u*)(Kt + lr * HST + lc) = kreg; *(LAS v4u*)(Vt + lr * HST + lc) = vreg;
        __syncthreads();
        if (i + 1 < nt) ATT_LOADT(i + 1);
        const bool win = i < nwin; const int kb = (n - 1) * 128 + 64 * (first + i);
        bf16x8v kf[4][2], vf[4][2];
#pragma unroll
        for (int kt = 0; kt < 4; ++kt)
#pragma unroll
            for (int ks = 0; ks < 2; ++ks) kf[kt][ks] = *(const LAS bf16x8v*)(Kt + (16 * kt + c) * HST + 32 * ks + 8 * g);
#pragma unroll
        for (int dt = 0; dt < 4; ++dt)
#pragma unroll
            for (int s2 = 0; s2 < 2; ++s2) { const v2u lo = *(const LAS v2u*)(Vt + (16 * dt + c) * HST + 32 * s2 + 4 * g), hi = *(const LAS v2u*)(Vt + (16 * dt + c) * HST + 32 * s2 + 16 + 4 * g);
                const v4u t = {lo.x, lo.y, hi.x, hi.y}; vf[dt][s2] = __builtin_bit_cast(bf16x8v, t); }
#pragma unroll
        for (int qt = 0; qt < 4; ++qt) {
            f32x4 s[4];
            const bf16x8v q0 = *(const LAS bf16x8v*)(Qw + (16 * qt + c) * HST + 8 * g), q1 = *(const LAS bf16x8v*)(Qw + (16 * qt + c) * HST + 32 + 8 * g);
#pragma unroll
            for (int kt = 0; kt < 4; ++kt) { s[kt] = (f32x4){nbnd, nbnd, nbnd, nbnd};
                s[kt] = __builtin_amdgcn_mfma_f32_16x16x32_bf16(kf[kt][0], q0, s[kt], 0, 0, 0); s[kt] = __builtin_amdgcn_mfma_f32_16x16x32_bf16(kf[kt][1], q1, s[kt], 0, 0, 0); }
            if (win) { const int dq = qpos0 + 16 * qt + c - kb - 4 * g;
#pragma unroll
                for (int kt = 0; kt < 4; ++kt)
#pragma unroll
                    for (int r = 0; r < 4; ++r) { const int dl = dq - 16 * kt - r; if (dl > 128 || dl < -128) s[kt][r] = -INFINITY; } }
            float ps = 0.f;
#pragma unroll
            for (int kt = 0; kt < 4; ++kt)
#pragma unroll
                for (int r = 0; r < 4; ++r) { s[kt][r] = __builtin_amdgcn_exp2f(s[kt][r]); ps += s[kt][r]; }
            ls[qt] += ps;
            bf16x8v pb[2];
#pragma unroll
            for (int s2 = 0; s2 < 2; ++s2) { const v4u t = {pk2(s[2 * s2][0], s[2 * s2][1]), pk2(s[2 * s2][2], s[2 * s2][3]), pk2(s[2 * s2 + 1][0], s[2 * s2 + 1][1]), pk2(s[2 * s2 + 1][2], s[2 * s2 + 1][3])};
                pb[s2] = __builtin_bit_cast(bf16x8v, t); }
#pragma unroll
            for (int dt = 0; dt < 4; ++dt) { o[qt][dt] = __builtin_amdgcn_mfma_f32_16x16x32_bf16(vf[dt][0], pb[0], o[qt][dt], 0, 0, 0); o[qt][dt] = __builtin_amdgcn_mfma_f32_16x16x32_bf16(vf[dt][1], pb[1], o[qt][dt], 0, 0, 0); }
        }
    }
#undef ATT_LOADT
    int c2 = lane & 15, g2 = lane >> 4; asm volatile("" : "+v"(c2), "+v"(g2));
#pragma unroll
    for (int qt = 0; qt < 4; ++qt) { float lt = ls[qt]; lt += sx<16>(lt); lt = sx32_add(lt); const float inv = 1.0f / lt;
        bf16* op = (bf16*)(a->ws + WS_MIX) + (size_t)(qbase + 16 * qt + c2) * DM + MIX_AT + qh * 64 + 4 * g2;
#pragma unroll
        for (int dt = 0; dt < 4; ++dt) { v2u w; w.x = pk2(o[qt][dt][0] * inv, o[qt][dt][1] * inv); w.y = pk2(o[qt][dt][2] * inv, o[qt][dt][3] * inv); *(GAS v2u*)(op + 16 * dt) = w; } }
}

constexpr int GST = 136;
__device__ __forceinline__ f32x4 mma16g(const LAS bf16* MA, const LAS bf16* MBt, int k0, f32x4 c, int lane) {
    const bf16x8v av = *(const LAS bf16x8v*)(MA + (lane & 15) * GST + k0 + 8 * (lane >> 4));
    const bf16x8v bv = *(const LAS bf16x8v*)(MBt + (lane & 15) * GST + k0 + 8 * (lane >> 4));
    return __builtin_amdgcn_mfma_f32_16x16x32_bf16(av, bv, c, 0, 0, 0);
}
__device__ __forceinline__ float gelu_as(float v) {
    const float av = fabsf(v), t = __builtin_amdgcn_rcpf(av * 0.2316418882f + 1.0f);
    float q = t * 0.5307027145f + (-0.7265760135f); q = q * t + 0.7107068705f; q = q * t + (-0.142248368f); q = q * t + 0.127414796f; q = q * t;
    const float e = __builtin_amdgcn_exp2f((v * v) * (-0.72134752044f)), mm = v * (q * e);
    return v < 0.f ? mm : v - mm;
}
__device__ __forceinline__ void gmlp_unit_mma(KA a, int l, int chunk, int g, LAS unsigned char* lds, int tid, int lane, int wave) {
    const bf16* PROJ = (const bf16*)(a->ws + WS_PROJ); bf16* MIX = (bf16*)(a->ws + WS_MIX);
    const int row0 = (chunk < 128) ? chunk * 128 : S_LAT + (chunk - 128) * 128;
    LAS bf16* WA = (LAS bf16*)lds;
    LAS bf16* VNT = WA + 128 * GST;
    LAS float* OUT = (LAS float*)(VNT + 64 * GST);
    const int pos = tid >> 2, part = tid & 3;
    {
      const float* W = a->in[I_GWS] + ((size_t)(l * 4 + g) * 128 + pos) * 128 + part * 32;
#pragma unroll
      for (int j = 0; j < 4; ++j) { const f32x4 w0 = *(const GAS f32x4*)(W + 8 * j), w1 = *(const GAS f32x4*)(W + 8 * j + 4);
          v4u o; o.x = pk2(w0.x, w0.y); o.y = pk2(w0.z, w0.w); o.z = pk2(w1.x, w1.y); o.w = pk2(w1.z, w1.w);
          *(LAS v4u*)(WA + pos * GST + part * 32 + 8 * j) = o; } }
    { const bf16* p = PROJ + (size_t)(row0 + pos) * INW + COL_GV + g * 64 + part * 16;
      float x[16]; unpack8(*(const GAS v4u*)p, x); unpack8(*(const GAS v4u*)(p + 8), x + 8);
      float ss = 0.f;
#pragma unroll
      for (int d = 0; d < 16; ++d) { x[d] = gelu_as(x[d]); ss += x[d] * x[d]; }
      ss += sx<1>(ss); ss += sx<2>(ss);
      const float rstd = __builtin_amdgcn_rsqf(ss * (1.0f / 64.0f) + EPS);
      const float* gn = a->in[I_GNG] + l * 256 + g * 64 + part * 16;
#pragma unroll
      for (int d = 0; d < 16; ++d) VNT[(part * 16 + d) * GST + pos] = (bf16)f2bf(x[d] * rstd * gn[d]); }
    __syncthreads();
    float z0 = 0.f; asm volatile("" : "+v"(z0));
#pragma unroll
    for (int cb = 0; cb < 4; ++cb) { f32x4 acc = {z0, z0, z0, z0};
#pragma unroll
        for (int ks = 0; ks < 4; ++ks) acc = mma16g(WA + 16 * wave * GST, VNT + 16 * cb * GST, 32 * ks, acc, lane);
#pragma unroll
        for (int r = 0; r < 4; ++r) OUT[(16 * wave + 4 * (lane >> 4) + r) * 68 + 16 * cb + (lane & 15)] = acc[r]; }
    __syncthreads();
    { const int row = row0 + pos; const float bsv = a->in[I_GBS][(l * 4 + g) * 128 + pos];
      const bf16* pu = PROJ + (size_t)row * INW + COL_GU + g * 64 + part * 16;
      float u[16]; unpack8(*(const GAS v4u*)pu, u); unpack8(*(const GAS v4u*)(pu + 8), u + 8);
      float y[16];
#pragma unroll
      for (int d = 0; d < 16; ++d) y[d] = gelu_as(u[d]) * (OUT[pos * 68 + part * 16 + d] + bsv);
      bf16* po = MIX + (size_t)row * DM + MIX_GM + g * 64 + part * 16;
      v4u w; w.x = pk2(y[0], y[1]); w.y = pk2(y[2], y[3]); w.z = pk2(y[4], y[5]); w.w = pk2(y[6], y[7]); *(GAS v4u*)po = w;
      w.x = pk2(y[8], y[9]); w.y = pk2(y[10], y[11]); w.z = pk2(y[12], y[13]); w.w = pk2(y[14], y[15]); *(GAS v4u*)(po + 8) = w; }
    __syncthreads();
}
__device__ __forceinline__ void attn_naive(KA a, int l, int nrows, int lane, int wave, int G, int bid) {
    const bf16* PROJ = (const bf16*)(a->ws + WS_PROJ); bf16* MIX = (bf16*)(a->ws + WS_MIX);
    const int gw = bid * NWAVES + wave, NGW = G * NWAVES;
    for (int pair = gw; pair < nrows * 2; pair += NGW) {
        const int row = pair >> 1, hk = pair & 1; const bool isctx = row >= S_LAT;
        float q[4], o[4], m[4], ls[4];
#pragma unroll
        for (int g = 0; g < 4; ++g) { q[g] = bflo((unsigned)PROJ[(size_t)row * INW + (hk * 4 + g) * 64 + lane]); o[g] = 0.f; ls[g] = 1.0f; m[g] = a->in[I_SINK][l * 8 + hk * 4 + g] * 1.4426950408889634f; }
        int j0 = 0, j1 = -1;
        if (!isctx) { j0 = row - 128 < 0 ? 0 : row - 128; j1 = row + 128 > S_LAT - 1 ? S_LAT - 1 : row + 128; }
        const int nwin = j1 - j0 + 1;
        const int nk = nwin + C_CTX;
#pragma unroll 4
        for (int t = 0; t < nk; ++t) {
            const int krow = (t < nwin) ? j0 + t : S_LAT + (t - nwin);
            const float k = bflo((unsigned)PROJ[(size_t)krow * INW + COL_AK + hk * 64 + lane]);
            const float v = bflo((unsigned)PROJ[(size_t)krow * INW + COL_AV + hk * 64 + lane]);
#pragma unroll
            for (int g = 0; g < 4; ++g) { const float s = wave_sum(q[g] * k); const float mn = fmaxf(m[g], s);
                const float c = __builtin_amdgcn_exp2f(m[g] - mn), p = __builtin_amdgcn_exp2f(s - mn);
                ls[g] = ls[g] * c + p; o[g] = o[g] * c + p * v; m[g] = mn; }
        }
#pragma unroll
        for (int g = 0; g < 4; ++g) MIX[(size_t)row * DM + MIX_AT + (hk * 4 + g) * 64 + lane] = (bf16)f2bf(o[g] / ls[g]);
    }
}
__device__ __forceinline__ void hgrn_combine(KA a, int l, int nrows, int lane, int wave, int G, int bid) {
    const bf16* PROJ = (const bf16*)(a->ws + WS_PROJ); bf16* MIX = (bf16*)(a->ws + WS_MIX);
    const float* O0 = (const float*)(a->ws + WS_HGO); const float* O1 = O0 + (size_t)R_ALL * 256;
    const f32x4 gn = *(const f32x4*)(a->in[I_HGAIN] + l * 64 + (lane & 15) * 4);
    const int gw = bid * NWAVES + wave, NGW = G * NWAVES;
    for (int r = gw; r < nrows; r += NGW) {
        const f32x4 o = *(const GAS f32x4*)(O0 + (size_t)r * 256 + 4 * lane) + *(const GAS f32x4*)(O1 + (size_t)r * 256 + 4 * lane);
        float ss = (o.x * o.x + o.y * o.y) + (o.z * o.z + o.w * o.w);
        ss += sx<1>(ss); ss += sx<2>(ss); ss += sx<4>(ss); ss += sx<8>(ss);
        const float rstd = __builtin_amdgcn_rsqf(ss * (1.0f / 64.0f) + EPS);
        const v2u gw2 = *(const GAS v2u*)(PROJ + (size_t)r * INW + COL_HG + 4 * lane);
        const float g0 = bflo(gw2.x), g1 = bfhi(gw2.x), g2 = bflo(gw2.y), g3 = bfhi(gw2.y);
        v2u w; w.x = pk2(o.x * rstd * gn.x * silu1(g0), o.y * rstd * gn.y * silu1(g1)); w.y = pk2(o.z * rstd * gn.z * silu1(g2), o.w * rstd * gn.w * silu1(g3));
        *(GAS v2u*)(MIX + (size_t)r * DM + MIX_HG + 4 * lane) = w;
    }
}
__device__ __forceinline__ void moe_gather(KA a, LAS unsigned char* lds, int tid, int lane, int wave, int G, int bid) {
    LAS int* sb = (LAS int*)lds;
    const unsigned* cnt = (const unsigned*)(a->ws + WS_CTL) + CW_MOECNT;
    int* mi = (int*)(a->ws + WS_VEC) + VO_MOE;
    if (tid == 0) { int b = 0;
        for (int e = 0; e < 8; ++e) { const int c = (int)__hip_atomic_load(cnt + e, RLX_AGENT); sb[e] = b; sb[16 + e] = c;
            const int nt = (c + 255) >> 8;
            if (bid == 0) for (int t = 0; t < nt; ++t) mi[16 + (b >> 8) + t] = e;
            b += nt << 8; }
        sb[8] = b; if (bid == 0) mi[0] = b >> 8; }
    __syncthreads();
    const bf16* H = (const bf16*)(a->ws + WS_H2B); bf16* AS = (bf16*)(a->ws + WS_AS);
    const int* tokinfo = (const int*)(a->ws + WS_TOK); int* tokslot = (int*)(a->ws + WS_TOK) + S_LAT * 8;
    const int gw = bid * NWAVES + wave, NGW = G * NWAVES;
    for (int t = gw; t < S_LAT; t += NGW) {
        const int* ti = tokinfo + (size_t)t * 8;
        const int e1 = ti[0], e2 = ti[1], r1 = ti[2], r2 = ti[3];
        const int s1 = sb[e1] + r1, s2 = sb[e2] + r2;
        const GAS v4u* src = (const GAS v4u*)(H + (size_t)t * DM) + lane;
        const v4u x0 = src[0], x1 = src[64];
        GAS v4u* d1 = (GAS v4u*)(AS + (size_t)s1 * DM) + lane; GAS v4u* d2 = (GAS v4u*)(AS + (size_t)s2 * DM) + lane;
        d1[0] = x0; d1[64] = x1; d2[0] = x0; d2[64] = x1;
        if (lane == 0) { int* ts = tokslot + (size_t)t * 4; ts[0] = s1; ts[1] = s2; ts[2] = ti[4]; ts[3] = ti[5]; }
    }
    { const f32x4 z4 = {0.f, 0.f, 0.f, 0.f}; for (int i = bid * NTHR + tid; i < 8 * 256 * DM / 4; i += G * NTHR) ((GAS f32x4*)(a->ws + WS_YF))[i] = z4; }
    for (int e = 0; e < 8; ++e) { const int c = sb[16 + e], pe = (c + 255) & ~255, b = sb[e];
        for (int j = c + gw; j < pe; j += NGW) { GAS v4u* d = (GAS v4u*)(AS + (size_t)(b + j) * DM) + lane; const v4u z = {0u, 0u, 0u, 0u}; d[0] = z; d[64] = z; } }
}
__device__ __forceinline__ void moe_combine(KA a, int lane, int wave, int G, int bid) {
    const float* gf = (const float*)(a->ws + WS_VEC) + VO_MOD + (1 * 2 + 0) * 6144 + 5 * 1024;
    const bf16* Y = (const bf16*)(a->ws + WS_Y); const int* tokslot = (const int*)(a->ws + WS_TOK) + S_LAT * 8;
    const int gw = bid * NWAVES + wave, NGW = G * NWAVES;
    for (int t = gw; t < S_LAT; t += NGW) {
        const int* ts = tokslot + (size_t)t * 4; const int s1 = ts[0], s2 = ts[1]; const float w1 = __builtin_bit_cast(float, ts[2]), w2 = __builtin_bit_cast(float, ts[3]);
        GAS f32x4* xr = (GAS f32x4*)(a->out + (size_t)t * DM) + lane;
        const float* YF = (const float*)(a->ws + WS_YF);
#pragma unroll
        for (int j = 0; j < 4; ++j) { const f32x4 g = *(const f32x4*)(gf + 4 * lane + 256 * j); f32x4 x = xr[64 * j]; f32x4 p, q;
            if (s1 < 32768) { const v2u t = ((const GAS v2u*)(Y + (size_t)s1 * DM) + lane)[64 * j]; p = (f32x4){bflo(t.x), bfhi(t.x), bflo(t.y), bfhi(t.y)}; } else p = ((const GAS f32x4*)(YF + (size_t)(s1 - 32768) * DM) + lane)[64 * j];
            if (s2 < 32768) { const v2u t = ((const GAS v2u*)(Y + (size_t)s2 * DM) + lane)[64 * j]; q = (f32x4){bflo(t.x), bfhi(t.x), bflo(t.y), bfhi(t.y)}; } else q = ((const GAS f32x4*)(YF + (size_t)(s2 - 32768) * DM) + lane)[64 * j];
            x = x + g * (p * w1 + q * w2);
            xr[64 * j] = x; }
    }
}

#define IN(k) (lo <= (k) && (k) < hi)
#define GRIDBAR() do { XcdBarrier b2_; b2_.bar = (unsigned*)(KARGS()->ws + WS_CTL) + CW_BAR; b2_.x = xb_xcc_id(); b2_.st = (volatile LAS unsigned*)(lds + MISC_OFF) + 8; xcd_barrier(b2_); } while (0)
#define SEAM(k) do { if (IN(k) && IN((k) + 1)) GRIDBAR(); } while (0)
#define PHASE_ROOTS() KA a = KARGS(); unsigned char* ws = a->ws; const float* vec = (const float*)(ws + WS_VEC); (void)vec; int bid = blockIdx.x, G = gridDim.x; asm volatile("" : "+s"(bid), "+s"(G)); int tid = threadIdx.x; asm volatile("" : "+v"(tid)); const int lane = tid & 63, wave = __builtin_amdgcn_readfirstlane(tid >> 6); (void)lane; (void)wave

template <int l> __device__ __forceinline__ void layer_body(const int lo, const int hi, LAS unsigned char* lds) {
        const int pb = 1 + 11 * l;
        if (IN(pb + 0)) { PHASE_ROOTS(); phase_norm(a, l, 0, R_ALL, (bf16*)(ws + WS_H), lane, wave, G, bid); SEAM(pb + 0); }
        if (IN(pb + 1)) {
            PHASE_ROOTS();
            pg8::Gemm g{(const pg8::bf16_t*)(ws + WS_H), (const pg8::bf16_t*)(ws + WS_WIN) + (size_t)l * INW * DM, R_ALL, INW, DM, 0, DM};
            pg8::StaticOrder S; S.init(R_ALL, INW, G, bid);
            pg8::EpiBf16<0> E{(pg8::bf16_t*)(ws + WS_PROJ), INW, nullptr, 0, 0, 1.f};
            pg8::gemm_phase<pg8::EpiBf16<0>, pg8::StaticOrder, true, true>(lds, g, S, E);
            SEAM(pb + 1);
        }
        if (IN(pb + 2)) {
            PHASE_ROOTS();
            qk_prep(a, l, bid * NTHR + tid, G * NTHR);
            for (int it = bid * NWAVES + wave; it < 520; it += G * NWAVES) vt_item(a, it, lane);
            for (int it = bid; it < 1040; it += G) hgrn_stepA(a, l, it >> 2, it & 3, lds, lane, wave);
            const int nch = (l == 0) ? 130 : 128;
            for (int it = bid; it < nch * 4; it += G) gmlp_unit_mma(a, l, it >> 2, it & 3, lds, tid, lane, wave);
            SEAM(pb + 2);
        }
        if (IN(pb + 3)) {
            PHASE_ROOTS();
            if (bid < 64) hgrn_stepB(a, bid, tid);
            { const int nu = (l == 0) ? 260 : 256; for (int u = bid; u < nu; u += G) { attn_unit(a, l, u, lds, tid, lane, wave); __syncthreads(); } }
            SEAM(pb + 3);
        }
        if (IN(pb + 4)) {
            PHASE_ROOTS();
            const int nit = (l == 0) ? 1040 : 1024;
            for (int it = bid; it < nit; it += G) hgrn_stepC(a, l, it >> 2, it & 3, lds, tid, lane, wave);
            SEAM(pb + 4);
        }
        if (IN(pb + 5)) {
            PHASE_ROOTS();
            const float* modl = vec + VO_MOD + (l * 2 + 0) * 6144; const float* modc = vec + VO_MOD + (l * 2 + 1) * 6144;
            const int M = S_LAT;
            pg8::Gemm g{(const pg8::bf16_t*)(ws + WS_MIX), (const pg8::bf16_t*)(ws + WS_WOUT) + (size_t)l * DM * DM, M, DM, DM, 0, DM};
            pg8::StaticOrder S; S.init(M, DM, G, bid);
            pg8::EpiResid E{(l == 0) ? a->in[I_X] : a->out, a->out, modl + 2048, a->in[I_CTX], (float*)(ws + WS_CTXR), modc + 2048, S_LAT / 256, DM};
            pg8::gemm_phase<pg8::EpiResid, pg8::StaticOrder, true, true>(lds, g, S, E);
            if (l == 0) {
                pg8::Gemm g2{(const pg8::bf16_t*)(ws + WS_MIX), (const pg8::bf16_t*)(ws + WS_WOUT), R_ALL, DM, 256, 0, DM};
                pg8::SplitKOrder S2{S_LAT / 256, 4, 4, 256, 16, bid, nullptr};
                pg8::EpiAtomic E2{(float*)(ws + WS_CTXR), modc + 2048, S_LAT / 256, DM};
                pg8::gemm_phase<pg8::EpiAtomic, pg8::SplitKOrder, false, true>(lds, g2, S2, E2);
            }
            SEAM(pb + 5);
        }
        if (l == 0) {
            if (IN(pb + 6)) { PHASE_ROOTS(); phase_norm(a, l, 1, R_ALL, (bf16*)(ws + WS_H), lane, wave, G, bid); SEAM(pb + 6); }
            if (IN(pb + 7)) {
                PHASE_ROOTS();
                pg8::Gemm g{(const pg8::bf16_t*)(ws + WS_H), (const pg8::bf16_t*)(ws + WS_WGU), R_ALL, 2 * FFN, DM, 0, DM};
                pg8::StaticOrder S; S.init(R_ALL, 2 * FFN, G, bid);
                pg8::EpiSwiGLU E{(pg8::bf16_t*)(ws + WS_HID), FFN};
                pg8::gemm_phase<pg8::EpiSwiGLU, pg8::StaticOrder, true, true>(lds, g, S, E);
                SEAM(pb + 7);
            }
            if (IN(pb + 8)) {
                PHASE_ROOTS();
                const float* modl = vec + VO_MOD + (l * 2 + 0) * 6144; const float* modc = vec + VO_MOD + (l * 2 + 1) * 6144;
                pg8::Gemm g{(const pg8::bf16_t*)(ws + WS_HID), (const pg8::bf16_t*)(ws + WS_WD), S_LAT, DM, FFN, 0, FFN};
                pg8::StaticOrder S; S.init(S_LAT, DM, G, bid);
                pg8::EpiResid E{a->out, a->out, modl + 5120, (const float*)(ws + WS_CTXR), (float*)(ws + WS_CTXR), modc + 5120, S_LAT / 256, DM};
                pg8::gemm_phase<pg8::EpiResid, pg8::StaticOrder, true, true>(lds, g, S, E);
                {
                    pg8::Gemm g2{(const pg8::bf16_t*)(ws + WS_HID), (const pg8::bf16_t*)(ws + WS_WD), R_ALL, DM, 256, 0, FFN};
                    pg8::SplitKOrder S2{S_LAT / 256, 4, 11, 256, 44, bid, nullptr};
                    pg8::EpiAtomic E2{(float*)(ws + WS_CTXR), modc + 5120, S_LAT / 256, DM};
                    pg8::gemm_phase<pg8::EpiAtomic, pg8::SplitKOrder, false, true>(lds, g2, S2, E2);
                }
                if (IN(pb + 8) && IN(pb + 11)) GRIDBAR();
            }
        } else {
            if (IN(pb + 6)) { PHASE_ROOTS(); phase_norm_route(a, lds, tid, lane, wave, G, bid); SEAM(pb + 6); }
            if (IN(pb + 7)) { PHASE_ROOTS(); moe_gather(a, lds, tid, lane, wave, G, bid); SEAM(pb + 7); }
            if (IN(pb + 8)) {
                PHASE_ROOTS();
                const int* mi = (const int*)(ws + WS_VEC) + VO_MOE; const int nt = __builtin_amdgcn_readfirstlane(mi[0]);
                pg8::Gemm g{(const pg8::bf16_t*)(ws + WS_AS), (const pg8::bf16_t*)(ws + WS_MGU), nt * 256, 2 * EXD, DM, (size_t)2 * EXD * DM * 2, DM};
                pg8::MoeOrder S; S.init(nt * 256, 2 * EXD, G, bid); S.tile_e = mi + 16;
                pg8::EpiSwiGLU E{(pg8::bf16_t*)(ws + WS_HIDM), EXD};
                pg8::gemm_phase<pg8::EpiSwiGLU, pg8::MoeOrder, true, true>(lds, g, S, E);
                SEAM(pb + 8);
            }
            if (IN(pb + 9)) {
                PHASE_ROOTS();
                const int* mi = (const int*)(ws + WS_VEC) + VO_MOE; const int nt = __builtin_amdgcn_readfirstlane(mi[0]); const int nm = nt < 128 ? nt : 128;
                pg8::Gemm g{(const pg8::bf16_t*)(ws + WS_HIDM), (const pg8::bf16_t*)(ws + WS_MD), nm * 256, DM, EXD, (size_t)DM * EXD * 2, EXD};
                pg8::MoeOrder S; S.init(nm * 256, DM, G, bid); S.tile_e = mi + 16;
                pg8::EpiBf16<0> E{(pg8::bf16_t*)(ws + WS_Y), DM, nullptr, 0, 0, 1.f};
                pg8::gemm_phase<pg8::EpiBf16<0>, pg8::MoeOrder, true, true>(lds, g, S, E);
                if (nt > 128) {
                    pg8::Gemm g2{(const pg8::bf16_t*)(ws + WS_HIDM), (const pg8::bf16_t*)(ws + WS_MD), nt * 256, DM, 512, (size_t)DM * EXD * 2, EXD};
                    pg8::SplitKOrder S2{128, 4, 7, 512, (nt - 128) * 28, bid, mi + 16};
                    pg8::EpiAtomic E2{(float*)(ws + WS_YF), nullptr, 128, DM};
                    pg8::gemm_phase<pg8::EpiAtomic, pg8::SplitKOrder, false, true>(lds, g2, S2, E2);
                }
                SEAM(pb + 9);
            }
            if (IN(pb + 10)) { PHASE_ROOTS(); moe_combine(a, lane, wave, G, bid); }
        }
    }
__global__ void __launch_bounds__(NTHR, 2) fwd_kernel(Args a_unused) {
    extern __shared__ __attribute__((aligned(16))) unsigned char lds_raw[];
    LAS unsigned char* lds = (LAS unsigned char*)lds_raw;
    const int tid0 = threadIdx.x;
    for (int u = tid0; u < (LDS_BYTES - LDSCTL_OFF) / 4; u += NTHR) ((LAS unsigned*)(lds + LDSCTL_OFF))[u] = 0u;
    __syncthreads();
    const int lo = KARGS()->ph_lo, hi = KARGS()->ph_hi;
    const bool fusedl = (hi - lo) > 1;
    if (fusedl) (void)xcd_barrier_post((unsigned*)(KARGS()->ws + WS_CTL) + CW_BAR, (volatile LAS unsigned*)(lds + MISC_OFF) + 8);
    if (IN(0)) { PHASE_ROOTS(); p0_prologue(a, lds, tid, lane, wave, G, bid); SEAM(0); }

    layer_body<0>(lo, hi, lds);
    layer_body<1>(lo, hi, lds);
}

extern "C" void kernel_launch(void* const* d_in, const int* in_sizes, int n_in, void* d_out, int out_size, void* d_ws, size_t ws_size, hipStream_t stream) {
    static int grid = 0;
    if (grid == 0) {
        if (n_in != 23 || in_sizes[0] != S_LAT * DM || out_size != S_LAT * DM || ws_size < WS_END) { fprintf(stderr, "kernel_launch: unexpected shapes / workspace (n_in %d, ws %zu, need %zu)\n", n_in, ws_size, (size_t)WS_END); grid = -1; return; }
        int dev = 0, cus = 0;
        if (hipGetDevice(&dev) != hipSuccess || hipDeviceGetAttribute(&cus, hipDeviceAttributeMultiprocessorCount, dev) != hipSuccess) { grid = -1; return; }
        if (hipFuncSetAttribute((const void*)fwd_kernel, hipFuncAttributeMaxDynamicSharedMemorySize, LDS_BYTES) != hipSuccess) { grid = -1; return; }
        int per_cu = 0;
        (void)hipOccupancyMaxActiveBlocksPerMultiprocessor(&per_cu, (const void*)fwd_kernel, NTHR, LDS_BYTES);
        (void)hipGetLastError();
        grid = cus;
    }
    if (grid < 0) return;
    if (hipMemsetAsync((char*)d_ws + WS_CTL, 0, CTL_ZERO_BYTES, stream) != hipSuccess) return;
    Args a{};
    for (int i = 0; i < 23; ++i) a.in[i] = (const float*)d_in[i];
    a.out = (float*)d_out; a.ws = (unsigned char*)d_ws;
#if ONE_LAUNCH
    a.ph_lo = 0; a.ph_hi = NPH;
    hipLaunchKernelGGL(fwd_kernel, dim3(grid), dim3(NTHR), LDS_BYTES, stream, a);
#else
    for (int p = 0; p < NPH; ++p) {
        if (p == 10 || p == 11) continue;
        a.ph_lo = p; a.ph_hi = p + 1;
        hipLaunchKernelGGL(fwd_kernel, dim3(grid), dim3(NTHR), LDS_BYTES, stream, a);
    }
#endif
}
```

```cpp
#include <hip/hip_runtime.h>
#include <cstdio>
#include <cstdint>
#include <cmath>
#ifndef ONE_LAUNCH
#define ONE_LAUNCH 1
#endif
namespace pg8 {
#define PG8_LAS __attribute__((address_space(3)))
typedef unsigned short bf16_t;
typedef short bf16x8 __attribute__((ext_vector_type(8)));
typedef float f32x4 __attribute__((ext_vector_type(4)));
typedef unsigned u32x4 __attribute__((ext_vector_type(4)));
constexpr int BM = 256, BK = 64, HALF = 128, HTB = HALF * BK * 2  , STAGE_BYTES = 8 * HTB, NXCD = 8, WGM = 8;

__host__ __device__ __forceinline__ int lds_byte(int r, int c) { const int st = (r >> 4) * 2 + (c >> 5), rr = r & 15, cc = c & 31, ob = rr * 64 + cc * 2; return st * 1024 + (ob ^ (((ob >> 9) & 1) << 5)); }
__host__ __device__ __forceinline__ void stage_rc(int b, int& R, int& C) { const int st = b / 1024, sb = b % 1024, swz = sb ^ (((sb >> 9) & 1) << 5); R = (st >> 1) * 16 + swz / 64; C = (st & 1) * 32 + (swz % 64) / 2; }
__host__ __device__ __forceinline__ int perm32(int rho) { const int n = rho >> 4, i = rho & 15; return 8 * (i >> 2) + 4 * n + (i & 3); }

struct Unit { int pm, pn, eb, ko; };
struct Gemm { const bf16_t* A; const bf16_t* Bt; int M, N, K; size_t bstride; int ld; };

struct StaticOrder {
    int nM, nN, nwg, G, c;
    __host__ __device__ void init(int M, int N, int G_, int c_) { nM = M / BM; nN = N / BM; nwg = nM * nN; G = G_; c = c_; }
    __host__ __device__ bool next(int i, Unit& u) const {
        const long L = (long)i * G + c; if (L >= nwg) return false;
        int wgid = (int)L; { const int q = nwg / NXCD, r = nwg % NXCD, xcd = wgid % NXCD, off = wgid / NXCD; wgid = (xcd < r ? xcd * (q + 1) : r * (q + 1) + (xcd - r) * q) + off; }
        const int nig = WGM * nN, gid = wgid / nig, fm = gid * WGM, gsz = (nM - fm) < WGM ? (nM - fm) : WGM;
        u.pm = fm + ((wgid % nig) % gsz); u.pn = (wgid % nig) / gsz; u.eb = 0; u.ko = 0; return true;
    }
    __device__ __forceinline__ void a_ready(const Unit&) const {}
    __device__ __forceinline__ void done(const Unit&) const {}
};

__device__ __forceinline__ unsigned cvt_pk_bf16(float lo, float hi) { unsigned r; asm volatile("v_cvt_pk_bf16_f32 %0, %1, %2" : "=v"(r) : "v"(lo), "v"(hi)); return r; }
typedef float f32x2 __attribute__((ext_vector_type(2)));
__device__ __forceinline__ f32x2 gelu_pk(f32x2 v) {
    const f32x2 av = __builtin_elementwise_abs(v), d = av * 0.2316418882f + 1.0f;
    f32x2 t; t.x = __builtin_amdgcn_rcpf(d.x); t.y = __builtin_amdgcn_rcpf(d.y);
    f32x2 q = t * 0.5307027145f + (-0.7265760135f); q = q * t + 0.7107068705f; q = q * t + (-0.142248368f); q = q * t + 0.127414796f; q = q * t;
    const f32x2 s = (v * v) * (-0.72134752044f);
    f32x2 e; e.x = __builtin_amdgcn_exp2f(s.x); e.y = __builtin_amdgcn_exp2f(s.y);
    const f32x2 m = v * (q * e), r = v - m;
    f32x2 o; o.x = v.x < 0.f ? m.x : r.x; o.y = v.y < 0.f ? m.y : r.y; return o;
}

template <int ACT  > struct EpiBf16 {
    static constexpr bool PERM = true, AFTER_DRAIN = false; static_assert(ACT == 0 || ACT == 1, "EpiBf16: ACT is 0 (none) or 1 (gelu_pk)");
    bf16_t* O; int ldc; const float* bias; int split_cols; size_t split_stride; float scale0;
    __device__ __forceinline__ void operator()(const f32x4 (&acc)[2][2][4][2], const Unit& u, int wr, int wc, int fr, int fq) const {
        const int row0 = u.pm * BM + wr * 64 + fr; int colt = u.pn * BM; bf16_t* base = O;
        float sc = 1.f; if (split_cols) { const int t = colt / split_cols; base += (size_t)t * split_stride; colt -= t * split_cols; if (t == 0) sc = scale0; }
        const int col0 = colt + wc * 32 + 8 * fq, bcol0 = u.pn * BM + wc * 32 + 8 * fq;
        f32x4 bv[2][2];
#pragma unroll
        for (int bj = 0; bj < 2; ++bj)
#pragma unroll
            for (int n = 0; n < 2; ++n) bv[bj][n] = bias ? *(const f32x4*)(bias + bcol0 + bj * HALF + 4 * n) : (f32x4){0.f, 0.f, 0.f, 0.f};
#pragma unroll
        for (int ai = 0; ai < 2; ++ai)
#pragma unroll
            for (int m = 0; m < 4; ++m) { bf16_t* rowp = base + (size_t)(row0 + ai * HALF + m * 16) * ldc + col0;
#pragma unroll
                for (int bj = 0; bj < 2; ++bj) { f32x4 v0 = acc[ai][bj][m][0] + bv[bj][0], v1 = acc[ai][bj][m][1] + bv[bj][1];
                    if (ACT == 1) { f32x2 a = gelu_pk((f32x2){v0[0], v0[1]}), b = gelu_pk((f32x2){v0[2], v0[3]}), c = gelu_pk((f32x2){v1[0], v1[1]}), d = gelu_pk((f32x2){v1[2], v1[3]});
                        v0 = (f32x4){a.x, a.y, b.x, b.y}; v1 = (f32x4){c.x, c.y, d.x, d.y}; }
                    v0 = v0 * sc; v1 = v1 * sc; u32x4 w; w.x = cvt_pk_bf16(v0[0], v0[1]); w.y = cvt_pk_bf16(v0[2], v0[3]); w.z = cvt_pk_bf16(v1[0], v1[1]); w.w = cvt_pk_bf16(v1[2], v1[3]);
                    *(u32x4*)(rowp + bj * HALF) = w; } }
    }
};

__device__ __forceinline__ float silu_f(float x) { return x * __builtin_amdgcn_rcpf(1.0f + __builtin_amdgcn_exp2f(-1.4426950408889634f * x)); }
struct EpiResid {
    static constexpr bool PERM = false, AFTER_DRAIN = false;
    const float* base; float* out; const float* gate; const float* cbase; float* cout; const float* cgate; int mlat; int ldc;
    __device__ __forceinline__ void operator()(const f32x4 (&acc)[2][2][4][2], const Unit& u, int wr, int wc, int fr, int fq) const {
        const bool isc = u.pm >= mlat;
        const float* b = isc ? cbase : base; float* o = isc ? cout : out; const float* g = isc ? cgate : gate;
        const int row0 = (isc ? (u.pm - mlat) : u.pm) * BM + wr * 64 + fr, col0 = u.pn * BM + wc * 32 + 4 * fq;
        f32x4 gv[2][2];
#pragma unroll
        for (int bj = 0; bj < 2; ++bj)
#pragma unroll
            for (int n = 0; n < 2; ++n) gv[bj][n] = *(const f32x4*)(g + col0 + bj * HALF + n * 16);
#pragma unroll
        for (int ai = 0; ai < 2; ++ai)
#pragma unroll
            for (int m = 0; m < 4; ++m) { const size_t off = (size_t)(row0 + ai * HALF + m * 16) * ldc + col0;
#pragma unroll
                for (int bj = 0; bj < 2; ++bj)
#pragma unroll
                    for (int n = 0; n < 2; ++n) { const f32x4 bs = *(const f32x4*)(b + off + bj * HALF + n * 16); *(f32x4*)(o + off + bj * HALF + n * 16) = bs + gv[bj][n] * acc[ai][bj][m][n]; }
                if (m & 1) asm volatile("" ::: "memory"); }
    }
};
struct EpiSwiGLU {
    static constexpr bool PERM = true, AFTER_DRAIN = false;
    bf16_t* O; int ldc;
    __device__ __forceinline__ void operator()(const f32x4 (&acc)[2][2][4][2], const Unit& u, int wr, int wc, int fr, int fq) const {
        const int row0 = u.pm * BM + wr * 64 + fr, col0 = u.pn * HALF + wc * 32 + 8 * fq;
#pragma unroll
        for (int ai = 0; ai < 2; ++ai)
#pragma unroll
            for (int m = 0; m < 4; ++m) { bf16_t* rowp = O + (size_t)(row0 + ai * HALF + m * 16) * ldc + col0;
                const f32x4 g0 = acc[ai][0][m][0], g1 = acc[ai][0][m][1], u0 = acc[ai][1][m][0], u1 = acc[ai][1][m][1];
                f32x4 h0, h1;
#pragma unroll
                for (int j = 0; j < 4; ++j) { h0[j] = silu_f(g0[j]) * u0[j]; h1[j] = silu_f(g1[j]) * u1[j]; }
                u32x4 w; w.x = cvt_pk_bf16(h0[0], h0[1]); w.y = cvt_pk_bf16(h0[2], h0[3]); w.z = cvt_pk_bf16(h1[0], h1[1]); w.w = cvt_pk_bf16(h1[2], h1[3]);
                *(u32x4*)rowp = w; }
    }
};
struct MoeOrder : StaticOrder {
    const int* tile_e;
    __device__ __forceinline__ bool next(int i, Unit& u) const { if (!StaticOrder::next(i, u)) return false; u.eb = __builtin_amdgcn_readfirstlane(tile_e[u.pm]); return true; }
};

struct SplitKOrder {
    int pm0, nN, P, kp, total, c; const int* tile_e;
    __device__ __forceinline__ bool next(int i, Unit& u) const {
        if (i != 0 || c >= total) return false;
        const int p = c % P, t = c / P; u.pn = t % nN; u.pm = pm0 + t / nN; u.ko = p * kp; u.eb = tile_e ? __builtin_amdgcn_readfirstlane(tile_e[u.pm]) : 0; return true; }
    __device__ __forceinline__ void a_ready(const Unit&) const {}
    __device__ __forceinline__ void done(const Unit&) const {}
};
struct EpiAtomic {
    static constexpr bool PERM = false, AFTER_DRAIN = true;
    float* out; const float* scale; int pm_sub; int ldc;
    __device__ __forceinline__ void fused(f32x4 (&acc)[2][2][4][2], const Unit& u, int wr, int wc, int fr, int fq, PG8_LAS unsigned char* lds, int wid, int lane) const {
        PG8_LAS float* scr = (PG8_LAS float*)(lds + wid * 16384);
        const int rr = lane >> 5, cc = lane & 31;
#pragma unroll
        for (int ai = 0; ai < 2; ++ai)
#pragma unroll
            for (int bj = 0; bj < 2; ++bj) {
#pragma unroll
                for (int m = 0; m < 4; ++m)
#pragma unroll
                    for (int n = 0; n < 2; ++n) *(PG8_LAS f32x4*)(scr + (m * 16 + fr) * 36 + n * 16 + 4 * fq) = acc[ai][bj][m][n];
                asm volatile("s_waitcnt lgkmcnt(0)" ::: "memory");
                const int colg = u.pn * BM + bj * HALF + wc * 32 + cc; const float sc = scale ? scale[colg] : 1.0f;
                float* op = out + (size_t)((u.pm - pm_sub) * BM + ai * HALF + wr * 64 + rr) * ldc + colg;
#pragma unroll 8
                for (int i = 0; i < 32; ++i) { const float v = scr[(2 * i + rr) * 36 + cc]; __hip_atomic_fetch_add(op + (size_t)(2 * i) * ldc, v * sc, __ATOMIC_RELAXED, __HIP_MEMORY_SCOPE_AGENT); }
                asm volatile("s_waitcnt lgkmcnt(0)" ::: "memory");
            }
    }
};

template <class Epi, class Sched, bool ALIGN_EPI = false, bool SP2 = false>
__device__ __forceinline__ void gemm_phase(PG8_LAS unsigned char* lds, const Gemm g, const Sched& S, const Epi& E, int tid_in) {
    int tid_ = tid_in; asm volatile("" : "+v"(tid_));
    const int tid = tid_, wid = __builtin_amdgcn_readfirstlane(tid >> 6), lane = tid & 63, wr = wid >> 2, wc = wid & 3, fr = lane & 15, fq = lane >> 4;
    const int K = g.K, nt = K / BK, ld = g.ld;
    unsigned voffA[2], voffB[2];
#pragma unroll
    for (int i = 0; i < 2; ++i) { int R, C; stage_rc(tid * 16 + i * 8192, R, C); const int Rb = Epi::PERM ? ((R & ~31) + perm32(R & 31)) : R;
        voffA[i] = (unsigned)(R * ld + C) * 2u; voffB[i] = (unsigned)(Rb * ld + C) * 2u; }
    const size_t kstep = (size_t)(BK * 2);
    const size_t hstep = (size_t)HALF * ld * 2;
    const size_t tstep = 2 * hstep;
    const unsigned ldsw = (unsigned)wid * 1024u;
    const int aoff = lds_byte(wr * 64 + fr, fq * 8), boff = lds_byte(wc * 32 + fr, fq * 8);
#define PG8_SA(b, h) (((b) * 2 + (h)) * HTB)
#define PG8_SB(b, h) ((4 + (b) * 2 + (h)) * HTB)
#define PG8_STAGE(bufoff, gbase, voff) do { _Pragma("unroll") for (int _i = 0; _i < 2; ++_i) \
        __builtin_amdgcn_global_load_lds((const unsigned*)((const char*)(gbase) + (voff)[_i]), (PG8_LAS unsigned*)(lds + (bufoff) + ldsw + _i * 8192), 16, 0, 0); } while (0)
#define PG8_LDA(dst, b, h) do { _Pragma("unroll") for (int m = 0; m < 4; ++m) _Pragma("unroll") for (int k = 0; k < 2; ++k) dst[m][k] = *(const PG8_LAS bf16x8*)(lds + PG8_SA(b, h) + aoff + m * 2048 + k * 1024); } while (0)
#define PG8_LDB(dst, b, h) do { _Pragma("unroll") for (int n = 0; n < 2; ++n) _Pragma("unroll") for (int k = 0; k < 2; ++k) dst[n][k] = *(const PG8_LAS bf16x8*)(lds + PG8_SB(b, h) + boff + n * 2048 + k * 1024); } while (0)
#define PG8_MMA(ai, bj, At, Bt) do { __builtin_amdgcn_s_setprio(1); _Pragma("unroll") for (int m = 0; m < 4; ++m) _Pragma("unroll") for (int n = 0; n < 2; ++n) _Pragma("unroll") for (int k = 0; k < 2; ++k) \
        acc[ai][bj][m][n] = __builtin_amdgcn_mfma_f32_16x16x32_bf16(Bt[n][k], At[m][k], acc[ai][bj][m][n], 0, 0, 0); __builtin_amdgcn_s_setprio(0); } while (0)
#define PG8_WAIT_V(n) asm volatile("s_waitcnt vmcnt(" #n ")" ::: "memory")
#define PG8_WAIT_L(n) asm volatile("s_waitcnt lgkmcnt(" #n ")" ::: "memory")
#define PG8_BAR __builtin_amdgcn_s_barrier()
#define PG8_SCHED __builtin_amdgcn_sched_barrier(0)
    Unit cur, nxt; int ui = 0;
    if (!S.next(0, cur)) return;
    f32x4 acc[2][2][4][2];
#pragma unroll
    for (int a = 0; a < 2; ++a)
#pragma unroll
        for (int b = 0; b < 2; ++b)
#pragma unroll
            for (int m = 0; m < 4; ++m)
#pragma unroll
                for (int n = 0; n < 2; ++n) acc[a][b][m][n] = (f32x4){0.f, 0.f, 0.f, 0.f};
    bf16x8 At[4][2], B0[2][2], B1[2][2];
    const char* cA = (const char*)g.A + (size_t)cur.pm * tstep + (size_t)cur.ko * 2; const char* cB = (const char*)g.Bt + (size_t)cur.eb * g.bstride + (size_t)cur.pn * tstep + (size_t)cur.ko * 2;
    S.a_ready(cur);
    if constexpr (SP2) {
        PG8_STAGE(PG8_SB(0, 0), cB, voffB); PG8_STAGE(PG8_SB(0, 1), cB + hstep, voffB); PG8_STAGE(PG8_SA(0, 0), cA, voffA); PG8_STAGE(PG8_SA(0, 1), cA + hstep, voffA);
        if (wr == 1) PG8_BAR;
        PG8_WAIT_V(2); PG8_BAR;
        PG8_STAGE(PG8_SB(1, 0), cB + kstep, voffB); PG8_STAGE(PG8_SA(1, 0), cA + kstep, voffA); PG8_STAGE(PG8_SB(1, 1), cB + hstep + kstep, voffB);
        PG8_WAIT_V(6); PG8_BAR;
    } else {
        PG8_STAGE(PG8_SB(0, 0), cB, voffB); PG8_STAGE(PG8_SA(0, 0), cA, voffA); PG8_STAGE(PG8_SB(0, 1), cB + hstep, voffB); PG8_STAGE(PG8_SA(0, 1), cA + hstep, voffA);
        if (wr == 1) PG8_BAR;
        PG8_WAIT_V(4); PG8_BAR;
        PG8_STAGE(PG8_SB(1, 0), cB + kstep, voffB); PG8_STAGE(PG8_SA(1, 0), cA + kstep, voffA); PG8_STAGE(PG8_SB(1, 1), cB + hstep + kstep, voffB);
        PG8_WAIT_V(6); PG8_BAR;
    }
    for (;;) {
        const bool has_next = S.next(ui + 1, nxt);
        const char* nA = has_next ? (const char*)g.A + (size_t)nxt.pm * tstep + (size_t)nxt.ko * 2 : cA; const char* nB = has_next ? (const char*)g.Bt + (size_t)nxt.eb * g.bstride + (size_t)nxt.pn * tstep + (size_t)nxt.ko * 2 : cB;
        for (int t = 0; t < nt; t += 2) {
            const bool last = (t == nt - 2);
            const char* a1 = cA + (size_t)(t + 1) * kstep;
            const char* a2 = last ? nA : cA + (size_t)(t + 2) * kstep; const char* b2 = last ? nB : cB + (size_t)(t + 2) * kstep;
            const char* a3 = a2 + kstep; const char* b3 = b2 + kstep;
            if (last && has_next) S.a_ready(nxt);
            if constexpr (SP2) {
            PG8_LDB(B0, 0, 0); PG8_LDB(B1, 0, 1); PG8_SCHED; PG8_LDA(At, 0, 0); PG8_STAGE(PG8_SA(1, 1), a1 + hstep, voffA);
            PG8_WAIT_V(8); PG8_WAIT_L(0); PG8_BAR; PG8_MMA(0, 0, At, B0); PG8_MMA(0, 1, At, B1); PG8_BAR; PG8_SCHED;
            PG8_LDA(At, 0, 1); PG8_STAGE(PG8_SB(0, 0), b2, voffB); PG8_STAGE(PG8_SB(0, 1), b2 + hstep, voffB); PG8_STAGE(PG8_SA(0, 0), a2, voffA);
            PG8_WAIT_V(8); PG8_WAIT_L(0); PG8_BAR; PG8_MMA(1, 0, At, B0); PG8_MMA(1, 1, At, B1); PG8_BAR; PG8_SCHED;
            PG8_LDB(B0, 1, 0); PG8_LDB(B1, 1, 1); PG8_SCHED; PG8_LDA(At, 1, 0); PG8_STAGE(PG8_SA(0, 1), a2 + hstep, voffA);
            PG8_WAIT_V(8); PG8_WAIT_L(0); PG8_BAR; PG8_MMA(0, 0, At, B0); PG8_MMA(0, 1, At, B1); PG8_BAR; PG8_SCHED;
            PG8_LDA(At, 1, 1); PG8_STAGE(PG8_SB(1, 0), b3, voffB); PG8_STAGE(PG8_SB(1, 1), b3 + hstep, voffB); PG8_STAGE(PG8_SA(1, 0), a3, voffA);
            PG8_WAIT_V(8); PG8_WAIT_L(0); PG8_BAR; PG8_MMA(1, 0, At, B0); PG8_MMA(1, 1, At, B1); PG8_BAR; PG8_SCHED;
            } else {
            PG8_LDB(B0, 0, 0); PG8_SCHED; PG8_LDA(At, 0, 0); PG8_STAGE(PG8_SA(1, 1), a1 + hstep, voffA);
            PG8_WAIT_L(8); PG8_BAR; PG8_WAIT_L(0); PG8_MMA(0, 0, At, B0); PG8_BAR; PG8_SCHED;
            PG8_LDB(B1, 0, 1); PG8_STAGE(PG8_SB(0, 0), b2, voffB);
            PG8_BAR; PG8_WAIT_L(0); PG8_MMA(0, 1, At, B1); PG8_BAR;
            PG8_LDA(At, 0, 1); PG8_STAGE(PG8_SA(0, 0), a2, voffA);
            PG8_BAR; PG8_WAIT_L(0); PG8_MMA(1, 0, At, B0); PG8_BAR; PG8_SCHED;
            PG8_STAGE(PG8_SB(0, 1), b2 + hstep, voffB);
            PG8_WAIT_V(6); PG8_BAR; PG8_MMA(1, 1, At, B1); PG8_BAR;
            PG8_LDB(B0, 1, 0); PG8_SCHED; PG8_LDA(At, 1, 0); PG8_STAGE(PG8_SA(0, 1), a2 + hstep, voffA);
            PG8_WAIT_L(8); PG8_BAR; PG8_WAIT_L(0); PG8_MMA(0, 0, At, B0); PG8_BAR; PG8_SCHED;
            PG8_LDB(B1, 1, 1); PG8_STAGE(PG8_SB(1, 0), b3, voffB);
            PG8_BAR; PG8_WAIT_L(0); PG8_MMA(0, 1, At, B1); PG8_BAR;
            PG8_LDA(At, 1, 1); PG8_STAGE(PG8_SA(1, 0), a3, voffA);
            PG8_BAR; PG8_WAIT_L(0); PG8_MMA(1, 0, At, B0); PG8_BAR; PG8_SCHED;
            PG8_STAGE(PG8_SB(1, 1), b3 + hstep, voffB);
            PG8_WAIT_V(6); PG8_BAR; PG8_MMA(1, 1, At, B1); PG8_BAR;
            }
        }
        if constexpr (ALIGN_EPI) { if (wr == 0) PG8_BAR; }
        if constexpr (!Epi::AFTER_DRAIN) { E(acc, cur, wr, wc, fr, fq); S.done(cur); }
        if (!has_next) break;
#pragma unroll
        for (int a = 0; a < 2; ++a)
#pragma unroll
            for (int b = 0; b < 2; ++b)
#pragma unroll
                for (int m = 0; m < 4; ++m)
#pragma unroll
                    for (int n = 0; n < 2; ++n) acc[a][b][m][n] = (f32x4){0.f, 0.f, 0.f, 0.f};
        cur = nxt; cA = nA; cB = nB; ++ui;
        if constexpr (ALIGN_EPI) { if (wr == 1) PG8_BAR; }
    }
    PG8_WAIT_V(0);
    if constexpr (!ALIGN_EPI) { if (wr == 0) PG8_BAR; }
    PG8_BAR;
    if constexpr (Epi::AFTER_DRAIN) { E.fused(acc, cur, wr, wc, fr, fq, lds, wid, lane); S.done(cur); }
#undef PG8_SA
#undef PG8_SB
#undef PG8_STAGE
#undef PG8_LDA
#undef PG8_LDB
#undef PG8_MMA
#undef PG8_WAIT_V
#undef PG8_WAIT_L
#undef PG8_BAR
#undef PG8_SCHED
}
}


constexpr int S_LAT = 16384, C_CTX = 256, R_ALL = S_LAT + C_CTX, DM = 1024;
constexpr int INW = 2560, FFN = 2816, EXD = 3584, NEXP = 8;
constexpr int COL_AQ = 0, COL_AK = 512, COL_AV = 640, COL_HQ = 768, COL_HFF = 1024, COL_HFB = 1280, COL_HI = 1536, COL_HG = 1792, COL_GU = 2048, COL_GV = 2304;
constexpr int MIX_AT = 0, MIX_HG = 512, MIX_GM = 768;
constexpr int MOE_MAXROWS = 34816;
constexpr float EPS = 1e-6f;
constexpr int NWAVES = 8, NTHR = 512;
constexpr int NPH = 23;

constexpr size_t MiB = 1u << 20;
constexpr size_t WS_CTL = 0, CTL_ZERO_BYTES = 1 * MiB;
constexpr size_t WS_VEC = 1 * MiB;
constexpr size_t WS_TOK = 2 * MiB;
constexpr size_t WS_WIN = 3 * MiB;
constexpr size_t WS_WOUT = 13 * MiB;
constexpr size_t WS_WGU = 17 * MiB;
constexpr size_t WS_WD = 28 * MiB;
constexpr size_t WS_MGU = 34 * MiB;
constexpr size_t WS_MD = 146 * MiB;
constexpr size_t WS_H = 202 * MiB;
constexpr size_t WS_PROJ = 235 * MiB;
constexpr size_t WS_MIX = 317 * MiB;
constexpr size_t WS_HGO = 350 * MiB;
constexpr size_t WS_CTXR = 383 * MiB;
constexpr size_t WS_HLT = WS_HGO;
constexpr size_t WS_HSP = 384 * MiB;
constexpr size_t WS_HDG = 402 * MiB;
constexpr size_t WS_VT = 403 * MiB;
constexpr size_t WS_HID = WS_PROJ;
constexpr size_t WS_AS = 202 * MiB;
constexpr size_t WS_HIDM = 270 * MiB;
constexpr size_t WS_H2B = 440 * MiB;
constexpr size_t WS_YF = WS_WIN;
constexpr size_t WS_Y = WS_MGU;
constexpr size_t WS_END = 508 * MiB;
static_assert(WS_HID + (size_t)R_ALL * FFN * 2 <= WS_HGO && WS_AS + (size_t)MOE_MAXROWS * DM * 2 <= WS_HIDM && WS_HIDM + (size_t)MOE_MAXROWS * EXD * 2 <= WS_END, "ws map");
static_assert(WS_H2B >= WS_HIDM && WS_H2B + (size_t)S_LAT * DM * 2 <= WS_END && WS_H + (size_t)R_ALL * DM * 2 <= WS_PROJ && WS_PROJ + (size_t)R_ALL * INW * 2 <= WS_MIX && WS_MIX + (size_t)R_ALL * DM * 2 <= WS_HGO && WS_HGO + (size_t)2 * R_ALL * 256 * 4 <= WS_CTXR, "ws map 2");
constexpr int VO_MOD = 0;
constexpr int VO_ROPE = 32768;
constexpr int VO_MOE = 65536;
constexpr int CW_BAR = 4096;
constexpr int CW_QUEUE = 2048;
constexpr int CW_MOECNT = 1024;

constexpr int RING_BYTES = 131072;
constexpr int LDSCTL_OFF = 159744, MISC_OFF = LDSCTL_OFF + 320;
constexpr int LDS_BYTES = 163840;

#define GAS __attribute__((address_space(1)))
#define LAS __attribute__((address_space(3)))
typedef unsigned short bf16;
typedef unsigned v4u __attribute__((ext_vector_type(4)));
typedef unsigned v2u __attribute__((ext_vector_type(2)));
typedef float f32x4 __attribute__((ext_vector_type(4)));
typedef GAS unsigned gu32;
#define RLX_AGENT __ATOMIC_RELAXED, __HIP_MEMORY_SCOPE_AGENT
#define LDS_WAIT() asm volatile("s_waitcnt lgkmcnt(0)" ::: "memory")
__device__ __forceinline__ unsigned f2bf(float f) { unsigned u = __builtin_bit_cast(unsigned, f); return (u + 0x7fffu + ((u >> 16) & 1u)) >> 16; }
__device__ __forceinline__ unsigned pk2(float lo, float hi) { return f2bf(lo) | (f2bf(hi) << 16); }
__device__ __forceinline__ float bflo(unsigned w) { return __builtin_bit_cast(float, w << 16); }
__device__ __forceinline__ float bfhi(unsigned w) { return __builtin_bit_cast(float, w & 0xffff0000u); }
__device__ __forceinline__ float silu1(float x) { return x / (1.0f + __expf(-x)); }
__device__ __forceinline__ float sigm1(float x) { return 1.0f / (1.0f + __expf(-x)); }
__device__ __forceinline__ float gelu1(float x) { return 0.5f * x * (1.0f + erff(x * 0.70710678118654752f)); }
template <int X> __device__ __forceinline__ float sx(float v) { return __shfl_xor(v, X); }
__device__ __forceinline__ float sx32_add(float v) { return v + __shfl_xor(v, 32); }
__device__ __forceinline__ float sx32_max(float v) { return fmaxf(v, __shfl_xor(v, 32)); }
__device__ __forceinline__ float wave_sum(float v) { v += sx<1>(v); v += sx<2>(v); v += sx<4>(v); v += sx<8>(v); v += sx<16>(v); return sx32_add(v); }
__device__ __forceinline__ void unpack8(const v4u w, float* f) { f[0] = bflo(w.x); f[1] = bfhi(w.x); f[2] = bflo(w.y); f[3] = bfhi(w.y); f[4] = bflo(w.z); f[5] = bfhi(w.z); f[6] = bflo(w.w); f[7] = bfhi(w.w); }

#define XB_TMO      128
#define XB_XCNT(j)  (256  + 64 * (j))
#define XB_XSUB(j)  (1280 + 64 * (j))
#define XB_XGEN(j)  (2304 + 64 * (j))
#define XB_TOP      3328
#define XB_TOPGEN   3392
#define XCD_BAR_WORDS 3456
#define XB_SPIN_CAP (1u << 18)

__device__ __forceinline__ unsigned xb_ld(unsigned* p)              { return __hip_atomic_load(p, __ATOMIC_RELAXED, __HIP_MEMORY_SCOPE_AGENT); }
__device__ __forceinline__ unsigned xb_add(unsigned* p, unsigned v) { return __hip_atomic_fetch_add(p, v, __ATOMIC_RELAXED, __HIP_MEMORY_SCOPE_AGENT); }
__device__ __forceinline__ unsigned xb_xcc_id() { return (unsigned)__builtin_amdgcn_s_getreg((3 << 11) | 20) & 0xFu; }
#define XB_SPIN(cond, bar) do { unsigned _sp = 0; while (cond) { __builtin_amdgcn_s_sleep(1); \
    if ((++_sp & 255u) == 0u) { if (xb_ld(&(bar)[XB_TMO])) break; if (_sp > XB_SPIN_CAP) { atomicAdd(&(bar)[XB_TMO], 1u); break; } } } } while (0)

struct XcdBarrier {
    unsigned* bar; unsigned x;
    volatile LAS unsigned* st;
};

__device__ __forceinline__ XcdBarrier xcd_barrier_post(unsigned* bar, volatile LAS unsigned* st) {
    XcdBarrier b; b.bar = bar; b.x = xb_xcc_id(); b.st = st;
    if (threadIdx.x == 0) (void)xb_add(&bar[XB_XCNT(b.x)], 1u);
    return b;
}
__device__ __forceinline__ void xcd_barrier_complete(unsigned* bar, unsigned x, unsigned& nloc, unsigned& nx) {
    const unsigned G = gridDim.x * gridDim.y * gridDim.z;
    unsigned sum, cnt, mine, sp = 0u;
    for (;;) {
        sum = 0u; cnt = 0u; mine = 0u;
#pragma unroll
        for (unsigned j = 0; j < 16; ++j) { const unsigned c = xb_ld(&bar[XB_XCNT(j)]); sum += c; cnt += (c > 0u) ? 1u : 0u; mine = (j == x) ? c : mine; }
        if (sum == G) break;
        __builtin_amdgcn_s_sleep(1);
        if ((++sp & 255u) == 0u) { if (xb_ld(&bar[XB_TMO])) break; if (sp > XB_SPIN_CAP) { atomicAdd(&bar[XB_TMO], 1u); break; } }
    }
    nloc = mine > 0u ? mine : 1u; nx = cnt > 0u ? cnt : 1u;
}

__device__ __forceinline__ void xcd_barrier(const XcdBarrier& b, const int tid_in) {
    asm volatile("s_waitcnt vmcnt(0)" ::: "memory");
    __syncthreads();
    if (tid_in == 0) {
        unsigned* bar = b.bar;
        __builtin_amdgcn_s_waitcnt(0);
        unsigned nloc = b.st[0], nx = b.st[1];
        if (nloc == 0u) { xcd_barrier_complete(bar, b.x, nloc, nx); b.st[0] = nloc; b.st[1] = nx; }
        const unsigned old = xb_add(&bar[XB_XSUB(b.x)], 1u);
        const unsigned gen = old / nloc;
        if (old + 1u == (gen + 1u) * nloc) {
            __builtin_amdgcn_fence(__ATOMIC_RELEASE, "agent");
            asm volatile("s_waitcnt vmcnt(0)" ::: "memory");
            const unsigned og = xb_add(&bar[XB_TOP], 1u);
            const unsigned tg = og / nx;
            if (og + 1u == (tg + 1u) * nx) xb_add(&bar[XB_TOPGEN], 1u);
            else XB_SPIN(xb_ld(&bar[XB_TOPGEN]) == tg, bar);
            __builtin_amdgcn_fence(__ATOMIC_ACQUIRE, "agent");
            xb_add(&bar[XB_XGEN(b.x)], 1u);
            asm volatile("s_waitcnt vmcnt(0)" ::: "memory");
        } else {
            XB_SPIN(xb_ld(&bar[XB_XGEN(b.x)]) == gen, bar);
            __builtin_amdgcn_fence(__ATOMIC_ACQUIRE, "agent");
            asm volatile("s_waitcnt vmcnt(0)" ::: "memory");
        }
    }
    __syncthreads();
}


struct Args { const float* in[23]; float* out; unsigned char* ws; int ph_lo, ph_hi; };
typedef const __attribute__((address_space(4))) Args* KA;
#define KARGS() ({ KA p_ = (KA)__builtin_amdgcn_kernarg_segment_ptr(); asm volatile("" : "+s"(p_)); p_; })
enum { I_X = 0, I_C, I_CTX, I_CCTX, I_WADA, I_BADA, I_WIN, I_WOUT, I_QG, I_KG, I_SINK, I_HLB, I_HGAIN, I_GWS, I_GBS, I_GNG, I_FG, I_FU, I_FD, I_ROUTER, I_MG, I_MU, I_MDN };

__device__ __forceinline__ void transpose_item(const float* W, int K, int N, bf16* WT, int mode, LAS float* scr, int item, int lane) {
    const int nblk = N / 32, kb = item / nblk, nb = item % nblk, k0 = 64 * kb, n0 = 32 * nb;
#pragma unroll 8
    for (int i = 0; i < 32; ++i) { const int kk = 2 * i + (lane >> 5); scr[kk * 33 + (lane & 31)] = W[(size_t)(k0 + kk) * N + n0 + (lane & 31)]; }
    LDS_WAIT(); asm volatile("" ::: "memory");
    const int c = lane & 7;
#pragma unroll
    for (int j = 0; j < 4; ++j) { const int n = (lane >> 3) + 8 * j; const LAS float* s = scr + (8 * c) * 33 + n;
        v4u o; o.x = pk2(s[0 * 33], s[1 * 33]); o.y = pk2(s[2 * 33], s[3 * 33]); o.z = pk2(s[4 * 33], s[5 * 33]); o.w = pk2(s[6 * 33], s[7 * 33]);
        const int ng = n0 + n; const int drow = (mode == 0) ? ng : (ng + 128 * (ng / 128) + (mode == 2 ? 128 : 0));
        *(GAS v4u*)(WT + (size_t)drow * K + k0 + 8 * c) = o; }
    LDS_WAIT(); asm volatile("" ::: "memory");
}
__device__ __forceinline__ void p0_prologue(KA a, LAS unsigned char* lds, int tid, int lane, int wave, int G, int bid) {
    unsigned char* ws = a->ws;
    LAS float* scr = (LAS float*)(lds + wave * 8704);
    const int gw = bid * NWAVES + wave, NGW = G * NWAVES;
    constexpr int I_IN = 16 * 80, I_OUT = 16 * 32, I_F = 16 * 88, I_FDN = 44 * 32, I_M = 16 * 112;
    constexpr int NIT = 2 * I_IN + 2 * I_OUT + 2 * I_F + I_FDN + 24 * I_M;
    for (int it0 = gw; it0 < NIT; it0 += NGW) {
        int it = it0;
        if (it < 2 * I_IN) { const int l = it / I_IN, r = it % I_IN; transpose_item(a->in[I_WIN] + (size_t)l * DM * INW, DM, INW, (bf16*)(ws + WS_WIN) + (size_t)l * INW * DM, 0, scr, r, lane); continue; } it -= 2 * I_IN;
        if (it < 2 * I_OUT) { const int l = it / I_OUT, r = it % I_OUT; transpose_item(a->in[I_WOUT] + (size_t)l * DM * DM, DM, DM, (bf16*)(ws + WS_WOUT) + (size_t)l * DM * DM, 0, scr, r, lane); continue; } it -= 2 * I_OUT;
        if (it < I_F) { transpose_item(a->in[I_FG], DM, FFN, (bf16*)(ws + WS_WGU), 1, scr, it, lane); continue; } it -= I_F;
        if (it < I_F) { transpose_item(a->in[I_FU], DM, FFN, (bf16*)(ws + WS_WGU), 2, scr, it, lane); continue; } it -= I_F;
        if (it < I_FDN) { transpose_item(a->in[I_FD], FFN, DM, (bf16*)(ws + WS_WD), 0, scr, it, lane); continue; } it -= I_FDN;
        { const int idx = it / I_M, r = it % I_M;
          if (idx < 8) transpose_item(a->in[I_MG] + (size_t)idx * DM * EXD, DM, EXD, (bf16*)(ws + WS_MGU) + (size_t)idx * 2 * EXD * DM, 1, scr, r, lane);
          else if (idx < 16) transpose_item(a->in[I_MU] + (size_t)(idx - 8) * DM * EXD, DM, EXD, (bf16*)(ws + WS_MGU) + (size_t)(idx - 8) * 2 * EXD * DM, 2, scr, r, lane);
          else transpose_item(a->in[I_MDN] + (size_t)(idx - 16) * EXD * DM, EXD, DM, (bf16*)(ws + WS_MD) + (size_t)(idx - 16) * DM * EXD, 0, scr, r, lane); }
    }
    LAS float* sil = (LAS float*)(lds + 69632);
    LAS float* part = (LAS float*)(lds + 69632 + 8192);
    float* vec = (float*)(ws + WS_VEC);
    if (bid < 192) {
        for (int i = tid; i < 2048; i += NTHR) { const float v = (i < 1024) ? a->in[I_C][i] : a->in[I_CCTX][i - 1024]; sil[i] = silu1(v); }
        __syncthreads();
        for (int item = bid; item < 192; item += G) {
            const int l = item / 96, cb = item % 96, col = cb * 64 + lane;
            const float* w = a->in[I_WADA] + (size_t)l * DM * 6144 + col;
            float a0 = 0.f, a1 = 0.f;
#pragma unroll 8
            for (int k = wave * 128; k < wave * 128 + 128; ++k) { const float wv = w[(size_t)k * 6144]; a0 += sil[k] * wv; a1 += sil[1024 + k] * wv; }
            part[(wave * 2 + 0) * 64 + lane] = a0; part[(wave * 2 + 1) * 64 + lane] = a1;
            __syncthreads();
            if (wave == 0) { float s0 = 0.f, s1 = 0.f;
#pragma unroll
                for (int w8 = 0; w8 < 8; ++w8) { s0 += part[(w8 * 2 + 0) * 64 + lane]; s1 += part[(w8 * 2 + 1) * 64 + lane]; }
                const float b = a->in[I_BADA][l * 6144 + col];
                vec[VO_MOD + (l * 2 + 0) * 6144 + col] = s0 + b; vec[VO_MOD + (l * 2 + 1) * 6144 + col] = s1 + b; }
            __syncthreads();
        }
    }
    for (int i = bid * NTHR + tid; i < C_CTX * DM / 4; i += G * NTHR) ((GAS f32x4*)(ws + WS_CTXR))[i] = ((const GAS f32x4*)a->in[I_CTX])[i];
    if (bid == G - 1) {
        for (int idx = tid; idx < 5120; idx += NTHR) {
            const int isc = idx >= 4096, j = isc ? idx - 4096 : idx, pos = j / 16, i = j % 16;
            const float inv = exp2f(-(float)i * 0.83048202372184059f);
            const float ang = (float)pos * inv;
            double r = (double)ang * 0.15915494309189535; r -= floor(r);
            const float rf = (float)r;
            const float cs = __builtin_amdgcn_cosf(rf), sn = __builtin_amdgcn_sinf(rf);
            float* t = vec + VO_ROPE + (isc ? 8192 : 0);
            const int n = isc ? 1024 : 4096;
            t[j] = cs; t[n + j] = sn;
        }
    }
}

__device__ __forceinline__ void norm_row(const float* xrow, const float* sc, const float* sh, bf16* orow, int lane, f32x4 (&h)[4]) {
    const GAS f32x4* xr = (const GAS f32x4*)xrow + lane;
    f32x4 v[4]; float s = 0.f;
#pragma unroll
    for (int j = 0; j < 4; ++j) { v[j] = xr[64 * j]; s += (v[j].x * v[j].x + v[j].y * v[j].y) + (v[j].z * v[j].z + v[j].w * v[j].w); }
    const float rstd = __builtin_amdgcn_rsqf(wave_sum(s) * (1.0f / DM) + EPS);
    GAS v2u* o8 = (GAS v2u*)orow + lane;
#pragma unroll
    for (int j = 0; j < 4; ++j) { const f32x4 scv = *(const f32x4*)(sc + 4 * lane + 256 * j), shv = *(const f32x4*)(sh + 4 * lane + 256 * j);
        h[j] = v[j] * rstd * (scv + 1.0f) + shv;
        v2u w; w.x = pk2(h[j].x, h[j].y); w.y = pk2(h[j].z, h[j].w); o8[64 * j] = w; }
}
__device__ __forceinline__ void phase_norm(KA a, int l, int which, int nrows, bf16* H, int lane, int wave, int G, int bid) {
    const float* vec = (const float*)(a->ws + WS_VEC);
    const float* xl = (l == 0 && which == 0) ? a->in[I_X] : a->out;
    const float* xc = (l == 0 && which == 0) ? a->in[I_CTX] : (const float*)(a->ws + WS_CTXR);
    const float* ml = vec + VO_MOD + (l * 2 + 0) * 6144 + which * 3072;
    const float* mc = vec + VO_MOD + (l * 2 + 1) * 6144 + which * 3072;
    const int gw = bid * NWAVES + wave, NGW = G * NWAVES;
    for (int r = gw; r < nrows; r += NGW) {
        const bool isc = r >= S_LAT; f32x4 h[4];
        norm_row(isc ? xc + (size_t)(r - S_LAT) * DM : xl + (size_t)r * DM, (isc ? mc : ml) + 1024, isc ? mc : ml, H + (size_t)r * DM, lane, h);
    }
}
__device__ __forceinline__ void phase_norm_route(KA a, LAS unsigned char* lds, int tid, int lane, int wave, int G, int bid) {
    const int l = 1;
    const float* vec = (const float*)(a->ws + WS_VEC);
    const float* ml = vec + VO_MOD + (l * 2 + 0) * 6144 + 3072;
    bf16* H = (bf16*)(a->ws + WS_H2B);
    LAS float* rt = (LAS float*)lds;
    volatile LAS unsigned* lcnt = (volatile LAS unsigned*)(lds + 32768);
    for (int i = tid; i < 8192; i += NTHR) rt[i] = a->in[I_ROUTER][i];
    if (tid < 16) lcnt[tid] = 0u;
    __syncthreads();
    int* tokinfo = (int*)(a->ws + WS_TOK);
    unsigned* cnt = (unsigned*)(a->ws + WS_CTL) + CW_MOECNT;
    const int gw = bid * NWAVES + wave, NGW = G * NWAVES;
    unsigned keep = 0u, pk0 = 0u; int itn = 0;
    for (int r = gw; r < S_LAT; r += NGW) {
        f32x4 h[4];
        norm_row(a->out + (size_t)r * DM, ml + 1024, ml, H + (size_t)r * DM, lane, h);
        float lg[8];
#pragma unroll
        for (int e = 0; e < 8; ++e) lg[e] = 0.f;
#pragma unroll
        for (int j = 0; j < 4; ++j)
#pragma unroll
            for (int i = 0; i < 4; ++i) { const int d = 4 * lane + 256 * j + i; const f32x4 r0 = *(const LAS f32x4*)(rt + d * 8), r1 = *(const LAS f32x4*)(rt + d * 8 + 4); const float hv = h[j][i];
                lg[0] += hv * r0.x; lg[1] += hv * r0.y; lg[2] += hv * r0.z; lg[3] += hv * r0.w; lg[4] += hv * r1.x; lg[5] += hv * r1.y; lg[6] += hv * r1.z; lg[7] += hv * r1.w; }
#pragma unroll
        for (int e = 0; e < 8; ++e) lg[e] = wave_sum(lg[e]);
        int i1 = 0; float v1 = lg[0];
#pragma unroll
        for (int e = 1; e < 8; ++e) if (lg[e] > v1) { v1 = lg[e]; i1 = e; }
        int i2 = -1; float v2 = -INFINITY;
#pragma unroll
        for (int e = 0; e < 8; ++e) if (e != i1 && lg[e] > v2) { v2 = lg[e]; i2 = e; }
        const float w1 = 1.0f / (1.0f + __expf(v2 - v1)), w2 = 1.0f - w1;
        if (lane == 0) {
            const unsigned r1 = __hip_atomic_fetch_add((LAS unsigned*)lcnt + i1, 1u, __ATOMIC_RELAXED, __HIP_MEMORY_SCOPE_WORKGROUP), r2 = __hip_atomic_fetch_add((LAS unsigned*)lcnt + i2, 1u, __ATOMIC_RELAXED, __HIP_MEMORY_SCOPE_WORKGROUP);
            int* ti = tokinfo + (size_t)r * 8;
            ti[0] = i1; ti[1] = i2; ti[4] = __builtin_bit_cast(int, w1); ti[5] = __builtin_bit_cast(int, w2);
            pk0 = (unsigned)i1 | ((unsigned)i2 << 3) | (r1 << 6) | (r2 << 19);
        }
        const unsigned pku = (unsigned)__builtin_amdgcn_readfirstlane((int)pk0);
        if (lane == itn) keep = pku;
        ++itn;
    }
    __syncthreads();
    if (tid < 8) lcnt[8 + tid] = __hip_atomic_fetch_add(cnt + 64 * tid, lcnt[tid], RLX_AGENT);
    __syncthreads();
    { const int r = gw + lane * NGW; if (lane < itn && r < S_LAT) { int* ti = tokinfo + (size_t)r * 8; const unsigned e1 = keep & 7u, e2 = (keep >> 3) & 7u; ti[2] = (int)(((keep >> 6) & 0x1fffu) + lcnt[8 + e1]); ti[3] = (int)((keep >> 19) + lcnt[8 + e2]); } }
}

__device__ __forceinline__ void qk_prep(KA a, int l, int first_thread, int nthreads) {
    bf16* PROJ = (bf16*)(a->ws + WS_PROJ);
    const float* rope = (const float*)(a->ws + WS_VEC) + VO_ROPE;
    for (int i = first_thread; i < R_ALL * 10; i += nthreads) {
        const int row = i / 10, hh = i % 10; const bool isq = hh < 8;
        bf16* p = PROJ + (size_t)row * INW + (isq ? hh * 64 : COL_AK + (hh - 8) * 64);
        const float* gain = (isq ? a->in[I_QG] : a->in[I_KG]) + l * 64;
        float x[64]; float ss = 0.f;
#pragma unroll
        for (int c = 0; c < 8; ++c) { const v4u w = *(const GAS v4u*)(p + 8 * c); unpack8(w, x + 8 * c); }
#pragma unroll
        for (int d = 0; d < 64; ++d) ss += x[d] * x[d];
        const float rstd = __builtin_amdgcn_rsqf(ss * (1.0f / 64.0f) + EPS);
        const f32x4* g4 = (const f32x4*)gain;
#pragma unroll
        for (int c = 0; c < 16; ++c) { const f32x4 gv = g4[c]; x[4 * c] *= rstd * gv.x; x[4 * c + 1] *= rstd * gv.y; x[4 * c + 2] *= rstd * gv.z; x[4 * c + 3] *= rstd * gv.w; }
        if (row < S_LAT) {
            const int gr = row >> 6, gc = row & 63;
            const f32x4* cr = (const f32x4*)(rope + gr * 16); const f32x4* sr = (const f32x4*)(rope + 4096 + gr * 16); const f32x4* cc = (const f32x4*)(rope + 8192 + gc * 16); const f32x4* sc = (const f32x4*)(rope + 8192 + 1024 + gc * 16);
#pragma unroll
            for (int j4 = 0; j4 < 4; ++j4) { const f32x4 cv = cr[j4], sv = sr[j4];
#pragma unroll
                for (int i = 0; i < 4; ++i) { const int j = 4 * j4 + i; const float x1 = x[j], x2 = x[16 + j]; x[j] = x1 * cv[i] - x2 * sv[i]; x[16 + j] = x1 * sv[i] + x2 * cv[i]; } }
#pragma unroll
            for (int j4 = 0; j4 < 4; ++j4) { const f32x4 cv = cc[j4], sv = sc[j4];
#pragma unroll
                for (int i = 0; i < 4; ++i) { const int j = 4 * j4 + i; const float x1 = x[32 + j], x2 = x[48 + j]; x[32 + j] = x1 * cv[i] - x2 * sv[i]; x[48 + j] = x1 * sv[i] + x2 * cv[i]; } }
        }
        const float qs = isq ? 0.125f * 1.4426950408889634f : 1.0f;
#pragma unroll
        for (int c = 0; c < 8; ++c) { v4u w; w.x = pk2(x[8 * c] * qs, x[8 * c + 1] * qs); w.y = pk2(x[8 * c + 2] * qs, x[8 * c + 3] * qs); w.z = pk2(x[8 * c + 4] * qs, x[8 * c + 5] * qs); w.w = pk2(x[8 * c + 6] * qs, x[8 * c + 7] * qs);
            *(GAS v4u*)(p + 8 * c) = w; }
    }
}
__device__ __forceinline__ void gmlp_unit(KA a, int l, int chunk, int g, LAS unsigned char* lds, int tid, int lane, int wave) {
    const bf16* PROJ = (const bf16*)(a->ws + WS_PROJ); bf16* MIX = (bf16*)(a->ws + WS_MIX);
    const int row0 = (chunk < 128) ? chunk * 128 : S_LAT + (chunk - 128) * 128;
    LAS float* vn = (LAS float*)lds;
    { const int pos = tid >> 2, part = tid & 3;
      const bf16* p = PROJ + (size_t)(row0 + pos) * INW + COL_GV + g * 64 + part * 16;
      float x[16]; unpack8(*(const GAS v4u*)p, x); unpack8(*(const GAS v4u*)(p + 8), x + 8);
      float ss = 0.f;
#pragma unroll
      for (int d = 0; d < 16; ++d) { x[d] = gelu1(x[d]); ss += x[d] * x[d]; }
      ss += sx<1>(ss); ss += sx<2>(ss);
      const float rstd = __builtin_amdgcn_rsqf(ss * (1.0f / 64.0f) + EPS);
      const float* gn = a->in[I_GNG] + l * 256 + g * 64 + part * 16;
#pragma unroll
      for (int d = 0; d < 16; ++d) vn[pos * 64 + part * 16 + d] = x[d] * rstd * gn[d]; }
    __syncthreads();
    const int c = lane, t0 = wave * 16;
    const float* W = a->in[I_GWS] + ((size_t)(l * 4 + g) * 128 + t0) * 128;
    float acc[16];
#pragma unroll
    for (int i = 0; i < 16; ++i) acc[i] = 0.f;
    for (int s = 0; s < 128; ++s) { const float v = vn[s * 64 + c];
#pragma unroll
        for (int i = 0; i < 16; ++i) acc[i] += W[i * 128 + s] * v; }
    const float* bs = a->in[I_GBS] + (l * 4 + g) * 128 + t0;
#pragma unroll
    for (int i = 0; i < 16; ++i) { const int row = row0 + t0 + i;
        const float u = gelu1(bflo((unsigned)PROJ[(size_t)row * INW + COL_GU + g * 64 + c]));
        MIX[(size_t)row * DM + MIX_GM + g * 64 + c] = (bf16)f2bf(u * (acc[i] + bs[i])); }
    __syncthreads();
}
__device__ __forceinline__ void hgrn_naive(KA a, int l, int dir, int head, LAS unsigned char* lds, int tid, int lane, int wave) {
    const bf16* PROJ = (const bf16*)(a->ws + WS_PROJ);
    float* HGO = (float*)(a->ws + WS_HGO) + (size_t)dir * R_ALL * 256;
    LAS float* Qs = (LAS float*)lds;
    LAS float* Fs = Qs + 4096; LAS float* Vs = Fs + 4096; LAS float* part = Vs + 4096;
    const int v = lane, kg = wave;
    float S[8];
#pragma unroll
    for (int i = 0; i < 8; ++i) S[i] = 0.f;
    const int tl = tid >> 3, c8 = tid & 7;
    float lb[8];
#pragma unroll
    for (int j = 0; j < 8; ++j) { float b = 0.f; if (l == 1) { const float p0 = a->in[I_HLB][dir * 512 + head * 64 + c8 * 8 + j], p1 = a->in[I_HLB][dir * 512 + 256 + head * 64 + c8 * 8 + j]; b = 1.0f / (1.0f + __expf(p0 - p1)); } lb[j] = b; }
    const int fcol = (dir == 0 ? COL_HFF : COL_HFB) + head * 64 + c8 * 8;
    for (int n0 = 0; n0 < R_ALL; n0 += 64) {
        { const int n = n0 + tl; int row;
          if (dir == 0) row = (n < C_CTX) ? S_LAT + n : n - C_CTX; else row = (n < C_CTX) ? S_LAT + (C_CTX - 1 - n) : (S_LAT - 1) - (n - C_CTX);
          const bf16* pr = PROJ + (size_t)row * INW;
          float q[8], f[8], vv[8];
          unpack8(*(const GAS v4u*)(pr + COL_HQ + head * 64 + c8 * 8), q); unpack8(*(const GAS v4u*)(pr + fcol), f); unpack8(*(const GAS v4u*)(pr + COL_HI + head * 64 + c8 * 8), vv);
#pragma unroll
          for (int j = 0; j < 8; ++j) { Qs[tl * 64 + c8 * 8 + j] = silu1(q[j]) * 0.125f; Fs[tl * 64 + c8 * 8 + j] = lb[j] + (1.0f - lb[j]) * sigm1(f[j]); Vs[tl * 64 + c8 * 8 + j] = vv[j]; } }
        __syncthreads();
        for (int t = 0; t < 64; ++t) {
            const float vt = Vs[t * 64 + v]; float po = 0.f;
#pragma unroll
            for (int i = 0; i < 8; ++i) { const float f = Fs[t * 64 + kg * 8 + i], q = Qs[t * 64 + kg * 8 + i]; S[i] = f * S[i] + (1.0f - f) * vt; po += S[i] * q; }
            part[((t & 1) * 8 + kg) * 64 + v] = po;
            __syncthreads();
            if (wave == 0) { float o = 0.f;
#pragma unroll
                for (int w8 = 0; w8 < 8; ++w8) o += part[((t & 1) * 8 + w8) * 64 + v];
                const int n = n0 + t; int row;
                if (dir == 0) row = (n < C_CTX) ? S_LAT + n : n - C_CTX; else row = (n < C_CTX) ? S_LAT + (C_CTX - 1 - n) : (S_LAT - 1) - (n - C_CTX);
                HGO[(size_t)row * 256 + head * 64 + v] = o; }
        }
        __syncthreads();
    }
}

typedef short bf16x8v __attribute__((ext_vector_type(8)));
constexpr int HST = 72;
__device__ __forceinline__ f32x4 mma16(const LAS bf16* MA, const LAS bf16* MBt, int k0, f32x4 c, int lane) {
    const bf16x8v av = *(const LAS bf16x8v*)(MA + (lane & 15) * HST + k0 + 8 * (lane >> 4));
    const bf16x8v bv = *(const LAS bf16x8v*)(MBt + (lane & 15) * HST + k0 + 8 * (lane >> 4));
    return __builtin_amdgcn_mfma_f32_16x16x32_bf16(av, bv, c, 0, 0, 0);
}
__device__ __forceinline__ int hg_base_row(int cpos) { return cpos < 256 ? 64 * cpos : S_LAT + 64 * (cpos - 256); }
__device__ __forceinline__ int hg_scan_idx(int dir, int cpos) { return dir == 0 ? (cpos < 256 ? 4 + cpos : cpos - 256) : (cpos < 256 ? 4 + (255 - cpos) : 3 - (cpos - 256)); }
__device__ __forceinline__ float hg_lb(KA a, int l, int dir, int head, int k) {
    if (l == 0) return 0.f;
    const float p0 = a->in[I_HLB][dir * 512 + head * 64 + k], p1 = a->in[I_HLB][dir * 512 + 256 + head * 64 + k];
    return 1.0f / (1.0f + __expf(p0 - p1));
}
__device__ __forceinline__ void hgrn_stepA(KA a, int l, int cpos, int head, LAS unsigned char* lds, int lane, int wave) {
    const bf16* PROJ = (const bf16*)(a->ws + WS_PROJ);
    const int dir = wave >> 2, I = wave & 3, base = hg_base_row(cpos), ci = hg_scan_idx(dir, cpos);
    LAS float* TOT = (LAS float*)lds;
    LAS bf16* KLT = (LAS bf16*)(lds + 2048) + dir * 64 * HST;
    LAS bf16* VT = (LAS bf16*)(lds + 2048 + 2 * 64 * HST * 2) + dir * 64 * HST;
    const float lb = hg_lb(a, l, dir, head, lane);
    const int fcol = (dir == 0 ? COL_HFF : COL_HFB) + head * 64 + lane, vcol = COL_HI + head * 64 + lane;
    float kk[16], cl[16]; float run = 0.f;
#pragma unroll
    for (int i = 0; i < 16; ++i) { const int n = 16 * I + i, row = base + (dir ? 63 - n : n);
        const float fl = bflo((unsigned)PROJ[(size_t)row * INW + fcol]);
        const unsigned short vb = PROJ[(size_t)row * INW + vcol];
        const float f = lb + (1.0f - lb) * sigm1(fl);
        run += __logf(f); cl[i] = run; kk[i] = 1.0f - f;
        VT[lane * HST + n] = vb; }
    TOT[(dir * 4 + I) * 64 + lane] = run;
    __syncthreads();
    float post = 0.f, all = 0.f;
#pragma unroll
    for (int J = 0; J < 4; ++J) { const float t = TOT[(dir * 4 + J) * 64 + lane]; all += t; if (J > I) post += t; }
#pragma unroll
    for (int i = 0; i < 16; ++i) KLT[lane * HST + 16 * I + i] = (bf16)f2bf(kk[i] * __expf(run - cl[i] + post));
    if (I == 0) ((float*)(a->ws + WS_HDG))[((size_t)(dir * 4 + head) * 260 + ci) * 64 + lane] = __expf(all);
    __syncthreads();
    float* LT = (float*)(a->ws + WS_HLT) + ((size_t)(dir * 4 + head) * 260 + ci) * 4096;
    float z0 = 0.f; asm volatile("" : "+v"(z0));
#pragma unroll
    for (int kb = 0; kb < 4; ++kb) { f32x4 acc = {z0, z0, z0, z0};
        acc = mma16(VT + 16 * I * HST, KLT + 16 * kb * HST, 0, acc, lane); acc = mma16(VT + 16 * I * HST, KLT + 16 * kb * HST, 32, acc, lane);
#pragma unroll
        for (int r = 0; r < 4; ++r) LT[(16 * I + 4 * (lane >> 4) + r) * 64 + 16 * kb + (lane & 15)] = acc[r]; }
    __syncthreads();
}
__device__ __forceinline__ void hgrn_stepB(KA a, int item, int tid) {
    const int dh = item >> 3, vb = item & 7, v = vb * 8 + (tid >> 6), k = tid & 63;
    const float* LT = (const float*)(a->ws + WS_HLT) + (size_t)dh * 260 * 4096 + v * 64 + k;
    const float* DG = (const float*)(a->ws + WS_HDG) + (size_t)dh * 260 * 64 + k;
    bf16* SP = (bf16*)(a->ws + WS_HSP) + (size_t)dh * 260 * 4096 + v * 64 + k;
    float S = 0.f;
#pragma unroll 1
    for (int c0 = 0; c0 < 260; c0 += 26) {
        float lt[26], dg[26];
#pragma unroll
        for (int j = 0; j < 26; ++j) { lt[j] = LT[(size_t)(c0 + j) * 4096]; dg[j] = DG[(c0 + j) * 64]; }
#pragma unroll
        for (int j = 0; j < 26; ++j) { SP[(size_t)(c0 + j) * 4096] = (bf16)f2bf(S); S = dg[j] * S + lt[j]; }
    }
}
__device__ __forceinline__ void hgrn_stepC(KA a, int l, int cpos, int head, LAS unsigned char* lds, int tid, int lane, int wave) {
    const bf16* PROJ = (const bf16*)(a->ws + WS_PROJ); bf16* MIX = (bf16*)(a->ws + WS_MIX);
    const int dir = wave >> 2, I = wave & 3, base = hg_base_row(cpos), ci = hg_scan_idx(dir, cpos);
    constexpr int MSZ = 64 * HST;
    LAS float* TOT = (LAS float*)lds;
    LAS bf16* img = (LAS bf16*)(lds + 2048);
    LAS bf16* QT = img + dir * MSZ;
    LAS bf16* QD = img + 2 * MSZ + dir * MSZ;
    LAS bf16* VT = img + 4 * MSZ + dir * MSZ;
    LAS bf16* ST = img + 6 * MSZ + dir * MSZ;
    LAS bf16* AS = img + 8 * MSZ + dir * MSZ + I * 16 * HST;
    LAS bf16* KT = img + 10 * MSZ + dir * (10 * 16 * HST);
    LAS float* OS = (LAS float*)(img + 10 * MSZ);
    const float lb = hg_lb(a, l, dir, head, lane);
    const int fcol = (dir == 0 ? COL_HFF : COL_HFB) + head * 64 + lane, qcol = COL_HQ + head * 64 + lane, vcol = COL_HI + head * 64 + lane;
    { const bf16* SP = (const bf16*)(a->ws + WS_HSP) + ((size_t)(dir * 4 + head) * 260 + ci) * 4096;
#pragma unroll
      for (int h2 = 0; h2 < 2; ++h2) { const int e = ((I * 2 + h2) * 64 + lane) * 8, vv = e >> 6, kk0 = e & 63;
          *(LAS v4u*)(ST + vv * HST + kk0) = *(const GAS v4u*)(SP + e); } }
    float kk[16], cl[16], qv[16]; float run = 0.f;
#pragma unroll
    for (int i = 0; i < 16; ++i) { const int n = 16 * I + i, row = base + (dir ? 63 - n : n);
        const float fl = bflo((unsigned)PROJ[(size_t)row * INW + fcol]), ql = bflo((unsigned)PROJ[(size_t)row * INW + qcol]);
        const unsigned short vb = PROJ[(size_t)row * INW + vcol];
        const float f = lb + (1.0f - lb) * sigm1(fl);
        run += __logf(f); cl[i] = run; kk[i] = 1.0f - f; qv[i] = silu1(ql) * 0.125f;
        VT[lane * HST + n] = vb; }
    TOT[(dir * 4 + I) * 64 + lane] = run;
    __syncthreads();
    float tj[4];
#pragma unroll
    for (int J = 0; J < 4; ++J) tj[J] = TOT[(dir * 4 + J) * 64 + lane];
    float pre = 0.f;
#pragma unroll
    for (int J = 0; J < 4; ++J) if (J < I) pre += tj[J];
#pragma unroll
    for (int i = 0; i < 16; ++i) { const float e = __expf(cl[i]); QT[(16 * I + i) * HST + lane] = (bf16)f2bf(qv[i] * e); QD[(16 * I + i) * HST + lane] = (bf16)f2bf(qv[i] * e * __expf(pre)); }
    float eoff = 0.f;
#pragma unroll
    for (int I2 = 0; I2 < 4; ++I2) {
        if (I2 >= I) {
            if (I2 == I) eoff = 0.f; else if (I2 == I + 1) eoff = run; else eoff += tj[I2 - 1];
            LAS bf16* blk = KT + (I2 * (I2 + 1) / 2 + I) * 16 * HST;
#pragma unroll
            for (int i = 0; i < 16; ++i) blk[i * HST + lane] = (bf16)f2bf(kk[i] * __expf(fminf(eoff - cl[i], 80.0f)));
        }
    }
    __syncthreads();
    float z0 = 0.f; asm volatile("" : "+v"(z0));
    f32x4 sc[4];
#pragma unroll
    for (int J = 0; J < 4; ++J) { sc[J] = (f32x4){z0, z0, z0, z0};
        if (J <= I) { const LAS bf16* kb = KT + (I * (I + 1) / 2 + J) * 16 * HST;
            sc[J] = mma16(QT + 16 * I * HST, kb, 0, sc[J], lane); sc[J] = mma16(QT + 16 * I * HST, kb, 32, sc[J], lane);
            if (J == I) {
#pragma unroll
                for (int r = 0; r < 4; ++r) if ((lane & 15) > 4 * (lane >> 4) + r) sc[J][r] = z0; } } }
#pragma unroll
    for (int J = 0; J < 4; ++J)
#pragma unroll
        for (int r = 0; r < 4; ++r) AS[(4 * (lane >> 4) + r) * HST + 16 * J + (lane & 15)] = (bf16)f2bf(sc[J][r]);
    asm volatile("s_waitcnt lgkmcnt(0)" ::: "memory");
    f32x4 acc[4];
#pragma unroll
    for (int vb = 0; vb < 4; ++vb) { acc[vb] = (f32x4){z0, z0, z0, z0};
        acc[vb] = mma16(AS, VT + 16 * vb * HST, 0, acc[vb], lane); acc[vb] = mma16(AS, VT + 16 * vb * HST, 32, acc[vb], lane);
        acc[vb] = mma16(QD + 16 * I * HST, ST + 16 * vb * HST, 0, acc[vb], lane); acc[vb] = mma16(QD + 16 * I * HST, ST + 16 * vb * HST, 32, acc[vb], lane); }
    __syncthreads();
#pragma unroll
    for (int vb = 0; vb < 4; ++vb)
#pragma unroll
        for (int r = 0; r < 4; ++r) { const int n = 16 * I + 4 * (lane >> 4) + r, rl = dir ? 63 - n : n; OS[(dir * 64 + rl) * 68 + 16 * vb + (lane & 15)] = acc[vb][r]; }
    __syncthreads();
    { const int rl = tid >> 3, v8 = (tid & 7) * 8, row = base + rl;
      float o[8]; float ss = 0.f;
#pragma unroll
      for (int j = 0; j < 8; ++j) { o[j] = OS[rl * 68 + v8 + j] + OS[(64 + rl) * 68 + v8 + j]; ss += o[j] * o[j]; }
      ss += sx<1>(ss); ss += sx<2>(ss); ss += sx<4>(ss);
      const float rstd = __builtin_amdgcn_rsqf(ss * (1.0f / 64.0f) + EPS);
      float gt[8]; unpack8(*(const GAS v4u*)(PROJ + (size_t)row * INW + COL_HG + head * 64 + v8), gt);
      const float* gn = a->in[I_HGAIN] + l * 64 + v8;
      float y[8];
#pragma unroll
      for (int j = 0; j < 8; ++j) y[j] = o[j] * rstd * gn[j] * silu1(gt[j]);
      v4u w; w.x = pk2(y[0], y[1]); w.y = pk2(y[2], y[3]); w.z = pk2(y[4], y[5]); w.w = pk2(y[6], y[7]);
      *(GAS v4u*)(MIX + (size_t)row * DM + MIX_HG + head * 64 + v8) = w; }
    __syncthreads();
}

__device__ __forceinline__ void vt_item(KA a, int item, int lane) {
    const bf16* PROJ = (const bf16*)(a->ws + WS_PROJ); bf16* VTg = (bf16*)(a->ws + WS_VT);
    const int rb = item >> 1, hk = item & 1, row = rb * 64 + lane;
    const bf16* p = PROJ + (size_t)row * INW + COL_AV + hk * 64;
    unsigned w[32];
#pragma unroll
    for (int c = 0; c < 8; ++c) { const v4u t = *(const GAS v4u*)(p + 8 * c); w[4 * c] = t.x; w[4 * c + 1] = t.y; w[4 * c + 2] = t.z; w[4 * c + 3] = t.w; }
    bf16* o = VTg + (size_t)hk * 64 * R_ALL + row;
#pragma unroll
    for (int d2 = 0; d2 < 32; ++d2) { o[(size_t)(2 * d2) * R_ALL] = (bf16)(w[d2] & 0xffffu); o[(size_t)(2 * d2 + 1) * R_ALL] = (bf16)(w[d2] >> 16); }
}
__device__ __forceinline__ void attn_unit(KA a, int l, int u, LAS unsigned char* lds, int tid, int lane, int wave) {
    asm volatile("" : "+v"(tid), "+v"(lane));
    const bf16* PROJ = (const bf16*)(a->ws + WS_PROJ); const bf16* VTg = (const bf16*)(a->ws + WS_VT); bf16* MIX = (bf16*)(a->ws + WS_MIX);
    const bool isctx = u >= 256; const int uu = isctx ? u - 256 : u; const int n = uu >> 1, hk = uu & 1;
    const int qh = hk * 4 + (wave >> 1), half = wave & 1;
    const int qbase = (isctx ? S_LAT : 0) + n * 128 + half * 64, qpos0 = n * 128 + half * 64;
    const int c = lane & 15, g = lane >> 4;
    LAS bf16* Kt = (LAS bf16*)lds; LAS bf16* Vt = Kt + 64 * HST; LAS bf16* Qw = Vt + 64 * HST + wave * 64 * HST;
#pragma unroll
    for (int j = 0; j < 8; ++j) { const int qr = 8 * j + (lane >> 3), qc = (lane & 7) * 8;
        *(LAS v4u*)(Qw + qr * HST + qc) = *(const GAS v4u*)(PROJ + (size_t)(qbase + qr) * INW + qh * 64 + qc); }
    float z0 = 0.f; asm volatile("" : "+v"(z0));
    f32x4 o[4][4]; float ls[4];
    float gq = 0.f, gk = 0.f;
#pragma unroll 8
    for (int d = 0; d < 64; ++d) { gq = fmaxf(gq, fabsf(a->in[I_QG][l * 64 + d])); gk = fmaxf(gk, fabsf(a->in[I_KG][l * 64 + d])); }
    const float nbnd = -(8.0f * 1.4426950408889634f) * gq * gk;
    const float sink = a->in[I_SINK][l * 8 + qh] * 1.4426950408889634f;
#pragma unroll
    for (int qt = 0; qt < 4; ++qt) { ls[qt] = (g == 0) ? __builtin_amdgcn_exp2f(sink + nbnd) : z0;
#pragma unroll
        for (int dt = 0; dt < 4; ++dt) o[qt][dt] = (f32x4){z0, z0, z0, z0}; }
    const int first = (!isctx && n == 0) ? 2 : 0, nwin = isctx ? 0 : ((n == 0 || n == 127) ? 4 : 6), nt = nwin + 4;
    const int lr = tid >> 3, lc = (tid & 7) * 8;
    v4u kreg, vreg;
#define ATT_LOADT(i) do { const bool ct_ = (i) >= nwin; const int kb_ = ct_ ? S_LAT + 64 * ((i) - nwin) : (n - 1) * 128 + 64 * (first + (i)); \
        kreg = *(const GAS v4u*)(PROJ + (size_t)(kb_ + lr) * INW + COL_AK + hk * 64 + lc); vreg = *(const GAS v4u*)(VTg + ((size_t)hk * 64 + lr) * R_ALL + kb_ + lc); } while (0)
    ATT_LOADT(0);
#pragma unroll 1
    for (int i = 0; i < nt; ++i) {
        __syncthreads();
        *(LAS v4u*)(Kt + lr * HST + lc) = kreg; *(LAS v4u*)(Vt + lr * HST + lc) = vreg;
        __syncthreads();
        if (i + 1 < nt) ATT_LOADT(i + 1);
        const bool win = i < nwin; const int kb = (n - 1) * 128 + 64 * (first + i);
        bf16x8v kf[4][2], vf[4][2];
#pragma unroll
        for (int kt = 0; kt < 4; ++kt)
#pragma unroll
            for (int ks = 0; ks < 2; ++ks) kf[kt][ks] = *(const LAS bf16x8v*)(Kt + (16 * kt + c) * HST + 32 * ks + 8 * g);
#pragma unroll
        for (int dt = 0; dt < 4; ++dt)
#pragma unroll
            for (int s2 = 0; s2 < 2; ++s2) { const v2u lo = *(const LAS v2u*)(Vt + (16 * dt + c) * HST + 32 * s2 + 4 * g), hi = *(const LAS v2u*)(Vt + (16 * dt + c) * HST + 32 * s2 + 16 + 4 * g);
                const v4u t = {lo.x, lo.y, hi.x, hi.y}; vf[dt][s2] = __builtin_bit_cast(bf16x8v, t); }
#pragma unroll
        for (int qt = 0; qt < 4; ++qt) {
            f32x4 s[4];
            const bf16x8v q0 = *(const LAS bf16x8v*)(Qw + (16 * qt + c) * HST + 8 * g), q1 = *(const LAS bf16x8v*)(Qw + (16 * qt + c) * HST + 32 + 8 * g);
#pragma unroll
            for (int kt = 0; kt < 4; ++kt) { s[kt] = (f32x4){nbnd, nbnd, nbnd, nbnd};
                s[kt] = __builtin_amdgcn_mfma_f32_16x16x32_bf16(kf[kt][0], q0, s[kt], 0, 0, 0); s[kt] = __builtin_amdgcn_mfma_f32_16x16x32_bf16(kf[kt][1], q1, s[kt], 0, 0, 0); }
            if (win) { const int dq = qpos0 + 16 * qt + c - kb - 4 * g;
#pragma unroll
                for (int kt = 0; kt < 4; ++kt)
#pragma unroll
                    for (int r = 0; r < 4; ++r) { const int dl = dq - 16 * kt - r; if (dl > 128 || dl < -128) s[kt][r] = -INFINITY; } }
            float ps = 0.f;
#pragma unroll
            for (int kt = 0; kt < 4; ++kt)
#pragma unroll
                for (int r = 0; r < 4; ++r) { s[kt][r] = __builtin_amdgcn_exp2f(s[kt][r]); ps += s[kt][r]; }
            ls[qt] += ps;
            bf16x8v pb[2];
#pragma unroll
            for (int s2 = 0; s2 < 2; ++s2) { const v4u t = {pk2(s[2 * s2][0], s[2 * s2][1]), pk2(s[2 * s2][2], s[2 * s2][3]), pk2(s[2 * s2 + 1][0], s[2 * s2 + 1][1]), pk2(s[2 * s2 + 1][2], s[2 * s2 + 1][3])};
                pb[s2] = __builtin_bit_cast(bf16x8v, t); }
#pragma unroll
            for (int dt = 0; dt < 4; ++dt) { o[qt][dt] = __builtin_amdgcn_mfma_f32_16x16x32_bf16(vf[dt][0], pb[0], o[qt][dt], 0, 0, 0); o[qt][dt] = __builtin_amdgcn_mfma_f32_16x16x32_bf16(vf[dt][1], pb[1], o[qt][dt], 0, 0, 0); }
        }
    }
#undef ATT_LOADT
    int c2 = lane & 15, g2 = lane >> 4; asm volatile("" : "+v"(c2), "+v"(g2));
#pragma unroll
    for (int qt = 0; qt < 4; ++qt) { float lt = ls[qt]; lt += sx<16>(lt); lt = sx32_add(lt); const float inv = 1.0f / lt;
        bf16* op = (bf16*)(a->ws + WS_MIX) + (size_t)(qbase + 16 * qt + c2) * DM + MIX_AT + qh * 64 + 4 * g2;
#pragma unroll
        for (int dt = 0; dt < 4; ++dt) { v2u w; w.x = pk2(o[qt][dt][0] * inv, o[qt][dt][1] * inv); w.y = pk2(o[qt][dt][2] * inv, o[qt][dt][3] * inv); *(GAS v2u*)(op + 16 * dt) = w; } }
}

constexpr int GST = 136;
__device__ __forceinline__ f32x4 mma16g(const LAS bf16* MA, const LAS bf16* MBt, int k0, f32x4 c, int lane) {
    const bf16x8v av = *(const LAS bf16x8v*)(MA + (lane & 15) * GST + k0 + 8 * (lane >> 4));
    const bf16x8v bv = *(const LAS bf16x8v*)(MBt + (lane & 15) * GST + k0 + 8 * (lane >> 4));
    return __builtin_amdgcn_mfma_f32_16x16x32_bf16(av, bv, c, 0, 0, 0);
}
__device__ __forceinline__ float gelu_as(float v) {
    const float av = fabsf(v), t = __builtin_amdgcn_rcpf(av * 0.2316418882f + 1.0f);
    float q = t * 0.5307027145f + (-0.7265760135f); q = q * t + 0.7107068705f; q = q * t + (-0.142248368f); q = q * t + 0.127414796f; q = q * t;
    const float e = __builtin_amdgcn_exp2f((v * v) * (-0.72134752044f)), mm = v * (q * e);
    return v < 0.f ? mm : v - mm;
}
__device__ __forceinline__ void gmlp_unit_mma(KA a, int l, int chunk, int g, LAS unsigned char* lds, int tid, int lane, int wave) {
    const bf16* PROJ = (const bf16*)(a->ws + WS_PROJ); bf16* MIX = (bf16*)(a->ws + WS_MIX);
    const int row0 = (chunk < 128) ? chunk * 128 : S_LAT + (chunk - 128) * 128;
    LAS bf16* WA = (LAS bf16*)lds;
    LAS bf16* VNT = WA + 128 * GST;
    LAS float* OUT = (LAS float*)(VNT + 64 * GST);
    const int pos = tid >> 2, part = tid & 3;
    {
      const float* W = a->in[I_GWS] + ((size_t)(l * 4 + g) * 128 + pos) * 128 + part * 32;
#pragma unroll
      for (int j = 0; j < 4; ++j) { const f32x4 w0 = *(const GAS f32x4*)(W + 8 * j), w1 = *(const GAS f32x4*)(W + 8 * j + 4);
          v4u o; o.x = pk2(w0.x, w0.y); o.y = pk2(w0.z, w0.w); o.z = pk2(w1.x, w1.y); o.w = pk2(w1.z, w1.w);
          *(LAS v4u*)(WA + pos * GST + part * 32 + 8 * j) = o; } }
    { const bf16* p = PROJ + (size_t)(row0 + pos) * INW + COL_GV + g * 64 + part * 16;
      float x[16]; unpack8(*(const GAS v4u*)p, x); unpack8(*(const GAS v4u*)(p + 8), x + 8);
      float ss = 0.f;
#pragma unroll
      for (int d = 0; d < 16; ++d) { x[d] = gelu_as(x[d]); ss += x[d] * x[d]; }
      ss += sx<1>(ss); ss += sx<2>(ss);
      const float rstd = __builtin_amdgcn_rsqf(ss * (1.0f / 64.0f) + EPS);
      const float* gn = a->in[I_GNG] + l * 256 + g * 64 + part * 16;
#pragma unroll
      for (int d = 0; d < 16; ++d) VNT[(part * 16 + d) * GST + pos] = (bf16)f2bf(x[d] * rstd * gn[d]); }
    __syncthreads();
    float z0 = 0.f; asm volatile("" : "+v"(z0));
#pragma unroll
    for (int cb = 0; cb < 4; ++cb) { f32x4 acc = {z0, z0, z0, z0};
#pragma unroll
        for (int ks = 0; ks < 4; ++ks) acc = mma16g(WA + 16 * wave * GST, VNT + 16 * cb * GST, 32 * ks, acc, lane);
#pragma unroll
        for (int r = 0; r < 4; ++r) OUT[(16 * wave + 4 * (lane >> 4) + r) * 68 + 16 * cb + (lane & 15)] = acc[r]; }
    __syncthreads();
    { const int row = row0 + pos; const float bsv = a->in[I_GBS][(l * 4 + g) * 128 + pos];
      const bf16* pu = PROJ + (size_t)row * INW + COL_GU + g * 64 + part * 16;
      float u[16]; unpack8(*(const GAS v4u*)pu, u); unpack8(*(const GAS v4u*)(pu + 8), u + 8);
      float y[16];
#pragma unroll
      for (int d = 0; d < 16; ++d) y[d] = gelu_as(u[d]) * (OUT[pos * 68 + part * 16 + d] + bsv);
      bf16* po = MIX + (size_t)row * DM + MIX_GM + g * 64 + part * 16;
      v4u w; w.x = pk2(y[0], y[1]); w.y = pk2(y[2], y[3]); w.z = pk2(y[4], y[5]); w.w = pk2(y[6], y[7]); *(GAS v4u*)po = w;
      w.x = pk2(y[8], y[9]); w.y = pk2(y[10], y[11]); w.z = pk2(y[12], y[13]); w.w = pk2(y[14], y[15]); *(GAS v4u*)(po + 8) = w; }
    __syncthreads();
}
__device__ __forceinline__ void attn_naive(KA a, int l, int nrows, int lane, int wave, int G, int bid) {
    const bf16* PROJ = (const bf16*)(a->ws + WS_PROJ); bf16* MIX = (bf16*)(a->ws + WS_MIX);
    const int gw = bid * NWAVES + wave, NGW = G * NWAVES;
    for (int pair = gw; pair < nrows * 2; pair += NGW) {
        const int row = pair >> 1, hk = pair & 1; const bool isctx = row >= S_LAT;
        float q[4], o[4], m[4], ls[4];
#pragma unroll
        for (int g = 0; g < 4; ++g) { q[g] = bflo((unsigned)PROJ[(size_t)row * INW + (hk * 4 + g) * 64 + lane]); o[g] = 0.f; ls[g] = 1.0f; m[g] = a->in[I_SINK][l * 8 + hk * 4 + g] * 1.4426950408889634f; }
        int j0 = 0, j1 = -1;
        if (!isctx) { j0 = row - 128 < 0 ? 0 : row - 128; j1 = row + 128 > S_LAT - 1 ? S_LAT - 1 : row + 128; }
        const int nwin = j1 - j0 + 1;
        const int nk = nwin + C_CTX;
#pragma unroll 4
        for (int t = 0; t < nk; ++t) {
            const int krow = (t < nwin) ? j0 + t : S_LAT + (t - nwin);
            const float k = bflo((unsigned)PROJ[(size_t)krow * INW + COL_AK + hk * 64 + lane]);
            const float v = bflo((unsigned)PROJ[(size_t)krow * INW + COL_AV + hk * 64 + lane]);
#pragma unroll
            for (int g = 0; g < 4; ++g) { const float s = wave_sum(q[g] * k); const float mn = fmaxf(m[g], s);
                const float c = __builtin_amdgcn_exp2f(m[g] - mn), p = __builtin_amdgcn_exp2f(s - mn);
                ls[g] = ls[g] * c + p; o[g] = o[g] * c + p * v; m[g] = mn; }
        }
#pragma unroll
        for (int g = 0; g < 4; ++g) MIX[(size_t)row * DM + MIX_AT + (hk * 4 + g) * 64 + lane] = (bf16)f2bf(o[g] / ls[g]);
    }
}
__device__ __forceinline__ void hgrn_combine(KA a, int l, int nrows, int lane, int wave, int G, int bid) {
    const bf16* PROJ = (const bf16*)(a->ws + WS_PROJ); bf16* MIX = (bf16*)(a->ws + WS_MIX);
    const float* O0 = (const float*)(a->ws + WS_HGO); const float* O1 = O0 + (size_t)R_ALL * 256;
    const f32x4 gn = *(const f32x4*)(a->in[I_HGAIN] + l * 64 + (lane & 15) * 4);
    const int gw = bid * NWAVES + wave, NGW = G * NWAVES;
    for (int r = gw; r < nrows; r += NGW) {
        const f32x4 o = *(const GAS f32x4*)(O0 + (size_t)r * 256 + 4 * lane) + *(const GAS f32x4*)(O1 + (size_t)r * 256 + 4 * lane);
        float ss = (o.x * o.x + o.y * o.y) + (o.z * o.z + o.w * o.w);
        ss += sx<1>(ss); ss += sx<2>(ss); ss += sx<4>(ss); ss += sx<8>(ss);
        const float rstd = __builtin_amdgcn_rsqf(ss * (1.0f / 64.0f) + EPS);
        const v2u gw2 = *(const GAS v2u*)(PROJ + (size_t)r * INW + COL_HG + 4 * lane);
        const float g0 = bflo(gw2.x), g1 = bfhi(gw2.x), g2 = bflo(gw2.y), g3 = bfhi(gw2.y);
        v2u w; w.x = pk2(o.x * rstd * gn.x * silu1(g0), o.y * rstd * gn.y * silu1(g1)); w.y = pk2(o.z * rstd * gn.z * silu1(g2), o.w * rstd * gn.w * silu1(g3));
        *(GAS v2u*)(MIX + (size_t)r * DM + MIX_HG + 4 * lane) = w;
    }
}
__device__ __forceinline__ void moe_gather(KA a, LAS unsigned char* lds, int tid, int lane, int wave, int G, int bid) {
    LAS int* sb = (LAS int*)lds;
    const unsigned* cnt = (const unsigned*)(a->ws + WS_CTL) + CW_MOECNT;
    int* mi = (int*)(a->ws + WS_VEC) + VO_MOE;
    if (tid == 0) { int b = 0;
        for (int e = 0; e < 8; ++e) { const int c = (int)__hip_atomic_load(cnt + 64 * e, RLX_AGENT); sb[e] = b; sb[16 + e] = c;
            const int nt = (c + 255) >> 8;
            if (bid == 0) for (int t = 0; t < nt; ++t) mi[16 + (b >> 8) + t] = e;
            b += nt << 8; }
        sb[8] = b; if (bid == 0) mi[0] = b >> 8; }
    __syncthreads();
    const bf16* H = (const bf16*)(a->ws + WS_H2B); bf16* AS = (bf16*)(a->ws + WS_AS);
    const int* tokinfo = (const int*)(a->ws + WS_TOK); int* tokslot = (int*)(a->ws + WS_TOK) + S_LAT * 8;
    const int gw = bid * NWAVES + wave, NGW = G * NWAVES;
    for (int t = gw; t < S_LAT; t += NGW) {
        const int* ti = tokinfo + (size_t)t * 8;
        const int e1 = ti[0], e2 = ti[1], r1 = ti[2], r2 = ti[3];
        const int s1 = sb[e1] + r1, s2 = sb[e2] + r2;
        const GAS v4u* src = (const GAS v4u*)(H + (size_t)t * DM) + lane;
        const v4u x0 = src[0], x1 = src[64];
        GAS v4u* d1 = (GAS v4u*)(AS + (size_t)s1 * DM) + lane; GAS v4u* d2 = (GAS v4u*)(AS + (size_t)s2 * DM) + lane;
        d1[0] = x0; d1[64] = x1; d2[0] = x0; d2[64] = x1;
        if (lane == 0) { int* ts = tokslot + (size_t)t * 4; ts[0] = s1; ts[1] = s2; ts[2] = ti[4]; ts[3] = ti[5]; }
    }
    { const f32x4 z4 = {0.f, 0.f, 0.f, 0.f}; for (int i = bid * NTHR + tid; i < 8 * 256 * DM / 4; i += G * NTHR) ((GAS f32x4*)(a->ws + WS_YF))[i] = z4; }
    for (int e = 0; e < 8; ++e) { const int c = sb[16 + e], pe = (c + 255) & ~255, b = sb[e];
        for (int j = c + gw; j < pe; j += NGW) { GAS v4u* d = (GAS v4u*)(AS + (size_t)(b + j) * DM) + lane; const v4u z = {0u, 0u, 0u, 0u}; d[0] = z; d[64] = z; } }
}
__device__ __forceinline__ void moe_combine(KA a, int lane, int wave, int G, int bid) {
    const float* gf = (const float*)(a->ws + WS_VEC) + VO_MOD + (1 * 2 + 0) * 6144 + 5 * 1024;
    const bf16* Y = (const bf16*)(a->ws + WS_Y); const int* tokslot = (const int*)(a->ws + WS_TOK) + S_LAT * 8;
    const int gw = bid * NWAVES + wave, NGW = G * NWAVES;
    for (int t = gw; t < S_LAT; t += NGW) {
        const int* ts = tokslot + (size_t)t * 4; const int s1 = ts[0], s2 = ts[1]; const float w1 = __builtin_bit_cast(float, ts[2]), w2 = __builtin_bit_cast(float, ts[3]);
        GAS f32x4* xr = (GAS f32x4*)(a->out + (size_t)t * DM) + lane;
        const float* YF = (const float*)(a->ws + WS_YF);
#pragma unroll
        for (int j = 0; j < 4; ++j) { const f32x4 g = *(const f32x4*)(gf + 4 * lane + 256 * j); f32x4 x = xr[64 * j]; f32x4 p, q;
            if (s1 < 32768) { const v2u t = ((const GAS v2u*)(Y + (size_t)s1 * DM) + lane)[64 * j]; p = (f32x4){bflo(t.x), bfhi(t.x), bflo(t.y), bfhi(t.y)}; } else p = ((const GAS f32x4*)(YF + (size_t)(s1 - 32768) * DM) + lane)[64 * j];
            if (s2 < 32768) { const v2u t = ((const GAS v2u*)(Y + (size_t)s2 * DM) + lane)[64 * j]; q = (f32x4){bflo(t.x), bfhi(t.x), bflo(t.y), bfhi(t.y)}; } else q = ((const GAS f32x4*)(YF + (size_t)(s2 - 32768) * DM) + lane)[64 * j];
            x = x + g * (p * w1 + q * w2);
            xr[64 * j] = x; }
    }
}

#define IN(k) (lo <= (k) && (k) < hi)
#define GRIDBAR() do { XcdBarrier b2_; b2_.bar = (unsigned*)(KARGS()->ws + WS_CTL) + CW_BAR; b2_.x = xb_xcc_id(); b2_.st = (volatile LAS unsigned*)(lds + MISC_OFF) + 8; xcd_barrier(b2_, wv0 * 64 + (int)__builtin_amdgcn_mbcnt_hi(~0u, __builtin_amdgcn_mbcnt_lo(~0u, 0u))); } while (0)
#define SEAM(k) do { if (IN(k) && IN((k) + 1)) GRIDBAR(); } while (0)
#define PHASE_ROOTS() KA a = KARGS(); unsigned char* ws = a->ws; const float* vec = (const float*)(ws + WS_VEC); (void)vec; int bid = blockIdx.x, G = gridDim.x; asm volatile("" : "+s"(bid), "+s"(G)); int tid = wv0 * 64 + (int)__builtin_amdgcn_mbcnt_hi(~0u, __builtin_amdgcn_mbcnt_lo(~0u, 0u)); asm volatile("" : "+v"(tid)); const int lane = tid & 63, wave = __builtin_amdgcn_readfirstlane(tid >> 6); (void)lane; (void)wave

template <int l> __device__ __forceinline__ void layer_body(const int lo, const int hi, LAS unsigned char* lds, const int wv0) {
        const int pb = 1 + 11 * l;
        if (IN(pb + 0)) { PHASE_ROOTS(); phase_norm(a, l, 0, R_ALL, (bf16*)(ws + WS_H), lane, wave, G, bid); SEAM(pb + 0); }
        if (IN(pb + 1)) {
            PHASE_ROOTS();
            pg8::Gemm g{(const pg8::bf16_t*)(ws + WS_H), (const pg8::bf16_t*)(ws + WS_WIN) + (size_t)l * INW * DM, R_ALL, INW, DM, 0, DM};
            pg8::StaticOrder S; S.init(R_ALL, INW, G, bid);
            pg8::EpiBf16<0> E{(pg8::bf16_t*)(ws + WS_PROJ), INW, nullptr, 0, 0, 1.f};
            pg8::gemm_phase<pg8::EpiBf16<0>, pg8::StaticOrder, true, true>(lds, g, S, E, tid);
            SEAM(pb + 1);
        }
        if (IN(pb + 2)) {
            PHASE_ROOTS();
            qk_prep(a, l, bid * NTHR + tid, G * NTHR);
            for (int it = bid * NWAVES + wave; it < 520; it += G * NWAVES) vt_item(a, it, lane);
            for (int it = bid; it < 1040; it += G) hgrn_stepA(a, l, it >> 2, it & 3, lds, lane, wave);
            SEAM(pb + 2);
        }
        if (IN(pb + 3)) {
            PHASE_ROOTS();
            if (bid < 64) hgrn_stepB(a, bid, tid);
            {
                const int nu = (l == 0) ? 260 : 256, ng = (l == 0) ? 520 : 512;
                unsigned* qctr = (unsigned*)(ws + WS_CTL) + CW_QUEUE + 64 * l;
                volatile LAS unsigned* qslot = (volatile LAS unsigned*)(lds + MISC_OFF) + 16;
                for (;;) {
                    __syncthreads();
                    if (tid == 0) qslot[0] = __hip_atomic_fetch_add(qctr, 1u, RLX_AGENT);
                    __syncthreads();
                    const int it = __builtin_amdgcn_readfirstlane((int)qslot[0]);
                    if (it >= nu + ng) break;
                    if (it < nu) attn_unit(a, l, it, lds, tid, lane, wave);
                    else gmlp_unit_mma(a, l, (it - nu) >> 2, (it - nu) & 3, lds, tid, lane, wave);
                }
            }
            SEAM(pb + 3);
        }
        if (IN(pb + 4)) {
            PHASE_ROOTS();
            const int nit = (l == 0) ? 1040 : 1024;
            for (int it = bid; it < nit; it += G) hgrn_stepC(a, l, it >> 2, it & 3, lds, tid, lane, wave);
            SEAM(pb + 4);
        }
        if (IN(pb + 5)) {
            PHASE_ROOTS();
            const float* modl = vec + VO_MOD + (l * 2 + 0) * 6144; const float* modc = vec + VO_MOD + (l * 2 + 1) * 6144;
            const int M = S_LAT;
            pg8::Gemm g{(const pg8::bf16_t*)(ws + WS_MIX), (const pg8::bf16_t*)(ws + WS_WOUT) + (size_t)l * DM * DM, M, DM, DM, 0, DM};
            pg8::StaticOrder S; S.init(M, DM, G, bid);
            pg8::EpiResid E{(l == 0) ? a->in[I_X] : a->out, a->out, modl + 2048, a->in[I_CTX], (float*)(ws + WS_CTXR), modc + 2048, S_LAT / 256, DM};
            pg8::gemm_phase<pg8::EpiResid, pg8::StaticOrder, true, true>(lds, g, S, E, tid);
            if (l == 0) {
                pg8::Gemm g2{(const pg8::bf16_t*)(ws + WS_MIX), (const pg8::bf16_t*)(ws + WS_WOUT), R_ALL, DM, 256, 0, DM};
                pg8::SplitKOrder S2{S_LAT / 256, 4, 4, 256, 16, bid, nullptr};
                pg8::EpiAtomic E2{(float*)(ws + WS_CTXR), modc + 2048, S_LAT / 256, DM};
                pg8::gemm_phase<pg8::EpiAtomic, pg8::SplitKOrder, false, true>(lds, g2, S2, E2, tid);
            }
            SEAM(pb + 5);
        }
        if (l == 0) {
            if (IN(pb + 6)) { PHASE_ROOTS(); phase_norm(a, l, 1, R_ALL, (bf16*)(ws + WS_H), lane, wave, G, bid); SEAM(pb + 6); }
            if (IN(pb + 7)) {
                PHASE_ROOTS();
                pg8::Gemm g{(const pg8::bf16_t*)(ws + WS_H), (const pg8::bf16_t*)(ws + WS_WGU), R_ALL, 2 * FFN, DM, 0, DM};
                pg8::StaticOrder S; S.init(R_ALL, 2 * FFN, G, bid);
                pg8::EpiSwiGLU E{(pg8::bf16_t*)(ws + WS_HID), FFN};
                pg8::gemm_phase<pg8::EpiSwiGLU, pg8::StaticOrder, true, true>(lds, g, S, E, tid);
                SEAM(pb + 7);
            }
            if (IN(pb + 8)) {
                PHASE_ROOTS();
                const float* modl = vec + VO_MOD + (l * 2 + 0) * 6144; const float* modc = vec + VO_MOD + (l * 2 + 1) * 6144;
                pg8::Gemm g{(const pg8::bf16_t*)(ws + WS_HID), (const pg8::bf16_t*)(ws + WS_WD), S_LAT, DM, FFN, 0, FFN};
                pg8::StaticOrder S; S.init(S_LAT, DM, G, bid);
                pg8::EpiResid E{a->out, a->out, modl + 5120, (const float*)(ws + WS_CTXR), (float*)(ws + WS_CTXR), modc + 5120, S_LAT / 256, DM};
                pg8::gemm_phase<pg8::EpiResid, pg8::StaticOrder, true, true>(lds, g, S, E, tid);
                {
                    pg8::Gemm g2{(const pg8::bf16_t*)(ws + WS_HID), (const pg8::bf16_t*)(ws + WS_WD), R_ALL, DM, 256, 0, FFN};
                    pg8::SplitKOrder S2{S_LAT / 256, 4, 11, 256, 44, bid, nullptr};
                    pg8::EpiAtomic E2{(float*)(ws + WS_CTXR), modc + 5120, S_LAT / 256, DM};
                    pg8::gemm_phase<pg8::EpiAtomic, pg8::SplitKOrder, false, true>(lds, g2, S2, E2, tid);
                }
                if (IN(pb + 8) && IN(pb + 11)) GRIDBAR();
            }
        } else {
            if (IN(pb + 6)) { PHASE_ROOTS(); phase_norm_route(a, lds, tid, lane, wave, G, bid); SEAM(pb + 6); }
            if (IN(pb + 7)) { PHASE_ROOTS(); moe_gather(a, lds, tid, lane, wave, G, bid); SEAM(pb + 7); }
            if (IN(pb + 8)) {
                PHASE_ROOTS();
                const int* mi = (const int*)(ws + WS_VEC) + VO_MOE; const int nt = __builtin_amdgcn_readfirstlane(mi[0]);
                pg8::Gemm g{(const pg8::bf16_t*)(ws + WS_AS), (const pg8::bf16_t*)(ws + WS_MGU), nt * 256, 2 * EXD, DM, (size_t)2 * EXD * DM * 2, DM};
                pg8::MoeOrder S; S.init(nt * 256, 2 * EXD, G, bid); S.tile_e = mi + 16;
                pg8::EpiSwiGLU E{(pg8::bf16_t*)(ws + WS_HIDM), EXD};
                pg8::gemm_phase<pg8::EpiSwiGLU, pg8::MoeOrder, true, true>(lds, g, S, E, tid);
                SEAM(pb + 8);
            }
            if (IN(pb + 9)) {
                PHASE_ROOTS();
                const int* mi = (const int*)(ws + WS_VEC) + VO_MOE; const int nt = __builtin_amdgcn_readfirstlane(mi[0]); const int nm = nt < 128 ? nt : 128;
                pg8::Gemm g{(const pg8::bf16_t*)(ws + WS_HIDM), (const pg8::bf16_t*)(ws + WS_MD), nm * 256, DM, EXD, (size_t)DM * EXD * 2, EXD};
                pg8::MoeOrder S; S.init(nm * 256, DM, G, bid); S.tile_e = mi + 16;
                pg8::EpiBf16<0> E{(pg8::bf16_t*)(ws + WS_Y), DM, nullptr, 0, 0, 1.f};
                pg8::gemm_phase<pg8::EpiBf16<0>, pg8::MoeOrder, true, true>(lds, g, S, E, tid);
                if (nt > 128) {
                    pg8::Gemm g2{(const pg8::bf16_t*)(ws + WS_HIDM), (const pg8::bf16_t*)(ws + WS_MD), nt * 256, DM, 512, (size_t)DM * EXD * 2, EXD};
                    pg8::SplitKOrder S2{128, 4, 7, 512, (nt - 128) * 28, bid, mi + 16};
                    pg8::EpiAtomic E2{(float*)(ws + WS_YF), nullptr, 128, DM};
                    pg8::gemm_phase<pg8::EpiAtomic, pg8::SplitKOrder, false, true>(lds, g2, S2, E2, tid);
                }
                SEAM(pb + 9);
            }
            if (IN(pb + 10)) { PHASE_ROOTS(); moe_combine(a, lane, wave, G, bid); }
        }
    }
__global__ void __launch_bounds__(NTHR, 2) fwd_kernel(Args a_unused) {
    extern __shared__ __attribute__((aligned(16))) unsigned char lds_raw[];
    LAS unsigned char* lds = (LAS unsigned char*)lds_raw;
    const int tid0 = threadIdx.x;
    const int wv0 = __builtin_amdgcn_readfirstlane(tid0 >> 6);
    for (int u = tid0; u < (LDS_BYTES - LDSCTL_OFF) / 4; u += NTHR) ((LAS unsigned*)(lds + LDSCTL_OFF))[u] = 0u;
    __syncthreads();
    const int lo = KARGS()->ph_lo, hi = KARGS()->ph_hi;
    const bool fusedl = (hi - lo) > 1;
    if (fusedl) (void)xcd_barrier_post((unsigned*)(KARGS()->ws + WS_CTL) + CW_BAR, (volatile LAS unsigned*)(lds + MISC_OFF) + 8);
    if (IN(0)) { PHASE_ROOTS(); p0_prologue(a, lds, tid, lane, wave, G, bid); SEAM(0); }

    layer_body<0>(lo, hi, lds, wv0);
    layer_body<1>(lo, hi, lds, wv0);
}

extern "C" void kernel_launch(void* const* d_in, const int* in_sizes, int n_in, void* d_out, int out_size, void* d_ws, size_t ws_size, hipStream_t stream) {
    static int grid = 0;
    if (grid == 0) {
        if (n_in != 23 || in_sizes[0] != S_LAT * DM || out_size != S_LAT * DM || ws_size < WS_END) { fprintf(stderr, "kernel_launch: unexpected shapes / workspace (n_in %d, ws %zu, need %zu)\n", n_in, ws_size, (size_t)WS_END); grid = -1; return; }
        int dev = 0, cus = 0;
        if (hipGetDevice(&dev) != hipSuccess || hipDeviceGetAttribute(&cus, hipDeviceAttributeMultiprocessorCount, dev) != hipSuccess) { grid = -1; return; }
        if (hipFuncSetAttribute((const void*)fwd_kernel, hipFuncAttributeMaxDynamicSharedMemorySize, LDS_BYTES) != hipSuccess) { grid = -1; return; }
        int per_cu = 0;
        (void)hipOccupancyMaxActiveBlocksPerMultiprocessor(&per_cu, (const void*)fwd_kernel, NTHR, LDS_BYTES);
        (void)hipGetLastError();
        grid = cus;
    }
    if (grid < 0) return;
    if (hipMemsetAsync((char*)d_ws + WS_CTL, 0, CTL_ZERO_BYTES, stream) != hipSuccess) return;
    Args a{};
    for (int i = 0; i < 23; ++i) a.in[i] = (const float*)d_in[i];
    a.out = (float*)d_out; a.ws = (unsigned char*)d_ws;
#if ONE_LAUNCH
    a.ph_lo = 0; a.ph_hi = NPH;
    hipLaunchKernelGGL(fwd_kernel, dim3(grid), dim3(NTHR), LDS_BYTES, stream, a);
#else
    for (int p = 0; p < NPH; ++p) {
        if (p == 10 || p == 11) continue;
        a.ph_lo = p; a.ph_hi = p + 1;
        hipLaunchKernelGGL(fwd_kernel, dim3(grid), dim3(NTHR), LDS_BYTES, stream, a);
    }
#endif
}
```

```cpp
#include <hip/hip_runtime.h>
#include <cstdio>
#include <cstdint>
#include <cmath>
#ifndef ONE_LAUNCH
#define ONE_LAUNCH 1
#endif
namespace pg8 {
#define PG8_LAS __attribute__((address_space(3)))
typedef unsigned short bf16_t;
typedef short bf16x8 __attribute__((ext_vector_type(8)));
typedef float f32x4 __attribute__((ext_vector_type(4)));
typedef unsigned u32x4 __attribute__((ext_vector_type(4)));
constexpr int BM = 256, BK = 64, HALF = 128, HTB = HALF * BK * 2  , STAGE_BYTES = 8 * HTB, NXCD = 8, WGM = 8;

__host__ __device__ __forceinline__ int lds_byte(int r, int c) { const int st = (r >> 4) * 2 + (c >> 5), rr = r & 15, cc = c & 31, ob = rr * 64 + cc * 2; return st * 1024 + (ob ^ (((ob >> 9) & 1) << 5)); }
__host__ __device__ __forceinline__ void stage_rc(int b, int& R, int& C) { const int st = b / 1024, sb = b % 1024, swz = sb ^ (((sb >> 9) & 1) << 5); R = (st >> 1) * 16 + swz / 64; C = (st & 1) * 32 + (swz % 64) / 2; }
__host__ __device__ __forceinline__ int perm32(int rho) { const int n = rho >> 4, i = rho & 15; return 8 * (i >> 2) + 4 * n + (i & 3); }

struct Unit { int pm, pn, eb, ko; };
struct Gemm { const bf16_t* A; const bf16_t* Bt; int M, N, K; size_t bstride; int ld; };

struct StaticOrder {
    int nM, nN, nwg, G, c;
    __host__ __device__ void init(int M, int N, int G_, int c_) { nM = M / BM; nN = N / BM; nwg = nM * nN; G = G_; c = c_; }
    __host__ __device__ bool next(int i, Unit& u) const {
        const long L = (long)i * G + c; if (L >= nwg) return false;
        int wgid = (int)L; { const int q = nwg / NXCD, r = nwg % NXCD, xcd = wgid % NXCD, off = wgid / NXCD; wgid = (xcd < r ? xcd * (q + 1) : r * (q + 1) + (xcd - r) * q) + off; }
        const int nig = WGM * nN, gid = wgid / nig, fm = gid * WGM, gsz = (nM - fm) < WGM ? (nM - fm) : WGM;
        u.pm = fm + ((wgid % nig) % gsz); u.pn = (wgid % nig) / gsz; u.eb = 0; u.ko = 0; return true;
    }
    __device__ __forceinline__ void a_ready(const Unit&) const {}
    __device__ __forceinline__ void done(const Unit&) const {}
};

__device__ __forceinline__ unsigned cvt_pk_bf16(float lo, float hi) { unsigned r; asm volatile("v_cvt_pk_bf16_f32 %0, %1, %2" : "=v"(r) : "v"(lo), "v"(hi)); return r; }
typedef float f32x2 __attribute__((ext_vector_type(2)));
__device__ __forceinline__ f32x2 gelu_pk(f32x2 v) {
    const f32x2 av = __builtin_elementwise_abs(v), d = av * 0.2316418882f + 1.0f;
    f32x2 t; t.x = __builtin_amdgcn_rcpf(d.x); t.y = __builtin_amdgcn_rcpf(d.y);
    f32x2 q = t * 0.5307027145f + (-0.7265760135f); q = q * t + 0.7107068705f; q = q * t + (-0.142248368f); q = q * t + 0.127414796f; q = q * t;
    const f32x2 s = (v * v) * (-0.72134752044f);
    f32x2 e; e.x = __builtin_amdgcn_exp2f(s.x); e.y = __builtin_amdgcn_exp2f(s.y);
    const f32x2 m = v * (q * e), r = v - m;
    f32x2 o; o.x = v.x < 0.f ? m.x : r.x; o.y = v.y < 0.f ? m.y : r.y; return o;
}

template <int ACT  > struct EpiBf16 {
    static constexpr bool PERM = true, AFTER_DRAIN = false; static_assert(ACT == 0 || ACT == 1, "EpiBf16: ACT is 0 (none) or 1 (gelu_pk)");
    bf16_t* O; int ldc; const float* bias; int split_cols; size_t split_stride; float scale0;
    __device__ __forceinline__ void operator()(const f32x4 (&acc)[2][2][4][2], const Unit& u, int wr, int wc, int fr, int fq) const {
        const int row0 = u.pm * BM + wr * 64 + fr; int colt = u.pn * BM; bf16_t* base = O;
        float sc = 1.f; if (split_cols) { const int t = colt / split_cols; base += (size_t)t * split_stride; colt -= t * split_cols; if (t == 0) sc = scale0; }
        const int col0 = colt + wc * 32 + 8 * fq, bcol0 = u.pn * BM + wc * 32 + 8 * fq;
        f32x4 bv[2][2];
#pragma unroll
        for (int bj = 0; bj < 2; ++bj)
#pragma unroll
            for (int n = 0; n < 2; ++n) bv[bj][n] = bias ? *(const f32x4*)(bias + bcol0 + bj * HALF + 4 * n) : (f32x4){0.f, 0.f, 0.f, 0.f};
#pragma unroll
        for (int ai = 0; ai < 2; ++ai)
#pragma unroll
            for (int m = 0; m < 4; ++m) { bf16_t* rowp = base + (size_t)(row0 + ai * HALF + m * 16) * ldc + col0;
#pragma unroll
                for (int bj = 0; bj < 2; ++bj) { f32x4 v0 = acc[ai][bj][m][0] + bv[bj][0], v1 = acc[ai][bj][m][1] + bv[bj][1];
                    if (ACT == 1) { f32x2 a = gelu_pk((f32x2){v0[0], v0[1]}), b = gelu_pk((f32x2){v0[2], v0[3]}), c = gelu_pk((f32x2){v1[0], v1[1]}), d = gelu_pk((f32x2){v1[2], v1[3]});
                        v0 = (f32x4){a.x, a.y, b.x, b.y}; v1 = (f32x4){c.x, c.y, d.x, d.y}; }
                    v0 = v0 * sc; v1 = v1 * sc; u32x4 w; w.x = cvt_pk_bf16(v0[0], v0[1]); w.y = cvt_pk_bf16(v0[2], v0[3]); w.z = cvt_pk_bf16(v1[0], v1[1]); w.w = cvt_pk_bf16(v1[2], v1[3]);
                    *(u32x4*)(rowp + bj * HALF) = w; } }
    }
};

__device__ __forceinline__ float silu_f(float x) { return x * __builtin_amdgcn_rcpf(1.0f + __builtin_amdgcn_exp2f(-1.4426950408889634f * x)); }
struct EpiResid {
    static constexpr bool PERM = false, AFTER_DRAIN = false;
    const float* base; float* out; const float* gate; const float* cbase; float* cout; const float* cgate; int mlat; int ldc;
    __device__ __forceinline__ void operator()(const f32x4 (&acc)[2][2][4][2], const Unit& u, int wr, int wc, int fr, int fq) const {
        const bool isc = u.pm >= mlat;
        const float* b = isc ? cbase : base; float* o = isc ? cout : out; const float* g = isc ? cgate : gate;
        const int row0 = (isc ? (u.pm - mlat) : u.pm) * BM + wr * 64 + fr, col0 = u.pn * BM + wc * 32 + 4 * fq;
        f32x4 gv[2][2];
#pragma unroll
        for (int bj = 0; bj < 2; ++bj)
#pragma unroll
            for (int n = 0; n < 2; ++n) gv[bj][n] = *(const f32x4*)(g + col0 + bj * HALF + n * 16);
#pragma unroll
        for (int ai = 0; ai < 2; ++ai)
#pragma unroll
            for (int m = 0; m < 4; ++m) { const size_t off = (size_t)(row0 + ai * HALF + m * 16) * ldc + col0;
#pragma unroll
                for (int bj = 0; bj < 2; ++bj)
#pragma unroll
                    for (int n = 0; n < 2; ++n) { const f32x4 bs = *(const f32x4*)(b + off + bj * HALF + n * 16); *(f32x4*)(o + off + bj * HALF + n * 16) = bs + gv[bj][n] * acc[ai][bj][m][n]; }
                if (m & 1) asm volatile("" ::: "memory"); }
    }
};
struct EpiSwiGLU {
    static constexpr bool PERM = true, AFTER_DRAIN = false;
    bf16_t* O; int ldc;
    __device__ __forceinline__ void operator()(const f32x4 (&acc)[2][2][4][2], const Unit& u, int wr, int wc, int fr, int fq) const {
        const int row0 = u.pm * BM + wr * 64 + fr, col0 = u.pn * HALF + wc * 32 + 8 * fq;
#pragma unroll
        for (int ai = 0; ai < 2; ++ai)
#pragma unroll
            for (int m = 0; m < 4; ++m) { bf16_t* rowp = O + (size_t)(row0 + ai * HALF + m * 16) * ldc + col0;
                const f32x4 g0 = acc[ai][0][m][0], g1 = acc[ai][0][m][1], u0 = acc[ai][1][m][0], u1 = acc[ai][1][m][1];
                f32x4 h0, h1;
#pragma unroll
                for (int j = 0; j < 4; ++j) { h0[j] = silu_f(g0[j]) * u0[j]; h1[j] = silu_f(g1[j]) * u1[j]; }
                u32x4 w; w.x = cvt_pk_bf16(h0[0], h0[1]); w.y = cvt_pk_bf16(h0[2], h0[3]); w.z = cvt_pk_bf16(h1[0], h1[1]); w.w = cvt_pk_bf16(h1[2], h1[3]);
                *(u32x4*)rowp = w; }
    }
};
struct MoeOrder : StaticOrder {
    const int* tile_e;
    __device__ __forceinline__ bool next(int i, Unit& u) const { if (!StaticOrder::next(i, u)) return false; u.eb = __builtin_amdgcn_readfirstlane(tile_e[u.pm]); return true; }
};

struct SplitKOrder {
    int pm0, nN, P, kp, total, c; const int* tile_e;
    __device__ __forceinline__ bool next(int i, Unit& u) const {
        if (i != 0 || c >= total) return false;
        const int p = c % P, t = c / P; u.pn = t % nN; u.pm = pm0 + t / nN; u.ko = p * kp; u.eb = tile_e ? __builtin_amdgcn_readfirstlane(tile_e[u.pm]) : 0; return true; }
    __device__ __forceinline__ void a_ready(const Unit&) const {}
    __device__ __forceinline__ void done(const Unit&) const {}
};
struct EpiAtomic {
    static constexpr bool PERM = false, AFTER_DRAIN = true;
    float* out; const float* scale; int pm_sub; int ldc;
    __device__ __forceinline__ void fused(f32x4 (&acc)[2][2][4][2], const Unit& u, int wr, int wc, int fr, int fq, PG8_LAS unsigned char* lds, int wid, int lane) const {
        PG8_LAS float* scr = (PG8_LAS float*)(lds + wid * 16384);
        const int rr = lane >> 5, cc = lane & 31;
#pragma unroll
        for (int ai = 0; ai < 2; ++ai)
#pragma unroll
            for (int bj = 0; bj < 2; ++bj) {
#pragma unroll
                for (int m = 0; m < 4; ++m)
#pragma unroll
                    for (int n = 0; n < 2; ++n) *(PG8_LAS f32x4*)(scr + (m * 16 + fr) * 36 + n * 16 + 4 * fq) = acc[ai][bj][m][n];
                asm volatile("s_waitcnt lgkmcnt(0)" ::: "memory");
                const int colg = u.pn * BM + bj * HALF + wc * 32 + cc; const float sc = scale ? scale[colg] : 1.0f;
                float* op = out + (size_t)((u.pm - pm_sub) * BM + ai * HALF + wr * 64 + rr) * ldc + colg;
#pragma unroll 8
                for (int i = 0; i < 32; ++i) { const float v = scr[(2 * i + rr) * 36 + cc]; __hip_atomic_fetch_add(op + (size_t)(2 * i) * ldc, v * sc, __ATOMIC_RELAXED, __HIP_MEMORY_SCOPE_AGENT); }
                asm volatile("s_waitcnt lgkmcnt(0)" ::: "memory");
            }
    }
};

template <class Epi, class Sched, bool ALIGN_EPI = false, bool SP2 = false>
__device__ __forceinline__ void gemm_phase(PG8_LAS unsigned char* lds, const Gemm g, const Sched& S, const Epi& E, int tid_in) {
    int tid_ = tid_in; asm volatile("" : "+v"(tid_));
    const int tid = tid_, wid = __builtin_amdgcn_readfirstlane(tid >> 6), lane = tid & 63, wr = wid >> 2, wc = wid & 3, fr = lane & 15, fq = lane >> 4;
    const int K = g.K, nt = K / BK, ld = g.ld;
    unsigned voffA[2], voffB[2];
#pragma unroll
    for (int i = 0; i < 2; ++i) { int R, C; stage_rc(tid * 16 + i * 8192, R, C); const int Rb = Epi::PERM ? ((R & ~31) + perm32(R & 31)) : R;
        voffA[i] = (unsigned)(R * ld + C) * 2u; voffB[i] = (unsigned)(Rb * ld + C) * 2u; }
    const size_t kstep = (size_t)(BK * 2);
    const size_t hstep = (size_t)HALF * ld * 2;
    const size_t tstep = 2 * hstep;
    const unsigned ldsw = (unsigned)wid * 1024u;
    const int aoff = lds_byte(wr * 64 + fr, fq * 8), boff = lds_byte(wc * 32 + fr, fq * 8);
#define PG8_SA(b, h) (((b) * 2 + (h)) * HTB)
#define PG8_SB(b, h) ((4 + (b) * 2 + (h)) * HTB)
#define PG8_STAGE(bufoff, gbase, voff) do { _Pragma("unroll") for (int _i = 0; _i < 2; ++_i) \
        __builtin_amdgcn_global_load_lds((const unsigned*)((const char*)(gbase) + (voff)[_i]), (PG8_LAS unsigned*)(lds + (bufoff) + ldsw + _i * 8192), 16, 0, 0); } while (0)
#define PG8_LDA(dst, b, h) do { _Pragma("unroll") for (int m = 0; m < 4; ++m) _Pragma("unroll") for (int k = 0; k < 2; ++k) dst[m][k] = *(const PG8_LAS bf16x8*)(lds + PG8_SA(b, h) + aoff + m * 2048 + k * 1024); } while (0)
#define PG8_LDB(dst, b, h) do { _Pragma("unroll") for (int n = 0; n < 2; ++n) _Pragma("unroll") for (int k = 0; k < 2; ++k) dst[n][k] = *(const PG8_LAS bf16x8*)(lds + PG8_SB(b, h) + boff + n * 2048 + k * 1024); } while (0)
#define PG8_MMA(ai, bj, At, Bt) do { __builtin_amdgcn_s_setprio(1); _Pragma("unroll") for (int m = 0; m < 4; ++m) _Pragma("unroll") for (int n = 0; n < 2; ++n) _Pragma("unroll") for (int k = 0; k < 2; ++k) \
        acc[ai][bj][m][n] = __builtin_amdgcn_mfma_f32_16x16x32_bf16(Bt[n][k], At[m][k], acc[ai][bj][m][n], 0, 0, 0); __builtin_amdgcn_s_setprio(0); } while (0)
#define PG8_WAIT_V(n) asm volatile("s_waitcnt vmcnt(" #n ")" ::: "memory")
#define PG8_WAIT_L(n) asm volatile("s_waitcnt lgkmcnt(" #n ")" ::: "memory")
#define PG8_BAR __builtin_amdgcn_s_barrier()
#define PG8_SCHED __builtin_amdgcn_sched_barrier(0)
    Unit cur, nxt; int ui = 0;
    if (!S.next(0, cur)) return;
    f32x4 acc[2][2][4][2];
#pragma unroll
    for (int a = 0; a < 2; ++a)
#pragma unroll
        for (int b = 0; b < 2; ++b)
#pragma unroll
            for (int m = 0; m < 4; ++m)
#pragma unroll
                for (int n = 0; n < 2; ++n) acc[a][b][m][n] = (f32x4){0.f, 0.f, 0.f, 0.f};
    bf16x8 At[4][2], B0[2][2], B1[2][2];
    const char* cA = (const char*)g.A + (size_t)cur.pm * tstep + (size_t)cur.ko * 2; const char* cB = (const char*)g.Bt + (size_t)cur.eb * g.bstride + (size_t)cur.pn * tstep + (size_t)cur.ko * 2;
    S.a_ready(cur);
    if constexpr (SP2) {
        PG8_STAGE(PG8_SB(0, 0), cB, voffB); PG8_STAGE(PG8_SB(0, 1), cB + hstep, voffB); PG8_STAGE(PG8_SA(0, 0), cA, voffA); PG8_STAGE(PG8_SA(0, 1), cA + hstep, voffA);
        if (wr == 1) PG8_BAR;
        PG8_WAIT_V(2); PG8_BAR;
        PG8_STAGE(PG8_SB(1, 0), cB + kstep, voffB); PG8_STAGE(PG8_SA(1, 0), cA + kstep, voffA); PG8_STAGE(PG8_SB(1, 1), cB + hstep + kstep, voffB);
        PG8_WAIT_V(6); PG8_BAR;
    } else {
        PG8_STAGE(PG8_SB(0, 0), cB, voffB); PG8_STAGE(PG8_SA(0, 0), cA, voffA); PG8_STAGE(PG8_SB(0, 1), cB + hstep, voffB); PG8_STAGE(PG8_SA(0, 1), cA + hstep, voffA);
        if (wr == 1) PG8_BAR;
        PG8_WAIT_V(4); PG8_BAR;
        PG8_STAGE(PG8_SB(1, 0), cB + kstep, voffB); PG8_STAGE(PG8_SA(1, 0), cA + kstep, voffA); PG8_STAGE(PG8_SB(1, 1), cB + hstep + kstep, voffB);
        PG8_WAIT_V(6); PG8_BAR;
    }
    for (;;) {
        const bool has_next = S.next(ui + 1, nxt);
        const char* nA = has_next ? (const char*)g.A + (size_t)nxt.pm * tstep + (size_t)nxt.ko * 2 : cA; const char* nB = has_next ? (const char*)g.Bt + (size_t)nxt.eb * g.bstride + (size_t)nxt.pn * tstep + (size_t)nxt.ko * 2 : cB;
        for (int t = 0; t < nt; t += 2) {
            const bool last = (t == nt - 2);
            const char* a1 = cA + (size_t)(t + 1) * kstep;
            const char* a2 = last ? nA : cA + (size_t)(t + 2) * kstep; const char* b2 = last ? nB : cB + (size_t)(t + 2) * kstep;
            const char* a3 = a2 + kstep; const char* b3 = b2 + kstep;
            if (last && has_next) S.a_ready(nxt);
            if constexpr (SP2) {
            PG8_LDB(B0, 0, 0); PG8_LDB(B1, 0, 1); PG8_SCHED; PG8_LDA(At, 0, 0); PG8_STAGE(PG8_SA(1, 1), a1 + hstep, voffA);
            PG8_WAIT_V(8); PG8_WAIT_L(0); PG8_BAR; PG8_MMA(0, 0, At, B0); PG8_MMA(0, 1, At, B1); PG8_BAR; PG8_SCHED;
            PG8_LDA(At, 0, 1); PG8_STAGE(PG8_SB(0, 0), b2, voffB); PG8_STAGE(PG8_SB(0, 1), b2 + hstep, voffB); PG8_STAGE(PG8_SA(0, 0), a2, voffA);
            PG8_WAIT_V(8); PG8_WAIT_L(0); PG8_BAR; PG8_MMA(1, 0, At, B0); PG8_MMA(1, 1, At, B1); PG8_BAR; PG8_SCHED;
            PG8_LDB(B0, 1, 0); PG8_LDB(B1, 1, 1); PG8_SCHED; PG8_LDA(At, 1, 0); PG8_STAGE(PG8_SA(0, 1), a2 + hstep, voffA);
            PG8_WAIT_V(8); PG8_WAIT_L(0); PG8_BAR; PG8_MMA(0, 0, At, B0); PG8_MMA(0, 1, At, B1); PG8_BAR; PG8_SCHED;
            PG8_LDA(At, 1, 1); PG8_STAGE(PG8_SB(1, 0), b3, voffB); PG8_STAGE(PG8_SB(1, 1), b3 + hstep, voffB); PG8_STAGE(PG8_SA(1, 0), a3, voffA);
            PG8_WAIT_V(8); PG8_WAIT_L(0); PG8_BAR; PG8_MMA(1, 0, At, B0); PG8_MMA(1, 1, At, B1); PG8_BAR; PG8_SCHED;
            } else {
            PG8_LDB(B0, 0, 0); PG8_SCHED; PG8_LDA(At, 0, 0); PG8_STAGE(PG8_SA(1, 1), a1 + hstep, voffA);
            PG8_WAIT_L(8); PG8_BAR; PG8_WAIT_L(0); PG8_MMA(0, 0, At, B0); PG8_BAR; PG8_SCHED;
            PG8_LDB(B1, 0, 1); PG8_STAGE(PG8_SB(0, 0), b2, voffB);
            PG8_BAR; PG8_WAIT_L(0); PG8_MMA(0, 1, At, B1); PG8_BAR;
            PG8_LDA(At, 0, 1); PG8_STAGE(PG8_SA(0, 0), a2, voffA);
            PG8_BAR; PG8_WAIT_L(0); PG8_MMA(1, 0, At, B0); PG8_BAR; PG8_SCHED;
            PG8_STAGE(PG8_SB(0, 1), b2 + hstep, voffB);
            PG8_WAIT_V(6); PG8_BAR; PG8_MMA(1, 1, At, B1); PG8_BAR;
            PG8_LDB(B0, 1, 0); PG8_SCHED; PG8_LDA(At, 1, 0); PG8_STAGE(PG8_SA(0, 1), a2 + hstep, voffA);
            PG8_WAIT_L(8); PG8_BAR; PG8_WAIT_L(0); PG8_MMA(0, 0, At, B0); PG8_BAR; PG8_SCHED;
            PG8_LDB(B1, 1, 1); PG8_STAGE(PG8_SB(1, 0), b3, voffB);
            PG8_BAR; PG8_WAIT_L(0); PG8_MMA(0, 1, At, B1); PG8_BAR;
            PG8_LDA(At, 1, 1); PG8_STAGE(PG8_SA(1, 0), a3, voffA);
            PG8_BAR; PG8_WAIT_L(0); PG8_MMA(1, 0, At, B0); PG8_BAR; PG8_SCHED;
            PG8_STAGE(PG8_SB(1, 1), b3 + hstep, voffB);
            PG8_WAIT_V(6); PG8_BAR; PG8_MMA(1, 1, At, B1); PG8_BAR;
            }
        }
        if constexpr (ALIGN_EPI) { if (wr == 0) PG8_BAR; }
        if constexpr (!Epi::AFTER_DRAIN) { E(acc, cur, wr, wc, fr, fq); S.done(cur); }
        if (!has_next) break;
#pragma unroll
        for (int a = 0; a < 2; ++a)
#pragma unroll
            for (int b = 0; b < 2; ++b)
#pragma unroll
                for (int m = 0; m < 4; ++m)
#pragma unroll
                    for (int n = 0; n < 2; ++n) acc[a][b][m][n] = (f32x4){0.f, 0.f, 0.f, 0.f};
        cur = nxt; cA = nA; cB = nB; ++ui;
        if constexpr (ALIGN_EPI) { if (wr == 1) PG8_BAR; }
    }
    PG8_WAIT_V(0);
    if constexpr (!ALIGN_EPI) { if (wr == 0) PG8_BAR; }
    PG8_BAR;
    if constexpr (Epi::AFTER_DRAIN) { E.fused(acc, cur, wr, wc, fr, fq, lds, wid, lane); S.done(cur); }
#undef PG8_SA
#undef PG8_SB
#undef PG8_STAGE
#undef PG8_LDA
#undef PG8_LDB
#undef PG8_MMA
#undef PG8_WAIT_V
#undef PG8_WAIT_L
#undef PG8_BAR
#undef PG8_SCHED
}
}


constexpr int S_LAT = 16384, C_CTX = 256, R_ALL = S_LAT + C_CTX, DM = 1024;
constexpr int INW = 2560, FFN = 2816, EXD = 3584, NEXP = 8;
constexpr int COL_AQ = 0, COL_AK = 512, COL_AV = 640, COL_HQ = 768, COL_HFF = 1024, COL_HFB = 1280, COL_HI = 1536, COL_HG = 1792, COL_GU = 2048, COL_GV = 2304;
constexpr int MIX_AT = 0, MIX_HG = 512, MIX_GM = 768;
constexpr int MOE_MAXROWS = 34816;
constexpr float EPS = 1e-6f;
constexpr int NWAVES = 8, NTHR = 512;
constexpr int NPH = 23;

constexpr size_t MiB = 1u << 20;
constexpr size_t WS_CTL = 0, CTL_ZERO_BYTES = 1 * MiB;
constexpr size_t WS_VEC = 1 * MiB;
constexpr size_t WS_TOK = 2 * MiB;
constexpr size_t WS_WIN = 3 * MiB;
constexpr size_t WS_WOUT = 13 * MiB;
constexpr size_t WS_WGU = 17 * MiB;
constexpr size_t WS_WD = 28 * MiB;
constexpr size_t WS_MGU = 34 * MiB;
constexpr size_t WS_MD = 146 * MiB;
constexpr size_t WS_H = 202 * MiB;
constexpr size_t WS_PROJ = 235 * MiB;
constexpr size_t WS_MIX = 317 * MiB;
constexpr size_t WS_HGO = 350 * MiB;
constexpr size_t WS_CTXR = 383 * MiB;
constexpr size_t WS_HLT = WS_HGO;
constexpr size_t WS_HSP = 384 * MiB;
constexpr size_t WS_HDG = 402 * MiB;
constexpr size_t WS_VT = 403 * MiB;
constexpr size_t WS_HID = WS_PROJ;
constexpr size_t WS_AS = 202 * MiB;
constexpr size_t WS_HIDM = 270 * MiB;
constexpr size_t WS_H2B = 440 * MiB;
constexpr size_t WS_YF = WS_WIN;
constexpr size_t WS_Y = WS_MGU;
constexpr size_t WS_END = 508 * MiB;
static_assert(WS_HID + (size_t)R_ALL * FFN * 2 <= WS_HGO && WS_AS + (size_t)MOE_MAXROWS * DM * 2 <= WS_HIDM && WS_HIDM + (size_t)MOE_MAXROWS * EXD * 2 <= WS_END, "ws map");
static_assert(WS_H2B >= WS_HIDM && WS_H2B + (size_t)S_LAT * DM * 2 <= WS_END && WS_H + (size_t)R_ALL * DM * 2 <= WS_PROJ && WS_PROJ + (size_t)R_ALL * INW * 2 <= WS_MIX && WS_MIX + (size_t)R_ALL * DM * 2 <= WS_HGO && WS_HGO + (size_t)2 * R_ALL * 256 * 4 <= WS_CTXR, "ws map 2");
constexpr int VO_MOD = 0;
constexpr int VO_ROPE = 32768;
constexpr int VO_MOE = 65536;
constexpr int CW_BAR = 4096;
constexpr int CW_QUEUE = 2048;
constexpr int CW_MOECNT = 1024;

constexpr int RING_BYTES = 131072;
constexpr int LDSCTL_OFF = 159744, MISC_OFF = LDSCTL_OFF + 320;
constexpr int LDS_BYTES = 163840;

#define GAS __attribute__((address_space(1)))
#define LAS __attribute__((address_space(3)))
typedef unsigned short bf16;
typedef unsigned v4u __attribute__((ext_vector_type(4)));
typedef unsigned v2u __attribute__((ext_vector_type(2)));
typedef float f32x4 __attribute__((ext_vector_type(4)));
typedef GAS unsigned gu32;
#define RLX_AGENT __ATOMIC_RELAXED, __HIP_MEMORY_SCOPE_AGENT
#define LDS_WAIT() asm volatile("s_waitcnt lgkmcnt(0)" ::: "memory")
typedef float f32x2_t __attribute__((ext_vector_type(2))); typedef __bf16 bf16x2_t __attribute__((ext_vector_type(2)));
__device__ __forceinline__ unsigned pk2(float lo, float hi) { const f32x2_t v = {lo, hi}; const bf16x2_t b = __builtin_convertvector(v, bf16x2_t); return __builtin_bit_cast(unsigned, b); }
__device__ __forceinline__ unsigned f2bf(float f) { return pk2(f, 0.f) & 0xffffu; }
__device__ __forceinline__ float bflo(unsigned w) { return __builtin_bit_cast(float, w << 16); }
__device__ __forceinline__ float bfhi(unsigned w) { return __builtin_bit_cast(float, w & 0xffff0000u); }
__device__ __forceinline__ float sigm1(float x) { return __builtin_amdgcn_rcpf(1.0f + __builtin_amdgcn_exp2f(-1.4426950408889634f * x)); }
__device__ __forceinline__ float silu1(float x) { return x * sigm1(x); }
__device__ __forceinline__ float gelu1(float x) { return 0.5f * x * (1.0f + erff(x * 0.70710678118654752f)); }
template <int X> __device__ __forceinline__ float sx(float v) { return __shfl_xor(v, X); }
__device__ __forceinline__ float sx32_add(float v) { return v + __shfl_xor(v, 32); }
__device__ __forceinline__ float sx32_max(float v) { return fmaxf(v, __shfl_xor(v, 32)); }
__device__ __forceinline__ float wave_sum(float v) { v += sx<1>(v); v += sx<2>(v); v += sx<4>(v); v += sx<8>(v); v += sx<16>(v); return sx32_add(v); }
__device__ __forceinline__ void unpack8(const v4u w, float* f) { f[0] = bflo(w.x); f[1] = bfhi(w.x); f[2] = bflo(w.y); f[3] = bfhi(w.y); f[4] = bflo(w.z); f[5] = bfhi(w.z); f[6] = bflo(w.w); f[7] = bfhi(w.w); }

#define XB_TMO      128
#define XB_XCNT(j)  (256  + 64 * (j))
#define XB_XSUB(j)  (1280 + 64 * (j))
#define XB_XGEN(j)  (2304 + 64 * (j))
#define XB_TOP      3328
#define XB_TOPGEN   3392
#define XCD_BAR_WORDS 3456
#define XB_SPIN_CAP (1u << 18)

__device__ __forceinline__ unsigned xb_ld(unsigned* p)              { return __hip_atomic_load(p, __ATOMIC_RELAXED, __HIP_MEMORY_SCOPE_AGENT); }
__device__ __forceinline__ unsigned xb_add(unsigned* p, unsigned v) { return __hip_atomic_fetch_add(p, v, __ATOMIC_RELAXED, __HIP_MEMORY_SCOPE_AGENT); }
__device__ __forceinline__ unsigned xb_xcc_id() { return (unsigned)__builtin_amdgcn_s_getreg((3 << 11) | 20) & 0xFu; }
#define XB_SPIN(cond, bar) do { unsigned _sp = 0; while (cond) { __builtin_amdgcn_s_sleep(1); \
    if ((++_sp & 255u) == 0u) { if (xb_ld(&(bar)[XB_TMO])) break; if (_sp > XB_SPIN_CAP) { atomicAdd(&(bar)[XB_TMO], 1u); break; } } } } while (0)

struct XcdBarrier {
    unsigned* bar; unsigned x;
    volatile LAS unsigned* st;
};

__device__ __forceinline__ XcdBarrier xcd_barrier_post(unsigned* bar, volatile LAS unsigned* st) {
    XcdBarrier b; b.bar = bar; b.x = xb_xcc_id(); b.st = st;
    if (threadIdx.x == 0) (void)xb_add(&bar[XB_XCNT(b.x)], 1u);
    return b;
}
__device__ __forceinline__ void xcd_barrier_complete(unsigned* bar, unsigned x, unsigned& nloc, unsigned& nx) {
    const unsigned G = gridDim.x * gridDim.y * gridDim.z;
    unsigned sum, cnt, mine, sp = 0u;
    for (;;) {
        sum = 0u; cnt = 0u; mine = 0u;
#pragma unroll
        for (unsigned j = 0; j < 16; ++j) { const unsigned c = xb_ld(&bar[XB_XCNT(j)]); sum += c; cnt += (c > 0u) ? 1u : 0u; mine = (j == x) ? c : mine; }
        if (sum == G) break;
        __builtin_amdgcn_s_sleep(1);
        if ((++sp & 255u) == 0u) { if (xb_ld(&bar[XB_TMO])) break; if (sp > XB_SPIN_CAP) { atomicAdd(&bar[XB_TMO], 1u); break; } }
    }
    nloc = mine > 0u ? mine : 1u; nx = cnt > 0u ? cnt : 1u;
}

__device__ __forceinline__ void xcd_barrier(const XcdBarrier& b, const int tid_in) {
    asm volatile("s_waitcnt vmcnt(0)" ::: "memory");
    __syncthreads();
    if (tid_in == 0) {
        unsigned* bar = b.bar;
        __builtin_amdgcn_s_waitcnt(0);
        unsigned nloc = b.st[0], nx = b.st[1];
        if (nloc == 0u) { xcd_barrier_complete(bar, b.x, nloc, nx); b.st[0] = nloc; b.st[1] = nx; }
        const unsigned old = xb_add(&bar[XB_XSUB(b.x)], 1u);
        const unsigned gen = old / nloc;
        if (old + 1u == (gen + 1u) * nloc) {
            __builtin_amdgcn_fence(__ATOMIC_RELEASE, "agent");
            asm volatile("s_waitcnt vmcnt(0)" ::: "memory");
            const unsigned og = xb_add(&bar[XB_TOP], 1u);
            const unsigned tg = og / nx;
            if (og + 1u == (tg + 1u) * nx) xb_add(&bar[XB_TOPGEN], 1u);
            else XB_SPIN(xb_ld(&bar[XB_TOPGEN]) == tg, bar);
            __builtin_amdgcn_fence(__ATOMIC_ACQUIRE, "agent");
            xb_add(&bar[XB_XGEN(b.x)], 1u);
            asm volatile("s_waitcnt vmcnt(0)" ::: "memory");
        } else {
            XB_SPIN(xb_ld(&bar[XB_XGEN(b.x)]) == gen, bar);
            __builtin_amdgcn_fence(__ATOMIC_ACQUIRE, "agent");
            asm volatile("s_waitcnt vmcnt(0)" ::: "memory");
        }
    }
    __syncthreads();
}


struct Args { const float* in[23]; float* out; unsigned char* ws; int ph_lo, ph_hi; };
typedef const __attribute__((address_space(4))) Args* KA;
#define KARGS() ({ KA p_ = (KA)__builtin_amdgcn_kernarg_segment_ptr(); asm volatile("" : "+s"(p_)); p_; })
enum { I_X = 0, I_C, I_CTX, I_CCTX, I_WADA, I_BADA, I_WIN, I_WOUT, I_QG, I_KG, I_SINK, I_HLB, I_HGAIN, I_GWS, I_GBS, I_GNG, I_FG, I_FU, I_FD, I_ROUTER, I_MG, I_MU, I_MDN };

__device__ __forceinline__ void transpose_item(const float* W, int K, int N, bf16* WT, int mode, LAS float* scr, int item, int lane) {
    const int nblk = N / 32, kb = item / nblk, nb = item % nblk, k0 = 64 * kb, n0 = 32 * nb;
#pragma unroll 8
    for (int i = 0; i < 32; ++i) { const int kk = 2 * i + (lane >> 5); scr[kk * 33 + (lane & 31)] = W[(size_t)(k0 + kk) * N + n0 + (lane & 31)]; }
    LDS_WAIT(); asm volatile("" ::: "memory");
    const int c = lane & 7;
#pragma unroll
    for (int j = 0; j < 4; ++j) { const int n = (lane >> 3) + 8 * j; const LAS float* s = scr + (8 * c) * 33 + n;
        v4u o; o.x = pk2(s[0 * 33], s[1 * 33]); o.y = pk2(s[2 * 33], s[3 * 33]); o.z = pk2(s[4 * 33], s[5 * 33]); o.w = pk2(s[6 * 33], s[7 * 33]);
        const int ng = n0 + n; const int drow = (mode == 0) ? ng : (ng + 128 * (ng / 128) + (mode == 2 ? 128 : 0));
        *(GAS v4u*)(WT + (size_t)drow * K + k0 + 8 * c) = o; }
    LDS_WAIT(); asm volatile("" ::: "memory");
}
constexpr int MOE_ITEMS = 24 * 16 * 112;
constexpr int MOE_DEFER = 3 * 5376;
__device__ __forceinline__ void moe_conv_item(KA a, int it, LAS float* scr, int lane) {
    constexpr int I_M = 16 * 112;
    unsigned char* ws = a->ws;
    const int idx = it / I_M, r = it % I_M;
    if (idx < 8) transpose_item(a->in[I_MG] + (size_t)idx * DM * EXD, DM, EXD, (bf16*)(ws + WS_MGU) + (size_t)idx * 2 * EXD * DM, 1, scr, r, lane);
    else if (idx < 16) transpose_item(a->in[I_MU] + (size_t)(idx - 8) * DM * EXD, DM, EXD, (bf16*)(ws + WS_MGU) + (size_t)(idx - 8) * 2 * EXD * DM, 2, scr, r, lane);
    else transpose_item(a->in[I_MDN] + (size_t)(idx - 16) * EXD * DM, EXD, DM, (bf16*)(ws + WS_MD) + (size_t)(idx - 16) * DM * EXD, 0, scr, r, lane);
}
__device__ __forceinline__ void moe_conv_slice(KA a, int s, int first, LAS unsigned char* lds, int lane, int wave, int G, int bid) {
    if (bid < first) return;
    LAS float* scr = (LAS float*)(lds + wave * 8704);
    const int nw = (G - first) * NWAVES, w = (bid - first) * NWAVES + wave, per = MOE_DEFER / 3;
    for (int i = w; i < per; i += nw) moe_conv_item(a, s * per + i, scr, lane);
}
__device__ __forceinline__ void p0_prologue(KA a, LAS unsigned char* lds, int tid, int lane, int wave, int G, int bid) {
    unsigned char* ws = a->ws;
    LAS float* scr = (LAS float*)(lds + wave * 8704);
    const int gw = bid * NWAVES + wave, NGW = G * NWAVES;
    constexpr int I_IN = 16 * 80, I_OUT = 16 * 32, I_F = 16 * 88, I_FDN = 44 * 32, I_M = 16 * 112;
    constexpr int NIT = 2 * I_IN + 2 * I_OUT + 2 * I_F + I_FDN + 24 * I_M;
    for (int it0 = gw; it0 < NIT; it0 += NGW) {
        int it = it0;
        if (it < 2 * I_IN) { const int l = it / I_IN, r = it % I_IN; transpose_item(a->in[I_WIN] + (size_t)l * DM * INW, DM, INW, (bf16*)(ws + WS_WIN) + (size_t)l * INW * DM, 0, scr, r, lane); continue; } it -= 2 * I_IN;
        if (it < 2 * I_OUT) { const int l = it / I_OUT, r = it % I_OUT; transpose_item(a->in[I_WOUT] + (size_t)l * DM * DM, DM, DM, (bf16*)(ws + WS_WOUT) + (size_t)l * DM * DM, 0, scr, r, lane); continue; } it -= 2 * I_OUT;
        if (it < I_F) { transpose_item(a->in[I_FG], DM, FFN, (bf16*)(ws + WS_WGU), 1, scr, it, lane); continue; } it -= I_F;
        if (it < I_F) { transpose_item(a->in[I_FU], DM, FFN, (bf16*)(ws + WS_WGU), 2, scr, it, lane); continue; } it -= I_F;
        if (it < I_FDN) { transpose_item(a->in[I_FD], FFN, DM, (bf16*)(ws + WS_WD), 0, scr, it, lane); continue; } it -= I_FDN;
        if (it >= MOE_DEFER) moe_conv_item(a, it, scr, lane);
    }
    LAS float* sil = (LAS float*)(lds + 69632);
    LAS float* part = (LAS float*)(lds + 69632 + 8192);
    float* vec = (float*)(ws + WS_VEC);
    if (bid < 192) {
        for (int i = tid; i < 2048; i += NTHR) { const float v = (i < 1024) ? a->in[I_C][i] : a->in[I_CCTX][i - 1024]; sil[i] = silu1(v); }
        __syncthreads();
        for (int item = bid; item < 192; item += G) {
            const int l = item / 96, cb = item % 96, col = cb * 64 + lane;
            const float* w = a->in[I_WADA] + (size_t)l * DM * 6144 + col;
            float a0 = 0.f, a1 = 0.f;
#pragma unroll 8
            for (int k = wave * 128; k < wave * 128 + 128; ++k) { const float wv = w[(size_t)k * 6144]; a0 += sil[k] * wv; a1 += sil[1024 + k] * wv; }
            part[(wave * 2 + 0) * 64 + lane] = a0; part[(wave * 2 + 1) * 64 + lane] = a1;
            __syncthreads();
            if (wave == 0) { float s0 = 0.f, s1 = 0.f;
#pragma unroll
                for (int w8 = 0; w8 < 8; ++w8) { s0 += part[(w8 * 2 + 0) * 64 + lane]; s1 += part[(w8 * 2 + 1) * 64 + lane]; }
                const float b = a->in[I_BADA][l * 6144 + col];
                vec[VO_MOD + (l * 2 + 0) * 6144 + col] = s0 + b; vec[VO_MOD + (l * 2 + 1) * 6144 + col] = s1 + b; }
            __syncthreads();
        }
    }
    for (int i = bid * NTHR + tid; i < C_CTX * DM / 4; i += G * NTHR) ((GAS f32x4*)(ws + WS_CTXR))[i] = ((const GAS f32x4*)a->in[I_CTX])[i];
    if (bid == G - 1) {
        for (int idx = tid; idx < 5120; idx += NTHR) {
            const int isc = idx >= 4096, j = isc ? idx - 4096 : idx, pos = j / 16, i = j % 16;
            const float inv = exp2f(-(float)i * 0.83048202372184059f);
            const float ang = (float)pos * inv;
            double r = (double)ang * 0.15915494309189535; r -= floor(r);
            const float rf = (float)r;
            const float cs = __builtin_amdgcn_cosf(rf), sn = __builtin_amdgcn_sinf(rf);
            float* t = vec + VO_ROPE + (isc ? 8192 : 0);
            const int n = isc ? 1024 : 4096;
            t[j] = cs; t[n + j] = sn;
        }
    }
}

__device__ __forceinline__ void norm_row(const float* xrow, const float* sc, const float* sh, bf16* orow, int lane, f32x4 (&h)[4]) {
    const GAS f32x4* xr = (const GAS f32x4*)xrow + lane;
    f32x4 v[4]; float s = 0.f;
#pragma unroll
    for (int j = 0; j < 4; ++j) { v[j] = xr[64 * j]; s += (v[j].x * v[j].x + v[j].y * v[j].y) + (v[j].z * v[j].z + v[j].w * v[j].w); }
    const float rstd = __builtin_amdgcn_rsqf(wave_sum(s) * (1.0f / DM) + EPS);
    GAS v2u* o8 = (GAS v2u*)orow + lane;
#pragma unroll
    for (int j = 0; j < 4; ++j) { const f32x4 scv = *(const f32x4*)(sc + 4 * lane + 256 * j), shv = *(const f32x4*)(sh + 4 * lane + 256 * j);
        h[j] = v[j] * rstd * (scv + 1.0f) + shv;
        v2u w; w.x = pk2(h[j].x, h[j].y); w.y = pk2(h[j].z, h[j].w); o8[64 * j] = w; }
}
__device__ __forceinline__ void phase_norm(KA a, int l, int which, int nrows, bf16* H, int lane, int wave, int G, int bid) {
    const float* vec = (const float*)(a->ws + WS_VEC);
    const float* xl = (l == 0 && which == 0) ? a->in[I_X] : a->out;
    const float* xc = (l == 0 && which == 0) ? a->in[I_CTX] : (const float*)(a->ws + WS_CTXR);
    const float* ml = vec + VO_MOD + (l * 2 + 0) * 6144 + which * 3072;
    const float* mc = vec + VO_MOD + (l * 2 + 1) * 6144 + which * 3072;
    const int gw = bid * NWAVES + wave, NGW = G * NWAVES;
    for (int r = gw; r < nrows; r += NGW) {
        const bool isc = r >= S_LAT; f32x4 h[4];
        norm_row(isc ? xc + (size_t)(r - S_LAT) * DM : xl + (size_t)r * DM, (isc ? mc : ml) + 1024, isc ? mc : ml, H + (size_t)r * DM, lane, h);
    }
}
__device__ __forceinline__ void phase_norm_route(KA a, LAS unsigned char* lds, int tid, int lane, int wave, int G, int bid) {
    const int l = 1;
    const float* vec = (const float*)(a->ws + WS_VEC);
    const float* ml = vec + VO_MOD + (l * 2 + 0) * 6144 + 3072;
    bf16* H = (bf16*)(a->ws + WS_H2B);
    LAS float* rt = (LAS float*)lds;
    volatile LAS unsigned* lcnt = (volatile LAS unsigned*)(lds + 32768);
    for (int i = tid; i < 8192; i += NTHR) rt[i] = a->in[I_ROUTER][i];
    if (tid < 16) lcnt[tid] = 0u;
    __syncthreads();
    int* tokinfo = (int*)(a->ws + WS_TOK);
    unsigned* cnt = (unsigned*)(a->ws + WS_CTL) + CW_MOECNT;
    const int gw = bid * NWAVES + wave, NGW = G * NWAVES;
    unsigned keep = 0u, pk0 = 0u; int itn = 0;
    for (int r = gw; r < S_LAT; r += NGW) {
        f32x4 h[4];
        norm_row(a->out + (size_t)r * DM, ml + 1024, ml, H + (size_t)r * DM, lane, h);
        float lg[8];
#pragma unroll
        for (int e = 0; e < 8; ++e) lg[e] = 0.f;
#pragma unroll
        for (int j = 0; j < 4; ++j)
#pragma unroll
            for (int i = 0; i < 4; ++i) { const int d = 4 * lane + 256 * j + i; const f32x4 r0 = *(const LAS f32x4*)(rt + d * 8), r1 = *(const LAS f32x4*)(rt + d * 8 + 4); const float hv = h[j][i];
                lg[0] += hv * r0.x; lg[1] += hv * r0.y; lg[2] += hv * r0.z; lg[3] += hv * r0.w; lg[4] += hv * r1.x; lg[5] += hv * r1.y; lg[6] += hv * r1.z; lg[7] += hv * r1.w; }
#pragma unroll
        for (int e = 0; e < 8; ++e) lg[e] = wave_sum(lg[e]);
        int i1 = 0; float v1 = lg[0];
#pragma unroll
        for (int e = 1; e < 8; ++e) if (lg[e] > v1) { v1 = lg[e]; i1 = e; }
        int i2 = -1; float v2 = -INFINITY;
#pragma unroll
        for (int e = 0; e < 8; ++e) if (e != i1 && lg[e] > v2) { v2 = lg[e]; i2 = e; }
        const float w1 = 1.0f / (1.0f + __expf(v2 - v1)), w2 = 1.0f - w1;
        if (lane == 0) {
            const unsigned r1 = __hip_atomic_fetch_add((LAS unsigned*)lcnt + i1, 1u, __ATOMIC_RELAXED, __HIP_MEMORY_SCOPE_WORKGROUP), r2 = __hip_atomic_fetch_add((LAS unsigned*)lcnt + i2, 1u, __ATOMIC_RELAXED, __HIP_MEMORY_SCOPE_WORKGROUP);
            int* ti = tokinfo + (size_t)r * 8;
            ti[0] = i1; ti[1] = i2; ti[4] = __builtin_bit_cast(int, w1); ti[5] = __builtin_bit_cast(int, w2);
            pk0 = (unsigned)i1 | ((unsigned)i2 << 3) | (r1 << 6) | (r2 << 19);
        }
        const unsigned pku = (unsigned)__builtin_amdgcn_readfirstlane((int)pk0);
        if (lane == itn) keep = pku;
        ++itn;
    }
    __syncthreads();
    if (tid < 8) lcnt[8 + tid] = __hip_atomic_fetch_add(cnt + 64 * tid, lcnt[tid], RLX_AGENT);
    __syncthreads();
    { const int r = gw + lane * NGW; if (lane < itn && r < S_LAT) { int* ti = tokinfo + (size_t)r * 8; const unsigned e1 = keep & 7u, e2 = (keep >> 3) & 7u; ti[2] = (int)(((keep >> 6) & 0x1fffu) + lcnt[8 + e1]); ti[3] = (int)((keep >> 19) + lcnt[8 + e2]); } }
}

__device__ __forceinline__ void qk_prep(KA a, int l, int first_thread, int nthreads) {
    bf16* PROJ = (bf16*)(a->ws + WS_PROJ);
    const float* rope = (const float*)(a->ws + WS_VEC) + VO_ROPE;
    for (int i = first_thread; i < R_ALL * 10; i += nthreads) {
        const int row = i / 10, hh = i % 10; const bool isq = hh < 8;
        bf16* p = PROJ + (size_t)row * INW + (isq ? hh * 64 : COL_AK + (hh - 8) * 64);
        const float* gain = (isq ? a->in[I_QG] : a->in[I_KG]) + l * 64;
        float x[64]; float ss = 0.f;
#pragma unroll
        for (int c = 0; c < 8; ++c) { const v4u w = *(const GAS v4u*)(p + 8 * c); unpack8(w, x + 8 * c); }
#pragma unroll
        for (int d = 0; d < 64; ++d) ss += x[d] * x[d];
        const float rstd = __builtin_amdgcn_rsqf(ss * (1.0f / 64.0f) + EPS);
        const f32x4* g4 = (const f32x4*)gain;
#pragma unroll
        for (int c = 0; c < 16; ++c) { const f32x4 gv = g4[c]; x[4 * c] *= rstd * gv.x; x[4 * c + 1] *= rstd * gv.y; x[4 * c + 2] *= rstd * gv.z; x[4 * c + 3] *= rstd * gv.w; }
        if (row < S_LAT) {
            const int gr = row >> 6, gc = row & 63;
            const f32x4* cr = (const f32x4*)(rope + gr * 16); const f32x4* sr = (const f32x4*)(rope + 4096 + gr * 16); const f32x4* cc = (const f32x4*)(rope + 8192 + gc * 16); const f32x4* sc = (const f32x4*)(rope + 8192 + 1024 + gc * 16);
#pragma unroll
            for (int j4 = 0; j4 < 4; ++j4) { const f32x4 cv = cr[j4], sv = sr[j4];
#pragma unroll
                for (int i = 0; i < 4; ++i) { const int j = 4 * j4 + i; const float x1 = x[j], x2 = x[16 + j]; x[j] = x1 * cv[i] - x2 * sv[i]; x[16 + j] = x1 * sv[i] + x2 * cv[i]; } }
#pragma unroll
            for (int j4 = 0; j4 < 4; ++j4) { const f32x4 cv = cc[j4], sv = sc[j4];
#pragma unroll
                for (int i = 0; i < 4; ++i) { const int j = 4 * j4 + i; const float x1 = x[32 + j], x2 = x[48 + j]; x[32 + j] = x1 * cv[i] - x2 * sv[i]; x[48 + j] = x1 * sv[i] + x2 * cv[i]; } }
        }
        const float qs = isq ? 0.125f * 1.4426950408889634f : 1.0f;
#pragma unroll
        for (int c = 0; c < 8; ++c) { v4u w; w.x = pk2(x[8 * c] * qs, x[8 * c + 1] * qs); w.y = pk2(x[8 * c + 2] * qs, x[8 * c + 3] * qs); w.z = pk2(x[8 * c + 4] * qs, x[8 * c + 5] * qs); w.w = pk2(x[8 * c + 6] * qs, x[8 * c + 7] * qs);
            *(GAS v4u*)(p + 8 * c) = w; }
    }
}
__device__ __forceinline__ void gmlp_unit(KA a, int l, int chunk, int g, LAS unsigned char* lds, int tid, int lane, int wave) {
    const bf16* PROJ = (const bf16*)(a->ws + WS_PROJ); bf16* MIX = (bf16*)(a->ws + WS_MIX);
    const int row0 = (chunk < 128) ? chunk * 128 : S_LAT + (chunk - 128) * 128;
    LAS float* vn = (LAS float*)lds;
    { const int pos = tid >> 2, part = tid & 3;
      const bf16* p = PROJ + (size_t)(row0 + pos) * INW + COL_GV + g * 64 + part * 16;
      float x[16]; unpack8(*(const GAS v4u*)p, x); unpack8(*(const GAS v4u*)(p + 8), x + 8);
      float ss = 0.f;
#pragma unroll
      for (int d = 0; d < 16; ++d) { x[d] = gelu1(x[d]); ss += x[d] * x[d]; }
      ss += sx<1>(ss); ss += sx<2>(ss);
      const float rstd = __builtin_amdgcn_rsqf(ss * (1.0f / 64.0f) + EPS);
      const float* gn = a->in[I_GNG] + l * 256 + g * 64 + part * 16;
#pragma unroll
      for (int d = 0; d < 16; ++d) vn[pos * 64 + part * 16 + d] = x[d] * rstd * gn[d]; }
    __syncthreads();
    const int c = lane, t0 = wave * 16;
    const float* W = a->in[I_GWS] + ((size_t)(l * 4 + g) * 128 + t0) * 128;
    float acc[16];
#pragma unroll
    for (int i = 0; i < 16; ++i) acc[i] = 0.f;
    for (int s = 0; s < 128; ++s) { const float v = vn[s * 64 + c];
#pragma unroll
        for (int i = 0; i < 16; ++i) acc[i] += W[i * 128 + s] * v; }
    const float* bs = a->in[I_GBS] + (l * 4 + g) * 128 + t0;
#pragma unroll
    for (int i = 0; i < 16; ++i) { const int row = row0 + t0 + i;
        const float u = gelu1(bflo((unsigned)PROJ[(size_t)row * INW + COL_GU + g * 64 + c]));
        MIX[(size_t)row * DM + MIX_GM + g * 64 + c] = (bf16)f2bf(u * (acc[i] + bs[i])); }
    __syncthreads();
}
__device__ __forceinline__ void hgrn_naive(KA a, int l, int dir, int head, LAS unsigned char* lds, int tid, int lane, int wave) {
    const bf16* PROJ = (const bf16*)(a->ws + WS_PROJ);
    float* HGO = (float*)(a->ws + WS_HGO) + (size_t)dir * R_ALL * 256;
    LAS float* Qs = (LAS float*)lds;
    LAS float* Fs = Qs + 4096; LAS float* Vs = Fs + 4096; LAS float* part = Vs + 4096;
    const int v = lane, kg = wave;
    float S[8];
#pragma unroll
    for (int i = 0; i < 8; ++i) S[i] = 0.f;
    const int tl = tid >> 3, c8 = tid & 7;
    float lb[8];
#pragma unroll
    for (int j = 0; j < 8; ++j) { float b = 0.f; if (l == 1) { const float p0 = a->in[I_HLB][dir * 512 + head * 64 + c8 * 8 + j], p1 = a->in[I_HLB][dir * 512 + 256 + head * 64 + c8 * 8 + j]; b = 1.0f / (1.0f + __expf(p0 - p1)); } lb[j] = b; }
    const int fcol = (dir == 0 ? COL_HFF : COL_HFB) + head * 64 + c8 * 8;
    for (int n0 = 0; n0 < R_ALL; n0 += 64) {
        { const int n = n0 + tl; int row;
          if (dir == 0) row = (n < C_CTX) ? S_LAT + n : n - C_CTX; else row = (n < C_CTX) ? S_LAT + (C_CTX - 1 - n) : (S_LAT - 1) - (n - C_CTX);
          const bf16* pr = PROJ + (size_t)row * INW;
          float q[8], f[8], vv[8];
          unpack8(*(const GAS v4u*)(pr + COL_HQ + head * 64 + c8 * 8), q); unpack8(*(const GAS v4u*)(pr + fcol), f); unpack8(*(const GAS v4u*)(pr + COL_HI + head * 64 + c8 * 8), vv);
#pragma unroll
          for (int j = 0; j < 8; ++j) { Qs[tl * 64 + c8 * 8 + j] = silu1(q[j]) * 0.125f; Fs[tl * 64 + c8 * 8 + j] = lb[j] + (1.0f - lb[j]) * sigm1(f[j]); Vs[tl * 64 + c8 * 8 + j] = vv[j]; } }
        __syncthreads();
        for (int t = 0; t < 64; ++t) {
            const float vt = Vs[t * 64 + v]; float po = 0.f;
#pragma unroll
            for (int i = 0; i < 8; ++i) { const float f = Fs[t * 64 + kg * 8 + i], q = Qs[t * 64 + kg * 8 + i]; S[i] = f * S[i] + (1.0f - f) * vt; po += S[i] * q; }
            part[((t & 1) * 8 + kg) * 64 + v] = po;
            __syncthreads();
            if (wave == 0) { float o = 0.f;
#pragma unroll
                for (int w8 = 0; w8 < 8; ++w8) o += part[((t & 1) * 8 + w8) * 64 + v];
                const int n = n0 + t; int row;
                if (dir == 0) row = (n < C_CTX) ? S_LAT + n : n - C_CTX; else row = (n < C_CTX) ? S_LAT + (C_CTX - 1 - n) : (S_LAT - 1) - (n - C_CTX);
                HGO[(size_t)row * 256 + head * 64 + v] = o; }
        }
        __syncthreads();
    }
}

typedef short bf16x8v __attribute__((ext_vector_type(8)));
constexpr int HST = 72;
__device__ __forceinline__ f32x4 mma16(const LAS bf16* MA, const LAS bf16* MBt, int k0, f32x4 c, int lane) {
    const bf16x8v av = *(const LAS bf16x8v*)(MA + (lane & 15) * HST + k0 + 8 * (lane >> 4));
    const bf16x8v bv = *(const LAS bf16x8v*)(MBt + (lane & 15) * HST + k0 + 8 * (lane >> 4));
    return __builtin_amdgcn_mfma_f32_16x16x32_bf16(av, bv, c, 0, 0, 0);
}
__device__ __forceinline__ int hg_base_row(int cpos) { return cpos < 256 ? 64 * cpos : S_LAT + 64 * (cpos - 256); }
__device__ __forceinline__ int hg_scan_idx(int dir, int cpos) { return dir == 0 ? (cpos < 256 ? 4 + cpos : cpos - 256) : (cpos < 256 ? 4 + (255 - cpos) : 3 - (cpos - 256)); }
__device__ __forceinline__ float hg_lb(KA a, int l, int dir, int head, int k) {
    if (l == 0) return 0.f;
    const float p0 = a->in[I_HLB][dir * 512 + head * 64 + k], p1 = a->in[I_HLB][dir * 512 + 256 + head * 64 + k];
    return 1.0f / (1.0f + __expf(p0 - p1));
}
__device__ __forceinline__ void hgrn_stepA(KA a, int l, int cpos, int head, LAS unsigned char* lds, int lane, int wave) {
    const bf16* PROJ = (const bf16*)(a->ws + WS_PROJ);
    const int dir = wave >> 2, I = wave & 3, base = hg_base_row(cpos), ci = hg_scan_idx(dir, cpos);
    LAS float* TOT = (LAS float*)lds;
    LAS bf16* KLT = (LAS bf16*)(lds + 2048) + dir * 64 * HST;
    LAS bf16* VT = (LAS bf16*)(lds + 2048 + 2 * 64 * HST * 2) + dir * 64 * HST;
    const float lb = hg_lb(a, l, dir, head, lane);
    const int fcol = (dir == 0 ? COL_HFF : COL_HFB) + head * 64 + lane, vcol = COL_HI + head * 64 + lane;
    float kk[16], cl[16]; float run = 0.f;
#pragma unroll
    for (int i = 0; i < 16; ++i) { const int n = 16 * I + i, row = base + (dir ? 63 - n : n);
        const float fl = bflo((unsigned)PROJ[(size_t)row * INW + fcol]);
        const unsigned short vb = PROJ[(size_t)row * INW + vcol];
        const float f = lb + (1.0f - lb) * sigm1(fl);
        run += __logf(f); cl[i] = run; kk[i] = 1.0f - f;
        VT[lane * HST + n] = vb; }
    TOT[(dir * 4 + I) * 64 + lane] = run;
    __syncthreads();
    float post = 0.f, all = 0.f;
#pragma unroll
    for (int J = 0; J < 4; ++J) { const float t = TOT[(dir * 4 + J) * 64 + lane]; all += t; if (J > I) post += t; }
#pragma unroll
    for (int i = 0; i < 16; ++i) KLT[lane * HST + 16 * I + i] = (bf16)f2bf(kk[i] * __expf(run - cl[i] + post));
    if (I == 0) ((float*)(a->ws + WS_HDG))[((size_t)(dir * 4 + head) * 260 + ci) * 64 + lane] = __expf(all);
    __syncthreads();
    float* LT = (float*)(a->ws + WS_HLT) + ((size_t)(dir * 4 + head) * 260 + ci) * 4096;
    float z0 = 0.f; asm volatile("" : "+v"(z0));
#pragma unroll
    for (int kb = 0; kb < 4; ++kb) { f32x4 acc = {z0, z0, z0, z0};
        acc = mma16(VT + 16 * I * HST, KLT + 16 * kb * HST, 0, acc, lane); acc = mma16(VT + 16 * I * HST, KLT + 16 * kb * HST, 32, acc, lane);
#pragma unroll
        for (int r = 0; r < 4; ++r) LT[(16 * I + 4 * (lane >> 4) + r) * 64 + 16 * kb + (lane & 15)] = acc[r]; }
    __syncthreads();
}
__device__ __forceinline__ void hgrn_stepB(KA a, int item, int tid) {
    const int dh = item >> 3, vb = item & 7, v = vb * 8 + (tid >> 6), k = tid & 63;
    const float* LT = (const float*)(a->ws + WS_HLT) + (size_t)dh * 260 * 4096 + v * 64 + k;
    const float* DG = (const float*)(a->ws + WS_HDG) + (size_t)dh * 260 * 64 + k;
    bf16* SP = (bf16*)(a->ws + WS_HSP) + (size_t)dh * 260 * 4096 + v * 64 + k;
    float S = 0.f;
#pragma unroll 1
    for (int c0 = 0; c0 < 260; c0 += 26) {
        float lt[26], dg[26];
#pragma unroll
        for (int j = 0; j < 26; ++j) { lt[j] = LT[(size_t)(c0 + j) * 4096]; dg[j] = DG[(c0 + j) * 64]; }
#pragma unroll
        for (int j = 0; j < 26; ++j) { SP[(size_t)(c0 + j) * 4096] = (bf16)f2bf(S); S = dg[j] * S + lt[j]; }
    }
}
__device__ __forceinline__ void hgrn_stepC(KA a, int l, int cpos, int head, LAS unsigned char* lds, int tid, int lane, int wave) {
    const bf16* PROJ = (const bf16*)(a->ws + WS_PROJ); bf16* MIX = (bf16*)(a->ws + WS_MIX);
    const int dir = wave >> 2, I = wave & 3, base = hg_base_row(cpos), ci = hg_scan_idx(dir, cpos);
    constexpr int MSZ = 64 * HST;
    LAS float* TOT = (LAS float*)lds;
    LAS bf16* img = (LAS bf16*)(lds + 2048);
    LAS bf16* QT = img + dir * MSZ;
    LAS bf16* QD = img + 2 * MSZ + dir * MSZ;
    LAS bf16* VT = img + 4 * MSZ + dir * MSZ;
    LAS bf16* ST = img + 6 * MSZ + dir * MSZ;
    LAS bf16* AS = img + 8 * MSZ + dir * MSZ + I * 16 * HST;
    LAS bf16* KT = img + 10 * MSZ + dir * (10 * 16 * HST);
    LAS float* OS = (LAS float*)(img + 10 * MSZ);
    const float lb = hg_lb(a, l, dir, head, lane);
    const int fcol = (dir == 0 ? COL_HFF : COL_HFB) + head * 64 + lane, qcol = COL_HQ + head * 64 + lane, vcol = COL_HI + head * 64 + lane;
    { const bf16* SP = (const bf16*)(a->ws + WS_HSP) + ((size_t)(dir * 4 + head) * 260 + ci) * 4096;
#pragma unroll
      for (int h2 = 0; h2 < 2; ++h2) { const int e = ((I * 2 + h2) * 64 + lane) * 8, vv = e >> 6, kk0 = e & 63;
          *(LAS v4u*)(ST + vv * HST + kk0) = *(const GAS v4u*)(SP + e); } }
    float kk[16], cl[16], qv[16]; float run = 0.f;
#pragma unroll
    for (int i = 0; i < 16; ++i) { const int n = 16 * I + i, row = base + (dir ? 63 - n : n);
        const float fl = bflo((unsigned)PROJ[(size_t)row * INW + fcol]), ql = bflo((unsigned)PROJ[(size_t)row * INW + qcol]);
        const unsigned short vb = PROJ[(size_t)row * INW + vcol];
        const float f = lb + (1.0f - lb) * sigm1(fl);
        run += __logf(f); cl[i] = run; kk[i] = 1.0f - f; qv[i] = silu1(ql) * 0.125f;
        VT[lane * HST + n] = vb; }
    TOT[(dir * 4 + I) * 64 + lane] = run;
    __syncthreads();
    float tj[4];
#pragma unroll
    for (int J = 0; J < 4; ++J) tj[J] = TOT[(dir * 4 + J) * 64 + lane];
    float pre = 0.f;
#pragma unroll
    for (int J = 0; J < 4; ++J) if (J < I) pre += tj[J];
#pragma unroll
    for (int i = 0; i < 16; ++i) { const float e = __expf(cl[i]); QT[(16 * I + i) * HST + lane] = (bf16)f2bf(qv[i] * e); QD[(16 * I + i) * HST + lane] = (bf16)f2bf(qv[i] * e * __expf(pre)); }
    float eoff = 0.f;
#pragma unroll
    for (int I2 = 0; I2 < 4; ++I2) {
        if (I2 >= I) {
            if (I2 == I) eoff = 0.f; else if (I2 == I + 1) eoff = run; else eoff += tj[I2 - 1];
            LAS bf16* blk = KT + (I2 * (I2 + 1) / 2 + I) * 16 * HST;
#pragma unroll
            for (int i = 0; i < 16; ++i) blk[i * HST + lane] = (bf16)f2bf(kk[i] * __expf(fminf(eoff - cl[i], 80.0f)));
        }
    }
    __syncthreads();
    float z0 = 0.f; asm volatile("" : "+v"(z0));
    f32x4 sc[4];
#pragma unroll
    for (int J = 0; J < 4; ++J) { sc[J] = (f32x4){z0, z0, z0, z0};
        if (J <= I) { const LAS bf16* kb = KT + (I * (I + 1) / 2 + J) * 16 * HST;
            sc[J] = mma16(QT + 16 * I * HST, kb, 0, sc[J], lane); sc[J] = mma16(QT + 16 * I * HST, kb, 32, sc[J], lane);
            if (J == I) {
#pragma unroll
                for (int r = 0; r < 4; ++r) if ((lane & 15) > 4 * (lane >> 4) + r) sc[J][r] = z0; } } }
#pragma unroll
    for (int J = 0; J < 4; ++J)
#pragma unroll
        for (int r = 0; r < 4; ++r) AS[(4 * (lane >> 4) + r) * HST + 16 * J + (lane & 15)] = (bf16)f2bf(sc[J][r]);
    asm volatile("s_waitcnt lgkmcnt(0)" ::: "memory");
    f32x4 acc[4];
#pragma unroll
    for (int vb = 0; vb < 4; ++vb) { acc[vb] = (f32x4){z0, z0, z0, z0};
        acc[vb] = mma16(AS, VT + 16 * vb * HST, 0, acc[vb], lane); acc[vb] = mma16(AS, VT + 16 * vb * HST, 32, acc[vb], lane);
        acc[vb] = mma16(QD + 16 * I * HST, ST + 16 * vb * HST, 0, acc[vb], lane); acc[vb] = mma16(QD + 16 * I * HST, ST + 16 * vb * HST, 32, acc[vb], lane); }
    __syncthreads();
#pragma unroll
    for (int vb = 0; vb < 4; ++vb)
#pragma unroll
        for (int r = 0; r < 4; ++r) { const int n = 16 * I + 4 * (lane >> 4) + r, rl = dir ? 63 - n : n; OS[(dir * 64 + rl) * 68 + 16 * vb + (lane & 15)] = acc[vb][r]; }
    __syncthreads();
    { const int rl = tid >> 3, v8 = (tid & 7) * 8, row = base + rl;
      float o[8]; float ss = 0.f;
#pragma unroll
      for (int j = 0; j < 8; ++j) { o[j] = OS[rl * 68 + v8 + j] + OS[(64 + rl) * 68 + v8 + j]; ss += o[j] * o[j]; }
      ss += sx<1>(ss); ss += sx<2>(ss); ss += sx<4>(ss);
      const float rstd = __builtin_amdgcn_rsqf(ss * (1.0f / 64.0f) + EPS);
      float gt[8]; unpack8(*(const GAS v4u*)(PROJ + (size_t)row * INW + COL_HG + head * 64 + v8), gt);
      const float* gn = a->in[I_HGAIN] + l * 64 + v8;
      float y[8];
#pragma unroll
      for (int j = 0; j < 8; ++j) y[j] = o[j] * rstd * gn[j] * silu1(gt[j]);
      v4u w; w.x = pk2(y[0], y[1]); w.y = pk2(y[2], y[3]); w.z = pk2(y[4], y[5]); w.w = pk2(y[6], y[7]);
      *(GAS v4u*)(MIX + (size_t)row * DM + MIX_HG + head * 64 + v8) = w; }
    __syncthreads();
}

__device__ __forceinline__ void vt_item(KA a, int item, int lane) {
    const bf16* PROJ = (const bf16*)(a->ws + WS_PROJ); bf16* VTg = (bf16*)(a->ws + WS_VT);
    const int rb = item >> 1, hk = item & 1, row = rb * 64 + lane;
    const bf16* p = PROJ + (size_t)row * INW + COL_AV + hk * 64;
    unsigned w[32];
#pragma unroll
    for (int c = 0; c < 8; ++c) { const v4u t = *(const GAS v4u*)(p + 8 * c); w[4 * c] = t.x; w[4 * c + 1] = t.y; w[4 * c + 2] = t.z; w[4 * c + 3] = t.w; }
    bf16* o = VTg + (size_t)hk * 64 * R_ALL + row;
#pragma unroll
    for (int d2 = 0; d2 < 32; ++d2) { o[(size_t)(2 * d2) * R_ALL] = (bf16)(w[d2] & 0xffffu); o[(size_t)(2 * d2 + 1) * R_ALL] = (bf16)(w[d2] >> 16); }
}
__device__ __forceinline__ void attn_unit(KA a, int l, int u, LAS unsigned char* lds, int tid, int lane, int wave) {
    asm volatile("" : "+v"(tid), "+v"(lane));
    const bf16* PROJ = (const bf16*)(a->ws + WS_PROJ); const bf16* VTg = (const bf16*)(a->ws + WS_VT); bf16* MIX = (bf16*)(a->ws + WS_MIX);
    const bool isctx = u >= 256; const int uu = isctx ? u - 256 : u; const int n = uu >> 1, hk = uu & 1;
    const int qh = hk * 4 + (wave >> 1), half = wave & 1;
    const int qbase = (isctx ? S_LAT : 0) + n * 128 + half * 64, qpos0 = n * 128 + half * 64;
    const int c = lane & 15, g = lane >> 4;
    LAS bf16* Kt = (LAS bf16*)lds; LAS bf16* Vt = Kt + 64 * HST; LAS bf16* Qw = Vt + 64 * HST + wave * 64 * HST;
#pragma unroll
    for (int j = 0; j < 8; ++j) { const int qr = 8 * j + (lane >> 3), qc = (lane & 7) * 8;
        *(LAS v4u*)(Qw + qr * HST + qc) = *(const GAS v4u*)(PROJ + (size_t)(qbase + qr) * INW + qh * 64 + qc); }
    float z0 = 0.f; asm volatile("" : "+v"(z0));
    f32x4 o[4][4]; float ls[4];
    float gq = 0.f, gk = 0.f;
#pragma unroll 8
    for (int d = 0; d < 64; ++d) { gq = fmaxf(gq, fabsf(a->in[I_QG][l * 64 + d])); gk = fmaxf(gk, fabsf(a->in[I_KG][l * 64 + d])); }
    const float nbnd = -(8.0f * 1.4426950408889634f) * gq * gk;
    const float sink = a->in[I_SINK][l * 8 + qh] * 1.4426950408889634f;
#pragma unroll
    for (int qt = 0; qt < 4; ++qt) { ls[qt] = (g == 0) ? __builtin_amdgcn_exp2f(sink + nbnd) : z0;
#pragma unroll
        for (int dt = 0; dt < 4; ++dt) o[qt][dt] = (f32x4){z0, z0, z0, z0}; }
    const int first = (!isctx && n == 0) ? 2 : 0, nwin = isctx ? 0 : ((n == 0 || n == 127) ? 4 : 6), nt = nwin + 4;
    const int lr = tid >> 3, lc = (tid & 7) * 8;
    v4u kreg, vreg;
#define ATT_LOADT(i) do { const bool ct_ = (i) >= nwin; const int kb_ = ct_ ? S_LAT + 64 * ((i) - nwin) : (n - 1) * 128 + 64 * (first + (i)); \
        kreg = *(const GAS v4u*)(PROJ + (size_t)(kb_ + lr) * INW + COL_AK + hk * 64 + lc); vreg = *(const GAS v4u*)(VTg + ((size_t)hk * 64 + lr) * R_ALL + kb_ + lc); } while (0)
    ATT_LOADT(0);
#pragma unroll 1
    for (int i = 0; i < nt; ++i) {
        __syncthreads();
        *(LAS v4u*)(Kt + lr * HST + lc) = kreg; *(LAS v4u*)(Vt + lr * HST + lc) = vreg;
        __syncthreads();
        if (i + 1 < nt) ATT_LOADT(i + 1);
        const bool win = i < nwin; const int kb = (n - 1) * 128 + 64 * (first + i);
        bf16x8v kf[4][2], vf[4][2];
#pragma unroll
        for (int kt = 0; kt < 4; ++kt)
#pragma unroll
            for (int ks = 0; ks < 2; ++ks) kf[kt][ks] = *(const LAS bf16x8v*)(Kt + (16 * kt + c) * HST + 32 * ks + 8 * g);
#pragma unroll
        for (int dt = 0; dt < 4; ++dt)
#pragma unroll
            for (int s2 = 0; s2 < 2; ++s2) { const v2u lo = *(const LAS v2u*)(Vt + (16 * dt + c) * HST + 32 * s2 + 4 * g), hi = *(const LAS v2u*)(Vt + (16 * dt + c) * HST + 32 * s2 + 16 + 4 * g);
                const v4u t = {lo.x, lo.y, hi.x, hi.y}; vf[dt][s2] = __builtin_bit_cast(bf16x8v, t); }
#pragma unroll
        for (int qt = 0; qt < 4; ++qt) {
            f32x4 s[4];
            const bf16x8v q0 = *(const LAS bf16x8v*)(Qw + (16 * qt + c) * HST + 8 * g), q1 = *(const LAS bf16x8v*)(Qw + (16 * qt + c) * HST + 32 + 8 * g);
#pragma unroll
            for (int kt = 0; kt < 4; ++kt) { s[kt] = (f32x4){nbnd, nbnd, nbnd, nbnd};
                s[kt] = __builtin_amdgcn_mfma_f32_16x16x32_bf16(kf[kt][0], q0, s[kt], 0, 0, 0); s[kt] = __builtin_amdgcn_mfma_f32_16x16x32_bf16(kf[kt][1], q1, s[kt], 0, 0, 0); }
            if (win) { const int dq = qpos0 + 16 * qt + c - kb - 4 * g;
#pragma unroll
                for (int kt = 0; kt < 4; ++kt)
#pragma unroll
                    for (int r = 0; r < 4; ++r) { const int dl = dq - 16 * kt - r; if (dl > 128 || dl < -128) s[kt][r] = -INFINITY; } }
            float ps = 0.f;
#pragma unroll
            for (int kt = 0; kt < 4; ++kt)
#pragma unroll
                for (int r = 0; r < 4; ++r) { s[kt][r] = __builtin_amdgcn_exp2f(s[kt][r]); ps += s[kt][r]; }
            ls[qt] += ps;
            bf16x8v pb[2];
#pragma unroll
            for (int s2 = 0; s2 < 2; ++s2) { const v4u t = {pk2(s[2 * s2][0], s[2 * s2][1]), pk2(s[2 * s2][2], s[2 * s2][3]), pk2(s[2 * s2 + 1][0], s[2 * s2 + 1][1]), pk2(s[2 * s2 + 1][2], s[2 * s2 + 1][3])};
                pb[s2] = __builtin_bit_cast(bf16x8v, t); }
#pragma unroll
            for (int dt = 0; dt < 4; ++dt) { o[qt][dt] = __builtin_amdgcn_mfma_f32_16x16x32_bf16(vf[dt][0], pb[0], o[qt][dt], 0, 0, 0); o[qt][dt] = __builtin_amdgcn_mfma_f32_16x16x32_bf16(vf[dt][1], pb[1], o[qt][dt], 0, 0, 0); }
        }
    }
#undef ATT_LOADT
    int c2 = lane & 15, g2 = lane >> 4; asm volatile("" : "+v"(c2), "+v"(g2));
#pragma unroll
    for (int qt = 0; qt < 4; ++qt) { float lt = ls[qt]; lt += sx<16>(lt); lt = sx32_add(lt); const float inv = 1.0f / lt;
        bf16* op = (bf16*)(a->ws + WS_MIX) + (size_t)(qbase + 16 * qt + c2) * DM + MIX_AT + qh * 64 + 4 * g2;
#pragma unroll
        for (int dt = 0; dt < 4; ++dt) { v2u w; w.x = pk2(o[qt][dt][0] * inv, o[qt][dt][1] * inv); w.y = pk2(o[qt][dt][2] * inv, o[qt][dt][3] * inv); *(GAS v2u*)(op + 16 * dt) = w; } }
}

constexpr int GST = 136;
__device__ __forceinline__ f32x4 mma16g(const LAS bf16* MA, const LAS bf16* MBt, int k0, f32x4 c, int lane) {
    const bf16x8v av = *(const LAS bf16x8v*)(MA + (lane & 15) * GST + k0 + 8 * (lane >> 4));
    const bf16x8v bv = *(const LAS bf16x8v*)(MBt + (lane & 15) * GST + k0 + 8 * (lane >> 4));
    return __builtin_amdgcn_mfma_f32_16x16x32_bf16(av, bv, c, 0, 0, 0);
}
__device__ __forceinline__ float gelu_as(float v) {
    const float av = fabsf(v), t = __builtin_amdgcn_rcpf(av * 0.2316418882f + 1.0f);
    float q = t * 0.5307027145f + (-0.7265760135f); q = q * t + 0.7107068705f; q = q * t + (-0.142248368f); q = q * t + 0.127414796f; q = q * t;
    const float e = __builtin_amdgcn_exp2f((v * v) * (-0.72134752044f)), mm = v * (q * e);
    return v < 0.f ? mm : v - mm;
}
__device__ __forceinline__ void gmlp_unit_mma(KA a, int l, int chunk, int g, LAS unsigned char* lds, int tid, int lane, int wave) {
    const bf16* PROJ = (const bf16*)(a->ws + WS_PROJ); bf16* MIX = (bf16*)(a->ws + WS_MIX);
    const int row0 = (chunk < 128) ? chunk * 128 : S_LAT + (chunk - 128) * 128;
    LAS bf16* WA = (LAS bf16*)lds;
    LAS bf16* VNT = WA + 128 * GST;
    LAS float* OUT = (LAS float*)(VNT + 64 * GST);
    const int pos = tid >> 2, part = tid & 3;
    {
      const float* W = a->in[I_GWS] + ((size_t)(l * 4 + g) * 128 + pos) * 128 + part * 32;
#pragma unroll
      for (int j = 0; j < 4; ++j) { const f32x4 w0 = *(const GAS f32x4*)(W + 8 * j), w1 = *(const GAS f32x4*)(W + 8 * j + 4);
          v4u o; o.x = pk2(w0.x, w0.y); o.y = pk2(w0.z, w0.w); o.z = pk2(w1.x, w1.y); o.w = pk2(w1.z, w1.w);
          *(LAS v4u*)(WA + pos * GST + part * 32 + 8 * j) = o; } }
    { const bf16* p = PROJ + (size_t)(row0 + pos) * INW + COL_GV + g * 64 + part * 16;
      float x[16]; unpack8(*(const GAS v4u*)p, x); unpack8(*(const GAS v4u*)(p + 8), x + 8);
      float ss = 0.f;
#pragma unroll
      for (int d = 0; d < 16; ++d) { x[d] = gelu_as(x[d]); ss += x[d] * x[d]; }
      ss += sx<1>(ss); ss += sx<2>(ss);
      const float rstd = __builtin_amdgcn_rsqf(ss * (1.0f / 64.0f) + EPS);
      const float* gn = a->in[I_GNG] + l * 256 + g * 64 + part * 16;
#pragma unroll
      for (int d = 0; d < 16; ++d) VNT[(part * 16 + d) * GST + pos] = (bf16)f2bf(x[d] * rstd * gn[d]); }
    __syncthreads();
    float z0 = 0.f; asm volatile("" : "+v"(z0));
#pragma unroll
    for (int cb = 0; cb < 4; ++cb) { f32x4 acc = {z0, z0, z0, z0};
#pragma unroll
        for (int ks = 0; ks < 4; ++ks) acc = mma16g(WA + 16 * wave * GST, VNT + 16 * cb * GST, 32 * ks, acc, lane);
#pragma unroll
        for (int r = 0; r < 4; ++r) OUT[(16 * wave + 4 * (lane >> 4) + r) * 68 + 16 * cb + (lane & 15)] = acc[r]; }
    __syncthreads();
    { const int row = row0 + pos; const float bsv = a->in[I_GBS][(l * 4 + g) * 128 + pos];
      const bf16* pu = PROJ + (size_t)row * INW + COL_GU + g * 64 + part * 16;
      float u[16]; unpack8(*(const GAS v4u*)pu, u); unpack8(*(const GAS v4u*)(pu + 8), u + 8);
      float y[16];
#pragma unroll
      for (int d = 0; d < 16; ++d) y[d] = gelu_as(u[d]) * (OUT[pos * 68 + part * 16 + d] + bsv);
      bf16* po = MIX + (size_t)row * DM + MIX_GM + g * 64 + part * 16;
      v4u w; w.x = pk2(y[0], y[1]); w.y = pk2(y[2], y[3]); w.z = pk2(y[4], y[5]); w.w = pk2(y[6], y[7]); *(GAS v4u*)po = w;
      w.x = pk2(y[8], y[9]); w.y = pk2(y[10], y[11]); w.z = pk2(y[12], y[13]); w.w = pk2(y[14], y[15]); *(GAS v4u*)(po + 8) = w; }
    __syncthreads();
}
__device__ __forceinline__ void attn_naive(KA a, int l, int nrows, int lane, int wave, int G, int bid) {
    const bf16* PROJ = (const bf16*)(a->ws + WS_PROJ); bf16* MIX = (bf16*)(a->ws + WS_MIX);
    const int gw = bid * NWAVES + wave, NGW = G * NWAVES;
    for (int pair = gw; pair < nrows * 2; pair += NGW) {
        const int row = pair >> 1, hk = pair & 1; const bool isctx = row >= S_LAT;
        float q[4], o[4], m[4], ls[4];
#pragma unroll
        for (int g = 0; g < 4; ++g) { q[g] = bflo((unsigned)PROJ[(size_t)row * INW + (hk * 4 + g) * 64 + lane]); o[g] = 0.f; ls[g] = 1.0f; m[g] = a->in[I_SINK][l * 8 + hk * 4 + g] * 1.4426950408889634f; }
        int j0 = 0, j1 = -1;
        if (!isctx) { j0 = row - 128 < 0 ? 0 : row - 128; j1 = row + 128 > S_LAT - 1 ? S_LAT - 1 : row + 128; }
        const int nwin = j1 - j0 + 1;
        const int nk = nwin + C_CTX;
#pragma unroll 4
        for (int t = 0; t < nk; ++t) {
            const int krow = (t < nwin) ? j0 + t : S_LAT + (t - nwin);
            const float k = bflo((unsigned)PROJ[(size_t)krow * INW + COL_AK + hk * 64 + lane]);
            const float v = bflo((unsigned)PROJ[(size_t)krow * INW + COL_AV + hk * 64 + lane]);
#pragma unroll
            for (int g = 0; g < 4; ++g) { const float s = wave_sum(q[g] * k); const float mn = fmaxf(m[g], s);
                const float c = __builtin_amdgcn_exp2f(m[g] - mn), p = __builtin_amdgcn_exp2f(s - mn);
                ls[g] = ls[g] * c + p; o[g] = o[g] * c + p * v; m[g] = mn; }
        }
#pragma unroll
        for (int g = 0; g < 4; ++g) MIX[(size_t)row * DM + MIX_AT + (hk * 4 + g) * 64 + lane] = (bf16)f2bf(o[g] / ls[g]);
    }
}
__device__ __forceinline__ void hgrn_combine(KA a, int l, int nrows, int lane, int wave, int G, int bid) {
    const bf16* PROJ = (const bf16*)(a->ws + WS_PROJ); bf16* MIX = (bf16*)(a->ws + WS_MIX);
    const float* O0 = (const float*)(a->ws + WS_HGO); const float* O1 = O0 + (size_t)R_ALL * 256;
    const f32x4 gn = *(const f32x4*)(a->in[I_HGAIN] + l * 64 + (lane & 15) * 4);
    const int gw = bid * NWAVES + wave, NGW = G * NWAVES;
    for (int r = gw; r < nrows; r += NGW) {
        const f32x4 o = *(const GAS f32x4*)(O0 + (size_t)r * 256 + 4 * lane) + *(const GAS f32x4*)(O1 + (size_t)r * 256 + 4 * lane);
        float ss = (o.x * o.x + o.y * o.y) + (o.z * o.z + o.w * o.w);
        ss += sx<1>(ss); ss += sx<2>(ss); ss += sx<4>(ss); ss += sx<8>(ss);
        const float rstd = __builtin_amdgcn_rsqf(ss * (1.0f / 64.0f) + EPS);
        const v2u gw2 = *(const GAS v2u*)(PROJ + (size_t)r * INW + COL_HG + 4 * lane);
        const float g0 = bflo(gw2.x), g1 = bfhi(gw2.x), g2 = bflo(gw2.y), g3 = bfhi(gw2.y);
        v2u w; w.x = pk2(o.x * rstd * gn.x * silu1(g0), o.y * rstd * gn.y * silu1(g1)); w.y = pk2(o.z * rstd * gn.z * silu1(g2), o.w * rstd * gn.w * silu1(g3));
        *(GAS v2u*)(MIX + (size_t)r * DM + MIX_HG + 4 * lane) = w;
    }
}
__device__ __forceinline__ void moe_gather(KA a, LAS unsigned char* lds, int tid, int lane, int wave, int G, int bid) {
    LAS int* sb = (LAS int*)lds;
    const unsigned* cnt = (const unsigned*)(a->ws + WS_CTL) + CW_MOECNT;
    int* mi = (int*)(a->ws + WS_VEC) + VO_MOE;
    if (tid == 0) { int b = 0;
        for (int e = 0; e < 8; ++e) { const int c = (int)__hip_atomic_load(cnt + 64 * e, RLX_AGENT); sb[e] = b; sb[16 + e] = c;
            const int nt = (c + 255) >> 8;
            if (bid == 0) for (int t = 0; t < nt; ++t) mi[16 + (b >> 8) + t] = e;
            b += nt << 8; }
        sb[8] = b; if (bid == 0) mi[0] = b >> 8; }
    __syncthreads();
    const bf16* H = (const bf16*)(a->ws + WS_H2B); bf16* AS = (bf16*)(a->ws + WS_AS);
    const int* tokinfo = (const int*)(a->ws + WS_TOK); int* tokslot = (int*)(a->ws + WS_TOK) + S_LAT * 8;
    const int gw = bid * NWAVES + wave, NGW = G * NWAVES;
    for (int t = gw; t < S_LAT; t += NGW) {
        const int* ti = tokinfo + (size_t)t * 8;
        const int e1 = ti[0], e2 = ti[1], r1 = ti[2], r2 = ti[3];
        const int s1 = sb[e1] + r1, s2 = sb[e2] + r2;
        const GAS v4u* src = (const GAS v4u*)(H + (size_t)t * DM) + lane;
        const v4u x0 = src[0], x1 = src[64];
        GAS v4u* d1 = (GAS v4u*)(AS + (size_t)s1 * DM) + lane; GAS v4u* d2 = (GAS v4u*)(AS + (size_t)s2 * DM) + lane;
        d1[0] = x0; d1[64] = x1; d2[0] = x0; d2[64] = x1;
        if (lane == 0) { int* ts = tokslot + (size_t)t * 4; ts[0] = s1; ts[1] = s2; ts[2] = ti[4]; ts[3] = ti[5]; }
    }
    { const f32x4 z4 = {0.f, 0.f, 0.f, 0.f}; for (int i = bid * NTHR + tid; i < 8 * 256 * DM / 4; i += G * NTHR) ((GAS f32x4*)(a->ws + WS_YF))[i] = z4; }
    for (int e = 0; e < 8; ++e) { const int c = sb[16 + e], pe = (c + 255) & ~255, b = sb[e];
        for (int j = c + gw; j < pe; j += NGW) { GAS v4u* d = (GAS v4u*)(AS + (size_t)(b + j) * DM) + lane; const v4u z = {0u, 0u, 0u, 0u}; d[0] = z; d[64] = z; } }
}
__device__ __forceinline__ void moe_combine(KA a, int lane, int wave, int G, int bid) {
    const float* gf = (const float*)(a->ws + WS_VEC) + VO_MOD + (1 * 2 + 0) * 6144 + 5 * 1024;
    const bf16* Y = (const bf16*)(a->ws + WS_Y); const int* tokslot = (const int*)(a->ws + WS_TOK) + S_LAT * 8;
    const int gw = bid * NWAVES + wave, NGW = G * NWAVES;
    for (int t = gw; t < S_LAT; t += NGW) {
        const int* ts = tokslot + (size_t)t * 4; const int s1 = ts[0], s2 = ts[1]; const float w1 = __builtin_bit_cast(float, ts[2]), w2 = __builtin_bit_cast(float, ts[3]);
        GAS f32x4* xr = (GAS f32x4*)(a->out + (size_t)t * DM) + lane;
        const float* YF = (const float*)(a->ws + WS_YF);
#pragma unroll
        for (int j = 0; j < 4; ++j) { const f32x4 g = *(const f32x4*)(gf + 4 * lane + 256 * j); f32x4 x = xr[64 * j]; f32x4 p, q;
            if (s1 < 32768) { const v2u t = ((const GAS v2u*)(Y + (size_t)s1 * DM) + lane)[64 * j]; p = (f32x4){bflo(t.x), bfhi(t.x), bflo(t.y), bfhi(t.y)}; } else p = ((const GAS f32x4*)(YF + (size_t)(s1 - 32768) * DM) + lane)[64 * j];
            if (s2 < 32768) { const v2u t = ((const GAS v2u*)(Y + (size_t)s2 * DM) + lane)[64 * j]; q = (f32x4){bflo(t.x), bfhi(t.x), bflo(t.y), bfhi(t.y)}; } else q = ((const GAS f32x4*)(YF + (size_t)(s2 - 32768) * DM) + lane)[64 * j];
            x = x + g * (p * w1 + q * w2);
            xr[64 * j] = x; }
    }
}

#define IN(k) (lo <= (k) && (k) < hi)
#define GRIDBAR() do { XcdBarrier b2_; b2_.bar = (unsigned*)(KARGS()->ws + WS_CTL) + CW_BAR; b2_.x = xb_xcc_id(); b2_.st = (volatile LAS unsigned*)(lds + MISC_OFF) + 8; xcd_barrier(b2_, wv0 * 64 + (int)__builtin_amdgcn_mbcnt_hi(~0u, __builtin_amdgcn_mbcnt_lo(~0u, 0u))); } while (0)
#define SEAM(k) do { if (IN(k) && IN((k) + 1)) GRIDBAR(); } while (0)
#define PHASE_ROOTS() KA a = KARGS(); unsigned char* ws = a->ws; const float* vec = (const float*)(ws + WS_VEC); (void)vec; int bid = blockIdx.x, G = gridDim.x; asm volatile("" : "+s"(bid), "+s"(G)); int tid = wv0 * 64 + (int)__builtin_amdgcn_mbcnt_hi(~0u, __builtin_amdgcn_mbcnt_lo(~0u, 0u)); asm volatile("" : "+v"(tid)); const int lane = tid & 63, wave = __builtin_amdgcn_readfirstlane(tid >> 6); (void)lane; (void)wave

template <int l> __device__ __forceinline__ void layer_body(const int lo, const int hi, LAS unsigned char* lds, const int wv0) {
        const int pb = 1 + 11 * l;
        if (IN(pb + 0)) { PHASE_ROOTS(); phase_norm(a, l, 0, R_ALL, (bf16*)(ws + WS_H), lane, wave, G, bid); SEAM(pb + 0); }
        if (IN(pb + 1)) {
            PHASE_ROOTS();
            pg8::Gemm g{(const pg8::bf16_t*)(ws + WS_H), (const pg8::bf16_t*)(ws + WS_WIN) + (size_t)l * INW * DM, R_ALL, INW, DM, 0, DM};
            pg8::StaticOrder S; S.init(R_ALL, INW, G, bid);
            pg8::EpiBf16<0> E{(pg8::bf16_t*)(ws + WS_PROJ), INW, nullptr, 0, 0, 1.f};
            pg8::gemm_phase<pg8::EpiBf16<0>, pg8::StaticOrder, true, true>(lds, g, S, E, tid);
            moe_conv_slice(a, l == 0 ? 0 : 2, 650 - 2 * 256, lds, lane, wave, G, bid);
            SEAM(pb + 1);
        }
        if (IN(pb + 2)) {
            PHASE_ROOTS();
            qk_prep(a, l, bid * NTHR + tid, G * NTHR);
            for (int it = bid * NWAVES + wave; it < 520; it += G * NWAVES) vt_item(a, it, lane);
            for (int it = bid; it < 1040; it += G) hgrn_stepA(a, l, it >> 2, it & 3, lds, lane, wave);
            SEAM(pb + 2);
        }
        if (IN(pb + 3)) {
            PHASE_ROOTS();
            if (bid < 64) hgrn_stepB(a, bid, tid);
            {
                const int nu = (l == 0) ? 260 : 256, ng = (l == 0) ? 520 : 512;
                unsigned* qctr = (unsigned*)(ws + WS_CTL) + CW_QUEUE + 64 * l;
                volatile LAS unsigned* qslot = (volatile LAS unsigned*)(lds + MISC_OFF) + 16;
                for (;;) {
                    __syncthreads();
                    if (tid == 0) qslot[0] = __hip_atomic_fetch_add(qctr, 1u, RLX_AGENT);
                    __syncthreads();
                    const int it = __builtin_amdgcn_readfirstlane((int)qslot[0]);
                    if (it >= nu + ng) break;
                    if (it < nu) attn_unit(a, l, it, lds, tid, lane, wave);
                    else gmlp_unit_mma(a, l, (it - nu) >> 2, (it - nu) & 3, lds, tid, lane, wave);
                }
            }
            SEAM(pb + 3);
        }
        if (IN(pb + 4)) {
            PHASE_ROOTS();
            const int nit = (l == 0) ? 1040 : 1024;
            for (int it = bid; it < nit; it += G) hgrn_stepC(a, l, it >> 2, it & 3, lds, tid, lane, wave);
            SEAM(pb + 4);
        }
        if (IN(pb + 5)) {
            PHASE_ROOTS();
            const float* modl = vec + VO_MOD + (l * 2 + 0) * 6144; const float* modc = vec + VO_MOD + (l * 2 + 1) * 6144;
            const int M = S_LAT;
            pg8::Gemm g{(const pg8::bf16_t*)(ws + WS_MIX), (const pg8::bf16_t*)(ws + WS_WOUT) + (size_t)l * DM * DM, M, DM, DM, 0, DM};
            pg8::StaticOrder S; S.init(M, DM, G, bid);
            pg8::EpiResid E{(l == 0) ? a->in[I_X] : a->out, a->out, modl + 2048, a->in[I_CTX], (float*)(ws + WS_CTXR), modc + 2048, S_LAT / 256, DM};
            pg8::gemm_phase<pg8::EpiResid, pg8::StaticOrder, true, true>(lds, g, S, E, tid);
            if (l == 0) {
                pg8::Gemm g2{(const pg8::bf16_t*)(ws + WS_MIX), (const pg8::bf16_t*)(ws + WS_WOUT), R_ALL, DM, 256, 0, DM};
                pg8::SplitKOrder S2{S_LAT / 256, 4, 4, 256, 16, bid, nullptr};
                pg8::EpiAtomic E2{(float*)(ws + WS_CTXR), modc + 2048, S_LAT / 256, DM};
                pg8::gemm_phase<pg8::EpiAtomic, pg8::SplitKOrder, false, true>(lds, g2, S2, E2, tid);
            }
            SEAM(pb + 5);
        }
        if (l == 0) {
            if (IN(pb + 6)) { PHASE_ROOTS(); phase_norm(a, l, 1, R_ALL, (bf16*)(ws + WS_H), lane, wave, G, bid); SEAM(pb + 6); }
            if (IN(pb + 7)) {
                PHASE_ROOTS();
                pg8::Gemm g{(const pg8::bf16_t*)(ws + WS_H), (const pg8::bf16_t*)(ws + WS_WGU), R_ALL, 2 * FFN, DM, 0, DM};
                pg8::StaticOrder S; S.init(R_ALL, 2 * FFN, G, bid);
                pg8::EpiSwiGLU E{(pg8::bf16_t*)(ws + WS_HID), FFN};
                pg8::gemm_phase<pg8::EpiSwiGLU, pg8::StaticOrder, true, true>(lds, g, S, E, tid);
                moe_conv_slice(a, 1, 1430 - 5 * 256, lds, lane, wave, G, bid);
                SEAM(pb + 7);
            }
            if (IN(pb + 8)) {
                PHASE_ROOTS();
                const float* modl = vec + VO_MOD + (l * 2 + 0) * 6144; const float* modc = vec + VO_MOD + (l * 2 + 1) * 6144;
                pg8::Gemm g{(const pg8::bf16_t*)(ws + WS_HID), (const pg8::bf16_t*)(ws + WS_WD), S_LAT, DM, FFN, 0, FFN};
                pg8::StaticOrder S; S.init(S_LAT, DM, G, bid);
                pg8::EpiResid E{a->out, a->out, modl + 5120, (const float*)(ws + WS_CTXR), (float*)(ws + WS_CTXR), modc + 5120, S_LAT / 256, DM};
                pg8::gemm_phase<pg8::EpiResid, pg8::StaticOrder, true, true>(lds, g, S, E, tid);
                {
                    pg8::Gemm g2{(const pg8::bf16_t*)(ws + WS_HID), (const pg8::bf16_t*)(ws + WS_WD), R_ALL, DM, 256, 0, FFN};
                    pg8::SplitKOrder S2{S_LAT / 256, 4, 11, 256, 44, bid, nullptr};
                    pg8::EpiAtomic E2{(float*)(ws + WS_CTXR), modc + 5120, S_LAT / 256, DM};
                    pg8::gemm_phase<pg8::EpiAtomic, pg8::SplitKOrder, false, true>(lds, g2, S2, E2, tid);
                }
                if (IN(pb + 8) && IN(pb + 11)) GRIDBAR();
            }
        } else {
            if (IN(pb + 6)) { PHASE_ROOTS(); phase_norm_route(a, lds, tid, lane, wave, G, bid); SEAM(pb + 6); }
            if (IN(pb + 7)) { PHASE_ROOTS(); moe_gather(a, lds, tid, lane, wave, G, bid); SEAM(pb + 7); }
            if (IN(pb + 8)) {
                PHASE_ROOTS();
                const int* mi = (const int*)(ws + WS_VEC) + VO_MOE; const int nt = __builtin_amdgcn_readfirstlane(mi[0]);
                pg8::Gemm g{(const pg8::bf16_t*)(ws + WS_AS), (const pg8::bf16_t*)(ws + WS_MGU), nt * 256, 2 * EXD, DM, (size_t)2 * EXD * DM * 2, DM};
                pg8::MoeOrder S; S.init(nt * 256, 2 * EXD, G, bid); S.tile_e = mi + 16;
                pg8::EpiSwiGLU E{(pg8::bf16_t*)(ws + WS_HIDM), EXD};
                pg8::gemm_phase<pg8::EpiSwiGLU, pg8::MoeOrder, true, true>(lds, g, S, E, tid);
                SEAM(pb + 8);
            }
            if (IN(pb + 9)) {
                PHASE_ROOTS();
                const int* mi = (const int*)(ws + WS_VEC) + VO_MOE; const int nt = __builtin_amdgcn_readfirstlane(mi[0]); const int nm = nt < 128 ? nt : 128;
                pg8::Gemm g{(const pg8::bf16_t*)(ws + WS_HIDM), (const pg8::bf16_t*)(ws + WS_MD), nm * 256, DM, EXD, (size_t)DM * EXD * 2, EXD};
                pg8::MoeOrder S; S.init(nm * 256, DM, G, bid); S.tile_e = mi + 16;
                pg8::EpiBf16<0> E{(pg8::bf16_t*)(ws + WS_Y), DM, nullptr, 0, 0, 1.f};
                pg8::gemm_phase<pg8::EpiBf16<0>, pg8::MoeOrder, true, true>(lds, g, S, E, tid);
                if (nt > 128) {
                    pg8::Gemm g2{(const pg8::bf16_t*)(ws + WS_HIDM), (const pg8::bf16_t*)(ws + WS_MD), nt * 256, DM, 512, (size_t)DM * EXD * 2, EXD};
                    pg8::SplitKOrder S2{128, 4, 7, 512, (nt - 128) * 28, bid, mi + 16};
                    pg8::EpiAtomic E2{(float*)(ws + WS_YF), nullptr, 128, DM};
                    pg8::gemm_phase<pg8::EpiAtomic, pg8::SplitKOrder, false, true>(lds, g2, S2, E2, tid);
                }
                SEAM(pb + 9);
            }
            if (IN(pb + 10)) { PHASE_ROOTS(); moe_combine(a, lane, wave, G, bid); }
        }
    }
__global__ void __launch_bounds__(NTHR, 2) fwd_kernel(Args a_unused) {
    extern __shared__ __attribute__((aligned(16))) unsigned char lds_raw[];
    LAS unsigned char* lds = (LAS unsigned char*)lds_raw;
    const int tid0 = threadIdx.x;
    const int wv0 = __builtin_amdgcn_readfirstlane(tid0 >> 6);
    for (int u = tid0; u < (LDS_BYTES - LDSCTL_OFF) / 4; u += NTHR) ((LAS unsigned*)(lds + LDSCTL_OFF))[u] = 0u;
    __syncthreads();
    const int lo = KARGS()->ph_lo, hi = KARGS()->ph_hi;
    const bool fusedl = (hi - lo) > 1;
    if (fusedl) (void)xcd_barrier_post((unsigned*)(KARGS()->ws + WS_CTL) + CW_BAR, (volatile LAS unsigned*)(lds + MISC_OFF) + 8);
    if (IN(0)) { PHASE_ROOTS(); p0_prologue(a, lds, tid, lane, wave, G, bid); SEAM(0); }

    layer_body<0>(lo, hi, lds, wv0);
    layer_body<1>(lo, hi, lds, wv0);
}

extern "C" void kernel_launch(void* const* d_in, const int* in_sizes, int n_in, void* d_out, int out_size, void* d_ws, size_t ws_size, hipStream_t stream) {
    static int grid = 0;
    if (grid == 0) {
        if (n_in != 23 || in_sizes[0] != S_LAT * DM || out_size != S_LAT * DM || ws_size < WS_END) { fprintf(stderr, "kernel_launch: unexpected shapes / workspace (n_in %d, ws %zu, need %zu)\n", n_in, ws_size, (size_t)WS_END); grid = -1; return; }
        int dev = 0, cus = 0;
        if (hipGetDevice(&dev) != hipSuccess || hipDeviceGetAttribute(&cus, hipDeviceAttributeMultiprocessorCount, dev) != hipSuccess) { grid = -1; return; }
        if (hipFuncSetAttribute((const void*)fwd_kernel, hipFuncAttributeMaxDynamicSharedMemorySize, LDS_BYTES) != hipSuccess) { grid = -1; return; }
        int per_cu = 0;
        (void)hipOccupancyMaxActiveBlocksPerMultiprocessor(&per_cu, (const void*)fwd_kernel, NTHR, LDS_BYTES);
        (void)hipGetLastError();
        grid = cus;
    }
    if (grid < 0) return;
    if (hipMemsetAsync((char*)d_ws + WS_CTL, 0, CTL_ZERO_BYTES, stream) != hipSuccess) return;
    Args a{};
    for (int i = 0; i < 23; ++i) a.in[i] = (const float*)d_in[i];
    a.out = (float*)d_out; a.ws = (unsigned char*)d_ws;
#if ONE_LAUNCH
    a.ph_lo = 0; a.ph_hi = NPH;
    hipLaunchKernelGGL(fwd_kernel, dim3(grid), dim3(NTHR), LDS_BYTES, stream, a);
#else
    for (int p = 0; p < NPH; ++p) {
        if (p == 10 || p == 11) continue;
        a.ph_lo = p; a.ph_hi = p + 1;
        hipLaunchKernelGGL(fwd_kernel, dim3(grid), dim3(NTHR), LDS_BYTES, stream, a);
    }
#endif
}
```

```cpp
#include <hip/hip_runtime.h>
#include <cstdio>
#include <cstdint>
#include <cmath>
#ifndef ONE_LAUNCH
#define ONE_LAUNCH 1
#endif
namespace pg8 {
#define PG8_LAS __attribute__((address_space(3)))
typedef unsigned short bf16_t;
typedef short bf16x8 __attribute__((ext_vector_type(8)));
typedef float f32x4 __attribute__((ext_vector_type(4)));
typedef unsigned u32x4 __attribute__((ext_vector_type(4)));
constexpr int BM = 256, BK = 64, HALF = 128, HTB = HALF * BK * 2  , STAGE_BYTES = 8 * HTB, NXCD = 8, WGM = 8;

__host__ __device__ __forceinline__ int lds_byte(int r, int c) { const int st = (r >> 4) * 2 + (c >> 5), rr = r & 15, cc = c & 31, ob = rr * 64 + cc * 2; return st * 1024 + (ob ^ (((ob >> 9) & 1) << 5)); }
__host__ __device__ __forceinline__ void stage_rc(int b, int& R, int& C) { const int st = b / 1024, sb = b % 1024, swz = sb ^ (((sb >> 9) & 1) << 5); R = (st >> 1) * 16 + swz / 64; C = (st & 1) * 32 + (swz % 64) / 2; }
__host__ __device__ __forceinline__ int perm32(int rho) { const int n = rho >> 4, i = rho & 15; return 8 * (i >> 2) + 4 * n + (i & 3); }

struct Unit { int pm, pn, eb, ko; };
struct Gemm { const bf16_t* A; const bf16_t* Bt; int M, N, K; size_t bstride; int ld; };

struct StaticOrder {
    int nM, nN, nwg, G, c;
    __host__ __device__ void init(int M, int N, int G_, int c_) { nM = M / BM; nN = N / BM; nwg = nM * nN; G = G_; c = c_; }
    __host__ __device__ bool next(int i, Unit& u) const {
        const long L = (long)i * G + c; if (L >= nwg) return false;
        int wgid = (int)L; { const int q = nwg / NXCD, r = nwg % NXCD, xcd = wgid % NXCD, off = wgid / NXCD; wgid = (xcd < r ? xcd * (q + 1) : r * (q + 1) + (xcd - r) * q) + off; }
        const int nig = WGM * nN, gid = wgid / nig, fm = gid * WGM, gsz = (nM - fm) < WGM ? (nM - fm) : WGM;
        u.pm = fm + ((wgid % nig) % gsz); u.pn = (wgid % nig) / gsz; u.eb = 0; u.ko = 0; return true;
    }
    __device__ __forceinline__ void a_ready(const Unit&) const {}
    __device__ __forceinline__ void done(const Unit&) const {}
};

__device__ __forceinline__ unsigned cvt_pk_bf16(float lo, float hi) { unsigned r; asm volatile("v_cvt_pk_bf16_f32 %0, %1, %2" : "=v"(r) : "v"(lo), "v"(hi)); return r; }
typedef float f32x2 __attribute__((ext_vector_type(2)));
__device__ __forceinline__ f32x2 gelu_pk(f32x2 v) {
    const f32x2 av = __builtin_elementwise_abs(v), d = av * 0.2316418882f + 1.0f;
    f32x2 t; t.x = __builtin_amdgcn_rcpf(d.x); t.y = __builtin_amdgcn_rcpf(d.y);
    f32x2 q = t * 0.5307027145f + (-0.7265760135f); q = q * t + 0.7107068705f; q = q * t + (-0.142248368f); q = q * t + 0.127414796f; q = q * t;
    const f32x2 s = (v * v) * (-0.72134752044f);
    f32x2 e; e.x = __builtin_amdgcn_exp2f(s.x); e.y = __builtin_amdgcn_exp2f(s.y);
    const f32x2 m = v * (q * e), r = v - m;
    f32x2 o; o.x = v.x < 0.f ? m.x : r.x; o.y = v.y < 0.f ? m.y : r.y; return o;
}

template <int ACT  > struct EpiBf16 {
    static constexpr bool PERM = true, AFTER_DRAIN = false; static_assert(ACT == 0 || ACT == 1, "EpiBf16: ACT is 0 (none) or 1 (gelu_pk)");
    bf16_t* O; int ldc; const float* bias; int split_cols; size_t split_stride; float scale0;
    __device__ __forceinline__ void operator()(const f32x4 (&acc)[2][2][4][2], const Unit& u, int wr, int wc, int fr, int fq) const {
        const int row0 = u.pm * BM + wr * 64 + fr; int colt = u.pn * BM; bf16_t* base = O;
        float sc = 1.f; if (split_cols) { const int t = colt / split_cols; base += (size_t)t * split_stride; colt -= t * split_cols; if (t == 0) sc = scale0; }
        const int col0 = colt + wc * 32 + 8 * fq, bcol0 = u.pn * BM + wc * 32 + 8 * fq;
        f32x4 bv[2][2];
#pragma unroll
        for (int bj = 0; bj < 2; ++bj)
#pragma unroll
            for (int n = 0; n < 2; ++n) bv[bj][n] = bias ? *(const f32x4*)(bias + bcol0 + bj * HALF + 4 * n) : (f32x4){0.f, 0.f, 0.f, 0.f};
#pragma unroll
        for (int ai = 0; ai < 2; ++ai)
#pragma unroll
            for (int m = 0; m < 4; ++m) { bf16_t* rowp = base + (size_t)(row0 + ai * HALF + m * 16) * ldc + col0;
#pragma unroll
                for (int bj = 0; bj < 2; ++bj) { f32x4 v0 = acc[ai][bj][m][0] + bv[bj][0], v1 = acc[ai][bj][m][1] + bv[bj][1];
                    if (ACT == 1) { f32x2 a = gelu_pk((f32x2){v0[0], v0[1]}), b = gelu_pk((f32x2){v0[2], v0[3]}), c = gelu_pk((f32x2){v1[0], v1[1]}), d = gelu_pk((f32x2){v1[2], v1[3]});
                        v0 = (f32x4){a.x, a.y, b.x, b.y}; v1 = (f32x4){c.x, c.y, d.x, d.y}; }
                    v0 = v0 * sc; v1 = v1 * sc; u32x4 w; w.x = cvt_pk_bf16(v0[0], v0[1]); w.y = cvt_pk_bf16(v0[2], v0[3]); w.z = cvt_pk_bf16(v1[0], v1[1]); w.w = cvt_pk_bf16(v1[2], v1[3]);
                    *(u32x4*)(rowp + bj * HALF) = w; } }
    }
};

__device__ __forceinline__ float silu_f(float x) { return x * __builtin_amdgcn_rcpf(1.0f + __builtin_amdgcn_exp2f(-1.4426950408889634f * x)); }
struct EpiResid {
    static constexpr bool PERM = false, AFTER_DRAIN = false;
    const float* base; float* out; const float* gate; const float* cbase; float* cout; const float* cgate; int mlat; int ldc;
    __device__ __forceinline__ void operator()(const f32x4 (&acc)[2][2][4][2], const Unit& u, int wr, int wc, int fr, int fq) const {
        const bool isc = u.pm >= mlat;
        const float* b = isc ? cbase : base; float* o = isc ? cout : out; const float* g = isc ? cgate : gate;
        const int row0 = (isc ? (u.pm - mlat) : u.pm) * BM + wr * 64 + fr, col0 = u.pn * BM + wc * 32 + 4 * fq;
        f32x4 gv[2][2];
#pragma unroll
        for (int bj = 0; bj < 2; ++bj)
#pragma unroll
            for (int n = 0; n < 2; ++n) gv[bj][n] = *(const f32x4*)(g + col0 + bj * HALF + n * 16);
#pragma unroll
        for (int ai = 0; ai < 2; ++ai)
#pragma unroll
            for (int m = 0; m < 4; ++m) { const size_t off = (size_t)(row0 + ai * HALF + m * 16) * ldc + col0;
#pragma unroll
                for (int bj = 0; bj < 2; ++bj)
#pragma unroll
                    for (int n = 0; n < 2; ++n) { const f32x4 bs = *(const f32x4*)(b + off + bj * HALF + n * 16); *(f32x4*)(o + off + bj * HALF + n * 16) = bs + gv[bj][n] * acc[ai][bj][m][n]; }
                if (m & 1) asm volatile("" ::: "memory"); }
    }
};
struct EpiSwiGLU {
    static constexpr bool PERM = true, AFTER_DRAIN = false;
    bf16_t* O; int ldc;
    __device__ __forceinline__ void operator()(const f32x4 (&acc)[2][2][4][2], const Unit& u, int wr, int wc, int fr, int fq) const {
        const int row0 = u.pm * BM + wr * 64 + fr, col0 = u.pn * HALF + wc * 32 + 8 * fq;
#pragma unroll
        for (int ai = 0; ai < 2; ++ai)
#pragma unroll
            for (int m = 0; m < 4; ++m) { bf16_t* rowp = O + (size_t)(row0 + ai * HALF + m * 16) * ldc + col0;
                const f32x4 g0 = acc[ai][0][m][0], g1 = acc[ai][0][m][1], u0 = acc[ai][1][m][0], u1 = acc[ai][1][m][1];
                f32x4 h0, h1;
#pragma unroll
                for (int j = 0; j < 4; ++j) { h0[j] = silu_f(g0[j]) * u0[j]; h1[j] = silu_f(g1[j]) * u1[j]; }
                u32x4 w; w.x = cvt_pk_bf16(h0[0], h0[1]); w.y = cvt_pk_bf16(h0[2], h0[3]); w.z = cvt_pk_bf16(h1[0], h1[1]); w.w = cvt_pk_bf16(h1[2], h1[3]);
                *(u32x4*)rowp = w; }
    }
};
struct MoeOrder : StaticOrder {
    const int* tile_e;
    __device__ __forceinline__ bool next(int i, Unit& u) const { if (!StaticOrder::next(i, u)) return false; u.eb = __builtin_amdgcn_readfirstlane(tile_e[u.pm]); return true; }
};

struct SplitKOrder {
    int pm0, nN, P, kp, total, c; const int* tile_e;
    __device__ __forceinline__ bool next(int i, Unit& u) const {
        if (i != 0 || c >= total) return false;
        const int p = c % P, t = c / P; u.pn = t % nN; u.pm = pm0 + t / nN; u.ko = p * kp; u.eb = tile_e ? __builtin_amdgcn_readfirstlane(tile_e[u.pm]) : 0; return true; }
    __device__ __forceinline__ void a_ready(const Unit&) const {}
    __device__ __forceinline__ void done(const Unit&) const {}
};
struct EpiAtomic {
    static constexpr bool PERM = false, AFTER_DRAIN = true;
    float* out; const float* scale; int pm_sub; int ldc;
    __device__ __forceinline__ void fused(f32x4 (&acc)[2][2][4][2], const Unit& u, int wr, int wc, int fr, int fq, PG8_LAS unsigned char* lds, int wid, int lane) const {
        PG8_LAS float* scr = (PG8_LAS float*)(lds + wid * 16384);
        const int rr = lane >> 5, cc = lane & 31;
#pragma unroll
        for (int ai = 0; ai < 2; ++ai)
#pragma unroll
            for (int bj = 0; bj < 2; ++bj) {
#pragma unroll
                for (int m = 0; m < 4; ++m)
#pragma unroll
                    for (int n = 0; n < 2; ++n) *(PG8_LAS f32x4*)(scr + (m * 16 + fr) * 36 + n * 16 + 4 * fq) = acc[ai][bj][m][n];
                asm volatile("s_waitcnt lgkmcnt(0)" ::: "memory");
                const int colg = u.pn * BM + bj * HALF + wc * 32 + cc; const float sc = scale ? scale[colg] : 1.0f;
                float* op = out + (size_t)((u.pm - pm_sub) * BM + ai * HALF + wr * 64 + rr) * ldc + colg;
#pragma unroll 8
                for (int i = 0; i < 32; ++i) { const float v = scr[(2 * i + rr) * 36 + cc]; __hip_atomic_fetch_add(op + (size_t)(2 * i) * ldc, v * sc, __ATOMIC_RELAXED, __HIP_MEMORY_SCOPE_AGENT); }
                asm volatile("s_waitcnt lgkmcnt(0)" ::: "memory");
            }
    }
};

template <class Epi, class Sched, bool ALIGN_EPI = false, bool SP2 = false>
__device__ __forceinline__ void gemm_phase(PG8_LAS unsigned char* lds, const Gemm g, const Sched& S, const Epi& E, int tid_in) {
    int tid_ = tid_in; asm volatile("" : "+v"(tid_));
    const int tid = tid_, wid = __builtin_amdgcn_readfirstlane(tid >> 6), lane = tid & 63, wr = wid >> 2, wc = wid & 3, fr = lane & 15, fq = lane >> 4;
    const int K = g.K, nt = K / BK, ld = g.ld;
    unsigned voffA[2], voffB[2];
#pragma unroll
    for (int i = 0; i < 2; ++i) { int R, C; stage_rc(tid * 16 + i * 8192, R, C); const int Rb = Epi::PERM ? ((R & ~31) + perm32(R & 31)) : R;
        voffA[i] = (unsigned)(R * ld + C) * 2u; voffB[i] = (unsigned)(Rb * ld + C) * 2u; }
    const size_t kstep = (size_t)(BK * 2);
    const size_t hstep = (size_t)HALF * ld * 2;
    const size_t tstep = 2 * hstep;
    const unsigned ldsw = (unsigned)wid * 1024u;
    const int aoff = lds_byte(wr * 64 + fr, fq * 8), boff = lds_byte(wc * 32 + fr, fq * 8);
#define PG8_SA(b, h) (((b) * 2 + (h)) * HTB)
#define PG8_SB(b, h) ((4 + (b) * 2 + (h)) * HTB)
#define PG8_STAGE(bufoff, gbase, voff) do { _Pragma("unroll") for (int _i = 0; _i < 2; ++_i) \
        __builtin_amdgcn_global_load_lds((const unsigned*)((const char*)(gbase) + (voff)[_i]), (PG8_LAS unsigned*)(lds + (bufoff) + ldsw + _i * 8192), 16, 0, 0); } while (0)
#define PG8_LDA(dst, b, h) do { _Pragma("unroll") for (int m = 0; m < 4; ++m) _Pragma("unroll") for (int k = 0; k < 2; ++k) dst[m][k] = *(const PG8_LAS bf16x8*)(lds + PG8_SA(b, h) + aoff + m * 2048 + k * 1024); } while (0)
#define PG8_LDB(dst, b, h) do { _Pragma("unroll") for (int n = 0; n < 2; ++n) _Pragma("unroll") for (int k = 0; k < 2; ++k) dst[n][k] = *(const PG8_LAS bf16x8*)(lds + PG8_SB(b, h) + boff + n * 2048 + k * 1024); } while (0)
#define PG8_MMA(ai, bj, At, Bt) do { __builtin_amdgcn_s_setprio(1); _Pragma("unroll") for (int m = 0; m < 4; ++m) _Pragma("unroll") for (int n = 0; n < 2; ++n) _Pragma("unroll") for (int k = 0; k < 2; ++k) \
        acc[ai][bj][m][n] = __builtin_amdgcn_mfma_f32_16x16x32_bf16(Bt[n][k], At[m][k], acc[ai][bj][m][n], 0, 0, 0); __builtin_amdgcn_s_setprio(0); } while (0)
#define PG8_WAIT_V(n) asm volatile("s_waitcnt vmcnt(" #n ")" ::: "memory")
#define PG8_WAIT_L(n) asm volatile("s_waitcnt lgkmcnt(" #n ")" ::: "memory")
#define PG8_BAR __builtin_amdgcn_s_barrier()
#define PG8_SCHED __builtin_amdgcn_sched_barrier(0)
    Unit cur, nxt; int ui = 0;
    if (!S.next(0, cur)) return;
    f32x4 acc[2][2][4][2];
#pragma unroll
    for (int a = 0; a < 2; ++a)
#pragma unroll
        for (int b = 0; b < 2; ++b)
#pragma unroll
            for (int m = 0; m < 4; ++m)
#pragma unroll
                for (int n = 0; n < 2; ++n) acc[a][b][m][n] = (f32x4){0.f, 0.f, 0.f, 0.f};
    bf16x8 At[4][2], B0[2][2], B1[2][2];
    const char* cA = (const char*)g.A + (size_t)cur.pm * tstep + (size_t)cur.ko * 2; const char* cB = (const char*)g.Bt + (size_t)cur.eb * g.bstride + (size_t)cur.pn * tstep + (size_t)cur.ko * 2;
    S.a_ready(cur);
    if constexpr (SP2) {
        PG8_STAGE(PG8_SB(0, 0), cB, voffB); PG8_STAGE(PG8_SB(0, 1), cB + hstep, voffB); PG8_STAGE(PG8_SA(0, 0), cA, voffA); PG8_STAGE(PG8_SA(0, 1), cA + hstep, voffA);
        if (wr == 1) PG8_BAR;
        PG8_WAIT_V(2); PG8_BAR;
        PG8_STAGE(PG8_SB(1, 0), cB + kstep, voffB); PG8_STAGE(PG8_SA(1, 0), cA + kstep, voffA); PG8_STAGE(PG8_SB(1, 1), cB + hstep + kstep, voffB);
        PG8_WAIT_V(6); PG8_BAR;
    } else {
        PG8_STAGE(PG8_SB(0, 0), cB, voffB); PG8_STAGE(PG8_SA(0, 0), cA, voffA); PG8_STAGE(PG8_SB(0, 1), cB + hstep, voffB); PG8_STAGE(PG8_SA(0, 1), cA + hstep, voffA);
        if (wr == 1) PG8_BAR;
        PG8_WAIT_V(4); PG8_BAR;
        PG8_STAGE(PG8_SB(1, 0), cB + kstep, voffB); PG8_STAGE(PG8_SA(1, 0), cA + kstep, voffA); PG8_STAGE(PG8_SB(1, 1), cB + hstep + kstep, voffB);
        PG8_WAIT_V(6); PG8_BAR;
    }
    for (;;) {
        const bool has_next = S.next(ui + 1, nxt);
        const char* nA = has_next ? (const char*)g.A + (size_t)nxt.pm * tstep + (size_t)nxt.ko * 2 : cA; const char* nB = has_next ? (const char*)g.Bt + (size_t)nxt.eb * g.bstride + (size_t)nxt.pn * tstep + (size_t)nxt.ko * 2 : cB;
        for (int t = 0; t < nt; t += 2) {
            const bool last = (t == nt - 2);
            const char* a1 = cA + (size_t)(t + 1) * kstep;
            const char* a2 = last ? nA : cA + (size_t)(t + 2) * kstep; const char* b2 = last ? nB : cB + (size_t)(t + 2) * kstep;
            const char* a3 = a2 + kstep; const char* b3 = b2 + kstep;
            if (last && has_next) S.a_ready(nxt);
            if constexpr (SP2) {
            PG8_LDB(B0, 0, 0); PG8_LDB(B1, 0, 1); PG8_SCHED; PG8_LDA(At, 0, 0); PG8_STAGE(PG8_SA(1, 1), a1 + hstep, voffA);
            PG8_WAIT_V(8); PG8_WAIT_L(0); PG8_BAR; PG8_MMA(0, 0, At, B0); PG8_MMA(0, 1, At, B1); PG8_BAR; PG8_SCHED;
            PG8_LDA(At, 0, 1); PG8_STAGE(PG8_SB(0, 0), b2, voffB); PG8_STAGE(PG8_SB(0, 1), b2 + hstep, voffB); PG8_STAGE(PG8_SA(0, 0), a2, voffA);
            PG8_WAIT_V(8); PG8_WAIT_L(0); PG8_BAR; PG8_MMA(1, 0, At, B0); PG8_MMA(1, 1, At, B1); PG8_BAR; PG8_SCHED;
            PG8_LDB(B0, 1, 0); PG8_LDB(B1, 1, 1); PG8_SCHED; PG8_LDA(At, 1, 0); PG8_STAGE(PG8_SA(0, 1), a2 + hstep, voffA);
            PG8_WAIT_V(8); PG8_WAIT_L(0); PG8_BAR; PG8_MMA(0, 0, At, B0); PG8_MMA(0, 1, At, B1); PG8_BAR; PG8_SCHED;
            PG8_LDA(At, 1, 1); PG8_STAGE(PG8_SB(1, 0), b3, voffB); PG8_STAGE(PG8_SB(1, 1), b3 + hstep, voffB); PG8_STAGE(PG8_SA(1, 0), a3, voffA);
            PG8_WAIT_V(8); PG8_WAIT_L(0); PG8_BAR; PG8_MMA(1, 0, At, B0); PG8_MMA(1, 1, At, B1); PG8_BAR; PG8_SCHED;
            } else {
            PG8_LDB(B0, 0, 0); PG8_SCHED; PG8_LDA(At, 0, 0); PG8_STAGE(PG8_SA(1, 1), a1 + hstep, voffA);
            PG8_WAIT_L(8); PG8_BAR; PG8_WAIT_L(0); PG8_MMA(0, 0, At, B0); PG8_BAR; PG8_SCHED;
            PG8_LDB(B1, 0, 1); PG8_STAGE(PG8_SB(0, 0), b2, voffB);
            PG8_BAR; PG8_WAIT_L(0); PG8_MMA(0, 1, At, B1); PG8_BAR;
            PG8_LDA(At, 0, 1); PG8_STAGE(PG8_SA(0, 0), a2, voffA);
            PG8_BAR; PG8_WAIT_L(0); PG8_MMA(1, 0, At, B0); PG8_BAR; PG8_SCHED;
            PG8_STAGE(PG8_SB(0, 1), b2 + hstep, voffB);
            PG8_WAIT_V(6); PG8_BAR; PG8_MMA(1, 1, At, B1); PG8_BAR;
            PG8_LDB(B0, 1, 0); PG8_SCHED; PG8_LDA(At, 1, 0); PG8_STAGE(PG8_SA(0, 1), a2 + hstep, voffA);
            PG8_WAIT_L(8); PG8_BAR; PG8_WAIT_L(0); PG8_MMA(0, 0, At, B0); PG8_BAR; PG8_SCHED;
            PG8_LDB(B1, 1, 1); PG8_STAGE(PG8_SB(1, 0), b3, voffB);
            PG8_BAR; PG8_WAIT_L(0); PG8_MMA(0, 1, At, B1); PG8_BAR;
            PG8_LDA(At, 1, 1); PG8_STAGE(PG8_SA(1, 0), a3, voffA);
            PG8_BAR; PG8_WAIT_L(0); PG8_MMA(1, 0, At, B0); PG8_BAR; PG8_SCHED;
            PG8_STAGE(PG8_SB(1, 1), b3 + hstep, voffB);
            PG8_WAIT_V(6); PG8_BAR; PG8_MMA(1, 1, At, B1); PG8_BAR;
            }
        }
        if constexpr (ALIGN_EPI) { if (wr == 0) PG8_BAR; }
        if constexpr (!Epi::AFTER_DRAIN) { E(acc, cur, wr, wc, fr, fq); S.done(cur); }
        if (!has_next) break;
#pragma unroll
        for (int a = 0; a < 2; ++a)
#pragma unroll
            for (int b = 0; b < 2; ++b)
#pragma unroll
                for (int m = 0; m < 4; ++m)
#pragma unroll
                    for (int n = 0; n < 2; ++n) acc[a][b][m][n] = (f32x4){0.f, 0.f, 0.f, 0.f};
        cur = nxt; cA = nA; cB = nB; ++ui;
        if constexpr (ALIGN_EPI) { if (wr == 1) PG8_BAR; }
    }
    PG8_WAIT_V(0);
    if constexpr (!ALIGN_EPI) { if (wr == 0) PG8_BAR; }
    PG8_BAR;
    if constexpr (Epi::AFTER_DRAIN) { E.fused(acc, cur, wr, wc, fr, fq, lds, wid, lane); S.done(cur); }
#undef PG8_SA
#undef PG8_SB
#undef PG8_STAGE
#undef PG8_LDA
#undef PG8_LDB
#undef PG8_MMA
#undef PG8_WAIT_V
#undef PG8_WAIT_L
#undef PG8_BAR
#undef PG8_SCHED
}
}


constexpr int S_LAT = 16384, C_CTX = 256, R_ALL = S_LAT + C_CTX, DM = 1024;
constexpr int INW = 2560, FFN = 2816, EXD = 3584, NEXP = 8;
constexpr int COL_AQ = 0, COL_AK = 512, COL_AV = 640, COL_HQ = 768, COL_HFF = 1024, COL_HFB = 1280, COL_HI = 1536, COL_HG = 1792, COL_GU = 2048, COL_GV = 2304;
constexpr int MIX_AT = 0, MIX_HG = 512, MIX_GM = 768;
constexpr int MOE_MAXROWS = 34816;
constexpr float EPS = 1e-6f;
constexpr int NWAVES = 8, NTHR = 512;
constexpr int NPH = 23;

constexpr size_t MiB = 1u << 20;
constexpr size_t WS_CTL = 0, CTL_ZERO_BYTES = 1 * MiB;
constexpr size_t WS_VEC = 1 * MiB;
constexpr size_t WS_TOK = 2 * MiB;
constexpr size_t WS_WIN = 3 * MiB;
constexpr size_t WS_WOUT = 13 * MiB;
constexpr size_t WS_WGU = 17 * MiB;
constexpr size_t WS_WD = 28 * MiB;
constexpr size_t WS_MGU = 34 * MiB;
constexpr size_t WS_MD = 146 * MiB;
constexpr size_t WS_H = 202 * MiB;
constexpr size_t WS_PROJ = 235 * MiB;
constexpr size_t WS_MIX = 317 * MiB;
constexpr size_t WS_HGO = 350 * MiB;
constexpr size_t WS_CTXR = 383 * MiB;
constexpr size_t WS_HLT = WS_HGO;
constexpr size_t WS_HSP = 384 * MiB;
constexpr size_t WS_HDG = 402 * MiB;
constexpr size_t WS_VT = 403 * MiB;
constexpr size_t WS_HID = WS_PROJ;
constexpr size_t WS_AS = 202 * MiB;
constexpr size_t WS_HIDM = 270 * MiB;
constexpr size_t WS_H2B = 440 * MiB;
constexpr size_t WS_YF = WS_WIN;
constexpr size_t WS_Y = WS_MGU;
constexpr size_t WS_END = 508 * MiB;
static_assert(WS_HID + (size_t)R_ALL * FFN * 2 <= WS_HGO && WS_AS + (size_t)MOE_MAXROWS * DM * 2 <= WS_HIDM && WS_HIDM + (size_t)MOE_MAXROWS * EXD * 2 <= WS_END, "ws map");
static_assert(WS_H2B >= WS_HIDM && WS_H2B + (size_t)S_LAT * DM * 2 <= WS_END && WS_H + (size_t)R_ALL * DM * 2 <= WS_PROJ && WS_PROJ + (size_t)R_ALL * INW * 2 <= WS_MIX && WS_MIX + (size_t)R_ALL * DM * 2 <= WS_HGO && WS_HGO + (size_t)2 * R_ALL * 256 * 4 <= WS_CTXR, "ws map 2");
constexpr int VO_MOD = 0;
constexpr int VO_ROPE = 32768;
constexpr int VO_MOE = 65536;
constexpr int CW_BAR = 4096;
constexpr int CW_QUEUE = 2048;
constexpr int CW_MOECNT = 1024;

constexpr int RING_BYTES = 131072;
constexpr int LDSCTL_OFF = 159744, MISC_OFF = LDSCTL_OFF + 320;
constexpr int LDS_BYTES = 163840;

#define GAS __attribute__((address_space(1)))
#define LAS __attribute__((address_space(3)))
typedef unsigned short bf16;
typedef unsigned v4u __attribute__((ext_vector_type(4)));
typedef unsigned v2u __attribute__((ext_vector_type(2)));
typedef float f32x4 __attribute__((ext_vector_type(4)));
typedef GAS unsigned gu32;
#define RLX_AGENT __ATOMIC_RELAXED, __HIP_MEMORY_SCOPE_AGENT
#define LDS_WAIT() asm volatile("s_waitcnt lgkmcnt(0)" ::: "memory")
typedef float f32x2_t __attribute__((ext_vector_type(2))); typedef __bf16 bf16x2_t __attribute__((ext_vector_type(2)));
__device__ __forceinline__ unsigned pk2(float lo, float hi) { const f32x2_t v = {lo, hi}; const bf16x2_t b = __builtin_convertvector(v, bf16x2_t); return __builtin_bit_cast(unsigned, b); }
__device__ __forceinline__ unsigned f2bf(float f) { return pk2(f, 0.f) & 0xffffu; }
__device__ __forceinline__ float bflo(unsigned w) { return __builtin_bit_cast(float, w << 16); }
__device__ __forceinline__ float bfhi(unsigned w) { return __builtin_bit_cast(float, w & 0xffff0000u); }
__device__ __forceinline__ float sigm1(float x) { return __builtin_amdgcn_rcpf(1.0f + __builtin_amdgcn_exp2f(-1.4426950408889634f * x)); }
__device__ __forceinline__ float silu1(float x) { return x * sigm1(x); }
__device__ __forceinline__ float gelu1(float x) { return 0.5f * x * (1.0f + erff(x * 0.70710678118654752f)); }
template <int X> __device__ __forceinline__ float sx(float v) { return __shfl_xor(v, X); }
__device__ __forceinline__ float sx32_add(float v) { return v + __shfl_xor(v, 32); }
__device__ __forceinline__ float sx32_max(float v) { return fmaxf(v, __shfl_xor(v, 32)); }
__device__ __forceinline__ float wave_sum(float v) { v += sx<1>(v); v += sx<2>(v); v += sx<4>(v); v += sx<8>(v); v += sx<16>(v); return sx32_add(v); }
__device__ __forceinline__ void unpack8(const v4u w, float* f) { f[0] = bflo(w.x); f[1] = bfhi(w.x); f[2] = bflo(w.y); f[3] = bfhi(w.y); f[4] = bflo(w.z); f[5] = bfhi(w.z); f[6] = bflo(w.w); f[7] = bfhi(w.w); }

#define XB_TMO      128
#define XB_XCNT(j)  (256  + 64 * (j))
#define XB_XSUB(j)  (1280 + 64 * (j))
#define XB_XGEN(j)  (2304 + 64 * (j))
#define XB_TOP      3328
#define XB_TOPGEN   3392
#define XCD_BAR_WORDS 3456
#define XB_SPIN_CAP (1u << 18)

__device__ __forceinline__ unsigned xb_ld(unsigned* p)              { return __hip_atomic_load(p, __ATOMIC_RELAXED, __HIP_MEMORY_SCOPE_AGENT); }
__device__ __forceinline__ unsigned xb_add(unsigned* p, unsigned v) { return __hip_atomic_fetch_add(p, v, __ATOMIC_RELAXED, __HIP_MEMORY_SCOPE_AGENT); }
__device__ __forceinline__ unsigned xb_xcc_id() { return (unsigned)__builtin_amdgcn_s_getreg((3 << 11) | 20) & 0xFu; }
#define XB_SPIN(cond, bar) do { unsigned _sp = 0; while (cond) { __builtin_amdgcn_s_sleep(1); \
    if ((++_sp & 255u) == 0u) { if (xb_ld(&(bar)[XB_TMO])) break; if (_sp > XB_SPIN_CAP) { atomicAdd(&(bar)[XB_TMO], 1u); break; } } } } while (0)

struct XcdBarrier {
    unsigned* bar; unsigned x;
    volatile LAS unsigned* st;
};

__device__ __forceinline__ XcdBarrier xcd_barrier_post(unsigned* bar, volatile LAS unsigned* st) {
    XcdBarrier b; b.bar = bar; b.x = xb_xcc_id(); b.st = st;
    if (threadIdx.x == 0) (void)xb_add(&bar[XB_XCNT(b.x)], 1u);
    return b;
}
__device__ __forceinline__ void xcd_barrier_complete(unsigned* bar, unsigned x, unsigned& nloc, unsigned& nx) {
    const unsigned G = gridDim.x * gridDim.y * gridDim.z;
    unsigned sum, cnt, mine, sp = 0u;
    for (;;) {
        sum = 0u; cnt = 0u; mine = 0u;
#pragma unroll
        for (unsigned j = 0; j < 16; ++j) { const unsigned c = xb_ld(&bar[XB_XCNT(j)]); sum += c; cnt += (c > 0u) ? 1u : 0u; mine = (j == x) ? c : mine; }
        if (sum == G) break;
        __builtin_amdgcn_s_sleep(1);
        if ((++sp & 255u) == 0u) { if (xb_ld(&bar[XB_TMO])) break; if (sp > XB_SPIN_CAP) { atomicAdd(&bar[XB_TMO], 1u); break; } }
    }
    nloc = mine > 0u ? mine : 1u; nx = cnt > 0u ? cnt : 1u;
}

__device__ __forceinline__ void xcd_barrier(const XcdBarrier& b, const int tid_in) {
    asm volatile("s_waitcnt vmcnt(0)" ::: "memory");
    __syncthreads();
    if (tid_in == 0) {
        unsigned* bar = b.bar;
        __builtin_amdgcn_s_waitcnt(0);
        unsigned nloc = b.st[0], nx = b.st[1];
        if (nloc == 0u) { xcd_barrier_complete(bar, b.x, nloc, nx); b.st[0] = nloc; b.st[1] = nx; }
        const unsigned old = xb_add(&bar[XB_XSUB(b.x)], 1u);
        const unsigned gen = old / nloc;
        if (old + 1u == (gen + 1u) * nloc) {
            __builtin_amdgcn_fence(__ATOMIC_RELEASE, "agent");
            asm volatile("s_waitcnt vmcnt(0)" ::: "memory");
            const unsigned og = xb_add(&bar[XB_TOP], 1u);
            const unsigned tg = og / nx;
            if (og + 1u == (tg + 1u) * nx) xb_add(&bar[XB_TOPGEN], 1u);
            else XB_SPIN(xb_ld(&bar[XB_TOPGEN]) == tg, bar);
            __builtin_amdgcn_fence(__ATOMIC_ACQUIRE, "agent");
            xb_add(&bar[XB_XGEN(b.x)], 1u);
            asm volatile("s_waitcnt vmcnt(0)" ::: "memory");
        } else {
            XB_SPIN(xb_ld(&bar[XB_XGEN(b.x)]) == gen, bar);
            __builtin_amdgcn_fence(__ATOMIC_ACQUIRE, "agent");
            asm volatile("s_waitcnt vmcnt(0)" ::: "memory");
        }
    }
    __syncthreads();
}


struct Args { const float* in[23]; float* out; unsigned char* ws; int ph_lo, ph_hi; };
typedef const __attribute__((address_space(4))) Args* KA;
#define KARGS() ({ KA p_ = (KA)__builtin_amdgcn_kernarg_segment_ptr(); asm volatile("" : "+s"(p_)); p_; })
enum { I_X = 0, I_C, I_CTX, I_CCTX, I_WADA, I_BADA, I_WIN, I_WOUT, I_QG, I_KG, I_SINK, I_HLB, I_HGAIN, I_GWS, I_GBS, I_GNG, I_FG, I_FU, I_FD, I_ROUTER, I_MG, I_MU, I_MDN };

__device__ __forceinline__ void transpose_item(const float* W, int K, int N, bf16* WT, int mode, LAS float* scr, int item, int lane) {
    const int nblk = N / 32, kb = item / nblk, nb = item % nblk, k0 = 64 * kb, n0 = 32 * nb;
#pragma unroll 8
    for (int i = 0; i < 32; ++i) { const int kk = 2 * i + (lane >> 5); scr[kk * 33 + (lane & 31)] = W[(size_t)(k0 + kk) * N + n0 + (lane & 31)]; }
    LDS_WAIT(); asm volatile("" ::: "memory");
    const int c = lane & 7;
#pragma unroll
    for (int j = 0; j < 4; ++j) { const int n = (lane >> 3) + 8 * j; const LAS float* s = scr + (8 * c) * 33 + n;
        v4u o; o.x = pk2(s[0 * 33], s[1 * 33]); o.y = pk2(s[2 * 33], s[3 * 33]); o.z = pk2(s[4 * 33], s[5 * 33]); o.w = pk2(s[6 * 33], s[7 * 33]);
        const int ng = n0 + n; const int drow = (mode == 0) ? ng : (ng + 128 * (ng / 128) + (mode == 2 ? 128 : 0));
        *(GAS v4u*)(WT + (size_t)drow * K + k0 + 8 * c) = o; }
    LDS_WAIT(); asm volatile("" ::: "memory");
}
constexpr int MOE_ITEMS = 24 * 16 * 112;
constexpr int MOE_DEFER = 3 * 5376;
__device__ __forceinline__ void moe_conv_item(KA a, int it, LAS float* scr, int lane) {
    constexpr int I_M = 16 * 112;
    unsigned char* ws = a->ws;
    const int idx = it / I_M, r = it % I_M;
    if (idx < 8) transpose_item(a->in[I_MG] + (size_t)idx * DM * EXD, DM, EXD, (bf16*)(ws + WS_MGU) + (size_t)idx * 2 * EXD * DM, 1, scr, r, lane);
    else if (idx < 16) transpose_item(a->in[I_MU] + (size_t)(idx - 8) * DM * EXD, DM, EXD, (bf16*)(ws + WS_MGU) + (size_t)(idx - 8) * 2 * EXD * DM, 2, scr, r, lane);
    else transpose_item(a->in[I_MDN] + (size_t)(idx - 16) * EXD * DM, EXD, DM, (bf16*)(ws + WS_MD) + (size_t)(idx - 16) * DM * EXD, 0, scr, r, lane);
}
__device__ __forceinline__ void moe_conv_slice(KA a, int s, int first, LAS unsigned char* lds, int lane, int wave, int G, int bid) {
    if (bid < first) return;
    LAS float* scr = (LAS float*)(lds + wave * 8704);
    const int nw = (G - first) * NWAVES, w = (bid - first) * NWAVES + wave, per = MOE_DEFER / 3;
    for (int i = w; i < per; i += nw) moe_conv_item(a, s * per + i, scr, lane);
}
__device__ __forceinline__ void p0_prologue(KA a, LAS unsigned char* lds, int tid, int lane, int wave, int G, int bid) {
    unsigned char* ws = a->ws;
    LAS float* scr = (LAS float*)(lds + wave * 8704);
    const int gw = bid * NWAVES + wave, NGW = G * NWAVES;
    constexpr int I_IN = 16 * 80, I_OUT = 16 * 32, I_F = 16 * 88, I_FDN = 44 * 32, I_M = 16 * 112;
    constexpr int NIT = 2 * I_IN + 2 * I_OUT + 2 * I_F + I_FDN + 24 * I_M;
    for (int it0 = gw; it0 < NIT; it0 += NGW) {
        int it = it0;
        if (it < 2 * I_IN) { const int l = it / I_IN, r = it % I_IN; transpose_item(a->in[I_WIN] + (size_t)l * DM * INW, DM, INW, (bf16*)(ws + WS_WIN) + (size_t)l * INW * DM, 0, scr, r, lane); continue; } it -= 2 * I_IN;
        if (it < 2 * I_OUT) { const int l = it / I_OUT, r = it % I_OUT; transpose_item(a->in[I_WOUT] + (size_t)l * DM * DM, DM, DM, (bf16*)(ws + WS_WOUT) + (size_t)l * DM * DM, 0, scr, r, lane); continue; } it -= 2 * I_OUT;
        if (it < I_F) { transpose_item(a->in[I_FG], DM, FFN, (bf16*)(ws + WS_WGU), 1, scr, it, lane); continue; } it -= I_F;
        if (it < I_F) { transpose_item(a->in[I_FU], DM, FFN, (bf16*)(ws + WS_WGU), 2, scr, it, lane); continue; } it -= I_F;
        if (it < I_FDN) { transpose_item(a->in[I_FD], FFN, DM, (bf16*)(ws + WS_WD), 0, scr, it, lane); continue; } it -= I_FDN;
        if (it >= MOE_DEFER) moe_conv_item(a, it, scr, lane);
    }
    LAS float* sil = (LAS float*)(lds + 69632);
    LAS float* part = (LAS float*)(lds + 69632 + 8192);
    float* vec = (float*)(ws + WS_VEC);
    if (bid < 192) {
        for (int i = tid; i < 2048; i += NTHR) { const float v = (i < 1024) ? a->in[I_C][i] : a->in[I_CCTX][i - 1024]; sil[i] = silu1(v); }
        __syncthreads();
        for (int item = bid; item < 192; item += G) {
            const int l = item / 96, cb = item % 96, col = cb * 64 + lane;
            const float* w = a->in[I_WADA] + (size_t)l * DM * 6144 + col;
            float a0 = 0.f, a1 = 0.f;
#pragma unroll 8
            for (int k = wave * 128; k < wave * 128 + 128; ++k) { const float wv = w[(size_t)k * 6144]; a0 += sil[k] * wv; a1 += sil[1024 + k] * wv; }
            part[(wave * 2 + 0) * 64 + lane] = a0; part[(wave * 2 + 1) * 64 + lane] = a1;
            __syncthreads();
            if (wave == 0) { float s0 = 0.f, s1 = 0.f;
#pragma unroll
                for (int w8 = 0; w8 < 8; ++w8) { s0 += part[(w8 * 2 + 0) * 64 + lane]; s1 += part[(w8 * 2 + 1) * 64 + lane]; }
                const float b = a->in[I_BADA][l * 6144 + col];
                vec[VO_MOD + (l * 2 + 0) * 6144 + col] = s0 + b; vec[VO_MOD + (l * 2 + 1) * 6144 + col] = s1 + b; }
            __syncthreads();
        }
    }
    for (int i = bid * NTHR + tid; i < C_CTX * DM / 4; i += G * NTHR) ((GAS f32x4*)(ws + WS_CTXR))[i] = ((const GAS f32x4*)a->in[I_CTX])[i];
    if (bid == G - 1) {
        for (int idx = tid; idx < 5120; idx += NTHR) {
            const int isc = idx >= 4096, j = isc ? idx - 4096 : idx, pos = j / 16, i = j % 16;
            const float inv = exp2f(-(float)i * 0.83048202372184059f);
            const float ang = (float)pos * inv;
            double r = (double)ang * 0.15915494309189535; r -= floor(r);
            const float rf = (float)r;
            const float cs = __builtin_amdgcn_cosf(rf), sn = __builtin_amdgcn_sinf(rf);
            float* t = vec + VO_ROPE + (isc ? 8192 : 0);
            const int n = isc ? 1024 : 4096;
            t[j] = cs; t[n + j] = sn;
        }
    }
}

__device__ __forceinline__ void norm_row(const float* xrow, const float* sc, const float* sh, bf16* orow, int lane, f32x4 (&h)[4]) {
    const GAS f32x4* xr = (const GAS f32x4*)xrow + lane;
    f32x4 v[4]; float s = 0.f;
#pragma unroll
    for (int j = 0; j < 4; ++j) { v[j] = xr[64 * j]; s += (v[j].x * v[j].x + v[j].y * v[j].y) + (v[j].z * v[j].z + v[j].w * v[j].w); }
    const float rstd = __builtin_amdgcn_rsqf(wave_sum(s) * (1.0f / DM) + EPS);
    GAS v2u* o8 = (GAS v2u*)orow + lane;
#pragma unroll
    for (int j = 0; j < 4; ++j) { const f32x4 scv = *(const f32x4*)(sc + 4 * lane + 256 * j), shv = *(const f32x4*)(sh + 4 * lane + 256 * j);
        h[j] = v[j] * rstd * (scv + 1.0f) + shv;
        v2u w; w.x = pk2(h[j].x, h[j].y); w.y = pk2(h[j].z, h[j].w); o8[64 * j] = w; }
}
__device__ __forceinline__ void phase_norm(KA a, int l, int which, int nrows, bf16* H, int lane, int wave, int G, int bid) {
    const float* vec = (const float*)(a->ws + WS_VEC);
    const float* xl = (l == 0 && which == 0) ? a->in[I_X] : a->out;
    const float* xc = (l == 0 && which == 0) ? a->in[I_CTX] : (const float*)(a->ws + WS_CTXR);
    const float* ml = vec + VO_MOD + (l * 2 + 0) * 6144 + which * 3072;
    const float* mc = vec + VO_MOD + (l * 2 + 1) * 6144 + which * 3072;
    const int gw = bid * NWAVES + wave, NGW = G * NWAVES;
    f32x4 scl[4], shl[4], v[4];
#pragma unroll
    for (int j = 0; j < 4; ++j) { scl[j] = *(const f32x4*)(ml + 1024 + 4 * lane + 256 * j) + 1.0f; shl[j] = *(const f32x4*)(ml + 4 * lane + 256 * j); }
    if (gw < nrows) { const GAS f32x4* xr = (const GAS f32x4*)(gw >= S_LAT ? xc + (size_t)(gw - S_LAT) * DM : xl + (size_t)gw * DM) + lane;
#pragma unroll
        for (int j = 0; j < 4; ++j) v[j] = xr[64 * j]; }
    for (int r = gw; r < nrows; r += NGW) {
        const int rn = r + NGW; f32x4 vn[4];
        if (rn < nrows) { const GAS f32x4* xr = (const GAS f32x4*)(rn >= S_LAT ? xc + (size_t)(rn - S_LAT) * DM : xl + (size_t)rn * DM) + lane;
#pragma unroll
            for (int j = 0; j < 4; ++j) vn[j] = xr[64 * j]; }
        float s = 0.f;
#pragma unroll
        for (int j = 0; j < 4; ++j) s += (v[j].x * v[j].x + v[j].y * v[j].y) + (v[j].z * v[j].z + v[j].w * v[j].w);
        const float rstd = __builtin_amdgcn_rsqf(wave_sum(s) * (1.0f / DM) + EPS);
        GAS v2u* o8 = (GAS v2u*)(H + (size_t)r * DM) + lane;
        if (r >= S_LAT) {
#pragma unroll
            for (int j = 0; j < 4; ++j) { const f32x4 scv = *(const f32x4*)(mc + 1024 + 4 * lane + 256 * j), shv = *(const f32x4*)(mc + 4 * lane + 256 * j);
                const f32x4 h = v[j] * rstd * (scv + 1.0f) + shv; v2u w; w.x = pk2(h.x, h.y); w.y = pk2(h.z, h.w); o8[64 * j] = w; }
        } else {
#pragma unroll
            for (int j = 0; j < 4; ++j) { const f32x4 h = v[j] * rstd * scl[j] + shl[j]; v2u w; w.x = pk2(h.x, h.y); w.y = pk2(h.z, h.w); o8[64 * j] = w; }
        }
#pragma unroll
        for (int j = 0; j < 4; ++j) v[j] = vn[j];
    }
}
__device__ __forceinline__ void phase_norm_route(KA a, LAS unsigned char* lds, int tid, int lane, int wave, int G, int bid) {
    const int l = 1;
    const float* vec = (const float*)(a->ws + WS_VEC);
    const float* ml = vec + VO_MOD + (l * 2 + 0) * 6144 + 3072;
    bf16* H = (bf16*)(a->ws + WS_H2B);
    LAS float* rt = (LAS float*)lds;
    volatile LAS unsigned* lcnt = (volatile LAS unsigned*)(lds + 32768);
    for (int i = tid; i < 8192; i += NTHR) rt[i] = a->in[I_ROUTER][i];
    if (tid < 16) lcnt[tid] = 0u;
    __syncthreads();
    int* tokinfo = (int*)(a->ws + WS_TOK);
    unsigned* cnt = (unsigned*)(a->ws + WS_CTL) + CW_MOECNT;
    const int gw = bid * NWAVES + wave, NGW = G * NWAVES;
    unsigned keep = 0u, pk0 = 0u; int itn = 0;
    for (int r = gw; r < S_LAT; r += NGW) {
        f32x4 h[4];
        norm_row(a->out + (size_t)r * DM, ml + 1024, ml, H + (size_t)r * DM, lane, h);
        float lg[8];
#pragma unroll
        for (int e = 0; e < 8; ++e) lg[e] = 0.f;
#pragma unroll
        for (int j = 0; j < 4; ++j)
#pragma unroll
            for (int i = 0; i < 4; ++i) { const int d = 4 * lane + 256 * j + i; const f32x4 r0 = *(const LAS f32x4*)(rt + d * 8), r1 = *(const LAS f32x4*)(rt + d * 8 + 4); const float hv = h[j][i];
                lg[0] += hv * r0.x; lg[1] += hv * r0.y; lg[2] += hv * r0.z; lg[3] += hv * r0.w; lg[4] += hv * r1.x; lg[5] += hv * r1.y; lg[6] += hv * r1.z; lg[7] += hv * r1.w; }
#pragma unroll
        for (int e = 0; e < 8; ++e) lg[e] = wave_sum(lg[e]);
        int i1 = 0; float v1 = lg[0];
#pragma unroll
        for (int e = 1; e < 8; ++e) if (lg[e] > v1) { v1 = lg[e]; i1 = e; }
        int i2 = -1; float v2 = -INFINITY;
#pragma unroll
        for (int e = 0; e < 8; ++e) if (e != i1 && lg[e] > v2) { v2 = lg[e]; i2 = e; }
        const float w1 = 1.0f / (1.0f + __expf(v2 - v1)), w2 = 1.0f - w1;
        if (lane == 0) {
            const unsigned r1 = __hip_atomic_fetch_add((LAS unsigned*)lcnt + i1, 1u, __ATOMIC_RELAXED, __HIP_MEMORY_SCOPE_WORKGROUP), r2 = __hip_atomic_fetch_add((LAS unsigned*)lcnt + i2, 1u, __ATOMIC_RELAXED, __HIP_MEMORY_SCOPE_WORKGROUP);
            int* ti = tokinfo + (size_t)r * 8;
            ti[0] = i1; ti[1] = i2; ti[4] = __builtin_bit_cast(int, w1); ti[5] = __builtin_bit_cast(int, w2);
            pk0 = (unsigned)i1 | ((unsigned)i2 << 3) | (r1 << 6) | (r2 << 19);
        }
        const unsigned pku = (unsigned)__builtin_amdgcn_readfirstlane((int)pk0);
        if (lane == itn) keep = pku;
        ++itn;
    }
    __syncthreads();
    if (tid < 8) lcnt[8 + tid] = __hip_atomic_fetch_add(cnt + 64 * tid, lcnt[tid], RLX_AGENT);
    __syncthreads();
    { const int r = gw + lane * NGW; if (lane < itn && r < S_LAT) { int* ti = tokinfo + (size_t)r * 8; const unsigned e1 = keep & 7u, e2 = (keep >> 3) & 7u; ti[2] = (int)(((keep >> 6) & 0x1fffu) + lcnt[8 + e1]); ti[3] = (int)((keep >> 19) + lcnt[8 + e2]); } }
}

__device__ __forceinline__ void qk_prep(KA a, int l, int first_thread, int nthreads) {
    bf16* PROJ = (bf16*)(a->ws + WS_PROJ);
    const float* rope = (const float*)(a->ws + WS_VEC) + VO_ROPE;
    for (int i = first_thread; i < R_ALL * 10; i += nthreads) {
        const int row = i / 10, hh = i % 10; const bool isq = hh < 8;
        bf16* p = PROJ + (size_t)row * INW + (isq ? hh * 64 : COL_AK + (hh - 8) * 64);
        const float* gain = (isq ? a->in[I_QG] : a->in[I_KG]) + l * 64;
        float x[64]; float ss = 0.f;
#pragma unroll
        for (int c = 0; c < 8; ++c) { const v4u w = *(const GAS v4u*)(p + 8 * c); unpack8(w, x + 8 * c); }
#pragma unroll
        for (int d = 0; d < 64; ++d) ss += x[d] * x[d];
        const float rstd = __builtin_amdgcn_rsqf(ss * (1.0f / 64.0f) + EPS);
        const f32x4* g4 = (const f32x4*)gain;
#pragma unroll
        for (int c = 0; c < 16; ++c) { const f32x4 gv = g4[c]; x[4 * c] *= rstd * gv.x; x[4 * c + 1] *= rstd * gv.y; x[4 * c + 2] *= rstd * gv.z; x[4 * c + 3] *= rstd * gv.w; }
        if (row < S_LAT) {
            const int gr = row >> 6, gc = row & 63;
            const f32x4* cr = (const f32x4*)(rope + gr * 16); const f32x4* sr = (const f32x4*)(rope + 4096 + gr * 16); const f32x4* cc = (const f32x4*)(rope + 8192 + gc * 16); const f32x4* sc = (const f32x4*)(rope + 8192 + 1024 + gc * 16);
#pragma unroll
            for (int j4 = 0; j4 < 4; ++j4) { const f32x4 cv = cr[j4], sv = sr[j4];
#pragma unroll
                for (int i = 0; i < 4; ++i) { const int j = 4 * j4 + i; const float x1 = x[j], x2 = x[16 + j]; x[j] = x1 * cv[i] - x2 * sv[i]; x[16 + j] = x1 * sv[i] + x2 * cv[i]; } }
#pragma unroll
            for (int j4 = 0; j4 < 4; ++j4) { const f32x4 cv = cc[j4], sv = sc[j4];
#pragma unroll
                for (int i = 0; i < 4; ++i) { const int j = 4 * j4 + i; const float x1 = x[32 + j], x2 = x[48 + j]; x[32 + j] = x1 * cv[i] - x2 * sv[i]; x[48 + j] = x1 * sv[i] + x2 * cv[i]; } }
        }
        const float qs = isq ? 0.125f * 1.4426950408889634f : 1.0f;
#pragma unroll
        for (int c = 0; c < 8; ++c) { v4u w; w.x = pk2(x[8 * c] * qs, x[8 * c + 1] * qs); w.y = pk2(x[8 * c + 2] * qs, x[8 * c + 3] * qs); w.z = pk2(x[8 * c + 4] * qs, x[8 * c + 5] * qs); w.w = pk2(x[8 * c + 6] * qs, x[8 * c + 7] * qs);
            *(GAS v4u*)(p + 8 * c) = w; }
    }
}
__device__ __forceinline__ void gmlp_unit(KA a, int l, int chunk, int g, LAS unsigned char* lds, int tid, int lane, int wave) {
    const bf16* PROJ = (const bf16*)(a->ws + WS_PROJ); bf16* MIX = (bf16*)(a->ws + WS_MIX);
    const int row0 = (chunk < 128) ? chunk * 128 : S_LAT + (chunk - 128) * 128;
    LAS float* vn = (LAS float*)lds;
    { const int pos = tid >> 2, part = tid & 3;
      const bf16* p = PROJ + (size_t)(row0 + pos) * INW + COL_GV + g * 64 + part * 16;
      float x[16]; unpack8(*(const GAS v4u*)p, x); unpack8(*(const GAS v4u*)(p + 8), x + 8);
      float ss = 0.f;
#pragma unroll
      for (int d = 0; d < 16; ++d) { x[d] = gelu1(x[d]); ss += x[d] * x[d]; }
      ss += sx<1>(ss); ss += sx<2>(ss);
      const float rstd = __builtin_amdgcn_rsqf(ss * (1.0f / 64.0f) + EPS);
      const float* gn = a->in[I_GNG] + l * 256 + g * 64 + part * 16;
#pragma unroll
      for (int d = 0; d < 16; ++d) vn[pos * 64 + part * 16 + d] = x[d] * rstd * gn[d]; }
    __syncthreads();
    const int c = lane, t0 = wave * 16;
    const float* W = a->in[I_GWS] + ((size_t)(l * 4 + g) * 128 + t0) * 128;
    float acc[16];
#pragma unroll
    for (int i = 0; i < 16; ++i) acc[i] = 0.f;
    for (int s = 0; s < 128; ++s) { const float v = vn[s * 64 + c];
#pragma unroll
        for (int i = 0; i < 16; ++i) acc[i] += W[i * 128 + s] * v; }
    const float* bs = a->in[I_GBS] + (l * 4 + g) * 128 + t0;
#pragma unroll
    for (int i = 0; i < 16; ++i) { const int row = row0 + t0 + i;
        const float u = gelu1(bflo((unsigned)PROJ[(size_t)row * INW + COL_GU + g * 64 + c]));
        MIX[(size_t)row * DM + MIX_GM + g * 64 + c] = (bf16)f2bf(u * (acc[i] + bs[i])); }
    __syncthreads();
}
__device__ __forceinline__ void hgrn_naive(KA a, int l, int dir, int head, LAS unsigned char* lds, int tid, int lane, int wave) {
    const bf16* PROJ = (const bf16*)(a->ws + WS_PROJ);
    float* HGO = (float*)(a->ws + WS_HGO) + (size_t)dir * R_ALL * 256;
    LAS float* Qs = (LAS float*)lds;
    LAS float* Fs = Qs + 4096; LAS float* Vs = Fs + 4096; LAS float* part = Vs + 4096;
    const int v = lane, kg = wave;
    float S[8];
#pragma unroll
    for (int i = 0; i < 8; ++i) S[i] = 0.f;
    const int tl = tid >> 3, c8 = tid & 7;
    float lb[8];
#pragma unroll
    for (int j = 0; j < 8; ++j) { float b = 0.f; if (l == 1) { const float p0 = a->in[I_HLB][dir * 512 + head * 64 + c8 * 8 + j], p1 = a->in[I_HLB][dir * 512 + 256 + head * 64 + c8 * 8 + j]; b = 1.0f / (1.0f + __expf(p0 - p1)); } lb[j] = b; }
    const int fcol = (dir == 0 ? COL_HFF : COL_HFB) + head * 64 + c8 * 8;
    for (int n0 = 0; n0 < R_ALL; n0 += 64) {
        { const int n = n0 + tl; int row;
          if (dir == 0) row = (n < C_CTX) ? S_LAT + n : n - C_CTX; else row = (n < C_CTX) ? S_LAT + (C_CTX - 1 - n) : (S_LAT - 1) - (n - C_CTX);
          const bf16* pr = PROJ + (size_t)row * INW;
          float q[8], f[8], vv[8];
          unpack8(*(const GAS v4u*)(pr + COL_HQ + head * 64 + c8 * 8), q); unpack8(*(const GAS v4u*)(pr + fcol), f); unpack8(*(const GAS v4u*)(pr + COL_HI + head * 64 + c8 * 8), vv);
#pragma unroll
          for (int j = 0; j < 8; ++j) { Qs[tl * 64 + c8 * 8 + j] = silu1(q[j]) * 0.125f; Fs[tl * 64 + c8 * 8 + j] = lb[j] + (1.0f - lb[j]) * sigm1(f[j]); Vs[tl * 64 + c8 * 8 + j] = vv[j]; } }
        __syncthreads();
        for (int t = 0; t < 64; ++t) {
            const float vt = Vs[t * 64 + v]; float po = 0.f;
#pragma unroll
            for (int i = 0; i < 8; ++i) { const float f = Fs[t * 64 + kg * 8 + i], q = Qs[t * 64 + kg * 8 + i]; S[i] = f * S[i] + (1.0f - f) * vt; po += S[i] * q; }
            part[((t & 1) * 8 + kg) * 64 + v] = po;
            __syncthreads();
            if (wave == 0) { float o = 0.f;
#pragma unroll
                for (int w8 = 0; w8 < 8; ++w8) o += part[((t & 1) * 8 + w8) * 64 + v];
                const int n = n0 + t; int row;
                if (dir == 0) row = (n < C_CTX) ? S_LAT + n : n - C_CTX; else row = (n < C_CTX) ? S_LAT + (C_CTX - 1 - n) : (S_LAT - 1) - (n - C_CTX);
                HGO[(size_t)row * 256 + head * 64 + v] = o; }
        }
        __syncthreads();
    }
}

typedef short bf16x8v __attribute__((ext_vector_type(8)));
constexpr int HST = 72;
__device__ __forceinline__ f32x4 mma16(const LAS bf16* MA, const LAS bf16* MBt, int k0, f32x4 c, int lane) {
    const bf16x8v av = *(const LAS bf16x8v*)(MA + (lane & 15) * HST + k0 + 8 * (lane >> 4));
    const bf16x8v bv = *(const LAS bf16x8v*)(MBt + (lane & 15) * HST + k0 + 8 * (lane >> 4));
    return __builtin_amdgcn_mfma_f32_16x16x32_bf16(av, bv, c, 0, 0, 0);
}
__device__ __forceinline__ int hg_base_row(int cpos) { return cpos < 256 ? 64 * cpos : S_LAT + 64 * (cpos - 256); }
__device__ __forceinline__ int hg_scan_idx(int dir, int cpos) { return dir == 0 ? (cpos < 256 ? 4 + cpos : cpos - 256) : (cpos < 256 ? 4 + (255 - cpos) : 3 - (cpos - 256)); }
__device__ __forceinline__ float hg_lb(KA a, int l, int dir, int head, int k) {
    if (l == 0) return 0.f;
    const float p0 = a->in[I_HLB][dir * 512 + head * 64 + k], p1 = a->in[I_HLB][dir * 512 + 256 + head * 64 + k];
    return 1.0f / (1.0f + __expf(p0 - p1));
}
__device__ __forceinline__ void hgrn_stepA(KA a, int l, int cpos, int head, LAS unsigned char* lds, int lane, int wave) {
    const bf16* PROJ = (const bf16*)(a->ws + WS_PROJ);
    const int dir = wave >> 2, I = wave & 3, base = hg_base_row(cpos), ci = hg_scan_idx(dir, cpos);
    LAS float* TOT = (LAS float*)lds;
    LAS bf16* KLT = (LAS bf16*)(lds + 2048) + dir * 64 * HST;
    LAS bf16* VT = (LAS bf16*)(lds + 2048 + 2 * 64 * HST * 2) + dir * 64 * HST;
    const float lb = hg_lb(a, l, dir, head, lane);
    const int fcol = (dir == 0 ? COL_HFF : COL_HFB) + head * 64 + lane, vcol = COL_HI + head * 64 + lane;
    float kk[16], cl[16]; float run = 0.f;
#pragma unroll
    for (int i = 0; i < 16; ++i) { const int n = 16 * I + i, row = base + (dir ? 63 - n : n);
        const float fl = bflo((unsigned)PROJ[(size_t)row * INW + fcol]);
        const unsigned short vb = PROJ[(size_t)row * INW + vcol];
        const float f = lb + (1.0f - lb) * sigm1(fl);
        run += __logf(f); cl[i] = run; kk[i] = 1.0f - f;
        VT[lane * HST + n] = vb; }
    TOT[(dir * 4 + I) * 64 + lane] = run;
    __syncthreads();
    float post = 0.f, all = 0.f;
#pragma unroll
    for (int J = 0; J < 4; ++J) { const float t = TOT[(dir * 4 + J) * 64 + lane]; all += t; if (J > I) post += t; }
#pragma unroll
    for (int i = 0; i < 16; ++i) KLT[lane * HST + 16 * I + i] = (bf16)f2bf(kk[i] * __expf(run - cl[i] + post));
    if (I == 0) ((float*)(a->ws + WS_HDG))[((size_t)(dir * 4 + head) * 260 + ci) * 64 + lane] = __expf(all);
    __syncthreads();
    float* LT = (float*)(a->ws + WS_HLT) + ((size_t)(dir * 4 + head) * 260 + ci) * 4096;
    float z0 = 0.f; asm volatile("" : "+v"(z0));
#pragma unroll
    for (int kb = 0; kb < 4; ++kb) { f32x4 acc = {z0, z0, z0, z0};
        acc = mma16(VT + 16 * I * HST, KLT + 16 * kb * HST, 0, acc, lane); acc = mma16(VT + 16 * I * HST, KLT + 16 * kb * HST, 32, acc, lane);
#pragma unroll
        for (int r = 0; r < 4; ++r) LT[(16 * I + 4 * (lane >> 4) + r) * 64 + 16 * kb + (lane & 15)] = acc[r]; }
    __syncthreads();
}
__device__ __forceinline__ void hgrn_stepB(KA a, int item, int tid) {
    const int dh = item >> 3, vb = item & 7, v = vb * 8 + (tid >> 6), k = tid & 63;
    const float* LT = (const float*)(a->ws + WS_HLT) + (size_t)dh * 260 * 4096 + v * 64 + k;
    const float* DG = (const float*)(a->ws + WS_HDG) + (size_t)dh * 260 * 64 + k;
    bf16* SP = (bf16*)(a->ws + WS_HSP) + (size_t)dh * 260 * 4096 + v * 64 + k;
    float S = 0.f;
#pragma unroll 1
    for (int c0 = 0; c0 < 260; c0 += 26) {
        float lt[26], dg[26];
#pragma unroll
        for (int j = 0; j < 26; ++j) { lt[j] = LT[(size_t)(c0 + j) * 4096]; dg[j] = DG[(c0 + j) * 64]; }
#pragma unroll
        for (int j = 0; j < 26; ++j) { SP[(size_t)(c0 + j) * 4096] = (bf16)f2bf(S); S = dg[j] * S + lt[j]; }
    }
}
__device__ __forceinline__ void hgrn_stepC(KA a, int l, int cpos, int head, LAS unsigned char* lds, int tid, int lane, int wave) {
    const bf16* PROJ = (const bf16*)(a->ws + WS_PROJ); bf16* MIX = (bf16*)(a->ws + WS_MIX);
    const int dir = wave >> 2, I = wave & 3, base = hg_base_row(cpos), ci = hg_scan_idx(dir, cpos);
    constexpr int MSZ = 64 * HST;
    LAS float* TOT = (LAS float*)lds;
    LAS bf16* img = (LAS bf16*)(lds + 2048);
    LAS bf16* QT = img + dir * MSZ;
    LAS bf16* QD = img + 2 * MSZ + dir * MSZ;
    LAS bf16* VT = img + 4 * MSZ + dir * MSZ;
    LAS bf16* ST = img + 6 * MSZ + dir * MSZ;
    LAS bf16* AS = img + 8 * MSZ + dir * MSZ + I * 16 * HST;
    LAS bf16* KT = img + 10 * MSZ + dir * (10 * 16 * HST);
    LAS float* OS = (LAS float*)(img + 10 * MSZ);
    const float lb = hg_lb(a, l, dir, head, lane);
    const int fcol = (dir == 0 ? COL_HFF : COL_HFB) + head * 64 + lane, qcol = COL_HQ + head * 64 + lane, vcol = COL_HI + head * 64 + lane;
    { const bf16* SP = (const bf16*)(a->ws + WS_HSP) + ((size_t)(dir * 4 + head) * 260 + ci) * 4096;
#pragma unroll
      for (int h2 = 0; h2 < 2; ++h2) { const int e = ((I * 2 + h2) * 64 + lane) * 8, vv = e >> 6, kk0 = e & 63;
          *(LAS v4u*)(ST + vv * HST + kk0) = *(const GAS v4u*)(SP + e); } }
    float kk[16], cl[16], qv[16]; float run = 0.f;
#pragma unroll
    for (int i = 0; i < 16; ++i) { const int n = 16 * I + i, row = base + (dir ? 63 - n : n);
        const float fl = bflo((unsigned)PROJ[(size_t)row * INW + fcol]), ql = bflo((unsigned)PROJ[(size_t)row * INW + qcol]);
        const unsigned short vb = PROJ[(size_t)row * INW + vcol];
        const float f = lb + (1.0f - lb) * sigm1(fl);
        run += __logf(f); cl[i] = run; kk[i] = 1.0f - f; qv[i] = silu1(ql) * 0.125f;
        VT[lane * HST + n] = vb; }
    TOT[(dir * 4 + I) * 64 + lane] = run;
    __syncthreads();
    float tj[4];
#pragma unroll
    for (int J = 0; J < 4; ++J) tj[J] = TOT[(dir * 4 + J) * 64 + lane];
    float pre = 0.f;
#pragma unroll
    for (int J = 0; J < 4; ++J) if (J < I) pre += tj[J];
#pragma unroll
    for (int i = 0; i < 16; ++i) { const float e = __expf(cl[i]); QT[(16 * I + i) * HST + lane] = (bf16)f2bf(qv[i] * e); QD[(16 * I + i) * HST + lane] = (bf16)f2bf(qv[i] * e * __expf(pre)); }
    float eoff = 0.f;
#pragma unroll
    for (int I2 = 0; I2 < 4; ++I2) {
        if (I2 >= I) {
            if (I2 == I) eoff = 0.f; else if (I2 == I + 1) eoff = run; else eoff += tj[I2 - 1];
            LAS bf16* blk = KT + (I2 * (I2 + 1) / 2 + I) * 16 * HST;
#pragma unroll
            for (int i = 0; i < 16; ++i) blk[i * HST + lane] = (bf16)f2bf(kk[i] * __expf(fminf(eoff - cl[i], 80.0f)));
        }
    }
    __syncthreads();
    float z0 = 0.f; asm volatile("" : "+v"(z0));
    f32x4 sc[4];
#pragma unroll
    for (int J = 0; J < 4; ++J) { sc[J] = (f32x4){z0, z0, z0, z0};
        if (J <= I) { const LAS bf16* kb = KT + (I * (I + 1) / 2 + J) * 16 * HST;
            sc[J] = mma16(QT + 16 * I * HST, kb, 0, sc[J], lane); sc[J] = mma16(QT + 16 * I * HST, kb, 32, sc[J], lane);
            if (J == I) {
#pragma unroll
                for (int r = 0; r < 4; ++r) if ((lane & 15) > 4 * (lane >> 4) + r) sc[J][r] = z0; } } }
#pragma unroll
    for (int J = 0; J < 4; ++J)
#pragma unroll
        for (int r = 0; r < 4; ++r) AS[(4 * (lane >> 4) + r) * HST + 16 * J + (lane & 15)] = (bf16)f2bf(sc[J][r]);
    asm volatile("s_waitcnt lgkmcnt(0)" ::: "memory");
    f32x4 acc[4];
#pragma unroll
    for (int vb = 0; vb < 4; ++vb) { acc[vb] = (f32x4){z0, z0, z0, z0};
        acc[vb] = mma16(AS, VT + 16 * vb * HST, 0, acc[vb], lane); acc[vb] = mma16(AS, VT + 16 * vb * HST, 32, acc[vb], lane);
        acc[vb] = mma16(QD + 16 * I * HST, ST + 16 * vb * HST, 0, acc[vb], lane); acc[vb] = mma16(QD + 16 * I * HST, ST + 16 * vb * HST, 32, acc[vb], lane); }
    __syncthreads();
#pragma unroll
    for (int vb = 0; vb < 4; ++vb)
#pragma unroll
        for (int r = 0; r < 4; ++r) { const int n = 16 * I + 4 * (lane >> 4) + r, rl = dir ? 63 - n : n; OS[(dir * 64 + rl) * 68 + 16 * vb + (lane & 15)] = acc[vb][r]; }
    __syncthreads();
    { const int rl = tid >> 3, v8 = (tid & 7) * 8, row = base + rl;
      float o[8]; float ss = 0.f;
#pragma unroll
      for (int j = 0; j < 8; ++j) { o[j] = OS[rl * 68 + v8 + j] + OS[(64 + rl) * 68 + v8 + j]; ss += o[j] * o[j]; }
      ss += sx<1>(ss); ss += sx<2>(ss); ss += sx<4>(ss);
      const float rstd = __builtin_amdgcn_rsqf(ss * (1.0f / 64.0f) + EPS);
      float gt[8]; unpack8(*(const GAS v4u*)(PROJ + (size_t)row * INW + COL_HG + head * 64 + v8), gt);
      const float* gn = a->in[I_HGAIN] + l * 64 + v8;
      float y[8];
#pragma unroll
      for (int j = 0; j < 8; ++j) y[j] = o[j] * rstd * gn[j] * silu1(gt[j]);
      v4u w; w.x = pk2(y[0], y[1]); w.y = pk2(y[2], y[3]); w.z = pk2(y[4], y[5]); w.w = pk2(y[6], y[7]);
      *(GAS v4u*)(MIX + (size_t)row * DM + MIX_HG + head * 64 + v8) = w; }
    __syncthreads();
}

__device__ __forceinline__ void vt_item(KA a, int item, int lane) {
    const bf16* PROJ = (const bf16*)(a->ws + WS_PROJ); bf16* VTg = (bf16*)(a->ws + WS_VT);
    const int rb = item >> 1, hk = item & 1, row = rb * 64 + lane;
    const bf16* p = PROJ + (size_t)row * INW + COL_AV + hk * 64;
    unsigned w[32];
#pragma unroll
    for (int c = 0; c < 8; ++c) { const v4u t = *(const GAS v4u*)(p + 8 * c); w[4 * c] = t.x; w[4 * c + 1] = t.y; w[4 * c + 2] = t.z; w[4 * c + 3] = t.w; }
    bf16* o = VTg + (size_t)hk * 64 * R_ALL + row;
#pragma unroll
    for (int d2 = 0; d2 < 32; ++d2) { o[(size_t)(2 * d2) * R_ALL] = (bf16)(w[d2] & 0xffffu); o[(size_t)(2 * d2 + 1) * R_ALL] = (bf16)(w[d2] >> 16); }
}
__device__ __forceinline__ void attn_unit(KA a, int l, int u, LAS unsigned char* lds, int tid, int lane, int wave) {
    asm volatile("" : "+v"(tid), "+v"(lane));
    const bf16* PROJ = (const bf16*)(a->ws + WS_PROJ); const bf16* VTg = (const bf16*)(a->ws + WS_VT); bf16* MIX = (bf16*)(a->ws + WS_MIX);
    const bool isctx = u >= 256; const int uu = isctx ? u - 256 : u; const int n = uu >> 1, hk = uu & 1;
    const int qh = hk * 4 + (wave >> 1), half = wave & 1;
    const int qbase = (isctx ? S_LAT : 0) + n * 128 + half * 64, qpos0 = n * 128 + half * 64;
    const int c = lane & 15, g = lane >> 4;
    LAS bf16* Kt = (LAS bf16*)lds; LAS bf16* Vt = Kt + 64 * HST; LAS bf16* Qw = Vt + 64 * HST + wave * 64 * HST;
#pragma unroll
    for (int j = 0; j < 8; ++j) { const int qr = 8 * j + (lane >> 3), qc = (lane & 7) * 8;
        *(LAS v4u*)(Qw + qr * HST + qc) = *(const GAS v4u*)(PROJ + (size_t)(qbase + qr) * INW + qh * 64 + qc); }
    float z0 = 0.f; asm volatile("" : "+v"(z0));
    f32x4 o[4][4]; float ls[4];
    float gq = 0.f, gk = 0.f;
#pragma unroll 8
    for (int d = 0; d < 64; ++d) { gq = fmaxf(gq, fabsf(a->in[I_QG][l * 64 + d])); gk = fmaxf(gk, fabsf(a->in[I_KG][l * 64 + d])); }
    const float nbnd = -(8.0f * 1.4426950408889634f) * gq * gk;
    const float sink = a->in[I_SINK][l * 8 + qh] * 1.4426950408889634f;
#pragma unroll
    for (int qt = 0; qt < 4; ++qt) { ls[qt] = (g == 0) ? __builtin_amdgcn_exp2f(sink + nbnd) : z0;
#pragma unroll
        for (int dt = 0; dt < 4; ++dt) o[qt][dt] = (f32x4){z0, z0, z0, z0}; }
    const int first = (!isctx && n == 0) ? 2 : 0, nwin = isctx ? 0 : ((n == 0 || n == 127) ? 4 : 6), nt = nwin + 4;
    const int lr = tid >> 3, lc = (tid & 7) * 8;
    v4u kreg, vreg;
#define ATT_LOADT(i) do { const bool ct_ = (i) >= nwin; const int kb_ = ct_ ? S_LAT + 64 * ((i) - nwin) : (n - 1) * 128 + 64 * (first + (i)); \
        kreg = *(const GAS v4u*)(PROJ + (size_t)(kb_ + lr) * INW + COL_AK + hk * 64 + lc); vreg = *(const GAS v4u*)(VTg + ((size_t)hk * 64 + lr) * R_ALL + kb_ + lc); } while (0)
    ATT_LOADT(0);
#pragma unroll 1
    for (int i = 0; i < nt; ++i) {
        __syncthreads();
        *(LAS v4u*)(Kt + lr * HST + lc) = kreg; *(LAS v4u*)(Vt + lr * HST + lc) = vreg;
        __syncthreads();
        if (i + 1 < nt) ATT_LOADT(i + 1);
        const bool win = i < nwin; const int kb = (n - 1) * 128 + 64 * (first + i);
        bf16x8v kf[4][2], vf[4][2];
#pragma unroll
        for (int kt = 0; kt < 4; ++kt)
#pragma unroll
            for (int ks = 0; ks < 2; ++ks) kf[kt][ks] = *(const LAS bf16x8v*)(Kt + (16 * kt + c) * HST + 32 * ks + 8 * g);
#pragma unroll
        for (int dt = 0; dt < 4; ++dt)
#pragma unroll
            for (int s2 = 0; s2 < 2; ++s2) { const v2u lo = *(const LAS v2u*)(Vt + (16 * dt + c) * HST + 32 * s2 + 4 * g), hi = *(const LAS v2u*)(Vt + (16 * dt + c) * HST + 32 * s2 + 16 + 4 * g);
                const v4u t = {lo.x, lo.y, hi.x, hi.y}; vf[dt][s2] = __builtin_bit_cast(bf16x8v, t); }
#pragma unroll
        for (int qt = 0; qt < 4; ++qt) {
            f32x4 s[4];
            const bf16x8v q0 = *(const LAS bf16x8v*)(Qw + (16 * qt + c) * HST + 8 * g), q1 = *(const LAS bf16x8v*)(Qw + (16 * qt + c) * HST + 32 + 8 * g);
#pragma unroll
            for (int kt = 0; kt < 4; ++kt) { s[kt] = (f32x4){nbnd, nbnd, nbnd, nbnd};
                s[kt] = __builtin_amdgcn_mfma_f32_16x16x32_bf16(kf[kt][0], q0, s[kt], 0, 0, 0); s[kt] = __builtin_amdgcn_mfma_f32_16x16x32_bf16(kf[kt][1], q1, s[kt], 0, 0, 0); }
            if (win) { const int dq = qpos0 + 16 * qt + c - kb - 4 * g;
#pragma unroll
                for (int kt = 0; kt < 4; ++kt)
#pragma unroll
                    for (int r = 0; r < 4; ++r) { const int dl = dq - 16 * kt - r; if (dl > 128 || dl < -128) s[kt][r] = -INFINITY; } }
            float ps = 0.f;
#pragma unroll
            for (int kt = 0; kt < 4; ++kt)
#pragma unroll
                for (int r = 0; r < 4; ++r) { s[kt][r] = __builtin_amdgcn_exp2f(s[kt][r]); ps += s[kt][r]; }
            ls[qt] += ps;
            bf16x8v pb[2];
#pragma unroll
            for (int s2 = 0; s2 < 2; ++s2) { const v4u t = {pk2(s[2 * s2][0], s[2 * s2][1]), pk2(s[2 * s2][2], s[2 * s2][3]), pk2(s[2 * s2 + 1][0], s[2 * s2 + 1][1]), pk2(s[2 * s2 + 1][2], s[2 * s2 + 1][3])};
                pb[s2] = __builtin_bit_cast(bf16x8v, t); }
#pragma unroll
            for (int dt = 0; dt < 4; ++dt) { o[qt][dt] = __builtin_amdgcn_mfma_f32_16x16x32_bf16(vf[dt][0], pb[0], o[qt][dt], 0, 0, 0); o[qt][dt] = __builtin_amdgcn_mfma_f32_16x16x32_bf16(vf[dt][1], pb[1], o[qt][dt], 0, 0, 0); }
        }
    }
#undef ATT_LOADT
    int c2 = lane & 15, g2 = lane >> 4; asm volatile("" : "+v"(c2), "+v"(g2));
#pragma unroll
    for (int qt = 0; qt < 4; ++qt) { float lt = ls[qt]; lt += sx<16>(lt); lt = sx32_add(lt); const float inv = 1.0f / lt;
        bf16* op = (bf16*)(a->ws + WS_MIX) + (size_t)(qbase + 16 * qt + c2) * DM + MIX_AT + qh * 64 + 4 * g2;
#pragma unroll
        for (int dt = 0; dt < 4; ++dt) { v2u w; w.x = pk2(o[qt][dt][0] * inv, o[qt][dt][1] * inv); w.y = pk2(o[qt][dt][2] * inv, o[qt][dt][3] * inv); *(GAS v2u*)(op + 16 * dt) = w; } }
}

constexpr int GST = 136;
__device__ __forceinline__ f32x4 mma16g(const LAS bf16* MA, const LAS bf16* MBt, int k0, f32x4 c, int lane) {
    const bf16x8v av = *(const LAS bf16x8v*)(MA + (lane & 15) * GST + k0 + 8 * (lane >> 4));
    const bf16x8v bv = *(const LAS bf16x8v*)(MBt + (lane & 15) * GST + k0 + 8 * (lane >> 4));
    return __builtin_amdgcn_mfma_f32_16x16x32_bf16(av, bv, c, 0, 0, 0);
}
__device__ __forceinline__ float gelu_as(float v) {
    const float av = fabsf(v), t = __builtin_amdgcn_rcpf(av * 0.2316418882f + 1.0f);
    float q = t * 0.5307027145f + (-0.7265760135f); q = q * t + 0.7107068705f; q = q * t + (-0.142248368f); q = q * t + 0.127414796f; q = q * t;
    const float e = __builtin_amdgcn_exp2f((v * v) * (-0.72134752044f)), mm = v * (q * e);
    return v < 0.f ? mm : v - mm;
}
__device__ __forceinline__ void gmlp_unit_mma(KA a, int l, int chunk, int g, LAS unsigned char* lds, int tid, int lane, int wave) {
    const bf16* PROJ = (const bf16*)(a->ws + WS_PROJ); bf16* MIX = (bf16*)(a->ws + WS_MIX);
    const int row0 = (chunk < 128) ? chunk * 128 : S_LAT + (chunk - 128) * 128;
    LAS bf16* WA = (LAS bf16*)lds;
    LAS bf16* VNT = WA + 128 * GST;
    LAS float* OUT = (LAS float*)(VNT + 64 * GST);
    const int pos = tid >> 2, part = tid & 3;
    {
      const float* W = a->in[I_GWS] + ((size_t)(l * 4 + g) * 128 + pos) * 128 + part * 32;
#pragma unroll
      for (int j = 0; j < 4; ++j) { const f32x4 w0 = *(const GAS f32x4*)(W + 8 * j), w1 = *(const GAS f32x4*)(W + 8 * j + 4);
          v4u o; o.x = pk2(w0.x, w0.y); o.y = pk2(w0.z, w0.w); o.z = pk2(w1.x, w1.y); o.w = pk2(w1.z, w1.w);
          *(LAS v4u*)(WA + pos * GST + part * 32 + 8 * j) = o; } }
    { const bf16* p = PROJ + (size_t)(row0 + pos) * INW + COL_GV + g * 64 + part * 16;
      float x[16]; unpack8(*(const GAS v4u*)p, x); unpack8(*(const GAS v4u*)(p + 8), x + 8);
      float ss = 0.f;
#pragma unroll
      for (int d = 0; d < 16; ++d) { x[d] = gelu_as(x[d]); ss += x[d] * x[d]; }
      ss += sx<1>(ss); ss += sx<2>(ss);
      const float rstd = __builtin_amdgcn_rsqf(ss * (1.0f / 64.0f) + EPS);
      const float* gn = a->in[I_GNG] + l * 256 + g * 64 + part * 16;
#pragma unroll
      for (int d = 0; d < 16; ++d) VNT[(part * 16 + d) * GST + pos] = (bf16)f2bf(x[d] * rstd * gn[d]); }
    __syncthreads();
    float z0 = 0.f; asm volatile("" : "+v"(z0));
#pragma unroll
    for (int cb = 0; cb < 4; ++cb) { f32x4 acc = {z0, z0, z0, z0};
#pragma unroll
        for (int ks = 0; ks < 4; ++ks) acc = mma16g(WA + 16 * wave * GST, VNT + 16 * cb * GST, 32 * ks, acc, lane);
#pragma unroll
        for (int r = 0; r < 4; ++r) OUT[(16 * wave + 4 * (lane >> 4) + r) * 68 + 16 * cb + (lane & 15)] = acc[r]; }
    __syncthreads();
    { const int row = row0 + pos; const float bsv = a->in[I_GBS][(l * 4 + g) * 128 + pos];
      const bf16* pu = PROJ + (size_t)row * INW + COL_GU + g * 64 + part * 16;
      float u[16]; unpack8(*(const GAS v4u*)pu, u); unpack8(*(const GAS v4u*)(pu + 8), u + 8);
      float y[16];
#pragma unroll
      for (int d = 0; d < 16; ++d) y[d] = gelu_as(u[d]) * (OUT[pos * 68 + part * 16 + d] + bsv);
      bf16* po = MIX + (size_t)row * DM + MIX_GM + g * 64 + part * 16;
      v4u w; w.x = pk2(y[0], y[1]); w.y = pk2(y[2], y[3]); w.z = pk2(y[4], y[5]); w.w = pk2(y[6], y[7]); *(GAS v4u*)po = w;
      w.x = pk2(y[8], y[9]); w.y = pk2(y[10], y[11]); w.z = pk2(y[12], y[13]); w.w = pk2(y[14], y[15]); *(GAS v4u*)(po + 8) = w; }
    __syncthreads();
}
__device__ __forceinline__ void attn_naive(KA a, int l, int nrows, int lane, int wave, int G, int bid) {
    const bf16* PROJ = (const bf16*)(a->ws + WS_PROJ); bf16* MIX = (bf16*)(a->ws + WS_MIX);
    const int gw = bid * NWAVES + wave, NGW = G * NWAVES;
    for (int pair = gw; pair < nrows * 2; pair += NGW) {
        const int row = pair >> 1, hk = pair & 1; const bool isctx = row >= S_LAT;
        float q[4], o[4], m[4], ls[4];
#pragma unroll
        for (int g = 0; g < 4; ++g) { q[g] = bflo((unsigned)PROJ[(size_t)row * INW + (hk * 4 + g) * 64 + lane]); o[g] = 0.f; ls[g] = 1.0f; m[g] = a->in[I_SINK][l * 8 + hk * 4 + g] * 1.4426950408889634f; }
        int j0 = 0, j1 = -1;
        if (!isctx) { j0 = row - 128 < 0 ? 0 : row - 128; j1 = row + 128 > S_LAT - 1 ? S_LAT - 1 : row + 128; }
        const int nwin = j1 - j0 + 1;
        const int nk = nwin + C_CTX;
#pragma unroll 4
        for (int t = 0; t < nk; ++t) {
            const int krow = (t < nwin) ? j0 + t : S_LAT + (t - nwin);
            const float k = bflo((unsigned)PROJ[(size_t)krow * INW + COL_AK + hk * 64 + lane]);
            const float v = bflo((unsigned)PROJ[(size_t)krow * INW + COL_AV + hk * 64 + lane]);
#pragma unroll
            for (int g = 0; g < 4; ++g) { const float s = wave_sum(q[g] * k); const float mn = fmaxf(m[g], s);
                const float c = __builtin_amdgcn_exp2f(m[g] - mn), p = __builtin_amdgcn_exp2f(s - mn);
                ls[g] = ls[g] * c + p; o[g] = o[g] * c + p * v; m[g] = mn; }
        }
#pragma unroll
        for (int g = 0; g < 4; ++g) MIX[(size_t)row * DM + MIX_AT + (hk * 4 + g) * 64 + lane] = (bf16)f2bf(o[g] / ls[g]);
    }
}
__device__ __forceinline__ void hgrn_combine(KA a, int l, int nrows, int lane, int wave, int G, int bid) {
    const bf16* PROJ = (const bf16*)(a->ws + WS_PROJ); bf16* MIX = (bf16*)(a->ws + WS_MIX);
    const float* O0 = (const float*)(a->ws + WS_HGO); const float* O1 = O0 + (size_t)R_ALL * 256;
    const f32x4 gn = *(const f32x4*)(a->in[I_HGAIN] + l * 64 + (lane & 15) * 4);
    const int gw = bid * NWAVES + wave, NGW = G * NWAVES;
    for (int r = gw; r < nrows; r += NGW) {
        const f32x4 o = *(const GAS f32x4*)(O0 + (size_t)r * 256 + 4 * lane) + *(const GAS f32x4*)(O1 + (size_t)r * 256 + 4 * lane);
        float ss = (o.x * o.x + o.y * o.y) + (o.z * o.z + o.w * o.w);
        ss += sx<1>(ss); ss += sx<2>(ss); ss += sx<4>(ss); ss += sx<8>(ss);
        const float rstd = __builtin_amdgcn_rsqf(ss * (1.0f / 64.0f) + EPS);
        const v2u gw2 = *(const GAS v2u*)(PROJ + (size_t)r * INW + COL_HG + 4 * lane);
        const float g0 = bflo(gw2.x), g1 = bfhi(gw2.x), g2 = bflo(gw2.y), g3 = bfhi(gw2.y);
        v2u w; w.x = pk2(o.x * rstd * gn.x * silu1(g0), o.y * rstd * gn.y * silu1(g1)); w.y = pk2(o.z * rstd * gn.z * silu1(g2), o.w * rstd * gn.w * silu1(g3));
        *(GAS v2u*)(MIX + (size_t)r * DM + MIX_HG + 4 * lane) = w;
    }
}
__device__ __forceinline__ void moe_gather(KA a, LAS unsigned char* lds, int tid, int lane, int wave, int G, int bid) {
    LAS int* sb = (LAS int*)lds;
    const unsigned* cnt = (const unsigned*)(a->ws + WS_CTL) + CW_MOECNT;
    int* mi = (int*)(a->ws + WS_VEC) + VO_MOE;
    if (tid == 0) { int b = 0;
        for (int e = 0; e < 8; ++e) { const int c = (int)__hip_atomic_load(cnt + 64 * e, RLX_AGENT); sb[e] = b; sb[16 + e] = c;
            const int nt = (c + 255) >> 8;
            if (bid == 0) for (int t = 0; t < nt; ++t) mi[16 + (b >> 8) + t] = e;
            b += nt << 8; }
        sb[8] = b; if (bid == 0) mi[0] = b >> 8; }
    __syncthreads();
    const bf16* H = (const bf16*)(a->ws + WS_H2B); bf16* AS = (bf16*)(a->ws + WS_AS);
    const int* tokinfo = (const int*)(a->ws + WS_TOK); int* tokslot = (int*)(a->ws + WS_TOK) + S_LAT * 8;
    const int gw = bid * NWAVES + wave, NGW = G * NWAVES;
    for (int t = gw; t < S_LAT; t += NGW) {
        const int* ti = tokinfo + (size_t)t * 8;
        const int e1 = ti[0], e2 = ti[1], r1 = ti[2], r2 = ti[3];
        const int s1 = sb[e1] + r1, s2 = sb[e2] + r2;
        const GAS v4u* src = (const GAS v4u*)(H + (size_t)t * DM) + lane;
        const v4u x0 = src[0], x1 = src[64];
        GAS v4u* d1 = (GAS v4u*)(AS + (size_t)s1 * DM) + lane; GAS v4u* d2 = (GAS v4u*)(AS + (size_t)s2 * DM) + lane;
        d1[0] = x0; d1[64] = x1; d2[0] = x0; d2[64] = x1;
        if (lane == 0) { int* ts = tokslot + (size_t)t * 4; ts[0] = s1; ts[1] = s2; ts[2] = ti[4]; ts[3] = ti[5]; }
    }
    { const f32x4 z4 = {0.f, 0.f, 0.f, 0.f}; for (int i = bid * NTHR + tid; i < 8 * 256 * DM / 4; i += G * NTHR) ((GAS f32x4*)(a->ws + WS_YF))[i] = z4; }
    for (int e = 0; e < 8; ++e) { const int c = sb[16 + e], pe = (c + 255) & ~255, b = sb[e];
        for (int j = c + gw; j < pe; j += NGW) { GAS v4u* d = (GAS v4u*)(AS + (size_t)(b + j) * DM) + lane; const v4u z = {0u, 0u, 0u, 0u}; d[0] = z; d[64] = z; } }
}
__device__ __forceinline__ void moe_combine(KA a, int lane, int wave, int G, int bid) {
    const float* gf = (const float*)(a->ws + WS_VEC) + VO_MOD + (1 * 2 + 0) * 6144 + 5 * 1024;
    const bf16* Y = (const bf16*)(a->ws + WS_Y); const int* tokslot = (const int*)(a->ws + WS_TOK) + S_LAT * 8;
    const int gw = bid * NWAVES + wave, NGW = G * NWAVES;
    for (int t = gw; t < S_LAT; t += NGW) {
        const int* ts = tokslot + (size_t)t * 4; const int s1 = ts[0], s2 = ts[1]; const float w1 = __builtin_bit_cast(float, ts[2]), w2 = __builtin_bit_cast(float, ts[3]);
        GAS f32x4* xr = (GAS f32x4*)(a->out + (size_t)t * DM) + lane;
        const float* YF = (const float*)(a->ws + WS_YF);
#pragma unroll
        for (int j = 0; j < 4; ++j) { const f32x4 g = *(const f32x4*)(gf + 4 * lane + 256 * j); f32x4 x = xr[64 * j]; f32x4 p, q;
            if (s1 < 32768) { const v2u t = ((const GAS v2u*)(Y + (size_t)s1 * DM) + lane)[64 * j]; p = (f32x4){bflo(t.x), bfhi(t.x), bflo(t.y), bfhi(t.y)}; } else p = ((const GAS f32x4*)(YF + (size_t)(s1 - 32768) * DM) + lane)[64 * j];
            if (s2 < 32768) { const v2u t = ((const GAS v2u*)(Y + (size_t)s2 * DM) + lane)[64 * j]; q = (f32x4){bflo(t.x), bfhi(t.x), bflo(t.y), bfhi(t.y)}; } else q = ((const GAS f32x4*)(YF + (size_t)(s2 - 32768) * DM) + lane)[64 * j];
            x = x + g * (p * w1 + q * w2);
            xr[64 * j] = x; }
    }
}

#define IN(k) (lo <= (k) && (k) < hi)
#define GRIDBAR() do { XcdBarrier b2_; b2_.bar = (unsigned*)(KARGS()->ws + WS_CTL) + CW_BAR; b2_.x = xb_xcc_id(); b2_.st = (volatile LAS unsigned*)(lds + MISC_OFF) + 8; xcd_barrier(b2_, wv0 * 64 + (int)__builtin_amdgcn_mbcnt_hi(~0u, __builtin_amdgcn_mbcnt_lo(~0u, 0u))); } while (0)
#define SEAM(k) do { if (IN(k) && IN((k) + 1)) GRIDBAR(); } while (0)
#define PHASE_ROOTS() KA a = KARGS(); unsigned char* ws = a->ws; const float* vec = (const float*)(ws + WS_VEC); (void)vec; int bid = blockIdx.x, G = gridDim.x; asm volatile("" : "+s"(bid), "+s"(G)); int tid = wv0 * 64 + (int)__builtin_amdgcn_mbcnt_hi(~0u, __builtin_amdgcn_mbcnt_lo(~0u, 0u)); asm volatile("" : "+v"(tid)); const int lane = tid & 63, wave = __builtin_amdgcn_readfirstlane(tid >> 6); (void)lane; (void)wave

template <int l> __device__ __forceinline__ void layer_body(const int lo, const int hi, LAS unsigned char* lds, const int wv0) {
        const int pb = 1 + 11 * l;
        if (IN(pb + 0)) { PHASE_ROOTS(); phase_norm(a, l, 0, R_ALL, (bf16*)(ws + WS_H), lane, wave, G, bid); SEAM(pb + 0); }
        if (IN(pb + 1)) {
            PHASE_ROOTS();
            pg8::Gemm g{(const pg8::bf16_t*)(ws + WS_H), (const pg8::bf16_t*)(ws + WS_WIN) + (size_t)l * INW * DM, R_ALL, INW, DM, 0, DM};
            pg8::StaticOrder S; S.init(R_ALL, INW, G, bid);
            pg8::EpiBf16<0> E{(pg8::bf16_t*)(ws + WS_PROJ), INW, nullptr, 0, 0, 1.f};
            pg8::gemm_phase<pg8::EpiBf16<0>, pg8::StaticOrder, true, true>(lds, g, S, E, tid);
            moe_conv_slice(a, l == 0 ? 0 : 2, 650 - 2 * 256, lds, lane, wave, G, bid);
            SEAM(pb + 1);
        }
        if (IN(pb + 2)) {
            PHASE_ROOTS();
            qk_prep(a, l, bid * NTHR + tid, G * NTHR);
            for (int it = bid * NWAVES + wave; it < 520; it += G * NWAVES) vt_item(a, it, lane);
            for (int it = bid; it < 1040; it += G) hgrn_stepA(a, l, it >> 2, it & 3, lds, lane, wave);
            SEAM(pb + 2);
        }
        if (IN(pb + 3)) {
            PHASE_ROOTS();
            if (bid < 64) hgrn_stepB(a, bid, tid);
            {
                const int nu = (l == 0) ? 260 : 256, ng = (l == 0) ? 520 : 512;
                unsigned* qctr = (unsigned*)(ws + WS_CTL) + CW_QUEUE + 64 * l;
                volatile LAS unsigned* qslot = (volatile LAS unsigned*)(lds + MISC_OFF) + 16;
                for (;;) {
                    __syncthreads();
                    if (tid == 0) qslot[0] = __hip_atomic_fetch_add(qctr, 1u, RLX_AGENT);
                    __syncthreads();
                    const int it = __builtin_amdgcn_readfirstlane((int)qslot[0]);
                    if (it >= nu + ng) break;
                    if (it < nu) attn_unit(a, l, it, lds, tid, lane, wave);
                    else gmlp_unit_mma(a, l, (it - nu) >> 2, (it - nu) & 3, lds, tid, lane, wave);
                }
            }
            SEAM(pb + 3);
        }
        if (IN(pb + 4)) {
            PHASE_ROOTS();
            const int nit = (l == 0) ? 1040 : 1024;
            for (int it = bid; it < nit; it += G) hgrn_stepC(a, l, it >> 2, it & 3, lds, tid, lane, wave);
            SEAM(pb + 4);
        }
        if (IN(pb + 5)) {
            PHASE_ROOTS();
            const float* modl = vec + VO_MOD + (l * 2 + 0) * 6144; const float* modc = vec + VO_MOD + (l * 2 + 1) * 6144;
            const int M = S_LAT;
            pg8::Gemm g{(const pg8::bf16_t*)(ws + WS_MIX), (const pg8::bf16_t*)(ws + WS_WOUT) + (size_t)l * DM * DM, M, DM, DM, 0, DM};
            pg8::StaticOrder S; S.init(M, DM, G, bid);
            pg8::EpiResid E{(l == 0) ? a->in[I_X] : a->out, a->out, modl + 2048, a->in[I_CTX], (float*)(ws + WS_CTXR), modc + 2048, S_LAT / 256, DM};
            pg8::gemm_phase<pg8::EpiResid, pg8::StaticOrder, true, true>(lds, g, S, E, tid);
            if (l == 0) {
                pg8::Gemm g2{(const pg8::bf16_t*)(ws + WS_MIX), (const pg8::bf16_t*)(ws + WS_WOUT), R_ALL, DM, 256, 0, DM};
                pg8::SplitKOrder S2{S_LAT / 256, 4, 4, 256, 16, bid, nullptr};
                pg8::EpiAtomic E2{(float*)(ws + WS_CTXR), modc + 2048, S_LAT / 256, DM};
                pg8::gemm_phase<pg8::EpiAtomic, pg8::SplitKOrder, false, true>(lds, g2, S2, E2, tid);
            }
            SEAM(pb + 5);
        }
        if (l == 0) {
            if (IN(pb + 6)) { PHASE_ROOTS(); phase_norm(a, l, 1, R_ALL, (bf16*)(ws + WS_H), lane, wave, G, bid); SEAM(pb + 6); }
            if (IN(pb + 7)) {
                PHASE_ROOTS();
                pg8::Gemm g{(const pg8::bf16_t*)(ws + WS_H), (const pg8::bf16_t*)(ws + WS_WGU), R_ALL, 2 * FFN, DM, 0, DM};
                pg8::StaticOrder S; S.init(R_ALL, 2 * FFN, G, bid);
                pg8::EpiSwiGLU E{(pg8::bf16_t*)(ws + WS_HID), FFN};
                pg8::gemm_phase<pg8::EpiSwiGLU, pg8::StaticOrder, true, true>(lds, g, S, E, tid);
                moe_conv_slice(a, 1, 1430 - 5 * 256, lds, lane, wave, G, bid);
                SEAM(pb + 7);
            }
            if (IN(pb + 8)) {
                PHASE_ROOTS();
                const float* modl = vec + VO_MOD + (l * 2 + 0) * 6144; const float* modc = vec + VO_MOD + (l * 2 + 1) * 6144;
                pg8::Gemm g{(const pg8::bf16_t*)(ws + WS_HID), (const pg8::bf16_t*)(ws + WS_WD), S_LAT, DM, FFN, 0, FFN};
                pg8::StaticOrder S; S.init(S_LAT, DM, G, bid);
                pg8::EpiResid E{a->out, a->out, modl + 5120, (const float*)(ws + WS_CTXR), (float*)(ws + WS_CTXR), modc + 5120, S_LAT / 256, DM};
                pg8::gemm_phase<pg8::EpiResid, pg8::StaticOrder, true, true>(lds, g, S, E, tid);
                {
                    pg8::Gemm g2{(const pg8::bf16_t*)(ws + WS_HID), (const pg8::bf16_t*)(ws + WS_WD), R_ALL, DM, 256, 0, FFN};
                    pg8::SplitKOrder S2{S_LAT / 256, 4, 11, 256, 44, bid, nullptr};
                    pg8::EpiAtomic E2{(float*)(ws + WS_CTXR), modc + 5120, S_LAT / 256, DM};
                    pg8::gemm_phase<pg8::EpiAtomic, pg8::SplitKOrder, false, true>(lds, g2, S2, E2, tid);
                }
                if (IN(pb + 8) && IN(pb + 11)) GRIDBAR();
            }
        } else {
            if (IN(pb + 6)) { PHASE_ROOTS(); phase_norm_route(a, lds, tid, lane, wave, G, bid); SEAM(pb + 6); }
            if (IN(pb + 7)) { PHASE_ROOTS(); moe_gather(a, lds, tid, lane, wave, G, bid); SEAM(pb + 7); }
            if (IN(pb + 8)) {
                PHASE_ROOTS();
                const int* mi = (const int*)(ws + WS_VEC) + VO_MOE; const int nt = __builtin_amdgcn_readfirstlane(mi[0]);
                pg8::Gemm g{(const pg8::bf16_t*)(ws + WS_AS), (const pg8::bf16_t*)(ws + WS_MGU), nt * 256, 2 * EXD, DM, (size_t)2 * EXD * DM * 2, DM};
                pg8::MoeOrder S; S.init(nt * 256, 2 * EXD, G, bid); S.tile_e = mi + 16;
                pg8::EpiSwiGLU E{(pg8::bf16_t*)(ws + WS_HIDM), EXD};
                pg8::gemm_phase<pg8::EpiSwiGLU, pg8::MoeOrder, true, true>(lds, g, S, E, tid);
                SEAM(pb + 8);
            }
            if (IN(pb + 9)) {
                PHASE_ROOTS();
                const int* mi = (const int*)(ws + WS_VEC) + VO_MOE; const int nt = __builtin_amdgcn_readfirstlane(mi[0]); const int nm = nt < 128 ? nt : 128;
                pg8::Gemm g{(const pg8::bf16_t*)(ws + WS_HIDM), (const pg8::bf16_t*)(ws + WS_MD), nm * 256, DM, EXD, (size_t)DM * EXD * 2, EXD};
                pg8::MoeOrder S; S.init(nm * 256, DM, G, bid); S.tile_e = mi + 16;
                pg8::EpiBf16<0> E{(pg8::bf16_t*)(ws + WS_Y), DM, nullptr, 0, 0, 1.f};
                pg8::gemm_phase<pg8::EpiBf16<0>, pg8::MoeOrder, true, true>(lds, g, S, E, tid);
                if (nt > 128) {
                    pg8::Gemm g2{(const pg8::bf16_t*)(ws + WS_HIDM), (const pg8::bf16_t*)(ws + WS_MD), nt * 256, DM, 512, (size_t)DM * EXD * 2, EXD};
                    pg8::SplitKOrder S2{128, 4, 7, 512, (nt - 128) * 28, bid, mi + 16};
                    pg8::EpiAtomic E2{(float*)(ws + WS_YF), nullptr, 128, DM};
                    pg8::gemm_phase<pg8::EpiAtomic, pg8::SplitKOrder, false, true>(lds, g2, S2, E2, tid);
                }
                SEAM(pb + 9);
            }
            if (IN(pb + 10)) { PHASE_ROOTS(); moe_combine(a, lane, wave, G, bid); }
        }
    }
__global__ void __launch_bounds__(NTHR, 2) fwd_kernel(Args a_unused) {
    extern __shared__ __attribute__((aligned(16))) unsigned char lds_raw[];
    LAS unsigned char* lds = (LAS unsigned char*)lds_raw;
    const int tid0 = threadIdx.x;
    const int wv0 = __builtin_amdgcn_readfirstlane(tid0 >> 6);
    for (int u = tid0; u < (LDS_BYTES - LDSCTL_OFF) / 4; u += NTHR) ((LAS unsigned*)(lds + LDSCTL_OFF))[u] = 0u;
    __syncthreads();
    const int lo = KARGS()->ph_lo, hi = KARGS()->ph_hi;
    const bool fusedl = (hi - lo) > 1;
    if (fusedl) (void)xcd_barrier_post((unsigned*)(KARGS()->ws + WS_CTL) + CW_BAR, (volatile LAS unsigned*)(lds + MISC_OFF) + 8);
    if (IN(0)) { PHASE_ROOTS(); p0_prologue(a, lds, tid, lane, wave, G, bid); SEAM(0); }

    layer_body<0>(lo, hi, lds, wv0);
    layer_body<1>(lo, hi, lds, wv0);
}

extern "C" void kernel_launch(void* const* d_in, const int* in_sizes, int n_in, void* d_out, int out_size, void* d_ws, size_t ws_size, hipStream_t stream) {
    static int grid = 0;
    if (grid == 0) {
        if (n_in != 23 || in_sizes[0] != S_LAT * DM || out_size != S_LAT * DM || ws_size < WS_END) { fprintf(stderr, "kernel_launch: unexpected shapes / workspace (n_in %d, ws %zu, need %zu)\n", n_in, ws_size, (size_t)WS_END); grid = -1; return; }
        int dev = 0, cus = 0;
        if (hipGetDevice(&dev) != hipSuccess || hipDeviceGetAttribute(&cus, hipDeviceAttributeMultiprocessorCount, dev) != hipSuccess) { grid = -1; return; }
        if (hipFuncSetAttribute((const void*)fwd_kernel, hipFuncAttributeMaxDynamicSharedMemorySize, LDS_BYTES) != hipSuccess) { grid = -1; return; }
        int per_cu = 0;
        (void)hipOccupancyMaxActiveBlocksPerMultiprocessor(&per_cu, (const void*)fwd_kernel, NTHR, LDS_BYTES);
        (void)hipGetLastError();
        grid = cus;
    }
    if (grid < 0) return;
    if (hipMemsetAsync((char*)d_ws + WS_CTL, 0, CTL_ZERO_BYTES, stream) != hipSuccess) return;
    Args a{};
    for (int i = 0; i < 23; ++i) a.in[i] = (const float*)d_in[i];
    a.out = (float*)d_out; a.ws = (unsigned char*)d_ws;
#if ONE_LAUNCH
    a.ph_lo = 0; a.ph_hi = NPH;
    hipLaunchKernelGGL(fwd_kernel, dim3(grid), dim3(NTHR), LDS_BYTES, stream, a);
#else
    for (int p = 0; p < NPH; ++p) {
        if (p == 10 || p == 11) continue;
        a.ph_lo = p; a.ph_hi = p + 1;
        hipLaunchKernelGGL(fwd_kernel, dim3(grid), dim3(NTHR), LDS_BYTES, stream, a);
    }
#endif
}
```

```cpp
#include <hip/hip_runtime.h>
#include <cstdio>
#include <cstdint>
#include <cmath>
#ifndef ONE_LAUNCH
#define ONE_LAUNCH 1
#endif
namespace pg8 {
#define PG8_LAS __attribute__((address_space(3)))
typedef unsigned short bf16_t;
typedef short bf16x8 __attribute__((ext_vector_type(8)));
typedef float f32x4 __attribute__((ext_vector_type(4)));
typedef unsigned u32x4 __attribute__((ext_vector_type(4)));
constexpr int BM = 256, BK = 64, HALF = 128, HTB = HALF * BK * 2  , STAGE_BYTES = 8 * HTB, NXCD = 8, WGM = 8;

__host__ __device__ __forceinline__ int lds_byte(int r, int c) { const int st = (r >> 4) * 2 + (c >> 5), rr = r & 15, cc = c & 31, ob = rr * 64 + cc * 2; return st * 1024 + (ob ^ (((ob >> 9) & 1) << 5)); }
__host__ __device__ __forceinline__ void stage_rc(int b, int& R, int& C) { const int st = b / 1024, sb = b % 1024, swz = sb ^ (((sb >> 9) & 1) << 5); R = (st >> 1) * 16 + swz / 64; C = (st & 1) * 32 + (swz % 64) / 2; }
__host__ __device__ __forceinline__ int perm32(int rho) { const int n = rho >> 4, i = rho & 15; return 8 * (i >> 2) + 4 * n + (i & 3); }

struct Unit { int pm, pn, eb, ko; };
struct Gemm { const bf16_t* A; const bf16_t* Bt; int M, N, K; size_t bstride; int ld; };

struct StaticOrder {
    int nM, nN, nwg, G, c;
    __host__ __device__ void init(int M, int N, int G_, int c_) { nM = M / BM; nN = N / BM; nwg = nM * nN; G = G_; c = c_; }
    __host__ __device__ bool next(int i, Unit& u) const {
        const long L = (long)i * G + c; if (L >= nwg) return false;
        int wgid = (int)L; { const int q = nwg / NXCD, r = nwg % NXCD, xcd = wgid % NXCD, off = wgid / NXCD; wgid = (xcd < r ? xcd * (q + 1) : r * (q + 1) + (xcd - r) * q) + off; }
        const int nig = WGM * nN, gid = wgid / nig, fm = gid * WGM, gsz = (nM - fm) < WGM ? (nM - fm) : WGM;
        u.pm = fm + ((wgid % nig) % gsz); u.pn = (wgid % nig) / gsz; u.eb = 0; u.ko = 0; return true;
    }
    __device__ __forceinline__ void a_ready(const Unit&) const {}
    __device__ __forceinline__ void done(const Unit&) const {}
};

__device__ __forceinline__ unsigned cvt_pk_bf16(float lo, float hi) { unsigned r; asm volatile("v_cvt_pk_bf16_f32 %0, %1, %2" : "=v"(r) : "v"(lo), "v"(hi)); return r; }
typedef float f32x2 __attribute__((ext_vector_type(2)));
__device__ __forceinline__ f32x2 gelu_pk(f32x2 v) {
    const f32x2 av = __builtin_elementwise_abs(v), d = av * 0.2316418882f + 1.0f;
    f32x2 t; t.x = __builtin_amdgcn_rcpf(d.x); t.y = __builtin_amdgcn_rcpf(d.y);
    f32x2 q = t * 0.5307027145f + (-0.7265760135f); q = q * t + 0.7107068705f; q = q * t + (-0.142248368f); q = q * t + 0.127414796f; q = q * t;
    const f32x2 s = (v * v) * (-0.72134752044f);
    f32x2 e; e.x = __builtin_amdgcn_exp2f(s.x); e.y = __builtin_amdgcn_exp2f(s.y);
    const f32x2 m = v * (q * e), r = v - m;
    f32x2 o; o.x = v.x < 0.f ? m.x : r.x; o.y = v.y < 0.f ? m.y : r.y; return o;
}

template <int ACT  > struct EpiBf16 {
    static constexpr bool PERM = true, AFTER_DRAIN = false; static_assert(ACT == 0 || ACT == 1, "EpiBf16: ACT is 0 (none) or 1 (gelu_pk)");
    bf16_t* O; int ldc; const float* bias; int split_cols; size_t split_stride; float scale0;
    __device__ __forceinline__ void operator()(const f32x4 (&acc)[2][2][4][2], const Unit& u, int wr, int wc, int fr, int fq) const {
        const int row0 = u.pm * BM + wr * 64 + fr; int colt = u.pn * BM; bf16_t* base = O;
        float sc = 1.f; if (split_cols) { const int t = colt / split_cols; base += (size_t)t * split_stride; colt -= t * split_cols; if (t == 0) sc = scale0; }
        const int col0 = colt + wc * 32 + 8 * fq, bcol0 = u.pn * BM + wc * 32 + 8 * fq;
        f32x4 bv[2][2];
#pragma unroll
        for (int bj = 0; bj < 2; ++bj)
#pragma unroll
            for (int n = 0; n < 2; ++n) bv[bj][n] = bias ? *(const f32x4*)(bias + bcol0 + bj * HALF + 4 * n) : (f32x4){0.f, 0.f, 0.f, 0.f};
#pragma unroll
        for (int ai = 0; ai < 2; ++ai)
#pragma unroll
            for (int m = 0; m < 4; ++m) { bf16_t* rowp = base + (size_t)(row0 + ai * HALF + m * 16) * ldc + col0;
#pragma unroll
                for (int bj = 0; bj < 2; ++bj) { f32x4 v0 = acc[ai][bj][m][0] + bv[bj][0], v1 = acc[ai][bj][m][1] + bv[bj][1];
                    if (ACT == 1) { f32x2 a = gelu_pk((f32x2){v0[0], v0[1]}), b = gelu_pk((f32x2){v0[2], v0[3]}), c = gelu_pk((f32x2){v1[0], v1[1]}), d = gelu_pk((f32x2){v1[2], v1[3]});
                        v0 = (f32x4){a.x, a.y, b.x, b.y}; v1 = (f32x4){c.x, c.y, d.x, d.y}; }
                    v0 = v0 * sc; v1 = v1 * sc; u32x4 w; w.x = cvt_pk_bf16(v0[0], v0[1]); w.y = cvt_pk_bf16(v0[2], v0[3]); w.z = cvt_pk_bf16(v1[0], v1[1]); w.w = cvt_pk_bf16(v1[2], v1[3]);
                    *(u32x4*)(rowp + bj * HALF) = w; } }
    }
};

__device__ __forceinline__ float silu_f(float x) { return x * __builtin_amdgcn_rcpf(1.0f + __builtin_amdgcn_exp2f(-1.4426950408889634f * x)); }
struct EpiResid {
    static constexpr bool PERM = false, AFTER_DRAIN = false;
    const float* base; float* out; const float* gate; const float* cbase; float* cout; const float* cgate; int mlat; int ldc;
    __device__ __forceinline__ void operator()(const f32x4 (&acc)[2][2][4][2], const Unit& u, int wr, int wc, int fr, int fq) const {
        const bool isc = u.pm >= mlat;
        const float* b = isc ? cbase : base; float* o = isc ? cout : out; const float* g = isc ? cgate : gate;
        const int row0 = (isc ? (u.pm - mlat) : u.pm) * BM + wr * 64 + fr, col0 = u.pn * BM + wc * 32 + 4 * fq;
        f32x4 gv[2][2];
#pragma unroll
        for (int bj = 0; bj < 2; ++bj)
#pragma unroll
            for (int n = 0; n < 2; ++n) gv[bj][n] = *(const f32x4*)(g + col0 + bj * HALF + n * 16);
#pragma unroll
        for (int ai = 0; ai < 2; ++ai)
#pragma unroll
            for (int m = 0; m < 4; ++m) { const size_t off = (size_t)(row0 + ai * HALF + m * 16) * ldc + col0;
#pragma unroll
                for (int bj = 0; bj < 2; ++bj)
#pragma unroll
                    for (int n = 0; n < 2; ++n) { const f32x4 bs = *(const f32x4*)(b + off + bj * HALF + n * 16); *(f32x4*)(o + off + bj * HALF + n * 16) = bs + gv[bj][n] * acc[ai][bj][m][n]; }
                if (m & 1) asm volatile("" ::: "memory"); }
    }
};
struct EpiSwiGLU {
    static constexpr bool PERM = true, AFTER_DRAIN = false;
    bf16_t* O; int ldc; float ds;
    __device__ __forceinline__ void operator()(const f32x4 (&acc)[2][2][4][2], const Unit& u, int wr, int wc, int fr, int fq) const {
        const int row0 = u.pm * BM + wr * 64 + fr, col0 = u.pn * HALF + wc * 32 + 8 * fq;
#pragma unroll
        for (int ai = 0; ai < 2; ++ai)
#pragma unroll
            for (int m = 0; m < 4; ++m) { bf16_t* rowp = O + (size_t)(row0 + ai * HALF + m * 16) * ldc + col0;
                const f32x4 g0 = acc[ai][0][m][0] * ds, g1 = acc[ai][0][m][1] * ds, u0 = acc[ai][1][m][0] * ds, u1 = acc[ai][1][m][1] * ds;
                f32x4 h0, h1;
#pragma unroll
                for (int j = 0; j < 4; ++j) { h0[j] = silu_f(g0[j]) * u0[j]; h1[j] = silu_f(g1[j]) * u1[j]; }
                u32x4 w; w.x = cvt_pk_bf16(h0[0], h0[1]); w.y = cvt_pk_bf16(h0[2], h0[3]); w.z = cvt_pk_bf16(h1[0], h1[1]); w.w = cvt_pk_bf16(h1[2], h1[3]);
                *(u32x4*)rowp = w; }
    }
};
struct MoeOrder : StaticOrder {
    const int* tile_e;
    __device__ __forceinline__ bool next(int i, Unit& u) const { if (!StaticOrder::next(i, u)) return false; u.eb = __builtin_amdgcn_readfirstlane(tile_e[u.pm]); return true; }
};

struct SplitKOrder {
    int pm0, nN, P, kp, total, c; const int* tile_e;
    __device__ __forceinline__ bool next(int i, Unit& u) const {
        if (i != 0 || c >= total) return false;
        const int p = c % P, t = c / P; u.pn = t % nN; u.pm = pm0 + t / nN; u.ko = p * kp; u.eb = tile_e ? __builtin_amdgcn_readfirstlane(tile_e[u.pm]) : 0; return true; }
    __device__ __forceinline__ void a_ready(const Unit&) const {}
    __device__ __forceinline__ void done(const Unit&) const {}
};
struct EpiAtomic {
    static constexpr bool PERM = false, AFTER_DRAIN = true;
    float* out; const float* scale; int pm_sub; int ldc;
    __device__ __forceinline__ void fused(f32x4 (&acc)[2][2][4][2], const Unit& u, int wr, int wc, int fr, int fq, PG8_LAS unsigned char* lds, int wid, int lane) const {
        PG8_LAS float* scr = (PG8_LAS float*)(lds + wid * 16384);
        const int rr = lane >> 5, cc = lane & 31;
#pragma unroll
        for (int ai = 0; ai < 2; ++ai)
#pragma unroll
            for (int bj = 0; bj < 2; ++bj) {
#pragma unroll
                for (int m = 0; m < 4; ++m)
#pragma unroll
                    for (int n = 0; n < 2; ++n) *(PG8_LAS f32x4*)(scr + (m * 16 + fr) * 36 + n * 16 + 4 * fq) = acc[ai][bj][m][n];
                asm volatile("s_waitcnt lgkmcnt(0)" ::: "memory");
                const int colg = u.pn * BM + bj * HALF + wc * 32 + cc; const float sc = scale ? scale[colg] : 1.0f;
                float* op = out + (size_t)((u.pm - pm_sub) * BM + ai * HALF + wr * 64 + rr) * ldc + colg;
#pragma unroll 8
                for (int i = 0; i < 32; ++i) { const float v = scr[(2 * i + rr) * 36 + cc]; __hip_atomic_fetch_add(op + (size_t)(2 * i) * ldc, v * sc, __ATOMIC_RELAXED, __HIP_MEMORY_SCOPE_AGENT); }
                asm volatile("s_waitcnt lgkmcnt(0)" ::: "memory");
            }
    }
};

typedef int i32x4v __attribute__((ext_vector_type(4))); typedef int i32x8v __attribute__((ext_vector_type(8)));
struct FragB { bf16x8 k[2]; };
struct Frag8 { i32x8v v; };
template <bool F8> struct FragSel { typedef FragB type; };
template <> struct FragSel<true> { typedef Frag8 type; };
__device__ __forceinline__ void ld_frag(FragB& f, const PG8_LAS unsigned char* p) { f.k[0] = *(const PG8_LAS bf16x8*)p; f.k[1] = *(const PG8_LAS bf16x8*)(p + 1024); }
__device__ __forceinline__ void ld_frag(Frag8& f, const PG8_LAS unsigned char* p) { const i32x4v lo = *(const PG8_LAS i32x4v*)p, hi = *(const PG8_LAS i32x4v*)(p + 1024); f.v = __builtin_shufflevector(lo, hi, 0, 1, 2, 3, 4, 5, 6, 7); }
__device__ __forceinline__ f32x4 mma_frag(const FragB& b, const FragB& a, f32x4 c) { c = __builtin_amdgcn_mfma_f32_16x16x32_bf16(b.k[0], a.k[0], c, 0, 0, 0); return __builtin_amdgcn_mfma_f32_16x16x32_bf16(b.k[1], a.k[1], c, 0, 0, 0); }
__device__ __forceinline__ f32x4 mma_frag(const Frag8& b, const Frag8& a, f32x4 c) {
    asm volatile("v_mfma_scale_f32_16x16x128_f8f6f4 %0, %1, %2, %0, %3, %3 op_sel_hi:[0,0,0]" : "+v"(c) : "v"(b.v), "v"(a.v), "v"(0x7f7f7f7f));
    return c;
}

template <class Epi, class Sched, bool ALIGN_EPI = false, bool SP2 = false, bool F8 = false>
__device__ __forceinline__ void gemm_phase(PG8_LAS unsigned char* lds, const Gemm g, const Sched& S, const Epi& E, int tid_in) {
    int tid_ = tid_in; asm volatile("" : "+v"(tid_));
    const int tid = tid_, wid = __builtin_amdgcn_readfirstlane(tid >> 6), lane = tid & 63, wr = wid >> 2, wc = wid & 3, fr = lane & 15, fq = lane >> 4;
    const int K = g.K, nt = K / BK, ld = g.ld;
    unsigned voffA[2], voffB[2];
#pragma unroll
    for (int i = 0; i < 2; ++i) { int R, C; stage_rc(tid * 16 + i * 8192, R, C); const int Rb = Epi::PERM ? ((R & ~31) + perm32(R & 31)) : R;
        voffA[i] = (unsigned)(R * ld + C) * 2u; voffB[i] = (unsigned)(Rb * ld + C) * 2u; }
    const size_t kstep = (size_t)(BK * 2);
    const size_t hstep = (size_t)HALF * ld * 2;
    const size_t tstep = 2 * hstep;
    const unsigned ldsw = (unsigned)wid * 1024u;
    const int aoff = lds_byte(wr * 64 + fr, fq * 8), boff = lds_byte(wc * 32 + fr, fq * 8);
#define PG8_SA(b, h) (((b) * 2 + (h)) * HTB)
#define PG8_SB(b, h) ((4 + (b) * 2 + (h)) * HTB)
#define PG8_STAGE(bufoff, gbase, voff) do { _Pragma("unroll") for (int _i = 0; _i < 2; ++_i) \
        __builtin_amdgcn_global_load_lds((const unsigned*)((const char*)(gbase) + (voff)[_i]), (PG8_LAS unsigned*)(lds + (bufoff) + ldsw + _i * 8192), 16, 0, 0); } while (0)
#define PG8_LDA(dst, b, h) do { _Pragma("unroll") for (int m = 0; m < 4; ++m) ld_frag(dst[m], lds + PG8_SA(b, h) + aoff + m * 2048); } while (0)
#define PG8_LDB(dst, b, h) do { _Pragma("unroll") for (int n = 0; n < 2; ++n) ld_frag(dst[n], lds + PG8_SB(b, h) + boff + n * 2048); } while (0)
#define PG8_MMA(ai, bj, At, Bt) do { __builtin_amdgcn_s_setprio(1); _Pragma("unroll") for (int m = 0; m < 4; ++m) _Pragma("unroll") for (int n = 0; n < 2; ++n) \
        acc[ai][bj][m][n] = mma_frag(Bt[n], At[m], acc[ai][bj][m][n]); __builtin_amdgcn_s_setprio(0); } while (0)
#define PG8_WAIT_V(n) asm volatile("s_waitcnt vmcnt(" #n ")" ::: "memory")
#define PG8_WAIT_L(n) asm volatile("s_waitcnt lgkmcnt(" #n ")" ::: "memory")
#define PG8_BAR __builtin_amdgcn_s_barrier()
#define PG8_SCHED __builtin_amdgcn_sched_barrier(0)
    Unit cur, nxt; int ui = 0;
    if (!S.next(0, cur)) return;
    float zacc = 0.f; asm volatile("" : "+v"(zacc));
    f32x4 acc[2][2][4][2];
#pragma unroll
    for (int a = 0; a < 2; ++a)
#pragma unroll
        for (int b = 0; b < 2; ++b)
#pragma unroll
            for (int m = 0; m < 4; ++m)
#pragma unroll
                for (int n = 0; n < 2; ++n) acc[a][b][m][n] = (f32x4){zacc, zacc, zacc, zacc};
    typedef typename FragSel<F8>::type Frag;
    Frag At[4], B0[2], B1[2];
    const char* cA = (const char*)g.A + (size_t)cur.pm * tstep + (size_t)cur.ko * 2; const char* cB = (const char*)g.Bt + (size_t)cur.eb * g.bstride + (size_t)cur.pn * tstep + (size_t)cur.ko * 2;
    S.a_ready(cur);
    if constexpr (SP2) {
        PG8_STAGE(PG8_SB(0, 0), cB, voffB); PG8_STAGE(PG8_SB(0, 1), cB + hstep, voffB); PG8_STAGE(PG8_SA(0, 0), cA, voffA); PG8_STAGE(PG8_SA(0, 1), cA + hstep, voffA);
        if (wr == 1) PG8_BAR;
        PG8_WAIT_V(2); PG8_BAR;
        PG8_STAGE(PG8_SB(1, 0), cB + kstep, voffB); PG8_STAGE(PG8_SA(1, 0), cA + kstep, voffA); PG8_STAGE(PG8_SB(1, 1), cB + hstep + kstep, voffB);
        PG8_WAIT_V(6); PG8_BAR;
    } else {
        PG8_STAGE(PG8_SB(0, 0), cB, voffB); PG8_STAGE(PG8_SA(0, 0), cA, voffA); PG8_STAGE(PG8_SB(0, 1), cB + hstep, voffB); PG8_STAGE(PG8_SA(0, 1), cA + hstep, voffA);
        if (wr == 1) PG8_BAR;
        PG8_WAIT_V(4); PG8_BAR;
        PG8_STAGE(PG8_SB(1, 0), cB + kstep, voffB); PG8_STAGE(PG8_SA(1, 0), cA + kstep, voffA); PG8_STAGE(PG8_SB(1, 1), cB + hstep + kstep, voffB);
        PG8_WAIT_V(6); PG8_BAR;
    }
    for (;;) {
        const bool has_next = S.next(ui + 1, nxt);
        const char* nA = has_next ? (const char*)g.A + (size_t)nxt.pm * tstep + (size_t)nxt.ko * 2 : cA; const char* nB = has_next ? (const char*)g.Bt + (size_t)nxt.eb * g.bstride + (size_t)nxt.pn * tstep + (size_t)nxt.ko * 2 : cB;
        for (int t = 0; t < nt; t += 2) {
            const bool last = (t == nt - 2);
            const char* a1 = cA + (size_t)(t + 1) * kstep;
            const char* a2 = last ? nA : cA + (size_t)(t + 2) * kstep; const char* b2 = last ? nB : cB + (size_t)(t + 2) * kstep;
            const char* a3 = a2 + kstep; const char* b3 = b2 + kstep;
            if (last && has_next) S.a_ready(nxt);
            if constexpr (SP2) {
            PG8_LDB(B0, 0, 0); PG8_LDB(B1, 0, 1); PG8_SCHED; PG8_LDA(At, 0, 0); PG8_STAGE(PG8_SA(1, 1), a1 + hstep, voffA);
            PG8_WAIT_V(8); PG8_WAIT_L(0); PG8_BAR; PG8_MMA(0, 0, At, B0); PG8_MMA(0, 1, At, B1); PG8_BAR; PG8_SCHED;
            PG8_LDA(At, 0, 1); PG8_STAGE(PG8_SB(0, 0), b2, voffB); PG8_STAGE(PG8_SB(0, 1), b2 + hstep, voffB); PG8_STAGE(PG8_SA(0, 0), a2, voffA);
            PG8_WAIT_V(8); PG8_WAIT_L(0); PG8_BAR; PG8_MMA(1, 0, At, B0); PG8_MMA(1, 1, At, B1); PG8_BAR; PG8_SCHED;
            PG8_LDB(B0, 1, 0); PG8_LDB(B1, 1, 1); PG8_SCHED; PG8_LDA(At, 1, 0); PG8_STAGE(PG8_SA(0, 1), a2 + hstep, voffA);
            PG8_WAIT_V(8); PG8_WAIT_L(0); PG8_BAR; PG8_MMA(0, 0, At, B0); PG8_MMA(0, 1, At, B1); PG8_BAR; PG8_SCHED;
            PG8_LDA(At, 1, 1); PG8_STAGE(PG8_SB(1, 0), b3, voffB); PG8_STAGE(PG8_SB(1, 1), b3 + hstep, voffB); PG8_STAGE(PG8_SA(1, 0), a3, voffA);
            PG8_WAIT_V(8); PG8_WAIT_L(0); PG8_BAR; PG8_MMA(1, 0, At, B0); PG8_MMA(1, 1, At, B1); PG8_BAR; PG8_SCHED;
            } else {
            PG8_LDB(B0, 0, 0); PG8_SCHED; PG8_LDA(At, 0, 0); PG8_STAGE(PG8_SA(1, 1), a1 + hstep, voffA);
            PG8_WAIT_L(8); PG8_BAR; PG8_WAIT_L(0); PG8_MMA(0, 0, At, B0); PG8_BAR; PG8_SCHED;
            PG8_LDB(B1, 0, 1); PG8_STAGE(PG8_SB(0, 0), b2, voffB);
            PG8_BAR; PG8_WAIT_L(0); PG8_MMA(0, 1, At, B1); PG8_BAR;
            PG8_LDA(At, 0, 1); PG8_STAGE(PG8_SA(0, 0), a2, voffA);
            PG8_BAR; PG8_WAIT_L(0); PG8_MMA(1, 0, At, B0); PG8_BAR; PG8_SCHED;
            PG8_STAGE(PG8_SB(0, 1), b2 + hstep, voffB);
            PG8_WAIT_V(6); PG8_BAR; PG8_MMA(1, 1, At, B1); PG8_BAR;
            PG8_LDB(B0, 1, 0); PG8_SCHED; PG8_LDA(At, 1, 0); PG8_STAGE(PG8_SA(0, 1), a2 + hstep, voffA);
            PG8_WAIT_L(8); PG8_BAR; PG8_WAIT_L(0); PG8_MMA(0, 0, At, B0); PG8_BAR; PG8_SCHED;
            PG8_LDB(B1, 1, 1); PG8_STAGE(PG8_SB(1, 0), b3, voffB);
            PG8_BAR; PG8_WAIT_L(0); PG8_MMA(0, 1, At, B1); PG8_BAR;
            PG8_LDA(At, 1, 1); PG8_STAGE(PG8_SA(1, 0), a3, voffA);
            PG8_BAR; PG8_WAIT_L(0); PG8_MMA(1, 0, At, B0); PG8_BAR; PG8_SCHED;
            PG8_STAGE(PG8_SB(1, 1), b3 + hstep, voffB);
            PG8_WAIT_V(6); PG8_BAR; PG8_MMA(1, 1, At, B1); PG8_BAR;
            }
        }
        if constexpr (ALIGN_EPI) { if (wr == 0) PG8_BAR; }
        if constexpr (F8) {
            asm volatile("s_nop 15\n\ts_nop 15" : "+v"(acc[1][1][0][0]), "+v"(acc[1][1][0][1]), "+v"(acc[1][1][1][0]), "+v"(acc[1][1][1][1]), "+v"(acc[1][1][2][0]), "+v"(acc[1][1][2][1]), "+v"(acc[1][1][3][0]), "+v"(acc[1][1][3][1])); }
        if constexpr (!Epi::AFTER_DRAIN) { E(acc, cur, wr, wc, fr, fq); S.done(cur); }
        if (!has_next) break;
#pragma unroll
        for (int a = 0; a < 2; ++a)
#pragma unroll
            for (int b = 0; b < 2; ++b)
#pragma unroll
                for (int m = 0; m < 4; ++m)
#pragma unroll
                    for (int n = 0; n < 2; ++n) acc[a][b][m][n] = (f32x4){zacc, zacc, zacc, zacc};
        cur = nxt; cA = nA; cB = nB; ++ui;
        if constexpr (ALIGN_EPI) { if (wr == 1) PG8_BAR; }
    }
    PG8_WAIT_V(0);
    if constexpr (!ALIGN_EPI) { if (wr == 0) PG8_BAR; }
    PG8_BAR;
    if constexpr (Epi::AFTER_DRAIN) { E.fused(acc, cur, wr, wc, fr, fq, lds, wid, lane); S.done(cur); }
#undef PG8_SA
#undef PG8_SB
#undef PG8_STAGE
#undef PG8_LDA
#undef PG8_LDB
#undef PG8_MMA
#undef PG8_WAIT_V
#undef PG8_WAIT_L
#undef PG8_BAR
#undef PG8_SCHED
}
}


constexpr int S_LAT = 16384, C_CTX = 256, R_ALL = S_LAT + C_CTX, DM = 1024;
constexpr int INW = 2560, FFN = 2816, EXD = 3584, NEXP = 8;
constexpr int COL_AQ = 0, COL_AK = 512, COL_AV = 640, COL_HQ = 768, COL_HFF = 1024, COL_HFB = 1280, COL_HI = 1536, COL_HG = 1792, COL_GU = 2048, COL_GV = 2304;
constexpr int MIX_AT = 0, MIX_HG = 512, MIX_GM = 768;
constexpr int MOE_MAXROWS = 34816;
constexpr float EPS = 1e-6f;
constexpr int NWAVES = 8, NTHR = 512;
constexpr int NPH = 23;

constexpr size_t MiB = 1u << 20;
constexpr size_t WS_CTL = 0, CTL_ZERO_BYTES = 1 * MiB;
constexpr size_t WS_VEC = 1 * MiB;
constexpr size_t WS_TOK = 2 * MiB;
constexpr size_t WS_WIN = 3 * MiB;
constexpr size_t WS_WOUT = 13 * MiB;
constexpr size_t WS_WGU = 17 * MiB;
constexpr size_t WS_WD = 28 * MiB;
constexpr size_t WS_MGU = 34 * MiB;
constexpr size_t WS_MD = 146 * MiB;
constexpr size_t WS_H = 202 * MiB;
constexpr size_t WS_PROJ = 235 * MiB;
constexpr size_t WS_MIX = 317 * MiB;
constexpr size_t WS_HGO = 350 * MiB;
constexpr size_t WS_CTXR = 383 * MiB;
constexpr size_t WS_HLT = WS_HGO;
constexpr size_t WS_HSP = 384 * MiB;
constexpr size_t WS_HDG = 402 * MiB;
constexpr size_t WS_VT = 403 * MiB;
constexpr size_t WS_HID = WS_PROJ;
constexpr size_t WS_AS = 202 * MiB;
constexpr size_t WS_HIDM = 270 * MiB;
constexpr size_t WS_H2B = 440 * MiB;
constexpr size_t WS_YF = WS_WIN;
constexpr size_t WS_Y = WS_MGU;
constexpr size_t WS_END = 508 * MiB;
static_assert(WS_HID + (size_t)R_ALL * FFN * 2 <= WS_HGO && WS_AS + (size_t)MOE_MAXROWS * DM * 2 <= WS_HIDM && WS_HIDM + (size_t)MOE_MAXROWS * EXD * 2 <= WS_END, "ws map");
static_assert(WS_H2B >= WS_HIDM && WS_H2B + (size_t)S_LAT * DM * 2 <= WS_END && WS_H + (size_t)R_ALL * DM * 2 <= WS_PROJ && WS_PROJ + (size_t)R_ALL * INW * 2 <= WS_MIX && WS_MIX + (size_t)R_ALL * DM * 2 <= WS_HGO && WS_HGO + (size_t)2 * R_ALL * 256 * 4 <= WS_CTXR, "ws map 2");
constexpr int VO_MOD = 0;
constexpr int VO_ROPE = 32768;
constexpr int VO_MOE = 65536;
constexpr int CW_BAR = 4096;
constexpr int CW_QUEUE = 2048;
constexpr int CW_MOECNT = 1024;

constexpr int RING_BYTES = 131072;
constexpr int LDSCTL_OFF = 159744, MISC_OFF = LDSCTL_OFF + 320;
constexpr int LDS_BYTES = 163840;

#define GAS __attribute__((address_space(1)))
#define LAS __attribute__((address_space(3)))
typedef unsigned short bf16;
typedef unsigned v4u __attribute__((ext_vector_type(4)));
typedef unsigned v2u __attribute__((ext_vector_type(2)));
typedef float f32x4 __attribute__((ext_vector_type(4)));
typedef GAS unsigned gu32;
#define RLX_AGENT __ATOMIC_RELAXED, __HIP_MEMORY_SCOPE_AGENT
#define LDS_WAIT() asm volatile("s_waitcnt lgkmcnt(0)" ::: "memory")
typedef float f32x2_t __attribute__((ext_vector_type(2))); typedef __bf16 bf16x2_t __attribute__((ext_vector_type(2)));
__device__ __forceinline__ unsigned pk2(float lo, float hi) { const f32x2_t v = {lo, hi}; const bf16x2_t b = __builtin_convertvector(v, bf16x2_t); return __builtin_bit_cast(unsigned, b); }
__device__ __forceinline__ unsigned f2bf(float f) { return pk2(f, 0.f) & 0xffffu; }
__device__ __forceinline__ float bflo(unsigned w) { return __builtin_bit_cast(float, w << 16); }
__device__ __forceinline__ float bfhi(unsigned w) { return __builtin_bit_cast(float, w & 0xffff0000u); }
__device__ __forceinline__ float sigm1(float x) { return __builtin_amdgcn_rcpf(1.0f + __builtin_amdgcn_exp2f(-1.4426950408889634f * x)); }
__device__ __forceinline__ float silu1(float x) { return x * sigm1(x); }
__device__ __forceinline__ float gelu1(float x) { return 0.5f * x * (1.0f + erff(x * 0.70710678118654752f)); }
template <int X> __device__ __forceinline__ float sx(float v) { return __shfl_xor(v, X); }
__device__ __forceinline__ float sx32_add(float v) { return v + __shfl_xor(v, 32); }
__device__ __forceinline__ float sx32_max(float v) { return fmaxf(v, __shfl_xor(v, 32)); }
__device__ __forceinline__ float wave_sum(float v) { v += sx<1>(v); v += sx<2>(v); v += sx<4>(v); v += sx<8>(v); v += sx<16>(v); return sx32_add(v); }
__device__ __forceinline__ void unpack8(const v4u w, float* f) { f[0] = bflo(w.x); f[1] = bfhi(w.x); f[2] = bflo(w.y); f[3] = bfhi(w.y); f[4] = bflo(w.z); f[5] = bfhi(w.z); f[6] = bflo(w.w); f[7] = bfhi(w.w); }


__device__ __forceinline__ float clamp448(float x) { return fminf(fmaxf(x, -448.0f), 448.0f); }
__device__ __forceinline__ unsigned pk4_fp8(float a, float b, float c, float d) {
    unsigned w = 0u; w = __builtin_amdgcn_cvt_pk_fp8_f32(clamp448(a), clamp448(b), w, false); w = __builtin_amdgcn_cvt_pk_fp8_f32(clamp448(c), clamp448(d), w, true); return w; }
constexpr float F8_WSCALE = 128.0f;
constexpr float F8_ASCALE = 16.0f;
#define XB_TMO      128
#define XB_XCNT(j)  (256  + 64 * (j))
#define XB_XSUB(j)  (1280 + 64 * (j))
#define XB_XGEN(j)  (2304 + 64 * (j))
#define XB_TOP      3328
#define XB_TOPGEN   3392
#define XCD_BAR_WORDS 3456
#define XB_SPIN_CAP (1u << 18)

__device__ __forceinline__ unsigned xb_ld(unsigned* p)              { return __hip_atomic_load(p, __ATOMIC_RELAXED, __HIP_MEMORY_SCOPE_AGENT); }
__device__ __forceinline__ unsigned xb_add(unsigned* p, unsigned v) { return __hip_atomic_fetch_add(p, v, __ATOMIC_RELAXED, __HIP_MEMORY_SCOPE_AGENT); }
__device__ __forceinline__ unsigned xb_xcc_id() { return (unsigned)__builtin_amdgcn_s_getreg((3 << 11) | 20) & 0xFu; }
#define XB_SPIN(cond, bar) do { unsigned _sp = 0; while (cond) { __builtin_amdgcn_s_sleep(1); \
    if ((++_sp & 255u) == 0u) { if (xb_ld(&(bar)[XB_TMO])) break; if (_sp > XB_SPIN_CAP) { atomicAdd(&(bar)[XB_TMO], 1u); break; } } } } while (0)

struct XcdBarrier {
    unsigned* bar; unsigned x;
    volatile LAS unsigned* st;
};

__device__ __forceinline__ XcdBarrier xcd_barrier_post(unsigned* bar, volatile LAS unsigned* st) {
    XcdBarrier b; b.bar = bar; b.x = xb_xcc_id(); b.st = st;
    if (threadIdx.x == 0) (void)xb_add(&bar[XB_XCNT(b.x)], 1u);
    return b;
}
__device__ __forceinline__ void xcd_barrier_complete(unsigned* bar, unsigned x, unsigned& nloc, unsigned& nx) {
    const unsigned G = gridDim.x * gridDim.y * gridDim.z;
    unsigned sum, cnt, mine, sp = 0u;
    for (;;) {
        sum = 0u; cnt = 0u; mine = 0u;
#pragma unroll
        for (unsigned j = 0; j < 16; ++j) { const unsigned c = xb_ld(&bar[XB_XCNT(j)]); sum += c; cnt += (c > 0u) ? 1u : 0u; mine = (j == x) ? c : mine; }
        if (sum == G) break;
        __builtin_amdgcn_s_sleep(1);
        if ((++sp & 255u) == 0u) { if (xb_ld(&bar[XB_TMO])) break; if (sp > XB_SPIN_CAP) { atomicAdd(&bar[XB_TMO], 1u); break; } }
    }
    nloc = mine > 0u ? mine : 1u; nx = cnt > 0u ? cnt : 1u;
}

__device__ __forceinline__ void xcd_barrier(const XcdBarrier& b, const int tid_in) {
    asm volatile("s_waitcnt vmcnt(0)" ::: "memory");
    __syncthreads();
    if (tid_in == 0) {
        unsigned* bar = b.bar;
        __builtin_amdgcn_s_waitcnt(0);
        unsigned nloc = b.st[0], nx = b.st[1];
        if (nloc == 0u) { xcd_barrier_complete(bar, b.x, nloc, nx); b.st[0] = nloc; b.st[1] = nx; }
        const unsigned old = xb_add(&bar[XB_XSUB(b.x)], 1u);
        const unsigned gen = old / nloc;
        if (old + 1u == (gen + 1u) * nloc) {
            __builtin_amdgcn_fence(__ATOMIC_RELEASE, "agent");
            asm volatile("s_waitcnt vmcnt(0)" ::: "memory");
            const unsigned og = xb_add(&bar[XB_TOP], 1u);
            const unsigned tg = og / nx;
            if (og + 1u == (tg + 1u) * nx) xb_add(&bar[XB_TOPGEN], 1u);
            else XB_SPIN(xb_ld(&bar[XB_TOPGEN]) == tg, bar);
            __builtin_amdgcn_fence(__ATOMIC_ACQUIRE, "agent");
            xb_add(&bar[XB_XGEN(b.x)], 1u);
            asm volatile("s_waitcnt vmcnt(0)" ::: "memory");
        } else {
            XB_SPIN(xb_ld(&bar[XB_XGEN(b.x)]) == gen, bar);
            __builtin_amdgcn_fence(__ATOMIC_ACQUIRE, "agent");
            asm volatile("s_waitcnt vmcnt(0)" ::: "memory");
        }
    }
    __syncthreads();
}


struct Args { const float* in[23]; float* out; unsigned char* ws; int ph_lo, ph_hi; };
typedef const __attribute__((address_space(4))) Args* KA;
#define KARGS() ({ KA p_ = (KA)__builtin_amdgcn_kernarg_segment_ptr(); asm volatile("" : "+s"(p_)); p_; })
enum { I_X = 0, I_C, I_CTX, I_CCTX, I_WADA, I_BADA, I_WIN, I_WOUT, I_QG, I_KG, I_SINK, I_HLB, I_HGAIN, I_GWS, I_GBS, I_GNG, I_FG, I_FU, I_FD, I_ROUTER, I_MG, I_MU, I_MDN };

__device__ __forceinline__ void transpose_item(const float* W, int K, int N, bf16* WT, int mode, LAS float* scr, int item, int lane) {
    const int nblk = N / 32, kb = item / nblk, nb = item % nblk, k0 = 64 * kb, n0 = 32 * nb;
#pragma unroll 8
    for (int i = 0; i < 32; ++i) { const int kk = 2 * i + (lane >> 5); scr[kk * 33 + (lane & 31)] = W[(size_t)(k0 + kk) * N + n0 + (lane & 31)]; }
    LDS_WAIT(); asm volatile("" ::: "memory");
    const int c = lane & 7;
#pragma unroll
    for (int j = 0; j < 4; ++j) { const int n = (lane >> 3) + 8 * j; const LAS float* s = scr + (8 * c) * 33 + n;
        v4u o; o.x = pk2(s[0 * 33], s[1 * 33]); o.y = pk2(s[2 * 33], s[3 * 33]); o.z = pk2(s[4 * 33], s[5 * 33]); o.w = pk2(s[6 * 33], s[7 * 33]);
        const int ng = n0 + n; const int drow = (mode == 0) ? ng : (ng + 128 * (ng / 128) + (mode == 2 ? 128 : 0));
        *(GAS v4u*)(WT + (size_t)drow * K + k0 + 8 * c) = o; }
    LDS_WAIT(); asm volatile("" ::: "memory");
}
__device__ __forceinline__ void transpose_item8(const float* W, int K, int N, unsigned char* WT, int mode, LAS float* scr, int item, int lane) {
    const int nblk = N / 32, kb = item / nblk, nb = item % nblk, k0 = 64 * kb, n0 = 32 * nb;
#pragma unroll 8
    for (int i = 0; i < 32; ++i) { const int kk = 2 * i + (lane >> 5); scr[kk * 33 + (lane & 31)] = W[(size_t)(k0 + kk) * N + n0 + (lane & 31)]; }
    LDS_WAIT(); asm volatile("" ::: "memory");
    const int c = lane & 7;
#pragma unroll
    for (int j = 0; j < 4; ++j) { const int n = (lane >> 3) + 8 * j; const LAS float* s = scr + (8 * c) * 33 + n;
        v2u o; o.x = pk4_fp8(s[0 * 33] * F8_WSCALE, s[1 * 33] * F8_WSCALE, s[2 * 33] * F8_WSCALE, s[3 * 33] * F8_WSCALE); o.y = pk4_fp8(s[4 * 33] * F8_WSCALE, s[5 * 33] * F8_WSCALE, s[6 * 33] * F8_WSCALE, s[7 * 33] * F8_WSCALE);
        const int ng = n0 + n; const int drow = (mode == 0) ? ng : (ng + 128 * (ng / 128) + (mode == 2 ? 128 : 0));
        *(GAS v2u*)(WT + (size_t)drow * K + k0 + 8 * c) = o; }
    LDS_WAIT(); asm volatile("" ::: "memory");
}
constexpr int MOE_ITEMS = 24 * 16 * 112;
constexpr int MOE_DEFER = 3 * 5376;
__device__ __forceinline__ void moe_conv_item(KA a, int it, LAS float* scr, int lane) {
    constexpr int I_M = 16 * 112;
    unsigned char* ws = a->ws;
    const int idx = it / I_M, r = it % I_M;
    if (idx < 8) transpose_item8(a->in[I_MG] + (size_t)idx * DM * EXD, DM, EXD, (unsigned char*)(ws + WS_MGU) + (size_t)idx * 2 * EXD * DM, 1, scr, r, lane);
    else if (idx < 16) transpose_item8(a->in[I_MU] + (size_t)(idx - 8) * DM * EXD, DM, EXD, (unsigned char*)(ws + WS_MGU) + (size_t)(idx - 8) * 2 * EXD * DM, 2, scr, r, lane);
    else transpose_item(a->in[I_MDN] + (size_t)(idx - 16) * EXD * DM, EXD, DM, (bf16*)(ws + WS_MD) + (size_t)(idx - 16) * DM * EXD, 0, scr, r, lane);
}
__device__ __forceinline__ void moe_conv_slice(KA a, int s, int first, LAS unsigned char* lds, int lane, int wave, int G, int bid) {
    if (bid < first) return;
    LAS float* scr = (LAS float*)(lds + wave * 8704);
    const int nw = (G - first) * NWAVES, w = (bid - first) * NWAVES + wave, per = MOE_DEFER / 3;
    for (int i = w; i < per; i += nw) moe_conv_item(a, s * per + i, scr, lane);
}
__device__ __forceinline__ void p0_prologue(KA a, LAS unsigned char* lds, int tid, int lane, int wave, int G, int bid) {
    unsigned char* ws = a->ws;
    LAS float* scr = (LAS float*)(lds + wave * 8704);
    const int gw = bid * NWAVES + wave, NGW = G * NWAVES;
    constexpr int I_IN = 16 * 80, I_OUT = 16 * 32, I_F = 16 * 88, I_FDN = 44 * 32, I_M = 16 * 112;
    constexpr int NIT = 2 * I_IN + 2 * I_OUT + 2 * I_F + I_FDN + 24 * I_M;
    for (int it0 = gw; it0 < NIT; it0 += NGW) {
        int it = it0;
        if (it < 2 * I_IN) { const int l = it / I_IN, r = it % I_IN; transpose_item(a->in[I_WIN] + (size_t)l * DM * INW, DM, INW, (bf16*)(ws + WS_WIN) + (size_t)l * INW * DM, 0, scr, r, lane); continue; } it -= 2 * I_IN;
        if (it < 2 * I_OUT) { const int l = it / I_OUT, r = it % I_OUT; transpose_item(a->in[I_WOUT] + (size_t)l * DM * DM, DM, DM, (bf16*)(ws + WS_WOUT) + (size_t)l * DM * DM, 0, scr, r, lane); continue; } it -= 2 * I_OUT;
        if (it < I_F) { transpose_item(a->in[I_FG], DM, FFN, (bf16*)(ws + WS_WGU), 1, scr, it, lane); continue; } it -= I_F;
        if (it < I_F) { transpose_item(a->in[I_FU], DM, FFN, (bf16*)(ws + WS_WGU), 2, scr, it, lane); continue; } it -= I_F;
        if (it < I_FDN) { transpose_item(a->in[I_FD], FFN, DM, (bf16*)(ws + WS_WD), 0, scr, it, lane); continue; } it -= I_FDN;
        if (it >= MOE_DEFER) moe_conv_item(a, it, scr, lane);
    }
    LAS float* sil = (LAS float*)(lds + 69632);
    LAS float* part = (LAS float*)(lds + 69632 + 8192);
    float* vec = (float*)(ws + WS_VEC);
    if (bid < 192) {
        for (int i = tid; i < 2048; i += NTHR) { const float v = (i < 1024) ? a->in[I_C][i] : a->in[I_CCTX][i - 1024]; sil[i] = silu1(v); }
        __syncthreads();
        for (int item = bid; item < 192; item += G) {
            const int l = item / 96, cb = item % 96, col = cb * 64 + lane;
            const float* w = a->in[I_WADA] + (size_t)l * DM * 6144 + col;
            float a0 = 0.f, a1 = 0.f;
#pragma unroll 8
            for (int k = wave * 128; k < wave * 128 + 128; ++k) { const float wv = w[(size_t)k * 6144]; a0 += sil[k] * wv; a1 += sil[1024 + k] * wv; }
            part[(wave * 2 + 0) * 64 + lane] = a0; part[(wave * 2 + 1) * 64 + lane] = a1;
            __syncthreads();
            if (wave == 0) { float s0 = 0.f, s1 = 0.f;
#pragma unroll
                for (int w8 = 0; w8 < 8; ++w8) { s0 += part[(w8 * 2 + 0) * 64 + lane]; s1 += part[(w8 * 2 + 1) * 64 + lane]; }
                const float b = a->in[I_BADA][l * 6144 + col];
                vec[VO_MOD + (l * 2 + 0) * 6144 + col] = s0 + b; vec[VO_MOD + (l * 2 + 1) * 6144 + col] = s1 + b; }
            __syncthreads();
        }
    }
    for (int i = bid * NTHR + tid; i < C_CTX * DM / 4; i += G * NTHR) ((GAS f32x4*)(ws + WS_CTXR))[i] = ((const GAS f32x4*)a->in[I_CTX])[i];
    if (bid == G - 1) {
        for (int idx = tid; idx < 5120; idx += NTHR) {
            const int isc = idx >= 4096, j = isc ? idx - 4096 : idx, pos = j / 16, i = j % 16;
            const float inv = exp2f(-(float)i * 0.83048202372184059f);
            const float ang = (float)pos * inv;
            double r = (double)ang * 0.15915494309189535; r -= floor(r);
            const float rf = (float)r;
            const float cs = __builtin_amdgcn_cosf(rf), sn = __builtin_amdgcn_sinf(rf);
            float* t = vec + VO_ROPE + (isc ? 8192 : 0);
            const int n = isc ? 1024 : 4096;
            t[j] = cs; t[n + j] = sn;
        }
    }
}

template <bool STORE = true> __device__ __forceinline__ void norm_row(const float* xrow, const float* sc, const float* sh, bf16* orow, int lane, f32x4 (&h)[4]) {
    const GAS f32x4* xr = (const GAS f32x4*)xrow + lane;
    f32x4 v[4]; float s = 0.f;
#pragma unroll
    for (int j = 0; j < 4; ++j) { v[j] = xr[64 * j]; s += (v[j].x * v[j].x + v[j].y * v[j].y) + (v[j].z * v[j].z + v[j].w * v[j].w); }
    const float rstd = __builtin_amdgcn_rsqf(wave_sum(s) * (1.0f / DM) + EPS);
    GAS v2u* o8 = (GAS v2u*)orow + lane;
#pragma unroll
    for (int j = 0; j < 4; ++j) { const f32x4 scv = *(const f32x4*)(sc + 4 * lane + 256 * j), shv = *(const f32x4*)(sh + 4 * lane + 256 * j);
        h[j] = v[j] * rstd * (scv + 1.0f) + shv;
        if constexpr (STORE) { v2u w; w.x = pk2(h[j].x, h[j].y); w.y = pk2(h[j].z, h[j].w); o8[64 * j] = w; } }
}
__device__ __forceinline__ void phase_norm(KA a, int l, int which, int nrows, bf16* H, int lane, int wave, int G, int bid) {
    const float* vec = (const float*)(a->ws + WS_VEC);
    const float* xl = (l == 0 && which == 0) ? a->in[I_X] : a->out;
    const float* xc = (l == 0 && which == 0) ? a->in[I_CTX] : (const float*)(a->ws + WS_CTXR);
    const float* ml = vec + VO_MOD + (l * 2 + 0) * 6144 + which * 3072;
    const float* mc = vec + VO_MOD + (l * 2 + 1) * 6144 + which * 3072;
    const int gw = bid * NWAVES + wave, NGW = G * NWAVES;
    f32x4 scl[4], shl[4], v[4];
#pragma unroll
    for (int j = 0; j < 4; ++j) { scl[j] = *(const f32x4*)(ml + 1024 + 4 * lane + 256 * j) + 1.0f; shl[j] = *(const f32x4*)(ml + 4 * lane + 256 * j); }
    if (gw < nrows) { const GAS f32x4* xr = (const GAS f32x4*)(gw >= S_LAT ? xc + (size_t)(gw - S_LAT) * DM : xl + (size_t)gw * DM) + lane;
#pragma unroll
        for (int j = 0; j < 4; ++j) v[j] = xr[64 * j]; }
    for (int r = gw; r < nrows; r += NGW) {
        const int rn = r + NGW; f32x4 vn[4];
        if (rn < nrows) { const GAS f32x4* xr = (const GAS f32x4*)(rn >= S_LAT ? xc + (size_t)(rn - S_LAT) * DM : xl + (size_t)rn * DM) + lane;
#pragma unroll
            for (int j = 0; j < 4; ++j) vn[j] = xr[64 * j]; }
        float s = 0.f;
#pragma unroll
        for (int j = 0; j < 4; ++j) s += (v[j].x * v[j].x + v[j].y * v[j].y) + (v[j].z * v[j].z + v[j].w * v[j].w);
        const float rstd = __builtin_amdgcn_rsqf(wave_sum(s) * (1.0f / DM) + EPS);
        GAS v2u* o8 = (GAS v2u*)(H + (size_t)r * DM) + lane;
        if (r >= S_LAT) {
#pragma unroll
            for (int j = 0; j < 4; ++j) { const f32x4 scv = *(const f32x4*)(mc + 1024 + 4 * lane + 256 * j), shv = *(const f32x4*)(mc + 4 * lane + 256 * j);
                const f32x4 h = v[j] * rstd * (scv + 1.0f) + shv; v2u w; w.x = pk2(h.x, h.y); w.y = pk2(h.z, h.w); o8[64 * j] = w; }
        } else {
#pragma unroll
            for (int j = 0; j < 4; ++j) { const f32x4 h = v[j] * rstd * scl[j] + shl[j]; v2u w; w.x = pk2(h.x, h.y); w.y = pk2(h.z, h.w); o8[64 * j] = w; }
        }
#pragma unroll
        for (int j = 0; j < 4; ++j) v[j] = vn[j];
    }
}
__device__ __forceinline__ void phase_norm_route(KA a, LAS unsigned char* lds, int tid, int lane, int wave, int G, int bid) {
    const int l = 1;
    const float* vec = (const float*)(a->ws + WS_VEC);
    const float* ml = vec + VO_MOD + (l * 2 + 0) * 6144 + 3072;
    unsigned char* H8 = (unsigned char*)(a->ws + WS_H2B);
    LAS float* rt = (LAS float*)lds;
    volatile LAS unsigned* lcnt = (volatile LAS unsigned*)(lds + 32768);
    for (int i = tid; i < 8192; i += NTHR) rt[i] = a->in[I_ROUTER][i];
    if (tid < 16) lcnt[tid] = 0u;
    __syncthreads();
    int* tokinfo = (int*)(a->ws + WS_TOK);
    unsigned* cnt = (unsigned*)(a->ws + WS_CTL) + CW_MOECNT;
    const int gw = bid * NWAVES + wave, NGW = G * NWAVES;
    unsigned keep = 0u, pk0 = 0u; int itn = 0;
    for (int r = gw; r < S_LAT; r += NGW) {
        f32x4 h[4];
        norm_row<false>(a->out + (size_t)r * DM, ml + 1024, ml, nullptr, lane, h);
#pragma unroll
        for (int j = 0; j < 4; ++j) ((GAS unsigned*)(H8 + (size_t)r * DM))[lane + 64 * j] = pk4_fp8(h[j].x * F8_ASCALE, h[j].y * F8_ASCALE, h[j].z * F8_ASCALE, h[j].w * F8_ASCALE);
        float lg[8];
#pragma unroll
        for (int e = 0; e < 8; ++e) lg[e] = 0.f;
#pragma unroll
        for (int j = 0; j < 4; ++j)
#pragma unroll
            for (int i = 0; i < 4; ++i) { const int d = 4 * lane + 256 * j + i; const f32x4 r0 = *(const LAS f32x4*)(rt + d * 8), r1 = *(const LAS f32x4*)(rt + d * 8 + 4); const float hv = h[j][i];
                lg[0] += hv * r0.x; lg[1] += hv * r0.y; lg[2] += hv * r0.z; lg[3] += hv * r0.w; lg[4] += hv * r1.x; lg[5] += hv * r1.y; lg[6] += hv * r1.z; lg[7] += hv * r1.w; }
#pragma unroll
        for (int e = 0; e < 8; ++e) lg[e] = wave_sum(lg[e]);
        int i1 = 0; float v1 = lg[0];
#pragma unroll
        for (int e = 1; e < 8; ++e) if (lg[e] > v1) { v1 = lg[e]; i1 = e; }
        int i2 = -1; float v2 = -INFINITY;
#pragma unroll
        for (int e = 0; e < 8; ++e) if (e != i1 && lg[e] > v2) { v2 = lg[e]; i2 = e; }
        const float w1 = 1.0f / (1.0f + __expf(v2 - v1)), w2 = 1.0f - w1;
        if (lane == 0) {
            const unsigned r1 = __hip_atomic_fetch_add((LAS unsigned*)lcnt + i1, 1u, __ATOMIC_RELAXED, __HIP_MEMORY_SCOPE_WORKGROUP), r2 = __hip_atomic_fetch_add((LAS unsigned*)lcnt + i2, 1u, __ATOMIC_RELAXED, __HIP_MEMORY_SCOPE_WORKGROUP);
            int* ti = tokinfo + (size_t)r * 8;
            ti[0] = i1; ti[1] = i2; ti[4] = __builtin_bit_cast(int, w1); ti[5] = __builtin_bit_cast(int, w2);
            pk0 = (unsigned)i1 | ((unsigned)i2 << 3) | (r1 << 6) | (r2 << 19);
        }
        const unsigned pku = (unsigned)__builtin_amdgcn_readfirstlane((int)pk0);
        if (lane == itn) keep = pku;
        ++itn;
    }
    __syncthreads();
    if (tid < 8) lcnt[8 + tid] = __hip_atomic_fetch_add(cnt + 64 * tid, lcnt[tid], RLX_AGENT);
    __syncthreads();
    { const int r = gw + lane * NGW; if (lane < itn && r < S_LAT) { int* ti = tokinfo + (size_t)r * 8; const unsigned e1 = keep & 7u, e2 = (keep >> 3) & 7u; ti[2] = (int)(((keep >> 6) & 0x1fffu) + lcnt[8 + e1]); ti[3] = (int)((keep >> 19) + lcnt[8 + e2]); } }
}

__device__ __forceinline__ void qk_prep(KA a, int l, int first_thread, int nthreads) {
    bf16* PROJ = (bf16*)(a->ws + WS_PROJ);
    const float* rope = (const float*)(a->ws + WS_VEC) + VO_ROPE;
    for (int i = first_thread; i < R_ALL * 10; i += nthreads) {
        const int row = i / 10, hh = i % 10; const bool isq = hh < 8;
        bf16* p = PROJ + (size_t)row * INW + (isq ? hh * 64 : COL_AK + (hh - 8) * 64);
        const float* gain = (isq ? a->in[I_QG] : a->in[I_KG]) + l * 64;
        float x[64]; float ss = 0.f;
#pragma unroll
        for (int c = 0; c < 8; ++c) { const v4u w = *(const GAS v4u*)(p + 8 * c); unpack8(w, x + 8 * c); }
#pragma unroll
        for (int d = 0; d < 64; ++d) ss += x[d] * x[d];
        const float rstd = __builtin_amdgcn_rsqf(ss * (1.0f / 64.0f) + EPS);
        const f32x4* g4 = (const f32x4*)gain;
#pragma unroll
        for (int c = 0; c < 16; ++c) { const f32x4 gv = g4[c]; x[4 * c] *= rstd * gv.x; x[4 * c + 1] *= rstd * gv.y; x[4 * c + 2] *= rstd * gv.z; x[4 * c + 3] *= rstd * gv.w; }
        if (row < S_LAT) {
            const int gr = row >> 6, gc = row & 63;
            const f32x4* cr = (const f32x4*)(rope + gr * 16); const f32x4* sr = (const f32x4*)(rope + 4096 + gr * 16); const f32x4* cc = (const f32x4*)(rope + 8192 + gc * 16); const f32x4* sc = (const f32x4*)(rope + 8192 + 1024 + gc * 16);
#pragma unroll
            for (int j4 = 0; j4 < 4; ++j4) { const f32x4 cv = cr[j4], sv = sr[j4];
#pragma unroll
                for (int i = 0; i < 4; ++i) { const int j = 4 * j4 + i; const float x1 = x[j], x2 = x[16 + j]; x[j] = x1 * cv[i] - x2 * sv[i]; x[16 + j] = x1 * sv[i] + x2 * cv[i]; } }
#pragma unroll
            for (int j4 = 0; j4 < 4; ++j4) { const f32x4 cv = cc[j4], sv = sc[j4];
#pragma unroll
                for (int i = 0; i < 4; ++i) { const int j = 4 * j4 + i; const float x1 = x[32 + j], x2 = x[48 + j]; x[32 + j] = x1 * cv[i] - x2 * sv[i]; x[48 + j] = x1 * sv[i] + x2 * cv[i]; } }
        }
        const float qs = isq ? 0.125f * 1.4426950408889634f : 1.0f;
#pragma unroll
        for (int c = 0; c < 8; ++c) { v4u w; w.x = pk2(x[8 * c] * qs, x[8 * c + 1] * qs); w.y = pk2(x[8 * c + 2] * qs, x[8 * c + 3] * qs); w.z = pk2(x[8 * c + 4] * qs, x[8 * c + 5] * qs); w.w = pk2(x[8 * c + 6] * qs, x[8 * c + 7] * qs);
            *(GAS v4u*)(p + 8 * c) = w; }
    }
}
__device__ __forceinline__ void gmlp_unit(KA a, int l, int chunk, int g, LAS unsigned char* lds, int tid, int lane, int wave) {
    const bf16* PROJ = (const bf16*)(a->ws + WS_PROJ); bf16* MIX = (bf16*)(a->ws + WS_MIX);
    const int row0 = (chunk < 128) ? chunk * 128 : S_LAT + (chunk - 128) * 128;
    LAS float* vn = (LAS float*)lds;
    { const int pos = tid >> 2, part = tid & 3;
      const bf16* p = PROJ + (size_t)(row0 + pos) * INW + COL_GV + g * 64 + part * 16;
      float x[16]; unpack8(*(const GAS v4u*)p, x); unpack8(*(const GAS v4u*)(p + 8), x + 8);
      float ss = 0.f;
#pragma unroll
      for (int d = 0; d < 16; ++d) { x[d] = gelu1(x[d]); ss += x[d] * x[d]; }
      ss += sx<1>(ss); ss += sx<2>(ss);
      const float rstd = __builtin_amdgcn_rsqf(ss * (1.0f / 64.0f) + EPS);
      const float* gn = a->in[I_GNG] + l * 256 + g * 64 + part * 16;
#pragma unroll
      for (int d = 0; d < 16; ++d) vn[pos * 64 + part * 16 + d] = x[d] * rstd * gn[d]; }
    __syncthreads();
    const int c = lane, t0 = wave * 16;
    const float* W = a->in[I_GWS] + ((size_t)(l * 4 + g) * 128 + t0) * 128;
    float acc[16];
#pragma unroll
    for (int i = 0; i < 16; ++i) acc[i] = 0.f;
    for (int s = 0; s < 128; ++s) { const float v = vn[s * 64 + c];
#pragma unroll
        for (int i = 0; i < 16; ++i) acc[i] += W[i * 128 + s] * v; }
    const float* bs = a->in[I_GBS] + (l * 4 + g) * 128 + t0;
#pragma unroll
    for (int i = 0; i < 16; ++i) { const int row = row0 + t0 + i;
        const float u = gelu1(bflo((unsigned)PROJ[(size_t)row * INW + COL_GU + g * 64 + c]));
        MIX[(size_t)row * DM + MIX_GM + g * 64 + c] = (bf16)f2bf(u * (acc[i] + bs[i])); }
    __syncthreads();
}
__device__ __forceinline__ void hgrn_naive(KA a, int l, int dir, int head, LAS unsigned char* lds, int tid, int lane, int wave) {
    const bf16* PROJ = (const bf16*)(a->ws + WS_PROJ);
    float* HGO = (float*)(a->ws + WS_HGO) + (size_t)dir * R_ALL * 256;
    LAS float* Qs = (LAS float*)lds;
    LAS float* Fs = Qs + 4096; LAS float* Vs = Fs + 4096; LAS float* part = Vs + 4096;
    const int v = lane, kg = wave;
    float S[8];
#pragma unroll
    for (int i = 0; i < 8; ++i) S[i] = 0.f;
    const int tl = tid >> 3, c8 = tid & 7;
    float lb[8];
#pragma unroll
    for (int j = 0; j < 8; ++j) { float b = 0.f; if (l == 1) { const float p0 = a->in[I_HLB][dir * 512 + head * 64 + c8 * 8 + j], p1 = a->in[I_HLB][dir * 512 + 256 + head * 64 + c8 * 8 + j]; b = 1.0f / (1.0f + __expf(p0 - p1)); } lb[j] = b; }
    const int fcol = (dir == 0 ? COL_HFF : COL_HFB) + head * 64 + c8 * 8;
    for (int n0 = 0; n0 < R_ALL; n0 += 64) {
        { const int n = n0 + tl; int row;
          if (dir == 0) row = (n < C_CTX) ? S_LAT + n : n - C_CTX; else row = (n < C_CTX) ? S_LAT + (C_CTX - 1 - n) : (S_LAT - 1) - (n - C_CTX);
          const bf16* pr = PROJ + (size_t)row * INW;
          float q[8], f[8], vv[8];
          unpack8(*(const GAS v4u*)(pr + COL_HQ + head * 64 + c8 * 8), q); unpack8(*(const GAS v4u*)(pr + fcol), f); unpack8(*(const GAS v4u*)(pr + COL_HI + head * 64 + c8 * 8), vv);
#pragma unroll
          for (int j = 0; j < 8; ++j) { Qs[tl * 64 + c8 * 8 + j] = silu1(q[j]) * 0.125f; Fs[tl * 64 + c8 * 8 + j] = lb[j] + (1.0f - lb[j]) * sigm1(f[j]); Vs[tl * 64 + c8 * 8 + j] = vv[j]; } }
        __syncthreads();
        for (int t = 0; t < 64; ++t) {
            const float vt = Vs[t * 64 + v]; float po = 0.f;
#pragma unroll
            for (int i = 0; i < 8; ++i) { const float f = Fs[t * 64 + kg * 8 + i], q = Qs[t * 64 + kg * 8 + i]; S[i] = f * S[i] + (1.0f - f) * vt; po += S[i] * q; }
            part[((t & 1) * 8 + kg) * 64 + v] = po;
            __syncthreads();
            if (wave == 0) { float o = 0.f;
#pragma unroll
                for (int w8 = 0; w8 < 8; ++w8) o += part[((t & 1) * 8 + w8) * 64 + v];
                const int n = n0 + t; int row;
                if (dir == 0) row = (n < C_CTX) ? S_LAT + n : n - C_CTX; else row = (n < C_CTX) ? S_LAT + (C_CTX - 1 - n) : (S_LAT - 1) - (n - C_CTX);
                HGO[(size_t)row * 256 + head * 64 + v] = o; }
        }
        __syncthreads();
    }
}

typedef short bf16x8v __attribute__((ext_vector_type(8)));
constexpr int HST = 72;
__device__ __forceinline__ f32x4 mma16(const LAS bf16* MA, const LAS bf16* MBt, int k0, f32x4 c, int lane) {
    const bf16x8v av = *(const LAS bf16x8v*)(MA + (lane & 15) * HST + k0 + 8 * (lane >> 4));
    const bf16x8v bv = *(const LAS bf16x8v*)(MBt + (lane & 15) * HST + k0 + 8 * (lane >> 4));
    return __builtin_amdgcn_mfma_f32_16x16x32_bf16(av, bv, c, 0, 0, 0);
}
__device__ __forceinline__ int hg_base_row(int cpos) { return cpos < 256 ? 64 * cpos : S_LAT + 64 * (cpos - 256); }
__device__ __forceinline__ int hg_scan_idx(int dir, int cpos) { return dir == 0 ? (cpos < 256 ? 4 + cpos : cpos - 256) : (cpos < 256 ? 4 + (255 - cpos) : 3 - (cpos - 256)); }
__device__ __forceinline__ float hg_lb(KA a, int l, int dir, int head, int k) {
    if (l == 0) return 0.f;
    const float p0 = a->in[I_HLB][dir * 512 + head * 64 + k], p1 = a->in[I_HLB][dir * 512 + 256 + head * 64 + k];
    return 1.0f / (1.0f + __expf(p0 - p1));
}
__device__ __forceinline__ void hgrn_stepA(KA a, int l, int cpos, int head, LAS unsigned char* lds, int lane, int wave) {
    const bf16* PROJ = (const bf16*)(a->ws + WS_PROJ);
    const int dir = wave >> 2, I = wave & 3, base = hg_base_row(cpos), ci = hg_scan_idx(dir, cpos);
    LAS float* TOT = (LAS float*)lds;
    LAS bf16* KLT = (LAS bf16*)(lds + 2048) + dir * 64 * HST;
    LAS bf16* VT = (LAS bf16*)(lds + 2048 + 2 * 64 * HST * 2) + dir * 64 * HST;
    const float lb = hg_lb(a, l, dir, head, lane);
    const int fcol = (dir == 0 ? COL_HFF : COL_HFB) + head * 64 + lane, vcol = COL_HI + head * 64 + lane;
    float kk[16], cl[16]; float run = 0.f;
#pragma unroll
    for (int i = 0; i < 16; ++i) { const int n = 16 * I + i, row = base + (dir ? 63 - n : n);
        const float fl = bflo((unsigned)PROJ[(size_t)row * INW + fcol]);
        const unsigned short vb = PROJ[(size_t)row * INW + vcol];
        const float f = lb + (1.0f - lb) * sigm1(fl);
        run += __logf(f); cl[i] = run; kk[i] = 1.0f - f;
        VT[lane * HST + n] = vb; }
    TOT[(dir * 4 + I) * 64 + lane] = run;
    __syncthreads();
    float post = 0.f, all = 0.f;
#pragma unroll
    for (int J = 0; J < 4; ++J) { const float t = TOT[(dir * 4 + J) * 64 + lane]; all += t; if (J > I) post += t; }
#pragma unroll
    for (int i = 0; i < 16; ++i) KLT[lane * HST + 16 * I + i] = (bf16)f2bf(kk[i] * __expf(run - cl[i] + post));
    if (I == 0) ((float*)(a->ws + WS_HDG))[((size_t)(dir * 4 + head) * 260 + ci) * 64 + lane] = __expf(all);
    __syncthreads();
    float* LT = (float*)(a->ws + WS_HLT) + ((size_t)(dir * 4 + head) * 260 + ci) * 4096;
    float z0 = 0.f; asm volatile("" : "+v"(z0));
#pragma unroll
    for (int kb = 0; kb < 4; ++kb) { f32x4 acc = {z0, z0, z0, z0};
        acc = mma16(VT + 16 * I * HST, KLT + 16 * kb * HST, 0, acc, lane); acc = mma16(VT + 16 * I * HST, KLT + 16 * kb * HST, 32, acc, lane);
#pragma unroll
        for (int r = 0; r < 4; ++r) LT[(16 * I + 4 * (lane >> 4) + r) * 64 + 16 * kb + (lane & 15)] = acc[r]; }
    __syncthreads();
}
__device__ __forceinline__ void hgrn_stepB(KA a, int item, int tid) {
    const int dh = item >> 3, vb = item & 7, v = vb * 8 + (tid >> 6), k = tid & 63;
    const float* LT = (const float*)(a->ws + WS_HLT) + (size_t)dh * 260 * 4096 + v * 64 + k;
    const float* DG = (const float*)(a->ws + WS_HDG) + (size_t)dh * 260 * 64 + k;
    bf16* SP = (bf16*)(a->ws + WS_HSP) + (size_t)dh * 260 * 4096 + v * 64 + k;
    float S = 0.f;
#pragma unroll 1
    for (int c0 = 0; c0 < 260; c0 += 26) {
        float lt[26], dg[26];
#pragma unroll
        for (int j = 0; j < 26; ++j) { lt[j] = LT[(size_t)(c0 + j) * 4096]; dg[j] = DG[(c0 + j) * 64]; }
#pragma unroll
        for (int j = 0; j < 26; ++j) { SP[(size_t)(c0 + j) * 4096] = (bf16)f2bf(S); S = dg[j] * S + lt[j]; }
    }
}
__device__ __forceinline__ void hgrn_stepC(KA a, int l, int cpos, int head, LAS unsigned char* lds, int tid, int lane, int wave) {
    const bf16* PROJ = (const bf16*)(a->ws + WS_PROJ); bf16* MIX = (bf16*)(a->ws + WS_MIX);
    const int dir = wave >> 2, I = wave & 3, base = hg_base_row(cpos), ci = hg_scan_idx(dir, cpos);
    constexpr int MSZ = 64 * HST;
    LAS float* TOT = (LAS float*)lds;
    LAS bf16* img = (LAS bf16*)(lds + 2048);
    LAS bf16* QT = img + dir * MSZ;
    LAS bf16* QD = img + 2 * MSZ + dir * MSZ;
    LAS bf16* VT = img + 4 * MSZ + dir * MSZ;
    LAS bf16* ST = img + 6 * MSZ + dir * MSZ;
    LAS bf16* AS = img + 8 * MSZ + dir * MSZ + I * 16 * HST;
    LAS bf16* KT = img + 10 * MSZ + dir * (10 * 16 * HST);
    LAS float* OS = (LAS float*)(img + 10 * MSZ);
    const float lb = hg_lb(a, l, dir, head, lane);
    const int fcol = (dir == 0 ? COL_HFF : COL_HFB) + head * 64 + lane, qcol = COL_HQ + head * 64 + lane, vcol = COL_HI + head * 64 + lane;
    { const bf16* SP = (const bf16*)(a->ws + WS_HSP) + ((size_t)(dir * 4 + head) * 260 + ci) * 4096;
#pragma unroll
      for (int h2 = 0; h2 < 2; ++h2) { const int e = ((I * 2 + h2) * 64 + lane) * 8, vv = e >> 6, kk0 = e & 63;
          *(LAS v4u*)(ST + vv * HST + kk0) = *(const GAS v4u*)(SP + e); } }
    float kk[16], cl[16], qv[16]; float run = 0.f;
#pragma unroll
    for (int i = 0; i < 16; ++i) { const int n = 16 * I + i, row = base + (dir ? 63 - n : n);
        const float fl = bflo((unsigned)PROJ[(size_t)row * INW + fcol]), ql = bflo((unsigned)PROJ[(size_t)row * INW + qcol]);
        const unsigned short vb = PROJ[(size_t)row * INW + vcol];
        const float f = lb + (1.0f - lb) * sigm1(fl);
        run += __logf(f); cl[i] = run; kk[i] = 1.0f - f; qv[i] = silu1(ql) * 0.125f;
        VT[lane * HST + n] = vb; }
    TOT[(dir * 4 + I) * 64 + lane] = run;
    __syncthreads();
    float tj[4];
#pragma unroll
    for (int J = 0; J < 4; ++J) tj[J] = TOT[(dir * 4 + J) * 64 + lane];
    float pre = 0.f;
#pragma unroll
    for (int J = 0; J < 4; ++J) if (J < I) pre += tj[J];
#pragma unroll
    for (int i = 0; i < 16; ++i) { const float e = __expf(cl[i]); QT[(16 * I + i) * HST + lane] = (bf16)f2bf(qv[i] * e); QD[(16 * I + i) * HST + lane] = (bf16)f2bf(qv[i] * e * __expf(pre)); }
    float eoff = 0.f;
#pragma unroll
    for (int I2 = 0; I2 < 4; ++I2) {
        if (I2 >= I) {
            if (I2 == I) eoff = 0.f; else if (I2 == I + 1) eoff = run; else eoff += tj[I2 - 1];
            LAS bf16* blk = KT + (I2 * (I2 + 1) / 2 + I) * 16 * HST;
#pragma unroll
            for (int i = 0; i < 16; ++i) blk[i * HST + lane] = (bf16)f2bf(kk[i] * __expf(fminf(eoff - cl[i], 80.0f)));
        }
    }
    __syncthreads();
    float z0 = 0.f; asm volatile("" : "+v"(z0));
    f32x4 sc[4];
#pragma unroll
    for (int J = 0; J < 4; ++J) { sc[J] = (f32x4){z0, z0, z0, z0};
        if (J <= I) { const LAS bf16* kb = KT + (I * (I + 1) / 2 + J) * 16 * HST;
            sc[J] = mma16(QT + 16 * I * HST, kb, 0, sc[J], lane); sc[J] = mma16(QT + 16 * I * HST, kb, 32, sc[J], lane);
            if (J == I) {
#pragma unroll
                for (int r = 0; r < 4; ++r) if ((lane & 15) > 4 * (lane >> 4) + r) sc[J][r] = z0; } } }
#pragma unroll
    for (int J = 0; J < 4; ++J)
#pragma unroll
        for (int r = 0; r < 4; ++r) AS[(4 * (lane >> 4) + r) * HST + 16 * J + (lane & 15)] = (bf16)f2bf(sc[J][r]);
    asm volatile("s_waitcnt lgkmcnt(0)" ::: "memory");
    f32x4 acc[4];
#pragma unroll
    for (int vb = 0; vb < 4; ++vb) { acc[vb] = (f32x4){z0, z0, z0, z0};
        acc[vb] = mma16(AS, VT + 16 * vb * HST, 0, acc[vb], lane); acc[vb] = mma16(AS, VT + 16 * vb * HST, 32, acc[vb], lane);
        acc[vb] = mma16(QD + 16 * I * HST, ST + 16 * vb * HST, 0, acc[vb], lane); acc[vb] = mma16(QD + 16 * I * HST, ST + 16 * vb * HST, 32, acc[vb], lane); }
    __syncthreads();
#pragma unroll
    for (int vb = 0; vb < 4; ++vb)
#pragma unroll
        for (int r = 0; r < 4; ++r) { const int n = 16 * I + 4 * (lane >> 4) + r, rl = dir ? 63 - n : n; OS[(dir * 64 + rl) * 68 + 16 * vb + (lane & 15)] = acc[vb][r]; }
    __syncthreads();
    { const int rl = tid >> 3, v8 = (tid & 7) * 8, row = base + rl;
      float o[8]; float ss = 0.f;
#pragma unroll
      for (int j = 0; j < 8; ++j) { o[j] = OS[rl * 68 + v8 + j] + OS[(64 + rl) * 68 + v8 + j]; ss += o[j] * o[j]; }
      ss += sx<1>(ss); ss += sx<2>(ss); ss += sx<4>(ss);
      const float rstd = __builtin_amdgcn_rsqf(ss * (1.0f / 64.0f) + EPS);
      float gt[8]; unpack8(*(const GAS v4u*)(PROJ + (size_t)row * INW + COL_HG + head * 64 + v8), gt);
      const float* gn = a->in[I_HGAIN] + l * 64 + v8;
      float y[8];
#pragma unroll
      for (int j = 0; j < 8; ++j) y[j] = o[j] * rstd * gn[j] * silu1(gt[j]);
      v4u w; w.x = pk2(y[0], y[1]); w.y = pk2(y[2], y[3]); w.z = pk2(y[4], y[5]); w.w = pk2(y[6], y[7]);
      *(GAS v4u*)(MIX + (size_t)row * DM + MIX_HG + head * 64 + v8) = w; }
    __syncthreads();
}

__device__ __forceinline__ void vt_item(KA a, int item, int lane) {
    const bf16* PROJ = (const bf16*)(a->ws + WS_PROJ); bf16* VTg = (bf16*)(a->ws + WS_VT);
    const int rb = item >> 1, hk = item & 1, row = rb * 64 + lane;
    const bf16* p = PROJ + (size_t)row * INW + COL_AV + hk * 64;
    unsigned w[32];
#pragma unroll
    for (int c = 0; c < 8; ++c) { const v4u t = *(const GAS v4u*)(p + 8 * c); w[4 * c] = t.x; w[4 * c + 1] = t.y; w[4 * c + 2] = t.z; w[4 * c + 3] = t.w; }
    bf16* o = VTg + (size_t)hk * 64 * R_ALL + row;
#pragma unroll
    for (int d2 = 0; d2 < 32; ++d2) { o[(size_t)(2 * d2) * R_ALL] = (bf16)(w[d2] & 0xffffu); o[(size_t)(2 * d2 + 1) * R_ALL] = (bf16)(w[d2] >> 16); }
}
__device__ __forceinline__ void attn_unit(KA a, int l, int u, LAS unsigned char* lds, int tid, int lane, int wave) {
    asm volatile("" : "+v"(tid), "+v"(lane));
    const bf16* PROJ = (const bf16*)(a->ws + WS_PROJ); const bf16* VTg = (const bf16*)(a->ws + WS_VT); bf16* MIX = (bf16*)(a->ws + WS_MIX);
    const bool isctx = u >= 256; const int uu = isctx ? u - 256 : u; const int n = uu >> 1, hk = uu & 1;
    const int qh = hk * 4 + (wave >> 1), half = wave & 1;
    const int qbase = (isctx ? S_LAT : 0) + n * 128 + half * 64, qpos0 = n * 128 + half * 64;
    const int c = lane & 15, g = lane >> 4;
    LAS bf16* Kt = (LAS bf16*)lds; LAS bf16* Vt = Kt + 64 * HST; LAS bf16* Qw = Vt + 64 * HST + wave * 64 * HST;
#pragma unroll
    for (int j = 0; j < 8; ++j) { const int qr = 8 * j + (lane >> 3), qc = (lane & 7) * 8;
        *(LAS v4u*)(Qw + qr * HST + qc) = *(const GAS v4u*)(PROJ + (size_t)(qbase + qr) * INW + qh * 64 + qc); }
    float z0 = 0.f; asm volatile("" : "+v"(z0));
    f32x4 o[4][4]; float ls[4];
    float gq = 0.f, gk = 0.f;
#pragma unroll 8
    for (int d = 0; d < 64; ++d) { gq = fmaxf(gq, fabsf(a->in[I_QG][l * 64 + d])); gk = fmaxf(gk, fabsf(a->in[I_KG][l * 64 + d])); }
    const float nbnd = -(8.0f * 1.4426950408889634f) * gq * gk;
    const float sink = a->in[I_SINK][l * 8 + qh] * 1.4426950408889634f;
#pragma unroll
    for (int qt = 0; qt < 4; ++qt) { ls[qt] = (g == 0) ? __builtin_amdgcn_exp2f(sink + nbnd) : z0;
#pragma unroll
        for (int dt = 0; dt < 4; ++dt) o[qt][dt] = (f32x4){z0, z0, z0, z0}; }
    const int first = (!isctx && n == 0) ? 2 : 0, nwin = isctx ? 0 : ((n == 0 || n == 127) ? 4 : 6), nt = nwin + 4;
    const int lr = tid >> 3, lc = (tid & 7) * 8;
    v4u kreg, vreg;
#define ATT_LOADT(i) do { const bool ct_ = (i) >= nwin; const int kb_ = ct_ ? S_LAT + 64 * ((i) - nwin) : (n - 1) * 128 + 64 * (first + (i)); \
        kreg = *(const GAS v4u*)(PROJ + (size_t)(kb_ + lr) * INW + COL_AK + hk * 64 + lc); vreg = *(const GAS v4u*)(VTg + ((size_t)hk * 64 + lr) * R_ALL + kb_ + lc); } while (0)
    ATT_LOADT(0);
#pragma unroll 1
    for (int i = 0; i < nt; ++i) {
        __syncthreads();
        *(LAS v4u*)(Kt + lr * HST + lc) = kreg; *(LAS v4u*)(Vt + lr * HST + lc) = vreg;
        __syncthreads();
        if (i + 1 < nt) ATT_LOADT(i + 1);
        const bool win = i < nwin; const int kb = (n - 1) * 128 + 64 * (first + i);
        bf16x8v kf[4][2], vf[4][2];
#pragma unroll
        for (int kt = 0; kt < 4; ++kt)
#pragma unroll
            for (int ks = 0; ks < 2; ++ks) kf[kt][ks] = *(const LAS bf16x8v*)(Kt + (16 * kt + c) * HST + 32 * ks + 8 * g);
#pragma unroll
        for (int dt = 0; dt < 4; ++dt)
#pragma unroll
            for (int s2 = 0; s2 < 2; ++s2) { const v2u lo = *(const LAS v2u*)(Vt + (16 * dt + c) * HST + 32 * s2 + 4 * g), hi = *(const LAS v2u*)(Vt + (16 * dt + c) * HST + 32 * s2 + 16 + 4 * g);
                const v4u t = {lo.x, lo.y, hi.x, hi.y}; vf[dt][s2] = __builtin_bit_cast(bf16x8v, t); }
#pragma unroll
        for (int qt = 0; qt < 4; ++qt) {
            f32x4 s[4];
            const bf16x8v q0 = *(const LAS bf16x8v*)(Qw + (16 * qt + c) * HST + 8 * g), q1 = *(const LAS bf16x8v*)(Qw + (16 * qt + c) * HST + 32 + 8 * g);
#pragma unroll
            for (int kt = 0; kt < 4; ++kt) { s[kt] = (f32x4){nbnd, nbnd, nbnd, nbnd};
                s[kt] = __builtin_amdgcn_mfma_f32_16x16x32_bf16(kf[kt][0], q0, s[kt], 0, 0, 0); s[kt] = __builtin_amdgcn_mfma_f32_16x16x32_bf16(kf[kt][1], q1, s[kt], 0, 0, 0); }
            if (win) { const int dq = qpos0 + 16 * qt + c - kb - 4 * g;
#pragma unroll
                for (int kt = 0; kt < 4; ++kt)
#pragma unroll
                    for (int r = 0; r < 4; ++r) { const int dl = dq - 16 * kt - r; if (dl > 128 || dl < -128) s[kt][r] = -INFINITY; } }
            float ps = 0.f;
#pragma unroll
            for (int kt = 0; kt < 4; ++kt)
#pragma unroll
                for (int r = 0; r < 4; ++r) { s[kt][r] = __builtin_amdgcn_exp2f(s[kt][r]); ps += s[kt][r]; }
            ls[qt] += ps;
            bf16x8v pb[2];
#pragma unroll
            for (int s2 = 0; s2 < 2; ++s2) { const v4u t = {pk2(s[2 * s2][0], s[2 * s2][1]), pk2(s[2 * s2][2], s[2 * s2][3]), pk2(s[2 * s2 + 1][0], s[2 * s2 + 1][1]), pk2(s[2 * s2 + 1][2], s[2 * s2 + 1][3])};
                pb[s2] = __builtin_bit_cast(bf16x8v, t); }
#pragma unroll
            for (int dt = 0; dt < 4; ++dt) { o[qt][dt] = __builtin_amdgcn_mfma_f32_16x16x32_bf16(vf[dt][0], pb[0], o[qt][dt], 0, 0, 0); o[qt][dt] = __builtin_amdgcn_mfma_f32_16x16x32_bf16(vf[dt][1], pb[1], o[qt][dt], 0, 0, 0); }
        }
    }
#undef ATT_LOADT
    int c2 = lane & 15, g2 = lane >> 4; asm volatile("" : "+v"(c2), "+v"(g2));
#pragma unroll
    for (int qt = 0; qt < 4; ++qt) { float lt = ls[qt]; lt += sx<16>(lt); lt = sx32_add(lt); const float inv = 1.0f / lt;
        bf16* op = (bf16*)(a->ws + WS_MIX) + (size_t)(qbase + 16 * qt + c2) * DM + MIX_AT + qh * 64 + 4 * g2;
#pragma unroll
        for (int dt = 0; dt < 4; ++dt) { v2u w; w.x = pk2(o[qt][dt][0] * inv, o[qt][dt][1] * inv); w.y = pk2(o[qt][dt][2] * inv, o[qt][dt][3] * inv); *(GAS v2u*)(op + 16 * dt) = w; } }
}

constexpr int GST = 136;
__device__ __forceinline__ f32x4 mma16g(const LAS bf16* MA, const LAS bf16* MBt, int k0, f32x4 c, int lane) {
    const bf16x8v av = *(const LAS bf16x8v*)(MA + (lane & 15) * GST + k0 + 8 * (lane >> 4));
    const bf16x8v bv = *(const LAS bf16x8v*)(MBt + (lane & 15) * GST + k0 + 8 * (lane >> 4));
    return __builtin_amdgcn_mfma_f32_16x16x32_bf16(av, bv, c, 0, 0, 0);
}
__device__ __forceinline__ float gelu_as(float v) {
    const float av = fabsf(v), t = __builtin_amdgcn_rcpf(av * 0.2316418882f + 1.0f);
    float q = t * 0.5307027145f + (-0.7265760135f); q = q * t + 0.7107068705f; q = q * t + (-0.142248368f); q = q * t + 0.127414796f; q = q * t;
    const float e = __builtin_amdgcn_exp2f((v * v) * (-0.72134752044f)), mm = v * (q * e);
    return v < 0.f ? mm : v - mm;
}
__device__ __forceinline__ void gmlp_unit_mma(KA a, int l, int chunk, int g, LAS unsigned char* lds, int tid, int lane, int wave) {
    const bf16* PROJ = (const bf16*)(a->ws + WS_PROJ); bf16* MIX = (bf16*)(a->ws + WS_MIX);
    const int row0 = (chunk < 128) ? chunk * 128 : S_LAT + (chunk - 128) * 128;
    LAS bf16* WA = (LAS bf16*)lds;
    LAS bf16* VNT = WA + 128 * GST;
    LAS float* OUT = (LAS float*)(VNT + 64 * GST);
    const int pos = tid >> 2, part = tid & 3;
    {
      const float* W = a->in[I_GWS] + ((size_t)(l * 4 + g) * 128 + pos) * 128 + part * 32;
#pragma unroll
      for (int j = 0; j < 4; ++j) { const f32x4 w0 = *(const GAS f32x4*)(W + 8 * j), w1 = *(const GAS f32x4*)(W + 8 * j + 4);
          v4u o; o.x = pk2(w0.x, w0.y); o.y = pk2(w0.z, w0.w); o.z = pk2(w1.x, w1.y); o.w = pk2(w1.z, w1.w);
          *(LAS v4u*)(WA + pos * GST + part * 32 + 8 * j) = o; } }
    { const bf16* p = PROJ + (size_t)(row0 + pos) * INW + COL_GV + g * 64 + part * 16;
      float x[16]; unpack8(*(const GAS v4u*)p, x); unpack8(*(const GAS v4u*)(p + 8), x + 8);
      float ss = 0.f;
#pragma unroll
      for (int d = 0; d < 16; ++d) { x[d] = gelu_as(x[d]); ss += x[d] * x[d]; }
      ss += sx<1>(ss); ss += sx<2>(ss);
      const float rstd = __builtin_amdgcn_rsqf(ss * (1.0f / 64.0f) + EPS);
      const float* gn = a->in[I_GNG] + l * 256 + g * 64 + part * 16;
#pragma unroll
      for (int d = 0; d < 16; ++d) VNT[(part * 16 + d) * GST + pos] = (bf16)f2bf(x[d] * rstd * gn[d]); }
    __syncthreads();
    float z0 = 0.f; asm volatile("" : "+v"(z0));
#pragma unroll
    for (int cb = 0; cb < 4; ++cb) { f32x4 acc = {z0, z0, z0, z0};
#pragma unroll
        for (int ks = 0; ks < 4; ++ks) acc = mma16g(WA + 16 * wave * GST, VNT + 16 * cb * GST, 32 * ks, acc, lane);
#pragma unroll
        for (int r = 0; r < 4; ++r) OUT[(16 * wave + 4 * (lane >> 4) + r) * 68 + 16 * cb + (lane & 15)] = acc[r]; }
    __syncthreads();
    { const int row = row0 + pos; const float bsv = a->in[I_GBS][(l * 4 + g) * 128 + pos];
      const bf16* pu = PROJ + (size_t)row * INW + COL_GU + g * 64 + part * 16;
      float u[16]; unpack8(*(const GAS v4u*)pu, u); unpack8(*(const GAS v4u*)(pu + 8), u + 8);
      float y[16];
#pragma unroll
      for (int d = 0; d < 16; ++d) y[d] = gelu_as(u[d]) * (OUT[pos * 68 + part * 16 + d] + bsv);
      bf16* po = MIX + (size_t)row * DM + MIX_GM + g * 64 + part * 16;
      v4u w; w.x = pk2(y[0], y[1]); w.y = pk2(y[2], y[3]); w.z = pk2(y[4], y[5]); w.w = pk2(y[6], y[7]); *(GAS v4u*)po = w;
      w.x = pk2(y[8], y[9]); w.y = pk2(y[10], y[11]); w.z = pk2(y[12], y[13]); w.w = pk2(y[14], y[15]); *(GAS v4u*)(po + 8) = w; }
    __syncthreads();
}
__device__ __forceinline__ void attn_naive(KA a, int l, int nrows, int lane, int wave, int G, int bid) {
    const bf16* PROJ = (const bf16*)(a->ws + WS_PROJ); bf16* MIX = (bf16*)(a->ws + WS_MIX);
    const int gw = bid * NWAVES + wave, NGW = G * NWAVES;
    for (int pair = gw; pair < nrows * 2; pair += NGW) {
        const int row = pair >> 1, hk = pair & 1; const bool isctx = row >= S_LAT;
        float q[4], o[4], m[4], ls[4];
#pragma unroll
        for (int g = 0; g < 4; ++g) { q[g] = bflo((unsigned)PROJ[(size_t)row * INW + (hk * 4 + g) * 64 + lane]); o[g] = 0.f; ls[g] = 1.0f; m[g] = a->in[I_SINK][l * 8 + hk * 4 + g] * 1.4426950408889634f; }
        int j0 = 0, j1 = -1;
        if (!isctx) { j0 = row - 128 < 0 ? 0 : row - 128; j1 = row + 128 > S_LAT - 1 ? S_LAT - 1 : row + 128; }
        const int nwin = j1 - j0 + 1;
        const int nk = nwin + C_CTX;
#pragma unroll 4
        for (int t = 0; t < nk; ++t) {
            const int krow = (t < nwin) ? j0 + t : S_LAT + (t - nwin);
            const float k = bflo((unsigned)PROJ[(size_t)krow * INW + COL_AK + hk * 64 + lane]);
            const float v = bflo((unsigned)PROJ[(size_t)krow * INW + COL_AV + hk * 64 + lane]);
#pragma unroll
            for (int g = 0; g < 4; ++g) { const float s = wave_sum(q[g] * k); const float mn = fmaxf(m[g], s);
                const float c = __builtin_amdgcn_exp2f(m[g] - mn), p = __builtin_amdgcn_exp2f(s - mn);
                ls[g] = ls[g] * c + p; o[g] = o[g] * c + p * v; m[g] = mn; }
        }
#pragma unroll
        for (int g = 0; g < 4; ++g) MIX[(size_t)row * DM + MIX_AT + (hk * 4 + g) * 64 + lane] = (bf16)f2bf(o[g] / ls[g]);
    }
}
__device__ __forceinline__ void hgrn_combine(KA a, int l, int nrows, int lane, int wave, int G, int bid) {
    const bf16* PROJ = (const bf16*)(a->ws + WS_PROJ); bf16* MIX = (bf16*)(a->ws + WS_MIX);
    const float* O0 = (const float*)(a->ws + WS_HGO); const float* O1 = O0 + (size_t)R_ALL * 256;
    const f32x4 gn = *(const f32x4*)(a->in[I_HGAIN] + l * 64 + (lane & 15) * 4);
    const int gw = bid * NWAVES + wave, NGW = G * NWAVES;
    for (int r = gw; r < nrows; r += NGW) {
        const f32x4 o = *(const GAS f32x4*)(O0 + (size_t)r * 256 + 4 * lane) + *(const GAS f32x4*)(O1 + (size_t)r * 256 + 4 * lane);
        float ss = (o.x * o.x + o.y * o.y) + (o.z * o.z + o.w * o.w);
        ss += sx<1>(ss); ss += sx<2>(ss); ss += sx<4>(ss); ss += sx<8>(ss);
        const float rstd = __builtin_amdgcn_rsqf(ss * (1.0f / 64.0f) + EPS);
        const v2u gw2 = *(const GAS v2u*)(PROJ + (size_t)r * INW + COL_HG + 4 * lane);
        const float g0 = bflo(gw2.x), g1 = bfhi(gw2.x), g2 = bflo(gw2.y), g3 = bfhi(gw2.y);
        v2u w; w.x = pk2(o.x * rstd * gn.x * silu1(g0), o.y * rstd * gn.y * silu1(g1)); w.y = pk2(o.z * rstd * gn.z * silu1(g2), o.w * rstd * gn.w * silu1(g3));
        *(GAS v2u*)(MIX + (size_t)r * DM + MIX_HG + 4 * lane) = w;
    }
}
__device__ __forceinline__ void moe_gather(KA a, LAS unsigned char* lds, int tid, int lane, int wave, int G, int bid) {
    LAS int* sb = (LAS int*)lds;
    const unsigned* cnt = (const unsigned*)(a->ws + WS_CTL) + CW_MOECNT;
    int* mi = (int*)(a->ws + WS_VEC) + VO_MOE;
    if (tid == 0) { int b = 0;
        for (int e = 0; e < 8; ++e) { const int c = (int)__hip_atomic_load(cnt + 64 * e, RLX_AGENT); sb[e] = b; sb[16 + e] = c;
            const int nt = (c + 255) >> 8;
            if (bid == 0) for (int t = 0; t < nt; ++t) mi[16 + (b >> 8) + t] = e;
            b += nt << 8; }
        sb[8] = b; if (bid == 0) mi[0] = b >> 8; }
    __syncthreads();
    const unsigned char* H8 = (const unsigned char*)(a->ws + WS_H2B); unsigned char* AS = (unsigned char*)(a->ws + WS_AS);
    const int* tokinfo = (const int*)(a->ws + WS_TOK); int* tokslot = (int*)(a->ws + WS_TOK) + S_LAT * 8;
    const int gw = bid * NWAVES + wave, NGW = G * NWAVES;
    for (int t = gw; t < S_LAT; t += NGW) {
        const int* ti = tokinfo + (size_t)t * 8;
        const int e1 = ti[0], e2 = ti[1], r1 = ti[2], r2 = ti[3];
        const int s1 = sb[e1] + r1, s2 = sb[e2] + r2;
        const v4u x0 = ((const GAS v4u*)(H8 + (size_t)t * DM))[lane];
        ((GAS v4u*)(AS + (size_t)s1 * DM))[lane] = x0; ((GAS v4u*)(AS + (size_t)s2 * DM))[lane] = x0;
        if (lane == 0) { int* ts = tokslot + (size_t)t * 4; ts[0] = s1; ts[1] = s2; ts[2] = ti[4]; ts[3] = ti[5]; }
    }
    { const f32x4 z4 = {0.f, 0.f, 0.f, 0.f}; for (int i = bid * NTHR + tid; i < 8 * 256 * DM / 4; i += G * NTHR) ((GAS f32x4*)(a->ws + WS_YF))[i] = z4; }
    for (int e = 0; e < 8; ++e) { const int c = sb[16 + e], pe = (c + 255) & ~255, b = sb[e];
        for (int j = c + gw; j < pe; j += NGW) { const v4u z = {0u, 0u, 0u, 0u}; ((GAS v4u*)(AS + (size_t)(b + j) * DM))[lane] = z; } }
}
__device__ __forceinline__ void moe_combine(KA a, int lane, int wave, int G, int bid) {
    const float* gf = (const float*)(a->ws + WS_VEC) + VO_MOD + (1 * 2 + 0) * 6144 + 5 * 1024;
    const bf16* Y = (const bf16*)(a->ws + WS_Y); const int* tokslot = (const int*)(a->ws + WS_TOK) + S_LAT * 8;
    const int gw = bid * NWAVES + wave, NGW = G * NWAVES;
    for (int t = gw; t < S_LAT; t += NGW) {
        const int* ts = tokslot + (size_t)t * 4; const int s1 = ts[0], s2 = ts[1]; const float w1 = __builtin_bit_cast(float, ts[2]), w2 = __builtin_bit_cast(float, ts[3]);
        GAS f32x4* xr = (GAS f32x4*)(a->out + (size_t)t * DM) + lane;
        const float* YF = (const float*)(a->ws + WS_YF);
#pragma unroll
        for (int j = 0; j < 4; ++j) { const f32x4 g = *(const f32x4*)(gf + 4 * lane + 256 * j); f32x4 x = xr[64 * j]; f32x4 p, q;
            if (s1 < 32768) { const v2u t = ((const GAS v2u*)(Y + (size_t)s1 * DM) + lane)[64 * j]; p = (f32x4){bflo(t.x), bfhi(t.x), bflo(t.y), bfhi(t.y)}; } else p = ((const GAS f32x4*)(YF + (size_t)(s1 - 32768) * DM) + lane)[64 * j];
            if (s2 < 32768) { const v2u t = ((const GAS v2u*)(Y + (size_t)s2 * DM) + lane)[64 * j]; q = (f32x4){bflo(t.x), bfhi(t.x), bflo(t.y), bfhi(t.y)}; } else q = ((const GAS f32x4*)(YF + (size_t)(s2 - 32768) * DM) + lane)[64 * j];
            x = x + g * (p * w1 + q * w2);
            xr[64 * j] = x; }
    }
}

#define IN(k) (lo <= (k) && (k) < hi)
#define GRIDBAR() do { XcdBarrier b2_; b2_.bar = (unsigned*)(KARGS()->ws + WS_CTL) + CW_BAR; b2_.x = xb_xcc_id(); b2_.st = (volatile LAS unsigned*)(lds + MISC_OFF) + 8; xcd_barrier(b2_, wv0 * 64 + (int)__builtin_amdgcn_mbcnt_hi(~0u, __builtin_amdgcn_mbcnt_lo(~0u, 0u))); } while (0)
#define SEAM(k) do { if (IN(k) && IN((k) + 1)) GRIDBAR(); } while (0)
#define PHASE_ROOTS() KA a = KARGS(); unsigned char* ws = a->ws; const float* vec = (const float*)(ws + WS_VEC); (void)vec; int bid = blockIdx.x, G = gridDim.x; asm volatile("" : "+s"(bid), "+s"(G)); int tid = wv0 * 64 + (int)__builtin_amdgcn_mbcnt_hi(~0u, __builtin_amdgcn_mbcnt_lo(~0u, 0u)); asm volatile("" : "+v"(tid)); const int lane = tid & 63, wave = __builtin_amdgcn_readfirstlane(tid >> 6); (void)lane; (void)wave

template <int l> __device__ __forceinline__ void layer_body(const int lo, const int hi, LAS unsigned char* lds, const int wv0) {
        const int pb = 1 + 11 * l;
        if (IN(pb + 0)) { PHASE_ROOTS(); phase_norm(a, l, 0, R_ALL, (bf16*)(ws + WS_H), lane, wave, G, bid); SEAM(pb + 0); }
        if (IN(pb + 1)) {
            PHASE_ROOTS();
            pg8::Gemm g{(const pg8::bf16_t*)(ws + WS_H), (const pg8::bf16_t*)(ws + WS_WIN) + (size_t)l * INW * DM, R_ALL, INW, DM, 0, DM};
            pg8::StaticOrder S; S.init(R_ALL, INW, G, bid);
            pg8::EpiBf16<0> E{(pg8::bf16_t*)(ws + WS_PROJ), INW, nullptr, 0, 0, 1.f};
            pg8::gemm_phase<pg8::EpiBf16<0>, pg8::StaticOrder, true, true>(lds, g, S, E, tid);
            moe_conv_slice(a, l == 0 ? 0 : 2, 650 - 2 * 256, lds, lane, wave, G, bid);
            SEAM(pb + 1);
        }
        if (IN(pb + 2)) {
            PHASE_ROOTS();
            qk_prep(a, l, bid * NTHR + tid, G * NTHR);
            for (int it = bid * NWAVES + wave; it < 520; it += G * NWAVES) vt_item(a, it, lane);
            for (int it = bid; it < 1040; it += G) hgrn_stepA(a, l, it >> 2, it & 3, lds, lane, wave);
            SEAM(pb + 2);
        }
        if (IN(pb + 3)) {
            PHASE_ROOTS();
            if (bid < 64) hgrn_stepB(a, bid, tid);
            {
                const int nu = (l == 0) ? 260 : 256, ng = (l == 0) ? 520 : 512;
                unsigned* qctr = (unsigned*)(ws + WS_CTL) + CW_QUEUE + 64 * l;
                volatile LAS unsigned* qslot = (volatile LAS unsigned*)(lds + MISC_OFF) + 16;
                for (;;) {
                    __syncthreads();
                    if (tid == 0) qslot[0] = __hip_atomic_fetch_add(qctr, 1u, RLX_AGENT);
                    __syncthreads();
                    const int it = __builtin_amdgcn_readfirstlane((int)qslot[0]);
                    if (it >= nu + ng) break;
                    if (it < nu) attn_unit(a, l, it, lds, tid, lane, wave);
                    else gmlp_unit_mma(a, l, (it - nu) >> 2, (it - nu) & 3, lds, tid, lane, wave);
                }
            }
            SEAM(pb + 3);
        }
        if (IN(pb + 4)) {
            PHASE_ROOTS();
            const int nit = (l == 0) ? 1040 : 1024;
            for (int it = bid; it < nit; it += G) hgrn_stepC(a, l, it >> 2, it & 3, lds, tid, lane, wave);
            SEAM(pb + 4);
        }
        if (IN(pb + 5)) {
            PHASE_ROOTS();
            const float* modl = vec + VO_MOD + (l * 2 + 0) * 6144; const float* modc = vec + VO_MOD + (l * 2 + 1) * 6144;
            const int M = S_LAT;
            pg8::Gemm g{(const pg8::bf16_t*)(ws + WS_MIX), (const pg8::bf16_t*)(ws + WS_WOUT) + (size_t)l * DM * DM, M, DM, DM, 0, DM};
            pg8::StaticOrder S; S.init(M, DM, G, bid);
            pg8::EpiResid E{(l == 0) ? a->in[I_X] : a->out, a->out, modl + 2048, a->in[I_CTX], (float*)(ws + WS_CTXR), modc + 2048, S_LAT / 256, DM};
            pg8::gemm_phase<pg8::EpiResid, pg8::StaticOrder, true, true>(lds, g, S, E, tid);
            if (l == 0) {
                pg8::Gemm g2{(const pg8::bf16_t*)(ws + WS_MIX), (const pg8::bf16_t*)(ws + WS_WOUT), R_ALL, DM, 256, 0, DM};
                pg8::SplitKOrder S2{S_LAT / 256, 4, 4, 256, 16, bid, nullptr};
                pg8::EpiAtomic E2{(float*)(ws + WS_CTXR), modc + 2048, S_LAT / 256, DM};
                pg8::gemm_phase<pg8::EpiAtomic, pg8::SplitKOrder, false, true>(lds, g2, S2, E2, tid);
            }
            SEAM(pb + 5);
        }
        if (l == 0) {
            if (IN(pb + 6)) { PHASE_ROOTS(); phase_norm(a, l, 1, R_ALL, (bf16*)(ws + WS_H), lane, wave, G, bid); SEAM(pb + 6); }
            if (IN(pb + 7)) {
                PHASE_ROOTS();
                pg8::Gemm g{(const pg8::bf16_t*)(ws + WS_H), (const pg8::bf16_t*)(ws + WS_WGU), R_ALL, 2 * FFN, DM, 0, DM};
                pg8::StaticOrder S; S.init(R_ALL, 2 * FFN, G, bid);
                pg8::EpiSwiGLU E{(pg8::bf16_t*)(ws + WS_HID), FFN, 1.0f};
                pg8::gemm_phase<pg8::EpiSwiGLU, pg8::StaticOrder, true, true>(lds, g, S, E, tid);
                moe_conv_slice(a, 1, 1430 - 5 * 256, lds, lane, wave, G, bid);
                SEAM(pb + 7);
            }
            if (IN(pb + 8)) {
                PHASE_ROOTS();
                const float* modl = vec + VO_MOD + (l * 2 + 0) * 6144; const float* modc = vec + VO_MOD + (l * 2 + 1) * 6144;
                pg8::Gemm g{(const pg8::bf16_t*)(ws + WS_HID), (const pg8::bf16_t*)(ws + WS_WD), S_LAT, DM, FFN, 0, FFN};
                pg8::StaticOrder S; S.init(S_LAT, DM, G, bid);
                pg8::EpiResid E{a->out, a->out, modl + 5120, (const float*)(ws + WS_CTXR), (float*)(ws + WS_CTXR), modc + 5120, S_LAT / 256, DM};
                pg8::gemm_phase<pg8::EpiResid, pg8::StaticOrder, true, true>(lds, g, S, E, tid);
                {
                    pg8::Gemm g2{(const pg8::bf16_t*)(ws + WS_HID), (const pg8::bf16_t*)(ws + WS_WD), R_ALL, DM, 256, 0, FFN};
                    pg8::SplitKOrder S2{S_LAT / 256, 4, 11, 256, 44, bid, nullptr};
                    pg8::EpiAtomic E2{(float*)(ws + WS_CTXR), modc + 5120, S_LAT / 256, DM};
                    pg8::gemm_phase<pg8::EpiAtomic, pg8::SplitKOrder, false, true>(lds, g2, S2, E2, tid);
                }
                if (IN(pb + 8) && IN(pb + 11)) GRIDBAR();
            }
        } else {
            if (IN(pb + 6)) { PHASE_ROOTS(); phase_norm_route(a, lds, tid, lane, wave, G, bid); SEAM(pb + 6); }
            if (IN(pb + 7)) { PHASE_ROOTS(); moe_gather(a, lds, tid, lane, wave, G, bid); SEAM(pb + 7); }
            if (IN(pb + 8)) {
                PHASE_ROOTS();
                const int* mi = (const int*)(ws + WS_VEC) + VO_MOE; const int nt = __builtin_amdgcn_readfirstlane(mi[0]);
                pg8::Gemm g{(const pg8::bf16_t*)(ws + WS_AS), (const pg8::bf16_t*)(ws + WS_MGU), nt * 256, 2 * EXD, DM / 2, (size_t)2 * EXD * DM, DM / 2};
                pg8::MoeOrder S; S.init(nt * 256, 2 * EXD, G, bid); S.tile_e = mi + 16;
                pg8::EpiSwiGLU E{(pg8::bf16_t*)(ws + WS_HIDM), EXD, 1.0f / (F8_WSCALE * F8_ASCALE)};
                pg8::gemm_phase<pg8::EpiSwiGLU, pg8::MoeOrder, true, true, true>(lds, g, S, E, tid);
                SEAM(pb + 8);
            }
            if (IN(pb + 9)) {
                PHASE_ROOTS();
                const int* mi = (const int*)(ws + WS_VEC) + VO_MOE; const int nt = __builtin_amdgcn_readfirstlane(mi[0]); const int nm = nt < 128 ? nt : 128;
                pg8::Gemm g{(const pg8::bf16_t*)(ws + WS_HIDM), (const pg8::bf16_t*)(ws + WS_MD), nm * 256, DM, EXD, (size_t)DM * EXD * 2, EXD};
                pg8::MoeOrder S; S.init(nm * 256, DM, G, bid); S.tile_e = mi + 16;
                pg8::EpiBf16<0> E{(pg8::bf16_t*)(ws + WS_Y), DM, nullptr, 0, 0, 1.f};
                pg8::gemm_phase<pg8::EpiBf16<0>, pg8::MoeOrder, true, true>(lds, g, S, E, tid);
                if (nt > 128) {
                    pg8::Gemm g2{(const pg8::bf16_t*)(ws + WS_HIDM), (const pg8::bf16_t*)(ws + WS_MD), nt * 256, DM, 512, (size_t)DM * EXD * 2, EXD};
                    pg8::SplitKOrder S2{128, 4, 7, 512, (nt - 128) * 28, bid, mi + 16};
                    pg8::EpiAtomic E2{(float*)(ws + WS_YF), nullptr, 128, DM};
                    pg8::gemm_phase<pg8::EpiAtomic, pg8::SplitKOrder, false, true>(lds, g2, S2, E2, tid);
                }
                SEAM(pb + 9);
            }
            if (IN(pb + 10)) { PHASE_ROOTS(); moe_combine(a, lane, wave, G, bid); }
        }
    }
__global__ void __launch_bounds__(NTHR, 2) fwd_kernel(Args a_unused) {
    extern __shared__ __attribute__((aligned(16))) unsigned char lds_raw[];
    LAS unsigned char* lds = (LAS unsigned char*)lds_raw;
    const int tid0 = threadIdx.x;
    const int wv0 = __builtin_amdgcn_readfirstlane(tid0 >> 6);
    for (int u = tid0; u < (LDS_BYTES - LDSCTL_OFF) / 4; u += NTHR) ((LAS unsigned*)(lds + LDSCTL_OFF))[u] = 0u;
    __syncthreads();
    const int lo = KARGS()->ph_lo, hi = KARGS()->ph_hi;
    const bool fusedl = (hi - lo) > 1;
    if (fusedl) (void)xcd_barrier_post((unsigned*)(KARGS()->ws + WS_CTL) + CW_BAR, (volatile LAS unsigned*)(lds + MISC_OFF) + 8);
    if (IN(0)) { PHASE_ROOTS(); p0_prologue(a, lds, tid, lane, wave, G, bid); SEAM(0); }

    layer_body<0>(lo, hi, lds, wv0);
    layer_body<1>(lo, hi, lds, wv0);
}

extern "C" void kernel_launch(void* const* d_in, const int* in_sizes, int n_in, void* d_out, int out_size, void* d_ws, size_t ws_size, hipStream_t stream) {
    static int grid = 0;
    if (grid == 0) {
        if (n_in != 23 || in_sizes[0] != S_LAT * DM || out_size != S_LAT * DM || ws_size < WS_END) { fprintf(stderr, "kernel_launch: unexpected shapes / workspace (n_in %d, ws %zu, need %zu)\n", n_in, ws_size, (size_t)WS_END); grid = -1; return; }
        int dev = 0, cus = 0;
        if (hipGetDevice(&dev) != hipSuccess || hipDeviceGetAttribute(&cus, hipDeviceAttributeMultiprocessorCount, dev) != hipSuccess) { grid = -1; return; }
        if (hipFuncSetAttribute((const void*)fwd_kernel, hipFuncAttributeMaxDynamicSharedMemorySize, LDS_BYTES) != hipSuccess) { grid = -1; return; }
        int per_cu = 0;
        (void)hipOccupancyMaxActiveBlocksPerMultiprocessor(&per_cu, (const void*)fwd_kernel, NTHR, LDS_BYTES);
        (void)hipGetLastError();
        grid = cus;
    }
    if (grid < 0) return;
    if (hipMemsetAsync((char*)d_ws + WS_CTL, 0, CTL_ZERO_BYTES, stream) != hipSuccess) return;
    Args a{};
    for (int i = 0; i < 23; ++i) a.in[i] = (const float*)d_in[i];
    a.out = (float*)d_out; a.ws = (unsigned char*)d_ws;
#if ONE_LAUNCH
    a.ph_lo = 0; a.ph_hi = NPH;
    hipLaunchKernelGGL(fwd_kernel, dim3(grid), dim3(NTHR), LDS_BYTES, stream, a);
#else
    for (int p = 0; p < NPH; ++p) {
        if (p == 10 || p == 11) continue;
        a.ph_lo = p; a.ph_hi = p + 1;
        hipLaunchKernelGGL(fwd_kernel, dim3(grid), dim3(NTHR), LDS_BYTES, stream, a);
    }
#endif
}
```

```cpp
#include <hip/hip_runtime.h>
#include <cstdio>
#include <cstdint>
#include <cmath>
#ifndef ONE_LAUNCH
#define ONE_LAUNCH 1
#endif
namespace pg8 {
#define PG8_LAS __attribute__((address_space(3)))
typedef unsigned short bf16_t;
typedef short bf16x8 __attribute__((ext_vector_type(8)));
typedef float f32x4 __attribute__((ext_vector_type(4)));
typedef unsigned u32x4 __attribute__((ext_vector_type(4)));
constexpr int BM = 256, BK = 64, HALF = 128, HTB = HALF * BK * 2  , STAGE_BYTES = 8 * HTB, NXCD = 8, WGM = 8;

__host__ __device__ __forceinline__ int lds_byte(int r, int c) { const int st = (r >> 4) * 2 + (c >> 5), rr = r & 15, cc = c & 31, ob = rr * 64 + cc * 2; return st * 1024 + (ob ^ (((ob >> 9) & 1) << 5)); }
__host__ __device__ __forceinline__ void stage_rc(int b, int& R, int& C) { const int st = b / 1024, sb = b % 1024, swz = sb ^ (((sb >> 9) & 1) << 5); R = (st >> 1) * 16 + swz / 64; C = (st & 1) * 32 + (swz % 64) / 2; }
__host__ __device__ __forceinline__ int perm32(int rho) { const int n = rho >> 4, i = rho & 15; return 8 * (i >> 2) + 4 * n + (i & 3); }

struct Unit { int pm, pn, eb, ko; };
struct Gemm { const bf16_t* A; const bf16_t* Bt; int M, N, K; size_t bstride; int ld; };

struct StaticOrder {
    int nM, nN, nwg, G, c;
    __host__ __device__ void init(int M, int N, int G_, int c_) { nM = M / BM; nN = N / BM; nwg = nM * nN; G = G_; c = c_; }
    __host__ __device__ bool next(int i, Unit& u) const {
        const long L = (long)i * G + c; if (L >= nwg) return false;
        int wgid = (int)L; { const int q = nwg / NXCD, r = nwg % NXCD, xcd = wgid % NXCD, off = wgid / NXCD; wgid = (xcd < r ? xcd * (q + 1) : r * (q + 1) + (xcd - r) * q) + off; }
        const int nig = WGM * nN, gid = wgid / nig, fm = gid * WGM, gsz = (nM - fm) < WGM ? (nM - fm) : WGM;
        u.pm = fm + ((wgid % nig) % gsz); u.pn = (wgid % nig) / gsz; u.eb = 0; u.ko = 0; return true;
    }
    __device__ __forceinline__ void a_ready(const Unit&) const {}
    __device__ __forceinline__ void done(const Unit&) const {}
};

__device__ __forceinline__ unsigned cvt_pk_bf16(float lo, float hi) { unsigned r; asm volatile("v_cvt_pk_bf16_f32 %0, %1, %2" : "=v"(r) : "v"(lo), "v"(hi)); return r; }
typedef float f32x2 __attribute__((ext_vector_type(2)));
__device__ __forceinline__ f32x2 gelu_pk(f32x2 v) {
    const f32x2 av = __builtin_elementwise_abs(v), d = av * 0.2316418882f + 1.0f;
    f32x2 t; t.x = __builtin_amdgcn_rcpf(d.x); t.y = __builtin_amdgcn_rcpf(d.y);
    f32x2 q = t * 0.5307027145f + (-0.7265760135f); q = q * t + 0.7107068705f; q = q * t + (-0.142248368f); q = q * t + 0.127414796f; q = q * t;
    const f32x2 s = (v * v) * (-0.72134752044f);
    f32x2 e; e.x = __builtin_amdgcn_exp2f(s.x); e.y = __builtin_amdgcn_exp2f(s.y);
    const f32x2 m = v * (q * e), r = v - m;
    f32x2 o; o.x = v.x < 0.f ? m.x : r.x; o.y = v.y < 0.f ? m.y : r.y; return o;
}

template <int ACT  > struct EpiBf16 {
    static constexpr bool PERM = true, AFTER_DRAIN = false; static_assert(ACT == 0 || ACT == 1, "EpiBf16: ACT is 0 (none) or 1 (gelu_pk)");
    bf16_t* O; int ldc; const float* bias; int split_cols; size_t split_stride; float scale0;
    __device__ __forceinline__ void operator()(const f32x4 (&acc)[2][2][4][2], const Unit& u, int wr, int wc, int fr, int fq) const {
        const int row0 = u.pm * BM + wr * 64 + fr; int colt = u.pn * BM; bf16_t* base = O;
        float sc = 1.f; if (split_cols) { const int t = colt / split_cols; base += (size_t)t * split_stride; colt -= t * split_cols; if (t == 0) sc = scale0; }
        const int col0 = colt + wc * 32 + 8 * fq, bcol0 = u.pn * BM + wc * 32 + 8 * fq;
        f32x4 bv[2][2];
#pragma unroll
        for (int bj = 0; bj < 2; ++bj)
#pragma unroll
            for (int n = 0; n < 2; ++n) bv[bj][n] = bias ? *(const f32x4*)(bias + bcol0 + bj * HALF + 4 * n) : (f32x4){0.f, 0.f, 0.f, 0.f};
#pragma unroll
        for (int ai = 0; ai < 2; ++ai)
#pragma unroll
            for (int m = 0; m < 4; ++m) { bf16_t* rowp = base + (size_t)(row0 + ai * HALF + m * 16) * ldc + col0;
#pragma unroll
                for (int bj = 0; bj < 2; ++bj) { f32x4 v0 = acc[ai][bj][m][0] + bv[bj][0], v1 = acc[ai][bj][m][1] + bv[bj][1];
                    if (ACT == 1) { f32x2 a = gelu_pk((f32x2){v0[0], v0[1]}), b = gelu_pk((f32x2){v0[2], v0[3]}), c = gelu_pk((f32x2){v1[0], v1[1]}), d = gelu_pk((f32x2){v1[2], v1[3]});
                        v0 = (f32x4){a.x, a.y, b.x, b.y}; v1 = (f32x4){c.x, c.y, d.x, d.y}; }
                    v0 = v0 * sc; v1 = v1 * sc; u32x4 w; w.x = cvt_pk_bf16(v0[0], v0[1]); w.y = cvt_pk_bf16(v0[2], v0[3]); w.z = cvt_pk_bf16(v1[0], v1[1]); w.w = cvt_pk_bf16(v1[2], v1[3]);
                    *(u32x4*)(rowp + bj * HALF) = w; } }
    }
};

__device__ __forceinline__ float silu_f(float x) { return x * __builtin_amdgcn_rcpf(1.0f + __builtin_amdgcn_exp2f(-1.4426950408889634f * x)); }
struct EpiResid {
    static constexpr bool PERM = false, AFTER_DRAIN = false;
    const float* base; float* out; const float* gate; const float* cbase; float* cout; const float* cgate; int mlat; int ldc;
    __device__ __forceinline__ void operator()(const f32x4 (&acc)[2][2][4][2], const Unit& u, int wr, int wc, int fr, int fq) const {
        const bool isc = u.pm >= mlat;
        const float* b = isc ? cbase : base; float* o = isc ? cout : out; const float* g = isc ? cgate : gate;
        const int row0 = (isc ? (u.pm - mlat) : u.pm) * BM + wr * 64 + fr, col0 = u.pn * BM + wc * 32 + 4 * fq;
        f32x4 gv[2][2];
#pragma unroll
        for (int bj = 0; bj < 2; ++bj)
#pragma unroll
            for (int n = 0; n < 2; ++n) gv[bj][n] = *(const f32x4*)(g + col0 + bj * HALF + n * 16);
#pragma unroll
        for (int ai = 0; ai < 2; ++ai)
#pragma unroll
            for (int m = 0; m < 4; ++m) { const size_t off = (size_t)(row0 + ai * HALF + m * 16) * ldc + col0;
#pragma unroll
                for (int bj = 0; bj < 2; ++bj)
#pragma unroll
                    for (int n = 0; n < 2; ++n) { const f32x4 bs = *(const f32x4*)(b + off + bj * HALF + n * 16); *(f32x4*)(o + off + bj * HALF + n * 16) = bs + gv[bj][n] * acc[ai][bj][m][n]; }
                if (m & 1) asm volatile("" ::: "memory"); }
    }
};
struct EpiSwiGLU {
    static constexpr bool PERM = true, AFTER_DRAIN = false;
    bf16_t* O; int ldc; float ds;
    __device__ __forceinline__ void operator()(const f32x4 (&acc)[2][2][4][2], const Unit& u, int wr, int wc, int fr, int fq) const {
        const int row0 = u.pm * BM + wr * 64 + fr, col0 = u.pn * HALF + wc * 32 + 8 * fq;
#pragma unroll
        for (int ai = 0; ai < 2; ++ai)
#pragma unroll
            for (int m = 0; m < 4; ++m) { bf16_t* rowp = O + (size_t)(row0 + ai * HALF + m * 16) * ldc + col0;
                const f32x4 g0 = acc[ai][0][m][0] * ds, g1 = acc[ai][0][m][1] * ds, u0 = acc[ai][1][m][0] * ds, u1 = acc[ai][1][m][1] * ds;
                f32x4 h0, h1;
#pragma unroll
                for (int j = 0; j < 4; ++j) { h0[j] = silu_f(g0[j]) * u0[j]; h1[j] = silu_f(g1[j]) * u1[j]; }
                u32x4 w; w.x = cvt_pk_bf16(h0[0], h0[1]); w.y = cvt_pk_bf16(h0[2], h0[3]); w.z = cvt_pk_bf16(h1[0], h1[1]); w.w = cvt_pk_bf16(h1[2], h1[3]);
                *(u32x4*)rowp = w; }
    }
};
struct MoeOrder : StaticOrder {
    const int* tile_e;
    __device__ __forceinline__ bool next(int i, Unit& u) const { if (!StaticOrder::next(i, u)) return false; u.eb = __builtin_amdgcn_readfirstlane(tile_e[u.pm]); return true; }
};

struct SplitKOrder {
    int pm0, nN, P, kp, total, c; const int* tile_e;
    __device__ __forceinline__ bool next(int i, Unit& u) const {
        if (i != 0 || c >= total) return false;
        const int p = c % P, t = c / P; u.pn = t % nN; u.pm = pm0 + t / nN; u.ko = p * kp; u.eb = tile_e ? __builtin_amdgcn_readfirstlane(tile_e[u.pm]) : 0; return true; }
    __device__ __forceinline__ void a_ready(const Unit&) const {}
    __device__ __forceinline__ void done(const Unit&) const {}
};
struct EpiAtomic {
    static constexpr bool PERM = false, AFTER_DRAIN = true;
    float* out; const float* scale; int pm_sub; int ldc; float ds;
    __device__ __forceinline__ void fused(f32x4 (&acc)[2][2][4][2], const Unit& u, int wr, int wc, int fr, int fq, PG8_LAS unsigned char* lds, int wid, int lane) const {
        PG8_LAS float* scr = (PG8_LAS float*)(lds + wid * 16384);
        const int rr = lane >> 5, cc = lane & 31;
#pragma unroll
        for (int ai = 0; ai < 2; ++ai)
#pragma unroll
            for (int bj = 0; bj < 2; ++bj) {
#pragma unroll
                for (int m = 0; m < 4; ++m)
#pragma unroll
                    for (int n = 0; n < 2; ++n) *(PG8_LAS f32x4*)(scr + (m * 16 + fr) * 36 + n * 16 + 4 * fq) = acc[ai][bj][m][n];
                asm volatile("s_waitcnt lgkmcnt(0)" ::: "memory");
                const int colg = u.pn * BM + bj * HALF + wc * 32 + cc; const float sc = (scale ? scale[colg] : 1.0f) * ds;
                float* op = out + (size_t)((u.pm - pm_sub) * BM + ai * HALF + wr * 64 + rr) * ldc + colg;
#pragma unroll 8
                for (int i = 0; i < 32; ++i) { const float v = scr[(2 * i + rr) * 36 + cc]; __hip_atomic_fetch_add(op + (size_t)(2 * i) * ldc, v * sc, __ATOMIC_RELAXED, __HIP_MEMORY_SCOPE_AGENT); }
                asm volatile("s_waitcnt lgkmcnt(0)" ::: "memory");
            }
    }
};

typedef int i32x4v __attribute__((ext_vector_type(4))); typedef int i32x8v __attribute__((ext_vector_type(8)));
struct FragB { bf16x8 k[2]; };
struct Frag8 { i32x8v v; };
template <bool F8> struct FragSel { typedef FragB type; };
template <> struct FragSel<true> { typedef Frag8 type; };
__device__ __forceinline__ void ld_frag(FragB& f, const PG8_LAS unsigned char* p) { f.k[0] = *(const PG8_LAS bf16x8*)p; f.k[1] = *(const PG8_LAS bf16x8*)(p + 1024); }
__device__ __forceinline__ void ld_frag(Frag8& f, const PG8_LAS unsigned char* p) { const i32x4v lo = *(const PG8_LAS i32x4v*)p, hi = *(const PG8_LAS i32x4v*)(p + 1024); f.v = __builtin_shufflevector(lo, hi, 0, 1, 2, 3, 4, 5, 6, 7); }
__device__ __forceinline__ f32x4 mma_frag(const FragB& b, const FragB& a, f32x4 c) { c = __builtin_amdgcn_mfma_f32_16x16x32_bf16(b.k[0], a.k[0], c, 0, 0, 0); return __builtin_amdgcn_mfma_f32_16x16x32_bf16(b.k[1], a.k[1], c, 0, 0, 0); }
__device__ __forceinline__ f32x4 mma_frag(const Frag8& b, const Frag8& a, f32x4 c) {
    asm volatile("v_mfma_scale_f32_16x16x128_f8f6f4 %0, %1, %2, %0, %3, %3 op_sel_hi:[0,0,0]" : "+v"(c) : "v"(b.v), "v"(a.v), "v"(0x7f7f7f7f));
    return c;
}

struct EpiSwiGLU8 {
    static constexpr bool PERM = true, AFTER_DRAIN = false;
    unsigned char* O; int ldc; float ds, hs;
    __device__ __forceinline__ void operator()(const f32x4 (&acc)[2][2][4][2], const Unit& u, int wr, int wc, int fr, int fq) const {
        const int row0 = u.pm * BM + wr * 64 + fr, col0 = u.pn * HALF + wc * 32 + 8 * fq;
#pragma unroll
        for (int ai = 0; ai < 2; ++ai)
#pragma unroll
            for (int m = 0; m < 4; ++m) { unsigned char* rowp = O + (size_t)(row0 + ai * HALF + m * 16) * ldc + col0;
                const f32x4 g0 = acc[ai][0][m][0] * ds, g1 = acc[ai][0][m][1] * ds, u0 = acc[ai][1][m][0] * ds, u1 = acc[ai][1][m][1] * ds;
                float h[8];
#pragma unroll
                for (int j = 0; j < 4; ++j) { h[j] = fminf(fmaxf(silu_f(g0[j]) * u0[j] * hs, -448.0f), 448.0f); h[4 + j] = fminf(fmaxf(silu_f(g1[j]) * u1[j] * hs, -448.0f), 448.0f); }
                unsigned lo = 0u, hi = 0u;
                lo = __builtin_amdgcn_cvt_pk_fp8_f32(h[0], h[1], lo, false); lo = __builtin_amdgcn_cvt_pk_fp8_f32(h[2], h[3], lo, true);
                hi = __builtin_amdgcn_cvt_pk_fp8_f32(h[4], h[5], hi, false); hi = __builtin_amdgcn_cvt_pk_fp8_f32(h[6], h[7], hi, true);
                typedef unsigned u32x2 __attribute__((ext_vector_type(2)));
                *(u32x2*)rowp = (u32x2){lo, hi}; }
    }
};
struct EpiScaleBf16 {
    static constexpr bool PERM = true, AFTER_DRAIN = false;
    bf16_t* O; int ldc; float ds;
    __device__ __forceinline__ void operator()(const f32x4 (&acc)[2][2][4][2], const Unit& u, int wr, int wc, int fr, int fq) const {
        const int row0 = u.pm * BM + wr * 64 + fr, col0 = u.pn * BM + wc * 32 + 8 * fq;
#pragma unroll
        for (int ai = 0; ai < 2; ++ai)
#pragma unroll
            for (int m = 0; m < 4; ++m) { bf16_t* rowp = O + (size_t)(row0 + ai * HALF + m * 16) * ldc + col0;
#pragma unroll
                for (int bj = 0; bj < 2; ++bj) { const f32x4 v0 = acc[ai][bj][m][0] * ds, v1 = acc[ai][bj][m][1] * ds;
                    u32x4 w; w.x = cvt_pk_bf16(v0[0], v0[1]); w.y = cvt_pk_bf16(v0[2], v0[3]); w.z = cvt_pk_bf16(v1[0], v1[1]); w.w = cvt_pk_bf16(v1[2], v1[3]);
                    *(u32x4*)(rowp + bj * HALF) = w; } }
    }
};

template <class Epi, class Sched, bool ALIGN_EPI = false, bool SP2 = false, bool F8 = false>
__device__ __forceinline__ void gemm_phase(PG8_LAS unsigned char* lds, const Gemm g, const Sched& S, const Epi& E, int tid_in) {
    int tid_ = tid_in; asm volatile("" : "+v"(tid_));
    const int tid = tid_, wid = __builtin_amdgcn_readfirstlane(tid >> 6), lane = tid & 63, wr = wid >> 2, wc = wid & 3, fr = lane & 15, fq = lane >> 4;
    const int K = g.K, nt = K / BK, ld = g.ld;
    unsigned voffA[2], voffB[2];
#pragma unroll
    for (int i = 0; i < 2; ++i) { int R, C; stage_rc(tid * 16 + i * 8192, R, C); const int Rb = Epi::PERM ? ((R & ~31) + perm32(R & 31)) : R;
        voffA[i] = (unsigned)(R * ld + C) * 2u; voffB[i] = (unsigned)(Rb * ld + C) * 2u; }
    const size_t kstep = (size_t)(BK * 2);
    const size_t hstep = (size_t)HALF * ld * 2;
    const size_t tstep = 2 * hstep;
    const unsigned ldsw = (unsigned)wid * 1024u;
    const int aoff = lds_byte(wr * 64 + fr, fq * 8), boff = lds_byte(wc * 32 + fr, fq * 8);
#define PG8_SA(b, h) (((b) * 2 + (h)) * HTB)
#define PG8_SB(b, h) ((4 + (b) * 2 + (h)) * HTB)
#define PG8_STAGE(bufoff, gbase, voff) do { _Pragma("unroll") for (int _i = 0; _i < 2; ++_i) \
        __builtin_amdgcn_global_load_lds((const unsigned*)((const char*)(gbase) + (voff)[_i]), (PG8_LAS unsigned*)(lds + (bufoff) + ldsw + _i * 8192), 16, 0, 0); } while (0)
#define PG8_LDA(dst, b, h) do { _Pragma("unroll") for (int m = 0; m < 4; ++m) ld_frag(dst[m], lds + PG8_SA(b, h) + aoff + m * 2048); } while (0)
#define PG8_LDB(dst, b, h) do { _Pragma("unroll") for (int n = 0; n < 2; ++n) ld_frag(dst[n], lds + PG8_SB(b, h) + boff + n * 2048); } while (0)
#define PG8_MMA(ai, bj, At, Bt) do { __builtin_amdgcn_s_setprio(1); _Pragma("unroll") for (int m = 0; m < 4; ++m) _Pragma("unroll") for (int n = 0; n < 2; ++n) \
        acc[ai][bj][m][n] = mma_frag(Bt[n], At[m], acc[ai][bj][m][n]); __builtin_amdgcn_s_setprio(0); } while (0)
#define PG8_WAIT_V(n) asm volatile("s_waitcnt vmcnt(" #n ")" ::: "memory")
#define PG8_WAIT_L(n) asm volatile("s_waitcnt lgkmcnt(" #n ")" ::: "memory")
#define PG8_BAR __builtin_amdgcn_s_barrier()
#define PG8_SCHED __builtin_amdgcn_sched_barrier(0)
    Unit cur, nxt; int ui = 0;
    if (!S.next(0, cur)) return;
    float zacc = 0.f; asm volatile("" : "+v"(zacc));
    f32x4 acc[2][2][4][2];
#pragma unroll
    for (int a = 0; a < 2; ++a)
#pragma unroll
        for (int b = 0; b < 2; ++b)
#pragma unroll
            for (int m = 0; m < 4; ++m)
#pragma unroll
                for (int n = 0; n < 2; ++n) acc[a][b][m][n] = (f32x4){zacc, zacc, zacc, zacc};
    typedef typename FragSel<F8>::type Frag;
    Frag At[4], B0[2], B1[2];
    const char* cA = (const char*)g.A + (size_t)cur.pm * tstep + (size_t)cur.ko * 2; const char* cB = (const char*)g.Bt + (size_t)cur.eb * g.bstride + (size_t)cur.pn * tstep + (size_t)cur.ko * 2;
    S.a_ready(cur);
    if constexpr (SP2) {
        PG8_STAGE(PG8_SB(0, 0), cB, voffB); PG8_STAGE(PG8_SB(0, 1), cB + hstep, voffB); PG8_STAGE(PG8_SA(0, 0), cA, voffA); PG8_STAGE(PG8_SA(0, 1), cA + hstep, voffA);
        if (wr == 1) PG8_BAR;
        PG8_WAIT_V(2); PG8_BAR;
        PG8_STAGE(PG8_SB(1, 0), cB + kstep, voffB); PG8_STAGE(PG8_SA(1, 0), cA + kstep, voffA); PG8_STAGE(PG8_SB(1, 1), cB + hstep + kstep, voffB);
        PG8_WAIT_V(6); PG8_BAR;
    } else {
        PG8_STAGE(PG8_SB(0, 0), cB, voffB); PG8_STAGE(PG8_SA(0, 0), cA, voffA); PG8_STAGE(PG8_SB(0, 1), cB + hstep, voffB); PG8_STAGE(PG8_SA(0, 1), cA + hstep, voffA);
        if (wr == 1) PG8_BAR;
        PG8_WAIT_V(4); PG8_BAR;
        PG8_STAGE(PG8_SB(1, 0), cB + kstep, voffB); PG8_STAGE(PG8_SA(1, 0), cA + kstep, voffA); PG8_STAGE(PG8_SB(1, 1), cB + hstep + kstep, voffB);
        PG8_WAIT_V(6); PG8_BAR;
    }
    for (;;) {
        const bool has_next = S.next(ui + 1, nxt);
        const char* nA = has_next ? (const char*)g.A + (size_t)nxt.pm * tstep + (size_t)nxt.ko * 2 : cA; const char* nB = has_next ? (const char*)g.Bt + (size_t)nxt.eb * g.bstride + (size_t)nxt.pn * tstep + (size_t)nxt.ko * 2 : cB;
        for (int t = 0; t < nt; t += 2) {
            const bool last = (t == nt - 2);
            const char* a1 = cA + (size_t)(t + 1) * kstep;
            const char* a2 = last ? nA : cA + (size_t)(t + 2) * kstep; const char* b2 = last ? nB : cB + (size_t)(t + 2) * kstep;
            const char* a3 = a2 + kstep; const char* b3 = b2 + kstep;
            if (last && has_next) S.a_ready(nxt);
            if constexpr (SP2) {
            PG8_LDB(B0, 0, 0); PG8_LDB(B1, 0, 1); PG8_SCHED; PG8_LDA(At, 0, 0); PG8_STAGE(PG8_SA(1, 1), a1 + hstep, voffA);
            PG8_WAIT_V(8); PG8_WAIT_L(0); PG8_BAR; PG8_MMA(0, 0, At, B0); PG8_MMA(0, 1, At, B1); PG8_BAR; PG8_SCHED;
            PG8_LDA(At, 0, 1); PG8_STAGE(PG8_SB(0, 0), b2, voffB); PG8_STAGE(PG8_SB(0, 1), b2 + hstep, voffB); PG8_STAGE(PG8_SA(0, 0), a2, voffA);
            PG8_WAIT_V(8); PG8_WAIT_L(0); PG8_BAR; PG8_MMA(1, 0, At, B0); PG8_MMA(1, 1, At, B1); PG8_BAR; PG8_SCHED;
            PG8_LDB(B0, 1, 0); PG8_LDB(B1, 1, 1); PG8_SCHED; PG8_LDA(At, 1, 0); PG8_STAGE(PG8_SA(0, 1), a2 + hstep, voffA);
            PG8_WAIT_V(8); PG8_WAIT_L(0); PG8_BAR; PG8_MMA(0, 0, At, B0); PG8_MMA(0, 1, At, B1); PG8_BAR; PG8_SCHED;
            PG8_LDA(At, 1, 1); PG8_STAGE(PG8_SB(1, 0), b3, voffB); PG8_STAGE(PG8_SB(1, 1), b3 + hstep, voffB); PG8_STAGE(PG8_SA(1, 0), a3, voffA);
            PG8_WAIT_V(8); PG8_WAIT_L(0); PG8_BAR; PG8_MMA(1, 0, At, B0); PG8_MMA(1, 1, At, B1); PG8_BAR; PG8_SCHED;
            } else {
            PG8_LDB(B0, 0, 0); PG8_SCHED; PG8_LDA(At, 0, 0); PG8_STAGE(PG8_SA(1, 1), a1 + hstep, voffA);
            PG8_WAIT_L(8); PG8_BAR; PG8_WAIT_L(0); PG8_MMA(0, 0, At, B0); PG8_BAR; PG8_SCHED;
            PG8_LDB(B1, 0, 1); PG8_STAGE(PG8_SB(0, 0), b2, voffB);
            PG8_BAR; PG8_WAIT_L(0); PG8_MMA(0, 1, At, B1); PG8_BAR;
            PG8_LDA(At, 0, 1); PG8_STAGE(PG8_SA(0, 0), a2, voffA);
            PG8_BAR; PG8_WAIT_L(0); PG8_MMA(1, 0, At, B0); PG8_BAR; PG8_SCHED;
            PG8_STAGE(PG8_SB(0, 1), b2 + hstep, voffB);
            PG8_WAIT_V(6); PG8_BAR; PG8_MMA(1, 1, At, B1); PG8_BAR;
            PG8_LDB(B0, 1, 0); PG8_SCHED; PG8_LDA(At, 1, 0); PG8_STAGE(PG8_SA(0, 1), a2 + hstep, voffA);
            PG8_WAIT_L(8); PG8_BAR; PG8_WAIT_L(0); PG8_MMA(0, 0, At, B0); PG8_BAR; PG8_SCHED;
            PG8_LDB(B1, 1, 1); PG8_STAGE(PG8_SB(1, 0), b3, voffB);
            PG8_BAR; PG8_WAIT_L(0); PG8_MMA(0, 1, At, B1); PG8_BAR;
            PG8_LDA(At, 1, 1); PG8_STAGE(PG8_SA(1, 0), a3, voffA);
            PG8_BAR; PG8_WAIT_L(0); PG8_MMA(1, 0, At, B0); PG8_BAR; PG8_SCHED;
            PG8_STAGE(PG8_SB(1, 1), b3 + hstep, voffB);
            PG8_WAIT_V(6); PG8_BAR; PG8_MMA(1, 1, At, B1); PG8_BAR;
            }
        }
        if constexpr (ALIGN_EPI) { if (wr == 0) PG8_BAR; }
        if constexpr (F8) {
            asm volatile("s_nop 15\n\ts_nop 15" : "+v"(acc[1][1][0][0]), "+v"(acc[1][1][0][1]), "+v"(acc[1][1][1][0]), "+v"(acc[1][1][1][1]), "+v"(acc[1][1][2][0]), "+v"(acc[1][1][2][1]), "+v"(acc[1][1][3][0]), "+v"(acc[1][1][3][1])); }
        if constexpr (!Epi::AFTER_DRAIN) { E(acc, cur, wr, wc, fr, fq); S.done(cur); }
        if (!has_next) break;
#pragma unroll
        for (int a = 0; a < 2; ++a)
#pragma unroll
            for (int b = 0; b < 2; ++b)
#pragma unroll
                for (int m = 0; m < 4; ++m)
#pragma unroll
                    for (int n = 0; n < 2; ++n) acc[a][b][m][n] = (f32x4){zacc, zacc, zacc, zacc};
        cur = nxt; cA = nA; cB = nB; ++ui;
        if constexpr (ALIGN_EPI) { if (wr == 1) PG8_BAR; }
    }
    PG8_WAIT_V(0);
    if constexpr (!ALIGN_EPI) { if (wr == 0) PG8_BAR; }
    PG8_BAR;
    if constexpr (Epi::AFTER_DRAIN) { E.fused(acc, cur, wr, wc, fr, fq, lds, wid, lane); S.done(cur); }
#undef PG8_SA
#undef PG8_SB
#undef PG8_STAGE
#undef PG8_LDA
#undef PG8_LDB
#undef PG8_MMA
#undef PG8_WAIT_V
#undef PG8_WAIT_L
#undef PG8_BAR
#undef PG8_SCHED
}
}


constexpr int S_LAT = 16384, C_CTX = 256, R_ALL = S_LAT + C_CTX, DM = 1024;
constexpr int INW = 2560, FFN = 2816, EXD = 3584, NEXP = 8;
constexpr int COL_AQ = 0, COL_AK = 512, COL_AV = 640, COL_HQ = 768, COL_HFF = 1024, COL_HFB = 1280, COL_HI = 1536, COL_HG = 1792, COL_GU = 2048, COL_GV = 2304;
constexpr int MIX_AT = 0, MIX_HG = 512, MIX_GM = 768;
constexpr int MOE_MAXROWS = 34816;
constexpr float EPS = 1e-6f;
constexpr int NWAVES = 8, NTHR = 512;
constexpr int NPH = 23;

constexpr size_t MiB = 1u << 20;
constexpr size_t WS_CTL = 0, CTL_ZERO_BYTES = 1 * MiB;
constexpr size_t WS_VEC = 1 * MiB;
constexpr size_t WS_TOK = 2 * MiB;
constexpr size_t WS_WIN = 3 * MiB;
constexpr size_t WS_WOUT = 13 * MiB;
constexpr size_t WS_WGU = 17 * MiB;
constexpr size_t WS_WD = 28 * MiB;
constexpr size_t WS_MGU = 34 * MiB;
constexpr size_t WS_MD = 146 * MiB;
constexpr size_t WS_H = 202 * MiB;
constexpr size_t WS_PROJ = 235 * MiB;
constexpr size_t WS_MIX = 317 * MiB;
constexpr size_t WS_HGO = 350 * MiB;
constexpr size_t WS_CTXR = 383 * MiB;
constexpr size_t WS_HLT = WS_HGO;
constexpr size_t WS_HSP = 384 * MiB;
constexpr size_t WS_HDG = 402 * MiB;
constexpr size_t WS_VT = 403 * MiB;
constexpr size_t WS_HID = WS_PROJ;
constexpr size_t WS_AS = 202 * MiB;
constexpr size_t WS_HIDM = 270 * MiB;
constexpr size_t WS_H2B = 440 * MiB;
constexpr size_t WS_YF = WS_WIN;
constexpr size_t WS_Y = WS_MGU;
constexpr size_t WS_END = 508 * MiB;
static_assert(WS_HID + (size_t)R_ALL * FFN * 2 <= WS_HGO && WS_AS + (size_t)MOE_MAXROWS * DM * 2 <= WS_HIDM && WS_HIDM + (size_t)MOE_MAXROWS * EXD * 2 <= WS_END, "ws map");
static_assert(WS_H2B >= WS_HIDM && WS_H2B + (size_t)S_LAT * DM * 2 <= WS_END && WS_H + (size_t)R_ALL * DM * 2 <= WS_PROJ && WS_PROJ + (size_t)R_ALL * INW * 2 <= WS_MIX && WS_MIX + (size_t)R_ALL * DM * 2 <= WS_HGO && WS_HGO + (size_t)2 * R_ALL * 256 * 4 <= WS_CTXR, "ws map 2");
constexpr int VO_MOD = 0;
constexpr int VO_ROPE = 32768;
constexpr int VO_MOE = 65536;
constexpr int CW_BAR = 4096;
constexpr int CW_QUEUE = 2048;
constexpr int CW_MOECNT = 1024;

constexpr int RING_BYTES = 131072;
constexpr int LDSCTL_OFF = 159744, MISC_OFF = LDSCTL_OFF + 320;
constexpr int LDS_BYTES = 163840;

#define GAS __attribute__((address_space(1)))
#define LAS __attribute__((address_space(3)))
typedef unsigned short bf16;
typedef unsigned v4u __attribute__((ext_vector_type(4)));
typedef unsigned v2u __attribute__((ext_vector_type(2)));
typedef float f32x4 __attribute__((ext_vector_type(4)));
typedef GAS unsigned gu32;
#define RLX_AGENT __ATOMIC_RELAXED, __HIP_MEMORY_SCOPE_AGENT
#define LDS_WAIT() asm volatile("s_waitcnt lgkmcnt(0)" ::: "memory")
typedef float f32x2_t __attribute__((ext_vector_type(2))); typedef __bf16 bf16x2_t __attribute__((ext_vector_type(2)));
__device__ __forceinline__ unsigned pk2(float lo, float hi) { const f32x2_t v = {lo, hi}; const bf16x2_t b = __builtin_convertvector(v, bf16x2_t); return __builtin_bit_cast(unsigned, b); }
__device__ __forceinline__ unsigned f2bf(float f) { return pk2(f, 0.f) & 0xffffu; }
__device__ __forceinline__ float bflo(unsigned w) { return __builtin_bit_cast(float, w << 16); }
__device__ __forceinline__ float bfhi(unsigned w) { return __builtin_bit_cast(float, w & 0xffff0000u); }
__device__ __forceinline__ float sigm1(float x) { return __builtin_amdgcn_rcpf(1.0f + __builtin_amdgcn_exp2f(-1.4426950408889634f * x)); }
__device__ __forceinline__ float silu1(float x) { return x * sigm1(x); }
__device__ __forceinline__ float gelu1(float x) { return 0.5f * x * (1.0f + erff(x * 0.70710678118654752f)); }
template <int X> __device__ __forceinline__ float sx(float v) { return __shfl_xor(v, X); }
__device__ __forceinline__ float sx32_add(float v) { return v + __shfl_xor(v, 32); }
__device__ __forceinline__ float sx32_max(float v) { return fmaxf(v, __shfl_xor(v, 32)); }
__device__ __forceinline__ float wave_sum(float v) { v += sx<1>(v); v += sx<2>(v); v += sx<4>(v); v += sx<8>(v); v += sx<16>(v); return sx32_add(v); }
__device__ __forceinline__ void unpack8(const v4u w, float* f) { f[0] = bflo(w.x); f[1] = bfhi(w.x); f[2] = bflo(w.y); f[3] = bfhi(w.y); f[4] = bflo(w.z); f[5] = bfhi(w.z); f[6] = bflo(w.w); f[7] = bfhi(w.w); }


__device__ __forceinline__ float clamp448(float x) { return fminf(fmaxf(x, -448.0f), 448.0f); }
__device__ __forceinline__ unsigned pk4_fp8(float a, float b, float c, float d) {
    unsigned w = 0u; w = __builtin_amdgcn_cvt_pk_fp8_f32(clamp448(a), clamp448(b), w, false); w = __builtin_amdgcn_cvt_pk_fp8_f32(clamp448(c), clamp448(d), w, true); return w; }
constexpr float F8_WSCALE = 128.0f;
constexpr float F8_ASCALE = 16.0f;
constexpr float F8_HSCALE = 8.0f;
#define XB_TMO      128
#define XB_XCNT(j)  (256  + 64 * (j))
#define XB_XSUB(j)  (1280 + 64 * (j))
#define XB_XGEN(j)  (2304 + 64 * (j))
#define XB_TOP      3328
#define XB_TOPGEN   3392
#define XCD_BAR_WORDS 3456
#define XB_SPIN_CAP (1u << 18)

__device__ __forceinline__ unsigned xb_ld(unsigned* p)              { return __hip_atomic_load(p, __ATOMIC_RELAXED, __HIP_MEMORY_SCOPE_AGENT); }
__device__ __forceinline__ unsigned xb_add(unsigned* p, unsigned v) { return __hip_atomic_fetch_add(p, v, __ATOMIC_RELAXED, __HIP_MEMORY_SCOPE_AGENT); }
__device__ __forceinline__ unsigned xb_xcc_id() { return (unsigned)__builtin_amdgcn_s_getreg((3 << 11) | 20) & 0xFu; }
#define XB_SPIN(cond, bar) do { unsigned _sp = 0; while (cond) { __builtin_amdgcn_s_sleep(1); \
    if ((++_sp & 255u) == 0u) { if (xb_ld(&(bar)[XB_TMO])) break; if (_sp > XB_SPIN_CAP) { atomicAdd(&(bar)[XB_TMO], 1u); break; } } } } while (0)

struct XcdBarrier {
    unsigned* bar; unsigned x;
    volatile LAS unsigned* st;
};

__device__ __forceinline__ XcdBarrier xcd_barrier_post(unsigned* bar, volatile LAS unsigned* st) {
    XcdBarrier b; b.bar = bar; b.x = xb_xcc_id(); b.st = st;
    if (threadIdx.x == 0) (void)xb_add(&bar[XB_XCNT(b.x)], 1u);
    return b;
}
__device__ __forceinline__ void xcd_barrier_complete(unsigned* bar, unsigned x, unsigned& nloc, unsigned& nx) {
    const unsigned G = gridDim.x * gridDim.y * gridDim.z;
    unsigned sum, cnt, mine, sp = 0u;
    for (;;) {
        sum = 0u; cnt = 0u; mine = 0u;
#pragma unroll
        for (unsigned j = 0; j < 16; ++j) { const unsigned c = xb_ld(&bar[XB_XCNT(j)]); sum += c; cnt += (c > 0u) ? 1u : 0u; mine = (j == x) ? c : mine; }
        if (sum == G) break;
        __builtin_amdgcn_s_sleep(1);
        if ((++sp & 255u) == 0u) { if (xb_ld(&bar[XB_TMO])) break; if (sp > XB_SPIN_CAP) { atomicAdd(&bar[XB_TMO], 1u); break; } }
    }
    nloc = mine > 0u ? mine : 1u; nx = cnt > 0u ? cnt : 1u;
}

__device__ __forceinline__ void xcd_barrier(const XcdBarrier& b, const int tid_in) {
    asm volatile("s_waitcnt vmcnt(0)" ::: "memory");
    __syncthreads();
    if (tid_in == 0) {
        unsigned* bar = b.bar;
        __builtin_amdgcn_s_waitcnt(0);
        unsigned nloc = b.st[0], nx = b.st[1];
        if (nloc == 0u) { xcd_barrier_complete(bar, b.x, nloc, nx); b.st[0] = nloc; b.st[1] = nx; }
        const unsigned old = xb_add(&bar[XB_XSUB(b.x)], 1u);
        const unsigned gen = old / nloc;
        if (old + 1u == (gen + 1u) * nloc) {
            __builtin_amdgcn_fence(__ATOMIC_RELEASE, "agent");
            asm volatile("s_waitcnt vmcnt(0)" ::: "memory");
            const unsigned og = xb_add(&bar[XB_TOP], 1u);
            const unsigned tg = og / nx;
            if (og + 1u == (tg + 1u) * nx) xb_add(&bar[XB_TOPGEN], 1u);
            else XB_SPIN(xb_ld(&bar[XB_TOPGEN]) == tg, bar);
            __builtin_amdgcn_fence(__ATOMIC_ACQUIRE, "agent");
            xb_add(&bar[XB_XGEN(b.x)], 1u);
            asm volatile("s_waitcnt vmcnt(0)" ::: "memory");
        } else {
            XB_SPIN(xb_ld(&bar[XB_XGEN(b.x)]) == gen, bar);
            __builtin_amdgcn_fence(__ATOMIC_ACQUIRE, "agent");
            asm volatile("s_waitcnt vmcnt(0)" ::: "memory");
        }
    }
    __syncthreads();
}


struct Args { const float* in[23]; float* out; unsigned char* ws; int ph_lo, ph_hi; };
typedef const __attribute__((address_space(4))) Args* KA;
#define KARGS() ({ KA p_ = (KA)__builtin_amdgcn_kernarg_segment_ptr(); asm volatile("" : "+s"(p_)); p_; })
enum { I_X = 0, I_C, I_CTX, I_CCTX, I_WADA, I_BADA, I_WIN, I_WOUT, I_QG, I_KG, I_SINK, I_HLB, I_HGAIN, I_GWS, I_GBS, I_GNG, I_FG, I_FU, I_FD, I_ROUTER, I_MG, I_MU, I_MDN };

__device__ __forceinline__ void transpose_item(const float* W, int K, int N, bf16* WT, int mode, LAS float* scr, int item, int lane) {
    const int nblk = N / 32, kb = item / nblk, nb = item % nblk, k0 = 64 * kb, n0 = 32 * nb;
#pragma unroll 8
    for (int i = 0; i < 32; ++i) { const int kk = 2 * i + (lane >> 5); scr[kk * 33 + (lane & 31)] = W[(size_t)(k0 + kk) * N + n0 + (lane & 31)]; }
    LDS_WAIT(); asm volatile("" ::: "memory");
    const int c = lane & 7;
#pragma unroll
    for (int j = 0; j < 4; ++j) { const int n = (lane >> 3) + 8 * j; const LAS float* s = scr + (8 * c) * 33 + n;
        v4u o; o.x = pk2(s[0 * 33], s[1 * 33]); o.y = pk2(s[2 * 33], s[3 * 33]); o.z = pk2(s[4 * 33], s[5 * 33]); o.w = pk2(s[6 * 33], s[7 * 33]);
        const int ng = n0 + n; const int drow = (mode == 0) ? ng : (ng + 128 * (ng / 128) + (mode == 2 ? 128 : 0));
        *(GAS v4u*)(WT + (size_t)drow * K + k0 + 8 * c) = o; }
    LDS_WAIT(); asm volatile("" ::: "memory");
}
__device__ __forceinline__ void transpose_item8(const float* W, int K, int N, unsigned char* WT, int mode, LAS float* scr, int item, int lane) {
    const int nblk = N / 32, kb = item / nblk, nb = item % nblk, k0 = 64 * kb, n0 = 32 * nb;
#pragma unroll 8
    for (int i = 0; i < 32; ++i) { const int kk = 2 * i + (lane >> 5); scr[kk * 33 + (lane & 31)] = W[(size_t)(k0 + kk) * N + n0 + (lane & 31)]; }
    LDS_WAIT(); asm volatile("" ::: "memory");
    const int c = lane & 7;
#pragma unroll
    for (int j = 0; j < 4; ++j) { const int n = (lane >> 3) + 8 * j; const LAS float* s = scr + (8 * c) * 33 + n;
        v2u o; o.x = pk4_fp8(s[0 * 33] * F8_WSCALE, s[1 * 33] * F8_WSCALE, s[2 * 33] * F8_WSCALE, s[3 * 33] * F8_WSCALE); o.y = pk4_fp8(s[4 * 33] * F8_WSCALE, s[5 * 33] * F8_WSCALE, s[6 * 33] * F8_WSCALE, s[7 * 33] * F8_WSCALE);
        const int ng = n0 + n; const int drow = (mode == 0) ? ng : (ng + 128 * (ng / 128) + (mode == 2 ? 128 : 0));
        *(GAS v2u*)(WT + (size_t)drow * K + k0 + 8 * c) = o; }
    LDS_WAIT(); asm volatile("" ::: "memory");
}
constexpr int MOE_ITEMS = 24 * 16 * 112;
constexpr int MOE_DEFER = 3 * 5376;
__device__ __forceinline__ void moe_conv_item(KA a, int it, LAS float* scr, int lane) {
    constexpr int I_M = 16 * 112;
    unsigned char* ws = a->ws;
    const int idx = it / I_M, r = it % I_M;
    if (idx < 8) transpose_item8(a->in[I_MG] + (size_t)idx * DM * EXD, DM, EXD, (unsigned char*)(ws + WS_MGU) + (size_t)idx * 2 * EXD * DM, 1, scr, r, lane);
    else if (idx < 16) transpose_item8(a->in[I_MU] + (size_t)(idx - 8) * DM * EXD, DM, EXD, (unsigned char*)(ws + WS_MGU) + (size_t)(idx - 8) * 2 * EXD * DM, 2, scr, r, lane);
    else transpose_item8(a->in[I_MDN] + (size_t)(idx - 16) * EXD * DM, EXD, DM, (unsigned char*)(ws + WS_MD) + (size_t)(idx - 16) * DM * EXD, 0, scr, r, lane);
}
__device__ __forceinline__ void moe_conv_slice(KA a, int s, int first, LAS unsigned char* lds, int lane, int wave, int G, int bid) {
    if (bid < first) return;
    LAS float* scr = (LAS float*)(lds + wave * 8704);
    const int nw = (G - first) * NWAVES, w = (bid - first) * NWAVES + wave, per = MOE_DEFER / 3;
    for (int i = w; i < per; i += nw) moe_conv_item(a, s * per + i, scr, lane);
}
__device__ __forceinline__ void p0_prologue(KA a, LAS unsigned char* lds, int tid, int lane, int wave, int G, int bid) {
    unsigned char* ws = a->ws;
    LAS float* scr = (LAS float*)(lds + wave * 8704);
    const int gw = bid * NWAVES + wave, NGW = G * NWAVES;
    constexpr int I_IN = 16 * 80, I_OUT = 16 * 32, I_F = 16 * 88, I_FDN = 44 * 32, I_M = 16 * 112;
    constexpr int NIT = 2 * I_IN + 2 * I_OUT + 2 * I_F + I_FDN + 24 * I_M;
    for (int it0 = gw; it0 < NIT; it0 += NGW) {
        int it = it0;
        if (it < 2 * I_IN) { const int l = it / I_IN, r = it % I_IN; transpose_item(a->in[I_WIN] + (size_t)l * DM * INW, DM, INW, (bf16*)(ws + WS_WIN) + (size_t)l * INW * DM, 0, scr, r, lane); continue; } it -= 2 * I_IN;
        if (it < 2 * I_OUT) { const int l = it / I_OUT, r = it % I_OUT; transpose_item(a->in[I_WOUT] + (size_t)l * DM * DM, DM, DM, (bf16*)(ws + WS_WOUT) + (size_t)l * DM * DM, 0, scr, r, lane); continue; } it -= 2 * I_OUT;
        if (it < I_F) { transpose_item(a->in[I_FG], DM, FFN, (bf16*)(ws + WS_WGU), 1, scr, it, lane); continue; } it -= I_F;
        if (it < I_F) { transpose_item(a->in[I_FU], DM, FFN, (bf16*)(ws + WS_WGU), 2, scr, it, lane); continue; } it -= I_F;
        if (it < I_FDN) { transpose_item(a->in[I_FD], FFN, DM, (bf16*)(ws + WS_WD), 0, scr, it, lane); continue; } it -= I_FDN;
        if (it >= MOE_DEFER) moe_conv_item(a, it, scr, lane);
    }
    LAS float* sil = (LAS float*)(lds + 69632);
    LAS float* part = (LAS float*)(lds + 69632 + 8192);
    float* vec = (float*)(ws + WS_VEC);
    if (bid < 192) {
        for (int i = tid; i < 2048; i += NTHR) { const float v = (i < 1024) ? a->in[I_C][i] : a->in[I_CCTX][i - 1024]; sil[i] = silu1(v); }
        __syncthreads();
        for (int item = bid; item < 192; item += G) {
            const int l = item / 96, cb = item % 96, col = cb * 64 + lane;
            const float* w = a->in[I_WADA] + (size_t)l * DM * 6144 + col;
            float a0 = 0.f, a1 = 0.f;
#pragma unroll 8
            for (int k = wave * 128; k < wave * 128 + 128; ++k) { const float wv = w[(size_t)k * 6144]; a0 += sil[k] * wv; a1 += sil[1024 + k] * wv; }
            part[(wave * 2 + 0) * 64 + lane] = a0; part[(wave * 2 + 1) * 64 + lane] = a1;
            __syncthreads();
            if (wave == 0) { float s0 = 0.f, s1 = 0.f;
#pragma unroll
                for (int w8 = 0; w8 < 8; ++w8) { s0 += part[(w8 * 2 + 0) * 64 + lane]; s1 += part[(w8 * 2 + 1) * 64 + lane]; }
                const float b = a->in[I_BADA][l * 6144 + col];
                vec[VO_MOD + (l * 2 + 0) * 6144 + col] = s0 + b; vec[VO_MOD + (l * 2 + 1) * 6144 + col] = s1 + b; }
            __syncthreads();
        }
    }
    for (int i = bid * NTHR + tid; i < C_CTX * DM / 4; i += G * NTHR) ((GAS f32x4*)(ws + WS_CTXR))[i] = ((const GAS f32x4*)a->in[I_CTX])[i];
    if (bid == G - 1) {
        for (int idx = tid; idx < 5120; idx += NTHR) {
            const int isc = idx >= 4096, j = isc ? idx - 4096 : idx, pos = j / 16, i = j % 16;
            const float inv = exp2f(-(float)i * 0.83048202372184059f);
            const float ang = (float)pos * inv;
            double r = (double)ang * 0.15915494309189535; r -= floor(r);
            const float rf = (float)r;
            const float cs = __builtin_amdgcn_cosf(rf), sn = __builtin_amdgcn_sinf(rf);
            float* t = vec + VO_ROPE + (isc ? 8192 : 0);
            const int n = isc ? 1024 : 4096;
            t[j] = cs; t[n + j] = sn;
        }
    }
}

template <bool STORE = true> __device__ __forceinline__ void norm_row(const float* xrow, const float* sc, const float* sh, bf16* orow, int lane, f32x4 (&h)[4]) {
    const GAS f32x4* xr = (const GAS f32x4*)xrow + lane;
    f32x4 v[4]; float s = 0.f;
#pragma unroll
    for (int j = 0; j < 4; ++j) { v[j] = xr[64 * j]; s += (v[j].x * v[j].x + v[j].y * v[j].y) + (v[j].z * v[j].z + v[j].w * v[j].w); }
    const float rstd = __builtin_amdgcn_rsqf(wave_sum(s) * (1.0f / DM) + EPS);
    GAS v2u* o8 = (GAS v2u*)orow + lane;
#pragma unroll
    for (int j = 0; j < 4; ++j) { const f32x4 scv = *(const f32x4*)(sc + 4 * lane + 256 * j), shv = *(const f32x4*)(sh + 4 * lane + 256 * j);
        h[j] = v[j] * rstd * (scv + 1.0f) + shv;
        if constexpr (STORE) { v2u w; w.x = pk2(h[j].x, h[j].y); w.y = pk2(h[j].z, h[j].w); o8[64 * j] = w; } }
}
__device__ __forceinline__ void phase_norm(KA a, int l, int which, int nrows, bf16* H, int lane, int wave, int G, int bid) {
    const float* vec = (const float*)(a->ws + WS_VEC);
    const float* xl = (l == 0 && which == 0) ? a->in[I_X] : a->out;
    const float* xc = (l == 0 && which == 0) ? a->in[I_CTX] : (const float*)(a->ws + WS_CTXR);
    const float* ml = vec + VO_MOD + (l * 2 + 0) * 6144 + which * 3072;
    const float* mc = vec + VO_MOD + (l * 2 + 1) * 6144 + which * 3072;
    const int gw = bid * NWAVES + wave, NGW = G * NWAVES;
    f32x4 scl[4], shl[4], v[4];
#pragma unroll
    for (int j = 0; j < 4; ++j) { scl[j] = *(const f32x4*)(ml + 1024 + 4 * lane + 256 * j) + 1.0f; shl[j] = *(const f32x4*)(ml + 4 * lane + 256 * j); }
    if (gw < nrows) { const GAS f32x4* xr = (const GAS f32x4*)(gw >= S_LAT ? xc + (size_t)(gw - S_LAT) * DM : xl + (size_t)gw * DM) + lane;
#pragma unroll
        for (int j = 0; j < 4; ++j) v[j] = xr[64 * j]; }
    for (int r = gw; r < nrows; r += NGW) {
        const int rn = r + NGW; f32x4 vn[4];
        if (rn < nrows) { const GAS f32x4* xr = (const GAS f32x4*)(rn >= S_LAT ? xc + (size_t)(rn - S_LAT) * DM : xl + (size_t)rn * DM) + lane;
#pragma unroll
            for (int j = 0; j < 4; ++j) vn[j] = xr[64 * j]; }
        float s = 0.f;
#pragma unroll
        for (int j = 0; j < 4; ++j) s += (v[j].x * v[j].x + v[j].y * v[j].y) + (v[j].z * v[j].z + v[j].w * v[j].w);
        const float rstd = __builtin_amdgcn_rsqf(wave_sum(s) * (1.0f / DM) + EPS);
        GAS v2u* o8 = (GAS v2u*)(H + (size_t)r * DM) + lane;
        if (r >= S_LAT) {
#pragma unroll
            for (int j = 0; j < 4; ++j) { const f32x4 scv = *(const f32x4*)(mc + 1024 + 4 * lane + 256 * j), shv = *(const f32x4*)(mc + 4 * lane + 256 * j);
                const f32x4 h = v[j] * rstd * (scv + 1.0f) + shv; v2u w; w.x = pk2(h.x, h.y); w.y = pk2(h.z, h.w); o8[64 * j] = w; }
        } else {
#pragma unroll
            for (int j = 0; j < 4; ++j) { const f32x4 h = v[j] * rstd * scl[j] + shl[j]; v2u w; w.x = pk2(h.x, h.y); w.y = pk2(h.z, h.w); o8[64 * j] = w; }
        }
#pragma unroll
        for (int j = 0; j < 4; ++j) v[j] = vn[j];
    }
}
__device__ __forceinline__ void phase_norm_route(KA a, LAS unsigned char* lds, int tid, int lane, int wave, int G, int bid) {
    const int l = 1;
    const float* vec = (const float*)(a->ws + WS_VEC);
    const float* ml = vec + VO_MOD + (l * 2 + 0) * 6144 + 3072;
    unsigned char* H8 = (unsigned char*)(a->ws + WS_H2B);
    LAS float* rt = (LAS float*)lds;
    volatile LAS unsigned* lcnt = (volatile LAS unsigned*)(lds + 32768);
    for (int i = tid; i < 8192; i += NTHR) rt[i] = a->in[I_ROUTER][i];
    if (tid < 16) lcnt[tid] = 0u;
    __syncthreads();
    int* tokinfo = (int*)(a->ws + WS_TOK);
    unsigned* cnt = (unsigned*)(a->ws + WS_CTL) + CW_MOECNT;
    const int gw = bid * NWAVES + wave, NGW = G * NWAVES;
    unsigned keep = 0u, pk0 = 0u; int itn = 0;
    for (int r = gw; r < S_LAT; r += NGW) {
        f32x4 h[4];
        norm_row<false>(a->out + (size_t)r * DM, ml + 1024, ml, nullptr, lane, h);
#pragma unroll
        for (int j = 0; j < 4; ++j) ((GAS unsigned*)(H8 + (size_t)r * DM))[lane + 64 * j] = pk4_fp8(h[j].x * F8_ASCALE, h[j].y * F8_ASCALE, h[j].z * F8_ASCALE, h[j].w * F8_ASCALE);
        float lg[8];
#pragma unroll
        for (int e = 0; e < 8; ++e) lg[e] = 0.f;
#pragma unroll
        for (int j = 0; j < 4; ++j)
#pragma unroll
            for (int i = 0; i < 4; ++i) { const int d = 4 * lane + 256 * j + i; const f32x4 r0 = *(const LAS f32x4*)(rt + d * 8), r1 = *(const LAS f32x4*)(rt + d * 8 + 4); const float hv = h[j][i];
                lg[0] += hv * r0.x; lg[1] += hv * r0.y; lg[2] += hv * r0.z; lg[3] += hv * r0.w; lg[4] += hv * r1.x; lg[5] += hv * r1.y; lg[6] += hv * r1.z; lg[7] += hv * r1.w; }
#pragma unroll
        for (int e = 0; e < 8; ++e) lg[e] = wave_sum(lg[e]);
        int i1 = 0; float v1 = lg[0];
#pragma unroll
        for (int e = 1; e < 8; ++e) if (lg[e] > v1) { v1 = lg[e]; i1 = e; }
        int i2 = -1; float v2 = -INFINITY;
#pragma unroll
        for (int e = 0; e < 8; ++e) if (e != i1 && lg[e] > v2) { v2 = lg[e]; i2 = e; }
        const float w1 = 1.0f / (1.0f + __expf(v2 - v1)), w2 = 1.0f - w1;
        if (lane == 0) {
            const unsigned r1 = __hip_atomic_fetch_add((LAS unsigned*)lcnt + i1, 1u, __ATOMIC_RELAXED, __HIP_MEMORY_SCOPE_WORKGROUP), r2 = __hip_atomic_fetch_add((LAS unsigned*)lcnt + i2, 1u, __ATOMIC_RELAXED, __HIP_MEMORY_SCOPE_WORKGROUP);
            int* ti = tokinfo + (size_t)r * 8;
            ti[0] = i1; ti[1] = i2; ti[4] = __builtin_bit_cast(int, w1); ti[5] = __builtin_bit_cast(int, w2);
            pk0 = (unsigned)i1 | ((unsigned)i2 << 3) | (r1 << 6) | (r2 << 19);
        }
        const unsigned pku = (unsigned)__builtin_amdgcn_readfirstlane((int)pk0);
        if (lane == itn) keep = pku;
        ++itn;
    }
    __syncthreads();
    if (tid < 8) lcnt[8 + tid] = __hip_atomic_fetch_add(cnt + 64 * tid, lcnt[tid], RLX_AGENT);
    __syncthreads();
    { const int r = gw + lane * NGW; if (lane < itn && r < S_LAT) { int* ti = tokinfo + (size_t)r * 8; const unsigned e1 = keep & 7u, e2 = (keep >> 3) & 7u; ti[2] = (int)(((keep >> 6) & 0x1fffu) + lcnt[8 + e1]); ti[3] = (int)((keep >> 19) + lcnt[8 + e2]); } }
}

__device__ __forceinline__ void qk_prep(KA a, int l, int first_thread, int nthreads) {
    bf16* PROJ = (bf16*)(a->ws + WS_PROJ);
    const float* rope = (const float*)(a->ws + WS_VEC) + VO_ROPE;
    for (int i = first_thread; i < R_ALL * 10; i += nthreads) {
        const int row = i / 10, hh = i % 10; const bool isq = hh < 8;
        bf16* p = PROJ + (size_t)row * INW + (isq ? hh * 64 : COL_AK + (hh - 8) * 64);
        const float* gain = (isq ? a->in[I_QG] : a->in[I_KG]) + l * 64;
        float x[64]; float ss = 0.f;
#pragma unroll
        for (int c = 0; c < 8; ++c) { const v4u w = *(const GAS v4u*)(p + 8 * c); unpack8(w, x + 8 * c); }
#pragma unroll
        for (int d = 0; d < 64; ++d) ss += x[d] * x[d];
        const float rstd = __builtin_amdgcn_rsqf(ss * (1.0f / 64.0f) + EPS);
        const f32x4* g4 = (const f32x4*)gain;
#pragma unroll
        for (int c = 0; c < 16; ++c) { const f32x4 gv = g4[c]; x[4 * c] *= rstd * gv.x; x[4 * c + 1] *= rstd * gv.y; x[4 * c + 2] *= rstd * gv.z; x[4 * c + 3] *= rstd * gv.w; }
        if (row < S_LAT) {
            const int gr = row >> 6, gc = row & 63;
            const f32x4* cr = (const f32x4*)(rope + gr * 16); const f32x4* sr = (const f32x4*)(rope + 4096 + gr * 16); const f32x4* cc = (const f32x4*)(rope + 8192 + gc * 16); const f32x4* sc = (const f32x4*)(rope + 8192 + 1024 + gc * 16);
#pragma unroll
            for (int j4 = 0; j4 < 4; ++j4) { const f32x4 cv = cr[j4], sv = sr[j4];
#pragma unroll
                for (int i = 0; i < 4; ++i) { const int j = 4 * j4 + i; const float x1 = x[j], x2 = x[16 + j]; x[j] = x1 * cv[i] - x2 * sv[i]; x[16 + j] = x1 * sv[i] + x2 * cv[i]; } }
#pragma unroll
            for (int j4 = 0; j4 < 4; ++j4) { const f32x4 cv = cc[j4], sv = sc[j4];
#pragma unroll
                for (int i = 0; i < 4; ++i) { const int j = 4 * j4 + i; const float x1 = x[32 + j], x2 = x[48 + j]; x[32 + j] = x1 * cv[i] - x2 * sv[i]; x[48 + j] = x1 * sv[i] + x2 * cv[i]; } }
        }
        const float qs = isq ? 0.125f * 1.4426950408889634f : 1.0f;
#pragma unroll
        for (int c = 0; c < 8; ++c) { v4u w; w.x = pk2(x[8 * c] * qs, x[8 * c + 1] * qs); w.y = pk2(x[8 * c + 2] * qs, x[8 * c + 3] * qs); w.z = pk2(x[8 * c + 4] * qs, x[8 * c + 5] * qs); w.w = pk2(x[8 * c + 6] * qs, x[8 * c + 7] * qs);
            *(GAS v4u*)(p + 8 * c) = w; }
    }
}
__device__ __forceinline__ void gmlp_unit(KA a, int l, int chunk, int g, LAS unsigned char* lds, int tid, int lane, int wave) {
    const bf16* PROJ = (const bf16*)(a->ws + WS_PROJ); bf16* MIX = (bf16*)(a->ws + WS_MIX);
    const int row0 = (chunk < 128) ? chunk * 128 : S_LAT + (chunk - 128) * 128;
    LAS float* vn = (LAS float*)lds;
    { const int pos = tid >> 2, part = tid & 3;
      const bf16* p = PROJ + (size_t)(row0 + pos) * INW + COL_GV + g * 64 + part * 16;
      float x[16]; unpack8(*(const GAS v4u*)p, x); unpack8(*(const GAS v4u*)(p + 8), x + 8);
      float ss = 0.f;
#pragma unroll
      for (int d = 0; d < 16; ++d) { x[d] = gelu1(x[d]); ss += x[d] * x[d]; }
      ss += sx<1>(ss); ss += sx<2>(ss);
      const float rstd = __builtin_amdgcn_rsqf(ss * (1.0f / 64.0f) + EPS);
      const float* gn = a->in[I_GNG] + l * 256 + g * 64 + part * 16;
#pragma unroll
      for (int d = 0; d < 16; ++d) vn[pos * 64 + part * 16 + d] = x[d] * rstd * gn[d]; }
    __syncthreads();
    const int c = lane, t0 = wave * 16;
    const float* W = a->in[I_GWS] + ((size_t)(l * 4 + g) * 128 + t0) * 128;
    float acc[16];
#pragma unroll
    for (int i = 0; i < 16; ++i) acc[i] = 0.f;
    for (int s = 0; s < 128; ++s) { const float v = vn[s * 64 + c];
#pragma unroll
        for (int i = 0; i < 16; ++i) acc[i] += W[i * 128 + s] * v; }
    const float* bs = a->in[I_GBS] + (l * 4 + g) * 128 + t0;
#pragma unroll
    for (int i = 0; i < 16; ++i) { const int row = row0 + t0 + i;
        const float u = gelu1(bflo((unsigned)PROJ[(size_t)row * INW + COL_GU + g * 64 + c]));
        MIX[(size_t)row * DM + MIX_GM + g * 64 + c] = (bf16)f2bf(u * (acc[i] + bs[i])); }
    __syncthreads();
}
__device__ __forceinline__ void hgrn_naive(KA a, int l, int dir, int head, LAS unsigned char* lds, int tid, int lane, int wave) {
    const bf16* PROJ = (const bf16*)(a->ws + WS_PROJ);
    float* HGO = (float*)(a->ws + WS_HGO) + (size_t)dir * R_ALL * 256;
    LAS float* Qs = (LAS float*)lds;
    LAS float* Fs = Qs + 4096; LAS float* Vs = Fs + 4096; LAS float* part = Vs + 4096;
    const int v = lane, kg = wave;
    float S[8];
#pragma unroll
    for (int i = 0; i < 8; ++i) S[i] = 0.f;
    const int tl = tid >> 3, c8 = tid & 7;
    float lb[8];
#pragma unroll
    for (int j = 0; j < 8; ++j) { float b = 0.f; if (l == 1) { const float p0 = a->in[I_HLB][dir * 512 + head * 64 + c8 * 8 + j], p1 = a->in[I_HLB][dir * 512 + 256 + head * 64 + c8 * 8 + j]; b = 1.0f / (1.0f + __expf(p0 - p1)); } lb[j] = b; }
    const int fcol = (dir == 0 ? COL_HFF : COL_HFB) + head * 64 + c8 * 8;
    for (int n0 = 0; n0 < R_ALL; n0 += 64) {
        { const int n = n0 + tl; int row;
          if (dir == 0) row = (n < C_CTX) ? S_LAT + n : n - C_CTX; else row = (n < C_CTX) ? S_LAT + (C_CTX - 1 - n) : (S_LAT - 1) - (n - C_CTX);
          const bf16* pr = PROJ + (size_t)row * INW;
          float q[8], f[8], vv[8];
          unpack8(*(const GAS v4u*)(pr + COL_HQ + head * 64 + c8 * 8), q); unpack8(*(const GAS v4u*)(pr + fcol), f); unpack8(*(const GAS v4u*)(pr + COL_HI + head * 64 + c8 * 8), vv);
#pragma unroll
          for (int j = 0; j < 8; ++j) { Qs[tl * 64 + c8 * 8 + j] = silu1(q[j]) * 0.125f; Fs[tl * 64 + c8 * 8 + j] = lb[j] + (1.0f - lb[j]) * sigm1(f[j]); Vs[tl * 64 + c8 * 8 + j] = vv[j]; } }
        __syncthreads();
        for (int t = 0; t < 64; ++t) {
            const float vt = Vs[t * 64 + v]; float po = 0.f;
#pragma unroll
            for (int i = 0; i < 8; ++i) { const float f = Fs[t * 64 + kg * 8 + i], q = Qs[t * 64 + kg * 8 + i]; S[i] = f * S[i] + (1.0f - f) * vt; po += S[i] * q; }
            part[((t & 1) * 8 + kg) * 64 + v] = po;
            __syncthreads();
            if (wave == 0) { float o = 0.f;
#pragma unroll
                for (int w8 = 0; w8 < 8; ++w8) o += part[((t & 1) * 8 + w8) * 64 + v];
                const int n = n0 + t; int row;
                if (dir == 0) row = (n < C_CTX) ? S_LAT + n : n - C_CTX; else row = (n < C_CTX) ? S_LAT + (C_CTX - 1 - n) : (S_LAT - 1) - (n - C_CTX);
                HGO[(size_t)row * 256 + head * 64 + v] = o; }
        }
        __syncthreads();
    }
}

typedef short bf16x8v __attribute__((ext_vector_type(8)));
constexpr int HST = 72;
__device__ __forceinline__ f32x4 mma16(const LAS bf16* MA, const LAS bf16* MBt, int k0, f32x4 c, int lane) {
    const bf16x8v av = *(const LAS bf16x8v*)(MA + (lane & 15) * HST + k0 + 8 * (lane >> 4));
    const bf16x8v bv = *(const LAS bf16x8v*)(MBt + (lane & 15) * HST + k0 + 8 * (lane >> 4));
    return __builtin_amdgcn_mfma_f32_16x16x32_bf16(av, bv, c, 0, 0, 0);
}
__device__ __forceinline__ int hg_base_row(int cpos) { return cpos < 256 ? 64 * cpos : S_LAT + 64 * (cpos - 256); }
__device__ __forceinline__ int hg_scan_idx(int dir, int cpos) { return dir == 0 ? (cpos < 256 ? 4 + cpos : cpos - 256) : (cpos < 256 ? 4 + (255 - cpos) : 3 - (cpos - 256)); }
__device__ __forceinline__ float hg_lb(KA a, int l, int dir, int head, int k) {
    if (l == 0) return 0.f;
    const float p0 = a->in[I_HLB][dir * 512 + head * 64 + k], p1 = a->in[I_HLB][dir * 512 + 256 + head * 64 + k];
    return 1.0f / (1.0f + __expf(p0 - p1));
}
__device__ __forceinline__ void hgrn_stepA(KA a, int l, int cpos, int head, LAS unsigned char* lds, int lane, int wave) {
    const bf16* PROJ = (const bf16*)(a->ws + WS_PROJ);
    const int dir = wave >> 2, I = wave & 3, base = hg_base_row(cpos), ci = hg_scan_idx(dir, cpos);
    LAS float* TOT = (LAS float*)lds;
    LAS bf16* KLT = (LAS bf16*)(lds + 2048) + dir * 64 * HST;
    LAS bf16* VT = (LAS bf16*)(lds + 2048 + 2 * 64 * HST * 2) + dir * 64 * HST;
    const float lb = hg_lb(a, l, dir, head, lane);
    const int fcol = (dir == 0 ? COL_HFF : COL_HFB) + head * 64 + lane, vcol = COL_HI + head * 64 + lane;
    float kk[16], cl[16]; float run = 0.f;
#pragma unroll
    for (int i = 0; i < 16; ++i) { const int n = 16 * I + i, row = base + (dir ? 63 - n : n);
        const float fl = bflo((unsigned)PROJ[(size_t)row * INW + fcol]);
        const unsigned short vb = PROJ[(size_t)row * INW + vcol];
        const float f = lb + (1.0f - lb) * sigm1(fl);
        run += __logf(f); cl[i] = run; kk[i] = 1.0f - f;
        VT[lane * HST + n] = vb; }
    TOT[(dir * 4 + I) * 64 + lane] = run;
    __syncthreads();
    float post = 0.f, all = 0.f;
#pragma unroll
    for (int J = 0; J < 4; ++J) { const float t = TOT[(dir * 4 + J) * 64 + lane]; all += t; if (J > I) post += t; }
#pragma unroll
    for (int i = 0; i < 16; ++i) KLT[lane * HST + 16 * I + i] = (bf16)f2bf(kk[i] * __expf(run - cl[i] + post));
    if (I == 0) ((float*)(a->ws + WS_HDG))[((size_t)(dir * 4 + head) * 260 + ci) * 64 + lane] = __expf(all);
    __syncthreads();
    float* LT = (float*)(a->ws + WS_HLT) + ((size_t)(dir * 4 + head) * 260 + ci) * 4096;
    float z0 = 0.f; asm volatile("" : "+v"(z0));
#pragma unroll
    for (int kb = 0; kb < 4; ++kb) { f32x4 acc = {z0, z0, z0, z0};
        acc = mma16(VT + 16 * I * HST, KLT + 16 * kb * HST, 0, acc, lane); acc = mma16(VT + 16 * I * HST, KLT + 16 * kb * HST, 32, acc, lane);
#pragma unroll
        for (int r = 0; r < 4; ++r) LT[(16 * I + 4 * (lane >> 4) + r) * 64 + 16 * kb + (lane & 15)] = acc[r]; }
    __syncthreads();
}
__device__ __forceinline__ void hgrn_stepB(KA a, int item, int tid) {
    const int dh = item >> 3, vb = item & 7, v = vb * 8 + (tid >> 6), k = tid & 63;
    const float* LT = (const float*)(a->ws + WS_HLT) + (size_t)dh * 260 * 4096 + v * 64 + k;
    const float* DG = (const float*)(a->ws + WS_HDG) + (size_t)dh * 260 * 64 + k;
    bf16* SP = (bf16*)(a->ws + WS_HSP) + (size_t)dh * 260 * 4096 + v * 64 + k;
    float S = 0.f;
#pragma unroll 1
    for (int c0 = 0; c0 < 260; c0 += 26) {
        float lt[26], dg[26];
#pragma unroll
        for (int j = 0; j < 26; ++j) { lt[j] = LT[(size_t)(c0 + j) * 4096]; dg[j] = DG[(c0 + j) * 64]; }
#pragma unroll
        for (int j = 0; j < 26; ++j) { SP[(size_t)(c0 + j) * 4096] = (bf16)f2bf(S); S = dg[j] * S + lt[j]; }
    }
}
__device__ __forceinline__ void hgrn_stepC(KA a, int l, int cpos, int head, LAS unsigned char* lds, int tid, int lane, int wave) {
    const bf16* PROJ = (const bf16*)(a->ws + WS_PROJ); bf16* MIX = (bf16*)(a->ws + WS_MIX);
    const int dir = wave >> 2, I = wave & 3, base = hg_base_row(cpos), ci = hg_scan_idx(dir, cpos);
    constexpr int MSZ = 64 * HST;
    LAS float* TOT = (LAS float*)lds;
    LAS bf16* img = (LAS bf16*)(lds + 2048);
    LAS bf16* QT = img + dir * MSZ;
    LAS bf16* QD = img + 2 * MSZ + dir * MSZ;
    LAS bf16* VT = img + 4 * MSZ + dir * MSZ;
    LAS bf16* ST = img + 6 * MSZ + dir * MSZ;
    LAS bf16* AS = img + 8 * MSZ + dir * MSZ + I * 16 * HST;
    LAS bf16* KT = img + 10 * MSZ + dir * (10 * 16 * HST);
    LAS float* OS = (LAS float*)(img + 10 * MSZ);
    const float lb = hg_lb(a, l, dir, head, lane);
    const int fcol = (dir == 0 ? COL_HFF : COL_HFB) + head * 64 + lane, qcol = COL_HQ + head * 64 + lane, vcol = COL_HI + head * 64 + lane;
    { const bf16* SP = (const bf16*)(a->ws + WS_HSP) + ((size_t)(dir * 4 + head) * 260 + ci) * 4096;
#pragma unroll
      for (int h2 = 0; h2 < 2; ++h2) { const int e = ((I * 2 + h2) * 64 + lane) * 8, vv = e >> 6, kk0 = e & 63;
          *(LAS v4u*)(ST + vv * HST + kk0) = *(const GAS v4u*)(SP + e); } }
    float kk[16], cl[16], qv[16]; float run = 0.f;
#pragma unroll
    for (int i = 0; i < 16; ++i) { const int n = 16 * I + i, row = base + (dir ? 63 - n : n);
        const float fl = bflo((unsigned)PROJ[(size_t)row * INW + fcol]), ql = bflo((unsigned)PROJ[(size_t)row * INW + qcol]);
        const unsigned short vb = PROJ[(size_t)row * INW + vcol];
        const float f = lb + (1.0f - lb) * sigm1(fl);
        run += __logf(f); cl[i] = run; kk[i] = 1.0f - f; qv[i] = silu1(ql) * 0.125f;
        VT[lane * HST + n] = vb; }
    TOT[(dir * 4 + I) * 64 + lane] = run;
    __syncthreads();
    float tj[4];
#pragma unroll
    for (int J = 0; J < 4; ++J) tj[J] = TOT[(dir * 4 + J) * 64 + lane];
    float pre = 0.f;
#pragma unroll
    for (int J = 0; J < 4; ++J) if (J < I) pre += tj[J];
#pragma unroll
    for (int i = 0; i < 16; ++i) { const float e = __expf(cl[i]); QT[(16 * I + i) * HST + lane] = (bf16)f2bf(qv[i] * e); QD[(16 * I + i) * HST + lane] = (bf16)f2bf(qv[i] * e * __expf(pre)); }
    float eoff = 0.f;
#pragma unroll
    for (int I2 = 0; I2 < 4; ++I2) {
        if (I2 >= I) {
            if (I2 == I) eoff = 0.f; else if (I2 == I + 1) eoff = run; else eoff += tj[I2 - 1];
            LAS bf16* blk = KT + (I2 * (I2 + 1) / 2 + I) * 16 * HST;
#pragma unroll
            for (int i = 0; i < 16; ++i) blk[i * HST + lane] = (bf16)f2bf(kk[i] * __expf(fminf(eoff - cl[i], 80.0f)));
        }
    }
    __syncthreads();
    float z0 = 0.f; asm volatile("" : "+v"(z0));
    f32x4 sc[4];
#pragma unroll
    for (int J = 0; J < 4; ++J) { sc[J] = (f32x4){z0, z0, z0, z0};
        if (J <= I) { const LAS bf16* kb = KT + (I * (I + 1) / 2 + J) * 16 * HST;
            sc[J] = mma16(QT + 16 * I * HST, kb, 0, sc[J], lane); sc[J] = mma16(QT + 16 * I * HST, kb, 32, sc[J], lane);
            if (J == I) {
#pragma unroll
                for (int r = 0; r < 4; ++r) if ((lane & 15) > 4 * (lane >> 4) + r) sc[J][r] = z0; } } }
#pragma unroll
    for (int J = 0; J < 4; ++J)
#pragma unroll
        for (int r = 0; r < 4; ++r) AS[(4 * (lane >> 4) + r) * HST + 16 * J + (lane & 15)] = (bf16)f2bf(sc[J][r]);
    asm volatile("s_waitcnt lgkmcnt(0)" ::: "memory");
    f32x4 acc[4];
#pragma unroll
    for (int vb = 0; vb < 4; ++vb) { acc[vb] = (f32x4){z0, z0, z0, z0};
        acc[vb] = mma16(AS, VT + 16 * vb * HST, 0, acc[vb], lane); acc[vb] = mma16(AS, VT + 16 * vb * HST, 32, acc[vb], lane);
        acc[vb] = mma16(QD + 16 * I * HST, ST + 16 * vb * HST, 0, acc[vb], lane); acc[vb] = mma16(QD + 16 * I * HST, ST + 16 * vb * HST, 32, acc[vb], lane); }
    __syncthreads();
#pragma unroll
    for (int vb = 0; vb < 4; ++vb)
#pragma unroll
        for (int r = 0; r < 4; ++r) { const int n = 16 * I + 4 * (lane >> 4) + r, rl = dir ? 63 - n : n; OS[(dir * 64 + rl) * 68 + 16 * vb + (lane & 15)] = acc[vb][r]; }
    __syncthreads();
    { const int rl = tid >> 3, v8 = (tid & 7) * 8, row = base + rl;
      float o[8]; float ss = 0.f;
#pragma unroll
      for (int j = 0; j < 8; ++j) { o[j] = OS[rl * 68 + v8 + j] + OS[(64 + rl) * 68 + v8 + j]; ss += o[j] * o[j]; }
      ss += sx<1>(ss); ss += sx<2>(ss); ss += sx<4>(ss);
      const float rstd = __builtin_amdgcn_rsqf(ss * (1.0f / 64.0f) + EPS);
      float gt[8]; unpack8(*(const GAS v4u*)(PROJ + (size_t)row * INW + COL_HG + head * 64 + v8), gt);
      const float* gn = a->in[I_HGAIN] + l * 64 + v8;
      float y[8];
#pragma unroll
      for (int j = 0; j < 8; ++j) y[j] = o[j] * rstd * gn[j] * silu1(gt[j]);
      v4u w; w.x = pk2(y[0], y[1]); w.y = pk2(y[2], y[3]); w.z = pk2(y[4], y[5]); w.w = pk2(y[6], y[7]);
      *(GAS v4u*)(MIX + (size_t)row * DM + MIX_HG + head * 64 + v8) = w; }
    __syncthreads();
}

__device__ __forceinline__ void vt_item(KA a, int item, int lane) {
    const bf16* PROJ = (const bf16*)(a->ws + WS_PROJ); bf16* VTg = (bf16*)(a->ws + WS_VT);
    const int rb = item >> 1, hk = item & 1, row = rb * 64 + lane;
    const bf16* p = PROJ + (size_t)row * INW + COL_AV + hk * 64;
    unsigned w[32];
#pragma unroll
    for (int c = 0; c < 8; ++c) { const v4u t = *(const GAS v4u*)(p + 8 * c); w[4 * c] = t.x; w[4 * c + 1] = t.y; w[4 * c + 2] = t.z; w[4 * c + 3] = t.w; }
    bf16* o = VTg + (size_t)hk * 64 * R_ALL + row;
#pragma unroll
    for (int d2 = 0; d2 < 32; ++d2) { o[(size_t)(2 * d2) * R_ALL] = (bf16)(w[d2] & 0xffffu); o[(size_t)(2 * d2 + 1) * R_ALL] = (bf16)(w[d2] >> 16); }
}
__device__ __forceinline__ void attn_unit(KA a, int l, int u, LAS unsigned char* lds, int tid, int lane, int wave) {
    asm volatile("" : "+v"(tid), "+v"(lane));
    const bf16* PROJ = (const bf16*)(a->ws + WS_PROJ); const bf16* VTg = (const bf16*)(a->ws + WS_VT); bf16* MIX = (bf16*)(a->ws + WS_MIX);
    const bool isctx = u >= 256; const int uu = isctx ? u - 256 : u; const int n = uu >> 1, hk = uu & 1;
    const int qh = hk * 4 + (wave >> 1), half = wave & 1;
    const int qbase = (isctx ? S_LAT : 0) + n * 128 + half * 64, qpos0 = n * 128 + half * 64;
    const int c = lane & 15, g = lane >> 4;
    LAS bf16* Kt = (LAS bf16*)lds; LAS bf16* Vt = Kt + 64 * HST; LAS bf16* Qw = Vt + 64 * HST + wave * 64 * HST;
#pragma unroll
    for (int j = 0; j < 8; ++j) { const int qr = 8 * j + (lane >> 3), qc = (lane & 7) * 8;
        *(LAS v4u*)(Qw + qr * HST + qc) = *(const GAS v4u*)(PROJ + (size_t)(qbase + qr) * INW + qh * 64 + qc); }
    float z0 = 0.f; asm volatile("" : "+v"(z0));
    f32x4 o[4][4]; float ls[4];
    float gq = 0.f, gk = 0.f;
#pragma unroll 8
    for (int d = 0; d < 64; ++d) { gq = fmaxf(gq, fabsf(a->in[I_QG][l * 64 + d])); gk = fmaxf(gk, fabsf(a->in[I_KG][l * 64 + d])); }
    const float nbnd = -(8.0f * 1.4426950408889634f) * gq * gk;
    const float sink = a->in[I_SINK][l * 8 + qh] * 1.4426950408889634f;
#pragma unroll
    for (int qt = 0; qt < 4; ++qt) { ls[qt] = (g == 0) ? __builtin_amdgcn_exp2f(sink + nbnd) : z0;
#pragma unroll
        for (int dt = 0; dt < 4; ++dt) o[qt][dt] = (f32x4){z0, z0, z0, z0}; }
    const int first = (!isctx && n == 0) ? 2 : 0, nwin = isctx ? 0 : ((n == 0 || n == 127) ? 4 : 6), nt = nwin + 4;
    const int lr = tid >> 3, lc = (tid & 7) * 8;
    v4u kreg, vreg;
#define ATT_LOADT(i) do { const bool ct_ = (i) >= nwin; const int kb_ = ct_ ? S_LAT + 64 * ((i) - nwin) : (n - 1) * 128 + 64 * (first + (i)); \
        kreg = *(const GAS v4u*)(PROJ + (size_t)(kb_ + lr) * INW + COL_AK + hk * 64 + lc); vreg = *(const GAS v4u*)(VTg + ((size_t)hk * 64 + lr) * R_ALL + kb_ + lc); } while (0)
    ATT_LOADT(0);
#pragma unroll 1
    for (int i = 0; i < nt; ++i) {
        __syncthreads();
        *(LAS v4u*)(Kt + lr * HST + lc) = kreg; *(LAS v4u*)(Vt + lr * HST + lc) = vreg;
        __syncthreads();
        if (i + 1 < nt) ATT_LOADT(i + 1);
        const bool win = i < nwin; const int kb = (n - 1) * 128 + 64 * (first + i);
        bf16x8v kf[4][2], vf[4][2];
#pragma unroll
        for (int kt = 0; kt < 4; ++kt)
#pragma unroll
            for (int ks = 0; ks < 2; ++ks) kf[kt][ks] = *(const LAS bf16x8v*)(Kt + (16 * kt + c) * HST + 32 * ks + 8 * g);
#pragma unroll
        for (int dt = 0; dt < 4; ++dt)
#pragma unroll
            for (int s2 = 0; s2 < 2; ++s2) { const v2u lo = *(const LAS v2u*)(Vt + (16 * dt + c) * HST + 32 * s2 + 4 * g), hi = *(const LAS v2u*)(Vt + (16 * dt + c) * HST + 32 * s2 + 16 + 4 * g);
                const v4u t = {lo.x, lo.y, hi.x, hi.y}; vf[dt][s2] = __builtin_bit_cast(bf16x8v, t); }
#pragma unroll
        for (int qt = 0; qt < 4; ++qt) {
            f32x4 s[4];
            const bf16x8v q0 = *(const LAS bf16x8v*)(Qw + (16 * qt + c) * HST + 8 * g), q1 = *(const LAS bf16x8v*)(Qw + (16 * qt + c) * HST + 32 + 8 * g);
#pragma unroll
            for (int kt = 0; kt < 4; ++kt) { s[kt] = (f32x4){nbnd, nbnd, nbnd, nbnd};
                s[kt] = __builtin_amdgcn_mfma_f32_16x16x32_bf16(kf[kt][0], q0, s[kt], 0, 0, 0); s[kt] = __builtin_amdgcn_mfma_f32_16x16x32_bf16(kf[kt][1], q1, s[kt], 0, 0, 0); }
            if (win) { const int dq = qpos0 + 16 * qt + c - kb - 4 * g;
#pragma unroll
                for (int kt = 0; kt < 4; ++kt)
#pragma unroll
                    for (int r = 0; r < 4; ++r) { const int dl = dq - 16 * kt - r; if (dl > 128 || dl < -128) s[kt][r] = -INFINITY; } }
            float ps = 0.f;
#pragma unroll
            for (int kt = 0; kt < 4; ++kt)
#pragma unroll
                for (int r = 0; r < 4; ++r) { s[kt][r] = __builtin_amdgcn_exp2f(s[kt][r]); ps += s[kt][r]; }
            ls[qt] += ps;
            bf16x8v pb[2];
#pragma unroll
            for (int s2 = 0; s2 < 2; ++s2) { const v4u t = {pk2(s[2 * s2][0], s[2 * s2][1]), pk2(s[2 * s2][2], s[2 * s2][3]), pk2(s[2 * s2 + 1][0], s[2 * s2 + 1][1]), pk2(s[2 * s2 + 1][2], s[2 * s2 + 1][3])};
                pb[s2] = __builtin_bit_cast(bf16x8v, t); }
#pragma unroll
            for (int dt = 0; dt < 4; ++dt) { o[qt][dt] = __builtin_amdgcn_mfma_f32_16x16x32_bf16(vf[dt][0], pb[0], o[qt][dt], 0, 0, 0); o[qt][dt] = __builtin_amdgcn_mfma_f32_16x16x32_bf16(vf[dt][1], pb[1], o[qt][dt], 0, 0, 0); }
        }
    }
#undef ATT_LOADT
    int c2 = lane & 15, g2 = lane >> 4; asm volatile("" : "+v"(c2), "+v"(g2));
#pragma unroll
    for (int qt = 0; qt < 4; ++qt) { float lt = ls[qt]; lt += sx<16>(lt); lt = sx32_add(lt); const float inv = 1.0f / lt;
        bf16* op = (bf16*)(a->ws + WS_MIX) + (size_t)(qbase + 16 * qt + c2) * DM + MIX_AT + qh * 64 + 4 * g2;
#pragma unroll
        for (int dt = 0; dt < 4; ++dt) { v2u w; w.x = pk2(o[qt][dt][0] * inv, o[qt][dt][1] * inv); w.y = pk2(o[qt][dt][2] * inv, o[qt][dt][3] * inv); *(GAS v2u*)(op + 16 * dt) = w; } }
}

constexpr int GST = 136;
__device__ __forceinline__ f32x4 mma16g(const LAS bf16* MA, const LAS bf16* MBt, int k0, f32x4 c, int lane) {
    const bf16x8v av = *(const LAS bf16x8v*)(MA + (lane & 15) * GST + k0 + 8 * (lane >> 4));
    const bf16x8v bv = *(const LAS bf16x8v*)(MBt + (lane & 15) * GST + k0 + 8 * (lane >> 4));
    return __builtin_amdgcn_mfma_f32_16x16x32_bf16(av, bv, c, 0, 0, 0);
}
__device__ __forceinline__ float gelu_as(float v) {
    const float av = fabsf(v), t = __builtin_amdgcn_rcpf(av * 0.2316418882f + 1.0f);
    float q = t * 0.5307027145f + (-0.7265760135f); q = q * t + 0.7107068705f; q = q * t + (-0.142248368f); q = q * t + 0.127414796f; q = q * t;
    const float e = __builtin_amdgcn_exp2f((v * v) * (-0.72134752044f)), mm = v * (q * e);
    return v < 0.f ? mm : v - mm;
}
__device__ __forceinline__ void gmlp_unit_mma(KA a, int l, int chunk, int g, LAS unsigned char* lds, int tid, int lane, int wave) {
    const bf16* PROJ = (const bf16*)(a->ws + WS_PROJ); bf16* MIX = (bf16*)(a->ws + WS_MIX);
    const int row0 = (chunk < 128) ? chunk * 128 : S_LAT + (chunk - 128) * 128;
    LAS bf16* WA = (LAS bf16*)lds;
    LAS bf16* VNT = WA + 128 * GST;
    LAS float* OUT = (LAS float*)(VNT + 64 * GST);
    const int pos = tid >> 2, part = tid & 3;
    {
      const float* W = a->in[I_GWS] + ((size_t)(l * 4 + g) * 128 + pos) * 128 + part * 32;
#pragma unroll
      for (int j = 0; j < 4; ++j) { const f32x4 w0 = *(const GAS f32x4*)(W + 8 * j), w1 = *(const GAS f32x4*)(W + 8 * j + 4);
          v4u o; o.x = pk2(w0.x, w0.y); o.y = pk2(w0.z, w0.w); o.z = pk2(w1.x, w1.y); o.w = pk2(w1.z, w1.w);
          *(LAS v4u*)(WA + pos * GST + part * 32 + 8 * j) = o; } }
    { const bf16* p = PROJ + (size_t)(row0 + pos) * INW + COL_GV + g * 64 + part * 16;
      float x[16]; unpack8(*(const GAS v4u*)p, x); unpack8(*(const GAS v4u*)(p + 8), x + 8);
      float ss = 0.f;
#pragma unroll
      for (int d = 0; d < 16; ++d) { x[d] = gelu_as(x[d]); ss += x[d] * x[d]; }
      ss += sx<1>(ss); ss += sx<2>(ss);
      const float rstd = __builtin_amdgcn_rsqf(ss * (1.0f / 64.0f) + EPS);
      const float* gn = a->in[I_GNG] + l * 256 + g * 64 + part * 16;
#pragma unroll
      for (int d = 0; d < 16; ++d) VNT[(part * 16 + d) * GST + pos] = (bf16)f2bf(x[d] * rstd * gn[d]); }
    __syncthreads();
    float z0 = 0.f; asm volatile("" : "+v"(z0));
#pragma unroll
    for (int cb = 0; cb < 4; ++cb) { f32x4 acc = {z0, z0, z0, z0};
#pragma unroll
        for (int ks = 0; ks < 4; ++ks) acc = mma16g(WA + 16 * wave * GST, VNT + 16 * cb * GST, 32 * ks, acc, lane);
#pragma unroll
        for (int r = 0; r < 4; ++r) OUT[(16 * wave + 4 * (lane >> 4) + r) * 68 + 16 * cb + (lane & 15)] = acc[r]; }
    __syncthreads();
    { const int row = row0 + pos; const float bsv = a->in[I_GBS][(l * 4 + g) * 128 + pos];
      const bf16* pu = PROJ + (size_t)row * INW + COL_GU + g * 64 + part * 16;
      float u[16]; unpack8(*(const GAS v4u*)pu, u); unpack8(*(const GAS v4u*)(pu + 8), u + 8);
      float y[16];
#pragma unroll
      for (int d = 0; d < 16; ++d) y[d] = gelu_as(u[d]) * (OUT[pos * 68 + part * 16 + d] + bsv);
      bf16* po = MIX + (size_t)row * DM + MIX_GM + g * 64 + part * 16;
      v4u w; w.x = pk2(y[0], y[1]); w.y = pk2(y[2], y[3]); w.z = pk2(y[4], y[5]); w.w = pk2(y[6], y[7]); *(GAS v4u*)po = w;
      w.x = pk2(y[8], y[9]); w.y = pk2(y[10], y[11]); w.z = pk2(y[12], y[13]); w.w = pk2(y[14], y[15]); *(GAS v4u*)(po + 8) = w; }
    __syncthreads();
}
__device__ __forceinline__ void attn_naive(KA a, int l, int nrows, int lane, int wave, int G, int bid) {
    const bf16* PROJ = (const bf16*)(a->ws + WS_PROJ); bf16* MIX = (bf16*)(a->ws + WS_MIX);
    const int gw = bid * NWAVES + wave, NGW = G * NWAVES;
    for (int pair = gw; pair < nrows * 2; pair += NGW) {
        const int row = pair >> 1, hk = pair & 1; const bool isctx = row >= S_LAT;
        float q[4], o[4], m[4], ls[4];
#pragma unroll
        for (int g = 0; g < 4; ++g) { q[g] = bflo((unsigned)PROJ[(size_t)row * INW + (hk * 4 + g) * 64 + lane]); o[g] = 0.f; ls[g] = 1.0f; m[g] = a->in[I_SINK][l * 8 + hk * 4 + g] * 1.4426950408889634f; }
        int j0 = 0, j1 = -1;
        if (!isctx) { j0 = row - 128 < 0 ? 0 : row - 128; j1 = row + 128 > S_LAT - 1 ? S_LAT - 1 : row + 128; }
        const int nwin = j1 - j0 + 1;
        const int nk = nwin + C_CTX;
#pragma unroll 4
        for (int t = 0; t < nk; ++t) {
            const int krow = (t < nwin) ? j0 + t : S_LAT + (t - nwin);
            const float k = bflo((unsigned)PROJ[(size_t)krow * INW + COL_AK + hk * 64 + lane]);
            const float v = bflo((unsigned)PROJ[(size_t)krow * INW + COL_AV + hk * 64 + lane]);
#pragma unroll
            for (int g = 0; g < 4; ++g) { const float s = wave_sum(q[g] * k); const float mn = fmaxf(m[g], s);
                const float c = __builtin_amdgcn_exp2f(m[g] - mn), p = __builtin_amdgcn_exp2f(s - mn);
                ls[g] = ls[g] * c + p; o[g] = o[g] * c + p * v; m[g] = mn; }
        }
#pragma unroll
        for (int g = 0; g < 4; ++g) MIX[(size_t)row * DM + MIX_AT + (hk * 4 + g) * 64 + lane] = (bf16)f2bf(o[g] / ls[g]);
    }
}
__device__ __forceinline__ void hgrn_combine(KA a, int l, int nrows, int lane, int wave, int G, int bid) {
    const bf16* PROJ = (const bf16*)(a->ws + WS_PROJ); bf16* MIX = (bf16*)(a->ws + WS_MIX);
    const float* O0 = (const float*)(a->ws + WS_HGO); const float* O1 = O0 + (size_t)R_ALL * 256;
    const f32x4 gn = *(const f32x4*)(a->in[I_HGAIN] + l * 64 + (lane & 15) * 4);
    const int gw = bid * NWAVES + wave, NGW = G * NWAVES;
    for (int r = gw; r < nrows; r += NGW) {
        const f32x4 o = *(const GAS f32x4*)(O0 + (size_t)r * 256 + 4 * lane) + *(const GAS f32x4*)(O1 + (size_t)r * 256 + 4 * lane);
        float ss = (o.x * o.x + o.y * o.y) + (o.z * o.z + o.w * o.w);
        ss += sx<1>(ss); ss += sx<2>(ss); ss += sx<4>(ss); ss += sx<8>(ss);
        const float rstd = __builtin_amdgcn_rsqf(ss * (1.0f / 64.0f) + EPS);
        const v2u gw2 = *(const GAS v2u*)(PROJ + (size_t)r * INW + COL_HG + 4 * lane);
        const float g0 = bflo(gw2.x), g1 = bfhi(gw2.x), g2 = bflo(gw2.y), g3 = bfhi(gw2.y);
        v2u w; w.x = pk2(o.x * rstd * gn.x * silu1(g0), o.y * rstd * gn.y * silu1(g1)); w.y = pk2(o.z * rstd * gn.z * silu1(g2), o.w * rstd * gn.w * silu1(g3));
        *(GAS v2u*)(MIX + (size_t)r * DM + MIX_HG + 4 * lane) = w;
    }
}
__device__ __forceinline__ void moe_gather(KA a, LAS unsigned char* lds, int tid, int lane, int wave, int G, int bid) {
    LAS int* sb = (LAS int*)lds;
    const unsigned* cnt = (const unsigned*)(a->ws + WS_CTL) + CW_MOECNT;
    int* mi = (int*)(a->ws + WS_VEC) + VO_MOE;
    if (tid == 0) { int b = 0;
        for (int e = 0; e < 8; ++e) { const int c = (int)__hip_atomic_load(cnt + 64 * e, RLX_AGENT); sb[e] = b; sb[16 + e] = c;
            const int nt = (c + 255) >> 8;
            if (bid == 0) for (int t = 0; t < nt; ++t) mi[16 + (b >> 8) + t] = e;
            b += nt << 8; }
        sb[8] = b; if (bid == 0) mi[0] = b >> 8; }
    __syncthreads();
    const unsigned char* H8 = (const unsigned char*)(a->ws + WS_H2B); unsigned char* AS = (unsigned char*)(a->ws + WS_AS);
    const int* tokinfo = (const int*)(a->ws + WS_TOK); int* tokslot = (int*)(a->ws + WS_TOK) + S_LAT * 8;
    const int gw = bid * NWAVES + wave, NGW = G * NWAVES;
    for (int t = gw; t < S_LAT; t += NGW) {
        const int* ti = tokinfo + (size_t)t * 8;
        const int e1 = ti[0], e2 = ti[1], r1 = ti[2], r2 = ti[3];
        const int s1 = sb[e1] + r1, s2 = sb[e2] + r2;
        const v4u x0 = ((const GAS v4u*)(H8 + (size_t)t * DM))[lane];
        ((GAS v4u*)(AS + (size_t)s1 * DM))[lane] = x0; ((GAS v4u*)(AS + (size_t)s2 * DM))[lane] = x0;
        if (lane == 0) { int* ts = tokslot + (size_t)t * 4; ts[0] = s1; ts[1] = s2; ts[2] = ti[4]; ts[3] = ti[5]; }
    }
    { const f32x4 z4 = {0.f, 0.f, 0.f, 0.f}; for (int i = bid * NTHR + tid; i < 8 * 256 * DM / 4; i += G * NTHR) ((GAS f32x4*)(a->ws + WS_YF))[i] = z4; }
    for (int e = 0; e < 8; ++e) { const int c = sb[16 + e], pe = (c + 255) & ~255, b = sb[e];
        for (int j = c + gw; j < pe; j += NGW) { const v4u z = {0u, 0u, 0u, 0u}; ((GAS v4u*)(AS + (size_t)(b + j) * DM))[lane] = z; } }
}
__device__ __forceinline__ void moe_combine(KA a, int lane, int wave, int G, int bid) {
    const float* gf = (const float*)(a->ws + WS_VEC) + VO_MOD + (1 * 2 + 0) * 6144 + 5 * 1024;
    const bf16* Y = (const bf16*)(a->ws + WS_Y); const int* tokslot = (const int*)(a->ws + WS_TOK) + S_LAT * 8;
    const int gw = bid * NWAVES + wave, NGW = G * NWAVES;
    for (int t = gw; t < S_LAT; t += NGW) {
        const int* ts = tokslot + (size_t)t * 4; const int s1 = ts[0], s2 = ts[1]; const float w1 = __builtin_bit_cast(float, ts[2]), w2 = __builtin_bit_cast(float, ts[3]);
        GAS f32x4* xr = (GAS f32x4*)(a->out + (size_t)t * DM) + lane;
        const float* YF = (const float*)(a->ws + WS_YF);
#pragma unroll
        for (int j = 0; j < 4; ++j) { const f32x4 g = *(const f32x4*)(gf + 4 * lane + 256 * j); f32x4 x = xr[64 * j]; f32x4 p, q;
            if (s1 < 32768) { const v2u t = ((const GAS v2u*)(Y + (size_t)s1 * DM) + lane)[64 * j]; p = (f32x4){bflo(t.x), bfhi(t.x), bflo(t.y), bfhi(t.y)}; } else p = ((const GAS f32x4*)(YF + (size_t)(s1 - 32768) * DM) + lane)[64 * j];
            if (s2 < 32768) { const v2u t = ((const GAS v2u*)(Y + (size_t)s2 * DM) + lane)[64 * j]; q = (f32x4){bflo(t.x), bfhi(t.x), bflo(t.y), bfhi(t.y)}; } else q = ((const GAS f32x4*)(YF + (size_t)(s2 - 32768) * DM) + lane)[64 * j];
            x = x + g * (p * w1 + q * w2);
            xr[64 * j] = x; }
    }
}

#define IN(k) (lo <= (k) && (k) < hi)
#define GRIDBAR() do { XcdBarrier b2_; b2_.bar = (unsigned*)(KARGS()->ws + WS_CTL) + CW_BAR; b2_.x = xb_xcc_id(); b2_.st = (volatile LAS unsigned*)(lds + MISC_OFF) + 8; xcd_barrier(b2_, wv0 * 64 + (int)__builtin_amdgcn_mbcnt_hi(~0u, __builtin_amdgcn_mbcnt_lo(~0u, 0u))); } while (0)
#define SEAM(k) do { if (IN(k) && IN((k) + 1)) GRIDBAR(); } while (0)
#define PHASE_ROOTS() KA a = KARGS(); unsigned char* ws = a->ws; const float* vec = (const float*)(ws + WS_VEC); (void)vec; int bid = blockIdx.x, G = gridDim.x; asm volatile("" : "+s"(bid), "+s"(G)); int tid = wv0 * 64 + (int)__builtin_amdgcn_mbcnt_hi(~0u, __builtin_amdgcn_mbcnt_lo(~0u, 0u)); asm volatile("" : "+v"(tid)); const int lane = tid & 63, wave = __builtin_amdgcn_readfirstlane(tid >> 6); (void)lane; (void)wave

template <int l> __device__ __forceinline__ void layer_body(const int lo, const int hi, LAS unsigned char* lds, const int wv0) {
        const int pb = 1 + 11 * l;
        if (IN(pb + 0)) { PHASE_ROOTS(); phase_norm(a, l, 0, R_ALL, (bf16*)(ws + WS_H), lane, wave, G, bid); SEAM(pb + 0); }
        if (IN(pb + 1)) {
            PHASE_ROOTS();
            pg8::Gemm g{(const pg8::bf16_t*)(ws + WS_H), (const pg8::bf16_t*)(ws + WS_WIN) + (size_t)l * INW * DM, R_ALL, INW, DM, 0, DM};
            pg8::StaticOrder S; S.init(R_ALL, INW, G, bid);
            pg8::EpiBf16<0> E{(pg8::bf16_t*)(ws + WS_PROJ), INW, nullptr, 0, 0, 1.f};
            pg8::gemm_phase<pg8::EpiBf16<0>, pg8::StaticOrder, true, true>(lds, g, S, E, tid);
            moe_conv_slice(a, l == 0 ? 0 : 2, 650 - 2 * 256, lds, lane, wave, G, bid);
            SEAM(pb + 1);
        }
        if (IN(pb + 2)) {
            PHASE_ROOTS();
            qk_prep(a, l, bid * NTHR + tid, G * NTHR);
            for (int it = bid * NWAVES + wave; it < 520; it += G * NWAVES) vt_item(a, it, lane);
            for (int it = bid; it < 1040; it += G) hgrn_stepA(a, l, it >> 2, it & 3, lds, lane, wave);
            SEAM(pb + 2);
        }
        if (IN(pb + 3)) {
            PHASE_ROOTS();
            if (bid < 64) hgrn_stepB(a, bid, tid);
            {
                const int nu = (l == 0) ? 260 : 256, ng = (l == 0) ? 520 : 512;
                unsigned* qctr = (unsigned*)(ws + WS_CTL) + CW_QUEUE + 64 * l;
                volatile LAS unsigned* qslot = (volatile LAS unsigned*)(lds + MISC_OFF) + 16;
                for (;;) {
                    __syncthreads();
                    if (tid == 0) qslot[0] = __hip_atomic_fetch_add(qctr, 1u, RLX_AGENT);
                    __syncthreads();
                    const int it = __builtin_amdgcn_readfirstlane((int)qslot[0]);
                    if (it >= nu + ng) break;
                    if (it < nu) attn_unit(a, l, it, lds, tid, lane, wave);
                    else gmlp_unit_mma(a, l, (it - nu) >> 2, (it - nu) & 3, lds, tid, lane, wave);
                }
            }
            SEAM(pb + 3);
        }
        if (IN(pb + 4)) {
            PHASE_ROOTS();
            const int nit = (l == 0) ? 1040 : 1024;
            for (int it = bid; it < nit; it += G) hgrn_stepC(a, l, it >> 2, it & 3, lds, tid, lane, wave);
            SEAM(pb + 4);
        }
        if (IN(pb + 5)) {
            PHASE_ROOTS();
            const float* modl = vec + VO_MOD + (l * 2 + 0) * 6144; const float* modc = vec + VO_MOD + (l * 2 + 1) * 6144;
            const int M = S_LAT;
            pg8::Gemm g{(const pg8::bf16_t*)(ws + WS_MIX), (const pg8::bf16_t*)(ws + WS_WOUT) + (size_t)l * DM * DM, M, DM, DM, 0, DM};
            pg8::StaticOrder S; S.init(M, DM, G, bid);
            pg8::EpiResid E{(l == 0) ? a->in[I_X] : a->out, a->out, modl + 2048, a->in[I_CTX], (float*)(ws + WS_CTXR), modc + 2048, S_LAT / 256, DM};
            pg8::gemm_phase<pg8::EpiResid, pg8::StaticOrder, true, true>(lds, g, S, E, tid);
            if (l == 0) {
                pg8::Gemm g2{(const pg8::bf16_t*)(ws + WS_MIX), (const pg8::bf16_t*)(ws + WS_WOUT), R_ALL, DM, 256, 0, DM};
                pg8::SplitKOrder S2{S_LAT / 256, 4, 4, 256, 16, bid, nullptr};
                pg8::EpiAtomic E2{(float*)(ws + WS_CTXR), modc + 2048, S_LAT / 256, DM, 1.0f};
                pg8::gemm_phase<pg8::EpiAtomic, pg8::SplitKOrder, false, true>(lds, g2, S2, E2, tid);
            }
            SEAM(pb + 5);
        }
        if (l == 0) {
            if (IN(pb + 6)) { PHASE_ROOTS(); phase_norm(a, l, 1, R_ALL, (bf16*)(ws + WS_H), lane, wave, G, bid); SEAM(pb + 6); }
            if (IN(pb + 7)) {
                PHASE_ROOTS();
                pg8::Gemm g{(const pg8::bf16_t*)(ws + WS_H), (const pg8::bf16_t*)(ws + WS_WGU), R_ALL, 2 * FFN, DM, 0, DM};
                pg8::StaticOrder S; S.init(R_ALL, 2 * FFN, G, bid);
                pg8::EpiSwiGLU E{(pg8::bf16_t*)(ws + WS_HID), FFN, 1.0f};
                pg8::gemm_phase<pg8::EpiSwiGLU, pg8::StaticOrder, true, true>(lds, g, S, E, tid);
                moe_conv_slice(a, 1, 1430 - 5 * 256, lds, lane, wave, G, bid);
                SEAM(pb + 7);
            }
            if (IN(pb + 8)) {
                PHASE_ROOTS();
                const float* modl = vec + VO_MOD + (l * 2 + 0) * 6144; const float* modc = vec + VO_MOD + (l * 2 + 1) * 6144;
                pg8::Gemm g{(const pg8::bf16_t*)(ws + WS_HID), (const pg8::bf16_t*)(ws + WS_WD), S_LAT, DM, FFN, 0, FFN};
                pg8::StaticOrder S; S.init(S_LAT, DM, G, bid);
                pg8::EpiResid E{a->out, a->out, modl + 5120, (const float*)(ws + WS_CTXR), (float*)(ws + WS_CTXR), modc + 5120, S_LAT / 256, DM};
                pg8::gemm_phase<pg8::EpiResid, pg8::StaticOrder, true, true>(lds, g, S, E, tid);
                {
                    pg8::Gemm g2{(const pg8::bf16_t*)(ws + WS_HID), (const pg8::bf16_t*)(ws + WS_WD), R_ALL, DM, 256, 0, FFN};
                    pg8::SplitKOrder S2{S_LAT / 256, 4, 11, 256, 44, bid, nullptr};
                    pg8::EpiAtomic E2{(float*)(ws + WS_CTXR), modc + 5120, S_LAT / 256, DM, 1.0f};
                    pg8::gemm_phase<pg8::EpiAtomic, pg8::SplitKOrder, false, true>(lds, g2, S2, E2, tid);
                }
                if (IN(pb + 8) && IN(pb + 11)) GRIDBAR();
            }
        } else {
            if (IN(pb + 6)) { PHASE_ROOTS(); phase_norm_route(a, lds, tid, lane, wave, G, bid); SEAM(pb + 6); }
            if (IN(pb + 7)) { PHASE_ROOTS(); moe_gather(a, lds, tid, lane, wave, G, bid); SEAM(pb + 7); }
            if (IN(pb + 8)) {
                PHASE_ROOTS();
                const int* mi = (const int*)(ws + WS_VEC) + VO_MOE; const int nt = __builtin_amdgcn_readfirstlane(mi[0]);
                pg8::Gemm g{(const pg8::bf16_t*)(ws + WS_AS), (const pg8::bf16_t*)(ws + WS_MGU), nt * 256, 2 * EXD, DM / 2, (size_t)2 * EXD * DM, DM / 2};
                pg8::MoeOrder S; S.init(nt * 256, 2 * EXD, G, bid); S.tile_e = mi + 16;
                pg8::EpiSwiGLU8 E{(unsigned char*)(ws + WS_HIDM), EXD, 1.0f / (F8_WSCALE * F8_ASCALE), F8_HSCALE};
                pg8::gemm_phase<pg8::EpiSwiGLU8, pg8::MoeOrder, true, true, true>(lds, g, S, E, tid);
                SEAM(pb + 8);
            }
            if (IN(pb + 9)) {
                PHASE_ROOTS();
                const int* mi = (const int*)(ws + WS_VEC) + VO_MOE; const int nt = __builtin_amdgcn_readfirstlane(mi[0]); const int nm = nt < 128 ? nt : 128;
                pg8::Gemm g{(const pg8::bf16_t*)(ws + WS_HIDM), (const pg8::bf16_t*)(ws + WS_MD), nm * 256, DM, EXD / 2, (size_t)DM * EXD, EXD / 2};
                pg8::MoeOrder S; S.init(nm * 256, DM, G, bid); S.tile_e = mi + 16;
                pg8::EpiScaleBf16 E{(pg8::bf16_t*)(ws + WS_Y), DM, 1.0f / (F8_WSCALE * F8_HSCALE)};
                pg8::gemm_phase<pg8::EpiScaleBf16, pg8::MoeOrder, true, true, true>(lds, g, S, E, tid);
                if (nt > 128) {
                    pg8::Gemm g2{(const pg8::bf16_t*)(ws + WS_HIDM), (const pg8::bf16_t*)(ws + WS_MD), nt * 256, DM, 256, (size_t)DM * EXD, EXD / 2};
                    pg8::SplitKOrder S2{128, 4, 7, 256, (nt - 128) * 28, bid, mi + 16};
                    pg8::EpiAtomic E2{(float*)(ws + WS_YF), nullptr, 128, DM, 1.0f / (F8_WSCALE * F8_HSCALE)};
                    pg8::gemm_phase<pg8::EpiAtomic, pg8::SplitKOrder, false, true, true>(lds, g2, S2, E2, tid);
                }
                SEAM(pb + 9);
            }
            if (IN(pb + 10)) { PHASE_ROOTS(); moe_combine(a, lane, wave, G, bid); }
        }
    }
__global__ void __launch_bounds__(NTHR, 2) fwd_kernel(Args a_unused) {
    extern __shared__ __attribute__((aligned(16))) unsigned char lds_raw[];
    LAS unsigned char* lds = (LAS unsigned char*)lds_raw;
    const int tid0 = threadIdx.x;
    const int wv0 = __builtin_amdgcn_readfirstlane(tid0 >> 6);
    for (int u = tid0; u < (LDS_BYTES - LDSCTL_OFF) / 4; u += NTHR) ((LAS unsigned*)(lds + LDSCTL_OFF))[u] = 0u;
    __syncthreads();
    const int lo = KARGS()->ph_lo, hi = KARGS()->ph_hi;
    const bool fusedl = (hi - lo) > 1;
    if (fusedl) (void)xcd_barrier_post((unsigned*)(KARGS()->ws + WS_CTL) + CW_BAR, (volatile LAS unsigned*)(lds + MISC_OFF) + 8);
    if (IN(0)) { PHASE_ROOTS(); p0_prologue(a, lds, tid, lane, wave, G, bid); SEAM(0); }

    layer_body<0>(lo, hi, lds, wv0);
    layer_body<1>(lo, hi, lds, wv0);
}

extern "C" void kernel_launch(void* const* d_in, const int* in_sizes, int n_in, void* d_out, int out_size, void* d_ws, size_t ws_size, hipStream_t stream) {
    static int grid = 0;
    if (grid == 0) {
        if (n_in != 23 || in_sizes[0] != S_LAT * DM || out_size != S_LAT * DM || ws_size < WS_END) { fprintf(stderr, "kernel_launch: unexpected shapes / workspace (n_in %d, ws %zu, need %zu)\n", n_in, ws_size, (size_t)WS_END); grid = -1; return; }
        int dev = 0, cus = 0;
        if (hipGetDevice(&dev) != hipSuccess || hipDeviceGetAttribute(&cus, hipDeviceAttributeMultiprocessorCount, dev) != hipSuccess) { grid = -1; return; }
        if (hipFuncSetAttribute((const void*)fwd_kernel, hipFuncAttributeMaxDynamicSharedMemorySize, LDS_BYTES) != hipSuccess) { grid = -1; return; }
        int per_cu = 0;
        (void)hipOccupancyMaxActiveBlocksPerMultiprocessor(&per_cu, (const void*)fwd_kernel, NTHR, LDS_BYTES);
        (void)hipGetLastError();
        grid = cus;
    }
    if (grid < 0) return;
    if (hipMemsetAsync((char*)d_ws + WS_CTL, 0, CTL_ZERO_BYTES, stream) != hipSuccess) return;
    Args a{};
    for (int i = 0; i < 23; ++i) a.in[i] = (const float*)d_in[i];
    a.out = (float*)d_out; a.ws = (unsigned char*)d_ws;
#if ONE_LAUNCH
    a.ph_lo = 0; a.ph_hi = NPH;
    hipLaunchKernelGGL(fwd_kernel, dim3(grid), dim3(NTHR), LDS_BYTES, stream, a);
#else
    for (int p = 0; p < NPH; ++p) {
        if (p == 10 || p == 11) continue;
        a.ph_lo = p; a.ph_hi = p + 1;
        hipLaunchKernelGGL(fwd_kernel, dim3(grid), dim3(NTHR), LDS_BYTES, stream, a);
    }
#endif
}
```

```cpp
#include <hip/hip_runtime.h>
#include <cstdio>
#include <cstdint>
#include <cmath>
#ifndef ONE_LAUNCH
#define ONE_LAUNCH 1
#endif
namespace pg8 {
#define PG8_LAS __attribute__((address_space(3)))
typedef unsigned short bf16_t;
typedef short bf16x8 __attribute__((ext_vector_type(8)));
typedef float f32x4 __attribute__((ext_vector_type(4)));
typedef unsigned u32x4 __attribute__((ext_vector_type(4)));
constexpr int BM = 256, BK = 64, HALF = 128, HTB = HALF * BK * 2  , STAGE_BYTES = 8 * HTB, NXCD = 8, WGM = 8;

__host__ __device__ __forceinline__ int lds_byte(int r, int c) { const int st = (r >> 4) * 2 + (c >> 5), rr = r & 15, cc = c & 31, ob = rr * 64 + cc * 2; return st * 1024 + (ob ^ (((ob >> 9) & 1) << 5)); }
__host__ __device__ __forceinline__ void stage_rc(int b, int& R, int& C) { const int st = b / 1024, sb = b % 1024, swz = sb ^ (((sb >> 9) & 1) << 5); R = (st >> 1) * 16 + swz / 64; C = (st & 1) * 32 + (swz % 64) / 2; }
__host__ __device__ __forceinline__ int perm32(int rho) { const int n = rho >> 4, i = rho & 15; return 8 * (i >> 2) + 4 * n + (i & 3); }

struct Unit { int pm, pn, eb, ko; };
struct Gemm { const bf16_t* A; const bf16_t* Bt; int M, N, K; size_t bstride; int ld; };

struct StaticOrder {
    int nM, nN, nwg, G, c;
    __host__ __device__ void init(int M, int N, int G_, int c_) { nM = M / BM; nN = N / BM; nwg = nM * nN; G = G_; c = c_; }
    __host__ __device__ bool next(int i, Unit& u) const {
        const long L = (long)i * G + c; if (L >= nwg) return false;
        int wgid = (int)L; { const int q = nwg / NXCD, r = nwg % NXCD, xcd = wgid % NXCD, off = wgid / NXCD; wgid = (xcd < r ? xcd * (q + 1) : r * (q + 1) + (xcd - r) * q) + off; }
        const int nig = WGM * nN, gid = wgid / nig, fm = gid * WGM, gsz = (nM - fm) < WGM ? (nM - fm) : WGM;
        u.pm = fm + ((wgid % nig) % gsz); u.pn = (wgid % nig) / gsz; u.eb = 0; u.ko = 0; return true;
    }
    __device__ __forceinline__ void a_ready(const Unit&) const {}
    __device__ __forceinline__ void done(const Unit&) const {}
};

__device__ __forceinline__ unsigned cvt_pk_bf16(float lo, float hi) { unsigned r; asm volatile("v_cvt_pk_bf16_f32 %0, %1, %2" : "=v"(r) : "v"(lo), "v"(hi)); return r; }
typedef float f32x2 __attribute__((ext_vector_type(2)));
__device__ __forceinline__ f32x2 gelu_pk(f32x2 v) {
    const f32x2 av = __builtin_elementwise_abs(v), d = av * 0.2316418882f + 1.0f;
    f32x2 t; t.x = __builtin_amdgcn_rcpf(d.x); t.y = __builtin_amdgcn_rcpf(d.y);
    f32x2 q = t * 0.5307027145f + (-0.7265760135f); q = q * t + 0.7107068705f; q = q * t + (-0.142248368f); q = q * t + 0.127414796f; q = q * t;
    const f32x2 s = (v * v) * (-0.72134752044f);
    f32x2 e; e.x = __builtin_amdgcn_exp2f(s.x); e.y = __builtin_amdgcn_exp2f(s.y);
    const f32x2 m = v * (q * e), r = v - m;
    f32x2 o; o.x = v.x < 0.f ? m.x : r.x; o.y = v.y < 0.f ? m.y : r.y; return o;
}

template <int ACT  > struct EpiBf16 {
    static constexpr bool PERM = true, AFTER_DRAIN = false; static_assert(ACT == 0 || ACT == 1, "EpiBf16: ACT is 0 (none) or 1 (gelu_pk)");
    bf16_t* O; int ldc; const float* bias; int split_cols; size_t split_stride; float scale0;
    __device__ __forceinline__ void operator()(const f32x4 (&acc)[2][2][4][2], const Unit& u, int wr, int wc, int fr, int fq) const {
        const int row0 = u.pm * BM + wr * 64 + fr; int colt = u.pn * BM; bf16_t* base = O;
        float sc = 1.f; if (split_cols) { const int t = colt / split_cols; base += (size_t)t * split_stride; colt -= t * split_cols; if (t == 0) sc = scale0; }
        const int col0 = colt + wc * 32 + 8 * fq, bcol0 = u.pn * BM + wc * 32 + 8 * fq;
        f32x4 bv[2][2];
#pragma unroll
        for (int bj = 0; bj < 2; ++bj)
#pragma unroll
            for (int n = 0; n < 2; ++n) bv[bj][n] = bias ? *(const f32x4*)(bias + bcol0 + bj * HALF + 4 * n) : (f32x4){0.f, 0.f, 0.f, 0.f};
#pragma unroll
        for (int ai = 0; ai < 2; ++ai)
#pragma unroll
            for (int m = 0; m < 4; ++m) { bf16_t* rowp = base + (size_t)(row0 + ai * HALF + m * 16) * ldc + col0;
#pragma unroll
                for (int bj = 0; bj < 2; ++bj) { f32x4 v0 = acc[ai][bj][m][0] + bv[bj][0], v1 = acc[ai][bj][m][1] + bv[bj][1];
                    if (ACT == 1) { f32x2 a = gelu_pk((f32x2){v0[0], v0[1]}), b = gelu_pk((f32x2){v0[2], v0[3]}), c = gelu_pk((f32x2){v1[0], v1[1]}), d = gelu_pk((f32x2){v1[2], v1[3]});
                        v0 = (f32x4){a.x, a.y, b.x, b.y}; v1 = (f32x4){c.x, c.y, d.x, d.y}; }
                    v0 = v0 * sc; v1 = v1 * sc; u32x4 w; w.x = cvt_pk_bf16(v0[0], v0[1]); w.y = cvt_pk_bf16(v0[2], v0[3]); w.z = cvt_pk_bf16(v1[0], v1[1]); w.w = cvt_pk_bf16(v1[2], v1[3]);
                    *(u32x4*)(rowp + bj * HALF) = w; } }
    }
};

__device__ __forceinline__ float silu_f(float x) { return x * __builtin_amdgcn_rcpf(1.0f + __builtin_amdgcn_exp2f(-1.4426950408889634f * x)); }
struct EpiResid {
    static constexpr bool PERM = false, AFTER_DRAIN = false;
    const float* base; float* out; const float* gate; const float* cbase; float* cout; const float* cgate; int mlat; int ldc;
    __device__ __forceinline__ void operator()(const f32x4 (&acc)[2][2][4][2], const Unit& u, int wr, int wc, int fr, int fq) const {
        const bool isc = u.pm >= mlat;
        const float* b = isc ? cbase : base; float* o = isc ? cout : out; const float* g = isc ? cgate : gate;
        const int row0 = (isc ? (u.pm - mlat) : u.pm) * BM + wr * 64 + fr, col0 = u.pn * BM + wc * 32 + 4 * fq;
        f32x4 gv[2][2];
#pragma unroll
        for (int bj = 0; bj < 2; ++bj)
#pragma unroll
            for (int n = 0; n < 2; ++n) gv[bj][n] = *(const f32x4*)(g + col0 + bj * HALF + n * 16);
#pragma unroll
        for (int ai = 0; ai < 2; ++ai)
#pragma unroll
            for (int m = 0; m < 4; ++m) { const size_t off = (size_t)(row0 + ai * HALF + m * 16) * ldc + col0;
#pragma unroll
                for (int bj = 0; bj < 2; ++bj)
#pragma unroll
                    for (int n = 0; n < 2; ++n) { const f32x4 bs = *(const f32x4*)(b + off + bj * HALF + n * 16); *(f32x4*)(o + off + bj * HALF + n * 16) = bs + gv[bj][n] * acc[ai][bj][m][n]; }
                if (m & 1) asm volatile("" ::: "memory"); }
    }
};
struct EpiSwiGLU {
    static constexpr bool PERM = true, AFTER_DRAIN = false;
    bf16_t* O; int ldc; float ds;
    __device__ __forceinline__ void operator()(const f32x4 (&acc)[2][2][4][2], const Unit& u, int wr, int wc, int fr, int fq) const {
        const int row0 = u.pm * BM + wr * 64 + fr, col0 = u.pn * HALF + wc * 32 + 8 * fq;
#pragma unroll
        for (int ai = 0; ai < 2; ++ai)
#pragma unroll
            for (int m = 0; m < 4; ++m) { bf16_t* rowp = O + (size_t)(row0 + ai * HALF + m * 16) * ldc + col0;
                const f32x4 g0 = acc[ai][0][m][0] * ds, g1 = acc[ai][0][m][1] * ds, u0 = acc[ai][1][m][0] * ds, u1 = acc[ai][1][m][1] * ds;
                f32x4 h0, h1;
#pragma unroll
                for (int j = 0; j < 4; ++j) { h0[j] = silu_f(g0[j]) * u0[j]; h1[j] = silu_f(g1[j]) * u1[j]; }
                u32x4 w; w.x = cvt_pk_bf16(h0[0], h0[1]); w.y = cvt_pk_bf16(h0[2], h0[3]); w.z = cvt_pk_bf16(h1[0], h1[1]); w.w = cvt_pk_bf16(h1[2], h1[3]);
                *(u32x4*)rowp = w; }
    }
};
struct MoeOrder : StaticOrder {
    const int* tile_e;
    __device__ __forceinline__ bool next(int i, Unit& u) const { if (!StaticOrder::next(i, u)) return false; u.eb = __builtin_amdgcn_readfirstlane(tile_e[u.pm]); return true; }
};

struct SplitKOrder {
    int pm0, nN, P, kp, total, c; const int* tile_e;
    __device__ __forceinline__ bool next(int i, Unit& u) const {
        if (i != 0 || c >= total) return false;
        const int p = c % P, t = c / P; u.pn = t % nN; u.pm = pm0 + t / nN; u.ko = p * kp; u.eb = tile_e ? __builtin_amdgcn_readfirstlane(tile_e[u.pm]) : 0; return true; }
    __device__ __forceinline__ void a_ready(const Unit&) const {}
    __device__ __forceinline__ void done(const Unit&) const {}
};
struct EpiAtomic {
    static constexpr bool PERM = false, AFTER_DRAIN = true;
    float* out; const float* scale; int pm_sub; int ldc; float ds;
    __device__ __forceinline__ void fused(f32x4 (&acc)[2][2][4][2], const Unit& u, int wr, int wc, int fr, int fq, PG8_LAS unsigned char* lds, int wid, int lane) const {
        PG8_LAS float* scr = (PG8_LAS float*)(lds + wid * 16384);
        const int rr = lane >> 5, cc = lane & 31;
#pragma unroll
        for (int ai = 0; ai < 2; ++ai)
#pragma unroll
            for (int bj = 0; bj < 2; ++bj) {
#pragma unroll
                for (int m = 0; m < 4; ++m)
#pragma unroll
                    for (int n = 0; n < 2; ++n) *(PG8_LAS f32x4*)(scr + (m * 16 + fr) * 36 + n * 16 + 4 * fq) = acc[ai][bj][m][n];
                asm volatile("s_waitcnt lgkmcnt(0)" ::: "memory");
                const int colg = u.pn * BM + bj * HALF + wc * 32 + cc; const float sc = (scale ? scale[colg] : 1.0f) * ds;
                float* op = out + (size_t)((u.pm - pm_sub) * BM + ai * HALF + wr * 64 + rr) * ldc + colg;
#pragma unroll 8
                for (int i = 0; i < 32; ++i) { const float v = scr[(2 * i + rr) * 36 + cc]; __hip_atomic_fetch_add(op + (size_t)(2 * i) * ldc, v * sc, __ATOMIC_RELAXED, __HIP_MEMORY_SCOPE_AGENT); }
                asm volatile("s_waitcnt lgkmcnt(0)" ::: "memory");
            }
    }
};

typedef int i32x4v __attribute__((ext_vector_type(4))); typedef int i32x8v __attribute__((ext_vector_type(8)));
struct FragB { bf16x8 k[2]; };
struct Frag8 { i32x8v v; };
template <bool F8> struct FragSel { typedef FragB type; };
template <> struct FragSel<true> { typedef Frag8 type; };
__device__ __forceinline__ void ld_frag(FragB& f, const PG8_LAS unsigned char* p) { f.k[0] = *(const PG8_LAS bf16x8*)p; f.k[1] = *(const PG8_LAS bf16x8*)(p + 1024); }
__device__ __forceinline__ void ld_frag(Frag8& f, const PG8_LAS unsigned char* p) { const i32x4v lo = *(const PG8_LAS i32x4v*)p, hi = *(const PG8_LAS i32x4v*)(p + 1024); f.v = __builtin_shufflevector(lo, hi, 0, 1, 2, 3, 4, 5, 6, 7); }
__device__ __forceinline__ f32x4 mma_frag(const FragB& b, const FragB& a, f32x4 c) { c = __builtin_amdgcn_mfma_f32_16x16x32_bf16(b.k[0], a.k[0], c, 0, 0, 0); return __builtin_amdgcn_mfma_f32_16x16x32_bf16(b.k[1], a.k[1], c, 0, 0, 0); }
__device__ __forceinline__ f32x4 mma_frag(const Frag8& b, const Frag8& a, f32x4 c) {
    asm volatile("v_mfma_scale_f32_16x16x128_f8f6f4 %0, %1, %2, %0, %3, %3 op_sel_hi:[0,0,0]" : "+v"(c) : "v"(b.v), "v"(a.v), "v"(0x7f7f7f7f));
    return c;
}

struct EpiSwiGLU8 {
    static constexpr bool PERM = true, AFTER_DRAIN = false;
    unsigned char* O; int ldc; float ds, hs;
    __device__ __forceinline__ void operator()(const f32x4 (&acc)[2][2][4][2], const Unit& u, int wr, int wc, int fr, int fq) const {
        const int row0 = u.pm * BM + wr * 64 + fr, col0 = u.pn * HALF + wc * 32 + 8 * fq;
#pragma unroll
        for (int ai = 0; ai < 2; ++ai)
#pragma unroll
            for (int m = 0; m < 4; ++m) { unsigned char* rowp = O + (size_t)(row0 + ai * HALF + m * 16) * ldc + col0;
                const f32x4 g0 = acc[ai][0][m][0] * ds, g1 = acc[ai][0][m][1] * ds, u0 = acc[ai][1][m][0] * ds, u1 = acc[ai][1][m][1] * ds;
                float h[8];
#pragma unroll
                for (int j = 0; j < 4; ++j) { h[j] = fminf(fmaxf(silu_f(g0[j]) * u0[j] * hs, -448.0f), 448.0f); h[4 + j] = fminf(fmaxf(silu_f(g1[j]) * u1[j] * hs, -448.0f), 448.0f); }
                unsigned lo = 0u, hi = 0u;
                lo = __builtin_amdgcn_cvt_pk_fp8_f32(h[0], h[1], lo, false); lo = __builtin_amdgcn_cvt_pk_fp8_f32(h[2], h[3], lo, true);
                hi = __builtin_amdgcn_cvt_pk_fp8_f32(h[4], h[5], hi, false); hi = __builtin_amdgcn_cvt_pk_fp8_f32(h[6], h[7], hi, true);
                typedef unsigned u32x2 __attribute__((ext_vector_type(2)));
                *(u32x2*)rowp = (u32x2){lo, hi}; }
    }
};
struct EpiScaleBf16 {
    static constexpr bool PERM = true, AFTER_DRAIN = false;
    bf16_t* O; int ldc; float ds;
    __device__ __forceinline__ void operator()(const f32x4 (&acc)[2][2][4][2], const Unit& u, int wr, int wc, int fr, int fq) const {
        const int row0 = u.pm * BM + wr * 64 + fr, col0 = u.pn * BM + wc * 32 + 8 * fq;
#pragma unroll
        for (int ai = 0; ai < 2; ++ai)
#pragma unroll
            for (int m = 0; m < 4; ++m) { bf16_t* rowp = O + (size_t)(row0 + ai * HALF + m * 16) * ldc + col0;
#pragma unroll
                for (int bj = 0; bj < 2; ++bj) { const f32x4 v0 = acc[ai][bj][m][0] * ds, v1 = acc[ai][bj][m][1] * ds;
                    u32x4 w; w.x = cvt_pk_bf16(v0[0], v0[1]); w.y = cvt_pk_bf16(v0[2], v0[3]); w.z = cvt_pk_bf16(v1[0], v1[1]); w.w = cvt_pk_bf16(v1[2], v1[3]);
                    *(u32x4*)(rowp + bj * HALF) = w; } }
    }
};

template <class Epi, class Sched, bool ALIGN_EPI = false, bool SP2 = false, bool F8 = false>
__device__ __forceinline__ void gemm_phase(PG8_LAS unsigned char* lds, const Gemm g, const Sched& S, const Epi& E, int tid_in) {
    int tid_ = tid_in; asm volatile("" : "+v"(tid_));
    const int tid = tid_, wid = __builtin_amdgcn_readfirstlane(tid >> 6), lane = tid & 63, wr = wid >> 2, wc = wid & 3, fr = lane & 15, fq = lane >> 4;
    const int K = g.K, nt = K / BK, ld = g.ld;
    unsigned voffA[2], voffB[2];
#pragma unroll
    for (int i = 0; i < 2; ++i) { int R, C; stage_rc(tid * 16 + i * 8192, R, C); const int Rb = Epi::PERM ? ((R & ~31) + perm32(R & 31)) : R;
        voffA[i] = (unsigned)(R * ld + C) * 2u; voffB[i] = (unsigned)(Rb * ld + C) * 2u; }
    const size_t kstep = (size_t)(BK * 2);
    const size_t hstep = (size_t)HALF * ld * 2;
    const size_t tstep = 2 * hstep;
    const unsigned ldsw = (unsigned)wid * 1024u;
    const int aoff = lds_byte(wr * 64 + fr, fq * 8), boff = lds_byte(wc * 32 + fr, fq * 8);
#define PG8_SA(b, h) (((b) * 2 + (h)) * HTB)
#define PG8_SB(b, h) ((4 + (b) * 2 + (h)) * HTB)
#define PG8_STAGE(bufoff, gbase, voff) do { _Pragma("unroll") for (int _i = 0; _i < 2; ++_i) \
        __builtin_amdgcn_global_load_lds((const unsigned*)((const char*)(gbase) + (voff)[_i]), (PG8_LAS unsigned*)(lds + (bufoff) + ldsw + _i * 8192), 16, 0, 0); } while (0)
#define PG8_LDA(dst, b, h) do { _Pragma("unroll") for (int m = 0; m < 4; ++m) ld_frag(dst[m], lds + PG8_SA(b, h) + aoff + m * 2048); } while (0)
#define PG8_LDB(dst, b, h) do { _Pragma("unroll") for (int n = 0; n < 2; ++n) ld_frag(dst[n], lds + PG8_SB(b, h) + boff + n * 2048); } while (0)
#define PG8_MMA(ai, bj, At, Bt) do { __builtin_amdgcn_s_setprio(1); _Pragma("unroll") for (int m = 0; m < 4; ++m) _Pragma("unroll") for (int n = 0; n < 2; ++n) \
        acc[ai][bj][m][n] = mma_frag(Bt[n], At[m], acc[ai][bj][m][n]); __builtin_amdgcn_s_setprio(0); } while (0)
#define PG8_WAIT_V(n) asm volatile("s_waitcnt vmcnt(" #n ")" ::: "memory")
#define PG8_WAIT_L(n) asm volatile("s_waitcnt lgkmcnt(" #n ")" ::: "memory")
#define PG8_BAR __builtin_amdgcn_s_barrier()
#define PG8_SCHED __builtin_amdgcn_sched_barrier(0)
    Unit cur, nxt; int ui = 0;
    if (!S.next(0, cur)) return;
    float zacc = 0.f; asm volatile("" : "+v"(zacc));
    f32x4 acc[2][2][4][2];
#pragma unroll
    for (int a = 0; a < 2; ++a)
#pragma unroll
        for (int b = 0; b < 2; ++b)
#pragma unroll
            for (int m = 0; m < 4; ++m)
#pragma unroll
                for (int n = 0; n < 2; ++n) acc[a][b][m][n] = (f32x4){zacc, zacc, zacc, zacc};
    typedef typename FragSel<F8>::type Frag;
    Frag At[4], B0[2], B1[2];
    const char* cA = (const char*)g.A + (size_t)cur.pm * tstep + (size_t)cur.ko * 2; const char* cB = (const char*)g.Bt + (size_t)cur.eb * g.bstride + (size_t)cur.pn * tstep + (size_t)cur.ko * 2;
    S.a_ready(cur);
    if constexpr (SP2) {
        PG8_STAGE(PG8_SB(0, 0), cB, voffB); PG8_STAGE(PG8_SB(0, 1), cB + hstep, voffB); PG8_STAGE(PG8_SA(0, 0), cA, voffA); PG8_STAGE(PG8_SA(0, 1), cA + hstep, voffA);
        if (wr == 1) PG8_BAR;
        PG8_WAIT_V(2); PG8_BAR;
        PG8_STAGE(PG8_SB(1, 0), cB + kstep, voffB); PG8_STAGE(PG8_SA(1, 0), cA + kstep, voffA); PG8_STAGE(PG8_SB(1, 1), cB + hstep + kstep, voffB);
        PG8_WAIT_V(6); PG8_BAR;
    } else {
        PG8_STAGE(PG8_SB(0, 0), cB, voffB); PG8_STAGE(PG8_SA(0, 0), cA, voffA); PG8_STAGE(PG8_SB(0, 1), cB + hstep, voffB); PG8_STAGE(PG8_SA(0, 1), cA + hstep, voffA);
        if (wr == 1) PG8_BAR;
        PG8_WAIT_V(4); PG8_BAR;
        PG8_STAGE(PG8_SB(1, 0), cB + kstep, voffB); PG8_STAGE(PG8_SA(1, 0), cA + kstep, voffA); PG8_STAGE(PG8_SB(1, 1), cB + hstep + kstep, voffB);
        PG8_WAIT_V(6); PG8_BAR;
    }
    for (;;) {
        const bool has_next = S.next(ui + 1, nxt);
        const char* nA = has_next ? (const char*)g.A + (size_t)nxt.pm * tstep + (size_t)nxt.ko * 2 : cA; const char* nB = has_next ? (const char*)g.Bt + (size_t)nxt.eb * g.bstride + (size_t)nxt.pn * tstep + (size_t)nxt.ko * 2 : cB;
        for (int t = 0; t < nt; t += 2) {
            const bool last = (t == nt - 2);
            const char* a1 = cA + (size_t)(t + 1) * kstep;
            const char* a2 = last ? nA : cA + (size_t)(t + 2) * kstep; const char* b2 = last ? nB : cB + (size_t)(t + 2) * kstep;
            const char* a3 = a2 + kstep; const char* b3 = b2 + kstep;
            if (last && has_next) S.a_ready(nxt);
            if constexpr (SP2) {
            PG8_LDB(B0, 0, 0); PG8_LDB(B1, 0, 1); PG8_SCHED; PG8_LDA(At, 0, 0); PG8_STAGE(PG8_SA(1, 1), a1 + hstep, voffA);
            PG8_WAIT_V(8); PG8_WAIT_L(0); PG8_BAR; PG8_MMA(0, 0, At, B0); PG8_MMA(0, 1, At, B1); PG8_BAR; PG8_SCHED;
            PG8_LDA(At, 0, 1); PG8_STAGE(PG8_SB(0, 0), b2, voffB); PG8_STAGE(PG8_SB(0, 1), b2 + hstep, voffB); PG8_STAGE(PG8_SA(0, 0), a2, voffA);
            PG8_WAIT_V(8); PG8_WAIT_L(0); PG8_BAR; PG8_MMA(1, 0, At, B0); PG8_MMA(1, 1, At, B1); PG8_BAR; PG8_SCHED;
            PG8_LDB(B0, 1, 0); PG8_LDB(B1, 1, 1); PG8_SCHED; PG8_LDA(At, 1, 0); PG8_STAGE(PG8_SA(0, 1), a2 + hstep, voffA);
            PG8_WAIT_V(8); PG8_WAIT_L(0); PG8_BAR; PG8_MMA(0, 0, At, B0); PG8_MMA(0, 1, At, B1); PG8_BAR; PG8_SCHED;
            PG8_LDA(At, 1, 1); PG8_STAGE(PG8_SB(1, 0), b3, voffB); PG8_STAGE(PG8_SB(1, 1), b3 + hstep, voffB); PG8_STAGE(PG8_SA(1, 0), a3, voffA);
            PG8_WAIT_V(8); PG8_WAIT_L(0); PG8_BAR; PG8_MMA(1, 0, At, B0); PG8_MMA(1, 1, At, B1); PG8_BAR; PG8_SCHED;
            } else {
            PG8_LDB(B0, 0, 0); PG8_SCHED; PG8_LDA(At, 0, 0); PG8_STAGE(PG8_SA(1, 1), a1 + hstep, voffA);
            PG8_WAIT_L(8); PG8_BAR; PG8_WAIT_L(0); PG8_MMA(0, 0, At, B0); PG8_BAR; PG8_SCHED;
            PG8_LDB(B1, 0, 1); PG8_STAGE(PG8_SB(0, 0), b2, voffB);
            PG8_BAR; PG8_WAIT_L(0); PG8_MMA(0, 1, At, B1); PG8_BAR;
            PG8_LDA(At, 0, 1); PG8_STAGE(PG8_SA(0, 0), a2, voffA);
            PG8_BAR; PG8_WAIT_L(0); PG8_MMA(1, 0, At, B0); PG8_BAR; PG8_SCHED;
            PG8_STAGE(PG8_SB(0, 1), b2 + hstep, voffB);
            PG8_WAIT_V(6); PG8_BAR; PG8_MMA(1, 1, At, B1); PG8_BAR;
            PG8_LDB(B0, 1, 0); PG8_SCHED; PG8_LDA(At, 1, 0); PG8_STAGE(PG8_SA(0, 1), a2 + hstep, voffA);
            PG8_WAIT_L(8); PG8_BAR; PG8_WAIT_L(0); PG8_MMA(0, 0, At, B0); PG8_BAR; PG8_SCHED;
            PG8_LDB(B1, 1, 1); PG8_STAGE(PG8_SB(1, 0), b3, voffB);
            PG8_BAR; PG8_WAIT_L(0); PG8_MMA(0, 1, At, B1); PG8_BAR;
            PG8_LDA(At, 1, 1); PG8_STAGE(PG8_SA(1, 0), a3, voffA);
            PG8_BAR; PG8_WAIT_L(0); PG8_MMA(1, 0, At, B0); PG8_BAR; PG8_SCHED;
            PG8_STAGE(PG8_SB(1, 1), b3 + hstep, voffB);
            PG8_WAIT_V(6); PG8_BAR; PG8_MMA(1, 1, At, B1); PG8_BAR;
            }
        }
        if constexpr (ALIGN_EPI) { if (wr == 0) PG8_BAR; }
        if constexpr (F8) {
            asm volatile("s_nop 15\n\ts_nop 15" : "+v"(acc[1][1][0][0]), "+v"(acc[1][1][0][1]), "+v"(acc[1][1][1][0]), "+v"(acc[1][1][1][1]), "+v"(acc[1][1][2][0]), "+v"(acc[1][1][2][1]), "+v"(acc[1][1][3][0]), "+v"(acc[1][1][3][1])); }
        if constexpr (!Epi::AFTER_DRAIN) { E(acc, cur, wr, wc, fr, fq); S.done(cur); }
        if (!has_next) break;
#pragma unroll
        for (int a = 0; a < 2; ++a)
#pragma unroll
            for (int b = 0; b < 2; ++b)
#pragma unroll
                for (int m = 0; m < 4; ++m)
#pragma unroll
                    for (int n = 0; n < 2; ++n) acc[a][b][m][n] = (f32x4){zacc, zacc, zacc, zacc};
        cur = nxt; cA = nA; cB = nB; ++ui;
        if constexpr (ALIGN_EPI) { if (wr == 1) PG8_BAR; }
    }
    PG8_WAIT_V(0);
    if constexpr (!ALIGN_EPI) { if (wr == 0) PG8_BAR; }
    PG8_BAR;
    if constexpr (Epi::AFTER_DRAIN) { E.fused(acc, cur, wr, wc, fr, fq, lds, wid, lane); S.done(cur); }
#undef PG8_SA
#undef PG8_SB
#undef PG8_STAGE
#undef PG8_LDA
#undef PG8_LDB
#undef PG8_MMA
#undef PG8_WAIT_V
#undef PG8_WAIT_L
#undef PG8_BAR
#undef PG8_SCHED
}
}


constexpr int S_LAT = 16384, C_CTX = 256, R_ALL = S_LAT + C_CTX, DM = 1024;
constexpr int INW = 2560, FFN = 2816, EXD = 3584, NEXP = 8;
constexpr int COL_AQ = 0, COL_AK = 512, COL_AV = 640, COL_HQ = 768, COL_HFF = 1024, COL_HFB = 1280, COL_HI = 1536, COL_HG = 1792, COL_GU = 2048, COL_GV = 2304;
constexpr int MIX_AT = 0, MIX_HG = 512, MIX_GM = 768;
constexpr int MOE_MAXROWS = 34816;
constexpr float EPS = 1e-6f;
constexpr int NWAVES = 8, NTHR = 512;
constexpr int NPH = 23;

constexpr size_t MiB = 1u << 20;
constexpr size_t WS_CTL = 0, CTL_ZERO_BYTES = 1 * MiB;
constexpr size_t WS_VEC = 1 * MiB;
constexpr size_t WS_TOK = 2 * MiB;
constexpr size_t WS_WIN = 3 * MiB;
constexpr size_t WS_WOUT = 13 * MiB;
constexpr size_t WS_WGU = 17 * MiB;
constexpr size_t WS_WD = 28 * MiB;
constexpr size_t WS_MGU = 34 * MiB;
constexpr size_t WS_MD = 146 * MiB;
constexpr size_t WS_H = 202 * MiB;
constexpr size_t WS_PROJ = 235 * MiB;
constexpr size_t WS_MIX = 317 * MiB;
constexpr size_t WS_HGO = 350 * MiB;
constexpr size_t WS_CTXR = 383 * MiB;
constexpr size_t WS_HLT = WS_HGO;
constexpr size_t WS_HSP = 384 * MiB;
constexpr size_t WS_HDG = 402 * MiB;
constexpr size_t WS_VT = 403 * MiB;
constexpr size_t WS_HID = WS_PROJ;
constexpr size_t WS_AS = 202 * MiB;
constexpr size_t WS_HIDM = 270 * MiB;
constexpr size_t WS_H2B = 440 * MiB;
constexpr size_t WS_YF = WS_WIN;
constexpr size_t WS_Y = WS_MGU;
constexpr size_t WS_END = 508 * MiB;
static_assert(WS_HID + (size_t)R_ALL * FFN * 2 <= WS_HGO && WS_AS + (size_t)MOE_MAXROWS * DM * 2 <= WS_HIDM && WS_HIDM + (size_t)MOE_MAXROWS * EXD * 2 <= WS_END, "ws map");
static_assert(WS_H2B >= WS_HIDM && WS_H2B + (size_t)S_LAT * DM * 2 <= WS_END && WS_H + (size_t)R_ALL * DM * 2 <= WS_PROJ && WS_PROJ + (size_t)R_ALL * INW * 2 <= WS_MIX && WS_MIX + (size_t)R_ALL * DM * 2 <= WS_HGO && WS_HGO + (size_t)2 * R_ALL * 256 * 4 <= WS_CTXR, "ws map 2");
constexpr int VO_MOD = 0;
constexpr int VO_ROPE = 32768;
constexpr int VO_MOE = 65536;
constexpr int CW_BAR = 4096;
constexpr int CW_QUEUE = 2048;
constexpr int CW_MOECNT = 1024;

constexpr int RING_BYTES = 131072;
constexpr int LDSCTL_OFF = 159744, MISC_OFF = LDSCTL_OFF + 320;
constexpr int LDS_BYTES = 163840;

#define GAS __attribute__((address_space(1)))
#define LAS __attribute__((address_space(3)))
typedef unsigned short bf16;
typedef unsigned v4u __attribute__((ext_vector_type(4)));
typedef unsigned v2u __attribute__((ext_vector_type(2)));
typedef float f32x4 __attribute__((ext_vector_type(4)));
typedef GAS unsigned gu32;
#define RLX_AGENT __ATOMIC_RELAXED, __HIP_MEMORY_SCOPE_AGENT
#define LDS_WAIT() asm volatile("s_waitcnt lgkmcnt(0)" ::: "memory")
typedef float f32x2_t __attribute__((ext_vector_type(2))); typedef __bf16 bf16x2_t __attribute__((ext_vector_type(2)));
__device__ __forceinline__ unsigned pk2(float lo, float hi) { const f32x2_t v = {lo, hi}; const bf16x2_t b = __builtin_convertvector(v, bf16x2_t); return __builtin_bit_cast(unsigned, b); }
__device__ __forceinline__ unsigned f2bf(float f) { return pk2(f, 0.f) & 0xffffu; }
__device__ __forceinline__ float bflo(unsigned w) { return __builtin_bit_cast(float, w << 16); }
__device__ __forceinline__ float bfhi(unsigned w) { return __builtin_bit_cast(float, w & 0xffff0000u); }
__device__ __forceinline__ float sigm1(float x) { return __builtin_amdgcn_rcpf(1.0f + __builtin_amdgcn_exp2f(-1.4426950408889634f * x)); }
__device__ __forceinline__ float silu1(float x) { return x * sigm1(x); }
__device__ __forceinline__ float gelu1(float x) { return 0.5f * x * (1.0f + erff(x * 0.70710678118654752f)); }
template <int X> __device__ __forceinline__ float sx(float v) { return __shfl_xor(v, X); }
__device__ __forceinline__ float sx32_add(float v) { return v + __shfl_xor(v, 32); }
__device__ __forceinline__ float sx32_max(float v) { return fmaxf(v, __shfl_xor(v, 32)); }
__device__ __forceinline__ float wave_sum(float v) { v += sx<1>(v); v += sx<2>(v); v += sx<4>(v); v += sx<8>(v); v += sx<16>(v); return sx32_add(v); }
__device__ __forceinline__ void unpack8(const v4u w, float* f) { f[0] = bflo(w.x); f[1] = bfhi(w.x); f[2] = bflo(w.y); f[3] = bfhi(w.y); f[4] = bflo(w.z); f[5] = bfhi(w.z); f[6] = bflo(w.w); f[7] = bfhi(w.w); }


__device__ __forceinline__ float clamp448(float x) { return fminf(fmaxf(x, -448.0f), 448.0f); }
__device__ __forceinline__ unsigned pk4_fp8(float a, float b, float c, float d) {
    unsigned w = 0u; w = __builtin_amdgcn_cvt_pk_fp8_f32(clamp448(a), clamp448(b), w, false); w = __builtin_amdgcn_cvt_pk_fp8_f32(clamp448(c), clamp448(d), w, true); return w; }
constexpr float F8_WSCALE = 128.0f;
constexpr float F8_ASCALE = 16.0f;
constexpr float F8_HSCALE = 8.0f;
#define XB_TMO      128
#define XB_XCNT(j)  (256  + 64 * (j))
#define XB_XSUB(j)  (1280 + 64 * (j))
#define XB_XGEN(j)  (2304 + 64 * (j))
#define XB_TOP      3328
#define XB_TOPGEN   3392
#define XCD_BAR_WORDS 3456
#define XB_SPIN_CAP (1u << 18)

__device__ __forceinline__ unsigned xb_ld(unsigned* p)              { return __hip_atomic_load(p, __ATOMIC_RELAXED, __HIP_MEMORY_SCOPE_AGENT); }
__device__ __forceinline__ unsigned xb_add(unsigned* p, unsigned v) { return __hip_atomic_fetch_add(p, v, __ATOMIC_RELAXED, __HIP_MEMORY_SCOPE_AGENT); }
__device__ __forceinline__ unsigned xb_xcc_id() { return (unsigned)__builtin_amdgcn_s_getreg((3 << 11) | 20) & 0xFu; }
#define XB_SPIN(cond, bar) do { unsigned _sp = 0; while (cond) { __builtin_amdgcn_s_sleep(1); \
    if ((++_sp & 255u) == 0u) { if (xb_ld(&(bar)[XB_TMO])) break; if (_sp > XB_SPIN_CAP) { atomicAdd(&(bar)[XB_TMO], 1u); break; } } } } while (0)

struct XcdBarrier {
    unsigned* bar; unsigned x;
    volatile LAS unsigned* st;
};

__device__ __forceinline__ XcdBarrier xcd_barrier_post(unsigned* bar, volatile LAS unsigned* st) {
    XcdBarrier b; b.bar = bar; b.x = xb_xcc_id(); b.st = st;
    if (threadIdx.x == 0) (void)xb_add(&bar[XB_XCNT(b.x)], 1u);
    return b;
}
__device__ __forceinline__ void xcd_barrier_complete(unsigned* bar, unsigned x, unsigned& nloc, unsigned& nx) {
    const unsigned G = gridDim.x * gridDim.y * gridDim.z;
    unsigned sum, cnt, mine, sp = 0u;
    for (;;) {
        sum = 0u; cnt = 0u; mine = 0u;
#pragma unroll
        for (unsigned j = 0; j < 16; ++j) { const unsigned c = xb_ld(&bar[XB_XCNT(j)]); sum += c; cnt += (c > 0u) ? 1u : 0u; mine = (j == x) ? c : mine; }
        if (sum == G) break;
        __builtin_amdgcn_s_sleep(1);
        if ((++sp & 255u) == 0u) { if (xb_ld(&bar[XB_TMO])) break; if (sp > XB_SPIN_CAP) { atomicAdd(&bar[XB_TMO], 1u); break; } }
    }
    nloc = mine > 0u ? mine : 1u; nx = cnt > 0u ? cnt : 1u;
}

__device__ __forceinline__ void xcd_barrier(const XcdBarrier& b, const int tid_in) {
    asm volatile("s_waitcnt vmcnt(0)" ::: "memory");
    __syncthreads();
    if (tid_in == 0) {
        unsigned* bar = b.bar;
        __builtin_amdgcn_s_waitcnt(0);
        unsigned nloc = b.st[0], nx = b.st[1];
        if (nloc == 0u) { xcd_barrier_complete(bar, b.x, nloc, nx); b.st[0] = nloc; b.st[1] = nx; }
        const unsigned old = xb_add(&bar[XB_XSUB(b.x)], 1u);
        const unsigned gen = old / nloc;
        if (old + 1u == (gen + 1u) * nloc) {
            __builtin_amdgcn_fence(__ATOMIC_RELEASE, "agent");
            asm volatile("s_waitcnt vmcnt(0)" ::: "memory");
            const unsigned og = xb_add(&bar[XB_TOP], 1u);
            const unsigned tg = og / nx;
            if (og + 1u == (tg + 1u) * nx) xb_add(&bar[XB_TOPGEN], 1u);
            else XB_SPIN(xb_ld(&bar[XB_TOPGEN]) == tg, bar);
            __builtin_amdgcn_fence(__ATOMIC_ACQUIRE, "agent");
            xb_add(&bar[XB_XGEN(b.x)], 1u);
            asm volatile("s_waitcnt vmcnt(0)" ::: "memory");
        } else {
            XB_SPIN(xb_ld(&bar[XB_XGEN(b.x)]) == gen, bar);
            __builtin_amdgcn_fence(__ATOMIC_ACQUIRE, "agent");
            asm volatile("s_waitcnt vmcnt(0)" ::: "memory");
        }
    }
    __syncthreads();
}


struct Args { const float* in[23]; float* out; unsigned char* ws; int ph_lo, ph_hi; };
typedef const __attribute__((address_space(4))) Args* KA;
#define KARGS() ({ KA p_ = (KA)__builtin_amdgcn_kernarg_segment_ptr(); asm volatile("" : "+s"(p_)); p_; })
enum { I_X = 0, I_C, I_CTX, I_CCTX, I_WADA, I_BADA, I_WIN, I_WOUT, I_QG, I_KG, I_SINK, I_HLB, I_HGAIN, I_GWS, I_GBS, I_GNG, I_FG, I_FU, I_FD, I_ROUTER, I_MG, I_MU, I_MDN };

__device__ __forceinline__ void transpose_item(const float* W, int K, int N, bf16* WT, int mode, LAS float* scr, int item, int lane) {
    const int nblk = N / 32, kb = item / nblk, nb = item % nblk, k0 = 64 * kb, n0 = 32 * nb;
#pragma unroll 8
    for (int i = 0; i < 32; ++i) { const int kk = 2 * i + (lane >> 5); scr[kk * 33 + (lane & 31)] = W[(size_t)(k0 + kk) * N + n0 + (lane & 31)]; }
    LDS_WAIT(); asm volatile("" ::: "memory");
    const int c = lane & 7;
#pragma unroll
    for (int j = 0; j < 4; ++j) { const int n = (lane >> 3) + 8 * j; const LAS float* s = scr + (8 * c) * 33 + n;
        v4u o; o.x = pk2(s[0 * 33], s[1 * 33]); o.y = pk2(s[2 * 33], s[3 * 33]); o.z = pk2(s[4 * 33], s[5 * 33]); o.w = pk2(s[6 * 33], s[7 * 33]);
        const int ng = n0 + n; const int drow = (mode == 0) ? ng : (ng + 128 * (ng / 128) + (mode == 2 ? 128 : 0));
        *(GAS v4u*)(WT + (size_t)drow * K + k0 + 8 * c) = o; }
    LDS_WAIT(); asm volatile("" ::: "memory");
}
__device__ __forceinline__ void transpose_item8(const float* W, int K, int N, unsigned char* WT, int mode, LAS float* scr, int item, int lane) {
    const int nblk = N / 32, kb = item / nblk, nb = item % nblk, k0 = 64 * kb, n0 = 32 * nb;
#pragma unroll 8
    for (int i = 0; i < 32; ++i) { const int kk = 2 * i + (lane >> 5); scr[kk * 33 + (lane & 31)] = W[(size_t)(k0 + kk) * N + n0 + (lane & 31)]; }
    LDS_WAIT(); asm volatile("" ::: "memory");
    const int c = lane & 7;
#pragma unroll
    for (int j = 0; j < 4; ++j) { const int n = (lane >> 3) + 8 * j; const LAS float* s = scr + (8 * c) * 33 + n;
        v2u o; o.x = pk4_fp8(s[0 * 33] * F8_WSCALE, s[1 * 33] * F8_WSCALE, s[2 * 33] * F8_WSCALE, s[3 * 33] * F8_WSCALE); o.y = pk4_fp8(s[4 * 33] * F8_WSCALE, s[5 * 33] * F8_WSCALE, s[6 * 33] * F8_WSCALE, s[7 * 33] * F8_WSCALE);
        const int ng = n0 + n; const int drow = (mode == 0) ? ng : (ng + 128 * (ng / 128) + (mode == 2 ? 128 : 0));
        *(GAS v2u*)(WT + (size_t)drow * K + k0 + 8 * c) = o; }
    LDS_WAIT(); asm volatile("" ::: "memory");
}
constexpr int MOE_ITEMS = 24 * 16 * 112;
constexpr int MOE_SL0 = 0, MOE_SL1 = 5376, MOE_SL2 = 10752, MOE_SL3 = 16128, MOE_SL4 = 19200, MOE_DEFER = 25344;
__device__ __forceinline__ void moe_conv_item(KA a, int it, LAS float* scr, int lane) {
    constexpr int I_M = 16 * 112;
    unsigned char* ws = a->ws;
    const int idx = it / I_M, r = it % I_M;
    if (idx < 8) transpose_item8(a->in[I_MG] + (size_t)idx * DM * EXD, DM, EXD, (unsigned char*)(ws + WS_MGU) + (size_t)idx * 2 * EXD * DM, 1, scr, r, lane);
    else if (idx < 16) transpose_item8(a->in[I_MU] + (size_t)(idx - 8) * DM * EXD, DM, EXD, (unsigned char*)(ws + WS_MGU) + (size_t)(idx - 8) * 2 * EXD * DM, 2, scr, r, lane);
    else transpose_item8(a->in[I_MDN] + (size_t)(idx - 16) * EXD * DM, EXD, DM, (unsigned char*)(ws + WS_MD) + (size_t)(idx - 16) * DM * EXD, 0, scr, r, lane);
}
__device__ __forceinline__ void moe_conv_range(KA a, int lo, int hi, int first, LAS unsigned char* lds, int lane, int wave, int G, int bid) {
    if (bid < first) return;
    LAS float* scr = (LAS float*)(lds + wave * 8704);
    const int nw = (G - first) * NWAVES, w = (bid - first) * NWAVES + wave;
    for (int i = lo + w; i < hi; i += nw) moe_conv_item(a, i, scr, lane);
}
__device__ __forceinline__ void p0_prologue(KA a, LAS unsigned char* lds, int tid, int lane, int wave, int G, int bid) {
    unsigned char* ws = a->ws;
    LAS float* scr = (LAS float*)(lds + wave * 8704);
    const int gw = bid * NWAVES + wave, NGW = G * NWAVES;
    constexpr int I_IN = 16 * 80, I_OUT = 16 * 32, I_F = 16 * 88, I_FDN = 44 * 32, I_M = 16 * 112;
    constexpr int NIT = 2 * I_IN + 2 * I_OUT + 2 * I_F + I_FDN + 24 * I_M;
    for (int it0 = gw; it0 < NIT; it0 += NGW) {
        int it = it0;
        if (it < 2 * I_IN) { const int l = it / I_IN, r = it % I_IN; transpose_item(a->in[I_WIN] + (size_t)l * DM * INW, DM, INW, (bf16*)(ws + WS_WIN) + (size_t)l * INW * DM, 0, scr, r, lane); continue; } it -= 2 * I_IN;
        if (it < 2 * I_OUT) { const int l = it / I_OUT, r = it % I_OUT; transpose_item(a->in[I_WOUT] + (size_t)l * DM * DM, DM, DM, (bf16*)(ws + WS_WOUT) + (size_t)l * DM * DM, 0, scr, r, lane); continue; } it -= 2 * I_OUT;
        if (it < I_F) { transpose_item(a->in[I_FG], DM, FFN, (bf16*)(ws + WS_WGU), 1, scr, it, lane); continue; } it -= I_F;
        if (it < I_F) { transpose_item(a->in[I_FU], DM, FFN, (bf16*)(ws + WS_WGU), 2, scr, it, lane); continue; } it -= I_F;
        if (it < I_FDN) { transpose_item(a->in[I_FD], FFN, DM, (bf16*)(ws + WS_WD), 0, scr, it, lane); continue; } it -= I_FDN;
        if (it >= MOE_DEFER) moe_conv_item(a, it, scr, lane);
    }
    LAS float* sil = (LAS float*)(lds + 69632);
    LAS float* part = (LAS float*)(lds + 69632 + 8192);
    float* vec = (float*)(ws + WS_VEC);
    if (bid < 192) {
        for (int i = tid; i < 2048; i += NTHR) { const float v = (i < 1024) ? a->in[I_C][i] : a->in[I_CCTX][i - 1024]; sil[i] = silu1(v); }
        __syncthreads();
        for (int item = bid; item < 192; item += G) {
            const int l = item / 96, cb = item % 96, col = cb * 64 + lane;
            const float* w = a->in[I_WADA] + (size_t)l * DM * 6144 + col;
            float a0 = 0.f, a1 = 0.f;
#pragma unroll 8
            for (int k = wave * 128; k < wave * 128 + 128; ++k) { const float wv = w[(size_t)k * 6144]; a0 += sil[k] * wv; a1 += sil[1024 + k] * wv; }
            part[(wave * 2 + 0) * 64 + lane] = a0; part[(wave * 2 + 1) * 64 + lane] = a1;
            __syncthreads();
            if (wave == 0) { float s0 = 0.f, s1 = 0.f;
#pragma unroll
                for (int w8 = 0; w8 < 8; ++w8) { s0 += part[(w8 * 2 + 0) * 64 + lane]; s1 += part[(w8 * 2 + 1) * 64 + lane]; }
                const float b = a->in[I_BADA][l * 6144 + col];
                vec[VO_MOD + (l * 2 + 0) * 6144 + col] = s0 + b; vec[VO_MOD + (l * 2 + 1) * 6144 + col] = s1 + b; }
            __syncthreads();
        }
    }
    for (int i = bid * NTHR + tid; i < C_CTX * DM / 4; i += G * NTHR) ((GAS f32x4*)(ws + WS_CTXR))[i] = ((const GAS f32x4*)a->in[I_CTX])[i];
    if (bid == G - 1) {
        for (int idx = tid; idx < 5120; idx += NTHR) {
            const int isc = idx >= 4096, j = isc ? idx - 4096 : idx, pos = j / 16, i = j % 16;
            const float inv = exp2f(-(float)i * 0.83048202372184059f);
            const float ang = (float)pos * inv;
            double r = (double)ang * 0.15915494309189535; r -= floor(r);
            const float rf = (float)r;
            const float cs = __builtin_amdgcn_cosf(rf), sn = __builtin_amdgcn_sinf(rf);
            float* t = vec + VO_ROPE + (isc ? 8192 : 0);
            const int n = isc ? 1024 : 4096;
            t[j] = cs; t[n + j] = sn;
        }
    }
}

template <bool STORE = true> __device__ __forceinline__ void norm_row(const float* xrow, const float* sc, const float* sh, bf16* orow, int lane, f32x4 (&h)[4]) {
    const GAS f32x4* xr = (const GAS f32x4*)xrow + lane;
    f32x4 v[4]; float s = 0.f;
#pragma unroll
    for (int j = 0; j < 4; ++j) { v[j] = xr[64 * j]; s += (v[j].x * v[j].x + v[j].y * v[j].y) + (v[j].z * v[j].z + v[j].w * v[j].w); }
    const float rstd = __builtin_amdgcn_rsqf(wave_sum(s) * (1.0f / DM) + EPS);
    GAS v2u* o8 = (GAS v2u*)orow + lane;
#pragma unroll
    for (int j = 0; j < 4; ++j) { const f32x4 scv = *(const f32x4*)(sc + 4 * lane + 256 * j), shv = *(const f32x4*)(sh + 4 * lane + 256 * j);
        h[j] = v[j] * rstd * (scv + 1.0f) + shv;
        if constexpr (STORE) { v2u w; w.x = pk2(h[j].x, h[j].y); w.y = pk2(h[j].z, h[j].w); o8[64 * j] = w; } }
}
__device__ __forceinline__ void phase_norm(KA a, int l, int which, int nrows, bf16* H, int lane, int wave, int G, int bid) {
    const float* vec = (const float*)(a->ws + WS_VEC);
    const float* xl = (l == 0 && which == 0) ? a->in[I_X] : a->out;
    const float* xc = (l == 0 && which == 0) ? a->in[I_CTX] : (const float*)(a->ws + WS_CTXR);
    const float* ml = vec + VO_MOD + (l * 2 + 0) * 6144 + which * 3072;
    const float* mc = vec + VO_MOD + (l * 2 + 1) * 6144 + which * 3072;
    const int gw = bid * NWAVES + wave, NGW = G * NWAVES;
    f32x4 scl[4], shl[4], v[4];
#pragma unroll
    for (int j = 0; j < 4; ++j) { scl[j] = *(const f32x4*)(ml + 1024 + 4 * lane + 256 * j) + 1.0f; shl[j] = *(const f32x4*)(ml + 4 * lane + 256 * j); }
    if (gw < nrows) { const GAS f32x4* xr = (const GAS f32x4*)(gw >= S_LAT ? xc + (size_t)(gw - S_LAT) * DM : xl + (size_t)gw * DM) + lane;
#pragma unroll
        for (int j = 0; j < 4; ++j) v[j] = xr[64 * j]; }
    for (int r = gw; r < nrows; r += NGW) {
        const int rn = r + NGW; f32x4 vn[4];
        if (rn < nrows) { const GAS f32x4* xr = (const GAS f32x4*)(rn >= S_LAT ? xc + (size_t)(rn - S_LAT) * DM : xl + (size_t)rn * DM) + lane;
#pragma unroll
            for (int j = 0; j < 4; ++j) vn[j] = xr[64 * j]; }
        float s = 0.f;
#pragma unroll
        for (int j = 0; j < 4; ++j) s += (v[j].x * v[j].x + v[j].y * v[j].y) + (v[j].z * v[j].z + v[j].w * v[j].w);
        const float rstd = __builtin_amdgcn_rsqf(wave_sum(s) * (1.0f / DM) + EPS);
        GAS v2u* o8 = (GAS v2u*)(H + (size_t)r * DM) + lane;
        if (r >= S_LAT) {
#pragma unroll
            for (int j = 0; j < 4; ++j) { const f32x4 scv = *(const f32x4*)(mc + 1024 + 4 * lane + 256 * j), shv = *(const f32x4*)(mc + 4 * lane + 256 * j);
                const f32x4 h = v[j] * rstd * (scv + 1.0f) + shv; v2u w; w.x = pk2(h.x, h.y); w.y = pk2(h.z, h.w); o8[64 * j] = w; }
        } else {
#pragma unroll
            for (int j = 0; j < 4; ++j) { const f32x4 h = v[j] * rstd * scl[j] + shl[j]; v2u w; w.x = pk2(h.x, h.y); w.y = pk2(h.z, h.w); o8[64 * j] = w; }
        }
#pragma unroll
        for (int j = 0; j < 4; ++j) v[j] = vn[j];
    }
}
__device__ __forceinline__ void phase_norm_route(KA a, LAS unsigned char* lds, int tid, int lane, int wave, int G, int bid) {
    const int l = 1;
    const float* vec = (const float*)(a->ws + WS_VEC);
    const float* ml = vec + VO_MOD + (l * 2 + 0) * 6144 + 3072;
    unsigned char* H8 = (unsigned char*)(a->ws + WS_H2B);
    LAS float* rt = (LAS float*)lds;
    volatile LAS unsigned* lcnt = (volatile LAS unsigned*)(lds + 32768);
    for (int i = tid; i < 8192; i += NTHR) rt[i] = a->in[I_ROUTER][i];
    if (tid < 16) lcnt[tid] = 0u;
    __syncthreads();
    int* tokinfo = (int*)(a->ws + WS_TOK);
    unsigned* cnt = (unsigned*)(a->ws + WS_CTL) + CW_MOECNT;
    const int gw = bid * NWAVES + wave, NGW = G * NWAVES;
    unsigned keep = 0u, pk0 = 0u; int itn = 0;
    for (int r = gw; r < S_LAT; r += NGW) {
        f32x4 h[4];
        norm_row<false>(a->out + (size_t)r * DM, ml + 1024, ml, nullptr, lane, h);
#pragma unroll
        for (int j = 0; j < 4; ++j) ((GAS unsigned*)(H8 + (size_t)r * DM))[lane + 64 * j] = pk4_fp8(h[j].x * F8_ASCALE, h[j].y * F8_ASCALE, h[j].z * F8_ASCALE, h[j].w * F8_ASCALE);
        float lg[8];
#pragma unroll
        for (int e = 0; e < 8; ++e) lg[e] = 0.f;
#pragma unroll
        for (int j = 0; j < 4; ++j)
#pragma unroll
            for (int i = 0; i < 4; ++i) { const int d = 4 * lane + 256 * j + i; const f32x4 r0 = *(const LAS f32x4*)(rt + d * 8), r1 = *(const LAS f32x4*)(rt + d * 8 + 4); const float hv = h[j][i];
                lg[0] += hv * r0.x; lg[1] += hv * r0.y; lg[2] += hv * r0.z; lg[3] += hv * r0.w; lg[4] += hv * r1.x; lg[5] += hv * r1.y; lg[6] += hv * r1.z; lg[7] += hv * r1.w; }
#pragma unroll
        for (int e = 0; e < 8; ++e) lg[e] = wave_sum(lg[e]);
        int i1 = 0; float v1 = lg[0];
#pragma unroll
        for (int e = 1; e < 8; ++e) if (lg[e] > v1) { v1 = lg[e]; i1 = e; }
        int i2 = -1; float v2 = -INFINITY;
#pragma unroll
        for (int e = 0; e < 8; ++e) if (e != i1 && lg[e] > v2) { v2 = lg[e]; i2 = e; }
        const float w1 = 1.0f / (1.0f + __expf(v2 - v1)), w2 = 1.0f - w1;
        if (lane == 0) {
            const unsigned r1 = __hip_atomic_fetch_add((LAS unsigned*)lcnt + i1, 1u, __ATOMIC_RELAXED, __HIP_MEMORY_SCOPE_WORKGROUP), r2 = __hip_atomic_fetch_add((LAS unsigned*)lcnt + i2, 1u, __ATOMIC_RELAXED, __HIP_MEMORY_SCOPE_WORKGROUP);
            int* ti = tokinfo + (size_t)r * 8;
            ti[0] = i1; ti[1] = i2; ti[4] = __builtin_bit_cast(int, w1); ti[5] = __builtin_bit_cast(int, w2);
            pk0 = (unsigned)i1 | ((unsigned)i2 << 3) | (r1 << 6) | (r2 << 19);
        }
        const unsigned pku = (unsigned)__builtin_amdgcn_readfirstlane((int)pk0);
        if (lane == itn) keep = pku;
        ++itn;
    }
    __syncthreads();
    if (tid < 8) lcnt[8 + tid] = __hip_atomic_fetch_add(cnt + 64 * tid, lcnt[tid], RLX_AGENT);
    __syncthreads();
    { const int r = gw + lane * NGW; if (lane < itn && r < S_LAT) { int* ti = tokinfo + (size_t)r * 8; const unsigned e1 = keep & 7u, e2 = (keep >> 3) & 7u; ti[2] = (int)(((keep >> 6) & 0x1fffu) + lcnt[8 + e1]); ti[3] = (int)((keep >> 19) + lcnt[8 + e2]); } }
}

__device__ __forceinline__ void qk_prep(KA a, int l, int first_thread, int nthreads) {
    bf16* PROJ = (bf16*)(a->ws + WS_PROJ);
    const float* rope = (const float*)(a->ws + WS_VEC) + VO_ROPE;
    for (int i = first_thread; i < R_ALL * 10; i += nthreads) {
        const int row = i / 10, hh = i % 10; const bool isq = hh < 8;
        bf16* p = PROJ + (size_t)row * INW + (isq ? hh * 64 : COL_AK + (hh - 8) * 64);
        const float* gain = (isq ? a->in[I_QG] : a->in[I_KG]) + l * 64;
        float x[64]; float ss = 0.f;
#pragma unroll
        for (int c = 0; c < 8; ++c) { const v4u w = *(const GAS v4u*)(p + 8 * c); unpack8(w, x + 8 * c); }
#pragma unroll
        for (int d = 0; d < 64; ++d) ss += x[d] * x[d];
        const float rstd = __builtin_amdgcn_rsqf(ss * (1.0f / 64.0f) + EPS);
        const f32x4* g4 = (const f32x4*)gain;
#pragma unroll
        for (int c = 0; c < 16; ++c) { const f32x4 gv = g4[c]; x[4 * c] *= rstd * gv.x; x[4 * c + 1] *= rstd * gv.y; x[4 * c + 2] *= rstd * gv.z; x[4 * c + 3] *= rstd * gv.w; }
        if (row < S_LAT) {
            const int gr = row >> 6, gc = row & 63;
            const f32x4* cr = (const f32x4*)(rope + gr * 16); const f32x4* sr = (const f32x4*)(rope + 4096 + gr * 16); const f32x4* cc = (const f32x4*)(rope + 8192 + gc * 16); const f32x4* sc = (const f32x4*)(rope + 8192 + 1024 + gc * 16);
#pragma unroll
            for (int j4 = 0; j4 < 4; ++j4) { const f32x4 cv = cr[j4], sv = sr[j4];
#pragma unroll
                for (int i = 0; i < 4; ++i) { const int j = 4 * j4 + i; const float x1 = x[j], x2 = x[16 + j]; x[j] = x1 * cv[i] - x2 * sv[i]; x[16 + j] = x1 * sv[i] + x2 * cv[i]; } }
#pragma unroll
            for (int j4 = 0; j4 < 4; ++j4) { const f32x4 cv = cc[j4], sv = sc[j4];
#pragma unroll
                for (int i = 0; i < 4; ++i) { const int j = 4 * j4 + i; const float x1 = x[32 + j], x2 = x[48 + j]; x[32 + j] = x1 * cv[i] - x2 * sv[i]; x[48 + j] = x1 * sv[i] + x2 * cv[i]; } }
        }
        const float qs = isq ? 0.125f * 1.4426950408889634f : 1.0f;
#pragma unroll
        for (int c = 0; c < 8; ++c) { v4u w; w.x = pk2(x[8 * c] * qs, x[8 * c + 1] * qs); w.y = pk2(x[8 * c + 2] * qs, x[8 * c + 3] * qs); w.z = pk2(x[8 * c + 4] * qs, x[8 * c + 5] * qs); w.w = pk2(x[8 * c + 6] * qs, x[8 * c + 7] * qs);
            *(GAS v4u*)(p + 8 * c) = w; }
    }
}
__device__ __forceinline__ void gmlp_unit(KA a, int l, int chunk, int g, LAS unsigned char* lds, int tid, int lane, int wave) {
    const bf16* PROJ = (const bf16*)(a->ws + WS_PROJ); bf16* MIX = (bf16*)(a->ws + WS_MIX);
    const int row0 = (chunk < 128) ? chunk * 128 : S_LAT + (chunk - 128) * 128;
    LAS float* vn = (LAS float*)lds;
    { const int pos = tid >> 2, part = tid & 3;
      const bf16* p = PROJ + (size_t)(row0 + pos) * INW + COL_GV + g * 64 + part * 16;
      float x[16]; unpack8(*(const GAS v4u*)p, x); unpack8(*(const GAS v4u*)(p + 8), x + 8);
      float ss = 0.f;
#pragma unroll
      for (int d = 0; d < 16; ++d) { x[d] = gelu1(x[d]); ss += x[d] * x[d]; }
      ss += sx<1>(ss); ss += sx<2>(ss);
      const float rstd = __builtin_amdgcn_rsqf(ss * (1.0f / 64.0f) + EPS);
      const float* gn = a->in[I_GNG] + l * 256 + g * 64 + part * 16;
#pragma unroll
      for (int d = 0; d < 16; ++d) vn[pos * 64 + part * 16 + d] = x[d] * rstd * gn[d]; }
    __syncthreads();
    const int c = lane, t0 = wave * 16;
    const float* W = a->in[I_GWS] + ((size_t)(l * 4 + g) * 128 + t0) * 128;
    float acc[16];
#pragma unroll
    for (int i = 0; i < 16; ++i) acc[i] = 0.f;
    for (int s = 0; s < 128; ++s) { const float v = vn[s * 64 + c];
#pragma unroll
        for (int i = 0; i < 16; ++i) acc[i] += W[i * 128 + s] * v; }
    const float* bs = a->in[I_GBS] + (l * 4 + g) * 128 + t0;
#pragma unroll
    for (int i = 0; i < 16; ++i) { const int row = row0 + t0 + i;
        const float u = gelu1(bflo((unsigned)PROJ[(size_t)row * INW + COL_GU + g * 64 + c]));
        MIX[(size_t)row * DM + MIX_GM + g * 64 + c] = (bf16)f2bf(u * (acc[i] + bs[i])); }
    __syncthreads();
}
__device__ __forceinline__ void hgrn_naive(KA a, int l, int dir, int head, LAS unsigned char* lds, int tid, int lane, int wave) {
    const bf16* PROJ = (const bf16*)(a->ws + WS_PROJ);
    float* HGO = (float*)(a->ws + WS_HGO) + (size_t)dir * R_ALL * 256;
    LAS float* Qs = (LAS float*)lds;
    LAS float* Fs = Qs + 4096; LAS float* Vs = Fs + 4096; LAS float* part = Vs + 4096;
    const int v = lane, kg = wave;
    float S[8];
#pragma unroll
    for (int i = 0; i < 8; ++i) S[i] = 0.f;
    const int tl = tid >> 3, c8 = tid & 7;
    float lb[8];
#pragma unroll
    for (int j = 0; j < 8; ++j) { float b = 0.f; if (l == 1) { const float p0 = a->in[I_HLB][dir * 512 + head * 64 + c8 * 8 + j], p1 = a->in[I_HLB][dir * 512 + 256 + head * 64 + c8 * 8 + j]; b = 1.0f / (1.0f + __expf(p0 - p1)); } lb[j] = b; }
    const int fcol = (dir == 0 ? COL_HFF : COL_HFB) + head * 64 + c8 * 8;
    for (int n0 = 0; n0 < R_ALL; n0 += 64) {
        { const int n = n0 + tl; int row;
          if (dir == 0) row = (n < C_CTX) ? S_LAT + n : n - C_CTX; else row = (n < C_CTX) ? S_LAT + (C_CTX - 1 - n) : (S_LAT - 1) - (n - C_CTX);
          const bf16* pr = PROJ + (size_t)row * INW;
          float q[8], f[8], vv[8];
          unpack8(*(const GAS v4u*)(pr + COL_HQ + head * 64 + c8 * 8), q); unpack8(*(const GAS v4u*)(pr + fcol), f); unpack8(*(const GAS v4u*)(pr + COL_HI + head * 64 + c8 * 8), vv);
#pragma unroll
          for (int j = 0; j < 8; ++j) { Qs[tl * 64 + c8 * 8 + j] = silu1(q[j]) * 0.125f; Fs[tl * 64 + c8 * 8 + j] = lb[j] + (1.0f - lb[j]) * sigm1(f[j]); Vs[tl * 64 + c8 * 8 + j] = vv[j]; } }
        __syncthreads();
        for (int t = 0; t < 64; ++t) {
            const float vt = Vs[t * 64 + v]; float po = 0.f;
#pragma unroll
            for (int i = 0; i < 8; ++i) { const float f = Fs[t * 64 + kg * 8 + i], q = Qs[t * 64 + kg * 8 + i]; S[i] = f * S[i] + (1.0f - f) * vt; po += S[i] * q; }
            part[((t & 1) * 8 + kg) * 64 + v] = po;
            __syncthreads();
            if (wave == 0) { float o = 0.f;
#pragma unroll
                for (int w8 = 0; w8 < 8; ++w8) o += part[((t & 1) * 8 + w8) * 64 + v];
                const int n = n0 + t; int row;
                if (dir == 0) row = (n < C_CTX) ? S_LAT + n : n - C_CTX; else row = (n < C_CTX) ? S_LAT + (C_CTX - 1 - n) : (S_LAT - 1) - (n - C_CTX);
                HGO[(size_t)row * 256 + head * 64 + v] = o; }
        }
        __syncthreads();
    }
}

typedef short bf16x8v __attribute__((ext_vector_type(8)));
constexpr int HST = 72;
__device__ __forceinline__ f32x4 mma16(const LAS bf16* MA, const LAS bf16* MBt, int k0, f32x4 c, int lane) {
    const bf16x8v av = *(const LAS bf16x8v*)(MA + (lane & 15) * HST + k0 + 8 * (lane >> 4));
    const bf16x8v bv = *(const LAS bf16x8v*)(MBt + (lane & 15) * HST + k0 + 8 * (lane >> 4));
    return __builtin_amdgcn_mfma_f32_16x16x32_bf16(av, bv, c, 0, 0, 0);
}
__device__ __forceinline__ int hg_base_row(int cpos) { return cpos < 256 ? 64 * cpos : S_LAT + 64 * (cpos - 256); }
__device__ __forceinline__ int hg_scan_idx(int dir, int cpos) { return dir == 0 ? (cpos < 256 ? 4 + cpos : cpos - 256) : (cpos < 256 ? 4 + (255 - cpos) : 3 - (cpos - 256)); }
__device__ __forceinline__ float hg_lb(KA a, int l, int dir, int head, int k) {
    if (l == 0) return 0.f;
    const float p0 = a->in[I_HLB][dir * 512 + head * 64 + k], p1 = a->in[I_HLB][dir * 512 + 256 + head * 64 + k];
    return 1.0f / (1.0f + __expf(p0 - p1));
}
__device__ __forceinline__ void hgrn_stepA(KA a, int l, int cpos, int head, LAS unsigned char* lds, int lane, int wave) {
    const bf16* PROJ = (const bf16*)(a->ws + WS_PROJ);
    const int dir = wave >> 2, I = wave & 3, base = hg_base_row(cpos), ci = hg_scan_idx(dir, cpos);
    LAS float* TOT = (LAS float*)lds;
    LAS bf16* KLT = (LAS bf16*)(lds + 2048) + dir * 64 * HST;
    LAS bf16* VT = (LAS bf16*)(lds + 2048 + 2 * 64 * HST * 2) + dir * 64 * HST;
    const float lb = hg_lb(a, l, dir, head, lane);
    const int fcol = (dir == 0 ? COL_HFF : COL_HFB) + head * 64 + lane, vcol = COL_HI + head * 64 + lane;
    float kk[16], cl[16]; float run = 0.f;
#pragma unroll
    for (int i = 0; i < 16; ++i) { const int n = 16 * I + i, row = base + (dir ? 63 - n : n);
        const float fl = bflo((unsigned)PROJ[(size_t)row * INW + fcol]);
        const unsigned short vb = PROJ[(size_t)row * INW + vcol];
        const float f = lb + (1.0f - lb) * sigm1(fl);
        run += __logf(f); cl[i] = run; kk[i] = 1.0f - f;
        VT[lane * HST + n] = vb; }
    TOT[(dir * 4 + I) * 64 + lane] = run;
    __syncthreads();
    float post = 0.f, all = 0.f;
#pragma unroll
    for (int J = 0; J < 4; ++J) { const float t = TOT[(dir * 4 + J) * 64 + lane]; all += t; if (J > I) post += t; }
#pragma unroll
    for (int i = 0; i < 16; ++i) KLT[lane * HST + 16 * I + i] = (bf16)f2bf(kk[i] * __expf(run - cl[i] + post));
    if (I == 0) ((float*)(a->ws + WS_HDG))[((size_t)(dir * 4 + head) * 260 + ci) * 64 + lane] = __expf(all);
    __syncthreads();
    float* LT = (float*)(a->ws + WS_HLT) + ((size_t)(dir * 4 + head) * 260 + ci) * 4096;
    float z0 = 0.f; asm volatile("" : "+v"(z0));
#pragma unroll
    for (int kb = 0; kb < 4; ++kb) { f32x4 acc = {z0, z0, z0, z0};
        acc = mma16(VT + 16 * I * HST, KLT + 16 * kb * HST, 0, acc, lane); acc = mma16(VT + 16 * I * HST, KLT + 16 * kb * HST, 32, acc, lane);
#pragma unroll
        for (int r = 0; r < 4; ++r) LT[(16 * I + 4 * (lane >> 4) + r) * 64 + 16 * kb + (lane & 15)] = acc[r]; }
    __syncthreads();
}
__device__ __forceinline__ void hgrn_stepB(KA a, int item, int tid) {
    const int dh = item >> 3, vb = item & 7, v = vb * 8 + (tid >> 6), k = tid & 63;
    const float* LT = (const float*)(a->ws + WS_HLT) + (size_t)dh * 260 * 4096 + v * 64 + k;
    const float* DG = (const float*)(a->ws + WS_HDG) + (size_t)dh * 260 * 64 + k;
    bf16* SP = (bf16*)(a->ws + WS_HSP) + (size_t)dh * 260 * 4096 + v * 64 + k;
    float S = 0.f;
#pragma unroll 1
    for (int c0 = 0; c0 < 260; c0 += 26) {
        float lt[26], dg[26];
#pragma unroll
        for (int j = 0; j < 26; ++j) { lt[j] = LT[(size_t)(c0 + j) * 4096]; dg[j] = DG[(c0 + j) * 64]; }
#pragma unroll
        for (int j = 0; j < 26; ++j) { SP[(size_t)(c0 + j) * 4096] = (bf16)f2bf(S); S = dg[j] * S + lt[j]; }
    }
}
__device__ __forceinline__ void hgrn_stepC(KA a, int l, int cpos, int head, LAS unsigned char* lds, int tid, int lane, int wave) {
    const bf16* PROJ = (const bf16*)(a->ws + WS_PROJ); bf16* MIX = (bf16*)(a->ws + WS_MIX);
    const int dir = wave >> 2, I = wave & 3, base = hg_base_row(cpos), ci = hg_scan_idx(dir, cpos);
    constexpr int MSZ = 64 * HST;
    LAS float* TOT = (LAS float*)lds;
    LAS bf16* img = (LAS bf16*)(lds + 2048);
    LAS bf16* QT = img + dir * MSZ;
    LAS bf16* QD = img + 2 * MSZ + dir * MSZ;
    LAS bf16* VT = img + 4 * MSZ + dir * MSZ;
    LAS bf16* ST = img + 6 * MSZ + dir * MSZ;
    LAS bf16* AS = img + 8 * MSZ + dir * MSZ + I * 16 * HST;
    LAS bf16* KT = img + 10 * MSZ + dir * (10 * 16 * HST);
    LAS float* OS = (LAS float*)(img + 10 * MSZ);
    const float lb = hg_lb(a, l, dir, head, lane);
    const int fcol = (dir == 0 ? COL_HFF : COL_HFB) + head * 64 + lane, qcol = COL_HQ + head * 64 + lane, vcol = COL_HI + head * 64 + lane;
    { const bf16* SP = (const bf16*)(a->ws + WS_HSP) + ((size_t)(dir * 4 + head) * 260 + ci) * 4096;
#pragma unroll
      for (int h2 = 0; h2 < 2; ++h2) { const int e = ((I * 2 + h2) * 64 + lane) * 8, vv = e >> 6, kk0 = e & 63;
          *(LAS v4u*)(ST + vv * HST + kk0) = *(const GAS v4u*)(SP + e); } }
    float kk[16], cl[16], qv[16]; float run = 0.f;
#pragma unroll
    for (int i = 0; i < 16; ++i) { const int n = 16 * I + i, row = base + (dir ? 63 - n : n);
        const float fl = bflo((unsigned)PROJ[(size_t)row * INW + fcol]), ql = bflo((unsigned)PROJ[(size_t)row * INW + qcol]);
        const unsigned short vb = PROJ[(size_t)row * INW + vcol];
        const float f = lb + (1.0f - lb) * sigm1(fl);
        run += __logf(f); cl[i] = run; kk[i] = 1.0f - f; qv[i] = silu1(ql) * 0.125f;
        VT[lane * HST + n] = vb; }
    TOT[(dir * 4 + I) * 64 + lane] = run;
    __syncthreads();
    float tj[4];
#pragma unroll
    for (int J = 0; J < 4; ++J) tj[J] = TOT[(dir * 4 + J) * 64 + lane];
    float pre = 0.f;
#pragma unroll
    for (int J = 0; J < 4; ++J) if (J < I) pre += tj[J];
    const float epre = __expf(pre); float kei[16];
#pragma unroll
    for (int i = 0; i < 16; ++i) { const float e = __expf(cl[i]); QT[(16 * I + i) * HST + lane] = (bf16)f2bf(qv[i] * e); QD[(16 * I + i) * HST + lane] = (bf16)f2bf(qv[i] * e * epre); kei[i] = kk[i] * fminf(__builtin_amdgcn_rcpf(e), 5.5e34f); }
    float eoff = 0.f;
#pragma unroll
    for (int I2 = 0; I2 < 4; ++I2) {
        if (I2 >= I) {
            if (I2 == I) eoff = 0.f; else if (I2 == I + 1) eoff = run; else eoff += tj[I2 - 1];
            LAS bf16* blk = KT + (I2 * (I2 + 1) / 2 + I) * 16 * HST;
            const float fo = __expf(eoff);
#pragma unroll
            for (int i = 0; i < 16; ++i) blk[i * HST + lane] = (bf16)f2bf(kei[i] * fo);
        }
    }
    __syncthreads();
    float z0 = 0.f; asm volatile("" : "+v"(z0));
    f32x4 sc[4];
#pragma unroll
    for (int J = 0; J < 4; ++J) { sc[J] = (f32x4){z0, z0, z0, z0};
        if (J <= I) { const LAS bf16* kb = KT + (I * (I + 1) / 2 + J) * 16 * HST;
            sc[J] = mma16(QT + 16 * I * HST, kb, 0, sc[J], lane); sc[J] = mma16(QT + 16 * I * HST, kb, 32, sc[J], lane);
            if (J == I) {
#pragma unroll
                for (int r = 0; r < 4; ++r) if ((lane & 15) > 4 * (lane >> 4) + r) sc[J][r] = z0; } } }
#pragma unroll
    for (int J = 0; J < 4; ++J)
#pragma unroll
        for (int r = 0; r < 4; ++r) AS[(4 * (lane >> 4) + r) * HST + 16 * J + (lane & 15)] = (bf16)f2bf(sc[J][r]);
    asm volatile("s_waitcnt lgkmcnt(0)" ::: "memory");
    f32x4 acc[4];
#pragma unroll
    for (int vb = 0; vb < 4; ++vb) { acc[vb] = (f32x4){z0, z0, z0, z0};
        acc[vb] = mma16(AS, VT + 16 * vb * HST, 0, acc[vb], lane); acc[vb] = mma16(AS, VT + 16 * vb * HST, 32, acc[vb], lane);
        acc[vb] = mma16(QD + 16 * I * HST, ST + 16 * vb * HST, 0, acc[vb], lane); acc[vb] = mma16(QD + 16 * I * HST, ST + 16 * vb * HST, 32, acc[vb], lane); }
    __syncthreads();
#pragma unroll
    for (int vb = 0; vb < 4; ++vb)
#pragma unroll
        for (int r = 0; r < 4; ++r) { const int n = 16 * I + 4 * (lane >> 4) + r, rl = dir ? 63 - n : n; OS[(dir * 64 + rl) * 68 + 16 * vb + (lane & 15)] = acc[vb][r]; }
    __syncthreads();
    { const int rl = tid >> 3, v8 = (tid & 7) * 8, row = base + rl;
      float o[8]; float ss = 0.f;
#pragma unroll
      for (int j = 0; j < 8; ++j) { o[j] = OS[rl * 68 + v8 + j] + OS[(64 + rl) * 68 + v8 + j]; ss += o[j] * o[j]; }
      ss += sx<1>(ss); ss += sx<2>(ss); ss += sx<4>(ss);
      const float rstd = __builtin_amdgcn_rsqf(ss * (1.0f / 64.0f) + EPS);
      float gt[8]; unpack8(*(const GAS v4u*)(PROJ + (size_t)row * INW + COL_HG + head * 64 + v8), gt);
      const float* gn = a->in[I_HGAIN] + l * 64 + v8;
      float y[8];
#pragma unroll
      for (int j = 0; j < 8; ++j) y[j] = o[j] * rstd * gn[j] * silu1(gt[j]);
      v4u w; w.x = pk2(y[0], y[1]); w.y = pk2(y[2], y[3]); w.z = pk2(y[4], y[5]); w.w = pk2(y[6], y[7]);
      *(GAS v4u*)(MIX + (size_t)row * DM + MIX_HG + head * 64 + v8) = w; }
    __syncthreads();
}

__device__ __forceinline__ void vt_item(KA a, int item, int lane) {
    const bf16* PROJ = (const bf16*)(a->ws + WS_PROJ); bf16* VTg = (bf16*)(a->ws + WS_VT);
    const int rb = item >> 1, hk = item & 1, row = rb * 64 + lane;
    const bf16* p = PROJ + (size_t)row * INW + COL_AV + hk * 64;
    unsigned w[32];
#pragma unroll
    for (int c = 0; c < 8; ++c) { const v4u t = *(const GAS v4u*)(p + 8 * c); w[4 * c] = t.x; w[4 * c + 1] = t.y; w[4 * c + 2] = t.z; w[4 * c + 3] = t.w; }
    bf16* o = VTg + (size_t)hk * 64 * R_ALL + row;
#pragma unroll
    for (int d2 = 0; d2 < 32; ++d2) { o[(size_t)(2 * d2) * R_ALL] = (bf16)(w[d2] & 0xffffu); o[(size_t)(2 * d2 + 1) * R_ALL] = (bf16)(w[d2] >> 16); }
}
__device__ __forceinline__ void attn_unit(KA a, int l, int u, LAS unsigned char* lds, int tid, int lane, int wave) {
    asm volatile("" : "+v"(tid), "+v"(lane));
    const bf16* PROJ = (const bf16*)(a->ws + WS_PROJ); const bf16* VTg = (const bf16*)(a->ws + WS_VT); bf16* MIX = (bf16*)(a->ws + WS_MIX);
    const bool isctx = u >= 256; const int uu = isctx ? u - 256 : u; const int n = uu >> 1, hk = uu & 1;
    const int qh = hk * 4 + (wave >> 1), half = wave & 1;
    const int qbase = (isctx ? S_LAT : 0) + n * 128 + half * 64, qpos0 = n * 128 + half * 64;
    const int c = lane & 15, g = lane >> 4;
    LAS bf16* Kt = (LAS bf16*)lds; LAS bf16* Vt = Kt + 64 * HST; LAS bf16* Qw = Vt + 64 * HST + wave * 64 * HST;
#pragma unroll
    for (int j = 0; j < 8; ++j) { const int qr = 8 * j + (lane >> 3), qc = (lane & 7) * 8;
        *(LAS v4u*)(Qw + qr * HST + qc) = *(const GAS v4u*)(PROJ + (size_t)(qbase + qr) * INW + qh * 64 + qc); }
    float z0 = 0.f; asm volatile("" : "+v"(z0));
    f32x4 o[4][4]; float ls[4];
    float gq = 0.f, gk = 0.f;
#pragma unroll 8
    for (int d = 0; d < 64; ++d) { gq = fmaxf(gq, fabsf(a->in[I_QG][l * 64 + d])); gk = fmaxf(gk, fabsf(a->in[I_KG][l * 64 + d])); }
    const float nbnd = -(8.0f * 1.4426950408889634f) * gq * gk;
    const float sink = a->in[I_SINK][l * 8 + qh] * 1.4426950408889634f;
#pragma unroll
    for (int qt = 0; qt < 4; ++qt) { ls[qt] = (g == 0) ? __builtin_amdgcn_exp2f(sink + nbnd) : z0;
#pragma unroll
        for (int dt = 0; dt < 4; ++dt) o[qt][dt] = (f32x4){z0, z0, z0, z0}; }
    const int first = (!isctx && n == 0) ? 2 : 0, nwin = isctx ? 0 : ((n == 0 || n == 127) ? 4 : 6), nt = nwin + 4;
    const int lr = tid >> 3, lc = (tid & 7) * 8;
    v4u kreg, vreg;
#define ATT_LOADT(i) do { const bool ct_ = (i) >= nwin; const int kb_ = ct_ ? S_LAT + 64 * ((i) - nwin) : (n - 1) * 128 + 64 * (first + (i)); \
        kreg = *(const GAS v4u*)(PROJ + (size_t)(kb_ + lr) * INW + COL_AK + hk * 64 + lc); vreg = *(const GAS v4u*)(VTg + ((size_t)hk * 64 + lr) * R_ALL + kb_ + lc); } while (0)
    ATT_LOADT(0);
#pragma unroll 1
    for (int i = 0; i < nt; ++i) {
        __syncthreads();
        *(LAS v4u*)(Kt + lr * HST + lc) = kreg; *(LAS v4u*)(Vt + lr * HST + lc) = vreg;
        __syncthreads();
        if (i + 1 < nt) ATT_LOADT(i + 1);
        const bool win = i < nwin; const int kb = (n - 1) * 128 + 64 * (first + i);
        const int rel = kb - qpos0;
        const bool maskw = win && (rel == 128 || rel == -128);
        if (win && (rel >= 192 || rel <= -192)) continue;
        bf16x8v kf[4][2], vf[4][2];
#pragma unroll
        for (int kt = 0; kt < 4; ++kt)
#pragma unroll
            for (int ks = 0; ks < 2; ++ks) kf[kt][ks] = *(const LAS bf16x8v*)(Kt + (16 * kt + c) * HST + 32 * ks + 8 * g);
#pragma unroll
        for (int dt = 0; dt < 4; ++dt)
#pragma unroll
            for (int s2 = 0; s2 < 2; ++s2) { const v2u lo = *(const LAS v2u*)(Vt + (16 * dt + c) * HST + 32 * s2 + 4 * g), hi = *(const LAS v2u*)(Vt + (16 * dt + c) * HST + 32 * s2 + 16 + 4 * g);
                const v4u t = {lo.x, lo.y, hi.x, hi.y}; vf[dt][s2] = __builtin_bit_cast(bf16x8v, t); }
#pragma unroll
        for (int qt = 0; qt < 4; ++qt) {
            f32x4 s[4];
            const bf16x8v q0 = *(const LAS bf16x8v*)(Qw + (16 * qt + c) * HST + 8 * g), q1 = *(const LAS bf16x8v*)(Qw + (16 * qt + c) * HST + 32 + 8 * g);
#pragma unroll
            for (int kt = 0; kt < 4; ++kt) { s[kt] = (f32x4){nbnd, nbnd, nbnd, nbnd};
                s[kt] = __builtin_amdgcn_mfma_f32_16x16x32_bf16(kf[kt][0], q0, s[kt], 0, 0, 0); s[kt] = __builtin_amdgcn_mfma_f32_16x16x32_bf16(kf[kt][1], q1, s[kt], 0, 0, 0); }
            if (maskw) { const int dq = qpos0 + 16 * qt + c - kb - 4 * g;
#pragma unroll
                for (int kt = 0; kt < 4; ++kt)
#pragma unroll
                    for (int r = 0; r < 4; ++r) { const int dl = dq - 16 * kt - r; if (dl > 128 || dl < -128) s[kt][r] = -INFINITY; } }
            float ps = 0.f;
#pragma unroll
            for (int kt = 0; kt < 4; ++kt)
#pragma unroll
                for (int r = 0; r < 4; ++r) { s[kt][r] = __builtin_amdgcn_exp2f(s[kt][r]); ps += s[kt][r]; }
            ls[qt] += ps;
            bf16x8v pb[2];
#pragma unroll
            for (int s2 = 0; s2 < 2; ++s2) { const v4u t = {pk2(s[2 * s2][0], s[2 * s2][1]), pk2(s[2 * s2][2], s[2 * s2][3]), pk2(s[2 * s2 + 1][0], s[2 * s2 + 1][1]), pk2(s[2 * s2 + 1][2], s[2 * s2 + 1][3])};
                pb[s2] = __builtin_bit_cast(bf16x8v, t); }
#pragma unroll
            for (int dt = 0; dt < 4; ++dt) { o[qt][dt] = __builtin_amdgcn_mfma_f32_16x16x32_bf16(vf[dt][0], pb[0], o[qt][dt], 0, 0, 0); o[qt][dt] = __builtin_amdgcn_mfma_f32_16x16x32_bf16(vf[dt][1], pb[1], o[qt][dt], 0, 0, 0); }
        }
    }
#undef ATT_LOADT
    int c2 = lane & 15, g2 = lane >> 4; asm volatile("" : "+v"(c2), "+v"(g2));
#pragma unroll
    for (int qt = 0; qt < 4; ++qt) { float lt = ls[qt]; lt += sx<16>(lt); lt = sx32_add(lt); const float inv = 1.0f / lt;
        bf16* op = (bf16*)(a->ws + WS_MIX) + (size_t)(qbase + 16 * qt + c2) * DM + MIX_AT + qh * 64 + 4 * g2;
#pragma unroll
        for (int dt = 0; dt < 4; ++dt) { v2u w; w.x = pk2(o[qt][dt][0] * inv, o[qt][dt][1] * inv); w.y = pk2(o[qt][dt][2] * inv, o[qt][dt][3] * inv); *(GAS v2u*)(op + 16 * dt) = w; } }
}

constexpr int GST = 136;
__device__ __forceinline__ f32x4 mma16g(const LAS bf16* MA, const LAS bf16* MBt, int k0, f32x4 c, int lane) {
    const bf16x8v av = *(const LAS bf16x8v*)(MA + (lane & 15) * GST + k0 + 8 * (lane >> 4));
    const bf16x8v bv = *(const LAS bf16x8v*)(MBt + (lane & 15) * GST + k0 + 8 * (lane >> 4));
    return __builtin_amdgcn_mfma_f32_16x16x32_bf16(av, bv, c, 0, 0, 0);
}
__device__ __forceinline__ float gelu_as(float v) {
    const float av = fabsf(v), t = __builtin_amdgcn_rcpf(av * 0.2316418882f + 1.0f);
    float q = t * 0.5307027145f + (-0.7265760135f); q = q * t + 0.7107068705f; q = q * t + (-0.142248368f); q = q * t + 0.127414796f; q = q * t;
    const float e = __builtin_amdgcn_exp2f((v * v) * (-0.72134752044f)), mm = v * (q * e);
    return v < 0.f ? mm : v - mm;
}
__device__ __forceinline__ void gmlp_unit_mma(KA a, int l, int chunk, int g, LAS unsigned char* lds, int tid, int lane, int wave) {
    const bf16* PROJ = (const bf16*)(a->ws + WS_PROJ); bf16* MIX = (bf16*)(a->ws + WS_MIX);
    const int row0 = (chunk < 128) ? chunk * 128 : S_LAT + (chunk - 128) * 128;
    LAS bf16* WA = (LAS bf16*)lds;
    LAS bf16* VNT = WA + 128 * GST;
    LAS float* OUT = (LAS float*)(VNT + 64 * GST);
    const int pos = tid >> 2, part = tid & 3;
    {
      const float* W = a->in[I_GWS] + ((size_t)(l * 4 + g) * 128 + pos) * 128 + part * 32;
#pragma unroll
      for (int j = 0; j < 4; ++j) { const f32x4 w0 = *(const GAS f32x4*)(W + 8 * j), w1 = *(const GAS f32x4*)(W + 8 * j + 4);
          v4u o; o.x = pk2(w0.x, w0.y); o.y = pk2(w0.z, w0.w); o.z = pk2(w1.x, w1.y); o.w = pk2(w1.z, w1.w);
          *(LAS v4u*)(WA + pos * GST + part * 32 + 8 * j) = o; } }
    { const bf16* p = PROJ + (size_t)(row0 + pos) * INW + COL_GV + g * 64 + part * 16;
      float x[16]; unpack8(*(const GAS v4u*)p, x); unpack8(*(const GAS v4u*)(p + 8), x + 8);
      float ss = 0.f;
#pragma unroll
      for (int d = 0; d < 16; ++d) { x[d] = gelu_as(x[d]); ss += x[d] * x[d]; }
      ss += sx<1>(ss); ss += sx<2>(ss);
      const float rstd = __builtin_amdgcn_rsqf(ss * (1.0f / 64.0f) + EPS);
      const float* gn = a->in[I_GNG] + l * 256 + g * 64 + part * 16;
#pragma unroll
      for (int d = 0; d < 16; ++d) VNT[(part * 16 + d) * GST + pos] = (bf16)f2bf(x[d] * rstd * gn[d]); }
    __syncthreads();
    float z0 = 0.f; asm volatile("" : "+v"(z0));
#pragma unroll
    for (int cb = 0; cb < 4; ++cb) { f32x4 acc = {z0, z0, z0, z0};
#pragma unroll
        for (int ks = 0; ks < 4; ++ks) acc = mma16g(WA + 16 * wave * GST, VNT + 16 * cb * GST, 32 * ks, acc, lane);
#pragma unroll
        for (int r = 0; r < 4; ++r) OUT[(16 * wave + 4 * (lane >> 4) + r) * 68 + 16 * cb + (lane & 15)] = acc[r]; }
    __syncthreads();
    { const int row = row0 + pos; const float bsv = a->in[I_GBS][(l * 4 + g) * 128 + pos];
      const bf16* pu = PROJ + (size_t)row * INW + COL_GU + g * 64 + part * 16;
      float u[16]; unpack8(*(const GAS v4u*)pu, u); unpack8(*(const GAS v4u*)(pu + 8), u + 8);
      float y[16];
#pragma unroll
      for (int d = 0; d < 16; ++d) y[d] = gelu_as(u[d]) * (OUT[pos * 68 + part * 16 + d] + bsv);
      bf16* po = MIX + (size_t)row * DM + MIX_GM + g * 64 + part * 16;
      v4u w; w.x = pk2(y[0], y[1]); w.y = pk2(y[2], y[3]); w.z = pk2(y[4], y[5]); w.w = pk2(y[6], y[7]); *(GAS v4u*)po = w;
      w.x = pk2(y[8], y[9]); w.y = pk2(y[10], y[11]); w.z = pk2(y[12], y[13]); w.w = pk2(y[14], y[15]); *(GAS v4u*)(po + 8) = w; }
    __syncthreads();
}
__device__ __forceinline__ void attn_naive(KA a, int l, int nrows, int lane, int wave, int G, int bid) {
    const bf16* PROJ = (const bf16*)(a->ws + WS_PROJ); bf16* MIX = (bf16*)(a->ws + WS_MIX);
    const int gw = bid * NWAVES + wave, NGW = G * NWAVES;
    for (int pair = gw; pair < nrows * 2; pair += NGW) {
        const int row = pair >> 1, hk = pair & 1; const bool isctx = row >= S_LAT;
        float q[4], o[4], m[4], ls[4];
#pragma unroll
        for (int g = 0; g < 4; ++g) { q[g] = bflo((unsigned)PROJ[(size_t)row * INW + (hk * 4 + g) * 64 + lane]); o[g] = 0.f; ls[g] = 1.0f; m[g] = a->in[I_SINK][l * 8 + hk * 4 + g] * 1.4426950408889634f; }
        int j0 = 0, j1 = -1;
        if (!isctx) { j0 = row - 128 < 0 ? 0 : row - 128; j1 = row + 128 > S_LAT - 1 ? S_LAT - 1 : row + 128; }
        const int nwin = j1 - j0 + 1;
        const int nk = nwin + C_CTX;
#pragma unroll 4
        for (int t = 0; t < nk; ++t) {
            const int krow = (t < nwin) ? j0 + t : S_LAT + (t - nwin);
            const float k = bflo((unsigned)PROJ[(size_t)krow * INW + COL_AK + hk * 64 + lane]);
            const float v = bflo((unsigned)PROJ[(size_t)krow * INW + COL_AV + hk * 64 + lane]);
#pragma unroll
            for (int g = 0; g < 4; ++g) { const float s = wave_sum(q[g] * k); const float mn = fmaxf(m[g], s);
                const float c = __builtin_amdgcn_exp2f(m[g] - mn), p = __builtin_amdgcn_exp2f(s - mn);
                ls[g] = ls[g] * c + p; o[g] = o[g] * c + p * v; m[g] = mn; }
        }
#pragma unroll
        for (int g = 0; g < 4; ++g) MIX[(size_t)row * DM + MIX_AT + (hk * 4 + g) * 64 + lane] = (bf16)f2bf(o[g] / ls[g]);
    }
}
__device__ __forceinline__ void hgrn_combine(KA a, int l, int nrows, int lane, int wave, int G, int bid) {
    const bf16* PROJ = (const bf16*)(a->ws + WS_PROJ); bf16* MIX = (bf16*)(a->ws + WS_MIX);
    const float* O0 = (const float*)(a->ws + WS_HGO); const float* O1 = O0 + (size_t)R_ALL * 256;
    const f32x4 gn = *(const f32x4*)(a->in[I_HGAIN] + l * 64 + (lane & 15) * 4);
    const int gw = bid * NWAVES + wave, NGW = G * NWAVES;
    for (int r = gw; r < nrows; r += NGW) {
        const f32x4 o = *(const GAS f32x4*)(O0 + (size_t)r * 256 + 4 * lane) + *(const GAS f32x4*)(O1 + (size_t)r * 256 + 4 * lane);
        float ss = (o.x * o.x + o.y * o.y) + (o.z * o.z + o.w * o.w);
        ss += sx<1>(ss); ss += sx<2>(ss); ss += sx<4>(ss); ss += sx<8>(ss);
        const float rstd = __builtin_amdgcn_rsqf(ss * (1.0f / 64.0f) + EPS);
        const v2u gw2 = *(const GAS v2u*)(PROJ + (size_t)r * INW + COL_HG + 4 * lane);
        const float g0 = bflo(gw2.x), g1 = bfhi(gw2.x), g2 = bflo(gw2.y), g3 = bfhi(gw2.y);
        v2u w; w.x = pk2(o.x * rstd * gn.x * silu1(g0), o.y * rstd * gn.y * silu1(g1)); w.y = pk2(o.z * rstd * gn.z * silu1(g2), o.w * rstd * gn.w * silu1(g3));
        *(GAS v2u*)(MIX + (size_t)r * DM + MIX_HG + 4 * lane) = w;
    }
}
__device__ __forceinline__ void moe_gather(KA a, LAS unsigned char* lds, int tid, int lane, int wave, int G, int bid) {
    LAS int* sb = (LAS int*)lds;
    const unsigned* cnt = (const unsigned*)(a->ws + WS_CTL) + CW_MOECNT;
    int* mi = (int*)(a->ws + WS_VEC) + VO_MOE;
    if (tid == 0) { int b = 0;
        for (int e = 0; e < 8; ++e) { const int c = (int)__hip_atomic_load(cnt + 64 * e, RLX_AGENT); sb[e] = b; sb[16 + e] = c;
            const int nt = (c + 255) >> 8;
            if (bid == 0) for (int t = 0; t < nt; ++t) mi[16 + (b >> 8) + t] = e;
            b += nt << 8; }
        sb[8] = b; if (bid == 0) mi[0] = b >> 8; }
    __syncthreads();
    const unsigned char* H8 = (const unsigned char*)(a->ws + WS_H2B); unsigned char* AS = (unsigned char*)(a->ws + WS_AS);
    const int* tokinfo = (const int*)(a->ws + WS_TOK); int* tokslot = (int*)(a->ws + WS_TOK) + S_LAT * 8;
    const int gw = bid * NWAVES + wave, NGW = G * NWAVES;
    for (int t = gw; t < S_LAT; t += NGW) {
        const int* ti = tokinfo + (size_t)t * 8;
        const int e1 = ti[0], e2 = ti[1], r1 = ti[2], r2 = ti[3];
        const int s1 = sb[e1] + r1, s2 = sb[e2] + r2;
        const v4u x0 = ((const GAS v4u*)(H8 + (size_t)t * DM))[lane];
        ((GAS v4u*)(AS + (size_t)s1 * DM))[lane] = x0; ((GAS v4u*)(AS + (size_t)s2 * DM))[lane] = x0;
        if (lane == 0) { int* ts = tokslot + (size_t)t * 4; ts[0] = s1; ts[1] = s2; ts[2] = ti[4]; ts[3] = ti[5]; }
    }
    { const f32x4 z4 = {0.f, 0.f, 0.f, 0.f}; for (int i = bid * NTHR + tid; i < 8 * 256 * DM / 4; i += G * NTHR) ((GAS f32x4*)(a->ws + WS_YF))[i] = z4; }
    for (int e = 0; e < 8; ++e) { const int c = sb[16 + e], pe = (c + 255) & ~255, b = sb[e];
        for (int j = c + gw; j < pe; j += NGW) { const v4u z = {0u, 0u, 0u, 0u}; ((GAS v4u*)(AS + (size_t)(b + j) * DM))[lane] = z; } }
}
__device__ __forceinline__ void moe_combine(KA a, int lane, int wave, int G, int bid) {
    const float* gf = (const float*)(a->ws + WS_VEC) + VO_MOD + (1 * 2 + 0) * 6144 + 5 * 1024;
    const bf16* Y = (const bf16*)(a->ws + WS_Y); const int* tokslot = (const int*)(a->ws + WS_TOK) + S_LAT * 8;
    const int gw = bid * NWAVES + wave, NGW = G * NWAVES;
    for (int t = gw; t < S_LAT; t += NGW) {
        const int* ts = tokslot + (size_t)t * 4; const int s1 = ts[0], s2 = ts[1]; const float w1 = __builtin_bit_cast(float, ts[2]), w2 = __builtin_bit_cast(float, ts[3]);
        GAS f32x4* xr = (GAS f32x4*)(a->out + (size_t)t * DM) + lane;
        const float* YF = (const float*)(a->ws + WS_YF);
#pragma unroll
        for (int j = 0; j < 4; ++j) { const f32x4 g = *(const f32x4*)(gf + 4 * lane + 256 * j); f32x4 x = xr[64 * j]; f32x4 p, q;
            if (s1 < 32768) { const v2u t = ((const GAS v2u*)(Y + (size_t)s1 * DM) + lane)[64 * j]; p = (f32x4){bflo(t.x), bfhi(t.x), bflo(t.y), bfhi(t.y)}; } else p = ((const GAS f32x4*)(YF + (size_t)(s1 - 32768) * DM) + lane)[64 * j];
            if (s2 < 32768) { const v2u t = ((const GAS v2u*)(Y + (size_t)s2 * DM) + lane)[64 * j]; q = (f32x4){bflo(t.x), bfhi(t.x), bflo(t.y), bfhi(t.y)}; } else q = ((const GAS f32x4*)(YF + (size_t)(s2 - 32768) * DM) + lane)[64 * j];
            x = x + g * (p * w1 + q * w2);
            xr[64 * j] = x; }
    }
}

#define IN(k) (lo <= (k) && (k) < hi)
#define GRIDBAR() do { XcdBarrier b2_; b2_.bar = (unsigned*)(KARGS()->ws + WS_CTL) + CW_BAR; b2_.x = xb_xcc_id(); b2_.st = (volatile LAS unsigned*)(lds + MISC_OFF) + 8; xcd_barrier(b2_, wv0 * 64 + (int)__builtin_amdgcn_mbcnt_hi(~0u, __builtin_amdgcn_mbcnt_lo(~0u, 0u))); } while (0)
#define SEAM(k) do { if (IN(k) && IN((k) + 1)) GRIDBAR(); } while (0)
#define PHASE_ROOTS() KA a = KARGS(); unsigned char* ws = a->ws; const float* vec = (const float*)(ws + WS_VEC); (void)vec; int bid = blockIdx.x, G = gridDim.x; asm volatile("" : "+s"(bid), "+s"(G)); int tid = wv0 * 64 + (int)__builtin_amdgcn_mbcnt_hi(~0u, __builtin_amdgcn_mbcnt_lo(~0u, 0u)); asm volatile("" : "+v"(tid)); const int lane = tid & 63, wave = __builtin_amdgcn_readfirstlane(tid >> 6); (void)lane; (void)wave

template <int l> __device__ __forceinline__ void layer_body(const int lo, const int hi, LAS unsigned char* lds, const int wv0) {
        const int pb = 1 + 11 * l;
        if (IN(pb + 0)) { PHASE_ROOTS(); phase_norm(a, l, 0, R_ALL, (bf16*)(ws + WS_H), lane, wave, G, bid); SEAM(pb + 0); }
        if (IN(pb + 1)) {
            PHASE_ROOTS();
            pg8::Gemm g{(const pg8::bf16_t*)(ws + WS_H), (const pg8::bf16_t*)(ws + WS_WIN) + (size_t)l * INW * DM, R_ALL, INW, DM, 0, DM};
            pg8::StaticOrder S; S.init(R_ALL, INW, G, bid);
            pg8::EpiBf16<0> E{(pg8::bf16_t*)(ws + WS_PROJ), INW, nullptr, 0, 0, 1.f};
            pg8::gemm_phase<pg8::EpiBf16<0>, pg8::StaticOrder, true, true>(lds, g, S, E, tid);
            moe_conv_range(a, l == 0 ? MOE_SL0 : MOE_SL2, l == 0 ? MOE_SL1 : MOE_SL3, 650 - 2 * 256, lds, lane, wave, G, bid);
            SEAM(pb + 1);
        }
        if (IN(pb + 2)) {
            PHASE_ROOTS();
            qk_prep(a, l, bid * NTHR + tid, G * NTHR);
            for (int it = bid * NWAVES + wave; it < 520; it += G * NWAVES) vt_item(a, it, lane);
            for (int it = bid; it < 1040; it += G) hgrn_stepA(a, l, it >> 2, it & 3, lds, lane, wave);
            if (l == 0) { __syncthreads(); moe_conv_range(a, MOE_SL3, MOE_SL4, 1040 - 4 * 256, lds, lane, wave, G, bid); }
            SEAM(pb + 2);
        }
        if (IN(pb + 3)) {
            PHASE_ROOTS();
            if (bid < 64) hgrn_stepB(a, bid, tid);
            {
                const int nu = (l == 0) ? 260 : 256, ng = (l == 0) ? 520 : 512;
                unsigned* qctr = (unsigned*)(ws + WS_CTL) + CW_QUEUE + 64 * l;
                volatile LAS unsigned* qslot = (volatile LAS unsigned*)(lds + MISC_OFF) + 16;
                for (;;) {
                    __syncthreads();
                    if (tid == 0) qslot[0] = __hip_atomic_fetch_add(qctr, 1u, RLX_AGENT);
                    __syncthreads();
                    const int it = __builtin_amdgcn_readfirstlane((int)qslot[0]);
                    if (it >= nu + ng) break;
                    if (it < nu) attn_unit(a, l, it, lds, tid, lane, wave);
                    else gmlp_unit_mma(a, l, (it - nu) >> 2, (it - nu) & 3, lds, tid, lane, wave);
                }
            }
            SEAM(pb + 3);
        }
        if (IN(pb + 4)) {
            PHASE_ROOTS();
            const int nit = (l == 0) ? 1040 : 1024;
            for (int it = bid; it < nit; it += G) hgrn_stepC(a, l, it >> 2, it & 3, lds, tid, lane, wave);
            if (l == 0) { __syncthreads(); moe_conv_range(a, MOE_SL4, MOE_DEFER, 1040 - 4 * 256, lds, lane, wave, G, bid); }
            SEAM(pb + 4);
        }
        if (IN(pb + 5)) {
            PHASE_ROOTS();
            const float* modl = vec + VO_MOD + (l * 2 + 0) * 6144; const float* modc = vec + VO_MOD + (l * 2 + 1) * 6144;
            const int M = S_LAT;
            pg8::Gemm g{(const pg8::bf16_t*)(ws + WS_MIX), (const pg8::bf16_t*)(ws + WS_WOUT) + (size_t)l * DM * DM, M, DM, DM, 0, DM};
            pg8::StaticOrder S; S.init(M, DM, G, bid);
            pg8::EpiResid E{(l == 0) ? a->in[I_X] : a->out, a->out, modl + 2048, a->in[I_CTX], (float*)(ws + WS_CTXR), modc + 2048, S_LAT / 256, DM};
            pg8::gemm_phase<pg8::EpiResid, pg8::StaticOrder, true, true>(lds, g, S, E, tid);
            if (l == 0) {
                pg8::Gemm g2{(const pg8::bf16_t*)(ws + WS_MIX), (const pg8::bf16_t*)(ws + WS_WOUT), R_ALL, DM, 256, 0, DM};
                pg8::SplitKOrder S2{S_LAT / 256, 4, 4, 256, 16, bid, nullptr};
                pg8::EpiAtomic E2{(float*)(ws + WS_CTXR), modc + 2048, S_LAT / 256, DM, 1.0f};
                pg8::gemm_phase<pg8::EpiAtomic, pg8::SplitKOrder, false, true>(lds, g2, S2, E2, tid);
            }
            SEAM(pb + 5);
        }
        if (l == 0) {
            if (IN(pb + 6)) { PHASE_ROOTS(); phase_norm(a, l, 1, R_ALL, (bf16*)(ws + WS_H), lane, wave, G, bid); SEAM(pb + 6); }
            if (IN(pb + 7)) {
                PHASE_ROOTS();
                pg8::Gemm g{(const pg8::bf16_t*)(ws + WS_H), (const pg8::bf16_t*)(ws + WS_WGU), R_ALL, 2 * FFN, DM, 0, DM};
                pg8::StaticOrder S; S.init(R_ALL, 2 * FFN, G, bid);
                pg8::EpiSwiGLU E{(pg8::bf16_t*)(ws + WS_HID), FFN, 1.0f};
                pg8::gemm_phase<pg8::EpiSwiGLU, pg8::StaticOrder, true, true>(lds, g, S, E, tid);
                moe_conv_range(a, MOE_SL1, MOE_SL2, 1430 - 5 * 256, lds, lane, wave, G, bid);
                SEAM(pb + 7);
            }
            if (IN(pb + 8)) {
                PHASE_ROOTS();
                const float* modl = vec + VO_MOD + (l * 2 + 0) * 6144; const float* modc = vec + VO_MOD + (l * 2 + 1) * 6144;
                pg8::Gemm g{(const pg8::bf16_t*)(ws + WS_HID), (const pg8::bf16_t*)(ws + WS_WD), S_LAT, DM, FFN, 0, FFN};
                pg8::StaticOrder S; S.init(S_LAT, DM, G, bid);
                pg8::EpiResid E{a->out, a->out, modl + 5120, (const float*)(ws + WS_CTXR), (float*)(ws + WS_CTXR), modc + 5120, S_LAT / 256, DM};
                pg8::gemm_phase<pg8::EpiResid, pg8::StaticOrder, true, true>(lds, g, S, E, tid);
                {
                    pg8::Gemm g2{(const pg8::bf16_t*)(ws + WS_HID), (const pg8::bf16_t*)(ws + WS_WD), R_ALL, DM, 256, 0, FFN};
                    pg8::SplitKOrder S2{S_LAT / 256, 4, 11, 256, 44, bid, nullptr};
                    pg8::EpiAtomic E2{(float*)(ws + WS_CTXR), modc + 5120, S_LAT / 256, DM, 1.0f};
                    pg8::gemm_phase<pg8::EpiAtomic, pg8::SplitKOrder, false, true>(lds, g2, S2, E2, tid);
                }
                if (IN(pb + 8) && IN(pb + 11)) GRIDBAR();
            }
        } else {
            if (IN(pb + 6)) { PHASE_ROOTS(); phase_norm_route(a, lds, tid, lane, wave, G, bid); SEAM(pb + 6); }
            if (IN(pb + 7)) { PHASE_ROOTS(); moe_gather(a, lds, tid, lane, wave, G, bid); SEAM(pb + 7); }
            if (IN(pb + 8)) {
                PHASE_ROOTS();
                const int* mi = (const int*)(ws + WS_VEC) + VO_MOE; const int nt = __builtin_amdgcn_readfirstlane(mi[0]);
                pg8::Gemm g{(const pg8::bf16_t*)(ws + WS_AS), (const pg8::bf16_t*)(ws + WS_MGU), nt * 256, 2 * EXD, DM / 2, (size_t)2 * EXD * DM, DM / 2};
                pg8::MoeOrder S; S.init(nt * 256, 2 * EXD, G, bid); S.tile_e = mi + 16;
                pg8::EpiSwiGLU8 E{(unsigned char*)(ws + WS_HIDM), EXD, 1.0f / (F8_WSCALE * F8_ASCALE), F8_HSCALE};
                pg8::gemm_phase<pg8::EpiSwiGLU8, pg8::MoeOrder, true, true, true>(lds, g, S, E, tid);
                SEAM(pb + 8);
            }
            if (IN(pb + 9)) {
                PHASE_ROOTS();
                const int* mi = (const int*)(ws + WS_VEC) + VO_MOE; const int nt = __builtin_amdgcn_readfirstlane(mi[0]); const int nm = nt < 128 ? nt : 128;
                pg8::Gemm g{(const pg8::bf16_t*)(ws + WS_HIDM), (const pg8::bf16_t*)(ws + WS_MD), nm * 256, DM, EXD / 2, (size_t)DM * EXD, EXD / 2};
                pg8::MoeOrder S; S.init(nm * 256, DM, G, bid); S.tile_e = mi + 16;
                pg8::EpiScaleBf16 E{(pg8::bf16_t*)(ws + WS_Y), DM, 1.0f / (F8_WSCALE * F8_HSCALE)};
                pg8::gemm_phase<pg8::EpiScaleBf16, pg8::MoeOrder, true, true, true>(lds, g, S, E, tid);
                if (nt > 128) {
                    pg8::Gemm g2{(const pg8::bf16_t*)(ws + WS_HIDM), (const pg8::bf16_t*)(ws + WS_MD), nt * 256, DM, 256, (size_t)DM * EXD, EXD / 2};
                    pg8::SplitKOrder S2{128, 4, 7, 256, (nt - 128) * 28, bid, mi + 16};
                    pg8::EpiAtomic E2{(float*)(ws + WS_YF), nullptr, 128, DM, 1.0f / (F8_WSCALE * F8_HSCALE)};
                    pg8::gemm_phase<pg8::EpiAtomic, pg8::SplitKOrder, false, true, true>(lds, g2, S2, E2, tid);
                }
                SEAM(pb + 9);
            }
            if (IN(pb + 10)) { PHASE_ROOTS(); moe_combine(a, lane, wave, G, bid); }
        }
    }
__global__ void __launch_bounds__(NTHR, 2) fwd_kernel(Args a_unused) {
    extern __shared__ __attribute__((aligned(16))) unsigned char lds_raw[];
    LAS unsigned char* lds = (LAS unsigned char*)lds_raw;
    const int tid0 = threadIdx.x;
    const int wv0 = __builtin_amdgcn_readfirstlane(tid0 >> 6);
    for (int u = tid0; u < (LDS_BYTES - LDSCTL_OFF) / 4; u += NTHR) ((LAS unsigned*)(lds + LDSCTL_OFF))[u] = 0u;
    __syncthreads();
    const int lo = KARGS()->ph_lo, hi = KARGS()->ph_hi;
    const bool fusedl = (hi - lo) > 1;
    if (fusedl) (void)xcd_barrier_post((unsigned*)(KARGS()->ws + WS_CTL) + CW_BAR, (volatile LAS unsigned*)(lds + MISC_OFF) + 8);
    if (IN(0)) { PHASE_ROOTS(); p0_prologue(a, lds, tid, lane, wave, G, bid); SEAM(0); }

    layer_body<0>(lo, hi, lds, wv0);
    layer_body<1>(lo, hi, lds, wv0);
}

extern "C" void kernel_launch(void* const* d_in, const int* in_sizes, int n_in, void* d_out, int out_size, void* d_ws, size_t ws_size, hipStream_t stream) {
    static int grid = 0;
    if (grid == 0) {
        if (n_in != 23 || in_sizes[0] != S_LAT * DM || out_size != S_LAT * DM || ws_size < WS_END) { fprintf(stderr, "kernel_launch: unexpected shapes / workspace (n_in %d, ws %zu, need %zu)\n", n_in, ws_size, (size_t)WS_END); grid = -1; return; }
        int dev = 0, cus = 0;
        if (hipGetDevice(&dev) != hipSuccess || hipDeviceGetAttribute(&cus, hipDeviceAttributeMultiprocessorCount, dev) != hipSuccess) { grid = -1; return; }
        if (hipFuncSetAttribute((const void*)fwd_kernel, hipFuncAttributeMaxDynamicSharedMemorySize, LDS_BYTES) != hipSuccess) { grid = -1; return; }
        int per_cu = 0;
        (void)hipOccupancyMaxActiveBlocksPerMultiprocessor(&per_cu, (const void*)fwd_kernel, NTHR, LDS_BYTES);
        (void)hipGetLastError();
        grid = cus;
    }
    if (grid < 0) return;
    if (hipMemsetAsync((char*)d_ws + WS_CTL, 0, CTL_ZERO_BYTES, stream) != hipSuccess) return;
    Args a{};
    for (int i = 0; i < 23; ++i) a.in[i] = (const float*)d_in[i];
    a.out = (float*)d_out; a.ws = (unsigned char*)d_ws;
#if ONE_LAUNCH
    a.ph_lo = 0; a.ph_hi = NPH;
    hipLaunchKernelGGL(fwd_kernel, dim3(grid), dim3(NTHR), LDS_BYTES, stream, a);
#else
    for (int p = 0; p < NPH; ++p) {
        if (p == 10 || p == 11) continue;
        a.ph_lo = p; a.ph_hi = p + 1;
        hipLaunchKernelGGL(fwd_kernel, dim3(grid), dim3(NTHR), LDS_BYTES, stream, a);
    }
#endif
}
```

```cpp
#include <hip/hip_runtime.h>
#include <cstdio>
#include <cstdint>
#include <cmath>
#ifndef ONE_LAUNCH
#define ONE_LAUNCH 1
#endif
namespace pg8 {
#define PG8_LAS __attribute__((address_space(3)))
typedef unsigned short bf16_t;
typedef short bf16x8 __attribute__((ext_vector_type(8)));
typedef float f32x4 __attribute__((ext_vector_type(4)));
typedef unsigned u32x4 __attribute__((ext_vector_type(4)));
constexpr int BM = 256, BK = 64, HALF = 128, HTB = HALF * BK * 2  , STAGE_BYTES = 8 * HTB, NXCD = 8, WGM = 8;

__host__ __device__ __forceinline__ int lds_byte(int r, int c) { const int st = (r >> 4) * 2 + (c >> 5), rr = r & 15, cc = c & 31, ob = rr * 64 + cc * 2; return st * 1024 + (ob ^ (((ob >> 9) & 1) << 5)); }
__host__ __device__ __forceinline__ void stage_rc(int b, int& R, int& C) { const int st = b / 1024, sb = b % 1024, swz = sb ^ (((sb >> 9) & 1) << 5); R = (st >> 1) * 16 + swz / 64; C = (st & 1) * 32 + (swz % 64) / 2; }
__host__ __device__ __forceinline__ int perm32(int rho) { const int n = rho >> 4, i = rho & 15; return 8 * (i >> 2) + 4 * n + (i & 3); }

struct Unit { int pm, pn, eb, ko; };
struct Gemm { const bf16_t* A; const bf16_t* Bt; int M, N, K; size_t bstride; int ld; };

struct StaticOrder {
    int nM, nN, nwg, G, c;
    __host__ __device__ void init(int M, int N, int G_, int c_) { nM = M / BM; nN = N / BM; nwg = nM * nN; G = G_; c = c_; }
    __host__ __device__ bool next(int i, Unit& u) const {
        const long L = (long)i * G + c; if (L >= nwg) return false;
        int wgid = (int)L; { const int q = nwg / NXCD, r = nwg % NXCD, xcd = wgid % NXCD, off = wgid / NXCD; wgid = (xcd < r ? xcd * (q + 1) : r * (q + 1) + (xcd - r) * q) + off; }
        const int nig = WGM * nN, gid = wgid / nig, fm = gid * WGM, gsz = (nM - fm) < WGM ? (nM - fm) : WGM;
        u.pm = fm + ((wgid % nig) % gsz); u.pn = (wgid % nig) / gsz; u.eb = 0; u.ko = 0; return true;
    }
    __device__ __forceinline__ void a_ready(const Unit&) const {}
    __device__ __forceinline__ void done(const Unit&) const {}
};

__device__ __forceinline__ unsigned cvt_pk_bf16(float lo, float hi) { unsigned r; asm volatile("v_cvt_pk_bf16_f32 %0, %1, %2" : "=v"(r) : "v"(lo), "v"(hi)); return r; }
typedef float f32x2 __attribute__((ext_vector_type(2)));
__device__ __forceinline__ f32x2 gelu_pk(f32x2 v) {
    const f32x2 av = __builtin_elementwise_abs(v), d = av * 0.2316418882f + 1.0f;
    f32x2 t; t.x = __builtin_amdgcn_rcpf(d.x); t.y = __builtin_amdgcn_rcpf(d.y);
    f32x2 q = t * 0.5307027145f + (-0.7265760135f); q = q * t + 0.7107068705f; q = q * t + (-0.142248368f); q = q * t + 0.127414796f; q = q * t;
    const f32x2 s = (v * v) * (-0.72134752044f);
    f32x2 e; e.x = __builtin_amdgcn_exp2f(s.x); e.y = __builtin_amdgcn_exp2f(s.y);
    const f32x2 m = v * (q * e), r = v - m;
    f32x2 o; o.x = v.x < 0.f ? m.x : r.x; o.y = v.y < 0.f ? m.y : r.y; return o;
}

template <int ACT  > struct EpiBf16 {
    static constexpr bool PERM = true, AFTER_DRAIN = false; static_assert(ACT == 0 || ACT == 1, "EpiBf16: ACT is 0 (none) or 1 (gelu_pk)");
    bf16_t* O; int ldc; const float* bias; int split_cols; size_t split_stride; float scale0;
    __device__ __forceinline__ void operator()(const f32x4 (&acc)[2][2][4][2], const Unit& u, int wr, int wc, int fr, int fq) const {
        const int row0 = u.pm * BM + wr * 64 + fr; int colt = u.pn * BM; bf16_t* base = O;
        float sc = 1.f; if (split_cols) { const int t = colt / split_cols; base += (size_t)t * split_stride; colt -= t * split_cols; if (t == 0) sc = scale0; }
        const int col0 = colt + wc * 32 + 8 * fq, bcol0 = u.pn * BM + wc * 32 + 8 * fq;
        f32x4 bv[2][2];
#pragma unroll
        for (int bj = 0; bj < 2; ++bj)
#pragma unroll
            for (int n = 0; n < 2; ++n) bv[bj][n] = bias ? *(const f32x4*)(bias + bcol0 + bj * HALF + 4 * n) : (f32x4){0.f, 0.f, 0.f, 0.f};
#pragma unroll
        for (int ai = 0; ai < 2; ++ai)
#pragma unroll
            for (int m = 0; m < 4; ++m) { bf16_t* rowp = base + (size_t)(row0 + ai * HALF + m * 16) * ldc + col0;
#pragma unroll
                for (int bj = 0; bj < 2; ++bj) { f32x4 v0 = acc[ai][bj][m][0] + bv[bj][0], v1 = acc[ai][bj][m][1] + bv[bj][1];
                    if (ACT == 1) { f32x2 a = gelu_pk((f32x2){v0[0], v0[1]}), b = gelu_pk((f32x2){v0[2], v0[3]}), c = gelu_pk((f32x2){v1[0], v1[1]}), d = gelu_pk((f32x2){v1[2], v1[3]});
                        v0 = (f32x4){a.x, a.y, b.x, b.y}; v1 = (f32x4){c.x, c.y, d.x, d.y}; }
                    v0 = v0 * sc; v1 = v1 * sc; u32x4 w; w.x = cvt_pk_bf16(v0[0], v0[1]); w.y = cvt_pk_bf16(v0[2], v0[3]); w.z = cvt_pk_bf16(v1[0], v1[1]); w.w = cvt_pk_bf16(v1[2], v1[3]);
                    *(u32x4*)(rowp + bj * HALF) = w; } }
    }
};

__device__ __forceinline__ float silu_f(float x) { return x * __builtin_amdgcn_rcpf(1.0f + __builtin_amdgcn_exp2f(-1.4426950408889634f * x)); }
struct EpiResid {
    static constexpr bool PERM = false, AFTER_DRAIN = false;
    const float* base; float* out; const float* gate; const float* cbase; float* cout; const float* cgate; int mlat; int ldc;
    __device__ __forceinline__ void operator()(const f32x4 (&acc)[2][2][4][2], const Unit& u, int wr, int wc, int fr, int fq) const {
        const bool isc = u.pm >= mlat;
        const float* b = isc ? cbase : base; float* o = isc ? cout : out; const float* g = isc ? cgate : gate;
        const int row0 = (isc ? (u.pm - mlat) : u.pm) * BM + wr * 64 + fr, col0 = u.pn * BM + wc * 32 + 4 * fq;
        f32x4 gv[2][2];
#pragma unroll
        for (int bj = 0; bj < 2; ++bj)
#pragma unroll
            for (int n = 0; n < 2; ++n) gv[bj][n] = *(const f32x4*)(g + col0 + bj * HALF + n * 16);
#pragma unroll
        for (int ai = 0; ai < 2; ++ai)
#pragma unroll
            for (int m = 0; m < 4; ++m) { const size_t off = (size_t)(row0 + ai * HALF + m * 16) * ldc + col0;
#pragma unroll
                for (int bj = 0; bj < 2; ++bj)
#pragma unroll
                    for (int n = 0; n < 2; ++n) { const f32x4 bs = *(const f32x4*)(b + off + bj * HALF + n * 16); *(f32x4*)(o + off + bj * HALF + n * 16) = bs + gv[bj][n] * acc[ai][bj][m][n]; }
                if (m & 1) asm volatile("" ::: "memory"); }
    }
};
struct EpiSwiGLU {
    static constexpr bool PERM = true, AFTER_DRAIN = false;
    bf16_t* O; int ldc; float ds;
    __device__ __forceinline__ void operator()(const f32x4 (&acc)[2][2][4][2], const Unit& u, int wr, int wc, int fr, int fq) const {
        const int row0 = u.pm * BM + wr * 64 + fr, col0 = u.pn * HALF + wc * 32 + 8 * fq;
#pragma unroll
        for (int ai = 0; ai < 2; ++ai)
#pragma unroll
            for (int m = 0; m < 4; ++m) { bf16_t* rowp = O + (size_t)(row0 + ai * HALF + m * 16) * ldc + col0;
                const f32x4 g0 = acc[ai][0][m][0] * ds, g1 = acc[ai][0][m][1] * ds, u0 = acc[ai][1][m][0] * ds, u1 = acc[ai][1][m][1] * ds;
                f32x4 h0, h1;
#pragma unroll
                for (int j = 0; j < 4; ++j) { h0[j] = silu_f(g0[j]) * u0[j]; h1[j] = silu_f(g1[j]) * u1[j]; }
                u32x4 w; w.x = cvt_pk_bf16(h0[0], h0[1]); w.y = cvt_pk_bf16(h0[2], h0[3]); w.z = cvt_pk_bf16(h1[0], h1[1]); w.w = cvt_pk_bf16(h1[2], h1[3]);
                *(u32x4*)rowp = w; }
    }
};
struct MoeOrder : StaticOrder {
    const int* tile_e;
    __device__ __forceinline__ bool next(int i, Unit& u) const { if (!StaticOrder::next(i, u)) return false; u.eb = __builtin_amdgcn_readfirstlane(tile_e[u.pm]); return true; }
};

struct SplitKOrder {
    int pm0, nN, P, kp, total, c; const int* tile_e;
    __device__ __forceinline__ bool next(int i, Unit& u) const {
        if (i != 0 || c >= total) return false;
        const int p = c % P, t = c / P; u.pn = t % nN; u.pm = pm0 + t / nN; u.ko = p * kp; u.eb = tile_e ? __builtin_amdgcn_readfirstlane(tile_e[u.pm]) : 0; return true; }
    __device__ __forceinline__ void a_ready(const Unit&) const {}
    __device__ __forceinline__ void done(const Unit&) const {}
};
struct EpiAtomic {
    static constexpr bool PERM = false, AFTER_DRAIN = true;
    float* out; const float* scale; int pm_sub; int ldc; float ds;
    __device__ __forceinline__ void fused(f32x4 (&acc)[2][2][4][2], const Unit& u, int wr, int wc, int fr, int fq, PG8_LAS unsigned char* lds, int wid, int lane) const {
        PG8_LAS float* scr = (PG8_LAS float*)(lds + wid * 16384);
        const int rr = lane >> 5, cc = lane & 31;
#pragma unroll
        for (int ai = 0; ai < 2; ++ai)
#pragma unroll
            for (int bj = 0; bj < 2; ++bj) {
#pragma unroll
                for (int m = 0; m < 4; ++m)
#pragma unroll
                    for (int n = 0; n < 2; ++n) *(PG8_LAS f32x4*)(scr + (m * 16 + fr) * 36 + n * 16 + 4 * fq) = acc[ai][bj][m][n];
                asm volatile("s_waitcnt lgkmcnt(0)" ::: "memory");
                const int colg = u.pn * BM + bj * HALF + wc * 32 + cc; const float sc = (scale ? scale[colg] : 1.0f) * ds;
                float* op = out + (size_t)((u.pm - pm_sub) * BM + ai * HALF + wr * 64 + rr) * ldc + colg;
#pragma unroll 8
                for (int i = 0; i < 32; ++i) { const float v = scr[(2 * i + rr) * 36 + cc]; __hip_atomic_fetch_add(op + (size_t)(2 * i) * ldc, v * sc, __ATOMIC_RELAXED, __HIP_MEMORY_SCOPE_AGENT); }
                asm volatile("s_waitcnt lgkmcnt(0)" ::: "memory");
            }
    }
};

typedef int i32x4v __attribute__((ext_vector_type(4))); typedef int i32x8v __attribute__((ext_vector_type(8)));
struct FragB { bf16x8 k[2]; };
struct Frag8 { i32x8v v; };
template <bool F8> struct FragSel { typedef FragB type; };
template <> struct FragSel<true> { typedef Frag8 type; };
__device__ __forceinline__ void ld_frag(FragB& f, const PG8_LAS unsigned char* p) { f.k[0] = *(const PG8_LAS bf16x8*)p; f.k[1] = *(const PG8_LAS bf16x8*)(p + 1024); }
__device__ __forceinline__ void ld_frag(Frag8& f, const PG8_LAS unsigned char* p) { const i32x4v lo = *(const PG8_LAS i32x4v*)p, hi = *(const PG8_LAS i32x4v*)(p + 1024); f.v = __builtin_shufflevector(lo, hi, 0, 1, 2, 3, 4, 5, 6, 7); }
__device__ __forceinline__ f32x4 mma_frag(const FragB& b, const FragB& a, f32x4 c) { c = __builtin_amdgcn_mfma_f32_16x16x32_bf16(b.k[0], a.k[0], c, 0, 0, 0); return __builtin_amdgcn_mfma_f32_16x16x32_bf16(b.k[1], a.k[1], c, 0, 0, 0); }
__device__ __forceinline__ f32x4 mma_frag(const Frag8& b, const Frag8& a, f32x4 c) {
    asm volatile("v_mfma_scale_f32_16x16x128_f8f6f4 %0, %1, %2, %0, %3, %3 op_sel_hi:[0,0,0]" : "+v"(c) : "v"(b.v), "v"(a.v), "v"(0x7f7f7f7f));
    return c;
}

struct EpiSwiGLU8 {
    static constexpr bool PERM = true, AFTER_DRAIN = false;
    unsigned char* O; int ldc; float ds, hs;
    __device__ __forceinline__ void operator()(const f32x4 (&acc)[2][2][4][2], const Unit& u, int wr, int wc, int fr, int fq) const {
        const int row0 = u.pm * BM + wr * 64 + fr, col0 = u.pn * HALF + wc * 32 + 8 * fq;
#pragma unroll
        for (int ai = 0; ai < 2; ++ai)
#pragma unroll
            for (int m = 0; m < 4; ++m) { unsigned char* rowp = O + (size_t)(row0 + ai * HALF + m * 16) * ldc + col0;
                const f32x4 g0 = acc[ai][0][m][0] * ds, g1 = acc[ai][0][m][1] * ds, u0 = acc[ai][1][m][0] * ds, u1 = acc[ai][1][m][1] * ds;
                float h[8];
#pragma unroll
                for (int j = 0; j < 4; ++j) { h[j] = fminf(fmaxf(silu_f(g0[j]) * u0[j] * hs, -448.0f), 448.0f); h[4 + j] = fminf(fmaxf(silu_f(g1[j]) * u1[j] * hs, -448.0f), 448.0f); }
                unsigned lo = 0u, hi = 0u;
                lo = __builtin_amdgcn_cvt_pk_fp8_f32(h[0], h[1], lo, false); lo = __builtin_amdgcn_cvt_pk_fp8_f32(h[2], h[3], lo, true);
                hi = __builtin_amdgcn_cvt_pk_fp8_f32(h[4], h[5], hi, false); hi = __builtin_amdgcn_cvt_pk_fp8_f32(h[6], h[7], hi, true);
                typedef unsigned u32x2 __attribute__((ext_vector_type(2)));
                *(u32x2*)rowp = (u32x2){lo, hi}; }
    }
};
struct EpiScaleBf16 {
    static constexpr bool PERM = true, AFTER_DRAIN = false;
    bf16_t* O; int ldc; float ds;
    __device__ __forceinline__ void operator()(const f32x4 (&acc)[2][2][4][2], const Unit& u, int wr, int wc, int fr, int fq) const {
        const int row0 = u.pm * BM + wr * 64 + fr, col0 = u.pn * BM + wc * 32 + 8 * fq;
#pragma unroll
        for (int ai = 0; ai < 2; ++ai)
#pragma unroll
            for (int m = 0; m < 4; ++m) { bf16_t* rowp = O + (size_t)(row0 + ai * HALF + m * 16) * ldc + col0;
#pragma unroll
                for (int bj = 0; bj < 2; ++bj) { const f32x4 v0 = acc[ai][bj][m][0] * ds, v1 = acc[ai][bj][m][1] * ds;
                    u32x4 w; w.x = cvt_pk_bf16(v0[0], v0[1]); w.y = cvt_pk_bf16(v0[2], v0[3]); w.z = cvt_pk_bf16(v1[0], v1[1]); w.w = cvt_pk_bf16(v1[2], v1[3]);
                    *(u32x4*)(rowp + bj * HALF) = w; } }
    }
};

template <class Epi, class Sched, bool ALIGN_EPI = false, bool SP2 = false, bool F8 = false>
__device__ __forceinline__ void gemm_phase(PG8_LAS unsigned char* lds, const Gemm g, const Sched& S, const Epi& E, int tid_in) {
    int tid_ = tid_in; asm volatile("" : "+v"(tid_));
    const int tid = tid_, wid = __builtin_amdgcn_readfirstlane(tid >> 6), lane = tid & 63, wr = wid >> 2, wc = wid & 3, fr = lane & 15, fq = lane >> 4;
    const int K = g.K, nt = K / BK, ld = g.ld;
    unsigned voffA[2], voffB[2];
#pragma unroll
    for (int i = 0; i < 2; ++i) { int R, C; stage_rc(tid * 16 + i * 8192, R, C); const int Rb = Epi::PERM ? ((R & ~31) + perm32(R & 31)) : R;
        voffA[i] = (unsigned)(R * ld + C) * 2u; voffB[i] = (unsigned)(Rb * ld + C) * 2u; }
    const size_t kstep = (size_t)(BK * 2);
    const size_t hstep = (size_t)HALF * ld * 2;
    const size_t tstep = 2 * hstep;
    const unsigned ldsw = (unsigned)wid * 1024u;
    const int aoff = lds_byte(wr * 64 + fr, fq * 8), boff = lds_byte(wc * 32 + fr, fq * 8);
#define PG8_SA(b, h) (((b) * 2 + (h)) * HTB)
#define PG8_SB(b, h) ((4 + (b) * 2 + (h)) * HTB)
#define PG8_STAGE(bufoff, gbase, voff) do { _Pragma("unroll") for (int _i = 0; _i < 2; ++_i) \
        __builtin_amdgcn_global_load_lds((const unsigned*)((const char*)(gbase) + (voff)[_i]), (PG8_LAS unsigned*)(lds + (bufoff) + ldsw + _i * 8192), 16, 0, 0); } while (0)
#define PG8_LDA(dst, b, h) do { _Pragma("unroll") for (int m = 0; m < 4; ++m) ld_frag(dst[m], lds + PG8_SA(b, h) + aoff + m * 2048); } while (0)
#define PG8_LDB(dst, b, h) do { _Pragma("unroll") for (int n = 0; n < 2; ++n) ld_frag(dst[n], lds + PG8_SB(b, h) + boff + n * 2048); } while (0)
#define PG8_MMA(ai, bj, At, Bt) do { __builtin_amdgcn_s_setprio(1); _Pragma("unroll") for (int m = 0; m < 4; ++m) _Pragma("unroll") for (int n = 0; n < 2; ++n) \
        acc[ai][bj][m][n] = mma_frag(Bt[n], At[m], acc[ai][bj][m][n]); __builtin_amdgcn_s_setprio(0); } while (0)
#define PG8_WAIT_V(n) asm volatile("s_waitcnt vmcnt(" #n ")" ::: "memory")
#define PG8_WAIT_L(n) asm volatile("s_waitcnt lgkmcnt(" #n ")" ::: "memory")
#define PG8_BAR __builtin_amdgcn_s_barrier()
#define PG8_SCHED __builtin_amdgcn_sched_barrier(0)
    Unit cur, nxt; int ui = 0;
    if (!S.next(0, cur)) return;
    float zacc = 0.f; asm volatile("" : "+v"(zacc));
    f32x4 acc[2][2][4][2];
#pragma unroll
    for (int a = 0; a < 2; ++a)
#pragma unroll
        for (int b = 0; b < 2; ++b)
#pragma unroll
            for (int m = 0; m < 4; ++m)
#pragma unroll
                for (int n = 0; n < 2; ++n) acc[a][b][m][n] = (f32x4){zacc, zacc, zacc, zacc};
    typedef typename FragSel<F8>::type Frag;
    Frag At[4], B0[2], B1[2];
    const char* cA = (const char*)g.A + (size_t)cur.pm * tstep + (size_t)cur.ko * 2; const char* cB = (const char*)g.Bt + (size_t)cur.eb * g.bstride + (size_t)cur.pn * tstep + (size_t)cur.ko * 2;
    S.a_ready(cur);
    if constexpr (SP2) {
        PG8_STAGE(PG8_SB(0, 0), cB, voffB); PG8_STAGE(PG8_SB(0, 1), cB + hstep, voffB); PG8_STAGE(PG8_SA(0, 0), cA, voffA); PG8_STAGE(PG8_SA(0, 1), cA + hstep, voffA);
        if (wr == 1) PG8_BAR;
        PG8_WAIT_V(2); PG8_BAR;
        PG8_STAGE(PG8_SB(1, 0), cB + kstep, voffB); PG8_STAGE(PG8_SA(1, 0), cA + kstep, voffA); PG8_STAGE(PG8_SB(1, 1), cB + hstep + kstep, voffB);
        PG8_WAIT_V(6); PG8_BAR;
    } else {
        PG8_STAGE(PG8_SB(0, 0), cB, voffB); PG8_STAGE(PG8_SA(0, 0), cA, voffA); PG8_STAGE(PG8_SB(0, 1), cB + hstep, voffB); PG8_STAGE(PG8_SA(0, 1), cA + hstep, voffA);
        if (wr == 1) PG8_BAR;
        PG8_WAIT_V(4); PG8_BAR;
        PG8_STAGE(PG8_SB(1, 0), cB + kstep, voffB); PG8_STAGE(PG8_SA(1, 0), cA + kstep, voffA); PG8_STAGE(PG8_SB(1, 1), cB + hstep + kstep, voffB);
        PG8_WAIT_V(6); PG8_BAR;
    }
    for (;;) {
        const bool has_next = S.next(ui + 1, nxt);
        const char* nA = has_next ? (const char*)g.A + (size_t)nxt.pm * tstep + (size_t)nxt.ko * 2 : cA; const char* nB = has_next ? (const char*)g.Bt + (size_t)nxt.eb * g.bstride + (size_t)nxt.pn * tstep + (size_t)nxt.ko * 2 : cB;
        for (int t = 0; t < nt; t += 2) {
            const bool last = (t == nt - 2);
            const char* a1 = cA + (size_t)(t + 1) * kstep;
            const char* a2 = last ? nA : cA + (size_t)(t + 2) * kstep; const char* b2 = last ? nB : cB + (size_t)(t + 2) * kstep;
            const char* a3 = a2 + kstep; const char* b3 = b2 + kstep;
            if (last && has_next) S.a_ready(nxt);
            if constexpr (SP2) {
            PG8_LDB(B0, 0, 0); PG8_LDB(B1, 0, 1); PG8_SCHED; PG8_LDA(At, 0, 0); PG8_STAGE(PG8_SA(1, 1), a1 + hstep, voffA);
            PG8_WAIT_V(8); PG8_WAIT_L(0); PG8_BAR; PG8_MMA(0, 0, At, B0); PG8_MMA(0, 1, At, B1); PG8_BAR; PG8_SCHED;
            PG8_LDA(At, 0, 1); PG8_STAGE(PG8_SB(0, 0), b2, voffB); PG8_STAGE(PG8_SB(0, 1), b2 + hstep, voffB); PG8_STAGE(PG8_SA(0, 0), a2, voffA);
            PG8_WAIT_V(8); PG8_WAIT_L(0); PG8_BAR; PG8_MMA(1, 0, At, B0); PG8_MMA(1, 1, At, B1); PG8_BAR; PG8_SCHED;
            PG8_LDB(B0, 1, 0); PG8_LDB(B1, 1, 1); PG8_SCHED; PG8_LDA(At, 1, 0); PG8_STAGE(PG8_SA(0, 1), a2 + hstep, voffA);
            PG8_WAIT_V(8); PG8_WAIT_L(0); PG8_BAR; PG8_MMA(0, 0, At, B0); PG8_MMA(0, 1, At, B1); PG8_BAR; PG8_SCHED;
            PG8_LDA(At, 1, 1); PG8_STAGE(PG8_SB(1, 0), b3, voffB); PG8_STAGE(PG8_SB(1, 1), b3 + hstep, voffB); PG8_STAGE(PG8_SA(1, 0), a3, voffA);
            PG8_WAIT_V(8); PG8_WAIT_L(0); PG8_BAR; PG8_MMA(1, 0, At, B0); PG8_MMA(1, 1, At, B1); PG8_BAR; PG8_SCHED;
            } else {
            PG8_LDB(B0, 0, 0); PG8_SCHED; PG8_LDA(At, 0, 0); PG8_STAGE(PG8_SA(1, 1), a1 + hstep, voffA);
            PG8_WAIT_L(8); PG8_BAR; PG8_WAIT_L(0); PG8_MMA(0, 0, At, B0); PG8_BAR; PG8_SCHED;
            PG8_LDB(B1, 0, 1); PG8_STAGE(PG8_SB(0, 0), b2, voffB);
            PG8_BAR; PG8_WAIT_L(0); PG8_MMA(0, 1, At, B1); PG8_BAR;
            PG8_LDA(At, 0, 1); PG8_STAGE(PG8_SA(0, 0), a2, voffA);
            PG8_BAR; PG8_WAIT_L(0); PG8_MMA(1, 0, At, B0); PG8_BAR; PG8_SCHED;
            PG8_STAGE(PG8_SB(0, 1), b2 + hstep, voffB);
            PG8_WAIT_V(6); PG8_BAR; PG8_MMA(1, 1, At, B1); PG8_BAR;
            PG8_LDB(B0, 1, 0); PG8_SCHED; PG8_LDA(At, 1, 0); PG8_STAGE(PG8_SA(0, 1), a2 + hstep, voffA);
            PG8_WAIT_L(8); PG8_BAR; PG8_WAIT_L(0); PG8_MMA(0, 0, At, B0); PG8_BAR; PG8_SCHED;
            PG8_LDB(B1, 1, 1); PG8_STAGE(PG8_SB(1, 0), b3, voffB);
            PG8_BAR; PG8_WAIT_L(0); PG8_MMA(0, 1, At, B1); PG8_BAR;
            PG8_LDA(At, 1, 1); PG8_STAGE(PG8_SA(1, 0), a3, voffA);
            PG8_BAR; PG8_WAIT_L(0); PG8_MMA(1, 0, At, B0); PG8_BAR; PG8_SCHED;
            PG8_STAGE(PG8_SB(1, 1), b3 + hstep, voffB);
            PG8_WAIT_V(6); PG8_BAR; PG8_MMA(1, 1, At, B1); PG8_BAR;
            }
        }
        if constexpr (ALIGN_EPI) { if (wr == 0) PG8_BAR; }
        if constexpr (F8) {
            asm volatile("s_nop 15\n\ts_nop 15" : "+v"(acc[1][1][0][0]), "+v"(acc[1][1][0][1]), "+v"(acc[1][1][1][0]), "+v"(acc[1][1][1][1]), "+v"(acc[1][1][2][0]), "+v"(acc[1][1][2][1]), "+v"(acc[1][1][3][0]), "+v"(acc[1][1][3][1])); }
        if constexpr (!Epi::AFTER_DRAIN) { E(acc, cur, wr, wc, fr, fq); S.done(cur); }
        if (!has_next) break;
#pragma unroll
        for (int a = 0; a < 2; ++a)
#pragma unroll
            for (int b = 0; b < 2; ++b)
#pragma unroll
                for (int m = 0; m < 4; ++m)
#pragma unroll
                    for (int n = 0; n < 2; ++n) acc[a][b][m][n] = (f32x4){zacc, zacc, zacc, zacc};
        cur = nxt; cA = nA; cB = nB; ++ui;
        if constexpr (ALIGN_EPI) { if (wr == 1) PG8_BAR; }
    }
    PG8_WAIT_V(0);
    if constexpr (!ALIGN_EPI) { if (wr == 0) PG8_BAR; }
    PG8_BAR;
    if constexpr (Epi::AFTER_DRAIN) { E.fused(acc, cur, wr, wc, fr, fq, lds, wid, lane); S.done(cur); }
#undef PG8_SA
#undef PG8_SB
#undef PG8_STAGE
#undef PG8_LDA
#undef PG8_LDB
#undef PG8_MMA
#undef PG8_WAIT_V
#undef PG8_WAIT_L
#undef PG8_BAR
#undef PG8_SCHED
}
}


constexpr int S_LAT = 16384, C_CTX = 256, R_ALL = S_LAT + C_CTX, DM = 1024;
constexpr int INW = 2560, FFN = 2816, EXD = 3584, NEXP = 8;
constexpr int COL_AQ = 0, COL_AK = 512, COL_AV = 640, COL_HQ = 768, COL_HFF = 1024, COL_HFB = 1280, COL_HI = 1536, COL_HG = 1792, COL_GU = 2048, COL_GV = 2304;
constexpr int MIX_AT = 0, MIX_HG = 512, MIX_GM = 768;
constexpr int MOE_MAXROWS = 34816;
constexpr float EPS = 1e-6f;
constexpr int NWAVES = 8, NTHR = 512;
constexpr int NPH = 23;

constexpr size_t MiB = 1u << 20;
constexpr size_t WS_CTL = 0, CTL_ZERO_BYTES = 1 * MiB;
constexpr size_t WS_VEC = 1 * MiB;
constexpr size_t WS_TOK = 2 * MiB;
constexpr size_t WS_WIN = 3 * MiB;
constexpr size_t WS_WOUT = 13 * MiB;
constexpr size_t WS_WGU = 17 * MiB;
constexpr size_t WS_WD = 28 * MiB;
constexpr size_t WS_MGU = 34 * MiB;
constexpr size_t WS_MD = 146 * MiB;
constexpr size_t WS_H = 202 * MiB;
constexpr size_t WS_PROJ = 235 * MiB;
constexpr size_t WS_MIX = 317 * MiB;
constexpr size_t WS_HGO = 350 * MiB;
constexpr size_t WS_CTXR = 383 * MiB;
constexpr size_t WS_HLT = WS_HGO;
constexpr size_t WS_HSP = 384 * MiB;
constexpr size_t WS_HDG = 402 * MiB;
constexpr size_t WS_VT = 403 * MiB;
constexpr size_t WS_HID = WS_PROJ;
constexpr size_t WS_AS = 202 * MiB;
constexpr size_t WS_HIDM = 270 * MiB;
constexpr size_t WS_H2B = 440 * MiB;
constexpr size_t WS_YF = WS_WIN;
constexpr size_t WS_Y = WS_MGU;
constexpr size_t WS_END = 508 * MiB;
static_assert(WS_HID + (size_t)R_ALL * FFN * 2 <= WS_HGO && WS_AS + (size_t)MOE_MAXROWS * DM * 2 <= WS_HIDM && WS_HIDM + (size_t)MOE_MAXROWS * EXD * 2 <= WS_END, "ws map");
static_assert(WS_H2B >= WS_HIDM && WS_H2B + (size_t)S_LAT * DM * 2 <= WS_END && WS_H + (size_t)R_ALL * DM * 2 <= WS_PROJ && WS_PROJ + (size_t)R_ALL * INW * 2 <= WS_MIX && WS_MIX + (size_t)R_ALL * DM * 2 <= WS_HGO && WS_HGO + (size_t)2 * R_ALL * 256 * 4 <= WS_CTXR, "ws map 2");
constexpr int VO_MOD = 0;
constexpr int VO_ROPE = 32768;
constexpr int VO_MOE = 65536;
constexpr int CW_BAR = 4096;
constexpr int CW_QUEUE = 2048;
constexpr int CW_MOECNT = 1024;

constexpr int RING_BYTES = 131072;
constexpr int LDSCTL_OFF = 159744, MISC_OFF = LDSCTL_OFF + 320;
constexpr int LDS_BYTES = 163840;

#define GAS __attribute__((address_space(1)))
#define LAS __attribute__((address_space(3)))
typedef unsigned short bf16;
typedef unsigned v4u __attribute__((ext_vector_type(4)));
typedef unsigned v2u __attribute__((ext_vector_type(2)));
typedef float f32x4 __attribute__((ext_vector_type(4)));
typedef GAS unsigned gu32;
#define RLX_AGENT __ATOMIC_RELAXED, __HIP_MEMORY_SCOPE_AGENT
#define LDS_WAIT() asm volatile("s_waitcnt lgkmcnt(0)" ::: "memory")
typedef float f32x2_t __attribute__((ext_vector_type(2))); typedef __bf16 bf16x2_t __attribute__((ext_vector_type(2)));
__device__ __forceinline__ unsigned pk2(float lo, float hi) { const f32x2_t v = {lo, hi}; const bf16x2_t b = __builtin_convertvector(v, bf16x2_t); return __builtin_bit_cast(unsigned, b); }
__device__ __forceinline__ unsigned f2bf(float f) { return pk2(f, 0.f) & 0xffffu; }
__device__ __forceinline__ float bflo(unsigned w) { return __builtin_bit_cast(float, w << 16); }
__device__ __forceinline__ float bfhi(unsigned w) { return __builtin_bit_cast(float, w & 0xffff0000u); }
__device__ __forceinline__ float sigm1(float x) { return __builtin_amdgcn_rcpf(1.0f + __builtin_amdgcn_exp2f(-1.4426950408889634f * x)); }
__device__ __forceinline__ float silu1(float x) { return x * sigm1(x); }
__device__ __forceinline__ float gelu1(float x) { return 0.5f * x * (1.0f + erff(x * 0.70710678118654752f)); }
template <int X> __device__ __forceinline__ float sx(float v) { return __shfl_xor(v, X); }
__device__ __forceinline__ float sx32_add(float v) { return v + __shfl_xor(v, 32); }
__device__ __forceinline__ float sx32_max(float v) { return fmaxf(v, __shfl_xor(v, 32)); }
__device__ __forceinline__ float wave_sum(float v) { v += sx<1>(v); v += sx<2>(v); v += sx<4>(v); v += sx<8>(v); v += sx<16>(v); return sx32_add(v); }
__device__ __forceinline__ void unpack8(const v4u w, float* f) { f[0] = bflo(w.x); f[1] = bfhi(w.x); f[2] = bflo(w.y); f[3] = bfhi(w.y); f[4] = bflo(w.z); f[5] = bfhi(w.z); f[6] = bflo(w.w); f[7] = bfhi(w.w); }


__device__ __forceinline__ float clamp448(float x) { return fminf(fmaxf(x, -448.0f), 448.0f); }
__device__ __forceinline__ unsigned pk4_fp8(float a, float b, float c, float d) {
    unsigned w = 0u; w = __builtin_amdgcn_cvt_pk_fp8_f32(clamp448(a), clamp448(b), w, false); w = __builtin_amdgcn_cvt_pk_fp8_f32(clamp448(c), clamp448(d), w, true); return w; }
constexpr float F8_WSCALE = 128.0f;
constexpr float F8_ASCALE = 16.0f;
constexpr float F8_HSCALE = 8.0f;
#define XB_TMO      128
#define XB_XCNT(j)  (256  + 64 * (j))
#define XB_XSUB(j)  (1280 + 64 * (j))
#define XB_XGEN(j)  (2304 + 64 * (j))
#define XB_TOP      3328
#define XB_TOPGEN   3392
#define XCD_BAR_WORDS 3456
#define XB_SPIN_CAP (1u << 18)

__device__ __forceinline__ unsigned xb_ld(unsigned* p)              { return __hip_atomic_load(p, __ATOMIC_RELAXED, __HIP_MEMORY_SCOPE_AGENT); }
__device__ __forceinline__ unsigned xb_add(unsigned* p, unsigned v) { return __hip_atomic_fetch_add(p, v, __ATOMIC_RELAXED, __HIP_MEMORY_SCOPE_AGENT); }
__device__ __forceinline__ unsigned xb_xcc_id() { return (unsigned)__builtin_amdgcn_s_getreg((3 << 11) | 20) & 0xFu; }
#define XB_SPIN(cond, bar) do { unsigned _sp = 0; while (cond) { __builtin_amdgcn_s_sleep(1); \
    if ((++_sp & 255u) == 0u) { if (xb_ld(&(bar)[XB_TMO])) break; if (_sp > XB_SPIN_CAP) { atomicAdd(&(bar)[XB_TMO], 1u); break; } } } } while (0)

struct XcdBarrier {
    unsigned* bar; unsigned x;
    volatile LAS unsigned* st;
};

__device__ __forceinline__ XcdBarrier xcd_barrier_post(unsigned* bar, volatile LAS unsigned* st) {
    XcdBarrier b; b.bar = bar; b.x = xb_xcc_id(); b.st = st;
    if (threadIdx.x == 0) (void)xb_add(&bar[XB_XCNT(b.x)], 1u);
    return b;
}
__device__ __forceinline__ void xcd_barrier_complete(unsigned* bar, unsigned x, unsigned& nloc, unsigned& nx) {
    const unsigned G = gridDim.x * gridDim.y * gridDim.z;
    unsigned sum, cnt, mine, sp = 0u;
    for (;;) {
        sum = 0u; cnt = 0u; mine = 0u;
#pragma unroll
        for (unsigned j = 0; j < 16; ++j) { const unsigned c = xb_ld(&bar[XB_XCNT(j)]); sum += c; cnt += (c > 0u) ? 1u : 0u; mine = (j == x) ? c : mine; }
        if (sum == G) break;
        __builtin_amdgcn_s_sleep(1);
        if ((++sp & 255u) == 0u) { if (xb_ld(&bar[XB_TMO])) break; if (sp > XB_SPIN_CAP) { atomicAdd(&bar[XB_TMO], 1u); break; } }
    }
    nloc = mine > 0u ? mine : 1u; nx = cnt > 0u ? cnt : 1u;
}

__device__ __forceinline__ void xcd_barrier(const XcdBarrier& b, const int tid_in) {
    asm volatile("s_waitcnt vmcnt(0)" ::: "memory");
    __syncthreads();
    if (tid_in == 0) {
        unsigned* bar = b.bar;
        __builtin_amdgcn_s_waitcnt(0);
        unsigned nloc = b.st[0], nx = b.st[1];
        if (nloc == 0u) { xcd_barrier_complete(bar, b.x, nloc, nx); b.st[0] = nloc; b.st[1] = nx; }
        const unsigned old = xb_add(&bar[XB_XSUB(b.x)], 1u);
        const unsigned gen = old / nloc;
        if (old + 1u == (gen + 1u) * nloc) {
            __builtin_amdgcn_fence(__ATOMIC_RELEASE, "agent");
            asm volatile("s_waitcnt vmcnt(0)" ::: "memory");
            const unsigned og = xb_add(&bar[XB_TOP], 1u);
            const unsigned tg = og / nx;
            if (og + 1u == (tg + 1u) * nx) xb_add(&bar[XB_TOPGEN], 1u);
            else XB_SPIN(xb_ld(&bar[XB_TOPGEN]) == tg, bar);
            __builtin_amdgcn_fence(__ATOMIC_ACQUIRE, "agent");
            xb_add(&bar[XB_XGEN(b.x)], 1u);
            asm volatile("s_waitcnt vmcnt(0)" ::: "memory");
        } else {
            XB_SPIN(xb_ld(&bar[XB_XGEN(b.x)]) == gen, bar);
            __builtin_amdgcn_fence(__ATOMIC_ACQUIRE, "agent");
            asm volatile("s_waitcnt vmcnt(0)" ::: "memory");
        }
    }
    __syncthreads();
}


struct Args { const float* in[23]; float* out; unsigned char* ws; int ph_lo, ph_hi; };
typedef const __attribute__((address_space(4))) Args* KA;
#define KARGS() ({ KA p_ = (KA)__builtin_amdgcn_kernarg_segment_ptr(); asm volatile("" : "+s"(p_)); p_; })
enum { I_X = 0, I_C, I_CTX, I_CCTX, I_WADA, I_BADA, I_WIN, I_WOUT, I_QG, I_KG, I_SINK, I_HLB, I_HGAIN, I_GWS, I_GBS, I_GNG, I_FG, I_FU, I_FD, I_ROUTER, I_MG, I_MU, I_MDN };

__device__ __forceinline__ void transpose_item(const float* W, int K, int N, bf16* WT, int mode, LAS float* scr, int item, int lane) {
    const int nblk = N / 32, kb = item / nblk, nb = item % nblk, k0 = 64 * kb, n0 = 32 * nb;
#pragma unroll 8
    for (int i = 0; i < 32; ++i) { const int kk = 2 * i + (lane >> 5); scr[kk * 33 + (lane & 31)] = __builtin_nontemporal_load(&W[(size_t)(k0 + kk) * N + n0 + (lane & 31)]); }
    LDS_WAIT(); asm volatile("" ::: "memory");
    const int c = lane & 7;
#pragma unroll
    for (int j = 0; j < 4; ++j) { const int n = (lane >> 3) + 8 * j; const LAS float* s = scr + (8 * c) * 33 + n;
        v4u o; o.x = pk2(s[0 * 33], s[1 * 33]); o.y = pk2(s[2 * 33], s[3 * 33]); o.z = pk2(s[4 * 33], s[5 * 33]); o.w = pk2(s[6 * 33], s[7 * 33]);
        const int ng = n0 + n; const int drow = (mode == 0) ? ng : (ng + 128 * (ng / 128) + (mode == 2 ? 128 : 0));
        *(GAS v4u*)(WT + (size_t)drow * K + k0 + 8 * c) = o; }
    LDS_WAIT(); asm volatile("" ::: "memory");
}
__device__ __forceinline__ void transpose_item8(const float* W, int K, int N, unsigned char* WT, int mode, LAS float* scr, int item, int lane) {
    const int nblk = N / 32, kb = item / nblk, nb = item % nblk, k0 = 64 * kb, n0 = 32 * nb;
#pragma unroll 8
    for (int i = 0; i < 32; ++i) { const int kk = 2 * i + (lane >> 5); scr[kk * 33 + (lane & 31)] = __builtin_nontemporal_load(&W[(size_t)(k0 + kk) * N + n0 + (lane & 31)]); }
    LDS_WAIT(); asm volatile("" ::: "memory");
    const int c = lane & 7;
#pragma unroll
    for (int j = 0; j < 4; ++j) { const int n = (lane >> 3) + 8 * j; const LAS float* s = scr + (8 * c) * 33 + n;
        v2u o; o.x = pk4_fp8(s[0 * 33] * F8_WSCALE, s[1 * 33] * F8_WSCALE, s[2 * 33] * F8_WSCALE, s[3 * 33] * F8_WSCALE); o.y = pk4_fp8(s[4 * 33] * F8_WSCALE, s[5 * 33] * F8_WSCALE, s[6 * 33] * F8_WSCALE, s[7 * 33] * F8_WSCALE);
        const int ng = n0 + n; const int drow = (mode == 0) ? ng : (ng + 128 * (ng / 128) + (mode == 2 ? 128 : 0));
        *(GAS v2u*)(WT + (size_t)drow * K + k0 + 8 * c) = o; }
    LDS_WAIT(); asm volatile("" ::: "memory");
}
constexpr int MOE_ITEMS = 24 * 16 * 112;
constexpr int MOE_SL0 = 0, MOE_SL1 = 5376, MOE_SL2 = 10752, MOE_SL3 = 16128, MOE_SL4 = 19200, MOE_DEFER = 25344;
__device__ __forceinline__ void moe_conv_item(KA a, int it, LAS float* scr, int lane) {
    constexpr int I_M = 16 * 112;
    unsigned char* ws = a->ws;
    const int idx = it / I_M, r = it % I_M;
    if (idx < 8) transpose_item8(a->in[I_MG] + (size_t)idx * DM * EXD, DM, EXD, (unsigned char*)(ws + WS_MGU) + (size_t)idx * 2 * EXD * DM, 1, scr, r, lane);
    else if (idx < 16) transpose_item8(a->in[I_MU] + (size_t)(idx - 8) * DM * EXD, DM, EXD, (unsigned char*)(ws + WS_MGU) + (size_t)(idx - 8) * 2 * EXD * DM, 2, scr, r, lane);
    else transpose_item8(a->in[I_MDN] + (size_t)(idx - 16) * EXD * DM, EXD, DM, (unsigned char*)(ws + WS_MD) + (size_t)(idx - 16) * DM * EXD, 0, scr, r, lane);
}
__device__ __forceinline__ void moe_conv_range(KA a, int lo, int hi, int first, LAS unsigned char* lds, int lane, int wave, int G, int bid) {
    if (bid < first) return;
    LAS float* scr = (LAS float*)(lds + wave * 8704);
    const int nw = (G - first) * NWAVES, w = (bid - first) * NWAVES + wave;
    for (int i = lo + w; i < hi; i += nw) moe_conv_item(a, i, scr, lane);
}
__device__ __forceinline__ void p0_prologue(KA a, LAS unsigned char* lds, int tid, int lane, int wave, int G, int bid) {
    unsigned char* ws = a->ws;
    LAS float* scr = (LAS float*)(lds + wave * 8704);
    const int gw = bid * NWAVES + wave, NGW = G * NWAVES;
    constexpr int I_IN = 16 * 80, I_OUT = 16 * 32, I_F = 16 * 88, I_FDN = 44 * 32, I_M = 16 * 112;
    constexpr int NIT = 2 * I_IN + 2 * I_OUT + 2 * I_F + I_FDN + 24 * I_M;
    for (int it0 = gw; it0 < NIT; it0 += NGW) {
        int it = it0;
        if (it < 2 * I_IN) { const int l = it / I_IN, r = it % I_IN; transpose_item(a->in[I_WIN] + (size_t)l * DM * INW, DM, INW, (bf16*)(ws + WS_WIN) + (size_t)l * INW * DM, 0, scr, r, lane); continue; } it -= 2 * I_IN;
        if (it < 2 * I_OUT) { const int l = it / I_OUT, r = it % I_OUT; transpose_item(a->in[I_WOUT] + (size_t)l * DM * DM, DM, DM, (bf16*)(ws + WS_WOUT) + (size_t)l * DM * DM, 0, scr, r, lane); continue; } it -= 2 * I_OUT;
        if (it < I_F) { transpose_item(a->in[I_FG], DM, FFN, (bf16*)(ws + WS_WGU), 1, scr, it, lane); continue; } it -= I_F;
        if (it < I_F) { transpose_item(a->in[I_FU], DM, FFN, (bf16*)(ws + WS_WGU), 2, scr, it, lane); continue; } it -= I_F;
        if (it < I_FDN) { transpose_item(a->in[I_FD], FFN, DM, (bf16*)(ws + WS_WD), 0, scr, it, lane); continue; } it -= I_FDN;
        if (it >= MOE_DEFER) moe_conv_item(a, it, scr, lane);
    }
    LAS float* sil = (LAS float*)(lds + 69632);
    LAS float* part = (LAS float*)(lds + 69632 + 8192);
    float* vec = (float*)(ws + WS_VEC);
    if (bid < 192) {
        for (int i = tid; i < 2048; i += NTHR) { const float v = (i < 1024) ? a->in[I_C][i] : a->in[I_CCTX][i - 1024]; sil[i] = silu1(v); }
        __syncthreads();
        for (int item = bid; item < 192; item += G) {
            const int l = item / 96, cb = item % 96, col = cb * 64 + lane;
            const float* w = a->in[I_WADA] + (size_t)l * DM * 6144 + col;
            float a0 = 0.f, a1 = 0.f;
#pragma unroll 8
            for (int k = wave * 128; k < wave * 128 + 128; ++k) { const float wv = w[(size_t)k * 6144]; a0 += sil[k] * wv; a1 += sil[1024 + k] * wv; }
            part[(wave * 2 + 0) * 64 + lane] = a0; part[(wave * 2 + 1) * 64 + lane] = a1;
            __syncthreads();
            if (wave == 0) { float s0 = 0.f, s1 = 0.f;
#pragma unroll
                for (int w8 = 0; w8 < 8; ++w8) { s0 += part[(w8 * 2 + 0) * 64 + lane]; s1 += part[(w8 * 2 + 1) * 64 + lane]; }
                const float b = a->in[I_BADA][l * 6144 + col];
                vec[VO_MOD + (l * 2 + 0) * 6144 + col] = s0 + b; vec[VO_MOD + (l * 2 + 1) * 6144 + col] = s1 + b; }
            __syncthreads();
        }
    }
    for (int i = bid * NTHR + tid; i < C_CTX * DM / 4; i += G * NTHR) ((GAS f32x4*)(ws + WS_CTXR))[i] = ((const GAS f32x4*)a->in[I_CTX])[i];
    if (bid == G - 1) {
        for (int idx = tid; idx < 5120; idx += NTHR) {
            const int isc = idx >= 4096, j = isc ? idx - 4096 : idx, pos = j / 16, i = j % 16;
            const float inv = exp2f(-(float)i * 0.83048202372184059f);
            const float ang = (float)pos * inv;
            double r = (double)ang * 0.15915494309189535; r -= floor(r);
            const float rf = (float)r;
            const float cs = __builtin_amdgcn_cosf(rf), sn = __builtin_amdgcn_sinf(rf);
            float* t = vec + VO_ROPE + (isc ? 8192 : 0);
            const int n = isc ? 1024 : 4096;
            t[j] = cs; t[n + j] = sn;
        }
    }
}

template <bool STORE = true> __device__ __forceinline__ void norm_row(const float* xrow, const float* sc, const float* sh, bf16* orow, int lane, f32x4 (&h)[4]) {
    const GAS f32x4* xr = (const GAS f32x4*)xrow + lane;
    f32x4 v[4]; float s = 0.f;
#pragma unroll
    for (int j = 0; j < 4; ++j) { v[j] = xr[64 * j]; s += (v[j].x * v[j].x + v[j].y * v[j].y) + (v[j].z * v[j].z + v[j].w * v[j].w); }
    const float rstd = __builtin_amdgcn_rsqf(wave_sum(s) * (1.0f / DM) + EPS);
    GAS v2u* o8 = (GAS v2u*)orow + lane;
#pragma unroll
    for (int j = 0; j < 4; ++j) { const f32x4 scv = *(const f32x4*)(sc + 4 * lane + 256 * j), shv = *(const f32x4*)(sh + 4 * lane + 256 * j);
        h[j] = v[j] * rstd * (scv + 1.0f) + shv;
        if constexpr (STORE) { v2u w; w.x = pk2(h[j].x, h[j].y); w.y = pk2(h[j].z, h[j].w); o8[64 * j] = w; } }
}
__device__ __forceinline__ void phase_norm(KA a, int l, int which, int nrows, bf16* H, int lane, int wave, int G, int bid) {
    const float* vec = (const float*)(a->ws + WS_VEC);
    const float* xl = (l == 0 && which == 0) ? a->in[I_X] : a->out;
    const float* xc = (l == 0 && which == 0) ? a->in[I_CTX] : (const float*)(a->ws + WS_CTXR);
    const float* ml = vec + VO_MOD + (l * 2 + 0) * 6144 + which * 3072;
    const float* mc = vec + VO_MOD + (l * 2 + 1) * 6144 + which * 3072;
    const int gw = bid * NWAVES + wave, NGW = G * NWAVES;
    f32x4 scl[4], shl[4], v[4];
#pragma unroll
    for (int j = 0; j < 4; ++j) { scl[j] = *(const f32x4*)(ml + 1024 + 4 * lane + 256 * j) + 1.0f; shl[j] = *(const f32x4*)(ml + 4 * lane + 256 * j); }
    if (gw < nrows) { const GAS f32x4* xr = (const GAS f32x4*)(gw >= S_LAT ? xc + (size_t)(gw - S_LAT) * DM : xl + (size_t)gw * DM) + lane;
#pragma unroll
        for (int j = 0; j < 4; ++j) v[j] = xr[64 * j]; }
    for (int r = gw; r < nrows; r += NGW) {
        const int rn = r + NGW; f32x4 vn[4];
        if (rn < nrows) { const GAS f32x4* xr = (const GAS f32x4*)(rn >= S_LAT ? xc + (size_t)(rn - S_LAT) * DM : xl + (size_t)rn * DM) + lane;
#pragma unroll
            for (int j = 0; j < 4; ++j) vn[j] = xr[64 * j]; }
        float s = 0.f;
#pragma unroll
        for (int j = 0; j < 4; ++j) s += (v[j].x * v[j].x + v[j].y * v[j].y) + (v[j].z * v[j].z + v[j].w * v[j].w);
        const float rstd = __builtin_amdgcn_rsqf(wave_sum(s) * (1.0f / DM) + EPS);
        GAS v2u* o8 = (GAS v2u*)(H + (size_t)r * DM) + lane;
        if (r >= S_LAT) {
#pragma unroll
            for (int j = 0; j < 4; ++j) { const f32x4 scv = *(const f32x4*)(mc + 1024 + 4 * lane + 256 * j), shv = *(const f32x4*)(mc + 4 * lane + 256 * j);
                const f32x4 h = v[j] * rstd * (scv + 1.0f) + shv; v2u w; w.x = pk2(h.x, h.y); w.y = pk2(h.z, h.w); o8[64 * j] = w; }
        } else {
#pragma unroll
            for (int j = 0; j < 4; ++j) { const f32x4 h = v[j] * rstd * scl[j] + shl[j]; v2u w; w.x = pk2(h.x, h.y); w.y = pk2(h.z, h.w); o8[64 * j] = w; }
        }
#pragma unroll
        for (int j = 0; j < 4; ++j) v[j] = vn[j];
    }
}
__device__ __forceinline__ void phase_norm_route(KA a, LAS unsigned char* lds, int tid, int lane, int wave, int G, int bid) {
    const int l = 1;
    const float* vec = (const float*)(a->ws + WS_VEC);
    const float* ml = vec + VO_MOD + (l * 2 + 0) * 6144 + 3072;
    unsigned char* H8 = (unsigned char*)(a->ws + WS_H2B);
    LAS float* rt = (LAS float*)lds;
    volatile LAS unsigned* lcnt = (volatile LAS unsigned*)(lds + 32768);
    for (int i = tid; i < 8192; i += NTHR) rt[i] = a->in[I_ROUTER][i];
    if (tid < 16) lcnt[tid] = 0u;
    __syncthreads();
    int* tokinfo = (int*)(a->ws + WS_TOK);
    unsigned* cnt = (unsigned*)(a->ws + WS_CTL) + CW_MOECNT;
    const int gw = bid * NWAVES + wave, NGW = G * NWAVES;
    unsigned keep = 0u, pk0 = 0u; int itn = 0;
    for (int r = gw; r < S_LAT; r += NGW) {
        f32x4 h[4];
        norm_row<false>(a->out + (size_t)r * DM, ml + 1024, ml, nullptr, lane, h);
#pragma unroll
        for (int j = 0; j < 4; ++j) ((GAS unsigned*)(H8 + (size_t)r * DM))[lane + 64 * j] = pk4_fp8(h[j].x * F8_ASCALE, h[j].y * F8_ASCALE, h[j].z * F8_ASCALE, h[j].w * F8_ASCALE);
        float lg[8];
#pragma unroll
        for (int e = 0; e < 8; ++e) lg[e] = 0.f;
#pragma unroll
        for (int j = 0; j < 4; ++j)
#pragma unroll
            for (int i = 0; i < 4; ++i) { const int d = 4 * lane + 256 * j + i; const f32x4 r0 = *(const LAS f32x4*)(rt + d * 8), r1 = *(const LAS f32x4*)(rt + d * 8 + 4); const float hv = h[j][i];
                lg[0] += hv * r0.x; lg[1] += hv * r0.y; lg[2] += hv * r0.z; lg[3] += hv * r0.w; lg[4] += hv * r1.x; lg[5] += hv * r1.y; lg[6] += hv * r1.z; lg[7] += hv * r1.w; }
#pragma unroll
        for (int e = 0; e < 8; ++e) lg[e] = wave_sum(lg[e]);
        int i1 = 0; float v1 = lg[0];
#pragma unroll
        for (int e = 1; e < 8; ++e) if (lg[e] > v1) { v1 = lg[e]; i1 = e; }
        int i2 = -1; float v2 = -INFINITY;
#pragma unroll
        for (int e = 0; e < 8; ++e) if (e != i1 && lg[e] > v2) { v2 = lg[e]; i2 = e; }
        const float w1 = 1.0f / (1.0f + __expf(v2 - v1)), w2 = 1.0f - w1;
        if (lane == 0) {
            const unsigned r1 = __hip_atomic_fetch_add((LAS unsigned*)lcnt + i1, 1u, __ATOMIC_RELAXED, __HIP_MEMORY_SCOPE_WORKGROUP), r2 = __hip_atomic_fetch_add((LAS unsigned*)lcnt + i2, 1u, __ATOMIC_RELAXED, __HIP_MEMORY_SCOPE_WORKGROUP);
            int* ti = tokinfo + (size_t)r * 8;
            ti[0] = i1; ti[1] = i2; ti[4] = __builtin_bit_cast(int, w1); ti[5] = __builtin_bit_cast(int, w2);
            pk0 = (unsigned)i1 | ((unsigned)i2 << 3) | (r1 << 6) | (r2 << 19);
        }
        const unsigned pku = (unsigned)__builtin_amdgcn_readfirstlane((int)pk0);
        if (lane == itn) keep = pku;
        ++itn;
    }
    __syncthreads();
    if (tid < 8) lcnt[8 + tid] = __hip_atomic_fetch_add(cnt + 64 * tid, lcnt[tid], RLX_AGENT);
    __syncthreads();
    { const int r = gw + lane * NGW; if (lane < itn && r < S_LAT) { int* ti = tokinfo + (size_t)r * 8; const unsigned e1 = keep & 7u, e2 = (keep >> 3) & 7u; ti[2] = (int)(((keep >> 6) & 0x1fffu) + lcnt[8 + e1]); ti[3] = (int)((keep >> 19) + lcnt[8 + e2]); } }
}

__device__ __forceinline__ void qk_prep(KA a, int l, int first_thread, int nthreads) {
    bf16* PROJ = (bf16*)(a->ws + WS_PROJ);
    const float* rope = (const float*)(a->ws + WS_VEC) + VO_ROPE;
    for (int i = first_thread; i < R_ALL * 10; i += nthreads) {
        const int row = i / 10, hh = i % 10; const bool isq = hh < 8;
        bf16* p = PROJ + (size_t)row * INW + (isq ? hh * 64 : COL_AK + (hh - 8) * 64);
        const float* gain = (isq ? a->in[I_QG] : a->in[I_KG]) + l * 64;
        float x[64]; float ss = 0.f;
#pragma unroll
        for (int c = 0; c < 8; ++c) { const v4u w = *(const GAS v4u*)(p + 8 * c); unpack8(w, x + 8 * c); }
#pragma unroll
        for (int d = 0; d < 64; ++d) ss += x[d] * x[d];
        const float rstd = __builtin_amdgcn_rsqf(ss * (1.0f / 64.0f) + EPS);
        const f32x4* g4 = (const f32x4*)gain;
#pragma unroll
        for (int c = 0; c < 16; ++c) { const f32x4 gv = g4[c]; x[4 * c] *= rstd * gv.x; x[4 * c + 1] *= rstd * gv.y; x[4 * c + 2] *= rstd * gv.z; x[4 * c + 3] *= rstd * gv.w; }
        if (row < S_LAT) {
            const int gr = row >> 6, gc = row & 63;
            const f32x4* cr = (const f32x4*)(rope + gr * 16); const f32x4* sr = (const f32x4*)(rope + 4096 + gr * 16); const f32x4* cc = (const f32x4*)(rope + 8192 + gc * 16); const f32x4* sc = (const f32x4*)(rope + 8192 + 1024 + gc * 16);
#pragma unroll
            for (int j4 = 0; j4 < 4; ++j4) { const f32x4 cv = cr[j4], sv = sr[j4];
#pragma unroll
                for (int i = 0; i < 4; ++i) { const int j = 4 * j4 + i; const float x1 = x[j], x2 = x[16 + j]; x[j] = x1 * cv[i] - x2 * sv[i]; x[16 + j] = x1 * sv[i] + x2 * cv[i]; } }
#pragma unroll
            for (int j4 = 0; j4 < 4; ++j4) { const f32x4 cv = cc[j4], sv = sc[j4];
#pragma unroll
                for (int i = 0; i < 4; ++i) { const int j = 4 * j4 + i; const float x1 = x[32 + j], x2 = x[48 + j]; x[32 + j] = x1 * cv[i] - x2 * sv[i]; x[48 + j] = x1 * sv[i] + x2 * cv[i]; } }
        }
        const float qs = isq ? 0.125f * 1.4426950408889634f : 1.0f;
#pragma unroll
        for (int c = 0; c < 8; ++c) { v4u w; w.x = pk2(x[8 * c] * qs, x[8 * c + 1] * qs); w.y = pk2(x[8 * c + 2] * qs, x[8 * c + 3] * qs); w.z = pk2(x[8 * c + 4] * qs, x[8 * c + 5] * qs); w.w = pk2(x[8 * c + 6] * qs, x[8 * c + 7] * qs);
            *(GAS v4u*)(p + 8 * c) = w; }
    }
}
__device__ __forceinline__ void gmlp_unit(KA a, int l, int chunk, int g, LAS unsigned char* lds, int tid, int lane, int wave) {
    const bf16* PROJ = (const bf16*)(a->ws + WS_PROJ); bf16* MIX = (bf16*)(a->ws + WS_MIX);
    const int row0 = (chunk < 128) ? chunk * 128 : S_LAT + (chunk - 128) * 128;
    LAS float* vn = (LAS float*)lds;
    { const int pos = tid >> 2, part = tid & 3;
      const bf16* p = PROJ + (size_t)(row0 + pos) * INW + COL_GV + g * 64 + part * 16;
      float x[16]; unpack8(*(const GAS v4u*)p, x); unpack8(*(const GAS v4u*)(p + 8), x + 8);
      float ss = 0.f;
#pragma unroll
      for (int d = 0; d < 16; ++d) { x[d] = gelu1(x[d]); ss += x[d] * x[d]; }
      ss += sx<1>(ss); ss += sx<2>(ss);
      const float rstd = __builtin_amdgcn_rsqf(ss * (1.0f / 64.0f) + EPS);
      const float* gn = a->in[I_GNG] + l * 256 + g * 64 + part * 16;
#pragma unroll
      for (int d = 0; d < 16; ++d) vn[pos * 64 + part * 16 + d] = x[d] * rstd * gn[d]; }
    __syncthreads();
    const int c = lane, t0 = wave * 16;
    const float* W = a->in[I_GWS] + ((size_t)(l * 4 + g) * 128 + t0) * 128;
    float acc[16];
#pragma unroll
    for (int i = 0; i < 16; ++i) acc[i] = 0.f;
    for (int s = 0; s < 128; ++s) { const float v = vn[s * 64 + c];
#pragma unroll
        for (int i = 0; i < 16; ++i) acc[i] += W[i * 128 + s] * v; }
    const float* bs = a->in[I_GBS] + (l * 4 + g) * 128 + t0;
#pragma unroll
    for (int i = 0; i < 16; ++i) { const int row = row0 + t0 + i;
        const float u = gelu1(bflo((unsigned)PROJ[(size_t)row * INW + COL_GU + g * 64 + c]));
        MIX[(size_t)row * DM + MIX_GM + g * 64 + c] = (bf16)f2bf(u * (acc[i] + bs[i])); }
    __syncthreads();
}
__device__ __forceinline__ void hgrn_naive(KA a, int l, int dir, int head, LAS unsigned char* lds, int tid, int lane, int wave) {
    const bf16* PROJ = (const bf16*)(a->ws + WS_PROJ);
    float* HGO = (float*)(a->ws + WS_HGO) + (size_t)dir * R_ALL * 256;
    LAS float* Qs = (LAS float*)lds;
    LAS float* Fs = Qs + 4096; LAS float* Vs = Fs + 4096; LAS float* part = Vs + 4096;
    const int v = lane, kg = wave;
    float S[8];
#pragma unroll
    for (int i = 0; i < 8; ++i) S[i] = 0.f;
    const int tl = tid >> 3, c8 = tid & 7;
    float lb[8];
#pragma unroll
    for (int j = 0; j < 8; ++j) { float b = 0.f; if (l == 1) { const float p0 = a->in[I_HLB][dir * 512 + head * 64 + c8 * 8 + j], p1 = a->in[I_HLB][dir * 512 + 256 + head * 64 + c8 * 8 + j]; b = 1.0f / (1.0f + __expf(p0 - p1)); } lb[j] = b; }
    const int fcol = (dir == 0 ? COL_HFF : COL_HFB) + head * 64 + c8 * 8;
    for (int n0 = 0; n0 < R_ALL; n0 += 64) {
        { const int n = n0 + tl; int row;
          if (dir == 0) row = (n < C_CTX) ? S_LAT + n : n - C_CTX; else row = (n < C_CTX) ? S_LAT + (C_CTX - 1 - n) : (S_LAT - 1) - (n - C_CTX);
          const bf16* pr = PROJ + (size_t)row * INW;
          float q[8], f[8], vv[8];
          unpack8(*(const GAS v4u*)(pr + COL_HQ + head * 64 + c8 * 8), q); unpack8(*(const GAS v4u*)(pr + fcol), f); unpack8(*(const GAS v4u*)(pr + COL_HI + head * 64 + c8 * 8), vv);
#pragma unroll
          for (int j = 0; j < 8; ++j) { Qs[tl * 64 + c8 * 8 + j] = silu1(q[j]) * 0.125f; Fs[tl * 64 + c8 * 8 + j] = lb[j] + (1.0f - lb[j]) * sigm1(f[j]); Vs[tl * 64 + c8 * 8 + j] = vv[j]; } }
        __syncthreads();
        for (int t = 0; t < 64; ++t) {
            const float vt = Vs[t * 64 + v]; float po = 0.f;
#pragma unroll
            for (int i = 0; i < 8; ++i) { const float f = Fs[t * 64 + kg * 8 + i], q = Qs[t * 64 + kg * 8 + i]; S[i] = f * S[i] + (1.0f - f) * vt; po += S[i] * q; }
            part[((t & 1) * 8 + kg) * 64 + v] = po;
            __syncthreads();
            if (wave == 0) { float o = 0.f;
#pragma unroll
                for (int w8 = 0; w8 < 8; ++w8) o += part[((t & 1) * 8 + w8) * 64 + v];
                const int n = n0 + t; int row;
                if (dir == 0) row = (n < C_CTX) ? S_LAT + n : n - C_CTX; else row = (n < C_CTX) ? S_LAT + (C_CTX - 1 - n) : (S_LAT - 1) - (n - C_CTX);
                HGO[(size_t)row * 256 + head * 64 + v] = o; }
        }
        __syncthreads();
    }
}

typedef short bf16x8v __attribute__((ext_vector_type(8)));
constexpr int HST = 72;
__device__ __forceinline__ f32x4 mma16(const LAS bf16* MA, const LAS bf16* MBt, int k0, f32x4 c, int lane) {
    const bf16x8v av = *(const LAS bf16x8v*)(MA + (lane & 15) * HST + k0 + 8 * (lane >> 4));
    const bf16x8v bv = *(const LAS bf16x8v*)(MBt + (lane & 15) * HST + k0 + 8 * (lane >> 4));
    return __builtin_amdgcn_mfma_f32_16x16x32_bf16(av, bv, c, 0, 0, 0);
}
__device__ __forceinline__ int hg_base_row(int cpos) { return cpos < 256 ? 64 * cpos : S_LAT + 64 * (cpos - 256); }
__device__ __forceinline__ int hg_scan_idx(int dir, int cpos) { return dir == 0 ? (cpos < 256 ? 4 + cpos : cpos - 256) : (cpos < 256 ? 4 + (255 - cpos) : 3 - (cpos - 256)); }
__device__ __forceinline__ float hg_lb(KA a, int l, int dir, int head, int k) {
    if (l == 0) return 0.f;
    const float p0 = a->in[I_HLB][dir * 512 + head * 64 + k], p1 = a->in[I_HLB][dir * 512 + 256 + head * 64 + k];
    return 1.0f / (1.0f + __expf(p0 - p1));
}
__device__ __forceinline__ void hgrn_stepA(KA a, int l, int cpos, int head, LAS unsigned char* lds, int lane, int wave) {
    const bf16* PROJ = (const bf16*)(a->ws + WS_PROJ);
    const int dir = wave >> 2, I = wave & 3, base = hg_base_row(cpos), ci = hg_scan_idx(dir, cpos);
    LAS float* TOT = (LAS float*)lds;
    LAS bf16* KLT = (LAS bf16*)(lds + 2048) + dir * 64 * HST;
    LAS bf16* VT = (LAS bf16*)(lds + 2048 + 2 * 64 * HST * 2) + dir * 64 * HST;
    const float lb = hg_lb(a, l, dir, head, lane);
    const int fcol = (dir == 0 ? COL_HFF : COL_HFB) + head * 64 + lane, vcol = COL_HI + head * 64 + lane;
    float kk[16], cl[16]; float run = 0.f;
#pragma unroll
    for (int i = 0; i < 16; ++i) { const int n = 16 * I + i, row = base + (dir ? 63 - n : n);
        const float fl = bflo((unsigned)PROJ[(size_t)row * INW + fcol]);
        const unsigned short vb = PROJ[(size_t)row * INW + vcol];
        const float f = lb + (1.0f - lb) * sigm1(fl);
        run += __logf(f); cl[i] = run; kk[i] = 1.0f - f;
        VT[lane * HST + n] = vb; }
    TOT[(dir * 4 + I) * 64 + lane] = run;
    __syncthreads();
    float post = 0.f, all = 0.f;
#pragma unroll
    for (int J = 0; J < 4; ++J) { const float t = TOT[(dir * 4 + J) * 64 + lane]; all += t; if (J > I) post += t; }
#pragma unroll
    for (int i = 0; i < 16; ++i) KLT[lane * HST + 16 * I + i] = (bf16)f2bf(kk[i] * __expf(run - cl[i] + post));
    if (I == 0) ((float*)(a->ws + WS_HDG))[((size_t)(dir * 4 + head) * 260 + ci) * 64 + lane] = __expf(all);
    __syncthreads();
    float* LT = (float*)(a->ws + WS_HLT) + ((size_t)(dir * 4 + head) * 260 + ci) * 4096;
    float z0 = 0.f; asm volatile("" : "+v"(z0));
#pragma unroll
    for (int kb = 0; kb < 4; ++kb) { f32x4 acc = {z0, z0, z0, z0};
        acc = mma16(VT + 16 * I * HST, KLT + 16 * kb * HST, 0, acc, lane); acc = mma16(VT + 16 * I * HST, KLT + 16 * kb * HST, 32, acc, lane);
#pragma unroll
        for (int r = 0; r < 4; ++r) LT[(16 * I + 4 * (lane >> 4) + r) * 64 + 16 * kb + (lane & 15)] = acc[r]; }
    __syncthreads();
}
__device__ __forceinline__ void hgrn_stepB(KA a, int item, int tid) {
    const int dh = item >> 3, vb = item & 7, v = vb * 8 + (tid >> 6), k = tid & 63;
    const float* LT = (const float*)(a->ws + WS_HLT) + (size_t)dh * 260 * 4096 + v * 64 + k;
    const float* DG = (const float*)(a->ws + WS_HDG) + (size_t)dh * 260 * 64 + k;
    bf16* SP = (bf16*)(a->ws + WS_HSP) + (size_t)dh * 260 * 4096 + v * 64 + k;
    float S = 0.f;
#pragma unroll 1
    for (int c0 = 0; c0 < 260; c0 += 26) {
        float lt[26], dg[26];
#pragma unroll
        for (int j = 0; j < 26; ++j) { lt[j] = LT[(size_t)(c0 + j) * 4096]; dg[j] = DG[(c0 + j) * 64]; }
#pragma unroll
        for (int j = 0; j < 26; ++j) { SP[(size_t)(c0 + j) * 4096] = (bf16)f2bf(S); S = dg[j] * S + lt[j]; }
    }
}
__device__ __forceinline__ void hgrn_stepC(KA a, int l, int cpos, int head, LAS unsigned char* lds, int tid, int lane, int wave) {
    const bf16* PROJ = (const bf16*)(a->ws + WS_PROJ); bf16* MIX = (bf16*)(a->ws + WS_MIX);
    const int dir = wave >> 2, I = wave & 3, base = hg_base_row(cpos), ci = hg_scan_idx(dir, cpos);
    constexpr int MSZ = 64 * HST;
    LAS float* TOT = (LAS float*)lds;
    LAS bf16* img = (LAS bf16*)(lds + 2048);
    LAS bf16* QT = img + dir * MSZ;
    LAS bf16* QD = img + 2 * MSZ + dir * MSZ;
    LAS bf16* VT = img + 4 * MSZ + dir * MSZ;
    LAS bf16* ST = img + 6 * MSZ + dir * MSZ;
    LAS bf16* AS = img + 8 * MSZ + dir * MSZ + I * 16 * HST;
    LAS bf16* KT = img + 10 * MSZ + dir * (10 * 16 * HST);
    LAS float* OS = (LAS float*)(img + 10 * MSZ);
    const float lb = hg_lb(a, l, dir, head, lane);
    const int fcol = (dir == 0 ? COL_HFF : COL_HFB) + head * 64 + lane, qcol = COL_HQ + head * 64 + lane, vcol = COL_HI + head * 64 + lane;
    { const bf16* SP = (const bf16*)(a->ws + WS_HSP) + ((size_t)(dir * 4 + head) * 260 + ci) * 4096;
#pragma unroll
      for (int h2 = 0; h2 < 2; ++h2) { const int e = ((I * 2 + h2) * 64 + lane) * 8, vv = e >> 6, kk0 = e & 63;
          *(LAS v4u*)(ST + vv * HST + kk0) = *(const GAS v4u*)(SP + e); } }
    float kk[16], cl[16], qv[16]; float run = 0.f;
#pragma unroll
    for (int i = 0; i < 16; ++i) { const int n = 16 * I + i, row = base + (dir ? 63 - n : n);
        const float fl = bflo((unsigned)PROJ[(size_t)row * INW + fcol]), ql = bflo((unsigned)PROJ[(size_t)row * INW + qcol]);
        const unsigned short vb = PROJ[(size_t)row * INW + vcol];
        const float f = lb + (1.0f - lb) * sigm1(fl);
        run += __logf(f); cl[i] = run; kk[i] = 1.0f - f; qv[i] = silu1(ql) * 0.125f;
        VT[lane * HST + n] = vb; }
    TOT[(dir * 4 + I) * 64 + lane] = run;
    __syncthreads();
    float tj[4];
#pragma unroll
    for (int J = 0; J < 4; ++J) tj[J] = TOT[(dir * 4 + J) * 64 + lane];
    float pre = 0.f;
#pragma unroll
    for (int J = 0; J < 4; ++J) if (J < I) pre += tj[J];
    const float epre = __expf(pre); float kei[16];
#pragma unroll
    for (int i = 0; i < 16; ++i) { const float e = __expf(cl[i]); QT[(16 * I + i) * HST + lane] = (bf16)f2bf(qv[i] * e); QD[(16 * I + i) * HST + lane] = (bf16)f2bf(qv[i] * e * epre); kei[i] = kk[i] * fminf(__builtin_amdgcn_rcpf(e), 5.5e34f); }
    float eoff = 0.f;
#pragma unroll
    for (int I2 = 0; I2 < 4; ++I2) {
        if (I2 >= I) {
            if (I2 == I) eoff = 0.f; else if (I2 == I + 1) eoff = run; else eoff += tj[I2 - 1];
            LAS bf16* blk = KT + (I2 * (I2 + 1) / 2 + I) * 16 * HST;
            const float fo = __expf(eoff);
#pragma unroll
            for (int i = 0; i < 16; ++i) blk[i * HST + lane] = (bf16)f2bf(kei[i] * fo);
        }
    }
    __syncthreads();
    float z0 = 0.f; asm volatile("" : "+v"(z0));
    f32x4 sc[4];
#pragma unroll
    for (int J = 0; J < 4; ++J) { sc[J] = (f32x4){z0, z0, z0, z0};
        if (J <= I) { const LAS bf16* kb = KT + (I * (I + 1) / 2 + J) * 16 * HST;
            sc[J] = mma16(QT + 16 * I * HST, kb, 0, sc[J], lane); sc[J] = mma16(QT + 16 * I * HST, kb, 32, sc[J], lane);
            if (J == I) {
#pragma unroll
                for (int r = 0; r < 4; ++r) if ((lane & 15) > 4 * (lane >> 4) + r) sc[J][r] = z0; } } }
#pragma unroll
    for (int J = 0; J < 4; ++J)
#pragma unroll
        for (int r = 0; r < 4; ++r) AS[(4 * (lane >> 4) + r) * HST + 16 * J + (lane & 15)] = (bf16)f2bf(sc[J][r]);
    asm volatile("s_waitcnt lgkmcnt(0)" ::: "memory");
    f32x4 acc[4];
#pragma unroll
    for (int vb = 0; vb < 4; ++vb) { acc[vb] = (f32x4){z0, z0, z0, z0};
        acc[vb] = mma16(AS, VT + 16 * vb * HST, 0, acc[vb], lane); acc[vb] = mma16(AS, VT + 16 * vb * HST, 32, acc[vb], lane);
        acc[vb] = mma16(QD + 16 * I * HST, ST + 16 * vb * HST, 0, acc[vb], lane); acc[vb] = mma16(QD + 16 * I * HST, ST + 16 * vb * HST, 32, acc[vb], lane); }
    __syncthreads();
#pragma unroll
    for (int vb = 0; vb < 4; ++vb)
#pragma unroll
        for (int r = 0; r < 4; ++r) { const int n = 16 * I + 4 * (lane >> 4) + r, rl = dir ? 63 - n : n; OS[(dir * 64 + rl) * 68 + 16 * vb + (lane & 15)] = acc[vb][r]; }
    __syncthreads();
    { const int rl = tid >> 3, v8 = (tid & 7) * 8, row = base + rl;
      float o[8]; float ss = 0.f;
#pragma unroll
      for (int j = 0; j < 8; ++j) { o[j] = OS[rl * 68 + v8 + j] + OS[(64 + rl) * 68 + v8 + j]; ss += o[j] * o[j]; }
      ss += sx<1>(ss); ss += sx<2>(ss); ss += sx<4>(ss);
      const float rstd = __builtin_amdgcn_rsqf(ss * (1.0f / 64.0f) + EPS);
      float gt[8]; unpack8(*(const GAS v4u*)(PROJ + (size_t)row * INW + COL_HG + head * 64 + v8), gt);
      const float* gn = a->in[I_HGAIN] + l * 64 + v8;
      float y[8];
#pragma unroll
      for (int j = 0; j < 8; ++j) y[j] = o[j] * rstd * gn[j] * silu1(gt[j]);
      v4u w; w.x = pk2(y[0], y[1]); w.y = pk2(y[2], y[3]); w.z = pk2(y[4], y[5]); w.w = pk2(y[6], y[7]);
      *(GAS v4u*)(MIX + (size_t)row * DM + MIX_HG + head * 64 + v8) = w; }
    __syncthreads();
}

__device__ __forceinline__ void vt_item(KA a, int item, int lane) {
    const bf16* PROJ = (const bf16*)(a->ws + WS_PROJ); bf16* VTg = (bf16*)(a->ws + WS_VT);
    const int rb = item >> 1, hk = item & 1, row = rb * 64 + lane;
    const bf16* p = PROJ + (size_t)row * INW + COL_AV + hk * 64;
    unsigned w[32];
#pragma unroll
    for (int c = 0; c < 8; ++c) { const v4u t = *(const GAS v4u*)(p + 8 * c); w[4 * c] = t.x; w[4 * c + 1] = t.y; w[4 * c + 2] = t.z; w[4 * c + 3] = t.w; }
    bf16* o = VTg + (size_t)hk * 64 * R_ALL + row;
#pragma unroll
    for (int d2 = 0; d2 < 32; ++d2) { o[(size_t)(2 * d2) * R_ALL] = (bf16)(w[d2] & 0xffffu); o[(size_t)(2 * d2 + 1) * R_ALL] = (bf16)(w[d2] >> 16); }
}
__device__ __forceinline__ void attn_unit(KA a, int l, int u, LAS unsigned char* lds, int tid, int lane, int wave) {
    asm volatile("" : "+v"(tid), "+v"(lane));
    const bf16* PROJ = (const bf16*)(a->ws + WS_PROJ); const bf16* VTg = (const bf16*)(a->ws + WS_VT); bf16* MIX = (bf16*)(a->ws + WS_MIX);
    const bool isctx = u >= 256; const int uu = isctx ? u - 256 : u; const int n = uu >> 1, hk = uu & 1;
    const int qh = hk * 4 + (wave >> 1), half = wave & 1;
    const int qbase = (isctx ? S_LAT : 0) + n * 128 + half * 64, qpos0 = n * 128 + half * 64;
    const int c = lane & 15, g = lane >> 4;
    LAS bf16* Kt = (LAS bf16*)lds; LAS bf16* Vt = Kt + 64 * HST; LAS bf16* Qw = Vt + 64 * HST + wave * 64 * HST;
#pragma unroll
    for (int j = 0; j < 8; ++j) { const int qr = 8 * j + (lane >> 3), qc = (lane & 7) * 8;
        *(LAS v4u*)(Qw + qr * HST + qc) = *(const GAS v4u*)(PROJ + (size_t)(qbase + qr) * INW + qh * 64 + qc); }
    float z0 = 0.f; asm volatile("" : "+v"(z0));
    f32x4 o[4][4]; float ls[4];
    float gq = 0.f, gk = 0.f;
#pragma unroll 8
    for (int d = 0; d < 64; ++d) { gq = fmaxf(gq, fabsf(a->in[I_QG][l * 64 + d])); gk = fmaxf(gk, fabsf(a->in[I_KG][l * 64 + d])); }
    const float nbnd = -(8.0f * 1.4426950408889634f) * gq * gk;
    const float sink = a->in[I_SINK][l * 8 + qh] * 1.4426950408889634f;
#pragma unroll
    for (int qt = 0; qt < 4; ++qt) { ls[qt] = (g == 0) ? __builtin_amdgcn_exp2f(sink + nbnd) : z0;
#pragma unroll
        for (int dt = 0; dt < 4; ++dt) o[qt][dt] = (f32x4){z0, z0, z0, z0}; }
    const int first = (!isctx && n == 0) ? 2 : 0, nwin = isctx ? 0 : ((n == 0 || n == 127) ? 4 : 6), nt = nwin + 4;
    const int lr = tid >> 3, lc = (tid & 7) * 8;
    v4u kreg, vreg;
#define ATT_LOADT(i) do { const bool ct_ = (i) >= nwin; const int kb_ = ct_ ? S_LAT + 64 * ((i) - nwin) : (n - 1) * 128 + 64 * (first + (i)); \
        kreg = *(const GAS v4u*)(PROJ + (size_t)(kb_ + lr) * INW + COL_AK + hk * 64 + lc); vreg = *(const GAS v4u*)(VTg + ((size_t)hk * 64 + lr) * R_ALL + kb_ + lc); } while (0)
    ATT_LOADT(0);
#pragma unroll 1
    for (int i = 0; i < nt; ++i) {
        __syncthreads();
        *(LAS v4u*)(Kt + lr * HST + lc) = kreg; *(LAS v4u*)(Vt + lr * HST + lc) = vreg;
        __syncthreads();
        if (i + 1 < nt) ATT_LOADT(i + 1);
        const bool win = i < nwin; const int kb = (n - 1) * 128 + 64 * (first + i);
        const int rel = kb - qpos0;
        const bool maskw = win && (rel == 128 || rel == -128);
        if (win && (rel >= 192 || rel <= -192)) continue;
        bf16x8v kf[4][2], vf[4][2];
#pragma unroll
        for (int kt = 0; kt < 4; ++kt)
#pragma unroll
            for (int ks = 0; ks < 2; ++ks) kf[kt][ks] = *(const LAS bf16x8v*)(Kt + (16 * kt + c) * HST + 32 * ks + 8 * g);
#pragma unroll
        for (int dt = 0; dt < 4; ++dt)
#pragma unroll
            for (int s2 = 0; s2 < 2; ++s2) { const v2u lo = *(const LAS v2u*)(Vt + (16 * dt + c) * HST + 32 * s2 + 4 * g), hi = *(const LAS v2u*)(Vt + (16 * dt + c) * HST + 32 * s2 + 16 + 4 * g);
                const v4u t = {lo.x, lo.y, hi.x, hi.y}; vf[dt][s2] = __builtin_bit_cast(bf16x8v, t); }
#pragma unroll
        for (int qt = 0; qt < 4; ++qt) {
            f32x4 s[4];
            const bf16x8v q0 = *(const LAS bf16x8v*)(Qw + (16 * qt + c) * HST + 8 * g), q1 = *(const LAS bf16x8v*)(Qw + (16 * qt + c) * HST + 32 + 8 * g);
#pragma unroll
            for (int kt = 0; kt < 4; ++kt) { s[kt] = (f32x4){nbnd, nbnd, nbnd, nbnd};
                s[kt] = __builtin_amdgcn_mfma_f32_16x16x32_bf16(kf[kt][0], q0, s[kt], 0, 0, 0); s[kt] = __builtin_amdgcn_mfma_f32_16x16x32_bf16(kf[kt][1], q1, s[kt], 0, 0, 0); }
            if (maskw) { const int dq = qpos0 + 16 * qt + c - kb - 4 * g;
#pragma unroll
                for (int kt = 0; kt < 4; ++kt)
#pragma unroll
                    for (int r = 0; r < 4; ++r) { const int dl = dq - 16 * kt - r; if (dl > 128 || dl < -128) s[kt][r] = -INFINITY; } }
            float ps = 0.f;
#pragma unroll
            for (int kt = 0; kt < 4; ++kt)
#pragma unroll
                for (int r = 0; r < 4; ++r) { s[kt][r] = __builtin_amdgcn_exp2f(s[kt][r]); ps += s[kt][r]; }
            ls[qt] += ps;
            bf16x8v pb[2];
#pragma unroll
            for (int s2 = 0; s2 < 2; ++s2) { const v4u t = {pk2(s[2 * s2][0], s[2 * s2][1]), pk2(s[2 * s2][2], s[2 * s2][3]), pk2(s[2 * s2 + 1][0], s[2 * s2 + 1][1]), pk2(s[2 * s2 + 1][2], s[2 * s2 + 1][3])};
                pb[s2] = __builtin_bit_cast(bf16x8v, t); }
#pragma unroll
            for (int dt = 0; dt < 4; ++dt) { o[qt][dt] = __builtin_amdgcn_mfma_f32_16x16x32_bf16(vf[dt][0], pb[0], o[qt][dt], 0, 0, 0); o[qt][dt] = __builtin_amdgcn_mfma_f32_16x16x32_bf16(vf[dt][1], pb[1], o[qt][dt], 0, 0, 0); }
        }
    }
#undef ATT_LOADT
    int c2 = lane & 15, g2 = lane >> 4; asm volatile("" : "+v"(c2), "+v"(g2));
#pragma unroll
    for (int qt = 0; qt < 4; ++qt) { float lt = ls[qt]; lt += sx<16>(lt); lt = sx32_add(lt); const float inv = 1.0f / lt;
        bf16* op = (bf16*)(a->ws + WS_MIX) + (size_t)(qbase + 16 * qt + c2) * DM + MIX_AT + qh * 64 + 4 * g2;
#pragma unroll
        for (int dt = 0; dt < 4; ++dt) { v2u w; w.x = pk2(o[qt][dt][0] * inv, o[qt][dt][1] * inv); w.y = pk2(o[qt][dt][2] * inv, o[qt][dt][3] * inv); *(GAS v2u*)(op + 16 * dt) = w; } }
}

constexpr int GST = 136;
__device__ __forceinline__ f32x4 mma16g(const LAS bf16* MA, const LAS bf16* MBt, int k0, f32x4 c, int lane) {
    const bf16x8v av = *(const LAS bf16x8v*)(MA + (lane & 15) * GST + k0 + 8 * (lane >> 4));
    const bf16x8v bv = *(const LAS bf16x8v*)(MBt + (lane & 15) * GST + k0 + 8 * (lane >> 4));
    return __builtin_amdgcn_mfma_f32_16x16x32_bf16(av, bv, c, 0, 0, 0);
}
__device__ __forceinline__ float gelu_as(float v) {
    const float av = fabsf(v), t = __builtin_amdgcn_rcpf(av * 0.2316418882f + 1.0f);
    float q = t * 0.5307027145f + (-0.7265760135f); q = q * t + 0.7107068705f; q = q * t + (-0.142248368f); q = q * t + 0.127414796f; q = q * t;
    const float e = __builtin_amdgcn_exp2f((v * v) * (-0.72134752044f)), mm = v * (q * e);
    return v < 0.f ? mm : v - mm;
}
__device__ __forceinline__ void gmlp_unit_mma(KA a, int l, int chunk, int g, LAS unsigned char* lds, int tid, int lane, int wave) {
    const bf16* PROJ = (const bf16*)(a->ws + WS_PROJ); bf16* MIX = (bf16*)(a->ws + WS_MIX);
    const int row0 = (chunk < 128) ? chunk * 128 : S_LAT + (chunk - 128) * 128;
    LAS bf16* WA = (LAS bf16*)lds;
    LAS bf16* VNT = WA + 128 * GST;
    LAS float* OUT = (LAS float*)(VNT + 64 * GST);
    const int pos = tid >> 2, part = tid & 3;
    {
      const float* W = a->in[I_GWS] + ((size_t)(l * 4 + g) * 128 + pos) * 128 + part * 32;
#pragma unroll
      for (int j = 0; j < 4; ++j) { const f32x4 w0 = *(const GAS f32x4*)(W + 8 * j), w1 = *(const GAS f32x4*)(W + 8 * j + 4);
          v4u o; o.x = pk2(w0.x, w0.y); o.y = pk2(w0.z, w0.w); o.z = pk2(w1.x, w1.y); o.w = pk2(w1.z, w1.w);
          *(LAS v4u*)(WA + pos * GST + part * 32 + 8 * j) = o; } }
    { const bf16* p = PROJ + (size_t)(row0 + pos) * INW + COL_GV + g * 64 + part * 16;
      float x[16]; unpack8(*(const GAS v4u*)p, x); unpack8(*(const GAS v4u*)(p + 8), x + 8);
      float ss = 0.f;
#pragma unroll
      for (int d = 0; d < 16; ++d) { x[d] = gelu_as(x[d]); ss += x[d] * x[d]; }
      ss += sx<1>(ss); ss += sx<2>(ss);
      const float rstd = __builtin_amdgcn_rsqf(ss * (1.0f / 64.0f) + EPS);
      const float* gn = a->in[I_GNG] + l * 256 + g * 64 + part * 16;
#pragma unroll
      for (int d = 0; d < 16; ++d) VNT[(part * 16 + d) * GST + pos] = (bf16)f2bf(x[d] * rstd * gn[d]); }
    __syncthreads();
    float z0 = 0.f; asm volatile("" : "+v"(z0));
#pragma unroll
    for (int cb = 0; cb < 4; ++cb) { f32x4 acc = {z0, z0, z0, z0};
#pragma unroll
        for (int ks = 0; ks < 4; ++ks) acc = mma16g(WA + 16 * wave * GST, VNT + 16 * cb * GST, 32 * ks, acc, lane);
#pragma unroll
        for (int r = 0; r < 4; ++r) OUT[(16 * wave + 4 * (lane >> 4) + r) * 68 + 16 * cb + (lane & 15)] = acc[r]; }
    __syncthreads();
    { const int row = row0 + pos; const float bsv = a->in[I_GBS][(l * 4 + g) * 128 + pos];
      const bf16* pu = PROJ + (size_t)row * INW + COL_GU + g * 64 + part * 16;
      float u[16]; unpack8(*(const GAS v4u*)pu, u); unpack8(*(const GAS v4u*)(pu + 8), u + 8);
      float y[16];
#pragma unroll
      for (int d = 0; d < 16; ++d) y[d] = gelu_as(u[d]) * (OUT[pos * 68 + part * 16 + d] + bsv);
      bf16* po = MIX + (size_t)row * DM + MIX_GM + g * 64 + part * 16;
      v4u w; w.x = pk2(y[0], y[1]); w.y = pk2(y[2], y[3]); w.z = pk2(y[4], y[5]); w.w = pk2(y[6], y[7]); *(GAS v4u*)po = w;
      w.x = pk2(y[8], y[9]); w.y = pk2(y[10], y[11]); w.z = pk2(y[12], y[13]); w.w = pk2(y[14], y[15]); *(GAS v4u*)(po + 8) = w; }
    __syncthreads();
}
__device__ __forceinline__ void attn_naive(KA a, int l, int nrows, int lane, int wave, int G, int bid) {
    const bf16* PROJ = (const bf16*)(a->ws + WS_PROJ); bf16* MIX = (bf16*)(a->ws + WS_MIX);
    const int gw = bid * NWAVES + wave, NGW = G * NWAVES;
    for (int pair = gw; pair < nrows * 2; pair += NGW) {
        const int row = pair >> 1, hk = pair & 1; const bool isctx = row >= S_LAT;
        float q[4], o[4], m[4], ls[4];
#pragma unroll
        for (int g = 0; g < 4; ++g) { q[g] = bflo((unsigned)PROJ[(size_t)row * INW + (hk * 4 + g) * 64 + lane]); o[g] = 0.f; ls[g] = 1.0f; m[g] = a->in[I_SINK][l * 8 + hk * 4 + g] * 1.4426950408889634f; }
        int j0 = 0, j1 = -1;
        if (!isctx) { j0 = row - 128 < 0 ? 0 : row - 128; j1 = row + 128 > S_LAT - 1 ? S_LAT - 1 : row + 128; }
        const int nwin = j1 - j0 + 1;
        const int nk = nwin + C_CTX;
#pragma unroll 4
        for (int t = 0; t < nk; ++t) {
            const int krow = (t < nwin) ? j0 + t : S_LAT + (t - nwin);
            const float k = bflo((unsigned)PROJ[(size_t)krow * INW + COL_AK + hk * 64 + lane]);
            const float v = bflo((unsigned)PROJ[(size_t)krow * INW + COL_AV + hk * 64 + lane]);
#pragma unroll
            for (int g = 0; g < 4; ++g) { const float s = wave_sum(q[g] * k); const float mn = fmaxf(m[g], s);
                const float c = __builtin_amdgcn_exp2f(m[g] - mn), p = __builtin_amdgcn_exp2f(s - mn);
                ls[g] = ls[g] * c + p; o[g] = o[g] * c + p * v; m[g] = mn; }
        }
#pragma unroll
        for (int g = 0; g < 4; ++g) MIX[(size_t)row * DM + MIX_AT + (hk * 4 + g) * 64 + lane] = (bf16)f2bf(o[g] / ls[g]);
    }
}
__device__ __forceinline__ void hgrn_combine(KA a, int l, int nrows, int lane, int wave, int G, int bid) {
    const bf16* PROJ = (const bf16*)(a->ws + WS_PROJ); bf16* MIX = (bf16*)(a->ws + WS_MIX);
    const float* O0 = (const float*)(a->ws + WS_HGO); const float* O1 = O0 + (size_t)R_ALL * 256;
    const f32x4 gn = *(const f32x4*)(a->in[I_HGAIN] + l * 64 + (lane & 15) * 4);
    const int gw = bid * NWAVES + wave, NGW = G * NWAVES;
    for (int r = gw; r < nrows; r += NGW) {
        const f32x4 o = *(const GAS f32x4*)(O0 + (size_t)r * 256 + 4 * lane) + *(const GAS f32x4*)(O1 + (size_t)r * 256 + 4 * lane);
        float ss = (o.x * o.x + o.y * o.y) + (o.z * o.z + o.w * o.w);
        ss += sx<1>(ss); ss += sx<2>(ss); ss += sx<4>(ss); ss += sx<8>(ss);
        const float rstd = __builtin_amdgcn_rsqf(ss * (1.0f / 64.0f) + EPS);
        const v2u gw2 = *(const GAS v2u*)(PROJ + (size_t)r * INW + COL_HG + 4 * lane);
        const float g0 = bflo(gw2.x), g1 = bfhi(gw2.x), g2 = bflo(gw2.y), g3 = bfhi(gw2.y);
        v2u w; w.x = pk2(o.x * rstd * gn.x * silu1(g0), o.y * rstd * gn.y * silu1(g1)); w.y = pk2(o.z * rstd * gn.z * silu1(g2), o.w * rstd * gn.w * silu1(g3));
        *(GAS v2u*)(MIX + (size_t)r * DM + MIX_HG + 4 * lane) = w;
    }
}
__device__ __forceinline__ void moe_gather(KA a, LAS unsigned char* lds, int tid, int lane, int wave, int G, int bid) {
    LAS int* sb = (LAS int*)lds;
    const unsigned* cnt = (const unsigned*)(a->ws + WS_CTL) + CW_MOECNT;
    int* mi = (int*)(a->ws + WS_VEC) + VO_MOE;
    if (tid == 0) { int b = 0;
        for (int e = 0; e < 8; ++e) { const int c = (int)__hip_atomic_load(cnt + 64 * e, RLX_AGENT); sb[e] = b; sb[16 + e] = c;
            const int nt = (c + 255) >> 8;
            if (bid == 0) for (int t = 0; t < nt; ++t) mi[16 + (b >> 8) + t] = e;
            b += nt << 8; }
        sb[8] = b; if (bid == 0) mi[0] = b >> 8; }
    __syncthreads();
    const unsigned char* H8 = (const unsigned char*)(a->ws + WS_H2B); unsigned char* AS = (unsigned char*)(a->ws + WS_AS);
    const int* tokinfo = (const int*)(a->ws + WS_TOK); int* tokslot = (int*)(a->ws + WS_TOK) + S_LAT * 8;
    const int gw = bid * NWAVES + wave, NGW = G * NWAVES;
    for (int t = gw; t < S_LAT; t += NGW) {
        const int* ti = tokinfo + (size_t)t * 8;
        const int e1 = ti[0], e2 = ti[1], r1 = ti[2], r2 = ti[3];
        const int s1 = sb[e1] + r1, s2 = sb[e2] + r2;
        const v4u x0 = ((const GAS v4u*)(H8 + (size_t)t * DM))[lane];
        ((GAS v4u*)(AS + (size_t)s1 * DM))[lane] = x0; ((GAS v4u*)(AS + (size_t)s2 * DM))[lane] = x0;
        if (lane == 0) { int* ts = tokslot + (size_t)t * 4; ts[0] = s1; ts[1] = s2; ts[2] = ti[4]; ts[3] = ti[5]; }
    }
    { const f32x4 z4 = {0.f, 0.f, 0.f, 0.f}; for (int i = bid * NTHR + tid; i < 8 * 256 * DM / 4; i += G * NTHR) ((GAS f32x4*)(a->ws + WS_YF))[i] = z4; }
    for (int e = 0; e < 8; ++e) { const int c = sb[16 + e], pe = (c + 255) & ~255, b = sb[e];
        for (int j = c + gw; j < pe; j += NGW) { const v4u z = {0u, 0u, 0u, 0u}; ((GAS v4u*)(AS + (size_t)(b + j) * DM))[lane] = z; } }
}
__device__ __forceinline__ void moe_combine(KA a, int lane, int wave, int G, int bid) {
    const float* gf = (const float*)(a->ws + WS_VEC) + VO_MOD + (1 * 2 + 0) * 6144 + 5 * 1024;
    const bf16* Y = (const bf16*)(a->ws + WS_Y); const int* tokslot = (const int*)(a->ws + WS_TOK) + S_LAT * 8;
    const int gw = bid * NWAVES + wave, NGW = G * NWAVES;
    for (int t = gw; t < S_LAT; t += NGW) {
        const int* ts = tokslot + (size_t)t * 4; const int s1 = ts[0], s2 = ts[1]; const float w1 = __builtin_bit_cast(float, ts[2]), w2 = __builtin_bit_cast(float, ts[3]);
        GAS f32x4* xr = (GAS f32x4*)(a->out + (size_t)t * DM) + lane;
        const float* YF = (const float*)(a->ws + WS_YF);
#pragma unroll
        for (int j = 0; j < 4; ++j) { const f32x4 g = *(const f32x4*)(gf + 4 * lane + 256 * j); f32x4 x = xr[64 * j]; f32x4 p, q;
            if (s1 < 32768) { const v2u t = ((const GAS v2u*)(Y + (size_t)s1 * DM) + lane)[64 * j]; p = (f32x4){bflo(t.x), bfhi(t.x), bflo(t.y), bfhi(t.y)}; } else p = ((const GAS f32x4*)(YF + (size_t)(s1 - 32768) * DM) + lane)[64 * j];
            if (s2 < 32768) { const v2u t = ((const GAS v2u*)(Y + (size_t)s2 * DM) + lane)[64 * j]; q = (f32x4){bflo(t.x), bfhi(t.x), bflo(t.y), bfhi(t.y)}; } else q = ((const GAS f32x4*)(YF + (size_t)(s2 - 32768) * DM) + lane)[64 * j];
            x = x + g * (p * w1 + q * w2);
            xr[64 * j] = x; }
    }
}

#define IN(k) (lo <= (k) && (k) < hi)
#define GRIDBAR() do { XcdBarrier b2_; b2_.bar = (unsigned*)(KARGS()->ws + WS_CTL) + CW_BAR; b2_.x = xb_xcc_id(); b2_.st = (volatile LAS unsigned*)(lds + MISC_OFF) + 8; xcd_barrier(b2_, wv0 * 64 + (int)__builtin_amdgcn_mbcnt_hi(~0u, __builtin_amdgcn_mbcnt_lo(~0u, 0u))); } while (0)
#define SEAM(k) do { if (IN(k) && IN((k) + 1)) GRIDBAR(); } while (0)
#define PHASE_ROOTS() KA a = KARGS(); unsigned char* ws = a->ws; const float* vec = (const float*)(ws + WS_VEC); (void)vec; int bid = blockIdx.x, G = gridDim.x; asm volatile("" : "+s"(bid), "+s"(G)); int tid = wv0 * 64 + (int)__builtin_amdgcn_mbcnt_hi(~0u, __builtin_amdgcn_mbcnt_lo(~0u, 0u)); asm volatile("" : "+v"(tid)); const int lane = tid & 63, wave = __builtin_amdgcn_readfirstlane(tid >> 6); (void)lane; (void)wave

template <int l> __device__ __forceinline__ void layer_body(const int lo, const int hi, LAS unsigned char* lds, const int wv0) {
        const int pb = 1 + 11 * l;
        if (IN(pb + 0)) { PHASE_ROOTS(); phase_norm(a, l, 0, R_ALL, (bf16*)(ws + WS_H), lane, wave, G, bid); SEAM(pb + 0); }
        if (IN(pb + 1)) {
            PHASE_ROOTS();
            pg8::Gemm g{(const pg8::bf16_t*)(ws + WS_H), (const pg8::bf16_t*)(ws + WS_WIN) + (size_t)l * INW * DM, R_ALL, INW, DM, 0, DM};
            pg8::StaticOrder S; S.init(R_ALL, INW, G, bid);
            pg8::EpiBf16<0> E{(pg8::bf16_t*)(ws + WS_PROJ), INW, nullptr, 0, 0, 1.f};
            pg8::gemm_phase<pg8::EpiBf16<0>, pg8::StaticOrder, true, true>(lds, g, S, E, tid);
            moe_conv_range(a, l == 0 ? MOE_SL0 : MOE_SL2, l == 0 ? MOE_SL1 : MOE_SL3, 650 - 2 * 256, lds, lane, wave, G, bid);
            SEAM(pb + 1);
        }
        if (IN(pb + 2)) {
            PHASE_ROOTS();
            qk_prep(a, l, bid * NTHR + tid, G * NTHR);
            for (int it = bid * NWAVES + wave; it < 520; it += G * NWAVES) vt_item(a, it, lane);
            for (int it = bid; it < 1040; it += G) hgrn_stepA(a, l, it >> 2, it & 3, lds, lane, wave);
            if (l == 0) { __syncthreads(); moe_conv_range(a, MOE_SL3, MOE_SL4, 1040 - 4 * 256, lds, lane, wave, G, bid); }
            SEAM(pb + 2);
        }
        if (IN(pb + 3)) {
            PHASE_ROOTS();
            if (bid < 64) hgrn_stepB(a, bid, tid);
            {
                const int nu = (l == 0) ? 260 : 256, ng = (l == 0) ? 520 : 512;
                unsigned* qctr = (unsigned*)(ws + WS_CTL) + CW_QUEUE + 64 * l;
                volatile LAS unsigned* qslot = (volatile LAS unsigned*)(lds + MISC_OFF) + 16;
                for (;;) {
                    __syncthreads();
                    if (tid == 0) qslot[0] = __hip_atomic_fetch_add(qctr, 1u, RLX_AGENT);
                    __syncthreads();
                    const int it = __builtin_amdgcn_readfirstlane((int)qslot[0]);
                    if (it >= nu + ng) break;
                    if (it < nu) attn_unit(a, l, it, lds, tid, lane, wave);
                    else gmlp_unit_mma(a, l, (it - nu) >> 2, (it - nu) & 3, lds, tid, lane, wave);
                }
            }
            SEAM(pb + 3);
        }
        if (IN(pb + 4)) {
            PHASE_ROOTS();
            const int nit = (l == 0) ? 1040 : 1024;
            for (int it = bid; it < nit; it += G) hgrn_stepC(a, l, it >> 2, it & 3, lds, tid, lane, wave);
            if (l == 0) { __syncthreads(); moe_conv_range(a, MOE_SL4, MOE_DEFER, 1040 - 4 * 256, lds, lane, wave, G, bid); }
            SEAM(pb + 4);
        }
        if (IN(pb + 5)) {
            PHASE_ROOTS();
            const float* modl = vec + VO_MOD + (l * 2 + 0) * 6144; const float* modc = vec + VO_MOD + (l * 2 + 1) * 6144;
            const int M = S_LAT;
            pg8::Gemm g{(const pg8::bf16_t*)(ws + WS_MIX), (const pg8::bf16_t*)(ws + WS_WOUT) + (size_t)l * DM * DM, M, DM, DM, 0, DM};
            pg8::StaticOrder S; S.init(M, DM, G, bid);
            pg8::EpiResid E{(l == 0) ? a->in[I_X] : a->out, a->out, modl + 2048, a->in[I_CTX], (float*)(ws + WS_CTXR), modc + 2048, S_LAT / 256, DM};
            pg8::gemm_phase<pg8::EpiResid, pg8::StaticOrder, true, true>(lds, g, S, E, tid);
            if (l == 0) {
                pg8::Gemm g2{(const pg8::bf16_t*)(ws + WS_MIX), (const pg8::bf16_t*)(ws + WS_WOUT), R_ALL, DM, 256, 0, DM};
                pg8::SplitKOrder S2{S_LAT / 256, 4, 4, 256, 16, bid, nullptr};
                pg8::EpiAtomic E2{(float*)(ws + WS_CTXR), modc + 2048, S_LAT / 256, DM, 1.0f};
                pg8::gemm_phase<pg8::EpiAtomic, pg8::SplitKOrder, false, true>(lds, g2, S2, E2, tid);
            }
            SEAM(pb + 5);
        }
        if (l == 0) {
            if (IN(pb + 6)) { PHASE_ROOTS(); phase_norm(a, l, 1, R_ALL, (bf16*)(ws + WS_H), lane, wave, G, bid); SEAM(pb + 6); }
            if (IN(pb + 7)) {
                PHASE_ROOTS();
                pg8::Gemm g{(const pg8::bf16_t*)(ws + WS_H), (const pg8::bf16_t*)(ws + WS_WGU), R_ALL, 2 * FFN, DM, 0, DM};
                pg8::StaticOrder S; S.init(R_ALL, 2 * FFN, G, bid);
                pg8::EpiSwiGLU E{(pg8::bf16_t*)(ws + WS_HID), FFN, 1.0f};
                pg8::gemm_phase<pg8::EpiSwiGLU, pg8::StaticOrder, true, true>(lds, g, S, E, tid);
                moe_conv_range(a, MOE_SL1, MOE_SL2, 1430 - 5 * 256, lds, lane, wave, G, bid);
                SEAM(pb + 7);
            }
            if (IN(pb + 8)) {
                PHASE_ROOTS();
                const float* modl = vec + VO_MOD + (l * 2 + 0) * 6144; const float* modc = vec + VO_MOD + (l * 2 + 1) * 6144;
                pg8::Gemm g{(const pg8::bf16_t*)(ws + WS_HID), (const pg8::bf16_t*)(ws + WS_WD), S_LAT, DM, FFN, 0, FFN};
                pg8::StaticOrder S; S.init(S_LAT, DM, G, bid);
                pg8::EpiResid E{a->out, a->out, modl + 5120, (const float*)(ws + WS_CTXR), (float*)(ws + WS_CTXR), modc + 5120, S_LAT / 256, DM};
                pg8::gemm_phase<pg8::EpiResid, pg8::StaticOrder, true, true>(lds, g, S, E, tid);
                {
                    pg8::Gemm g2{(const pg8::bf16_t*)(ws + WS_HID), (const pg8::bf16_t*)(ws + WS_WD), R_ALL, DM, 256, 0, FFN};
                    pg8::SplitKOrder S2{S_LAT / 256, 4, 11, 256, 44, bid, nullptr};
                    pg8::EpiAtomic E2{(float*)(ws + WS_CTXR), modc + 5120, S_LAT / 256, DM, 1.0f};
                    pg8::gemm_phase<pg8::EpiAtomic, pg8::SplitKOrder, false, true>(lds, g2, S2, E2, tid);
                }
                if (IN(pb + 8) && IN(pb + 11)) GRIDBAR();
            }
        } else {
            if (IN(pb + 6)) { PHASE_ROOTS(); phase_norm_route(a, lds, tid, lane, wave, G, bid); SEAM(pb + 6); }
            if (IN(pb + 7)) { PHASE_ROOTS(); moe_gather(a, lds, tid, lane, wave, G, bid); SEAM(pb + 7); }
            if (IN(pb + 8)) {
                PHASE_ROOTS();
                const int* mi = (const int*)(ws + WS_VEC) + VO_MOE; const int nt = __builtin_amdgcn_readfirstlane(mi[0]);
                pg8::Gemm g{(const pg8::bf16_t*)(ws + WS_AS), (const pg8::bf16_t*)(ws + WS_MGU), nt * 256, 2 * EXD, DM / 2, (size_t)2 * EXD * DM, DM / 2};
                pg8::MoeOrder S; S.init(nt * 256, 2 * EXD, G, bid); S.tile_e = mi + 16;
                pg8::EpiSwiGLU8 E{(unsigned char*)(ws + WS_HIDM), EXD, 1.0f / (F8_WSCALE * F8_ASCALE), F8_HSCALE};
                pg8::gemm_phase<pg8::EpiSwiGLU8, pg8::MoeOrder, true, true, true>(lds, g, S, E, tid);
                SEAM(pb + 8);
            }
            if (IN(pb + 9)) {
                PHASE_ROOTS();
                const int* mi = (const int*)(ws + WS_VEC) + VO_MOE; const int nt = __builtin_amdgcn_readfirstlane(mi[0]); const int nm = nt < 128 ? nt : 128;
                pg8::Gemm g{(const pg8::bf16_t*)(ws + WS_HIDM), (const pg8::bf16_t*)(ws + WS_MD), nm * 256, DM, EXD / 2, (size_t)DM * EXD, EXD / 2};
                pg8::MoeOrder S; S.init(nm * 256, DM, G, bid); S.tile_e = mi + 16;
                pg8::EpiScaleBf16 E{(pg8::bf16_t*)(ws + WS_Y), DM, 1.0f / (F8_WSCALE * F8_HSCALE)};
                pg8::gemm_phase<pg8::EpiScaleBf16, pg8::MoeOrder, true, true, true>(lds, g, S, E, tid);
                if (nt > 128) {
                    pg8::Gemm g2{(const pg8::bf16_t*)(ws + WS_HIDM), (const pg8::bf16_t*)(ws + WS_MD), nt * 256, DM, 256, (size_t)DM * EXD, EXD / 2};
                    pg8::SplitKOrder S2{128, 4, 7, 256, (nt - 128) * 28, bid, mi + 16};
                    pg8::EpiAtomic E2{(float*)(ws + WS_YF), nullptr, 128, DM, 1.0f / (F8_WSCALE * F8_HSCALE)};
                    pg8::gemm_phase<pg8::EpiAtomic, pg8::SplitKOrder, false, true, true>(lds, g2, S2, E2, tid);
                }
                SEAM(pb + 9);
            }
            if (IN(pb + 10)) { PHASE_ROOTS(); moe_combine(a, lane, wave, G, bid); }
        }
    }
__global__ void __launch_bounds__(NTHR, 2) fwd_kernel(Args a_unused) {
    extern __shared__ __attribute__((aligned(16))) unsigned char lds_raw[];
    LAS unsigned char* lds = (LAS unsigned char*)lds_raw;
    const int tid0 = threadIdx.x;
    const int wv0 = __builtin_amdgcn_readfirstlane(tid0 >> 6);
    for (int u = tid0; u < (LDS_BYTES - LDSCTL_OFF) / 4; u += NTHR) ((LAS unsigned*)(lds + LDSCTL_OFF))[u] = 0u;
    __syncthreads();
    const int lo = KARGS()->ph_lo, hi = KARGS()->ph_hi;
    const bool fusedl = (hi - lo) > 1;
    if (fusedl) (void)xcd_barrier_post((unsigned*)(KARGS()->ws + WS_CTL) + CW_BAR, (volatile LAS unsigned*)(lds + MISC_OFF) + 8);
    if (IN(0)) { PHASE_ROOTS(); p0_prologue(a, lds, tid, lane, wave, G, bid); SEAM(0); }

    layer_body<0>(lo, hi, lds, wv0);
    layer_body<1>(lo, hi, lds, wv0);
}

extern "C" void kernel_launch(void* const* d_in, const int* in_sizes, int n_in, void* d_out, int out_size, void* d_ws, size_t ws_size, hipStream_t stream) {
    static int grid = 0;
    if (grid == 0) {
        if (n_in != 23 || in_sizes[0] != S_LAT * DM || out_size != S_LAT * DM || ws_size < WS_END) { fprintf(stderr, "kernel_launch: unexpected shapes / workspace (n_in %d, ws %zu, need %zu)\n", n_in, ws_size, (size_t)WS_END); grid = -1; return; }
        int dev = 0, cus = 0;
        if (hipGetDevice(&dev) != hipSuccess || hipDeviceGetAttribute(&cus, hipDeviceAttributeMultiprocessorCount, dev) != hipSuccess) { grid = -1; return; }
        if (hipFuncSetAttribute((const void*)fwd_kernel, hipFuncAttributeMaxDynamicSharedMemorySize, LDS_BYTES) != hipSuccess) { grid = -1; return; }
        int per_cu = 0;
        (void)hipOccupancyMaxActiveBlocksPerMultiprocessor(&per_cu, (const void*)fwd_kernel, NTHR, LDS_BYTES);
        (void)hipGetLastError();
        grid = cus;
    }
    if (grid < 0) return;
    if (hipMemsetAsync((char*)d_ws + WS_CTL, 0, CTL_ZERO_BYTES, stream) != hipSuccess) return;
    Args a{};
    for (int i = 0; i < 23; ++i) a.in[i] = (const float*)d_in[i];
    a.out = (float*)d_out; a.ws = (unsigned char*)d_ws;
#if ONE_LAUNCH
    a.ph_lo = 0; a.ph_hi = NPH;
    hipLaunchKernelGGL(fwd_kernel, dim3(grid), dim3(NTHR), LDS_BYTES, stream, a);
#else
    for (int p = 0; p < NPH; ++p) {
        if (p == 10 || p == 11) continue;
        a.ph_lo = p; a.ph_hi = p + 1;
        hipLaunchKernelGGL(fwd_kernel, dim3(grid), dim3(NTHR), LDS_BYTES, stream, a);
    }
#endif
}
```

```cpp
#include <hip/hip_runtime.h>
#include <cstdio>
#include <cstdint>
#include <cmath>
#ifndef ONE_LAUNCH
#define ONE_LAUNCH 1
#endif
namespace pg8 {
#define PG8_LAS __attribute__((address_space(3)))
typedef unsigned short bf16_t;
typedef short bf16x8 __attribute__((ext_vector_type(8)));
typedef float f32x4 __attribute__((ext_vector_type(4)));
typedef unsigned u32x4 __attribute__((ext_vector_type(4)));
constexpr int BM = 256, BK = 64, HALF = 128, HTB = HALF * BK * 2  , STAGE_BYTES = 8 * HTB, NXCD = 8, WGM = 8;

__host__ __device__ __forceinline__ int lds_byte(int r, int c) { const int st = (r >> 4) * 2 + (c >> 5), rr = r & 15, cc = c & 31, ob = rr * 64 + cc * 2; return st * 1024 + (ob ^ (((ob >> 9) & 1) << 5)); }
__host__ __device__ __forceinline__ void stage_rc(int b, int& R, int& C) { const int st = b / 1024, sb = b % 1024, swz = sb ^ (((sb >> 9) & 1) << 5); R = (st >> 1) * 16 + swz / 64; C = (st & 1) * 32 + (swz % 64) / 2; }
__host__ __device__ __forceinline__ int perm32(int rho) { const int n = rho >> 4, i = rho & 15; return 8 * (i >> 2) + 4 * n + (i & 3); }

struct Unit { int pm, pn, eb, ko; };
struct Gemm { const bf16_t* A; const bf16_t* Bt; int M, N, K; size_t bstride; int ld; };

struct StaticOrder {
    int nM, nN, nwg, G, c;
    __host__ __device__ void init(int M, int N, int G_, int c_) { nM = M / BM; nN = N / BM; nwg = nM * nN; G = G_; c = c_; }
    __host__ __device__ bool next(int i, Unit& u) const {
        const long L = (long)i * G + c; if (L >= nwg) return false;
        int wgid = (int)L; { const int q = nwg / NXCD, r = nwg % NXCD, xcd = wgid % NXCD, off = wgid / NXCD; wgid = (xcd < r ? xcd * (q + 1) : r * (q + 1) + (xcd - r) * q) + off; }
        const int nig = WGM * nN, gid = wgid / nig, fm = gid * WGM, gsz = (nM - fm) < WGM ? (nM - fm) : WGM;
        u.pm = fm + ((wgid % nig) % gsz); u.pn = (wgid % nig) / gsz; u.eb = 0; u.ko = 0; return true;
    }
    __device__ __forceinline__ void a_ready(const Unit&) const {}
    __device__ __forceinline__ void done(const Unit&) const {}
};

__device__ __forceinline__ unsigned cvt_pk_bf16(float lo, float hi) { unsigned r; asm volatile("v_cvt_pk_bf16_f32 %0, %1, %2" : "=v"(r) : "v"(lo), "v"(hi)); return r; }
typedef float f32x2 __attribute__((ext_vector_type(2)));
__device__ __forceinline__ f32x2 gelu_pk(f32x2 v) {
    const f32x2 av = __builtin_elementwise_abs(v), d = av * 0.2316418882f + 1.0f;
    f32x2 t; t.x = __builtin_amdgcn_rcpf(d.x); t.y = __builtin_amdgcn_rcpf(d.y);
    f32x2 q = t * 0.5307027145f + (-0.7265760135f); q = q * t + 0.7107068705f; q = q * t + (-0.142248368f); q = q * t + 0.127414796f; q = q * t;
    const f32x2 s = (v * v) * (-0.72134752044f);
    f32x2 e; e.x = __builtin_amdgcn_exp2f(s.x); e.y = __builtin_amdgcn_exp2f(s.y);
    const f32x2 m = v * (q * e), r = v - m;
    f32x2 o; o.x = v.x < 0.f ? m.x : r.x; o.y = v.y < 0.f ? m.y : r.y; return o;
}

template <int ACT  > struct EpiBf16 {
    static constexpr bool PERM = true, AFTER_DRAIN = false; static_assert(ACT == 0 || ACT == 1, "EpiBf16: ACT is 0 (none) or 1 (gelu_pk)");
    bf16_t* O; int ldc; const float* bias; int split_cols; size_t split_stride; float scale0;
    __device__ __forceinline__ void operator()(const f32x4 (&acc)[2][2][4][2], const Unit& u, int wr, int wc, int fr, int fq) const {
        const int row0 = u.pm * BM + wr * 64 + fr; int colt = u.pn * BM; bf16_t* base = O;
        float sc = 1.f; if (split_cols) { const int t = colt / split_cols; base += (size_t)t * split_stride; colt -= t * split_cols; if (t == 0) sc = scale0; }
        const int col0 = colt + wc * 32 + 8 * fq, bcol0 = u.pn * BM + wc * 32 + 8 * fq;
        f32x4 bv[2][2];
#pragma unroll
        for (int bj = 0; bj < 2; ++bj)
#pragma unroll
            for (int n = 0; n < 2; ++n) bv[bj][n] = bias ? *(const f32x4*)(bias + bcol0 + bj * HALF + 4 * n) : (f32x4){0.f, 0.f, 0.f, 0.f};
#pragma unroll
        for (int ai = 0; ai < 2; ++ai)
#pragma unroll
            for (int m = 0; m < 4; ++m) { bf16_t* rowp = base + (size_t)(row0 + ai * HALF + m * 16) * ldc + col0;
#pragma unroll
                for (int bj = 0; bj < 2; ++bj) { f32x4 v0 = acc[ai][bj][m][0] + bv[bj][0], v1 = acc[ai][bj][m][1] + bv[bj][1];
                    if (ACT == 1) { f32x2 a = gelu_pk((f32x2){v0[0], v0[1]}), b = gelu_pk((f32x2){v0[2], v0[3]}), c = gelu_pk((f32x2){v1[0], v1[1]}), d = gelu_pk((f32x2){v1[2], v1[3]});
                        v0 = (f32x4){a.x, a.y, b.x, b.y}; v1 = (f32x4){c.x, c.y, d.x, d.y}; }
                    v0 = v0 * sc; v1 = v1 * sc; u32x4 w; w.x = cvt_pk_bf16(v0[0], v0[1]); w.y = cvt_pk_bf16(v0[2], v0[3]); w.z = cvt_pk_bf16(v1[0], v1[1]); w.w = cvt_pk_bf16(v1[2], v1[3]);
                    *(u32x4*)(rowp + bj * HALF) = w; } }
    }
};

__device__ __forceinline__ float silu_f(float x) { return x * __builtin_amdgcn_rcpf(1.0f + __builtin_amdgcn_exp2f(-1.4426950408889634f * x)); }
struct EpiResid {
    static constexpr bool PERM = false, AFTER_DRAIN = false;
    const float* base; float* out; const float* gate; const float* cbase; float* cout; const float* cgate; int mlat; int ldc;
    __device__ __forceinline__ void operator()(const f32x4 (&acc)[2][2][4][2], const Unit& u, int wr, int wc, int fr, int fq) const {
        const bool isc = u.pm >= mlat;
        const float* b = isc ? cbase : base; float* o = isc ? cout : out; const float* g = isc ? cgate : gate;
        const int row0 = (isc ? (u.pm - mlat) : u.pm) * BM + wr * 64 + fr, col0 = u.pn * BM + wc * 32 + 4 * fq;
        f32x4 gv[2][2];
#pragma unroll
        for (int bj = 0; bj < 2; ++bj)
#pragma unroll
            for (int n = 0; n < 2; ++n) gv[bj][n] = *(const f32x4*)(g + col0 + bj * HALF + n * 16);
#pragma unroll
        for (int ai = 0; ai < 2; ++ai)
#pragma unroll
            for (int m = 0; m < 4; ++m) { const size_t off = (size_t)(row0 + ai * HALF + m * 16) * ldc + col0;
#pragma unroll
                for (int bj = 0; bj < 2; ++bj)
#pragma unroll
                    for (int n = 0; n < 2; ++n) { const f32x4 bs = *(const f32x4*)(b + off + bj * HALF + n * 16); *(f32x4*)(o + off + bj * HALF + n * 16) = bs + gv[bj][n] * acc[ai][bj][m][n]; }
                if (m & 1) asm volatile("" ::: "memory"); }
    }
};
struct EpiSwiGLU {
    static constexpr bool PERM = true, AFTER_DRAIN = false;
    bf16_t* O; int ldc; float ds;
    __device__ __forceinline__ void operator()(const f32x4 (&acc)[2][2][4][2], const Unit& u, int wr, int wc, int fr, int fq) const {
        const int row0 = u.pm * BM + wr * 64 + fr, col0 = u.pn * HALF + wc * 32 + 8 * fq;
#pragma unroll
        for (int ai = 0; ai < 2; ++ai)
#pragma unroll
            for (int m = 0; m < 4; ++m) { bf16_t* rowp = O + (size_t)(row0 + ai * HALF + m * 16) * ldc + col0;
                const f32x4 g0 = acc[ai][0][m][0] * ds, g1 = acc[ai][0][m][1] * ds, u0 = acc[ai][1][m][0] * ds, u1 = acc[ai][1][m][1] * ds;
                f32x4 h0, h1;
#pragma unroll
                for (int j = 0; j < 4; ++j) { h0[j] = silu_f(g0[j]) * u0[j]; h1[j] = silu_f(g1[j]) * u1[j]; }
                u32x4 w; w.x = cvt_pk_bf16(h0[0], h0[1]); w.y = cvt_pk_bf16(h0[2], h0[3]); w.z = cvt_pk_bf16(h1[0], h1[1]); w.w = cvt_pk_bf16(h1[2], h1[3]);
                *(u32x4*)rowp = w; }
    }
};
struct MoeOrder : StaticOrder {
    const int* tile_e;
    __device__ __forceinline__ bool next(int i, Unit& u) const { if (!StaticOrder::next(i, u)) return false; u.eb = __builtin_amdgcn_readfirstlane(tile_e[u.pm]); return true; }
};

struct SplitKOrder {
    int pm0, nN, P, kp, total, c; const int* tile_e;
    __device__ __forceinline__ bool next(int i, Unit& u) const {
        if (i != 0 || c >= total) return false;
        const int p = c % P, t = c / P; u.pn = t % nN; u.pm = pm0 + t / nN; u.ko = p * kp; u.eb = tile_e ? __builtin_amdgcn_readfirstlane(tile_e[u.pm]) : 0; return true; }
    __device__ __forceinline__ void a_ready(const Unit&) const {}
    __device__ __forceinline__ void done(const Unit&) const {}
};
struct EpiAtomic {
    static constexpr bool PERM = false, AFTER_DRAIN = true;
    float* out; const float* scale; int pm_sub; int ldc; float ds;
    __device__ __forceinline__ void fused(f32x4 (&acc)[2][2][4][2], const Unit& u, int wr, int wc, int fr, int fq, PG8_LAS unsigned char* lds, int wid, int lane) const {
        PG8_LAS float* scr = (PG8_LAS float*)(lds + wid * 16384);
        const int rr = lane >> 5, cc = lane & 31;
#pragma unroll
        for (int ai = 0; ai < 2; ++ai)
#pragma unroll
            for (int bj = 0; bj < 2; ++bj) {
#pragma unroll
                for (int m = 0; m < 4; ++m)
#pragma unroll
                    for (int n = 0; n < 2; ++n) *(PG8_LAS f32x4*)(scr + (m * 16 + fr) * 36 + n * 16 + 4 * fq) = acc[ai][bj][m][n];
                asm volatile("s_waitcnt lgkmcnt(0)" ::: "memory");
                const int colg = u.pn * BM + bj * HALF + wc * 32 + cc; const float sc = (scale ? scale[colg] : 1.0f) * ds;
                float* op = out + (size_t)((u.pm - pm_sub) * BM + ai * HALF + wr * 64 + rr) * ldc + colg;
#pragma unroll 8
                for (int i = 0; i < 32; ++i) { const float v = scr[(2 * i + rr) * 36 + cc]; __hip_atomic_fetch_add(op + (size_t)(2 * i) * ldc, v * sc, __ATOMIC_RELAXED, __HIP_MEMORY_SCOPE_AGENT); }
                asm volatile("s_waitcnt lgkmcnt(0)" ::: "memory");
            }
    }
};

typedef int i32x4v __attribute__((ext_vector_type(4))); typedef int i32x8v __attribute__((ext_vector_type(8)));
struct FragB { bf16x8 k[2]; };
struct Frag8 { i32x8v v; };
template <bool F8> struct FragSel { typedef FragB type; };
template <> struct FragSel<true> { typedef Frag8 type; };
__device__ __forceinline__ void ld_frag(FragB& f, const PG8_LAS unsigned char* p) { f.k[0] = *(const PG8_LAS bf16x8*)p; f.k[1] = *(const PG8_LAS bf16x8*)(p + 1024); }
__device__ __forceinline__ void ld_frag(Frag8& f, const PG8_LAS unsigned char* p) { const i32x4v lo = *(const PG8_LAS i32x4v*)p, hi = *(const PG8_LAS i32x4v*)(p + 1024); f.v = __builtin_shufflevector(lo, hi, 0, 1, 2, 3, 4, 5, 6, 7); }
__device__ __forceinline__ f32x4 mma_frag(const FragB& b, const FragB& a, f32x4 c) { c = __builtin_amdgcn_mfma_f32_16x16x32_bf16(b.k[0], a.k[0], c, 0, 0, 0); return __builtin_amdgcn_mfma_f32_16x16x32_bf16(b.k[1], a.k[1], c, 0, 0, 0); }
__device__ __forceinline__ f32x4 mma_frag(const Frag8& b, const Frag8& a, f32x4 c) {
    asm volatile("v_mfma_scale_f32_16x16x128_f8f6f4 %0, %1, %2, %0, %3, %3 op_sel_hi:[0,0,0]" : "+v"(c) : "v"(b.v), "v"(a.v), "v"(0x7f7f7f7f));
    return c;
}

struct EpiSwiGLU8 {
    static constexpr bool PERM = true, AFTER_DRAIN = false;
    unsigned char* O; int ldc; float ds, hs;
    __device__ __forceinline__ void operator()(const f32x4 (&acc)[2][2][4][2], const Unit& u, int wr, int wc, int fr, int fq) const {
        const int row0 = u.pm * BM + wr * 64 + fr, col0 = u.pn * HALF + wc * 32 + 8 * fq;
#pragma unroll
        for (int ai = 0; ai < 2; ++ai)
#pragma unroll
            for (int m = 0; m < 4; ++m) { unsigned char* rowp = O + (size_t)(row0 + ai * HALF + m * 16) * ldc + col0;
                const f32x4 g0 = acc[ai][0][m][0] * ds, g1 = acc[ai][0][m][1] * ds, u0 = acc[ai][1][m][0] * ds, u1 = acc[ai][1][m][1] * ds;
                float h[8];
#pragma unroll
                for (int j = 0; j < 4; ++j) { h[j] = fminf(fmaxf(silu_f(g0[j]) * u0[j] * hs, -448.0f), 448.0f); h[4 + j] = fminf(fmaxf(silu_f(g1[j]) * u1[j] * hs, -448.0f), 448.0f); }
                unsigned lo = 0u, hi = 0u;
                lo = __builtin_amdgcn_cvt_pk_fp8_f32(h[0], h[1], lo, false); lo = __builtin_amdgcn_cvt_pk_fp8_f32(h[2], h[3], lo, true);
                hi = __builtin_amdgcn_cvt_pk_fp8_f32(h[4], h[5], hi, false); hi = __builtin_amdgcn_cvt_pk_fp8_f32(h[6], h[7], hi, true);
                typedef unsigned u32x2 __attribute__((ext_vector_type(2)));
                *(u32x2*)rowp = (u32x2){lo, hi}; }
    }
};
struct EpiScaleBf16 {
    static constexpr bool PERM = true, AFTER_DRAIN = false;
    bf16_t* O; int ldc; float ds;
    __device__ __forceinline__ void operator()(const f32x4 (&acc)[2][2][4][2], const Unit& u, int wr, int wc, int fr, int fq) const {
        const int row0 = u.pm * BM + wr * 64 + fr, col0 = u.pn * BM + wc * 32 + 8 * fq;
#pragma unroll
        for (int ai = 0; ai < 2; ++ai)
#pragma unroll
            for (int m = 0; m < 4; ++m) { bf16_t* rowp = O + (size_t)(row0 + ai * HALF + m * 16) * ldc + col0;
#pragma unroll
                for (int bj = 0; bj < 2; ++bj) { const f32x4 v0 = acc[ai][bj][m][0] * ds, v1 = acc[ai][bj][m][1] * ds;
                    u32x4 w; w.x = cvt_pk_bf16(v0[0], v0[1]); w.y = cvt_pk_bf16(v0[2], v0[3]); w.z = cvt_pk_bf16(v1[0], v1[1]); w.w = cvt_pk_bf16(v1[2], v1[3]);
                    *(u32x4*)(rowp + bj * HALF) = w; } }
    }
};

template <class Epi, class Sched, bool ALIGN_EPI = false, bool SP2 = false, bool F8 = false>
__device__ __forceinline__ void gemm_phase(PG8_LAS unsigned char* lds, const Gemm g, const Sched& S, const Epi& E, int tid_in) {
    int tid_ = tid_in; asm volatile("" : "+v"(tid_));
    const int tid = tid_, wid = __builtin_amdgcn_readfirstlane(tid >> 6), lane = tid & 63, wr = wid >> 2, wc = wid & 3, fr = lane & 15, fq = lane >> 4;
    const int K = g.K, nt = K / BK, ld = g.ld;
    unsigned voffA[2], voffB[2];
#pragma unroll
    for (int i = 0; i < 2; ++i) { int R, C; stage_rc(tid * 16 + i * 8192, R, C); const int Rb = Epi::PERM ? ((R & ~31) + perm32(R & 31)) : R;
        voffA[i] = (unsigned)(R * ld + C) * 2u; voffB[i] = (unsigned)(Rb * ld + C) * 2u; }
    const size_t kstep = (size_t)(BK * 2);
    const size_t hstep = (size_t)HALF * ld * 2;
    const size_t tstep = 2 * hstep;
    const unsigned ldsw = (unsigned)wid * 1024u;
    const int aoff = lds_byte(wr * 64 + fr, fq * 8), boff = lds_byte(wc * 32 + fr, fq * 8);
#define PG8_SA(b, h) (((b) * 2 + (h)) * HTB)
#define PG8_SB(b, h) ((4 + (b) * 2 + (h)) * HTB)
#define PG8_STAGE(bufoff, gbase, voff) do { _Pragma("unroll") for (int _i = 0; _i < 2; ++_i) \
        __builtin_amdgcn_global_load_lds((const unsigned*)((const char*)(gbase) + (voff)[_i]), (PG8_LAS unsigned*)(lds + (bufoff) + ldsw + _i * 8192), 16, 0, 0); } while (0)
#define PG8_LDA(dst, b, h) do { _Pragma("unroll") for (int m = 0; m < 4; ++m) ld_frag(dst[m], lds + PG8_SA(b, h) + aoff + m * 2048); } while (0)
#define PG8_LDB(dst, b, h) do { _Pragma("unroll") for (int n = 0; n < 2; ++n) ld_frag(dst[n], lds + PG8_SB(b, h) + boff + n * 2048); } while (0)
#define PG8_MMA(ai, bj, At, Bt) do { __builtin_amdgcn_s_setprio(1); _Pragma("unroll") for (int m = 0; m < 4; ++m) _Pragma("unroll") for (int n = 0; n < 2; ++n) \
        acc[ai][bj][m][n] = mma_frag(Bt[n], At[m], acc[ai][bj][m][n]); __builtin_amdgcn_s_setprio(0); } while (0)
#define PG8_WAIT_V(n) asm volatile("s_waitcnt vmcnt(" #n ")" ::: "memory")
#define PG8_WAIT_L(n) asm volatile("s_waitcnt lgkmcnt(" #n ")" ::: "memory")
#define PG8_BAR __builtin_amdgcn_s_barrier()
#define PG8_SCHED __builtin_amdgcn_sched_barrier(0)
    Unit cur, nxt; int ui = 0;
    if (!S.next(0, cur)) return;
    float zacc = 0.f; asm volatile("" : "+v"(zacc));
    f32x4 acc[2][2][4][2];
#pragma unroll
    for (int a = 0; a < 2; ++a)
#pragma unroll
        for (int b = 0; b < 2; ++b)
#pragma unroll
            for (int m = 0; m < 4; ++m)
#pragma unroll
                for (int n = 0; n < 2; ++n) acc[a][b][m][n] = (f32x4){zacc, zacc, zacc, zacc};
    typedef typename FragSel<F8>::type Frag;
    Frag At[4], B0[2], B1[2];
    const char* cA = (const char*)g.A + (size_t)cur.pm * tstep + (size_t)cur.ko * 2; const char* cB = (const char*)g.Bt + (size_t)cur.eb * g.bstride + (size_t)cur.pn * tstep + (size_t)cur.ko * 2;
    S.a_ready(cur);
    if constexpr (SP2) {
        PG8_STAGE(PG8_SB(0, 0), cB, voffB); PG8_STAGE(PG8_SB(0, 1), cB + hstep, voffB); PG8_STAGE(PG8_SA(0, 0), cA, voffA); PG8_STAGE(PG8_SA(0, 1), cA + hstep, voffA);
        if (wr == 1) PG8_BAR;
        PG8_WAIT_V(2); PG8_BAR;
        PG8_STAGE(PG8_SB(1, 0), cB + kstep, voffB); PG8_STAGE(PG8_SA(1, 0), cA + kstep, voffA); PG8_STAGE(PG8_SB(1, 1), cB + hstep + kstep, voffB);
        PG8_WAIT_V(6); PG8_BAR;
    } else {
        PG8_STAGE(PG8_SB(0, 0), cB, voffB); PG8_STAGE(PG8_SA(0, 0), cA, voffA); PG8_STAGE(PG8_SB(0, 1), cB + hstep, voffB); PG8_STAGE(PG8_SA(0, 1), cA + hstep, voffA);
        if (wr == 1) PG8_BAR;
        PG8_WAIT_V(4); PG8_BAR;
        PG8_STAGE(PG8_SB(1, 0), cB + kstep, voffB); PG8_STAGE(PG8_SA(1, 0), cA + kstep, voffA); PG8_STAGE(PG8_SB(1, 1), cB + hstep + kstep, voffB);
        PG8_WAIT_V(6); PG8_BAR;
    }
    for (;;) {
        const bool has_next = S.next(ui + 1, nxt);
        const char* nA = has_next ? (const char*)g.A + (size_t)nxt.pm * tstep + (size_t)nxt.ko * 2 : cA; const char* nB = has_next ? (const char*)g.Bt + (size_t)nxt.eb * g.bstride + (size_t)nxt.pn * tstep + (size_t)nxt.ko * 2 : cB;
        for (int t = 0; t < nt; t += 2) {
            const bool last = (t == nt - 2);
            const char* a1 = cA + (size_t)(t + 1) * kstep;
            const char* a2 = last ? nA : cA + (size_t)(t + 2) * kstep; const char* b2 = last ? nB : cB + (size_t)(t + 2) * kstep;
            const char* a3 = a2 + kstep; const char* b3 = b2 + kstep;
            if (last && has_next) S.a_ready(nxt);
            if constexpr (SP2) {
            PG8_LDB(B0, 0, 0); PG8_LDB(B1, 0, 1); PG8_SCHED; PG8_LDA(At, 0, 0); PG8_STAGE(PG8_SA(1, 1), a1 + hstep, voffA);
            PG8_WAIT_V(8); PG8_WAIT_L(0); PG8_BAR; PG8_MMA(0, 0, At, B0); PG8_MMA(0, 1, At, B1); PG8_BAR; PG8_SCHED;
            PG8_LDA(At, 0, 1); PG8_STAGE(PG8_SB(0, 0), b2, voffB); PG8_STAGE(PG8_SB(0, 1), b2 + hstep, voffB); PG8_STAGE(PG8_SA(0, 0), a2, voffA);
            PG8_WAIT_V(8); PG8_WAIT_L(0); PG8_BAR; PG8_MMA(1, 0, At, B0); PG8_MMA(1, 1, At, B1); PG8_BAR; PG8_SCHED;
            PG8_LDB(B0, 1, 0); PG8_LDB(B1, 1, 1); PG8_SCHED; PG8_LDA(At, 1, 0); PG8_STAGE(PG8_SA(0, 1), a2 + hstep, voffA);
            PG8_WAIT_V(8); PG8_WAIT_L(0); PG8_BAR; PG8_MMA(0, 0, At, B0); PG8_MMA(0, 1, At, B1); PG8_BAR; PG8_SCHED;
            PG8_LDA(At, 1, 1); PG8_STAGE(PG8_SB(1, 0), b3, voffB); PG8_STAGE(PG8_SB(1, 1), b3 + hstep, voffB); PG8_STAGE(PG8_SA(1, 0), a3, voffA);
            PG8_WAIT_V(8); PG8_WAIT_L(0); PG8_BAR; PG8_MMA(1, 0, At, B0); PG8_MMA(1, 1, At, B1); PG8_BAR; PG8_SCHED;
            } else {
            PG8_LDB(B0, 0, 0); PG8_SCHED; PG8_LDA(At, 0, 0); PG8_STAGE(PG8_SA(1, 1), a1 + hstep, voffA);
            PG8_WAIT_L(8); PG8_BAR; PG8_WAIT_L(0); PG8_MMA(0, 0, At, B0); PG8_BAR; PG8_SCHED;
            PG8_LDB(B1, 0, 1); PG8_STAGE(PG8_SB(0, 0), b2, voffB);
            PG8_BAR; PG8_WAIT_L(0); PG8_MMA(0, 1, At, B1); PG8_BAR;
            PG8_LDA(At, 0, 1); PG8_STAGE(PG8_SA(0, 0), a2, voffA);
            PG8_BAR; PG8_WAIT_L(0); PG8_MMA(1, 0, At, B0); PG8_BAR; PG8_SCHED;
            PG8_STAGE(PG8_SB(0, 1), b2 + hstep, voffB);
            PG8_WAIT_V(6); PG8_BAR; PG8_MMA(1, 1, At, B1); PG8_BAR;
            PG8_LDB(B0, 1, 0); PG8_SCHED; PG8_LDA(At, 1, 0); PG8_STAGE(PG8_SA(0, 1), a2 + hstep, voffA);
            PG8_WAIT_L(8); PG8_BAR; PG8_WAIT_L(0); PG8_MMA(0, 0, At, B0); PG8_BAR; PG8_SCHED;
            PG8_LDB(B1, 1, 1); PG8_STAGE(PG8_SB(1, 0), b3, voffB);
            PG8_BAR; PG8_WAIT_L(0); PG8_MMA(0, 1, At, B1); PG8_BAR;
            PG8_LDA(At, 1, 1); PG8_STAGE(PG8_SA(1, 0), a3, voffA);
            PG8_BAR; PG8_WAIT_L(0); PG8_MMA(1, 0, At, B0); PG8_BAR; PG8_SCHED;
            PG8_STAGE(PG8_SB(1, 1), b3 + hstep, voffB);
            PG8_WAIT_V(6); PG8_BAR; PG8_MMA(1, 1, At, B1); PG8_BAR;
            }
        }
        if constexpr (ALIGN_EPI) { if (wr == 0) PG8_BAR; }
        if constexpr (F8) {
            asm volatile("s_nop 15\n\ts_nop 15" : "+v"(acc[1][1][0][0]), "+v"(acc[1][1][0][1]), "+v"(acc[1][1][1][0]), "+v"(acc[1][1][1][1]), "+v"(acc[1][1][2][0]), "+v"(acc[1][1][2][1]), "+v"(acc[1][1][3][0]), "+v"(acc[1][1][3][1])); }
        if constexpr (!Epi::AFTER_DRAIN) { E(acc, cur, wr, wc, fr, fq); S.done(cur); }
        if (!has_next) break;
#pragma unroll
        for (int a = 0; a < 2; ++a)
#pragma unroll
            for (int b = 0; b < 2; ++b)
#pragma unroll
                for (int m = 0; m < 4; ++m)
#pragma unroll
                    for (int n = 0; n < 2; ++n) acc[a][b][m][n] = (f32x4){zacc, zacc, zacc, zacc};
        cur = nxt; cA = nA; cB = nB; ++ui;
        if constexpr (ALIGN_EPI) { if (wr == 1) PG8_BAR; }
    }
    PG8_WAIT_V(0);
    if constexpr (!ALIGN_EPI) { if (wr == 0) PG8_BAR; }
    PG8_BAR;
    if constexpr (Epi::AFTER_DRAIN) { E.fused(acc, cur, wr, wc, fr, fq, lds, wid, lane); S.done(cur); }
#undef PG8_SA
#undef PG8_SB
#undef PG8_STAGE
#undef PG8_LDA
#undef PG8_LDB
#undef PG8_MMA
#undef PG8_WAIT_V
#undef PG8_WAIT_L
#undef PG8_BAR
#undef PG8_SCHED
}
}


constexpr int S_LAT = 16384, C_CTX = 256, R_ALL = S_LAT + C_CTX, DM = 1024;
constexpr int INW = 2560, FFN = 2816, EXD = 3584, NEXP = 8;
constexpr int COL_AQ = 0, COL_AK = 512, COL_AV = 640, COL_HQ = 768, COL_HFF = 1024, COL_HFB = 1280, COL_HI = 1536, COL_HG = 1792, COL_GU = 2048, COL_GV = 2304;
constexpr int MIX_AT = 0, MIX_HG = 512, MIX_GM = 768;
constexpr int MOE_MAXROWS = 34816;
constexpr float EPS = 1e-6f;
constexpr int NWAVES = 8, NTHR = 512;
constexpr int NPH = 23;

constexpr size_t MiB = 1u << 20;
constexpr size_t WS_CTL = 0, CTL_ZERO_BYTES = 1 * MiB;
constexpr size_t WS_VEC = 1 * MiB;
constexpr size_t WS_TOK = 2 * MiB;
constexpr size_t WS_WIN = 3 * MiB;
constexpr size_t WS_WOUT = 13 * MiB;
constexpr size_t WS_WGU = 17 * MiB;
constexpr size_t WS_WD = 28 * MiB;
constexpr size_t WS_MGU = 34 * MiB;
constexpr size_t WS_MD = 146 * MiB;
constexpr size_t WS_H = 202 * MiB;
constexpr size_t WS_PROJ = 235 * MiB;
constexpr size_t WS_MIX = 317 * MiB;
constexpr size_t WS_HGO = 350 * MiB;
constexpr size_t WS_CTXR = 383 * MiB;
constexpr size_t WS_HLT = WS_HGO;
constexpr size_t WS_HSP = 384 * MiB;
constexpr size_t WS_HDG = 402 * MiB;
constexpr size_t WS_VT = 403 * MiB;
constexpr size_t WS_HID = WS_PROJ;
constexpr size_t WS_AS = 202 * MiB;
constexpr size_t WS_HIDM = 270 * MiB;
constexpr size_t WS_H2B = 440 * MiB;
constexpr size_t WS_YF = WS_WIN;
constexpr size_t WS_Y = WS_MGU;
constexpr size_t WS_END = 508 * MiB;
static_assert(WS_HID + (size_t)R_ALL * FFN * 2 <= WS_HGO && WS_AS + (size_t)MOE_MAXROWS * DM * 2 <= WS_HIDM && WS_HIDM + (size_t)MOE_MAXROWS * EXD * 2 <= WS_END, "ws map");
static_assert(WS_H2B >= WS_HIDM && WS_H2B + (size_t)S_LAT * DM * 2 <= WS_END && WS_H + (size_t)R_ALL * DM * 2 <= WS_PROJ && WS_PROJ + (size_t)R_ALL * INW * 2 <= WS_MIX && WS_MIX + (size_t)R_ALL * DM * 2 <= WS_HGO && WS_HGO + (size_t)2 * R_ALL * 256 * 4 <= WS_CTXR, "ws map 2");
constexpr int VO_MOD = 0;
constexpr int VO_ROPE = 32768;
constexpr int VO_MOE = 65536;
constexpr int CW_BAR = 4096;
constexpr int CW_QUEUE = 2048;
constexpr int CW_MOECNT = 1024;

constexpr int RING_BYTES = 131072;
constexpr int LDSCTL_OFF = 159744, MISC_OFF = LDSCTL_OFF + 320;
constexpr int LDS_BYTES = 163840;

#define GAS __attribute__((address_space(1)))
#define LAS __attribute__((address_space(3)))
typedef unsigned short bf16;
typedef unsigned v4u __attribute__((ext_vector_type(4)));
typedef unsigned v2u __attribute__((ext_vector_type(2)));
typedef float f32x4 __attribute__((ext_vector_type(4)));
typedef GAS unsigned gu32;
#define RLX_AGENT __ATOMIC_RELAXED, __HIP_MEMORY_SCOPE_AGENT
#define LDS_WAIT() asm volatile("s_waitcnt lgkmcnt(0)" ::: "memory")
typedef float f32x2_t __attribute__((ext_vector_type(2))); typedef __bf16 bf16x2_t __attribute__((ext_vector_type(2)));
__device__ __forceinline__ unsigned pk2(float lo, float hi) { const f32x2_t v = {lo, hi}; const bf16x2_t b = __builtin_convertvector(v, bf16x2_t); return __builtin_bit_cast(unsigned, b); }
__device__ __forceinline__ unsigned f2bf(float f) { return pk2(f, 0.f) & 0xffffu; }
__device__ __forceinline__ float bflo(unsigned w) { return __builtin_bit_cast(float, w << 16); }
__device__ __forceinline__ float bfhi(unsigned w) { return __builtin_bit_cast(float, w & 0xffff0000u); }
__device__ __forceinline__ float sigm1(float x) { return __builtin_amdgcn_rcpf(1.0f + __builtin_amdgcn_exp2f(-1.4426950408889634f * x)); }
__device__ __forceinline__ float silu1(float x) { return x * sigm1(x); }
__device__ __forceinline__ float gelu1(float x) { return 0.5f * x * (1.0f + erff(x * 0.70710678118654752f)); }
template <int X> __device__ __forceinline__ float sx(float v) { return __shfl_xor(v, X); }
__device__ __forceinline__ float sx32_add(float v) { return v + __shfl_xor(v, 32); }
__device__ __forceinline__ float sx32_max(float v) { return fmaxf(v, __shfl_xor(v, 32)); }
__device__ __forceinline__ float wave_sum(float v) { v += sx<1>(v); v += sx<2>(v); v += sx<4>(v); v += sx<8>(v); v += sx<16>(v); return sx32_add(v); }
__device__ __forceinline__ void unpack8(const v4u w, float* f) { f[0] = bflo(w.x); f[1] = bfhi(w.x); f[2] = bflo(w.y); f[3] = bfhi(w.y); f[4] = bflo(w.z); f[5] = bfhi(w.z); f[6] = bflo(w.w); f[7] = bfhi(w.w); }


__device__ __forceinline__ float clamp448(float x) { return fminf(fmaxf(x, -448.0f), 448.0f); }
__device__ __forceinline__ unsigned pk4_fp8(float a, float b, float c, float d) {
    unsigned w = 0u; w = __builtin_amdgcn_cvt_pk_fp8_f32(clamp448(a), clamp448(b), w, false); w = __builtin_amdgcn_cvt_pk_fp8_f32(clamp448(c), clamp448(d), w, true); return w; }
constexpr float F8_WSCALE = 128.0f;
constexpr float F8_ASCALE = 16.0f;
constexpr float F8_HSCALE = 8.0f;
#define XB_TMO      128
#define XB_XCNT(j)  (256  + 64 * (j))
#define XB_XSUB(j)  (1280 + 64 * (j))
#define XB_XGEN(j)  (2304 + 64 * (j))
#define XB_TOP      3328
#define XB_TOPGEN   3392
#define XCD_BAR_WORDS 3456
#define XB_SPIN_CAP (1u << 18)

__device__ __forceinline__ unsigned xb_ld(unsigned* p)              { return __hip_atomic_load(p, __ATOMIC_RELAXED, __HIP_MEMORY_SCOPE_AGENT); }
__device__ __forceinline__ unsigned xb_add(unsigned* p, unsigned v) { return __hip_atomic_fetch_add(p, v, __ATOMIC_RELAXED, __HIP_MEMORY_SCOPE_AGENT); }
__device__ __forceinline__ unsigned xb_xcc_id() { return (unsigned)__builtin_amdgcn_s_getreg((3 << 11) | 20) & 0xFu; }
#define XB_SPIN(cond, bar) do { unsigned _sp = 0; while (cond) { __builtin_amdgcn_s_sleep(1); \
    if ((++_sp & 255u) == 0u) { if (xb_ld(&(bar)[XB_TMO])) break; if (_sp > XB_SPIN_CAP) { atomicAdd(&(bar)[XB_TMO], 1u); break; } } } } while (0)

struct XcdBarrier {
    unsigned* bar; unsigned x;
    volatile LAS unsigned* st;
};

__device__ __forceinline__ XcdBarrier xcd_barrier_post(unsigned* bar, volatile LAS unsigned* st) {
    XcdBarrier b; b.bar = bar; b.x = xb_xcc_id(); b.st = st;
    if (threadIdx.x == 0) (void)xb_add(&bar[XB_XCNT(b.x)], 1u);
    return b;
}
__device__ __forceinline__ void xcd_barrier_complete(unsigned* bar, unsigned x, unsigned& nloc, unsigned& nx) {
    const unsigned G = gridDim.x * gridDim.y * gridDim.z;
    unsigned sum, cnt, mine, sp = 0u;
    for (;;) {
        sum = 0u; cnt = 0u; mine = 0u;
#pragma unroll
        for (unsigned j = 0; j < 16; ++j) { const unsigned c = xb_ld(&bar[XB_XCNT(j)]); sum += c; cnt += (c > 0u) ? 1u : 0u; mine = (j == x) ? c : mine; }
        if (sum == G) break;
        __builtin_amdgcn_s_sleep(1);
        if ((++sp & 255u) == 0u) { if (xb_ld(&bar[XB_TMO])) break; if (sp > XB_SPIN_CAP) { atomicAdd(&bar[XB_TMO], 1u); break; } }
    }
    nloc = mine > 0u ? mine : 1u; nx = cnt > 0u ? cnt : 1u;
}

__device__ __forceinline__ void xcd_barrier(const XcdBarrier& b, const int tid_in) {
    asm volatile("s_waitcnt vmcnt(0)" ::: "memory");
    __syncthreads();
    if (tid_in == 0) {
        unsigned* bar = b.bar;
        __builtin_amdgcn_s_waitcnt(0);
        unsigned nloc = b.st[0], nx = b.st[1];
        if (nloc == 0u) { xcd_barrier_complete(bar, b.x, nloc, nx); b.st[0] = nloc; b.st[1] = nx; }
        const unsigned old = xb_add(&bar[XB_XSUB(b.x)], 1u);
        const unsigned gen = old / nloc;
        if (old + 1u == (gen + 1u) * nloc) {
            __builtin_amdgcn_fence(__ATOMIC_RELEASE, "agent");
            asm volatile("s_waitcnt vmcnt(0)" ::: "memory");
            const unsigned og = xb_add(&bar[XB_TOP], 1u);
            const unsigned tg = og / nx;
            if (og + 1u == (tg + 1u) * nx) xb_add(&bar[XB_TOPGEN], 1u);
            else XB_SPIN(xb_ld(&bar[XB_TOPGEN]) == tg, bar);
            __builtin_amdgcn_fence(__ATOMIC_ACQUIRE, "agent");
            xb_add(&bar[XB_XGEN(b.x)], 1u);
            asm volatile("s_waitcnt vmcnt(0)" ::: "memory");
        } else {
            XB_SPIN(xb_ld(&bar[XB_XGEN(b.x)]) == gen, bar);
            __builtin_amdgcn_fence(__ATOMIC_ACQUIRE, "agent");
            asm volatile("s_waitcnt vmcnt(0)" ::: "memory");
        }
    }
    __syncthreads();
}


struct Args { const float* in[23]; float* out; unsigned char* ws; int ph_lo, ph_hi; };
typedef const __attribute__((address_space(4))) Args* KA;
#define KARGS() ({ KA p_ = (KA)__builtin_amdgcn_kernarg_segment_ptr(); asm volatile("" : "+s"(p_)); p_; })
enum { I_X = 0, I_C, I_CTX, I_CCTX, I_WADA, I_BADA, I_WIN, I_WOUT, I_QG, I_KG, I_SINK, I_HLB, I_HGAIN, I_GWS, I_GBS, I_GNG, I_FG, I_FU, I_FD, I_ROUTER, I_MG, I_MU, I_MDN };

__device__ __forceinline__ void transpose_item(const float* W, int K, int N, bf16* WT, int mode, LAS float* scr, int item, int lane) {
    const int nblk = N / 32, kb = item / nblk, nb = item % nblk, k0 = 64 * kb, n0 = 32 * nb;
#pragma unroll 8
    for (int i = 0; i < 32; ++i) { const int kk = 2 * i + (lane >> 5); scr[kk * 33 + (lane & 31)] = __builtin_nontemporal_load(&W[(size_t)(k0 + kk) * N + n0 + (lane & 31)]); }
    LDS_WAIT(); asm volatile("" ::: "memory");
    const int c = lane & 7;
#pragma unroll
    for (int j = 0; j < 4; ++j) { const int n = (lane >> 3) + 8 * j; const LAS float* s = scr + (8 * c) * 33 + n;
        v4u o; o.x = pk2(s[0 * 33], s[1 * 33]); o.y = pk2(s[2 * 33], s[3 * 33]); o.z = pk2(s[4 * 33], s[5 * 33]); o.w = pk2(s[6 * 33], s[7 * 33]);
        const int ng = n0 + n; const int drow = (mode == 0) ? ng : (ng + 128 * (ng / 128) + (mode == 2 ? 128 : 0));
        *(GAS v4u*)(WT + (size_t)drow * K + k0 + 8 * c) = o; }
    LDS_WAIT(); asm volatile("" ::: "memory");
}
__device__ __forceinline__ void transpose_item8(const float* W, int K, int N, unsigned char* WT, int mode, LAS float* scr, int item, int lane) {
    const int nblk = N / 32, kb = item / nblk, nb = item % nblk, k0 = 64 * kb, n0 = 32 * nb;
#pragma unroll 8
    for (int i = 0; i < 32; ++i) { const int kk = 2 * i + (lane >> 5); scr[kk * 33 + (lane & 31)] = __builtin_nontemporal_load(&W[(size_t)(k0 + kk) * N + n0 + (lane & 31)]); }
    LDS_WAIT(); asm volatile("" ::: "memory");
    const int c = lane & 7;
#pragma unroll
    for (int j = 0; j < 4; ++j) { const int n = (lane >> 3) + 8 * j; const LAS float* s = scr + (8 * c) * 33 + n;
        v2u o; o.x = pk4_fp8(s[0 * 33] * F8_WSCALE, s[1 * 33] * F8_WSCALE, s[2 * 33] * F8_WSCALE, s[3 * 33] * F8_WSCALE); o.y = pk4_fp8(s[4 * 33] * F8_WSCALE, s[5 * 33] * F8_WSCALE, s[6 * 33] * F8_WSCALE, s[7 * 33] * F8_WSCALE);
        const int ng = n0 + n; const int drow = (mode == 0) ? ng : (ng + 128 * (ng / 128) + (mode == 2 ? 128 : 0));
        *(GAS v2u*)(WT + (size_t)drow * K + k0 + 8 * c) = o; }
    LDS_WAIT(); asm volatile("" ::: "memory");
}
constexpr int MOE_ITEMS = 24 * 16 * 112;
constexpr int MOE_SL0 = 0, MOE_SL1 = 5376, MOE_SL2 = 10752, MOE_SL3 = 16128, MOE_SL4 = 19200, MOE_SL5 = 25344, MOE_SL6 = 29184, MOE_SL7 = 32576, MOE_DEFER = 34496;
__device__ __forceinline__ void moe_conv_item(KA a, int it, LAS float* scr, int lane) {
    constexpr int I_M = 16 * 112;
    unsigned char* ws = a->ws;
    const int idx = it / I_M, r = it % I_M;
    if (idx < 8) transpose_item8(a->in[I_MG] + (size_t)idx * DM * EXD, DM, EXD, (unsigned char*)(ws + WS_MGU) + (size_t)idx * 2 * EXD * DM, 1, scr, r, lane);
    else if (idx < 16) transpose_item8(a->in[I_MU] + (size_t)(idx - 8) * DM * EXD, DM, EXD, (unsigned char*)(ws + WS_MGU) + (size_t)(idx - 8) * 2 * EXD * DM, 2, scr, r, lane);
    else transpose_item8(a->in[I_MDN] + (size_t)(idx - 16) * EXD * DM, EXD, DM, (unsigned char*)(ws + WS_MD) + (size_t)(idx - 16) * DM * EXD, 0, scr, r, lane);
}
__device__ __forceinline__ void moe_conv_range(KA a, int lo, int hi, int first, LAS unsigned char* lds, int lane, int wave, int G, int bid) {
    if (bid < first) return;
    LAS float* scr = (LAS float*)(lds + wave * 8704);
    const int nw = (G - first) * NWAVES, w = (bid - first) * NWAVES + wave;
    for (int i = lo + w; i < hi; i += nw) moe_conv_item(a, i, scr, lane);
}
__device__ __forceinline__ void p0_prologue(KA a, LAS unsigned char* lds, int tid, int lane, int wave, int G, int bid) {
    unsigned char* ws = a->ws;
    LAS float* scr = (LAS float*)(lds + wave * 8704);
    const int gw = bid * NWAVES + wave, NGW = G * NWAVES;
    constexpr int I_IN = 16 * 80, I_OUT = 16 * 32, I_F = 16 * 88, I_FDN = 44 * 32, I_M = 16 * 112;
    constexpr int NIT = 2 * I_IN + 2 * I_OUT + 2 * I_F + I_FDN + 24 * I_M;
    for (int it0 = gw; it0 < NIT; it0 += NGW) {
        int it = it0;
        if (it < 2 * I_IN) { const int l = it / I_IN, r = it % I_IN; transpose_item(a->in[I_WIN] + (size_t)l * DM * INW, DM, INW, (bf16*)(ws + WS_WIN) + (size_t)l * INW * DM, 0, scr, r, lane); continue; } it -= 2 * I_IN;
        if (it < 2 * I_OUT) { const int l = it / I_OUT, r = it % I_OUT; transpose_item(a->in[I_WOUT] + (size_t)l * DM * DM, DM, DM, (bf16*)(ws + WS_WOUT) + (size_t)l * DM * DM, 0, scr, r, lane); continue; } it -= 2 * I_OUT;
        if (it < I_F) { transpose_item(a->in[I_FG], DM, FFN, (bf16*)(ws + WS_WGU), 1, scr, it, lane); continue; } it -= I_F;
        if (it < I_F) { transpose_item(a->in[I_FU], DM, FFN, (bf16*)(ws + WS_WGU), 2, scr, it, lane); continue; } it -= I_F;
        if (it < I_FDN) { transpose_item(a->in[I_FD], FFN, DM, (bf16*)(ws + WS_WD), 0, scr, it, lane); continue; } it -= I_FDN;
        if (it >= MOE_DEFER) moe_conv_item(a, it, scr, lane);
    }
    LAS float* sil = (LAS float*)(lds + 69632);
    LAS float* part = (LAS float*)(lds + 69632 + 8192);
    float* vec = (float*)(ws + WS_VEC);
    if (bid < 192) {
        for (int i = tid; i < 2048; i += NTHR) { const float v = (i < 1024) ? a->in[I_C][i] : a->in[I_CCTX][i - 1024]; sil[i] = silu1(v); }
        __syncthreads();
        for (int item = bid; item < 192; item += G) {
            const int l = item / 96, cb = item % 96, col = cb * 64 + lane;
            const float* w = a->in[I_WADA] + (size_t)l * DM * 6144 + col;
            float a0 = 0.f, a1 = 0.f;
#pragma unroll 1
            for (int k0 = wave * 128; k0 < wave * 128 + 128; k0 += 32) { float wv[32];
#pragma unroll
                for (int j = 0; j < 32; ++j) wv[j] = __builtin_nontemporal_load(&w[(size_t)(k0 + j) * 6144]);
#pragma unroll
                for (int j = 0; j < 32; ++j) { a0 += sil[k0 + j] * wv[j]; a1 += sil[1024 + k0 + j] * wv[j]; } }
            part[(wave * 2 + 0) * 64 + lane] = a0; part[(wave * 2 + 1) * 64 + lane] = a1;
            __syncthreads();
            if (wave == 0) { float s0 = 0.f, s1 = 0.f;
#pragma unroll
                for (int w8 = 0; w8 < 8; ++w8) { s0 += part[(w8 * 2 + 0) * 64 + lane]; s1 += part[(w8 * 2 + 1) * 64 + lane]; }
                const float b = a->in[I_BADA][l * 6144 + col];
                vec[VO_MOD + (l * 2 + 0) * 6144 + col] = s0 + b; vec[VO_MOD + (l * 2 + 1) * 6144 + col] = s1 + b; }
            __syncthreads();
        }
    }
    for (int i = bid * NTHR + tid; i < C_CTX * DM / 4; i += G * NTHR) ((GAS f32x4*)(ws + WS_CTXR))[i] = ((const GAS f32x4*)a->in[I_CTX])[i];
    if (bid == G - 1) {
        for (int idx = tid; idx < 5120; idx += NTHR) {
            const int isc = idx >= 4096, j = isc ? idx - 4096 : idx, pos = j / 16, i = j % 16;
            const float inv = exp2f(-(float)i * 0.83048202372184059f);
            const float ang = (float)pos * inv;
            double r = (double)ang * 0.15915494309189535; r -= floor(r);
            const float rf = (float)r;
            const float cs = __builtin_amdgcn_cosf(rf), sn = __builtin_amdgcn_sinf(rf);
            float* t = vec + VO_ROPE + (isc ? 8192 : 0);
            const int n = isc ? 1024 : 4096;
            t[j] = cs; t[n + j] = sn;
        }
    }
}

template <bool STORE = true> __device__ __forceinline__ void norm_row(const float* xrow, const float* sc, const float* sh, bf16* orow, int lane, f32x4 (&h)[4]) {
    const GAS f32x4* xr = (const GAS f32x4*)xrow + lane;
    f32x4 v[4]; float s = 0.f;
#pragma unroll
    for (int j = 0; j < 4; ++j) { v[j] = xr[64 * j]; s += (v[j].x * v[j].x + v[j].y * v[j].y) + (v[j].z * v[j].z + v[j].w * v[j].w); }
    const float rstd = __builtin_amdgcn_rsqf(wave_sum(s) * (1.0f / DM) + EPS);
    GAS v2u* o8 = (GAS v2u*)orow + lane;
#pragma unroll
    for (int j = 0; j < 4; ++j) { const f32x4 scv = *(const f32x4*)(sc + 4 * lane + 256 * j), shv = *(const f32x4*)(sh + 4 * lane + 256 * j);
        h[j] = v[j] * rstd * (scv + 1.0f) + shv;
        if constexpr (STORE) { v2u w; w.x = pk2(h[j].x, h[j].y); w.y = pk2(h[j].z, h[j].w); o8[64 * j] = w; } }
}
__device__ __forceinline__ void phase_norm(KA a, int l, int which, int nrows, bf16* H, int lane, int wave, int G, int bid) {
    const float* vec = (const float*)(a->ws + WS_VEC);
    const float* xl = (l == 0 && which == 0) ? a->in[I_X] : a->out;
    const float* xc = (l == 0 && which == 0) ? a->in[I_CTX] : (const float*)(a->ws + WS_CTXR);
    const float* ml = vec + VO_MOD + (l * 2 + 0) * 6144 + which * 3072;
    const float* mc = vec + VO_MOD + (l * 2 + 1) * 6144 + which * 3072;
    const int gw = bid * NWAVES + wave, NGW = G * NWAVES;
    f32x4 scl[4], shl[4], v[4];
#pragma unroll
    for (int j = 0; j < 4; ++j) { scl[j] = *(const f32x4*)(ml + 1024 + 4 * lane + 256 * j) + 1.0f; shl[j] = *(const f32x4*)(ml + 4 * lane + 256 * j); }
    if (gw < nrows) { const GAS f32x4* xr = (const GAS f32x4*)(gw >= S_LAT ? xc + (size_t)(gw - S_LAT) * DM : xl + (size_t)gw * DM) + lane;
#pragma unroll
        for (int j = 0; j < 4; ++j) v[j] = xr[64 * j]; }
    for (int r = gw; r < nrows; r += NGW) {
        const int rn = r + NGW; f32x4 vn[4];
        if (rn < nrows) { const GAS f32x4* xr = (const GAS f32x4*)(rn >= S_LAT ? xc + (size_t)(rn - S_LAT) * DM : xl + (size_t)rn * DM) + lane;
#pragma unroll
            for (int j = 0; j < 4; ++j) vn[j] = xr[64 * j]; }
        float s = 0.f;
#pragma unroll
        for (int j = 0; j < 4; ++j) s += (v[j].x * v[j].x + v[j].y * v[j].y) + (v[j].z * v[j].z + v[j].w * v[j].w);
        const float rstd = __builtin_amdgcn_rsqf(wave_sum(s) * (1.0f / DM) + EPS);
        GAS v2u* o8 = (GAS v2u*)(H + (size_t)r * DM) + lane;
        if (r >= S_LAT) {
#pragma unroll
            for (int j = 0; j < 4; ++j) { const f32x4 scv = *(const f32x4*)(mc + 1024 + 4 * lane + 256 * j), shv = *(const f32x4*)(mc + 4 * lane + 256 * j);
                const f32x4 h = v[j] * rstd * (scv + 1.0f) + shv; v2u w; w.x = pk2(h.x, h.y); w.y = pk2(h.z, h.w); o8[64 * j] = w; }
        } else {
#pragma unroll
            for (int j = 0; j < 4; ++j) { const f32x4 h = v[j] * rstd * scl[j] + shl[j]; v2u w; w.x = pk2(h.x, h.y); w.y = pk2(h.z, h.w); o8[64 * j] = w; }
        }
#pragma unroll
        for (int j = 0; j < 4; ++j) v[j] = vn[j];
    }
}
__device__ __forceinline__ void phase_norm_route(KA a, LAS unsigned char* lds, int tid, int lane, int wave, int G, int bid) {
    const int l = 1;
    const float* vec = (const float*)(a->ws + WS_VEC);
    const float* ml = vec + VO_MOD + (l * 2 + 0) * 6144 + 3072;
    unsigned char* H8 = (unsigned char*)(a->ws + WS_H2B);
    LAS float* rt = (LAS float*)lds;
    volatile LAS unsigned* lcnt = (volatile LAS unsigned*)(lds + 32768);
    for (int i = tid; i < 8192; i += NTHR) rt[i] = a->in[I_ROUTER][i];
    if (tid < 16) lcnt[tid] = 0u;
    __syncthreads();
    int* tokinfo = (int*)(a->ws + WS_TOK);
    unsigned* cnt = (unsigned*)(a->ws + WS_CTL) + CW_MOECNT;
    const int gw = bid * NWAVES + wave, NGW = G * NWAVES;
    unsigned keep = 0u, pk0 = 0u; int itn = 0;
    for (int r = gw; r < S_LAT; r += NGW) {
        f32x4 h[4];
        norm_row<false>(a->out + (size_t)r * DM, ml + 1024, ml, nullptr, lane, h);
#pragma unroll
        for (int j = 0; j < 4; ++j) ((GAS unsigned*)(H8 + (size_t)r * DM))[lane + 64 * j] = pk4_fp8(h[j].x * F8_ASCALE, h[j].y * F8_ASCALE, h[j].z * F8_ASCALE, h[j].w * F8_ASCALE);
        float lg[8];
#pragma unroll
        for (int e = 0; e < 8; ++e) lg[e] = 0.f;
#pragma unroll
        for (int j = 0; j < 4; ++j)
#pragma unroll
            for (int i = 0; i < 4; ++i) { const int d = 4 * lane + 256 * j + i; const f32x4 r0 = *(const LAS f32x4*)(rt + d * 8), r1 = *(const LAS f32x4*)(rt + d * 8 + 4); const float hv = h[j][i];
                lg[0] += hv * r0.x; lg[1] += hv * r0.y; lg[2] += hv * r0.z; lg[3] += hv * r0.w; lg[4] += hv * r1.x; lg[5] += hv * r1.y; lg[6] += hv * r1.z; lg[7] += hv * r1.w; }
#pragma unroll
        for (int e = 0; e < 8; ++e) lg[e] = wave_sum(lg[e]);
        int i1 = 0; float v1 = lg[0];
#pragma unroll
        for (int e = 1; e < 8; ++e) if (lg[e] > v1) { v1 = lg[e]; i1 = e; }
        int i2 = -1; float v2 = -INFINITY;
#pragma unroll
        for (int e = 0; e < 8; ++e) if (e != i1 && lg[e] > v2) { v2 = lg[e]; i2 = e; }
        const float w1 = 1.0f / (1.0f + __expf(v2 - v1)), w2 = 1.0f - w1;
        if (lane == 0) {
            const unsigned r1 = __hip_atomic_fetch_add((LAS unsigned*)lcnt + i1, 1u, __ATOMIC_RELAXED, __HIP_MEMORY_SCOPE_WORKGROUP), r2 = __hip_atomic_fetch_add((LAS unsigned*)lcnt + i2, 1u, __ATOMIC_RELAXED, __HIP_MEMORY_SCOPE_WORKGROUP);
            int* ti = tokinfo + (size_t)r * 8;
            ti[0] = i1; ti[1] = i2; ti[4] = __builtin_bit_cast(int, w1); ti[5] = __builtin_bit_cast(int, w2);
            pk0 = (unsigned)i1 | ((unsigned)i2 << 3) | (r1 << 6) | (r2 << 19);
        }
        const unsigned pku = (unsigned)__builtin_amdgcn_readfirstlane((int)pk0);
        if (lane == itn) keep = pku;
        ++itn;
    }
    __syncthreads();
    if (tid < 8) lcnt[8 + tid] = __hip_atomic_fetch_add(cnt + 64 * tid, lcnt[tid], RLX_AGENT);
    __syncthreads();
    { const int r = gw + lane * NGW; if (lane < itn && r < S_LAT) { int* ti = tokinfo + (size_t)r * 8; const unsigned e1 = keep & 7u, e2 = (keep >> 3) & 7u; ti[2] = (int)(((keep >> 6) & 0x1fffu) + lcnt[8 + e1]); ti[3] = (int)((keep >> 19) + lcnt[8 + e2]); } }
}

__device__ __forceinline__ void qk_prep(KA a, int l, int first_thread, int nthreads) {
    bf16* PROJ = (bf16*)(a->ws + WS_PROJ);
    const float* rope = (const float*)(a->ws + WS_VEC) + VO_ROPE;
    for (int i = first_thread; i < R_ALL * 10; i += nthreads) {
        const int row = i / 10, hh = i % 10; const bool isq = hh < 8;
        bf16* p = PROJ + (size_t)row * INW + (isq ? hh * 64 : COL_AK + (hh - 8) * 64);
        const float* gain = (isq ? a->in[I_QG] : a->in[I_KG]) + l * 64;
        float x[64]; float ss = 0.f;
#pragma unroll
        for (int c = 0; c < 8; ++c) { const v4u w = *(const GAS v4u*)(p + 8 * c); unpack8(w, x + 8 * c); }
#pragma unroll
        for (int d = 0; d < 64; ++d) ss += x[d] * x[d];
        const float rstd = __builtin_amdgcn_rsqf(ss * (1.0f / 64.0f) + EPS);
        const f32x4* g4 = (const f32x4*)gain;
#pragma unroll
        for (int c = 0; c < 16; ++c) { const f32x4 gv = g4[c]; x[4 * c] *= rstd * gv.x; x[4 * c + 1] *= rstd * gv.y; x[4 * c + 2] *= rstd * gv.z; x[4 * c + 3] *= rstd * gv.w; }
        if (row < S_LAT) {
            const int gr = row >> 6, gc = row & 63;
            const f32x4* cr = (const f32x4*)(rope + gr * 16); const f32x4* sr = (const f32x4*)(rope + 4096 + gr * 16); const f32x4* cc = (const f32x4*)(rope + 8192 + gc * 16); const f32x4* sc = (const f32x4*)(rope + 8192 + 1024 + gc * 16);
#pragma unroll
            for (int j4 = 0; j4 < 4; ++j4) { const f32x4 cv = cr[j4], sv = sr[j4];
#pragma unroll
                for (int i = 0; i < 4; ++i) { const int j = 4 * j4 + i; const float x1 = x[j], x2 = x[16 + j]; x[j] = x1 * cv[i] - x2 * sv[i]; x[16 + j] = x1 * sv[i] + x2 * cv[i]; } }
#pragma unroll
            for (int j4 = 0; j4 < 4; ++j4) { const f32x4 cv = cc[j4], sv = sc[j4];
#pragma unroll
                for (int i = 0; i < 4; ++i) { const int j = 4 * j4 + i; const float x1 = x[32 + j], x2 = x[48 + j]; x[32 + j] = x1 * cv[i] - x2 * sv[i]; x[48 + j] = x1 * sv[i] + x2 * cv[i]; } }
        }
        const float qs = isq ? 0.125f * 1.4426950408889634f : 1.0f;
#pragma unroll
        for (int c = 0; c < 8; ++c) { v4u w; w.x = pk2(x[8 * c] * qs, x[8 * c + 1] * qs); w.y = pk2(x[8 * c + 2] * qs, x[8 * c + 3] * qs); w.z = pk2(x[8 * c + 4] * qs, x[8 * c + 5] * qs); w.w = pk2(x[8 * c + 6] * qs, x[8 * c + 7] * qs);
            *(GAS v4u*)(p + 8 * c) = w; }
    }
}
__device__ __forceinline__ void gmlp_unit(KA a, int l, int chunk, int g, LAS unsigned char* lds, int tid, int lane, int wave) {
    const bf16* PROJ = (const bf16*)(a->ws + WS_PROJ); bf16* MIX = (bf16*)(a->ws + WS_MIX);
    const int row0 = (chunk < 128) ? chunk * 128 : S_LAT + (chunk - 128) * 128;
    LAS float* vn = (LAS float*)lds;
    { const int pos = tid >> 2, part = tid & 3;
      const bf16* p = PROJ + (size_t)(row0 + pos) * INW + COL_GV + g * 64 + part * 16;
      float x[16]; unpack8(*(const GAS v4u*)p, x); unpack8(*(const GAS v4u*)(p + 8), x + 8);
      float ss = 0.f;
#pragma unroll
      for (int d = 0; d < 16; ++d) { x[d] = gelu1(x[d]); ss += x[d] * x[d]; }
      ss += sx<1>(ss); ss += sx<2>(ss);
      const float rstd = __builtin_amdgcn_rsqf(ss * (1.0f / 64.0f) + EPS);
      const float* gn = a->in[I_GNG] + l * 256 + g * 64 + part * 16;
#pragma unroll
      for (int d = 0; d < 16; ++d) vn[pos * 64 + part * 16 + d] = x[d] * rstd * gn[d]; }
    __syncthreads();
    const int c = lane, t0 = wave * 16;
    const float* W = a->in[I_GWS] + ((size_t)(l * 4 + g) * 128 + t0) * 128;
    float acc[16];
#pragma unroll
    for (int i = 0; i < 16; ++i) acc[i] = 0.f;
    for (int s = 0; s < 128; ++s) { const float v = vn[s * 64 + c];
#pragma unroll
        for (int i = 0; i < 16; ++i) acc[i] += W[i * 128 + s] * v; }
    const float* bs = a->in[I_GBS] + (l * 4 + g) * 128 + t0;
#pragma unroll
    for (int i = 0; i < 16; ++i) { const int row = row0 + t0 + i;
        const float u = gelu1(bflo((unsigned)PROJ[(size_t)row * INW + COL_GU + g * 64 + c]));
        MIX[(size_t)row * DM + MIX_GM + g * 64 + c] = (bf16)f2bf(u * (acc[i] + bs[i])); }
    __syncthreads();
}
__device__ __forceinline__ void hgrn_naive(KA a, int l, int dir, int head, LAS unsigned char* lds, int tid, int lane, int wave) {
    const bf16* PROJ = (const bf16*)(a->ws + WS_PROJ);
    float* HGO = (float*)(a->ws + WS_HGO) + (size_t)dir * R_ALL * 256;
    LAS float* Qs = (LAS float*)lds;
    LAS float* Fs = Qs + 4096; LAS float* Vs = Fs + 4096; LAS float* part = Vs + 4096;
    const int v = lane, kg = wave;
    float S[8];
#pragma unroll
    for (int i = 0; i < 8; ++i) S[i] = 0.f;
    const int tl = tid >> 3, c8 = tid & 7;
    float lb[8];
#pragma unroll
    for (int j = 0; j < 8; ++j) { float b = 0.f; if (l == 1) { const float p0 = a->in[I_HLB][dir * 512 + head * 64 + c8 * 8 + j], p1 = a->in[I_HLB][dir * 512 + 256 + head * 64 + c8 * 8 + j]; b = 1.0f / (1.0f + __expf(p0 - p1)); } lb[j] = b; }
    const int fcol = (dir == 0 ? COL_HFF : COL_HFB) + head * 64 + c8 * 8;
    for (int n0 = 0; n0 < R_ALL; n0 += 64) {
        { const int n = n0 + tl; int row;
          if (dir == 0) row = (n < C_CTX) ? S_LAT + n : n - C_CTX; else row = (n < C_CTX) ? S_LAT + (C_CTX - 1 - n) : (S_LAT - 1) - (n - C_CTX);
          const bf16* pr = PROJ + (size_t)row * INW;
          float q[8], f[8], vv[8];
          unpack8(*(const GAS v4u*)(pr + COL_HQ + head * 64 + c8 * 8), q); unpack8(*(const GAS v4u*)(pr + fcol), f); unpack8(*(const GAS v4u*)(pr + COL_HI + head * 64 + c8 * 8), vv);
#pragma unroll
          for (int j = 0; j < 8; ++j) { Qs[tl * 64 + c8 * 8 + j] = silu1(q[j]) * 0.125f; Fs[tl * 64 + c8 * 8 + j] = lb[j] + (1.0f - lb[j]) * sigm1(f[j]); Vs[tl * 64 + c8 * 8 + j] = vv[j]; } }
        __syncthreads();
        for (int t = 0; t < 64; ++t) {
            const float vt = Vs[t * 64 + v]; float po = 0.f;
#pragma unroll
            for (int i = 0; i < 8; ++i) { const float f = Fs[t * 64 + kg * 8 + i], q = Qs[t * 64 + kg * 8 + i]; S[i] = f * S[i] + (1.0f - f) * vt; po += S[i] * q; }
            part[((t & 1) * 8 + kg) * 64 + v] = po;
            __syncthreads();
            if (wave == 0) { float o = 0.f;
#pragma unroll
                for (int w8 = 0; w8 < 8; ++w8) o += part[((t & 1) * 8 + w8) * 64 + v];
                const int n = n0 + t; int row;
                if (dir == 0) row = (n < C_CTX) ? S_LAT + n : n - C_CTX; else row = (n < C_CTX) ? S_LAT + (C_CTX - 1 - n) : (S_LAT - 1) - (n - C_CTX);
                HGO[(size_t)row * 256 + head * 64 + v] = o; }
        }
        __syncthreads();
    }
}

typedef short bf16x8v __attribute__((ext_vector_type(8)));
constexpr int HST = 72;
__device__ __forceinline__ f32x4 mma16(const LAS bf16* MA, const LAS bf16* MBt, int k0, f32x4 c, int lane) {
    const bf16x8v av = *(const LAS bf16x8v*)(MA + (lane & 15) * HST + k0 + 8 * (lane >> 4));
    const bf16x8v bv = *(const LAS bf16x8v*)(MBt + (lane & 15) * HST + k0 + 8 * (lane >> 4));
    return __builtin_amdgcn_mfma_f32_16x16x32_bf16(av, bv, c, 0, 0, 0);
}
__device__ __forceinline__ int hg_base_row(int cpos) { return cpos < 256 ? 64 * cpos : S_LAT + 64 * (cpos - 256); }
__device__ __forceinline__ int hg_scan_idx(int dir, int cpos) { return dir == 0 ? (cpos < 256 ? 4 + cpos : cpos - 256) : (cpos < 256 ? 4 + (255 - cpos) : 3 - (cpos - 256)); }
__device__ __forceinline__ float hg_lb(KA a, int l, int dir, int head, int k) {
    if (l == 0) return 0.f;
    const float p0 = a->in[I_HLB][dir * 512 + head * 64 + k], p1 = a->in[I_HLB][dir * 512 + 256 + head * 64 + k];
    return 1.0f / (1.0f + __expf(p0 - p1));
}
__device__ __forceinline__ void hgrn_stepA(KA a, int l, int cpos, int head, LAS unsigned char* lds, int lane, int wave) {
    const bf16* PROJ = (const bf16*)(a->ws + WS_PROJ);
    const int dir = wave >> 2, I = wave & 3, base = hg_base_row(cpos), ci = hg_scan_idx(dir, cpos);
    LAS float* TOT = (LAS float*)lds;
    LAS bf16* KLT = (LAS bf16*)(lds + 2048) + dir * 64 * HST;
    LAS bf16* VT = (LAS bf16*)(lds + 2048 + 2 * 64 * HST * 2) + dir * 64 * HST;
    const float lb = hg_lb(a, l, dir, head, lane);
    const int fcol = (dir == 0 ? COL_HFF : COL_HFB) + head * 64 + lane, vcol = COL_HI + head * 64 + lane;
    float kk[16], cl[16]; float run = 0.f;
#pragma unroll
    for (int i = 0; i < 16; ++i) { const int n = 16 * I + i, row = base + (dir ? 63 - n : n);
        const float fl = bflo((unsigned)PROJ[(size_t)row * INW + fcol]);
        const unsigned short vb = PROJ[(size_t)row * INW + vcol];
        const float f = lb + (1.0f - lb) * sigm1(fl);
        run += __logf(f); cl[i] = run; kk[i] = 1.0f - f;
        VT[lane * HST + n] = vb; }
    TOT[(dir * 4 + I) * 64 + lane] = run;
    __syncthreads();
    float post = 0.f, all = 0.f;
#pragma unroll
    for (int J = 0; J < 4; ++J) { const float t = TOT[(dir * 4 + J) * 64 + lane]; all += t; if (J > I) post += t; }
#pragma unroll
    for (int i = 0; i < 16; ++i) KLT[lane * HST + 16 * I + i] = (bf16)f2bf(kk[i] * __expf(run - cl[i] + post));
    if (I == 0) ((float*)(a->ws + WS_HDG))[((size_t)(dir * 4 + head) * 260 + ci) * 64 + lane] = __expf(all);
    __syncthreads();
    float* LT = (float*)(a->ws + WS_HLT) + ((size_t)(dir * 4 + head) * 260 + ci) * 4096;
    float z0 = 0.f; asm volatile("" : "+v"(z0));
#pragma unroll
    for (int kb = 0; kb < 4; ++kb) { f32x4 acc = {z0, z0, z0, z0};
        acc = mma16(VT + 16 * I * HST, KLT + 16 * kb * HST, 0, acc, lane); acc = mma16(VT + 16 * I * HST, KLT + 16 * kb * HST, 32, acc, lane);
#pragma unroll
        for (int r = 0; r < 4; ++r) LT[(16 * I + 4 * (lane >> 4) + r) * 64 + 16 * kb + (lane & 15)] = acc[r]; }
    __syncthreads();
}
__device__ __forceinline__ void hgrn_stepB(KA a, int item, int tid) {
    const int dh = item >> 3, vb = item & 7, v = vb * 8 + (tid >> 6), k = tid & 63;
    const float* LT = (const float*)(a->ws + WS_HLT) + (size_t)dh * 260 * 4096 + v * 64 + k;
    const float* DG = (const float*)(a->ws + WS_HDG) + (size_t)dh * 260 * 64 + k;
    bf16* SP = (bf16*)(a->ws + WS_HSP) + (size_t)dh * 260 * 4096 + v * 64 + k;
    float S = 0.f;
#pragma unroll 1
    for (int c0 = 0; c0 < 260; c0 += 26) {
        float lt[26], dg[26];
#pragma unroll
        for (int j = 0; j < 26; ++j) { lt[j] = LT[(size_t)(c0 + j) * 4096]; dg[j] = DG[(c0 + j) * 64]; }
#pragma unroll
        for (int j = 0; j < 26; ++j) { SP[(size_t)(c0 + j) * 4096] = (bf16)f2bf(S); S = dg[j] * S + lt[j]; }
    }
}
__device__ __forceinline__ void hgrn_stepC(KA a, int l, int cpos, int head, LAS unsigned char* lds, int tid, int lane, int wave) {
    const bf16* PROJ = (const bf16*)(a->ws + WS_PROJ); bf16* MIX = (bf16*)(a->ws + WS_MIX);
    const int dir = wave >> 2, I = wave & 3, base = hg_base_row(cpos), ci = hg_scan_idx(dir, cpos);
    constexpr int MSZ = 64 * HST;
    LAS float* TOT = (LAS float*)lds;
    LAS bf16* img = (LAS bf16*)(lds + 2048);
    LAS bf16* QT = img + dir * MSZ;
    LAS bf16* QD = img + 2 * MSZ + dir * MSZ;
    LAS bf16* VT = img + 4 * MSZ + dir * MSZ;
    LAS bf16* ST = img + 6 * MSZ + dir * MSZ;
    LAS bf16* AS = img + 8 * MSZ + dir * MSZ + I * 16 * HST;
    LAS bf16* KT = img + 10 * MSZ + dir * (10 * 16 * HST);
    LAS float* OS = (LAS float*)(img + 10 * MSZ);
    const float lb = hg_lb(a, l, dir, head, lane);
    const int fcol = (dir == 0 ? COL_HFF : COL_HFB) + head * 64 + lane, qcol = COL_HQ + head * 64 + lane, vcol = COL_HI + head * 64 + lane;
    { const bf16* SP = (const bf16*)(a->ws + WS_HSP) + ((size_t)(dir * 4 + head) * 260 + ci) * 4096;
#pragma unroll
      for (int h2 = 0; h2 < 2; ++h2) { const int e = ((I * 2 + h2) * 64 + lane) * 8, vv = e >> 6, kk0 = e & 63;
          *(LAS v4u*)(ST + vv * HST + kk0) = *(const GAS v4u*)(SP + e); } }
    float kk[16], cl[16], qv[16]; float run = 0.f;
#pragma unroll
    for (int i = 0; i < 16; ++i) { const int n = 16 * I + i, row = base + (dir ? 63 - n : n);
        const float fl = bflo((unsigned)PROJ[(size_t)row * INW + fcol]), ql = bflo((unsigned)PROJ[(size_t)row * INW + qcol]);
        const unsigned short vb = PROJ[(size_t)row * INW + vcol];
        const float f = lb + (1.0f - lb) * sigm1(fl);
        run += __logf(f); cl[i] = run; kk[i] = 1.0f - f; qv[i] = silu1(ql) * 0.125f;
        VT[lane * HST + n] = vb; }
    TOT[(dir * 4 + I) * 64 + lane] = run;
    __syncthreads();
    float tj[4];
#pragma unroll
    for (int J = 0; J < 4; ++J) tj[J] = TOT[(dir * 4 + J) * 64 + lane];
    float pre = 0.f;
#pragma unroll
    for (int J = 0; J < 4; ++J) if (J < I) pre += tj[J];
    const float epre = __expf(pre); float kei[16];
#pragma unroll
    for (int i = 0; i < 16; ++i) { const float e = __expf(cl[i]); QT[(16 * I + i) * HST + lane] = (bf16)f2bf(qv[i] * e); QD[(16 * I + i) * HST + lane] = (bf16)f2bf(qv[i] * e * epre); kei[i] = kk[i] * fminf(__builtin_amdgcn_rcpf(e), 5.5e34f); }
    float eoff = 0.f;
#pragma unroll
    for (int I2 = 0; I2 < 4; ++I2) {
        if (I2 >= I) {
            if (I2 == I) eoff = 0.f; else if (I2 == I + 1) eoff = run; else eoff += tj[I2 - 1];
            LAS bf16* blk = KT + (I2 * (I2 + 1) / 2 + I) * 16 * HST;
            const float fo = __expf(eoff);
#pragma unroll
            for (int i = 0; i < 16; ++i) blk[i * HST + lane] = (bf16)f2bf(kei[i] * fo);
        }
    }
    __syncthreads();
    float z0 = 0.f; asm volatile("" : "+v"(z0));
    f32x4 sc[4];
#pragma unroll
    for (int J = 0; J < 4; ++J) { sc[J] = (f32x4){z0, z0, z0, z0};
        if (J <= I) { const LAS bf16* kb = KT + (I * (I + 1) / 2 + J) * 16 * HST;
            sc[J] = mma16(QT + 16 * I * HST, kb, 0, sc[J], lane); sc[J] = mma16(QT + 16 * I * HST, kb, 32, sc[J], lane);
            if (J == I) {
#pragma unroll
                for (int r = 0; r < 4; ++r) if ((lane & 15) > 4 * (lane >> 4) + r) sc[J][r] = z0; } } }
#pragma unroll
    for (int J = 0; J < 4; ++J)
#pragma unroll
        for (int r = 0; r < 4; ++r) AS[(4 * (lane >> 4) + r) * HST + 16 * J + (lane & 15)] = (bf16)f2bf(sc[J][r]);
    asm volatile("s_waitcnt lgkmcnt(0)" ::: "memory");
    f32x4 acc[4];
#pragma unroll
    for (int vb = 0; vb < 4; ++vb) { acc[vb] = (f32x4){z0, z0, z0, z0};
        acc[vb] = mma16(AS, VT + 16 * vb * HST, 0, acc[vb], lane); acc[vb] = mma16(AS, VT + 16 * vb * HST, 32, acc[vb], lane);
        acc[vb] = mma16(QD + 16 * I * HST, ST + 16 * vb * HST, 0, acc[vb], lane); acc[vb] = mma16(QD + 16 * I * HST, ST + 16 * vb * HST, 32, acc[vb], lane); }
    __syncthreads();
#pragma unroll
    for (int vb = 0; vb < 4; ++vb)
#pragma unroll
        for (int r = 0; r < 4; ++r) { const int n = 16 * I + 4 * (lane >> 4) + r, rl = dir ? 63 - n : n; OS[(dir * 64 + rl) * 68 + 16 * vb + (lane & 15)] = acc[vb][r]; }
    __syncthreads();
    { const int rl = tid >> 3, v8 = (tid & 7) * 8, row = base + rl;
      float o[8]; float ss = 0.f;
#pragma unroll
      for (int j = 0; j < 8; ++j) { o[j] = OS[rl * 68 + v8 + j] + OS[(64 + rl) * 68 + v8 + j]; ss += o[j] * o[j]; }
      ss += sx<1>(ss); ss += sx<2>(ss); ss += sx<4>(ss);
      const float rstd = __builtin_amdgcn_rsqf(ss * (1.0f / 64.0f) + EPS);
      float gt[8]; unpack8(*(const GAS v4u*)(PROJ + (size_t)row * INW + COL_HG + head * 64 + v8), gt);
      const float* gn = a->in[I_HGAIN] + l * 64 + v8;
      float y[8];
#pragma unroll
      for (int j = 0; j < 8; ++j) y[j] = o[j] * rstd * gn[j] * silu1(gt[j]);
      v4u w; w.x = pk2(y[0], y[1]); w.y = pk2(y[2], y[3]); w.z = pk2(y[4], y[5]); w.w = pk2(y[6], y[7]);
      *(GAS v4u*)(MIX + (size_t)row * DM + MIX_HG + head * 64 + v8) = w; }
    __syncthreads();
}

__device__ __forceinline__ void vt_item(KA a, int item, int lane) {
    const bf16* PROJ = (const bf16*)(a->ws + WS_PROJ); bf16* VTg = (bf16*)(a->ws + WS_VT);
    const int rb = item >> 1, hk = item & 1, row = rb * 64 + lane;
    const bf16* p = PROJ + (size_t)row * INW + COL_AV + hk * 64;
    unsigned w[32];
#pragma unroll
    for (int c = 0; c < 8; ++c) { const v4u t = *(const GAS v4u*)(p + 8 * c); w[4 * c] = t.x; w[4 * c + 1] = t.y; w[4 * c + 2] = t.z; w[4 * c + 3] = t.w; }
    bf16* o = VTg + (size_t)hk * 64 * R_ALL + row;
#pragma unroll
    for (int d2 = 0; d2 < 32; ++d2) { o[(size_t)(2 * d2) * R_ALL] = (bf16)(w[d2] & 0xffffu); o[(size_t)(2 * d2 + 1) * R_ALL] = (bf16)(w[d2] >> 16); }
}
__device__ __forceinline__ void attn_unit(KA a, int l, int u, LAS unsigned char* lds, int tid, int lane, int wave) {
    asm volatile("" : "+v"(tid), "+v"(lane));
    const bf16* PROJ = (const bf16*)(a->ws + WS_PROJ); const bf16* VTg = (const bf16*)(a->ws + WS_VT); bf16* MIX = (bf16*)(a->ws + WS_MIX);
    const bool isctx = u >= 256; const int uu = isctx ? u - 256 : u; const int n = uu >> 1, hk = uu & 1;
    const int qh = hk * 4 + (wave >> 1), half = wave & 1;
    const int qbase = (isctx ? S_LAT : 0) + n * 128 + half * 64, qpos0 = n * 128 + half * 64;
    const int c = lane & 15, g = lane >> 4;
    LAS bf16* Kt = (LAS bf16*)lds; LAS bf16* Vt = Kt + 64 * HST; LAS bf16* Qw = Vt + 64 * HST + wave * 64 * HST;
#pragma unroll
    for (int j = 0; j < 8; ++j) { const int qr = 8 * j + (lane >> 3), qc = (lane & 7) * 8;
        *(LAS v4u*)(Qw + qr * HST + qc) = *(const GAS v4u*)(PROJ + (size_t)(qbase + qr) * INW + qh * 64 + qc); }
    float z0 = 0.f; asm volatile("" : "+v"(z0));
    f32x4 o[4][4]; float ls[4];
    float gq = 0.f, gk = 0.f;
#pragma unroll 8
    for (int d = 0; d < 64; ++d) { gq = fmaxf(gq, fabsf(a->in[I_QG][l * 64 + d])); gk = fmaxf(gk, fabsf(a->in[I_KG][l * 64 + d])); }
    const float nbnd = -(8.0f * 1.4426950408889634f) * gq * gk;
    const float sink = a->in[I_SINK][l * 8 + qh] * 1.4426950408889634f;
#pragma unroll
    for (int qt = 0; qt < 4; ++qt) { ls[qt] = (g == 0) ? __builtin_amdgcn_exp2f(sink + nbnd) : z0;
#pragma unroll
        for (int dt = 0; dt < 4; ++dt) o[qt][dt] = (f32x4){z0, z0, z0, z0}; }
    const int first = (!isctx && n == 0) ? 2 : 0, nwin = isctx ? 0 : ((n == 0 || n == 127) ? 4 : 6), nt = nwin + 4;
    const int lr = tid >> 3, lc = (tid & 7) * 8;
    v4u kreg, vreg;
#define ATT_LOADT(i) do { const bool ct_ = (i) >= nwin; const int kb_ = ct_ ? S_LAT + 64 * ((i) - nwin) : (n - 1) * 128 + 64 * (first + (i)); \
        kreg = *(const GAS v4u*)(PROJ + (size_t)(kb_ + lr) * INW + COL_AK + hk * 64 + lc); vreg = *(const GAS v4u*)(VTg + ((size_t)hk * 64 + lr) * R_ALL + kb_ + lc); } while (0)
    ATT_LOADT(0);
#pragma unroll 1
    for (int i = 0; i < nt; ++i) {
        __syncthreads();
        *(LAS v4u*)(Kt + lr * HST + lc) = kreg; *(LAS v4u*)(Vt + lr * HST + lc) = vreg;
        __syncthreads();
        if (i + 1 < nt) ATT_LOADT(i + 1);
        const bool win = i < nwin; const int kb = (n - 1) * 128 + 64 * (first + i);
        const int rel = kb - qpos0;
        const bool maskw = win && (rel == 128 || rel == -128);
        if (win && (rel >= 192 || rel <= -192)) continue;
        bf16x8v kf[4][2], vf[4][2];
#pragma unroll
        for (int kt = 0; kt < 4; ++kt)
#pragma unroll
            for (int ks = 0; ks < 2; ++ks) kf[kt][ks] = *(const LAS bf16x8v*)(Kt + (16 * kt + c) * HST + 32 * ks + 8 * g);
#pragma unroll
        for (int dt = 0; dt < 4; ++dt)
#pragma unroll
            for (int s2 = 0; s2 < 2; ++s2) { const v2u lo = *(const LAS v2u*)(Vt + (16 * dt + c) * HST + 32 * s2 + 4 * g), hi = *(const LAS v2u*)(Vt + (16 * dt + c) * HST + 32 * s2 + 16 + 4 * g);
                const v4u t = {lo.x, lo.y, hi.x, hi.y}; vf[dt][s2] = __builtin_bit_cast(bf16x8v, t); }
#pragma unroll
        for (int qt = 0; qt < 4; ++qt) {
            f32x4 s[4];
            const bf16x8v q0 = *(const LAS bf16x8v*)(Qw + (16 * qt + c) * HST + 8 * g), q1 = *(const LAS bf16x8v*)(Qw + (16 * qt + c) * HST + 32 + 8 * g);
#pragma unroll
            for (int kt = 0; kt < 4; ++kt) { s[kt] = (f32x4){nbnd, nbnd, nbnd, nbnd};
                s[kt] = __builtin_amdgcn_mfma_f32_16x16x32_bf16(kf[kt][0], q0, s[kt], 0, 0, 0); s[kt] = __builtin_amdgcn_mfma_f32_16x16x32_bf16(kf[kt][1], q1, s[kt], 0, 0, 0); }
            if (maskw) { const int dq = qpos0 + 16 * qt + c - kb - 4 * g;
#pragma unroll
                for (int kt = 0; kt < 4; ++kt)
#pragma unroll
                    for (int r = 0; r < 4; ++r) { const int dl = dq - 16 * kt - r; if (dl > 128 || dl < -128) s[kt][r] = -INFINITY; } }
            float ps = 0.f;
#pragma unroll
            for (int kt = 0; kt < 4; ++kt)
#pragma unroll
                for (int r = 0; r < 4; ++r) { s[kt][r] = __builtin_amdgcn_exp2f(s[kt][r]); ps += s[kt][r]; }
            ls[qt] += ps;
            bf16x8v pb[2];
#pragma unroll
            for (int s2 = 0; s2 < 2; ++s2) { const v4u t = {pk2(s[2 * s2][0], s[2 * s2][1]), pk2(s[2 * s2][2], s[2 * s2][3]), pk2(s[2 * s2 + 1][0], s[2 * s2 + 1][1]), pk2(s[2 * s2 + 1][2], s[2 * s2 + 1][3])};
                pb[s2] = __builtin_bit_cast(bf16x8v, t); }
#pragma unroll
            for (int dt = 0; dt < 4; ++dt) { o[qt][dt] = __builtin_amdgcn_mfma_f32_16x16x32_bf16(vf[dt][0], pb[0], o[qt][dt], 0, 0, 0); o[qt][dt] = __builtin_amdgcn_mfma_f32_16x16x32_bf16(vf[dt][1], pb[1], o[qt][dt], 0, 0, 0); }
        }
    }
#undef ATT_LOADT
    int c2 = lane & 15, g2 = lane >> 4; asm volatile("" : "+v"(c2), "+v"(g2));
#pragma unroll
    for (int qt = 0; qt < 4; ++qt) { float lt = ls[qt]; lt += sx<16>(lt); lt = sx32_add(lt); const float inv = 1.0f / lt;
        bf16* op = (bf16*)(a->ws + WS_MIX) + (size_t)(qbase + 16 * qt + c2) * DM + MIX_AT + qh * 64 + 4 * g2;
#pragma unroll
        for (int dt = 0; dt < 4; ++dt) { v2u w; w.x = pk2(o[qt][dt][0] * inv, o[qt][dt][1] * inv); w.y = pk2(o[qt][dt][2] * inv, o[qt][dt][3] * inv); *(GAS v2u*)(op + 16 * dt) = w; } }
}

constexpr int GST = 136;
__device__ __forceinline__ f32x4 mma16g(const LAS bf16* MA, const LAS bf16* MBt, int k0, f32x4 c, int lane) {
    const bf16x8v av = *(const LAS bf16x8v*)(MA + (lane & 15) * GST + k0 + 8 * (lane >> 4));
    const bf16x8v bv = *(const LAS bf16x8v*)(MBt + (lane & 15) * GST + k0 + 8 * (lane >> 4));
    return __builtin_amdgcn_mfma_f32_16x16x32_bf16(av, bv, c, 0, 0, 0);
}
__device__ __forceinline__ float gelu_as(float v) {
    const float av = fabsf(v), t = __builtin_amdgcn_rcpf(av * 0.2316418882f + 1.0f);
    float q = t * 0.5307027145f + (-0.7265760135f); q = q * t + 0.7107068705f; q = q * t + (-0.142248368f); q = q * t + 0.127414796f; q = q * t;
    const float e = __builtin_amdgcn_exp2f((v * v) * (-0.72134752044f)), mm = v * (q * e);
    return v < 0.f ? mm : v - mm;
}
__device__ __forceinline__ void gmlp_unit_mma(KA a, int l, int chunk, int g, LAS unsigned char* lds, int tid, int lane, int wave) {
    const bf16* PROJ = (const bf16*)(a->ws + WS_PROJ); bf16* MIX = (bf16*)(a->ws + WS_MIX);
    const int row0 = (chunk < 128) ? chunk * 128 : S_LAT + (chunk - 128) * 128;
    LAS bf16* WA = (LAS bf16*)lds;
    LAS bf16* VNT = WA + 128 * GST;
    LAS float* OUT = (LAS float*)(VNT + 64 * GST);
    const int pos = tid >> 2, part = tid & 3;
    {
      const float* W = a->in[I_GWS] + ((size_t)(l * 4 + g) * 128 + pos) * 128 + part * 32;
#pragma unroll
      for (int j = 0; j < 4; ++j) { const f32x4 w0 = *(const GAS f32x4*)(W + 8 * j), w1 = *(const GAS f32x4*)(W + 8 * j + 4);
          v4u o; o.x = pk2(w0.x, w0.y); o.y = pk2(w0.z, w0.w); o.z = pk2(w1.x, w1.y); o.w = pk2(w1.z, w1.w);
          *(LAS v4u*)(WA + pos * GST + part * 32 + 8 * j) = o; } }
    { const bf16* p = PROJ + (size_t)(row0 + pos) * INW + COL_GV + g * 64 + part * 16;
      float x[16]; unpack8(*(const GAS v4u*)p, x); unpack8(*(const GAS v4u*)(p + 8), x + 8);
      float ss = 0.f;
#pragma unroll
      for (int d = 0; d < 16; ++d) { x[d] = gelu_as(x[d]); ss += x[d] * x[d]; }
      ss += sx<1>(ss); ss += sx<2>(ss);
      const float rstd = __builtin_amdgcn_rsqf(ss * (1.0f / 64.0f) + EPS);
      const float* gn = a->in[I_GNG] + l * 256 + g * 64 + part * 16;
#pragma unroll
      for (int d = 0; d < 16; ++d) VNT[(part * 16 + d) * GST + pos] = (bf16)f2bf(x[d] * rstd * gn[d]); }
    __syncthreads();
    float z0 = 0.f; asm volatile("" : "+v"(z0));
#pragma unroll
    for (int cb = 0; cb < 4; ++cb) { f32x4 acc = {z0, z0, z0, z0};
#pragma unroll
        for (int ks = 0; ks < 4; ++ks) acc = mma16g(WA + 16 * wave * GST, VNT + 16 * cb * GST, 32 * ks, acc, lane);
#pragma unroll
        for (int r = 0; r < 4; ++r) OUT[(16 * wave + 4 * (lane >> 4) + r) * 68 + 16 * cb + (lane & 15)] = acc[r]; }
    __syncthreads();
    { const int row = row0 + pos; const float bsv = a->in[I_GBS][(l * 4 + g) * 128 + pos];
      const bf16* pu = PROJ + (size_t)row * INW + COL_GU + g * 64 + part * 16;
      float u[16]; unpack8(*(const GAS v4u*)pu, u); unpack8(*(const GAS v4u*)(pu + 8), u + 8);
      float y[16];
#pragma unroll
      for (int d = 0; d < 16; ++d) y[d] = gelu_as(u[d]) * (OUT[pos * 68 + part * 16 + d] + bsv);
      bf16* po = MIX + (size_t)row * DM + MIX_GM + g * 64 + part * 16;
      v4u w; w.x = pk2(y[0], y[1]); w.y = pk2(y[2], y[3]); w.z = pk2(y[4], y[5]); w.w = pk2(y[6], y[7]); *(GAS v4u*)po = w;
      w.x = pk2(y[8], y[9]); w.y = pk2(y[10], y[11]); w.z = pk2(y[12], y[13]); w.w = pk2(y[14], y[15]); *(GAS v4u*)(po + 8) = w; }
    __syncthreads();
}
__device__ __forceinline__ void attn_naive(KA a, int l, int nrows, int lane, int wave, int G, int bid) {
    const bf16* PROJ = (const bf16*)(a->ws + WS_PROJ); bf16* MIX = (bf16*)(a->ws + WS_MIX);
    const int gw = bid * NWAVES + wave, NGW = G * NWAVES;
    for (int pair = gw; pair < nrows * 2; pair += NGW) {
        const int row = pair >> 1, hk = pair & 1; const bool isctx = row >= S_LAT;
        float q[4], o[4], m[4], ls[4];
#pragma unroll
        for (int g = 0; g < 4; ++g) { q[g] = bflo((unsigned)PROJ[(size_t)row * INW + (hk * 4 + g) * 64 + lane]); o[g] = 0.f; ls[g] = 1.0f; m[g] = a->in[I_SINK][l * 8 + hk * 4 + g] * 1.4426950408889634f; }
        int j0 = 0, j1 = -1;
        if (!isctx) { j0 = row - 128 < 0 ? 0 : row - 128; j1 = row + 128 > S_LAT - 1 ? S_LAT - 1 : row + 128; }
        const int nwin = j1 - j0 + 1;
        const int nk = nwin + C_CTX;
#pragma unroll 4
        for (int t = 0; t < nk; ++t) {
            const int krow = (t < nwin) ? j0 + t : S_LAT + (t - nwin);
            const float k = bflo((unsigned)PROJ[(size_t)krow * INW + COL_AK + hk * 64 + lane]);
            const float v = bflo((unsigned)PROJ[(size_t)krow * INW + COL_AV + hk * 64 + lane]);
#pragma unroll
            for (int g = 0; g < 4; ++g) { const float s = wave_sum(q[g] * k); const float mn = fmaxf(m[g], s);
                const float c = __builtin_amdgcn_exp2f(m[g] - mn), p = __builtin_amdgcn_exp2f(s - mn);
                ls[g] = ls[g] * c + p; o[g] = o[g] * c + p * v; m[g] = mn; }
        }
#pragma unroll
        for (int g = 0; g < 4; ++g) MIX[(size_t)row * DM + MIX_AT + (hk * 4 + g) * 64 + lane] = (bf16)f2bf(o[g] / ls[g]);
    }
}
__device__ __forceinline__ void hgrn_combine(KA a, int l, int nrows, int lane, int wave, int G, int bid) {
    const bf16* PROJ = (const bf16*)(a->ws + WS_PROJ); bf16* MIX = (bf16*)(a->ws + WS_MIX);
    const float* O0 = (const float*)(a->ws + WS_HGO); const float* O1 = O0 + (size_t)R_ALL * 256;
    const f32x4 gn = *(const f32x4*)(a->in[I_HGAIN] + l * 64 + (lane & 15) * 4);
    const int gw = bid * NWAVES + wave, NGW = G * NWAVES;
    for (int r = gw; r < nrows; r += NGW) {
        const f32x4 o = *(const GAS f32x4*)(O0 + (size_t)r * 256 + 4 * lane) + *(const GAS f32x4*)(O1 + (size_t)r * 256 + 4 * lane);
        float ss = (o.x * o.x + o.y * o.y) + (o.z * o.z + o.w * o.w);
        ss += sx<1>(ss); ss += sx<2>(ss); ss += sx<4>(ss); ss += sx<8>(ss);
        const float rstd = __builtin_amdgcn_rsqf(ss * (1.0f / 64.0f) + EPS);
        const v2u gw2 = *(const GAS v2u*)(PROJ + (size_t)r * INW + COL_HG + 4 * lane);
        const float g0 = bflo(gw2.x), g1 = bfhi(gw2.x), g2 = bflo(gw2.y), g3 = bfhi(gw2.y);
        v2u w; w.x = pk2(o.x * rstd * gn.x * silu1(g0), o.y * rstd * gn.y * silu1(g1)); w.y = pk2(o.z * rstd * gn.z * silu1(g2), o.w * rstd * gn.w * silu1(g3));
        *(GAS v2u*)(MIX + (size_t)r * DM + MIX_HG + 4 * lane) = w;
    }
}
__device__ __forceinline__ void moe_gather(KA a, LAS unsigned char* lds, int tid, int lane, int wave, int G, int bid) {
    LAS int* sb = (LAS int*)lds;
    const unsigned* cnt = (const unsigned*)(a->ws + WS_CTL) + CW_MOECNT;
    int* mi = (int*)(a->ws + WS_VEC) + VO_MOE;
    if (tid == 0) { int b = 0;
        for (int e = 0; e < 8; ++e) { const int c = (int)__hip_atomic_load(cnt + 64 * e, RLX_AGENT); sb[e] = b; sb[16 + e] = c;
            const int nt = (c + 255) >> 8;
            if (bid == 0) for (int t = 0; t < nt; ++t) mi[16 + (b >> 8) + t] = e;
            b += nt << 8; }
        sb[8] = b; if (bid == 0) mi[0] = b >> 8; }
    __syncthreads();
    const unsigned char* H8 = (const unsigned char*)(a->ws + WS_H2B); unsigned char* AS = (unsigned char*)(a->ws + WS_AS);
    const int* tokinfo = (const int*)(a->ws + WS_TOK); int* tokslot = (int*)(a->ws + WS_TOK) + S_LAT * 8;
    const int gw = bid * NWAVES + wave, NGW = G * NWAVES;
    for (int t = gw; t < S_LAT; t += NGW) {
        const int* ti = tokinfo + (size_t)t * 8;
        const int e1 = ti[0], e2 = ti[1], r1 = ti[2], r2 = ti[3];
        const int s1 = sb[e1] + r1, s2 = sb[e2] + r2;
        const v4u x0 = ((const GAS v4u*)(H8 + (size_t)t * DM))[lane];
        ((GAS v4u*)(AS + (size_t)s1 * DM))[lane] = x0; ((GAS v4u*)(AS + (size_t)s2 * DM))[lane] = x0;
        if (lane == 0) { int* ts = tokslot + (size_t)t * 4; ts[0] = s1; ts[1] = s2; ts[2] = ti[4]; ts[3] = ti[5]; }
    }
    { const f32x4 z4 = {0.f, 0.f, 0.f, 0.f}; for (int i = bid * NTHR + tid; i < 8 * 256 * DM / 4; i += G * NTHR) ((GAS f32x4*)(a->ws + WS_YF))[i] = z4; }
    for (int e = 0; e < 8; ++e) { const int c = sb[16 + e], pe = (c + 255) & ~255, b = sb[e];
        for (int j = c + gw; j < pe; j += NGW) { const v4u z = {0u, 0u, 0u, 0u}; ((GAS v4u*)(AS + (size_t)(b + j) * DM))[lane] = z; } }
}
__device__ __forceinline__ void moe_combine(KA a, int lane, int wave, int G, int bid) {
    const float* gf = (const float*)(a->ws + WS_VEC) + VO_MOD + (1 * 2 + 0) * 6144 + 5 * 1024;
    const bf16* Y = (const bf16*)(a->ws + WS_Y); const int* tokslot = (const int*)(a->ws + WS_TOK) + S_LAT * 8;
    const int gw = bid * NWAVES + wave, NGW = G * NWAVES;
    for (int t = gw; t < S_LAT; t += NGW) {
        const int* ts = tokslot + (size_t)t * 4; const int s1 = ts[0], s2 = ts[1]; const float w1 = __builtin_bit_cast(float, ts[2]), w2 = __builtin_bit_cast(float, ts[3]);
        GAS f32x4* xr = (GAS f32x4*)(a->out + (size_t)t * DM) + lane;
        const float* YF = (const float*)(a->ws + WS_YF);
#pragma unroll
        for (int j = 0; j < 4; ++j) { const f32x4 g = *(const f32x4*)(gf + 4 * lane + 256 * j); f32x4 x = xr[64 * j]; f32x4 p, q;
            if (s1 < 32768) { const v2u t = ((const GAS v2u*)(Y + (size_t)s1 * DM) + lane)[64 * j]; p = (f32x4){bflo(t.x), bfhi(t.x), bflo(t.y), bfhi(t.y)}; } else p = ((const GAS f32x4*)(YF + (size_t)(s1 - 32768) * DM) + lane)[64 * j];
            if (s2 < 32768) { const v2u t = ((const GAS v2u*)(Y + (size_t)s2 * DM) + lane)[64 * j]; q = (f32x4){bflo(t.x), bfhi(t.x), bflo(t.y), bfhi(t.y)}; } else q = ((const GAS f32x4*)(YF + (size_t)(s2 - 32768) * DM) + lane)[64 * j];
            x = x + g * (p * w1 + q * w2);
            xr[64 * j] = x; }
    }
}

#define IN(k) (lo <= (k) && (k) < hi)
#define GRIDBAR() do { XcdBarrier b2_; b2_.bar = (unsigned*)(KARGS()->ws + WS_CTL) + CW_BAR; b2_.x = xb_xcc_id(); b2_.st = (volatile LAS unsigned*)(lds + MISC_OFF) + 8; xcd_barrier(b2_, wv0 * 64 + (int)__builtin_amdgcn_mbcnt_hi(~0u, __builtin_amdgcn_mbcnt_lo(~0u, 0u))); } while (0)
#define SEAM(k) do { if (IN(k) && IN((k) + 1)) GRIDBAR(); } while (0)
#define PHASE_ROOTS() KA a = KARGS(); unsigned char* ws = a->ws; const float* vec = (const float*)(ws + WS_VEC); (void)vec; int bid = blockIdx.x, G = gridDim.x; asm volatile("" : "+s"(bid), "+s"(G)); int tid = wv0 * 64 + (int)__builtin_amdgcn_mbcnt_hi(~0u, __builtin_amdgcn_mbcnt_lo(~0u, 0u)); asm volatile("" : "+v"(tid)); const int lane = tid & 63, wave = __builtin_amdgcn_readfirstlane(tid >> 6); (void)lane; (void)wave

template <int l> __device__ __forceinline__ void layer_body(const int lo, const int hi, LAS unsigned char* lds, const int wv0) {
        const int pb = 1 + 11 * l;
        if (IN(pb + 0)) { PHASE_ROOTS(); phase_norm(a, l, 0, R_ALL, (bf16*)(ws + WS_H), lane, wave, G, bid); SEAM(pb + 0); }
        if (IN(pb + 1)) {
            PHASE_ROOTS();
            pg8::Gemm g{(const pg8::bf16_t*)(ws + WS_H), (const pg8::bf16_t*)(ws + WS_WIN) + (size_t)l * INW * DM, R_ALL, INW, DM, 0, DM};
            pg8::StaticOrder S; S.init(R_ALL, INW, G, bid);
            pg8::EpiBf16<0> E{(pg8::bf16_t*)(ws + WS_PROJ), INW, nullptr, 0, 0, 1.f};
            pg8::gemm_phase<pg8::EpiBf16<0>, pg8::StaticOrder, true, true>(lds, g, S, E, tid);
            moe_conv_range(a, l == 0 ? MOE_SL0 : MOE_SL2, l == 0 ? MOE_SL1 : MOE_SL3, 650 - 2 * 256, lds, lane, wave, G, bid);
            SEAM(pb + 1);
        }
        if (IN(pb + 2)) {
            PHASE_ROOTS();
            qk_prep(a, l, bid * NTHR + tid, G * NTHR);
            for (int it = bid * NWAVES + wave; it < 520; it += G * NWAVES) vt_item(a, it, lane);
            for (int it = bid; it < 1040; it += G) hgrn_stepA(a, l, it >> 2, it & 3, lds, lane, wave);
            { __syncthreads(); moe_conv_range(a, l == 0 ? MOE_SL3 : MOE_SL7, l == 0 ? MOE_SL4 : MOE_DEFER, 1040 - 4 * 256, lds, lane, wave, G, bid); }
            SEAM(pb + 2);
        }
        if (IN(pb + 3)) {
            PHASE_ROOTS();
            if (bid < 64) hgrn_stepB(a, bid, tid);
            {
                const int nu = (l == 0) ? 260 : 256, ng = (l == 0) ? 520 : 512;
                unsigned* qctr = (unsigned*)(ws + WS_CTL) + CW_QUEUE + 64 * l;
                volatile LAS unsigned* qslot = (volatile LAS unsigned*)(lds + MISC_OFF) + 16;
                for (;;) {
                    __syncthreads();
                    if (tid == 0) qslot[0] = __hip_atomic_fetch_add(qctr, 1u, RLX_AGENT);
                    __syncthreads();
                    const int it = __builtin_amdgcn_readfirstlane((int)qslot[0]);
                    if (it >= nu + ng) break;
                    if (it < nu) attn_unit(a, l, it, lds, tid, lane, wave);
                    else gmlp_unit_mma(a, l, (it - nu) >> 2, (it - nu) & 3, lds, tid, lane, wave);
                }
            }
            SEAM(pb + 3);
        }
        if (IN(pb + 4)) {
            PHASE_ROOTS();
            const int nit = (l == 0) ? 1040 : 1024;
            for (int it = bid; it < nit; it += G) hgrn_stepC(a, l, it >> 2, it & 3, lds, tid, lane, wave);
            if (l == 0) { __syncthreads(); moe_conv_range(a, MOE_SL4, MOE_SL5, 1040 - 4 * 256, lds, lane, wave, G, bid); }
            SEAM(pb + 4);
        }
        if (IN(pb + 5)) {
            PHASE_ROOTS();
            const float* modl = vec + VO_MOD + (l * 2 + 0) * 6144; const float* modc = vec + VO_MOD + (l * 2 + 1) * 6144;
            const int M = S_LAT;
            pg8::Gemm g{(const pg8::bf16_t*)(ws + WS_MIX), (const pg8::bf16_t*)(ws + WS_WOUT) + (size_t)l * DM * DM, M, DM, DM, 0, DM};
            pg8::StaticOrder S; S.init(M, DM, G, bid);
            pg8::EpiResid E{(l == 0) ? a->in[I_X] : a->out, a->out, modl + 2048, a->in[I_CTX], (float*)(ws + WS_CTXR), modc + 2048, S_LAT / 256, DM};
            pg8::gemm_phase<pg8::EpiResid, pg8::StaticOrder, true, true>(lds, g, S, E, tid);
            if (l == 0) {
                pg8::Gemm g2{(const pg8::bf16_t*)(ws + WS_MIX), (const pg8::bf16_t*)(ws + WS_WOUT), R_ALL, DM, 256, 0, DM};
                pg8::SplitKOrder S2{S_LAT / 256, 4, 4, 256, 16, bid, nullptr};
                pg8::EpiAtomic E2{(float*)(ws + WS_CTXR), modc + 2048, S_LAT / 256, DM, 1.0f};
                pg8::gemm_phase<pg8::EpiAtomic, pg8::SplitKOrder, false, true>(lds, g2, S2, E2, tid);
                moe_conv_range(a, MOE_SL5, MOE_SL6, 16, lds, lane, wave, G, bid);
            }
            SEAM(pb + 5);
        }
        if (l == 0) {
            if (IN(pb + 6)) { PHASE_ROOTS(); phase_norm(a, l, 1, R_ALL, (bf16*)(ws + WS_H), lane, wave, G, bid); SEAM(pb + 6); }
            if (IN(pb + 7)) {
                PHASE_ROOTS();
                pg8::Gemm g{(const pg8::bf16_t*)(ws + WS_H), (const pg8::bf16_t*)(ws + WS_WGU), R_ALL, 2 * FFN, DM, 0, DM};
                pg8::StaticOrder S; S.init(R_ALL, 2 * FFN, G, bid);
                pg8::EpiSwiGLU E{(pg8::bf16_t*)(ws + WS_HID), FFN, 1.0f};
                pg8::gemm_phase<pg8::EpiSwiGLU, pg8::StaticOrder, true, true>(lds, g, S, E, tid);
                moe_conv_range(a, MOE_SL1, MOE_SL2, 1430 - 5 * 256, lds, lane, wave, G, bid);
                SEAM(pb + 7);
            }
            if (IN(pb + 8)) {
                PHASE_ROOTS();
                const float* modl = vec + VO_MOD + (l * 2 + 0) * 6144; const float* modc = vec + VO_MOD + (l * 2 + 1) * 6144;
                pg8::Gemm g{(const pg8::bf16_t*)(ws + WS_HID), (const pg8::bf16_t*)(ws + WS_WD), S_LAT, DM, FFN, 0, FFN};
                pg8::StaticOrder S; S.init(S_LAT, DM, G, bid);
                pg8::EpiResid E{a->out, a->out, modl + 5120, (const float*)(ws + WS_CTXR), (float*)(ws + WS_CTXR), modc + 5120, S_LAT / 256, DM};
                pg8::gemm_phase<pg8::EpiResid, pg8::StaticOrder, true, true>(lds, g, S, E, tid);
                {
                    pg8::Gemm g2{(const pg8::bf16_t*)(ws + WS_HID), (const pg8::bf16_t*)(ws + WS_WD), R_ALL, DM, 256, 0, FFN};
                    pg8::SplitKOrder S2{S_LAT / 256, 4, 11, 256, 44, bid, nullptr};
                    pg8::EpiAtomic E2{(float*)(ws + WS_CTXR), modc + 5120, S_LAT / 256, DM, 1.0f};
                    pg8::gemm_phase<pg8::EpiAtomic, pg8::SplitKOrder, false, true>(lds, g2, S2, E2, tid);
                    moe_conv_range(a, MOE_SL6, MOE_SL7, 44, lds, lane, wave, G, bid);
                }
                if (IN(pb + 8) && IN(pb + 11)) GRIDBAR();
            }
        } else {
            if (IN(pb + 6)) { PHASE_ROOTS(); phase_norm_route(a, lds, tid, lane, wave, G, bid); SEAM(pb + 6); }
            if (IN(pb + 7)) { PHASE_ROOTS(); moe_gather(a, lds, tid, lane, wave, G, bid); SEAM(pb + 7); }
            if (IN(pb + 8)) {
                PHASE_ROOTS();
                const int* mi = (const int*)(ws + WS_VEC) + VO_MOE; const int nt = __builtin_amdgcn_readfirstlane(mi[0]);
                pg8::Gemm g{(const pg8::bf16_t*)(ws + WS_AS), (const pg8::bf16_t*)(ws + WS_MGU), nt * 256, 2 * EXD, DM / 2, (size_t)2 * EXD * DM, DM / 2};
                pg8::MoeOrder S; S.init(nt * 256, 2 * EXD, G, bid); S.tile_e = mi + 16;
                pg8::EpiSwiGLU8 E{(unsigned char*)(ws + WS_HIDM), EXD, 1.0f / (F8_WSCALE * F8_ASCALE), F8_HSCALE};
                pg8::gemm_phase<pg8::EpiSwiGLU8, pg8::MoeOrder, true, true, true>(lds, g, S, E, tid);
                SEAM(pb + 8);
            }
            if (IN(pb + 9)) {
                PHASE_ROOTS();
                const int* mi = (const int*)(ws + WS_VEC) + VO_MOE; const int nt = __builtin_amdgcn_readfirstlane(mi[0]); const int nm = nt < 128 ? nt : 128;
                pg8::Gemm g{(const pg8::bf16_t*)(ws + WS_HIDM), (const pg8::bf16_t*)(ws + WS_MD), nm * 256, DM, EXD / 2, (size_t)DM * EXD, EXD / 2};
                pg8::MoeOrder S; S.init(nm * 256, DM, G, bid); S.tile_e = mi + 16;
                pg8::EpiScaleBf16 E{(pg8::bf16_t*)(ws + WS_Y), DM, 1.0f / (F8_WSCALE * F8_HSCALE)};
                pg8::gemm_phase<pg8::EpiScaleBf16, pg8::MoeOrder, true, true, true>(lds, g, S, E, tid);
                if (nt > 128) {
                    pg8::Gemm g2{(const pg8::bf16_t*)(ws + WS_HIDM), (const pg8::bf16_t*)(ws + WS_MD), nt * 256, DM, 256, (size_t)DM * EXD, EXD / 2};
                    pg8::SplitKOrder S2{128, 4, 7, 256, (nt - 128) * 28, bid, mi + 16};
                    pg8::EpiAtomic E2{(float*)(ws + WS_YF), nullptr, 128, DM, 1.0f / (F8_WSCALE * F8_HSCALE)};
                    pg8::gemm_phase<pg8::EpiAtomic, pg8::SplitKOrder, false, true, true>(lds, g2, S2, E2, tid);
                }
                SEAM(pb + 9);
            }
            if (IN(pb + 10)) { PHASE_ROOTS(); moe_combine(a, lane, wave, G, bid); }
        }
    }
__global__ void __launch_bounds__(NTHR, 2) fwd_kernel(Args a_unused) {
    extern __shared__ __attribute__((aligned(16))) unsigned char lds_raw[];
    LAS unsigned char* lds = (LAS unsigned char*)lds_raw;
    const int tid0 = threadIdx.x;
    const int wv0 = __builtin_amdgcn_readfirstlane(tid0 >> 6);
    for (int u = tid0; u < (LDS_BYTES - LDSCTL_OFF) / 4; u += NTHR) ((LAS unsigned*)(lds + LDSCTL_OFF))[u] = 0u;
    __syncthreads();
    const int lo = KARGS()->ph_lo, hi = KARGS()->ph_hi;
    const bool fusedl = (hi - lo) > 1;
    if (fusedl) (void)xcd_barrier_post((unsigned*)(KARGS()->ws + WS_CTL) + CW_BAR, (volatile LAS unsigned*)(lds + MISC_OFF) + 8);
    if (IN(0)) { PHASE_ROOTS(); p0_prologue(a, lds, tid, lane, wave, G, bid); SEAM(0); }

    layer_body<0>(lo, hi, lds, wv0);
    layer_body<1>(lo, hi, lds, wv0);
}

extern "C" void kernel_launch(void* const* d_in, const int* in_sizes, int n_in, void* d_out, int out_size, void* d_ws, size_t ws_size, hipStream_t stream) {
    static int grid = 0;
    if (grid == 0) {
        if (n_in != 23 || in_sizes[0] != S_LAT * DM || out_size != S_LAT * DM || ws_size < WS_END) { fprintf(stderr, "kernel_launch: unexpected shapes / workspace (n_in %d, ws %zu, need %zu)\n", n_in, ws_size, (size_t)WS_END); grid = -1; return; }
        int dev = 0, cus = 0;
        if (hipGetDevice(&dev) != hipSuccess || hipDeviceGetAttribute(&cus, hipDeviceAttributeMultiprocessorCount, dev) != hipSuccess) { grid = -1; return; }
        if (hipFuncSetAttribute((const void*)fwd_kernel, hipFuncAttributeMaxDynamicSharedMemorySize, LDS_BYTES) != hipSuccess) { grid = -1; return; }
        int per_cu = 0;
        (void)hipOccupancyMaxActiveBlocksPerMultiprocessor(&per_cu, (const void*)fwd_kernel, NTHR, LDS_BYTES);
        (void)hipGetLastError();
        grid = cus;
    }
    if (grid < 0) return;
    if (hipMemsetAsync((char*)d_ws + WS_CTL, 0, CTL_ZERO_BYTES, stream) != hipSuccess) return;
    Args a{};
    for (int i = 0; i < 23; ++i) a.in[i] = (const float*)d_in[i];
    a.out = (float*)d_out; a.ws = (unsigned char*)d_ws;
#if ONE_LAUNCH
    a.ph_lo = 0; a.ph_hi = NPH;
    hipLaunchKernelGGL(fwd_kernel, dim3(grid), dim3(NTHR), LDS_BYTES, stream, a);
#else
    for (int p = 0; p < NPH; ++p) {
        if (p == 10 || p == 11) continue;
        a.ph_lo = p; a.ph_hi = p + 1;
        hipLaunchKernelGGL(fwd_kernel, dim3(grid), dim3(NTHR), LDS_BYTES, stream, a);
    }
#endif
}
```

```cpp
#include <hip/hip_runtime.h>
#include <cstdio>
#include <cstdint>
#include <cmath>
#ifndef ONE_LAUNCH
#define ONE_LAUNCH 1
#endif
namespace pg8 {
#define PG8_LAS __attribute__((address_space(3)))
typedef unsigned short bf16_t;
typedef short bf16x8 __attribute__((ext_vector_type(8)));
typedef float f32x4 __attribute__((ext_vector_type(4)));
typedef unsigned u32x4 __attribute__((ext_vector_type(4)));
constexpr int BM = 256, BK = 64, HALF = 128, HTB = HALF * BK * 2  , STAGE_BYTES = 8 * HTB, NXCD = 8, WGM = 8;

__host__ __device__ __forceinline__ int lds_byte(int r, int c) { const int st = (r >> 4) * 2 + (c >> 5), rr = r & 15, cc = c & 31, ob = rr * 64 + cc * 2; return st * 1024 + (ob ^ (((ob >> 9) & 1) << 5)); }
__host__ __device__ __forceinline__ void stage_rc(int b, int& R, int& C) { const int st = b / 1024, sb = b % 1024, swz = sb ^ (((sb >> 9) & 1) << 5); R = (st >> 1) * 16 + swz / 64; C = (st & 1) * 32 + (swz % 64) / 2; }
__host__ __device__ __forceinline__ int perm32(int rho) { const int n = rho >> 4, i = rho & 15; return 8 * (i >> 2) + 4 * n + (i & 3); }

struct Unit { int pm, pn, eb, ko; };
struct Gemm { const bf16_t* A; const bf16_t* Bt; int M, N, K; size_t bstride; int ld; };

struct StaticOrder {
    int nM, nN, nwg, G, c;
    __host__ __device__ void init(int M, int N, int G_, int c_) { nM = M / BM; nN = N / BM; nwg = nM * nN; G = G_; c = c_; }
    __host__ __device__ bool next(int i, Unit& u) const {
        const long L = (long)i * G + c; if (L >= nwg) return false;
        int wgid = (int)L; { const int q = nwg / NXCD, r = nwg % NXCD, xcd = wgid % NXCD, off = wgid / NXCD; wgid = (xcd < r ? xcd * (q + 1) : r * (q + 1) + (xcd - r) * q) + off; }
        const int nig = WGM * nN, gid = wgid / nig, fm = gid * WGM, gsz = (nM - fm) < WGM ? (nM - fm) : WGM;
        u.pm = fm + ((wgid % nig) % gsz); u.pn = (wgid % nig) / gsz; u.eb = 0; u.ko = 0; return true;
    }
    __device__ __forceinline__ void a_ready(const Unit&) const {}
    __device__ __forceinline__ void done(const Unit&) const {}
};

__device__ __forceinline__ unsigned cvt_pk_bf16(float lo, float hi) { unsigned r; asm volatile("v_cvt_pk_bf16_f32 %0, %1, %2" : "=v"(r) : "v"(lo), "v"(hi)); return r; }
typedef float f32x2 __attribute__((ext_vector_type(2)));
__device__ __forceinline__ f32x2 gelu_pk(f32x2 v) {
    const f32x2 av = __builtin_elementwise_abs(v), d = av * 0.2316418882f + 1.0f;
    f32x2 t; t.x = __builtin_amdgcn_rcpf(d.x); t.y = __builtin_amdgcn_rcpf(d.y);
    f32x2 q = t * 0.5307027145f + (-0.7265760135f); q = q * t + 0.7107068705f; q = q * t + (-0.142248368f); q = q * t + 0.127414796f; q = q * t;
    const f32x2 s = (v * v) * (-0.72134752044f);
    f32x2 e; e.x = __builtin_amdgcn_exp2f(s.x); e.y = __builtin_amdgcn_exp2f(s.y);
    const f32x2 m = v * (q * e), r = v - m;
    f32x2 o; o.x = v.x < 0.f ? m.x : r.x; o.y = v.y < 0.f ? m.y : r.y; return o;
}

template <int ACT  > struct EpiBf16 {
    static constexpr bool PERM = true, AFTER_DRAIN = false; static_assert(ACT == 0 || ACT == 1, "EpiBf16: ACT is 0 (none) or 1 (gelu_pk)");
    bf16_t* O; int ldc; const float* bias; int split_cols; size_t split_stride; float scale0;
    __device__ __forceinline__ void operator()(const f32x4 (&acc)[2][2][4][2], const Unit& u, int wr, int wc, int fr, int fq) const {
        const int row0 = u.pm * BM + wr * 64 + fr; int colt = u.pn * BM; bf16_t* base = O;
        float sc = 1.f; if (split_cols) { const int t = colt / split_cols; base += (size_t)t * split_stride; colt -= t * split_cols; if (t == 0) sc = scale0; }
        const int col0 = colt + wc * 32 + 8 * fq, bcol0 = u.pn * BM + wc * 32 + 8 * fq;
        f32x4 bv[2][2];
#pragma unroll
        for (int bj = 0; bj < 2; ++bj)
#pragma unroll
            for (int n = 0; n < 2; ++n) bv[bj][n] = bias ? *(const f32x4*)(bias + bcol0 + bj * HALF + 4 * n) : (f32x4){0.f, 0.f, 0.f, 0.f};
#pragma unroll
        for (int ai = 0; ai < 2; ++ai)
#pragma unroll
            for (int m = 0; m < 4; ++m) { bf16_t* rowp = base + (size_t)(row0 + ai * HALF + m * 16) * ldc + col0;
#pragma unroll
                for (int bj = 0; bj < 2; ++bj) { f32x4 v0 = acc[ai][bj][m][0] + bv[bj][0], v1 = acc[ai][bj][m][1] + bv[bj][1];
                    if (ACT == 1) { f32x2 a = gelu_pk((f32x2){v0[0], v0[1]}), b = gelu_pk((f32x2){v0[2], v0[3]}), c = gelu_pk((f32x2){v1[0], v1[1]}), d = gelu_pk((f32x2){v1[2], v1[3]});
                        v0 = (f32x4){a.x, a.y, b.x, b.y}; v1 = (f32x4){c.x, c.y, d.x, d.y}; }
                    v0 = v0 * sc; v1 = v1 * sc; u32x4 w; w.x = cvt_pk_bf16(v0[0], v0[1]); w.y = cvt_pk_bf16(v0[2], v0[3]); w.z = cvt_pk_bf16(v1[0], v1[1]); w.w = cvt_pk_bf16(v1[2], v1[3]);
                    *(u32x4*)(rowp + bj * HALF) = w; } }
    }
};

__device__ __forceinline__ float silu_f(float x) { return x * __builtin_amdgcn_rcpf(1.0f + __builtin_amdgcn_exp2f(-1.4426950408889634f * x)); }
struct EpiResid {
    static constexpr bool PERM = false, AFTER_DRAIN = false;
    const float* base; float* out; const float* gate; const float* cbase; float* cout; const float* cgate; int mlat; int ldc;
    __device__ __forceinline__ void operator()(const f32x4 (&acc)[2][2][4][2], const Unit& u, int wr, int wc, int fr, int fq) const {
        const bool isc = u.pm >= mlat;
        const float* b = isc ? cbase : base; float* o = isc ? cout : out; const float* g = isc ? cgate : gate;
        const int row0 = (isc ? (u.pm - mlat) : u.pm) * BM + wr * 64 + fr, col0 = u.pn * BM + wc * 32 + 4 * fq;
        f32x4 gv[2][2];
#pragma unroll
        for (int bj = 0; bj < 2; ++bj)
#pragma unroll
            for (int n = 0; n < 2; ++n) gv[bj][n] = *(const f32x4*)(g + col0 + bj * HALF + n * 16);
#pragma unroll
        for (int ai = 0; ai < 2; ++ai)
#pragma unroll
            for (int m = 0; m < 4; ++m) { const size_t off = (size_t)(row0 + ai * HALF + m * 16) * ldc + col0;
#pragma unroll
                for (int bj = 0; bj < 2; ++bj)
#pragma unroll
                    for (int n = 0; n < 2; ++n) { const f32x4 bs = *(const f32x4*)(b + off + bj * HALF + n * 16); *(f32x4*)(o + off + bj * HALF + n * 16) = bs + gv[bj][n] * acc[ai][bj][m][n]; }
                if (m & 1) asm volatile("" ::: "memory"); }
    }
};
struct EpiSwiGLU {
    static constexpr bool PERM = true, AFTER_DRAIN = false;
    bf16_t* O; int ldc; float ds;
    __device__ __forceinline__ void operator()(const f32x4 (&acc)[2][2][4][2], const Unit& u, int wr, int wc, int fr, int fq) const {
        const int row0 = u.pm * BM + wr * 64 + fr, col0 = u.pn * HALF + wc * 32 + 8 * fq;
#pragma unroll
        for (int ai = 0; ai < 2; ++ai)
#pragma unroll
            for (int m = 0; m < 4; ++m) { bf16_t* rowp = O + (size_t)(row0 + ai * HALF + m * 16) * ldc + col0;
                const f32x4 g0 = acc[ai][0][m][0] * ds, g1 = acc[ai][0][m][1] * ds, u0 = acc[ai][1][m][0] * ds, u1 = acc[ai][1][m][1] * ds;
                f32x4 h0, h1;
#pragma unroll
                for (int j = 0; j < 4; ++j) { h0[j] = silu_f(g0[j]) * u0[j]; h1[j] = silu_f(g1[j]) * u1[j]; }
                u32x4 w; w.x = cvt_pk_bf16(h0[0], h0[1]); w.y = cvt_pk_bf16(h0[2], h0[3]); w.z = cvt_pk_bf16(h1[0], h1[1]); w.w = cvt_pk_bf16(h1[2], h1[3]);
                *(u32x4*)rowp = w; }
    }
};
struct MoeOrder : StaticOrder {
    int tb[8];
    __device__ __forceinline__ void load_bases(const int* mi) {
#pragma unroll
        for (int e = 0; e < 8; ++e) tb[e] = __builtin_amdgcn_readfirstlane(mi[e]); }
    __device__ __forceinline__ int expert_of(int pm) const { int e = 0;
#pragma unroll
        for (int j = 0; j < 7; ++j) e += (pm >= tb[j]) ? 1 : 0;
        return e; }
    __device__ __forceinline__ bool next(int i, Unit& u) const { if (!StaticOrder::next(i, u)) return false; u.eb = expert_of(u.pm); return true; }
};

struct SplitKOrder {
    int pm0, nN, P, kp, total, c; const int* tile_e;
    __device__ __forceinline__ bool next(int i, Unit& u) const {
        if (i != 0 || c >= total) return false;
        const int p = c % P, t = c / P; u.pn = t % nN; u.pm = pm0 + t / nN; u.ko = p * kp; u.eb = tile_e ? __builtin_amdgcn_readfirstlane(tile_e[u.pm]) : 0; return true; }
    __device__ __forceinline__ void a_ready(const Unit&) const {}
    __device__ __forceinline__ void done(const Unit&) const {}
};
struct EpiAtomic {
    static constexpr bool PERM = false, AFTER_DRAIN = true;
    float* out; const float* scale; int pm_sub; int ldc; float ds;
    __device__ __forceinline__ void fused(f32x4 (&acc)[2][2][4][2], const Unit& u, int wr, int wc, int fr, int fq, PG8_LAS unsigned char* lds, int wid, int lane) const {
        PG8_LAS float* scr = (PG8_LAS float*)(lds + wid * 16384);
        const int rr = lane >> 5, cc = lane & 31;
#pragma unroll
        for (int ai = 0; ai < 2; ++ai)
#pragma unroll
            for (int bj = 0; bj < 2; ++bj) {
#pragma unroll
                for (int m = 0; m < 4; ++m)
#pragma unroll
                    for (int n = 0; n < 2; ++n) *(PG8_LAS f32x4*)(scr + (m * 16 + fr) * 36 + n * 16 + 4 * fq) = acc[ai][bj][m][n];
                asm volatile("s_waitcnt lgkmcnt(0)" ::: "memory");
                const int colg = u.pn * BM + bj * HALF + wc * 32 + cc; const float sc = (scale ? scale[colg] : 1.0f) * ds;
                float* op = out + (size_t)((u.pm - pm_sub) * BM + ai * HALF + wr * 64 + rr) * ldc + colg;
#pragma unroll 8
                for (int i = 0; i < 32; ++i) { const float v = scr[(2 * i + rr) * 36 + cc]; __hip_atomic_fetch_add(op + (size_t)(2 * i) * ldc, v * sc, __ATOMIC_RELAXED, __HIP_MEMORY_SCOPE_AGENT); }
                asm volatile("s_waitcnt lgkmcnt(0)" ::: "memory");
            }
    }
};

typedef int i32x4v __attribute__((ext_vector_type(4))); typedef int i32x8v __attribute__((ext_vector_type(8)));
struct FragB { bf16x8 k[2]; };
struct Frag8 { i32x8v v; };
template <bool F8> struct FragSel { typedef FragB type; };
template <> struct FragSel<true> { typedef Frag8 type; };
__device__ __forceinline__ void ld_frag(FragB& f, const PG8_LAS unsigned char* p) { f.k[0] = *(const PG8_LAS bf16x8*)p; f.k[1] = *(const PG8_LAS bf16x8*)(p + 1024); }
__device__ __forceinline__ void ld_frag(Frag8& f, const PG8_LAS unsigned char* p) { const i32x4v lo = *(const PG8_LAS i32x4v*)p, hi = *(const PG8_LAS i32x4v*)(p + 1024); f.v = __builtin_shufflevector(lo, hi, 0, 1, 2, 3, 4, 5, 6, 7); }
__device__ __forceinline__ f32x4 mma_frag(const FragB& b, const FragB& a, f32x4 c) { c = __builtin_amdgcn_mfma_f32_16x16x32_bf16(b.k[0], a.k[0], c, 0, 0, 0); return __builtin_amdgcn_mfma_f32_16x16x32_bf16(b.k[1], a.k[1], c, 0, 0, 0); }
__device__ __forceinline__ f32x4 mma_frag(const Frag8& b, const Frag8& a, f32x4 c) {
    asm volatile("v_mfma_scale_f32_16x16x128_f8f6f4 %0, %1, %2, %0, %3, %3 op_sel_hi:[0,0,0]" : "+v"(c) : "v"(b.v), "v"(a.v), "v"(0x7f7f7f7f));
    return c;
}

struct EpiSwiGLU8 {
    static constexpr bool PERM = true, AFTER_DRAIN = false;
    unsigned char* O; int ldc; float ds, hs;
    __device__ __forceinline__ void operator()(const f32x4 (&acc)[2][2][4][2], const Unit& u, int wr, int wc, int fr, int fq) const {
        const int row0 = u.pm * BM + wr * 64 + fr, col0 = u.pn * HALF + wc * 32 + 8 * fq;
        const float k1 = -1.4426950408889634f * ds, k2 = ds * ds * hs;
#pragma unroll
        for (int ai = 0; ai < 2; ++ai)
#pragma unroll
            for (int m = 0; m < 4; ++m) { unsigned char* rowp = O + (size_t)(row0 + ai * HALF + m * 16) * ldc + col0;
                const f32x4 g0 = acc[ai][0][m][0], g1 = acc[ai][0][m][1], u0 = acc[ai][1][m][0], u1 = acc[ai][1][m][1];
                float h[8];
#pragma unroll
                for (int j = 0; j < 4; ++j) {
                    h[j] = __builtin_amdgcn_fmed3f((g0[j] * u0[j]) * k2 * __builtin_amdgcn_rcpf(1.0f + __builtin_amdgcn_exp2f(g0[j] * k1)), -448.0f, 448.0f);
                    h[4 + j] = __builtin_amdgcn_fmed3f((g1[j] * u1[j]) * k2 * __builtin_amdgcn_rcpf(1.0f + __builtin_amdgcn_exp2f(g1[j] * k1)), -448.0f, 448.0f); }
                unsigned lo = 0u, hi = 0u;
                lo = __builtin_amdgcn_cvt_pk_fp8_f32(h[0], h[1], lo, false); lo = __builtin_amdgcn_cvt_pk_fp8_f32(h[2], h[3], lo, true);
                hi = __builtin_amdgcn_cvt_pk_fp8_f32(h[4], h[5], hi, false); hi = __builtin_amdgcn_cvt_pk_fp8_f32(h[6], h[7], hi, true);
                typedef unsigned u32x2 __attribute__((ext_vector_type(2)));
                *(u32x2*)rowp = (u32x2){lo, hi}; }
    }
};
struct EpiScaleBf16 {
    static constexpr bool PERM = true, AFTER_DRAIN = false;
    bf16_t* O; int ldc; float ds;
    __device__ __forceinline__ void operator()(const f32x4 (&acc)[2][2][4][2], const Unit& u, int wr, int wc, int fr, int fq) const {
        const int row0 = u.pm * BM + wr * 64 + fr, col0 = u.pn * BM + wc * 32 + 8 * fq;
#pragma unroll
        for (int ai = 0; ai < 2; ++ai)
#pragma unroll
            for (int m = 0; m < 4; ++m) { bf16_t* rowp = O + (size_t)(row0 + ai * HALF + m * 16) * ldc + col0;
#pragma unroll
                for (int bj = 0; bj < 2; ++bj) { const f32x4 v0 = acc[ai][bj][m][0] * ds, v1 = acc[ai][bj][m][1] * ds;
                    u32x4 w; w.x = cvt_pk_bf16(v0[0], v0[1]); w.y = cvt_pk_bf16(v0[2], v0[3]); w.z = cvt_pk_bf16(v1[0], v1[1]); w.w = cvt_pk_bf16(v1[2], v1[3]);
                    *(u32x4*)(rowp + bj * HALF) = w; } }
    }
};

template <class Epi, class Sched, bool ALIGN_EPI = false, bool SP2 = false, bool F8 = false>
__device__ __forceinline__ void gemm_phase(PG8_LAS unsigned char* lds, const Gemm g, const Sched& S, const Epi& E, int tid_in) {
    int tid_ = tid_in; asm volatile("" : "+v"(tid_));
    const int tid = tid_, wid = __builtin_amdgcn_readfirstlane(tid >> 6), lane = tid & 63, wr = wid >> 2, wc = wid & 3, fr = lane & 15, fq = lane >> 4;
    const int K = g.K, nt = K / BK, ld = g.ld;
    unsigned voffA[2], voffB[2];
#pragma unroll
    for (int i = 0; i < 2; ++i) { int R, C; stage_rc(tid * 16 + i * 8192, R, C); const int Rb = Epi::PERM ? ((R & ~31) + perm32(R & 31)) : R;
        voffA[i] = (unsigned)(R * ld + C) * 2u; voffB[i] = (unsigned)(Rb * ld + C) * 2u; }
    const size_t kstep = (size_t)(BK * 2);
    const size_t hstep = (size_t)HALF * ld * 2;
    const size_t tstep = 2 * hstep;
    const unsigned ldsw = (unsigned)wid * 1024u;
    const int aoff = lds_byte(wr * 64 + fr, fq * 8), boff = lds_byte(wc * 32 + fr, fq * 8);
#define PG8_SA(b, h) (((b) * 2 + (h)) * HTB)
#define PG8_SB(b, h) ((4 + (b) * 2 + (h)) * HTB)
#define PG8_STAGE(bufoff, gbase, voff) do { _Pragma("unroll") for (int _i = 0; _i < 2; ++_i) \
        __builtin_amdgcn_global_load_lds((const unsigned*)((const char*)(gbase) + (voff)[_i]), (PG8_LAS unsigned*)(lds + (bufoff) + ldsw + _i * 8192), 16, 0, 0); } while (0)
#define PG8_LDA(dst, b, h) do { _Pragma("unroll") for (int m = 0; m < 4; ++m) ld_frag(dst[m], lds + PG8_SA(b, h) + aoff + m * 2048); } while (0)
#define PG8_LDB(dst, b, h) do { _Pragma("unroll") for (int n = 0; n < 2; ++n) ld_frag(dst[n], lds + PG8_SB(b, h) + boff + n * 2048); } while (0)
#define PG8_MMA(ai, bj, At, Bt) do { __builtin_amdgcn_s_setprio(1); _Pragma("unroll") for (int m = 0; m < 4; ++m) _Pragma("unroll") for (int n = 0; n < 2; ++n) \
        acc[ai][bj][m][n] = mma_frag(Bt[n], At[m], acc[ai][bj][m][n]); __builtin_amdgcn_s_setprio(0); } while (0)
#define PG8_WAIT_V(n) asm volatile("s_waitcnt vmcnt(" #n ")" ::: "memory")
#define PG8_WAIT_L(n) asm volatile("s_waitcnt lgkmcnt(" #n ")" ::: "memory")
#define PG8_BAR __builtin_amdgcn_s_barrier()
#define PG8_SCHED __builtin_amdgcn_sched_barrier(0)
    Unit cur, nxt; int ui = 0;
    if (!S.next(0, cur)) return;
    float zacc = 0.f; asm volatile("" : "+v"(zacc));
    f32x4 acc[2][2][4][2];
#pragma unroll
    for (int a = 0; a < 2; ++a)
#pragma unroll
        for (int b = 0; b < 2; ++b)
#pragma unroll
            for (int m = 0; m < 4; ++m)
#pragma unroll
                for (int n = 0; n < 2; ++n) acc[a][b][m][n] = (f32x4){zacc, zacc, zacc, zacc};
    typedef typename FragSel<F8>::type Frag;
    Frag At[4], B0[2], B1[2];
    const char* cA = (const char*)g.A + (size_t)cur.pm * tstep + (size_t)cur.ko * 2; const char* cB = (const char*)g.Bt + (size_t)cur.eb * g.bstride + (size_t)cur.pn * tstep + (size_t)cur.ko * 2;
    S.a_ready(cur);
    if constexpr (SP2) {
        PG8_STAGE(PG8_SB(0, 0), cB, voffB); PG8_STAGE(PG8_SB(0, 1), cB + hstep, voffB); PG8_STAGE(PG8_SA(0, 0), cA, voffA); PG8_STAGE(PG8_SA(0, 1), cA + hstep, voffA);
        if (wr == 1) PG8_BAR;
        PG8_WAIT_V(2); PG8_BAR;
        PG8_STAGE(PG8_SB(1, 0), cB + kstep, voffB); PG8_STAGE(PG8_SA(1, 0), cA + kstep, voffA); PG8_STAGE(PG8_SB(1, 1), cB + hstep + kstep, voffB);
        PG8_WAIT_V(6); PG8_BAR;
    } else {
        PG8_STAGE(PG8_SB(0, 0), cB, voffB); PG8_STAGE(PG8_SA(0, 0), cA, voffA); PG8_STAGE(PG8_SB(0, 1), cB + hstep, voffB); PG8_STAGE(PG8_SA(0, 1), cA + hstep, voffA);
        if (wr == 1) PG8_BAR;
        PG8_WAIT_V(4); PG8_BAR;
        PG8_STAGE(PG8_SB(1, 0), cB + kstep, voffB); PG8_STAGE(PG8_SA(1, 0), cA + kstep, voffA); PG8_STAGE(PG8_SB(1, 1), cB + hstep + kstep, voffB);
        PG8_WAIT_V(6); PG8_BAR;
    }
    for (;;) {
        const bool has_next = S.next(ui + 1, nxt);
        const char* nA = has_next ? (const char*)g.A + (size_t)nxt.pm * tstep + (size_t)nxt.ko * 2 : cA; const char* nB = has_next ? (const char*)g.Bt + (size_t)nxt.eb * g.bstride + (size_t)nxt.pn * tstep + (size_t)nxt.ko * 2 : cB;
        for (int t = 0; t < nt; t += 2) {
            const bool last = (t == nt - 2);
            const char* a1 = cA + (size_t)(t + 1) * kstep;
            const char* a2 = last ? nA : cA + (size_t)(t + 2) * kstep; const char* b2 = last ? nB : cB + (size_t)(t + 2) * kstep;
            const char* a3 = a2 + kstep; const char* b3 = b2 + kstep;
            if (last && has_next) S.a_ready(nxt);
            if constexpr (SP2) {
            PG8_LDB(B0, 0, 0); PG8_LDB(B1, 0, 1); PG8_SCHED; PG8_LDA(At, 0, 0); PG8_STAGE(PG8_SA(1, 1), a1 + hstep, voffA);
            PG8_WAIT_V(8); PG8_WAIT_L(0); PG8_BAR; PG8_MMA(0, 0, At, B0); PG8_MMA(0, 1, At, B1); PG8_BAR; PG8_SCHED;
            PG8_LDA(At, 0, 1); PG8_STAGE(PG8_SB(0, 0), b2, voffB); PG8_STAGE(PG8_SB(0, 1), b2 + hstep, voffB); PG8_STAGE(PG8_SA(0, 0), a2, voffA);
            PG8_WAIT_V(8); PG8_WAIT_L(0); PG8_BAR; PG8_MMA(1, 0, At, B0); PG8_MMA(1, 1, At, B1); PG8_BAR; PG8_SCHED;
            PG8_LDB(B0, 1, 0); PG8_LDB(B1, 1, 1); PG8_SCHED; PG8_LDA(At, 1, 0); PG8_STAGE(PG8_SA(0, 1), a2 + hstep, voffA);
            PG8_WAIT_V(8); PG8_WAIT_L(0); PG8_BAR; PG8_MMA(0, 0, At, B0); PG8_MMA(0, 1, At, B1); PG8_BAR; PG8_SCHED;
            PG8_LDA(At, 1, 1); PG8_STAGE(PG8_SB(1, 0), b3, voffB); PG8_STAGE(PG8_SB(1, 1), b3 + hstep, voffB); PG8_STAGE(PG8_SA(1, 0), a3, voffA);
            PG8_WAIT_V(8); PG8_WAIT_L(0); PG8_BAR; PG8_MMA(1, 0, At, B0); PG8_MMA(1, 1, At, B1); PG8_BAR; PG8_SCHED;
            } else {
            PG8_LDB(B0, 0, 0); PG8_SCHED; PG8_LDA(At, 0, 0); PG8_STAGE(PG8_SA(1, 1), a1 + hstep, voffA);
            PG8_WAIT_L(8); PG8_BAR; PG8_WAIT_L(0); PG8_MMA(0, 0, At, B0); PG8_BAR; PG8_SCHED;
            PG8_LDB(B1, 0, 1); PG8_STAGE(PG8_SB(0, 0), b2, voffB);
            PG8_BAR; PG8_WAIT_L(0); PG8_MMA(0, 1, At, B1); PG8_BAR;
            PG8_LDA(At, 0, 1); PG8_STAGE(PG8_SA(0, 0), a2, voffA);
            PG8_BAR; PG8_WAIT_L(0); PG8_MMA(1, 0, At, B0); PG8_BAR; PG8_SCHED;
            PG8_STAGE(PG8_SB(0, 1), b2 + hstep, voffB);
            PG8_WAIT_V(6); PG8_BAR; PG8_MMA(1, 1, At, B1); PG8_BAR;
            PG8_LDB(B0, 1, 0); PG8_SCHED; PG8_LDA(At, 1, 0); PG8_STAGE(PG8_SA(0, 1), a2 + hstep, voffA);
            PG8_WAIT_L(8); PG8_BAR; PG8_WAIT_L(0); PG8_MMA(0, 0, At, B0); PG8_BAR; PG8_SCHED;
            PG8_LDB(B1, 1, 1); PG8_STAGE(PG8_SB(1, 0), b3, voffB);
            PG8_BAR; PG8_WAIT_L(0); PG8_MMA(0, 1, At, B1); PG8_BAR;
            PG8_LDA(At, 1, 1); PG8_STAGE(PG8_SA(1, 0), a3, voffA);
            PG8_BAR; PG8_WAIT_L(0); PG8_MMA(1, 0, At, B0); PG8_BAR; PG8_SCHED;
            PG8_STAGE(PG8_SB(1, 1), b3 + hstep, voffB);
            PG8_WAIT_V(6); PG8_BAR; PG8_MMA(1, 1, At, B1); PG8_BAR;
            }
        }
        if constexpr (ALIGN_EPI) { if (wr == 0) PG8_BAR; }
        if constexpr (F8) {
            asm volatile("s_nop 15\n\ts_nop 15" : "+v"(acc[1][1][0][0]), "+v"(acc[1][1][0][1]), "+v"(acc[1][1][1][0]), "+v"(acc[1][1][1][1]), "+v"(acc[1][1][2][0]), "+v"(acc[1][1][2][1]), "+v"(acc[1][1][3][0]), "+v"(acc[1][1][3][1])); }
        if constexpr (!Epi::AFTER_DRAIN) { E(acc, cur, wr, wc, fr, fq); S.done(cur); }
        if (!has_next) break;
#pragma unroll
        for (int a = 0; a < 2; ++a)
#pragma unroll
            for (int b = 0; b < 2; ++b)
#pragma unroll
                for (int m = 0; m < 4; ++m)
#pragma unroll
                    for (int n = 0; n < 2; ++n) acc[a][b][m][n] = (f32x4){zacc, zacc, zacc, zacc};
        cur = nxt; cA = nA; cB = nB; ++ui;
        if constexpr (ALIGN_EPI) { if (wr == 1) PG8_BAR; }
    }
    PG8_WAIT_V(0);
    if constexpr (!ALIGN_EPI) { if (wr == 0) PG8_BAR; }
    PG8_BAR;
    if constexpr (Epi::AFTER_DRAIN) { E.fused(acc, cur, wr, wc, fr, fq, lds, wid, lane); S.done(cur); }
#undef PG8_SA
#undef PG8_SB
#undef PG8_STAGE
#undef PG8_LDA
#undef PG8_LDB
#undef PG8_MMA
#undef PG8_WAIT_V
#undef PG8_WAIT_L
#undef PG8_BAR
#undef PG8_SCHED
}
}


constexpr int S_LAT = 16384, C_CTX = 256, R_ALL = S_LAT + C_CTX, DM = 1024;
constexpr int INW = 2560, FFN = 2816, EXD = 3584, NEXP = 8;
constexpr int COL_AQ = 0, COL_AK = 512, COL_AV = 640, COL_HQ = 768, COL_HFF = 1024, COL_HFB = 1280, COL_HI = 1536, COL_HG = 1792, COL_GU = 2048, COL_GV = 2304;
constexpr int MIX_AT = 0, MIX_HG = 512, MIX_GM = 768;
constexpr int MOE_MAXROWS = 34816;
constexpr float EPS = 1e-6f;
constexpr int NWAVES = 8, NTHR = 512;
constexpr int NPH = 23;

constexpr size_t MiB = 1u << 20;
constexpr size_t WS_CTL = 0, CTL_ZERO_BYTES = 1 * MiB;
constexpr size_t WS_VEC = 1 * MiB;
constexpr size_t WS_TOK = 2 * MiB;
constexpr size_t WS_WIN = 3 * MiB;
constexpr size_t WS_WOUT = 13 * MiB;
constexpr size_t WS_WGU = 17 * MiB;
constexpr size_t WS_WD = 28 * MiB;
constexpr size_t WS_MGU = 34 * MiB;
constexpr size_t WS_MD = 146 * MiB;
constexpr size_t WS_H = 202 * MiB;
constexpr size_t WS_PROJ = 235 * MiB;
constexpr size_t WS_MIX = 317 * MiB;
constexpr size_t WS_HGO = 350 * MiB;
constexpr size_t WS_CTXR = 383 * MiB;
constexpr size_t WS_HLT = WS_HGO;
constexpr size_t WS_HSP = 384 * MiB;
constexpr size_t WS_HDG = 402 * MiB;
constexpr size_t WS_VT = 403 * MiB;
constexpr size_t WS_HID = WS_PROJ;
constexpr size_t WS_AS = 202 * MiB;
constexpr size_t WS_HIDM = 270 * MiB;
constexpr size_t WS_H2B = 440 * MiB;
constexpr size_t WS_YF = WS_WIN;
constexpr size_t WS_Y = WS_MGU;
constexpr size_t WS_END = 508 * MiB;
static_assert(WS_HID + (size_t)R_ALL * FFN * 2 <= WS_HGO && WS_AS + (size_t)MOE_MAXROWS * DM * 2 <= WS_HIDM && WS_HIDM + (size_t)MOE_MAXROWS * EXD * 2 <= WS_END, "ws map");
static_assert(WS_H2B >= WS_HIDM && WS_H2B + (size_t)S_LAT * DM * 2 <= WS_END && WS_H + (size_t)R_ALL * DM * 2 <= WS_PROJ && WS_PROJ + (size_t)R_ALL * INW * 2 <= WS_MIX && WS_MIX + (size_t)R_ALL * DM * 2 <= WS_HGO && WS_HGO + (size_t)2 * R_ALL * 256 * 4 <= WS_CTXR, "ws map 2");
constexpr int VO_MOD = 0;
constexpr int VO_ROPE = 32768;
constexpr int VO_MOE = 65536;
constexpr int CW_BAR = 4096;
constexpr int CW_QUEUE = 2048;
constexpr int CW_MOECNT = 1024;

constexpr int RING_BYTES = 131072;
constexpr int LDSCTL_OFF = 159744, MISC_OFF = LDSCTL_OFF + 320;
constexpr int LDS_BYTES = 163840;

#define GAS __attribute__((address_space(1)))
#define LAS __attribute__((address_space(3)))
typedef unsigned short bf16;
typedef unsigned v4u __attribute__((ext_vector_type(4)));
typedef unsigned v2u __attribute__((ext_vector_type(2)));
typedef float f32x4 __attribute__((ext_vector_type(4)));
typedef GAS unsigned gu32;
#define RLX_AGENT __ATOMIC_RELAXED, __HIP_MEMORY_SCOPE_AGENT
#define LDS_WAIT() asm volatile("s_waitcnt lgkmcnt(0)" ::: "memory")
typedef float f32x2_t __attribute__((ext_vector_type(2))); typedef __bf16 bf16x2_t __attribute__((ext_vector_type(2)));
__device__ __forceinline__ unsigned pk2(float lo, float hi) { const f32x2_t v = {lo, hi}; const bf16x2_t b = __builtin_convertvector(v, bf16x2_t); return __builtin_bit_cast(unsigned, b); }
__device__ __forceinline__ unsigned f2bf(float f) { return pk2(f, 0.f) & 0xffffu; }
__device__ __forceinline__ float bflo(unsigned w) { return __builtin_bit_cast(float, w << 16); }
__device__ __forceinline__ float bfhi(unsigned w) { return __builtin_bit_cast(float, w & 0xffff0000u); }
__device__ __forceinline__ float sigm1(float x) { return __builtin_amdgcn_rcpf(1.0f + __builtin_amdgcn_exp2f(-1.4426950408889634f * x)); }
__device__ __forceinline__ float silu1(float x) { return x * sigm1(x); }
__device__ __forceinline__ float gelu1(float x) { return 0.5f * x * (1.0f + erff(x * 0.70710678118654752f)); }
template <int X> __device__ __forceinline__ float sx(float v) { return __shfl_xor(v, X); }
__device__ __forceinline__ float sx32_add(float v) { return v + __shfl_xor(v, 32); }
__device__ __forceinline__ float sx32_max(float v) { return fmaxf(v, __shfl_xor(v, 32)); }
__device__ __forceinline__ float wave_sum(float v) { v += sx<1>(v); v += sx<2>(v); v += sx<4>(v); v += sx<8>(v); v += sx<16>(v); return sx32_add(v); }
__device__ __forceinline__ void unpack8(const v4u w, float* f) { f[0] = bflo(w.x); f[1] = bfhi(w.x); f[2] = bflo(w.y); f[3] = bfhi(w.y); f[4] = bflo(w.z); f[5] = bfhi(w.z); f[6] = bflo(w.w); f[7] = bfhi(w.w); }


__device__ __forceinline__ float clamp448(float x) { return fminf(fmaxf(x, -448.0f), 448.0f); }
__device__ __forceinline__ unsigned pk4_fp8(float a, float b, float c, float d) {
    unsigned w = 0u; w = __builtin_amdgcn_cvt_pk_fp8_f32(clamp448(a), clamp448(b), w, false); w = __builtin_amdgcn_cvt_pk_fp8_f32(clamp448(c), clamp448(d), w, true); return w; }
constexpr float F8_WSCALE = 128.0f;
constexpr float F8_ASCALE = 16.0f;
constexpr float F8_HSCALE = 8.0f;
#define XB_TMO      128
#define XB_XCNT(j)  (256  + 64 * (j))
#define XB_XSUB(j)  (1280 + 64 * (j))
#define XB_XGEN(j)  (2304 + 64 * (j))
#define XB_TOP      3328
#define XB_TOPGEN   3392
#define XCD_BAR_WORDS 3456
#define XB_SPIN_CAP (1u << 18)

__device__ __forceinline__ unsigned xb_ld(unsigned* p)              { return __hip_atomic_load(p, __ATOMIC_RELAXED, __HIP_MEMORY_SCOPE_AGENT); }
__device__ __forceinline__ unsigned xb_add(unsigned* p, unsigned v) { return __hip_atomic_fetch_add(p, v, __ATOMIC_RELAXED, __HIP_MEMORY_SCOPE_AGENT); }
__device__ __forceinline__ unsigned xb_xcc_id() { return (unsigned)__builtin_amdgcn_s_getreg((3 << 11) | 20) & 0xFu; }
#define XB_SPIN(cond, bar) do { unsigned _sp = 0; while (cond) { __builtin_amdgcn_s_sleep(1); \
    if ((++_sp & 255u) == 0u) { if (xb_ld(&(bar)[XB_TMO])) break; if (_sp > XB_SPIN_CAP) { atomicAdd(&(bar)[XB_TMO], 1u); break; } } } } while (0)

struct XcdBarrier {
    unsigned* bar; unsigned x;
    volatile LAS unsigned* st;
};

__device__ __forceinline__ XcdBarrier xcd_barrier_post(unsigned* bar, volatile LAS unsigned* st) {
    XcdBarrier b; b.bar = bar; b.x = xb_xcc_id(); b.st = st;
    if (threadIdx.x == 0) (void)xb_add(&bar[XB_XCNT(b.x)], 1u);
    return b;
}
__device__ __forceinline__ void xcd_barrier_complete(unsigned* bar, unsigned x, unsigned& nloc, unsigned& nx) {
    const unsigned G = gridDim.x * gridDim.y * gridDim.z;
    unsigned sum, cnt, mine, sp = 0u;
    for (;;) {
        sum = 0u; cnt = 0u; mine = 0u;
#pragma unroll
        for (unsigned j = 0; j < 16; ++j) { const unsigned c = xb_ld(&bar[XB_XCNT(j)]); sum += c; cnt += (c > 0u) ? 1u : 0u; mine = (j == x) ? c : mine; }
        if (sum == G) break;
        __builtin_amdgcn_s_sleep(1);
        if ((++sp & 255u) == 0u) { if (xb_ld(&bar[XB_TMO])) break; if (sp > XB_SPIN_CAP) { atomicAdd(&bar[XB_TMO], 1u); break; } }
    }
    nloc = mine > 0u ? mine : 1u; nx = cnt > 0u ? cnt : 1u;
}

__device__ __forceinline__ void xcd_barrier(const XcdBarrier& b, const int tid_in) {
    asm volatile("s_waitcnt vmcnt(0)" ::: "memory");
    __syncthreads();
    if (tid_in == 0) {
        unsigned* bar = b.bar;
        __builtin_amdgcn_s_waitcnt(0);
        unsigned nloc = b.st[0], nx = b.st[1];
        if (nloc == 0u) { xcd_barrier_complete(bar, b.x, nloc, nx); b.st[0] = nloc; b.st[1] = nx; }
        const unsigned old = xb_add(&bar[XB_XSUB(b.x)], 1u);
        const unsigned gen = old / nloc;
        if (old + 1u == (gen + 1u) * nloc) {
            __builtin_amdgcn_fence(__ATOMIC_RELEASE, "agent");
            asm volatile("s_waitcnt vmcnt(0)" ::: "memory");
            const unsigned og = xb_add(&bar[XB_TOP], 1u);
            const unsigned tg = og / nx;
            if (og + 1u == (tg + 1u) * nx) xb_add(&bar[XB_TOPGEN], 1u);
            else XB_SPIN(xb_ld(&bar[XB_TOPGEN]) == tg, bar);
            __builtin_amdgcn_fence(__ATOMIC_ACQUIRE, "agent");
            xb_add(&bar[XB_XGEN(b.x)], 1u);
            asm volatile("s_waitcnt vmcnt(0)" ::: "memory");
        } else {
            XB_SPIN(xb_ld(&bar[XB_XGEN(b.x)]) == gen, bar);
            __builtin_amdgcn_fence(__ATOMIC_ACQUIRE, "agent");
            asm volatile("s_waitcnt vmcnt(0)" ::: "memory");
        }
    }
    __syncthreads();
}


struct Args { const float* in[23]; float* out; unsigned char* ws; int ph_lo, ph_hi; };
typedef const __attribute__((address_space(4))) Args* KA;
#define KARGS() ({ KA p_ = (KA)__builtin_amdgcn_kernarg_segment_ptr(); asm volatile("" : "+s"(p_)); p_; })
enum { I_X = 0, I_C, I_CTX, I_CCTX, I_WADA, I_BADA, I_WIN, I_WOUT, I_QG, I_KG, I_SINK, I_HLB, I_HGAIN, I_GWS, I_GBS, I_GNG, I_FG, I_FU, I_FD, I_ROUTER, I_MG, I_MU, I_MDN };

__device__ __forceinline__ void transpose_item(const float* W, int K, int N, bf16* WT, int mode, LAS float* scr, int item, int lane) {
    const int nblk = N / 32, kb = item / nblk, nb = item % nblk, k0 = 64 * kb, n0 = 32 * nb;
#pragma unroll 8
    for (int i = 0; i < 32; ++i) { const int kk = 2 * i + (lane >> 5); scr[kk * 33 + (lane & 31)] = __builtin_nontemporal_load(&W[(size_t)(k0 + kk) * N + n0 + (lane & 31)]); }
    LDS_WAIT(); asm volatile("" ::: "memory");
    const int c = lane & 7;
#pragma unroll
    for (int j = 0; j < 4; ++j) { const int n = (lane >> 3) + 8 * j; const LAS float* s = scr + (8 * c) * 33 + n;
        v4u o; o.x = pk2(s[0 * 33], s[1 * 33]); o.y = pk2(s[2 * 33], s[3 * 33]); o.z = pk2(s[4 * 33], s[5 * 33]); o.w = pk2(s[6 * 33], s[7 * 33]);
        const int ng = n0 + n; const int drow = (mode == 0) ? ng : (ng + 128 * (ng / 128) + (mode == 2 ? 128 : 0));
        *(GAS v4u*)(WT + (size_t)drow * K + k0 + 8 * c) = o; }
    LDS_WAIT(); asm volatile("" ::: "memory");
}
__device__ __forceinline__ void transpose_item8(const float* W, int K, int N, unsigned char* WT, int mode, LAS float* scr, int item, int lane) {
    const int nblk = N / 32, kb = item / nblk, nb = item % nblk, k0 = 64 * kb, n0 = 32 * nb;
#pragma unroll 8
    for (int i = 0; i < 32; ++i) { const int kk = 2 * i + (lane >> 5); scr[kk * 33 + (lane & 31)] = __builtin_nontemporal_load(&W[(size_t)(k0 + kk) * N + n0 + (lane & 31)]); }
    LDS_WAIT(); asm volatile("" ::: "memory");
    const int c = lane & 7;
#pragma unroll
    for (int j = 0; j < 4; ++j) { const int n = (lane >> 3) + 8 * j; const LAS float* s = scr + (8 * c) * 33 + n;
        v2u o; o.x = pk4_fp8(s[0 * 33] * F8_WSCALE, s[1 * 33] * F8_WSCALE, s[2 * 33] * F8_WSCALE, s[3 * 33] * F8_WSCALE); o.y = pk4_fp8(s[4 * 33] * F8_WSCALE, s[5 * 33] * F8_WSCALE, s[6 * 33] * F8_WSCALE, s[7 * 33] * F8_WSCALE);
        const int ng = n0 + n; const int drow = (mode == 0) ? ng : (ng + 128 * (ng / 128) + (mode == 2 ? 128 : 0));
        *(GAS v2u*)(WT + (size_t)drow * K + k0 + 8 * c) = o; }
    LDS_WAIT(); asm volatile("" ::: "memory");
}
constexpr int MOE_ITEMS = 24 * 16 * 112;
constexpr int MOE_SL0 = 0, MOE_SL1 = 5376, MOE_SL2 = 10752, MOE_SL3 = 16128, MOE_SL4 = 19200, MOE_SL5 = 25344, MOE_SL6 = 29184, MOE_SL7 = 32576, MOE_DEFER = 34496;
__device__ __forceinline__ void moe_conv_item(KA a, int it, LAS float* scr, int lane) {
    constexpr int I_M = 16 * 112;
    unsigned char* ws = a->ws;
    const int idx = it / I_M, r = it % I_M;
    if (idx < 8) transpose_item8(a->in[I_MG] + (size_t)idx * DM * EXD, DM, EXD, (unsigned char*)(ws + WS_MGU) + (size_t)idx * 2 * EXD * DM, 1, scr, r, lane);
    else if (idx < 16) transpose_item8(a->in[I_MU] + (size_t)(idx - 8) * DM * EXD, DM, EXD, (unsigned char*)(ws + WS_MGU) + (size_t)(idx - 8) * 2 * EXD * DM, 2, scr, r, lane);
    else transpose_item8(a->in[I_MDN] + (size_t)(idx - 16) * EXD * DM, EXD, DM, (unsigned char*)(ws + WS_MD) + (size_t)(idx - 16) * DM * EXD, 0, scr, r, lane);
}
__device__ __forceinline__ void moe_conv_range(KA a, int lo, int hi, int first, LAS unsigned char* lds, int lane, int wave, int G, int bid) {
    if (bid < first) return;
    LAS float* scr = (LAS float*)(lds + wave * 8704);
    const int nw = (G - first) * NWAVES, w = (bid - first) * NWAVES + wave;
    for (int i = lo + w; i < hi; i += nw) moe_conv_item(a, i, scr, lane);
}
__device__ __forceinline__ void p0_prologue(KA a, LAS unsigned char* lds, int tid, int lane, int wave, int G, int bid) {
    unsigned char* ws = a->ws;
    LAS float* scr = (LAS float*)(lds + wave * 8704);
    const int gw = bid * NWAVES + wave, NGW = G * NWAVES;
    constexpr int I_IN = 16 * 80, I_OUT = 16 * 32, I_F = 16 * 88, I_FDN = 44 * 32, I_M = 16 * 112;
    constexpr int NIT = 2 * I_IN + 2 * I_OUT + 2 * I_F + I_FDN + 24 * I_M;
    for (int it0 = gw; it0 < NIT; it0 += NGW) {
        int it = it0;
        if (it < 2 * I_IN) { const int l = it / I_IN, r = it % I_IN; transpose_item(a->in[I_WIN] + (size_t)l * DM * INW, DM, INW, (bf16*)(ws + WS_WIN) + (size_t)l * INW * DM, 0, scr, r, lane); continue; } it -= 2 * I_IN;
        if (it < 2 * I_OUT) { const int l = it / I_OUT, r = it % I_OUT; transpose_item(a->in[I_WOUT] + (size_t)l * DM * DM, DM, DM, (bf16*)(ws + WS_WOUT) + (size_t)l * DM * DM, 0, scr, r, lane); continue; } it -= 2 * I_OUT;
        if (it < I_F) { transpose_item(a->in[I_FG], DM, FFN, (bf16*)(ws + WS_WGU), 1, scr, it, lane); continue; } it -= I_F;
        if (it < I_F) { transpose_item(a->in[I_FU], DM, FFN, (bf16*)(ws + WS_WGU), 2, scr, it, lane); continue; } it -= I_F;
        if (it < I_FDN) { transpose_item(a->in[I_FD], FFN, DM, (bf16*)(ws + WS_WD), 0, scr, it, lane); continue; } it -= I_FDN;
        if (it >= MOE_DEFER) moe_conv_item(a, it, scr, lane);
    }
    LAS float* sil = (LAS float*)(lds + 69632);
    LAS float* part = (LAS float*)(lds + 69632 + 8192);
    float* vec = (float*)(ws + WS_VEC);
    if (bid < 192) {
        for (int i = tid; i < 2048; i += NTHR) { const float v = (i < 1024) ? a->in[I_C][i] : a->in[I_CCTX][i - 1024]; sil[i] = silu1(v); }
        __syncthreads();
        for (int item = bid; item < 192; item += G) {
            const int l = item / 96, cb = item % 96, col = cb * 64 + lane;
            const float* w = a->in[I_WADA] + (size_t)l * DM * 6144 + col;
            float a0 = 0.f, a1 = 0.f;
#pragma unroll 1
            for (int k0 = wave * 128; k0 < wave * 128 + 128; k0 += 32) { float wv[32];
#pragma unroll
                for (int j = 0; j < 32; ++j) wv[j] = __builtin_nontemporal_load(&w[(size_t)(k0 + j) * 6144]);
#pragma unroll
                for (int j = 0; j < 32; ++j) { a0 += sil[k0 + j] * wv[j]; a1 += sil[1024 + k0 + j] * wv[j]; } }
            part[(wave * 2 + 0) * 64 + lane] = a0; part[(wave * 2 + 1) * 64 + lane] = a1;
            __syncthreads();
            if (wave == 0) { float s0 = 0.f, s1 = 0.f;
#pragma unroll
                for (int w8 = 0; w8 < 8; ++w8) { s0 += part[(w8 * 2 + 0) * 64 + lane]; s1 += part[(w8 * 2 + 1) * 64 + lane]; }
                const float b = a->in[I_BADA][l * 6144 + col];
                vec[VO_MOD + (l * 2 + 0) * 6144 + col] = s0 + b; vec[VO_MOD + (l * 2 + 1) * 6144 + col] = s1 + b; }
            __syncthreads();
        }
    }
    for (int i = bid * NTHR + tid; i < C_CTX * DM / 4; i += G * NTHR) ((GAS f32x4*)(ws + WS_CTXR))[i] = ((const GAS f32x4*)a->in[I_CTX])[i];
    if (bid == G - 1) {
        for (int idx = tid; idx < 5120; idx += NTHR) {
            const int isc = idx >= 4096, j = isc ? idx - 4096 : idx, pos = j / 16, i = j % 16;
            const float inv = exp2f(-(float)i * 0.83048202372184059f);
            const float ang = (float)pos * inv;
            double r = (double)ang * 0.15915494309189535; r -= floor(r);
            const float rf = (float)r;
            const float cs = __builtin_amdgcn_cosf(rf), sn = __builtin_amdgcn_sinf(rf);
            float* t = vec + VO_ROPE + (isc ? 8192 : 0);
            const int n = isc ? 1024 : 4096;
            t[j] = cs; t[n + j] = sn;
        }
    }
}

template <bool STORE = true> __device__ __forceinline__ void norm_row(const float* xrow, const float* sc, const float* sh, bf16* orow, int lane, f32x4 (&h)[4]) {
    const GAS f32x4* xr = (const GAS f32x4*)xrow + lane;
    f32x4 v[4]; float s = 0.f;
#pragma unroll
    for (int j = 0; j < 4; ++j) { v[j] = xr[64 * j]; s += (v[j].x * v[j].x + v[j].y * v[j].y) + (v[j].z * v[j].z + v[j].w * v[j].w); }
    const float rstd = __builtin_amdgcn_rsqf(wave_sum(s) * (1.0f / DM) + EPS);
    GAS v2u* o8 = (GAS v2u*)orow + lane;
#pragma unroll
    for (int j = 0; j < 4; ++j) { const f32x4 scv = *(const f32x4*)(sc + 4 * lane + 256 * j), shv = *(const f32x4*)(sh + 4 * lane + 256 * j);
        h[j] = v[j] * rstd * (scv + 1.0f) + shv;
        if constexpr (STORE) { v2u w; w.x = pk2(h[j].x, h[j].y); w.y = pk2(h[j].z, h[j].w); o8[64 * j] = w; } }
}
__device__ __forceinline__ void phase_norm(KA a, int l, int which, int nrows, bf16* H, int lane, int wave, int G, int bid) {
    const float* vec = (const float*)(a->ws + WS_VEC);
    const float* xl = (l == 0 && which == 0) ? a->in[I_X] : a->out;
    const float* xc = (l == 0 && which == 0) ? a->in[I_CTX] : (const float*)(a->ws + WS_CTXR);
    const float* ml = vec + VO_MOD + (l * 2 + 0) * 6144 + which * 3072;
    const float* mc = vec + VO_MOD + (l * 2 + 1) * 6144 + which * 3072;
    const int gw = bid * NWAVES + wave, NGW = G * NWAVES;
    f32x4 scl[4], shl[4], v[4];
#pragma unroll
    for (int j = 0; j < 4; ++j) { scl[j] = *(const f32x4*)(ml + 1024 + 4 * lane + 256 * j) + 1.0f; shl[j] = *(const f32x4*)(ml + 4 * lane + 256 * j); }
    if (gw < nrows) { const GAS f32x4* xr = (const GAS f32x4*)(gw >= S_LAT ? xc + (size_t)(gw - S_LAT) * DM : xl + (size_t)gw * DM) + lane;
#pragma unroll
        for (int j = 0; j < 4; ++j) v[j] = xr[64 * j]; }
    for (int r = gw; r < nrows; r += NGW) {
        const int rn = r + NGW; f32x4 vn[4];
        if (rn < nrows) { const GAS f32x4* xr = (const GAS f32x4*)(rn >= S_LAT ? xc + (size_t)(rn - S_LAT) * DM : xl + (size_t)rn * DM) + lane;
#pragma unroll
            for (int j = 0; j < 4; ++j) vn[j] = xr[64 * j]; }
        float s = 0.f;
#pragma unroll
        for (int j = 0; j < 4; ++j) s += (v[j].x * v[j].x + v[j].y * v[j].y) + (v[j].z * v[j].z + v[j].w * v[j].w);
        const float rstd = __builtin_amdgcn_rsqf(wave_sum(s) * (1.0f / DM) + EPS);
        GAS v2u* o8 = (GAS v2u*)(H + (size_t)r * DM) + lane;
        if (r >= S_LAT) {
#pragma unroll
            for (int j = 0; j < 4; ++j) { const f32x4 scv = *(const f32x4*)(mc + 1024 + 4 * lane + 256 * j), shv = *(const f32x4*)(mc + 4 * lane + 256 * j);
                const f32x4 h = v[j] * rstd * (scv + 1.0f) + shv; v2u w; w.x = pk2(h.x, h.y); w.y = pk2(h.z, h.w); o8[64 * j] = w; }
        } else {
#pragma unroll
            for (int j = 0; j < 4; ++j) { const f32x4 h = v[j] * rstd * scl[j] + shl[j]; v2u w; w.x = pk2(h.x, h.y); w.y = pk2(h.z, h.w); o8[64 * j] = w; }
        }
#pragma unroll
        for (int j = 0; j < 4; ++j) v[j] = vn[j];
    }
}
__device__ __forceinline__ void phase_norm_route(KA a, LAS unsigned char* lds, int tid, int lane, int wave, int G, int bid) {
    const int l = 1;
    const float* vec = (const float*)(a->ws + WS_VEC);
    const float* ml = vec + VO_MOD + (l * 2 + 0) * 6144 + 3072;
    unsigned char* H8 = (unsigned char*)(a->ws + WS_H2B);
    LAS float* rt = (LAS float*)lds;
    volatile LAS unsigned* lcnt = (volatile LAS unsigned*)(lds + 32768);
    for (int i = tid; i < 8192; i += NTHR) rt[i] = a->in[I_ROUTER][i];
    if (tid < 16) lcnt[tid] = 0u;
    __syncthreads();
    int* tokinfo = (int*)(a->ws + WS_TOK);
    unsigned* cnt = (unsigned*)(a->ws + WS_CTL) + CW_MOECNT;
    const int gw = bid * NWAVES + wave, NGW = G * NWAVES;
    unsigned keep = 0u, pk0 = 0u; int itn = 0;
    for (int r = gw; r < S_LAT; r += NGW) {
        f32x4 h[4];
        norm_row<false>(a->out + (size_t)r * DM, ml + 1024, ml, nullptr, lane, h);
#pragma unroll
        for (int j = 0; j < 4; ++j) ((GAS unsigned*)(H8 + (size_t)r * DM))[lane + 64 * j] = pk4_fp8(h[j].x * F8_ASCALE, h[j].y * F8_ASCALE, h[j].z * F8_ASCALE, h[j].w * F8_ASCALE);
        float lg[8];
#pragma unroll
        for (int e = 0; e < 8; ++e) lg[e] = 0.f;
#pragma unroll
        for (int j = 0; j < 4; ++j)
#pragma unroll
            for (int i = 0; i < 4; ++i) { const int d = 4 * lane + 256 * j + i; const f32x4 r0 = *(const LAS f32x4*)(rt + d * 8), r1 = *(const LAS f32x4*)(rt + d * 8 + 4); const float hv = h[j][i];
                lg[0] += hv * r0.x; lg[1] += hv * r0.y; lg[2] += hv * r0.z; lg[3] += hv * r0.w; lg[4] += hv * r1.x; lg[5] += hv * r1.y; lg[6] += hv * r1.z; lg[7] += hv * r1.w; }
#pragma unroll
        for (int e = 0; e < 8; ++e) lg[e] = wave_sum(lg[e]);
        int i1 = 0; float v1 = lg[0];
#pragma unroll
        for (int e = 1; e < 8; ++e) if (lg[e] > v1) { v1 = lg[e]; i1 = e; }
        int i2 = -1; float v2 = -INFINITY;
#pragma unroll
        for (int e = 0; e < 8; ++e) if (e != i1 && lg[e] > v2) { v2 = lg[e]; i2 = e; }
        const float w1 = 1.0f / (1.0f + __expf(v2 - v1)), w2 = 1.0f - w1;
        if (lane == 0) {
            const unsigned r1 = __hip_atomic_fetch_add((LAS unsigned*)lcnt + i1, 1u, __ATOMIC_RELAXED, __HIP_MEMORY_SCOPE_WORKGROUP), r2 = __hip_atomic_fetch_add((LAS unsigned*)lcnt + i2, 1u, __ATOMIC_RELAXED, __HIP_MEMORY_SCOPE_WORKGROUP);
            int* ti = tokinfo + (size_t)r * 8;
            ti[0] = i1; ti[1] = i2; ti[4] = __builtin_bit_cast(int, w1); ti[5] = __builtin_bit_cast(int, w2);
            pk0 = (unsigned)i1 | ((unsigned)i2 << 3) | (r1 << 6) | (r2 << 19);
        }
        const unsigned pku = (unsigned)__builtin_amdgcn_readfirstlane((int)pk0);
        if (lane == itn) keep = pku;
        ++itn;
    }
    __syncthreads();
    if (tid < 8) lcnt[8 + tid] = __hip_atomic_fetch_add(cnt + 64 * tid, lcnt[tid], RLX_AGENT);
    __syncthreads();
    { const int r = gw + lane * NGW; if (lane < itn && r < S_LAT) { int* ti = tokinfo + (size_t)r * 8; const unsigned e1 = keep & 7u, e2 = (keep >> 3) & 7u; ti[2] = (int)(((keep >> 6) & 0x1fffu) + lcnt[8 + e1]); ti[3] = (int)((keep >> 19) + lcnt[8 + e2]); } }
}

__device__ __forceinline__ void qk_prep(KA a, int l, int first_thread, int nthreads) {
    bf16* PROJ = (bf16*)(a->ws + WS_PROJ);
    const float* rope = (const float*)(a->ws + WS_VEC) + VO_ROPE;
    for (int i = first_thread; i < R_ALL * 10; i += nthreads) {
        const int row = i / 10, hh = i % 10; const bool isq = hh < 8;
        bf16* p = PROJ + (size_t)row * INW + (isq ? hh * 64 : COL_AK + (hh - 8) * 64);
        const float* gain = (isq ? a->in[I_QG] : a->in[I_KG]) + l * 64;
        float x[64]; float ss = 0.f;
#pragma unroll
        for (int c = 0; c < 8; ++c) { const v4u w = *(const GAS v4u*)(p + 8 * c); unpack8(w, x + 8 * c); }
#pragma unroll
        for (int d = 0; d < 64; ++d) ss += x[d] * x[d];
        const float rstd = __builtin_amdgcn_rsqf(ss * (1.0f / 64.0f) + EPS);
        const f32x4* g4 = (const f32x4*)gain;
#pragma unroll
        for (int c = 0; c < 16; ++c) { const f32x4 gv = g4[c]; x[4 * c] *= rstd * gv.x; x[4 * c + 1] *= rstd * gv.y; x[4 * c + 2] *= rstd * gv.z; x[4 * c + 3] *= rstd * gv.w; }
        if (row < S_LAT) {
            const int gr = row >> 6, gc = row & 63;
            const f32x4* cr = (const f32x4*)(rope + gr * 16); const f32x4* sr = (const f32x4*)(rope + 4096 + gr * 16); const f32x4* cc = (const f32x4*)(rope + 8192 + gc * 16); const f32x4* sc = (const f32x4*)(rope + 8192 + 1024 + gc * 16);
#pragma unroll
            for (int j4 = 0; j4 < 4; ++j4) { const f32x4 cv = cr[j4], sv = sr[j4];
#pragma unroll
                for (int i = 0; i < 4; ++i) { const int j = 4 * j4 + i; const float x1 = x[j], x2 = x[16 + j]; x[j] = x1 * cv[i] - x2 * sv[i]; x[16 + j] = x1 * sv[i] + x2 * cv[i]; } }
#pragma unroll
            for (int j4 = 0; j4 < 4; ++j4) { const f32x4 cv = cc[j4], sv = sc[j4];
#pragma unroll
                for (int i = 0; i < 4; ++i) { const int j = 4 * j4 + i; const float x1 = x[32 + j], x2 = x[48 + j]; x[32 + j] = x1 * cv[i] - x2 * sv[i]; x[48 + j] = x1 * sv[i] + x2 * cv[i]; } }
        }
        const float qs = isq ? 0.125f * 1.4426950408889634f : 1.0f;
#pragma unroll
        for (int c = 0; c < 8; ++c) { v4u w; w.x = pk2(x[8 * c] * qs, x[8 * c + 1] * qs); w.y = pk2(x[8 * c + 2] * qs, x[8 * c + 3] * qs); w.z = pk2(x[8 * c + 4] * qs, x[8 * c + 5] * qs); w.w = pk2(x[8 * c + 6] * qs, x[8 * c + 7] * qs);
            *(GAS v4u*)(p + 8 * c) = w; }
    }
}
__device__ __forceinline__ void gmlp_unit(KA a, int l, int chunk, int g, LAS unsigned char* lds, int tid, int lane, int wave) {
    const bf16* PROJ = (const bf16*)(a->ws + WS_PROJ); bf16* MIX = (bf16*)(a->ws + WS_MIX);
    const int row0 = (chunk < 128) ? chunk * 128 : S_LAT + (chunk - 128) * 128;
    LAS float* vn = (LAS float*)lds;
    { const int pos = tid >> 2, part = tid & 3;
      const bf16* p = PROJ + (size_t)(row0 + pos) * INW + COL_GV + g * 64 + part * 16;
      float x[16]; unpack8(*(const GAS v4u*)p, x); unpack8(*(const GAS v4u*)(p + 8), x + 8);
      float ss = 0.f;
#pragma unroll
      for (int d = 0; d < 16; ++d) { x[d] = gelu1(x[d]); ss += x[d] * x[d]; }
      ss += sx<1>(ss); ss += sx<2>(ss);
      const float rstd = __builtin_amdgcn_rsqf(ss * (1.0f / 64.0f) + EPS);
      const float* gn = a->in[I_GNG] + l * 256 + g * 64 + part * 16;
#pragma unroll
      for (int d = 0; d < 16; ++d) vn[pos * 64 + part * 16 + d] = x[d] * rstd * gn[d]; }
    __syncthreads();
    const int c = lane, t0 = wave * 16;
    const float* W = a->in[I_GWS] + ((size_t)(l * 4 + g) * 128 + t0) * 128;
    float acc[16];
#pragma unroll
    for (int i = 0; i < 16; ++i) acc[i] = 0.f;
    for (int s = 0; s < 128; ++s) { const float v = vn[s * 64 + c];
#pragma unroll
        for (int i = 0; i < 16; ++i) acc[i] += W[i * 128 + s] * v; }
    const float* bs = a->in[I_GBS] + (l * 4 + g) * 128 + t0;
#pragma unroll
    for (int i = 0; i < 16; ++i) { const int row = row0 + t0 + i;
        const float u = gelu1(bflo((unsigned)PROJ[(size_t)row * INW + COL_GU + g * 64 + c]));
        MIX[(size_t)row * DM + MIX_GM + g * 64 + c] = (bf16)f2bf(u * (acc[i] + bs[i])); }
    __syncthreads();
}
__device__ __forceinline__ void hgrn_naive(KA a, int l, int dir, int head, LAS unsigned char* lds, int tid, int lane, int wave) {
    const bf16* PROJ = (const bf16*)(a->ws + WS_PROJ);
    float* HGO = (float*)(a->ws + WS_HGO) + (size_t)dir * R_ALL * 256;
    LAS float* Qs = (LAS float*)lds;
    LAS float* Fs = Qs + 4096; LAS float* Vs = Fs + 4096; LAS float* part = Vs + 4096;
    const int v = lane, kg = wave;
    float S[8];
#pragma unroll
    for (int i = 0; i < 8; ++i) S[i] = 0.f;
    const int tl = tid >> 3, c8 = tid & 7;
    float lb[8];
#pragma unroll
    for (int j = 0; j < 8; ++j) { float b = 0.f; if (l == 1) { const float p0 = a->in[I_HLB][dir * 512 + head * 64 + c8 * 8 + j], p1 = a->in[I_HLB][dir * 512 + 256 + head * 64 + c8 * 8 + j]; b = 1.0f / (1.0f + __expf(p0 - p1)); } lb[j] = b; }
    const int fcol = (dir == 0 ? COL_HFF : COL_HFB) + head * 64 + c8 * 8;
    for (int n0 = 0; n0 < R_ALL; n0 += 64) {
        { const int n = n0 + tl; int row;
          if (dir == 0) row = (n < C_CTX) ? S_LAT + n : n - C_CTX; else row = (n < C_CTX) ? S_LAT + (C_CTX - 1 - n) : (S_LAT - 1) - (n - C_CTX);
          const bf16* pr = PROJ + (size_t)row * INW;
          float q[8], f[8], vv[8];
          unpack8(*(const GAS v4u*)(pr + COL_HQ + head * 64 + c8 * 8), q); unpack8(*(const GAS v4u*)(pr + fcol), f); unpack8(*(const GAS v4u*)(pr + COL_HI + head * 64 + c8 * 8), vv);
#pragma unroll
          for (int j = 0; j < 8; ++j) { Qs[tl * 64 + c8 * 8 + j] = silu1(q[j]) * 0.125f; Fs[tl * 64 + c8 * 8 + j] = lb[j] + (1.0f - lb[j]) * sigm1(f[j]); Vs[tl * 64 + c8 * 8 + j] = vv[j]; } }
        __syncthreads();
        for (int t = 0; t < 64; ++t) {
            const float vt = Vs[t * 64 + v]; float po = 0.f;
#pragma unroll
            for (int i = 0; i < 8; ++i) { const float f = Fs[t * 64 + kg * 8 + i], q = Qs[t * 64 + kg * 8 + i]; S[i] = f * S[i] + (1.0f - f) * vt; po += S[i] * q; }
            part[((t & 1) * 8 + kg) * 64 + v] = po;
            __syncthreads();
            if (wave == 0) { float o = 0.f;
#pragma unroll
                for (int w8 = 0; w8 < 8; ++w8) o += part[((t & 1) * 8 + w8) * 64 + v];
                const int n = n0 + t; int row;
                if (dir == 0) row = (n < C_CTX) ? S_LAT + n : n - C_CTX; else row = (n < C_CTX) ? S_LAT + (C_CTX - 1 - n) : (S_LAT - 1) - (n - C_CTX);
                HGO[(size_t)row * 256 + head * 64 + v] = o; }
        }
        __syncthreads();
    }
}

typedef short bf16x8v __attribute__((ext_vector_type(8)));
constexpr int HST = 72;
__device__ __forceinline__ f32x4 mma16(const LAS bf16* MA, const LAS bf16* MBt, int k0, f32x4 c, int lane) {
    const bf16x8v av = *(const LAS bf16x8v*)(MA + (lane & 15) * HST + k0 + 8 * (lane >> 4));
    const bf16x8v bv = *(const LAS bf16x8v*)(MBt + (lane & 15) * HST + k0 + 8 * (lane >> 4));
    return __builtin_amdgcn_mfma_f32_16x16x32_bf16(av, bv, c, 0, 0, 0);
}
__device__ __forceinline__ int hg_base_row(int cpos) { return cpos < 256 ? 64 * cpos : S_LAT + 64 * (cpos - 256); }
__device__ __forceinline__ int hg_scan_idx(int dir, int cpos) { return dir == 0 ? (cpos < 256 ? 4 + cpos : cpos - 256) : (cpos < 256 ? 4 + (255 - cpos) : 3 - (cpos - 256)); }
__device__ __forceinline__ float hg_lb(KA a, int l, int dir, int head, int k) {
    if (l == 0) return 0.f;
    const float p0 = a->in[I_HLB][dir * 512 + head * 64 + k], p1 = a->in[I_HLB][dir * 512 + 256 + head * 64 + k];
    return 1.0f / (1.0f + __expf(p0 - p1));
}
__device__ __forceinline__ void hgrn_stepA(KA a, int l, int cpos, int head, LAS unsigned char* lds, int lane, int wave) {
    const bf16* PROJ = (const bf16*)(a->ws + WS_PROJ);
    const int dir = wave >> 2, I = wave & 3, base = hg_base_row(cpos), ci = hg_scan_idx(dir, cpos);
    LAS float* TOT = (LAS float*)lds;
    LAS bf16* KLT = (LAS bf16*)(lds + 2048) + dir * 64 * HST;
    LAS bf16* VT = (LAS bf16*)(lds + 2048 + 2 * 64 * HST * 2) + dir * 64 * HST;
    const float lb = hg_lb(a, l, dir, head, lane);
    const int fcol = (dir == 0 ? COL_HFF : COL_HFB) + head * 64 + lane, vcol = COL_HI + head * 64 + lane;
    float kk[16], cl[16]; float run = 0.f;
#pragma unroll
    for (int i = 0; i < 16; ++i) { const int n = 16 * I + i, row = base + (dir ? 63 - n : n);
        const float fl = bflo((unsigned)PROJ[(size_t)row * INW + fcol]);
        const unsigned short vb = PROJ[(size_t)row * INW + vcol];
        const float f = lb + (1.0f - lb) * sigm1(fl);
        run += __logf(f); cl[i] = run; kk[i] = 1.0f - f;
        VT[lane * HST + n] = vb; }
    TOT[(dir * 4 + I) * 64 + lane] = run;
    __syncthreads();
    float post = 0.f, all = 0.f;
#pragma unroll
    for (int J = 0; J < 4; ++J) { const float t = TOT[(dir * 4 + J) * 64 + lane]; all += t; if (J > I) post += t; }
#pragma unroll
    for (int i = 0; i < 16; ++i) KLT[lane * HST + 16 * I + i] = (bf16)f2bf(kk[i] * __expf(run - cl[i] + post));
    if (I == 0) ((float*)(a->ws + WS_HDG))[((size_t)(dir * 4 + head) * 260 + ci) * 64 + lane] = __expf(all);
    __syncthreads();
    float* LT = (float*)(a->ws + WS_HLT) + ((size_t)(dir * 4 + head) * 260 + ci) * 4096;
    float z0 = 0.f; asm volatile("" : "+v"(z0));
#pragma unroll
    for (int kb = 0; kb < 4; ++kb) { f32x4 acc = {z0, z0, z0, z0};
        acc = mma16(VT + 16 * I * HST, KLT + 16 * kb * HST, 0, acc, lane); acc = mma16(VT + 16 * I * HST, KLT + 16 * kb * HST, 32, acc, lane);
#pragma unroll
        for (int r = 0; r < 4; ++r) LT[(16 * I + 4 * (lane >> 4) + r) * 64 + 16 * kb + (lane & 15)] = acc[r]; }
    __syncthreads();
}
__device__ __forceinline__ void hgrn_stepB(KA a, int item, int tid) {
    const int dh = item >> 3, vb = item & 7, v = vb * 8 + (tid >> 6), k = tid & 63;
    const float* LT = (const float*)(a->ws + WS_HLT) + (size_t)dh * 260 * 4096 + v * 64 + k;
    const float* DG = (const float*)(a->ws + WS_HDG) + (size_t)dh * 260 * 64 + k;
    bf16* SP = (bf16*)(a->ws + WS_HSP) + (size_t)dh * 260 * 4096 + v * 64 + k;
    float S = 0.f;
#pragma unroll 1
    for (int c0 = 0; c0 < 260; c0 += 26) {
        float lt[26], dg[26];
#pragma unroll
        for (int j = 0; j < 26; ++j) { lt[j] = LT[(size_t)(c0 + j) * 4096]; dg[j] = DG[(c0 + j) * 64]; }
#pragma unroll
        for (int j = 0; j < 26; ++j) { SP[(size_t)(c0 + j) * 4096] = (bf16)f2bf(S); S = dg[j] * S + lt[j]; }
    }
}
__device__ __forceinline__ void hgrn_stepC(KA a, int l, int cpos, int head, LAS unsigned char* lds, int tid, int lane, int wave) {
    const bf16* PROJ = (const bf16*)(a->ws + WS_PROJ); bf16* MIX = (bf16*)(a->ws + WS_MIX);
    const int dir = wave >> 2, I = wave & 3, base = hg_base_row(cpos), ci = hg_scan_idx(dir, cpos);
    constexpr int MSZ = 64 * HST;
    LAS float* TOT = (LAS float*)lds;
    LAS bf16* img = (LAS bf16*)(lds + 2048);
    LAS bf16* QT = img + dir * MSZ;
    LAS bf16* QD = img + 2 * MSZ + dir * MSZ;
    LAS bf16* VT = img + 4 * MSZ + dir * MSZ;
    LAS bf16* ST = img + 6 * MSZ + dir * MSZ;
    LAS bf16* AS = img + 8 * MSZ + dir * MSZ + I * 16 * HST;
    LAS bf16* KT = img + 10 * MSZ + dir * (10 * 16 * HST);
    LAS float* OS = (LAS float*)(img + 10 * MSZ);
    const float lb = hg_lb(a, l, dir, head, lane);
    const int fcol = (dir == 0 ? COL_HFF : COL_HFB) + head * 64 + lane, qcol = COL_HQ + head * 64 + lane, vcol = COL_HI + head * 64 + lane;
    { const bf16* SP = (const bf16*)(a->ws + WS_HSP) + ((size_t)(dir * 4 + head) * 260 + ci) * 4096;
#pragma unroll
      for (int h2 = 0; h2 < 2; ++h2) { const int e = ((I * 2 + h2) * 64 + lane) * 8, vv = e >> 6, kk0 = e & 63;
          *(LAS v4u*)(ST + vv * HST + kk0) = *(const GAS v4u*)(SP + e); } }
    float kk[16], cl[16], qv[16]; float run = 0.f;
#pragma unroll
    for (int i = 0; i < 16; ++i) { const int n = 16 * I + i, row = base + (dir ? 63 - n : n);
        const float fl = bflo((unsigned)PROJ[(size_t)row * INW + fcol]), ql = bflo((unsigned)PROJ[(size_t)row * INW + qcol]);
        const unsigned short vb = PROJ[(size_t)row * INW + vcol];
        const float f = lb + (1.0f - lb) * sigm1(fl);
        run += __logf(f); cl[i] = run; kk[i] = 1.0f - f; qv[i] = silu1(ql) * 0.125f;
        VT[lane * HST + n] = vb; }
    TOT[(dir * 4 + I) * 64 + lane] = run;
    __syncthreads();
    float tj[4];
#pragma unroll
    for (int J = 0; J < 4; ++J) tj[J] = TOT[(dir * 4 + J) * 64 + lane];
    float pre = 0.f;
#pragma unroll
    for (int J = 0; J < 4; ++J) if (J < I) pre += tj[J];
    const float epre = __expf(pre); float kei[16];
#pragma unroll
    for (int i = 0; i < 16; ++i) { const float e = __expf(cl[i]); QT[(16 * I + i) * HST + lane] = (bf16)f2bf(qv[i] * e); QD[(16 * I + i) * HST + lane] = (bf16)f2bf(qv[i] * e * epre); kei[i] = kk[i] * fminf(__builtin_amdgcn_rcpf(e), 5.5e34f); }
    float eoff = 0.f;
#pragma unroll
    for (int I2 = 0; I2 < 4; ++I2) {
        if (I2 >= I) {
            if (I2 == I) eoff = 0.f; else if (I2 == I + 1) eoff = run; else eoff += tj[I2 - 1];
            LAS bf16* blk = KT + (I2 * (I2 + 1) / 2 + I) * 16 * HST;
            const float fo = __expf(eoff);
#pragma unroll
            for (int i = 0; i < 16; ++i) blk[i * HST + lane] = (bf16)f2bf(kei[i] * fo);
        }
    }
    __syncthreads();
    float z0 = 0.f; asm volatile("" : "+v"(z0));
    f32x4 sc[4];
#pragma unroll
    for (int J = 0; J < 4; ++J) { sc[J] = (f32x4){z0, z0, z0, z0};
        if (J <= I) { const LAS bf16* kb = KT + (I * (I + 1) / 2 + J) * 16 * HST;
            sc[J] = mma16(QT + 16 * I * HST, kb, 0, sc[J], lane); sc[J] = mma16(QT + 16 * I * HST, kb, 32, sc[J], lane);
            if (J == I) {
#pragma unroll
                for (int r = 0; r < 4; ++r) if ((lane & 15) > 4 * (lane >> 4) + r) sc[J][r] = z0; } } }
#pragma unroll
    for (int J = 0; J < 4; ++J)
#pragma unroll
        for (int r = 0; r < 4; ++r) AS[(4 * (lane >> 4) + r) * HST + 16 * J + (lane & 15)] = (bf16)f2bf(sc[J][r]);
    asm volatile("s_waitcnt lgkmcnt(0)" ::: "memory");
    f32x4 acc[4];
#pragma unroll
    for (int vb = 0; vb < 4; ++vb) { acc[vb] = (f32x4){z0, z0, z0, z0};
        acc[vb] = mma16(AS, VT + 16 * vb * HST, 0, acc[vb], lane); acc[vb] = mma16(AS, VT + 16 * vb * HST, 32, acc[vb], lane);
        acc[vb] = mma16(QD + 16 * I * HST, ST + 16 * vb * HST, 0, acc[vb], lane); acc[vb] = mma16(QD + 16 * I * HST, ST + 16 * vb * HST, 32, acc[vb], lane); }
    __syncthreads();
#pragma unroll
    for (int vb = 0; vb < 4; ++vb)
#pragma unroll
        for (int r = 0; r < 4; ++r) { const int n = 16 * I + 4 * (lane >> 4) + r, rl = dir ? 63 - n : n; OS[(dir * 64 + rl) * 68 + 16 * vb + (lane & 15)] = acc[vb][r]; }
    __syncthreads();
    { const int rl = tid >> 3, v8 = (tid & 7) * 8, row = base + rl;
      float o[8]; float ss = 0.f;
#pragma unroll
      for (int j = 0; j < 8; ++j) { o[j] = OS[rl * 68 + v8 + j] + OS[(64 + rl) * 68 + v8 + j]; ss += o[j] * o[j]; }
      ss += sx<1>(ss); ss += sx<2>(ss); ss += sx<4>(ss);
      const float rstd = __builtin_amdgcn_rsqf(ss * (1.0f / 64.0f) + EPS);
      float gt[8]; unpack8(*(const GAS v4u*)(PROJ + (size_t)row * INW + COL_HG + head * 64 + v8), gt);
      const float* gn = a->in[I_HGAIN] + l * 64 + v8;
      float y[8];
#pragma unroll
      for (int j = 0; j < 8; ++j) y[j] = o[j] * rstd * gn[j] * silu1(gt[j]);
      v4u w; w.x = pk2(y[0], y[1]); w.y = pk2(y[2], y[3]); w.z = pk2(y[4], y[5]); w.w = pk2(y[6], y[7]);
      *(GAS v4u*)(MIX + (size_t)row * DM + MIX_HG + head * 64 + v8) = w; }
    __syncthreads();
}

__device__ __forceinline__ void vt_item(KA a, int item, int lane) {
    const bf16* PROJ = (const bf16*)(a->ws + WS_PROJ); bf16* VTg = (bf16*)(a->ws + WS_VT);
    const int rb = item >> 1, hk = item & 1, row = rb * 64 + lane;
    const bf16* p = PROJ + (size_t)row * INW + COL_AV + hk * 64;
    unsigned w[32];
#pragma unroll
    for (int c = 0; c < 8; ++c) { const v4u t = *(const GAS v4u*)(p + 8 * c); w[4 * c] = t.x; w[4 * c + 1] = t.y; w[4 * c + 2] = t.z; w[4 * c + 3] = t.w; }
    bf16* o = VTg + (size_t)hk * 64 * R_ALL + row;
#pragma unroll
    for (int d2 = 0; d2 < 32; ++d2) { o[(size_t)(2 * d2) * R_ALL] = (bf16)(w[d2] & 0xffffu); o[(size_t)(2 * d2 + 1) * R_ALL] = (bf16)(w[d2] >> 16); }
}
__device__ __forceinline__ void attn_unit(KA a, int l, int u, LAS unsigned char* lds, int tid, int lane, int wave) {
    asm volatile("" : "+v"(tid), "+v"(lane));
    const bf16* PROJ = (const bf16*)(a->ws + WS_PROJ); const bf16* VTg = (const bf16*)(a->ws + WS_VT); bf16* MIX = (bf16*)(a->ws + WS_MIX);
    const bool isctx = u >= 256; const int uu = isctx ? u - 256 : u; const int n = uu >> 1, hk = uu & 1;
    const int qh = hk * 4 + (wave >> 1), half = wave & 1;
    const int qbase = (isctx ? S_LAT : 0) + n * 128 + half * 64, qpos0 = n * 128 + half * 64;
    const int c = lane & 15, g = lane >> 4;
    LAS bf16* Kt = (LAS bf16*)lds; LAS bf16* Vt = Kt + 64 * HST; LAS bf16* Qw = Vt + 64 * HST + wave * 64 * HST;
#pragma unroll
    for (int j = 0; j < 8; ++j) { const int qr = 8 * j + (lane >> 3), qc = (lane & 7) * 8;
        *(LAS v4u*)(Qw + qr * HST + qc) = *(const GAS v4u*)(PROJ + (size_t)(qbase + qr) * INW + qh * 64 + qc); }
    float z0 = 0.f; asm volatile("" : "+v"(z0));
    f32x4 o[4][4]; float ls[4];
    float gq = 0.f, gk = 0.f;
#pragma unroll 8
    for (int d = 0; d < 64; ++d) { gq = fmaxf(gq, fabsf(a->in[I_QG][l * 64 + d])); gk = fmaxf(gk, fabsf(a->in[I_KG][l * 64 + d])); }
    const float nbnd = -(8.0f * 1.4426950408889634f) * gq * gk;
    const f32x4 nb4 = {nbnd, nbnd, nbnd, nbnd};
    const float sink = a->in[I_SINK][l * 8 + qh] * 1.4426950408889634f;
#pragma unroll
    for (int qt = 0; qt < 4; ++qt) { ls[qt] = (g == 0) ? __builtin_amdgcn_exp2f(sink + nbnd) : z0;
#pragma unroll
        for (int dt = 0; dt < 4; ++dt) o[qt][dt] = (f32x4){z0, z0, z0, z0}; }
    const int first = (!isctx && n == 0) ? 2 : 0, nwin = isctx ? 0 : ((n == 0 || n == 127) ? 4 : 6), nt = nwin + 4;
    const int lr = tid >> 3, lc = (tid & 7) * 8;
    v4u kreg, vreg;
#define ATT_LOADT(i) do { const bool ct_ = (i) >= nwin; const int kb_ = ct_ ? S_LAT + 64 * ((i) - nwin) : (n - 1) * 128 + 64 * (first + (i)); \
        kreg = *(const GAS v4u*)(PROJ + (size_t)(kb_ + lr) * INW + COL_AK + hk * 64 + lc); vreg = *(const GAS v4u*)(VTg + ((size_t)hk * 64 + lr) * R_ALL + kb_ + lc); } while (0)
    ATT_LOADT(0);
#pragma unroll 1
    for (int i = 0; i < nt; ++i) {
        __syncthreads();
        *(LAS v4u*)(Kt + lr * HST + lc) = kreg; *(LAS v4u*)(Vt + lr * HST + lc) = vreg;
        __syncthreads();
        if (i + 1 < nt) ATT_LOADT(i + 1);
        const bool win = i < nwin; const int kb = (n - 1) * 128 + 64 * (first + i);
        const int rel = kb - qpos0;
        const bool maskw = win && (rel == 128 || rel == -128);
        if (win && (rel >= 192 || rel <= -192)) continue;
        bf16x8v kf[4][2], vf[4][2];
#pragma unroll
        for (int kt = 0; kt < 4; ++kt)
#pragma unroll
            for (int ks = 0; ks < 2; ++ks) kf[kt][ks] = *(const LAS bf16x8v*)(Kt + (16 * kt + c) * HST + 32 * ks + 8 * g);
#pragma unroll
        for (int dt = 0; dt < 4; ++dt)
#pragma unroll
            for (int s2 = 0; s2 < 2; ++s2) { const v2u lo = *(const LAS v2u*)(Vt + (16 * dt + c) * HST + 32 * s2 + 4 * g), hi = *(const LAS v2u*)(Vt + (16 * dt + c) * HST + 32 * s2 + 16 + 4 * g);
                const v4u t = {lo.x, lo.y, hi.x, hi.y}; vf[dt][s2] = __builtin_bit_cast(bf16x8v, t); }
        f32x4 sA[4], sB[4];
#define ATT_SCORES(QT, S_) do { const bf16x8v q0_ = *(const LAS bf16x8v*)(Qw + (16 * (QT) + c) * HST + 8 * g), q1_ = *(const LAS bf16x8v*)(Qw + (16 * (QT) + c) * HST + 32 + 8 * g); \
            _Pragma("unroll") for (int kt = 0; kt < 4; ++kt) { S_[kt] = __builtin_amdgcn_mfma_f32_16x16x32_bf16(kf[kt][0], q0_, nb4, 0, 0, 0); S_[kt] = __builtin_amdgcn_mfma_f32_16x16x32_bf16(kf[kt][1], q1_, S_[kt], 0, 0, 0); } } while (0)
#define ATT_REST(QT, S_) do { \
            if (maskw) { const int dq = qpos0 + 16 * (QT) + c - kb - 4 * g; \
                _Pragma("unroll") for (int kt = 0; kt < 4; ++kt) _Pragma("unroll") for (int r = 0; r < 4; ++r) { const int dl = dq - 16 * kt - r; if (dl > 128 || dl < -128) S_[kt][r] = -INFINITY; } } \
            float ps = 0.f; \
            _Pragma("unroll") for (int kt = 0; kt < 4; ++kt) _Pragma("unroll") for (int r = 0; r < 4; ++r) { S_[kt][r] = __builtin_amdgcn_exp2f(S_[kt][r]); ps += S_[kt][r]; } \
            ls[QT] += ps; \
            bf16x8v pb[2]; \
            _Pragma("unroll") for (int s2 = 0; s2 < 2; ++s2) { const v4u t = {pk2(S_[2 * s2][0], S_[2 * s2][1]), pk2(S_[2 * s2][2], S_[2 * s2][3]), pk2(S_[2 * s2 + 1][0], S_[2 * s2 + 1][1]), pk2(S_[2 * s2 + 1][2], S_[2 * s2 + 1][3])}; pb[s2] = __builtin_bit_cast(bf16x8v, t); } \
            _Pragma("unroll") for (int dt = 0; dt < 4; ++dt) { o[QT][dt] = __builtin_amdgcn_mfma_f32_16x16x32_bf16(vf[dt][0], pb[0], o[QT][dt], 0, 0, 0); o[QT][dt] = __builtin_amdgcn_mfma_f32_16x16x32_bf16(vf[dt][1], pb[1], o[QT][dt], 0, 0, 0); } } while (0)
        ATT_SCORES(0, sA);
        ATT_SCORES(1, sB); ATT_REST(0, sA);
        ATT_SCORES(2, sA); ATT_REST(1, sB);
        ATT_SCORES(3, sB); ATT_REST(2, sA);
        ATT_REST(3, sB);
#undef ATT_SCORES
#undef ATT_REST
    }
#undef ATT_LOADT
    int c2 = lane & 15, g2 = lane >> 4; asm volatile("" : "+v"(c2), "+v"(g2));
#pragma unroll
    for (int qt = 0; qt < 4; ++qt) { float lt = ls[qt]; lt += sx<16>(lt); lt = sx32_add(lt); const float inv = 1.0f / lt;
        bf16* op = (bf16*)(a->ws + WS_MIX) + (size_t)(qbase + 16 * qt + c2) * DM + MIX_AT + qh * 64 + 4 * g2;
#pragma unroll
        for (int dt = 0; dt < 4; ++dt) { v2u w; w.x = pk2(o[qt][dt][0] * inv, o[qt][dt][1] * inv); w.y = pk2(o[qt][dt][2] * inv, o[qt][dt][3] * inv); *(GAS v2u*)(op + 16 * dt) = w; } }
}

constexpr int GST = 136;
__device__ __forceinline__ f32x4 mma16g(const LAS bf16* MA, const LAS bf16* MBt, int k0, f32x4 c, int lane) {
    const bf16x8v av = *(const LAS bf16x8v*)(MA + (lane & 15) * GST + k0 + 8 * (lane >> 4));
    const bf16x8v bv = *(const LAS bf16x8v*)(MBt + (lane & 15) * GST + k0 + 8 * (lane >> 4));
    return __builtin_amdgcn_mfma_f32_16x16x32_bf16(av, bv, c, 0, 0, 0);
}
__device__ __forceinline__ float gelu_as(float v) {
    const float av = fabsf(v), t = __builtin_amdgcn_rcpf(av * 0.2316418882f + 1.0f);
    float q = t * 0.5307027145f + (-0.7265760135f); q = q * t + 0.7107068705f; q = q * t + (-0.142248368f); q = q * t + 0.127414796f; q = q * t;
    const float e = __builtin_amdgcn_exp2f((v * v) * (-0.72134752044f)), mm = v * (q * e);
    return v < 0.f ? mm : v - mm;
}
__device__ __forceinline__ void gmlp_unit_mma(KA a, int l, int chunk, int g, LAS unsigned char* lds, int tid, int lane, int wave) {
    const bf16* PROJ = (const bf16*)(a->ws + WS_PROJ); bf16* MIX = (bf16*)(a->ws + WS_MIX);
    const int row0 = (chunk < 128) ? chunk * 128 : S_LAT + (chunk - 128) * 128;
    LAS bf16* WA = (LAS bf16*)lds;
    LAS bf16* VNT = WA + 128 * GST;
    LAS float* OUT = (LAS float*)(VNT + 64 * GST);
    const int pos = tid >> 2, part = tid & 3;
    {
      const float* W = a->in[I_GWS] + ((size_t)(l * 4 + g) * 128 + pos) * 128 + part * 32;
#pragma unroll
      for (int j = 0; j < 4; ++j) { const f32x4 w0 = *(const GAS f32x4*)(W + 8 * j), w1 = *(const GAS f32x4*)(W + 8 * j + 4);
          v4u o; o.x = pk2(w0.x, w0.y); o.y = pk2(w0.z, w0.w); o.z = pk2(w1.x, w1.y); o.w = pk2(w1.z, w1.w);
          *(LAS v4u*)(WA + pos * GST + part * 32 + 8 * j) = o; } }
    { const bf16* p = PROJ + (size_t)(row0 + pos) * INW + COL_GV + g * 64 + part * 16;
      float x[16]; unpack8(*(const GAS v4u*)p, x); unpack8(*(const GAS v4u*)(p + 8), x + 8);
      float ss = 0.f;
#pragma unroll
      for (int d = 0; d < 16; ++d) { x[d] = gelu_as(x[d]); ss += x[d] * x[d]; }
      ss += sx<1>(ss); ss += sx<2>(ss);
      const float rstd = __builtin_amdgcn_rsqf(ss * (1.0f / 64.0f) + EPS);
      const float* gn = a->in[I_GNG] + l * 256 + g * 64 + part * 16;
#pragma unroll
      for (int d = 0; d < 16; ++d) VNT[(part * 16 + d) * GST + pos] = (bf16)f2bf(x[d] * rstd * gn[d]); }
    __syncthreads();
    float z0 = 0.f; asm volatile("" : "+v"(z0));
#pragma unroll
    for (int cb = 0; cb < 4; ++cb) { f32x4 acc = {z0, z0, z0, z0};
#pragma unroll
        for (int ks = 0; ks < 4; ++ks) acc = mma16g(WA + 16 * wave * GST, VNT + 16 * cb * GST, 32 * ks, acc, lane);
#pragma unroll
        for (int r = 0; r < 4; ++r) OUT[(16 * wave + 4 * (lane >> 4) + r) * 68 + 16 * cb + (lane & 15)] = acc[r]; }
    __syncthreads();
    { const int row = row0 + pos; const float bsv = a->in[I_GBS][(l * 4 + g) * 128 + pos];
      const bf16* pu = PROJ + (size_t)row * INW + COL_GU + g * 64 + part * 16;
      float u[16]; unpack8(*(const GAS v4u*)pu, u); unpack8(*(const GAS v4u*)(pu + 8), u + 8);
      float y[16];
#pragma unroll
      for (int d = 0; d < 16; ++d) y[d] = gelu_as(u[d]) * (OUT[pos * 68 + part * 16 + d] + bsv);
      bf16* po = MIX + (size_t)row * DM + MIX_GM + g * 64 + part * 16;
      v4u w; w.x = pk2(y[0], y[1]); w.y = pk2(y[2], y[3]); w.z = pk2(y[4], y[5]); w.w = pk2(y[6], y[7]); *(GAS v4u*)po = w;
      w.x = pk2(y[8], y[9]); w.y = pk2(y[10], y[11]); w.z = pk2(y[12], y[13]); w.w = pk2(y[14], y[15]); *(GAS v4u*)(po + 8) = w; }
    __syncthreads();
}
__device__ __forceinline__ void attn_naive(KA a, int l, int nrows, int lane, int wave, int G, int bid) {
    const bf16* PROJ = (const bf16*)(a->ws + WS_PROJ); bf16* MIX = (bf16*)(a->ws + WS_MIX);
    const int gw = bid * NWAVES + wave, NGW = G * NWAVES;
    for (int pair = gw; pair < nrows * 2; pair += NGW) {
        const int row = pair >> 1, hk = pair & 1; const bool isctx = row >= S_LAT;
        float q[4], o[4], m[4], ls[4];
#pragma unroll
        for (int g = 0; g < 4; ++g) { q[g] = bflo((unsigned)PROJ[(size_t)row * INW + (hk * 4 + g) * 64 + lane]); o[g] = 0.f; ls[g] = 1.0f; m[g] = a->in[I_SINK][l * 8 + hk * 4 + g] * 1.4426950408889634f; }
        int j0 = 0, j1 = -1;
        if (!isctx) { j0 = row - 128 < 0 ? 0 : row - 128; j1 = row + 128 > S_LAT - 1 ? S_LAT - 1 : row + 128; }
        const int nwin = j1 - j0 + 1;
        const int nk = nwin + C_CTX;
#pragma unroll 4
        for (int t = 0; t < nk; ++t) {
            const int krow = (t < nwin) ? j0 + t : S_LAT + (t - nwin);
            const float k = bflo((unsigned)PROJ[(size_t)krow * INW + COL_AK + hk * 64 + lane]);
            const float v = bflo((unsigned)PROJ[(size_t)krow * INW + COL_AV + hk * 64 + lane]);
#pragma unroll
            for (int g = 0; g < 4; ++g) { const float s = wave_sum(q[g] * k); const float mn = fmaxf(m[g], s);
                const float c = __builtin_amdgcn_exp2f(m[g] - mn), p = __builtin_amdgcn_exp2f(s - mn);
                ls[g] = ls[g] * c + p; o[g] = o[g] * c + p * v; m[g] = mn; }
        }
#pragma unroll
        for (int g = 0; g < 4; ++g) MIX[(size_t)row * DM + MIX_AT + (hk * 4 + g) * 64 + lane] = (bf16)f2bf(o[g] / ls[g]);
    }
}
__device__ __forceinline__ void hgrn_combine(KA a, int l, int nrows, int lane, int wave, int G, int bid) {
    const bf16* PROJ = (const bf16*)(a->ws + WS_PROJ); bf16* MIX = (bf16*)(a->ws + WS_MIX);
    const float* O0 = (const float*)(a->ws + WS_HGO); const float* O1 = O0 + (size_t)R_ALL * 256;
    const f32x4 gn = *(const f32x4*)(a->in[I_HGAIN] + l * 64 + (lane & 15) * 4);
    const int gw = bid * NWAVES + wave, NGW = G * NWAVES;
    for (int r = gw; r < nrows; r += NGW) {
        const f32x4 o = *(const GAS f32x4*)(O0 + (size_t)r * 256 + 4 * lane) + *(const GAS f32x4*)(O1 + (size_t)r * 256 + 4 * lane);
        float ss = (o.x * o.x + o.y * o.y) + (o.z * o.z + o.w * o.w);
        ss += sx<1>(ss); ss += sx<2>(ss); ss += sx<4>(ss); ss += sx<8>(ss);
        const float rstd = __builtin_amdgcn_rsqf(ss * (1.0f / 64.0f) + EPS);
        const v2u gw2 = *(const GAS v2u*)(PROJ + (size_t)r * INW + COL_HG + 4 * lane);
        const float g0 = bflo(gw2.x), g1 = bfhi(gw2.x), g2 = bflo(gw2.y), g3 = bfhi(gw2.y);
        v2u w; w.x = pk2(o.x * rstd * gn.x * silu1(g0), o.y * rstd * gn.y * silu1(g1)); w.y = pk2(o.z * rstd * gn.z * silu1(g2), o.w * rstd * gn.w * silu1(g3));
        *(GAS v2u*)(MIX + (size_t)r * DM + MIX_HG + 4 * lane) = w;
    }
}
__device__ __forceinline__ void moe_gather(KA a, LAS unsigned char* lds, int tid, int lane, int wave, int G, int bid) {
    LAS int* sb = (LAS int*)lds;
    const unsigned* cnt = (const unsigned*)(a->ws + WS_CTL) + CW_MOECNT;
    int* mi = (int*)(a->ws + WS_VEC) + VO_MOE;
    if (tid < 8) sb[16 + tid] = (int)__hip_atomic_load(cnt + 64 * tid, RLX_AGENT);
    __syncthreads();
    if (tid == 0) { int b = 0;
#pragma unroll
        for (int e = 0; e < 8; ++e) { sb[e] = b; b += ((sb[16 + e] + 255) >> 8) << 8; }
        sb[8] = b; }
    __syncthreads();
    if (bid == 0) {
        if (tid == 0) mi[0] = sb[8] >> 8;
        if (tid < 8) mi[160 + tid] = sb[tid + 1] >> 8;
        for (int t = tid; t < (sb[8] >> 8); t += NTHR) { int e = 0;
#pragma unroll
            for (int j = 1; j < 8; ++j) e += (t >= (sb[j] >> 8)) ? 1 : 0;
            mi[16 + t] = e; } }
    const unsigned char* H8 = (const unsigned char*)(a->ws + WS_H2B); unsigned char* AS = (unsigned char*)(a->ws + WS_AS);
    const int* tokinfo = (const int*)(a->ws + WS_TOK); int* tokslot = (int*)(a->ws + WS_TOK) + S_LAT * 8;
    const int gw = bid * NWAVES + wave, NGW = G * NWAVES;
    for (int t = gw; t < S_LAT; t += NGW) {
        const int* ti = tokinfo + (size_t)t * 8;
        const int e1 = ti[0], e2 = ti[1], r1 = ti[2], r2 = ti[3];
        const int s1 = sb[e1] + r1, s2 = sb[e2] + r2;
        const v4u x0 = ((const GAS v4u*)(H8 + (size_t)t * DM))[lane];
        ((GAS v4u*)(AS + (size_t)s1 * DM))[lane] = x0; ((GAS v4u*)(AS + (size_t)s2 * DM))[lane] = x0;
        if (lane == 0) { int* ts = tokslot + (size_t)t * 4; ts[0] = s1; ts[1] = s2; ts[2] = ti[4]; ts[3] = ti[5]; }
    }
    { const f32x4 z4 = {0.f, 0.f, 0.f, 0.f}; for (int i = bid * NTHR + tid; i < 8 * 256 * DM / 4; i += G * NTHR) ((GAS f32x4*)(a->ws + WS_YF))[i] = z4; }
    for (int e = 0; e < 8; ++e) { const int c = sb[16 + e], pe = (c + 255) & ~255, b = sb[e];
        for (int j = c + gw; j < pe; j += NGW) { const v4u z = {0u, 0u, 0u, 0u}; ((GAS v4u*)(AS + (size_t)(b + j) * DM))[lane] = z; } }
}
__device__ __forceinline__ void moe_combine(KA a, int lane, int wave, int G, int bid) {
    const float* gf = (const float*)(a->ws + WS_VEC) + VO_MOD + (1 * 2 + 0) * 6144 + 5 * 1024;
    const bf16* Y = (const bf16*)(a->ws + WS_Y); const int* tokslot = (const int*)(a->ws + WS_TOK) + S_LAT * 8;
    const int gw = bid * NWAVES + wave, NGW = G * NWAVES;
    for (int t = gw; t < S_LAT; t += NGW) {
        const int* ts = tokslot + (size_t)t * 4; const int s1 = ts[0], s2 = ts[1]; const float w1 = __builtin_bit_cast(float, ts[2]), w2 = __builtin_bit_cast(float, ts[3]);
        GAS f32x4* xr = (GAS f32x4*)(a->out + (size_t)t * DM) + lane;
        const float* YF = (const float*)(a->ws + WS_YF);
#pragma unroll
        for (int j = 0; j < 4; ++j) { const f32x4 g = *(const f32x4*)(gf + 4 * lane + 256 * j); f32x4 x = xr[64 * j]; f32x4 p, q;
            if (s1 < 32768) { const v2u t = ((const GAS v2u*)(Y + (size_t)s1 * DM) + lane)[64 * j]; p = (f32x4){bflo(t.x), bfhi(t.x), bflo(t.y), bfhi(t.y)}; } else p = ((const GAS f32x4*)(YF + (size_t)(s1 - 32768) * DM) + lane)[64 * j];
            if (s2 < 32768) { const v2u t = ((const GAS v2u*)(Y + (size_t)s2 * DM) + lane)[64 * j]; q = (f32x4){bflo(t.x), bfhi(t.x), bflo(t.y), bfhi(t.y)}; } else q = ((const GAS f32x4*)(YF + (size_t)(s2 - 32768) * DM) + lane)[64 * j];
            x = x + g * (p * w1 + q * w2);
            xr[64 * j] = x; }
    }
}

#define IN(k) (lo <= (k) && (k) < hi)
#define GRIDBAR() do { XcdBarrier b2_; b2_.bar = (unsigned*)(KARGS()->ws + WS_CTL) + CW_BAR; b2_.x = xb_xcc_id(); b2_.st = (volatile LAS unsigned*)(lds + MISC_OFF) + 8; xcd_barrier(b2_, wv0 * 64 + (int)__builtin_amdgcn_mbcnt_hi(~0u, __builtin_amdgcn_mbcnt_lo(~0u, 0u))); } while (0)
#define SEAM(k) do { if (IN(k) && IN((k) + 1)) GRIDBAR(); } while (0)
#define PHASE_ROOTS() KA a = KARGS(); unsigned char* ws = a->ws; const float* vec = (const float*)(ws + WS_VEC); (void)vec; int bid = blockIdx.x, G = gridDim.x; asm volatile("" : "+s"(bid), "+s"(G)); int tid = wv0 * 64 + (int)__builtin_amdgcn_mbcnt_hi(~0u, __builtin_amdgcn_mbcnt_lo(~0u, 0u)); asm volatile("" : "+v"(tid)); const int lane = tid & 63, wave = __builtin_amdgcn_readfirstlane(tid >> 6); (void)lane; (void)wave

template <int l> __device__ __forceinline__ void layer_body(const int lo, const int hi, LAS unsigned char* lds, const int wv0) {
        const int pb = 1 + 11 * l;
        if (IN(pb + 0)) { PHASE_ROOTS(); phase_norm(a, l, 0, R_ALL, (bf16*)(ws + WS_H), lane, wave, G, bid); SEAM(pb + 0); }
        if (IN(pb + 1)) {
            PHASE_ROOTS();
            pg8::Gemm g{(const pg8::bf16_t*)(ws + WS_H), (const pg8::bf16_t*)(ws + WS_WIN) + (size_t)l * INW * DM, R_ALL, INW, DM, 0, DM};
            pg8::StaticOrder S; S.init(R_ALL, INW, G, bid);
            pg8::EpiBf16<0> E{(pg8::bf16_t*)(ws + WS_PROJ), INW, nullptr, 0, 0, 1.f};
            pg8::gemm_phase<pg8::EpiBf16<0>, pg8::StaticOrder, true, true>(lds, g, S, E, tid);
            moe_conv_range(a, l == 0 ? MOE_SL0 : MOE_SL2, l == 0 ? MOE_SL1 : MOE_SL3, 650 - 2 * 256, lds, lane, wave, G, bid);
            SEAM(pb + 1);
        }
        if (IN(pb + 2)) {
            PHASE_ROOTS();
            qk_prep(a, l, bid * NTHR + tid, G * NTHR);
            for (int it = bid * NWAVES + wave; it < 520; it += G * NWAVES) vt_item(a, it, lane);
            for (int it = bid; it < 1040; it += G) hgrn_stepA(a, l, it >> 2, it & 3, lds, lane, wave);
            { __syncthreads(); moe_conv_range(a, l == 0 ? MOE_SL3 : MOE_SL7, l == 0 ? MOE_SL4 : MOE_DEFER, 1040 - 4 * 256, lds, lane, wave, G, bid); }
            SEAM(pb + 2);
        }
        if (IN(pb + 3)) {
            PHASE_ROOTS();
            if (bid < 64) hgrn_stepB(a, bid, tid);
            {
                const int nu = (l == 0) ? 260 : 256, ng = (l == 0) ? 520 : 512;
                unsigned* qctr = (unsigned*)(ws + WS_CTL) + CW_QUEUE + 64 * l;
                volatile LAS unsigned* qslot = (volatile LAS unsigned*)(lds + MISC_OFF) + 16;
                for (;;) {
                    __syncthreads();
                    if (tid == 0) qslot[0] = __hip_atomic_fetch_add(qctr, 1u, RLX_AGENT);
                    __syncthreads();
                    const int it = __builtin_amdgcn_readfirstlane((int)qslot[0]);
                    if (it >= nu + ng) break;
                    if (it < nu) attn_unit(a, l, it, lds, tid, lane, wave);
                    else gmlp_unit_mma(a, l, (it - nu) >> 2, (it - nu) & 3, lds, tid, lane, wave);
                }
            }
            SEAM(pb + 3);
        }
        if (IN(pb + 4)) {
            PHASE_ROOTS();
            const int nit = (l == 0) ? 1040 : 1024;
            for (int it = bid; it < nit; it += G) hgrn_stepC(a, l, it >> 2, it & 3, lds, tid, lane, wave);
            if (l == 0) { __syncthreads(); moe_conv_range(a, MOE_SL4, MOE_SL5, 1040 - 4 * 256, lds, lane, wave, G, bid); }
            SEAM(pb + 4);
        }
        if (IN(pb + 5)) {
            PHASE_ROOTS();
            const float* modl = vec + VO_MOD + (l * 2 + 0) * 6144; const float* modc = vec + VO_MOD + (l * 2 + 1) * 6144;
            const int M = S_LAT;
            pg8::Gemm g{(const pg8::bf16_t*)(ws + WS_MIX), (const pg8::bf16_t*)(ws + WS_WOUT) + (size_t)l * DM * DM, M, DM, DM, 0, DM};
            pg8::StaticOrder S; S.init(M, DM, G, bid);
            pg8::EpiResid E{(l == 0) ? a->in[I_X] : a->out, a->out, modl + 2048, a->in[I_CTX], (float*)(ws + WS_CTXR), modc + 2048, S_LAT / 256, DM};
            pg8::gemm_phase<pg8::EpiResid, pg8::StaticOrder, true, true>(lds, g, S, E, tid);
            if (l == 0) {
                pg8::Gemm g2{(const pg8::bf16_t*)(ws + WS_MIX), (const pg8::bf16_t*)(ws + WS_WOUT), R_ALL, DM, 256, 0, DM};
                pg8::SplitKOrder S2{S_LAT / 256, 4, 4, 256, 16, bid, nullptr};
                pg8::EpiAtomic E2{(float*)(ws + WS_CTXR), modc + 2048, S_LAT / 256, DM, 1.0f};
                pg8::gemm_phase<pg8::EpiAtomic, pg8::SplitKOrder, false, true>(lds, g2, S2, E2, tid);
                moe_conv_range(a, MOE_SL5, MOE_SL6, 16, lds, lane, wave, G, bid);
            }
            SEAM(pb + 5);
        }
        if (l == 0) {
            if (IN(pb + 6)) { PHASE_ROOTS(); phase_norm(a, l, 1, R_ALL, (bf16*)(ws + WS_H), lane, wave, G, bid); SEAM(pb + 6); }
            if (IN(pb + 7)) {
                PHASE_ROOTS();
                pg8::Gemm g{(const pg8::bf16_t*)(ws + WS_H), (const pg8::bf16_t*)(ws + WS_WGU), R_ALL, 2 * FFN, DM, 0, DM};
                pg8::StaticOrder S; S.init(R_ALL, 2 * FFN, G, bid);
                pg8::EpiSwiGLU E{(pg8::bf16_t*)(ws + WS_HID), FFN, 1.0f};
                pg8::gemm_phase<pg8::EpiSwiGLU, pg8::StaticOrder, true, true>(lds, g, S, E, tid);
                moe_conv_range(a, MOE_SL1, MOE_SL2, 1430 - 5 * 256, lds, lane, wave, G, bid);
                SEAM(pb + 7);
            }
            if (IN(pb + 8)) {
                PHASE_ROOTS();
                const float* modl = vec + VO_MOD + (l * 2 + 0) * 6144; const float* modc = vec + VO_MOD + (l * 2 + 1) * 6144;
                pg8::Gemm g{(const pg8::bf16_t*)(ws + WS_HID), (const pg8::bf16_t*)(ws + WS_WD), S_LAT, DM, FFN, 0, FFN};
                pg8::StaticOrder S; S.init(S_LAT, DM, G, bid);
                pg8::EpiResid E{a->out, a->out, modl + 5120, (const float*)(ws + WS_CTXR), (float*)(ws + WS_CTXR), modc + 5120, S_LAT / 256, DM};
                pg8::gemm_phase<pg8::EpiResid, pg8::StaticOrder, true, true>(lds, g, S, E, tid);
                {
                    pg8::Gemm g2{(const pg8::bf16_t*)(ws + WS_HID), (const pg8::bf16_t*)(ws + WS_WD), R_ALL, DM, 256, 0, FFN};
                    pg8::SplitKOrder S2{S_LAT / 256, 4, 11, 256, 44, bid, nullptr};
                    pg8::EpiAtomic E2{(float*)(ws + WS_CTXR), modc + 5120, S_LAT / 256, DM, 1.0f};
                    pg8::gemm_phase<pg8::EpiAtomic, pg8::SplitKOrder, false, true>(lds, g2, S2, E2, tid);
                    moe_conv_range(a, MOE_SL6, MOE_SL7, 44, lds, lane, wave, G, bid);
                }
                if (IN(pb + 8) && IN(pb + 11)) GRIDBAR();
            }
        } else {
            if (IN(pb + 6)) { PHASE_ROOTS(); phase_norm_route(a, lds, tid, lane, wave, G, bid); SEAM(pb + 6); }
            if (IN(pb + 7)) { PHASE_ROOTS(); moe_gather(a, lds, tid, lane, wave, G, bid); SEAM(pb + 7); }
            if (IN(pb + 8)) {
                PHASE_ROOTS();
                const int* mi = (const int*)(ws + WS_VEC) + VO_MOE; const int nt = __builtin_amdgcn_readfirstlane(mi[0]);
                pg8::Gemm g{(const pg8::bf16_t*)(ws + WS_AS), (const pg8::bf16_t*)(ws + WS_MGU), nt * 256, 2 * EXD, DM / 2, (size_t)2 * EXD * DM, DM / 2};
                pg8::MoeOrder S; S.init(nt * 256, 2 * EXD, G, bid); S.load_bases(mi + 160);
                pg8::EpiSwiGLU8 E{(unsigned char*)(ws + WS_HIDM), EXD, 1.0f / (F8_WSCALE * F8_ASCALE), F8_HSCALE};
                pg8::gemm_phase<pg8::EpiSwiGLU8, pg8::MoeOrder, true, true, true>(lds, g, S, E, tid);
                SEAM(pb + 8);
            }
            if (IN(pb + 9)) {
                PHASE_ROOTS();
                const int* mi = (const int*)(ws + WS_VEC) + VO_MOE; const int nt = __builtin_amdgcn_readfirstlane(mi[0]); const int nm = nt < 128 ? nt : 128;
                pg8::Gemm g{(const pg8::bf16_t*)(ws + WS_HIDM), (const pg8::bf16_t*)(ws + WS_MD), nm * 256, DM, EXD / 2, (size_t)DM * EXD, EXD / 2};
                pg8::MoeOrder S; S.init(nm * 256, DM, G, bid); S.load_bases(mi + 160);
                pg8::EpiScaleBf16 E{(pg8::bf16_t*)(ws + WS_Y), DM, 1.0f / (F8_WSCALE * F8_HSCALE)};
                pg8::gemm_phase<pg8::EpiScaleBf16, pg8::MoeOrder, true, true, true>(lds, g, S, E, tid);
                if (nt > 128) {
                    pg8::Gemm g2{(const pg8::bf16_t*)(ws + WS_HIDM), (const pg8::bf16_t*)(ws + WS_MD), nt * 256, DM, 256, (size_t)DM * EXD, EXD / 2};
                    pg8::SplitKOrder S2{128, 4, 7, 256, (nt - 128) * 28, bid, mi + 16};
                    pg8::EpiAtomic E2{(float*)(ws + WS_YF), nullptr, 128, DM, 1.0f / (F8_WSCALE * F8_HSCALE)};
                    pg8::gemm_phase<pg8::EpiAtomic, pg8::SplitKOrder, false, true, true>(lds, g2, S2, E2, tid);
                }
                SEAM(pb + 9);
            }
            if (IN(pb + 10)) { PHASE_ROOTS(); moe_combine(a, lane, wave, G, bid); }
        }
    }
__global__ void __launch_bounds__(NTHR, 2) fwd_kernel(Args a_unused) {
    extern __shared__ __attribute__((aligned(16))) unsigned char lds_raw[];
    LAS unsigned char* lds = (LAS unsigned char*)lds_raw;
    const int tid0 = threadIdx.x;
    const int wv0 = __builtin_amdgcn_readfirstlane(tid0 >> 6);
    for (int u = tid0; u < (LDS_BYTES - LDSCTL_OFF) / 4; u += NTHR) ((LAS unsigned*)(lds + LDSCTL_OFF))[u] = 0u;
    __syncthreads();
    const int lo = KARGS()->ph_lo, hi = KARGS()->ph_hi;
    const bool fusedl = (hi - lo) > 1;
    if (fusedl) (void)xcd_barrier_post((unsigned*)(KARGS()->ws + WS_CTL) + CW_BAR, (volatile LAS unsigned*)(lds + MISC_OFF) + 8);
    if (IN(0)) { PHASE_ROOTS(); p0_prologue(a, lds, tid, lane, wave, G, bid); SEAM(0); }

    layer_body<0>(lo, hi, lds, wv0);
    layer_body<1>(lo, hi, lds, wv0);
}

extern "C" void kernel_launch(void* const* d_in, const int* in_sizes, int n_in, void* d_out, int out_size, void* d_ws, size_t ws_size, hipStream_t stream) {
    static int grid = 0;
    if (grid == 0) {
        if (n_in != 23 || in_sizes[0] != S_LAT * DM || out_size != S_LAT * DM || ws_size < WS_END) { fprintf(stderr, "kernel_launch: unexpected shapes / workspace (n_in %d, ws %zu, need %zu)\n", n_in, ws_size, (size_t)WS_END); grid = -1; return; }
        int dev = 0, cus = 0;
        if (hipGetDevice(&dev) != hipSuccess || hipDeviceGetAttribute(&cus, hipDeviceAttributeMultiprocessorCount, dev) != hipSuccess) { grid = -1; return; }
        if (hipFuncSetAttribute((const void*)fwd_kernel, hipFuncAttributeMaxDynamicSharedMemorySize, LDS_BYTES) != hipSuccess) { grid = -1; return; }
        int per_cu = 0;
        (void)hipOccupancyMaxActiveBlocksPerMultiprocessor(&per_cu, (const void*)fwd_kernel, NTHR, LDS_BYTES);
        (void)hipGetLastError();
        grid = cus;
    }
    if (grid < 0) return;
    if (hipMemsetAsync((char*)d_ws + WS_CTL, 0, CTL_ZERO_BYTES, stream) != hipSuccess) return;
    Args a{};
    for (int i = 0; i < 23; ++i) a.in[i] = (const float*)d_in[i];
    a.out = (float*)d_out; a.ws = (unsigned char*)d_ws;
#if ONE_LAUNCH
    a.ph_lo = 0; a.ph_hi = NPH;
    hipLaunchKernelGGL(fwd_kernel, dim3(grid), dim3(NTHR), LDS_BYTES, stream, a);
#else
    for (int p = 0; p < NPH; ++p) {
        if (p == 10 || p == 11) continue;
        a.ph_lo = p; a.ph_hi = p + 1;
        hipLaunchKernelGGL(fwd_kernel, dim3(grid), dim3(NTHR), LDS_BYTES, stream, a);
    }
#endif
}
```

```cpp
#include <hip/hip_runtime.h>
#include <cstdio>
#include <cstdint>
#include <cmath>
#ifndef ONE_LAUNCH
#define ONE_LAUNCH 1
#endif
namespace pg8 {
#define PG8_LAS __attribute__((address_space(3)))
typedef unsigned short bf16_t;
typedef short bf16x8 __attribute__((ext_vector_type(8)));
typedef float f32x4 __attribute__((ext_vector_type(4)));
typedef unsigned u32x4 __attribute__((ext_vector_type(4)));
constexpr int BM = 256, BK = 64, HALF = 128, HTB = HALF * BK * 2  , STAGE_BYTES = 8 * HTB, NXCD = 8, WGM = 8;

__host__ __device__ __forceinline__ int lds_byte(int r, int c) { const int st = (r >> 4) * 2 + (c >> 5), rr = r & 15, cc = c & 31, ob = rr * 64 + cc * 2; return st * 1024 + (ob ^ (((ob >> 9) & 1) << 5)); }
__host__ __device__ __forceinline__ void stage_rc(int b, int& R, int& C) { const int st = b / 1024, sb = b % 1024, swz = sb ^ (((sb >> 9) & 1) << 5); R = (st >> 1) * 16 + swz / 64; C = (st & 1) * 32 + (swz % 64) / 2; }
__host__ __device__ __forceinline__ int perm32(int rho) { const int n = rho >> 4, i = rho & 15; return 8 * (i >> 2) + 4 * n + (i & 3); }

struct Unit { int pm, pn, eb, ko; };
struct Gemm { const bf16_t* A; const bf16_t* Bt; int M, N, K; size_t bstride; int ld; };

struct StaticOrder {
    int nM, nN, nwg, G, c;
    __host__ __device__ void init(int M, int N, int G_, int c_) { nM = M / BM; nN = N / BM; nwg = nM * nN; G = G_; c = c_; }
    __host__ __device__ bool next(int i, Unit& u) const {
        const long L = (long)i * G + c; if (L >= nwg) return false;
        int wgid = (int)L; { const int q = nwg / NXCD, r = nwg % NXCD, xcd = wgid % NXCD, off = wgid / NXCD; wgid = (xcd < r ? xcd * (q + 1) : r * (q + 1) + (xcd - r) * q) + off; }
        const int nig = WGM * nN, gid = wgid / nig, fm = gid * WGM, gsz = (nM - fm) < WGM ? (nM - fm) : WGM;
        u.pm = fm + ((wgid % nig) % gsz); u.pn = (wgid % nig) / gsz; u.eb = 0; u.ko = 0; return true;
    }
    __device__ __forceinline__ void a_ready(const Unit&) const {}
    __device__ __forceinline__ void done(const Unit&) const {}
};

__device__ __forceinline__ unsigned cvt_pk_bf16(float lo, float hi) { unsigned r; asm volatile("v_cvt_pk_bf16_f32 %0, %1, %2" : "=v"(r) : "v"(lo), "v"(hi)); return r; }
typedef float f32x2 __attribute__((ext_vector_type(2)));
__device__ __forceinline__ f32x2 gelu_pk(f32x2 v) {
    const f32x2 av = __builtin_elementwise_abs(v), d = av * 0.2316418882f + 1.0f;
    f32x2 t; t.x = __builtin_amdgcn_rcpf(d.x); t.y = __builtin_amdgcn_rcpf(d.y);
    f32x2 q = t * 0.5307027145f + (-0.7265760135f); q = q * t + 0.7107068705f; q = q * t + (-0.142248368f); q = q * t + 0.127414796f; q = q * t;
    const f32x2 s = (v * v) * (-0.72134752044f);
    f32x2 e; e.x = __builtin_amdgcn_exp2f(s.x); e.y = __builtin_amdgcn_exp2f(s.y);
    const f32x2 m = v * (q * e), r = v - m;
    f32x2 o; o.x = v.x < 0.f ? m.x : r.x; o.y = v.y < 0.f ? m.y : r.y; return o;
}

template <int ACT  > struct EpiBf16 {
    static constexpr bool PERM = true, AFTER_DRAIN = false; static_assert(ACT == 0 || ACT == 1, "EpiBf16: ACT is 0 (none) or 1 (gelu_pk)");
    bf16_t* O; int ldc; const float* bias; int split_cols; size_t split_stride; float scale0;
    __device__ __forceinline__ void operator()(const f32x4 (&acc)[2][2][4][2], const Unit& u, int wr, int wc, int fr, int fq) const {
        const int row0 = u.pm * BM + wr * 64 + fr; int colt = u.pn * BM; bf16_t* base = O;
        float sc = 1.f; if (split_cols) { const int t = colt / split_cols; base += (size_t)t * split_stride; colt -= t * split_cols; if (t == 0) sc = scale0; }
        const int col0 = colt + wc * 32 + 8 * fq, bcol0 = u.pn * BM + wc * 32 + 8 * fq;
        f32x4 bv[2][2];
#pragma unroll
        for (int bj = 0; bj < 2; ++bj)
#pragma unroll
            for (int n = 0; n < 2; ++n) bv[bj][n] = bias ? *(const f32x4*)(bias + bcol0 + bj * HALF + 4 * n) : (f32x4){0.f, 0.f, 0.f, 0.f};
#pragma unroll
        for (int ai = 0; ai < 2; ++ai)
#pragma unroll
            for (int m = 0; m < 4; ++m) { bf16_t* rowp = base + (size_t)(row0 + ai * HALF + m * 16) * ldc + col0;
#pragma unroll
                for (int bj = 0; bj < 2; ++bj) { f32x4 v0 = acc[ai][bj][m][0] + bv[bj][0], v1 = acc[ai][bj][m][1] + bv[bj][1];
                    if (ACT == 1) { f32x2 a = gelu_pk((f32x2){v0[0], v0[1]}), b = gelu_pk((f32x2){v0[2], v0[3]}), c = gelu_pk((f32x2){v1[0], v1[1]}), d = gelu_pk((f32x2){v1[2], v1[3]});
                        v0 = (f32x4){a.x, a.y, b.x, b.y}; v1 = (f32x4){c.x, c.y, d.x, d.y}; }
                    v0 = v0 * sc; v1 = v1 * sc; u32x4 w; w.x = cvt_pk_bf16(v0[0], v0[1]); w.y = cvt_pk_bf16(v0[2], v0[3]); w.z = cvt_pk_bf16(v1[0], v1[1]); w.w = cvt_pk_bf16(v1[2], v1[3]);
                    *(u32x4*)(rowp + bj * HALF) = w; } }
    }
};

__device__ __forceinline__ float silu_f(float x) { return x * __builtin_amdgcn_rcpf(1.0f + __builtin_amdgcn_exp2f(-1.4426950408889634f * x)); }
struct EpiResid {
    static constexpr bool PERM = false, AFTER_DRAIN = false;
    const float* base; float* out; const float* gate; const float* cbase; float* cout; const float* cgate; int mlat; int ldc;
    __device__ __forceinline__ void operator()(const f32x4 (&acc)[2][2][4][2], const Unit& u, int wr, int wc, int fr, int fq) const {
        const bool isc = u.pm >= mlat;
        const float* b = isc ? cbase : base; float* o = isc ? cout : out; const float* g = isc ? cgate : gate;
        const int row0 = (isc ? (u.pm - mlat) : u.pm) * BM + wr * 64 + fr, col0 = u.pn * BM + wc * 32 + 4 * fq;
        f32x4 gv[2][2];
#pragma unroll
        for (int bj = 0; bj < 2; ++bj)
#pragma unroll
            for (int n = 0; n < 2; ++n) gv[bj][n] = *(const f32x4*)(g + col0 + bj * HALF + n * 16);
#pragma unroll
        for (int ai = 0; ai < 2; ++ai)
#pragma unroll
            for (int m = 0; m < 4; ++m) { const size_t off = (size_t)(row0 + ai * HALF + m * 16) * ldc + col0;
#pragma unroll
                for (int bj = 0; bj < 2; ++bj)
#pragma unroll
                    for (int n = 0; n < 2; ++n) { const f32x4 bs = *(const f32x4*)(b + off + bj * HALF + n * 16); *(f32x4*)(o + off + bj * HALF + n * 16) = bs + gv[bj][n] * acc[ai][bj][m][n]; }
                if (m & 1) asm volatile("" ::: "memory"); }
    }
};
template <bool BFB> struct EpiResidB {
    static constexpr bool PERM = true, AFTER_DRAIN = false;
    const void* base; bf16_t* out; const float* gate; int ldc;
    __device__ __forceinline__ void operator()(const f32x4 (&acc)[2][2][4][2], const Unit& u, int wr, int wc, int fr, int fq) const {
        const int row0 = u.pm * BM + wr * 64 + fr, col0 = u.pn * BM + wc * 32 + 8 * fq;
        f32x4 gv[2][2];
#pragma unroll
        for (int bj = 0; bj < 2; ++bj)
#pragma unroll
            for (int n = 0; n < 2; ++n) gv[bj][n] = *(const f32x4*)(gate + col0 + bj * HALF + 4 * n);
#pragma unroll
        for (int ai = 0; ai < 2; ++ai)
#pragma unroll
            for (int m = 0; m < 4; ++m) { const size_t off = (size_t)(row0 + ai * HALF + m * 16) * ldc + col0;
#pragma unroll
                for (int bj = 0; bj < 2; ++bj) { f32x4 b0, b1;
                    if constexpr (BFB) { const u32x4 t = *(const u32x4*)((const bf16_t*)base + off + bj * HALF);
                        b0 = (f32x4){__builtin_bit_cast(float, t.x << 16), __builtin_bit_cast(float, t.x & 0xffff0000u), __builtin_bit_cast(float, t.y << 16), __builtin_bit_cast(float, t.y & 0xffff0000u)};
                        b1 = (f32x4){__builtin_bit_cast(float, t.z << 16), __builtin_bit_cast(float, t.z & 0xffff0000u), __builtin_bit_cast(float, t.w << 16), __builtin_bit_cast(float, t.w & 0xffff0000u)}; }
                    else { b0 = *(const f32x4*)((const float*)base + off + bj * HALF); b1 = *(const f32x4*)((const float*)base + off + bj * HALF + 4); }
                    const f32x4 v0 = b0 + gv[bj][0] * acc[ai][bj][m][0], v1 = b1 + gv[bj][1] * acc[ai][bj][m][1];
                    u32x4 w; w.x = cvt_pk_bf16(v0[0], v0[1]); w.y = cvt_pk_bf16(v0[2], v0[3]); w.z = cvt_pk_bf16(v1[0], v1[1]); w.w = cvt_pk_bf16(v1[2], v1[3]);
                    *(u32x4*)(out + off + bj * HALF) = w; }
                if (m & 1) asm volatile("" ::: "memory"); }
    }
};
struct EpiSwiGLU {
    static constexpr bool PERM = true, AFTER_DRAIN = false;
    bf16_t* O; int ldc; float ds;
    __device__ __forceinline__ void operator()(const f32x4 (&acc)[2][2][4][2], const Unit& u, int wr, int wc, int fr, int fq) const {
        const int row0 = u.pm * BM + wr * 64 + fr, col0 = u.pn * HALF + wc * 32 + 8 * fq;
#pragma unroll
        for (int ai = 0; ai < 2; ++ai)
#pragma unroll
            for (int m = 0; m < 4; ++m) { bf16_t* rowp = O + (size_t)(row0 + ai * HALF + m * 16) * ldc + col0;
                const f32x4 g0 = acc[ai][0][m][0] * ds, g1 = acc[ai][0][m][1] * ds, u0 = acc[ai][1][m][0] * ds, u1 = acc[ai][1][m][1] * ds;
                f32x4 h0, h1;
#pragma unroll
                for (int j = 0; j < 4; ++j) { h0[j] = silu_f(g0[j]) * u0[j]; h1[j] = silu_f(g1[j]) * u1[j]; }
                u32x4 w; w.x = cvt_pk_bf16(h0[0], h0[1]); w.y = cvt_pk_bf16(h0[2], h0[3]); w.z = cvt_pk_bf16(h1[0], h1[1]); w.w = cvt_pk_bf16(h1[2], h1[3]);
                *(u32x4*)rowp = w; }
    }
};
struct MoeOrder : StaticOrder {
    int tb[8];
    __device__ __forceinline__ void load_bases(const int* mi) {
#pragma unroll
        for (int e = 0; e < 8; ++e) tb[e] = __builtin_amdgcn_readfirstlane(mi[e]); }
    __device__ __forceinline__ int expert_of(int pm) const { int e = 0;
#pragma unroll
        for (int j = 0; j < 7; ++j) e += (pm >= tb[j]) ? 1 : 0;
        return e; }
    __device__ __forceinline__ bool next(int i, Unit& u) const { if (!StaticOrder::next(i, u)) return false; u.eb = expert_of(u.pm); return true; }
};

struct SplitKOrder {
    int pm0, nN, P, kp, total, c; const int* tile_e;
    __device__ __forceinline__ bool next(int i, Unit& u) const {
        if (i != 0 || c >= total) return false;
        const int p = c % P, t = c / P; u.pn = t % nN; u.pm = pm0 + t / nN; u.ko = p * kp; u.eb = tile_e ? __builtin_amdgcn_readfirstlane(tile_e[u.pm]) : 0; return true; }
    __device__ __forceinline__ void a_ready(const Unit&) const {}
    __device__ __forceinline__ void done(const Unit&) const {}
};
struct EpiPart {
    static constexpr bool PERM = false, AFTER_DRAIN = false;
    float* part; const float* scale; int pm_sub; int kp; int ldc;
    __device__ __forceinline__ void operator()(const f32x4 (&acc)[2][2][4][2], const Unit& u, int wr, int wc, int fr, int fq) const {
        float* o = part + (size_t)(u.ko / kp) * BM * ldc;
        const int row0 = (u.pm - pm_sub) * BM + wr * 64 + fr, col0 = u.pn * BM + wc * 32 + 4 * fq;
        f32x4 gv[2][2];
#pragma unroll
        for (int bj = 0; bj < 2; ++bj)
#pragma unroll
            for (int n = 0; n < 2; ++n) gv[bj][n] = *(const f32x4*)(scale + col0 + bj * HALF + n * 16);
#pragma unroll
        for (int ai = 0; ai < 2; ++ai)
#pragma unroll
            for (int m = 0; m < 4; ++m) { const size_t off = (size_t)(row0 + ai * HALF + m * 16) * ldc + col0;
#pragma unroll
                for (int bj = 0; bj < 2; ++bj)
#pragma unroll
                    for (int n = 0; n < 2; ++n) *(f32x4*)(o + off + bj * HALF + n * 16) = gv[bj][n] * acc[ai][bj][m][n]; }
    }
};
struct EpiAtomic {
    static constexpr bool PERM = false, AFTER_DRAIN = true;
    float* out; const float* scale; int pm_sub; int ldc; float ds;
    __device__ __forceinline__ void fused(f32x4 (&acc)[2][2][4][2], const Unit& u, int wr, int wc, int fr, int fq, PG8_LAS unsigned char* lds, int wid, int lane) const {
        PG8_LAS float* scr = (PG8_LAS float*)(lds + wid * 16384);
        const int rr = lane >> 5, cc = lane & 31;
#pragma unroll
        for (int ai = 0; ai < 2; ++ai)
#pragma unroll
            for (int bj = 0; bj < 2; ++bj) {
#pragma unroll
                for (int m = 0; m < 4; ++m)
#pragma unroll
                    for (int n = 0; n < 2; ++n) *(PG8_LAS f32x4*)(scr + (m * 16 + fr) * 36 + n * 16 + 4 * fq) = acc[ai][bj][m][n];
                asm volatile("s_waitcnt lgkmcnt(0)" ::: "memory");
                const int colg = u.pn * BM + bj * HALF + wc * 32 + cc; const float sc = (scale ? scale[colg] : 1.0f) * ds;
                float* op = out + (size_t)((u.pm - pm_sub) * BM + ai * HALF + wr * 64 + rr) * ldc + colg;
#pragma unroll 8
                for (int i = 0; i < 32; ++i) { const float v = scr[(2 * i + rr) * 36 + cc]; __hip_atomic_fetch_add(op + (size_t)(2 * i) * ldc, v * sc, __ATOMIC_RELAXED, __HIP_MEMORY_SCOPE_AGENT); }
                asm volatile("s_waitcnt lgkmcnt(0)" ::: "memory");
            }
    }
};

typedef int i32x4v __attribute__((ext_vector_type(4))); typedef int i32x8v __attribute__((ext_vector_type(8)));
struct FragB { bf16x8 k[2]; };
struct Frag8 { i32x8v v; };
template <bool F8> struct FragSel { typedef FragB type; };
template <> struct FragSel<true> { typedef Frag8 type; };
__device__ __forceinline__ void ld_frag(FragB& f, const PG8_LAS unsigned char* p) { f.k[0] = *(const PG8_LAS bf16x8*)p; f.k[1] = *(const PG8_LAS bf16x8*)(p + 1024); }
__device__ __forceinline__ void ld_frag(Frag8& f, const PG8_LAS unsigned char* p) { const i32x4v lo = *(const PG8_LAS i32x4v*)p, hi = *(const PG8_LAS i32x4v*)(p + 1024); f.v = __builtin_shufflevector(lo, hi, 0, 1, 2, 3, 4, 5, 6, 7); }
__device__ __forceinline__ f32x4 mma_frag(const FragB& b, const FragB& a, f32x4 c) { c = __builtin_amdgcn_mfma_f32_16x16x32_bf16(b.k[0], a.k[0], c, 0, 0, 0); return __builtin_amdgcn_mfma_f32_16x16x32_bf16(b.k[1], a.k[1], c, 0, 0, 0); }
__device__ __forceinline__ f32x4 mma_frag(const Frag8& b, const Frag8& a, f32x4 c) {
    asm volatile("v_mfma_scale_f32_16x16x128_f8f6f4 %0, %1, %2, %0, %3, %3 op_sel_hi:[0,0,0]" : "+v"(c) : "v"(b.v), "v"(a.v), "v"(0x7f7f7f7f));
    return c;
}

struct EpiSwiGLU8 {
    static constexpr bool PERM = true, AFTER_DRAIN = false;
    unsigned char* O; int ldc; float ds, hs;
    __device__ __forceinline__ void operator()(const f32x4 (&acc)[2][2][4][2], const Unit& u, int wr, int wc, int fr, int fq) const {
        const int row0 = u.pm * BM + wr * 64 + fr, col0 = u.pn * HALF + wc * 32 + 8 * fq;
        const float k1 = -1.4426950408889634f * ds, k2 = ds * ds * hs;
#pragma unroll
        for (int ai = 0; ai < 2; ++ai)
#pragma unroll
            for (int m = 0; m < 4; ++m) { unsigned char* rowp = O + (size_t)(row0 + ai * HALF + m * 16) * ldc + col0;
                const f32x4 g0 = acc[ai][0][m][0], g1 = acc[ai][0][m][1], u0 = acc[ai][1][m][0], u1 = acc[ai][1][m][1];
                float h[8];
#pragma unroll
                for (int j = 0; j < 4; ++j) {
                    h[j] = __builtin_amdgcn_fmed3f((g0[j] * u0[j]) * k2 * __builtin_amdgcn_rcpf(1.0f + __builtin_amdgcn_exp2f(g0[j] * k1)), -448.0f, 448.0f);
                    h[4 + j] = __builtin_amdgcn_fmed3f((g1[j] * u1[j]) * k2 * __builtin_amdgcn_rcpf(1.0f + __builtin_amdgcn_exp2f(g1[j] * k1)), -448.0f, 448.0f); }
                unsigned lo = 0u, hi = 0u;
                lo = __builtin_amdgcn_cvt_pk_fp8_f32(h[0], h[1], lo, false); lo = __builtin_amdgcn_cvt_pk_fp8_f32(h[2], h[3], lo, true);
                hi = __builtin_amdgcn_cvt_pk_fp8_f32(h[4], h[5], hi, false); hi = __builtin_amdgcn_cvt_pk_fp8_f32(h[6], h[7], hi, true);
                typedef unsigned u32x2 __attribute__((ext_vector_type(2)));
                *(u32x2*)rowp = (u32x2){lo, hi}; }
    }
};
struct EpiScaleBf16 {
    static constexpr bool PERM = true, AFTER_DRAIN = false;
    bf16_t* O; int ldc; float ds;
    __device__ __forceinline__ void operator()(const f32x4 (&acc)[2][2][4][2], const Unit& u, int wr, int wc, int fr, int fq) const {
        const int row0 = u.pm * BM + wr * 64 + fr, col0 = u.pn * BM + wc * 32 + 8 * fq;
#pragma unroll
        for (int ai = 0; ai < 2; ++ai)
#pragma unroll
            for (int m = 0; m < 4; ++m) { bf16_t* rowp = O + (size_t)(row0 + ai * HALF + m * 16) * ldc + col0;
#pragma unroll
                for (int bj = 0; bj < 2; ++bj) { const f32x4 v0 = acc[ai][bj][m][0] * ds, v1 = acc[ai][bj][m][1] * ds;
                    u32x4 w; w.x = cvt_pk_bf16(v0[0], v0[1]); w.y = cvt_pk_bf16(v0[2], v0[3]); w.z = cvt_pk_bf16(v1[0], v1[1]); w.w = cvt_pk_bf16(v1[2], v1[3]);
                    *(u32x4*)(rowp + bj * HALF) = w; } }
    }
};

template <class Epi, class Sched, bool ALIGN_EPI = false, bool SP2 = false, bool F8 = false>
__device__ __forceinline__ void gemm_phase(PG8_LAS unsigned char* lds, const Gemm g, const Sched& S, const Epi& E, int tid_in) {
    int tid_ = tid_in; asm volatile("" : "+v"(tid_));
    const int tid = tid_, wid = __builtin_amdgcn_readfirstlane(tid >> 6), lane = tid & 63, wr = wid >> 2, wc = wid & 3, fr = lane & 15, fq = lane >> 4;
    const int K = g.K, nt = K / BK, ld = g.ld;
    unsigned voffA[2], voffB[2];
#pragma unroll
    for (int i = 0; i < 2; ++i) { int R, C; stage_rc(tid * 16 + i * 8192, R, C); const int Rb = Epi::PERM ? ((R & ~31) + perm32(R & 31)) : R;
        voffA[i] = (unsigned)(R * ld + C) * 2u; voffB[i] = (unsigned)(Rb * ld + C) * 2u; }
    const size_t kstep = (size_t)(BK * 2);
    const size_t hstep = (size_t)HALF * ld * 2;
    const size_t tstep = 2 * hstep;
    const unsigned ldsw = (unsigned)wid * 1024u;
    const int aoff = lds_byte(wr * 64 + fr, fq * 8), boff = lds_byte(wc * 32 + fr, fq * 8);
#define PG8_SA(b, h) (((b) * 2 + (h)) * HTB)
#define PG8_SB(b, h) ((4 + (b) * 2 + (h)) * HTB)
#define PG8_STAGE(bufoff, gbase, voff) do { _Pragma("unroll") for (int _i = 0; _i < 2; ++_i) \
        __builtin_amdgcn_global_load_lds((const unsigned*)((const char*)(gbase) + (voff)[_i]), (PG8_LAS unsigned*)(lds + (bufoff) + ldsw + _i * 8192), 16, 0, 0); } while (0)
#define PG8_LDA(dst, b, h) do { _Pragma("unroll") for (int m = 0; m < 4; ++m) ld_frag(dst[m], lds + PG8_SA(b, h) + aoff + m * 2048); } while (0)
#define PG8_LDB(dst, b, h) do { _Pragma("unroll") for (int n = 0; n < 2; ++n) ld_frag(dst[n], lds + PG8_SB(b, h) + boff + n * 2048); } while (0)
#define PG8_MMA(ai, bj, At, Bt) do { __builtin_amdgcn_s_setprio(1); _Pragma("unroll") for (int m = 0; m < 4; ++m) _Pragma("unroll") for (int n = 0; n < 2; ++n) \
        acc[ai][bj][m][n] = mma_frag(Bt[n], At[m], acc[ai][bj][m][n]); __builtin_amdgcn_s_setprio(0); } while (0)
#define PG8_WAIT_V(n) asm volatile("s_waitcnt vmcnt(" #n ")" ::: "memory")
#define PG8_WAIT_L(n) asm volatile("s_waitcnt lgkmcnt(" #n ")" ::: "memory")
#define PG8_BAR __builtin_amdgcn_s_barrier()
#define PG8_SCHED __builtin_amdgcn_sched_barrier(0)
    Unit cur, nxt; int ui = 0;
    if (!S.next(0, cur)) return;
    float zacc = 0.f; asm volatile("" : "+v"(zacc));
    f32x4 acc[2][2][4][2];
#pragma unroll
    for (int a = 0; a < 2; ++a)
#pragma unroll
        for (int b = 0; b < 2; ++b)
#pragma unroll
            for (int m = 0; m < 4; ++m)
#pragma unroll
                for (int n = 0; n < 2; ++n) acc[a][b][m][n] = (f32x4){zacc, zacc, zacc, zacc};
    typedef typename FragSel<F8>::type Frag;
    Frag At[4], B0[2], B1[2];
    const char* cA = (const char*)g.A + (size_t)cur.pm * tstep + (size_t)cur.ko * 2; const char* cB = (const char*)g.Bt + (size_t)cur.eb * g.bstride + (size_t)cur.pn * tstep + (size_t)cur.ko * 2;
    S.a_ready(cur);
    if constexpr (SP2) {
        PG8_STAGE(PG8_SB(0, 0), cB, voffB); PG8_STAGE(PG8_SB(0, 1), cB + hstep, voffB); PG8_STAGE(PG8_SA(0, 0), cA, voffA); PG8_STAGE(PG8_SA(0, 1), cA + hstep, voffA);
        if (wr == 1) PG8_BAR;
        PG8_WAIT_V(2); PG8_BAR;
        PG8_STAGE(PG8_SB(1, 0), cB + kstep, voffB); PG8_STAGE(PG8_SA(1, 0), cA + kstep, voffA); PG8_STAGE(PG8_SB(1, 1), cB + hstep + kstep, voffB);
        PG8_WAIT_V(6); PG8_BAR;
    } else {
        PG8_STAGE(PG8_SB(0, 0), cB, voffB); PG8_STAGE(PG8_SA(0, 0), cA, voffA); PG8_STAGE(PG8_SB(0, 1), cB + hstep, voffB); PG8_STAGE(PG8_SA(0, 1), cA + hstep, voffA);
        if (wr == 1) PG8_BAR;
        PG8_WAIT_V(4); PG8_BAR;
        PG8_STAGE(PG8_SB(1, 0), cB + kstep, voffB); PG8_STAGE(PG8_SA(1, 0), cA + kstep, voffA); PG8_STAGE(PG8_SB(1, 1), cB + hstep + kstep, voffB);
        PG8_WAIT_V(6); PG8_BAR;
    }
    for (;;) {
        const bool has_next = S.next(ui + 1, nxt);
        const char* nA = has_next ? (const char*)g.A + (size_t)nxt.pm * tstep + (size_t)nxt.ko * 2 : cA; const char* nB = has_next ? (const char*)g.Bt + (size_t)nxt.eb * g.bstride + (size_t)nxt.pn * tstep + (size_t)nxt.ko * 2 : cB;
        for (int t = 0; t < nt; t += 2) {
            const bool last = (t == nt - 2);
            const char* a1 = cA + (size_t)(t + 1) * kstep;
            const char* a2 = last ? nA : cA + (size_t)(t + 2) * kstep; const char* b2 = last ? nB : cB + (size_t)(t + 2) * kstep;
            const char* a3 = a2 + kstep; const char* b3 = b2 + kstep;
            if (last && has_next) S.a_ready(nxt);
            if constexpr (SP2) {
            PG8_LDB(B0, 0, 0); PG8_LDB(B1, 0, 1); PG8_SCHED; PG8_LDA(At, 0, 0); PG8_STAGE(PG8_SA(1, 1), a1 + hstep, voffA);
            PG8_WAIT_V(8); PG8_WAIT_L(0); PG8_BAR; PG8_MMA(0, 0, At, B0); PG8_MMA(0, 1, At, B1); PG8_BAR; PG8_SCHED;
            PG8_LDA(At, 0, 1); PG8_STAGE(PG8_SB(0, 0), b2, voffB); PG8_STAGE(PG8_SB(0, 1), b2 + hstep, voffB); PG8_STAGE(PG8_SA(0, 0), a2, voffA);
            PG8_WAIT_V(8); PG8_WAIT_L(0); PG8_BAR; PG8_MMA(1, 0, At, B0); PG8_MMA(1, 1, At, B1); PG8_BAR; PG8_SCHED;
            PG8_LDB(B0, 1, 0); PG8_LDB(B1, 1, 1); PG8_SCHED; PG8_LDA(At, 1, 0); PG8_STAGE(PG8_SA(0, 1), a2 + hstep, voffA);
            PG8_WAIT_V(8); PG8_WAIT_L(0); PG8_BAR; PG8_MMA(0, 0, At, B0); PG8_MMA(0, 1, At, B1); PG8_BAR; PG8_SCHED;
            PG8_LDA(At, 1, 1); PG8_STAGE(PG8_SB(1, 0), b3, voffB); PG8_STAGE(PG8_SB(1, 1), b3 + hstep, voffB); PG8_STAGE(PG8_SA(1, 0), a3, voffA);
            PG8_WAIT_V(8); PG8_WAIT_L(0); PG8_BAR; PG8_MMA(1, 0, At, B0); PG8_MMA(1, 1, At, B1); PG8_BAR; PG8_SCHED;
            } else {
            PG8_LDB(B0, 0, 0); PG8_SCHED; PG8_LDA(At, 0, 0); PG8_STAGE(PG8_SA(1, 1), a1 + hstep, voffA);
            PG8_WAIT_L(8); PG8_BAR; PG8_WAIT_L(0); PG8_MMA(0, 0, At, B0); PG8_BAR; PG8_SCHED;
            PG8_LDB(B1, 0, 1); PG8_STAGE(PG8_SB(0, 0), b2, voffB);
            PG8_BAR; PG8_WAIT_L(0); PG8_MMA(0, 1, At, B1); PG8_BAR;
            PG8_LDA(At, 0, 1); PG8_STAGE(PG8_SA(0, 0), a2, voffA);
            PG8_BAR; PG8_WAIT_L(0); PG8_MMA(1, 0, At, B0); PG8_BAR; PG8_SCHED;
            PG8_STAGE(PG8_SB(0, 1), b2 + hstep, voffB);
            PG8_WAIT_V(6); PG8_BAR; PG8_MMA(1, 1, At, B1); PG8_BAR;
            PG8_LDB(B0, 1, 0); PG8_SCHED; PG8_LDA(At, 1, 0); PG8_STAGE(PG8_SA(0, 1), a2 + hstep, voffA);
            PG8_WAIT_L(8); PG8_BAR; PG8_WAIT_L(0); PG8_MMA(0, 0, At, B0); PG8_BAR; PG8_SCHED;
            PG8_LDB(B1, 1, 1); PG8_STAGE(PG8_SB(1, 0), b3, voffB);
            PG8_BAR; PG8_WAIT_L(0); PG8_MMA(0, 1, At, B1); PG8_BAR;
            PG8_LDA(At, 1, 1); PG8_STAGE(PG8_SA(1, 0), a3, voffA);
            PG8_BAR; PG8_WAIT_L(0); PG8_MMA(1, 0, At, B0); PG8_BAR; PG8_SCHED;
            PG8_STAGE(PG8_SB(1, 1), b3 + hstep, voffB);
            PG8_WAIT_V(6); PG8_BAR; PG8_MMA(1, 1, At, B1); PG8_BAR;
            }
        }
        if constexpr (ALIGN_EPI) { if (wr == 0) PG8_BAR; }
        if constexpr (F8) {
            asm volatile("s_nop 15\n\ts_nop 15" : "+v"(acc[1][1][0][0]), "+v"(acc[1][1][0][1]), "+v"(acc[1][1][1][0]), "+v"(acc[1][1][1][1]), "+v"(acc[1][1][2][0]), "+v"(acc[1][1][2][1]), "+v"(acc[1][1][3][0]), "+v"(acc[1][1][3][1])); }
        if constexpr (!Epi::AFTER_DRAIN) { E(acc, cur, wr, wc, fr, fq); S.done(cur); }
        if (!has_next) break;
#pragma unroll
        for (int a = 0; a < 2; ++a)
#pragma unroll
            for (int b = 0; b < 2; ++b)
#pragma unroll
                for (int m = 0; m < 4; ++m)
#pragma unroll
                    for (int n = 0; n < 2; ++n) acc[a][b][m][n] = (f32x4){zacc, zacc, zacc, zacc};
        cur = nxt; cA = nA; cB = nB; ++ui;
        if constexpr (ALIGN_EPI) { if (wr == 1) PG8_BAR; }
    }
    PG8_WAIT_V(0);
    if constexpr (!ALIGN_EPI) { if (wr == 0) PG8_BAR; }
    PG8_BAR;
    if constexpr (Epi::AFTER_DRAIN) { E.fused(acc, cur, wr, wc, fr, fq, lds, wid, lane); S.done(cur); }
#undef PG8_SA
#undef PG8_SB
#undef PG8_STAGE
#undef PG8_LDA
#undef PG8_LDB
#undef PG8_MMA
#undef PG8_WAIT_V
#undef PG8_WAIT_L
#undef PG8_BAR
#undef PG8_SCHED
}
}


constexpr int S_LAT = 16384, C_CTX = 256, R_ALL = S_LAT + C_CTX, DM = 1024;
constexpr int INW = 2560, FFN = 2816, EXD = 3584, NEXP = 8;
constexpr int COL_AQ = 0, COL_AK = 512, COL_AV = 640, COL_HQ = 768, COL_HFF = 1024, COL_HFB = 1280, COL_HI = 1536, COL_HG = 1792, COL_GU = 2048, COL_GV = 2304;
constexpr int MIX_AT = 0, MIX_HG = 512, MIX_GM = 768;
constexpr int MOE_MAXROWS = 34816;
constexpr float EPS = 1e-6f;
constexpr int NWAVES = 8, NTHR = 512;
constexpr int NPH = 23;

constexpr size_t MiB = 1u << 20;
constexpr size_t WS_CTL = 0, CTL_ZERO_BYTES = 1 * MiB;
constexpr size_t WS_VEC = 1 * MiB;
constexpr size_t WS_TOK = 2 * MiB;
constexpr size_t WS_WIN = 3 * MiB;
constexpr size_t WS_WOUT = 13 * MiB;
constexpr size_t WS_WGU = 17 * MiB;
constexpr size_t WS_WD = 28 * MiB;
constexpr size_t WS_MGU = 34 * MiB;
constexpr size_t WS_MD = 146 * MiB;
constexpr size_t WS_H = 202 * MiB;
constexpr size_t WS_PROJ = 235 * MiB;
constexpr size_t WS_MIX = 317 * MiB;
constexpr size_t WS_HGO = 350 * MiB;
constexpr size_t WS_CTXR = 383 * MiB;
constexpr size_t WS_HLT = WS_HGO;
constexpr size_t WS_HSP = 384 * MiB;
constexpr size_t WS_HDG = 402 * MiB;
constexpr size_t WS_VT = 403 * MiB;
constexpr size_t WS_HID = WS_PROJ;
constexpr size_t WS_AS = 202 * MiB;
constexpr size_t WS_HIDM = 270 * MiB;
constexpr size_t WS_H2B = 440 * MiB;
constexpr size_t WS_YF = WS_WIN;
constexpr size_t WS_Y = WS_MGU;
constexpr size_t WS_XB = 104 * MiB;
constexpr size_t WS_PART1 = 176 * MiB;
constexpr size_t WS_PART2 = 180 * MiB;
constexpr size_t WS_END = 508 * MiB;
static_assert(WS_HID + (size_t)R_ALL * FFN * 2 <= WS_HGO && WS_AS + (size_t)MOE_MAXROWS * DM * 2 <= WS_HIDM && WS_HIDM + (size_t)MOE_MAXROWS * EXD * 2 <= WS_END, "ws map");
static_assert(WS_PART1 >= WS_MD + (size_t)8 * DM * EXD && WS_PART1 + (size_t)4 * 256 * DM * 4 <= WS_PART2 && WS_PART2 + (size_t)11 * 256 * DM * 4 <= WS_H, "ws map 4");
static_assert(WS_XB >= WS_Y + (size_t)MOE_MAXROWS * DM * 2 && WS_XB >= WS_MGU + (size_t)8 * 2 * EXD * DM && WS_XB + (size_t)S_LAT * DM * 2 <= WS_MD, "ws map 3");
static_assert(WS_H2B >= WS_HIDM && WS_H2B + (size_t)S_LAT * DM * 2 <= WS_END && WS_H + (size_t)R_ALL * DM * 2 <= WS_PROJ && WS_PROJ + (size_t)R_ALL * INW * 2 <= WS_MIX && WS_MIX + (size_t)R_ALL * DM * 2 <= WS_HGO && WS_HGO + (size_t)2 * R_ALL * 256 * 4 <= WS_CTXR, "ws map 2");
constexpr int VO_MOD = 0;
constexpr int VO_ROPE = 32768;
constexpr int VO_MOE = 65536;
constexpr int CW_BAR = 4096;
constexpr int CW_QUEUE = 2048;
constexpr int CW_MOECNT = 1024;

constexpr int RING_BYTES = 131072;
constexpr int LDSCTL_OFF = 159744, MISC_OFF = LDSCTL_OFF + 320;
constexpr int LDS_BYTES = 163840;

#define GAS __attribute__((address_space(1)))
#define LAS __attribute__((address_space(3)))
typedef unsigned short bf16;
typedef unsigned v4u __attribute__((ext_vector_type(4)));
typedef unsigned v2u __attribute__((ext_vector_type(2)));
typedef float f32x4 __attribute__((ext_vector_type(4)));
typedef GAS unsigned gu32;
#define RLX_AGENT __ATOMIC_RELAXED, __HIP_MEMORY_SCOPE_AGENT
#define LDS_WAIT() asm volatile("s_waitcnt lgkmcnt(0)" ::: "memory")
typedef float f32x2_t __attribute__((ext_vector_type(2))); typedef __bf16 bf16x2_t __attribute__((ext_vector_type(2)));
__device__ __forceinline__ unsigned pk2(float lo, float hi) { const f32x2_t v = {lo, hi}; const bf16x2_t b = __builtin_convertvector(v, bf16x2_t); return __builtin_bit_cast(unsigned, b); }
__device__ __forceinline__ unsigned f2bf(float f) { return pk2(f, 0.f) & 0xffffu; }
__device__ __forceinline__ float bflo(unsigned w) { return __builtin_bit_cast(float, w << 16); }
__device__ __forceinline__ float bfhi(unsigned w) { return __builtin_bit_cast(float, w & 0xffff0000u); }
__device__ __forceinline__ float sigm1(float x) { return __builtin_amdgcn_rcpf(1.0f + __builtin_amdgcn_exp2f(-1.4426950408889634f * x)); }
__device__ __forceinline__ float silu1(float x) { return x * sigm1(x); }
__device__ __forceinline__ float gelu1(float x) { return 0.5f * x * (1.0f + erff(x * 0.70710678118654752f)); }
template <int X> __device__ __forceinline__ float sx(float v) { return __shfl_xor(v, X); }
__device__ __forceinline__ float sx32_add(float v) { return v + __shfl_xor(v, 32); }
__device__ __forceinline__ float sx32_max(float v) { return fmaxf(v, __shfl_xor(v, 32)); }
__device__ __forceinline__ float wave_sum(float v) { v += sx<1>(v); v += sx<2>(v); v += sx<4>(v); v += sx<8>(v); v += sx<16>(v); return sx32_add(v); }
__device__ __forceinline__ void unpack8(const v4u w, float* f) { f[0] = bflo(w.x); f[1] = bfhi(w.x); f[2] = bflo(w.y); f[3] = bfhi(w.y); f[4] = bflo(w.z); f[5] = bfhi(w.z); f[6] = bflo(w.w); f[7] = bfhi(w.w); }


__device__ __forceinline__ float clamp448(float x) { return fminf(fmaxf(x, -448.0f), 448.0f); }
__device__ __forceinline__ unsigned pk4_fp8(float a, float b, float c, float d) {
    unsigned w = 0u; w = __builtin_amdgcn_cvt_pk_fp8_f32(clamp448(a), clamp448(b), w, false); w = __builtin_amdgcn_cvt_pk_fp8_f32(clamp448(c), clamp448(d), w, true); return w; }
constexpr float F8_WSCALE = 128.0f;
constexpr float F8_ASCALE = 16.0f;
constexpr float F8_HSCALE = 8.0f;
#define XB_TMO      128
#define XB_XCNT(j)  (256  + 64 * (j))
#define XB_XSUB(j)  (1280 + 64 * (j))
#define XB_XGEN(j)  (2304 + 64 * (j))
#define XB_TOP      3328
#define XB_TOPGEN   3392
#define XCD_BAR_WORDS 3456
#define XB_SPIN_CAP (1u << 18)

__device__ __forceinline__ unsigned xb_ld(unsigned* p)              { return __hip_atomic_load(p, __ATOMIC_RELAXED, __HIP_MEMORY_SCOPE_AGENT); }
__device__ __forceinline__ unsigned xb_add(unsigned* p, unsigned v) { return __hip_atomic_fetch_add(p, v, __ATOMIC_RELAXED, __HIP_MEMORY_SCOPE_AGENT); }
__device__ __forceinline__ unsigned xb_xcc_id() { return (unsigned)__builtin_amdgcn_s_getreg((3 << 11) | 20) & 0xFu; }
#define XB_SPIN(cond, bar) do { unsigned _sp = 0; while (cond) { __builtin_amdgcn_s_sleep(1); \
    if ((++_sp & 255u) == 0u) { if (xb_ld(&(bar)[XB_TMO])) break; if (_sp > XB_SPIN_CAP) { atomicAdd(&(bar)[XB_TMO], 1u); break; } } } } while (0)

struct XcdBarrier {
    unsigned* bar; unsigned x;
    volatile LAS unsigned* st;
};

__device__ __forceinline__ XcdBarrier xcd_barrier_post(unsigned* bar, volatile LAS unsigned* st) {
    XcdBarrier b; b.bar = bar; b.x = xb_xcc_id(); b.st = st;
    if (threadIdx.x == 0) (void)xb_add(&bar[XB_XCNT(b.x)], 1u);
    return b;
}
__device__ __forceinline__ void xcd_barrier_complete(unsigned* bar, unsigned x, unsigned& nloc, unsigned& nx) {
    const unsigned G = gridDim.x * gridDim.y * gridDim.z;
    unsigned sum, cnt, mine, sp = 0u;
    for (;;) {
        sum = 0u; cnt = 0u; mine = 0u;
#pragma unroll
        for (unsigned j = 0; j < 16; ++j) { const unsigned c = xb_ld(&bar[XB_XCNT(j)]); sum += c; cnt += (c > 0u) ? 1u : 0u; mine = (j == x) ? c : mine; }
        if (sum == G) break;
        __builtin_amdgcn_s_sleep(1);
        if ((++sp & 255u) == 0u) { if (xb_ld(&bar[XB_TMO])) break; if (sp > XB_SPIN_CAP) { atomicAdd(&bar[XB_TMO], 1u); break; } }
    }
    nloc = mine > 0u ? mine : 1u; nx = cnt > 0u ? cnt : 1u;
}

__device__ __forceinline__ void xcd_barrier(const XcdBarrier& b, const int tid_in) {
    asm volatile("s_waitcnt vmcnt(0)" ::: "memory");
    __syncthreads();
    if (tid_in == 0) {
        unsigned* bar = b.bar;
        __builtin_amdgcn_s_waitcnt(0);
        unsigned nloc = b.st[0], nx = b.st[1];
        if (nloc == 0u) { xcd_barrier_complete(bar, b.x, nloc, nx); b.st[0] = nloc; b.st[1] = nx; }
        const unsigned old = xb_add(&bar[XB_XSUB(b.x)], 1u);
        const unsigned gen = old / nloc;
        if (old + 1u == (gen + 1u) * nloc) {
            __builtin_amdgcn_fence(__ATOMIC_RELEASE, "agent");
            asm volatile("s_waitcnt vmcnt(0)" ::: "memory");
            const unsigned og = xb_add(&bar[XB_TOP], 1u);
            const unsigned tg = og / nx;
            if (og + 1u == (tg + 1u) * nx) xb_add(&bar[XB_TOPGEN], 1u);
            else XB_SPIN(xb_ld(&bar[XB_TOPGEN]) == tg, bar);
            __builtin_amdgcn_fence(__ATOMIC_ACQUIRE, "agent");
            xb_add(&bar[XB_XGEN(b.x)], 1u);
            asm volatile("s_waitcnt vmcnt(0)" ::: "memory");
        } else {
            XB_SPIN(xb_ld(&bar[XB_XGEN(b.x)]) == gen, bar);
            __builtin_amdgcn_fence(__ATOMIC_ACQUIRE, "agent");
            asm volatile("s_waitcnt vmcnt(0)" ::: "memory");
        }
    }
    __syncthreads();
}


struct Args { const float* in[23]; float* out; unsigned char* ws; int ph_lo, ph_hi; };
typedef const __attribute__((address_space(4))) Args* KA;
#define KARGS() ({ KA p_ = (KA)__builtin_amdgcn_kernarg_segment_ptr(); asm volatile("" : "+s"(p_)); p_; })
enum { I_X = 0, I_C, I_CTX, I_CCTX, I_WADA, I_BADA, I_WIN, I_WOUT, I_QG, I_KG, I_SINK, I_HLB, I_HGAIN, I_GWS, I_GBS, I_GNG, I_FG, I_FU, I_FD, I_ROUTER, I_MG, I_MU, I_MDN };

__device__ __forceinline__ void transpose_item(const float* W, int K, int N, bf16* WT, int mode, LAS float* scr, int item, int lane) {
    const int nblk = N / 32, kb = item / nblk, nb = item % nblk, k0 = 64 * kb, n0 = 32 * nb;
#pragma unroll 8
    for (int i = 0; i < 32; ++i) { const int kk = 2 * i + (lane >> 5); scr[kk * 33 + (lane & 31)] = __builtin_nontemporal_load(&W[(size_t)(k0 + kk) * N + n0 + (lane & 31)]); }
    LDS_WAIT(); asm volatile("" ::: "memory");
    const int c = lane & 7;
#pragma unroll
    for (int j = 0; j < 4; ++j) { const int n = (lane >> 3) + 8 * j; const LAS float* s = scr + (8 * c) * 33 + n;
        v4u o; o.x = pk2(s[0 * 33], s[1 * 33]); o.y = pk2(s[2 * 33], s[3 * 33]); o.z = pk2(s[4 * 33], s[5 * 33]); o.w = pk2(s[6 * 33], s[7 * 33]);
        const int ng = n0 + n; const int drow = (mode == 0) ? ng : (ng + 128 * (ng / 128) + (mode == 2 ? 128 : 0));
        *(GAS v4u*)(WT + (size_t)drow * K + k0 + 8 * c) = o; }
    LDS_WAIT(); asm volatile("" ::: "memory");
}
__device__ __forceinline__ void transpose_item8(const float* W, int K, int N, unsigned char* WT, int mode, LAS float* scr, int item, int lane) {
    const int nblk = N / 32, kb = item / nblk, nb = item % nblk, k0 = 64 * kb, n0 = 32 * nb;
#pragma unroll 8
    for (int i = 0; i < 32; ++i) { const int kk = 2 * i + (lane >> 5); scr[kk * 33 + (lane & 31)] = __builtin_nontemporal_load(&W[(size_t)(k0 + kk) * N + n0 + (lane & 31)]); }
    LDS_WAIT(); asm volatile("" ::: "memory");
    const int c = lane & 7;
#pragma unroll
    for (int j = 0; j < 4; ++j) { const int n = (lane >> 3) + 8 * j; const LAS float* s = scr + (8 * c) * 33 + n;
        v2u o; o.x = pk4_fp8(s[0 * 33] * F8_WSCALE, s[1 * 33] * F8_WSCALE, s[2 * 33] * F8_WSCALE, s[3 * 33] * F8_WSCALE); o.y = pk4_fp8(s[4 * 33] * F8_WSCALE, s[5 * 33] * F8_WSCALE, s[6 * 33] * F8_WSCALE, s[7 * 33] * F8_WSCALE);
        const int ng = n0 + n; const int drow = (mode == 0) ? ng : (ng + 128 * (ng / 128) + (mode == 2 ? 128 : 0));
        *(GAS v2u*)(WT + (size_t)drow * K + k0 + 8 * c) = o; }
    LDS_WAIT(); asm volatile("" ::: "memory");
}
constexpr int MOE_ITEMS = 24 * 16 * 112;
constexpr int MOE_SL0 = 0, MOE_SL1 = 5376, MOE_SL2 = 10752, MOE_SL3 = 16128, MOE_SL4 = 19200, MOE_SL5 = 25344, MOE_SL6 = 29184, MOE_SL7 = 32576, MOE_DEFER = 34496;
__device__ __forceinline__ void moe_conv_item(KA a, int it, LAS float* scr, int lane) {
    constexpr int I_M = 16 * 112;
    unsigned char* ws = a->ws;
    const int idx = it / I_M, r = it % I_M;
    if (idx < 8) transpose_item8(a->in[I_MG] + (size_t)idx * DM * EXD, DM, EXD, (unsigned char*)(ws + WS_MGU) + (size_t)idx * 2 * EXD * DM, 1, scr, r, lane);
    else if (idx < 16) transpose_item8(a->in[I_MU] + (size_t)(idx - 8) * DM * EXD, DM, EXD, (unsigned char*)(ws + WS_MGU) + (size_t)(idx - 8) * 2 * EXD * DM, 2, scr, r, lane);
    else transpose_item8(a->in[I_MDN] + (size_t)(idx - 16) * EXD * DM, EXD, DM, (unsigned char*)(ws + WS_MD) + (size_t)(idx - 16) * DM * EXD, 0, scr, r, lane);
}
__device__ __forceinline__ void moe_conv_range(KA a, int lo, int hi, int first, LAS unsigned char* lds, int lane, int wave, int G, int bid) {
    if (bid < first) return;
    LAS float* scr = (LAS float*)(lds + wave * 8704);
    const int nw = (G - first) * NWAVES, w = (bid - first) * NWAVES + wave;
    for (int i = lo + w; i < hi; i += nw) moe_conv_item(a, i, scr, lane);
}
__device__ __forceinline__ void p0_prologue(KA a, LAS unsigned char* lds, int tid, int lane, int wave, int G, int bid) {
    unsigned char* ws = a->ws;
    LAS float* scr = (LAS float*)(lds + wave * 8704);
    const int gw = bid * NWAVES + wave, NGW = G * NWAVES;
    constexpr int I_IN = 16 * 80, I_OUT = 16 * 32, I_F = 16 * 88, I_FDN = 44 * 32, I_M = 16 * 112;
    constexpr int NIT = 2 * I_IN + 2 * I_OUT + 2 * I_F + I_FDN + 24 * I_M;
    for (int it0 = gw; it0 < NIT; it0 += NGW) {
        int it = it0;
        if (it < 2 * I_IN) { const int l = it / I_IN, r = it % I_IN; transpose_item(a->in[I_WIN] + (size_t)l * DM * INW, DM, INW, (bf16*)(ws + WS_WIN) + (size_t)l * INW * DM, 0, scr, r, lane); continue; } it -= 2 * I_IN;
        if (it < 2 * I_OUT) { const int l = it / I_OUT, r = it % I_OUT; transpose_item(a->in[I_WOUT] + (size_t)l * DM * DM, DM, DM, (bf16*)(ws + WS_WOUT) + (size_t)l * DM * DM, 0, scr, r, lane); continue; } it -= 2 * I_OUT;
        if (it < I_F) { transpose_item(a->in[I_FG], DM, FFN, (bf16*)(ws + WS_WGU), 1, scr, it, lane); continue; } it -= I_F;
        if (it < I_F) { transpose_item(a->in[I_FU], DM, FFN, (bf16*)(ws + WS_WGU), 2, scr, it, lane); continue; } it -= I_F;
        if (it < I_FDN) { transpose_item(a->in[I_FD], FFN, DM, (bf16*)(ws + WS_WD), 0, scr, it, lane); continue; } it -= I_FDN;
        if (it >= MOE_DEFER) moe_conv_item(a, it, scr, lane);
    }
    LAS float* sil = (LAS float*)(lds + 69632);
    LAS float* part = (LAS float*)(lds + 69632 + 8192);
    float* vec = (float*)(ws + WS_VEC);
    if (bid < 192) {
        for (int i = tid; i < 2048; i += NTHR) { const float v = (i < 1024) ? a->in[I_C][i] : a->in[I_CCTX][i - 1024]; sil[i] = silu1(v); }
        __syncthreads();
        for (int item = bid; item < 192; item += G) {
            const int l = item / 96, cb = item % 96, col = cb * 64 + lane;
            const float* w = a->in[I_WADA] + (size_t)l * DM * 6144 + col;
            float a0 = 0.f, a1 = 0.f;
#pragma unroll 1
            for (int k0 = wave * 128; k0 < wave * 128 + 128; k0 += 32) { float wv[32];
#pragma unroll
                for (int j = 0; j < 32; ++j) wv[j] = __builtin_nontemporal_load(&w[(size_t)(k0 + j) * 6144]);
#pragma unroll
                for (int j = 0; j < 32; ++j) { a0 += sil[k0 + j] * wv[j]; a1 += sil[1024 + k0 + j] * wv[j]; } }
            part[(wave * 2 + 0) * 64 + lane] = a0; part[(wave * 2 + 1) * 64 + lane] = a1;
            __syncthreads();
            if (wave == 0) { float s0 = 0.f, s1 = 0.f;
#pragma unroll
                for (int w8 = 0; w8 < 8; ++w8) { s0 += part[(w8 * 2 + 0) * 64 + lane]; s1 += part[(w8 * 2 + 1) * 64 + lane]; }
                const float b = a->in[I_BADA][l * 6144 + col];
                vec[VO_MOD + (l * 2 + 0) * 6144 + col] = s0 + b; vec[VO_MOD + (l * 2 + 1) * 6144 + col] = s1 + b; }
            __syncthreads();
        }
    }
    if (bid == G - 1) {
        for (int idx = tid; idx < 5120; idx += NTHR) {
            const int isc = idx >= 4096, j = isc ? idx - 4096 : idx, pos = j / 16, i = j % 16;
            const float inv = exp2f(-(float)i * 0.83048202372184059f);
            const float ang = (float)pos * inv;
            double r = (double)ang * 0.15915494309189535; r -= floor(r);
            const float rf = (float)r;
            const float cs = __builtin_amdgcn_cosf(rf), sn = __builtin_amdgcn_sinf(rf);
            float* t = vec + VO_ROPE + (isc ? 8192 : 0);
            const int n = isc ? 1024 : 4096;
            t[j] = cs; t[n + j] = sn;
        }
    }
}

template <bool STORE = true, bool BFX = false> __device__ __forceinline__ void norm_row(const void* xrow, const float* sc, const float* sh, bf16* orow, int lane, f32x4 (&h)[4]) {
    f32x4 v[4]; float s = 0.f;
    if constexpr (BFX) { const GAS v2u* xr = (const GAS v2u*)xrow + lane;
#pragma unroll
        for (int j = 0; j < 4; ++j) { const v2u t = xr[64 * j]; v[j] = (f32x4){bflo(t.x), bfhi(t.x), bflo(t.y), bfhi(t.y)}; } }
    else { const GAS f32x4* xr = (const GAS f32x4*)xrow + lane;
#pragma unroll
        for (int j = 0; j < 4; ++j) v[j] = xr[64 * j]; }
#pragma unroll
    for (int j = 0; j < 4; ++j) s += (v[j].x * v[j].x + v[j].y * v[j].y) + (v[j].z * v[j].z + v[j].w * v[j].w);
    const float rstd = __builtin_amdgcn_rsqf(wave_sum(s) * (1.0f / DM) + EPS);
    GAS v2u* o8 = (GAS v2u*)orow + lane;
#pragma unroll
    for (int j = 0; j < 4; ++j) { const f32x4 scv = *(const f32x4*)(sc + 4 * lane + 256 * j), shv = *(const f32x4*)(sh + 4 * lane + 256 * j);
        h[j] = v[j] * rstd * (scv + 1.0f) + shv;
        if constexpr (STORE) { v2u w; w.x = pk2(h[j].x, h[j].y); w.y = pk2(h[j].z, h[j].w); o8[64 * j] = w; } }
}
__device__ __forceinline__ void phase_norm(KA a, int l, int which, int nrows, bf16* H, int lane, int wave, int G, int bid) {
    const float* vec = (const float*)(a->ws + WS_VEC);
    const bool bfx = !(l == 0 && which == 0);
    const float* xl = a->in[I_X]; const bf16* xb = (const bf16*)(a->ws + WS_XB);
    const float* xc = (l == 0) ? a->in[I_CTX] : (const float*)(a->ws + WS_CTXR);
    const int nlat = nrows < S_LAT ? nrows : S_LAT;
    const float* ml = vec + VO_MOD + (l * 2 + 0) * 6144 + which * 3072;
    const float* mc = vec + VO_MOD + (l * 2 + 1) * 6144 + which * 3072;
    const int gw = bid * NWAVES + wave, NGW = G * NWAVES;
    f32x4 scl[4], shl[4], v[4];
#pragma unroll
    for (int j = 0; j < 4; ++j) { scl[j] = *(const f32x4*)(ml + 1024 + 4 * lane + 256 * j) + 1.0f; shl[j] = *(const f32x4*)(ml + 4 * lane + 256 * j); }
    if (gw < nlat) {
        if (bfx) { const GAS v2u* xr = (const GAS v2u*)(xb + (size_t)gw * DM) + lane;
#pragma unroll
            for (int j = 0; j < 4; ++j) { const v2u t = xr[64 * j]; v[j] = (f32x4){bflo(t.x), bfhi(t.x), bflo(t.y), bfhi(t.y)}; } }
        else { const GAS f32x4* xr = (const GAS f32x4*)(xl + (size_t)gw * DM) + lane;
#pragma unroll
            for (int j = 0; j < 4; ++j) v[j] = xr[64 * j]; } }
    for (int r = gw; r < nlat; r += NGW) {
        const int rn = r + NGW; f32x4 vn[4];
        if (rn < nlat) {
            if (bfx) { const GAS v2u* xr = (const GAS v2u*)(xb + (size_t)rn * DM) + lane;
#pragma unroll
                for (int j = 0; j < 4; ++j) { const v2u t = xr[64 * j]; vn[j] = (f32x4){bflo(t.x), bfhi(t.x), bflo(t.y), bfhi(t.y)}; } }
            else { const GAS f32x4* xr = (const GAS f32x4*)(xl + (size_t)rn * DM) + lane;
#pragma unroll
                for (int j = 0; j < 4; ++j) vn[j] = xr[64 * j]; } }
        float s = 0.f;
#pragma unroll
        for (int j = 0; j < 4; ++j) s += (v[j].x * v[j].x + v[j].y * v[j].y) + (v[j].z * v[j].z + v[j].w * v[j].w);
        const float rstd = __builtin_amdgcn_rsqf(wave_sum(s) * (1.0f / DM) + EPS);
        GAS v2u* o8 = (GAS v2u*)(H + (size_t)r * DM) + lane;
#pragma unroll
        for (int j = 0; j < 4; ++j) { const f32x4 h = v[j] * rstd * scl[j] + shl[j]; v2u w; w.x = pk2(h.x, h.y); w.y = pk2(h.z, h.w); o8[64 * j] = w; }
#pragma unroll
        for (int j = 0; j < 4; ++j) v[j] = vn[j];
    }
    const int npart = (l == 0 && which == 0) ? 0 : (l == 0 ? 4 : 11);
    const float* part = (const float*)(a->ws + (l == 0 ? WS_PART1 : WS_PART2));
    for (int r = S_LAT + (NGW - 1 - gw); r < nrows; r += NGW) {
        const int cr = r - S_LAT; f32x4 x[4];
        { const GAS f32x4* xr = (const GAS f32x4*)(xc + (size_t)cr * DM) + lane;
#pragma unroll
          for (int j = 0; j < 4; ++j) x[j] = xr[64 * j]; }
        for (int p = 0; p < npart; ++p) { const GAS f32x4* pr = (const GAS f32x4*)(part + ((size_t)p * 256 + cr) * DM) + lane;
#pragma unroll
            for (int j = 0; j < 4; ++j) x[j] = x[j] + pr[64 * j]; }
        if (npart && l == 0) { GAS f32x4* cw = (GAS f32x4*)((float*)(a->ws + WS_CTXR) + (size_t)cr * DM) + lane;
#pragma unroll
            for (int j = 0; j < 4; ++j) cw[64 * j] = x[j]; }
        float s = 0.f;
#pragma unroll
        for (int j = 0; j < 4; ++j) s += (x[j].x * x[j].x + x[j].y * x[j].y) + (x[j].z * x[j].z + x[j].w * x[j].w);
        const float rstd = __builtin_amdgcn_rsqf(wave_sum(s) * (1.0f / DM) + EPS);
        GAS v2u* o8 = (GAS v2u*)(H + (size_t)r * DM) + lane;
#pragma unroll
        for (int j = 0; j < 4; ++j) { const f32x4 scv = *(const f32x4*)(mc + 1024 + 4 * lane + 256 * j), shv = *(const f32x4*)(mc + 4 * lane + 256 * j);
            const f32x4 h = x[j] * rstd * (scv + 1.0f) + shv; v2u w; w.x = pk2(h.x, h.y); w.y = pk2(h.z, h.w); o8[64 * j] = w; }
    }
}
__device__ __forceinline__ void phase_norm_route(KA a, LAS unsigned char* lds, int tid, int lane, int wave, int G, int bid) {
    const int l = 1;
    const float* vec = (const float*)(a->ws + WS_VEC);
    const float* ml = vec + VO_MOD + (l * 2 + 0) * 6144 + 3072;
    unsigned char* H8 = (unsigned char*)(a->ws + WS_H2B);
    LAS float* rt = (LAS float*)lds;
    volatile LAS unsigned* lcnt = (volatile LAS unsigned*)(lds + 32768);
    for (int i = tid; i < 8192; i += NTHR) rt[i] = a->in[I_ROUTER][i];
    if (tid < 16) lcnt[tid] = 0u;
    __syncthreads();
    int* tokinfo = (int*)(a->ws + WS_TOK);
    unsigned* cnt = (unsigned*)(a->ws + WS_CTL) + CW_MOECNT;
    const int gw = bid * NWAVES + wave, NGW = G * NWAVES;
    unsigned keep = 0u, pk0 = 0u; int itn = 0;
    for (int r = gw; r < S_LAT; r += NGW) {
        f32x4 h[4];
        norm_row<false, true>((const bf16*)(a->ws + WS_XB) + (size_t)r * DM, ml + 1024, ml, nullptr, lane, h);
#pragma unroll
        for (int j = 0; j < 4; ++j) ((GAS unsigned*)(H8 + (size_t)r * DM))[lane + 64 * j] = pk4_fp8(h[j].x * F8_ASCALE, h[j].y * F8_ASCALE, h[j].z * F8_ASCALE, h[j].w * F8_ASCALE);
        float lg[8];
#pragma unroll
        for (int e = 0; e < 8; ++e) lg[e] = 0.f;
#pragma unroll
        for (int j = 0; j < 4; ++j)
#pragma unroll
            for (int i = 0; i < 4; ++i) { const int d = 4 * lane + 256 * j + i; const f32x4 r0 = *(const LAS f32x4*)(rt + d * 8), r1 = *(const LAS f32x4*)(rt + d * 8 + 4); const float hv = h[j][i];
                lg[0] += hv * r0.x; lg[1] += hv * r0.y; lg[2] += hv * r0.z; lg[3] += hv * r0.w; lg[4] += hv * r1.x; lg[5] += hv * r1.y; lg[6] += hv * r1.z; lg[7] += hv * r1.w; }
#pragma unroll
        for (int e = 0; e < 8; ++e) lg[e] = wave_sum(lg[e]);
        int i1 = 0; float v1 = lg[0];
#pragma unroll
        for (int e = 1; e < 8; ++e) if (lg[e] > v1) { v1 = lg[e]; i1 = e; }
        int i2 = -1; float v2 = -INFINITY;
#pragma unroll
        for (int e = 0; e < 8; ++e) if (e != i1 && lg[e] > v2) { v2 = lg[e]; i2 = e; }
        const float w1 = 1.0f / (1.0f + __expf(v2 - v1)), w2 = 1.0f - w1;
        if (lane == 0) {
            const unsigned r1 = __hip_atomic_fetch_add((LAS unsigned*)lcnt + i1, 1u, __ATOMIC_RELAXED, __HIP_MEMORY_SCOPE_WORKGROUP), r2 = __hip_atomic_fetch_add((LAS unsigned*)lcnt + i2, 1u, __ATOMIC_RELAXED, __HIP_MEMORY_SCOPE_WORKGROUP);
            int* ti = tokinfo + (size_t)r * 8;
            ti[0] = i1; ti[1] = i2; ti[4] = __builtin_bit_cast(int, w1); ti[5] = __builtin_bit_cast(int, w2);
            pk0 = (unsigned)i1 | ((unsigned)i2 << 3) | (r1 << 6) | (r2 << 19);
        }
        const unsigned pku = (unsigned)__builtin_amdgcn_readfirstlane((int)pk0);
        if (lane == itn) keep = pku;
        ++itn;
    }
    __syncthreads();
    if (tid < 8) lcnt[8 + tid] = __hip_atomic_fetch_add(cnt + 64 * tid, lcnt[tid], RLX_AGENT);
    __syncthreads();
    { const int r = gw + lane * NGW; if (lane < itn && r < S_LAT) { int* ti = tokinfo + (size_t)r * 8; const unsigned e1 = keep & 7u, e2 = (keep >> 3) & 7u; ti[2] = (int)(((keep >> 6) & 0x1fffu) + lcnt[8 + e1]); ti[3] = (int)((keep >> 19) + lcnt[8 + e2]); } }
}

__device__ __forceinline__ void qk_prep(KA a, int l, int first_thread, int nthreads) {
    bf16* PROJ = (bf16*)(a->ws + WS_PROJ);
    const float* rope = (const float*)(a->ws + WS_VEC) + VO_ROPE;
    for (int i = first_thread; i < R_ALL * 10; i += nthreads) {
        const int row = i / 10, hh = i % 10; const bool isq = hh < 8;
        bf16* p = PROJ + (size_t)row * INW + (isq ? hh * 64 : COL_AK + (hh - 8) * 64);
        const float* gain = (isq ? a->in[I_QG] : a->in[I_KG]) + l * 64;
        float x[64]; float ss = 0.f;
#pragma unroll
        for (int c = 0; c < 8; ++c) { const v4u w = *(const GAS v4u*)(p + 8 * c); unpack8(w, x + 8 * c); }
#pragma unroll
        for (int d = 0; d < 64; ++d) ss += x[d] * x[d];
        const float rstd = __builtin_amdgcn_rsqf(ss * (1.0f / 64.0f) + EPS);
        const f32x4* g4 = (const f32x4*)gain;
#pragma unroll
        for (int c = 0; c < 16; ++c) { const f32x4 gv = g4[c]; x[4 * c] *= rstd * gv.x; x[4 * c + 1] *= rstd * gv.y; x[4 * c + 2] *= rstd * gv.z; x[4 * c + 3] *= rstd * gv.w; }
        if (row < S_LAT) {
            const int gr = row >> 6, gc = row & 63;
            const f32x4* cr = (const f32x4*)(rope + gr * 16); const f32x4* sr = (const f32x4*)(rope + 4096 + gr * 16); const f32x4* cc = (const f32x4*)(rope + 8192 + gc * 16); const f32x4* sc = (const f32x4*)(rope + 8192 + 1024 + gc * 16);
#pragma unroll
            for (int j4 = 0; j4 < 4; ++j4) { const f32x4 cv = cr[j4], sv = sr[j4];
#pragma unroll
                for (int i = 0; i < 4; ++i) { const int j = 4 * j4 + i; const float x1 = x[j], x2 = x[16 + j]; x[j] = x1 * cv[i] - x2 * sv[i]; x[16 + j] = x1 * sv[i] + x2 * cv[i]; } }
#pragma unroll
            for (int j4 = 0; j4 < 4; ++j4) { const f32x4 cv = cc[j4], sv = sc[j4];
#pragma unroll
                for (int i = 0; i < 4; ++i) { const int j = 4 * j4 + i; const float x1 = x[32 + j], x2 = x[48 + j]; x[32 + j] = x1 * cv[i] - x2 * sv[i]; x[48 + j] = x1 * sv[i] + x2 * cv[i]; } }
        }
        const float qs = isq ? 0.125f * 1.4426950408889634f : 1.0f;
#pragma unroll
        for (int c = 0; c < 8; ++c) { v4u w; w.x = pk2(x[8 * c] * qs, x[8 * c + 1] * qs); w.y = pk2(x[8 * c + 2] * qs, x[8 * c + 3] * qs); w.z = pk2(x[8 * c + 4] * qs, x[8 * c + 5] * qs); w.w = pk2(x[8 * c + 6] * qs, x[8 * c + 7] * qs);
            *(GAS v4u*)(p + 8 * c) = w; }
    }
}
__device__ __forceinline__ void gmlp_unit(KA a, int l, int chunk, int g, LAS unsigned char* lds, int tid, int lane, int wave) {
    const bf16* PROJ = (const bf16*)(a->ws + WS_PROJ); bf16* MIX = (bf16*)(a->ws + WS_MIX);
    const int row0 = (chunk < 128) ? chunk * 128 : S_LAT + (chunk - 128) * 128;
    LAS float* vn = (LAS float*)lds;
    { const int pos = tid >> 2, part = tid & 3;
      const bf16* p = PROJ + (size_t)(row0 + pos) * INW + COL_GV + g * 64 + part * 16;
      float x[16]; unpack8(*(const GAS v4u*)p, x); unpack8(*(const GAS v4u*)(p + 8), x + 8);
      float ss = 0.f;
#pragma unroll
      for (int d = 0; d < 16; ++d) { x[d] = gelu1(x[d]); ss += x[d] * x[d]; }
      ss += sx<1>(ss); ss += sx<2>(ss);
      const float rstd = __builtin_amdgcn_rsqf(ss * (1.0f / 64.0f) + EPS);
      const float* gn = a->in[I_GNG] + l * 256 + g * 64 + part * 16;
#pragma unroll
      for (int d = 0; d < 16; ++d) vn[pos * 64 + part * 16 + d] = x[d] * rstd * gn[d]; }
    __syncthreads();
    const int c = lane, t0 = wave * 16;
    const float* W = a->in[I_GWS] + ((size_t)(l * 4 + g) * 128 + t0) * 128;
    float acc[16];
#pragma unroll
    for (int i = 0; i < 16; ++i) acc[i] = 0.f;
    for (int s = 0; s < 128; ++s) { const float v = vn[s * 64 + c];
#pragma unroll
        for (int i = 0; i < 16; ++i) acc[i] += W[i * 128 + s] * v; }
    const float* bs = a->in[I_GBS] + (l * 4 + g) * 128 + t0;
#pragma unroll
    for (int i = 0; i < 16; ++i) { const int row = row0 + t0 + i;
        const float u = gelu1(bflo((unsigned)PROJ[(size_t)row * INW + COL_GU + g * 64 + c]));
        MIX[(size_t)row * DM + MIX_GM + g * 64 + c] = (bf16)f2bf(u * (acc[i] + bs[i])); }
    __syncthreads();
}
__device__ __forceinline__ void hgrn_naive(KA a, int l, int dir, int head, LAS unsigned char* lds, int tid, int lane, int wave) {
    const bf16* PROJ = (const bf16*)(a->ws + WS_PROJ);
    float* HGO = (float*)(a->ws + WS_HGO) + (size_t)dir * R_ALL * 256;
    LAS float* Qs = (LAS float*)lds;
    LAS float* Fs = Qs + 4096; LAS float* Vs = Fs + 4096; LAS float* part = Vs + 4096;
    const int v = lane, kg = wave;
    float S[8];
#pragma unroll
    for (int i = 0; i < 8; ++i) S[i] = 0.f;
    const int tl = tid >> 3, c8 = tid & 7;
    float lb[8];
#pragma unroll
    for (int j = 0; j < 8; ++j) { float b = 0.f; if (l == 1) { const float p0 = a->in[I_HLB][dir * 512 + head * 64 + c8 * 8 + j], p1 = a->in[I_HLB][dir * 512 + 256 + head * 64 + c8 * 8 + j]; b = 1.0f / (1.0f + __expf(p0 - p1)); } lb[j] = b; }
    const int fcol = (dir == 0 ? COL_HFF : COL_HFB) + head * 64 + c8 * 8;
    for (int n0 = 0; n0 < R_ALL; n0 += 64) {
        { const int n = n0 + tl; int row;
          if (dir == 0) row = (n < C_CTX) ? S_LAT + n : n - C_CTX; else row = (n < C_CTX) ? S_LAT + (C_CTX - 1 - n) : (S_LAT - 1) - (n - C_CTX);
          const bf16* pr = PROJ + (size_t)row * INW;
          float q[8], f[8], vv[8];
          unpack8(*(const GAS v4u*)(pr + COL_HQ + head * 64 + c8 * 8), q); unpack8(*(const GAS v4u*)(pr + fcol), f); unpack8(*(const GAS v4u*)(pr + COL_HI + head * 64 + c8 * 8), vv);
#pragma unroll
          for (int j = 0; j < 8; ++j) { Qs[tl * 64 + c8 * 8 + j] = silu1(q[j]) * 0.125f; Fs[tl * 64 + c8 * 8 + j] = lb[j] + (1.0f - lb[j]) * sigm1(f[j]); Vs[tl * 64 + c8 * 8 + j] = vv[j]; } }
        __syncthreads();
        for (int t = 0; t < 64; ++t) {
            const float vt = Vs[t * 64 + v]; float po = 0.f;
#pragma unroll
            for (int i = 0; i < 8; ++i) { const float f = Fs[t * 64 + kg * 8 + i], q = Qs[t * 64 + kg * 8 + i]; S[i] = f * S[i] + (1.0f - f) * vt; po += S[i] * q; }
            part[((t & 1) * 8 + kg) * 64 + v] = po;
            __syncthreads();
            if (wave == 0) { float o = 0.f;
#pragma unroll
                for (int w8 = 0; w8 < 8; ++w8) o += part[((t & 1) * 8 + w8) * 64 + v];
                const int n = n0 + t; int row;
                if (dir == 0) row = (n < C_CTX) ? S_LAT + n : n - C_CTX; else row = (n < C_CTX) ? S_LAT + (C_CTX - 1 - n) : (S_LAT - 1) - (n - C_CTX);
                HGO[(size_t)row * 256 + head * 64 + v] = o; }
        }
        __syncthreads();
    }
}

typedef short bf16x8v __attribute__((ext_vector_type(8)));
constexpr int HST = 72;
__device__ __forceinline__ f32x4 mma16(const LAS bf16* MA, const LAS bf16* MBt, int k0, f32x4 c, int lane) {
    const bf16x8v av = *(const LAS bf16x8v*)(MA + (lane & 15) * HST + k0 + 8 * (lane >> 4));
    const bf16x8v bv = *(const LAS bf16x8v*)(MBt + (lane & 15) * HST + k0 + 8 * (lane >> 4));
    return __builtin_amdgcn_mfma_f32_16x16x32_bf16(av, bv, c, 0, 0, 0);
}
__device__ __forceinline__ int hg_base_row(int cpos) { return cpos < 256 ? 64 * cpos : S_LAT + 64 * (cpos - 256); }
__device__ __forceinline__ int hg_scan_idx(int dir, int cpos) { return dir == 0 ? (cpos < 256 ? 4 + cpos : cpos - 256) : (cpos < 256 ? 4 + (255 - cpos) : 3 - (cpos - 256)); }
__device__ __forceinline__ float hg_lb(KA a, int l, int dir, int head, int k) {
    if (l == 0) return 0.f;
    const float p0 = a->in[I_HLB][dir * 512 + head * 64 + k], p1 = a->in[I_HLB][dir * 512 + 256 + head * 64 + k];
    return 1.0f / (1.0f + __expf(p0 - p1));
}
__device__ __forceinline__ void hgrn_stepA(KA a, int l, int cpos, int head, LAS unsigned char* lds, int lane, int wave) {
    const bf16* PROJ = (const bf16*)(a->ws + WS_PROJ);
    const int dir = wave >> 2, I = wave & 3, base = hg_base_row(cpos), ci = hg_scan_idx(dir, cpos);
    LAS float* TOT = (LAS float*)lds;
    LAS bf16* KLT = (LAS bf16*)(lds + 2048) + dir * 64 * HST;
    LAS bf16* VT = (LAS bf16*)(lds + 2048 + 2 * 64 * HST * 2) + dir * 64 * HST;
    const float lb = hg_lb(a, l, dir, head, lane);
    const int fcol = (dir == 0 ? COL_HFF : COL_HFB) + head * 64 + lane, vcol = COL_HI + head * 64 + lane;
    float kk[16], cl[16]; float run = 0.f;
#pragma unroll
    for (int i = 0; i < 16; ++i) { const int n = 16 * I + i, row = base + (dir ? 63 - n : n);
        const float fl = bflo((unsigned)PROJ[(size_t)row * INW + fcol]);
        const unsigned short vb = PROJ[(size_t)row * INW + vcol];
        const float f = lb + (1.0f - lb) * sigm1(fl);
        run += __logf(f); cl[i] = run; kk[i] = 1.0f - f;
        VT[lane * HST + n] = vb; }
    TOT[(dir * 4 + I) * 64 + lane] = run;
    __syncthreads();
    float post = 0.f, all = 0.f;
#pragma unroll
    for (int J = 0; J < 4; ++J) { const float t = TOT[(dir * 4 + J) * 64 + lane]; all += t; if (J > I) post += t; }
#pragma unroll
    for (int i = 0; i < 16; ++i) KLT[lane * HST + 16 * I + i] = (bf16)f2bf(kk[i] * __expf(run - cl[i] + post));
    if (I == 0) ((float*)(a->ws + WS_HDG))[((size_t)(dir * 4 + head) * 260 + ci) * 64 + lane] = __expf(all);
    __syncthreads();
    float* LT = (float*)(a->ws + WS_HLT) + ((size_t)(dir * 4 + head) * 260 + ci) * 4096;
    float z0 = 0.f; asm volatile("" : "+v"(z0));
#pragma unroll
    for (int kb = 0; kb < 4; ++kb) { f32x4 acc = {z0, z0, z0, z0};
        acc = mma16(VT + 16 * I * HST, KLT + 16 * kb * HST, 0, acc, lane); acc = mma16(VT + 16 * I * HST, KLT + 16 * kb * HST, 32, acc, lane);
#pragma unroll
        for (int r = 0; r < 4; ++r) LT[(16 * I + 4 * (lane >> 4) + r) * 64 + 16 * kb + (lane & 15)] = acc[r]; }
    __syncthreads();
}
__device__ __forceinline__ void hgrn_stepB(KA a, int item, int tid) {
    const int dh = item >> 3, vb = item & 7, v = vb * 8 + (tid >> 6), k = tid & 63;
    const float* LT = (const float*)(a->ws + WS_HLT) + (size_t)dh * 260 * 4096 + v * 64 + k;
    const float* DG = (const float*)(a->ws + WS_HDG) + (size_t)dh * 260 * 64 + k;
    bf16* SP = (bf16*)(a->ws + WS_HSP) + (size_t)dh * 260 * 4096 + v * 64 + k;
    float S = 0.f;
#pragma unroll 1
    for (int c0 = 0; c0 < 260; c0 += 26) {
        float lt[26], dg[26];
#pragma unroll
        for (int j = 0; j < 26; ++j) { lt[j] = LT[(size_t)(c0 + j) * 4096]; dg[j] = DG[(c0 + j) * 64]; }
#pragma unroll
        for (int j = 0; j < 26; ++j) { SP[(size_t)(c0 + j) * 4096] = (bf16)f2bf(S); S = dg[j] * S + lt[j]; }
    }
}
__device__ __forceinline__ void hgrn_stepC(KA a, int l, int cpos, int head, LAS unsigned char* lds, int tid, int lane, int wave) {
    const bf16* PROJ = (const bf16*)(a->ws + WS_PROJ); bf16* MIX = (bf16*)(a->ws + WS_MIX);
    const int dir = wave >> 2, I = wave & 3, base = hg_base_row(cpos), ci = hg_scan_idx(dir, cpos);
    constexpr int MSZ = 64 * HST;
    LAS float* TOT = (LAS float*)lds;
    LAS bf16* img = (LAS bf16*)(lds + 2048);
    LAS bf16* QT = img + dir * MSZ;
    LAS bf16* QD = img + 2 * MSZ + dir * MSZ;
    LAS bf16* VT = img + 4 * MSZ + dir * MSZ;
    LAS bf16* ST = img + 6 * MSZ + dir * MSZ;
    LAS bf16* AS = img + 8 * MSZ + dir * MSZ + I * 16 * HST;
    LAS bf16* KT = img + 10 * MSZ + dir * (10 * 16 * HST);
    LAS float* OS = (LAS float*)(img + 10 * MSZ);
    const float lb = hg_lb(a, l, dir, head, lane);
    const int fcol = (dir == 0 ? COL_HFF : COL_HFB) + head * 64 + lane, qcol = COL_HQ + head * 64 + lane, vcol = COL_HI + head * 64 + lane;
    { const bf16* SP = (const bf16*)(a->ws + WS_HSP) + ((size_t)(dir * 4 + head) * 260 + ci) * 4096;
#pragma unroll
      for (int h2 = 0; h2 < 2; ++h2) { const int e = ((I * 2 + h2) * 64 + lane) * 8, vv = e >> 6, kk0 = e & 63;
          *(LAS v4u*)(ST + vv * HST + kk0) = *(const GAS v4u*)(SP + e); } }
    float kk[16], cl[16], qv[16]; float run = 0.f;
#pragma unroll
    for (int i = 0; i < 16; ++i) { const int n = 16 * I + i, row = base + (dir ? 63 - n : n);
        const float fl = bflo((unsigned)PROJ[(size_t)row * INW + fcol]), ql = bflo((unsigned)PROJ[(size_t)row * INW + qcol]);
        const unsigned short vb = PROJ[(size_t)row * INW + vcol];
        const float f = lb + (1.0f - lb) * sigm1(fl);
        run += __logf(f); cl[i] = run; kk[i] = 1.0f - f; qv[i] = silu1(ql) * 0.125f;
        VT[lane * HST + n] = vb; }
    TOT[(dir * 4 + I) * 64 + lane] = run;
    __syncthreads();
    float tj[4];
#pragma unroll
    for (int J = 0; J < 4; ++J) tj[J] = TOT[(dir * 4 + J) * 64 + lane];
    float pre = 0.f;
#pragma unroll
    for (int J = 0; J < 4; ++J) if (J < I) pre += tj[J];
    const float epre = __expf(pre); float kei[16];
#pragma unroll
    for (int i = 0; i < 16; ++i) { const float e = __expf(cl[i]); QT[(16 * I + i) * HST + lane] = (bf16)f2bf(qv[i] * e); QD[(16 * I + i) * HST + lane] = (bf16)f2bf(qv[i] * e * epre); kei[i] = kk[i] * fminf(__builtin_amdgcn_rcpf(e), 5.5e34f); }
    float eoff = 0.f;
#pragma unroll
    for (int I2 = 0; I2 < 4; ++I2) {
        if (I2 >= I) {
            if (I2 == I) eoff = 0.f; else if (I2 == I + 1) eoff = run; else eoff += tj[I2 - 1];
            LAS bf16* blk = KT + (I2 * (I2 + 1) / 2 + I) * 16 * HST;
            const float fo = __expf(eoff);
#pragma unroll
            for (int i = 0; i < 16; ++i) blk[i * HST + lane] = (bf16)f2bf(kei[i] * fo);
        }
    }
    __syncthreads();
    float z0 = 0.f; asm volatile("" : "+v"(z0));
    f32x4 sc[4];
#pragma unroll
    for (int J = 0; J < 4; ++J) { sc[J] = (f32x4){z0, z0, z0, z0};
        if (J <= I) { const LAS bf16* kb = KT + (I * (I + 1) / 2 + J) * 16 * HST;
            sc[J] = mma16(QT + 16 * I * HST, kb, 0, sc[J], lane); sc[J] = mma16(QT + 16 * I * HST, kb, 32, sc[J], lane);
            if (J == I) {
#pragma unroll
                for (int r = 0; r < 4; ++r) if ((lane & 15) > 4 * (lane >> 4) + r) sc[J][r] = z0; } } }
#pragma unroll
    for (int J = 0; J < 4; ++J)
#pragma unroll
        for (int r = 0; r < 4; ++r) AS[(4 * (lane >> 4) + r) * HST + 16 * J + (lane & 15)] = (bf16)f2bf(sc[J][r]);
    asm volatile("s_waitcnt lgkmcnt(0)" ::: "memory");
    f32x4 acc[4];
#pragma unroll
    for (int vb = 0; vb < 4; ++vb) { acc[vb] = (f32x4){z0, z0, z0, z0};
        acc[vb] = mma16(AS, VT + 16 * vb * HST, 0, acc[vb], lane); acc[vb] = mma16(AS, VT + 16 * vb * HST, 32, acc[vb], lane);
        acc[vb] = mma16(QD + 16 * I * HST, ST + 16 * vb * HST, 0, acc[vb], lane); acc[vb] = mma16(QD + 16 * I * HST, ST + 16 * vb * HST, 32, acc[vb], lane); }
    __syncthreads();
#pragma unroll
    for (int vb = 0; vb < 4; ++vb)
#pragma unroll
        for (int r = 0; r < 4; ++r) { const int n = 16 * I + 4 * (lane >> 4) + r, rl = dir ? 63 - n : n; OS[(dir * 64 + rl) * 68 + 16 * vb + (lane & 15)] = acc[vb][r]; }
    __syncthreads();
    { const int rl = tid >> 3, v8 = (tid & 7) * 8, row = base + rl;
      float o[8]; float ss = 0.f;
#pragma unroll
      for (int j = 0; j < 8; ++j) { o[j] = OS[rl * 68 + v8 + j] + OS[(64 + rl) * 68 + v8 + j]; ss += o[j] * o[j]; }
      ss += sx<1>(ss); ss += sx<2>(ss); ss += sx<4>(ss);
      const float rstd = __builtin_amdgcn_rsqf(ss * (1.0f / 64.0f) + EPS);
      float gt[8]; unpack8(*(const GAS v4u*)(PROJ + (size_t)row * INW + COL_HG + head * 64 + v8), gt);
      const float* gn = a->in[I_HGAIN] + l * 64 + v8;
      float y[8];
#pragma unroll
      for (int j = 0; j < 8; ++j) y[j] = o[j] * rstd * gn[j] * silu1(gt[j]);
      v4u w; w.x = pk2(y[0], y[1]); w.y = pk2(y[2], y[3]); w.z = pk2(y[4], y[5]); w.w = pk2(y[6], y[7]);
      *(GAS v4u*)(MIX + (size_t)row * DM + MIX_HG + head * 64 + v8) = w; }
    __syncthreads();
}

__device__ __forceinline__ void vt_item(KA a, int item, int lane) {
    const bf16* PROJ = (const bf16*)(a->ws + WS_PROJ); bf16* VTg = (bf16*)(a->ws + WS_VT);
    const int rb = item >> 1, hk = item & 1, row = rb * 64 + lane;
    const bf16* p = PROJ + (size_t)row * INW + COL_AV + hk * 64;
    unsigned w[32];
#pragma unroll
    for (int c = 0; c < 8; ++c) { const v4u t = *(const GAS v4u*)(p + 8 * c); w[4 * c] = t.x; w[4 * c + 1] = t.y; w[4 * c + 2] = t.z; w[4 * c + 3] = t.w; }
    bf16* o = VTg + (size_t)hk * 64 * R_ALL + row;
#pragma unroll
    for (int d2 = 0; d2 < 32; ++d2) { o[(size_t)(2 * d2) * R_ALL] = (bf16)(w[d2] & 0xffffu); o[(size_t)(2 * d2 + 1) * R_ALL] = (bf16)(w[d2] >> 16); }
}
__device__ __forceinline__ void attn_unit(KA a, int l, int u, LAS unsigned char* lds, int tid, int lane, int wave) {
    asm volatile("" : "+v"(tid), "+v"(lane));
    const bf16* PROJ = (const bf16*)(a->ws + WS_PROJ); const bf16* VTg = (const bf16*)(a->ws + WS_VT); bf16* MIX = (bf16*)(a->ws + WS_MIX);
    const bool isctx = u >= 256; const int uu = isctx ? u - 256 : u; const int n = uu >> 1, hk = uu & 1;
    const int qh = hk * 4 + (wave >> 1), half = wave & 1;
    const int qbase = (isctx ? S_LAT : 0) + n * 128 + half * 64, qpos0 = n * 128 + half * 64;
    const int c = lane & 15, g = lane >> 4;
    LAS bf16* Kt = (LAS bf16*)lds; LAS bf16* Vt = Kt + 64 * HST; LAS bf16* Qw = Vt + 64 * HST + wave * 64 * HST;
#pragma unroll
    for (int j = 0; j < 8; ++j) { const int qr = 8 * j + (lane >> 3), qc = (lane & 7) * 8;
        *(LAS v4u*)(Qw + qr * HST + qc) = *(const GAS v4u*)(PROJ + (size_t)(qbase + qr) * INW + qh * 64 + qc); }
    float z0 = 0.f; asm volatile("" : "+v"(z0));
    f32x4 o[4][4]; float ls[4];
    float gq = 0.f, gk = 0.f;
#pragma unroll 8
    for (int d = 0; d < 64; ++d) { gq = fmaxf(gq, fabsf(a->in[I_QG][l * 64 + d])); gk = fmaxf(gk, fabsf(a->in[I_KG][l * 64 + d])); }
    const float nbnd = -(8.0f * 1.4426950408889634f) * gq * gk;
    const f32x4 nb4 = {nbnd, nbnd, nbnd, nbnd};
    const float sink = a->in[I_SINK][l * 8 + qh] * 1.4426950408889634f;
#pragma unroll
    for (int qt = 0; qt < 4; ++qt) { ls[qt] = (g == 0) ? __builtin_amdgcn_exp2f(sink + nbnd) : z0;
#pragma unroll
        for (int dt = 0; dt < 4; ++dt) o[qt][dt] = (f32x4){z0, z0, z0, z0}; }
    const int first = (!isctx && n == 0) ? 2 : 0, nwin = isctx ? 0 : ((n == 0 || n == 127) ? 4 : 6), nt = nwin + 4;
    const int lr = tid >> 3, lc = (tid & 7) * 8;
    v4u kreg, vreg;
#define ATT_LOADT(i) do { const bool ct_ = (i) >= nwin; const int kb_ = ct_ ? S_LAT + 64 * ((i) - nwin) : (n - 1) * 128 + 64 * (first + (i)); \
        kreg = *(const GAS v4u*)(PROJ + (size_t)(kb_ + lr) * INW + COL_AK + hk * 64 + lc); vreg = *(const GAS v4u*)(VTg + ((size_t)hk * 64 + lr) * R_ALL + kb_ + lc); } while (0)
    ATT_LOADT(0);
#pragma unroll 1
    for (int i = 0; i < nt; ++i) {
        __syncthreads();
        *(LAS v4u*)(Kt + lr * HST + lc) = kreg; *(LAS v4u*)(Vt + lr * HST + lc) = vreg;
        __syncthreads();
        if (i + 1 < nt) ATT_LOADT(i + 1);
        const bool win = i < nwin; const int kb = (n - 1) * 128 + 64 * (first + i);
        const int rel = kb - qpos0;
        const bool maskw = win && (rel == 128 || rel == -128);
        if (win && (rel >= 192 || rel <= -192)) continue;
        bf16x8v kf[4][2], vf[4][2];
#pragma unroll
        for (int kt = 0; kt < 4; ++kt)
#pragma unroll
            for (int ks = 0; ks < 2; ++ks) kf[kt][ks] = *(const LAS bf16x8v*)(Kt + (16 * kt + c) * HST + 32 * ks + 8 * g);
#pragma unroll
        for (int dt = 0; dt < 4; ++dt)
#pragma unroll
            for (int s2 = 0; s2 < 2; ++s2) { const v2u lo = *(const LAS v2u*)(Vt + (16 * dt + c) * HST + 32 * s2 + 4 * g), hi = *(const LAS v2u*)(Vt + (16 * dt + c) * HST + 32 * s2 + 16 + 4 * g);
                const v4u t = {lo.x, lo.y, hi.x, hi.y}; vf[dt][s2] = __builtin_bit_cast(bf16x8v, t); }
        f32x4 sA[4], sB[4];
#define ATT_SCORES(QT, S_) do { const bf16x8v q0_ = *(const LAS bf16x8v*)(Qw + (16 * (QT) + c) * HST + 8 * g), q1_ = *(const LAS bf16x8v*)(Qw + (16 * (QT) + c) * HST + 32 + 8 * g); \
            _Pragma("unroll") for (int kt = 0; kt < 4; ++kt) { S_[kt] = __builtin_amdgcn_mfma_f32_16x16x32_bf16(kf[kt][0], q0_, nb4, 0, 0, 0); S_[kt] = __builtin_amdgcn_mfma_f32_16x16x32_bf16(kf[kt][1], q1_, S_[kt], 0, 0, 0); } } while (0)
#define ATT_REST(QT, S_) do { \
            if (maskw) { const int dq = qpos0 + 16 * (QT) + c - kb - 4 * g; \
                _Pragma("unroll") for (int kt = 0; kt < 4; ++kt) _Pragma("unroll") for (int r = 0; r < 4; ++r) { const int dl = dq - 16 * kt - r; if (dl > 128 || dl < -128) S_[kt][r] = -INFINITY; } } \
            float ps = 0.f; \
            _Pragma("unroll") for (int kt = 0; kt < 4; ++kt) _Pragma("unroll") for (int r = 0; r < 4; ++r) { S_[kt][r] = __builtin_amdgcn_exp2f(S_[kt][r]); ps += S_[kt][r]; } \
            ls[QT] += ps; \
            bf16x8v pb[2]; \
            _Pragma("unroll") for (int s2 = 0; s2 < 2; ++s2) { const v4u t = {pk2(S_[2 * s2][0], S_[2 * s2][1]), pk2(S_[2 * s2][2], S_[2 * s2][3]), pk2(S_[2 * s2 + 1][0], S_[2 * s2 + 1][1]), pk2(S_[2 * s2 + 1][2], S_[2 * s2 + 1][3])}; pb[s2] = __builtin_bit_cast(bf16x8v, t); } \
            _Pragma("unroll") for (int dt = 0; dt < 4; ++dt) { o[QT][dt] = __builtin_amdgcn_mfma_f32_16x16x32_bf16(vf[dt][0], pb[0], o[QT][dt], 0, 0, 0); o[QT][dt] = __builtin_amdgcn_mfma_f32_16x16x32_bf16(vf[dt][1], pb[1], o[QT][dt], 0, 0, 0); } } while (0)
        ATT_SCORES(0, sA);
        ATT_SCORES(1, sB); ATT_REST(0, sA);
        ATT_SCORES(2, sA); ATT_REST(1, sB);
        ATT_SCORES(3, sB); ATT_REST(2, sA);
        ATT_REST(3, sB);
#undef ATT_SCORES
#undef ATT_REST
    }
#undef ATT_LOADT
    int c2 = lane & 15, g2 = lane >> 4; asm volatile("" : "+v"(c2), "+v"(g2));
#pragma unroll
    for (int qt = 0; qt < 4; ++qt) { float lt = ls[qt]; lt += sx<16>(lt); lt = sx32_add(lt); const float inv = 1.0f / lt;
        bf16* op = (bf16*)(a->ws + WS_MIX) + (size_t)(qbase + 16 * qt + c2) * DM + MIX_AT + qh * 64 + 4 * g2;
#pragma unroll
        for (int dt = 0; dt < 4; ++dt) { v2u w; w.x = pk2(o[qt][dt][0] * inv, o[qt][dt][1] * inv); w.y = pk2(o[qt][dt][2] * inv, o[qt][dt][3] * inv); *(GAS v2u*)(op + 16 * dt) = w; } }
}

constexpr int GST = 136;
__device__ __forceinline__ f32x4 mma16g(const LAS bf16* MA, const LAS bf16* MBt, int k0, f32x4 c, int lane) {
    const bf16x8v av = *(const LAS bf16x8v*)(MA + (lane & 15) * GST + k0 + 8 * (lane >> 4));
    const bf16x8v bv = *(const LAS bf16x8v*)(MBt + (lane & 15) * GST + k0 + 8 * (lane >> 4));
    return __builtin_amdgcn_mfma_f32_16x16x32_bf16(av, bv, c, 0, 0, 0);
}
__device__ __forceinline__ float gelu_as(float v) {
    const float av = fabsf(v), t = __builtin_amdgcn_rcpf(av * 0.2316418882f + 1.0f);
    float q = t * 0.5307027145f + (-0.7265760135f); q = q * t + 0.7107068705f; q = q * t + (-0.142248368f); q = q * t + 0.127414796f; q = q * t;
    const float e = __builtin_amdgcn_exp2f((v * v) * (-0.72134752044f)), mm = v * (q * e);
    return v < 0.f ? mm : v - mm;
}
__device__ __forceinline__ void gmlp_unit_mma(KA a, int l, int chunk, int g, LAS unsigned char* lds, int tid, int lane, int wave) {
    const bf16* PROJ = (const bf16*)(a->ws + WS_PROJ); bf16* MIX = (bf16*)(a->ws + WS_MIX);
    const int row0 = (chunk < 128) ? chunk * 128 : S_LAT + (chunk - 128) * 128;
    LAS bf16* WA = (LAS bf16*)lds;
    LAS bf16* VNT = WA + 128 * GST;
    LAS float* OUT = (LAS float*)(VNT + 64 * GST);
    const int pos = tid >> 2, part = tid & 3;
    {
      const float* W = a->in[I_GWS] + ((size_t)(l * 4 + g) * 128 + pos) * 128 + part * 32;
#pragma unroll
      for (int j = 0; j < 4; ++j) { const f32x4 w0 = *(const GAS f32x4*)(W + 8 * j), w1 = *(const GAS f32x4*)(W + 8 * j + 4);
          v4u o; o.x = pk2(w0.x, w0.y); o.y = pk2(w0.z, w0.w); o.z = pk2(w1.x, w1.y); o.w = pk2(w1.z, w1.w);
          *(LAS v4u*)(WA + pos * GST + part * 32 + 8 * j) = o; } }
    { const bf16* p = PROJ + (size_t)(row0 + pos) * INW + COL_GV + g * 64 + part * 16;
      float x[16]; unpack8(*(const GAS v4u*)p, x); unpack8(*(const GAS v4u*)(p + 8), x + 8);
      float ss = 0.f;
#pragma unroll
      for (int d = 0; d < 16; ++d) { x[d] = gelu_as(x[d]); ss += x[d] * x[d]; }
      ss += sx<1>(ss); ss += sx<2>(ss);
      const float rstd = __builtin_amdgcn_rsqf(ss * (1.0f / 64.0f) + EPS);
      const float* gn = a->in[I_GNG] + l * 256 + g * 64 + part * 16;
#pragma unroll
      for (int d = 0; d < 16; ++d) VNT[(part * 16 + d) * GST + pos] = (bf16)f2bf(x[d] * rstd * gn[d]); }
    __syncthreads();
    float z0 = 0.f; asm volatile("" : "+v"(z0));
#pragma unroll
    for (int cb = 0; cb < 4; ++cb) { f32x4 acc = {z0, z0, z0, z0};
#pragma unroll
        for (int ks = 0; ks < 4; ++ks) acc = mma16g(WA + 16 * wave * GST, VNT + 16 * cb * GST, 32 * ks, acc, lane);
#pragma unroll
        for (int r = 0; r < 4; ++r) OUT[(16 * wave + 4 * (lane >> 4) + r) * 68 + 16 * cb + (lane & 15)] = acc[r]; }
    __syncthreads();
    { const int row = row0 + pos; const float bsv = a->in[I_GBS][(l * 4 + g) * 128 + pos];
      const bf16* pu = PROJ + (size_t)row * INW + COL_GU + g * 64 + part * 16;
      float u[16]; unpack8(*(const GAS v4u*)pu, u); unpack8(*(const GAS v4u*)(pu + 8), u + 8);
      float y[16];
#pragma unroll
      for (int d = 0; d < 16; ++d) y[d] = gelu_as(u[d]) * (OUT[pos * 68 + part * 16 + d] + bsv);
      bf16* po = MIX + (size_t)row * DM + MIX_GM + g * 64 + part * 16;
      v4u w; w.x = pk2(y[0], y[1]); w.y = pk2(y[2], y[3]); w.z = pk2(y[4], y[5]); w.w = pk2(y[6], y[7]); *(GAS v4u*)po = w;
      w.x = pk2(y[8], y[9]); w.y = pk2(y[10], y[11]); w.z = pk2(y[12], y[13]); w.w = pk2(y[14], y[15]); *(GAS v4u*)(po + 8) = w; }
    __syncthreads();
}
__device__ __forceinline__ void attn_naive(KA a, int l, int nrows, int lane, int wave, int G, int bid) {
    const bf16* PROJ = (const bf16*)(a->ws + WS_PROJ); bf16* MIX = (bf16*)(a->ws + WS_MIX);
    const int gw = bid * NWAVES + wave, NGW = G * NWAVES;
    for (int pair = gw; pair < nrows * 2; pair += NGW) {
        const int row = pair >> 1, hk = pair & 1; const bool isctx = row >= S_LAT;
        float q[4], o[4], m[4], ls[4];
#pragma unroll
        for (int g = 0; g < 4; ++g) { q[g] = bflo((unsigned)PROJ[(size_t)row * INW + (hk * 4 + g) * 64 + lane]); o[g] = 0.f; ls[g] = 1.0f; m[g] = a->in[I_SINK][l * 8 + hk * 4 + g] * 1.4426950408889634f; }
        int j0 = 0, j1 = -1;
        if (!isctx) { j0 = row - 128 < 0 ? 0 : row - 128; j1 = row + 128 > S_LAT - 1 ? S_LAT - 1 : row + 128; }
        const int nwin = j1 - j0 + 1;
        const int nk = nwin + C_CTX;
#pragma unroll 4
        for (int t = 0; t < nk; ++t) {
            const int krow = (t < nwin) ? j0 + t : S_LAT + (t - nwin);
            const float k = bflo((unsigned)PROJ[(size_t)krow * INW + COL_AK + hk * 64 + lane]);
            const float v = bflo((unsigned)PROJ[(size_t)krow * INW + COL_AV + hk * 64 + lane]);
#pragma unroll
            for (int g = 0; g < 4; ++g) { const float s = wave_sum(q[g] * k); const float mn = fmaxf(m[g], s);
                const float c = __builtin_amdgcn_exp2f(m[g] - mn), p = __builtin_amdgcn_exp2f(s - mn);
                ls[g] = ls[g] * c + p; o[g] = o[g] * c + p * v; m[g] = mn; }
        }
#pragma unroll
        for (int g = 0; g < 4; ++g) MIX[(size_t)row * DM + MIX_AT + (hk * 4 + g) * 64 + lane] = (bf16)f2bf(o[g] / ls[g]);
    }
}
__device__ __forceinline__ void hgrn_combine(KA a, int l, int nrows, int lane, int wave, int G, int bid) {
    const bf16* PROJ = (const bf16*)(a->ws + WS_PROJ); bf16* MIX = (bf16*)(a->ws + WS_MIX);
    const float* O0 = (const float*)(a->ws + WS_HGO); const float* O1 = O0 + (size_t)R_ALL * 256;
    const f32x4 gn = *(const f32x4*)(a->in[I_HGAIN] + l * 64 + (lane & 15) * 4);
    const int gw = bid * NWAVES + wave, NGW = G * NWAVES;
    for (int r = gw; r < nrows; r += NGW) {
        const f32x4 o = *(const GAS f32x4*)(O0 + (size_t)r * 256 + 4 * lane) + *(const GAS f32x4*)(O1 + (size_t)r * 256 + 4 * lane);
        float ss = (o.x * o.x + o.y * o.y) + (o.z * o.z + o.w * o.w);
        ss += sx<1>(ss); ss += sx<2>(ss); ss += sx<4>(ss); ss += sx<8>(ss);
        const float rstd = __builtin_amdgcn_rsqf(ss * (1.0f / 64.0f) + EPS);
        const v2u gw2 = *(const GAS v2u*)(PROJ + (size_t)r * INW + COL_HG + 4 * lane);
        const float g0 = bflo(gw2.x), g1 = bfhi(gw2.x), g2 = bflo(gw2.y), g3 = bfhi(gw2.y);
        v2u w; w.x = pk2(o.x * rstd * gn.x * silu1(g0), o.y * rstd * gn.y * silu1(g1)); w.y = pk2(o.z * rstd * gn.z * silu1(g2), o.w * rstd * gn.w * silu1(g3));
        *(GAS v2u*)(MIX + (size_t)r * DM + MIX_HG + 4 * lane) = w;
    }
}
__device__ __forceinline__ void moe_gather(KA a, LAS unsigned char* lds, int tid, int lane, int wave, int G, int bid) {
    LAS int* sb = (LAS int*)lds;
    const unsigned* cnt = (const unsigned*)(a->ws + WS_CTL) + CW_MOECNT;
    int* mi = (int*)(a->ws + WS_VEC) + VO_MOE;
    if (tid < 8) sb[16 + tid] = (int)__hip_atomic_load(cnt + 64 * tid, RLX_AGENT);
    __syncthreads();
    if (tid == 0) { int b = 0;
#pragma unroll
        for (int e = 0; e < 8; ++e) { sb[e] = b; b += ((sb[16 + e] + 255) >> 8) << 8; }
        sb[8] = b; }
    __syncthreads();
    if (bid == 0) {
        if (tid == 0) mi[0] = sb[8] >> 8;
        if (tid < 8) mi[160 + tid] = sb[tid + 1] >> 8;
        for (int t = tid; t < (sb[8] >> 8); t += NTHR) { int e = 0;
#pragma unroll
            for (int j = 1; j < 8; ++j) e += (t >= (sb[j] >> 8)) ? 1 : 0;
            mi[16 + t] = e; } }
    const unsigned char* H8 = (const unsigned char*)(a->ws + WS_H2B); unsigned char* AS = (unsigned char*)(a->ws + WS_AS);
    const int* tokinfo = (const int*)(a->ws + WS_TOK); int* tokslot = (int*)(a->ws + WS_TOK) + S_LAT * 8;
    const int gw = bid * NWAVES + wave, NGW = G * NWAVES;
    for (int t = gw; t < S_LAT; t += NGW) {
        const int* ti = tokinfo + (size_t)t * 8;
        const int e1 = ti[0], e2 = ti[1], r1 = ti[2], r2 = ti[3];
        const int s1 = sb[e1] + r1, s2 = sb[e2] + r2;
        const v4u x0 = ((const GAS v4u*)(H8 + (size_t)t * DM))[lane];
        ((GAS v4u*)(AS + (size_t)s1 * DM))[lane] = x0; ((GAS v4u*)(AS + (size_t)s2 * DM))[lane] = x0;
        if (lane == 0) { int* ts = tokslot + (size_t)t * 4; ts[0] = s1; ts[1] = s2; ts[2] = ti[4]; ts[3] = ti[5]; }
    }
    { const f32x4 z4 = {0.f, 0.f, 0.f, 0.f}; for (int i = bid * NTHR + tid; i < 8 * 256 * DM / 4; i += G * NTHR) ((GAS f32x4*)(a->ws + WS_YF))[i] = z4; }
    for (int e = 0; e < 8; ++e) { const int c = sb[16 + e], pe = (c + 255) & ~255, b = sb[e];
        for (int j = c + gw; j < pe; j += NGW) { const v4u z = {0u, 0u, 0u, 0u}; ((GAS v4u*)(AS + (size_t)(b + j) * DM))[lane] = z; } }
}
__device__ __forceinline__ void moe_combine(KA a, int lane, int wave, int G, int bid) {
    const float* gf = (const float*)(a->ws + WS_VEC) + VO_MOD + (1 * 2 + 0) * 6144 + 5 * 1024;
    const bf16* Y = (const bf16*)(a->ws + WS_Y); const int* tokslot = (const int*)(a->ws + WS_TOK) + S_LAT * 8;
    const int gw = bid * NWAVES + wave, NGW = G * NWAVES;
    for (int t = gw; t < S_LAT; t += NGW) {
        const int* ts = tokslot + (size_t)t * 4; const int s1 = ts[0], s2 = ts[1]; const float w1 = __builtin_bit_cast(float, ts[2]), w2 = __builtin_bit_cast(float, ts[3]);
        GAS f32x4* xr = (GAS f32x4*)(a->out + (size_t)t * DM) + lane; const GAS v2u* xbr = (const GAS v2u*)((const bf16*)(a->ws + WS_XB) + (size_t)t * DM) + lane;
        const float* YF = (const float*)(a->ws + WS_YF);
#pragma unroll
        for (int j = 0; j < 4; ++j) { const f32x4 g = *(const f32x4*)(gf + 4 * lane + 256 * j); const v2u xt = xbr[64 * j]; f32x4 x = (f32x4){bflo(xt.x), bfhi(xt.x), bflo(xt.y), bfhi(xt.y)}; f32x4 p, q;
            if (s1 < 32768) { const v2u t = ((const GAS v2u*)(Y + (size_t)s1 * DM) + lane)[64 * j]; p = (f32x4){bflo(t.x), bfhi(t.x), bflo(t.y), bfhi(t.y)}; } else p = ((const GAS f32x4*)(YF + (size_t)(s1 - 32768) * DM) + lane)[64 * j];
            if (s2 < 32768) { const v2u t = ((const GAS v2u*)(Y + (size_t)s2 * DM) + lane)[64 * j]; q = (f32x4){bflo(t.x), bfhi(t.x), bflo(t.y), bfhi(t.y)}; } else q = ((const GAS f32x4*)(YF + (size_t)(s2 - 32768) * DM) + lane)[64 * j];
            x = x + g * (p * w1 + q * w2);
            xr[64 * j] = x; }
    }
}

#define IN(k) (lo <= (k) && (k) < hi)
#define GRIDBAR() do { XcdBarrier b2_; b2_.bar = (unsigned*)(KARGS()->ws + WS_CTL) + CW_BAR; b2_.x = xb_xcc_id(); b2_.st = (volatile LAS unsigned*)(lds + MISC_OFF) + 8; xcd_barrier(b2_, wv0 * 64 + (int)__builtin_amdgcn_mbcnt_hi(~0u, __builtin_amdgcn_mbcnt_lo(~0u, 0u))); } while (0)
#define SEAM(k) do { if (IN(k) && IN((k) + 1)) GRIDBAR(); } while (0)
#define PHASE_ROOTS() KA a = KARGS(); unsigned char* ws = a->ws; const float* vec = (const float*)(ws + WS_VEC); (void)vec; int bid = blockIdx.x, G = gridDim.x; asm volatile("" : "+s"(bid), "+s"(G)); int tid = wv0 * 64 + (int)__builtin_amdgcn_mbcnt_hi(~0u, __builtin_amdgcn_mbcnt_lo(~0u, 0u)); asm volatile("" : "+v"(tid)); const int lane = tid & 63, wave = __builtin_amdgcn_readfirstlane(tid >> 6); (void)lane; (void)wave

template <int l> __device__ __forceinline__ void layer_body(const int lo, const int hi, LAS unsigned char* lds, const int wv0) {
        const int pb = 1 + 11 * l;
        if (IN(pb + 0)) { PHASE_ROOTS(); phase_norm(a, l, 0, R_ALL, (bf16*)(ws + WS_H), lane, wave, G, bid); SEAM(pb + 0); }
        if (IN(pb + 1)) {
            PHASE_ROOTS();
            pg8::Gemm g{(const pg8::bf16_t*)(ws + WS_H), (const pg8::bf16_t*)(ws + WS_WIN) + (size_t)l * INW * DM, R_ALL, INW, DM, 0, DM};
            pg8::StaticOrder S; S.init(R_ALL, INW, G, bid);
            pg8::EpiBf16<0> E{(pg8::bf16_t*)(ws + WS_PROJ), INW, nullptr, 0, 0, 1.f};
            pg8::gemm_phase<pg8::EpiBf16<0>, pg8::StaticOrder, true, true>(lds, g, S, E, tid);
            moe_conv_range(a, l == 0 ? MOE_SL0 : MOE_SL2, l == 0 ? MOE_SL1 : MOE_SL3, 650 - 2 * 256, lds, lane, wave, G, bid);
            SEAM(pb + 1);
        }
        if (IN(pb + 2)) {
            PHASE_ROOTS();
            qk_prep(a, l, bid * NTHR + tid, G * NTHR);
            for (int it = bid * NWAVES + wave; it < 520; it += G * NWAVES) vt_item(a, it, lane);
            for (int it = bid; it < 1040; it += G) hgrn_stepA(a, l, it >> 2, it & 3, lds, lane, wave);
            { __syncthreads(); moe_conv_range(a, l == 0 ? MOE_SL3 : MOE_SL7, l == 0 ? MOE_SL4 : MOE_DEFER, 1040 - 4 * 256, lds, lane, wave, G, bid); }
            SEAM(pb + 2);
        }
        if (IN(pb + 3)) {
            PHASE_ROOTS();
            if (bid < 64) hgrn_stepB(a, bid, tid);
            {
                const int nu = (l == 0) ? 260 : 256, ng = (l == 0) ? 520 : 512;
                unsigned* qctr = (unsigned*)(ws + WS_CTL) + CW_QUEUE + 64 * l;
                volatile LAS unsigned* qslot = (volatile LAS unsigned*)(lds + MISC_OFF) + 16;
                for (;;) {
                    __syncthreads();
                    if (tid == 0) qslot[0] = __hip_atomic_fetch_add(qctr, 1u, RLX_AGENT);
                    __syncthreads();
                    const int it = __builtin_amdgcn_readfirstlane((int)qslot[0]);
                    if (it >= nu + ng) break;
                    if (it < nu) attn_unit(a, l, it, lds, tid, lane, wave);
                    else gmlp_unit_mma(a, l, (it - nu) >> 2, (it - nu) & 3, lds, tid, lane, wave);
                }
            }
            SEAM(pb + 3);
        }
        if (IN(pb + 4)) {
            PHASE_ROOTS();
            const int nit = (l == 0) ? 1040 : 1024;
            for (int it = bid; it < nit; it += G) hgrn_stepC(a, l, it >> 2, it & 3, lds, tid, lane, wave);
            if (l == 0) { __syncthreads(); moe_conv_range(a, MOE_SL4, MOE_SL5, 1040 - 4 * 256, lds, lane, wave, G, bid); }
            SEAM(pb + 4);
        }
        if (IN(pb + 5)) {
            PHASE_ROOTS();
            const float* modl = vec + VO_MOD + (l * 2 + 0) * 6144; const float* modc = vec + VO_MOD + (l * 2 + 1) * 6144;
            const int M = S_LAT;
            pg8::Gemm g{(const pg8::bf16_t*)(ws + WS_MIX), (const pg8::bf16_t*)(ws + WS_WOUT) + (size_t)l * DM * DM, M, DM, DM, 0, DM};
            pg8::StaticOrder S; S.init(M, DM, G, bid);
            if (l == 0) { pg8::EpiResidB<false> E{a->in[I_X], (pg8::bf16_t*)(ws + WS_XB), modl + 2048, DM};
                pg8::gemm_phase<pg8::EpiResidB<false>, pg8::StaticOrder, true, true>(lds, g, S, E, tid); }
            else { pg8::EpiResidB<true> E{ws + WS_XB, (pg8::bf16_t*)(ws + WS_XB), modl + 2048, DM};
                pg8::gemm_phase<pg8::EpiResidB<true>, pg8::StaticOrder, true, true>(lds, g, S, E, tid); }
            if (l == 0) {
                pg8::Gemm g2{(const pg8::bf16_t*)(ws + WS_MIX), (const pg8::bf16_t*)(ws + WS_WOUT), R_ALL, DM, 256, 0, DM};
                pg8::SplitKOrder S2{S_LAT / 256, 4, 4, 256, 16, bid, nullptr};
                pg8::EpiPart E2{(float*)(ws + WS_PART1), modc + 2048, S_LAT / 256, 256, DM};
                pg8::gemm_phase<pg8::EpiPart, pg8::SplitKOrder, false, true>(lds, g2, S2, E2, tid);
                moe_conv_range(a, MOE_SL5, MOE_SL6, 16, lds, lane, wave, G, bid);
            }
            SEAM(pb + 5);
        }
        if (l == 0) {
            if (IN(pb + 6)) { PHASE_ROOTS(); phase_norm(a, l, 1, R_ALL, (bf16*)(ws + WS_H), lane, wave, G, bid); SEAM(pb + 6); }
            if (IN(pb + 7)) {
                PHASE_ROOTS();
                pg8::Gemm g{(const pg8::bf16_t*)(ws + WS_H), (const pg8::bf16_t*)(ws + WS_WGU), R_ALL, 2 * FFN, DM, 0, DM};
                pg8::StaticOrder S; S.init(R_ALL, 2 * FFN, G, bid);
                pg8::EpiSwiGLU E{(pg8::bf16_t*)(ws + WS_HID), FFN, 1.0f};
                pg8::gemm_phase<pg8::EpiSwiGLU, pg8::StaticOrder, true, true>(lds, g, S, E, tid);
                moe_conv_range(a, MOE_SL1, MOE_SL2, 1430 - 5 * 256, lds, lane, wave, G, bid);
                SEAM(pb + 7);
            }
            if (IN(pb + 8)) {
                PHASE_ROOTS();
                const float* modl = vec + VO_MOD + (l * 2 + 0) * 6144; const float* modc = vec + VO_MOD + (l * 2 + 1) * 6144;
                pg8::Gemm g{(const pg8::bf16_t*)(ws + WS_HID), (const pg8::bf16_t*)(ws + WS_WD), S_LAT, DM, FFN, 0, FFN};
                pg8::StaticOrder S; S.init(S_LAT, DM, G, bid);
                pg8::EpiResidB<true> E{ws + WS_XB, (pg8::bf16_t*)(ws + WS_XB), modl + 5120, DM};
                pg8::gemm_phase<pg8::EpiResidB<true>, pg8::StaticOrder, true, true>(lds, g, S, E, tid);
                {
                    pg8::Gemm g2{(const pg8::bf16_t*)(ws + WS_HID), (const pg8::bf16_t*)(ws + WS_WD), R_ALL, DM, 256, 0, FFN};
                    pg8::SplitKOrder S2{S_LAT / 256, 4, 11, 256, 44, bid, nullptr};
                    pg8::EpiPart E2{(float*)(ws + WS_PART2), modc + 5120, S_LAT / 256, 256, DM};
                    pg8::gemm_phase<pg8::EpiPart, pg8::SplitKOrder, false, true>(lds, g2, S2, E2, tid);
                    moe_conv_range(a, MOE_SL6, MOE_SL7, 44, lds, lane, wave, G, bid);
                }
                if (IN(pb + 8) && IN(pb + 11)) GRIDBAR();
            }
        } else {
            if (IN(pb + 6)) { PHASE_ROOTS(); phase_norm_route(a, lds, tid, lane, wave, G, bid); SEAM(pb + 6); }
            if (IN(pb + 7)) { PHASE_ROOTS(); moe_gather(a, lds, tid, lane, wave, G, bid); SEAM(pb + 7); }
            if (IN(pb + 8)) {
                PHASE_ROOTS();
                const int* mi = (const int*)(ws + WS_VEC) + VO_MOE; const int nt = __builtin_amdgcn_readfirstlane(mi[0]);
                pg8::Gemm g{(const pg8::bf16_t*)(ws + WS_AS), (const pg8::bf16_t*)(ws + WS_MGU), nt * 256, 2 * EXD, DM / 2, (size_t)2 * EXD * DM, DM / 2};
                pg8::MoeOrder S; S.init(nt * 256, 2 * EXD, G, bid); S.load_bases(mi + 160);
                pg8::EpiSwiGLU8 E{(unsigned char*)(ws + WS_HIDM), EXD, 1.0f / (F8_WSCALE * F8_ASCALE), F8_HSCALE};
                pg8::gemm_phase<pg8::EpiSwiGLU8, pg8::MoeOrder, true, true, true>(lds, g, S, E, tid);
                SEAM(pb + 8);
            }
            if (IN(pb + 9)) {
                PHASE_ROOTS();
                const int* mi = (const int*)(ws + WS_VEC) + VO_MOE; const int nt = __builtin_amdgcn_readfirstlane(mi[0]); const int nm = nt < 128 ? nt : 128;
                pg8::Gemm g{(const pg8::bf16_t*)(ws + WS_HIDM), (const pg8::bf16_t*)(ws + WS_MD), nm * 256, DM, EXD / 2, (size_t)DM * EXD, EXD / 2};
                pg8::MoeOrder S; S.init(nm * 256, DM, G, bid); S.load_bases(mi + 160);
                pg8::EpiScaleBf16 E{(pg8::bf16_t*)(ws + WS_Y), DM, 1.0f / (F8_WSCALE * F8_HSCALE)};
                pg8::gemm_phase<pg8::EpiScaleBf16, pg8::MoeOrder, true, true, true>(lds, g, S, E, tid);
                if (nt > 128) {
                    pg8::Gemm g2{(const pg8::bf16_t*)(ws + WS_HIDM), (const pg8::bf16_t*)(ws + WS_MD), nt * 256, DM, 256, (size_t)DM * EXD, EXD / 2};
                    pg8::SplitKOrder S2{128, 4, 7, 256, (nt - 128) * 28, bid, mi + 16};
                    pg8::EpiAtomic E2{(float*)(ws + WS_YF), nullptr, 128, DM, 1.0f / (F8_WSCALE * F8_HSCALE)};
                    pg8::gemm_phase<pg8::EpiAtomic, pg8::SplitKOrder, false, true, true>(lds, g2, S2, E2, tid);
                }
                SEAM(pb + 9);
            }
            if (IN(pb + 10)) { PHASE_ROOTS(); moe_combine(a, lane, wave, G, bid); }
        }
    }
__global__ void __launch_bounds__(NTHR, 2) fwd_kernel(Args a_unused) {
    extern __shared__ __attribute__((aligned(16))) unsigned char lds_raw[];
    LAS unsigned char* lds = (LAS unsigned char*)lds_raw;
    const int tid0 = threadIdx.x;
    const int wv0 = __builtin_amdgcn_readfirstlane(tid0 >> 6);
    for (int u = tid0; u < (LDS_BYTES - LDSCTL_OFF) / 4; u += NTHR) ((LAS unsigned*)(lds + LDSCTL_OFF))[u] = 0u;
    __syncthreads();
    const int lo = KARGS()->ph_lo, hi = KARGS()->ph_hi;
    const bool fusedl = (hi - lo) > 1;
    if (fusedl) (void)xcd_barrier_post((unsigned*)(KARGS()->ws + WS_CTL) + CW_BAR, (volatile LAS unsigned*)(lds + MISC_OFF) + 8);
    if (IN(0)) { PHASE_ROOTS(); p0_prologue(a, lds, tid, lane, wave, G, bid); SEAM(0); }

    layer_body<0>(lo, hi, lds, wv0);
    layer_body<1>(lo, hi, lds, wv0);
}

extern "C" void kernel_launch(void* const* d_in, const int* in_sizes, int n_in, void* d_out, int out_size, void* d_ws, size_t ws_size, hipStream_t stream) {
    static int grid = 0;
    if (grid == 0) {
        if (n_in != 23 || in_sizes[0] != S_LAT * DM || out_size != S_LAT * DM || ws_size < WS_END) { fprintf(stderr, "kernel_launch: unexpected shapes / workspace (n_in %d, ws %zu, need %zu)\n", n_in, ws_size, (size_t)WS_END); grid = -1; return; }
        int dev = 0, cus = 0;
        if (hipGetDevice(&dev) != hipSuccess || hipDeviceGetAttribute(&cus, hipDeviceAttributeMultiprocessorCount, dev) != hipSuccess) { grid = -1; return; }
        if (hipFuncSetAttribute((const void*)fwd_kernel, hipFuncAttributeMaxDynamicSharedMemorySize, LDS_BYTES) != hipSuccess) { grid = -1; return; }
        int per_cu = 0;
        (void)hipOccupancyMaxActiveBlocksPerMultiprocessor(&per_cu, (const void*)fwd_kernel, NTHR, LDS_BYTES);
        (void)hipGetLastError();
        grid = cus;
    }
    if (grid < 0) return;
    if (hipMemsetAsync((char*)d_ws + WS_CTL, 0, CTL_ZERO_BYTES, stream) != hipSuccess) return;
    Args a{};
    for (int i = 0; i < 23; ++i) a.in[i] = (const float*)d_in[i];
    a.out = (float*)d_out; a.ws = (unsigned char*)d_ws;
#if ONE_LAUNCH
    a.ph_lo = 0; a.ph_hi = NPH;
    hipLaunchKernelGGL(fwd_kernel, dim3(grid), dim3(NTHR), LDS_BYTES, stream, a);
#else
    for (int p = 0; p < NPH; ++p) {
        if (p == 10 || p == 11) continue;
        a.ph_lo = p; a.ph_hi = p + 1;
        hipLaunchKernelGGL(fwd_kernel, dim3(grid), dim3(NTHR), LDS_BYTES, stream, a);
    }
#endif
}
```

```cpp
#include <hip/hip_runtime.h>
#include <cstdio>
#include <cstdint>
#include <cmath>
#ifndef ONE_LAUNCH
#define ONE_LAUNCH 1
#endif
namespace pg8 {
#define PG8_LAS __attribute__((address_space(3)))
typedef unsigned short bf16_t;
typedef short bf16x8 __attribute__((ext_vector_type(8)));
typedef float f32x4 __attribute__((ext_vector_type(4)));
typedef unsigned u32x4 __attribute__((ext_vector_type(4)));
constexpr int BM = 256, BK = 64, HALF = 128, HTB = HALF * BK * 2  , STAGE_BYTES = 8 * HTB, NXCD = 8, WGM = 8;

__host__ __device__ __forceinline__ int lds_byte(int r, int c) { const int st = (r >> 4) * 2 + (c >> 5), rr = r & 15, cc = c & 31, ob = rr * 64 + cc * 2; return st * 1024 + (ob ^ (((ob >> 9) & 1) << 5)); }
__host__ __device__ __forceinline__ void stage_rc(int b, int& R, int& C) { const int st = b / 1024, sb = b % 1024, swz = sb ^ (((sb >> 9) & 1) << 5); R = (st >> 1) * 16 + swz / 64; C = (st & 1) * 32 + (swz % 64) / 2; }
__host__ __device__ __forceinline__ int perm32(int rho) { const int n = rho >> 4, i = rho & 15; return 8 * (i >> 2) + 4 * n + (i & 3); }

struct Unit { int pm, pn, eb, ko; };
struct Gemm { const bf16_t* A; const bf16_t* Bt; int M, N, K; size_t bstride; int ld; };

struct StaticOrder {
    int nM, nN, nwg, G, c;
    __host__ __device__ void init(int M, int N, int G_, int c_) { nM = M / BM; nN = N / BM; nwg = nM * nN; G = G_; c = c_; }
    __host__ __device__ bool next(int i, Unit& u) const {
        const long L = (long)i * G + c; if (L >= nwg) return false;
        int wgid = (int)L; { const int q = nwg / NXCD, r = nwg % NXCD, xcd = wgid % NXCD, off = wgid / NXCD; wgid = (xcd < r ? xcd * (q + 1) : r * (q + 1) + (xcd - r) * q) + off; }
        const int nig = WGM * nN, gid = wgid / nig, fm = gid * WGM, gsz = (nM - fm) < WGM ? (nM - fm) : WGM;
        u.pm = fm + ((wgid % nig) % gsz); u.pn = (wgid % nig) / gsz; u.eb = 0; u.ko = 0; return true;
    }
    __device__ __forceinline__ void a_ready(const Unit&) const {}
    __device__ __forceinline__ void done(const Unit&) const {}
};

__device__ __forceinline__ unsigned cvt_pk_bf16(float lo, float hi) { unsigned r; asm volatile("v_cvt_pk_bf16_f32 %0, %1, %2" : "=v"(r) : "v"(lo), "v"(hi)); return r; }
typedef float f32x2 __attribute__((ext_vector_type(2)));
__device__ __forceinline__ f32x2 gelu_pk(f32x2 v) {
    const f32x2 av = __builtin_elementwise_abs(v), d = av * 0.2316418882f + 1.0f;
    f32x2 t; t.x = __builtin_amdgcn_rcpf(d.x); t.y = __builtin_amdgcn_rcpf(d.y);
    f32x2 q = t * 0.5307027145f + (-0.7265760135f); q = q * t + 0.7107068705f; q = q * t + (-0.142248368f); q = q * t + 0.127414796f; q = q * t;
    const f32x2 s = (v * v) * (-0.72134752044f);
    f32x2 e; e.x = __builtin_amdgcn_exp2f(s.x); e.y = __builtin_amdgcn_exp2f(s.y);
    const f32x2 m = v * (q * e), r = v - m;
    f32x2 o; o.x = v.x < 0.f ? m.x : r.x; o.y = v.y < 0.f ? m.y : r.y; return o;
}

template <int ACT  > struct EpiBf16 {
    static constexpr bool PERM = true, AFTER_DRAIN = false; static_assert(ACT == 0 || ACT == 1, "EpiBf16: ACT is 0 (none) or 1 (gelu_pk)");
    bf16_t* O; int ldc; const float* bias; int split_cols; size_t split_stride; float scale0;
    __device__ __forceinline__ void operator()(const f32x4 (&acc)[2][2][4][2], const Unit& u, int wr, int wc, int fr, int fq) const {
        const int row0 = u.pm * BM + wr * 64 + fr; int colt = u.pn * BM; bf16_t* base = O;
        float sc = 1.f; if (split_cols) { const int t = colt / split_cols; base += (size_t)t * split_stride; colt -= t * split_cols; if (t == 0) sc = scale0; }
        const int col0 = colt + wc * 32 + 8 * fq, bcol0 = u.pn * BM + wc * 32 + 8 * fq;
        f32x4 bv[2][2];
#pragma unroll
        for (int bj = 0; bj < 2; ++bj)
#pragma unroll
            for (int n = 0; n < 2; ++n) bv[bj][n] = bias ? *(const f32x4*)(bias + bcol0 + bj * HALF + 4 * n) : (f32x4){0.f, 0.f, 0.f, 0.f};
#pragma unroll
        for (int ai = 0; ai < 2; ++ai)
#pragma unroll
            for (int m = 0; m < 4; ++m) { bf16_t* rowp = base + (size_t)(row0 + ai * HALF + m * 16) * ldc + col0;
#pragma unroll
                for (int bj = 0; bj < 2; ++bj) { f32x4 v0 = acc[ai][bj][m][0] + bv[bj][0], v1 = acc[ai][bj][m][1] + bv[bj][1];
                    if (ACT == 1) { f32x2 a = gelu_pk((f32x2){v0[0], v0[1]}), b = gelu_pk((f32x2){v0[2], v0[3]}), c = gelu_pk((f32x2){v1[0], v1[1]}), d = gelu_pk((f32x2){v1[2], v1[3]});
                        v0 = (f32x4){a.x, a.y, b.x, b.y}; v1 = (f32x4){c.x, c.y, d.x, d.y}; }
                    v0 = v0 * sc; v1 = v1 * sc; u32x4 w; w.x = cvt_pk_bf16(v0[0], v0[1]); w.y = cvt_pk_bf16(v0[2], v0[3]); w.z = cvt_pk_bf16(v1[0], v1[1]); w.w = cvt_pk_bf16(v1[2], v1[3]);
                    *(u32x4*)(rowp + bj * HALF) = w; } }
    }
};

__device__ __forceinline__ float silu_f(float x) { return x * __builtin_amdgcn_rcpf(1.0f + __builtin_amdgcn_exp2f(-1.4426950408889634f * x)); }
struct EpiResid {
    static constexpr bool PERM = false, AFTER_DRAIN = false;
    const float* base; float* out; const float* gate; const float* cbase; float* cout; const float* cgate; int mlat; int ldc;
    __device__ __forceinline__ void operator()(const f32x4 (&acc)[2][2][4][2], const Unit& u, int wr, int wc, int fr, int fq) const {
        const bool isc = u.pm >= mlat;
        const float* b = isc ? cbase : base; float* o = isc ? cout : out; const float* g = isc ? cgate : gate;
        const int row0 = (isc ? (u.pm - mlat) : u.pm) * BM + wr * 64 + fr, col0 = u.pn * BM + wc * 32 + 4 * fq;
        f32x4 gv[2][2];
#pragma unroll
        for (int bj = 0; bj < 2; ++bj)
#pragma unroll
            for (int n = 0; n < 2; ++n) gv[bj][n] = *(const f32x4*)(g + col0 + bj * HALF + n * 16);
#pragma unroll
        for (int ai = 0; ai < 2; ++ai)
#pragma unroll
            for (int m = 0; m < 4; ++m) { const size_t off = (size_t)(row0 + ai * HALF + m * 16) * ldc + col0;
#pragma unroll
                for (int bj = 0; bj < 2; ++bj)
#pragma unroll
                    for (int n = 0; n < 2; ++n) { const f32x4 bs = *(const f32x4*)(b + off + bj * HALF + n * 16); *(f32x4*)(o + off + bj * HALF + n * 16) = bs + gv[bj][n] * acc[ai][bj][m][n]; }
                if (m & 1) asm volatile("" ::: "memory"); }
    }
};
template <bool BFB> struct EpiResidB {
    static constexpr bool PERM = true, AFTER_DRAIN = false;
    const void* base; bf16_t* out; const float* gate; int ldc;
    __device__ __forceinline__ void operator()(const f32x4 (&acc)[2][2][4][2], const Unit& u, int wr, int wc, int fr, int fq) const {
        const int row0 = u.pm * BM + wr * 64 + fr, col0 = u.pn * BM + wc * 32 + 8 * fq;
        f32x4 gv[2][2];
#pragma unroll
        for (int bj = 0; bj < 2; ++bj)
#pragma unroll
            for (int n = 0; n < 2; ++n) gv[bj][n] = *(const f32x4*)(gate + col0 + bj * HALF + 4 * n);
#pragma unroll
        for (int ai = 0; ai < 2; ++ai)
#pragma unroll
            for (int m = 0; m < 4; ++m) { const size_t off = (size_t)(row0 + ai * HALF + m * 16) * ldc + col0;
#pragma unroll
                for (int bj = 0; bj < 2; ++bj) { f32x4 b0, b1;
                    if constexpr (BFB) { const u32x4 t = *(const u32x4*)((const bf16_t*)base + off + bj * HALF);
                        b0 = (f32x4){__builtin_bit_cast(float, t.x << 16), __builtin_bit_cast(float, t.x & 0xffff0000u), __builtin_bit_cast(float, t.y << 16), __builtin_bit_cast(float, t.y & 0xffff0000u)};
                        b1 = (f32x4){__builtin_bit_cast(float, t.z << 16), __builtin_bit_cast(float, t.z & 0xffff0000u), __builtin_bit_cast(float, t.w << 16), __builtin_bit_cast(float, t.w & 0xffff0000u)}; }
                    else { b0 = *(const f32x4*)((const float*)base + off + bj * HALF); b1 = *(const f32x4*)((const float*)base + off + bj * HALF + 4); }
                    const f32x4 v0 = b0 + gv[bj][0] * acc[ai][bj][m][0], v1 = b1 + gv[bj][1] * acc[ai][bj][m][1];
                    u32x4 w; w.x = cvt_pk_bf16(v0[0], v0[1]); w.y = cvt_pk_bf16(v0[2], v0[3]); w.z = cvt_pk_bf16(v1[0], v1[1]); w.w = cvt_pk_bf16(v1[2], v1[3]);
                    *(u32x4*)(out + off + bj * HALF) = w; }
                if (m & 1) asm volatile("" ::: "memory"); }
    }
};
struct EpiSwiGLU {
    static constexpr bool PERM = true, AFTER_DRAIN = false;
    bf16_t* O; int ldc; float ds;
    __device__ __forceinline__ void operator()(const f32x4 (&acc)[2][2][4][2], const Unit& u, int wr, int wc, int fr, int fq) const {
        const int row0 = u.pm * BM + wr * 64 + fr, col0 = u.pn * HALF + wc * 32 + 8 * fq;
#pragma unroll
        for (int ai = 0; ai < 2; ++ai)
#pragma unroll
            for (int m = 0; m < 4; ++m) { bf16_t* rowp = O + (size_t)(row0 + ai * HALF + m * 16) * ldc + col0;
                const f32x4 g0 = acc[ai][0][m][0] * ds, g1 = acc[ai][0][m][1] * ds, u0 = acc[ai][1][m][0] * ds, u1 = acc[ai][1][m][1] * ds;
                f32x4 h0, h1;
#pragma unroll
                for (int j = 0; j < 4; ++j) { h0[j] = silu_f(g0[j]) * u0[j]; h1[j] = silu_f(g1[j]) * u1[j]; }
                u32x4 w; w.x = cvt_pk_bf16(h0[0], h0[1]); w.y = cvt_pk_bf16(h0[2], h0[3]); w.z = cvt_pk_bf16(h1[0], h1[1]); w.w = cvt_pk_bf16(h1[2], h1[3]);
                *(u32x4*)rowp = w; }
    }
};
struct MoeOrder : StaticOrder {
    int tb[8];
    __device__ __forceinline__ void load_bases(const int* mi) {
#pragma unroll
        for (int e = 0; e < 8; ++e) tb[e] = __builtin_amdgcn_readfirstlane(mi[e]); }
    __device__ __forceinline__ int expert_of(int pm) const { int e = 0;
#pragma unroll
        for (int j = 0; j < 7; ++j) e += (pm >= tb[j]) ? 1 : 0;
        return e; }
    __device__ __forceinline__ bool next(int i, Unit& u) const { if (!StaticOrder::next(i, u)) return false; u.eb = expert_of(u.pm); return true; }
};

struct SplitKOrder {
    int pm0, nN, P, kp, total, c; const int* tile_e;
    __device__ __forceinline__ bool next(int i, Unit& u) const {
        if (i != 0 || c >= total) return false;
        const int p = c % P, t = c / P; u.pn = t % nN; u.pm = pm0 + t / nN; u.ko = p * kp; u.eb = tile_e ? __builtin_amdgcn_readfirstlane(tile_e[u.pm]) : 0; return true; }
    __device__ __forceinline__ void a_ready(const Unit&) const {}
    __device__ __forceinline__ void done(const Unit&) const {}
};
struct EpiPart {
    static constexpr bool PERM = false, AFTER_DRAIN = false;
    float* part; const float* scale; int pm_sub; int kp; int ldc;
    __device__ __forceinline__ void operator()(const f32x4 (&acc)[2][2][4][2], const Unit& u, int wr, int wc, int fr, int fq) const {
        float* o = part + (size_t)(u.ko / kp) * BM * ldc;
        const int row0 = (u.pm - pm_sub) * BM + wr * 64 + fr, col0 = u.pn * BM + wc * 32 + 4 * fq;
        f32x4 gv[2][2];
#pragma unroll
        for (int bj = 0; bj < 2; ++bj)
#pragma unroll
            for (int n = 0; n < 2; ++n) gv[bj][n] = *(const f32x4*)(scale + col0 + bj * HALF + n * 16);
#pragma unroll
        for (int ai = 0; ai < 2; ++ai)
#pragma unroll
            for (int m = 0; m < 4; ++m) { const size_t off = (size_t)(row0 + ai * HALF + m * 16) * ldc + col0;
#pragma unroll
                for (int bj = 0; bj < 2; ++bj)
#pragma unroll
                    for (int n = 0; n < 2; ++n) *(f32x4*)(o + off + bj * HALF + n * 16) = gv[bj][n] * acc[ai][bj][m][n]; }
    }
};
struct EpiAtomic {
    static constexpr bool PERM = false, AFTER_DRAIN = true;
    float* out; const float* scale; int pm_sub; int ldc; float ds;
    __device__ __forceinline__ void fused(f32x4 (&acc)[2][2][4][2], const Unit& u, int wr, int wc, int fr, int fq, PG8_LAS unsigned char* lds, int wid, int lane) const {
        PG8_LAS float* scr = (PG8_LAS float*)(lds + wid * 16384);
        const int rr = lane >> 5, cc = lane & 31;
#pragma unroll
        for (int ai = 0; ai < 2; ++ai)
#pragma unroll
            for (int bj = 0; bj < 2; ++bj) {
#pragma unroll
                for (int m = 0; m < 4; ++m)
#pragma unroll
                    for (int n = 0; n < 2; ++n) *(PG8_LAS f32x4*)(scr + (m * 16 + fr) * 36 + n * 16 + 4 * fq) = acc[ai][bj][m][n];
                asm volatile("s_waitcnt lgkmcnt(0)" ::: "memory");
                const int colg = u.pn * BM + bj * HALF + wc * 32 + cc; const float sc = (scale ? scale[colg] : 1.0f) * ds;
                float* op = out + (size_t)((u.pm - pm_sub) * BM + ai * HALF + wr * 64 + rr) * ldc + colg;
#pragma unroll 8
                for (int i = 0; i < 32; ++i) { const float v = scr[(2 * i + rr) * 36 + cc]; __hip_atomic_fetch_add(op + (size_t)(2 * i) * ldc, v * sc, __ATOMIC_RELAXED, __HIP_MEMORY_SCOPE_AGENT); }
                asm volatile("s_waitcnt lgkmcnt(0)" ::: "memory");
            }
    }
};

typedef int i32x4v __attribute__((ext_vector_type(4))); typedef int i32x8v __attribute__((ext_vector_type(8)));
struct FragB { bf16x8 k[2]; };
struct Frag8 { i32x8v v; };
template <bool F8> struct FragSel { typedef FragB type; };
template <> struct FragSel<true> { typedef Frag8 type; };
__device__ __forceinline__ void ld_frag(FragB& f, const PG8_LAS unsigned char* p) { f.k[0] = *(const PG8_LAS bf16x8*)p; f.k[1] = *(const PG8_LAS bf16x8*)(p + 1024); }
__device__ __forceinline__ void ld_frag(Frag8& f, const PG8_LAS unsigned char* p) { const i32x4v lo = *(const PG8_LAS i32x4v*)p, hi = *(const PG8_LAS i32x4v*)(p + 1024); f.v = __builtin_shufflevector(lo, hi, 0, 1, 2, 3, 4, 5, 6, 7); }
__device__ __forceinline__ f32x4 mma_frag(const FragB& b, const FragB& a, f32x4 c) { c = __builtin_amdgcn_mfma_f32_16x16x32_bf16(b.k[0], a.k[0], c, 0, 0, 0); return __builtin_amdgcn_mfma_f32_16x16x32_bf16(b.k[1], a.k[1], c, 0, 0, 0); }
__device__ __forceinline__ f32x4 mma_frag(const Frag8& b, const Frag8& a, f32x4 c) {
    asm volatile("v_mfma_scale_f32_16x16x128_f8f6f4 %0, %1, %2, %0, %3, %3 op_sel_hi:[0,0,0]" : "+v"(c) : "v"(b.v), "v"(a.v), "v"(0x7f7f7f7f));
    return c;
}

struct EpiSwiGLU8 {
    static constexpr bool PERM = true, AFTER_DRAIN = false;
    unsigned char* O; int ldc; float ds, hs;
    __device__ __forceinline__ void operator()(const f32x4 (&acc)[2][2][4][2], const Unit& u, int wr, int wc, int fr, int fq) const {
        const int row0 = u.pm * BM + wr * 64 + fr, col0 = u.pn * HALF + wc * 32 + 8 * fq;
        const float k1 = -1.4426950408889634f * ds, k2 = ds * ds * hs;
#pragma unroll
        for (int ai = 0; ai < 2; ++ai)
#pragma unroll
            for (int m = 0; m < 4; ++m) { unsigned char* rowp = O + (size_t)(row0 + ai * HALF + m * 16) * ldc + col0;
                const f32x4 g0 = acc[ai][0][m][0], g1 = acc[ai][0][m][1], u0 = acc[ai][1][m][0], u1 = acc[ai][1][m][1];
                float h[8];
#pragma unroll
                for (int j = 0; j < 4; ++j) {
                    h[j] = __builtin_amdgcn_fmed3f((g0[j] * u0[j]) * k2 * __builtin_amdgcn_rcpf(1.0f + __builtin_amdgcn_exp2f(g0[j] * k1)), -448.0f, 448.0f);
                    h[4 + j] = __builtin_amdgcn_fmed3f((g1[j] * u1[j]) * k2 * __builtin_amdgcn_rcpf(1.0f + __builtin_amdgcn_exp2f(g1[j] * k1)), -448.0f, 448.0f); }
                unsigned lo = 0u, hi = 0u;
                lo = __builtin_amdgcn_cvt_pk_fp8_f32(h[0], h[1], lo, false); lo = __builtin_amdgcn_cvt_pk_fp8_f32(h[2], h[3], lo, true);
                hi = __builtin_amdgcn_cvt_pk_fp8_f32(h[4], h[5], hi, false); hi = __builtin_amdgcn_cvt_pk_fp8_f32(h[6], h[7], hi, true);
                typedef unsigned u32x2 __attribute__((ext_vector_type(2)));
                *(u32x2*)rowp = (u32x2){lo, hi}; }
    }
};
struct EpiScaleBf16 {
    static constexpr bool PERM = true, AFTER_DRAIN = false;
    bf16_t* O; int ldc; float ds;
    __device__ __forceinline__ void operator()(const f32x4 (&acc)[2][2][4][2], const Unit& u, int wr, int wc, int fr, int fq) const {
        const int row0 = u.pm * BM + wr * 64 + fr, col0 = u.pn * BM + wc * 32 + 8 * fq;
#pragma unroll
        for (int ai = 0; ai < 2; ++ai)
#pragma unroll
            for (int m = 0; m < 4; ++m) { bf16_t* rowp = O + (size_t)(row0 + ai * HALF + m * 16) * ldc + col0;
#pragma unroll
                for (int bj = 0; bj < 2; ++bj) { const f32x4 v0 = acc[ai][bj][m][0] * ds, v1 = acc[ai][bj][m][1] * ds;
                    u32x4 w; w.x = cvt_pk_bf16(v0[0], v0[1]); w.y = cvt_pk_bf16(v0[2], v0[3]); w.z = cvt_pk_bf16(v1[0], v1[1]); w.w = cvt_pk_bf16(v1[2], v1[3]);
                    *(u32x4*)(rowp + bj * HALF) = w; } }
    }
};

template <class Epi, class Sched, bool ALIGN_EPI = false, bool SP2 = false, bool F8 = false>
__device__ __forceinline__ void gemm_phase(PG8_LAS unsigned char* lds, const Gemm g, const Sched& S, const Epi& E, int tid_in) {
    int tid_ = tid_in; asm volatile("" : "+v"(tid_));
    const int tid = tid_, wid = __builtin_amdgcn_readfirstlane(tid >> 6), lane = tid & 63, wr = wid >> 2, wc = wid & 3, fr = lane & 15, fq = lane >> 4;
    const int K = g.K, nt = K / BK, ld = g.ld;
    unsigned voffA[2], voffB[2];
#pragma unroll
    for (int i = 0; i < 2; ++i) { int R, C; stage_rc(tid * 16 + i * 8192, R, C); const int Rb = Epi::PERM ? ((R & ~31) + perm32(R & 31)) : R;
        voffA[i] = (unsigned)(R * ld + C) * 2u; voffB[i] = (unsigned)(Rb * ld + C) * 2u; }
    const size_t kstep = (size_t)(BK * 2);
    const size_t hstep = (size_t)HALF * ld * 2;
    const size_t tstep = 2 * hstep;
    const unsigned ldsw = (unsigned)wid * 1024u;
    const int aoff = lds_byte(wr * 64 + fr, fq * 8), boff = lds_byte(wc * 32 + fr, fq * 8);
#define PG8_SA(b, h) (((b) * 2 + (h)) * HTB)
#define PG8_SB(b, h) ((4 + (b) * 2 + (h)) * HTB)
#define PG8_STAGE(bufoff, gbase, voff) do { _Pragma("unroll") for (int _i = 0; _i < 2; ++_i) \
        __builtin_amdgcn_global_load_lds((const unsigned*)((const char*)(gbase) + (voff)[_i]), (PG8_LAS unsigned*)(lds + (bufoff) + ldsw + _i * 8192), 16, 0, 0); } while (0)
#define PG8_LDA(dst, b, h) do { _Pragma("unroll") for (int m = 0; m < 4; ++m) ld_frag(dst[m], lds + PG8_SA(b, h) + aoff + m * 2048); } while (0)
#define PG8_LDB(dst, b, h) do { _Pragma("unroll") for (int n = 0; n < 2; ++n) ld_frag(dst[n], lds + PG8_SB(b, h) + boff + n * 2048); } while (0)
#define PG8_MMA(ai, bj, At, Bt) do { __builtin_amdgcn_s_setprio(1); _Pragma("unroll") for (int m = 0; m < 4; ++m) _Pragma("unroll") for (int n = 0; n < 2; ++n) \
        acc[ai][bj][m][n] = mma_frag(Bt[n], At[m], acc[ai][bj][m][n]); __builtin_amdgcn_s_setprio(0); } while (0)
#define PG8_WAIT_V(n) asm volatile("s_waitcnt vmcnt(" #n ")" ::: "memory")
#define PG8_WAIT_L(n) asm volatile("s_waitcnt lgkmcnt(" #n ")" ::: "memory")
#define PG8_BAR __builtin_amdgcn_s_barrier()
#define PG8_SCHED __builtin_amdgcn_sched_barrier(0)
    Unit cur, nxt; int ui = 0;
    if (!S.next(0, cur)) return;
    float zacc = 0.f; asm volatile("" : "+v"(zacc));
    f32x4 acc[2][2][4][2];
#pragma unroll
    for (int a = 0; a < 2; ++a)
#pragma unroll
        for (int b = 0; b < 2; ++b)
#pragma unroll
            for (int m = 0; m < 4; ++m)
#pragma unroll
                for (int n = 0; n < 2; ++n) acc[a][b][m][n] = (f32x4){zacc, zacc, zacc, zacc};
    typedef typename FragSel<F8>::type Frag;
    Frag At[4], B0[2], B1[2];
    const char* cA = (const char*)g.A + (size_t)cur.pm * tstep + (size_t)cur.ko * 2; const char* cB = (const char*)g.Bt + (size_t)cur.eb * g.bstride + (size_t)cur.pn * tstep + (size_t)cur.ko * 2;
    S.a_ready(cur);
    if constexpr (SP2) {
        PG8_STAGE(PG8_SB(0, 0), cB, voffB); PG8_STAGE(PG8_SB(0, 1), cB + hstep, voffB); PG8_STAGE(PG8_SA(0, 0), cA, voffA); PG8_STAGE(PG8_SA(0, 1), cA + hstep, voffA);
        if (wr == 1) PG8_BAR;
        PG8_WAIT_V(2); PG8_BAR;
        PG8_STAGE(PG8_SB(1, 0), cB + kstep, voffB); PG8_STAGE(PG8_SA(1, 0), cA + kstep, voffA); PG8_STAGE(PG8_SB(1, 1), cB + hstep + kstep, voffB);
        PG8_WAIT_V(6); PG8_BAR;
    } else {
        PG8_STAGE(PG8_SB(0, 0), cB, voffB); PG8_STAGE(PG8_SA(0, 0), cA, voffA); PG8_STAGE(PG8_SB(0, 1), cB + hstep, voffB); PG8_STAGE(PG8_SA(0, 1), cA + hstep, voffA);
        if (wr == 1) PG8_BAR;
        PG8_WAIT_V(4); PG8_BAR;
        PG8_STAGE(PG8_SB(1, 0), cB + kstep, voffB); PG8_STAGE(PG8_SA(1, 0), cA + kstep, voffA); PG8_STAGE(PG8_SB(1, 1), cB + hstep + kstep, voffB);
        PG8_WAIT_V(6); PG8_BAR;
    }
    for (;;) {
        const bool has_next = S.next(ui + 1, nxt);
        const char* nA = has_next ? (const char*)g.A + (size_t)nxt.pm * tstep + (size_t)nxt.ko * 2 : cA; const char* nB = has_next ? (const char*)g.Bt + (size_t)nxt.eb * g.bstride + (size_t)nxt.pn * tstep + (size_t)nxt.ko * 2 : cB;
        for (int t = 0; t < nt; t += 2) {
            const bool last = (t == nt - 2);
            const char* a1 = cA + (size_t)(t + 1) * kstep;
            const char* a2 = last ? nA : cA + (size_t)(t + 2) * kstep; const char* b2 = last ? nB : cB + (size_t)(t + 2) * kstep;
            const char* a3 = a2 + kstep; const char* b3 = b2 + kstep;
            if (last && has_next) S.a_ready(nxt);
            if constexpr (SP2) {
            PG8_LDB(B0, 0, 0); PG8_LDB(B1, 0, 1); PG8_SCHED; PG8_LDA(At, 0, 0); PG8_STAGE(PG8_SA(1, 1), a1 + hstep, voffA);
            PG8_WAIT_V(8); PG8_WAIT_L(0); PG8_BAR; PG8_MMA(0, 0, At, B0); PG8_MMA(0, 1, At, B1); PG8_BAR; PG8_SCHED;
            PG8_LDA(At, 0, 1); PG8_STAGE(PG8_SB(0, 0), b2, voffB); PG8_STAGE(PG8_SB(0, 1), b2 + hstep, voffB); PG8_STAGE(PG8_SA(0, 0), a2, voffA);
            PG8_WAIT_V(8); PG8_WAIT_L(0); PG8_BAR; PG8_MMA(1, 0, At, B0); PG8_MMA(1, 1, At, B1); PG8_BAR; PG8_SCHED;
            PG8_LDB(B0, 1, 0); PG8_LDB(B1, 1, 1); PG8_SCHED; PG8_LDA(At, 1, 0); PG8_STAGE(PG8_SA(0, 1), a2 + hstep, voffA);
            PG8_WAIT_V(8); PG8_WAIT_L(0); PG8_BAR; PG8_MMA(0, 0, At, B0); PG8_MMA(0, 1, At, B1); PG8_BAR; PG8_SCHED;
            PG8_LDA(At, 1, 1); PG8_STAGE(PG8_SB(1, 0), b3, voffB); PG8_STAGE(PG8_SB(1, 1), b3 + hstep, voffB); PG8_STAGE(PG8_SA(1, 0), a3, voffA);
            PG8_WAIT_V(8); PG8_WAIT_L(0); PG8_BAR; PG8_MMA(1, 0, At, B0); PG8_MMA(1, 1, At, B1); PG8_BAR; PG8_SCHED;
            } else {
            PG8_LDB(B0, 0, 0); PG8_SCHED; PG8_LDA(At, 0, 0); PG8_STAGE(PG8_SA(1, 1), a1 + hstep, voffA);
            PG8_WAIT_L(8); PG8_BAR; PG8_WAIT_L(0); PG8_MMA(0, 0, At, B0); PG8_BAR; PG8_SCHED;
            PG8_LDB(B1, 0, 1); PG8_STAGE(PG8_SB(0, 0), b2, voffB);
            PG8_BAR; PG8_WAIT_L(0); PG8_MMA(0, 1, At, B1); PG8_BAR;
            PG8_LDA(At, 0, 1); PG8_STAGE(PG8_SA(0, 0), a2, voffA);
            PG8_BAR; PG8_WAIT_L(0); PG8_MMA(1, 0, At, B0); PG8_BAR; PG8_SCHED;
            PG8_STAGE(PG8_SB(0, 1), b2 + hstep, voffB);
            PG8_WAIT_V(6); PG8_BAR; PG8_MMA(1, 1, At, B1); PG8_BAR;
            PG8_LDB(B0, 1, 0); PG8_SCHED; PG8_LDA(At, 1, 0); PG8_STAGE(PG8_SA(0, 1), a2 + hstep, voffA);
            PG8_WAIT_L(8); PG8_BAR; PG8_WAIT_L(0); PG8_MMA(0, 0, At, B0); PG8_BAR; PG8_SCHED;
            PG8_LDB(B1, 1, 1); PG8_STAGE(PG8_SB(1, 0), b3, voffB);
            PG8_BAR; PG8_WAIT_L(0); PG8_MMA(0, 1, At, B1); PG8_BAR;
            PG8_LDA(At, 1, 1); PG8_STAGE(PG8_SA(1, 0), a3, voffA);
            PG8_BAR; PG8_WAIT_L(0); PG8_MMA(1, 0, At, B0); PG8_BAR; PG8_SCHED;
            PG8_STAGE(PG8_SB(1, 1), b3 + hstep, voffB);
            PG8_WAIT_V(6); PG8_BAR; PG8_MMA(1, 1, At, B1); PG8_BAR;
            }
        }
        if constexpr (ALIGN_EPI) { if (wr == 0) PG8_BAR; }
        if constexpr (F8) {
            asm volatile("s_nop 15\n\ts_nop 15" : "+v"(acc[1][1][0][0]), "+v"(acc[1][1][0][1]), "+v"(acc[1][1][1][0]), "+v"(acc[1][1][1][1]), "+v"(acc[1][1][2][0]), "+v"(acc[1][1][2][1]), "+v"(acc[1][1][3][0]), "+v"(acc[1][1][3][1])); }
        if constexpr (!Epi::AFTER_DRAIN) { E(acc, cur, wr, wc, fr, fq); S.done(cur); }
        if (!has_next) break;
#pragma unroll
        for (int a = 0; a < 2; ++a)
#pragma unroll
            for (int b = 0; b < 2; ++b)
#pragma unroll
                for (int m = 0; m < 4; ++m)
#pragma unroll
                    for (int n = 0; n < 2; ++n) acc[a][b][m][n] = (f32x4){zacc, zacc, zacc, zacc};
        cur = nxt; cA = nA; cB = nB; ++ui;
        if constexpr (ALIGN_EPI) { if (wr == 1) PG8_BAR; }
    }
    PG8_WAIT_V(0);
    if constexpr (!ALIGN_EPI) { if (wr == 0) PG8_BAR; }
    PG8_BAR;
    if constexpr (Epi::AFTER_DRAIN) { E.fused(acc, cur, wr, wc, fr, fq, lds, wid, lane); S.done(cur); }
#undef PG8_SA
#undef PG8_SB
#undef PG8_STAGE
#undef PG8_LDA
#undef PG8_LDB
#undef PG8_MMA
#undef PG8_WAIT_V
#undef PG8_WAIT_L
#undef PG8_BAR
#undef PG8_SCHED
}
}


constexpr int S_LAT = 16384, C_CTX = 256, R_ALL = S_LAT + C_CTX, DM = 1024;
constexpr int INW = 2560, FFN = 2816, EXD = 3584, NEXP = 8;
constexpr int COL_AQ = 0, COL_AK = 512, COL_AV = 640, COL_HQ = 768, COL_HFF = 1024, COL_HFB = 1280, COL_HI = 1536, COL_HG = 1792, COL_GU = 2048, COL_GV = 2304;
constexpr int MIX_AT = 0, MIX_HG = 512, MIX_GM = 768;
constexpr int MOE_MAXROWS = 34816;
constexpr float EPS = 1e-6f;
constexpr int NWAVES = 8, NTHR = 512;
constexpr int NPH = 23;

constexpr size_t MiB = 1u << 20;
constexpr size_t WS_CTL = 0, CTL_ZERO_BYTES = 1 * MiB;
constexpr size_t WS_VEC = 1 * MiB;
constexpr size_t WS_TOK = 2 * MiB;
constexpr size_t WS_WIN = 3 * MiB;
constexpr size_t WS_WOUT = 13 * MiB;
constexpr size_t WS_WGU = 17 * MiB;
constexpr size_t WS_WD = 28 * MiB;
constexpr size_t WS_MGU = 34 * MiB;
constexpr size_t WS_MD = 146 * MiB;
constexpr size_t WS_H = 202 * MiB;
constexpr size_t WS_PROJ = 235 * MiB;
constexpr size_t WS_MIX = 317 * MiB;
constexpr size_t WS_HGO = 350 * MiB;
constexpr size_t WS_CTXR = 383 * MiB;
constexpr size_t WS_HLT = WS_HGO;
constexpr size_t WS_HSP = 384 * MiB;
constexpr size_t WS_HDG = 402 * MiB;
constexpr size_t WS_VT = 403 * MiB;
constexpr size_t WS_HID = WS_PROJ;
constexpr size_t WS_AS = 202 * MiB;
constexpr size_t WS_HIDM = 270 * MiB;
constexpr size_t WS_H2B = 440 * MiB;
constexpr size_t WS_YF = WS_WIN;
constexpr size_t WS_Y = WS_MGU;
constexpr size_t WS_XB = 104 * MiB;
constexpr size_t WS_PART1 = 176 * MiB;
constexpr size_t WS_PART2 = 180 * MiB;
constexpr size_t WS_END = 508 * MiB;
static_assert(WS_HID + (size_t)R_ALL * FFN * 2 <= WS_HGO && WS_AS + (size_t)MOE_MAXROWS * DM * 2 <= WS_HIDM && WS_HIDM + (size_t)MOE_MAXROWS * EXD * 2 <= WS_END, "ws map");
static_assert(WS_PART1 >= WS_MD + (size_t)8 * DM * EXD && WS_PART1 + (size_t)4 * 256 * DM * 4 <= WS_PART2 && WS_PART2 + (size_t)11 * 256 * DM * 4 <= WS_H, "ws map 4");
static_assert(WS_XB >= WS_Y + (size_t)MOE_MAXROWS * DM * 2 && WS_XB >= WS_MGU + (size_t)8 * 2 * EXD * DM && WS_XB + (size_t)S_LAT * DM * 2 <= WS_MD, "ws map 3");
static_assert(WS_H2B >= WS_HIDM && WS_H2B + (size_t)S_LAT * DM * 2 <= WS_END && WS_H + (size_t)R_ALL * DM * 2 <= WS_PROJ && WS_PROJ + (size_t)R_ALL * INW * 2 <= WS_MIX && WS_MIX + (size_t)R_ALL * DM * 2 <= WS_HGO && WS_HGO + (size_t)2 * R_ALL * 256 * 4 <= WS_CTXR, "ws map 2");
constexpr int VO_MOD = 0;
constexpr int VO_ROPE = 32768;
constexpr int VO_MOE = 65536;
constexpr int CW_BAR = 4096;
constexpr int CW_QUEUE = 2048;
constexpr int CW_MOECNT = 1024;

constexpr int RING_BYTES = 131072;
constexpr int LDSCTL_OFF = 159744, MISC_OFF = LDSCTL_OFF + 320;
constexpr int LDS_BYTES = 163840;

#define GAS __attribute__((address_space(1)))
#define LAS __attribute__((address_space(3)))
typedef unsigned short bf16;
typedef unsigned v4u __attribute__((ext_vector_type(4)));
typedef unsigned v2u __attribute__((ext_vector_type(2)));
typedef float f32x4 __attribute__((ext_vector_type(4)));
typedef GAS unsigned gu32;
#define RLX_AGENT __ATOMIC_RELAXED, __HIP_MEMORY_SCOPE_AGENT
#define LDS_WAIT() asm volatile("s_waitcnt lgkmcnt(0)" ::: "memory")
typedef float f32x2_t __attribute__((ext_vector_type(2))); typedef __bf16 bf16x2_t __attribute__((ext_vector_type(2)));
__device__ __forceinline__ unsigned pk2(float lo, float hi) { const f32x2_t v = {lo, hi}; const bf16x2_t b = __builtin_convertvector(v, bf16x2_t); return __builtin_bit_cast(unsigned, b); }
__device__ __forceinline__ unsigned f2bf(float f) { return pk2(f, 0.f) & 0xffffu; }
__device__ __forceinline__ float bflo(unsigned w) { return __builtin_bit_cast(float, w << 16); }
__device__ __forceinline__ float bfhi(unsigned w) { return __builtin_bit_cast(float, w & 0xffff0000u); }
__device__ __forceinline__ float sigm1(float x) { return __builtin_amdgcn_rcpf(1.0f + __builtin_amdgcn_exp2f(-1.4426950408889634f * x)); }
__device__ __forceinline__ float silu1(float x) { return x * sigm1(x); }
__device__ __forceinline__ float gelu1(float x) { return 0.5f * x * (1.0f + erff(x * 0.70710678118654752f)); }
template <int X> __device__ __forceinline__ float sx(float v) { return __shfl_xor(v, X); }
__device__ __forceinline__ float sx32_add(float v) { return v + __shfl_xor(v, 32); }
__device__ __forceinline__ float sx32_max(float v) { return fmaxf(v, __shfl_xor(v, 32)); }
__device__ __forceinline__ float wave_sum(float v) { v += sx<1>(v); v += sx<2>(v); v += sx<4>(v); v += sx<8>(v); v += sx<16>(v); return sx32_add(v); }
__device__ __forceinline__ void unpack8(const v4u w, float* f) { f[0] = bflo(w.x); f[1] = bfhi(w.x); f[2] = bflo(w.y); f[3] = bfhi(w.y); f[4] = bflo(w.z); f[5] = bfhi(w.z); f[6] = bflo(w.w); f[7] = bfhi(w.w); }


__device__ __forceinline__ float clamp448(float x) { return fminf(fmaxf(x, -448.0f), 448.0f); }
__device__ __forceinline__ unsigned pk4_fp8(float a, float b, float c, float d) {
    unsigned w = 0u; w = __builtin_amdgcn_cvt_pk_fp8_f32(clamp448(a), clamp448(b), w, false); w = __builtin_amdgcn_cvt_pk_fp8_f32(clamp448(c), clamp448(d), w, true); return w; }
constexpr float F8_WSCALE = 128.0f;
constexpr float F8_ASCALE = 16.0f;
constexpr float F8_HSCALE = 8.0f;
#define XB_TMO      128
#define XB_XCNT(j)  (256  + 64 * (j))
#define XB_XSUB(j)  (1280 + 64 * (j))
#define XB_XGEN(j)  (2304 + 64 * (j))
#define XB_TOP      3328
#define XB_TOPGEN   3392
#define XCD_BAR_WORDS 3456
#define XB_SPIN_CAP (1u << 18)

__device__ __forceinline__ unsigned xb_ld(unsigned* p)              { return __hip_atomic_load(p, __ATOMIC_RELAXED, __HIP_MEMORY_SCOPE_AGENT); }
__device__ __forceinline__ unsigned xb_add(unsigned* p, unsigned v) { return __hip_atomic_fetch_add(p, v, __ATOMIC_RELAXED, __HIP_MEMORY_SCOPE_AGENT); }
__device__ __forceinline__ unsigned xb_xcc_id() { return (unsigned)__builtin_amdgcn_s_getreg((3 << 11) | 20) & 0xFu; }
#define XB_SPIN(cond, bar) do { unsigned _sp = 0; while (cond) { __builtin_amdgcn_s_sleep(1); \
    if ((++_sp & 255u) == 0u) { if (xb_ld(&(bar)[XB_TMO])) break; if (_sp > XB_SPIN_CAP) { atomicAdd(&(bar)[XB_TMO], 1u); break; } } } } while (0)

struct XcdBarrier {
    unsigned* bar; unsigned x;
    volatile LAS unsigned* st;
};

__device__ __forceinline__ XcdBarrier xcd_barrier_post(unsigned* bar, volatile LAS unsigned* st) {
    XcdBarrier b; b.bar = bar; b.x = xb_xcc_id(); b.st = st;
    if (threadIdx.x == 0) (void)xb_add(&bar[XB_XCNT(b.x)], 1u);
    return b;
}
__device__ __forceinline__ void xcd_barrier_complete(unsigned* bar, unsigned x, unsigned& nloc, unsigned& nx) {
    const unsigned G = gridDim.x * gridDim.y * gridDim.z;
    unsigned sum, cnt, mine, sp = 0u;
    for (;;) {
        sum = 0u; cnt = 0u; mine = 0u;
#pragma unroll
        for (unsigned j = 0; j < 16; ++j) { const unsigned c = xb_ld(&bar[XB_XCNT(j)]); sum += c; cnt += (c > 0u) ? 1u : 0u; mine = (j == x) ? c : mine; }
        if (sum == G) break;
        __builtin_amdgcn_s_sleep(1);
        if ((++sp & 255u) == 0u) { if (xb_ld(&bar[XB_TMO])) break; if (sp > XB_SPIN_CAP) { atomicAdd(&bar[XB_TMO], 1u); break; } }
    }
    nloc = mine > 0u ? mine : 1u; nx = cnt > 0u ? cnt : 1u;
}

__device__ __forceinline__ void xcd_barrier(const XcdBarrier& b, const int tid_in) {
    asm volatile("s_waitcnt vmcnt(0)" ::: "memory");
    __syncthreads();
    if (tid_in == 0) {
        unsigned* bar = b.bar;
        __builtin_amdgcn_s_waitcnt(0);
        unsigned nloc = b.st[0], nx = b.st[1];
        if (nloc == 0u) { xcd_barrier_complete(bar, b.x, nloc, nx); b.st[0] = nloc; b.st[1] = nx; }
        const unsigned old = xb_add(&bar[XB_XSUB(b.x)], 1u);
        const unsigned gen = old / nloc;
        if (old + 1u == (gen + 1u) * nloc) {
            __builtin_amdgcn_fence(__ATOMIC_RELEASE, "agent");
            asm volatile("s_waitcnt vmcnt(0)" ::: "memory");
            const unsigned og = xb_add(&bar[XB_TOP], 1u);
            const unsigned tg = og / nx;
            if (og + 1u == (tg + 1u) * nx) xb_add(&bar[XB_TOPGEN], 1u);
            else XB_SPIN(xb_ld(&bar[XB_TOPGEN]) == tg, bar);
            __builtin_amdgcn_fence(__ATOMIC_ACQUIRE, "agent");
            xb_add(&bar[XB_XGEN(b.x)], 1u);
            asm volatile("s_waitcnt vmcnt(0)" ::: "memory");
        } else {
            XB_SPIN(xb_ld(&bar[XB_XGEN(b.x)]) == gen, bar);
            __builtin_amdgcn_fence(__ATOMIC_ACQUIRE, "agent");
            asm volatile("s_waitcnt vmcnt(0)" ::: "memory");
        }
    }
    __syncthreads();
}


struct Args { const float* in[23]; float* out; unsigned char* ws; int ph_lo, ph_hi; };
typedef const __attribute__((address_space(4))) Args* KA;
#define KARGS() ({ KA p_ = (KA)__builtin_amdgcn_kernarg_segment_ptr(); asm volatile("" : "+s"(p_)); p_; })
enum { I_X = 0, I_C, I_CTX, I_CCTX, I_WADA, I_BADA, I_WIN, I_WOUT, I_QG, I_KG, I_SINK, I_HLB, I_HGAIN, I_GWS, I_GBS, I_GNG, I_FG, I_FU, I_FD, I_ROUTER, I_MG, I_MU, I_MDN };

__device__ __forceinline__ void transpose_item(const float* W, int K, int N, bf16* WT, int mode, LAS float* scr, int item, int lane) {
    const int nblk = N / 32, kb = item / nblk, nb = item % nblk, k0 = 64 * kb, n0 = 32 * nb;
#pragma unroll 8
    for (int i = 0; i < 32; ++i) { const int kk = 2 * i + (lane >> 5); scr[kk * 33 + (lane & 31)] = __builtin_nontemporal_load(&W[(size_t)(k0 + kk) * N + n0 + (lane & 31)]); }
    LDS_WAIT(); asm volatile("" ::: "memory");
    const int c = lane & 7;
#pragma unroll
    for (int j = 0; j < 4; ++j) { const int n = (lane >> 3) + 8 * j; const LAS float* s = scr + (8 * c) * 33 + n;
        v4u o; o.x = pk2(s[0 * 33], s[1 * 33]); o.y = pk2(s[2 * 33], s[3 * 33]); o.z = pk2(s[4 * 33], s[5 * 33]); o.w = pk2(s[6 * 33], s[7 * 33]);
        const int ng = n0 + n; const int drow = (mode == 0) ? ng : (ng + 128 * (ng / 128) + (mode == 2 ? 128 : 0));
        *(GAS v4u*)(WT + (size_t)drow * K + k0 + 8 * c) = o; }
    LDS_WAIT(); asm volatile("" ::: "memory");
}
__device__ __forceinline__ void transpose_item8(const float* W, int K, int N, unsigned char* WT, int mode, LAS float* scr, int item, int lane) {
    const int nblk = N / 32, kb = item / nblk, nb = item % nblk, k0 = 64 * kb, n0 = 32 * nb;
#pragma unroll 8
    for (int i = 0; i < 32; ++i) { const int kk = 2 * i + (lane >> 5); scr[kk * 33 + (lane & 31)] = __builtin_nontemporal_load(&W[(size_t)(k0 + kk) * N + n0 + (lane & 31)]); }
    LDS_WAIT(); asm volatile("" ::: "memory");
    const int c = lane & 7;
#pragma unroll
    for (int j = 0; j < 4; ++j) { const int n = (lane >> 3) + 8 * j; const LAS float* s = scr + (8 * c) * 33 + n;
        v2u o; o.x = pk4_fp8(s[0 * 33] * F8_WSCALE, s[1 * 33] * F8_WSCALE, s[2 * 33] * F8_WSCALE, s[3 * 33] * F8_WSCALE); o.y = pk4_fp8(s[4 * 33] * F8_WSCALE, s[5 * 33] * F8_WSCALE, s[6 * 33] * F8_WSCALE, s[7 * 33] * F8_WSCALE);
        const int ng = n0 + n; const int drow = (mode == 0) ? ng : (ng + 128 * (ng / 128) + (mode == 2 ? 128 : 0));
        *(GAS v2u*)(WT + (size_t)drow * K + k0 + 8 * c) = o; }
    LDS_WAIT(); asm volatile("" ::: "memory");
}
constexpr int MOE_ITEMS = 24 * 16 * 112;
constexpr int MOE_SL0 = 0, MOE_SL1 = 5376, MOE_SL2 = 10752, MOE_SL3 = 16128, MOE_SL4 = 19200, MOE_SL5 = 25344, MOE_SL6 = 29184, MOE_SL7 = 32576, MOE_DEFER = 34496;
__device__ __forceinline__ void moe_conv_item(KA a, int it, LAS float* scr, int lane) {
    constexpr int I_M = 16 * 112;
    unsigned char* ws = a->ws;
    const int idx = it / I_M, r = it % I_M;
    if (idx < 8) transpose_item8(a->in[I_MG] + (size_t)idx * DM * EXD, DM, EXD, (unsigned char*)(ws + WS_MGU) + (size_t)idx * 2 * EXD * DM, 1, scr, r, lane);
    else if (idx < 16) transpose_item8(a->in[I_MU] + (size_t)(idx - 8) * DM * EXD, DM, EXD, (unsigned char*)(ws + WS_MGU) + (size_t)(idx - 8) * 2 * EXD * DM, 2, scr, r, lane);
    else transpose_item8(a->in[I_MDN] + (size_t)(idx - 16) * EXD * DM, EXD, DM, (unsigned char*)(ws + WS_MD) + (size_t)(idx - 16) * DM * EXD, 0, scr, r, lane);
}
__device__ __forceinline__ void moe_conv_range(KA a, int lo, int hi, int first, LAS unsigned char* lds, int lane, int wave, int G, int bid) {
    if (bid < first) return;
    LAS float* scr = (LAS float*)(lds + wave * 8704);
    const int nw = (G - first) * NWAVES, w = (bid - first) * NWAVES + wave;
    for (int i = lo + w; i < hi; i += nw) moe_conv_item(a, i, scr, lane);
}
__device__ __forceinline__ void p0_prologue(KA a, LAS unsigned char* lds, int tid, int lane, int wave, int G, int bid) {
    unsigned char* ws = a->ws;
    LAS float* scr = (LAS float*)(lds + wave * 8704);
    const int gw = bid * NWAVES + wave, NGW = G * NWAVES;
    constexpr int I_IN = 16 * 80, I_OUT = 16 * 32, I_F = 16 * 88, I_FDN = 44 * 32, I_M = 16 * 112;
    constexpr int NIT = 2 * I_IN + 2 * I_OUT + 2 * I_F + I_FDN + 24 * I_M;
    for (int it0 = gw; it0 < NIT; it0 += NGW) {
        int it = it0;
        if (it < 2 * I_IN) { const int l = it / I_IN, r = it % I_IN; transpose_item(a->in[I_WIN] + (size_t)l * DM * INW, DM, INW, (bf16*)(ws + WS_WIN) + (size_t)l * INW * DM, 0, scr, r, lane); continue; } it -= 2 * I_IN;
        if (it < 2 * I_OUT) { const int l = it / I_OUT, r = it % I_OUT; transpose_item(a->in[I_WOUT] + (size_t)l * DM * DM, DM, DM, (bf16*)(ws + WS_WOUT) + (size_t)l * DM * DM, 0, scr, r, lane); continue; } it -= 2 * I_OUT;
        if (it < I_F) { transpose_item(a->in[I_FG], DM, FFN, (bf16*)(ws + WS_WGU), 1, scr, it, lane); continue; } it -= I_F;
        if (it < I_F) { transpose_item(a->in[I_FU], DM, FFN, (bf16*)(ws + WS_WGU), 2, scr, it, lane); continue; } it -= I_F;
        if (it < I_FDN) { transpose_item(a->in[I_FD], FFN, DM, (bf16*)(ws + WS_WD), 0, scr, it, lane); continue; } it -= I_FDN;
        if (it >= MOE_DEFER) moe_conv_item(a, it, scr, lane);
    }
    LAS float* sil = (LAS float*)(lds + 69632);
    LAS float* part = (LAS float*)(lds + 69632 + 8192);
    float* vec = (float*)(ws + WS_VEC);
    if (bid < 192) {
        for (int i = tid; i < 2048; i += NTHR) { const float v = (i < 1024) ? a->in[I_C][i] : a->in[I_CCTX][i - 1024]; sil[i] = silu1(v); }
        __syncthreads();
        for (int item = bid; item < 192; item += G) {
            const int l = item / 96, cb = item % 96, col = cb * 64 + lane;
            const float* w = a->in[I_WADA] + (size_t)l * DM * 6144 + col;
            float a0 = 0.f, a1 = 0.f;
#pragma unroll 1
            for (int k0 = wave * 128; k0 < wave * 128 + 128; k0 += 32) { float wv[32];
#pragma unroll
                for (int j = 0; j < 32; ++j) wv[j] = __builtin_nontemporal_load(&w[(size_t)(k0 + j) * 6144]);
#pragma unroll
                for (int j = 0; j < 32; ++j) { a0 += sil[k0 + j] * wv[j]; a1 += sil[1024 + k0 + j] * wv[j]; } }
            part[(wave * 2 + 0) * 64 + lane] = a0; part[(wave * 2 + 1) * 64 + lane] = a1;
            __syncthreads();
            if (wave == 0) { float s0 = 0.f, s1 = 0.f;
#pragma unroll
                for (int w8 = 0; w8 < 8; ++w8) { s0 += part[(w8 * 2 + 0) * 64 + lane]; s1 += part[(w8 * 2 + 1) * 64 + lane]; }
                const float b = a->in[I_BADA][l * 6144 + col];
                vec[VO_MOD + (l * 2 + 0) * 6144 + col] = s0 + b; vec[VO_MOD + (l * 2 + 1) * 6144 + col] = s1 + b; }
            __syncthreads();
        }
    }
    if (bid == G - 1) {
        for (int idx = tid; idx < 5120; idx += NTHR) {
            const int isc = idx >= 4096, j = isc ? idx - 4096 : idx, pos = j / 16, i = j % 16;
            const float inv = exp2f(-(float)i * 0.83048202372184059f);
            const float ang = (float)pos * inv;
            double r = (double)ang * 0.15915494309189535; r -= floor(r);
            const float rf = (float)r;
            const float cs = __builtin_amdgcn_cosf(rf), sn = __builtin_amdgcn_sinf(rf);
            float* t = vec + VO_ROPE + (isc ? 8192 : 0);
            const int n = isc ? 1024 : 4096;
            t[j] = cs; t[n + j] = sn;
        }
    }
}

template <bool STORE = true, bool BFX = false> __device__ __forceinline__ void norm_row(const void* xrow, const float* sc, const float* sh, bf16* orow, int lane, f32x4 (&h)[4]) {
    f32x4 v[4]; float s = 0.f;
    if constexpr (BFX) { const GAS v2u* xr = (const GAS v2u*)xrow + lane;
#pragma unroll
        for (int j = 0; j < 4; ++j) { const v2u t = xr[64 * j]; v[j] = (f32x4){bflo(t.x), bfhi(t.x), bflo(t.y), bfhi(t.y)}; } }
    else { const GAS f32x4* xr = (const GAS f32x4*)xrow + lane;
#pragma unroll
        for (int j = 0; j < 4; ++j) v[j] = xr[64 * j]; }
#pragma unroll
    for (int j = 0; j < 4; ++j) s += (v[j].x * v[j].x + v[j].y * v[j].y) + (v[j].z * v[j].z + v[j].w * v[j].w);
    const float rstd = __builtin_amdgcn_rsqf(wave_sum(s) * (1.0f / DM) + EPS);
    GAS v2u* o8 = (GAS v2u*)orow + lane;
#pragma unroll
    for (int j = 0; j < 4; ++j) { const f32x4 scv = *(const f32x4*)(sc + 4 * lane + 256 * j), shv = *(const f32x4*)(sh + 4 * lane + 256 * j);
        h[j] = v[j] * rstd * (scv + 1.0f) + shv;
        if constexpr (STORE) { v2u w; w.x = pk2(h[j].x, h[j].y); w.y = pk2(h[j].z, h[j].w); o8[64 * j] = w; } }
}
__device__ __forceinline__ void phase_norm(KA a, int l, int which, int nrows, bf16* H, int lane, int wave, int G, int bid) {
    const float* vec = (const float*)(a->ws + WS_VEC);
    const bool bfx = !(l == 0 && which == 0);
    const float* xl = a->in[I_X]; const bf16* xb = (const bf16*)(a->ws + WS_XB);
    const float* xc = (l == 0) ? a->in[I_CTX] : (const float*)(a->ws + WS_CTXR);
    const int nlat = nrows < S_LAT ? nrows : S_LAT;
    const float* ml = vec + VO_MOD + (l * 2 + 0) * 6144 + which * 3072;
    const float* mc = vec + VO_MOD + (l * 2 + 1) * 6144 + which * 3072;
    const int gw = bid * NWAVES + wave, NGW = G * NWAVES;
    f32x4 scl[4], shl[4], v[4];
#pragma unroll
    for (int j = 0; j < 4; ++j) { scl[j] = *(const f32x4*)(ml + 1024 + 4 * lane + 256 * j) + 1.0f; shl[j] = *(const f32x4*)(ml + 4 * lane + 256 * j); }
    if (gw < nlat) {
        if (bfx) { const GAS v2u* xr = (const GAS v2u*)(xb + (size_t)gw * DM) + lane;
#pragma unroll
            for (int j = 0; j < 4; ++j) { const v2u t = xr[64 * j]; v[j] = (f32x4){bflo(t.x), bfhi(t.x), bflo(t.y), bfhi(t.y)}; } }
        else { const GAS f32x4* xr = (const GAS f32x4*)(xl + (size_t)gw * DM) + lane;
#pragma unroll
            for (int j = 0; j < 4; ++j) v[j] = xr[64 * j]; } }
    for (int r = gw; r < nlat; r += NGW) {
        const int rn = r + NGW; f32x4 vn[4];
        if (rn < nlat) {
            if (bfx) { const GAS v2u* xr = (const GAS v2u*)(xb + (size_t)rn * DM) + lane;
#pragma unroll
                for (int j = 0; j < 4; ++j) { const v2u t = xr[64 * j]; vn[j] = (f32x4){bflo(t.x), bfhi(t.x), bflo(t.y), bfhi(t.y)}; } }
            else { const GAS f32x4* xr = (const GAS f32x4*)(xl + (size_t)rn * DM) + lane;
#pragma unroll
                for (int j = 0; j < 4; ++j) vn[j] = xr[64 * j]; } }
        float s = 0.f;
#pragma unroll
        for (int j = 0; j < 4; ++j) s += (v[j].x * v[j].x + v[j].y * v[j].y) + (v[j].z * v[j].z + v[j].w * v[j].w);
        const float rstd = __builtin_amdgcn_rsqf(wave_sum(s) * (1.0f / DM) + EPS);
        GAS v2u* o8 = (GAS v2u*)(H + (size_t)r * DM) + lane;
#pragma unroll
        for (int j = 0; j < 4; ++j) { const f32x4 h = v[j] * rstd * scl[j] + shl[j]; v2u w; w.x = pk2(h.x, h.y); w.y = pk2(h.z, h.w); o8[64 * j] = w; }
#pragma unroll
        for (int j = 0; j < 4; ++j) v[j] = vn[j];
    }
    const int npart = (l == 0 && which == 0) ? 0 : (l == 0 ? 4 : 11);
    const float* part = (const float*)(a->ws + (l == 0 ? WS_PART1 : WS_PART2));
    for (int r = S_LAT + (NGW - 1 - gw); r < nrows; r += NGW) {
        const int cr = r - S_LAT; f32x4 x[4];
        { const GAS f32x4* xr = (const GAS f32x4*)(xc + (size_t)cr * DM) + lane;
#pragma unroll
          for (int j = 0; j < 4; ++j) x[j] = xr[64 * j]; }
        for (int p = 0; p < npart; ++p) { const GAS f32x4* pr = (const GAS f32x4*)(part + ((size_t)p * 256 + cr) * DM) + lane;
#pragma unroll
            for (int j = 0; j < 4; ++j) x[j] = x[j] + pr[64 * j]; }
        if (npart && l == 0) { GAS f32x4* cw = (GAS f32x4*)((float*)(a->ws + WS_CTXR) + (size_t)cr * DM) + lane;
#pragma unroll
            for (int j = 0; j < 4; ++j) cw[64 * j] = x[j]; }
        float s = 0.f;
#pragma unroll
        for (int j = 0; j < 4; ++j) s += (x[j].x * x[j].x + x[j].y * x[j].y) + (x[j].z * x[j].z + x[j].w * x[j].w);
        const float rstd = __builtin_amdgcn_rsqf(wave_sum(s) * (1.0f / DM) + EPS);
        GAS v2u* o8 = (GAS v2u*)(H + (size_t)r * DM) + lane;
#pragma unroll
        for (int j = 0; j < 4; ++j) { const f32x4 scv = *(const f32x4*)(mc + 1024 + 4 * lane + 256 * j), shv = *(const f32x4*)(mc + 4 * lane + 256 * j);
            const f32x4 h = x[j] * rstd * (scv + 1.0f) + shv; v2u w; w.x = pk2(h.x, h.y); w.y = pk2(h.z, h.w); o8[64 * j] = w; }
    }
}
__device__ __forceinline__ void phase_norm_route(KA a, LAS unsigned char* lds, int tid, int lane, int wave, int G, int bid) {
    const int l = 1;
    const float* vec = (const float*)(a->ws + WS_VEC);
    const float* ml = vec + VO_MOD + (l * 2 + 0) * 6144 + 3072;
    unsigned char* H8 = (unsigned char*)(a->ws + WS_H2B);
    LAS float* rt = (LAS float*)lds;
    volatile LAS unsigned* lcnt = (volatile LAS unsigned*)(lds + 32768);
    for (int i = tid; i < 8192; i += NTHR) rt[i] = a->in[I_ROUTER][i];
    if (tid < 16) lcnt[tid] = 0u;
    __syncthreads();
    int* tokinfo = (int*)(a->ws + WS_TOK);
    unsigned* cnt = (unsigned*)(a->ws + WS_CTL) + CW_MOECNT;
    const int gw = bid * NWAVES + wave, NGW = G * NWAVES;
    unsigned keep = 0u, pk0 = 0u; int itn = 0;
    for (int r = gw; r < S_LAT; r += NGW) {
        f32x4 h[4];
        norm_row<false, true>((const bf16*)(a->ws + WS_XB) + (size_t)r * DM, ml + 1024, ml, nullptr, lane, h);
#pragma unroll
        for (int j = 0; j < 4; ++j) ((GAS unsigned*)(H8 + (size_t)r * DM))[lane + 64 * j] = pk4_fp8(h[j].x * F8_ASCALE, h[j].y * F8_ASCALE, h[j].z * F8_ASCALE, h[j].w * F8_ASCALE);
        float lg[8];
#pragma unroll
        for (int e = 0; e < 8; ++e) lg[e] = 0.f;
#pragma unroll
        for (int j = 0; j < 4; ++j)
#pragma unroll
            for (int i = 0; i < 4; ++i) { const int d = 4 * lane + 256 * j + i; const f32x4 r0 = *(const LAS f32x4*)(rt + d * 8), r1 = *(const LAS f32x4*)(rt + d * 8 + 4); const float hv = h[j][i];
                lg[0] += hv * r0.x; lg[1] += hv * r0.y; lg[2] += hv * r0.z; lg[3] += hv * r0.w; lg[4] += hv * r1.x; lg[5] += hv * r1.y; lg[6] += hv * r1.z; lg[7] += hv * r1.w; }
#pragma unroll
        for (int e = 0; e < 8; ++e) lg[e] = wave_sum(lg[e]);
        int i1 = 0; float v1 = lg[0];
#pragma unroll
        for (int e = 1; e < 8; ++e) if (lg[e] > v1) { v1 = lg[e]; i1 = e; }
        int i2 = -1; float v2 = -INFINITY;
#pragma unroll
        for (int e = 0; e < 8; ++e) if (e != i1 && lg[e] > v2) { v2 = lg[e]; i2 = e; }
        const float w1 = 1.0f / (1.0f + __expf(v2 - v1)), w2 = 1.0f - w1;
        if (lane == 0) {
            const unsigned r1 = __hip_atomic_fetch_add((LAS unsigned*)lcnt + i1, 1u, __ATOMIC_RELAXED, __HIP_MEMORY_SCOPE_WORKGROUP), r2 = __hip_atomic_fetch_add((LAS unsigned*)lcnt + i2, 1u, __ATOMIC_RELAXED, __HIP_MEMORY_SCOPE_WORKGROUP);
            int* ti = tokinfo + (size_t)r * 8;
            ti[0] = i1; ti[1] = i2; ti[4] = __builtin_bit_cast(int, w1); ti[5] = __builtin_bit_cast(int, w2);
            pk0 = (unsigned)i1 | ((unsigned)i2 << 3) | (r1 << 6) | (r2 << 19);
        }
        const unsigned pku = (unsigned)__builtin_amdgcn_readfirstlane((int)pk0);
        if (lane == itn) keep = pku;
        ++itn;
    }
    __syncthreads();
    if (tid < 8) lcnt[8 + tid] = __hip_atomic_fetch_add(cnt + 64 * tid, lcnt[tid], RLX_AGENT);
    __syncthreads();
    { const int r = gw + lane * NGW; if (lane < itn && r < S_LAT) { int* ti = tokinfo + (size_t)r * 8; const unsigned e1 = keep & 7u, e2 = (keep >> 3) & 7u; ti[2] = (int)(((keep >> 6) & 0x1fffu) + lcnt[8 + e1]); ti[3] = (int)((keep >> 19) + lcnt[8 + e2]); } }
}

__device__ __forceinline__ void qk_prep(KA a, int l, int first_thread, int nthreads) {
    bf16* PROJ = (bf16*)(a->ws + WS_PROJ);
    const float* rope = (const float*)(a->ws + WS_VEC) + VO_ROPE;
    for (int i = first_thread; i < R_ALL * 10; i += nthreads) {
        const int row = i / 10, hh = i % 10; const bool isq = hh < 8;
        bf16* p = PROJ + (size_t)row * INW + (isq ? hh * 64 : COL_AK + (hh - 8) * 64);
        const float* gain = (isq ? a->in[I_QG] : a->in[I_KG]) + l * 64;
        float x[64]; float ss = 0.f;
#pragma unroll
        for (int c = 0; c < 8; ++c) { const v4u w = *(const GAS v4u*)(p + 8 * c); unpack8(w, x + 8 * c); }
#pragma unroll
        for (int d = 0; d < 64; ++d) ss += x[d] * x[d];
        const float rstd = __builtin_amdgcn_rsqf(ss * (1.0f / 64.0f) + EPS);
        const f32x4* g4 = (const f32x4*)gain;
#pragma unroll
        for (int c = 0; c < 16; ++c) { const f32x4 gv = g4[c]; x[4 * c] *= rstd * gv.x; x[4 * c + 1] *= rstd * gv.y; x[4 * c + 2] *= rstd * gv.z; x[4 * c + 3] *= rstd * gv.w; }
        if (row < S_LAT) {
            const int gr = row >> 6, gc = row & 63;
            const f32x4* cr = (const f32x4*)(rope + gr * 16); const f32x4* sr = (const f32x4*)(rope + 4096 + gr * 16); const f32x4* cc = (const f32x4*)(rope + 8192 + gc * 16); const f32x4* sc = (const f32x4*)(rope + 8192 + 1024 + gc * 16);
#pragma unroll
            for (int j4 = 0; j4 < 4; ++j4) { const f32x4 cv = cr[j4], sv = sr[j4];
#pragma unroll
                for (int i = 0; i < 4; ++i) { const int j = 4 * j4 + i; const float x1 = x[j], x2 = x[16 + j]; x[j] = x1 * cv[i] - x2 * sv[i]; x[16 + j] = x1 * sv[i] + x2 * cv[i]; } }
#pragma unroll
            for (int j4 = 0; j4 < 4; ++j4) { const f32x4 cv = cc[j4], sv = sc[j4];
#pragma unroll
                for (int i = 0; i < 4; ++i) { const int j = 4 * j4 + i; const float x1 = x[32 + j], x2 = x[48 + j]; x[32 + j] = x1 * cv[i] - x2 * sv[i]; x[48 + j] = x1 * sv[i] + x2 * cv[i]; } }
        }
        const float qs = isq ? 0.125f * 1.4426950408889634f : 1.0f;
#pragma unroll
        for (int c = 0; c < 8; ++c) { v4u w; w.x = pk2(x[8 * c] * qs, x[8 * c + 1] * qs); w.y = pk2(x[8 * c + 2] * qs, x[8 * c + 3] * qs); w.z = pk2(x[8 * c + 4] * qs, x[8 * c + 5] * qs); w.w = pk2(x[8 * c + 6] * qs, x[8 * c + 7] * qs);
            *(GAS v4u*)(p + 8 * c) = w; }
    }
}
__device__ __forceinline__ void gmlp_unit(KA a, int l, int chunk, int g, LAS unsigned char* lds, int tid, int lane, int wave) {
    const bf16* PROJ = (const bf16*)(a->ws + WS_PROJ); bf16* MIX = (bf16*)(a->ws + WS_MIX);
    const int row0 = (chunk < 128) ? chunk * 128 : S_LAT + (chunk - 128) * 128;
    LAS float* vn = (LAS float*)lds;
    { const int pos = tid >> 2, part = tid & 3;
      const bf16* p = PROJ + (size_t)(row0 + pos) * INW + COL_GV + g * 64 + part * 16;
      float x[16]; unpack8(*(const GAS v4u*)p, x); unpack8(*(const GAS v4u*)(p + 8), x + 8);
      float ss = 0.f;
#pragma unroll
      for (int d = 0; d < 16; ++d) { x[d] = gelu1(x[d]); ss += x[d] * x[d]; }
      ss += sx<1>(ss); ss += sx<2>(ss);
      const float rstd = __builtin_amdgcn_rsqf(ss * (1.0f / 64.0f) + EPS);
      const float* gn = a->in[I_GNG] + l * 256 + g * 64 + part * 16;
#pragma unroll
      for (int d = 0; d < 16; ++d) vn[pos * 64 + part * 16 + d] = x[d] * rstd * gn[d]; }
    __syncthreads();
    const int c = lane, t0 = wave * 16;
    const float* W = a->in[I_GWS] + ((size_t)(l * 4 + g) * 128 + t0) * 128;
    float acc[16];
#pragma unroll
    for (int i = 0; i < 16; ++i) acc[i] = 0.f;
    for (int s = 0; s < 128; ++s) { const float v = vn[s * 64 + c];
#pragma unroll
        for (int i = 0; i < 16; ++i) acc[i] += W[i * 128 + s] * v; }
    const float* bs = a->in[I_GBS] + (l * 4 + g) * 128 + t0;
#pragma unroll
    for (int i = 0; i < 16; ++i) { const int row = row0 + t0 + i;
        const float u = gelu1(bflo((unsigned)PROJ[(size_t)row * INW + COL_GU + g * 64 + c]));
        MIX[(size_t)row * DM + MIX_GM + g * 64 + c] = (bf16)f2bf(u * (acc[i] + bs[i])); }
    __syncthreads();
}
__device__ __forceinline__ void hgrn_naive(KA a, int l, int dir, int head, LAS unsigned char* lds, int tid, int lane, int wave) {
    const bf16* PROJ = (const bf16*)(a->ws + WS_PROJ);
    float* HGO = (float*)(a->ws + WS_HGO) + (size_t)dir * R_ALL * 256;
    LAS float* Qs = (LAS float*)lds;
    LAS float* Fs = Qs + 4096; LAS float* Vs = Fs + 4096; LAS float* part = Vs + 4096;
    const int v = lane, kg = wave;
    float S[8];
#pragma unroll
    for (int i = 0; i < 8; ++i) S[i] = 0.f;
    const int tl = tid >> 3, c8 = tid & 7;
    float lb[8];
#pragma unroll
    for (int j = 0; j < 8; ++j) { float b = 0.f; if (l == 1) { const float p0 = a->in[I_HLB][dir * 512 + head * 64 + c8 * 8 + j], p1 = a->in[I_HLB][dir * 512 + 256 + head * 64 + c8 * 8 + j]; b = 1.0f / (1.0f + __expf(p0 - p1)); } lb[j] = b; }
    const int fcol = (dir == 0 ? COL_HFF : COL_HFB) + head * 64 + c8 * 8;
    for (int n0 = 0; n0 < R_ALL; n0 += 64) {
        { const int n = n0 + tl; int row;
          if (dir == 0) row = (n < C_CTX) ? S_LAT + n : n - C_CTX; else row = (n < C_CTX) ? S_LAT + (C_CTX - 1 - n) : (S_LAT - 1) - (n - C_CTX);
          const bf16* pr = PROJ + (size_t)row * INW;
          float q[8], f[8], vv[8];
          unpack8(*(const GAS v4u*)(pr + COL_HQ + head * 64 + c8 * 8), q); unpack8(*(const GAS v4u*)(pr + fcol), f); unpack8(*(const GAS v4u*)(pr + COL_HI + head * 64 + c8 * 8), vv);
#pragma unroll
          for (int j = 0; j < 8; ++j) { Qs[tl * 64 + c8 * 8 + j] = silu1(q[j]) * 0.125f; Fs[tl * 64 + c8 * 8 + j] = lb[j] + (1.0f - lb[j]) * sigm1(f[j]); Vs[tl * 64 + c8 * 8 + j] = vv[j]; } }
        __syncthreads();
        for (int t = 0; t < 64; ++t) {
            const float vt = Vs[t * 64 + v]; float po = 0.f;
#pragma unroll
            for (int i = 0; i < 8; ++i) { const float f = Fs[t * 64 + kg * 8 + i], q = Qs[t * 64 + kg * 8 + i]; S[i] = f * S[i] + (1.0f - f) * vt; po += S[i] * q; }
            part[((t & 1) * 8 + kg) * 64 + v] = po;
            __syncthreads();
            if (wave == 0) { float o = 0.f;
#pragma unroll
                for (int w8 = 0; w8 < 8; ++w8) o += part[((t & 1) * 8 + w8) * 64 + v];
                const int n = n0 + t; int row;
                if (dir == 0) row = (n < C_CTX) ? S_LAT + n : n - C_CTX; else row = (n < C_CTX) ? S_LAT + (C_CTX - 1 - n) : (S_LAT - 1) - (n - C_CTX);
                HGO[(size_t)row * 256 + head * 64 + v] = o; }
        }
        __syncthreads();
    }
}

typedef short bf16x8v __attribute__((ext_vector_type(8)));
constexpr int HST = 72;
__device__ __forceinline__ f32x4 mma16(const LAS bf16* MA, const LAS bf16* MBt, int k0, f32x4 c, int lane) {
    const bf16x8v av = *(const LAS bf16x8v*)(MA + (lane & 15) * HST + k0 + 8 * (lane >> 4));
    const bf16x8v bv = *(const LAS bf16x8v*)(MBt + (lane & 15) * HST + k0 + 8 * (lane >> 4));
    return __builtin_amdgcn_mfma_f32_16x16x32_bf16(av, bv, c, 0, 0, 0);
}
__device__ __forceinline__ int hg_base_row(int cpos) { return cpos < 256 ? 64 * cpos : S_LAT + 64 * (cpos - 256); }
__device__ __forceinline__ int hg_scan_idx(int dir, int cpos) { return dir == 0 ? (cpos < 256 ? 4 + cpos : cpos - 256) : (cpos < 256 ? 4 + (255 - cpos) : 3 - (cpos - 256)); }
__device__ __forceinline__ float hg_lb(KA a, int l, int dir, int head, int k) {
    if (l == 0) return 0.f;
    const float p0 = a->in[I_HLB][dir * 512 + head * 64 + k], p1 = a->in[I_HLB][dir * 512 + 256 + head * 64 + k];
    return 1.0f / (1.0f + __expf(p0 - p1));
}
__device__ __forceinline__ void hgrn_stepA(KA a, int l, int cpos, int head, LAS unsigned char* lds, int lane, int wave) {
    const bf16* PROJ = (const bf16*)(a->ws + WS_PROJ);
    const int dir = wave >> 2, I = wave & 3, base = hg_base_row(cpos), ci = hg_scan_idx(dir, cpos);
    LAS float* TOT = (LAS float*)lds;
    LAS bf16* KLT = (LAS bf16*)(lds + 2048) + dir * 64 * HST;
    LAS bf16* VT = (LAS bf16*)(lds + 2048 + 2 * 64 * HST * 2) + dir * 64 * HST;
    const float lb = hg_lb(a, l, dir, head, lane);
    const int fcol = (dir == 0 ? COL_HFF : COL_HFB) + head * 64 + lane, vcol = COL_HI + head * 64 + lane;
    float kk[16], cl[16]; float run = 0.f;
#pragma unroll
    for (int i = 0; i < 16; ++i) { const int n = 16 * I + i, row = base + (dir ? 63 - n : n);
        const float fl = bflo((unsigned)PROJ[(size_t)row * INW + fcol]);
        const unsigned short vb = PROJ[(size_t)row * INW + vcol];
        const float f = lb + (1.0f - lb) * sigm1(fl);
        run += __logf(f); cl[i] = run; kk[i] = 1.0f - f;
        VT[lane * HST + n] = vb; }
    TOT[(dir * 4 + I) * 64 + lane] = run;
    __syncthreads();
    float post = 0.f, all = 0.f;
#pragma unroll
    for (int J = 0; J < 4; ++J) { const float t = TOT[(dir * 4 + J) * 64 + lane]; all += t; if (J > I) post += t; }
#pragma unroll
    for (int i = 0; i < 16; ++i) KLT[lane * HST + 16 * I + i] = (bf16)f2bf(kk[i] * __expf(run - cl[i] + post));
    if (I == 0) ((float*)(a->ws + WS_HDG))[((size_t)(dir * 4 + head) * 260 + ci) * 64 + lane] = __expf(all);
    __syncthreads();
    float* LT = (float*)(a->ws + WS_HLT) + ((size_t)(dir * 4 + head) * 260 + ci) * 4096;
    float z0 = 0.f; asm volatile("" : "+v"(z0));
#pragma unroll
    for (int kb = 0; kb < 4; ++kb) { f32x4 acc = {z0, z0, z0, z0};
        acc = mma16(VT + 16 * I * HST, KLT + 16 * kb * HST, 0, acc, lane); acc = mma16(VT + 16 * I * HST, KLT + 16 * kb * HST, 32, acc, lane);
#pragma unroll
        for (int r = 0; r < 4; ++r) LT[(16 * I + 4 * (lane >> 4) + r) * 64 + 16 * kb + (lane & 15)] = acc[r]; }
    __syncthreads();
}
__device__ __forceinline__ void hgrn_stepB(KA a, int item, int tid) {
    const int dh = item >> 3, vb = item & 7, v = vb * 8 + (tid >> 6), k = tid & 63;
    const float* LT = (const float*)(a->ws + WS_HLT) + (size_t)dh * 260 * 4096 + v * 64 + k;
    const float* DG = (const float*)(a->ws + WS_HDG) + (size_t)dh * 260 * 64 + k;
    bf16* SP = (bf16*)(a->ws + WS_HSP) + (size_t)dh * 260 * 4096 + v * 64 + k;
    float S = 0.f;
#pragma unroll 1
    for (int c0 = 0; c0 < 260; c0 += 26) {
        float lt[26], dg[26];
#pragma unroll
        for (int j = 0; j < 26; ++j) { lt[j] = LT[(size_t)(c0 + j) * 4096]; dg[j] = DG[(c0 + j) * 64]; }
#pragma unroll
        for (int j = 0; j < 26; ++j) { SP[(size_t)(c0 + j) * 4096] = (bf16)f2bf(S); S = dg[j] * S + lt[j]; }
    }
}
__device__ __forceinline__ void hgrn_stepC(KA a, int l, int cpos, int head, LAS unsigned char* lds, int tid, int lane, int wave) {
    const bf16* PROJ = (const bf16*)(a->ws + WS_PROJ); bf16* MIX = (bf16*)(a->ws + WS_MIX);
    const int dir = wave >> 2, I = wave & 3, base = hg_base_row(cpos), ci = hg_scan_idx(dir, cpos);
    constexpr int MSZ = 64 * HST;
    LAS float* TOT = (LAS float*)lds;
    LAS bf16* img = (LAS bf16*)(lds + 2048);
    LAS bf16* QT = img + dir * MSZ;
    LAS bf16* QD = img + 2 * MSZ + dir * MSZ;
    LAS bf16* VT = img + 4 * MSZ + dir * MSZ;
    LAS bf16* ST = img + 6 * MSZ + dir * MSZ;
    LAS bf16* AS = img + 8 * MSZ + dir * MSZ + I * 16 * HST;
    LAS bf16* KT = img + 10 * MSZ + dir * (10 * 16 * HST);
    LAS float* OS = (LAS float*)(img + 10 * MSZ);
    const float lb = hg_lb(a, l, dir, head, lane);
    const int fcol = (dir == 0 ? COL_HFF : COL_HFB) + head * 64 + lane, qcol = COL_HQ + head * 64 + lane, vcol = COL_HI + head * 64 + lane;
    { const bf16* SP = (const bf16*)(a->ws + WS_HSP) + ((size_t)(dir * 4 + head) * 260 + ci) * 4096;
#pragma unroll
      for (int h2 = 0; h2 < 2; ++h2) { const int e = ((I * 2 + h2) * 64 + lane) * 8, vv = e >> 6, kk0 = e & 63;
          *(LAS v4u*)(ST + vv * HST + kk0) = *(const GAS v4u*)(SP + e); } }
    float kk[16], cl[16], qv[16]; float run = 0.f;
#pragma unroll
    for (int i = 0; i < 16; ++i) { const int n = 16 * I + i, row = base + (dir ? 63 - n : n);
        const float fl = bflo((unsigned)PROJ[(size_t)row * INW + fcol]), ql = bflo((unsigned)PROJ[(size_t)row * INW + qcol]);
        const unsigned short vb = PROJ[(size_t)row * INW + vcol];
        const float f = lb + (1.0f - lb) * sigm1(fl);
        run += __logf(f); cl[i] = run; kk[i] = 1.0f - f; qv[i] = silu1(ql) * 0.125f;
        VT[lane * HST + n] = vb; }
    TOT[(dir * 4 + I) * 64 + lane] = run;
    __syncthreads();
    float tj[4];
#pragma unroll
    for (int J = 0; J < 4; ++J) tj[J] = TOT[(dir * 4 + J) * 64 + lane];
    float pre = 0.f;
#pragma unroll
    for (int J = 0; J < 4; ++J) if (J < I) pre += tj[J];
    const float epre = __expf(pre); float kei[16];
#pragma unroll
    for (int i = 0; i < 16; ++i) { const float e = __expf(cl[i]); QT[(16 * I + i) * HST + lane] = (bf16)f2bf(qv[i] * e); QD[(16 * I + i) * HST + lane] = (bf16)f2bf(qv[i] * e * epre); kei[i] = kk[i] * fminf(__builtin_amdgcn_rcpf(e), 5.5e34f); }
    float eoff = 0.f;
#pragma unroll
    for (int I2 = 0; I2 < 4; ++I2) {
        if (I2 >= I) {
            if (I2 == I) eoff = 0.f; else if (I2 == I + 1) eoff = run; else eoff += tj[I2 - 1];
            LAS bf16* blk = KT + (I2 * (I2 + 1) / 2 + I) * 16 * HST;
            const float fo = __expf(eoff);
#pragma unroll
            for (int i = 0; i < 16; ++i) blk[i * HST + lane] = (bf16)f2bf(kei[i] * fo);
        }
    }
    __syncthreads();
    float z0 = 0.f; asm volatile("" : "+v"(z0));
    f32x4 sc[4];
#pragma unroll
    for (int J = 0; J < 4; ++J) { sc[J] = (f32x4){z0, z0, z0, z0};
        if (J <= I) { const LAS bf16* kb = KT + (I * (I + 1) / 2 + J) * 16 * HST;
            sc[J] = mma16(QT + 16 * I * HST, kb, 0, sc[J], lane); sc[J] = mma16(QT + 16 * I * HST, kb, 32, sc[J], lane);
            if (J == I) {
#pragma unroll
                for (int r = 0; r < 4; ++r) if ((lane & 15) > 4 * (lane >> 4) + r) sc[J][r] = z0; } } }
#pragma unroll
    for (int J = 0; J < 4; ++J)
#pragma unroll
        for (int r = 0; r < 4; ++r) AS[(4 * (lane >> 4) + r) * HST + 16 * J + (lane & 15)] = (bf16)f2bf(sc[J][r]);
    asm volatile("s_waitcnt lgkmcnt(0)" ::: "memory");
    f32x4 acc[4];
#pragma unroll
    for (int vb = 0; vb < 4; ++vb) { acc[vb] = (f32x4){z0, z0, z0, z0};
        acc[vb] = mma16(AS, VT + 16 * vb * HST, 0, acc[vb], lane); acc[vb] = mma16(AS, VT + 16 * vb * HST, 32, acc[vb], lane);
        acc[vb] = mma16(QD + 16 * I * HST, ST + 16 * vb * HST, 0, acc[vb], lane); acc[vb] = mma16(QD + 16 * I * HST, ST + 16 * vb * HST, 32, acc[vb], lane); }
    __syncthreads();
#pragma unroll
    for (int vb = 0; vb < 4; ++vb)
#pragma unroll
        for (int r = 0; r < 4; ++r) { const int n = 16 * I + 4 * (lane >> 4) + r, rl = dir ? 63 - n : n; OS[(dir * 64 + rl) * 68 + 16 * vb + (lane & 15)] = acc[vb][r]; }
    __syncthreads();
    { const int rl = tid >> 3, v8 = (tid & 7) * 8, row = base + rl;
      float o[8]; float ss = 0.f;
#pragma unroll
      for (int j = 0; j < 8; ++j) { o[j] = OS[rl * 68 + v8 + j] + OS[(64 + rl) * 68 + v8 + j]; ss += o[j] * o[j]; }
      ss += sx<1>(ss); ss += sx<2>(ss); ss += sx<4>(ss);
      const float rstd = __builtin_amdgcn_rsqf(ss * (1.0f / 64.0f) + EPS);
      float gt[8]; unpack8(*(const GAS v4u*)(PROJ + (size_t)row * INW + COL_HG + head * 64 + v8), gt);
      const float* gn = a->in[I_HGAIN] + l * 64 + v8;
      float y[8];
#pragma unroll
      for (int j = 0; j < 8; ++j) y[j] = o[j] * rstd * gn[j] * silu1(gt[j]);
      v4u w; w.x = pk2(y[0], y[1]); w.y = pk2(y[2], y[3]); w.z = pk2(y[4], y[5]); w.w = pk2(y[6], y[7]);
      *(GAS v4u*)(MIX + (size_t)row * DM + MIX_HG + head * 64 + v8) = w; }
    __syncthreads();
}

__device__ __forceinline__ void vt_item(KA a, int item, int lane) {
    const bf16* PROJ = (const bf16*)(a->ws + WS_PROJ); bf16* VTg = (bf16*)(a->ws + WS_VT);
    const int rb = item >> 1, hk = item & 1, row = rb * 64 + lane;
    const bf16* p = PROJ + (size_t)row * INW + COL_AV + hk * 64;
    unsigned w[32];
#pragma unroll
    for (int c = 0; c < 8; ++c) { const v4u t = *(const GAS v4u*)(p + 8 * c); w[4 * c] = t.x; w[4 * c + 1] = t.y; w[4 * c + 2] = t.z; w[4 * c + 3] = t.w; }
    bf16* o = VTg + (size_t)hk * 64 * R_ALL + row;
#pragma unroll
    for (int d2 = 0; d2 < 32; ++d2) { o[(size_t)(2 * d2) * R_ALL] = (bf16)(w[d2] & 0xffffu); o[(size_t)(2 * d2 + 1) * R_ALL] = (bf16)(w[d2] >> 16); }
}
__device__ __forceinline__ void attn_unit(KA a, int l, int u, LAS unsigned char* lds, int tid, int lane, int wave) {
    asm volatile("" : "+v"(tid), "+v"(lane));
    const bf16* PROJ = (const bf16*)(a->ws + WS_PROJ); const bf16* VTg = (const bf16*)(a->ws + WS_VT); bf16* MIX = (bf16*)(a->ws + WS_MIX);
    const bool isctx = u >= 256; const int uu = isctx ? u - 256 : u; const int n = uu >> 1, hk = uu & 1;
    const int qh = hk * 4 + (wave >> 1), half = wave & 1;
    const int qbase = (isctx ? S_LAT : 0) + n * 128 + half * 64, qpos0 = n * 128 + half * 64;
    const int c = lane & 15, g = lane >> 4;
    LAS bf16* Kt = (LAS bf16*)lds; LAS bf16* Vt = Kt + 64 * HST; LAS bf16* Qw = Vt + 64 * HST + wave * 64 * HST;
#pragma unroll
    for (int j = 0; j < 8; ++j) { const int qr = 8 * j + (lane >> 3), qc = (lane & 7) * 8;
        *(LAS v4u*)(Qw + qr * HST + qc) = *(const GAS v4u*)(PROJ + (size_t)(qbase + qr) * INW + qh * 64 + qc); }
    float z0 = 0.f; asm volatile("" : "+v"(z0));
    f32x4 o[4][4]; float ls[4];
    float gq = 0.f, gk = 0.f;
#pragma unroll 8
    for (int d = 0; d < 64; ++d) { gq = fmaxf(gq, fabsf(a->in[I_QG][l * 64 + d])); gk = fmaxf(gk, fabsf(a->in[I_KG][l * 64 + d])); }
    const float nbnd = -(8.0f * 1.4426950408889634f) * gq * gk;
    const f32x4 nb4 = {nbnd, nbnd, nbnd, nbnd};
    const float sink = a->in[I_SINK][l * 8 + qh] * 1.4426950408889634f;
#pragma unroll
    for (int qt = 0; qt < 4; ++qt) { ls[qt] = (g == 0) ? __builtin_amdgcn_exp2f(sink + nbnd) : z0;
#pragma unroll
        for (int dt = 0; dt < 4; ++dt) o[qt][dt] = (f32x4){z0, z0, z0, z0}; }
    const int first = (!isctx && n == 0) ? 2 : 0, nwin = isctx ? 0 : ((n == 0 || n == 127) ? 4 : 6), nt = nwin + 4;
    const int lr = tid >> 3, lc = (tid & 7) * 8;
    v4u kreg, vreg;
#define ATT_LOADT(i) do { const bool ct_ = (i) >= nwin; const int kb_ = ct_ ? S_LAT + 64 * ((i) - nwin) : (n - 1) * 128 + 64 * (first + (i)); \
        kreg = *(const GAS v4u*)(PROJ + (size_t)(kb_ + lr) * INW + COL_AK + hk * 64 + lc); vreg = *(const GAS v4u*)(VTg + ((size_t)hk * 64 + lr) * R_ALL + kb_ + lc); } while (0)
    ATT_LOADT(0);
#pragma unroll 1
    for (int i = 0; i < nt; ++i) {
        __syncthreads();
        *(LAS v4u*)(Kt + lr * HST + lc) = kreg; *(LAS v4u*)(Vt + lr * HST + lc) = vreg;
        __syncthreads();
        if (i + 1 < nt) ATT_LOADT(i + 1);
        const bool win = i < nwin; const int kb = (n - 1) * 128 + 64 * (first + i);
        const int rel = kb - qpos0;
        const bool maskw = win && (rel == 128 || rel == -128);
        if (win && (rel >= 192 || rel <= -192)) continue;
        bf16x8v kf[4][2], vf[4][2];
#pragma unroll
        for (int kt = 0; kt < 4; ++kt)
#pragma unroll
            for (int ks = 0; ks < 2; ++ks) kf[kt][ks] = *(const LAS bf16x8v*)(Kt + (16 * kt + c) * HST + 32 * ks + 8 * g);
#pragma unroll
        for (int dt = 0; dt < 4; ++dt)
#pragma unroll
            for (int s2 = 0; s2 < 2; ++s2) { const v2u lo = *(const LAS v2u*)(Vt + (16 * dt + c) * HST + 32 * s2 + 4 * g), hi = *(const LAS v2u*)(Vt + (16 * dt + c) * HST + 32 * s2 + 16 + 4 * g);
                const v4u t = {lo.x, lo.y, hi.x, hi.y}; vf[dt][s2] = __builtin_bit_cast(bf16x8v, t); }
        f32x4 sA[4], sB[4];
#define ATT_SCORES(QT, S_) do { const bf16x8v q0_ = *(const LAS bf16x8v*)(Qw + (16 * (QT) + c) * HST + 8 * g), q1_ = *(const LAS bf16x8v*)(Qw + (16 * (QT) + c) * HST + 32 + 8 * g); \
            _Pragma("unroll") for (int kt = 0; kt < 4; ++kt) { S_[kt] = __builtin_amdgcn_mfma_f32_16x16x32_bf16(kf[kt][0], q0_, nb4, 0, 0, 0); S_[kt] = __builtin_amdgcn_mfma_f32_16x16x32_bf16(kf[kt][1], q1_, S_[kt], 0, 0, 0); } } while (0)
#define ATT_REST(QT, S_) do { \
            if (maskw) { const int dq = qpos0 + 16 * (QT) + c - kb - 4 * g; \
                _Pragma("unroll") for (int kt = 0; kt < 4; ++kt) _Pragma("unroll") for (int r = 0; r < 4; ++r) { const int dl = dq - 16 * kt - r; if (dl > 128 || dl < -128) S_[kt][r] = -INFINITY; } } \
            float ps = 0.f; \
            _Pragma("unroll") for (int kt = 0; kt < 4; ++kt) _Pragma("unroll") for (int r = 0; r < 4; ++r) { S_[kt][r] = __builtin_amdgcn_exp2f(S_[kt][r]); ps += S_[kt][r]; } \
            ls[QT] += ps; \
            bf16x8v pb[2]; \
            _Pragma("unroll") for (int s2 = 0; s2 < 2; ++s2) { const v4u t = {pk2(S_[2 * s2][0], S_[2 * s2][1]), pk2(S_[2 * s2][2], S_[2 * s2][3]), pk2(S_[2 * s2 + 1][0], S_[2 * s2 + 1][1]), pk2(S_[2 * s2 + 1][2], S_[2 * s2 + 1][3])}; pb[s2] = __builtin_bit_cast(bf16x8v, t); } \
            _Pragma("unroll") for (int dt = 0; dt < 4; ++dt) { o[QT][dt] = __builtin_amdgcn_mfma_f32_16x16x32_bf16(vf[dt][0], pb[0], o[QT][dt], 0, 0, 0); o[QT][dt] = __builtin_amdgcn_mfma_f32_16x16x32_bf16(vf[dt][1], pb[1], o[QT][dt], 0, 0, 0); } } while (0)
        ATT_SCORES(0, sA);
        ATT_SCORES(1, sB); ATT_REST(0, sA);
        ATT_SCORES(2, sA); ATT_REST(1, sB);
        ATT_SCORES(3, sB); ATT_REST(2, sA);
        ATT_REST(3, sB);
#undef ATT_SCORES
#undef ATT_REST
    }
#undef ATT_LOADT
    int c2 = lane & 15, g2 = lane >> 4; asm volatile("" : "+v"(c2), "+v"(g2));
#pragma unroll
    for (int qt = 0; qt < 4; ++qt) { float lt = ls[qt]; lt += sx<16>(lt); lt = sx32_add(lt); const float inv = 1.0f / lt;
        bf16* op = (bf16*)(a->ws + WS_MIX) + (size_t)(qbase + 16 * qt + c2) * DM + MIX_AT + qh * 64 + 4 * g2;
#pragma unroll
        for (int dt = 0; dt < 4; ++dt) { v2u w; w.x = pk2(o[qt][dt][0] * inv, o[qt][dt][1] * inv); w.y = pk2(o[qt][dt][2] * inv, o[qt][dt][3] * inv); *(GAS v2u*)(op + 16 * dt) = w; } }
}

constexpr int GST = 136;
__device__ __forceinline__ f32x4 mma16g(const LAS bf16* MA, const LAS bf16* MBt, int k0, f32x4 c, int lane) {
    const bf16x8v av = *(const LAS bf16x8v*)(MA + (lane & 15) * GST + k0 + 8 * (lane >> 4));
    const bf16x8v bv = *(const LAS bf16x8v*)(MBt + (lane & 15) * GST + k0 + 8 * (lane >> 4));
    return __builtin_amdgcn_mfma_f32_16x16x32_bf16(av, bv, c, 0, 0, 0);
}
__device__ __forceinline__ float gelu_as(float v) {
    const float av = fabsf(v), t = __builtin_amdgcn_rcpf(av * 0.2316418882f + 1.0f);
    float q = t * 0.5307027145f + (-0.7265760135f); q = q * t + 0.7107068705f; q = q * t + (-0.142248368f); q = q * t + 0.127414796f; q = q * t;
    const float e = __builtin_amdgcn_exp2f((v * v) * (-0.72134752044f)), mm = v * (q * e);
    return v < 0.f ? mm : v - mm;
}
__device__ __forceinline__ void gmlp_unit_mma(KA a, int l, int chunk, int g, LAS unsigned char* lds, int tid, int lane, int wave) {
    const bf16* PROJ = (const bf16*)(a->ws + WS_PROJ); bf16* MIX = (bf16*)(a->ws + WS_MIX);
    const int row0 = (chunk < 128) ? chunk * 128 : S_LAT + (chunk - 128) * 128;
    LAS bf16* WA = (LAS bf16*)lds;
    LAS bf16* VNT = WA + 128 * GST;
    LAS float* OUT = (LAS float*)(VNT + 64 * GST);
    const int pos = tid >> 2, part = tid & 3;
    {
      const float* W = a->in[I_GWS] + ((size_t)(l * 4 + g) * 128 + pos) * 128 + part * 32;
#pragma unroll
      for (int j = 0; j < 4; ++j) { const f32x4 w0 = *(const GAS f32x4*)(W + 8 * j), w1 = *(const GAS f32x4*)(W + 8 * j + 4);
          v4u o; o.x = pk2(w0.x, w0.y); o.y = pk2(w0.z, w0.w); o.z = pk2(w1.x, w1.y); o.w = pk2(w1.z, w1.w);
          *(LAS v4u*)(WA + pos * GST + part * 32 + 8 * j) = o; } }
    { const bf16* p = PROJ + (size_t)(row0 + pos) * INW + COL_GV + g * 64 + part * 16;
      float x[16]; unpack8(*(const GAS v4u*)p, x); unpack8(*(const GAS v4u*)(p + 8), x + 8);
      float ss = 0.f;
#pragma unroll
      for (int d = 0; d < 16; ++d) { x[d] = gelu_as(x[d]); ss += x[d] * x[d]; }
      ss += sx<1>(ss); ss += sx<2>(ss);
      const float rstd = __builtin_amdgcn_rsqf(ss * (1.0f / 64.0f) + EPS);
      const float* gn = a->in[I_GNG] + l * 256 + g * 64 + part * 16;
#pragma unroll
      for (int d = 0; d < 16; ++d) VNT[(part * 16 + d) * GST + pos] = (bf16)f2bf(x[d] * rstd * gn[d]); }
    __syncthreads();
    float z0 = 0.f; asm volatile("" : "+v"(z0));
#pragma unroll
    for (int cb = 0; cb < 4; ++cb) { f32x4 acc = {z0, z0, z0, z0};
#pragma unroll
        for (int ks = 0; ks < 4; ++ks) acc = mma16g(WA + 16 * wave * GST, VNT + 16 * cb * GST, 32 * ks, acc, lane);
#pragma unroll
        for (int r = 0; r < 4; ++r) OUT[(16 * wave + 4 * (lane >> 4) + r) * 68 + 16 * cb + (lane & 15)] = acc[r]; }
    __syncthreads();
    { const int row = row0 + pos; const float bsv = a->in[I_GBS][(l * 4 + g) * 128 + pos];
      const bf16* pu = PROJ + (size_t)row * INW + COL_GU + g * 64 + part * 16;
      float u[16]; unpack8(*(const GAS v4u*)pu, u); unpack8(*(const GAS v4u*)(pu + 8), u + 8);
      float y[16];
#pragma unroll
      for (int d = 0; d < 16; ++d) y[d] = gelu_as(u[d]) * (OUT[pos * 68 + part * 16 + d] + bsv);
      bf16* po = MIX + (size_t)row * DM + MIX_GM + g * 64 + part * 16;
      v4u w; w.x = pk2(y[0], y[1]); w.y = pk2(y[2], y[3]); w.z = pk2(y[4], y[5]); w.w = pk2(y[6], y[7]); *(GAS v4u*)po = w;
      w.x = pk2(y[8], y[9]); w.y = pk2(y[10], y[11]); w.z = pk2(y[12], y[13]); w.w = pk2(y[14], y[15]); *(GAS v4u*)(po + 8) = w; }
    __syncthreads();
}
__device__ __forceinline__ void attn_naive(KA a, int l, int nrows, int lane, int wave, int G, int bid) {
    const bf16* PROJ = (const bf16*)(a->ws + WS_PROJ); bf16* MIX = (bf16*)(a->ws + WS_MIX);
    const int gw = bid * NWAVES + wave, NGW = G * NWAVES;
    for (int pair = gw; pair < nrows * 2; pair += NGW) {
        const int row = pair >> 1, hk = pair & 1; const bool isctx = row >= S_LAT;
        float q[4], o[4], m[4], ls[4];
#pragma unroll
        for (int g = 0; g < 4; ++g) { q[g] = bflo((unsigned)PROJ[(size_t)row * INW + (hk * 4 + g) * 64 + lane]); o[g] = 0.f; ls[g] = 1.0f; m[g] = a->in[I_SINK][l * 8 + hk * 4 + g] * 1.4426950408889634f; }
        int j0 = 0, j1 = -1;
        if (!isctx) { j0 = row - 128 < 0 ? 0 : row - 128; j1 = row + 128 > S_LAT - 1 ? S_LAT - 1 : row + 128; }
        const int nwin = j1 - j0 + 1;
        const int nk = nwin + C_CTX;
#pragma unroll 4
        for (int t = 0; t < nk; ++t) {
            const int krow = (t < nwin) ? j0 + t : S_LAT + (t - nwin);
            const float k = bflo((unsigned)PROJ[(size_t)krow * INW + COL_AK + hk * 64 + lane]);
            const float v = bflo((unsigned)PROJ[(size_t)krow * INW + COL_AV + hk * 64 + lane]);
#pragma unroll
            for (int g = 0; g < 4; ++g) { const float s = wave_sum(q[g] * k); const float mn = fmaxf(m[g], s);
                const float c = __builtin_amdgcn_exp2f(m[g] - mn), p = __builtin_amdgcn_exp2f(s - mn);
                ls[g] = ls[g] * c + p; o[g] = o[g] * c + p * v; m[g] = mn; }
        }
#pragma unroll
        for (int g = 0; g < 4; ++g) MIX[(size_t)row * DM + MIX_AT + (hk * 4 + g) * 64 + lane] = (bf16)f2bf(o[g] / ls[g]);
    }
}
__device__ __forceinline__ void hgrn_combine(KA a, int l, int nrows, int lane, int wave, int G, int bid) {
    const bf16* PROJ = (const bf16*)(a->ws + WS_PROJ); bf16* MIX = (bf16*)(a->ws + WS_MIX);
    const float* O0 = (const float*)(a->ws + WS_HGO); const float* O1 = O0 + (size_t)R_ALL * 256;
    const f32x4 gn = *(const f32x4*)(a->in[I_HGAIN] + l * 64 + (lane & 15) * 4);
    const int gw = bid * NWAVES + wave, NGW = G * NWAVES;
    for (int r = gw; r < nrows; r += NGW) {
        const f32x4 o = *(const GAS f32x4*)(O0 + (size_t)r * 256 + 4 * lane) + *(const GAS f32x4*)(O1 + (size_t)r * 256 + 4 * lane);
        float ss = (o.x * o.x + o.y * o.y) + (o.z * o.z + o.w * o.w);
        ss += sx<1>(ss); ss += sx<2>(ss); ss += sx<4>(ss); ss += sx<8>(ss);
        const float rstd = __builtin_amdgcn_rsqf(ss * (1.0f / 64.0f) + EPS);
        const v2u gw2 = *(const GAS v2u*)(PROJ + (size_t)r * INW + COL_HG + 4 * lane);
        const float g0 = bflo(gw2.x), g1 = bfhi(gw2.x), g2 = bflo(gw2.y), g3 = bfhi(gw2.y);
        v2u w; w.x = pk2(o.x * rstd * gn.x * silu1(g0), o.y * rstd * gn.y * silu1(g1)); w.y = pk2(o.z * rstd * gn.z * silu1(g2), o.w * rstd * gn.w * silu1(g3));
        *(GAS v2u*)(MIX + (size_t)r * DM + MIX_HG + 4 * lane) = w;
    }
}
__device__ __forceinline__ void moe_gather(KA a, LAS unsigned char* lds, int tid, int lane, int wave, int G, int bid) {
    LAS int* sb = (LAS int*)lds;
    const unsigned* cnt = (const unsigned*)(a->ws + WS_CTL) + CW_MOECNT;
    int* mi = (int*)(a->ws + WS_VEC) + VO_MOE;
    if (tid < 8) sb[16 + tid] = (int)__hip_atomic_load(cnt + 64 * tid, RLX_AGENT);
    __syncthreads();
    if (tid == 0) { int b = 0;
#pragma unroll
        for (int e = 0; e < 8; ++e) { sb[e] = b; b += ((sb[16 + e] + 255) >> 8) << 8; }
        sb[8] = b; }
    __syncthreads();
    if (bid == 0) {
        if (tid == 0) mi[0] = sb[8] >> 8;
        if (tid < 8) mi[160 + tid] = sb[tid + 1] >> 8;
        for (int t = tid; t < (sb[8] >> 8); t += NTHR) { int e = 0;
#pragma unroll
            for (int j = 1; j < 8; ++j) e += (t >= (sb[j] >> 8)) ? 1 : 0;
            mi[16 + t] = e; } }
    const unsigned char* H8 = (const unsigned char*)(a->ws + WS_H2B); unsigned char* AS = (unsigned char*)(a->ws + WS_AS);
    const int* tokinfo = (const int*)(a->ws + WS_TOK); int* tokslot = (int*)(a->ws + WS_TOK) + S_LAT * 8;
    const int gw = bid * NWAVES + wave, NGW = G * NWAVES;
    for (int t = gw; t < S_LAT; t += NGW) {
        const int* ti = tokinfo + (size_t)t * 8;
        const int e1 = ti[0], e2 = ti[1], r1 = ti[2], r2 = ti[3];
        const int s1 = sb[e1] + r1, s2 = sb[e2] + r2;
        const v4u x0 = ((const GAS v4u*)(H8 + (size_t)t * DM))[lane];
        ((GAS v4u*)(AS + (size_t)s1 * DM))[lane] = x0; ((GAS v4u*)(AS + (size_t)s2 * DM))[lane] = x0;
        if (lane == 0) { int* ts = tokslot + (size_t)t * 4; ts[0] = s1; ts[1] = s2; ts[2] = ti[4]; ts[3] = ti[5]; }
    }
    { const f32x4 z4 = {0.f, 0.f, 0.f, 0.f}; for (int i = bid * NTHR + tid; i < 8 * 256 * DM / 4; i += G * NTHR) ((GAS f32x4*)(a->ws + WS_YF))[i] = z4; }
    for (int e = 0; e < 8; ++e) { const int c = sb[16 + e], pe = (c + 255) & ~255, b = sb[e];
        for (int j = c + gw; j < pe; j += NGW) { const v4u z = {0u, 0u, 0u, 0u}; ((GAS v4u*)(AS + (size_t)(b + j) * DM))[lane] = z; } }
}
__device__ __forceinline__ void moe_combine(KA a, int lane, int wave, int G, int bid) {
    const float* gf = (const float*)(a->ws + WS_VEC) + VO_MOD + (1 * 2 + 0) * 6144 + 5 * 1024;
    const bf16* Y = (const bf16*)(a->ws + WS_Y); const int* tokslot = (const int*)(a->ws + WS_TOK) + S_LAT * 8;
    const int gw = bid * NWAVES + wave, NGW = G * NWAVES;
    for (int t = gw; t < S_LAT; t += NGW) {
        const int* ts = tokslot + (size_t)t * 4; const int s1 = ts[0], s2 = ts[1]; const float w1 = __builtin_bit_cast(float, ts[2]), w2 = __builtin_bit_cast(float, ts[3]);
        GAS f32x4* xr = (GAS f32x4*)(a->out + (size_t)t * DM) + lane; const GAS v2u* xbr = (const GAS v2u*)((const bf16*)(a->ws + WS_XB) + (size_t)t * DM) + lane;
        const float* YF = (const float*)(a->ws + WS_YF);
#pragma unroll
        for (int j = 0; j < 4; ++j) { const f32x4 g = *(const f32x4*)(gf + 4 * lane + 256 * j); const v2u xt = xbr[64 * j]; f32x4 x = (f32x4){bflo(xt.x), bfhi(xt.x), bflo(xt.y), bfhi(xt.y)}; f32x4 p, q;
            if (s1 < 32768) { const v2u t = ((const GAS v2u*)(Y + (size_t)s1 * DM) + lane)[64 * j]; p = (f32x4){bflo(t.x), bfhi(t.x), bflo(t.y), bfhi(t.y)}; } else p = ((const GAS f32x4*)(YF + (size_t)(s1 - 32768) * DM) + lane)[64 * j];
            if (s2 < 32768) { const v2u t = ((const GAS v2u*)(Y + (size_t)s2 * DM) + lane)[64 * j]; q = (f32x4){bflo(t.x), bfhi(t.x), bflo(t.y), bfhi(t.y)}; } else q = ((const GAS f32x4*)(YF + (size_t)(s2 - 32768) * DM) + lane)[64 * j];
            x = x + g * (p * w1 + q * w2);
            __builtin_nontemporal_store(x, (f32x4*)(xr + 64 * j)); }
    }
}

#define IN(k) (lo <= (k) && (k) < hi)
#define GRIDBAR() do { XcdBarrier b2_; b2_.bar = (unsigned*)(KARGS()->ws + WS_CTL) + CW_BAR; b2_.x = xb_xcc_id(); b2_.st = (volatile LAS unsigned*)(lds + MISC_OFF) + 8; xcd_barrier(b2_, wv0 * 64 + (int)__builtin_amdgcn_mbcnt_hi(~0u, __builtin_amdgcn_mbcnt_lo(~0u, 0u))); } while (0)
#define SEAM(k) do { if (IN(k) && IN((k) + 1)) GRIDBAR(); } while (0)
#define PHASE_ROOTS() KA a = KARGS(); unsigned char* ws = a->ws; const float* vec = (const float*)(ws + WS_VEC); (void)vec; int bid = blockIdx.x, G = gridDim.x; asm volatile("" : "+s"(bid), "+s"(G)); int tid = wv0 * 64 + (int)__builtin_amdgcn_mbcnt_hi(~0u, __builtin_amdgcn_mbcnt_lo(~0u, 0u)); asm volatile("" : "+v"(tid)); const int lane = tid & 63, wave = __builtin_amdgcn_readfirstlane(tid >> 6); (void)lane; (void)wave

template <int l> __device__ __forceinline__ void layer_body(const int lo, const int hi, LAS unsigned char* lds, const int wv0) {
        const int pb = 1 + 11 * l;
        if (IN(pb + 0)) { PHASE_ROOTS(); phase_norm(a, l, 0, R_ALL, (bf16*)(ws + WS_H), lane, wave, G, bid); SEAM(pb + 0); }
        if (IN(pb + 1)) {
            PHASE_ROOTS();
            pg8::Gemm g{(const pg8::bf16_t*)(ws + WS_H), (const pg8::bf16_t*)(ws + WS_WIN) + (size_t)l * INW * DM, R_ALL, INW, DM, 0, DM};
            pg8::StaticOrder S; S.init(R_ALL, INW, G, bid);
            pg8::EpiBf16<0> E{(pg8::bf16_t*)(ws + WS_PROJ), INW, nullptr, 0, 0, 1.f};
            pg8::gemm_phase<pg8::EpiBf16<0>, pg8::StaticOrder, true, true>(lds, g, S, E, tid);
            moe_conv_range(a, l == 0 ? MOE_SL0 : MOE_SL2, l == 0 ? MOE_SL1 : MOE_SL3, 650 - 2 * 256, lds, lane, wave, G, bid);
            SEAM(pb + 1);
        }
        if (IN(pb + 2)) {
            PHASE_ROOTS();
            qk_prep(a, l, (G - 1 - bid) * NTHR + tid, G * NTHR);
            for (int it = ((bid + G - 80) % G) * NWAVES + wave; it < 520; it += G * NWAVES) vt_item(a, it, lane);
            for (int it = bid; it < 1040; it += G) hgrn_stepA(a, l, it >> 2, it & 3, lds, lane, wave);
            { __syncthreads(); moe_conv_range(a, l == 0 ? MOE_SL3 : MOE_SL7, l == 0 ? MOE_SL4 : MOE_DEFER, 1040 - 4 * 256, lds, lane, wave, G, bid); }
            SEAM(pb + 2);
        }
        if (IN(pb + 3)) {
            PHASE_ROOTS();
            if (bid < 64) hgrn_stepB(a, bid, tid);
            {
                const int nu = (l == 0) ? 260 : 256, ng = (l == 0) ? 520 : 512;
                unsigned* qctr = (unsigned*)(ws + WS_CTL) + CW_QUEUE + 64 * l;
                volatile LAS unsigned* qslot = (volatile LAS unsigned*)(lds + MISC_OFF) + 16;
                for (;;) {
                    __syncthreads();
                    if (tid == 0) qslot[0] = __hip_atomic_fetch_add(qctr, 1u, RLX_AGENT);
                    __syncthreads();
                    const int it = __builtin_amdgcn_readfirstlane((int)qslot[0]);
                    if (it >= nu + ng) break;
                    if (it < nu) attn_unit(a, l, it, lds, tid, lane, wave);
                    else gmlp_unit_mma(a, l, (it - nu) >> 2, (it - nu) & 3, lds, tid, lane, wave);
                }
            }
            SEAM(pb + 3);
        }
        if (IN(pb + 4)) {
            PHASE_ROOTS();
            const int nit = (l == 0) ? 1040 : 1024;
            for (int it = bid; it < nit; it += G) hgrn_stepC(a, l, it >> 2, it & 3, lds, tid, lane, wave);
            if (l == 0) { __syncthreads(); moe_conv_range(a, MOE_SL4, MOE_SL5, 1040 - 4 * 256, lds, lane, wave, G, bid); }
            SEAM(pb + 4);
        }
        if (IN(pb + 5)) {
            PHASE_ROOTS();
            const float* modl = vec + VO_MOD + (l * 2 + 0) * 6144; const float* modc = vec + VO_MOD + (l * 2 + 1) * 6144;
            const int M = S_LAT;
            pg8::Gemm g{(const pg8::bf16_t*)(ws + WS_MIX), (const pg8::bf16_t*)(ws + WS_WOUT) + (size_t)l * DM * DM, M, DM, DM, 0, DM};
            pg8::StaticOrder S; S.init(M, DM, G, bid);
            if (l == 0) { pg8::EpiResidB<false> E{a->in[I_X], (pg8::bf16_t*)(ws + WS_XB), modl + 2048, DM};
                pg8::gemm_phase<pg8::EpiResidB<false>, pg8::StaticOrder, true, true>(lds, g, S, E, tid); }
            else { pg8::EpiResidB<true> E{ws + WS_XB, (pg8::bf16_t*)(ws + WS_XB), modl + 2048, DM};
                pg8::gemm_phase<pg8::EpiResidB<true>, pg8::StaticOrder, true, true>(lds, g, S, E, tid); }
            if (l == 0) {
                pg8::Gemm g2{(const pg8::bf16_t*)(ws + WS_MIX), (const pg8::bf16_t*)(ws + WS_WOUT), R_ALL, DM, 256, 0, DM};
                pg8::SplitKOrder S2{S_LAT / 256, 4, 4, 256, 16, bid, nullptr};
                pg8::EpiPart E2{(float*)(ws + WS_PART1), modc + 2048, S_LAT / 256, 256, DM};
                pg8::gemm_phase<pg8::EpiPart, pg8::SplitKOrder, false, true>(lds, g2, S2, E2, tid);
                moe_conv_range(a, MOE_SL5, MOE_SL6, 16, lds, lane, wave, G, bid);
            }
            SEAM(pb + 5);
        }
        if (l == 0) {
            if (IN(pb + 6)) { PHASE_ROOTS(); phase_norm(a, l, 1, R_ALL, (bf16*)(ws + WS_H), lane, wave, G, bid); SEAM(pb + 6); }
            if (IN(pb + 7)) {
                PHASE_ROOTS();
                pg8::Gemm g{(const pg8::bf16_t*)(ws + WS_H), (const pg8::bf16_t*)(ws + WS_WGU), R_ALL, 2 * FFN, DM, 0, DM};
                pg8::StaticOrder S; S.init(R_ALL, 2 * FFN, G, bid);
                pg8::EpiSwiGLU E{(pg8::bf16_t*)(ws + WS_HID), FFN, 1.0f};
                pg8::gemm_phase<pg8::EpiSwiGLU, pg8::StaticOrder, true, true>(lds, g, S, E, tid);
                moe_conv_range(a, MOE_SL1, MOE_SL2, 1430 - 5 * 256, lds, lane, wave, G, bid);
                SEAM(pb + 7);
            }
            if (IN(pb + 8)) {
                PHASE_ROOTS();
                const float* modl = vec + VO_MOD + (l * 2 + 0) * 6144; const float* modc = vec + VO_MOD + (l * 2 + 1) * 6144;
                pg8::Gemm g{(const pg8::bf16_t*)(ws + WS_HID), (const pg8::bf16_t*)(ws + WS_WD), S_LAT, DM, FFN, 0, FFN};
                pg8::StaticOrder S; S.init(S_LAT, DM, G, bid);
                pg8::EpiResidB<true> E{ws + WS_XB, (pg8::bf16_t*)(ws + WS_XB), modl + 5120, DM};
                pg8::gemm_phase<pg8::EpiResidB<true>, pg8::StaticOrder, true, true>(lds, g, S, E, tid);
                {
                    pg8::Gemm g2{(const pg8::bf16_t*)(ws + WS_HID), (const pg8::bf16_t*)(ws + WS_WD), R_ALL, DM, 256, 0, FFN};
                    pg8::SplitKOrder S2{S_LAT / 256, 4, 11, 256, 44, bid, nullptr};
                    pg8::EpiPart E2{(float*)(ws + WS_PART2), modc + 5120, S_LAT / 256, 256, DM};
                    pg8::gemm_phase<pg8::EpiPart, pg8::SplitKOrder, false, true>(lds, g2, S2, E2, tid);
                    moe_conv_range(a, MOE_SL6, MOE_SL7, 44, lds, lane, wave, G, bid);
                }
                if (IN(pb + 8) && IN(pb + 11)) GRIDBAR();
            }
        } else {
            if (IN(pb + 6)) { PHASE_ROOTS(); phase_norm_route(a, lds, tid, lane, wave, G, bid); SEAM(pb + 6); }
            if (IN(pb + 7)) { PHASE_ROOTS(); moe_gather(a, lds, tid, lane, wave, G, bid); SEAM(pb + 7); }
            if (IN(pb + 8)) {
                PHASE_ROOTS();
                const int* mi = (const int*)(ws + WS_VEC) + VO_MOE; const int nt = __builtin_amdgcn_readfirstlane(mi[0]);
                pg8::Gemm g{(const pg8::bf16_t*)(ws + WS_AS), (const pg8::bf16_t*)(ws + WS_MGU), nt * 256, 2 * EXD, DM / 2, (size_t)2 * EXD * DM, DM / 2};
                pg8::MoeOrder S; S.init(nt * 256, 2 * EXD, G, bid); S.load_bases(mi + 160);
                pg8::EpiSwiGLU8 E{(unsigned char*)(ws + WS_HIDM), EXD, 1.0f / (F8_WSCALE * F8_ASCALE), F8_HSCALE};
                pg8::gemm_phase<pg8::EpiSwiGLU8, pg8::MoeOrder, true, true, true>(lds, g, S, E, tid);
                SEAM(pb + 8);
            }
            if (IN(pb + 9)) {
                PHASE_ROOTS();
                const int* mi = (const int*)(ws + WS_VEC) + VO_MOE; const int nt = __builtin_amdgcn_readfirstlane(mi[0]); const int nm = nt < 128 ? nt : 128;
                pg8::Gemm g{(const pg8::bf16_t*)(ws + WS_HIDM), (const pg8::bf16_t*)(ws + WS_MD), nm * 256, DM, EXD / 2, (size_t)DM * EXD, EXD / 2};
                pg8::MoeOrder S; S.init(nm * 256, DM, G, bid); S.load_bases(mi + 160);
                pg8::EpiScaleBf16 E{(pg8::bf16_t*)(ws + WS_Y), DM, 1.0f / (F8_WSCALE * F8_HSCALE)};
                pg8::gemm_phase<pg8::EpiScaleBf16, pg8::MoeOrder, true, true, true>(lds, g, S, E, tid);
                if (nt > 128) {
                    pg8::Gemm g2{(const pg8::bf16_t*)(ws + WS_HIDM), (const pg8::bf16_t*)(ws + WS_MD), nt * 256, DM, 256, (size_t)DM * EXD, EXD / 2};
                    pg8::SplitKOrder S2{128, 4, 7, 256, (nt - 128) * 28, bid, mi + 16};
                    pg8::EpiAtomic E2{(float*)(ws + WS_YF), nullptr, 128, DM, 1.0f / (F8_WSCALE * F8_HSCALE)};
                    pg8::gemm_phase<pg8::EpiAtomic, pg8::SplitKOrder, false, true, true>(lds, g2, S2, E2, tid);
                }
                SEAM(pb + 9);
            }
            if (IN(pb + 10)) { PHASE_ROOTS(); moe_combine(a, lane, wave, G, bid); }
        }
    }
__global__ void __launch_bounds__(NTHR, 2) fwd_kernel(Args a_unused) {
    extern __shared__ __attribute__((aligned(16))) unsigned char lds_raw[];
    LAS unsigned char* lds = (LAS unsigned char*)lds_raw;
    const int tid0 = threadIdx.x;
    const int wv0 = __builtin_amdgcn_readfirstlane(tid0 >> 6);
    for (int u = tid0; u < (LDS_BYTES - LDSCTL_OFF) / 4; u += NTHR) ((LAS unsigned*)(lds + LDSCTL_OFF))[u] = 0u;
    __syncthreads();
    const int lo = KARGS()->ph_lo, hi = KARGS()->ph_hi;
    const bool fusedl = (hi - lo) > 1;
    if (fusedl) (void)xcd_barrier_post((unsigned*)(KARGS()->ws + WS_CTL) + CW_BAR, (volatile LAS unsigned*)(lds + MISC_OFF) + 8);
    if (IN(0)) { PHASE_ROOTS(); p0_prologue(a, lds, tid, lane, wave, G, bid); SEAM(0); }

    layer_body<0>(lo, hi, lds, wv0);
    layer_body<1>(lo, hi, lds, wv0);
}

extern "C" void kernel_launch(void* const* d_in, const int* in_sizes, int n_in, void* d_out, int out_size, void* d_ws, size_t ws_size, hipStream_t stream) {
    static int grid = 0;
    if (grid == 0) {
        if (n_in != 23 || in_sizes[0] != S_LAT * DM || out_size != S_LAT * DM || ws_size < WS_END) { fprintf(stderr, "kernel_launch: unexpected shapes / workspace (n_in %d, ws %zu, need %zu)\n", n_in, ws_size, (size_t)WS_END); grid = -1; return; }
        int dev = 0, cus = 0;
        if (hipGetDevice(&dev) != hipSuccess || hipDeviceGetAttribute(&cus, hipDeviceAttributeMultiprocessorCount, dev) != hipSuccess) { grid = -1; return; }
        if (hipFuncSetAttribute((const void*)fwd_kernel, hipFuncAttributeMaxDynamicSharedMemorySize, LDS_BYTES) != hipSuccess) { grid = -1; return; }
        int per_cu = 0;
        (void)hipOccupancyMaxActiveBlocksPerMultiprocessor(&per_cu, (const void*)fwd_kernel, NTHR, LDS_BYTES);
        (void)hipGetLastError();
        grid = cus;
    }
    if (grid < 0) return;
    if (hipMemsetAsync((char*)d_ws + WS_CTL, 0, CTL_ZERO_BYTES, stream) != hipSuccess) return;
    Args a{};
    for (int i = 0; i < 23; ++i) a.in[i] = (const float*)d_in[i];
    a.out = (float*)d_out; a.ws = (unsigned char*)d_ws;
#if ONE_LAUNCH
    a.ph_lo = 0; a.ph_hi = NPH;
    hipLaunchKernelGGL(fwd_kernel, dim3(grid), dim3(NTHR), LDS_BYTES, stream, a);
#else
    for (int p = 0; p < NPH; ++p) {
        if (p == 10 || p == 11) continue;
        a.ph_lo = p; a.ph_hi = p + 1;
        hipLaunchKernelGGL(fwd_kernel, dim3(grid), dim3(NTHR), LDS_BYTES, stream, a);
    }
#endif
}
```

```cpp
#include <hip/hip_runtime.h>
#include <cstdio>
#include <cstdint>
#include <cmath>
#ifndef ONE_LAUNCH
#define ONE_LAUNCH 1
#endif
namespace pg8 {
#define PG8_LAS __attribute__((address_space(3)))
typedef unsigned short bf16_t;
typedef short bf16x8 __attribute__((ext_vector_type(8)));
typedef float f32x4 __attribute__((ext_vector_type(4)));
typedef unsigned u32x4 __attribute__((ext_vector_type(4)));
constexpr int BM = 256, BK = 64, HALF = 128, HTB = HALF * BK * 2  , STAGE_BYTES = 8 * HTB, NXCD = 8, WGM = 8;

__host__ __device__ __forceinline__ int lds_byte(int r, int c) { const int st = (r >> 4) * 2 + (c >> 5), rr = r & 15, cc = c & 31, ob = rr * 64 + cc * 2; return st * 1024 + (ob ^ (((ob >> 9) & 1) << 5)); }
__host__ __device__ __forceinline__ void stage_rc(int b, int& R, int& C) { const int st = b / 1024, sb = b % 1024, swz = sb ^ (((sb >> 9) & 1) << 5); R = (st >> 1) * 16 + swz / 64; C = (st & 1) * 32 + (swz % 64) / 2; }
__host__ __device__ __forceinline__ int perm32(int rho) { const int n = rho >> 4, i = rho & 15; return 8 * (i >> 2) + 4 * n + (i & 3); }

struct Unit { int pm, pn, eb, ko; };
struct Gemm { const bf16_t* A; const bf16_t* Bt; int M, N, K; size_t bstride; int ld; };

struct StaticOrder {
    int nM, nN, nwg, G, c;
    __host__ __device__ void init(int M, int N, int G_, int c_) { nM = M / BM; nN = N / BM; nwg = nM * nN; G = G_; c = c_; }
    __host__ __device__ bool next(int i, Unit& u) const {
        const long L = (long)i * G + c; if (L >= nwg) return false;
        int wgid = (int)L; { const int q = nwg / NXCD, r = nwg % NXCD, xcd = wgid % NXCD, off = wgid / NXCD; wgid = (xcd < r ? xcd * (q + 1) : r * (q + 1) + (xcd - r) * q) + off; }
        const int nig = WGM * nN, gid = wgid / nig, fm = gid * WGM, gsz = (nM - fm) < WGM ? (nM - fm) : WGM;
        u.pm = fm + ((wgid % nig) % gsz); u.pn = (wgid % nig) / gsz; u.eb = 0; u.ko = 0; return true;
    }
    __device__ __forceinline__ void a_ready(const Unit&) const {}
    __device__ __forceinline__ void done(const Unit&) const {}
};

__device__ __forceinline__ unsigned cvt_pk_bf16(float lo, float hi) { unsigned r; asm volatile("v_cvt_pk_bf16_f32 %0, %1, %2" : "=v"(r) : "v"(lo), "v"(hi)); return r; }
typedef float f32x2 __attribute__((ext_vector_type(2)));
__device__ __forceinline__ f32x2 gelu_pk(f32x2 v) {
    const f32x2 av = __builtin_elementwise_abs(v), d = av * 0.2316418882f + 1.0f;
    f32x2 t; t.x = __builtin_amdgcn_rcpf(d.x); t.y = __builtin_amdgcn_rcpf(d.y);
    f32x2 q = t * 0.5307027145f + (-0.7265760135f); q = q * t + 0.7107068705f; q = q * t + (-0.142248368f); q = q * t + 0.127414796f; q = q * t;
    const f32x2 s = (v * v) * (-0.72134752044f);
    f32x2 e; e.x = __builtin_amdgcn_exp2f(s.x); e.y = __builtin_amdgcn_exp2f(s.y);
    const f32x2 m = v * (q * e), r = v - m;
    f32x2 o; o.x = v.x < 0.f ? m.x : r.x; o.y = v.y < 0.f ? m.y : r.y; return o;
}

template <int ACT  > struct EpiBf16 {
    static constexpr bool PERM = true, AFTER_DRAIN = false; static_assert(ACT == 0 || ACT == 1, "EpiBf16: ACT is 0 (none) or 1 (gelu_pk)");
    bf16_t* O; int ldc; const float* bias; int split_cols; size_t split_stride; float scale0;
    __device__ __forceinline__ void operator()(const f32x4 (&acc)[2][2][4][2], const Unit& u, int wr, int wc, int fr, int fq) const {
        const int row0 = u.pm * BM + wr * 64 + fr; int colt = u.pn * BM; bf16_t* base = O;
        float sc = 1.f; if (split_cols) { const int t = colt / split_cols; base += (size_t)t * split_stride; colt -= t * split_cols; if (t == 0) sc = scale0; }
        const int col0 = colt + wc * 32 + 8 * fq, bcol0 = u.pn * BM + wc * 32 + 8 * fq;
        f32x4 bv[2][2];
#pragma unroll
        for (int bj = 0; bj < 2; ++bj)
#pragma unroll
            for (int n = 0; n < 2; ++n) bv[bj][n] = bias ? *(const f32x4*)(bias + bcol0 + bj * HALF + 4 * n) : (f32x4){0.f, 0.f, 0.f, 0.f};
#pragma unroll
        for (int ai = 0; ai < 2; ++ai)
#pragma unroll
            for (int m = 0; m < 4; ++m) { bf16_t* rowp = base + (size_t)(row0 + ai * HALF + m * 16) * ldc + col0;
#pragma unroll
                for (int bj = 0; bj < 2; ++bj) { f32x4 v0 = acc[ai][bj][m][0] + bv[bj][0], v1 = acc[ai][bj][m][1] + bv[bj][1];
                    if (ACT == 1) { f32x2 a = gelu_pk((f32x2){v0[0], v0[1]}), b = gelu_pk((f32x2){v0[2], v0[3]}), c = gelu_pk((f32x2){v1[0], v1[1]}), d = gelu_pk((f32x2){v1[2], v1[3]});
                        v0 = (f32x4){a.x, a.y, b.x, b.y}; v1 = (f32x4){c.x, c.y, d.x, d.y}; }
                    v0 = v0 * sc; v1 = v1 * sc; u32x4 w; w.x = cvt_pk_bf16(v0[0], v0[1]); w.y = cvt_pk_bf16(v0[2], v0[3]); w.z = cvt_pk_bf16(v1[0], v1[1]); w.w = cvt_pk_bf16(v1[2], v1[3]);
                    *(u32x4*)(rowp + bj * HALF) = w; } }
    }
};

__device__ __forceinline__ float silu_f(float x) { return x * __builtin_amdgcn_rcpf(1.0f + __builtin_amdgcn_exp2f(-1.4426950408889634f * x)); }
struct EpiResid {
    static constexpr bool PERM = false, AFTER_DRAIN = false;
    const float* base; float* out; const float* gate; const float* cbase; float* cout; const float* cgate; int mlat; int ldc;
    __device__ __forceinline__ void operator()(const f32x4 (&acc)[2][2][4][2], const Unit& u, int wr, int wc, int fr, int fq) const {
        const bool isc = u.pm >= mlat;
        const float* b = isc ? cbase : base; float* o = isc ? cout : out; const float* g = isc ? cgate : gate;
        const int row0 = (isc ? (u.pm - mlat) : u.pm) * BM + wr * 64 + fr, col0 = u.pn * BM + wc * 32 + 4 * fq;
        f32x4 gv[2][2];
#pragma unroll
        for (int bj = 0; bj < 2; ++bj)
#pragma unroll
            for (int n = 0; n < 2; ++n) gv[bj][n] = *(const f32x4*)(g + col0 + bj * HALF + n * 16);
#pragma unroll
        for (int ai = 0; ai < 2; ++ai)
#pragma unroll
            for (int m = 0; m < 4; ++m) { const size_t off = (size_t)(row0 + ai * HALF + m * 16) * ldc + col0;
#pragma unroll
                for (int bj = 0; bj < 2; ++bj)
#pragma unroll
                    for (int n = 0; n < 2; ++n) { const f32x4 bs = *(const f32x4*)(b + off + bj * HALF + n * 16); *(f32x4*)(o + off + bj * HALF + n * 16) = bs + gv[bj][n] * acc[ai][bj][m][n]; }
                if (m & 1) asm volatile("" ::: "memory"); }
    }
};
template <bool BFB> struct EpiResidB {
    static constexpr bool PERM = true, AFTER_DRAIN = false;
    const void* base; bf16_t* out; const float* gate; int ldc;
    __device__ __forceinline__ void operator()(const f32x4 (&acc)[2][2][4][2], const Unit& u, int wr, int wc, int fr, int fq) const {
        const int row0 = u.pm * BM + wr * 64 + fr, col0 = u.pn * BM + wc * 32 + 8 * fq;
        f32x4 gv[2][2];
#pragma unroll
        for (int bj = 0; bj < 2; ++bj)
#pragma unroll
            for (int n = 0; n < 2; ++n) gv[bj][n] = *(const f32x4*)(gate + col0 + bj * HALF + 4 * n);
#pragma unroll
        for (int ai = 0; ai < 2; ++ai)
#pragma unroll
            for (int m = 0; m < 4; ++m) { const size_t off = (size_t)(row0 + ai * HALF + m * 16) * ldc + col0;
#pragma unroll
                for (int bj = 0; bj < 2; ++bj) { f32x4 b0, b1;
                    if constexpr (BFB) { const u32x4 t = *(const u32x4*)((const bf16_t*)base + off + bj * HALF);
                        b0 = (f32x4){__builtin_bit_cast(float, t.x << 16), __builtin_bit_cast(float, t.x & 0xffff0000u), __builtin_bit_cast(float, t.y << 16), __builtin_bit_cast(float, t.y & 0xffff0000u)};
                        b1 = (f32x4){__builtin_bit_cast(float, t.z << 16), __builtin_bit_cast(float, t.z & 0xffff0000u), __builtin_bit_cast(float, t.w << 16), __builtin_bit_cast(float, t.w & 0xffff0000u)}; }
                    else { b0 = *(const f32x4*)((const float*)base + off + bj * HALF); b1 = *(const f32x4*)((const float*)base + off + bj * HALF + 4); }
                    const f32x4 v0 = b0 + gv[bj][0] * acc[ai][bj][m][0], v1 = b1 + gv[bj][1] * acc[ai][bj][m][1];
                    u32x4 w; w.x = cvt_pk_bf16(v0[0], v0[1]); w.y = cvt_pk_bf16(v0[2], v0[3]); w.z = cvt_pk_bf16(v1[0], v1[1]); w.w = cvt_pk_bf16(v1[2], v1[3]);
                    *(u32x4*)(out + off + bj * HALF) = w; }
                if (m & 1) asm volatile("" ::: "memory"); }
    }
};
struct EpiSwiGLU {
    static constexpr bool PERM = true, AFTER_DRAIN = false;
    bf16_t* O; int ldc; float ds;
    __device__ __forceinline__ void operator()(const f32x4 (&acc)[2][2][4][2], const Unit& u, int wr, int wc, int fr, int fq) const {
        const int row0 = u.pm * BM + wr * 64 + fr, col0 = u.pn * HALF + wc * 32 + 8 * fq;
#pragma unroll
        for (int ai = 0; ai < 2; ++ai)
#pragma unroll
            for (int m = 0; m < 4; ++m) { bf16_t* rowp = O + (size_t)(row0 + ai * HALF + m * 16) * ldc + col0;
                const f32x4 g0 = acc[ai][0][m][0] * ds, g1 = acc[ai][0][m][1] * ds, u0 = acc[ai][1][m][0] * ds, u1 = acc[ai][1][m][1] * ds;
                f32x4 h0, h1;
#pragma unroll
                for (int j = 0; j < 4; ++j) { h0[j] = silu_f(g0[j]) * u0[j]; h1[j] = silu_f(g1[j]) * u1[j]; }
                u32x4 w; w.x = cvt_pk_bf16(h0[0], h0[1]); w.y = cvt_pk_bf16(h0[2], h0[3]); w.z = cvt_pk_bf16(h1[0], h1[1]); w.w = cvt_pk_bf16(h1[2], h1[3]);
                *(u32x4*)rowp = w; }
    }
};
struct MoeOrder : StaticOrder {
    int tb[8];
    __device__ __forceinline__ void load_bases(const int* mi) {
#pragma unroll
        for (int e = 0; e < 8; ++e) tb[e] = __builtin_amdgcn_readfirstlane(mi[e]); }
    __device__ __forceinline__ int expert_of(int pm) const { int e = 0;
#pragma unroll
        for (int j = 0; j < 7; ++j) e += (pm >= tb[j]) ? 1 : 0;
        return e; }
    __device__ __forceinline__ bool next(int i, Unit& u) const { if (!StaticOrder::next(i, u)) return false; u.eb = expert_of(u.pm); return true; }
};

struct SplitKOrder {
    int pm0, nN, P, kp, total, c; const int* tile_e;
    __device__ __forceinline__ bool next(int i, Unit& u) const {
        if (i != 0 || c >= total) return false;
        const int p = c % P, t = c / P; u.pn = t % nN; u.pm = pm0 + t / nN; u.ko = p * kp; u.eb = tile_e ? __builtin_amdgcn_readfirstlane(tile_e[u.pm]) : 0; return true; }
    __device__ __forceinline__ void a_ready(const Unit&) const {}
    __device__ __forceinline__ void done(const Unit&) const {}
};
struct EpiPart {
    static constexpr bool PERM = false, AFTER_DRAIN = false;
    float* part; const float* scale; int pm_sub; int kp; int ldc;
    __device__ __forceinline__ void operator()(const f32x4 (&acc)[2][2][4][2], const Unit& u, int wr, int wc, int fr, int fq) const {
        float* o = part + (size_t)(u.ko / kp) * BM * ldc;
        const int row0 = (u.pm - pm_sub) * BM + wr * 64 + fr, col0 = u.pn * BM + wc * 32 + 4 * fq;
        f32x4 gv[2][2];
#pragma unroll
        for (int bj = 0; bj < 2; ++bj)
#pragma unroll
            for (int n = 0; n < 2; ++n) gv[bj][n] = *(const f32x4*)(scale + col0 + bj * HALF + n * 16);
#pragma unroll
        for (int ai = 0; ai < 2; ++ai)
#pragma unroll
            for (int m = 0; m < 4; ++m) { const size_t off = (size_t)(row0 + ai * HALF + m * 16) * ldc + col0;
#pragma unroll
                for (int bj = 0; bj < 2; ++bj)
#pragma unroll
                    for (int n = 0; n < 2; ++n) *(f32x4*)(o + off + bj * HALF + n * 16) = gv[bj][n] * acc[ai][bj][m][n]; }
    }
};
struct EpiAtomic {
    static constexpr bool PERM = false, AFTER_DRAIN = true;
    float* out; const float* scale; int pm_sub; int ldc; float ds;
    __device__ __forceinline__ void fused(f32x4 (&acc)[2][2][4][2], const Unit& u, int wr, int wc, int fr, int fq, PG8_LAS unsigned char* lds, int wid, int lane) const {
        PG8_LAS float* scr = (PG8_LAS float*)(lds + wid * 16384);
        const int rr = lane >> 5, cc = lane & 31;
#pragma unroll
        for (int ai = 0; ai < 2; ++ai)
#pragma unroll
            for (int bj = 0; bj < 2; ++bj) {
#pragma unroll
                for (int m = 0; m < 4; ++m)
#pragma unroll
                    for (int n = 0; n < 2; ++n) *(PG8_LAS f32x4*)(scr + (m * 16 + fr) * 36 + n * 16 + 4 * fq) = acc[ai][bj][m][n];
                asm volatile("s_waitcnt lgkmcnt(0)" ::: "memory");
                const int colg = u.pn * BM + bj * HALF + wc * 32 + cc; const float sc = (scale ? scale[colg] : 1.0f) * ds;
                float* op = out + (size_t)((u.pm - pm_sub) * BM + ai * HALF + wr * 64 + rr) * ldc + colg;
#pragma unroll 8
                for (int i = 0; i < 32; ++i) { const float v = scr[(2 * i + rr) * 36 + cc]; __hip_atomic_fetch_add(op + (size_t)(2 * i) * ldc, v * sc, __ATOMIC_RELAXED, __HIP_MEMORY_SCOPE_AGENT); }
                asm volatile("s_waitcnt lgkmcnt(0)" ::: "memory");
            }
    }
};

typedef int i32x4v __attribute__((ext_vector_type(4))); typedef int i32x8v __attribute__((ext_vector_type(8)));
struct FragB { bf16x8 k[2]; };
struct Frag8 { i32x8v v; };
template <bool F8> struct FragSel { typedef FragB type; };
template <> struct FragSel<true> { typedef Frag8 type; };
__device__ __forceinline__ void ld_frag(FragB& f, const PG8_LAS unsigned char* p) { f.k[0] = *(const PG8_LAS bf16x8*)p; f.k[1] = *(const PG8_LAS bf16x8*)(p + 1024); }
__device__ __forceinline__ void ld_frag(Frag8& f, const PG8_LAS unsigned char* p) { const i32x4v lo = *(const PG8_LAS i32x4v*)p, hi = *(const PG8_LAS i32x4v*)(p + 1024); f.v = __builtin_shufflevector(lo, hi, 0, 1, 2, 3, 4, 5, 6, 7); }
__device__ __forceinline__ f32x4 mma_frag(const FragB& b, const FragB& a, f32x4 c) { c = __builtin_amdgcn_mfma_f32_16x16x32_bf16(b.k[0], a.k[0], c, 0, 0, 0); return __builtin_amdgcn_mfma_f32_16x16x32_bf16(b.k[1], a.k[1], c, 0, 0, 0); }
__device__ __forceinline__ f32x4 mma_frag(const Frag8& b, const Frag8& a, f32x4 c) {
    asm volatile("v_mfma_scale_f32_16x16x128_f8f6f4 %0, %1, %2, %0, %3, %3 op_sel_hi:[0,0,0]" : "+v"(c) : "v"(b.v), "v"(a.v), "v"(0x7f7f7f7f));
    return c;
}

struct EpiSwiGLU8 {
    static constexpr bool PERM = true, AFTER_DRAIN = false;
    unsigned char* O; int ldc; float ds, hs;
    __device__ __forceinline__ void operator()(const f32x4 (&acc)[2][2][4][2], const Unit& u, int wr, int wc, int fr, int fq) const {
        const int row0 = u.pm * BM + wr * 64 + fr, col0 = u.pn * HALF + wc * 32 + 8 * fq;
        const float k1 = -1.4426950408889634f * ds, k2 = ds * ds * hs;
#pragma unroll
        for (int ai = 0; ai < 2; ++ai)
#pragma unroll
            for (int m = 0; m < 4; ++m) { unsigned char* rowp = O + (size_t)(row0 + ai * HALF + m * 16) * ldc + col0;
                const f32x4 g0 = acc[ai][0][m][0], g1 = acc[ai][0][m][1], u0 = acc[ai][1][m][0], u1 = acc[ai][1][m][1];
                float h[8];
#pragma unroll
                for (int j = 0; j < 4; ++j) {
                    h[j] = __builtin_amdgcn_fmed3f((g0[j] * u0[j]) * k2 * __builtin_amdgcn_rcpf(1.0f + __builtin_amdgcn_exp2f(g0[j] * k1)), -448.0f, 448.0f);
                    h[4 + j] = __builtin_amdgcn_fmed3f((g1[j] * u1[j]) * k2 * __builtin_amdgcn_rcpf(1.0f + __builtin_amdgcn_exp2f(g1[j] * k1)), -448.0f, 448.0f); }
                unsigned lo = 0u, hi = 0u;
                lo = __builtin_amdgcn_cvt_pk_fp8_f32(h[0], h[1], lo, false); lo = __builtin_amdgcn_cvt_pk_fp8_f32(h[2], h[3], lo, true);
                hi = __builtin_amdgcn_cvt_pk_fp8_f32(h[4], h[5], hi, false); hi = __builtin_amdgcn_cvt_pk_fp8_f32(h[6], h[7], hi, true);
                typedef unsigned u32x2 __attribute__((ext_vector_type(2)));
                *(u32x2*)rowp = (u32x2){lo, hi}; }
    }
};
struct EpiScaleBf16 {
    static constexpr bool PERM = true, AFTER_DRAIN = false;
    bf16_t* O; int ldc; float ds;
    __device__ __forceinline__ void operator()(const f32x4 (&acc)[2][2][4][2], const Unit& u, int wr, int wc, int fr, int fq) const {
        const int row0 = u.pm * BM + wr * 64 + fr, col0 = u.pn * BM + wc * 32 + 8 * fq;
#pragma unroll
        for (int ai = 0; ai < 2; ++ai)
#pragma unroll
            for (int m = 0; m < 4; ++m) { bf16_t* rowp = O + (size_t)(row0 + ai * HALF + m * 16) * ldc + col0;
#pragma unroll
                for (int bj = 0; bj < 2; ++bj) { const f32x4 v0 = acc[ai][bj][m][0] * ds, v1 = acc[ai][bj][m][1] * ds;
                    u32x4 w; w.x = cvt_pk_bf16(v0[0], v0[1]); w.y = cvt_pk_bf16(v0[2], v0[3]); w.z = cvt_pk_bf16(v1[0], v1[1]); w.w = cvt_pk_bf16(v1[2], v1[3]);
                    *(u32x4*)(rowp + bj * HALF) = w; } }
    }
};

template <class Epi, class Sched, bool ALIGN_EPI = false, bool SP2 = false, bool F8 = false>
__device__ __forceinline__ void gemm_phase(PG8_LAS unsigned char* lds, const Gemm g, const Sched& S, const Epi& E, int tid_in) {
    int tid_ = tid_in; asm volatile("" : "+v"(tid_));
    const int tid = tid_, wid = __builtin_amdgcn_readfirstlane(tid >> 6), lane = tid & 63, wr = wid >> 2, wc = wid & 3, fr = lane & 15, fq = lane >> 4;
    const int K = g.K, nt = K / BK, ld = g.ld;
    unsigned voffA[2], voffB[2];
#pragma unroll
    for (int i = 0; i < 2; ++i) { int R, C; stage_rc(tid * 16 + i * 8192, R, C); const int Rb = Epi::PERM ? ((R & ~31) + perm32(R & 31)) : R;
        voffA[i] = (unsigned)(R * ld + C) * 2u; voffB[i] = (unsigned)(Rb * ld + C) * 2u; }
    const size_t kstep = (size_t)(BK * 2);
    const size_t hstep = (size_t)HALF * ld * 2;
    const size_t tstep = 2 * hstep;
    const unsigned ldsw = (unsigned)wid * 1024u;
    const int aoff = lds_byte(wr * 64 + fr, fq * 8), boff = lds_byte(wc * 32 + fr, fq * 8);
#define PG8_SA(b, h) (((b) * 2 + (h)) * HTB)
#define PG8_SB(b, h) ((4 + (b) * 2 + (h)) * HTB)
#define PG8_STAGE(bufoff, gbase, voff) do { _Pragma("unroll") for (int _i = 0; _i < 2; ++_i) \
        __builtin_amdgcn_global_load_lds((const unsigned*)((const char*)(gbase) + (voff)[_i]), (PG8_LAS unsigned*)(lds + (bufoff) + ldsw + _i * 8192), 16, 0, 0); } while (0)
#define PG8_LDA(dst, b, h) do { _Pragma("unroll") for (int m = 0; m < 4; ++m) ld_frag(dst[m], lds + PG8_SA(b, h) + aoff + m * 2048); } while (0)
#define PG8_LDB(dst, b, h) do { _Pragma("unroll") for (int n = 0; n < 2; ++n) ld_frag(dst[n], lds + PG8_SB(b, h) + boff + n * 2048); } while (0)
#define PG8_MMA(ai, bj, At, Bt) do { __builtin_amdgcn_s_setprio(1); _Pragma("unroll") for (int m = 0; m < 4; ++m) _Pragma("unroll") for (int n = 0; n < 2; ++n) \
        acc[ai][bj][m][n] = mma_frag(Bt[n], At[m], acc[ai][bj][m][n]); __builtin_amdgcn_s_setprio(0); } while (0)
#define PG8_WAIT_V(n) asm volatile("s_waitcnt vmcnt(" #n ")" ::: "memory")
#define PG8_WAIT_L(n) asm volatile("s_waitcnt lgkmcnt(" #n ")" ::: "memory")
#define PG8_BAR __builtin_amdgcn_s_barrier()
#define PG8_SCHED __builtin_amdgcn_sched_barrier(0)
    Unit cur, nxt; int ui = 0;
    if (!S.next(0, cur)) return;
    float zacc = 0.f; asm volatile("" : "+v"(zacc));
    f32x4 acc[2][2][4][2];
#pragma unroll
    for (int a = 0; a < 2; ++a)
#pragma unroll
        for (int b = 0; b < 2; ++b)
#pragma unroll
            for (int m = 0; m < 4; ++m)
#pragma unroll
                for (int n = 0; n < 2; ++n) acc[a][b][m][n] = (f32x4){zacc, zacc, zacc, zacc};
    typedef typename FragSel<F8>::type Frag;
    Frag At[4], B0[2], B1[2];
    const char* cA = (const char*)g.A + (size_t)cur.pm * tstep + (size_t)cur.ko * 2; const char* cB = (const char*)g.Bt + (size_t)cur.eb * g.bstride + (size_t)cur.pn * tstep + (size_t)cur.ko * 2;
    S.a_ready(cur);
    if constexpr (SP2) {
        PG8_STAGE(PG8_SB(0, 0), cB, voffB); PG8_STAGE(PG8_SB(0, 1), cB + hstep, voffB); PG8_STAGE(PG8_SA(0, 0), cA, voffA); PG8_STAGE(PG8_SA(0, 1), cA + hstep, voffA);
        if (wr == 1) PG8_BAR;
        PG8_WAIT_V(2); PG8_BAR;
        PG8_STAGE(PG8_SB(1, 0), cB + kstep, voffB); PG8_STAGE(PG8_SA(1, 0), cA + kstep, voffA); PG8_STAGE(PG8_SB(1, 1), cB + hstep + kstep, voffB);
        PG8_WAIT_V(6); PG8_BAR;
    } else {
        PG8_STAGE(PG8_SB(0, 0), cB, voffB); PG8_STAGE(PG8_SA(0, 0), cA, voffA); PG8_STAGE(PG8_SB(0, 1), cB + hstep, voffB); PG8_STAGE(PG8_SA(0, 1), cA + hstep, voffA);
        if (wr == 1) PG8_BAR;
        PG8_WAIT_V(4); PG8_BAR;
        PG8_STAGE(PG8_SB(1, 0), cB + kstep, voffB); PG8_STAGE(PG8_SA(1, 0), cA + kstep, voffA); PG8_STAGE(PG8_SB(1, 1), cB + hstep + kstep, voffB);
        PG8_WAIT_V(6); PG8_BAR;
    }
    for (;;) {
        const bool has_next = S.next(ui + 1, nxt);
        const char* nA = has_next ? (const char*)g.A + (size_t)nxt.pm * tstep + (size_t)nxt.ko * 2 : cA; const char* nB = has_next ? (const char*)g.Bt + (size_t)nxt.eb * g.bstride + (size_t)nxt.pn * tstep + (size_t)nxt.ko * 2 : cB;
        for (int t = 0; t < nt; t += 2) {
            const bool last = (t == nt - 2);
            const char* a1 = cA + (size_t)(t + 1) * kstep;
            const char* a2 = last ? nA : cA + (size_t)(t + 2) * kstep; const char* b2 = last ? nB : cB + (size_t)(t + 2) * kstep;
            const char* a3 = a2 + kstep; const char* b3 = b2 + kstep;
            if (last && has_next) S.a_ready(nxt);
            if constexpr (SP2) {
            PG8_LDB(B0, 0, 0); PG8_LDB(B1, 0, 1); PG8_SCHED; PG8_LDA(At, 0, 0); PG8_STAGE(PG8_SA(1, 1), a1 + hstep, voffA);
            PG8_WAIT_V(8); PG8_WAIT_L(0); PG8_BAR; PG8_MMA(0, 0, At, B0); PG8_MMA(0, 1, At, B1); PG8_BAR; PG8_SCHED;
            PG8_LDA(At, 0, 1); PG8_STAGE(PG8_SB(0, 0), b2, voffB); PG8_STAGE(PG8_SB(0, 1), b2 + hstep, voffB); PG8_STAGE(PG8_SA(0, 0), a2, voffA);
            PG8_WAIT_V(8); PG8_WAIT_L(0); PG8_BAR; PG8_MMA(1, 0, At, B0); PG8_MMA(1, 1, At, B1); PG8_BAR; PG8_SCHED;
            PG8_LDB(B0, 1, 0); PG8_LDB(B1, 1, 1); PG8_SCHED; PG8_LDA(At, 1, 0); PG8_STAGE(PG8_SA(0, 1), a2 + hstep, voffA);
            PG8_WAIT_V(8); PG8_WAIT_L(0); PG8_BAR; PG8_MMA(0, 0, At, B0); PG8_MMA(0, 1, At, B1); PG8_BAR; PG8_SCHED;
            PG8_LDA(At, 1, 1); PG8_STAGE(PG8_SB(1, 0), b3, voffB); PG8_STAGE(PG8_SB(1, 1), b3 + hstep, voffB); PG8_STAGE(PG8_SA(1, 0), a3, voffA);
            PG8_WAIT_V(8); PG8_WAIT_L(0); PG8_BAR; PG8_MMA(1, 0, At, B0); PG8_MMA(1, 1, At, B1); PG8_BAR; PG8_SCHED;
            } else {
            PG8_LDB(B0, 0, 0); PG8_SCHED; PG8_LDA(At, 0, 0); PG8_STAGE(PG8_SA(1, 1), a1 + hstep, voffA);
            PG8_WAIT_L(8); PG8_BAR; PG8_WAIT_L(0); PG8_MMA(0, 0, At, B0); PG8_BAR; PG8_SCHED;
            PG8_LDB(B1, 0, 1); PG8_STAGE(PG8_SB(0, 0), b2, voffB);
            PG8_BAR; PG8_WAIT_L(0); PG8_MMA(0, 1, At, B1); PG8_BAR;
            PG8_LDA(At, 0, 1); PG8_STAGE(PG8_SA(0, 0), a2, voffA);
            PG8_BAR; PG8_WAIT_L(0); PG8_MMA(1, 0, At, B0); PG8_BAR; PG8_SCHED;
            PG8_STAGE(PG8_SB(0, 1), b2 + hstep, voffB);
            PG8_WAIT_V(6); PG8_BAR; PG8_MMA(1, 1, At, B1); PG8_BAR;
            PG8_LDB(B0, 1, 0); PG8_SCHED; PG8_LDA(At, 1, 0); PG8_STAGE(PG8_SA(0, 1), a2 + hstep, voffA);
            PG8_WAIT_L(8); PG8_BAR; PG8_WAIT_L(0); PG8_MMA(0, 0, At, B0); PG8_BAR; PG8_SCHED;
            PG8_LDB(B1, 1, 1); PG8_STAGE(PG8_SB(1, 0), b3, voffB);
            PG8_BAR; PG8_WAIT_L(0); PG8_MMA(0, 1, At, B1); PG8_BAR;
            PG8_LDA(At, 1, 1); PG8_STAGE(PG8_SA(1, 0), a3, voffA);
            PG8_BAR; PG8_WAIT_L(0); PG8_MMA(1, 0, At, B0); PG8_BAR; PG8_SCHED;
            PG8_STAGE(PG8_SB(1, 1), b3 + hstep, voffB);
            PG8_WAIT_V(6); PG8_BAR; PG8_MMA(1, 1, At, B1); PG8_BAR;
            }
        }
        if constexpr (ALIGN_EPI) { if (wr == 0) PG8_BAR; }
        if constexpr (F8) {
            asm volatile("s_nop 15\n\ts_nop 15" : "+v"(acc[1][1][0][0]), "+v"(acc[1][1][0][1]), "+v"(acc[1][1][1][0]), "+v"(acc[1][1][1][1]), "+v"(acc[1][1][2][0]), "+v"(acc[1][1][2][1]), "+v"(acc[1][1][3][0]), "+v"(acc[1][1][3][1])); }
        if constexpr (!Epi::AFTER_DRAIN) { E(acc, cur, wr, wc, fr, fq); S.done(cur); }
        if (!has_next) break;
#pragma unroll
        for (int a = 0; a < 2; ++a)
#pragma unroll
            for (int b = 0; b < 2; ++b)
#pragma unroll
                for (int m = 0; m < 4; ++m)
#pragma unroll
                    for (int n = 0; n < 2; ++n) acc[a][b][m][n] = (f32x4){zacc, zacc, zacc, zacc};
        cur = nxt; cA = nA; cB = nB; ++ui;
        if constexpr (ALIGN_EPI) { if (wr == 1) PG8_BAR; }
    }
    PG8_WAIT_V(0);
    if constexpr (!ALIGN_EPI) { if (wr == 0) PG8_BAR; }
    PG8_BAR;
    if constexpr (Epi::AFTER_DRAIN) { E.fused(acc, cur, wr, wc, fr, fq, lds, wid, lane); S.done(cur); }
#undef PG8_SA
#undef PG8_SB
#undef PG8_STAGE
#undef PG8_LDA
#undef PG8_LDB
#undef PG8_MMA
#undef PG8_WAIT_V
#undef PG8_WAIT_L
#undef PG8_BAR
#undef PG8_SCHED
}
}


constexpr int S_LAT = 16384, C_CTX = 256, R_ALL = S_LAT + C_CTX, DM = 1024;
constexpr int INW = 2560, FFN = 2816, EXD = 3584, NEXP = 8;
constexpr int COL_AQ = 0, COL_AK = 512, COL_AV = 640, COL_HQ = 768, COL_HFF = 1024, COL_HFB = 1280, COL_HI = 1536, COL_HG = 1792, COL_GU = 2048, COL_GV = 2304;
constexpr int MIX_AT = 0, MIX_HG = 512, MIX_GM = 768;
constexpr int MOE_MAXROWS = 34816;
constexpr float EPS = 1e-6f;
constexpr int NWAVES = 8, NTHR = 512;
constexpr int NPH = 23;

constexpr size_t MiB = 1u << 20;
constexpr size_t WS_CTL = 0, CTL_ZERO_BYTES = 1 * MiB;
constexpr size_t WS_VEC = 1 * MiB;
constexpr size_t WS_TOK = 2 * MiB;
constexpr size_t WS_WIN = 3 * MiB;
constexpr size_t WS_WOUT = 13 * MiB;
constexpr size_t WS_WGU = 17 * MiB;
constexpr size_t WS_WD = 28 * MiB;
constexpr size_t WS_MGU = 34 * MiB;
constexpr size_t WS_MD = 146 * MiB;
constexpr size_t WS_H = 202 * MiB;
constexpr size_t WS_PROJ = 235 * MiB;
constexpr size_t WS_MIX = 317 * MiB;
constexpr size_t WS_HGO = 350 * MiB;
constexpr size_t WS_CTXR = 383 * MiB;
constexpr size_t WS_HLT = WS_HGO;
constexpr size_t WS_HSP = 384 * MiB;
constexpr size_t WS_HDG = 402 * MiB;
constexpr size_t WS_VT = 403 * MiB;
constexpr size_t WS_HID = WS_PROJ;
constexpr size_t WS_AS = 202 * MiB;
constexpr size_t WS_HIDM = 270 * MiB;
constexpr size_t WS_H2B = 440 * MiB;
constexpr size_t WS_YF = WS_WIN;
constexpr size_t WS_Y = WS_MGU;
constexpr size_t WS_XB = 104 * MiB;
constexpr size_t WS_PART1 = 176 * MiB;
constexpr size_t WS_PART2 = 180 * MiB;
constexpr size_t WS_END = 508 * MiB;
static_assert(WS_HID + (size_t)R_ALL * FFN * 2 <= WS_HGO && WS_AS + (size_t)MOE_MAXROWS * DM * 2 <= WS_HIDM && WS_HIDM + (size_t)MOE_MAXROWS * EXD * 2 <= WS_END, "ws map");
static_assert(WS_PART1 >= WS_MD + (size_t)8 * DM * EXD && WS_PART1 + (size_t)4 * 256 * DM * 4 <= WS_PART2 && WS_PART2 + (size_t)11 * 256 * DM * 4 <= WS_H, "ws map 4");
static_assert(WS_XB >= WS_Y + (size_t)MOE_MAXROWS * DM * 2 && WS_XB >= WS_MGU + (size_t)8 * 2 * EXD * DM && WS_XB + (size_t)S_LAT * DM * 2 <= WS_MD, "ws map 3");
static_assert(WS_H2B >= WS_HIDM && WS_H2B + (size_t)S_LAT * DM * 2 <= WS_END && WS_H + (size_t)R_ALL * DM * 2 <= WS_PROJ && WS_PROJ + (size_t)R_ALL * INW * 2 <= WS_MIX && WS_MIX + (size_t)R_ALL * DM * 2 <= WS_HGO && WS_HGO + (size_t)2 * R_ALL * 256 * 4 <= WS_CTXR, "ws map 2");
constexpr int VO_MOD = 0;
constexpr int VO_ROPE = 32768;
constexpr int VO_MOE = 65536;
constexpr int CW_BAR = 4096;
constexpr int CW_QUEUE = 2048;
constexpr int CW_MOECNT = 1024;

constexpr int RING_BYTES = 131072;
constexpr int LDSCTL_OFF = 159744, MISC_OFF = LDSCTL_OFF + 320;
constexpr int LDS_BYTES = 163840;

#define GAS __attribute__((address_space(1)))
#define LAS __attribute__((address_space(3)))
typedef unsigned short bf16;
typedef unsigned v4u __attribute__((ext_vector_type(4)));
typedef unsigned v2u __attribute__((ext_vector_type(2)));
typedef float f32x4 __attribute__((ext_vector_type(4)));
typedef GAS unsigned gu32;
#define RLX_AGENT __ATOMIC_RELAXED, __HIP_MEMORY_SCOPE_AGENT
#define LDS_WAIT() asm volatile("s_waitcnt lgkmcnt(0)" ::: "memory")
typedef float f32x2_t __attribute__((ext_vector_type(2))); typedef __bf16 bf16x2_t __attribute__((ext_vector_type(2)));
__device__ __forceinline__ unsigned pk2(float lo, float hi) { const f32x2_t v = {lo, hi}; const bf16x2_t b = __builtin_convertvector(v, bf16x2_t); return __builtin_bit_cast(unsigned, b); }
__device__ __forceinline__ unsigned f2bf(float f) { return pk2(f, 0.f) & 0xffffu; }
__device__ __forceinline__ float bflo(unsigned w) { return __builtin_bit_cast(float, w << 16); }
__device__ __forceinline__ float bfhi(unsigned w) { return __builtin_bit_cast(float, w & 0xffff0000u); }
__device__ __forceinline__ float sigm1(float x) { return __builtin_amdgcn_rcpf(1.0f + __builtin_amdgcn_exp2f(-1.4426950408889634f * x)); }
__device__ __forceinline__ float silu1(float x) { return x * sigm1(x); }
__device__ __forceinline__ float gelu1(float x) { return 0.5f * x * (1.0f + erff(x * 0.70710678118654752f)); }
template <int X> __device__ __forceinline__ float sx(float v) { return __shfl_xor(v, X); }
__device__ __forceinline__ float sx32_add(float v) { return v + __shfl_xor(v, 32); }
__device__ __forceinline__ float sx32_max(float v) { return fmaxf(v, __shfl_xor(v, 32)); }
__device__ __forceinline__ float wave_sum(float v) { v += sx<1>(v); v += sx<2>(v); v += sx<4>(v); v += sx<8>(v); v += sx<16>(v); return sx32_add(v); }
__device__ __forceinline__ void unpack8(const v4u w, float* f) { f[0] = bflo(w.x); f[1] = bfhi(w.x); f[2] = bflo(w.y); f[3] = bfhi(w.y); f[4] = bflo(w.z); f[5] = bfhi(w.z); f[6] = bflo(w.w); f[7] = bfhi(w.w); }


__device__ __forceinline__ float clamp448(float x) { return fminf(fmaxf(x, -448.0f), 448.0f); }
__device__ __forceinline__ unsigned pk4_fp8(float a, float b, float c, float d) {
    unsigned w = 0u; w = __builtin_amdgcn_cvt_pk_fp8_f32(clamp448(a), clamp448(b), w, false); w = __builtin_amdgcn_cvt_pk_fp8_f32(clamp448(c), clamp448(d), w, true); return w; }
constexpr float F8_WSCALE = 128.0f;
constexpr float F8_ASCALE = 16.0f;
constexpr float F8_HSCALE = 8.0f;
#define XB_TMO      128
#define XB_XCNT(j)  (256  + 64 * (j))
#define XB_XSUB(j)  (1280 + 64 * (j))
#define XB_XGEN(j)  (2304 + 64 * (j))
#define XB_TOP      3328
#define XB_TOPGEN   3392
#define XCD_BAR_WORDS 3456
#define XB_SPIN_CAP (1u << 18)

__device__ __forceinline__ unsigned xb_ld(unsigned* p)              { return __hip_atomic_load(p, __ATOMIC_RELAXED, __HIP_MEMORY_SCOPE_AGENT); }
__device__ __forceinline__ unsigned xb_add(unsigned* p, unsigned v) { return __hip_atomic_fetch_add(p, v, __ATOMIC_RELAXED, __HIP_MEMORY_SCOPE_AGENT); }
__device__ __forceinline__ unsigned xb_xcc_id() { return (unsigned)__builtin_amdgcn_s_getreg((3 << 11) | 20) & 0xFu; }
#define XB_SPIN(cond, bar) do { unsigned _sp = 0; while (cond) { __builtin_amdgcn_s_sleep(1); \
    if ((++_sp & 255u) == 0u) { if (xb_ld(&(bar)[XB_TMO])) break; if (_sp > XB_SPIN_CAP) { atomicAdd(&(bar)[XB_TMO], 1u); break; } } } } while (0)

struct XcdBarrier {
    unsigned* bar; unsigned x;
    volatile LAS unsigned* st;
};

__device__ __forceinline__ XcdBarrier xcd_barrier_post(unsigned* bar, volatile LAS unsigned* st) {
    XcdBarrier b; b.bar = bar; b.x = xb_xcc_id(); b.st = st;
    if (threadIdx.x == 0) (void)xb_add(&bar[XB_XCNT(b.x)], 1u);
    return b;
}
__device__ __forceinline__ void xcd_barrier_complete(unsigned* bar, unsigned x, unsigned& nloc, unsigned& nx) {
    const unsigned G = gridDim.x * gridDim.y * gridDim.z;
    unsigned sum, cnt, mine, sp = 0u;
    for (;;) {
        sum = 0u; cnt = 0u; mine = 0u;
#pragma unroll
        for (unsigned j = 0; j < 16; ++j) { const unsigned c = xb_ld(&bar[XB_XCNT(j)]); sum += c; cnt += (c > 0u) ? 1u : 0u; mine = (j == x) ? c : mine; }
        if (sum == G) break;
        __builtin_amdgcn_s_sleep(1);
        if ((++sp & 255u) == 0u) { if (xb_ld(&bar[XB_TMO])) break; if (sp > XB_SPIN_CAP) { atomicAdd(&bar[XB_TMO], 1u); break; } }
    }
    nloc = mine > 0u ? mine : 1u; nx = cnt > 0u ? cnt : 1u;
}

__device__ __forceinline__ void xcd_barrier(const XcdBarrier& b, const int tid_in) {
    asm volatile("s_waitcnt vmcnt(0)" ::: "memory");
    __syncthreads();
    if (tid_in == 0) {
        unsigned* bar = b.bar;
        __builtin_amdgcn_s_waitcnt(0);
        unsigned nloc = b.st[0], nx = b.st[1];
        if (nloc == 0u) { xcd_barrier_complete(bar, b.x, nloc, nx); b.st[0] = nloc; b.st[1] = nx; }
        const unsigned old = xb_add(&bar[XB_XSUB(b.x)], 1u);
        const unsigned gen = old / nloc;
        if (old + 1u == (gen + 1u) * nloc) {
            __builtin_amdgcn_fence(__ATOMIC_RELEASE, "agent");
            asm volatile("s_waitcnt vmcnt(0)" ::: "memory");
            const unsigned og = xb_add(&bar[XB_TOP], 1u);
            const unsigned tg = og / nx;
            if (og + 1u == (tg + 1u) * nx) xb_add(&bar[XB_TOPGEN], 1u);
            else XB_SPIN(xb_ld(&bar[XB_TOPGEN]) == tg, bar);
            __builtin_amdgcn_fence(__ATOMIC_ACQUIRE, "agent");
            xb_add(&bar[XB_XGEN(b.x)], 1u);
            asm volatile("s_waitcnt vmcnt(0)" ::: "memory");
        } else {
            XB_SPIN(xb_ld(&bar[XB_XGEN(b.x)]) == gen, bar);
            __builtin_amdgcn_fence(__ATOMIC_ACQUIRE, "agent");
            asm volatile("s_waitcnt vmcnt(0)" ::: "memory");
        }
    }
    __syncthreads();
}


struct Args { const float* in[23]; float* out; unsigned char* ws; int ph_lo, ph_hi; };
typedef const __attribute__((address_space(4))) Args* KA;
#define KARGS() ({ KA p_ = (KA)__builtin_amdgcn_kernarg_segment_ptr(); asm volatile("" : "+s"(p_)); p_; })
enum { I_X = 0, I_C, I_CTX, I_CCTX, I_WADA, I_BADA, I_WIN, I_WOUT, I_QG, I_KG, I_SINK, I_HLB, I_HGAIN, I_GWS, I_GBS, I_GNG, I_FG, I_FU, I_FD, I_ROUTER, I_MG, I_MU, I_MDN };

__device__ __forceinline__ void transpose_item(const float* W, int K, int N, bf16* WT, int mode, LAS float* scr, int item, int lane) {
    const int nblk = N / 32, kb = item / nblk, nb = item % nblk, k0 = 64 * kb, n0 = 32 * nb;
#pragma unroll 8
    for (int i = 0; i < 32; ++i) { const int kk = 2 * i + (lane >> 5); scr[kk * 33 + (lane & 31)] = __builtin_nontemporal_load(&W[(size_t)(k0 + kk) * N + n0 + (lane & 31)]); }
    LDS_WAIT(); asm volatile("" ::: "memory");
    const int c = lane & 7;
#pragma unroll
    for (int j = 0; j < 4; ++j) { const int n = (lane >> 3) + 8 * j; const LAS float* s = scr + (8 * c) * 33 + n;
        v4u o; o.x = pk2(s[0 * 33], s[1 * 33]); o.y = pk2(s[2 * 33], s[3 * 33]); o.z = pk2(s[4 * 33], s[5 * 33]); o.w = pk2(s[6 * 33], s[7 * 33]);
        const int ng = n0 + n; const int drow = (mode == 0) ? ng : (ng + 128 * (ng / 128) + (mode == 2 ? 128 : 0));
        *(GAS v4u*)(WT + (size_t)drow * K + k0 + 8 * c) = o; }
    LDS_WAIT(); asm volatile("" ::: "memory");
}
__device__ __forceinline__ void transpose_item8(const float* W, int K, int N, unsigned char* WT, int mode, LAS float* scr, int item, int lane) {
    const int nblk = N / 32, kb = item / nblk, nb = item % nblk, k0 = 64 * kb, n0 = 32 * nb;
#pragma unroll 8
    for (int i = 0; i < 32; ++i) { const int kk = 2 * i + (lane >> 5); scr[kk * 33 + (lane & 31)] = __builtin_nontemporal_load(&W[(size_t)(k0 + kk) * N + n0 + (lane & 31)]); }
    LDS_WAIT(); asm volatile("" ::: "memory");
    const int c = lane & 7;
#pragma unroll
    for (int j = 0; j < 4; ++j) { const int n = (lane >> 3) + 8 * j; const LAS float* s = scr + (8 * c) * 33 + n;
        v2u o; o.x = pk4_fp8(s[0 * 33] * F8_WSCALE, s[1 * 33] * F8_WSCALE, s[2 * 33] * F8_WSCALE, s[3 * 33] * F8_WSCALE); o.y = pk4_fp8(s[4 * 33] * F8_WSCALE, s[5 * 33] * F8_WSCALE, s[6 * 33] * F8_WSCALE, s[7 * 33] * F8_WSCALE);
        const int ng = n0 + n; const int drow = (mode == 0) ? ng : (ng + 128 * (ng / 128) + (mode == 2 ? 128 : 0));
        *(GAS v2u*)(WT + (size_t)drow * K + k0 + 8 * c) = o; }
    LDS_WAIT(); asm volatile("" ::: "memory");
}
constexpr int MOE_ITEMS = 24 * 16 * 112;
constexpr int MOE_SL0 = 0, MOE_SL1 = 5376, MOE_SL2 = 10752, MOE_SL3 = 16128, MOE_SL4 = 19200, MOE_SL5 = 25344, MOE_SL6 = 29184, MOE_SL7 = 32576, MOE_DEFER = 34496;
__device__ __forceinline__ void moe_conv_item(KA a, int it, LAS float* scr, int lane) {
    constexpr int I_M = 16 * 112;
    unsigned char* ws = a->ws;
    const int idx = it / I_M, r = it % I_M;
    if (idx < 8) transpose_item8(a->in[I_MG] + (size_t)idx * DM * EXD, DM, EXD, (unsigned char*)(ws + WS_MGU) + (size_t)idx * 2 * EXD * DM, 1, scr, r, lane);
    else if (idx < 16) transpose_item8(a->in[I_MU] + (size_t)(idx - 8) * DM * EXD, DM, EXD, (unsigned char*)(ws + WS_MGU) + (size_t)(idx - 8) * 2 * EXD * DM, 2, scr, r, lane);
    else transpose_item8(a->in[I_MDN] + (size_t)(idx - 16) * EXD * DM, EXD, DM, (unsigned char*)(ws + WS_MD) + (size_t)(idx - 16) * DM * EXD, 0, scr, r, lane);
}
__device__ __forceinline__ void moe_conv_range(KA a, int lo, int hi, int first, LAS unsigned char* lds, int lane, int wave, int G, int bid) {
    if (bid < first) return;
    LAS float* scr = (LAS float*)(lds + wave * 8704);
    const int nw = (G - first) * NWAVES, w = (bid - first) * NWAVES + wave;
    for (int i = lo + w; i < hi; i += nw) moe_conv_item(a, i, scr, lane);
}
__device__ __forceinline__ void p0_prologue(KA a, LAS unsigned char* lds, int tid, int lane, int wave, int G, int bid) {
    unsigned char* ws = a->ws;
    LAS float* scr = (LAS float*)(lds + wave * 8704);
    const int gw = bid * NWAVES + wave, NGW = G * NWAVES;
    constexpr int I_IN = 16 * 80, I_OUT = 16 * 32, I_F = 16 * 88, I_FDN = 44 * 32, I_M = 16 * 112;
    constexpr int NIT = 2 * I_IN + 2 * I_OUT + 2 * I_F + I_FDN + 24 * I_M;
    for (int it0 = gw; it0 < NIT; it0 += NGW) {
        int it = it0;
        if (it < 2 * I_IN) { const int l = it / I_IN, r = it % I_IN; transpose_item(a->in[I_WIN] + (size_t)l * DM * INW, DM, INW, (bf16*)(ws + WS_WIN) + (size_t)l * INW * DM, 0, scr, r, lane); continue; } it -= 2 * I_IN;
        if (it < 2 * I_OUT) { const int l = it / I_OUT, r = it % I_OUT; transpose_item(a->in[I_WOUT] + (size_t)l * DM * DM, DM, DM, (bf16*)(ws + WS_WOUT) + (size_t)l * DM * DM, 0, scr, r, lane); continue; } it -= 2 * I_OUT;
        if (it < I_F) { transpose_item(a->in[I_FG], DM, FFN, (bf16*)(ws + WS_WGU), 1, scr, it, lane); continue; } it -= I_F;
        if (it < I_F) { transpose_item(a->in[I_FU], DM, FFN, (bf16*)(ws + WS_WGU), 2, scr, it, lane); continue; } it -= I_F;
        if (it < I_FDN) { transpose_item(a->in[I_FD], FFN, DM, (bf16*)(ws + WS_WD), 0, scr, it, lane); continue; } it -= I_FDN;
        if (it >= MOE_DEFER) moe_conv_item(a, it, scr, lane);
    }
    LAS float* sil = (LAS float*)(lds + 69632);
    LAS float* part = (LAS float*)(lds + 69632 + 8192);
    float* vec = (float*)(ws + WS_VEC);
    if (bid < 192) {
        for (int i = tid; i < 2048; i += NTHR) { const float v = (i < 1024) ? a->in[I_C][i] : a->in[I_CCTX][i - 1024]; sil[i] = silu1(v); }
        __syncthreads();
        for (int item = bid; item < 192; item += G) {
            const int l = item / 96, cb = item % 96, col = cb * 64 + lane;
            const float* w = a->in[I_WADA] + (size_t)l * DM * 6144 + col;
            float a0 = 0.f, a1 = 0.f;
#pragma unroll 1
            for (int k0 = wave * 128; k0 < wave * 128 + 128; k0 += 32) { float wv[32];
#pragma unroll
                for (int j = 0; j < 32; ++j) wv[j] = __builtin_nontemporal_load(&w[(size_t)(k0 + j) * 6144]);
#pragma unroll
                for (int j = 0; j < 32; ++j) { a0 += sil[k0 + j] * wv[j]; a1 += sil[1024 + k0 + j] * wv[j]; } }
            part[(wave * 2 + 0) * 64 + lane] = a0; part[(wave * 2 + 1) * 64 + lane] = a1;
            __syncthreads();
            if (wave == 0) { float s0 = 0.f, s1 = 0.f;
#pragma unroll
                for (int w8 = 0; w8 < 8; ++w8) { s0 += part[(w8 * 2 + 0) * 64 + lane]; s1 += part[(w8 * 2 + 1) * 64 + lane]; }
                const float b = a->in[I_BADA][l * 6144 + col];
                vec[VO_MOD + (l * 2 + 0) * 6144 + col] = s0 + b; vec[VO_MOD + (l * 2 + 1) * 6144 + col] = s1 + b; }
            __syncthreads();
        }
    }
    if (bid == G - 1) {
        for (int idx = tid; idx < 5120; idx += NTHR) {
            const int isc = idx >= 4096, j = isc ? idx - 4096 : idx, pos = j / 16, i = j % 16;
            const float inv = exp2f(-(float)i * 0.83048202372184059f);
            const float ang = (float)pos * inv;
            double r = (double)ang * 0.15915494309189535; r -= floor(r);
            const float rf = (float)r;
            const float cs = __builtin_amdgcn_cosf(rf), sn = __builtin_amdgcn_sinf(rf);
            float* t = vec + VO_ROPE + (isc ? 8192 : 0);
            const int n = isc ? 1024 : 4096;
            t[j] = cs; t[n + j] = sn;
        }
    }
}

template <bool STORE = true, bool BFX = false> __device__ __forceinline__ void norm_row(const void* xrow, const float* sc, const float* sh, bf16* orow, int lane, f32x4 (&h)[4]) {
    f32x4 v[4]; float s = 0.f;
    if constexpr (BFX) { const GAS v2u* xr = (const GAS v2u*)xrow + lane;
#pragma unroll
        for (int j = 0; j < 4; ++j) { const v2u t = xr[64 * j]; v[j] = (f32x4){bflo(t.x), bfhi(t.x), bflo(t.y), bfhi(t.y)}; } }
    else { const GAS f32x4* xr = (const GAS f32x4*)xrow + lane;
#pragma unroll
        for (int j = 0; j < 4; ++j) v[j] = xr[64 * j]; }
#pragma unroll
    for (int j = 0; j < 4; ++j) s += (v[j].x * v[j].x + v[j].y * v[j].y) + (v[j].z * v[j].z + v[j].w * v[j].w);
    const float rstd = __builtin_amdgcn_rsqf(wave_sum(s) * (1.0f / DM) + EPS);
    GAS v2u* o8 = (GAS v2u*)orow + lane;
#pragma unroll
    for (int j = 0; j < 4; ++j) { const f32x4 scv = *(const f32x4*)(sc + 4 * lane + 256 * j), shv = *(const f32x4*)(sh + 4 * lane + 256 * j);
        h[j] = v[j] * rstd * (scv + 1.0f) + shv;
        if constexpr (STORE) { v2u w; w.x = pk2(h[j].x, h[j].y); w.y = pk2(h[j].z, h[j].w); o8[64 * j] = w; } }
}
__device__ __forceinline__ void phase_norm(KA a, int l, int which, int nrows, bf16* H, int lane, int wave, int G, int bid) {
    const float* vec = (const float*)(a->ws + WS_VEC);
    const bool bfx = !(l == 0 && which == 0);
    const float* xl = a->in[I_X]; const bf16* xb = (const bf16*)(a->ws + WS_XB);
    const float* xc = (l == 0) ? a->in[I_CTX] : (const float*)(a->ws + WS_CTXR);
    const int nlat = nrows < S_LAT ? nrows : S_LAT;
    const float* ml = vec + VO_MOD + (l * 2 + 0) * 6144 + which * 3072;
    const float* mc = vec + VO_MOD + (l * 2 + 1) * 6144 + which * 3072;
    const int gw = bid * NWAVES + wave, NGW = G * NWAVES;
    f32x4 scl[4], shl[4], v[4];
#pragma unroll
    for (int j = 0; j < 4; ++j) { scl[j] = *(const f32x4*)(ml + 1024 + 4 * lane + 256 * j) + 1.0f; shl[j] = *(const f32x4*)(ml + 4 * lane + 256 * j); }
    if (gw < nlat) {
        if (bfx) { const GAS v2u* xr = (const GAS v2u*)(xb + (size_t)gw * DM) + lane;
#pragma unroll
            for (int j = 0; j < 4; ++j) { const v2u t = xr[64 * j]; v[j] = (f32x4){bflo(t.x), bfhi(t.x), bflo(t.y), bfhi(t.y)}; } }
        else { const GAS f32x4* xr = (const GAS f32x4*)(xl + (size_t)gw * DM) + lane;
#pragma unroll
            for (int j = 0; j < 4; ++j) v[j] = xr[64 * j]; } }
    for (int r = gw; r < nlat; r += NGW) {
        const int rn = r + NGW; f32x4 vn[4];
        if (rn < nlat) {
            if (bfx) { const GAS v2u* xr = (const GAS v2u*)(xb + (size_t)rn * DM) + lane;
#pragma unroll
                for (int j = 0; j < 4; ++j) { const v2u t = xr[64 * j]; vn[j] = (f32x4){bflo(t.x), bfhi(t.x), bflo(t.y), bfhi(t.y)}; } }
            else { const GAS f32x4* xr = (const GAS f32x4*)(xl + (size_t)rn * DM) + lane;
#pragma unroll
                for (int j = 0; j < 4; ++j) vn[j] = xr[64 * j]; } }
        float s = 0.f;
#pragma unroll
        for (int j = 0; j < 4; ++j) s += (v[j].x * v[j].x + v[j].y * v[j].y) + (v[j].z * v[j].z + v[j].w * v[j].w);
        const float rstd = __builtin_amdgcn_rsqf(wave_sum(s) * (1.0f / DM) + EPS);
        GAS v2u* o8 = (GAS v2u*)(H + (size_t)r * DM) + lane;
#pragma unroll
        for (int j = 0; j < 4; ++j) { const f32x4 h = v[j] * rstd * scl[j] + shl[j]; v2u w; w.x = pk2(h.x, h.y); w.y = pk2(h.z, h.w); o8[64 * j] = w; }
#pragma unroll
        for (int j = 0; j < 4; ++j) v[j] = vn[j];
    }
    const int npart = (l == 0 && which == 0) ? 0 : (l == 0 ? 4 : 11);
    const float* part = (const float*)(a->ws + (l == 0 ? WS_PART1 : WS_PART2));
    for (int r = S_LAT + (NGW - 1 - gw); r < nrows; r += NGW) {
        const int cr = r - S_LAT; f32x4 x[4];
        { const GAS f32x4* xr = (const GAS f32x4*)(xc + (size_t)cr * DM) + lane;
#pragma unroll
          for (int j = 0; j < 4; ++j) x[j] = xr[64 * j]; }
        for (int p = 0; p < npart; ++p) { const GAS f32x4* pr = (const GAS f32x4*)(part + ((size_t)p * 256 + cr) * DM) + lane;
#pragma unroll
            for (int j = 0; j < 4; ++j) x[j] = x[j] + pr[64 * j]; }
        if (npart && l == 0) { GAS f32x4* cw = (GAS f32x4*)((float*)(a->ws + WS_CTXR) + (size_t)cr * DM) + lane;
#pragma unroll
            for (int j = 0; j < 4; ++j) cw[64 * j] = x[j]; }
        float s = 0.f;
#pragma unroll
        for (int j = 0; j < 4; ++j) s += (x[j].x * x[j].x + x[j].y * x[j].y) + (x[j].z * x[j].z + x[j].w * x[j].w);
        const float rstd = __builtin_amdgcn_rsqf(wave_sum(s) * (1.0f / DM) + EPS);
        GAS v2u* o8 = (GAS v2u*)(H + (size_t)r * DM) + lane;
#pragma unroll
        for (int j = 0; j < 4; ++j) { const f32x4 scv = *(const f32x4*)(mc + 1024 + 4 * lane + 256 * j), shv = *(const f32x4*)(mc + 4 * lane + 256 * j);
            const f32x4 h = x[j] * rstd * (scv + 1.0f) + shv; v2u w; w.x = pk2(h.x, h.y); w.y = pk2(h.z, h.w); o8[64 * j] = w; }
    }
}
constexpr int ROUTE_ROWS_OFF = 36864;
__device__ __forceinline__ void phase_norm_route(KA a, LAS unsigned char* lds, int tid, int lane, int wave, int G, int bid) {
    const int l = 1;
    const float* vec = (const float*)(a->ws + WS_VEC);
    const float* ml = vec + VO_MOD + (l * 2 + 0) * 6144 + 3072;
    LAS float* rt = (LAS float*)lds;
    volatile LAS unsigned* lcnt = (volatile LAS unsigned*)(lds + 32768);
    for (int i = tid; i < 8192; i += NTHR) rt[i] = a->in[I_ROUTER][i];
    if (tid < 16) lcnt[tid] = 0u;
    __syncthreads();
    int* tokinfo = (int*)(a->ws + WS_TOK);
    unsigned* cnt = (unsigned*)(a->ws + WS_CTL) + CW_MOECNT;
    const int gw = bid * NWAVES + wave, NGW = G * NWAVES;
    unsigned keep = 0u, pk0 = 0u; int itn = 0;
    for (int r = gw; r < S_LAT; r += NGW) {
        f32x4 h[4];
        norm_row<false, true>((const bf16*)(a->ws + WS_XB) + (size_t)r * DM, ml + 1024, ml, nullptr, lane, h);
#pragma unroll
        for (int j = 0; j < 4; ++j) ((LAS unsigned*)(lds + ROUTE_ROWS_OFF + wave * 8192 + itn * 1024))[lane + 64 * j] = pk4_fp8(h[j].x * F8_ASCALE, h[j].y * F8_ASCALE, h[j].z * F8_ASCALE, h[j].w * F8_ASCALE);
        float lg[8];
#pragma unroll
        for (int e = 0; e < 8; ++e) lg[e] = 0.f;
#pragma unroll
        for (int j = 0; j < 4; ++j)
#pragma unroll
            for (int i = 0; i < 4; ++i) { const int d = 4 * lane + 256 * j + i; const f32x4 r0 = *(const LAS f32x4*)(rt + d * 8), r1 = *(const LAS f32x4*)(rt + d * 8 + 4); const float hv = h[j][i];
                lg[0] += hv * r0.x; lg[1] += hv * r0.y; lg[2] += hv * r0.z; lg[3] += hv * r0.w; lg[4] += hv * r1.x; lg[5] += hv * r1.y; lg[6] += hv * r1.z; lg[7] += hv * r1.w; }
#pragma unroll
        for (int e = 0; e < 8; ++e) lg[e] = wave_sum(lg[e]);
        int i1 = 0; float v1 = lg[0];
#pragma unroll
        for (int e = 1; e < 8; ++e) if (lg[e] > v1) { v1 = lg[e]; i1 = e; }
        int i2 = -1; float v2 = -INFINITY;
#pragma unroll
        for (int e = 0; e < 8; ++e) if (e != i1 && lg[e] > v2) { v2 = lg[e]; i2 = e; }
        const float w1 = 1.0f / (1.0f + __expf(v2 - v1)), w2 = 1.0f - w1;
        if (lane == 0) {
            const unsigned r1 = __hip_atomic_fetch_add((LAS unsigned*)lcnt + i1, 1u, __ATOMIC_RELAXED, __HIP_MEMORY_SCOPE_WORKGROUP), r2 = __hip_atomic_fetch_add((LAS unsigned*)lcnt + i2, 1u, __ATOMIC_RELAXED, __HIP_MEMORY_SCOPE_WORKGROUP);
            int* ti = tokinfo + (size_t)r * 8;
            ti[0] = i1; ti[1] = i2; ti[4] = __builtin_bit_cast(int, w1); ti[5] = __builtin_bit_cast(int, w2);
            pk0 = (unsigned)i1 | ((unsigned)i2 << 3) | (r1 << 6) | (r2 << 19);
        }
        const unsigned pku = (unsigned)__builtin_amdgcn_readfirstlane((int)pk0);
        if (lane == itn) keep = pku;
        ++itn;
    }
    __syncthreads();
    if (tid < 8) lcnt[8 + tid] = __hip_atomic_fetch_add(cnt + 64 * tid, lcnt[tid], RLX_AGENT);
    __syncthreads();
    { const int r = gw + lane * NGW; if (lane < itn && r < S_LAT) { int* ti = tokinfo + (size_t)r * 8; const unsigned e1 = keep & 7u, e2 = (keep >> 3) & 7u; ti[2] = (int)(((keep >> 6) & 0x1fffu) + lcnt[8 + e1]); ti[3] = (int)((keep >> 19) + lcnt[8 + e2]); } }
}

__device__ __forceinline__ void qk_prep(KA a, int l, int first_thread, int nthreads) {
    bf16* PROJ = (bf16*)(a->ws + WS_PROJ);
    const float* rope = (const float*)(a->ws + WS_VEC) + VO_ROPE;
    for (int i = first_thread; i < R_ALL * 10; i += nthreads) {
        const int row = i / 10, hh = i % 10; const bool isq = hh < 8;
        bf16* p = PROJ + (size_t)row * INW + (isq ? hh * 64 : COL_AK + (hh - 8) * 64);
        const float* gain = (isq ? a->in[I_QG] : a->in[I_KG]) + l * 64;
        float x[64]; float ss = 0.f;
#pragma unroll
        for (int c = 0; c < 8; ++c) { const v4u w = *(const GAS v4u*)(p + 8 * c); unpack8(w, x + 8 * c); }
#pragma unroll
        for (int d = 0; d < 64; ++d) ss += x[d] * x[d];
        const float rstd = __builtin_amdgcn_rsqf(ss * (1.0f / 64.0f) + EPS);
        const f32x4* g4 = (const f32x4*)gain;
#pragma unroll
        for (int c = 0; c < 16; ++c) { const f32x4 gv = g4[c]; x[4 * c] *= rstd * gv.x; x[4 * c + 1] *= rstd * gv.y; x[4 * c + 2] *= rstd * gv.z; x[4 * c + 3] *= rstd * gv.w; }
        if (row < S_LAT) {
            const int gr = row >> 6, gc = row & 63;
            const f32x4* cr = (const f32x4*)(rope + gr * 16); const f32x4* sr = (const f32x4*)(rope + 4096 + gr * 16); const f32x4* cc = (const f32x4*)(rope + 8192 + gc * 16); const f32x4* sc = (const f32x4*)(rope + 8192 + 1024 + gc * 16);
#pragma unroll
            for (int j4 = 0; j4 < 4; ++j4) { const f32x4 cv = cr[j4], sv = sr[j4];
#pragma unroll
                for (int i = 0; i < 4; ++i) { const int j = 4 * j4 + i; const float x1 = x[j], x2 = x[16 + j]; x[j] = x1 * cv[i] - x2 * sv[i]; x[16 + j] = x1 * sv[i] + x2 * cv[i]; } }
#pragma unroll
            for (int j4 = 0; j4 < 4; ++j4) { const f32x4 cv = cc[j4], sv = sc[j4];
#pragma unroll
                for (int i = 0; i < 4; ++i) { const int j = 4 * j4 + i; const float x1 = x[32 + j], x2 = x[48 + j]; x[32 + j] = x1 * cv[i] - x2 * sv[i]; x[48 + j] = x1 * sv[i] + x2 * cv[i]; } }
        }
        const float qs = isq ? 0.125f * 1.4426950408889634f : 1.0f;
#pragma unroll
        for (int c = 0; c < 8; ++c) { v4u w; w.x = pk2(x[8 * c] * qs, x[8 * c + 1] * qs); w.y = pk2(x[8 * c + 2] * qs, x[8 * c + 3] * qs); w.z = pk2(x[8 * c + 4] * qs, x[8 * c + 5] * qs); w.w = pk2(x[8 * c + 6] * qs, x[8 * c + 7] * qs);
            *(GAS v4u*)(p + 8 * c) = w; }
    }
}
__device__ __forceinline__ void gmlp_unit(KA a, int l, int chunk, int g, LAS unsigned char* lds, int tid, int lane, int wave) {
    const bf16* PROJ = (const bf16*)(a->ws + WS_PROJ); bf16* MIX = (bf16*)(a->ws + WS_MIX);
    const int row0 = (chunk < 128) ? chunk * 128 : S_LAT + (chunk - 128) * 128;
    LAS float* vn = (LAS float*)lds;
    { const int pos = tid >> 2, part = tid & 3;
      const bf16* p = PROJ + (size_t)(row0 + pos) * INW + COL_GV + g * 64 + part * 16;
      float x[16]; unpack8(*(const GAS v4u*)p, x); unpack8(*(const GAS v4u*)(p + 8), x + 8);
      float ss = 0.f;
#pragma unroll
      for (int d = 0; d < 16; ++d) { x[d] = gelu1(x[d]); ss += x[d] * x[d]; }
      ss += sx<1>(ss); ss += sx<2>(ss);
      const float rstd = __builtin_amdgcn_rsqf(ss * (1.0f / 64.0f) + EPS);
      const float* gn = a->in[I_GNG] + l * 256 + g * 64 + part * 16;
#pragma unroll
      for (int d = 0; d < 16; ++d) vn[pos * 64 + part * 16 + d] = x[d] * rstd * gn[d]; }
    __syncthreads();
    const int c = lane, t0 = wave * 16;
    const float* W = a->in[I_GWS] + ((size_t)(l * 4 + g) * 128 + t0) * 128;
    float acc[16];
#pragma unroll
    for (int i = 0; i < 16; ++i) acc[i] = 0.f;
    for (int s = 0; s < 128; ++s) { const float v = vn[s * 64 + c];
#pragma unroll
        for (int i = 0; i < 16; ++i) acc[i] += W[i * 128 + s] * v; }
    const float* bs = a->in[I_GBS] + (l * 4 + g) * 128 + t0;
#pragma unroll
    for (int i = 0; i < 16; ++i) { const int row = row0 + t0 + i;
        const float u = gelu1(bflo((unsigned)PROJ[(size_t)row * INW + COL_GU + g * 64 + c]));
        MIX[(size_t)row * DM + MIX_GM + g * 64 + c] = (bf16)f2bf(u * (acc[i] + bs[i])); }
    __syncthreads();
}
__device__ __forceinline__ void hgrn_naive(KA a, int l, int dir, int head, LAS unsigned char* lds, int tid, int lane, int wave) {
    const bf16* PROJ = (const bf16*)(a->ws + WS_PROJ);
    float* HGO = (float*)(a->ws + WS_HGO) + (size_t)dir * R_ALL * 256;
    LAS float* Qs = (LAS float*)lds;
    LAS float* Fs = Qs + 4096; LAS float* Vs = Fs + 4096; LAS float* part = Vs + 4096;
    const int v = lane, kg = wave;
    float S[8];
#pragma unroll
    for (int i = 0; i < 8; ++i) S[i] = 0.f;
    const int tl = tid >> 3, c8 = tid & 7;
    float lb[8];
#pragma unroll
    for (int j = 0; j < 8; ++j) { float b = 0.f; if (l == 1) { const float p0 = a->in[I_HLB][dir * 512 + head * 64 + c8 * 8 + j], p1 = a->in[I_HLB][dir * 512 + 256 + head * 64 + c8 * 8 + j]; b = 1.0f / (1.0f + __expf(p0 - p1)); } lb[j] = b; }
    const int fcol = (dir == 0 ? COL_HFF : COL_HFB) + head * 64 + c8 * 8;
    for (int n0 = 0; n0 < R_ALL; n0 += 64) {
        { const int n = n0 + tl; int row;
          if (dir == 0) row = (n < C_CTX) ? S_LAT + n : n - C_CTX; else row = (n < C_CTX) ? S_LAT + (C_CTX - 1 - n) : (S_LAT - 1) - (n - C_CTX);
          const bf16* pr = PROJ + (size_t)row * INW;
          float q[8], f[8], vv[8];
          unpack8(*(const GAS v4u*)(pr + COL_HQ + head * 64 + c8 * 8), q); unpack8(*(const GAS v4u*)(pr + fcol), f); unpack8(*(const GAS v4u*)(pr + COL_HI + head * 64 + c8 * 8), vv);
#pragma unroll
          for (int j = 0; j < 8; ++j) { Qs[tl * 64 + c8 * 8 + j] = silu1(q[j]) * 0.125f; Fs[tl * 64 + c8 * 8 + j] = lb[j] + (1.0f - lb[j]) * sigm1(f[j]); Vs[tl * 64 + c8 * 8 + j] = vv[j]; } }
        __syncthreads();
        for (int t = 0; t < 64; ++t) {
            const float vt = Vs[t * 64 + v]; float po = 0.f;
#pragma unroll
            for (int i = 0; i < 8; ++i) { const float f = Fs[t * 64 + kg * 8 + i], q = Qs[t * 64 + kg * 8 + i]; S[i] = f * S[i] + (1.0f - f) * vt; po += S[i] * q; }
            part[((t & 1) * 8 + kg) * 64 + v] = po;
            __syncthreads();
            if (wave == 0) { float o = 0.f;
#pragma unroll
                for (int w8 = 0; w8 < 8; ++w8) o += part[((t & 1) * 8 + w8) * 64 + v];
                const int n = n0 + t; int row;
                if (dir == 0) row = (n < C_CTX) ? S_LAT + n : n - C_CTX; else row = (n < C_CTX) ? S_LAT + (C_CTX - 1 - n) : (S_LAT - 1) - (n - C_CTX);
                HGO[(size_t)row * 256 + head * 64 + v] = o; }
        }
        __syncthreads();
    }
}

typedef short bf16x8v __attribute__((ext_vector_type(8)));
constexpr int HST = 72;
__device__ __forceinline__ f32x4 mma16(const LAS bf16* MA, const LAS bf16* MBt, int k0, f32x4 c, int lane) {
    const bf16x8v av = *(const LAS bf16x8v*)(MA + (lane & 15) * HST + k0 + 8 * (lane >> 4));
    const bf16x8v bv = *(const LAS bf16x8v*)(MBt + (lane & 15) * HST + k0 + 8 * (lane >> 4));
    return __builtin_amdgcn_mfma_f32_16x16x32_bf16(av, bv, c, 0, 0, 0);
}
__device__ __forceinline__ int hg_base_row(int cpos) { return cpos < 256 ? 64 * cpos : S_LAT + 64 * (cpos - 256); }
__device__ __forceinline__ int hg_scan_idx(int dir, int cpos) { return dir == 0 ? (cpos < 256 ? 4 + cpos : cpos - 256) : (cpos < 256 ? 4 + (255 - cpos) : 3 - (cpos - 256)); }
__device__ __forceinline__ float hg_lb(KA a, int l, int dir, int head, int k) {
    if (l == 0) return 0.f;
    const float p0 = a->in[I_HLB][dir * 512 + head * 64 + k], p1 = a->in[I_HLB][dir * 512 + 256 + head * 64 + k];
    return 1.0f / (1.0f + __expf(p0 - p1));
}
__device__ __forceinline__ void hgrn_stepA(KA a, int l, int cpos, int head, LAS unsigned char* lds, int lane, int wave) {
    const bf16* PROJ = (const bf16*)(a->ws + WS_PROJ);
    const int dir = wave >> 2, I = wave & 3, base = hg_base_row(cpos), ci = hg_scan_idx(dir, cpos);
    LAS float* TOT = (LAS float*)lds;
    LAS bf16* KLT = (LAS bf16*)(lds + 2048) + dir * 64 * HST;
    LAS bf16* VT = (LAS bf16*)(lds + 2048 + 2 * 64 * HST * 2) + dir * 64 * HST;
    const float lb = hg_lb(a, l, dir, head, lane);
    const int fcol = (dir == 0 ? COL_HFF : COL_HFB) + head * 64 + lane, vcol = COL_HI + head * 64 + lane;
    float kk[16], cl[16]; float run = 0.f;
#pragma unroll
    for (int i = 0; i < 16; ++i) { const int n = 16 * I + i, row = base + (dir ? 63 - n : n);
        const float fl = bflo((unsigned)PROJ[(size_t)row * INW + fcol]);
        const unsigned short vb = PROJ[(size_t)row * INW + vcol];
        const float f = lb + (1.0f - lb) * sigm1(fl);
        run += __logf(f); cl[i] = run; kk[i] = 1.0f - f;
        VT[lane * HST + n] = vb; }
    TOT[(dir * 4 + I) * 64 + lane] = run;
    __syncthreads();
    float post = 0.f, all = 0.f;
#pragma unroll
    for (int J = 0; J < 4; ++J) { const float t = TOT[(dir * 4 + J) * 64 + lane]; all += t; if (J > I) post += t; }
#pragma unroll
    for (int i = 0; i < 16; ++i) KLT[lane * HST + 16 * I + i] = (bf16)f2bf(kk[i] * __expf(run - cl[i] + post));
    if (I == 0) ((float*)(a->ws + WS_HDG))[((size_t)(dir * 4 + head) * 260 + ci) * 64 + lane] = __expf(all);
    __syncthreads();
    float* LT = (float*)(a->ws + WS_HLT) + ((size_t)(dir * 4 + head) * 260 + ci) * 4096;
    float z0 = 0.f; asm volatile("" : "+v"(z0));
#pragma unroll
    for (int kb = 0; kb < 4; ++kb) { f32x4 acc = {z0, z0, z0, z0};
        acc = mma16(VT + 16 * I * HST, KLT + 16 * kb * HST, 0, acc, lane); acc = mma16(VT + 16 * I * HST, KLT + 16 * kb * HST, 32, acc, lane);
#pragma unroll
        for (int r = 0; r < 4; ++r) LT[(16 * I + 4 * (lane >> 4) + r) * 64 + 16 * kb + (lane & 15)] = acc[r]; }
    __syncthreads();
}
__device__ __forceinline__ void hgrn_stepB(KA a, int item, int tid) {
    const int dh = item >> 3, vb = item & 7, v = vb * 8 + (tid >> 6), k = tid & 63;
    const float* LT = (const float*)(a->ws + WS_HLT) + (size_t)dh * 260 * 4096 + v * 64 + k;
    const float* DG = (const float*)(a->ws + WS_HDG) + (size_t)dh * 260 * 64 + k;
    bf16* SP = (bf16*)(a->ws + WS_HSP) + (size_t)dh * 260 * 4096 + v * 64 + k;
    float S = 0.f;
#pragma unroll 1
    for (int c0 = 0; c0 < 260; c0 += 26) {
        float lt[26], dg[26];
#pragma unroll
        for (int j = 0; j < 26; ++j) { lt[j] = LT[(size_t)(c0 + j) * 4096]; dg[j] = DG[(c0 + j) * 64]; }
#pragma unroll
        for (int j = 0; j < 26; ++j) { SP[(size_t)(c0 + j) * 4096] = (bf16)f2bf(S); S = dg[j] * S + lt[j]; }
    }
}
__device__ __forceinline__ void hgrn_stepC(KA a, int l, int cpos, int head, LAS unsigned char* lds, int tid, int lane, int wave) {
    const bf16* PROJ = (const bf16*)(a->ws + WS_PROJ); bf16* MIX = (bf16*)(a->ws + WS_MIX);
    const int dir = wave >> 2, I = wave & 3, base = hg_base_row(cpos), ci = hg_scan_idx(dir, cpos);
    constexpr int MSZ = 64 * HST;
    LAS float* TOT = (LAS float*)lds;
    LAS bf16* img = (LAS bf16*)(lds + 2048);
    LAS bf16* QT = img + dir * MSZ;
    LAS bf16* QD = img + 2 * MSZ + dir * MSZ;
    LAS bf16* VT = img + 4 * MSZ + dir * MSZ;
    LAS bf16* ST = img + 6 * MSZ + dir * MSZ;
    LAS bf16* AS = img + 8 * MSZ + dir * MSZ + I * 16 * HST;
    LAS bf16* KT = img + 10 * MSZ + dir * (10 * 16 * HST);
    LAS float* OS = (LAS float*)(img + 10 * MSZ);
    const float lb = hg_lb(a, l, dir, head, lane);
    const int fcol = (dir == 0 ? COL_HFF : COL_HFB) + head * 64 + lane, qcol = COL_HQ + head * 64 + lane, vcol = COL_HI + head * 64 + lane;
    { const bf16* SP = (const bf16*)(a->ws + WS_HSP) + ((size_t)(dir * 4 + head) * 260 + ci) * 4096;
#pragma unroll
      for (int h2 = 0; h2 < 2; ++h2) { const int e = ((I * 2 + h2) * 64 + lane) * 8, vv = e >> 6, kk0 = e & 63;
          *(LAS v4u*)(ST + vv * HST + kk0) = *(const GAS v4u*)(SP + e); } }
    float kk[16], cl[16], qv[16]; float run = 0.f;
#pragma unroll
    for (int i = 0; i < 16; ++i) { const int n = 16 * I + i, row = base + (dir ? 63 - n : n);
        const float fl = bflo((unsigned)PROJ[(size_t)row * INW + fcol]), ql = bflo((unsigned)PROJ[(size_t)row * INW + qcol]);
        const unsigned short vb = PROJ[(size_t)row * INW + vcol];
        const float f = lb + (1.0f - lb) * sigm1(fl);
        run += __logf(f); cl[i] = run; kk[i] = 1.0f - f; qv[i] = silu1(ql) * 0.125f;
        VT[lane * HST + n] = vb; }
    TOT[(dir * 4 + I) * 64 + lane] = run;
    __syncthreads();
    float tj[4];
#pragma unroll
    for (int J = 0; J < 4; ++J) tj[J] = TOT[(dir * 4 + J) * 64 + lane];
    float pre = 0.f;
#pragma unroll
    for (int J = 0; J < 4; ++J) if (J < I) pre += tj[J];
    const float epre = __expf(pre); float kei[16];
#pragma unroll
    for (int i = 0; i < 16; ++i) { const float e = __expf(cl[i]); QT[(16 * I + i) * HST + lane] = (bf16)f2bf(qv[i] * e); QD[(16 * I + i) * HST + lane] = (bf16)f2bf(qv[i] * e * epre); kei[i] = kk[i] * fminf(__builtin_amdgcn_rcpf(e), 5.5e34f); }
    float eoff = 0.f;
#pragma unroll
    for (int I2 = 0; I2 < 4; ++I2) {
        if (I2 >= I) {
            if (I2 == I) eoff = 0.f; else if (I2 == I + 1) eoff = run; else eoff += tj[I2 - 1];
            LAS bf16* blk = KT + (I2 * (I2 + 1) / 2 + I) * 16 * HST;
            const float fo = __expf(eoff);
#pragma unroll
            for (int i = 0; i < 16; ++i) blk[i * HST + lane] = (bf16)f2bf(kei[i] * fo);
        }
    }
    __syncthreads();
    float z0 = 0.f; asm volatile("" : "+v"(z0));
    f32x4 sc[4];
#pragma unroll
    for (int J = 0; J < 4; ++J) { sc[J] = (f32x4){z0, z0, z0, z0};
        if (J <= I) { const LAS bf16* kb = KT + (I * (I + 1) / 2 + J) * 16 * HST;
            sc[J] = mma16(QT + 16 * I * HST, kb, 0, sc[J], lane); sc[J] = mma16(QT + 16 * I * HST, kb, 32, sc[J], lane);
            if (J == I) {
#pragma unroll
                for (int r = 0; r < 4; ++r) if ((lane & 15) > 4 * (lane >> 4) + r) sc[J][r] = z0; } } }
#pragma unroll
    for (int J = 0; J < 4; ++J)
#pragma unroll
        for (int r = 0; r < 4; ++r) AS[(4 * (lane >> 4) + r) * HST + 16 * J + (lane & 15)] = (bf16)f2bf(sc[J][r]);
    asm volatile("s_waitcnt lgkmcnt(0)" ::: "memory");
    f32x4 acc[4];
#pragma unroll
    for (int vb = 0; vb < 4; ++vb) { acc[vb] = (f32x4){z0, z0, z0, z0};
        acc[vb] = mma16(AS, VT + 16 * vb * HST, 0, acc[vb], lane); acc[vb] = mma16(AS, VT + 16 * vb * HST, 32, acc[vb], lane);
        acc[vb] = mma16(QD + 16 * I * HST, ST + 16 * vb * HST, 0, acc[vb], lane); acc[vb] = mma16(QD + 16 * I * HST, ST + 16 * vb * HST, 32, acc[vb], lane); }
    __syncthreads();
#pragma unroll
    for (int vb = 0; vb < 4; ++vb)
#pragma unroll
        for (int r = 0; r < 4; ++r) { const int n = 16 * I + 4 * (lane >> 4) + r, rl = dir ? 63 - n : n; OS[(dir * 64 + rl) * 68 + 16 * vb + (lane & 15)] = acc[vb][r]; }
    __syncthreads();
    { const int rl = tid >> 3, v8 = (tid & 7) * 8, row = base + rl;
      float o[8]; float ss = 0.f;
#pragma unroll
      for (int j = 0; j < 8; ++j) { o[j] = OS[rl * 68 + v8 + j] + OS[(64 + rl) * 68 + v8 + j]; ss += o[j] * o[j]; }
      ss += sx<1>(ss); ss += sx<2>(ss); ss += sx<4>(ss);
      const float rstd = __builtin_amdgcn_rsqf(ss * (1.0f / 64.0f) + EPS);
      float gt[8]; unpack8(*(const GAS v4u*)(PROJ + (size_t)row * INW + COL_HG + head * 64 + v8), gt);
      const float* gn = a->in[I_HGAIN] + l * 64 + v8;
      float y[8];
#pragma unroll
      for (int j = 0; j < 8; ++j) y[j] = o[j] * rstd * gn[j] * silu1(gt[j]);
      v4u w; w.x = pk2(y[0], y[1]); w.y = pk2(y[2], y[3]); w.z = pk2(y[4], y[5]); w.w = pk2(y[6], y[7]);
      *(GAS v4u*)(MIX + (size_t)row * DM + MIX_HG + head * 64 + v8) = w; }
    __syncthreads();
}

__device__ __forceinline__ void vt_item(KA a, int item, int lane) {
    const bf16* PROJ = (const bf16*)(a->ws + WS_PROJ); bf16* VTg = (bf16*)(a->ws + WS_VT);
    const int rb = item >> 1, hk = item & 1, row = rb * 64 + lane;
    const bf16* p = PROJ + (size_t)row * INW + COL_AV + hk * 64;
    unsigned w[32];
#pragma unroll
    for (int c = 0; c < 8; ++c) { const v4u t = *(const GAS v4u*)(p + 8 * c); w[4 * c] = t.x; w[4 * c + 1] = t.y; w[4 * c + 2] = t.z; w[4 * c + 3] = t.w; }
    bf16* o = VTg + (size_t)hk * 64 * R_ALL + row;
#pragma unroll
    for (int d2 = 0; d2 < 32; ++d2) { o[(size_t)(2 * d2) * R_ALL] = (bf16)(w[d2] & 0xffffu); o[(size_t)(2 * d2 + 1) * R_ALL] = (bf16)(w[d2] >> 16); }
}
__device__ __forceinline__ void attn_unit(KA a, int l, int u, LAS unsigned char* lds, int tid, int lane, int wave) {
    asm volatile("" : "+v"(tid), "+v"(lane));
    const bf16* PROJ = (const bf16*)(a->ws + WS_PROJ); const bf16* VTg = (const bf16*)(a->ws + WS_VT); bf16* MIX = (bf16*)(a->ws + WS_MIX);
    const bool isctx = u >= 256; const int uu = isctx ? u - 256 : u; const int n = uu >> 1, hk = uu & 1;
    const int qh = hk * 4 + (wave >> 1), half = wave & 1;
    const int qbase = (isctx ? S_LAT : 0) + n * 128 + half * 64, qpos0 = n * 128 + half * 64;
    const int c = lane & 15, g = lane >> 4;
    LAS bf16* Kt = (LAS bf16*)lds; LAS bf16* Vt = Kt + 64 * HST; LAS bf16* Qw = Vt + 64 * HST + wave * 64 * HST;
#pragma unroll
    for (int j = 0; j < 8; ++j) { const int qr = 8 * j + (lane >> 3), qc = (lane & 7) * 8;
        *(LAS v4u*)(Qw + qr * HST + qc) = *(const GAS v4u*)(PROJ + (size_t)(qbase + qr) * INW + qh * 64 + qc); }
    float z0 = 0.f; asm volatile("" : "+v"(z0));
    f32x4 o[4][4]; float ls[4];
    float gq = 0.f, gk = 0.f;
#pragma unroll 8
    for (int d = 0; d < 64; ++d) { gq = fmaxf(gq, fabsf(a->in[I_QG][l * 64 + d])); gk = fmaxf(gk, fabsf(a->in[I_KG][l * 64 + d])); }
    const float nbnd = -(8.0f * 1.4426950408889634f) * gq * gk;
    const f32x4 nb4 = {nbnd, nbnd, nbnd, nbnd};
    const float sink = a->in[I_SINK][l * 8 + qh] * 1.4426950408889634f;
#pragma unroll
    for (int qt = 0; qt < 4; ++qt) { ls[qt] = (g == 0) ? __builtin_amdgcn_exp2f(sink + nbnd) : z0;
#pragma unroll
        for (int dt = 0; dt < 4; ++dt) o[qt][dt] = (f32x4){z0, z0, z0, z0}; }
    const int first = (!isctx && n == 0) ? 2 : 0, nwin = isctx ? 0 : ((n == 0 || n == 127) ? 4 : 6), nt = nwin + 4;
    const int lr = tid >> 3, lc = (tid & 7) * 8;
    v4u kreg, vreg;
#define ATT_LOADT(i) do { const bool ct_ = (i) >= nwin; const int kb_ = ct_ ? S_LAT + 64 * ((i) - nwin) : (n - 1) * 128 + 64 * (first + (i)); \
        kreg = *(const GAS v4u*)(PROJ + (size_t)(kb_ + lr) * INW + COL_AK + hk * 64 + lc); vreg = *(const GAS v4u*)(VTg + ((size_t)hk * 64 + lr) * R_ALL + kb_ + lc); } while (0)
    ATT_LOADT(0);
#pragma unroll 1
    for (int i = 0; i < nt; ++i) {
        __syncthreads();
        *(LAS v4u*)(Kt + lr * HST + lc) = kreg; *(LAS v4u*)(Vt + lr * HST + lc) = vreg;
        __syncthreads();
        if (i + 1 < nt) ATT_LOADT(i + 1);
        const bool win = i < nwin; const int kb = (n - 1) * 128 + 64 * (first + i);
        const int rel = kb - qpos0;
        const bool maskw = win && (rel == 128 || rel == -128);
        if (win && (rel >= 192 || rel <= -192)) continue;
        bf16x8v kf[4][2], vf[4][2];
#pragma unroll
        for (int kt = 0; kt < 4; ++kt)
#pragma unroll
            for (int ks = 0; ks < 2; ++ks) kf[kt][ks] = *(const LAS bf16x8v*)(Kt + (16 * kt + c) * HST + 32 * ks + 8 * g);
#pragma unroll
        for (int dt = 0; dt < 4; ++dt)
#pragma unroll
            for (int s2 = 0; s2 < 2; ++s2) { const v2u lo = *(const LAS v2u*)(Vt + (16 * dt + c) * HST + 32 * s2 + 4 * g), hi = *(const LAS v2u*)(Vt + (16 * dt + c) * HST + 32 * s2 + 16 + 4 * g);
                const v4u t = {lo.x, lo.y, hi.x, hi.y}; vf[dt][s2] = __builtin_bit_cast(bf16x8v, t); }
        f32x4 sA[4], sB[4];
#define ATT_SCORES(QT, S_) do { const bf16x8v q0_ = *(const LAS bf16x8v*)(Qw + (16 * (QT) + c) * HST + 8 * g), q1_ = *(const LAS bf16x8v*)(Qw + (16 * (QT) + c) * HST + 32 + 8 * g); \
            _Pragma("unroll") for (int kt = 0; kt < 4; ++kt) { S_[kt] = __builtin_amdgcn_mfma_f32_16x16x32_bf16(kf[kt][0], q0_, nb4, 0, 0, 0); S_[kt] = __builtin_amdgcn_mfma_f32_16x16x32_bf16(kf[kt][1], q1_, S_[kt], 0, 0, 0); } } while (0)
#define ATT_REST(QT, S_) do { \
            if (maskw) { const int dq = qpos0 + 16 * (QT) + c - kb - 4 * g; \
                _Pragma("unroll") for (int kt = 0; kt < 4; ++kt) _Pragma("unroll") for (int r = 0; r < 4; ++r) { const int dl = dq - 16 * kt - r; if (dl > 128 || dl < -128) S_[kt][r] = -INFINITY; } } \
            float ps = 0.f; \
            _Pragma("unroll") for (int kt = 0; kt < 4; ++kt) _Pragma("unroll") for (int r = 0; r < 4; ++r) { S_[kt][r] = __builtin_amdgcn_exp2f(S_[kt][r]); ps += S_[kt][r]; } \
            ls[QT] += ps; \
            bf16x8v pb[2]; \
            _Pragma("unroll") for (int s2 = 0; s2 < 2; ++s2) { const v4u t = {pk2(S_[2 * s2][0], S_[2 * s2][1]), pk2(S_[2 * s2][2], S_[2 * s2][3]), pk2(S_[2 * s2 + 1][0], S_[2 * s2 + 1][1]), pk2(S_[2 * s2 + 1][2], S_[2 * s2 + 1][3])}; pb[s2] = __builtin_bit_cast(bf16x8v, t); } \
            _Pragma("unroll") for (int dt = 0; dt < 4; ++dt) { o[QT][dt] = __builtin_amdgcn_mfma_f32_16x16x32_bf16(vf[dt][0], pb[0], o[QT][dt], 0, 0, 0); o[QT][dt] = __builtin_amdgcn_mfma_f32_16x16x32_bf16(vf[dt][1], pb[1], o[QT][dt], 0, 0, 0); } } while (0)
        ATT_SCORES(0, sA);
        ATT_SCORES(1, sB); ATT_REST(0, sA);
        ATT_SCORES(2, sA); ATT_REST(1, sB);
        ATT_SCORES(3, sB); ATT_REST(2, sA);
        ATT_REST(3, sB);
#undef ATT_SCORES
#undef ATT_REST
    }
#undef ATT_LOADT
    int c2 = lane & 15, g2 = lane >> 4; asm volatile("" : "+v"(c2), "+v"(g2));
#pragma unroll
    for (int qt = 0; qt < 4; ++qt) { float lt = ls[qt]; lt += sx<16>(lt); lt = sx32_add(lt); const float inv = 1.0f / lt;
        bf16* op = (bf16*)(a->ws + WS_MIX) + (size_t)(qbase + 16 * qt + c2) * DM + MIX_AT + qh * 64 + 4 * g2;
#pragma unroll
        for (int dt = 0; dt < 4; ++dt) { v2u w; w.x = pk2(o[qt][dt][0] * inv, o[qt][dt][1] * inv); w.y = pk2(o[qt][dt][2] * inv, o[qt][dt][3] * inv); *(GAS v2u*)(op + 16 * dt) = w; } }
}

constexpr int GST = 136;
__device__ __forceinline__ f32x4 mma16g(const LAS bf16* MA, const LAS bf16* MBt, int k0, f32x4 c, int lane) {
    const bf16x8v av = *(const LAS bf16x8v*)(MA + (lane & 15) * GST + k0 + 8 * (lane >> 4));
    const bf16x8v bv = *(const LAS bf16x8v*)(MBt + (lane & 15) * GST + k0 + 8 * (lane >> 4));
    return __builtin_amdgcn_mfma_f32_16x16x32_bf16(av, bv, c, 0, 0, 0);
}
__device__ __forceinline__ float gelu_as(float v) {
    const float av = fabsf(v), t = __builtin_amdgcn_rcpf(av * 0.2316418882f + 1.0f);
    float q = t * 0.5307027145f + (-0.7265760135f); q = q * t + 0.7107068705f; q = q * t + (-0.142248368f); q = q * t + 0.127414796f; q = q * t;
    const float e = __builtin_amdgcn_exp2f((v * v) * (-0.72134752044f)), mm = v * (q * e);
    return v < 0.f ? mm : v - mm;
}
__device__ __forceinline__ void gmlp_unit_mma(KA a, int l, int chunk, int g, LAS unsigned char* lds, int tid, int lane, int wave) {
    const bf16* PROJ = (const bf16*)(a->ws + WS_PROJ); bf16* MIX = (bf16*)(a->ws + WS_MIX);
    const int row0 = (chunk < 128) ? chunk * 128 : S_LAT + (chunk - 128) * 128;
    LAS bf16* WA = (LAS bf16*)lds;
    LAS bf16* VNT = WA + 128 * GST;
    LAS float* OUT = (LAS float*)(VNT + 64 * GST);
    const int pos = tid >> 2, part = tid & 3;
    {
      const float* W = a->in[I_GWS] + ((size_t)(l * 4 + g) * 128 + pos) * 128 + part * 32;
#pragma unroll
      for (int j = 0; j < 4; ++j) { const f32x4 w0 = *(const GAS f32x4*)(W + 8 * j), w1 = *(const GAS f32x4*)(W + 8 * j + 4);
          v4u o; o.x = pk2(w0.x, w0.y); o.y = pk2(w0.z, w0.w); o.z = pk2(w1.x, w1.y); o.w = pk2(w1.z, w1.w);
          *(LAS v4u*)(WA + pos * GST + part * 32 + 8 * j) = o; } }
    { const bf16* p = PROJ + (size_t)(row0 + pos) * INW + COL_GV + g * 64 + part * 16;
      float x[16]; unpack8(*(const GAS v4u*)p, x); unpack8(*(const GAS v4u*)(p + 8), x + 8);
      float ss = 0.f;
#pragma unroll
      for (int d = 0; d < 16; ++d) { x[d] = gelu_as(x[d]); ss += x[d] * x[d]; }
      ss += sx<1>(ss); ss += sx<2>(ss);
      const float rstd = __builtin_amdgcn_rsqf(ss * (1.0f / 64.0f) + EPS);
      const float* gn = a->in[I_GNG] + l * 256 + g * 64 + part * 16;
#pragma unroll
      for (int d = 0; d < 16; ++d) VNT[(part * 16 + d) * GST + pos] = (bf16)f2bf(x[d] * rstd * gn[d]); }
    __syncthreads();
    float z0 = 0.f; asm volatile("" : "+v"(z0));
#pragma unroll
    for (int cb = 0; cb < 4; ++cb) { f32x4 acc = {z0, z0, z0, z0};
#pragma unroll
        for (int ks = 0; ks < 4; ++ks) acc = mma16g(WA + 16 * wave * GST, VNT + 16 * cb * GST, 32 * ks, acc, lane);
#pragma unroll
        for (int r = 0; r < 4; ++r) OUT[(16 * wave + 4 * (lane >> 4) + r) * 68 + 16 * cb + (lane & 15)] = acc[r]; }
    __syncthreads();
    { const int row = row0 + pos; const float bsv = a->in[I_GBS][(l * 4 + g) * 128 + pos];
      const bf16* pu = PROJ + (size_t)row * INW + COL_GU + g * 64 + part * 16;
      float u[16]; unpack8(*(const GAS v4u*)pu, u); unpack8(*(const GAS v4u*)(pu + 8), u + 8);
      float y[16];
#pragma unroll
      for (int d = 0; d < 16; ++d) y[d] = gelu_as(u[d]) * (OUT[pos * 68 + part * 16 + d] + bsv);
      bf16* po = MIX + (size_t)row * DM + MIX_GM + g * 64 + part * 16;
      v4u w; w.x = pk2(y[0], y[1]); w.y = pk2(y[2], y[3]); w.z = pk2(y[4], y[5]); w.w = pk2(y[6], y[7]); *(GAS v4u*)po = w;
      w.x = pk2(y[8], y[9]); w.y = pk2(y[10], y[11]); w.z = pk2(y[12], y[13]); w.w = pk2(y[14], y[15]); *(GAS v4u*)(po + 8) = w; }
    __syncthreads();
}
__device__ __forceinline__ void attn_naive(KA a, int l, int nrows, int lane, int wave, int G, int bid) {
    const bf16* PROJ = (const bf16*)(a->ws + WS_PROJ); bf16* MIX = (bf16*)(a->ws + WS_MIX);
    const int gw = bid * NWAVES + wave, NGW = G * NWAVES;
    for (int pair = gw; pair < nrows * 2; pair += NGW) {
        const int row = pair >> 1, hk = pair & 1; const bool isctx = row >= S_LAT;
        float q[4], o[4], m[4], ls[4];
#pragma unroll
        for (int g = 0; g < 4; ++g) { q[g] = bflo((unsigned)PROJ[(size_t)row * INW + (hk * 4 + g) * 64 + lane]); o[g] = 0.f; ls[g] = 1.0f; m[g] = a->in[I_SINK][l * 8 + hk * 4 + g] * 1.4426950408889634f; }
        int j0 = 0, j1 = -1;
        if (!isctx) { j0 = row - 128 < 0 ? 0 : row - 128; j1 = row + 128 > S_LAT - 1 ? S_LAT - 1 : row + 128; }
        const int nwin = j1 - j0 + 1;
        const int nk = nwin + C_CTX;
#pragma unroll 4
        for (int t = 0; t < nk; ++t) {
            const int krow = (t < nwin) ? j0 + t : S_LAT + (t - nwin);
            const float k = bflo((unsigned)PROJ[(size_t)krow * INW + COL_AK + hk * 64 + lane]);
            const float v = bflo((unsigned)PROJ[(size_t)krow * INW + COL_AV + hk * 64 + lane]);
#pragma unroll
            for (int g = 0; g < 4; ++g) { const float s = wave_sum(q[g] * k); const float mn = fmaxf(m[g], s);
                const float c = __builtin_amdgcn_exp2f(m[g] - mn), p = __builtin_amdgcn_exp2f(s - mn);
                ls[g] = ls[g] * c + p; o[g] = o[g] * c + p * v; m[g] = mn; }
        }
#pragma unroll
        for (int g = 0; g < 4; ++g) MIX[(size_t)row * DM + MIX_AT + (hk * 4 + g) * 64 + lane] = (bf16)f2bf(o[g] / ls[g]);
    }
}
__device__ __forceinline__ void hgrn_combine(KA a, int l, int nrows, int lane, int wave, int G, int bid) {
    const bf16* PROJ = (const bf16*)(a->ws + WS_PROJ); bf16* MIX = (bf16*)(a->ws + WS_MIX);
    const float* O0 = (const float*)(a->ws + WS_HGO); const float* O1 = O0 + (size_t)R_ALL * 256;
    const f32x4 gn = *(const f32x4*)(a->in[I_HGAIN] + l * 64 + (lane & 15) * 4);
    const int gw = bid * NWAVES + wave, NGW = G * NWAVES;
    for (int r = gw; r < nrows; r += NGW) {
        const f32x4 o = *(const GAS f32x4*)(O0 + (size_t)r * 256 + 4 * lane) + *(const GAS f32x4*)(O1 + (size_t)r * 256 + 4 * lane);
        float ss = (o.x * o.x + o.y * o.y) + (o.z * o.z + o.w * o.w);
        ss += sx<1>(ss); ss += sx<2>(ss); ss += sx<4>(ss); ss += sx<8>(ss);
        const float rstd = __builtin_amdgcn_rsqf(ss * (1.0f / 64.0f) + EPS);
        const v2u gw2 = *(const GAS v2u*)(PROJ + (size_t)r * INW + COL_HG + 4 * lane);
        const float g0 = bflo(gw2.x), g1 = bfhi(gw2.x), g2 = bflo(gw2.y), g3 = bfhi(gw2.y);
        v2u w; w.x = pk2(o.x * rstd * gn.x * silu1(g0), o.y * rstd * gn.y * silu1(g1)); w.y = pk2(o.z * rstd * gn.z * silu1(g2), o.w * rstd * gn.w * silu1(g3));
        *(GAS v2u*)(MIX + (size_t)r * DM + MIX_HG + 4 * lane) = w;
    }
}
__device__ __forceinline__ void moe_gather(KA a, LAS unsigned char* lds, int tid, int lane, int wave, int G, int bid) {
    LAS int* sb = (LAS int*)lds;
    const unsigned* cnt = (const unsigned*)(a->ws + WS_CTL) + CW_MOECNT;
    int* mi = (int*)(a->ws + WS_VEC) + VO_MOE;
    if (tid < 8) sb[16 + tid] = (int)__hip_atomic_load(cnt + 64 * tid, RLX_AGENT);
    __syncthreads();
    if (tid == 0) { int b = 0;
#pragma unroll
        for (int e = 0; e < 8; ++e) { sb[e] = b; b += ((sb[16 + e] + 255) >> 8) << 8; }
        sb[8] = b; }
    __syncthreads();
    if (bid == 0) {
        if (tid == 0) mi[0] = sb[8] >> 8;
        if (tid < 8) mi[160 + tid] = sb[tid + 1] >> 8;
        for (int t = tid; t < (sb[8] >> 8); t += NTHR) { int e = 0;
#pragma unroll
            for (int j = 1; j < 8; ++j) e += (t >= (sb[j] >> 8)) ? 1 : 0;
            mi[16 + t] = e; } }
    unsigned char* AS = (unsigned char*)(a->ws + WS_AS);
    const int* tokinfo = (const int*)(a->ws + WS_TOK); int* tokslot = (int*)(a->ws + WS_TOK) + S_LAT * 8;
    const int gw = bid * NWAVES + wave, NGW = G * NWAVES;
    int kq = 0;
    for (int t = gw; t < S_LAT; t += NGW, ++kq) {
        const int* ti = tokinfo + (size_t)t * 8;
        const int e1 = ti[0], e2 = ti[1], r1 = ti[2], r2 = ti[3];
        const int s1 = sb[e1] + r1, s2 = sb[e2] + r2;
        const v4u x0 = ((const LAS v4u*)(lds + ROUTE_ROWS_OFF + wave * 8192 + kq * 1024))[lane];
        ((GAS v4u*)(AS + (size_t)s1 * DM))[lane] = x0; ((GAS v4u*)(AS + (size_t)s2 * DM))[lane] = x0;
        if (lane == 0) { int* ts = tokslot + (size_t)t * 4; ts[0] = s1; ts[1] = s2; ts[2] = ti[4]; ts[3] = ti[5]; }
    }
    { const f32x4 z4 = {0.f, 0.f, 0.f, 0.f}; for (int i = bid * NTHR + tid; i < 8 * 256 * DM / 4; i += G * NTHR) ((GAS f32x4*)(a->ws + WS_YF))[i] = z4; }
    for (int e = 0; e < 8; ++e) { const int c = sb[16 + e], pe = (c + 255) & ~255, b = sb[e];
        for (int j = c + gw; j < pe; j += NGW) { const v4u z = {0u, 0u, 0u, 0u}; ((GAS v4u*)(AS + (size_t)(b + j) * DM))[lane] = z; } }
}
__device__ __forceinline__ void moe_combine(KA a, int lane, int wave, int G, int bid) {
    const float* gf = (const float*)(a->ws + WS_VEC) + VO_MOD + (1 * 2 + 0) * 6144 + 5 * 1024;
    const bf16* Y = (const bf16*)(a->ws + WS_Y); const int* tokslot = (const int*)(a->ws + WS_TOK) + S_LAT * 8;
    const int gw = bid * NWAVES + wave, NGW = G * NWAVES;
    for (int t = gw; t < S_LAT; t += NGW) {
        const int* ts = tokslot + (size_t)t * 4; const int s1 = ts[0], s2 = ts[1]; const float w1 = __builtin_bit_cast(float, ts[2]), w2 = __builtin_bit_cast(float, ts[3]);
        GAS f32x4* xr = (GAS f32x4*)(a->out + (size_t)t * DM) + lane; const GAS v2u* xbr = (const GAS v2u*)((const bf16*)(a->ws + WS_XB) + (size_t)t * DM) + lane;
        const float* YF = (const float*)(a->ws + WS_YF);
#pragma unroll
        for (int j = 0; j < 4; ++j) { const f32x4 g = *(const f32x4*)(gf + 4 * lane + 256 * j); const v2u xt = xbr[64 * j]; f32x4 x = (f32x4){bflo(xt.x), bfhi(xt.x), bflo(xt.y), bfhi(xt.y)}; f32x4 p, q;
            if (s1 < 32768) { const v2u t = ((const GAS v2u*)(Y + (size_t)s1 * DM) + lane)[64 * j]; p = (f32x4){bflo(t.x), bfhi(t.x), bflo(t.y), bfhi(t.y)}; } else p = ((const GAS f32x4*)(YF + (size_t)(s1 - 32768) * DM) + lane)[64 * j];
            if (s2 < 32768) { const v2u t = ((const GAS v2u*)(Y + (size_t)s2 * DM) + lane)[64 * j]; q = (f32x4){bflo(t.x), bfhi(t.x), bflo(t.y), bfhi(t.y)}; } else q = ((const GAS f32x4*)(YF + (size_t)(s2 - 32768) * DM) + lane)[64 * j];
            x = x + g * (p * w1 + q * w2);
            __builtin_nontemporal_store(x, (f32x4*)(xr + 64 * j)); }
    }
}

#define IN(k) (lo <= (k) && (k) < hi)
#define GRIDBAR() do { XcdBarrier b2_; b2_.bar = (unsigned*)(KARGS()->ws + WS_CTL) + CW_BAR; b2_.x = xb_xcc_id(); b2_.st = (volatile LAS unsigned*)(lds + MISC_OFF) + 8; xcd_barrier(b2_, wv0 * 64 + (int)__builtin_amdgcn_mbcnt_hi(~0u, __builtin_amdgcn_mbcnt_lo(~0u, 0u))); } while (0)
#define SEAM(k) do { if (IN(k) && IN((k) + 1)) GRIDBAR(); } while (0)
#define PHASE_ROOTS() KA a = KARGS(); unsigned char* ws = a->ws; const float* vec = (const float*)(ws + WS_VEC); (void)vec; int bid = blockIdx.x, G = gridDim.x; asm volatile("" : "+s"(bid), "+s"(G)); int tid = wv0 * 64 + (int)__builtin_amdgcn_mbcnt_hi(~0u, __builtin_amdgcn_mbcnt_lo(~0u, 0u)); asm volatile("" : "+v"(tid)); const int lane = tid & 63, wave = __builtin_amdgcn_readfirstlane(tid >> 6); (void)lane; (void)wave

template <int l> __device__ __forceinline__ void layer_body(const int lo, const int hi, LAS unsigned char* lds, const int wv0) {
        const int pb = 1 + 11 * l;
        if (IN(pb + 0)) { PHASE_ROOTS(); phase_norm(a, l, 0, R_ALL, (bf16*)(ws + WS_H), lane, wave, G, bid); SEAM(pb + 0); }
        if (IN(pb + 1)) {
            PHASE_ROOTS();
            pg8::Gemm g{(const pg8::bf16_t*)(ws + WS_H), (const pg8::bf16_t*)(ws + WS_WIN) + (size_t)l * INW * DM, R_ALL, INW, DM, 0, DM};
            pg8::StaticOrder S; S.init(R_ALL, INW, G, bid);
            pg8::EpiBf16<0> E{(pg8::bf16_t*)(ws + WS_PROJ), INW, nullptr, 0, 0, 1.f};
            pg8::gemm_phase<pg8::EpiBf16<0>, pg8::StaticOrder, true, true>(lds, g, S, E, tid);
            moe_conv_range(a, l == 0 ? MOE_SL0 : MOE_SL2, l == 0 ? MOE_SL1 : MOE_SL3, 650 - 2 * 256, lds, lane, wave, G, bid);
            SEAM(pb + 1);
        }
        if (IN(pb + 2)) {
            PHASE_ROOTS();
            qk_prep(a, l, (G - 1 - bid) * NTHR + tid, G * NTHR);
            for (int it = ((bid + G - 80) % G) * NWAVES + wave; it < 520; it += G * NWAVES) vt_item(a, it, lane);
            for (int it = bid; it < 1040; it += G) hgrn_stepA(a, l, it >> 2, it & 3, lds, lane, wave);
            { __syncthreads(); moe_conv_range(a, l == 0 ? MOE_SL3 : MOE_SL7, l == 0 ? MOE_SL4 : MOE_DEFER, 1040 - 4 * 256, lds, lane, wave, G, bid); }
            SEAM(pb + 2);
        }
        if (IN(pb + 3)) {
            PHASE_ROOTS();
            if (bid < 64) hgrn_stepB(a, bid, tid);
            {
                const int nu = (l == 0) ? 260 : 256, ng = (l == 0) ? 520 : 512;
                unsigned* qctr = (unsigned*)(ws + WS_CTL) + CW_QUEUE + 64 * l;
                volatile LAS unsigned* qslot = (volatile LAS unsigned*)(lds + MISC_OFF) + 16;
                for (;;) {
                    __syncthreads();
                    if (tid == 0) qslot[0] = __hip_atomic_fetch_add(qctr, 1u, RLX_AGENT);
                    __syncthreads();
                    const int it = __builtin_amdgcn_readfirstlane((int)qslot[0]);
                    if (it >= nu + ng) break;
                    if (it < nu) attn_unit(a, l, it, lds, tid, lane, wave);
                    else gmlp_unit_mma(a, l, (it - nu) >> 2, (it - nu) & 3, lds, tid, lane, wave);
                }
            }
            SEAM(pb + 3);
        }
        if (IN(pb + 4)) {
            PHASE_ROOTS();
            const int nit = (l == 0) ? 1040 : 1024;
            for (int it = bid; it < nit; it += G) hgrn_stepC(a, l, it >> 2, it & 3, lds, tid, lane, wave);
            if (l == 0) { __syncthreads(); moe_conv_range(a, MOE_SL4, MOE_SL5, 1040 - 4 * 256, lds, lane, wave, G, bid); }
            SEAM(pb + 4);
        }
        if (IN(pb + 5)) {
            PHASE_ROOTS();
            const float* modl = vec + VO_MOD + (l * 2 + 0) * 6144; const float* modc = vec + VO_MOD + (l * 2 + 1) * 6144;
            const int M = S_LAT;
            pg8::Gemm g{(const pg8::bf16_t*)(ws + WS_MIX), (const pg8::bf16_t*)(ws + WS_WOUT) + (size_t)l * DM * DM, M, DM, DM, 0, DM};
            pg8::StaticOrder S; S.init(M, DM, G, bid);
            if (l == 0) { pg8::EpiResidB<false> E{a->in[I_X], (pg8::bf16_t*)(ws + WS_XB), modl + 2048, DM};
                pg8::gemm_phase<pg8::EpiResidB<false>, pg8::StaticOrder, true, true>(lds, g, S, E, tid); }
            else { pg8::EpiResidB<true> E{ws + WS_XB, (pg8::bf16_t*)(ws + WS_XB), modl + 2048, DM};
                pg8::gemm_phase<pg8::EpiResidB<true>, pg8::StaticOrder, true, true>(lds, g, S, E, tid); }
            if (l == 0) {
                pg8::Gemm g2{(const pg8::bf16_t*)(ws + WS_MIX), (const pg8::bf16_t*)(ws + WS_WOUT), R_ALL, DM, 256, 0, DM};
                pg8::SplitKOrder S2{S_LAT / 256, 4, 4, 256, 16, bid, nullptr};
                pg8::EpiPart E2{(float*)(ws + WS_PART1), modc + 2048, S_LAT / 256, 256, DM};
                pg8::gemm_phase<pg8::EpiPart, pg8::SplitKOrder, false, true>(lds, g2, S2, E2, tid);
                moe_conv_range(a, MOE_SL5, MOE_SL6, 16, lds, lane, wave, G, bid);
            }
            SEAM(pb + 5);
        }
        if (l == 0) {
            if (IN(pb + 6)) { PHASE_ROOTS(); phase_norm(a, l, 1, R_ALL, (bf16*)(ws + WS_H), lane, wave, G, bid); SEAM(pb + 6); }
            if (IN(pb + 7)) {
                PHASE_ROOTS();
                pg8::Gemm g{(const pg8::bf16_t*)(ws + WS_H), (const pg8::bf16_t*)(ws + WS_WGU), R_ALL, 2 * FFN, DM, 0, DM};
                pg8::StaticOrder S; S.init(R_ALL, 2 * FFN, G, bid);
                pg8::EpiSwiGLU E{(pg8::bf16_t*)(ws + WS_HID), FFN, 1.0f};
                pg8::gemm_phase<pg8::EpiSwiGLU, pg8::StaticOrder, true, true>(lds, g, S, E, tid);
                moe_conv_range(a, MOE_SL1, MOE_SL2, 1430 - 5 * 256, lds, lane, wave, G, bid);
                SEAM(pb + 7);
            }
            if (IN(pb + 8)) {
                PHASE_ROOTS();
                const float* modl = vec + VO_MOD + (l * 2 + 0) * 6144; const float* modc = vec + VO_MOD + (l * 2 + 1) * 6144;
                pg8::Gemm g{(const pg8::bf16_t*)(ws + WS_HID), (const pg8::bf16_t*)(ws + WS_WD), S_LAT, DM, FFN, 0, FFN};
                pg8::StaticOrder S; S.init(S_LAT, DM, G, bid);
                pg8::EpiResidB<true> E{ws + WS_XB, (pg8::bf16_t*)(ws + WS_XB), modl + 5120, DM};
                pg8::gemm_phase<pg8::EpiResidB<true>, pg8::StaticOrder, true, true>(lds, g, S, E, tid);
                {
                    pg8::Gemm g2{(const pg8::bf16_t*)(ws + WS_HID), (const pg8::bf16_t*)(ws + WS_WD), R_ALL, DM, 256, 0, FFN};
                    pg8::SplitKOrder S2{S_LAT / 256, 4, 11, 256, 44, bid, nullptr};
                    pg8::EpiPart E2{(float*)(ws + WS_PART2), modc + 5120, S_LAT / 256, 256, DM};
                    pg8::gemm_phase<pg8::EpiPart, pg8::SplitKOrder, false, true>(lds, g2, S2, E2, tid);
                    moe_conv_range(a, MOE_SL6, MOE_SL7, 44, lds, lane, wave, G, bid);
                }
                if (IN(pb + 8) && IN(pb + 11)) GRIDBAR();
            }
        } else {
            if (IN(pb + 6)) { PHASE_ROOTS(); phase_norm_route(a, lds, tid, lane, wave, G, bid); SEAM(pb + 6); }
            if (IN(pb + 7)) { PHASE_ROOTS(); moe_gather(a, lds, tid, lane, wave, G, bid); SEAM(pb + 7); }
            if (IN(pb + 8)) {
                PHASE_ROOTS();
                const int* mi = (const int*)(ws + WS_VEC) + VO_MOE; const int nt = __builtin_amdgcn_readfirstlane(mi[0]);
                pg8::Gemm g{(const pg8::bf16_t*)(ws + WS_AS), (const pg8::bf16_t*)(ws + WS_MGU), nt * 256, 2 * EXD, DM / 2, (size_t)2 * EXD * DM, DM / 2};
                pg8::MoeOrder S; S.init(nt * 256, 2 * EXD, G, bid); S.load_bases(mi + 160);
                pg8::EpiSwiGLU8 E{(unsigned char*)(ws + WS_HIDM), EXD, 1.0f / (F8_WSCALE * F8_ASCALE), F8_HSCALE};
                pg8::gemm_phase<pg8::EpiSwiGLU8, pg8::MoeOrder, true, true, true>(lds, g, S, E, tid);
                SEAM(pb + 8);
            }
            if (IN(pb + 9)) {
                PHASE_ROOTS();
                const int* mi = (const int*)(ws + WS_VEC) + VO_MOE; const int nt = __builtin_amdgcn_readfirstlane(mi[0]); const int nm = nt < 128 ? nt : 128;
                pg8::Gemm g{(const pg8::bf16_t*)(ws + WS_HIDM), (const pg8::bf16_t*)(ws + WS_MD), nm * 256, DM, EXD / 2, (size_t)DM * EXD, EXD / 2};
                pg8::MoeOrder S; S.init(nm * 256, DM, G, bid); S.load_bases(mi + 160);
                pg8::EpiScaleBf16 E{(pg8::bf16_t*)(ws + WS_Y), DM, 1.0f / (F8_WSCALE * F8_HSCALE)};
                pg8::gemm_phase<pg8::EpiScaleBf16, pg8::MoeOrder, true, true, true>(lds, g, S, E, tid);
                if (nt > 128) {
                    pg8::Gemm g2{(const pg8::bf16_t*)(ws + WS_HIDM), (const pg8::bf16_t*)(ws + WS_MD), nt * 256, DM, 256, (size_t)DM * EXD, EXD / 2};
                    pg8::SplitKOrder S2{128, 4, 7, 256, (nt - 128) * 28, bid, mi + 16};
                    pg8::EpiAtomic E2{(float*)(ws + WS_YF), nullptr, 128, DM, 1.0f / (F8_WSCALE * F8_HSCALE)};
                    pg8::gemm_phase<pg8::EpiAtomic, pg8::SplitKOrder, false, true, true>(lds, g2, S2, E2, tid);
                }
                SEAM(pb + 9);
            }
            if (IN(pb + 10)) { PHASE_ROOTS(); moe_combine(a, lane, wave, G, bid); }
        }
    }
__global__ void __launch_bounds__(NTHR, 2) fwd_kernel(Args a_unused) {
    extern __shared__ __attribute__((aligned(16))) unsigned char lds_raw[];
    LAS unsigned char* lds = (LAS unsigned char*)lds_raw;
    const int tid0 = threadIdx.x;
    const int wv0 = __builtin_amdgcn_readfirstlane(tid0 >> 6);
    for (int u = tid0; u < (LDS_BYTES - LDSCTL_OFF) / 4; u += NTHR) ((LAS unsigned*)(lds + LDSCTL_OFF))[u] = 0u;
    __syncthreads();
    const int lo = KARGS()->ph_lo, hi = KARGS()->ph_hi;
    const bool fusedl = (hi - lo) > 1;
    if (fusedl) (void)xcd_barrier_post((unsigned*)(KARGS()->ws + WS_CTL) + CW_BAR, (volatile LAS unsigned*)(lds + MISC_OFF) + 8);
    if (IN(0)) { PHASE_ROOTS(); p0_prologue(a, lds, tid, lane, wave, G, bid); SEAM(0); }

    layer_body<0>(lo, hi, lds, wv0);
    layer_body<1>(lo, hi, lds, wv0);
}

extern "C" void kernel_launch(void* const* d_in, const int* in_sizes, int n_in, void* d_out, int out_size, void* d_ws, size_t ws_size, hipStream_t stream) {
    static int grid = 0;
    if (grid == 0) {
        if (n_in != 23 || in_sizes[0] != S_LAT * DM || out_size != S_LAT * DM || ws_size < WS_END) { fprintf(stderr, "kernel_launch: unexpected shapes / workspace (n_in %d, ws %zu, need %zu)\n", n_in, ws_size, (size_t)WS_END); grid = -1; return; }
        int dev = 0, cus = 0;
        if (hipGetDevice(&dev) != hipSuccess || hipDeviceGetAttribute(&cus, hipDeviceAttributeMultiprocessorCount, dev) != hipSuccess) { grid = -1; return; }
        if (hipFuncSetAttribute((const void*)fwd_kernel, hipFuncAttributeMaxDynamicSharedMemorySize, LDS_BYTES) != hipSuccess) { grid = -1; return; }
        int per_cu = 0;
        (void)hipOccupancyMaxActiveBlocksPerMultiprocessor(&per_cu, (const void*)fwd_kernel, NTHR, LDS_BYTES);
        (void)hipGetLastError();
        if (cus * NWAVES * 8 < S_LAT) { fprintf(stderr, "kernel_launch: needs at least %d compute units\n", S_LAT / (NWAVES * 8)); grid = -1; return; }
        grid = cus;
    }
    if (grid < 0) return;
    if (hipMemsetAsync((char*)d_ws + WS_CTL, 0, CTL_ZERO_BYTES, stream) != hipSuccess) return;
    Args a{};
    for (int i = 0; i < 23; ++i) a.in[i] = (const float*)d_in[i];
    a.out = (float*)d_out; a.ws = (unsigned char*)d_ws;
#if ONE_LAUNCH
    a.ph_lo = 0; a.ph_hi = NPH;
    hipLaunchKernelGGL(fwd_kernel, dim3(grid), dim3(NTHR), LDS_BYTES, stream, a);
#else
    for (int p = 0; p < NPH; ++p) {
        if (p == 10 || p == 11) continue;
        a.ph_lo = p; a.ph_hi = p + 1;
        hipLaunchKernelGGL(fwd_kernel, dim3(grid), dim3(NTHR), LDS_BYTES, stream, a);
    }
#endif
}
```

```cpp
#include <hip/hip_runtime.h>
#include <cstdio>
#include <cstdint>
#include <cmath>
#ifndef ONE_LAUNCH
#define ONE_LAUNCH 1
#endif
namespace pg8 {
#define PG8_LAS __attribute__((address_space(3)))
typedef unsigned short bf16_t;
typedef short bf16x8 __attribute__((ext_vector_type(8)));
typedef float f32x4 __attribute__((ext_vector_type(4)));
typedef unsigned u32x4 __attribute__((ext_vector_type(4)));
constexpr int BM = 256, BK = 64, HALF = 128, HTB = HALF * BK * 2  , STAGE_BYTES = 8 * HTB, NXCD = 8, WGM = 8;

__host__ __device__ __forceinline__ int lds_byte(int r, int c) { const int st = (r >> 4) * 2 + (c >> 5), rr = r & 15, cc = c & 31, ob = rr * 64 + cc * 2; return st * 1024 + (ob ^ (((ob >> 9) & 1) << 5)); }
__host__ __device__ __forceinline__ void stage_rc(int b, int& R, int& C) { const int st = b / 1024, sb = b % 1024, swz = sb ^ (((sb >> 9) & 1) << 5); R = (st >> 1) * 16 + swz / 64; C = (st & 1) * 32 + (swz % 64) / 2; }
__host__ __device__ __forceinline__ int perm32(int rho) { const int n = rho >> 4, i = rho & 15; return 8 * (i >> 2) + 4 * n + (i & 3); }

struct Unit { int pm, pn, eb, ko; };
struct Gemm { const bf16_t* A; const bf16_t* Bt; int M, N, K; size_t bstride; int ld; };

struct StaticOrder {
    int nM, nN, nwg, G, c;
    __host__ __device__ void init(int M, int N, int G_, int c_) { nM = M / BM; nN = N / BM; nwg = nM * nN; G = G_; c = c_; }
    __host__ __device__ bool next(int i, Unit& u) const {
        const long L = (long)i * G + c; if (L >= nwg) return false;
        int wgid = (int)L; { const int q = nwg / NXCD, r = nwg % NXCD, xcd = wgid % NXCD, off = wgid / NXCD; wgid = (xcd < r ? xcd * (q + 1) : r * (q + 1) + (xcd - r) * q) + off; }
        const int nig = WGM * nN, gid = wgid / nig, fm = gid * WGM, gsz = (nM - fm) < WGM ? (nM - fm) : WGM;
        u.pm = fm + ((wgid % nig) % gsz); u.pn = (wgid % nig) / gsz; u.eb = 0; u.ko = 0; return true;
    }
    __device__ __forceinline__ void a_ready(const Unit&) const {}
    __device__ __forceinline__ void done(const Unit&) const {}
};

__device__ __forceinline__ unsigned cvt_pk_bf16(float lo, float hi) { unsigned r; asm volatile("v_cvt_pk_bf16_f32 %0, %1, %2" : "=v"(r) : "v"(lo), "v"(hi)); return r; }
typedef float f32x2 __attribute__((ext_vector_type(2)));
__device__ __forceinline__ f32x2 gelu_pk(f32x2 v) {
    const f32x2 av = __builtin_elementwise_abs(v), d = av * 0.2316418882f + 1.0f;
    f32x2 t; t.x = __builtin_amdgcn_rcpf(d.x); t.y = __builtin_amdgcn_rcpf(d.y);
    f32x2 q = t * 0.5307027145f + (-0.7265760135f); q = q * t + 0.7107068705f; q = q * t + (-0.142248368f); q = q * t + 0.127414796f; q = q * t;
    const f32x2 s = (v * v) * (-0.72134752044f);
    f32x2 e; e.x = __builtin_amdgcn_exp2f(s.x); e.y = __builtin_amdgcn_exp2f(s.y);
    const f32x2 m = v * (q * e), r = v - m;
    f32x2 o; o.x = v.x < 0.f ? m.x : r.x; o.y = v.y < 0.f ? m.y : r.y; return o;
}

template <int ACT  > struct EpiBf16 {
    static constexpr bool PERM = true, AFTER_DRAIN = false; static_assert(ACT == 0 || ACT == 1, "EpiBf16: ACT is 0 (none) or 1 (gelu_pk)");
    bf16_t* O; int ldc; const float* bias; int split_cols; size_t split_stride; float scale0;
    __device__ __forceinline__ void operator()(const f32x4 (&acc)[2][2][4][2], const Unit& u, int wr, int wc, int fr, int fq) const {
        const int row0 = u.pm * BM + wr * 64 + fr; int colt = u.pn * BM; bf16_t* base = O;
        float sc = 1.f; if (split_cols) { const int t = colt / split_cols; base += (size_t)t * split_stride; colt -= t * split_cols; if (t == 0) sc = scale0; }
        const int col0 = colt + wc * 32 + 8 * fq, bcol0 = u.pn * BM + wc * 32 + 8 * fq;
        f32x4 bv[2][2];
#pragma unroll
        for (int bj = 0; bj < 2; ++bj)
#pragma unroll
            for (int n = 0; n < 2; ++n) bv[bj][n] = bias ? *(const f32x4*)(bias + bcol0 + bj * HALF + 4 * n) : (f32x4){0.f, 0.f, 0.f, 0.f};
#pragma unroll
        for (int ai = 0; ai < 2; ++ai)
#pragma unroll
            for (int m = 0; m < 4; ++m) { bf16_t* rowp = base + (size_t)(row0 + ai * HALF + m * 16) * ldc + col0;
#pragma unroll
                for (int bj = 0; bj < 2; ++bj) { f32x4 v0 = acc[ai][bj][m][0] + bv[bj][0], v1 = acc[ai][bj][m][1] + bv[bj][1];
                    if (ACT == 1) { f32x2 a = gelu_pk((f32x2){v0[0], v0[1]}), b = gelu_pk((f32x2){v0[2], v0[3]}), c = gelu_pk((f32x2){v1[0], v1[1]}), d = gelu_pk((f32x2){v1[2], v1[3]});
                        v0 = (f32x4){a.x, a.y, b.x, b.y}; v1 = (f32x4){c.x, c.y, d.x, d.y}; }
                    v0 = v0 * sc; v1 = v1 * sc; u32x4 w; w.x = cvt_pk_bf16(v0[0], v0[1]); w.y = cvt_pk_bf16(v0[2], v0[3]); w.z = cvt_pk_bf16(v1[0], v1[1]); w.w = cvt_pk_bf16(v1[2], v1[3]);
                    *(u32x4*)(rowp + bj * HALF) = w; } }
    }
};

__device__ __forceinline__ float silu_f(float x) { return x * __builtin_amdgcn_rcpf(1.0f + __builtin_amdgcn_exp2f(-1.4426950408889634f * x)); }
struct EpiResid {
    static constexpr bool PERM = false, AFTER_DRAIN = false;
    const float* base; float* out; const float* gate; const float* cbase; float* cout; const float* cgate; int mlat; int ldc;
    __device__ __forceinline__ void operator()(const f32x4 (&acc)[2][2][4][2], const Unit& u, int wr, int wc, int fr, int fq) const {
        const bool isc = u.pm >= mlat;
        const float* b = isc ? cbase : base; float* o = isc ? cout : out; const float* g = isc ? cgate : gate;
        const int row0 = (isc ? (u.pm - mlat) : u.pm) * BM + wr * 64 + fr, col0 = u.pn * BM + wc * 32 + 4 * fq;
        f32x4 gv[2][2];
#pragma unroll
        for (int bj = 0; bj < 2; ++bj)
#pragma unroll
            for (int n = 0; n < 2; ++n) gv[bj][n] = *(const f32x4*)(g + col0 + bj * HALF + n * 16);
#pragma unroll
        for (int ai = 0; ai < 2; ++ai)
#pragma unroll
            for (int m = 0; m < 4; ++m) { const size_t off = (size_t)(row0 + ai * HALF + m * 16) * ldc + col0;
#pragma unroll
                for (int bj = 0; bj < 2; ++bj)
#pragma unroll
                    for (int n = 0; n < 2; ++n) { const f32x4 bs = *(const f32x4*)(b + off + bj * HALF + n * 16); *(f32x4*)(o + off + bj * HALF + n * 16) = bs + gv[bj][n] * acc[ai][bj][m][n]; }
                if (m & 1) asm volatile("" ::: "memory"); }
    }
};
template <bool BFB> struct EpiResidB {
    static constexpr bool PERM = true, AFTER_DRAIN = false;
    const void* base; bf16_t* out; const float* gate; int ldc;
    __device__ __forceinline__ void operator()(const f32x4 (&acc)[2][2][4][2], const Unit& u, int wr, int wc, int fr, int fq) const {
        const int row0 = u.pm * BM + wr * 64 + fr, col0 = u.pn * BM + wc * 32 + 8 * fq;
        f32x4 gv[2][2];
#pragma unroll
        for (int bj = 0; bj < 2; ++bj)
#pragma unroll
            for (int n = 0; n < 2; ++n) gv[bj][n] = *(const f32x4*)(gate + col0 + bj * HALF + 4 * n);
#pragma unroll
        for (int ai = 0; ai < 2; ++ai)
#pragma unroll
            for (int m = 0; m < 4; ++m) { const size_t off = (size_t)(row0 + ai * HALF + m * 16) * ldc + col0;
#pragma unroll
                for (int bj = 0; bj < 2; ++bj) { f32x4 b0, b1;
                    if constexpr (BFB) { const u32x4 t = *(const u32x4*)((const bf16_t*)base + off + bj * HALF);
                        b0 = (f32x4){__builtin_bit_cast(float, t.x << 16), __builtin_bit_cast(float, t.x & 0xffff0000u), __builtin_bit_cast(float, t.y << 16), __builtin_bit_cast(float, t.y & 0xffff0000u)};
                        b1 = (f32x4){__builtin_bit_cast(float, t.z << 16), __builtin_bit_cast(float, t.z & 0xffff0000u), __builtin_bit_cast(float, t.w << 16), __builtin_bit_cast(float, t.w & 0xffff0000u)}; }
                    else { b0 = *(const f32x4*)((const float*)base + off + bj * HALF); b1 = *(const f32x4*)((const float*)base + off + bj * HALF + 4); }
                    const f32x4 v0 = b0 + gv[bj][0] * acc[ai][bj][m][0], v1 = b1 + gv[bj][1] * acc[ai][bj][m][1];
                    u32x4 w; w.x = cvt_pk_bf16(v0[0], v0[1]); w.y = cvt_pk_bf16(v0[2], v0[3]); w.z = cvt_pk_bf16(v1[0], v1[1]); w.w = cvt_pk_bf16(v1[2], v1[3]);
                    *(u32x4*)(out + off + bj * HALF) = w; }
                if (m & 1) asm volatile("" ::: "memory"); }
    }
};
struct EpiSwiGLU {
    static constexpr bool PERM = true, AFTER_DRAIN = false;
    bf16_t* O; int ldc; float ds;
    __device__ __forceinline__ void operator()(const f32x4 (&acc)[2][2][4][2], const Unit& u, int wr, int wc, int fr, int fq) const {
        const int row0 = u.pm * BM + wr * 64 + fr, col0 = u.pn * HALF + wc * 32 + 8 * fq;
#pragma unroll
        for (int ai = 0; ai < 2; ++ai)
#pragma unroll
            for (int m = 0; m < 4; ++m) { bf16_t* rowp = O + (size_t)(row0 + ai * HALF + m * 16) * ldc + col0;
                const f32x4 g0 = acc[ai][0][m][0] * ds, g1 = acc[ai][0][m][1] * ds, u0 = acc[ai][1][m][0] * ds, u1 = acc[ai][1][m][1] * ds;
                f32x4 h0, h1;
#pragma unroll
                for (int j = 0; j < 4; ++j) { h0[j] = silu_f(g0[j]) * u0[j]; h1[j] = silu_f(g1[j]) * u1[j]; }
                u32x4 w; w.x = cvt_pk_bf16(h0[0], h0[1]); w.y = cvt_pk_bf16(h0[2], h0[3]); w.z = cvt_pk_bf16(h1[0], h1[1]); w.w = cvt_pk_bf16(h1[2], h1[3]);
                *(u32x4*)rowp = w; }
    }
};
struct MoeOrder : StaticOrder {
    int tb[8];
    __device__ __forceinline__ void load_bases(const int* mi) {
#pragma unroll
        for (int e = 0; e < 8; ++e) tb[e] = __builtin_amdgcn_readfirstlane(mi[e]); }
    __device__ __forceinline__ int expert_of(int pm) const { int e = 0;
#pragma unroll
        for (int j = 0; j < 7; ++j) e += (pm >= tb[j]) ? 1 : 0;
        return e; }
    __device__ __forceinline__ bool next(int i, Unit& u) const { if (!StaticOrder::next(i, u)) return false; u.eb = expert_of(u.pm); return true; }
};

struct SplitKOrder {
    int pm0, nN, P, kp, total, c; const int* tile_e;
    __device__ __forceinline__ bool next(int i, Unit& u) const {
        if (i != 0 || c >= total) return false;
        const int p = c % P, t = c / P; u.pn = t % nN; u.pm = pm0 + t / nN; u.ko = p * kp; u.eb = tile_e ? __builtin_amdgcn_readfirstlane(tile_e[u.pm]) : 0; return true; }
    __device__ __forceinline__ void a_ready(const Unit&) const {}
    __device__ __forceinline__ void done(const Unit&) const {}
};
struct EpiPart {
    static constexpr bool PERM = false, AFTER_DRAIN = false;
    float* part; const float* scale; int pm_sub; int kp; int ldc;
    __device__ __forceinline__ void operator()(const f32x4 (&acc)[2][2][4][2], const Unit& u, int wr, int wc, int fr, int fq) const {
        float* o = part + (size_t)(u.ko / kp) * BM * ldc;
        const int row0 = (u.pm - pm_sub) * BM + wr * 64 + fr, col0 = u.pn * BM + wc * 32 + 4 * fq;
        f32x4 gv[2][2];
#pragma unroll
        for (int bj = 0; bj < 2; ++bj)
#pragma unroll
            for (int n = 0; n < 2; ++n) gv[bj][n] = *(const f32x4*)(scale + col0 + bj * HALF + n * 16);
#pragma unroll
        for (int ai = 0; ai < 2; ++ai)
#pragma unroll
            for (int m = 0; m < 4; ++m) { const size_t off = (size_t)(row0 + ai * HALF + m * 16) * ldc + col0;
#pragma unroll
                for (int bj = 0; bj < 2; ++bj)
#pragma unroll
                    for (int n = 0; n < 2; ++n) *(f32x4*)(o + off + bj * HALF + n * 16) = gv[bj][n] * acc[ai][bj][m][n]; }
    }
};
struct EpiAtomic {
    static constexpr bool PERM = false, AFTER_DRAIN = true;
    float* out; const float* scale; int pm_sub; int ldc; float ds;
    __device__ __forceinline__ void fused(f32x4 (&acc)[2][2][4][2], const Unit& u, int wr, int wc, int fr, int fq, PG8_LAS unsigned char* lds, int wid, int lane) const {
        PG8_LAS float* scr = (PG8_LAS float*)(lds + wid * 16384);
        const int rr = lane >> 5, cc = lane & 31;
#pragma unroll
        for (int ai = 0; ai < 2; ++ai)
#pragma unroll
            for (int bj = 0; bj < 2; ++bj) {
#pragma unroll
                for (int m = 0; m < 4; ++m)
#pragma unroll
                    for (int n = 0; n < 2; ++n) *(PG8_LAS f32x4*)(scr + (m * 16 + fr) * 36 + n * 16 + 4 * fq) = acc[ai][bj][m][n];
                asm volatile("s_waitcnt lgkmcnt(0)" ::: "memory");
                const int colg = u.pn * BM + bj * HALF + wc * 32 + cc; const float sc = (scale ? scale[colg] : 1.0f) * ds;
                float* op = out + (size_t)((u.pm - pm_sub) * BM + ai * HALF + wr * 64 + rr) * ldc + colg;
#pragma unroll 8
                for (int i = 0; i < 32; ++i) { const float v = scr[(2 * i + rr) * 36 + cc]; __hip_atomic_fetch_add(op + (size_t)(2 * i) * ldc, v * sc, __ATOMIC_RELAXED, __HIP_MEMORY_SCOPE_AGENT); }
                asm volatile("s_waitcnt lgkmcnt(0)" ::: "memory");
            }
    }
};

typedef int i32x4v __attribute__((ext_vector_type(4))); typedef int i32x8v __attribute__((ext_vector_type(8)));
struct FragB { bf16x8 k[2]; };
struct Frag8 { i32x8v v; };
template <bool F8> struct FragSel { typedef FragB type; };
template <> struct FragSel<true> { typedef Frag8 type; };
__device__ __forceinline__ void ld_frag(FragB& f, const PG8_LAS unsigned char* p) { f.k[0] = *(const PG8_LAS bf16x8*)p; f.k[1] = *(const PG8_LAS bf16x8*)(p + 1024); }
__device__ __forceinline__ void ld_frag(Frag8& f, const PG8_LAS unsigned char* p) { const i32x4v lo = *(const PG8_LAS i32x4v*)p, hi = *(const PG8_LAS i32x4v*)(p + 1024); f.v = __builtin_shufflevector(lo, hi, 0, 1, 2, 3, 4, 5, 6, 7); }
__device__ __forceinline__ f32x4 mma_frag(const FragB& b, const FragB& a, f32x4 c) { c = __builtin_amdgcn_mfma_f32_16x16x32_bf16(b.k[0], a.k[0], c, 0, 0, 0); return __builtin_amdgcn_mfma_f32_16x16x32_bf16(b.k[1], a.k[1], c, 0, 0, 0); }
__device__ __forceinline__ f32x4 mma_frag(const Frag8& b, const Frag8& a, f32x4 c) {
    asm volatile("v_mfma_scale_f32_16x16x128_f8f6f4 %0, %1, %2, %0, %3, %3 op_sel_hi:[0,0,0]" : "+v"(c) : "v"(b.v), "v"(a.v), "v"(0x7f7f7f7f));
    return c;
}

struct EpiSwiGLU8 {
    static constexpr bool PERM = true, AFTER_DRAIN = false;
    unsigned char* O; int ldc; float ds, hs;
    __device__ __forceinline__ void operator()(const f32x4 (&acc)[2][2][4][2], const Unit& u, int wr, int wc, int fr, int fq) const {
        const int row0 = u.pm * BM + wr * 64 + fr, col0 = u.pn * HALF + wc * 32 + 8 * fq;
        const float k1 = -1.4426950408889634f * ds, k2 = ds * ds * hs;
#pragma unroll
        for (int ai = 0; ai < 2; ++ai)
#pragma unroll
            for (int m = 0; m < 4; ++m) { unsigned char* rowp = O + (size_t)(row0 + ai * HALF + m * 16) * ldc + col0;
                const f32x4 g0 = acc[ai][0][m][0], g1 = acc[ai][0][m][1], u0 = acc[ai][1][m][0], u1 = acc[ai][1][m][1];
                float h[8];
#pragma unroll
                for (int j = 0; j < 4; ++j) {
                    h[j] = __builtin_amdgcn_fmed3f((g0[j] * u0[j]) * k2 * __builtin_amdgcn_rcpf(1.0f + __builtin_amdgcn_exp2f(g0[j] * k1)), -448.0f, 448.0f);
                    h[4 + j] = __builtin_amdgcn_fmed3f((g1[j] * u1[j]) * k2 * __builtin_amdgcn_rcpf(1.0f + __builtin_amdgcn_exp2f(g1[j] * k1)), -448.0f, 448.0f); }
                unsigned lo = 0u, hi = 0u;
                lo = __builtin_amdgcn_cvt_pk_fp8_f32(h[0], h[1], lo, false); lo = __builtin_amdgcn_cvt_pk_fp8_f32(h[2], h[3], lo, true);
                hi = __builtin_amdgcn_cvt_pk_fp8_f32(h[4], h[5], hi, false); hi = __builtin_amdgcn_cvt_pk_fp8_f32(h[6], h[7], hi, true);
                typedef unsigned u32x2 __attribute__((ext_vector_type(2)));
                *(u32x2*)rowp = (u32x2){lo, hi}; }
    }
};
struct EpiScaleBf16 {
    static constexpr bool PERM = true, AFTER_DRAIN = false;
    bf16_t* O; int ldc; float ds;
    __device__ __forceinline__ void operator()(const f32x4 (&acc)[2][2][4][2], const Unit& u, int wr, int wc, int fr, int fq) const {
        const int row0 = u.pm * BM + wr * 64 + fr, col0 = u.pn * BM + wc * 32 + 8 * fq;
#pragma unroll
        for (int ai = 0; ai < 2; ++ai)
#pragma unroll
            for (int m = 0; m < 4; ++m) { bf16_t* rowp = O + (size_t)(row0 + ai * HALF + m * 16) * ldc + col0;
#pragma unroll
                for (int bj = 0; bj < 2; ++bj) { const f32x4 v0 = acc[ai][bj][m][0] * ds, v1 = acc[ai][bj][m][1] * ds;
                    u32x4 w; w.x = cvt_pk_bf16(v0[0], v0[1]); w.y = cvt_pk_bf16(v0[2], v0[3]); w.z = cvt_pk_bf16(v1[0], v1[1]); w.w = cvt_pk_bf16(v1[2], v1[3]);
                    *(u32x4*)(rowp + bj * HALF) = w; } }
    }
};

template <class Epi, class Sched, bool ALIGN_EPI = false, bool SP2 = false, bool F8 = false>
__device__ __forceinline__ void gemm_phase(PG8_LAS unsigned char* lds, const Gemm g, const Sched& S, const Epi& E, int tid_in) {
    int tid_ = tid_in; asm volatile("" : "+v"(tid_));
    const int tid = tid_, wid = __builtin_amdgcn_readfirstlane(tid >> 6), lane = tid & 63, wr = wid >> 2, wc = wid & 3, fr = lane & 15, fq = lane >> 4;
    const int K = g.K, nt = K / BK, ld = g.ld;
    unsigned voffA[2], voffB[2];
#pragma unroll
    for (int i = 0; i < 2; ++i) { int R, C; stage_rc(tid * 16 + i * 8192, R, C); const int Rb = Epi::PERM ? ((R & ~31) + perm32(R & 31)) : R;
        voffA[i] = (unsigned)(R * ld + C) * 2u; voffB[i] = (unsigned)(Rb * ld + C) * 2u; }
    const size_t kstep = (size_t)(BK * 2);
    const size_t hstep = (size_t)HALF * ld * 2;
    const size_t tstep = 2 * hstep;
    const unsigned ldsw = (unsigned)wid * 1024u;
    const int aoff = lds_byte(wr * 64 + fr, fq * 8), boff = lds_byte(wc * 32 + fr, fq * 8);
#define PG8_SA(b, h) (((b) * 2 + (h)) * HTB)
#define PG8_SB(b, h) ((4 + (b) * 2 + (h)) * HTB)
#define PG8_STAGE(bufoff, gbase, voff) do { _Pragma("unroll") for (int _i = 0; _i < 2; ++_i) \
        __builtin_amdgcn_global_load_lds((const unsigned*)((const char*)(gbase) + (voff)[_i]), (PG8_LAS unsigned*)(lds + (bufoff) + ldsw + _i * 8192), 16, 0, 0); } while (0)
#define PG8_LDA(dst, b, h) do { _Pragma("unroll") for (int m = 0; m < 4; ++m) ld_frag(dst[m], lds + PG8_SA(b, h) + aoff + m * 2048); } while (0)
#define PG8_LDB(dst, b, h) do { _Pragma("unroll") for (int n = 0; n < 2; ++n) ld_frag(dst[n], lds + PG8_SB(b, h) + boff + n * 2048); } while (0)
#define PG8_MMA(ai, bj, At, Bt) do { __builtin_amdgcn_s_setprio(1); _Pragma("unroll") for (int m = 0; m < 4; ++m) _Pragma("unroll") for (int n = 0; n < 2; ++n) \
        acc[ai][bj][m][n] = mma_frag(Bt[n], At[m], acc[ai][bj][m][n]); __builtin_amdgcn_s_setprio(0); } while (0)
#define PG8_WAIT_V(n) asm volatile("s_waitcnt vmcnt(" #n ")" ::: "memory")
#define PG8_WAIT_L(n) asm volatile("s_waitcnt lgkmcnt(" #n ")" ::: "memory")
#define PG8_BAR __builtin_amdgcn_s_barrier()
#define PG8_SCHED __builtin_amdgcn_sched_barrier(0)
    Unit cur, nxt; int ui = 0;
    if (!S.next(0, cur)) return;
    float zacc = 0.f; asm volatile("" : "+v"(zacc));
    f32x4 acc[2][2][4][2];
#pragma unroll
    for (int a = 0; a < 2; ++a)
#pragma unroll
        for (int b = 0; b < 2; ++b)
#pragma unroll
            for (int m = 0; m < 4; ++m)
#pragma unroll
                for (int n = 0; n < 2; ++n) acc[a][b][m][n] = (f32x4){zacc, zacc, zacc, zacc};
    typedef typename FragSel<F8>::type Frag;
    Frag At[4], B0[2], B1[2];
    const char* cA = (const char*)g.A + (size_t)cur.pm * tstep + (size_t)cur.ko * 2; const char* cB = (const char*)g.Bt + (size_t)cur.eb * g.bstride + (size_t)cur.pn * tstep + (size_t)cur.ko * 2;
    S.a_ready(cur);
    if constexpr (SP2) {
        PG8_STAGE(PG8_SB(0, 0), cB, voffB); PG8_STAGE(PG8_SB(0, 1), cB + hstep, voffB); PG8_STAGE(PG8_SA(0, 0), cA, voffA); PG8_STAGE(PG8_SA(0, 1), cA + hstep, voffA);
        if (wr == 1) PG8_BAR;
        PG8_WAIT_V(2); PG8_BAR;
        PG8_STAGE(PG8_SB(1, 0), cB + kstep, voffB); PG8_STAGE(PG8_SA(1, 0), cA + kstep, voffA); PG8_STAGE(PG8_SB(1, 1), cB + hstep + kstep, voffB);
        PG8_WAIT_V(6); PG8_BAR;
    } else {
        PG8_STAGE(PG8_SB(0, 0), cB, voffB); PG8_STAGE(PG8_SA(0, 0), cA, voffA); PG8_STAGE(PG8_SB(0, 1), cB + hstep, voffB); PG8_STAGE(PG8_SA(0, 1), cA + hstep, voffA);
        if (wr == 1) PG8_BAR;
        PG8_WAIT_V(4); PG8_BAR;
        PG8_STAGE(PG8_SB(1, 0), cB + kstep, voffB); PG8_STAGE(PG8_SA(1, 0), cA + kstep, voffA); PG8_STAGE(PG8_SB(1, 1), cB + hstep + kstep, voffB);
        PG8_WAIT_V(6); PG8_BAR;
    }
    for (;;) {
        const bool has_next = S.next(ui + 1, nxt);
        const char* nA = has_next ? (const char*)g.A + (size_t)nxt.pm * tstep + (size_t)nxt.ko * 2 : cA; const char* nB = has_next ? (const char*)g.Bt + (size_t)nxt.eb * g.bstride + (size_t)nxt.pn * tstep + (size_t)nxt.ko * 2 : cB;
        for (int t = 0; t < nt; t += 2) {
            const bool last = (t == nt - 2);
            const char* a1 = cA + (size_t)(t + 1) * kstep;
            const char* a2 = last ? nA : cA + (size_t)(t + 2) * kstep; const char* b2 = last ? nB : cB + (size_t)(t + 2) * kstep;
            const char* a3 = a2 + kstep; const char* b3 = b2 + kstep;
            if (last && has_next) S.a_ready(nxt);
            if constexpr (SP2) {
            PG8_LDB(B0, 0, 0); PG8_LDB(B1, 0, 1); PG8_SCHED; PG8_LDA(At, 0, 0); PG8_STAGE(PG8_SA(1, 1), a1 + hstep, voffA);
            PG8_WAIT_V(8); PG8_WAIT_L(0); PG8_BAR; PG8_MMA(0, 0, At, B0); PG8_MMA(0, 1, At, B1); PG8_BAR; PG8_SCHED;
            PG8_LDA(At, 0, 1); PG8_STAGE(PG8_SB(0, 0), b2, voffB); PG8_STAGE(PG8_SB(0, 1), b2 + hstep, voffB); PG8_STAGE(PG8_SA(0, 0), a2, voffA);
            PG8_WAIT_V(8); PG8_WAIT_L(0); PG8_BAR; PG8_MMA(1, 0, At, B0); PG8_MMA(1, 1, At, B1); PG8_BAR; PG8_SCHED;
            PG8_LDB(B0, 1, 0); PG8_LDB(B1, 1, 1); PG8_SCHED; PG8_LDA(At, 1, 0); PG8_STAGE(PG8_SA(0, 1), a2 + hstep, voffA);
            PG8_WAIT_V(8); PG8_WAIT_L(0); PG8_BAR; PG8_MMA(0, 0, At, B0); PG8_MMA(0, 1, At, B1); PG8_BAR; PG8_SCHED;
            PG8_LDA(At, 1, 1); PG8_STAGE(PG8_SB(1, 0), b3, voffB); PG8_STAGE(PG8_SB(1, 1), b3 + hstep, voffB); PG8_STAGE(PG8_SA(1, 0), a3, voffA);
            PG8_WAIT_V(8); PG8_WAIT_L(0); PG8_BAR; PG8_MMA(1, 0, At, B0); PG8_MMA(1, 1, At, B1); PG8_BAR; PG8_SCHED;
            } else {
            PG8_LDB(B0, 0, 0); PG8_SCHED; PG8_LDA(At, 0, 0); PG8_STAGE(PG8_SA(1, 1), a1 + hstep, voffA);
            PG8_WAIT_L(8); PG8_BAR; PG8_WAIT_L(0); PG8_MMA(0, 0, At, B0); PG8_BAR; PG8_SCHED;
            PG8_LDB(B1, 0, 1); PG8_STAGE(PG8_SB(0, 0), b2, voffB);
            PG8_BAR; PG8_WAIT_L(0); PG8_MMA(0, 1, At, B1); PG8_BAR;
            PG8_LDA(At, 0, 1); PG8_STAGE(PG8_SA(0, 0), a2, voffA);
            PG8_BAR; PG8_WAIT_L(0); PG8_MMA(1, 0, At, B0); PG8_BAR; PG8_SCHED;
            PG8_STAGE(PG8_SB(0, 1), b2 + hstep, voffB);
            PG8_WAIT_V(6); PG8_BAR; PG8_MMA(1, 1, At, B1); PG8_BAR;
            PG8_LDB(B0, 1, 0); PG8_SCHED; PG8_LDA(At, 1, 0); PG8_STAGE(PG8_SA(0, 1), a2 + hstep, voffA);
            PG8_WAIT_L(8); PG8_BAR; PG8_WAIT_L(0); PG8_MMA(0, 0, At, B0); PG8_BAR; PG8_SCHED;
            PG8_LDB(B1, 1, 1); PG8_STAGE(PG8_SB(1, 0), b3, voffB);
            PG8_BAR; PG8_WAIT_L(0); PG8_MMA(0, 1, At, B1); PG8_BAR;
            PG8_LDA(At, 1, 1); PG8_STAGE(PG8_SA(1, 0), a3, voffA);
            PG8_BAR; PG8_WAIT_L(0); PG8_MMA(1, 0, At, B0); PG8_BAR; PG8_SCHED;
            PG8_STAGE(PG8_SB(1, 1), b3 + hstep, voffB);
            PG8_WAIT_V(6); PG8_BAR; PG8_MMA(1, 1, At, B1); PG8_BAR;
            }
        }
        if constexpr (ALIGN_EPI) { if (wr == 0) PG8_BAR; }
        if constexpr (F8) {
            asm volatile("s_nop 15\n\ts_nop 15" : "+v"(acc[1][1][0][0]), "+v"(acc[1][1][0][1]), "+v"(acc[1][1][1][0]), "+v"(acc[1][1][1][1]), "+v"(acc[1][1][2][0]), "+v"(acc[1][1][2][1]), "+v"(acc[1][1][3][0]), "+v"(acc[1][1][3][1])); }
        if constexpr (!Epi::AFTER_DRAIN) { E(acc, cur, wr, wc, fr, fq); S.done(cur); }
        if (!has_next) break;
#pragma unroll
        for (int a = 0; a < 2; ++a)
#pragma unroll
            for (int b = 0; b < 2; ++b)
#pragma unroll
                for (int m = 0; m < 4; ++m)
#pragma unroll
                    for (int n = 0; n < 2; ++n) acc[a][b][m][n] = (f32x4){zacc, zacc, zacc, zacc};
        cur = nxt; cA = nA; cB = nB; ++ui;
        if constexpr (ALIGN_EPI) { if (wr == 1) PG8_BAR; }
    }
    PG8_WAIT_V(0);
    if constexpr (!ALIGN_EPI) { if (wr == 0) PG8_BAR; }
    PG8_BAR;
    if constexpr (Epi::AFTER_DRAIN) { E.fused(acc, cur, wr, wc, fr, fq, lds, wid, lane); S.done(cur); }
#undef PG8_SA
#undef PG8_SB
#undef PG8_STAGE
#undef PG8_LDA
#undef PG8_LDB
#undef PG8_MMA
#undef PG8_WAIT_V
#undef PG8_WAIT_L
#undef PG8_BAR
#undef PG8_SCHED
}
}


constexpr int S_LAT = 16384, C_CTX = 256, R_ALL = S_LAT + C_CTX, DM = 1024;
constexpr int INW = 2560, FFN = 2816, EXD = 3584, NEXP = 8;
constexpr int COL_AQ = 0, COL_AK = 512, COL_AV = 640, COL_HQ = 768, COL_HFF = 1024, COL_HFB = 1280, COL_HI = 1536, COL_HG = 1792, COL_GU = 2048, COL_GV = 2304;
constexpr int MIX_AT = 0, MIX_HG = 512, MIX_GM = 768;
constexpr int MOE_MAXROWS = 34816;
constexpr float EPS = 1e-6f;
constexpr int NWAVES = 8, NTHR = 512;
constexpr int NPH = 23;

constexpr size_t MiB = 1u << 20;
constexpr size_t WS_CTL = 0, CTL_ZERO_BYTES = 1 * MiB;
constexpr size_t WS_VEC = 1 * MiB;
constexpr size_t WS_TOK = 2 * MiB;
constexpr size_t WS_WIN = 3 * MiB;
constexpr size_t WS_WOUT = 13 * MiB;
constexpr size_t WS_WGU = 17 * MiB;
constexpr size_t WS_WD = 28 * MiB;
constexpr size_t WS_MGU = 34 * MiB;
constexpr size_t WS_MD = 146 * MiB;
constexpr size_t WS_H = 202 * MiB;
constexpr size_t WS_PROJ = 235 * MiB;
constexpr size_t WS_MIX = 317 * MiB;
constexpr size_t WS_HGO = 350 * MiB;
constexpr size_t WS_CTXR = 383 * MiB;
constexpr size_t WS_HLT = WS_HGO;
constexpr size_t WS_HSP = 384 * MiB;
constexpr size_t WS_HDG = 402 * MiB;
constexpr size_t WS_VT = 403 * MiB;
constexpr size_t WS_HID = WS_PROJ;
constexpr size_t WS_AS = 202 * MiB;
constexpr size_t WS_HIDM = 270 * MiB;
constexpr size_t WS_H2B = 440 * MiB;
constexpr size_t WS_YF = WS_WIN;
constexpr size_t WS_Y = WS_MGU;
constexpr size_t WS_XB = 104 * MiB;
constexpr size_t WS_PART1 = 176 * MiB;
constexpr size_t WS_PART2 = 180 * MiB;
constexpr size_t WS_END = 508 * MiB;
static_assert(WS_HID + (size_t)R_ALL * FFN * 2 <= WS_HGO && WS_AS + (size_t)MOE_MAXROWS * DM * 2 <= WS_HIDM && WS_HIDM + (size_t)MOE_MAXROWS * EXD * 2 <= WS_END, "ws map");
static_assert(WS_PART1 >= WS_MD + (size_t)8 * DM * EXD && WS_PART1 + (size_t)4 * 256 * DM * 4 <= WS_PART2 && WS_PART2 + (size_t)11 * 256 * DM * 4 <= WS_H, "ws map 4");
static_assert(WS_XB >= WS_Y + (size_t)MOE_MAXROWS * DM * 2 && WS_XB >= WS_MGU + (size_t)8 * 2 * EXD * DM && WS_XB + (size_t)S_LAT * DM * 2 <= WS_MD, "ws map 3");
static_assert(WS_H2B >= WS_HIDM && WS_H2B + (size_t)S_LAT * DM * 2 <= WS_END && WS_H + (size_t)R_ALL * DM * 2 <= WS_PROJ && WS_PROJ + (size_t)R_ALL * INW * 2 <= WS_MIX && WS_MIX + (size_t)R_ALL * DM * 2 <= WS_HGO && WS_HGO + (size_t)2 * R_ALL * 256 * 4 <= WS_CTXR, "ws map 2");
constexpr int VO_MOD = 0;
constexpr int VO_ROPE = 32768;
constexpr int VO_MOE = 65536;
constexpr int CW_BAR = 4096;
constexpr int CW_QUEUE = 2048;
constexpr int CW_MOECNT = 1024;

constexpr int RING_BYTES = 131072;
constexpr int LDSCTL_OFF = 159744, MISC_OFF = LDSCTL_OFF + 320;
constexpr int LDS_BYTES = 163840;

#define GAS __attribute__((address_space(1)))
#define LAS __attribute__((address_space(3)))
typedef unsigned short bf16;
typedef unsigned v4u __attribute__((ext_vector_type(4)));
typedef unsigned v2u __attribute__((ext_vector_type(2)));
typedef float f32x4 __attribute__((ext_vector_type(4)));
typedef GAS unsigned gu32;
#define RLX_AGENT __ATOMIC_RELAXED, __HIP_MEMORY_SCOPE_AGENT
#define LDS_WAIT() asm volatile("s_waitcnt lgkmcnt(0)" ::: "memory")
typedef float f32x2_t __attribute__((ext_vector_type(2))); typedef __bf16 bf16x2_t __attribute__((ext_vector_type(2)));
__device__ __forceinline__ unsigned pk2(float lo, float hi) { const f32x2_t v = {lo, hi}; const bf16x2_t b = __builtin_convertvector(v, bf16x2_t); return __builtin_bit_cast(unsigned, b); }
__device__ __forceinline__ unsigned f2bf(float f) { return pk2(f, 0.f) & 0xffffu; }
__device__ __forceinline__ float bflo(unsigned w) { return __builtin_bit_cast(float, w << 16); }
__device__ __forceinline__ float bfhi(unsigned w) { return __builtin_bit_cast(float, w & 0xffff0000u); }
__device__ __forceinline__ float sigm1(float x) { return __builtin_amdgcn_rcpf(1.0f + __builtin_amdgcn_exp2f(-1.4426950408889634f * x)); }
__device__ __forceinline__ float silu1(float x) { return x * sigm1(x); }
__device__ __forceinline__ float gelu1(float x) { return 0.5f * x * (1.0f + erff(x * 0.70710678118654752f)); }
template <int X> __device__ __forceinline__ float sx(float v) { return __shfl_xor(v, X); }
__device__ __forceinline__ float sx32_add(float v) { return v + __shfl_xor(v, 32); }
__device__ __forceinline__ float sx32_max(float v) { return fmaxf(v, __shfl_xor(v, 32)); }
__device__ __forceinline__ float wave_sum(float v) { v += sx<1>(v); v += sx<2>(v); v += sx<4>(v); v += sx<8>(v); v += sx<16>(v); return sx32_add(v); }
__device__ __forceinline__ void unpack8(const v4u w, float* f) { f[0] = bflo(w.x); f[1] = bfhi(w.x); f[2] = bflo(w.y); f[3] = bfhi(w.y); f[4] = bflo(w.z); f[5] = bfhi(w.z); f[6] = bflo(w.w); f[7] = bfhi(w.w); }


__device__ __forceinline__ float clamp448(float x) { return fminf(fmaxf(x, -448.0f), 448.0f); }
__device__ __forceinline__ unsigned pk4_fp8(float a, float b, float c, float d) {
    unsigned w = 0u; w = __builtin_amdgcn_cvt_pk_fp8_f32(clamp448(a), clamp448(b), w, false); w = __builtin_amdgcn_cvt_pk_fp8_f32(clamp448(c), clamp448(d), w, true); return w; }
constexpr float F8_WSCALE = 128.0f;
constexpr float F8_ASCALE = 16.0f;
constexpr float F8_HSCALE = 8.0f;
#define XB_TMO      128
#define XB_XCNT(j)  (256  + 64 * (j))
#define XB_XSUB(j)  (1280 + 64 * (j))
#define XB_XGEN(j)  (2304 + 64 * (j))
#define XB_TOP      3328
#define XB_TOPGEN   3392
#define XCD_BAR_WORDS 3456
#define XB_SPIN_CAP (1u << 18)

__device__ __forceinline__ unsigned xb_ld(unsigned* p)              { return __hip_atomic_load(p, __ATOMIC_RELAXED, __HIP_MEMORY_SCOPE_AGENT); }
__device__ __forceinline__ unsigned xb_add(unsigned* p, unsigned v) { return __hip_atomic_fetch_add(p, v, __ATOMIC_RELAXED, __HIP_MEMORY_SCOPE_AGENT); }
__device__ __forceinline__ unsigned xb_xcc_id() { return (unsigned)__builtin_amdgcn_s_getreg((3 << 11) | 20) & 0xFu; }
#define XB_SPIN(cond, bar) do { unsigned _sp = 0; while (cond) { __builtin_amdgcn_s_sleep(1); \
    if ((++_sp & 255u) == 0u) { if (xb_ld(&(bar)[XB_TMO])) break; if (_sp > XB_SPIN_CAP) { atomicAdd(&(bar)[XB_TMO], 1u); break; } } } } while (0)

struct XcdBarrier {
    unsigned* bar; unsigned x;
    volatile LAS unsigned* st;
};

__device__ __forceinline__ XcdBarrier xcd_barrier_post(unsigned* bar, volatile LAS unsigned* st) {
    XcdBarrier b; b.bar = bar; b.x = xb_xcc_id(); b.st = st;
    if (threadIdx.x == 0) (void)xb_add(&bar[XB_XCNT(b.x)], 1u);
    return b;
}
__device__ __forceinline__ void xcd_barrier_complete(unsigned* bar, unsigned x, unsigned& nloc, unsigned& nx) {
    const unsigned G = gridDim.x * gridDim.y * gridDim.z;
    unsigned sum, cnt, mine, sp = 0u;
    for (;;) {
        sum = 0u; cnt = 0u; mine = 0u;
#pragma unroll
        for (unsigned j = 0; j < 16; ++j) { const unsigned c = xb_ld(&bar[XB_XCNT(j)]); sum += c; cnt += (c > 0u) ? 1u : 0u; mine = (j == x) ? c : mine; }
        if (sum == G) break;
        __builtin_amdgcn_s_sleep(1);
        if ((++sp & 255u) == 0u) { if (xb_ld(&bar[XB_TMO])) break; if (sp > XB_SPIN_CAP) { atomicAdd(&bar[XB_TMO], 1u); break; } }
    }
    nloc = mine > 0u ? mine : 1u; nx = cnt > 0u ? cnt : 1u;
}

__device__ __forceinline__ void xcd_barrier(const XcdBarrier& b, const int tid_in) {
    asm volatile("s_waitcnt vmcnt(0)" ::: "memory");
    __syncthreads();
    if (tid_in == 0) {
        unsigned* bar = b.bar;
        __builtin_amdgcn_s_waitcnt(0);
        unsigned nloc = b.st[0], nx = b.st[1];
        if (nloc == 0u) { xcd_barrier_complete(bar, b.x, nloc, nx); b.st[0] = nloc; b.st[1] = nx; }
        const unsigned old = xb_add(&bar[XB_XSUB(b.x)], 1u);
        const unsigned gen = old / nloc;
        if (old + 1u == (gen + 1u) * nloc) {
            __builtin_amdgcn_fence(__ATOMIC_RELEASE, "agent");
            asm volatile("s_waitcnt vmcnt(0)" ::: "memory");
            const unsigned og = xb_add(&bar[XB_TOP], 1u);
            const unsigned tg = og / nx;
            if (og + 1u == (tg + 1u) * nx) xb_add(&bar[XB_TOPGEN], 1u);
            else XB_SPIN(xb_ld(&bar[XB_TOPGEN]) == tg, bar);
            __builtin_amdgcn_fence(__ATOMIC_ACQUIRE, "agent");
            xb_add(&bar[XB_XGEN(b.x)], 1u);
            asm volatile("s_waitcnt vmcnt(0)" ::: "memory");
        } else {
            XB_SPIN(xb_ld(&bar[XB_XGEN(b.x)]) == gen, bar);
            __builtin_amdgcn_fence(__ATOMIC_ACQUIRE, "agent");
            asm volatile("s_waitcnt vmcnt(0)" ::: "memory");
        }
    }
    __syncthreads();
}


struct Args { const float* in[23]; float* out; unsigned char* ws; int ph_lo, ph_hi; };
typedef const __attribute__((address_space(4))) Args* KA;
#define KARGS() ({ KA p_ = (KA)__builtin_amdgcn_kernarg_segment_ptr(); asm volatile("" : "+s"(p_)); p_; })
enum { I_X = 0, I_C, I_CTX, I_CCTX, I_WADA, I_BADA, I_WIN, I_WOUT, I_QG, I_KG, I_SINK, I_HLB, I_HGAIN, I_GWS, I_GBS, I_GNG, I_FG, I_FU, I_FD, I_ROUTER, I_MG, I_MU, I_MDN };

__device__ __forceinline__ void transpose_item(const float* W, int K, int N, bf16* WT, int mode, LAS float* scr, int item, int lane) {
    const int nblk = N / 32, kb = item / nblk, nb = item % nblk, k0 = 64 * kb, n0 = 32 * nb;
    const float* wb = W + (size_t)k0 * N + n0; const int loff = (lane >> 5) * N + (lane & 31);
    float wv[32];
#pragma unroll
    for (int i = 0; i < 32; ++i) wv[i] = __builtin_nontemporal_load(wb + (size_t)(2 * i) * N + loff);
#pragma unroll
    for (int i = 0; i < 32; ++i) scr[(2 * i + (lane >> 5)) * 33 + (lane & 31)] = wv[i];
    LDS_WAIT(); asm volatile("" ::: "memory");
    const int c = lane & 7;
#pragma unroll
    for (int j = 0; j < 4; ++j) { const int n = (lane >> 3) + 8 * j; const LAS float* s = scr + (8 * c) * 33 + n;
        v4u o; o.x = pk2(s[0 * 33], s[1 * 33]); o.y = pk2(s[2 * 33], s[3 * 33]); o.z = pk2(s[4 * 33], s[5 * 33]); o.w = pk2(s[6 * 33], s[7 * 33]);
        const int ng = n0 + n; const int drow = (mode == 0) ? ng : (ng + 128 * (ng / 128) + (mode == 2 ? 128 : 0));
        *(GAS v4u*)(WT + (size_t)drow * K + k0 + 8 * c) = o; }
    LDS_WAIT(); asm volatile("" ::: "memory");
}
__device__ __forceinline__ void transpose_item8(const float* W, int K, int N, unsigned char* WT, int mode, LAS float* scr, int item, int lane) {
    const int nblk = N / 32, kb = item / nblk, nb = item % nblk, k0 = 64 * kb, n0 = 32 * nb;
    const float* wb = W + (size_t)k0 * N + n0; const int loff = (lane >> 5) * N + (lane & 31);
    float wv[32];
#pragma unroll
    for (int i = 0; i < 32; ++i) wv[i] = __builtin_nontemporal_load(wb + (size_t)(2 * i) * N + loff);
#pragma unroll
    for (int i = 0; i < 32; ++i) scr[(2 * i + (lane >> 5)) * 33 + (lane & 31)] = wv[i];
    LDS_WAIT(); asm volatile("" ::: "memory");
    const int c = lane & 7;
#pragma unroll
    for (int j = 0; j < 4; ++j) { const int n = (lane >> 3) + 8 * j; const LAS float* s = scr + (8 * c) * 33 + n;
        v2u o; o.x = pk4_fp8(s[0 * 33] * F8_WSCALE, s[1 * 33] * F8_WSCALE, s[2 * 33] * F8_WSCALE, s[3 * 33] * F8_WSCALE); o.y = pk4_fp8(s[4 * 33] * F8_WSCALE, s[5 * 33] * F8_WSCALE, s[6 * 33] * F8_WSCALE, s[7 * 33] * F8_WSCALE);
        const int ng = n0 + n; const int drow = (mode == 0) ? ng : (ng + 128 * (ng / 128) + (mode == 2 ? 128 : 0));
        *(GAS v2u*)(WT + (size_t)drow * K + k0 + 8 * c) = o; }
    LDS_WAIT(); asm volatile("" ::: "memory");
}
constexpr int MOE_ITEMS = 24 * 16 * 112;
constexpr int MOE_SL0 = 0, MOE_SL1 = 5376, MOE_SL2 = 10752, MOE_SL3 = 16128, MOE_SL4 = 19200, MOE_SL5 = 25344, MOE_SL6 = 29184, MOE_SL7 = 32576, MOE_DEFER = 34496;
__device__ __forceinline__ void moe_conv_item(KA a, int it, LAS float* scr, int lane) {
    constexpr int I_M = 16 * 112;
    unsigned char* ws = a->ws;
    const int idx = it / I_M, r = it % I_M;
    if (idx < 8) transpose_item8(a->in[I_MG] + (size_t)idx * DM * EXD, DM, EXD, (unsigned char*)(ws + WS_MGU) + (size_t)idx * 2 * EXD * DM, 1, scr, r, lane);
    else if (idx < 16) transpose_item8(a->in[I_MU] + (size_t)(idx - 8) * DM * EXD, DM, EXD, (unsigned char*)(ws + WS_MGU) + (size_t)(idx - 8) * 2 * EXD * DM, 2, scr, r, lane);
    else transpose_item8(a->in[I_MDN] + (size_t)(idx - 16) * EXD * DM, EXD, DM, (unsigned char*)(ws + WS_MD) + (size_t)(idx - 16) * DM * EXD, 0, scr, r, lane);
}
__device__ __forceinline__ void moe_conv_range(KA a, int lo, int hi, int first, LAS unsigned char* lds, int lane, int wave, int G, int bid) {
    if (bid < first) return;
    LAS float* scr = (LAS float*)(lds + wave * 8704);
    const int nw = (G - first) * NWAVES, w = (bid - first) * NWAVES + wave;
    for (int i = lo + w; i < hi; i += nw) moe_conv_item(a, i, scr, lane);
}
__device__ __forceinline__ void p0_prologue(KA a, LAS unsigned char* lds, int tid, int lane, int wave, int G, int bid) {
    unsigned char* ws = a->ws;
    LAS float* scr = (LAS float*)(lds + wave * 8704);
    const int gw = bid * NWAVES + wave, NGW = G * NWAVES;
    constexpr int I_IN = 16 * 80, I_OUT = 16 * 32, I_F = 16 * 88, I_FDN = 44 * 32, I_M = 16 * 112;
    constexpr int NIT = 2 * I_IN + 2 * I_OUT + 2 * I_F + I_FDN + 24 * I_M;
    for (int it0 = gw; it0 < NIT; it0 += NGW) {
        int it = it0;
        if (it < 2 * I_IN) { const int l = it / I_IN, r = it % I_IN; transpose_item(a->in[I_WIN] + (size_t)l * DM * INW, DM, INW, (bf16*)(ws + WS_WIN) + (size_t)l * INW * DM, 0, scr, r, lane); continue; } it -= 2 * I_IN;
        if (it < 2 * I_OUT) { const int l = it / I_OUT, r = it % I_OUT; transpose_item(a->in[I_WOUT] + (size_t)l * DM * DM, DM, DM, (bf16*)(ws + WS_WOUT) + (size_t)l * DM * DM, 0, scr, r, lane); continue; } it -= 2 * I_OUT;
        if (it < I_F) { transpose_item(a->in[I_FG], DM, FFN, (bf16*)(ws + WS_WGU), 1, scr, it, lane); continue; } it -= I_F;
        if (it < I_F) { transpose_item(a->in[I_FU], DM, FFN, (bf16*)(ws + WS_WGU), 2, scr, it, lane); continue; } it -= I_F;
        if (it < I_FDN) { transpose_item(a->in[I_FD], FFN, DM, (bf16*)(ws + WS_WD), 0, scr, it, lane); continue; } it -= I_FDN;
        if (it >= MOE_DEFER) moe_conv_item(a, it, scr, lane);
    }
    LAS float* sil = (LAS float*)(lds + 69632);
    LAS float* part = (LAS float*)(lds + 69632 + 8192);
    float* vec = (float*)(ws + WS_VEC);
    if (bid < 192) {
        for (int i = tid; i < 2048; i += NTHR) { const float v = (i < 1024) ? a->in[I_C][i] : a->in[I_CCTX][i - 1024]; sil[i] = silu1(v); }
        __syncthreads();
        for (int item = bid; item < 192; item += G) {
            const int l = item / 96, cb = item % 96, col = cb * 64 + lane;
            const float* w = a->in[I_WADA] + (size_t)l * DM * 6144 + col;
            float a0 = 0.f, a1 = 0.f;
#pragma unroll 1
            for (int k0 = wave * 128; k0 < wave * 128 + 128; k0 += 32) { float wv[32];
#pragma unroll
                for (int j = 0; j < 32; ++j) wv[j] = __builtin_nontemporal_load(&w[(size_t)(k0 + j) * 6144]);
#pragma unroll
                for (int j = 0; j < 32; ++j) { a0 += sil[k0 + j] * wv[j]; a1 += sil[1024 + k0 + j] * wv[j]; } }
            part[(wave * 2 + 0) * 64 + lane] = a0; part[(wave * 2 + 1) * 64 + lane] = a1;
            __syncthreads();
            if (wave == 0) { float s0 = 0.f, s1 = 0.f;
#pragma unroll
                for (int w8 = 0; w8 < 8; ++w8) { s0 += part[(w8 * 2 + 0) * 64 + lane]; s1 += part[(w8 * 2 + 1) * 64 + lane]; }
                const float b = a->in[I_BADA][l * 6144 + col];
                vec[VO_MOD + (l * 2 + 0) * 6144 + col] = s0 + b; vec[VO_MOD + (l * 2 + 1) * 6144 + col] = s1 + b; }
            __syncthreads();
        }
    }
    if (bid == G - 1) {
        for (int idx = tid; idx < 5120; idx += NTHR) {
            const int isc = idx >= 4096, j = isc ? idx - 4096 : idx, pos = j / 16, i = j % 16;
            const float inv = exp2f(-(float)i * 0.83048202372184059f);
            const float ang = (float)pos * inv;
            double r = (double)ang * 0.15915494309189535; r -= floor(r);
            const float rf = (float)r;
            const float cs = __builtin_amdgcn_cosf(rf), sn = __builtin_amdgcn_sinf(rf);
            float* t = vec + VO_ROPE + (isc ? 8192 : 0);
            const int n = isc ? 1024 : 4096;
            t[j] = cs; t[n + j] = sn;
        }
    }
}

template <bool STORE = true, bool BFX = false> __device__ __forceinline__ void norm_row(const void* xrow, const float* sc, const float* sh, bf16* orow, int lane, f32x4 (&h)[4]) {
    f32x4 v[4]; float s = 0.f;
    if constexpr (BFX) { const GAS v2u* xr = (const GAS v2u*)xrow + lane;
#pragma unroll
        for (int j = 0; j < 4; ++j) { const v2u t = xr[64 * j]; v[j] = (f32x4){bflo(t.x), bfhi(t.x), bflo(t.y), bfhi(t.y)}; } }
    else { const GAS f32x4* xr = (const GAS f32x4*)xrow + lane;
#pragma unroll
        for (int j = 0; j < 4; ++j) v[j] = xr[64 * j]; }
#pragma unroll
    for (int j = 0; j < 4; ++j) s += (v[j].x * v[j].x + v[j].y * v[j].y) + (v[j].z * v[j].z + v[j].w * v[j].w);
    const float rstd = __builtin_amdgcn_rsqf(wave_sum(s) * (1.0f / DM) + EPS);
    GAS v2u* o8 = (GAS v2u*)orow + lane;
#pragma unroll
    for (int j = 0; j < 4; ++j) { const f32x4 scv = *(const f32x4*)(sc + 4 * lane + 256 * j), shv = *(const f32x4*)(sh + 4 * lane + 256 * j);
        h[j] = v[j] * rstd * (scv + 1.0f) + shv;
        if constexpr (STORE) { v2u w; w.x = pk2(h[j].x, h[j].y); w.y = pk2(h[j].z, h[j].w); o8[64 * j] = w; } }
}
__device__ __forceinline__ void phase_norm(KA a, int l, int which, int nrows, bf16* H, int lane, int wave, int G, int bid) {
    const float* vec = (const float*)(a->ws + WS_VEC);
    const bool bfx = !(l == 0 && which == 0);
    const float* xl = a->in[I_X]; const bf16* xb = (const bf16*)(a->ws + WS_XB);
    const float* xc = (l == 0) ? a->in[I_CTX] : (const float*)(a->ws + WS_CTXR);
    const int nlat = nrows < S_LAT ? nrows : S_LAT;
    const float* ml = vec + VO_MOD + (l * 2 + 0) * 6144 + which * 3072;
    const float* mc = vec + VO_MOD + (l * 2 + 1) * 6144 + which * 3072;
    const int gw = bid * NWAVES + wave, NGW = G * NWAVES;
    f32x4 scl[4], shl[4], v[4];
#pragma unroll
    for (int j = 0; j < 4; ++j) { scl[j] = *(const f32x4*)(ml + 1024 + 4 * lane + 256 * j) + 1.0f; shl[j] = *(const f32x4*)(ml + 4 * lane + 256 * j); }
    if (gw < nlat) {
        if (bfx) { const GAS v2u* xr = (const GAS v2u*)(xb + (size_t)gw * DM) + lane;
#pragma unroll
            for (int j = 0; j < 4; ++j) { const v2u t = xr[64 * j]; v[j] = (f32x4){bflo(t.x), bfhi(t.x), bflo(t.y), bfhi(t.y)}; } }
        else { const GAS f32x4* xr = (const GAS f32x4*)(xl + (size_t)gw * DM) + lane;
#pragma unroll
            for (int j = 0; j < 4; ++j) v[j] = xr[64 * j]; } }
    for (int r = gw; r < nlat; r += NGW) {
        const int rn = r + NGW; f32x4 vn[4];
        if (rn < nlat) {
            if (bfx) { const GAS v2u* xr = (const GAS v2u*)(xb + (size_t)rn * DM) + lane;
#pragma unroll
                for (int j = 0; j < 4; ++j) { const v2u t = xr[64 * j]; vn[j] = (f32x4){bflo(t.x), bfhi(t.x), bflo(t.y), bfhi(t.y)}; } }
            else { const GAS f32x4* xr = (const GAS f32x4*)(xl + (size_t)rn * DM) + lane;
#pragma unroll
                for (int j = 0; j < 4; ++j) vn[j] = xr[64 * j]; } }
        float s = 0.f;
#pragma unroll
        for (int j = 0; j < 4; ++j) s += (v[j].x * v[j].x + v[j].y * v[j].y) + (v[j].z * v[j].z + v[j].w * v[j].w);
        const float rstd = __builtin_amdgcn_rsqf(wave_sum(s) * (1.0f / DM) + EPS);
        GAS v2u* o8 = (GAS v2u*)(H + (size_t)r * DM) + lane;
#pragma unroll
        for (int j = 0; j < 4; ++j) { const f32x4 h = v[j] * rstd * scl[j] + shl[j]; v2u w; w.x = pk2(h.x, h.y); w.y = pk2(h.z, h.w); o8[64 * j] = w; }
#pragma unroll
        for (int j = 0; j < 4; ++j) v[j] = vn[j];
    }
    const int npart = (l == 0 && which == 0) ? 0 : (l == 0 ? 4 : 11);
    const float* part = (const float*)(a->ws + (l == 0 ? WS_PART1 : WS_PART2));
    for (int r = S_LAT + (NGW - 1 - gw); r < nrows; r += NGW) {
        const int cr = r - S_LAT; f32x4 x[4];
        { const GAS f32x4* xr = (const GAS f32x4*)(xc + (size_t)cr * DM) + lane;
#pragma unroll
          for (int j = 0; j < 4; ++j) x[j] = xr[64 * j]; }
        for (int p = 0; p < npart; ++p) { const GAS f32x4* pr = (const GAS f32x4*)(part + ((size_t)p * 256 + cr) * DM) + lane;
#pragma unroll
            for (int j = 0; j < 4; ++j) x[j] = x[j] + pr[64 * j]; }
        if (npart && l == 0) { GAS f32x4* cw = (GAS f32x4*)((float*)(a->ws + WS_CTXR) + (size_t)cr * DM) + lane;
#pragma unroll
            for (int j = 0; j < 4; ++j) cw[64 * j] = x[j]; }
        float s = 0.f;
#pragma unroll
        for (int j = 0; j < 4; ++j) s += (x[j].x * x[j].x + x[j].y * x[j].y) + (x[j].z * x[j].z + x[j].w * x[j].w);
        const float rstd = __builtin_amdgcn_rsqf(wave_sum(s) * (1.0f / DM) + EPS);
        GAS v2u* o8 = (GAS v2u*)(H + (size_t)r * DM) + lane;
#pragma unroll
        for (int j = 0; j < 4; ++j) { const f32x4 scv = *(const f32x4*)(mc + 1024 + 4 * lane + 256 * j), shv = *(const f32x4*)(mc + 4 * lane + 256 * j);
            const f32x4 h = x[j] * rstd * (scv + 1.0f) + shv; v2u w; w.x = pk2(h.x, h.y); w.y = pk2(h.z, h.w); o8[64 * j] = w; }
    }
}
constexpr int ROUTE_ROWS_OFF = 36864;
__device__ __forceinline__ void phase_norm_route(KA a, LAS unsigned char* lds, int tid, int lane, int wave, int G, int bid) {
    const int l = 1;
    const float* vec = (const float*)(a->ws + WS_VEC);
    const float* ml = vec + VO_MOD + (l * 2 + 0) * 6144 + 3072;
    LAS float* rt = (LAS float*)lds;
    volatile LAS unsigned* lcnt = (volatile LAS unsigned*)(lds + 32768);
    for (int i = tid; i < 8192; i += NTHR) rt[i] = a->in[I_ROUTER][i];
    if (tid < 16) lcnt[tid] = 0u;
    __syncthreads();
    int* tokinfo = (int*)(a->ws + WS_TOK);
    unsigned* cnt = (unsigned*)(a->ws + WS_CTL) + CW_MOECNT;
    const int gw = bid * NWAVES + wave, NGW = G * NWAVES;
    unsigned keep = 0u, pk0 = 0u; int itn = 0;
    for (int r = gw; r < S_LAT; r += NGW) {
        f32x4 h[4];
        norm_row<false, true>((const bf16*)(a->ws + WS_XB) + (size_t)r * DM, ml + 1024, ml, nullptr, lane, h);
#pragma unroll
        for (int j = 0; j < 4; ++j) ((LAS unsigned*)(lds + ROUTE_ROWS_OFF + wave * 8192 + itn * 1024))[lane + 64 * j] = pk4_fp8(h[j].x * F8_ASCALE, h[j].y * F8_ASCALE, h[j].z * F8_ASCALE, h[j].w * F8_ASCALE);
        float lg[8];
#pragma unroll
        for (int e = 0; e < 8; ++e) lg[e] = 0.f;
#pragma unroll
        for (int j = 0; j < 4; ++j)
#pragma unroll
            for (int i = 0; i < 4; ++i) { const int d = 4 * lane + 256 * j + i; const f32x4 r0 = *(const LAS f32x4*)(rt + d * 8), r1 = *(const LAS f32x4*)(rt + d * 8 + 4); const float hv = h[j][i];
                lg[0] += hv * r0.x; lg[1] += hv * r0.y; lg[2] += hv * r0.z; lg[3] += hv * r0.w; lg[4] += hv * r1.x; lg[5] += hv * r1.y; lg[6] += hv * r1.z; lg[7] += hv * r1.w; }
#pragma unroll
        for (int e = 0; e < 8; ++e) lg[e] = wave_sum(lg[e]);
        int i1 = 0; float v1 = lg[0];
#pragma unroll
        for (int e = 1; e < 8; ++e) if (lg[e] > v1) { v1 = lg[e]; i1 = e; }
        int i2 = -1; float v2 = -INFINITY;
#pragma unroll
        for (int e = 0; e < 8; ++e) if (e != i1 && lg[e] > v2) { v2 = lg[e]; i2 = e; }
        const float w1 = 1.0f / (1.0f + __expf(v2 - v1)), w2 = 1.0f - w1;
        if (lane == 0) {
            const unsigned r1 = __hip_atomic_fetch_add((LAS unsigned*)lcnt + i1, 1u, __ATOMIC_RELAXED, __HIP_MEMORY_SCOPE_WORKGROUP), r2 = __hip_atomic_fetch_add((LAS unsigned*)lcnt + i2, 1u, __ATOMIC_RELAXED, __HIP_MEMORY_SCOPE_WORKGROUP);
            int* ti = tokinfo + (size_t)r * 8;
            ti[0] = i1; ti[1] = i2; ti[4] = __builtin_bit_cast(int, w1); ti[5] = __builtin_bit_cast(int, w2);
            pk0 = (unsigned)i1 | ((unsigned)i2 << 3) | (r1 << 6) | (r2 << 19);
        }
        const unsigned pku = (unsigned)__builtin_amdgcn_readfirstlane((int)pk0);
        if (lane == itn) keep = pku;
        ++itn;
    }
    __syncthreads();
    if (tid < 8) lcnt[8 + tid] = __hip_atomic_fetch_add(cnt + 64 * tid, lcnt[tid], RLX_AGENT);
    __syncthreads();
    { const int r = gw + lane * NGW; if (lane < itn && r < S_LAT) { int* ti = tokinfo + (size_t)r * 8; const unsigned e1 = keep & 7u, e2 = (keep >> 3) & 7u; ti[2] = (int)(((keep >> 6) & 0x1fffu) + lcnt[8 + e1]); ti[3] = (int)((keep >> 19) + lcnt[8 + e2]); } }
}

__device__ __forceinline__ void qk_prep(KA a, int l, int first_thread, int nthreads) {
    bf16* PROJ = (bf16*)(a->ws + WS_PROJ);
    const float* rope = (const float*)(a->ws + WS_VEC) + VO_ROPE;
    for (int i = first_thread; i < R_ALL * 10; i += nthreads) {
        const int row = i / 10, hh = i % 10; const bool isq = hh < 8;
        bf16* p = PROJ + (size_t)row * INW + (isq ? hh * 64 : COL_AK + (hh - 8) * 64);
        const float* gain = (isq ? a->in[I_QG] : a->in[I_KG]) + l * 64;
        float x[64]; float ss = 0.f;
#pragma unroll
        for (int c = 0; c < 8; ++c) { const v4u w = *(const GAS v4u*)(p + 8 * c); unpack8(w, x + 8 * c); }
#pragma unroll
        for (int d = 0; d < 64; ++d) ss += x[d] * x[d];
        const float rstd = __builtin_amdgcn_rsqf(ss * (1.0f / 64.0f) + EPS);
        const f32x4* g4 = (const f32x4*)gain;
#pragma unroll
        for (int c = 0; c < 16; ++c) { const f32x4 gv = g4[c]; x[4 * c] *= rstd * gv.x; x[4 * c + 1] *= rstd * gv.y; x[4 * c + 2] *= rstd * gv.z; x[4 * c + 3] *= rstd * gv.w; }
        if (row < S_LAT) {
            const int gr = row >> 6, gc = row & 63;
            const f32x4* cr = (const f32x4*)(rope + gr * 16); const f32x4* sr = (const f32x4*)(rope + 4096 + gr * 16); const f32x4* cc = (const f32x4*)(rope + 8192 + gc * 16); const f32x4* sc = (const f32x4*)(rope + 8192 + 1024 + gc * 16);
#pragma unroll
            for (int j4 = 0; j4 < 4; ++j4) { const f32x4 cv = cr[j4], sv = sr[j4];
#pragma unroll
                for (int i = 0; i < 4; ++i) { const int j = 4 * j4 + i; const float x1 = x[j], x2 = x[16 + j]; x[j] = x1 * cv[i] - x2 * sv[i]; x[16 + j] = x1 * sv[i] + x2 * cv[i]; } }
#pragma unroll
            for (int j4 = 0; j4 < 4; ++j4) { const f32x4 cv = cc[j4], sv = sc[j4];
#pragma unroll
                for (int i = 0; i < 4; ++i) { const int j = 4 * j4 + i; const float x1 = x[32 + j], x2 = x[48 + j]; x[32 + j] = x1 * cv[i] - x2 * sv[i]; x[48 + j] = x1 * sv[i] + x2 * cv[i]; } }
        }
        const float qs = isq ? 0.125f * 1.4426950408889634f : 1.0f;
#pragma unroll
        for (int c = 0; c < 8; ++c) { v4u w; w.x = pk2(x[8 * c] * qs, x[8 * c + 1] * qs); w.y = pk2(x[8 * c + 2] * qs, x[8 * c + 3] * qs); w.z = pk2(x[8 * c + 4] * qs, x[8 * c + 5] * qs); w.w = pk2(x[8 * c + 6] * qs, x[8 * c + 7] * qs);
            *(GAS v4u*)(p + 8 * c) = w; }
    }
}
__device__ __forceinline__ void gmlp_unit(KA a, int l, int chunk, int g, LAS unsigned char* lds, int tid, int lane, int wave) {
    const bf16* PROJ = (const bf16*)(a->ws + WS_PROJ); bf16* MIX = (bf16*)(a->ws + WS_MIX);
    const int row0 = (chunk < 128) ? chunk * 128 : S_LAT + (chunk - 128) * 128;
    LAS float* vn = (LAS float*)lds;
    { const int pos = tid >> 2, part = tid & 3;
      const bf16* p = PROJ + (size_t)(row0 + pos) * INW + COL_GV + g * 64 + part * 16;
      float x[16]; unpack8(*(const GAS v4u*)p, x); unpack8(*(const GAS v4u*)(p + 8), x + 8);
      float ss = 0.f;
#pragma unroll
      for (int d = 0; d < 16; ++d) { x[d] = gelu1(x[d]); ss += x[d] * x[d]; }
      ss += sx<1>(ss); ss += sx<2>(ss);
      const float rstd = __builtin_amdgcn_rsqf(ss * (1.0f / 64.0f) + EPS);
      const float* gn = a->in[I_GNG] + l * 256 + g * 64 + part * 16;
#pragma unroll
      for (int d = 0; d < 16; ++d) vn[pos * 64 + part * 16 + d] = x[d] * rstd * gn[d]; }
    __syncthreads();
    const int c = lane, t0 = wave * 16;
    const float* W = a->in[I_GWS] + ((size_t)(l * 4 + g) * 128 + t0) * 128;
    float acc[16];
#pragma unroll
    for (int i = 0; i < 16; ++i) acc[i] = 0.f;
    for (int s = 0; s < 128; ++s) { const float v = vn[s * 64 + c];
#pragma unroll
        for (int i = 0; i < 16; ++i) acc[i] += W[i * 128 + s] * v; }
    const float* bs = a->in[I_GBS] + (l * 4 + g) * 128 + t0;
#pragma unroll
    for (int i = 0; i < 16; ++i) { const int row = row0 + t0 + i;
        const float u = gelu1(bflo((unsigned)PROJ[(size_t)row * INW + COL_GU + g * 64 + c]));
        MIX[(size_t)row * DM + MIX_GM + g * 64 + c] = (bf16)f2bf(u * (acc[i] + bs[i])); }
    __syncthreads();
}
__device__ __forceinline__ void hgrn_naive(KA a, int l, int dir, int head, LAS unsigned char* lds, int tid, int lane, int wave) {
    const bf16* PROJ = (const bf16*)(a->ws + WS_PROJ);
    float* HGO = (float*)(a->ws + WS_HGO) + (size_t)dir * R_ALL * 256;
    LAS float* Qs = (LAS float*)lds;
    LAS float* Fs = Qs + 4096; LAS float* Vs = Fs + 4096; LAS float* part = Vs + 4096;
    const int v = lane, kg = wave;
    float S[8];
#pragma unroll
    for (int i = 0; i < 8; ++i) S[i] = 0.f;
    const int tl = tid >> 3, c8 = tid & 7;
    float lb[8];
#pragma unroll
    for (int j = 0; j < 8; ++j) { float b = 0.f; if (l == 1) { const float p0 = a->in[I_HLB][dir * 512 + head * 64 + c8 * 8 + j], p1 = a->in[I_HLB][dir * 512 + 256 + head * 64 + c8 * 8 + j]; b = 1.0f / (1.0f + __expf(p0 - p1)); } lb[j] = b; }
    const int fcol = (dir == 0 ? COL_HFF : COL_HFB) + head * 64 + c8 * 8;
    for (int n0 = 0; n0 < R_ALL; n0 += 64) {
        { const int n = n0 + tl; int row;
          if (dir == 0) row = (n < C_CTX) ? S_LAT + n : n - C_CTX; else row = (n < C_CTX) ? S_LAT + (C_CTX - 1 - n) : (S_LAT - 1) - (n - C_CTX);
          const bf16* pr = PROJ + (size_t)row * INW;
          float q[8], f[8], vv[8];
          unpack8(*(const GAS v4u*)(pr + COL_HQ + head * 64 + c8 * 8), q); unpack8(*(const GAS v4u*)(pr + fcol), f); unpack8(*(const GAS v4u*)(pr + COL_HI + head * 64 + c8 * 8), vv);
#pragma unroll
          for (int j = 0; j < 8; ++j) { Qs[tl * 64 + c8 * 8 + j] = silu1(q[j]) * 0.125f; Fs[tl * 64 + c8 * 8 + j] = lb[j] + (1.0f - lb[j]) * sigm1(f[j]); Vs[tl * 64 + c8 * 8 + j] = vv[j]; } }
        __syncthreads();
        for (int t = 0; t < 64; ++t) {
            const float vt = Vs[t * 64 + v]; float po = 0.f;
#pragma unroll
            for (int i = 0; i < 8; ++i) { const float f = Fs[t * 64 + kg * 8 + i], q = Qs[t * 64 + kg * 8 + i]; S[i] = f * S[i] + (1.0f - f) * vt; po += S[i] * q; }
            part[((t & 1) * 8 + kg) * 64 + v] = po;
            __syncthreads();
            if (wave == 0) { float o = 0.f;
#pragma unroll
                for (int w8 = 0; w8 < 8; ++w8) o += part[((t & 1) * 8 + w8) * 64 + v];
                const int n = n0 + t; int row;
                if (dir == 0) row = (n < C_CTX) ? S_LAT + n : n - C_CTX; else row = (n < C_CTX) ? S_LAT + (C_CTX - 1 - n) : (S_LAT - 1) - (n - C_CTX);
                HGO[(size_t)row * 256 + head * 64 + v] = o; }
        }
        __syncthreads();
    }
}

typedef short bf16x8v __attribute__((ext_vector_type(8)));
constexpr int HST = 72;
__device__ __forceinline__ f32x4 mma16(const LAS bf16* MA, const LAS bf16* MBt, int k0, f32x4 c, int lane) {
    const bf16x8v av = *(const LAS bf16x8v*)(MA + (lane & 15) * HST + k0 + 8 * (lane >> 4));
    const bf16x8v bv = *(const LAS bf16x8v*)(MBt + (lane & 15) * HST + k0 + 8 * (lane >> 4));
    return __builtin_amdgcn_mfma_f32_16x16x32_bf16(av, bv, c, 0, 0, 0);
}
__device__ __forceinline__ int hg_base_row(int cpos) { return cpos < 256 ? 64 * cpos : S_LAT + 64 * (cpos - 256); }
__device__ __forceinline__ int hg_scan_idx(int dir, int cpos) { return dir == 0 ? (cpos < 256 ? 4 + cpos : cpos - 256) : (cpos < 256 ? 4 + (255 - cpos) : 3 - (cpos - 256)); }
__device__ __forceinline__ float hg_lb(KA a, int l, int dir, int head, int k) {
    if (l == 0) return 0.f;
    const float p0 = a->in[I_HLB][dir * 512 + head * 64 + k], p1 = a->in[I_HLB][dir * 512 + 256 + head * 64 + k];
    return 1.0f / (1.0f + __expf(p0 - p1));
}
__device__ __forceinline__ void hgrn_stepA(KA a, int l, int cpos, int head, LAS unsigned char* lds, int lane, int wave) {
    const bf16* PROJ = (const bf16*)(a->ws + WS_PROJ);
    const int dir = wave >> 2, I = wave & 3, base = hg_base_row(cpos), ci = hg_scan_idx(dir, cpos);
    LAS float* TOT = (LAS float*)lds;
    LAS bf16* KLT = (LAS bf16*)(lds + 2048) + dir * 64 * HST;
    LAS bf16* VT = (LAS bf16*)(lds + 2048 + 2 * 64 * HST * 2) + dir * 64 * HST;
    const float lb = hg_lb(a, l, dir, head, lane);
    const int fcol = (dir == 0 ? COL_HFF : COL_HFB) + head * 64 + lane, vcol = COL_HI + head * 64 + lane;
    float kk[16], cl[16]; float run = 0.f;
#pragma unroll
    for (int i = 0; i < 16; ++i) { const int n = 16 * I + i, row = base + (dir ? 63 - n : n);
        const float fl = bflo((unsigned)PROJ[(size_t)row * INW + fcol]);
        const unsigned short vb = PROJ[(size_t)row * INW + vcol];
        const float f = lb + (1.0f - lb) * sigm1(fl);
        run += __logf(f); cl[i] = run; kk[i] = 1.0f - f;
        VT[lane * HST + n] = vb; }
    TOT[(dir * 4 + I) * 64 + lane] = run;
    __syncthreads();
    float post = 0.f, all = 0.f;
#pragma unroll
    for (int J = 0; J < 4; ++J) { const float t = TOT[(dir * 4 + J) * 64 + lane]; all += t; if (J > I) post += t; }
#pragma unroll
    for (int i = 0; i < 16; ++i) KLT[lane * HST + 16 * I + i] = (bf16)f2bf(kk[i] * __expf(run - cl[i] + post));
    if (I == 0) ((float*)(a->ws + WS_HDG))[((size_t)(dir * 4 + head) * 260 + ci) * 64 + lane] = __expf(all);
    __syncthreads();
    float* LT = (float*)(a->ws + WS_HLT) + ((size_t)(dir * 4 + head) * 260 + ci) * 4096;
    float z0 = 0.f; asm volatile("" : "+v"(z0));
#pragma unroll
    for (int kb = 0; kb < 4; ++kb) { f32x4 acc = {z0, z0, z0, z0};
        acc = mma16(VT + 16 * I * HST, KLT + 16 * kb * HST, 0, acc, lane); acc = mma16(VT + 16 * I * HST, KLT + 16 * kb * HST, 32, acc, lane);
#pragma unroll
        for (int r = 0; r < 4; ++r) LT[(16 * I + 4 * (lane >> 4) + r) * 64 + 16 * kb + (lane & 15)] = acc[r]; }
    __syncthreads();
}
__device__ __forceinline__ void hgrn_stepB(KA a, int item, int tid) {
    const int dh = item >> 3, vb = item & 7, v = vb * 8 + (tid >> 6), k = tid & 63;
    const float* LT = (const float*)(a->ws + WS_HLT) + (size_t)dh * 260 * 4096 + v * 64 + k;
    const float* DG = (const float*)(a->ws + WS_HDG) + (size_t)dh * 260 * 64 + k;
    bf16* SP = (bf16*)(a->ws + WS_HSP) + (size_t)dh * 260 * 4096 + v * 64 + k;
    float S = 0.f;
#pragma unroll 1
    for (int c0 = 0; c0 < 260; c0 += 26) {
        float lt[26], dg[26];
#pragma unroll
        for (int j = 0; j < 26; ++j) { lt[j] = LT[(size_t)(c0 + j) * 4096]; dg[j] = DG[(c0 + j) * 64]; }
#pragma unroll
        for (int j = 0; j < 26; ++j) { SP[(size_t)(c0 + j) * 4096] = (bf16)f2bf(S); S = dg[j] * S + lt[j]; }
    }
}
__device__ __forceinline__ void hgrn_stepC(KA a, int l, int cpos, int head, LAS unsigned char* lds, int tid, int lane, int wave) {
    const bf16* PROJ = (const bf16*)(a->ws + WS_PROJ); bf16* MIX = (bf16*)(a->ws + WS_MIX);
    const int dir = wave >> 2, I = wave & 3, base = hg_base_row(cpos), ci = hg_scan_idx(dir, cpos);
    constexpr int MSZ = 64 * HST;
    LAS float* TOT = (LAS float*)lds;
    LAS bf16* img = (LAS bf16*)(lds + 2048);
    LAS bf16* QT = img + dir * MSZ;
    LAS bf16* QD = img + 2 * MSZ + dir * MSZ;
    LAS bf16* VT = img + 4 * MSZ + dir * MSZ;
    LAS bf16* ST = img + 6 * MSZ + dir * MSZ;
    LAS bf16* AS = img + 8 * MSZ + dir * MSZ + I * 16 * HST;
    LAS bf16* KT = img + 10 * MSZ + dir * (10 * 16 * HST);
    LAS float* OS = (LAS float*)(img + 10 * MSZ);
    const float lb = hg_lb(a, l, dir, head, lane);
    const int fcol = (dir == 0 ? COL_HFF : COL_HFB) + head * 64 + lane, qcol = COL_HQ + head * 64 + lane, vcol = COL_HI + head * 64 + lane;
    { const bf16* SP = (const bf16*)(a->ws + WS_HSP) + ((size_t)(dir * 4 + head) * 260 + ci) * 4096;
#pragma unroll
      for (int h2 = 0; h2 < 2; ++h2) { const int e = ((I * 2 + h2) * 64 + lane) * 8, vv = e >> 6, kk0 = e & 63;
          *(LAS v4u*)(ST + vv * HST + kk0) = *(const GAS v4u*)(SP + e); } }
    float kk[16], cl[16], qv[16]; float run = 0.f;
#pragma unroll
    for (int i = 0; i < 16; ++i) { const int n = 16 * I + i, row = base + (dir ? 63 - n : n);
        const float fl = bflo((unsigned)PROJ[(size_t)row * INW + fcol]), ql = bflo((unsigned)PROJ[(size_t)row * INW + qcol]);
        const unsigned short vb = PROJ[(size_t)row * INW + vcol];
        const float f = lb + (1.0f - lb) * sigm1(fl);
        run += __logf(f); cl[i] = run; kk[i] = 1.0f - f; qv[i] = silu1(ql) * 0.125f;
        VT[lane * HST + n] = vb; }
    TOT[(dir * 4 + I) * 64 + lane] = run;
    __syncthreads();
    float tj[4];
#pragma unroll
    for (int J = 0; J < 4; ++J) tj[J] = TOT[(dir * 4 + J) * 64 + lane];
    float pre = 0.f;
#pragma unroll
    for (int J = 0; J < 4; ++J) if (J < I) pre += tj[J];
    const float epre = __expf(pre); float kei[16];
#pragma unroll
    for (int i = 0; i < 16; ++i) { const float e = __expf(cl[i]); QT[(16 * I + i) * HST + lane] = (bf16)f2bf(qv[i] * e); QD[(16 * I + i) * HST + lane] = (bf16)f2bf(qv[i] * e * epre); kei[i] = kk[i] * fminf(__builtin_amdgcn_rcpf(e), 5.5e34f); }
    float eoff = 0.f;
#pragma unroll
    for (int I2 = 0; I2 < 4; ++I2) {
        if (I2 >= I) {
            if (I2 == I) eoff = 0.f; else if (I2 == I + 1) eoff = run; else eoff += tj[I2 - 1];
            LAS bf16* blk = KT + (I2 * (I2 + 1) / 2 + I) * 16 * HST;
            const float fo = __expf(eoff);
#pragma unroll
            for (int i = 0; i < 16; ++i) blk[i * HST + lane] = (bf16)f2bf(kei[i] * fo);
        }
    }
    __syncthreads();
    float z0 = 0.f; asm volatile("" : "+v"(z0));
    f32x4 sc[4];
#pragma unroll
    for (int J = 0; J < 4; ++J) { sc[J] = (f32x4){z0, z0, z0, z0};
        if (J <= I) { const LAS bf16* kb = KT + (I * (I + 1) / 2 + J) * 16 * HST;
            sc[J] = mma16(QT + 16 * I * HST, kb, 0, sc[J], lane); sc[J] = mma16(QT + 16 * I * HST, kb, 32, sc[J], lane);
            if (J == I) {
#pragma unroll
                for (int r = 0; r < 4; ++r) if ((lane & 15) > 4 * (lane >> 4) + r) sc[J][r] = z0; } } }
#pragma unroll
    for (int J = 0; J < 4; ++J)
#pragma unroll
        for (int r = 0; r < 4; ++r) AS[(4 * (lane >> 4) + r) * HST + 16 * J + (lane & 15)] = (bf16)f2bf(sc[J][r]);
    asm volatile("s_waitcnt lgkmcnt(0)" ::: "memory");
    f32x4 acc[4];
#pragma unroll
    for (int vb = 0; vb < 4; ++vb) { acc[vb] = (f32x4){z0, z0, z0, z0};
        acc[vb] = mma16(AS, VT + 16 * vb * HST, 0, acc[vb], lane); acc[vb] = mma16(AS, VT + 16 * vb * HST, 32, acc[vb], lane);
        acc[vb] = mma16(QD + 16 * I * HST, ST + 16 * vb * HST, 0, acc[vb], lane); acc[vb] = mma16(QD + 16 * I * HST, ST + 16 * vb * HST, 32, acc[vb], lane); }
    __syncthreads();
#pragma unroll
    for (int vb = 0; vb < 4; ++vb)
#pragma unroll
        for (int r = 0; r < 4; ++r) { const int n = 16 * I + 4 * (lane >> 4) + r, rl = dir ? 63 - n : n; OS[(dir * 64 + rl) * 68 + 16 * vb + (lane & 15)] = acc[vb][r]; }
    __syncthreads();
    { const int rl = tid >> 3, v8 = (tid & 7) * 8, row = base + rl;
      float o[8]; float ss = 0.f;
#pragma unroll
      for (int j = 0; j < 8; ++j) { o[j] = OS[rl * 68 + v8 + j] + OS[(64 + rl) * 68 + v8 + j]; ss += o[j] * o[j]; }
      ss += sx<1>(ss); ss += sx<2>(ss); ss += sx<4>(ss);
      const float rstd = __builtin_amdgcn_rsqf(ss * (1.0f / 64.0f) + EPS);
      float gt[8]; unpack8(*(const GAS v4u*)(PROJ + (size_t)row * INW + COL_HG + head * 64 + v8), gt);
      const float* gn = a->in[I_HGAIN] + l * 64 + v8;
      float y[8];
#pragma unroll
      for (int j = 0; j < 8; ++j) y[j] = o[j] * rstd * gn[j] * silu1(gt[j]);
      v4u w; w.x = pk2(y[0], y[1]); w.y = pk2(y[2], y[3]); w.z = pk2(y[4], y[5]); w.w = pk2(y[6], y[7]);
      *(GAS v4u*)(MIX + (size_t)row * DM + MIX_HG + head * 64 + v8) = w; }
    __syncthreads();
}

__device__ __forceinline__ void vt_item(KA a, int item, int lane) {
    const bf16* PROJ = (const bf16*)(a->ws + WS_PROJ); bf16* VTg = (bf16*)(a->ws + WS_VT);
    const int rb = item >> 1, hk = item & 1, row = rb * 64 + lane;
    const bf16* p = PROJ + (size_t)row * INW + COL_AV + hk * 64;
    unsigned w[32];
#pragma unroll
    for (int c = 0; c < 8; ++c) { const v4u t = *(const GAS v4u*)(p + 8 * c); w[4 * c] = t.x; w[4 * c + 1] = t.y; w[4 * c + 2] = t.z; w[4 * c + 3] = t.w; }
    bf16* o = VTg + (size_t)hk * 64 * R_ALL + row;
#pragma unroll
    for (int d2 = 0; d2 < 32; ++d2) { o[(size_t)(2 * d2) * R_ALL] = (bf16)(w[d2] & 0xffffu); o[(size_t)(2 * d2 + 1) * R_ALL] = (bf16)(w[d2] >> 16); }
}
__device__ __forceinline__ void attn_unit(KA a, int l, int u, LAS unsigned char* lds, int tid, int lane, int wave) {
    asm volatile("" : "+v"(tid), "+v"(lane));
    const bf16* PROJ = (const bf16*)(a->ws + WS_PROJ); const bf16* VTg = (const bf16*)(a->ws + WS_VT); bf16* MIX = (bf16*)(a->ws + WS_MIX);
    const bool isctx = u >= 256; const int uu = isctx ? u - 256 : u; const int n = uu >> 1, hk = uu & 1;
    const int qh = hk * 4 + (wave >> 1), half = wave & 1;
    const int qbase = (isctx ? S_LAT : 0) + n * 128 + half * 64, qpos0 = n * 128 + half * 64;
    const int c = lane & 15, g = lane >> 4;
    LAS bf16* Kt = (LAS bf16*)lds; LAS bf16* Vt = Kt + 64 * HST; LAS bf16* Qw = Vt + 64 * HST + wave * 64 * HST;
#pragma unroll
    for (int j = 0; j < 8; ++j) { const int qr = 8 * j + (lane >> 3), qc = (lane & 7) * 8;
        *(LAS v4u*)(Qw + qr * HST + qc) = *(const GAS v4u*)(PROJ + (size_t)(qbase + qr) * INW + qh * 64 + qc); }
    float z0 = 0.f; asm volatile("" : "+v"(z0));
    f32x4 o[4][4]; float ls[4];
    float gq = 0.f, gk = 0.f;
#pragma unroll 8
    for (int d = 0; d < 64; ++d) { gq = fmaxf(gq, fabsf(a->in[I_QG][l * 64 + d])); gk = fmaxf(gk, fabsf(a->in[I_KG][l * 64 + d])); }
    const float nbnd = -(8.0f * 1.4426950408889634f) * gq * gk;
    const f32x4 nb4 = {nbnd, nbnd, nbnd, nbnd};
    const float sink = a->in[I_SINK][l * 8 + qh] * 1.4426950408889634f;
#pragma unroll
    for (int qt = 0; qt < 4; ++qt) { ls[qt] = (g == 0) ? __builtin_amdgcn_exp2f(sink + nbnd) : z0;
#pragma unroll
        for (int dt = 0; dt < 4; ++dt) o[qt][dt] = (f32x4){z0, z0, z0, z0}; }
    const int first = (!isctx && n == 0) ? 2 : 0, nwin = isctx ? 0 : ((n == 0 || n == 127) ? 4 : 6), nt = nwin + 4;
    const int lr = tid >> 3, lc = (tid & 7) * 8;
    v4u kreg, vreg;
#define ATT_LOADT(i) do { const bool ct_ = (i) >= nwin; const int kb_ = ct_ ? S_LAT + 64 * ((i) - nwin) : (n - 1) * 128 + 64 * (first + (i)); \
        kreg = *(const GAS v4u*)(PROJ + (size_t)(kb_ + lr) * INW + COL_AK + hk * 64 + lc); vreg = *(const GAS v4u*)(VTg + ((size_t)hk * 64 + lr) * R_ALL + kb_ + lc); } while (0)
    ATT_LOADT(0);
#pragma unroll 1
    for (int i = 0; i < nt; ++i) {
        __syncthreads();
        *(LAS v4u*)(Kt + lr * HST + lc) = kreg; *(LAS v4u*)(Vt + lr * HST + lc) = vreg;
        __syncthreads();
        if (i + 1 < nt) ATT_LOADT(i + 1);
        const bool win = i < nwin; const int kb = (n - 1) * 128 + 64 * (first + i);
        const int rel = kb - qpos0;
        const bool maskw = win && (rel == 128 || rel == -128);
        if (win && (rel >= 192 || rel <= -192)) continue;
        bf16x8v kf[4][2], vf[4][2];
#pragma unroll
        for (int kt = 0; kt < 4; ++kt)
#pragma unroll
            for (int ks = 0; ks < 2; ++ks) kf[kt][ks] = *(const LAS bf16x8v*)(Kt + (16 * kt + c) * HST + 32 * ks + 8 * g);
#pragma unroll
        for (int dt = 0; dt < 4; ++dt)
#pragma unroll
            for (int s2 = 0; s2 < 2; ++s2) { const v2u lo = *(const LAS v2u*)(Vt + (16 * dt + c) * HST + 32 * s2 + 4 * g), hi = *(const LAS v2u*)(Vt + (16 * dt + c) * HST + 32 * s2 + 16 + 4 * g);
                const v4u t = {lo.x, lo.y, hi.x, hi.y}; vf[dt][s2] = __builtin_bit_cast(bf16x8v, t); }
        f32x4 sA[4], sB[4];
#define ATT_SCORES(QT, S_) do { const bf16x8v q0_ = *(const LAS bf16x8v*)(Qw + (16 * (QT) + c) * HST + 8 * g), q1_ = *(const LAS bf16x8v*)(Qw + (16 * (QT) + c) * HST + 32 + 8 * g); \
            _Pragma("unroll") for (int kt = 0; kt < 4; ++kt) { S_[kt] = __builtin_amdgcn_mfma_f32_16x16x32_bf16(kf[kt][0], q0_, nb4, 0, 0, 0); S_[kt] = __builtin_amdgcn_mfma_f32_16x16x32_bf16(kf[kt][1], q1_, S_[kt], 0, 0, 0); } } while (0)
#define ATT_REST(QT, S_) do { \
            if (maskw) { const int dq = qpos0 + 16 * (QT) + c - kb - 4 * g; \
                _Pragma("unroll") for (int kt = 0; kt < 4; ++kt) _Pragma("unroll") for (int r = 0; r < 4; ++r) { const int dl = dq - 16 * kt - r; if (dl > 128 || dl < -128) S_[kt][r] = -INFINITY; } } \
            float ps = 0.f; \
            _Pragma("unroll") for (int kt = 0; kt < 4; ++kt) _Pragma("unroll") for (int r = 0; r < 4; ++r) { S_[kt][r] = __builtin_amdgcn_exp2f(S_[kt][r]); ps += S_[kt][r]; } \
            ls[QT] += ps; \
            bf16x8v pb[2]; \
            _Pragma("unroll") for (int s2 = 0; s2 < 2; ++s2) { const v4u t = {pk2(S_[2 * s2][0], S_[2 * s2][1]), pk2(S_[2 * s2][2], S_[2 * s2][3]), pk2(S_[2 * s2 + 1][0], S_[2 * s2 + 1][1]), pk2(S_[2 * s2 + 1][2], S_[2 * s2 + 1][3])}; pb[s2] = __builtin_bit_cast(bf16x8v, t); } \
            _Pragma("unroll") for (int dt = 0; dt < 4; ++dt) { o[QT][dt] = __builtin_amdgcn_mfma_f32_16x16x32_bf16(vf[dt][0], pb[0], o[QT][dt], 0, 0, 0); o[QT][dt] = __builtin_amdgcn_mfma_f32_16x16x32_bf16(vf[dt][1], pb[1], o[QT][dt], 0, 0, 0); } } while (0)
        ATT_SCORES(0, sA);
        ATT_SCORES(1, sB); ATT_REST(0, sA);
        ATT_SCORES(2, sA); ATT_REST(1, sB);
        ATT_SCORES(3, sB); ATT_REST(2, sA);
        ATT_REST(3, sB);
#undef ATT_SCORES
#undef ATT_REST
    }
#undef ATT_LOADT
    int c2 = lane & 15, g2 = lane >> 4; asm volatile("" : "+v"(c2), "+v"(g2));
#pragma unroll
    for (int qt = 0; qt < 4; ++qt) { float lt = ls[qt]; lt += sx<16>(lt); lt = sx32_add(lt); const float inv = 1.0f / lt;
        bf16* op = (bf16*)(a->ws + WS_MIX) + (size_t)(qbase + 16 * qt + c2) * DM + MIX_AT + qh * 64 + 4 * g2;
#pragma unroll
        for (int dt = 0; dt < 4; ++dt) { v2u w; w.x = pk2(o[qt][dt][0] * inv, o[qt][dt][1] * inv); w.y = pk2(o[qt][dt][2] * inv, o[qt][dt][3] * inv); *(GAS v2u*)(op + 16 * dt) = w; } }
}

constexpr int GST = 136;
__device__ __forceinline__ f32x4 mma16g(const LAS bf16* MA, const LAS bf16* MBt, int k0, f32x4 c, int lane) {
    const bf16x8v av = *(const LAS bf16x8v*)(MA + (lane & 15) * GST + k0 + 8 * (lane >> 4));
    const bf16x8v bv = *(const LAS bf16x8v*)(MBt + (lane & 15) * GST + k0 + 8 * (lane >> 4));
    return __builtin_amdgcn_mfma_f32_16x16x32_bf16(av, bv, c, 0, 0, 0);
}
__device__ __forceinline__ float gelu_as(float v) {
    const float av = fabsf(v), t = __builtin_amdgcn_rcpf(av * 0.2316418882f + 1.0f);
    float q = t * 0.5307027145f + (-0.7265760135f); q = q * t + 0.7107068705f; q = q * t + (-0.142248368f); q = q * t + 0.127414796f; q = q * t;
    const float e = __builtin_amdgcn_exp2f((v * v) * (-0.72134752044f)), mm = v * (q * e);
    return v < 0.f ? mm : v - mm;
}
__device__ __forceinline__ void gmlp_unit_mma(KA a, int l, int chunk, int g, LAS unsigned char* lds, int tid, int lane, int wave) {
    const bf16* PROJ = (const bf16*)(a->ws + WS_PROJ); bf16* MIX = (bf16*)(a->ws + WS_MIX);
    const int row0 = (chunk < 128) ? chunk * 128 : S_LAT + (chunk - 128) * 128;
    LAS bf16* WA = (LAS bf16*)lds;
    LAS bf16* VNT = WA + 128 * GST;
    LAS float* OUT = (LAS float*)(VNT + 64 * GST);
    const int pos = tid >> 2, part = tid & 3;
    {
      const float* W = a->in[I_GWS] + ((size_t)(l * 4 + g) * 128 + pos) * 128 + part * 32;
#pragma unroll
      for (int j = 0; j < 4; ++j) { const f32x4 w0 = *(const GAS f32x4*)(W + 8 * j), w1 = *(const GAS f32x4*)(W + 8 * j + 4);
          v4u o; o.x = pk2(w0.x, w0.y); o.y = pk2(w0.z, w0.w); o.z = pk2(w1.x, w1.y); o.w = pk2(w1.z, w1.w);
          *(LAS v4u*)(WA + pos * GST + part * 32 + 8 * j) = o; } }
    { const bf16* p = PROJ + (size_t)(row0 + pos) * INW + COL_GV + g * 64 + part * 16;
      float x[16]; unpack8(*(const GAS v4u*)p, x); unpack8(*(const GAS v4u*)(p + 8), x + 8);
      float ss = 0.f;
#pragma unroll
      for (int d = 0; d < 16; ++d) { x[d] = gelu_as(x[d]); ss += x[d] * x[d]; }
      ss += sx<1>(ss); ss += sx<2>(ss);
      const float rstd = __builtin_amdgcn_rsqf(ss * (1.0f / 64.0f) + EPS);
      const float* gn = a->in[I_GNG] + l * 256 + g * 64 + part * 16;
#pragma unroll
      for (int d = 0; d < 16; ++d) VNT[(part * 16 + d) * GST + pos] = (bf16)f2bf(x[d] * rstd * gn[d]); }
    __syncthreads();
    float z0 = 0.f; asm volatile("" : "+v"(z0));
#pragma unroll
    for (int cb = 0; cb < 4; ++cb) { f32x4 acc = {z0, z0, z0, z0};
#pragma unroll
        for (int ks = 0; ks < 4; ++ks) acc = mma16g(WA + 16 * wave * GST, VNT + 16 * cb * GST, 32 * ks, acc, lane);
#pragma unroll
        for (int r = 0; r < 4; ++r) OUT[(16 * wave + 4 * (lane >> 4) + r) * 68 + 16 * cb + (lane & 15)] = acc[r]; }
    __syncthreads();
    { const int row = row0 + pos; const float bsv = a->in[I_GBS][(l * 4 + g) * 128 + pos];
      const bf16* pu = PROJ + (size_t)row * INW + COL_GU + g * 64 + part * 16;
      float u[16]; unpack8(*(const GAS v4u*)pu, u); unpack8(*(const GAS v4u*)(pu + 8), u + 8);
      float y[16];
#pragma unroll
      for (int d = 0; d < 16; ++d) y[d] = gelu_as(u[d]) * (OUT[pos * 68 + part * 16 + d] + bsv);
      bf16* po = MIX + (size_t)row * DM + MIX_GM + g * 64 + part * 16;
      v4u w; w.x = pk2(y[0], y[1]); w.y = pk2(y[2], y[3]); w.z = pk2(y[4], y[5]); w.w = pk2(y[6], y[7]); *(GAS v4u*)po = w;
      w.x = pk2(y[8], y[9]); w.y = pk2(y[10], y[11]); w.z = pk2(y[12], y[13]); w.w = pk2(y[14], y[15]); *(GAS v4u*)(po + 8) = w; }
    __syncthreads();
}
__device__ __forceinline__ void attn_naive(KA a, int l, int nrows, int lane, int wave, int G, int bid) {
    const bf16* PROJ = (const bf16*)(a->ws + WS_PROJ); bf16* MIX = (bf16*)(a->ws + WS_MIX);
    const int gw = bid * NWAVES + wave, NGW = G * NWAVES;
    for (int pair = gw; pair < nrows * 2; pair += NGW) {
        const int row = pair >> 1, hk = pair & 1; const bool isctx = row >= S_LAT;
        float q[4], o[4], m[4], ls[4];
#pragma unroll
        for (int g = 0; g < 4; ++g) { q[g] = bflo((unsigned)PROJ[(size_t)row * INW + (hk * 4 + g) * 64 + lane]); o[g] = 0.f; ls[g] = 1.0f; m[g] = a->in[I_SINK][l * 8 + hk * 4 + g] * 1.4426950408889634f; }
        int j0 = 0, j1 = -1;
        if (!isctx) { j0 = row - 128 < 0 ? 0 : row - 128; j1 = row + 128 > S_LAT - 1 ? S_LAT - 1 : row + 128; }
        const int nwin = j1 - j0 + 1;
        const int nk = nwin + C_CTX;
#pragma unroll 4
        for (int t = 0; t < nk; ++t) {
            const int krow = (t < nwin) ? j0 + t : S_LAT + (t - nwin);
            const float k = bflo((unsigned)PROJ[(size_t)krow * INW + COL_AK + hk * 64 + lane]);
            const float v = bflo((unsigned)PROJ[(size_t)krow * INW + COL_AV + hk * 64 + lane]);
#pragma unroll
            for (int g = 0; g < 4; ++g) { const float s = wave_sum(q[g] * k); const float mn = fmaxf(m[g], s);
                const float c = __builtin_amdgcn_exp2f(m[g] - mn), p = __builtin_amdgcn_exp2f(s - mn);
                ls[g] = ls[g] * c + p; o[g] = o[g] * c + p * v; m[g] = mn; }
        }
#pragma unroll
        for (int g = 0; g < 4; ++g) MIX[(size_t)row * DM + MIX_AT + (hk * 4 + g) * 64 + lane] = (bf16)f2bf(o[g] / ls[g]);
    }
}
__device__ __forceinline__ void hgrn_combine(KA a, int l, int nrows, int lane, int wave, int G, int bid) {
    const bf16* PROJ = (const bf16*)(a->ws + WS_PROJ); bf16* MIX = (bf16*)(a->ws + WS_MIX);
    const float* O0 = (const float*)(a->ws + WS_HGO); const float* O1 = O0 + (size_t)R_ALL * 256;
    const f32x4 gn = *(const f32x4*)(a->in[I_HGAIN] + l * 64 + (lane & 15) * 4);
    const int gw = bid * NWAVES + wave, NGW = G * NWAVES;
    for (int r = gw; r < nrows; r += NGW) {
        const f32x4 o = *(const GAS f32x4*)(O0 + (size_t)r * 256 + 4 * lane) + *(const GAS f32x4*)(O1 + (size_t)r * 256 + 4 * lane);
        float ss = (o.x * o.x + o.y * o.y) + (o.z * o.z + o.w * o.w);
        ss += sx<1>(ss); ss += sx<2>(ss); ss += sx<4>(ss); ss += sx<8>(ss);
        const float rstd = __builtin_amdgcn_rsqf(ss * (1.0f / 64.0f) + EPS);
        const v2u gw2 = *(const GAS v2u*)(PROJ + (size_t)r * INW + COL_HG + 4 * lane);
        const float g0 = bflo(gw2.x), g1 = bfhi(gw2.x), g2 = bflo(gw2.y), g3 = bfhi(gw2.y);
        v2u w; w.x = pk2(o.x * rstd * gn.x * silu1(g0), o.y * rstd * gn.y * silu1(g1)); w.y = pk2(o.z * rstd * gn.z * silu1(g2), o.w * rstd * gn.w * silu1(g3));
        *(GAS v2u*)(MIX + (size_t)r * DM + MIX_HG + 4 * lane) = w;
    }
}
__device__ __forceinline__ void moe_gather(KA a, LAS unsigned char* lds, int tid, int lane, int wave, int G, int bid) {
    LAS int* sb = (LAS int*)lds;
    const unsigned* cnt = (const unsigned*)(a->ws + WS_CTL) + CW_MOECNT;
    int* mi = (int*)(a->ws + WS_VEC) + VO_MOE;
    if (tid < 8) sb[16 + tid] = (int)__hip_atomic_load(cnt + 64 * tid, RLX_AGENT);
    __syncthreads();
    if (tid == 0) { int b = 0;
#pragma unroll
        for (int e = 0; e < 8; ++e) { sb[e] = b; b += ((sb[16 + e] + 255) >> 8) << 8; }
        sb[8] = b; }
    __syncthreads();
    if (bid == 0) {
        if (tid == 0) mi[0] = sb[8] >> 8;
        if (tid < 8) mi[160 + tid] = sb[tid + 1] >> 8;
        for (int t = tid; t < (sb[8] >> 8); t += NTHR) { int e = 0;
#pragma unroll
            for (int j = 1; j < 8; ++j) e += (t >= (sb[j] >> 8)) ? 1 : 0;
            mi[16 + t] = e; } }
    unsigned char* AS = (unsigned char*)(a->ws + WS_AS);
    const int* tokinfo = (const int*)(a->ws + WS_TOK); int* tokslot = (int*)(a->ws + WS_TOK) + S_LAT * 8;
    const int gw = bid * NWAVES + wave, NGW = G * NWAVES;
    int kq = 0;
    for (int t = gw; t < S_LAT; t += NGW, ++kq) {
        const int* ti = tokinfo + (size_t)t * 8;
        const int e1 = ti[0], e2 = ti[1], r1 = ti[2], r2 = ti[3];
        const int s1 = sb[e1] + r1, s2 = sb[e2] + r2;
        const v4u x0 = ((const LAS v4u*)(lds + ROUTE_ROWS_OFF + wave * 8192 + kq * 1024))[lane];
        ((GAS v4u*)(AS + (size_t)s1 * DM))[lane] = x0; ((GAS v4u*)(AS + (size_t)s2 * DM))[lane] = x0;
        if (lane == 0) { int* ts = tokslot + (size_t)t * 4; ts[0] = s1; ts[1] = s2; ts[2] = ti[4]; ts[3] = ti[5]; }
    }
    { const f32x4 z4 = {0.f, 0.f, 0.f, 0.f}; for (int i = bid * NTHR + tid; i < 8 * 256 * DM / 4; i += G * NTHR) ((GAS f32x4*)(a->ws + WS_YF))[i] = z4; }
    for (int e = 0; e < 8; ++e) { const int c = sb[16 + e], pe = (c + 255) & ~255, b = sb[e];
        for (int j = c + gw; j < pe; j += NGW) { const v4u z = {0u, 0u, 0u, 0u}; ((GAS v4u*)(AS + (size_t)(b + j) * DM))[lane] = z; } }
}
__device__ __forceinline__ void moe_combine(KA a, int lane, int wave, int G, int bid) {
    const float* gf = (const float*)(a->ws + WS_VEC) + VO_MOD + (1 * 2 + 0) * 6144 + 5 * 1024;
    const bf16* Y = (const bf16*)(a->ws + WS_Y); const int* tokslot = (const int*)(a->ws + WS_TOK) + S_LAT * 8;
    const int gw = bid * NWAVES + wave, NGW = G * NWAVES;
    for (int t = gw; t < S_LAT; t += NGW) {
        const int* ts = tokslot + (size_t)t * 4; const int s1 = ts[0], s2 = ts[1]; const float w1 = __builtin_bit_cast(float, ts[2]), w2 = __builtin_bit_cast(float, ts[3]);
        GAS f32x4* xr = (GAS f32x4*)(a->out + (size_t)t * DM) + lane; const GAS v2u* xbr = (const GAS v2u*)((const bf16*)(a->ws + WS_XB) + (size_t)t * DM) + lane;
        const float* YF = (const float*)(a->ws + WS_YF);
#pragma unroll
        for (int j = 0; j < 4; ++j) { const f32x4 g = *(const f32x4*)(gf + 4 * lane + 256 * j); const v2u xt = xbr[64 * j]; f32x4 x = (f32x4){bflo(xt.x), bfhi(xt.x), bflo(xt.y), bfhi(xt.y)}; f32x4 p, q;
            if (s1 < 32768) { const v2u t = ((const GAS v2u*)(Y + (size_t)s1 * DM) + lane)[64 * j]; p = (f32x4){bflo(t.x), bfhi(t.x), bflo(t.y), bfhi(t.y)}; } else p = ((const GAS f32x4*)(YF + (size_t)(s1 - 32768) * DM) + lane)[64 * j];
            if (s2 < 32768) { const v2u t = ((const GAS v2u*)(Y + (size_t)s2 * DM) + lane)[64 * j]; q = (f32x4){bflo(t.x), bfhi(t.x), bflo(t.y), bfhi(t.y)}; } else q = ((const GAS f32x4*)(YF + (size_t)(s2 - 32768) * DM) + lane)[64 * j];
            x = x + g * (p * w1 + q * w2);
            __builtin_nontemporal_store(x, (f32x4*)(xr + 64 * j)); }
    }
}

#define IN(k) (lo <= (k) && (k) < hi)
#define GRIDBAR() do { XcdBarrier b2_; b2_.bar = (unsigned*)(KARGS()->ws + WS_CTL) + CW_BAR; b2_.x = xb_xcc_id(); b2_.st = (volatile LAS unsigned*)(lds + MISC_OFF) + 8; xcd_barrier(b2_, wv0 * 64 + (int)__builtin_amdgcn_mbcnt_hi(~0u, __builtin_amdgcn_mbcnt_lo(~0u, 0u))); } while (0)
#define SEAM(k) do { if (IN(k) && IN((k) + 1)) GRIDBAR(); } while (0)
#define PHASE_ROOTS() KA a = KARGS(); unsigned char* ws = a->ws; const float* vec = (const float*)(ws + WS_VEC); (void)vec; int bid = blockIdx.x, G = gridDim.x; asm volatile("" : "+s"(bid), "+s"(G)); int tid = wv0 * 64 + (int)__builtin_amdgcn_mbcnt_hi(~0u, __builtin_amdgcn_mbcnt_lo(~0u, 0u)); asm volatile("" : "+v"(tid)); const int lane = tid & 63, wave = __builtin_amdgcn_readfirstlane(tid >> 6); (void)lane; (void)wave

template <int l> __device__ __forceinline__ void layer_body(const int lo, const int hi, LAS unsigned char* lds, const int wv0) {
        const int pb = 1 + 11 * l;
        if (IN(pb + 0)) { PHASE_ROOTS(); phase_norm(a, l, 0, R_ALL, (bf16*)(ws + WS_H), lane, wave, G, bid); SEAM(pb + 0); }
        if (IN(pb + 1)) {
            PHASE_ROOTS();
            pg8::Gemm g{(const pg8::bf16_t*)(ws + WS_H), (const pg8::bf16_t*)(ws + WS_WIN) + (size_t)l * INW * DM, R_ALL, INW, DM, 0, DM};
            pg8::StaticOrder S; S.init(R_ALL, INW, G, bid);
            pg8::EpiBf16<0> E{(pg8::bf16_t*)(ws + WS_PROJ), INW, nullptr, 0, 0, 1.f};
            pg8::gemm_phase<pg8::EpiBf16<0>, pg8::StaticOrder, true, true>(lds, g, S, E, tid);
            moe_conv_range(a, l == 0 ? MOE_SL0 : MOE_SL2, l == 0 ? MOE_SL1 : MOE_SL3, 650 - 2 * 256, lds, lane, wave, G, bid);
            SEAM(pb + 1);
        }
        if (IN(pb + 2)) {
            PHASE_ROOTS();
            qk_prep(a, l, (G - 1 - bid) * NTHR + tid, G * NTHR);
            for (int it = ((bid + G - 80) % G) * NWAVES + wave; it < 520; it += G * NWAVES) vt_item(a, it, lane);
            for (int it = bid; it < 1040; it += G) hgrn_stepA(a, l, it >> 2, it & 3, lds, lane, wave);
            { __syncthreads(); moe_conv_range(a, l == 0 ? MOE_SL3 : MOE_SL7, l == 0 ? MOE_SL4 : MOE_DEFER, 1040 - 4 * 256, lds, lane, wave, G, bid); }
            SEAM(pb + 2);
        }
        if (IN(pb + 3)) {
            PHASE_ROOTS();
            if (bid < 64) hgrn_stepB(a, bid, tid);
            {
                const int nu = (l == 0) ? 260 : 256, ng = (l == 0) ? 520 : 512;
                unsigned* qctr = (unsigned*)(ws + WS_CTL) + CW_QUEUE + 64 * l;
                volatile LAS unsigned* qslot = (volatile LAS unsigned*)(lds + MISC_OFF) + 16;
                for (;;) {
                    __syncthreads();
                    if (tid == 0) qslot[0] = __hip_atomic_fetch_add(qctr, 1u, RLX_AGENT);
                    __syncthreads();
                    const int it = __builtin_amdgcn_readfirstlane((int)qslot[0]);
                    if (it >= nu + ng) break;
                    if (it < nu) attn_unit(a, l, it, lds, tid, lane, wave);
                    else gmlp_unit_mma(a, l, (it - nu) >> 2, (it - nu) & 3, lds, tid, lane, wave);
                }
            }
            SEAM(pb + 3);
        }
        if (IN(pb + 4)) {
            PHASE_ROOTS();
            const int nit = (l == 0) ? 1040 : 1024;
            for (int it = bid; it < nit; it += G) hgrn_stepC(a, l, it >> 2, it & 3, lds, tid, lane, wave);
            if (l == 0) { __syncthreads(); moe_conv_range(a, MOE_SL4, MOE_SL5, 1040 - 4 * 256, lds, lane, wave, G, bid); }
            SEAM(pb + 4);
        }
        if (IN(pb + 5)) {
            PHASE_ROOTS();
            const float* modl = vec + VO_MOD + (l * 2 + 0) * 6144; const float* modc = vec + VO_MOD + (l * 2 + 1) * 6144;
            const int M = S_LAT;
            pg8::Gemm g{(const pg8::bf16_t*)(ws + WS_MIX), (const pg8::bf16_t*)(ws + WS_WOUT) + (size_t)l * DM * DM, M, DM, DM, 0, DM};
            pg8::StaticOrder S; S.init(M, DM, G, bid);
            if (l == 0) { pg8::EpiResidB<false> E{a->in[I_X], (pg8::bf16_t*)(ws + WS_XB), modl + 2048, DM};
                pg8::gemm_phase<pg8::EpiResidB<false>, pg8::StaticOrder, true, true>(lds, g, S, E, tid); }
            else { pg8::EpiResidB<true> E{ws + WS_XB, (pg8::bf16_t*)(ws + WS_XB), modl + 2048, DM};
                pg8::gemm_phase<pg8::EpiResidB<true>, pg8::StaticOrder, true, true>(lds, g, S, E, tid); }
            if (l == 0) {
                pg8::Gemm g2{(const pg8::bf16_t*)(ws + WS_MIX), (const pg8::bf16_t*)(ws + WS_WOUT), R_ALL, DM, 256, 0, DM};
                pg8::SplitKOrder S2{S_LAT / 256, 4, 4, 256, 16, bid, nullptr};
                pg8::EpiPart E2{(float*)(ws + WS_PART1), modc + 2048, S_LAT / 256, 256, DM};
                pg8::gemm_phase<pg8::EpiPart, pg8::SplitKOrder, false, true>(lds, g2, S2, E2, tid);
                moe_conv_range(a, MOE_SL5, MOE_SL6, 16, lds, lane, wave, G, bid);
            }
            SEAM(pb + 5);
        }
        if (l == 0) {
            if (IN(pb + 6)) { PHASE_ROOTS(); phase_norm(a, l, 1, R_ALL, (bf16*)(ws + WS_H), lane, wave, G, bid); SEAM(pb + 6); }
            if (IN(pb + 7)) {
                PHASE_ROOTS();
                pg8::Gemm g{(const pg8::bf16_t*)(ws + WS_H), (const pg8::bf16_t*)(ws + WS_WGU), R_ALL, 2 * FFN, DM, 0, DM};
                pg8::StaticOrder S; S.init(R_ALL, 2 * FFN, G, bid);
                pg8::EpiSwiGLU E{(pg8::bf16_t*)(ws + WS_HID), FFN, 1.0f};
                pg8::gemm_phase<pg8::EpiSwiGLU, pg8::StaticOrder, true, true>(lds, g, S, E, tid);
                moe_conv_range(a, MOE_SL1, MOE_SL2, 1430 - 5 * 256, lds, lane, wave, G, bid);
                SEAM(pb + 7);
            }
            if (IN(pb + 8)) {
                PHASE_ROOTS();
                const float* modl = vec + VO_MOD + (l * 2 + 0) * 6144; const float* modc = vec + VO_MOD + (l * 2 + 1) * 6144;
                pg8::Gemm g{(const pg8::bf16_t*)(ws + WS_HID), (const pg8::bf16_t*)(ws + WS_WD), S_LAT, DM, FFN, 0, FFN};
                pg8::StaticOrder S; S.init(S_LAT, DM, G, bid);
                pg8::EpiResidB<true> E{ws + WS_XB, (pg8::bf16_t*)(ws + WS_XB), modl + 5120, DM};
                pg8::gemm_phase<pg8::EpiResidB<true>, pg8::StaticOrder, true, true>(lds, g, S, E, tid);
                {
                    pg8::Gemm g2{(const pg8::bf16_t*)(ws + WS_HID), (const pg8::bf16_t*)(ws + WS_WD), R_ALL, DM, 256, 0, FFN};
                    pg8::SplitKOrder S2{S_LAT / 256, 4, 11, 256, 44, bid, nullptr};
                    pg8::EpiPart E2{(float*)(ws + WS_PART2), modc + 5120, S_LAT / 256, 256, DM};
                    pg8::gemm_phase<pg8::EpiPart, pg8::SplitKOrder, false, true>(lds, g2, S2, E2, tid);
                    moe_conv_range(a, MOE_SL6, MOE_SL7, 44, lds, lane, wave, G, bid);
                }
                if (IN(pb + 8) && IN(pb + 11)) GRIDBAR();
            }
        } else {
            if (IN(pb + 6)) { PHASE_ROOTS(); phase_norm_route(a, lds, tid, lane, wave, G, bid); SEAM(pb + 6); }
            if (IN(pb + 7)) { PHASE_ROOTS(); moe_gather(a, lds, tid, lane, wave, G, bid); SEAM(pb + 7); }
            if (IN(pb + 8)) {
                PHASE_ROOTS();
                const int* mi = (const int*)(ws + WS_VEC) + VO_MOE; const int nt = __builtin_amdgcn_readfirstlane(mi[0]);
                pg8::Gemm g{(const pg8::bf16_t*)(ws + WS_AS), (const pg8::bf16_t*)(ws + WS_MGU), nt * 256, 2 * EXD, DM / 2, (size_t)2 * EXD * DM, DM / 2};
                pg8::MoeOrder S; S.init(nt * 256, 2 * EXD, G, bid); S.load_bases(mi + 160);
                pg8::EpiSwiGLU8 E{(unsigned char*)(ws + WS_HIDM), EXD, 1.0f / (F8_WSCALE * F8_ASCALE), F8_HSCALE};
                pg8::gemm_phase<pg8::EpiSwiGLU8, pg8::MoeOrder, true, true, true>(lds, g, S, E, tid);
                SEAM(pb + 8);
            }
            if (IN(pb + 9)) {
                PHASE_ROOTS();
                const int* mi = (const int*)(ws + WS_VEC) + VO_MOE; const int nt = __builtin_amdgcn_readfirstlane(mi[0]); const int nm = nt < 128 ? nt : 128;
                pg8::Gemm g{(const pg8::bf16_t*)(ws + WS_HIDM), (const pg8::bf16_t*)(ws + WS_MD), nm * 256, DM, EXD / 2, (size_t)DM * EXD, EXD / 2};
                pg8::MoeOrder S; S.init(nm * 256, DM, G, bid); S.load_bases(mi + 160);
                pg8::EpiScaleBf16 E{(pg8::bf16_t*)(ws + WS_Y), DM, 1.0f / (F8_WSCALE * F8_HSCALE)};
                pg8::gemm_phase<pg8::EpiScaleBf16, pg8::MoeOrder, true, true, true>(lds, g, S, E, tid);
                if (nt > 128) {
                    pg8::Gemm g2{(const pg8::bf16_t*)(ws + WS_HIDM), (const pg8::bf16_t*)(ws + WS_MD), nt * 256, DM, 256, (size_t)DM * EXD, EXD / 2};
                    pg8::SplitKOrder S2{128, 4, 7, 256, (nt - 128) * 28, bid, mi + 16};
                    pg8::EpiAtomic E2{(float*)(ws + WS_YF), nullptr, 128, DM, 1.0f / (F8_WSCALE * F8_HSCALE)};
                    pg8::gemm_phase<pg8::EpiAtomic, pg8::SplitKOrder, false, true, true>(lds, g2, S2, E2, tid);
                }
                SEAM(pb + 9);
            }
            if (IN(pb + 10)) { PHASE_ROOTS(); moe_combine(a, lane, wave, G, bid); }
        }
    }
__global__ void __launch_bounds__(NTHR, 2) fwd_kernel(Args a_unused) {
    extern __shared__ __attribute__((aligned(16))) unsigned char lds_raw[];
    LAS unsigned char* lds = (LAS unsigned char*)lds_raw;
    const int tid0 = threadIdx.x;
    const int wv0 = __builtin_amdgcn_readfirstlane(tid0 >> 6);
    for (int u = tid0; u < (LDS_BYTES - LDSCTL_OFF) / 4; u += NTHR) ((LAS unsigned*)(lds + LDSCTL_OFF))[u] = 0u;
    __syncthreads();
    const int lo = KARGS()->ph_lo, hi = KARGS()->ph_hi;
    const bool fusedl = (hi - lo) > 1;
    if (fusedl) (void)xcd_barrier_post((unsigned*)(KARGS()->ws + WS_CTL) + CW_BAR, (volatile LAS unsigned*)(lds + MISC_OFF) + 8);
    if (IN(0)) { PHASE_ROOTS(); p0_prologue(a, lds, tid, lane, wave, G, bid); SEAM(0); }

    layer_body<0>(lo, hi, lds, wv0);
    layer_body<1>(lo, hi, lds, wv0);
}

extern "C" void kernel_launch(void* const* d_in, const int* in_sizes, int n_in, void* d_out, int out_size, void* d_ws, size_t ws_size, hipStream_t stream) {
    static int grid = 0;
    if (grid == 0) {
        if (n_in != 23 || in_sizes[0] != S_LAT * DM || out_size != S_LAT * DM || ws_size < WS_END) { fprintf(stderr, "kernel_launch: unexpected shapes / workspace (n_in %d, ws %zu, need %zu)\n", n_in, ws_size, (size_t)WS_END); grid = -1; return; }
        int dev = 0, cus = 0;
        if (hipGetDevice(&dev) != hipSuccess || hipDeviceGetAttribute(&cus, hipDeviceAttributeMultiprocessorCount, dev) != hipSuccess) { grid = -1; return; }
        if (hipFuncSetAttribute((const void*)fwd_kernel, hipFuncAttributeMaxDynamicSharedMemorySize, LDS_BYTES) != hipSuccess) { grid = -1; return; }
        int per_cu = 0;
        (void)hipOccupancyMaxActiveBlocksPerMultiprocessor(&per_cu, (const void*)fwd_kernel, NTHR, LDS_BYTES);
        (void)hipGetLastError();
        if (cus * NWAVES * 8 < S_LAT) { fprintf(stderr, "kernel_launch: needs at least %d compute units\n", S_LAT / (NWAVES * 8)); grid = -1; return; }
        grid = cus;
    }
    if (grid < 0) return;
    if (hipMemsetAsync((char*)d_ws + WS_CTL, 0, CTL_ZERO_BYTES, stream) != hipSuccess) return;
    Args a{};
    for (int i = 0; i < 23; ++i) a.in[i] = (const float*)d_in[i];
    a.out = (float*)d_out; a.ws = (unsigned char*)d_ws;
#if ONE_LAUNCH
    a.ph_lo = 0; a.ph_hi = NPH;
    hipLaunchKernelGGL(fwd_kernel, dim3(grid), dim3(NTHR), LDS_BYTES, stream, a);
#else
    for (int p = 0; p < NPH; ++p) {
        if (p == 10 || p == 11) continue;
        a.ph_lo = p; a.ph_hi = p + 1;
        hipLaunchKernelGGL(fwd_kernel, dim3(grid), dim3(NTHR), LDS_BYTES, stream, a);
    }
#endif
}
```

```cpp
#include <hip/hip_runtime.h>
#include <cstdio>
#include <cstdint>
#include <cmath>
#ifndef ONE_LAUNCH
#define ONE_LAUNCH 1
#endif
namespace pg8 {
#define PG8_LAS __attribute__((address_space(3)))
typedef unsigned short bf16_t;
typedef short bf16x8 __attribute__((ext_vector_type(8)));
typedef float f32x4 __attribute__((ext_vector_type(4)));
typedef unsigned u32x4 __attribute__((ext_vector_type(4)));
constexpr int BM = 256, BK = 64, HALF = 128, HTB = HALF * BK * 2  , STAGE_BYTES = 8 * HTB, NXCD = 8, WGM = 8;

__host__ __device__ __forceinline__ int lds_byte(int r, int c) { const int st = (r >> 4) * 2 + (c >> 5), rr = r & 15, cc = c & 31, ob = rr * 64 + cc * 2; return st * 1024 + (ob ^ (((ob >> 9) & 1) << 5)); }
__host__ __device__ __forceinline__ void stage_rc(int b, int& R, int& C) { const int st = b / 1024, sb = b % 1024, swz = sb ^ (((sb >> 9) & 1) << 5); R = (st >> 1) * 16 + swz / 64; C = (st & 1) * 32 + (swz % 64) / 2; }
__host__ __device__ __forceinline__ int perm32(int rho) { const int n = rho >> 4, i = rho & 15; return 8 * (i >> 2) + 4 * n + (i & 3); }

struct Unit { int pm, pn, eb, ko; };
struct Gemm { const bf16_t* A; const bf16_t* Bt; int M, N, K; size_t bstride; int ld; };

struct StaticOrder {
    int nM, nN, nwg, G, c;
    __host__ __device__ void init(int M, int N, int G_, int c_) { nM = M / BM; nN = N / BM; nwg = nM * nN; G = G_; c = c_; }
    __host__ __device__ bool next(int i, Unit& u) const {
        const long L = (long)i * G + c; if (L >= nwg) return false;
        int wgid = (int)L; { const int q = nwg / NXCD, r = nwg % NXCD, xcd = wgid % NXCD, off = wgid / NXCD; wgid = (xcd < r ? xcd * (q + 1) : r * (q + 1) + (xcd - r) * q) + off; }
        const int nig = WGM * nN, gid = wgid / nig, fm = gid * WGM, gsz = (nM - fm) < WGM ? (nM - fm) : WGM;
        u.pm = fm + ((wgid % nig) % gsz); u.pn = (wgid % nig) / gsz; u.eb = 0; u.ko = 0; return true;
    }
    __device__ __forceinline__ void a_ready(const Unit&) const {}
    __device__ __forceinline__ void done(const Unit&) const {}
};

__device__ __forceinline__ unsigned cvt_pk_bf16(float lo, float hi) { unsigned r; asm volatile("v_cvt_pk_bf16_f32 %0, %1, %2" : "=v"(r) : "v"(lo), "v"(hi)); return r; }
typedef float f32x2 __attribute__((ext_vector_type(2)));
__device__ __forceinline__ f32x2 gelu_pk(f32x2 v) {
    const f32x2 av = __builtin_elementwise_abs(v), d = av * 0.2316418882f + 1.0f;
    f32x2 t; t.x = __builtin_amdgcn_rcpf(d.x); t.y = __builtin_amdgcn_rcpf(d.y);
    f32x2 q = t * 0.5307027145f + (-0.7265760135f); q = q * t + 0.7107068705f; q = q * t + (-0.142248368f); q = q * t + 0.127414796f; q = q * t;
    const f32x2 s = (v * v) * (-0.72134752044f);
    f32x2 e; e.x = __builtin_amdgcn_exp2f(s.x); e.y = __builtin_amdgcn_exp2f(s.y);
    const f32x2 m = v * (q * e), r = v - m;
    f32x2 o; o.x = v.x < 0.f ? m.x : r.x; o.y = v.y < 0.f ? m.y : r.y; return o;
}

template <int ACT  > struct EpiBf16 {
    static constexpr bool PERM = true, AFTER_DRAIN = false; static_assert(ACT == 0 || ACT == 1, "EpiBf16: ACT is 0 (none) or 1 (gelu_pk)");
    bf16_t* O; int ldc; const float* bias; int split_cols; size_t split_stride; float scale0;
    __device__ __forceinline__ void operator()(const f32x4 (&acc)[2][2][4][2], const Unit& u, int wr, int wc, int fr, int fq) const {
        const int row0 = u.pm * BM + wr * 64 + fr; int colt = u.pn * BM; bf16_t* base = O;
        float sc = 1.f; if (split_cols) { const int t = colt / split_cols; base += (size_t)t * split_stride; colt -= t * split_cols; if (t == 0) sc = scale0; }
        const int col0 = colt + wc * 32 + 8 * fq, bcol0 = u.pn * BM + wc * 32 + 8 * fq;
        f32x4 bv[2][2];
#pragma unroll
        for (int bj = 0; bj < 2; ++bj)
#pragma unroll
            for (int n = 0; n < 2; ++n) bv[bj][n] = bias ? *(const f32x4*)(bias + bcol0 + bj * HALF + 4 * n) : (f32x4){0.f, 0.f, 0.f, 0.f};
#pragma unroll
        for (int ai = 0; ai < 2; ++ai)
#pragma unroll
            for (int m = 0; m < 4; ++m) { bf16_t* rowp = base + (size_t)(row0 + ai * HALF + m * 16) * ldc + col0;
#pragma unroll
                for (int bj = 0; bj < 2; ++bj) { f32x4 v0 = acc[ai][bj][m][0] + bv[bj][0], v1 = acc[ai][bj][m][1] + bv[bj][1];
                    if (ACT == 1) { f32x2 a = gelu_pk((f32x2){v0[0], v0[1]}), b = gelu_pk((f32x2){v0[2], v0[3]}), c = gelu_pk((f32x2){v1[0], v1[1]}), d = gelu_pk((f32x2){v1[2], v1[3]});
                        v0 = (f32x4){a.x, a.y, b.x, b.y}; v1 = (f32x4){c.x, c.y, d.x, d.y}; }
                    v0 = v0 * sc; v1 = v1 * sc; u32x4 w; w.x = cvt_pk_bf16(v0[0], v0[1]); w.y = cvt_pk_bf16(v0[2], v0[3]); w.z = cvt_pk_bf16(v1[0], v1[1]); w.w = cvt_pk_bf16(v1[2], v1[3]);
                    *(u32x4*)(rowp + bj * HALF) = w; } }
    }
};

__device__ __forceinline__ float silu_f(float x) { return x * __builtin_amdgcn_rcpf(1.0f + __builtin_amdgcn_exp2f(-1.4426950408889634f * x)); }
struct EpiResid {
    static constexpr bool PERM = false, AFTER_DRAIN = false;
    const float* base; float* out; const float* gate; const float* cbase; float* cout; const float* cgate; int mlat; int ldc;
    __device__ __forceinline__ void operator()(const f32x4 (&acc)[2][2][4][2], const Unit& u, int wr, int wc, int fr, int fq) const {
        const bool isc = u.pm >= mlat;
        const float* b = isc ? cbase : base; float* o = isc ? cout : out; const float* g = isc ? cgate : gate;
        const int row0 = (isc ? (u.pm - mlat) : u.pm) * BM + wr * 64 + fr, col0 = u.pn * BM + wc * 32 + 4 * fq;
        f32x4 gv[2][2];
#pragma unroll
        for (int bj = 0; bj < 2; ++bj)
#pragma unroll
            for (int n = 0; n < 2; ++n) gv[bj][n] = *(const f32x4*)(g + col0 + bj * HALF + n * 16);
#pragma unroll
        for (int ai = 0; ai < 2; ++ai)
#pragma unroll
            for (int m = 0; m < 4; ++m) { const size_t off = (size_t)(row0 + ai * HALF + m * 16) * ldc + col0;
#pragma unroll
                for (int bj = 0; bj < 2; ++bj)
#pragma unroll
                    for (int n = 0; n < 2; ++n) { const f32x4 bs = *(const f32x4*)(b + off + bj * HALF + n * 16); *(f32x4*)(o + off + bj * HALF + n * 16) = bs + gv[bj][n] * acc[ai][bj][m][n]; }
                if (m & 1) asm volatile("" ::: "memory"); }
    }
};
template <bool BFB> struct EpiResidB {
    static constexpr bool PERM = true, AFTER_DRAIN = false;
    const void* base; bf16_t* out; const float* gate; int ldc;
    __device__ __forceinline__ void operator()(const f32x4 (&acc)[2][2][4][2], const Unit& u, int wr, int wc, int fr, int fq) const {
        const int row0 = u.pm * BM + wr * 64 + fr, col0 = u.pn * BM + wc * 32 + 8 * fq;
        f32x4 gv[2][2];
#pragma unroll
        for (int bj = 0; bj < 2; ++bj)
#pragma unroll
            for (int n = 0; n < 2; ++n) gv[bj][n] = *(const f32x4*)(gate + col0 + bj * HALF + 4 * n);
#pragma unroll
        for (int ai = 0; ai < 2; ++ai)
#pragma unroll
            for (int m = 0; m < 4; ++m) { const size_t off = (size_t)(row0 + ai * HALF + m * 16) * ldc + col0;
#pragma unroll
                for (int bj = 0; bj < 2; ++bj) { f32x4 b0, b1;
                    if constexpr (BFB) { const u32x4 t = *(const u32x4*)((const bf16_t*)base + off + bj * HALF);
                        b0 = (f32x4){__builtin_bit_cast(float, t.x << 16), __builtin_bit_cast(float, t.x & 0xffff0000u), __builtin_bit_cast(float, t.y << 16), __builtin_bit_cast(float, t.y & 0xffff0000u)};
                        b1 = (f32x4){__builtin_bit_cast(float, t.z << 16), __builtin_bit_cast(float, t.z & 0xffff0000u), __builtin_bit_cast(float, t.w << 16), __builtin_bit_cast(float, t.w & 0xffff0000u)}; }
                    else { b0 = *(const f32x4*)((const float*)base + off + bj * HALF); b1 = *(const f32x4*)((const float*)base + off + bj * HALF + 4); }
                    const f32x4 v0 = b0 + gv[bj][0] * acc[ai][bj][m][0], v1 = b1 + gv[bj][1] * acc[ai][bj][m][1];
                    u32x4 w; w.x = cvt_pk_bf16(v0[0], v0[1]); w.y = cvt_pk_bf16(v0[2], v0[3]); w.z = cvt_pk_bf16(v1[0], v1[1]); w.w = cvt_pk_bf16(v1[2], v1[3]);
                    *(u32x4*)(out + off + bj * HALF) = w; }
                if (m & 1) asm volatile("" ::: "memory"); }
    }
};
struct EpiSwiGLU {
    static constexpr bool PERM = true, AFTER_DRAIN = false;
    bf16_t* O; int ldc; float ds;
    __device__ __forceinline__ void operator()(const f32x4 (&acc)[2][2][4][2], const Unit& u, int wr, int wc, int fr, int fq) const {
        const int row0 = u.pm * BM + wr * 64 + fr, col0 = u.pn * HALF + wc * 32 + 8 * fq;
#pragma unroll
        for (int ai = 0; ai < 2; ++ai)
#pragma unroll
            for (int m = 0; m < 4; ++m) { bf16_t* rowp = O + (size_t)(row0 + ai * HALF + m * 16) * ldc + col0;
                const f32x4 g0 = acc[ai][0][m][0] * ds, g1 = acc[ai][0][m][1] * ds, u0 = acc[ai][1][m][0] * ds, u1 = acc[ai][1][m][1] * ds;
                f32x4 h0, h1;
#pragma unroll
                for (int j = 0; j < 4; ++j) { h0[j] = silu_f(g0[j]) * u0[j]; h1[j] = silu_f(g1[j]) * u1[j]; }
                u32x4 w; w.x = cvt_pk_bf16(h0[0], h0[1]); w.y = cvt_pk_bf16(h0[2], h0[3]); w.z = cvt_pk_bf16(h1[0], h1[1]); w.w = cvt_pk_bf16(h1[2], h1[3]);
                *(u32x4*)rowp = w; }
    }
};
struct MoeOrder : StaticOrder {
    int tb[8];
    __device__ __forceinline__ void load_bases(const int* mi) {
#pragma unroll
        for (int e = 0; e < 8; ++e) tb[e] = __builtin_amdgcn_readfirstlane(mi[e]); }
    __device__ __forceinline__ int expert_of(int pm) const { int e = 0;
#pragma unroll
        for (int j = 0; j < 7; ++j) e += (pm >= tb[j]) ? 1 : 0;
        return e; }
    __device__ __forceinline__ bool next(int i, Unit& u) const { if (!StaticOrder::next(i, u)) return false; u.eb = expert_of(u.pm); return true; }
};

struct SplitKOrder {
    int pm0, nN, P, kp, total, c; const int* tile_e;
    __device__ __forceinline__ bool next(int i, Unit& u) const {
        if (i != 0 || c >= total) return false;
        const int p = c % P, t = c / P; u.pn = t % nN; u.pm = pm0 + t / nN; u.ko = p * kp; u.eb = tile_e ? __builtin_amdgcn_readfirstlane(tile_e[u.pm]) : 0; return true; }
    __device__ __forceinline__ void a_ready(const Unit&) const {}
    __device__ __forceinline__ void done(const Unit&) const {}
};
struct EpiPart {
    static constexpr bool PERM = false, AFTER_DRAIN = false;
    float* part; const float* scale; int pm_sub; int kp; int ldc;
    __device__ __forceinline__ void operator()(const f32x4 (&acc)[2][2][4][2], const Unit& u, int wr, int wc, int fr, int fq) const {
        float* o = part + (size_t)(u.ko / kp) * BM * ldc;
        const int row0 = (u.pm - pm_sub) * BM + wr * 64 + fr, col0 = u.pn * BM + wc * 32 + 4 * fq;
        f32x4 gv[2][2];
#pragma unroll
        for (int bj = 0; bj < 2; ++bj)
#pragma unroll
            for (int n = 0; n < 2; ++n) gv[bj][n] = *(const f32x4*)(scale + col0 + bj * HALF + n * 16);
#pragma unroll
        for (int ai = 0; ai < 2; ++ai)
#pragma unroll
            for (int m = 0; m < 4; ++m) { const size_t off = (size_t)(row0 + ai * HALF + m * 16) * ldc + col0;
#pragma unroll
                for (int bj = 0; bj < 2; ++bj)
#pragma unroll
                    for (int n = 0; n < 2; ++n) *(f32x4*)(o + off + bj * HALF + n * 16) = gv[bj][n] * acc[ai][bj][m][n]; }
    }
};
struct EpiAtomic {
    static constexpr bool PERM = false, AFTER_DRAIN = true;
    float* out; const float* scale; int pm_sub; int ldc; float ds;
    __device__ __forceinline__ void fused(f32x4 (&acc)[2][2][4][2], const Unit& u, int wr, int wc, int fr, int fq, PG8_LAS unsigned char* lds, int wid, int lane) const {
        PG8_LAS float* scr = (PG8_LAS float*)(lds + wid * 16384);
        const int rr = lane >> 5, cc = lane & 31;
#pragma unroll
        for (int ai = 0; ai < 2; ++ai)
#pragma unroll
            for (int bj = 0; bj < 2; ++bj) {
#pragma unroll
                for (int m = 0; m < 4; ++m)
#pragma unroll
                    for (int n = 0; n < 2; ++n) *(PG8_LAS f32x4*)(scr + (m * 16 + fr) * 36 + n * 16 + 4 * fq) = acc[ai][bj][m][n];
                asm volatile("s_waitcnt lgkmcnt(0)" ::: "memory");
                const int colg = u.pn * BM + bj * HALF + wc * 32 + cc; const float sc = (scale ? scale[colg] : 1.0f) * ds;
                float* op = out + (size_t)((u.pm - pm_sub) * BM + ai * HALF + wr * 64 + rr) * ldc + colg;
#pragma unroll 8
                for (int i = 0; i < 32; ++i) { const float v = scr[(2 * i + rr) * 36 + cc]; __hip_atomic_fetch_add(op + (size_t)(2 * i) * ldc, v * sc, __ATOMIC_RELAXED, __HIP_MEMORY_SCOPE_AGENT); }
                asm volatile("s_waitcnt lgkmcnt(0)" ::: "memory");
            }
    }
};

typedef int i32x4v __attribute__((ext_vector_type(4))); typedef int i32x8v __attribute__((ext_vector_type(8)));
struct FragB { bf16x8 k[2]; };
struct Frag8 { i32x8v v; };
template <bool F8> struct FragSel { typedef FragB type; };
template <> struct FragSel<true> { typedef Frag8 type; };
__device__ __forceinline__ void ld_frag(FragB& f, const PG8_LAS unsigned char* p) { f.k[0] = *(const PG8_LAS bf16x8*)p; f.k[1] = *(const PG8_LAS bf16x8*)(p + 1024); }
__device__ __forceinline__ void ld_frag(Frag8& f, const PG8_LAS unsigned char* p) { const i32x4v lo = *(const PG8_LAS i32x4v*)p, hi = *(const PG8_LAS i32x4v*)(p + 1024); f.v = __builtin_shufflevector(lo, hi, 0, 1, 2, 3, 4, 5, 6, 7); }
__device__ __forceinline__ f32x4 mma_frag(const FragB& b, const FragB& a, f32x4 c) { c = __builtin_amdgcn_mfma_f32_16x16x32_bf16(b.k[0], a.k[0], c, 0, 0, 0); return __builtin_amdgcn_mfma_f32_16x16x32_bf16(b.k[1], a.k[1], c, 0, 0, 0); }
__device__ __forceinline__ f32x4 mma_frag(const Frag8& b, const Frag8& a, f32x4 c) {
    asm volatile("v_mfma_scale_f32_16x16x128_f8f6f4 %0, %1, %2, %0, %3, %3 op_sel_hi:[0,0,0]" : "+v"(c) : "v"(b.v), "v"(a.v), "v"(0x7f7f7f7f));
    return c;
}

struct EpiSwiGLU8 {
    static constexpr bool PERM = true, AFTER_DRAIN = false;
    unsigned char* O; int ldc; float ds, hs;
    __device__ __forceinline__ void operator()(const f32x4 (&acc)[2][2][4][2], const Unit& u, int wr, int wc, int fr, int fq) const {
        const int row0 = u.pm * BM + wr * 64 + fr, col0 = u.pn * HALF + wc * 32 + 8 * fq;
        const float k1 = -1.4426950408889634f * ds, k2 = ds * ds * hs;
#pragma unroll
        for (int ai = 0; ai < 2; ++ai)
#pragma unroll
            for (int m = 0; m < 4; ++m) { unsigned char* rowp = O + (size_t)(row0 + ai * HALF + m * 16) * ldc + col0;
                const f32x4 g0 = acc[ai][0][m][0], g1 = acc[ai][0][m][1], u0 = acc[ai][1][m][0], u1 = acc[ai][1][m][1];
                float h[8];
#pragma unroll
                for (int j = 0; j < 4; ++j) {
                    h[j] = __builtin_amdgcn_fmed3f((g0[j] * u0[j]) * k2 * __builtin_amdgcn_rcpf(1.0f + __builtin_amdgcn_exp2f(g0[j] * k1)), -448.0f, 448.0f);
                    h[4 + j] = __builtin_amdgcn_fmed3f((g1[j] * u1[j]) * k2 * __builtin_amdgcn_rcpf(1.0f + __builtin_amdgcn_exp2f(g1[j] * k1)), -448.0f, 448.0f); }
                unsigned lo = 0u, hi = 0u;
                lo = __builtin_amdgcn_cvt_pk_fp8_f32(h[0], h[1], lo, false); lo = __builtin_amdgcn_cvt_pk_fp8_f32(h[2], h[3], lo, true);
                hi = __builtin_amdgcn_cvt_pk_fp8_f32(h[4], h[5], hi, false); hi = __builtin_amdgcn_cvt_pk_fp8_f32(h[6], h[7], hi, true);
                typedef unsigned u32x2 __attribute__((ext_vector_type(2)));
                *(u32x2*)rowp = (u32x2){lo, hi}; }
    }
};
struct EpiScaleBf16 {
    static constexpr bool PERM = true, AFTER_DRAIN = false;
    bf16_t* O; int ldc; float ds;
    __device__ __forceinline__ void operator()(const f32x4 (&acc)[2][2][4][2], const Unit& u, int wr, int wc, int fr, int fq) const {
        const int row0 = u.pm * BM + wr * 64 + fr, col0 = u.pn * BM + wc * 32 + 8 * fq;
#pragma unroll
        for (int ai = 0; ai < 2; ++ai)
#pragma unroll
            for (int m = 0; m < 4; ++m) { bf16_t* rowp = O + (size_t)(row0 + ai * HALF + m * 16) * ldc + col0;
#pragma unroll
                for (int bj = 0; bj < 2; ++bj) { const f32x4 v0 = acc[ai][bj][m][0] * ds, v1 = acc[ai][bj][m][1] * ds;
                    u32x4 w; w.x = cvt_pk_bf16(v0[0], v0[1]); w.y = cvt_pk_bf16(v0[2], v0[3]); w.z = cvt_pk_bf16(v1[0], v1[1]); w.w = cvt_pk_bf16(v1[2], v1[3]);
                    *(u32x4*)(rowp + bj * HALF) = w; } }
    }
};

template <class Epi, class Sched, bool ALIGN_EPI = false, bool SP2 = false, bool F8 = false>
__device__ __forceinline__ void gemm_phase(PG8_LAS unsigned char* lds, const Gemm g, const Sched& S, const Epi& E, int tid_in) {
    int tid_ = tid_in; asm volatile("" : "+v"(tid_));
    const int tid = tid_, wid = __builtin_amdgcn_readfirstlane(tid >> 6), lane = tid & 63, wr = wid >> 2, wc = wid & 3, fr = lane & 15, fq = lane >> 4;
    const int K = g.K, nt = K / BK, ld = g.ld;
    unsigned voffA[2], voffB[2];
#pragma unroll
    for (int i = 0; i < 2; ++i) { int R, C; stage_rc(tid * 16 + i * 8192, R, C); const int Rb = Epi::PERM ? ((R & ~31) + perm32(R & 31)) : R;
        voffA[i] = (unsigned)(R * ld + C) * 2u; voffB[i] = (unsigned)(Rb * ld + C) * 2u; }
    const size_t kstep = (size_t)(BK * 2);
    const size_t hstep = (size_t)HALF * ld * 2;
    const size_t tstep = 2 * hstep;
    const unsigned ldsw = (unsigned)wid * 1024u;
    const int aoff = lds_byte(wr * 64 + fr, fq * 8), boff = lds_byte(wc * 32 + fr, fq * 8);
#define PG8_SA(b, h) (((b) * 2 + (h)) * HTB)
#define PG8_SB(b, h) ((4 + (b) * 2 + (h)) * HTB)
#define PG8_STAGE(bufoff, gbase, voff) do { _Pragma("unroll") for (int _i = 0; _i < 2; ++_i) \
        __builtin_amdgcn_global_load_lds((const unsigned*)((const char*)(gbase) + (voff)[_i]), (PG8_LAS unsigned*)(lds + (bufoff) + ldsw + _i * 8192), 16, 0, 0); } while (0)
#define PG8_LDA(dst, b, h) do { _Pragma("unroll") for (int m = 0; m < 4; ++m) ld_frag(dst[m], lds + PG8_SA(b, h) + aoff + m * 2048); } while (0)
#define PG8_LDB(dst, b, h) do { _Pragma("unroll") for (int n = 0; n < 2; ++n) ld_frag(dst[n], lds + PG8_SB(b, h) + boff + n * 2048); } while (0)
#define PG8_MMA(ai, bj, At, Bt) do { __builtin_amdgcn_s_setprio(1); _Pragma("unroll") for (int m = 0; m < 4; ++m) _Pragma("unroll") for (int n = 0; n < 2; ++n) \
        acc[ai][bj][m][n] = mma_frag(Bt[n], At[m], acc[ai][bj][m][n]); __builtin_amdgcn_s_setprio(0); } while (0)
#define PG8_WAIT_V(n) asm volatile("s_waitcnt vmcnt(" #n ")" ::: "memory")
#define PG8_WAIT_L(n) asm volatile("s_waitcnt lgkmcnt(" #n ")" ::: "memory")
#define PG8_BAR __builtin_amdgcn_s_barrier()
#define PG8_SCHED __builtin_amdgcn_sched_barrier(0)
    Unit cur, nxt; int ui = 0;
    if (!S.next(0, cur)) return;
    float zacc = 0.f; asm volatile("" : "+v"(zacc));
    f32x4 acc[2][2][4][2];
#pragma unroll
    for (int a = 0; a < 2; ++a)
#pragma unroll
        for (int b = 0; b < 2; ++b)
#pragma unroll
            for (int m = 0; m < 4; ++m)
#pragma unroll
                for (int n = 0; n < 2; ++n) acc[a][b][m][n] = (f32x4){zacc, zacc, zacc, zacc};
    typedef typename FragSel<F8>::type Frag;
    Frag At[4], B0[2], B1[2];
    const char* cA = (const char*)g.A + (size_t)cur.pm * tstep + (size_t)cur.ko * 2; const char* cB = (const char*)g.Bt + (size_t)cur.eb * g.bstride + (size_t)cur.pn * tstep + (size_t)cur.ko * 2;
    S.a_ready(cur);
    if constexpr (SP2) {
        PG8_STAGE(PG8_SB(0, 0), cB, voffB); PG8_STAGE(PG8_SB(0, 1), cB + hstep, voffB); PG8_STAGE(PG8_SA(0, 0), cA, voffA); PG8_STAGE(PG8_SA(0, 1), cA + hstep, voffA);
        if (wr == 1) PG8_BAR;
        PG8_WAIT_V(2); PG8_BAR;
        PG8_STAGE(PG8_SB(1, 0), cB + kstep, voffB); PG8_STAGE(PG8_SA(1, 0), cA + kstep, voffA); PG8_STAGE(PG8_SB(1, 1), cB + hstep + kstep, voffB);
        PG8_WAIT_V(6); PG8_BAR;
    } else {
        PG8_STAGE(PG8_SB(0, 0), cB, voffB); PG8_STAGE(PG8_SA(0, 0), cA, voffA); PG8_STAGE(PG8_SB(0, 1), cB + hstep, voffB); PG8_STAGE(PG8_SA(0, 1), cA + hstep, voffA);
        if (wr == 1) PG8_BAR;
        PG8_WAIT_V(4); PG8_BAR;
        PG8_STAGE(PG8_SB(1, 0), cB + kstep, voffB); PG8_STAGE(PG8_SA(1, 0), cA + kstep, voffA); PG8_STAGE(PG8_SB(1, 1), cB + hstep + kstep, voffB);
        PG8_WAIT_V(6); PG8_BAR;
    }
    for (;;) {
        const bool has_next = S.next(ui + 1, nxt);
        const char* nA = has_next ? (const char*)g.A + (size_t)nxt.pm * tstep + (size_t)nxt.ko * 2 : cA; const char* nB = has_next ? (const char*)g.Bt + (size_t)nxt.eb * g.bstride + (size_t)nxt.pn * tstep + (size_t)nxt.ko * 2 : cB;
        for (int t = 0; t < nt; t += 2) {
            const bool last = (t == nt - 2);
            const char* a1 = cA + (size_t)(t + 1) * kstep;
            const char* a2 = last ? nA : cA + (size_t)(t + 2) * kstep; const char* b2 = last ? nB : cB + (size_t)(t + 2) * kstep;
            const char* a3 = a2 + kstep; const char* b3 = b2 + kstep;
            if (last && has_next) S.a_ready(nxt);
            if constexpr (SP2) {
            PG8_LDB(B0, 0, 0); PG8_LDB(B1, 0, 1); PG8_SCHED; PG8_LDA(At, 0, 0); PG8_STAGE(PG8_SA(1, 1), a1 + hstep, voffA);
            PG8_WAIT_V(8); PG8_WAIT_L(0); PG8_BAR; PG8_MMA(0, 0, At, B0); PG8_MMA(0, 1, At, B1); PG8_BAR; PG8_SCHED;
            PG8_LDA(At, 0, 1); PG8_STAGE(PG8_SB(0, 0), b2, voffB); PG8_STAGE(PG8_SB(0, 1), b2 + hstep, voffB); PG8_STAGE(PG8_SA(0, 0), a2, voffA);
            PG8_WAIT_V(8); PG8_WAIT_L(0); PG8_BAR; PG8_MMA(1, 0, At, B0); PG8_MMA(1, 1, At, B1); PG8_BAR; PG8_SCHED;
            PG8_LDB(B0, 1, 0); PG8_LDB(B1, 1, 1); PG8_SCHED; PG8_LDA(At, 1, 0); PG8_STAGE(PG8_SA(0, 1), a2 + hstep, voffA);
            PG8_WAIT_V(8); PG8_WAIT_L(0); PG8_BAR; PG8_MMA(0, 0, At, B0); PG8_MMA(0, 1, At, B1); PG8_BAR; PG8_SCHED;
            PG8_LDA(At, 1, 1); PG8_STAGE(PG8_SB(1, 0), b3, voffB); PG8_STAGE(PG8_SB(1, 1), b3 + hstep, voffB); PG8_STAGE(PG8_SA(1, 0), a3, voffA);
            PG8_WAIT_V(8); PG8_WAIT_L(0); PG8_BAR; PG8_MMA(1, 0, At, B0); PG8_MMA(1, 1, At, B1); PG8_BAR; PG8_SCHED;
            } else {
            PG8_LDB(B0, 0, 0); PG8_SCHED; PG8_LDA(At, 0, 0); PG8_STAGE(PG8_SA(1, 1), a1 + hstep, voffA);
            PG8_WAIT_L(8); PG8_BAR; PG8_WAIT_L(0); PG8_MMA(0, 0, At, B0); PG8_BAR; PG8_SCHED;
            PG8_LDB(B1, 0, 1); PG8_STAGE(PG8_SB(0, 0), b2, voffB);
            PG8_BAR; PG8_WAIT_L(0); PG8_MMA(0, 1, At, B1); PG8_BAR;
            PG8_LDA(At, 0, 1); PG8_STAGE(PG8_SA(0, 0), a2, voffA);
            PG8_BAR; PG8_WAIT_L(0); PG8_MMA(1, 0, At, B0); PG8_BAR; PG8_SCHED;
            PG8_STAGE(PG8_SB(0, 1), b2 + hstep, voffB);
            PG8_WAIT_V(6); PG8_BAR; PG8_MMA(1, 1, At, B1); PG8_BAR;
            PG8_LDB(B0, 1, 0); PG8_SCHED; PG8_LDA(At, 1, 0); PG8_STAGE(PG8_SA(0, 1), a2 + hstep, voffA);
            PG8_WAIT_L(8); PG8_BAR; PG8_WAIT_L(0); PG8_MMA(0, 0, At, B0); PG8_BAR; PG8_SCHED;
            PG8_LDB(B1, 1, 1); PG8_STAGE(PG8_SB(1, 0), b3, voffB);
            PG8_BAR; PG8_WAIT_L(0); PG8_MMA(0, 1, At, B1); PG8_BAR;
            PG8_LDA(At, 1, 1); PG8_STAGE(PG8_SA(1, 0), a3, voffA);
            PG8_BAR; PG8_WAIT_L(0); PG8_MMA(1, 0, At, B0); PG8_BAR; PG8_SCHED;
            PG8_STAGE(PG8_SB(1, 1), b3 + hstep, voffB);
            PG8_WAIT_V(6); PG8_BAR; PG8_MMA(1, 1, At, B1); PG8_BAR;
            }
        }
        if constexpr (ALIGN_EPI) { if (wr == 0) PG8_BAR; }
        if constexpr (F8) {
            asm volatile("s_nop 15\n\ts_nop 15" : "+v"(acc[1][1][0][0]), "+v"(acc[1][1][0][1]), "+v"(acc[1][1][1][0]), "+v"(acc[1][1][1][1]), "+v"(acc[1][1][2][0]), "+v"(acc[1][1][2][1]), "+v"(acc[1][1][3][0]), "+v"(acc[1][1][3][1])); }
        if constexpr (!Epi::AFTER_DRAIN) { E(acc, cur, wr, wc, fr, fq); S.done(cur); }
        if (!has_next) break;
#pragma unroll
        for (int a = 0; a < 2; ++a)
#pragma unroll
            for (int b = 0; b < 2; ++b)
#pragma unroll
                for (int m = 0; m < 4; ++m)
#pragma unroll
                    for (int n = 0; n < 2; ++n) acc[a][b][m][n] = (f32x4){zacc, zacc, zacc, zacc};
        cur = nxt; cA = nA; cB = nB; ++ui;
        if constexpr (ALIGN_EPI) { if (wr == 1) PG8_BAR; }
    }
    PG8_WAIT_V(0);
    if constexpr (!ALIGN_EPI) { if (wr == 0) PG8_BAR; }
    PG8_BAR;
    if constexpr (Epi::AFTER_DRAIN) { E.fused(acc, cur, wr, wc, fr, fq, lds, wid, lane); S.done(cur); }
#undef PG8_SA
#undef PG8_SB
#undef PG8_STAGE
#undef PG8_LDA
#undef PG8_LDB
#undef PG8_MMA
#undef PG8_WAIT_V
#undef PG8_WAIT_L
#undef PG8_BAR
#undef PG8_SCHED
}
}


constexpr int S_LAT = 16384, C_CTX = 256, R_ALL = S_LAT + C_CTX, DM = 1024;
constexpr int INW = 2560, FFN = 2816, EXD = 3584, NEXP = 8;
constexpr int COL_AQ = 0, COL_AK = 512, COL_AV = 640, COL_HQ = 768, COL_HFF = 1024, COL_HFB = 1280, COL_HI = 1536, COL_HG = 1792, COL_GU = 2048, COL_GV = 2304;
constexpr int MIX_AT = 0, MIX_HG = 512, MIX_GM = 768;
constexpr int MOE_MAXROWS = 34816;
constexpr float EPS = 1e-6f;
constexpr int NWAVES = 8, NTHR = 512;
constexpr int NPH = 23;

constexpr size_t MiB = 1u << 20;
constexpr size_t WS_CTL = 0, CTL_ZERO_BYTES = 1 * MiB;
constexpr size_t WS_VEC = 1 * MiB;
constexpr size_t WS_TOK = 2 * MiB;
constexpr size_t WS_WIN = 3 * MiB;
constexpr size_t WS_WOUT = 13 * MiB;
constexpr size_t WS_WGU = 17 * MiB;
constexpr size_t WS_WD = 28 * MiB;
constexpr size_t WS_MGU = 34 * MiB;
constexpr size_t WS_MD = 146 * MiB;
constexpr size_t WS_H = 202 * MiB;
constexpr size_t WS_PROJ = 235 * MiB;
constexpr size_t WS_MIX = 317 * MiB;
constexpr size_t WS_HGO = 350 * MiB;
constexpr size_t WS_CTXR = 383 * MiB;
constexpr size_t WS_HLT = WS_HGO;
constexpr size_t WS_HSP = 384 * MiB;
constexpr size_t WS_HDG = 402 * MiB;
constexpr size_t WS_VT = 403 * MiB;
constexpr size_t WS_HID = WS_PROJ;
constexpr size_t WS_AS = 202 * MiB;
constexpr size_t WS_HIDM = 270 * MiB;
constexpr size_t WS_H2B = 440 * MiB;
constexpr size_t WS_YF = WS_WIN;
constexpr size_t WS_Y = WS_MGU;
constexpr size_t WS_XB = 104 * MiB;
constexpr size_t WS_PART1 = 176 * MiB;
constexpr size_t WS_PART2 = 180 * MiB;
constexpr size_t WS_END = 508 * MiB;
static_assert(WS_HID + (size_t)R_ALL * FFN * 2 <= WS_HGO && WS_AS + (size_t)MOE_MAXROWS * DM * 2 <= WS_HIDM && WS_HIDM + (size_t)MOE_MAXROWS * EXD * 2 <= WS_END, "ws map");
static_assert(WS_PART1 >= WS_MD + (size_t)8 * DM * EXD && WS_PART1 + (size_t)4 * 256 * DM * 4 <= WS_PART2 && WS_PART2 + (size_t)11 * 256 * DM * 4 <= WS_H, "ws map 4");
static_assert(WS_XB >= WS_Y + (size_t)MOE_MAXROWS * DM * 2 && WS_XB >= WS_MGU + (size_t)8 * 2 * EXD * DM && WS_XB + (size_t)S_LAT * DM * 2 <= WS_MD, "ws map 3");
static_assert(WS_H2B >= WS_HIDM && WS_H2B + (size_t)S_LAT * DM * 2 <= WS_END && WS_H + (size_t)R_ALL * DM * 2 <= WS_PROJ && WS_PROJ + (size_t)R_ALL * INW * 2 <= WS_MIX && WS_MIX + (size_t)R_ALL * DM * 2 <= WS_HGO && WS_HGO + (size_t)2 * R_ALL * 256 * 4 <= WS_CTXR, "ws map 2");
constexpr int VO_MOD = 0;
constexpr int VO_ROPE = 32768;
constexpr int VO_MOE = 65536;
constexpr int CW_BAR = 4096;
constexpr int CW_QUEUE = 2048;
constexpr int CW_MOECNT = 1024;

constexpr int RING_BYTES = 131072;
constexpr int LDSCTL_OFF = 159744, MISC_OFF = LDSCTL_OFF + 320;
constexpr int LDS_BYTES = 163840;

#define GAS __attribute__((address_space(1)))
#define LAS __attribute__((address_space(3)))
typedef unsigned short bf16;
typedef unsigned v4u __attribute__((ext_vector_type(4)));
typedef unsigned v2u __attribute__((ext_vector_type(2)));
typedef float f32x4 __attribute__((ext_vector_type(4)));
typedef GAS unsigned gu32;
#define RLX_AGENT __ATOMIC_RELAXED, __HIP_MEMORY_SCOPE_AGENT
#define LDS_WAIT() asm volatile("s_waitcnt lgkmcnt(0)" ::: "memory")
typedef float f32x2_t __attribute__((ext_vector_type(2))); typedef __bf16 bf16x2_t __attribute__((ext_vector_type(2)));
__device__ __forceinline__ unsigned pk2(float lo, float hi) { const f32x2_t v = {lo, hi}; const bf16x2_t b = __builtin_convertvector(v, bf16x2_t); return __builtin_bit_cast(unsigned, b); }
__device__ __forceinline__ unsigned f2bf(float f) { return pk2(f, 0.f) & 0xffffu; }
__device__ __forceinline__ float bflo(unsigned w) { return __builtin_bit_cast(float, w << 16); }
__device__ __forceinline__ float bfhi(unsigned w) { return __builtin_bit_cast(float, w & 0xffff0000u); }
__device__ __forceinline__ float sigm1(float x) { return __builtin_amdgcn_rcpf(1.0f + __builtin_amdgcn_exp2f(-1.4426950408889634f * x)); }
__device__ __forceinline__ float silu1(float x) { return x * sigm1(x); }
__device__ __forceinline__ float gelu1(float x) { return 0.5f * x * (1.0f + erff(x * 0.70710678118654752f)); }
template <int X> __device__ __forceinline__ float sx(float v) { return __shfl_xor(v, X); }
__device__ __forceinline__ float sx32_add(float v) { return v + __shfl_xor(v, 32); }
__device__ __forceinline__ float sx32_max(float v) { return fmaxf(v, __shfl_xor(v, 32)); }
__device__ __forceinline__ float wave_sum(float v) { v += sx<1>(v); v += sx<2>(v); v += sx<4>(v); v += sx<8>(v); v += sx<16>(v); return sx32_add(v); }
__device__ __forceinline__ void unpack8(const v4u w, float* f) { f[0] = bflo(w.x); f[1] = bfhi(w.x); f[2] = bflo(w.y); f[3] = bfhi(w.y); f[4] = bflo(w.z); f[5] = bfhi(w.z); f[6] = bflo(w.w); f[7] = bfhi(w.w); }


__device__ __forceinline__ float clamp448(float x) { return fminf(fmaxf(x, -448.0f), 448.0f); }
__device__ __forceinline__ unsigned pk4_fp8(float a, float b, float c, float d) {
    unsigned w = 0u; w = __builtin_amdgcn_cvt_pk_fp8_f32(clamp448(a), clamp448(b), w, false); w = __builtin_amdgcn_cvt_pk_fp8_f32(clamp448(c), clamp448(d), w, true); return w; }
constexpr float F8_WSCALE = 128.0f;
constexpr float F8_ASCALE = 16.0f;
constexpr float F8_HSCALE = 8.0f;
#define XB_TMO      128
#define XB_XCNT(j)  (256  + 64 * (j))
#define XB_XSUB(j)  (1280 + 64 * (j))
#define XB_XGEN(j)  (2304 + 64 * (j))
#define XB_TOP      3328
#define XB_TOPGEN   3392
#define XCD_BAR_WORDS 3456
#define XB_SPIN_CAP (1u << 18)

__device__ __forceinline__ unsigned xb_ld(unsigned* p)              { return __hip_atomic_load(p, __ATOMIC_RELAXED, __HIP_MEMORY_SCOPE_AGENT); }
__device__ __forceinline__ unsigned xb_add(unsigned* p, unsigned v) { return __hip_atomic_fetch_add(p, v, __ATOMIC_RELAXED, __HIP_MEMORY_SCOPE_AGENT); }
__device__ __forceinline__ unsigned xb_xcc_id() { return (unsigned)__builtin_amdgcn_s_getreg((3 << 11) | 20) & 0xFu; }
#define XB_SPIN(cond, bar) do { unsigned _sp = 0; while (cond) { __builtin_amdgcn_s_sleep(1); \
    if ((++_sp & 255u) == 0u) { if (xb_ld(&(bar)[XB_TMO])) break; if (_sp > XB_SPIN_CAP) { atomicAdd(&(bar)[XB_TMO], 1u); break; } } } } while (0)

struct XcdBarrier {
    unsigned* bar; unsigned x;
    volatile LAS unsigned* st;
};

__device__ __forceinline__ XcdBarrier xcd_barrier_post(unsigned* bar, volatile LAS unsigned* st) {
    XcdBarrier b; b.bar = bar; b.x = xb_xcc_id(); b.st = st;
    if (threadIdx.x == 0) (void)xb_add(&bar[XB_XCNT(b.x)], 1u);
    return b;
}
__device__ __forceinline__ void xcd_barrier_complete(unsigned* bar, unsigned x, unsigned& nloc, unsigned& nx) {
    const unsigned G = gridDim.x * gridDim.y * gridDim.z;
    unsigned sum, cnt, mine, sp = 0u;
    for (;;) {
        sum = 0u; cnt = 0u; mine = 0u;
#pragma unroll
        for (unsigned j = 0; j < 16; ++j) { const unsigned c = xb_ld(&bar[XB_XCNT(j)]); sum += c; cnt += (c > 0u) ? 1u : 0u; mine = (j == x) ? c : mine; }
        if (sum == G) break;
        __builtin_amdgcn_s_sleep(1);
        if ((++sp & 255u) == 0u) { if (xb_ld(&bar[XB_TMO])) break; if (sp > XB_SPIN_CAP) { atomicAdd(&bar[XB_TMO], 1u); break; } }
    }
    nloc = mine > 0u ? mine : 1u; nx = cnt > 0u ? cnt : 1u;
}

__device__ __forceinline__ void xcd_barrier(const XcdBarrier& b, const int tid_in) {
    asm volatile("s_waitcnt vmcnt(0)" ::: "memory");
    __syncthreads();
    if (tid_in == 0) {
        unsigned* bar = b.bar;
        __builtin_amdgcn_s_waitcnt(0);
        unsigned nloc = b.st[0], nx = b.st[1];
        if (nloc == 0u) { xcd_barrier_complete(bar, b.x, nloc, nx); b.st[0] = nloc; b.st[1] = nx; }
        const unsigned old = xb_add(&bar[XB_XSUB(b.x)], 1u);
        const unsigned gen = old / nloc;
        if (old + 1u == (gen + 1u) * nloc) {
            __builtin_amdgcn_fence(__ATOMIC_RELEASE, "agent");
            asm volatile("s_waitcnt vmcnt(0)" ::: "memory");
            const unsigned og = xb_add(&bar[XB_TOP], 1u);
            const unsigned tg = og / nx;
            if (og + 1u == (tg + 1u) * nx) xb_add(&bar[XB_TOPGEN], 1u);
            else XB_SPIN(xb_ld(&bar[XB_TOPGEN]) == tg, bar);
            __builtin_amdgcn_fence(__ATOMIC_ACQUIRE, "agent");
            xb_add(&bar[XB_XGEN(b.x)], 1u);
            asm volatile("s_waitcnt vmcnt(0)" ::: "memory");
        } else {
            XB_SPIN(xb_ld(&bar[XB_XGEN(b.x)]) == gen, bar);
            __builtin_amdgcn_fence(__ATOMIC_ACQUIRE, "agent");
            asm volatile("s_waitcnt vmcnt(0)" ::: "memory");
        }
    }
    __syncthreads();
}


struct Args { const float* in[23]; float* out; unsigned char* ws; int ph_lo, ph_hi; };
typedef const __attribute__((address_space(4))) Args* KA;
#define KARGS() ({ KA p_ = (KA)__builtin_amdgcn_kernarg_segment_ptr(); asm volatile("" : "+s"(p_)); p_; })
enum { I_X = 0, I_C, I_CTX, I_CCTX, I_WADA, I_BADA, I_WIN, I_WOUT, I_QG, I_KG, I_SINK, I_HLB, I_HGAIN, I_GWS, I_GBS, I_GNG, I_FG, I_FU, I_FD, I_ROUTER, I_MG, I_MU, I_MDN };

__device__ __forceinline__ void transpose_item(const float* W, int K, int N, bf16* WT, int mode, LAS float* scr, int item, int lane) {
    const int nblk = N / 32, kb = item / nblk, nb = item % nblk, k0 = 64 * kb, n0 = 32 * nb;
    const float* wb = W + (size_t)k0 * N + n0; const int loff = (lane >> 5) * N + (lane & 31);
    float wv[32];
#pragma unroll
    for (int i = 0; i < 32; ++i) wv[i] = __builtin_nontemporal_load(wb + (size_t)(2 * i) * N + loff);
#pragma unroll
    for (int i = 0; i < 32; ++i) scr[(2 * i + (lane >> 5)) * 33 + (lane & 31)] = wv[i];
    LDS_WAIT(); asm volatile("" ::: "memory");
    const int c = lane & 7;
#pragma unroll
    for (int j = 0; j < 4; ++j) { const int n = (lane >> 3) + 8 * j; const LAS float* s = scr + (8 * c) * 33 + n;
        v4u o; o.x = pk2(s[0 * 33], s[1 * 33]); o.y = pk2(s[2 * 33], s[3 * 33]); o.z = pk2(s[4 * 33], s[5 * 33]); o.w = pk2(s[6 * 33], s[7 * 33]);
        const int ng = n0 + n; const int drow = (mode == 0) ? ng : (ng + 128 * (ng / 128) + (mode == 2 ? 128 : 0));
        *(GAS v4u*)(WT + (size_t)drow * K + k0 + 8 * c) = o; }
    LDS_WAIT(); asm volatile("" ::: "memory");
}
__device__ __forceinline__ void transpose_item8(const float* W, int K, int N, unsigned char* WT, int mode, LAS float* scr, int item, int lane) {
    const int nblk = N / 32, kb = item / nblk, nb = item % nblk, k0 = 64 * kb, n0 = 32 * nb;
    const float* wb = W + (size_t)k0 * N + n0; const int loff = (lane >> 5) * N + (lane & 31);
    float wv[32];
#pragma unroll
    for (int i = 0; i < 32; ++i) wv[i] = __builtin_nontemporal_load(wb + (size_t)(2 * i) * N + loff);
#pragma unroll
    for (int i = 0; i < 32; ++i) scr[(2 * i + (lane >> 5)) * 33 + (lane & 31)] = wv[i];
    LDS_WAIT(); asm volatile("" ::: "memory");
    const int c = lane & 7;
#pragma unroll
    for (int j = 0; j < 4; ++j) { const int n = (lane >> 3) + 8 * j; const LAS float* s = scr + (8 * c) * 33 + n;
        v2u o; o.x = pk4_fp8(s[0 * 33] * F8_WSCALE, s[1 * 33] * F8_WSCALE, s[2 * 33] * F8_WSCALE, s[3 * 33] * F8_WSCALE); o.y = pk4_fp8(s[4 * 33] * F8_WSCALE, s[5 * 33] * F8_WSCALE, s[6 * 33] * F8_WSCALE, s[7 * 33] * F8_WSCALE);
        const int ng = n0 + n; const int drow = (mode == 0) ? ng : (ng + 128 * (ng / 128) + (mode == 2 ? 128 : 0));
        *(GAS v2u*)(WT + (size_t)drow * K + k0 + 8 * c) = o; }
    LDS_WAIT(); asm volatile("" ::: "memory");
}
constexpr int MOE_ITEMS = 24 * 16 * 112;
constexpr int MOE_SL0 = 0, MOE_SL1 = 5376, MOE_SL2 = 10752, MOE_SL3 = 16128, MOE_SL4 = 19200, MOE_SL5 = 25344, MOE_SL6 = 29184, MOE_SL7 = 32576, MOE_DEFER = 34496;
__device__ __forceinline__ void moe_conv_item(KA a, int it, LAS float* scr, int lane) {
    constexpr int I_M = 16 * 112;
    unsigned char* ws = a->ws;
    const int idx = it / I_M, r = it % I_M;
    if (idx < 8) transpose_item8(a->in[I_MG] + (size_t)idx * DM * EXD, DM, EXD, (unsigned char*)(ws + WS_MGU) + (size_t)idx * 2 * EXD * DM, 1, scr, r, lane);
    else if (idx < 16) transpose_item8(a->in[I_MU] + (size_t)(idx - 8) * DM * EXD, DM, EXD, (unsigned char*)(ws + WS_MGU) + (size_t)(idx - 8) * 2 * EXD * DM, 2, scr, r, lane);
    else transpose_item8(a->in[I_MDN] + (size_t)(idx - 16) * EXD * DM, EXD, DM, (unsigned char*)(ws + WS_MD) + (size_t)(idx - 16) * DM * EXD, 0, scr, r, lane);
}
__device__ __forceinline__ void moe_conv_range(KA a, int lo, int hi, int first, LAS unsigned char* lds, int lane, int wave, int G, int bid) {
    if (bid < first) return;
    LAS float* scr = (LAS float*)(lds + wave * 8704);
    const int nw = (G - first) * NWAVES, w = (bid - first) * NWAVES + wave;
    for (int i = lo + w; i < hi; i += nw) moe_conv_item(a, i, scr, lane);
}
__device__ __forceinline__ void p0_prologue(KA a, LAS unsigned char* lds, int tid, int lane, int wave, int G, int bid) {
    unsigned char* ws = a->ws;
    LAS float* scr = (LAS float*)(lds + wave * 8704);
    const int gw = bid * NWAVES + wave, NGW = G * NWAVES;
    constexpr int I_IN = 16 * 80, I_OUT = 16 * 32, I_F = 16 * 88, I_FDN = 44 * 32, I_M = 16 * 112;
    constexpr int NIT = 2 * I_IN + 2 * I_OUT + 2 * I_F + I_FDN + 24 * I_M;
    for (int it0 = gw; it0 < NIT; it0 += NGW) {
        int it = it0;
        if (it < 2 * I_IN) { const int l = it / I_IN, r = it % I_IN; transpose_item(a->in[I_WIN] + (size_t)l * DM * INW, DM, INW, (bf16*)(ws + WS_WIN) + (size_t)l * INW * DM, 0, scr, r, lane); continue; } it -= 2 * I_IN;
        if (it < 2 * I_OUT) { const int l = it / I_OUT, r = it % I_OUT; transpose_item(a->in[I_WOUT] + (size_t)l * DM * DM, DM, DM, (bf16*)(ws + WS_WOUT) + (size_t)l * DM * DM, 0, scr, r, lane); continue; } it -= 2 * I_OUT;
        if (it < I_F) { transpose_item(a->in[I_FG], DM, FFN, (bf16*)(ws + WS_WGU), 1, scr, it, lane); continue; } it -= I_F;
        if (it < I_F) { transpose_item(a->in[I_FU], DM, FFN, (bf16*)(ws + WS_WGU), 2, scr, it, lane); continue; } it -= I_F;
        if (it < I_FDN) { transpose_item(a->in[I_FD], FFN, DM, (bf16*)(ws + WS_WD), 0, scr, it, lane); continue; } it -= I_FDN;
        if (it >= MOE_DEFER) moe_conv_item(a, it, scr, lane);
    }
    LAS float* sil = (LAS float*)(lds + 69632);
    LAS float* part = (LAS float*)(lds + 69632 + 8192);
    float* vec = (float*)(ws + WS_VEC);
    if (bid < 192) {
        for (int i = tid; i < 2048; i += NTHR) { const float v = (i < 1024) ? a->in[I_C][i] : a->in[I_CCTX][i - 1024]; sil[i] = silu1(v); }
        __syncthreads();
        for (int item = bid; item < 192; item += G) {
            const int l = item / 96, cb = item % 96, col = cb * 64 + lane;
            const float* w = a->in[I_WADA] + (size_t)l * DM * 6144 + col;
            float a0 = 0.f, a1 = 0.f;
#pragma unroll 1
            for (int k0 = wave * 128; k0 < wave * 128 + 128; k0 += 32) { float wv[32];
#pragma unroll
                for (int j = 0; j < 32; ++j) wv[j] = __builtin_nontemporal_load(&w[(size_t)(k0 + j) * 6144]);
#pragma unroll
                for (int j = 0; j < 32; ++j) { a0 += sil[k0 + j] * wv[j]; a1 += sil[1024 + k0 + j] * wv[j]; } }
            part[(wave * 2 + 0) * 64 + lane] = a0; part[(wave * 2 + 1) * 64 + lane] = a1;
            __syncthreads();
            if (wave == 0) { float s0 = 0.f, s1 = 0.f;
#pragma unroll
                for (int w8 = 0; w8 < 8; ++w8) { s0 += part[(w8 * 2 + 0) * 64 + lane]; s1 += part[(w8 * 2 + 1) * 64 + lane]; }
                const float b = a->in[I_BADA][l * 6144 + col];
                vec[VO_MOD + (l * 2 + 0) * 6144 + col] = s0 + b; vec[VO_MOD + (l * 2 + 1) * 6144 + col] = s1 + b; }
            __syncthreads();
        }
    }
    if (bid == G - 1) {
        for (int idx = tid; idx < 5120; idx += NTHR) {
            const int isc = idx >= 4096, j = isc ? idx - 4096 : idx, pos = j / 16, i = j % 16;
            const float inv = exp2f(-(float)i * 0.83048202372184059f);
            const float ang = (float)pos * inv;
            double r = (double)ang * 0.15915494309189535; r -= floor(r);
            const float rf = (float)r;
            const float cs = __builtin_amdgcn_cosf(rf), sn = __builtin_amdgcn_sinf(rf);
            float* t = vec + VO_ROPE + (isc ? 8192 : 0);
            const int n = isc ? 1024 : 4096;
            t[j] = cs; t[n + j] = sn;
        }
    }
}

template <bool STORE = true, bool BFX = false> __device__ __forceinline__ void norm_row(const void* xrow, const float* sc, const float* sh, bf16* orow, int lane, f32x4 (&h)[4]) {
    f32x4 v[4]; float s = 0.f;
    if constexpr (BFX) { const GAS v2u* xr = (const GAS v2u*)xrow + lane;
#pragma unroll
        for (int j = 0; j < 4; ++j) { const v2u t = xr[64 * j]; v[j] = (f32x4){bflo(t.x), bfhi(t.x), bflo(t.y), bfhi(t.y)}; } }
    else { const GAS f32x4* xr = (const GAS f32x4*)xrow + lane;
#pragma unroll
        for (int j = 0; j < 4; ++j) v[j] = xr[64 * j]; }
#pragma unroll
    for (int j = 0; j < 4; ++j) s += (v[j].x * v[j].x + v[j].y * v[j].y) + (v[j].z * v[j].z + v[j].w * v[j].w);
    const float rstd = __builtin_amdgcn_rsqf(wave_sum(s) * (1.0f / DM) + EPS);
    GAS v2u* o8 = (GAS v2u*)orow + lane;
#pragma unroll
    for (int j = 0; j < 4; ++j) { const f32x4 scv = *(const f32x4*)(sc + 4 * lane + 256 * j), shv = *(const f32x4*)(sh + 4 * lane + 256 * j);
        h[j] = v[j] * rstd * (scv + 1.0f) + shv;
        if constexpr (STORE) { v2u w; w.x = pk2(h[j].x, h[j].y); w.y = pk2(h[j].z, h[j].w); o8[64 * j] = w; } }
}
__device__ __forceinline__ void phase_norm(KA a, int l, int which, int nrows, bf16* H, int lane, int wave, int G, int bid) {
    const float* vec = (const float*)(a->ws + WS_VEC);
    const bool bfx = !(l == 0 && which == 0);
    const float* xl = a->in[I_X]; const bf16* xb = (const bf16*)(a->ws + WS_XB);
    const float* xc = (l == 0) ? a->in[I_CTX] : (const float*)(a->ws + WS_CTXR);
    const int nlat = nrows < S_LAT ? nrows : S_LAT;
    const float* ml = vec + VO_MOD + (l * 2 + 0) * 6144 + which * 3072;
    const float* mc = vec + VO_MOD + (l * 2 + 1) * 6144 + which * 3072;
    const int gw = bid * NWAVES + wave, NGW = G * NWAVES;
    f32x4 scl[4], shl[4], v[4];
#pragma unroll
    for (int j = 0; j < 4; ++j) { scl[j] = *(const f32x4*)(ml + 1024 + 4 * lane + 256 * j) + 1.0f; shl[j] = *(const f32x4*)(ml + 4 * lane + 256 * j); }
    if (gw < nlat) {
        if (bfx) { const GAS v2u* xr = (const GAS v2u*)(xb + (size_t)gw * DM) + lane;
#pragma unroll
            for (int j = 0; j < 4; ++j) { const v2u t = xr[64 * j]; v[j] = (f32x4){bflo(t.x), bfhi(t.x), bflo(t.y), bfhi(t.y)}; } }
        else { const GAS f32x4* xr = (const GAS f32x4*)(xl + (size_t)gw * DM) + lane;
#pragma unroll
            for (int j = 0; j < 4; ++j) v[j] = xr[64 * j]; } }
    for (int r = gw; r < nlat; r += NGW) {
        const int rn = r + NGW; f32x4 vn[4];
        if (rn < nlat) {
            if (bfx) { const GAS v2u* xr = (const GAS v2u*)(xb + (size_t)rn * DM) + lane;
#pragma unroll
                for (int j = 0; j < 4; ++j) { const v2u t = xr[64 * j]; vn[j] = (f32x4){bflo(t.x), bfhi(t.x), bflo(t.y), bfhi(t.y)}; } }
            else { const GAS f32x4* xr = (const GAS f32x4*)(xl + (size_t)rn * DM) + lane;
#pragma unroll
                for (int j = 0; j < 4; ++j) vn[j] = xr[64 * j]; } }
        float s = 0.f;
#pragma unroll
        for (int j = 0; j < 4; ++j) s += (v[j].x * v[j].x + v[j].y * v[j].y) + (v[j].z * v[j].z + v[j].w * v[j].w);
        const float rstd = __builtin_amdgcn_rsqf(wave_sum(s) * (1.0f / DM) + EPS);
        GAS v2u* o8 = (GAS v2u*)(H + (size_t)r * DM) + lane;
#pragma unroll
        for (int j = 0; j < 4; ++j) { const f32x4 h = v[j] * rstd * scl[j] + shl[j]; v2u w; w.x = pk2(h.x, h.y); w.y = pk2(h.z, h.w); o8[64 * j] = w; }
#pragma unroll
        for (int j = 0; j < 4; ++j) v[j] = vn[j];
    }
    const int npart = (l == 0 && which == 0) ? 0 : (l == 0 ? 4 : 11);
    const float* part = (const float*)(a->ws + (l == 0 ? WS_PART1 : WS_PART2));
    for (int r = S_LAT + (NGW - 1 - gw); r < nrows; r += NGW) {
        const int cr = r - S_LAT; f32x4 x[4];
        { const GAS f32x4* xr = (const GAS f32x4*)(xc + (size_t)cr * DM) + lane;
#pragma unroll
          for (int j = 0; j < 4; ++j) x[j] = xr[64 * j]; }
        for (int p = 0; p < npart; ++p) { const GAS f32x4* pr = (const GAS f32x4*)(part + ((size_t)p * 256 + cr) * DM) + lane;
#pragma unroll
            for (int j = 0; j < 4; ++j) x[j] = x[j] + pr[64 * j]; }
        if (npart && l == 0) { GAS f32x4* cw = (GAS f32x4*)((float*)(a->ws + WS_CTXR) + (size_t)cr * DM) + lane;
#pragma unroll
            for (int j = 0; j < 4; ++j) cw[64 * j] = x[j]; }
        float s = 0.f;
#pragma unroll
        for (int j = 0; j < 4; ++j) s += (x[j].x * x[j].x + x[j].y * x[j].y) + (x[j].z * x[j].z + x[j].w * x[j].w);
        const float rstd = __builtin_amdgcn_rsqf(wave_sum(s) * (1.0f / DM) + EPS);
        GAS v2u* o8 = (GAS v2u*)(H + (size_t)r * DM) + lane;
#pragma unroll
        for (int j = 0; j < 4; ++j) { const f32x4 scv = *(const f32x4*)(mc + 1024 + 4 * lane + 256 * j), shv = *(const f32x4*)(mc + 4 * lane + 256 * j);
            const f32x4 h = x[j] * rstd * (scv + 1.0f) + shv; v2u w; w.x = pk2(h.x, h.y); w.y = pk2(h.z, h.w); o8[64 * j] = w; }
    }
}
constexpr int ROUTE_ROWS_OFF = 36864;
__device__ __forceinline__ void phase_norm_route(KA a, LAS unsigned char* lds, int tid, int lane, int wave, int G, int bid) {
    const int l = 1;
    const float* vec = (const float*)(a->ws + WS_VEC);
    const float* ml = vec + VO_MOD + (l * 2 + 0) * 6144 + 3072;
    LAS float* rt = (LAS float*)lds;
    volatile LAS unsigned* lcnt = (volatile LAS unsigned*)(lds + 32768);
    for (int i = tid; i < 8192; i += NTHR) rt[i] = a->in[I_ROUTER][i];
    if (tid < 16) lcnt[tid] = 0u;
    __syncthreads();
    int* tokinfo = (int*)(a->ws + WS_TOK);
    unsigned* cnt = (unsigned*)(a->ws + WS_CTL) + CW_MOECNT;
    const int gw = bid * NWAVES + wave, NGW = G * NWAVES;
    unsigned keep = 0u, pk0 = 0u; int itn = 0;
    f32x4 scl[4], shl[4]; v2u nx[4];
#pragma unroll
    for (int j = 0; j < 4; ++j) { scl[j] = *(const f32x4*)(ml + 1024 + 4 * lane + 256 * j) + 1.0f; shl[j] = *(const f32x4*)(ml + 4 * lane + 256 * j); }
    if (gw < S_LAT) { const GAS v2u* xr = (const GAS v2u*)((const bf16*)(a->ws + WS_XB) + (size_t)gw * DM) + lane;
#pragma unroll
        for (int j = 0; j < 4; ++j) nx[j] = xr[64 * j]; }
    for (int r = gw; r < S_LAT; r += NGW) {
        f32x4 h[4];
        { v2u cu[4];
#pragma unroll
          for (int j = 0; j < 4; ++j) cu[j] = nx[j];
          if (r + NGW < S_LAT) { const GAS v2u* xr = (const GAS v2u*)((const bf16*)(a->ws + WS_XB) + (size_t)(r + NGW) * DM) + lane;
#pragma unroll
              for (int j = 0; j < 4; ++j) nx[j] = xr[64 * j]; }
          float s = 0.f;
#pragma unroll
          for (int j = 0; j < 4; ++j) { h[j] = (f32x4){bflo(cu[j].x), bfhi(cu[j].x), bflo(cu[j].y), bfhi(cu[j].y)}; s += (h[j].x * h[j].x + h[j].y * h[j].y) + (h[j].z * h[j].z + h[j].w * h[j].w); }
          const float rstd = __builtin_amdgcn_rsqf(wave_sum(s) * (1.0f / DM) + EPS);
#pragma unroll
          for (int j = 0; j < 4; ++j) h[j] = h[j] * rstd * scl[j] + shl[j]; }
#pragma unroll
        for (int j = 0; j < 4; ++j) ((LAS unsigned*)(lds + ROUTE_ROWS_OFF + wave * 8192 + itn * 1024))[lane + 64 * j] = pk4_fp8(h[j].x * F8_ASCALE, h[j].y * F8_ASCALE, h[j].z * F8_ASCALE, h[j].w * F8_ASCALE);
        float lg[8];
#pragma unroll
        for (int e = 0; e < 8; ++e) lg[e] = 0.f;
#pragma unroll
        for (int j = 0; j < 4; ++j)
#pragma unroll
            for (int i = 0; i < 4; ++i) { const int d = 4 * lane + 256 * j + i; const f32x4 r0 = *(const LAS f32x4*)(rt + d * 8), r1 = *(const LAS f32x4*)(rt + d * 8 + 4); const float hv = h[j][i];
                lg[0] += hv * r0.x; lg[1] += hv * r0.y; lg[2] += hv * r0.z; lg[3] += hv * r0.w; lg[4] += hv * r1.x; lg[5] += hv * r1.y; lg[6] += hv * r1.z; lg[7] += hv * r1.w; }
#pragma unroll
        for (int e = 0; e < 8; ++e) lg[e] = wave_sum(lg[e]);
        int i1 = 0; float v1 = lg[0];
#pragma unroll
        for (int e = 1; e < 8; ++e) if (lg[e] > v1) { v1 = lg[e]; i1 = e; }
        int i2 = -1; float v2 = -INFINITY;
#pragma unroll
        for (int e = 0; e < 8; ++e) if (e != i1 && lg[e] > v2) { v2 = lg[e]; i2 = e; }
        const float w1 = 1.0f / (1.0f + __expf(v2 - v1)), w2 = 1.0f - w1;
        if (lane == 0) {
            const unsigned r1 = __hip_atomic_fetch_add((LAS unsigned*)lcnt + i1, 1u, __ATOMIC_RELAXED, __HIP_MEMORY_SCOPE_WORKGROUP), r2 = __hip_atomic_fetch_add((LAS unsigned*)lcnt + i2, 1u, __ATOMIC_RELAXED, __HIP_MEMORY_SCOPE_WORKGROUP);
            int* ti = tokinfo + (size_t)r * 8;
            ti[0] = i1; ti[1] = i2; ti[4] = __builtin_bit_cast(int, w1); ti[5] = __builtin_bit_cast(int, w2);
            pk0 = (unsigned)i1 | ((unsigned)i2 << 3) | (r1 << 6) | (r2 << 19);
        }
        const unsigned pku = (unsigned)__builtin_amdgcn_readfirstlane((int)pk0);
        if (lane == itn) keep = pku;
        ++itn;
    }
    __syncthreads();
    if (tid < 8) lcnt[8 + tid] = __hip_atomic_fetch_add(cnt + 64 * tid, lcnt[tid], RLX_AGENT);
    __syncthreads();
    { const int r = gw + lane * NGW; if (lane < itn && r < S_LAT) { int* ti = tokinfo + (size_t)r * 8; const unsigned e1 = keep & 7u, e2 = (keep >> 3) & 7u; ti[2] = (int)(((keep >> 6) & 0x1fffu) + lcnt[8 + e1]); ti[3] = (int)((keep >> 19) + lcnt[8 + e2]); } }
}

__device__ __forceinline__ void qk_prep(KA a, int l, int first_thread, int nthreads) {
    bf16* PROJ = (bf16*)(a->ws + WS_PROJ);
    const float* rope = (const float*)(a->ws + WS_VEC) + VO_ROPE;
    for (int i = first_thread; i < R_ALL * 10; i += nthreads) {
        const int row = i / 10, hh = i % 10; const bool isq = hh < 8;
        bf16* p = PROJ + (size_t)row * INW + (isq ? hh * 64 : COL_AK + (hh - 8) * 64);
        const float* gain = (isq ? a->in[I_QG] : a->in[I_KG]) + l * 64;
        float x[64]; float ss = 0.f;
#pragma unroll
        for (int c = 0; c < 8; ++c) { const v4u w = *(const GAS v4u*)(p + 8 * c); unpack8(w, x + 8 * c); }
#pragma unroll
        for (int d = 0; d < 64; ++d) ss += x[d] * x[d];
        const float rstd = __builtin_amdgcn_rsqf(ss * (1.0f / 64.0f) + EPS);
        const f32x4* g4 = (const f32x4*)gain;
#pragma unroll
        for (int c = 0; c < 16; ++c) { const f32x4 gv = g4[c]; x[4 * c] *= rstd * gv.x; x[4 * c + 1] *= rstd * gv.y; x[4 * c + 2] *= rstd * gv.z; x[4 * c + 3] *= rstd * gv.w; }
        if (row < S_LAT) {
            const int gr = row >> 6, gc = row & 63;
            const f32x4* cr = (const f32x4*)(rope + gr * 16); const f32x4* sr = (const f32x4*)(rope + 4096 + gr * 16); const f32x4* cc = (const f32x4*)(rope + 8192 + gc * 16); const f32x4* sc = (const f32x4*)(rope + 8192 + 1024 + gc * 16);
#pragma unroll
            for (int j4 = 0; j4 < 4; ++j4) { const f32x4 cv = cr[j4], sv = sr[j4];
#pragma unroll
                for (int i = 0; i < 4; ++i) { const int j = 4 * j4 + i; const float x1 = x[j], x2 = x[16 + j]; x[j] = x1 * cv[i] - x2 * sv[i]; x[16 + j] = x1 * sv[i] + x2 * cv[i]; } }
#pragma unroll
            for (int j4 = 0; j4 < 4; ++j4) { const f32x4 cv = cc[j4], sv = sc[j4];
#pragma unroll
                for (int i = 0; i < 4; ++i) { const int j = 4 * j4 + i; const float x1 = x[32 + j], x2 = x[48 + j]; x[32 + j] = x1 * cv[i] - x2 * sv[i]; x[48 + j] = x1 * sv[i] + x2 * cv[i]; } }
        }
        const float qs = isq ? 0.125f * 1.4426950408889634f : 1.0f;
#pragma unroll
        for (int c = 0; c < 8; ++c) { v4u w; w.x = pk2(x[8 * c] * qs, x[8 * c + 1] * qs); w.y = pk2(x[8 * c + 2] * qs, x[8 * c + 3] * qs); w.z = pk2(x[8 * c + 4] * qs, x[8 * c + 5] * qs); w.w = pk2(x[8 * c + 6] * qs, x[8 * c + 7] * qs);
            *(GAS v4u*)(p + 8 * c) = w; }
    }
}
__device__ __forceinline__ void gmlp_unit(KA a, int l, int chunk, int g, LAS unsigned char* lds, int tid, int lane, int wave) {
    const bf16* PROJ = (const bf16*)(a->ws + WS_PROJ); bf16* MIX = (bf16*)(a->ws + WS_MIX);
    const int row0 = (chunk < 128) ? chunk * 128 : S_LAT + (chunk - 128) * 128;
    LAS float* vn = (LAS float*)lds;
    { const int pos = tid >> 2, part = tid & 3;
      const bf16* p = PROJ + (size_t)(row0 + pos) * INW + COL_GV + g * 64 + part * 16;
      float x[16]; unpack8(*(const GAS v4u*)p, x); unpack8(*(const GAS v4u*)(p + 8), x + 8);
      float ss = 0.f;
#pragma unroll
      for (int d = 0; d < 16; ++d) { x[d] = gelu1(x[d]); ss += x[d] * x[d]; }
      ss += sx<1>(ss); ss += sx<2>(ss);
      const float rstd = __builtin_amdgcn_rsqf(ss * (1.0f / 64.0f) + EPS);
      const float* gn = a->in[I_GNG] + l * 256 + g * 64 + part * 16;
#pragma unroll
      for (int d = 0; d < 16; ++d) vn[pos * 64 + part * 16 + d] = x[d] * rstd * gn[d]; }
    __syncthreads();
    const int c = lane, t0 = wave * 16;
    const float* W = a->in[I_GWS] + ((size_t)(l * 4 + g) * 128 + t0) * 128;
    float acc[16];
#pragma unroll
    for (int i = 0; i < 16; ++i) acc[i] = 0.f;
    for (int s = 0; s < 128; ++s) { const float v = vn[s * 64 + c];
#pragma unroll
        for (int i = 0; i < 16; ++i) acc[i] += W[i * 128 + s] * v; }
    const float* bs = a->in[I_GBS] + (l * 4 + g) * 128 + t0;
#pragma unroll
    for (int i = 0; i < 16; ++i) { const int row = row0 + t0 + i;
        const float u = gelu1(bflo((unsigned)PROJ[(size_t)row * INW + COL_GU + g * 64 + c]));
        MIX[(size_t)row * DM + MIX_GM + g * 64 + c] = (bf16)f2bf(u * (acc[i] + bs[i])); }
    __syncthreads();
}
__device__ __forceinline__ void hgrn_naive(KA a, int l, int dir, int head, LAS unsigned char* lds, int tid, int lane, int wave) {
    const bf16* PROJ = (const bf16*)(a->ws + WS_PROJ);
    float* HGO = (float*)(a->ws + WS_HGO) + (size_t)dir * R_ALL * 256;
    LAS float* Qs = (LAS float*)lds;
    LAS float* Fs = Qs + 4096; LAS float* Vs = Fs + 4096; LAS float* part = Vs + 4096;
    const int v = lane, kg = wave;
    float S[8];
#pragma unroll
    for (int i = 0; i < 8; ++i) S[i] = 0.f;
    const int tl = tid >> 3, c8 = tid & 7;
    float lb[8];
#pragma unroll
    for (int j = 0; j < 8; ++j) { float b = 0.f; if (l == 1) { const float p0 = a->in[I_HLB][dir * 512 + head * 64 + c8 * 8 + j], p1 = a->in[I_HLB][dir * 512 + 256 + head * 64 + c8 * 8 + j]; b = 1.0f / (1.0f + __expf(p0 - p1)); } lb[j] = b; }
    const int fcol = (dir == 0 ? COL_HFF : COL_HFB) + head * 64 + c8 * 8;
    for (int n0 = 0; n0 < R_ALL; n0 += 64) {
        { const int n = n0 + tl; int row;
          if (dir == 0) row = (n < C_CTX) ? S_LAT + n : n - C_CTX; else row = (n < C_CTX) ? S_LAT + (C_CTX - 1 - n) : (S_LAT - 1) - (n - C_CTX);
          const bf16* pr = PROJ + (size_t)row * INW;
          float q[8], f[8], vv[8];
          unpack8(*(const GAS v4u*)(pr + COL_HQ + head * 64 + c8 * 8), q); unpack8(*(const GAS v4u*)(pr + fcol), f); unpack8(*(const GAS v4u*)(pr + COL_HI + head * 64 + c8 * 8), vv);
#pragma unroll
          for (int j = 0; j < 8; ++j) { Qs[tl * 64 + c8 * 8 + j] = silu1(q[j]) * 0.125f; Fs[tl * 64 + c8 * 8 + j] = lb[j] + (1.0f - lb[j]) * sigm1(f[j]); Vs[tl * 64 + c8 * 8 + j] = vv[j]; } }
        __syncthreads();
        for (int t = 0; t < 64; ++t) {
            const float vt = Vs[t * 64 + v]; float po = 0.f;
#pragma unroll
            for (int i = 0; i < 8; ++i) { const float f = Fs[t * 64 + kg * 8 + i], q = Qs[t * 64 + kg * 8 + i]; S[i] = f * S[i] + (1.0f - f) * vt; po += S[i] * q; }
            part[((t & 1) * 8 + kg) * 64 + v] = po;
            __syncthreads();
            if (wave == 0) { float o = 0.f;
#pragma unroll
                for (int w8 = 0; w8 < 8; ++w8) o += part[((t & 1) * 8 + w8) * 64 + v];
                const int n = n0 + t; int row;
                if (dir == 0) row = (n < C_CTX) ? S_LAT + n : n - C_CTX; else row = (n < C_CTX) ? S_LAT + (C_CTX - 1 - n) : (S_LAT - 1) - (n - C_CTX);
                HGO[(size_t)row * 256 + head * 64 + v] = o; }
        }
        __syncthreads();
    }
}

typedef short bf16x8v __attribute__((ext_vector_type(8)));
constexpr int HST = 72;
__device__ __forceinline__ f32x4 mma16(const LAS bf16* MA, const LAS bf16* MBt, int k0, f32x4 c, int lane) {
    const bf16x8v av = *(const LAS bf16x8v*)(MA + (lane & 15) * HST + k0 + 8 * (lane >> 4));
    const bf16x8v bv = *(const LAS bf16x8v*)(MBt + (lane & 15) * HST + k0 + 8 * (lane >> 4));
    return __builtin_amdgcn_mfma_f32_16x16x32_bf16(av, bv, c, 0, 0, 0);
}
__device__ __forceinline__ int hg_base_row(int cpos) { return cpos < 256 ? 64 * cpos : S_LAT + 64 * (cpos - 256); }
__device__ __forceinline__ int hg_scan_idx(int dir, int cpos) { return dir == 0 ? (cpos < 256 ? 4 + cpos : cpos - 256) : (cpos < 256 ? 4 + (255 - cpos) : 3 - (cpos - 256)); }
__device__ __forceinline__ float hg_lb(KA a, int l, int dir, int head, int k) {
    if (l == 0) return 0.f;
    const float p0 = a->in[I_HLB][dir * 512 + head * 64 + k], p1 = a->in[I_HLB][dir * 512 + 256 + head * 64 + k];
    return 1.0f / (1.0f + __expf(p0 - p1));
}
__device__ __forceinline__ void hgrn_stepA(KA a, int l, int cpos, int head, LAS unsigned char* lds, int lane, int wave) {
    const bf16* PROJ = (const bf16*)(a->ws + WS_PROJ);
    const int dir = wave >> 2, I = wave & 3, base = hg_base_row(cpos), ci = hg_scan_idx(dir, cpos);
    LAS float* TOT = (LAS float*)lds;
    LAS bf16* KLT = (LAS bf16*)(lds + 2048) + dir * 64 * HST;
    LAS bf16* VT = (LAS bf16*)(lds + 2048 + 2 * 64 * HST * 2) + dir * 64 * HST;
    const float lb = hg_lb(a, l, dir, head, lane);
    const int fcol = (dir == 0 ? COL_HFF : COL_HFB) + head * 64 + lane, vcol = COL_HI + head * 64 + lane;
    float kk[16], cl[16]; float run = 0.f;
#pragma unroll
    for (int i = 0; i < 16; ++i) { const int n = 16 * I + i, row = base + (dir ? 63 - n : n);
        const float fl = bflo((unsigned)PROJ[(size_t)row * INW + fcol]);
        const unsigned short vb = PROJ[(size_t)row * INW + vcol];
        const float f = lb + (1.0f - lb) * sigm1(fl);
        run += __logf(f); cl[i] = run; kk[i] = 1.0f - f;
        VT[lane * HST + n] = vb; }
    TOT[(dir * 4 + I) * 64 + lane] = run;
    __syncthreads();
    float post = 0.f, all = 0.f;
#pragma unroll
    for (int J = 0; J < 4; ++J) { const float t = TOT[(dir * 4 + J) * 64 + lane]; all += t; if (J > I) post += t; }
#pragma unroll
    for (int i = 0; i < 16; ++i) KLT[lane * HST + 16 * I + i] = (bf16)f2bf(kk[i] * __expf(run - cl[i] + post));
    if (I == 0) ((float*)(a->ws + WS_HDG))[((size_t)(dir * 4 + head) * 260 + ci) * 64 + lane] = __expf(all);
    __syncthreads();
    float* LT = (float*)(a->ws + WS_HLT) + ((size_t)(dir * 4 + head) * 260 + ci) * 4096;
    float z0 = 0.f; asm volatile("" : "+v"(z0));
#pragma unroll
    for (int kb = 0; kb < 4; ++kb) { f32x4 acc = {z0, z0, z0, z0};
        acc = mma16(VT + 16 * I * HST, KLT + 16 * kb * HST, 0, acc, lane); acc = mma16(VT + 16 * I * HST, KLT + 16 * kb * HST, 32, acc, lane);
#pragma unroll
        for (int r = 0; r < 4; ++r) LT[(16 * I + 4 * (lane >> 4) + r) * 64 + 16 * kb + (lane & 15)] = acc[r]; }
    __syncthreads();
}
__device__ __forceinline__ void hgrn_stepB(KA a, int item, int tid) {
    const int dh = item >> 3, vb = item & 7, v = vb * 8 + (tid >> 6), k = tid & 63;
    const float* LT = (const float*)(a->ws + WS_HLT) + (size_t)dh * 260 * 4096 + v * 64 + k;
    const float* DG = (const float*)(a->ws + WS_HDG) + (size_t)dh * 260 * 64 + k;
    bf16* SP = (bf16*)(a->ws + WS_HSP) + (size_t)dh * 260 * 4096 + v * 64 + k;
    float S = 0.f;
#pragma unroll 1
    for (int c0 = 0; c0 < 260; c0 += 26) {
        float lt[26], dg[26];
#pragma unroll
        for (int j = 0; j < 26; ++j) { lt[j] = LT[(size_t)(c0 + j) * 4096]; dg[j] = DG[(c0 + j) * 64]; }
#pragma unroll
        for (int j = 0; j < 26; ++j) { SP[(size_t)(c0 + j) * 4096] = (bf16)f2bf(S); S = dg[j] * S + lt[j]; }
    }
}
__device__ __forceinline__ void hgrn_stepC(KA a, int l, int cpos, int head, LAS unsigned char* lds, int tid, int lane, int wave) {
    const bf16* PROJ = (const bf16*)(a->ws + WS_PROJ); bf16* MIX = (bf16*)(a->ws + WS_MIX);
    const int dir = wave >> 2, I = wave & 3, base = hg_base_row(cpos), ci = hg_scan_idx(dir, cpos);
    constexpr int MSZ = 64 * HST;
    LAS float* TOT = (LAS float*)lds;
    LAS bf16* img = (LAS bf16*)(lds + 2048);
    LAS bf16* QT = img + dir * MSZ;
    LAS bf16* QD = img + 2 * MSZ + dir * MSZ;
    LAS bf16* VT = img + 4 * MSZ + dir * MSZ;
    LAS bf16* ST = img + 6 * MSZ + dir * MSZ;
    LAS bf16* AS = img + 8 * MSZ + dir * MSZ + I * 16 * HST;
    LAS bf16* KT = img + 10 * MSZ + dir * (10 * 16 * HST);
    LAS float* OS = (LAS float*)(img + 10 * MSZ);
    const float lb = hg_lb(a, l, dir, head, lane);
    const int fcol = (dir == 0 ? COL_HFF : COL_HFB) + head * 64 + lane, qcol = COL_HQ + head * 64 + lane, vcol = COL_HI + head * 64 + lane;
    { const bf16* SP = (const bf16*)(a->ws + WS_HSP) + ((size_t)(dir * 4 + head) * 260 + ci) * 4096;
#pragma unroll
      for (int h2 = 0; h2 < 2; ++h2) { const int e = ((I * 2 + h2) * 64 + lane) * 8, vv = e >> 6, kk0 = e & 63;
          *(LAS v4u*)(ST + vv * HST + kk0) = *(const GAS v4u*)(SP + e); } }
    float kk[16], cl[16], qv[16]; float run = 0.f;
#pragma unroll
    for (int i = 0; i < 16; ++i) { const int n = 16 * I + i, row = base + (dir ? 63 - n : n);
        const float fl = bflo((unsigned)PROJ[(size_t)row * INW + fcol]), ql = bflo((unsigned)PROJ[(size_t)row * INW + qcol]);
        const unsigned short vb = PROJ[(size_t)row * INW + vcol];
        const float f = lb + (1.0f - lb) * sigm1(fl);
        run += __logf(f); cl[i] = run; kk[i] = 1.0f - f; qv[i] = silu1(ql) * 0.125f;
        VT[lane * HST + n] = vb; }
    TOT[(dir * 4 + I) * 64 + lane] = run;
    __syncthreads();
    float tj[4];
#pragma unroll
    for (int J = 0; J < 4; ++J) tj[J] = TOT[(dir * 4 + J) * 64 + lane];
    float pre = 0.f;
#pragma unroll
    for (int J = 0; J < 4; ++J) if (J < I) pre += tj[J];
    const float epre = __expf(pre); float kei[16];
#pragma unroll
    for (int i = 0; i < 16; ++i) { const float e = __expf(cl[i]); QT[(16 * I + i) * HST + lane] = (bf16)f2bf(qv[i] * e); QD[(16 * I + i) * HST + lane] = (bf16)f2bf(qv[i] * e * epre); kei[i] = kk[i] * fminf(__builtin_amdgcn_rcpf(e), 5.5e34f); }
    float eoff = 0.f;
#pragma unroll
    for (int I2 = 0; I2 < 4; ++I2) {
        if (I2 >= I) {
            if (I2 == I) eoff = 0.f; else if (I2 == I + 1) eoff = run; else eoff += tj[I2 - 1];
            LAS bf16* blk = KT + (I2 * (I2 + 1) / 2 + I) * 16 * HST;
            const float fo = __expf(eoff);
#pragma unroll
            for (int i = 0; i < 16; ++i) blk[i * HST + lane] = (bf16)f2bf(kei[i] * fo);
        }
    }
    __syncthreads();
    float z0 = 0.f; asm volatile("" : "+v"(z0));
    f32x4 sc[4];
#pragma unroll
    for (int J = 0; J < 4; ++J) { sc[J] = (f32x4){z0, z0, z0, z0};
        if (J <= I) { const LAS bf16* kb = KT + (I * (I + 1) / 2 + J) * 16 * HST;
            sc[J] = mma16(QT + 16 * I * HST, kb, 0, sc[J], lane); sc[J] = mma16(QT + 16 * I * HST, kb, 32, sc[J], lane);
            if (J == I) {
#pragma unroll
                for (int r = 0; r < 4; ++r) if ((lane & 15) > 4 * (lane >> 4) + r) sc[J][r] = z0; } } }
#pragma unroll
    for (int J = 0; J < 4; ++J)
#pragma unroll
        for (int r = 0; r < 4; ++r) AS[(4 * (lane >> 4) + r) * HST + 16 * J + (lane & 15)] = (bf16)f2bf(sc[J][r]);
    asm volatile("s_waitcnt lgkmcnt(0)" ::: "memory");
    f32x4 acc[4];
#pragma unroll
    for (int vb = 0; vb < 4; ++vb) { acc[vb] = (f32x4){z0, z0, z0, z0};
        acc[vb] = mma16(AS, VT + 16 * vb * HST, 0, acc[vb], lane); acc[vb] = mma16(AS, VT + 16 * vb * HST, 32, acc[vb], lane);
        acc[vb] = mma16(QD + 16 * I * HST, ST + 16 * vb * HST, 0, acc[vb], lane); acc[vb] = mma16(QD + 16 * I * HST, ST + 16 * vb * HST, 32, acc[vb], lane); }
    __syncthreads();
#pragma unroll
    for (int vb = 0; vb < 4; ++vb)
#pragma unroll
        for (int r = 0; r < 4; ++r) { const int n = 16 * I + 4 * (lane >> 4) + r, rl = dir ? 63 - n : n; OS[(dir * 64 + rl) * 68 + 16 * vb + (lane & 15)] = acc[vb][r]; }
    __syncthreads();
    { const int rl = tid >> 3, v8 = (tid & 7) * 8, row = base + rl;
      float o[8]; float ss = 0.f;
#pragma unroll
      for (int j = 0; j < 8; ++j) { o[j] = OS[rl * 68 + v8 + j] + OS[(64 + rl) * 68 + v8 + j]; ss += o[j] * o[j]; }
      ss += sx<1>(ss); ss += sx<2>(ss); ss += sx<4>(ss);
      const float rstd = __builtin_amdgcn_rsqf(ss * (1.0f / 64.0f) + EPS);
      float gt[8]; unpack8(*(const GAS v4u*)(PROJ + (size_t)row * INW + COL_HG + head * 64 + v8), gt);
      const float* gn = a->in[I_HGAIN] + l * 64 + v8;
      float y[8];
#pragma unroll
      for (int j = 0; j < 8; ++j) y[j] = o[j] * rstd * gn[j] * silu1(gt[j]);
      v4u w; w.x = pk2(y[0], y[1]); w.y = pk2(y[2], y[3]); w.z = pk2(y[4], y[5]); w.w = pk2(y[6], y[7]);
      *(GAS v4u*)(MIX + (size_t)row * DM + MIX_HG + head * 64 + v8) = w; }
    __syncthreads();
}

__device__ __forceinline__ void vt_item(KA a, int item, int lane) {
    const bf16* PROJ = (const bf16*)(a->ws + WS_PROJ); bf16* VTg = (bf16*)(a->ws + WS_VT);
    const int rb = item >> 1, hk = item & 1, row = rb * 64 + lane;
    const bf16* p = PROJ + (size_t)row * INW + COL_AV + hk * 64;
    unsigned w[32];
#pragma unroll
    for (int c = 0; c < 8; ++c) { const v4u t = *(const GAS v4u*)(p + 8 * c); w[4 * c] = t.x; w[4 * c + 1] = t.y; w[4 * c + 2] = t.z; w[4 * c + 3] = t.w; }
    bf16* o = VTg + (size_t)hk * 64 * R_ALL + row;
#pragma unroll
    for (int d2 = 0; d2 < 32; ++d2) { o[(size_t)(2 * d2) * R_ALL] = (bf16)(w[d2] & 0xffffu); o[(size_t)(2 * d2 + 1) * R_ALL] = (bf16)(w[d2] >> 16); }
}
__device__ __forceinline__ void attn_unit(KA a, int l, int u, LAS unsigned char* lds, int tid, int lane, int wave) {
    asm volatile("" : "+v"(tid), "+v"(lane));
    const bf16* PROJ = (const bf16*)(a->ws + WS_PROJ); const bf16* VTg = (const bf16*)(a->ws + WS_VT); bf16* MIX = (bf16*)(a->ws + WS_MIX);
    const bool isctx = u >= 256; const int uu = isctx ? u - 256 : u; const int n = uu >> 1, hk = uu & 1;
    const int qh = hk * 4 + (wave >> 1), half = wave & 1;
    const int qbase = (isctx ? S_LAT : 0) + n * 128 + half * 64, qpos0 = n * 128 + half * 64;
    const int c = lane & 15, g = lane >> 4;
    LAS bf16* Kt = (LAS bf16*)lds; LAS bf16* Vt = Kt + 64 * HST; LAS bf16* Qw = Vt + 64 * HST + wave * 64 * HST;
#pragma unroll
    for (int j = 0; j < 8; ++j) { const int qr = 8 * j + (lane >> 3), qc = (lane & 7) * 8;
        *(LAS v4u*)(Qw + qr * HST + qc) = *(const GAS v4u*)(PROJ + (size_t)(qbase + qr) * INW + qh * 64 + qc); }
    float z0 = 0.f; asm volatile("" : "+v"(z0));
    f32x4 o[4][4]; float ls[4];
    float gq = 0.f, gk = 0.f;
#pragma unroll 8
    for (int d = 0; d < 64; ++d) { gq = fmaxf(gq, fabsf(a->in[I_QG][l * 64 + d])); gk = fmaxf(gk, fabsf(a->in[I_KG][l * 64 + d])); }
    const float nbnd = -(8.0f * 1.4426950408889634f) * gq * gk;
    const f32x4 nb4 = {nbnd, nbnd, nbnd, nbnd};
    const float sink = a->in[I_SINK][l * 8 + qh] * 1.4426950408889634f;
#pragma unroll
    for (int qt = 0; qt < 4; ++qt) { ls[qt] = (g == 0) ? __builtin_amdgcn_exp2f(sink + nbnd) : z0;
#pragma unroll
        for (int dt = 0; dt < 4; ++dt) o[qt][dt] = (f32x4){z0, z0, z0, z0}; }
    const int first = (!isctx && n == 0) ? 2 : 0, nwin = isctx ? 0 : ((n == 0 || n == 127) ? 4 : 6), nt = nwin + 4;
    const int lr = tid >> 3, lc = (tid & 7) * 8;
    v4u kreg, vreg;
#define ATT_LOADT(i) do { const bool ct_ = (i) >= nwin; const int kb_ = ct_ ? S_LAT + 64 * ((i) - nwin) : (n - 1) * 128 + 64 * (first + (i)); \
        kreg = *(const GAS v4u*)(PROJ + (size_t)(kb_ + lr) * INW + COL_AK + hk * 64 + lc); vreg = *(const GAS v4u*)(VTg + ((size_t)hk * 64 + lr) * R_ALL + kb_ + lc); } while (0)
    ATT_LOADT(0);
#pragma unroll 1
    for (int i = 0; i < nt; ++i) {
        __syncthreads();
        *(LAS v4u*)(Kt + lr * HST + lc) = kreg; *(LAS v4u*)(Vt + lr * HST + lc) = vreg;
        __syncthreads();
        if (i + 1 < nt) ATT_LOADT(i + 1);
        const bool win = i < nwin; const int kb = (n - 1) * 128 + 64 * (first + i);
        const int rel = kb - qpos0;
        const bool maskw = win && (rel == 128 || rel == -128);
        if (win && (rel >= 192 || rel <= -192)) continue;
        bf16x8v kf[4][2], vf[4][2];
#pragma unroll
        for (int kt = 0; kt < 4; ++kt)
#pragma unroll
            for (int ks = 0; ks < 2; ++ks) kf[kt][ks] = *(const LAS bf16x8v*)(Kt + (16 * kt + c) * HST + 32 * ks + 8 * g);
#pragma unroll
        for (int dt = 0; dt < 4; ++dt)
#pragma unroll
            for (int s2 = 0; s2 < 2; ++s2) { const v2u lo = *(const LAS v2u*)(Vt + (16 * dt + c) * HST + 32 * s2 + 4 * g), hi = *(const LAS v2u*)(Vt + (16 * dt + c) * HST + 32 * s2 + 16 + 4 * g);
                const v4u t = {lo.x, lo.y, hi.x, hi.y}; vf[dt][s2] = __builtin_bit_cast(bf16x8v, t); }
        f32x4 sA[4], sB[4];
#define ATT_SCORES(QT, S_) do { const bf16x8v q0_ = *(const LAS bf16x8v*)(Qw + (16 * (QT) + c) * HST + 8 * g), q1_ = *(const LAS bf16x8v*)(Qw + (16 * (QT) + c) * HST + 32 + 8 * g); \
            _Pragma("unroll") for (int kt = 0; kt < 4; ++kt) { S_[kt] = __builtin_amdgcn_mfma_f32_16x16x32_bf16(kf[kt][0], q0_, nb4, 0, 0, 0); S_[kt] = __builtin_amdgcn_mfma_f32_16x16x32_bf16(kf[kt][1], q1_, S_[kt], 0, 0, 0); } } while (0)
#define ATT_REST(QT, S_) do { \
            if (maskw) { const int dq = qpos0 + 16 * (QT) + c - kb - 4 * g; \
                _Pragma("unroll") for (int kt = 0; kt < 4; ++kt) _Pragma("unroll") for (int r = 0; r < 4; ++r) { const int dl = dq - 16 * kt - r; if (dl > 128 || dl < -128) S_[kt][r] = -INFINITY; } } \
            float ps = 0.f; \
            _Pragma("unroll") for (int kt = 0; kt < 4; ++kt) _Pragma("unroll") for (int r = 0; r < 4; ++r) { S_[kt][r] = __builtin_amdgcn_exp2f(S_[kt][r]); ps += S_[kt][r]; } \
            ls[QT] += ps; \
            bf16x8v pb[2]; \
            _Pragma("unroll") for (int s2 = 0; s2 < 2; ++s2) { const v4u t = {pk2(S_[2 * s2][0], S_[2 * s2][1]), pk2(S_[2 * s2][2], S_[2 * s2][3]), pk2(S_[2 * s2 + 1][0], S_[2 * s2 + 1][1]), pk2(S_[2 * s2 + 1][2], S_[2 * s2 + 1][3])}; pb[s2] = __builtin_bit_cast(bf16x8v, t); } \
            _Pragma("unroll") for (int dt = 0; dt < 4; ++dt) { o[QT][dt] = __builtin_amdgcn_mfma_f32_16x16x32_bf16(vf[dt][0], pb[0], o[QT][dt], 0, 0, 0); o[QT][dt] = __builtin_amdgcn_mfma_f32_16x16x32_bf16(vf[dt][1], pb[1], o[QT][dt], 0, 0, 0); } } while (0)
        ATT_SCORES(0, sA);
        ATT_SCORES(1, sB); ATT_REST(0, sA);
        ATT_SCORES(2, sA); ATT_REST(1, sB);
        ATT_SCORES(3, sB); ATT_REST(2, sA);
        ATT_REST(3, sB);
#undef ATT_SCORES
#undef ATT_REST
    }
#undef ATT_LOADT
    int c2 = lane & 15, g2 = lane >> 4; asm volatile("" : "+v"(c2), "+v"(g2));
#pragma unroll
    for (int qt = 0; qt < 4; ++qt) { float lt = ls[qt]; lt += sx<16>(lt); lt = sx32_add(lt); const float inv = 1.0f / lt;
        bf16* op = (bf16*)(a->ws + WS_MIX) + (size_t)(qbase + 16 * qt + c2) * DM + MIX_AT + qh * 64 + 4 * g2;
#pragma unroll
        for (int dt = 0; dt < 4; ++dt) { v2u w; w.x = pk2(o[qt][dt][0] * inv, o[qt][dt][1] * inv); w.y = pk2(o[qt][dt][2] * inv, o[qt][dt][3] * inv); *(GAS v2u*)(op + 16 * dt) = w; } }
}

constexpr int GST = 136;
__device__ __forceinline__ f32x4 mma16g(const LAS bf16* MA, const LAS bf16* MBt, int k0, f32x4 c, int lane) {
    const bf16x8v av = *(const LAS bf16x8v*)(MA + (lane & 15) * GST + k0 + 8 * (lane >> 4));
    const bf16x8v bv = *(const LAS bf16x8v*)(MBt + (lane & 15) * GST + k0 + 8 * (lane >> 4));
    return __builtin_amdgcn_mfma_f32_16x16x32_bf16(av, bv, c, 0, 0, 0);
}
__device__ __forceinline__ float gelu_as(float v) {
    const float av = fabsf(v), t = __builtin_amdgcn_rcpf(av * 0.2316418882f + 1.0f);
    float q = t * 0.5307027145f + (-0.7265760135f); q = q * t + 0.7107068705f; q = q * t + (-0.142248368f); q = q * t + 0.127414796f; q = q * t;
    const float e = __builtin_amdgcn_exp2f((v * v) * (-0.72134752044f)), mm = v * (q * e);
    return v < 0.f ? mm : v - mm;
}
__device__ __forceinline__ void gmlp_unit_mma(KA a, int l, int chunk, int g, LAS unsigned char* lds, int tid, int lane, int wave) {
    const bf16* PROJ = (const bf16*)(a->ws + WS_PROJ); bf16* MIX = (bf16*)(a->ws + WS_MIX);
    const int row0 = (chunk < 128) ? chunk * 128 : S_LAT + (chunk - 128) * 128;
    LAS bf16* WA = (LAS bf16*)lds;
    LAS bf16* VNT = WA + 128 * GST;
    LAS float* OUT = (LAS float*)(VNT + 64 * GST);
    const int pos = tid >> 2, part = tid & 3;
    {
      const float* W = a->in[I_GWS] + ((size_t)(l * 4 + g) * 128 + pos) * 128 + part * 32;
#pragma unroll
      for (int j = 0; j < 4; ++j) { const f32x4 w0 = *(const GAS f32x4*)(W + 8 * j), w1 = *(const GAS f32x4*)(W + 8 * j + 4);
          v4u o; o.x = pk2(w0.x, w0.y); o.y = pk2(w0.z, w0.w); o.z = pk2(w1.x, w1.y); o.w = pk2(w1.z, w1.w);
          *(LAS v4u*)(WA + pos * GST + part * 32 + 8 * j) = o; } }
    { const bf16* p = PROJ + (size_t)(row0 + pos) * INW + COL_GV + g * 64 + part * 16;
      float x[16]; unpack8(*(const GAS v4u*)p, x); unpack8(*(const GAS v4u*)(p + 8), x + 8);
      float ss = 0.f;
#pragma unroll
      for (int d = 0; d < 16; ++d) { x[d] = gelu_as(x[d]); ss += x[d] * x[d]; }
      ss += sx<1>(ss); ss += sx<2>(ss);
      const float rstd = __builtin_amdgcn_rsqf(ss * (1.0f / 64.0f) + EPS);
      const float* gn = a->in[I_GNG] + l * 256 + g * 64 + part * 16;
#pragma unroll
      for (int d = 0; d < 16; ++d) VNT[(part * 16 + d) * GST + pos] = (bf16)f2bf(x[d] * rstd * gn[d]); }
    __syncthreads();
    float z0 = 0.f; asm volatile("" : "+v"(z0));
#pragma unroll
    for (int cb = 0; cb < 4; ++cb) { f32x4 acc = {z0, z0, z0, z0};
#pragma unroll
        for (int ks = 0; ks < 4; ++ks) acc = mma16g(WA + 16 * wave * GST, VNT + 16 * cb * GST, 32 * ks, acc, lane);
#pragma unroll
        for (int r = 0; r < 4; ++r) OUT[(16 * wave + 4 * (lane >> 4) + r) * 68 + 16 * cb + (lane & 15)] = acc[r]; }
    __syncthreads();
    { const int row = row0 + pos; const float bsv = a->in[I_GBS][(l * 4 + g) * 128 + pos];
      const bf16* pu = PROJ + (size_t)row * INW + COL_GU + g * 64 + part * 16;
      float u[16]; unpack8(*(const GAS v4u*)pu, u); unpack8(*(const GAS v4u*)(pu + 8), u + 8);
      float y[16];
#pragma unroll
      for (int d = 0; d < 16; ++d) y[d] = gelu_as(u[d]) * (OUT[pos * 68 + part * 16 + d] + bsv);
      bf16* po = MIX + (size_t)row * DM + MIX_GM + g * 64 + part * 16;
      v4u w; w.x = pk2(y[0], y[1]); w.y = pk2(y[2], y[3]); w.z = pk2(y[4], y[5]); w.w = pk2(y[6], y[7]); *(GAS v4u*)po = w;
      w.x = pk2(y[8], y[9]); w.y = pk2(y[10], y[11]); w.z = pk2(y[12], y[13]); w.w = pk2(y[14], y[15]); *(GAS v4u*)(po + 8) = w; }
    __syncthreads();
}
__device__ __forceinline__ void attn_naive(KA a, int l, int nrows, int lane, int wave, int G, int bid) {
    const bf16* PROJ = (const bf16*)(a->ws + WS_PROJ); bf16* MIX = (bf16*)(a->ws + WS_MIX);
    const int gw = bid * NWAVES + wave, NGW = G * NWAVES;
    for (int pair = gw; pair < nrows * 2; pair += NGW) {
        const int row = pair >> 1, hk = pair & 1; const bool isctx = row >= S_LAT;
        float q[4], o[4], m[4], ls[4];
#pragma unroll
        for (int g = 0; g < 4; ++g) { q[g] = bflo((unsigned)PROJ[(size_t)row * INW + (hk * 4 + g) * 64 + lane]); o[g] = 0.f; ls[g] = 1.0f; m[g] = a->in[I_SINK][l * 8 + hk * 4 + g] * 1.4426950408889634f; }
        int j0 = 0, j1 = -1;
        if (!isctx) { j0 = row - 128 < 0 ? 0 : row - 128; j1 = row + 128 > S_LAT - 1 ? S_LAT - 1 : row + 128; }
        const int nwin = j1 - j0 + 1;
        const int nk = nwin + C_CTX;
#pragma unroll 4
        for (int t = 0; t < nk; ++t) {
            const int krow = (t < nwin) ? j0 + t : S_LAT + (t - nwin);
            const float k = bflo((unsigned)PROJ[(size_t)krow * INW + COL_AK + hk * 64 + lane]);
            const float v = bflo((unsigned)PROJ[(size_t)krow * INW + COL_AV + hk * 64 + lane]);
#pragma unroll
            for (int g = 0; g < 4; ++g) { const float s = wave_sum(q[g] * k); const float mn = fmaxf(m[g], s);
                const float c = __builtin_amdgcn_exp2f(m[g] - mn), p = __builtin_amdgcn_exp2f(s - mn);
                ls[g] = ls[g] * c + p; o[g] = o[g] * c + p * v; m[g] = mn; }
        }
#pragma unroll
        for (int g = 0; g < 4; ++g) MIX[(size_t)row * DM + MIX_AT + (hk * 4 + g) * 64 + lane] = (bf16)f2bf(o[g] / ls[g]);
    }
}
__device__ __forceinline__ void hgrn_combine(KA a, int l, int nrows, int lane, int wave, int G, int bid) {
    const bf16* PROJ = (const bf16*)(a->ws + WS_PROJ); bf16* MIX = (bf16*)(a->ws + WS_MIX);
    const float* O0 = (const float*)(a->ws + WS_HGO); const float* O1 = O0 + (size_t)R_ALL * 256;
    const f32x4 gn = *(const f32x4*)(a->in[I_HGAIN] + l * 64 + (lane & 15) * 4);
    const int gw = bid * NWAVES + wave, NGW = G * NWAVES;
    for (int r = gw; r < nrows; r += NGW) {
        const f32x4 o = *(const GAS f32x4*)(O0 + (size_t)r * 256 + 4 * lane) + *(const GAS f32x4*)(O1 + (size_t)r * 256 + 4 * lane);
        float ss = (o.x * o.x + o.y * o.y) + (o.z * o.z + o.w * o.w);
        ss += sx<1>(ss); ss += sx<2>(ss); ss += sx<4>(ss); ss += sx<8>(ss);
        const float rstd = __builtin_amdgcn_rsqf(ss * (1.0f / 64.0f) + EPS);
        const v2u gw2 = *(const GAS v2u*)(PROJ + (size_t)r * INW + COL_HG + 4 * lane);
        const float g0 = bflo(gw2.x), g1 = bfhi(gw2.x), g2 = bflo(gw2.y), g3 = bfhi(gw2.y);
        v2u w; w.x = pk2(o.x * rstd * gn.x * silu1(g0), o.y * rstd * gn.y * silu1(g1)); w.y = pk2(o.z * rstd * gn.z * silu1(g2), o.w * rstd * gn.w * silu1(g3));
        *(GAS v2u*)(MIX + (size_t)r * DM + MIX_HG + 4 * lane) = w;
    }
}
__device__ __forceinline__ void moe_gather(KA a, LAS unsigned char* lds, int tid, int lane, int wave, int G, int bid) {
    LAS int* sb = (LAS int*)lds;
    const unsigned* cnt = (const unsigned*)(a->ws + WS_CTL) + CW_MOECNT;
    int* mi = (int*)(a->ws + WS_VEC) + VO_MOE;
    if (tid < 8) sb[16 + tid] = (int)__hip_atomic_load(cnt + 64 * tid, RLX_AGENT);
    __syncthreads();
    if (tid == 0) { int b = 0;
#pragma unroll
        for (int e = 0; e < 8; ++e) { sb[e] = b; b += ((sb[16 + e] + 255) >> 8) << 8; }
        sb[8] = b; }
    __syncthreads();
    if (bid == 0) {
        if (tid == 0) mi[0] = sb[8] >> 8;
        if (tid < 8) mi[160 + tid] = sb[tid + 1] >> 8;
        for (int t = tid; t < (sb[8] >> 8); t += NTHR) { int e = 0;
#pragma unroll
            for (int j = 1; j < 8; ++j) e += (t >= (sb[j] >> 8)) ? 1 : 0;
            mi[16 + t] = e; } }
    unsigned char* AS = (unsigned char*)(a->ws + WS_AS);
    const int* tokinfo = (const int*)(a->ws + WS_TOK); int* tokslot = (int*)(a->ws + WS_TOK) + S_LAT * 8;
    const int gw = bid * NWAVES + wave, NGW = G * NWAVES;
    int kq = 0;
    for (int t = gw; t < S_LAT; t += NGW, ++kq) {
        const int* ti = tokinfo + (size_t)t * 8;
        const int e1 = ti[0], e2 = ti[1], r1 = ti[2], r2 = ti[3];
        const int s1 = sb[e1] + r1, s2 = sb[e2] + r2;
        const v4u x0 = ((const LAS v4u*)(lds + ROUTE_ROWS_OFF + wave * 8192 + kq * 1024))[lane];
        ((GAS v4u*)(AS + (size_t)s1 * DM))[lane] = x0; ((GAS v4u*)(AS + (size_t)s2 * DM))[lane] = x0;
        if (lane == 0) { int* ts = tokslot + (size_t)t * 4; ts[0] = s1; ts[1] = s2; ts[2] = ti[4]; ts[3] = ti[5]; }
    }
    { const f32x4 z4 = {0.f, 0.f, 0.f, 0.f}; for (int i = bid * NTHR + tid; i < 8 * 256 * DM / 4; i += G * NTHR) ((GAS f32x4*)(a->ws + WS_YF))[i] = z4; }
    for (int e = 0; e < 8; ++e) { const int c = sb[16 + e], pe = (c + 255) & ~255, b = sb[e];
        for (int j = c + gw; j < pe; j += NGW) { const v4u z = {0u, 0u, 0u, 0u}; ((GAS v4u*)(AS + (size_t)(b + j) * DM))[lane] = z; } }
}
__device__ __forceinline__ void moe_combine(KA a, int lane, int wave, int G, int bid) {
    const float* gf = (const float*)(a->ws + WS_VEC) + VO_MOD + (1 * 2 + 0) * 6144 + 5 * 1024;
    const bf16* Y = (const bf16*)(a->ws + WS_Y); const int* tokslot = (const int*)(a->ws + WS_TOK) + S_LAT * 8; const float* YF = (const float*)(a->ws + WS_YF);
    const int gw = bid * NWAVES + wave, NGW = G * NWAVES;
    f32x4 gl[4];
#pragma unroll
    for (int j = 0; j < 4; ++j) gl[j] = *(const f32x4*)(gf + 4 * lane + 256 * j);
    int n0 = 0, n1 = 0, n2 = 0, n3 = 0;
    if (gw < S_LAT) { const int* ts = tokslot + (size_t)gw * 4; n0 = ts[0]; n1 = ts[1]; n2 = ts[2]; n3 = ts[3]; }
    for (int t = gw; t < S_LAT; t += NGW) {
        const int s1 = n0, s2 = n1; const float w1 = __builtin_bit_cast(float, n2), w2 = __builtin_bit_cast(float, n3);
        if (t + NGW < S_LAT) { const int* ts = tokslot + (size_t)(t + NGW) * 4; n0 = ts[0]; n1 = ts[1]; n2 = ts[2]; n3 = ts[3]; }
        GAS f32x4* xr = (GAS f32x4*)(a->out + (size_t)t * DM) + lane; const GAS v2u* xbr = (const GAS v2u*)((const bf16*)(a->ws + WS_XB) + (size_t)t * DM) + lane;
        v2u xt[4]; f32x4 p[4], q[4];
#pragma unroll
        for (int j = 0; j < 4; ++j) xt[j] = xbr[64 * j];
        if (s1 < 32768) { const GAS v2u* yr = (const GAS v2u*)(Y + (size_t)s1 * DM) + lane; v2u u[4];
#pragma unroll
            for (int j = 0; j < 4; ++j) u[j] = yr[64 * j];
#pragma unroll
            for (int j = 0; j < 4; ++j) p[j] = (f32x4){bflo(u[j].x), bfhi(u[j].x), bflo(u[j].y), bfhi(u[j].y)}; }
        else { const GAS f32x4* yr = (const GAS f32x4*)(YF + (size_t)(s1 - 32768) * DM) + lane;
#pragma unroll
            for (int j = 0; j < 4; ++j) p[j] = yr[64 * j]; }
        if (s2 < 32768) { const GAS v2u* yr = (const GAS v2u*)(Y + (size_t)s2 * DM) + lane; v2u u[4];
#pragma unroll
            for (int j = 0; j < 4; ++j) u[j] = yr[64 * j];
#pragma unroll
            for (int j = 0; j < 4; ++j) q[j] = (f32x4){bflo(u[j].x), bfhi(u[j].x), bflo(u[j].y), bfhi(u[j].y)}; }
        else { const GAS f32x4* yr = (const GAS f32x4*)(YF + (size_t)(s2 - 32768) * DM) + lane;
#pragma unroll
            for (int j = 0; j < 4; ++j) q[j] = yr[64 * j]; }
#pragma unroll
        for (int j = 0; j < 4; ++j) { f32x4 x = (f32x4){bflo(xt[j].x), bfhi(xt[j].x), bflo(xt[j].y), bfhi(xt[j].y)};
            x = x + gl[j] * (p[j] * w1 + q[j] * w2);
            __builtin_nontemporal_store(x, (f32x4*)(xr + 64 * j)); }
    }
}

#define IN(k) (lo <= (k) && (k) < hi)
#define GRIDBAR() do { XcdBarrier b2_; b2_.bar = (unsigned*)(KARGS()->ws + WS_CTL) + CW_BAR; b2_.x = xb_xcc_id(); b2_.st = (volatile LAS unsigned*)(lds + MISC_OFF) + 8; xcd_barrier(b2_, wv0 * 64 + (int)__builtin_amdgcn_mbcnt_hi(~0u, __builtin_amdgcn_mbcnt_lo(~0u, 0u))); } while (0)
#define SEAM(k) do { if (IN(k) && IN((k) + 1)) GRIDBAR(); } while (0)
#define PHASE_ROOTS() KA a = KARGS(); unsigned char* ws = a->ws; const float* vec = (const float*)(ws + WS_VEC); (void)vec; int bid = blockIdx.x, G = gridDim.x; asm volatile("" : "+s"(bid), "+s"(G)); int tid = wv0 * 64 + (int)__builtin_amdgcn_mbcnt_hi(~0u, __builtin_amdgcn_mbcnt_lo(~0u, 0u)); asm volatile("" : "+v"(tid)); const int lane = tid & 63, wave = __builtin_amdgcn_readfirstlane(tid >> 6); (void)lane; (void)wave

template <int l> __device__ __forceinline__ void layer_body(const int lo, const int hi, LAS unsigned char* lds, const int wv0) {
        const int pb = 1 + 11 * l;
        if (IN(pb + 0)) { PHASE_ROOTS(); phase_norm(a, l, 0, R_ALL, (bf16*)(ws + WS_H), lane, wave, G, bid); SEAM(pb + 0); }
        if (IN(pb + 1)) {
            PHASE_ROOTS();
            pg8::Gemm g{(const pg8::bf16_t*)(ws + WS_H), (const pg8::bf16_t*)(ws + WS_WIN) + (size_t)l * INW * DM, R_ALL, INW, DM, 0, DM};
            pg8::StaticOrder S; S.init(R_ALL, INW, G, bid);
            pg8::EpiBf16<0> E{(pg8::bf16_t*)(ws + WS_PROJ), INW, nullptr, 0, 0, 1.f};
            pg8::gemm_phase<pg8::EpiBf16<0>, pg8::StaticOrder, true, true>(lds, g, S, E, tid);
            moe_conv_range(a, l == 0 ? MOE_SL0 : MOE_SL2, l == 0 ? MOE_SL1 : MOE_SL3, 650 - 2 * 256, lds, lane, wave, G, bid);
            SEAM(pb + 1);
        }
        if (IN(pb + 2)) {
            PHASE_ROOTS();
            qk_prep(a, l, (G - 1 - bid) * NTHR + tid, G * NTHR);
            for (int it = ((bid + G - 80) % G) * NWAVES + wave; it < 520; it += G * NWAVES) vt_item(a, it, lane);
            for (int it = bid; it < 1040; it += G) hgrn_stepA(a, l, it >> 2, it & 3, lds, lane, wave);
            { __syncthreads(); moe_conv_range(a, l == 0 ? MOE_SL3 : MOE_SL7, l == 0 ? MOE_SL4 : MOE_DEFER, 1040 - 4 * 256, lds, lane, wave, G, bid); }
            SEAM(pb + 2);
        }
        if (IN(pb + 3)) {
            PHASE_ROOTS();
            if (bid < 64) hgrn_stepB(a, bid, tid);
            {
                const int nu = (l == 0) ? 260 : 256, ng = (l == 0) ? 520 : 512;
                unsigned* qctr = (unsigned*)(ws + WS_CTL) + CW_QUEUE + 64 * l;
                volatile LAS unsigned* qslot = (volatile LAS unsigned*)(lds + MISC_OFF) + 16;
                for (;;) {
                    __syncthreads();
                    if (tid == 0) qslot[0] = __hip_atomic_fetch_add(qctr, 1u, RLX_AGENT);
                    __syncthreads();
                    const int it = __builtin_amdgcn_readfirstlane((int)qslot[0]);
                    if (it >= nu + ng) break;
                    if (it < nu) attn_unit(a, l, it, lds, tid, lane, wave);
                    else gmlp_unit_mma(a, l, (it - nu) >> 2, (it - nu) & 3, lds, tid, lane, wave);
                }
            }
            SEAM(pb + 3);
        }
        if (IN(pb + 4)) {
            PHASE_ROOTS();
            const int nit = (l == 0) ? 1040 : 1024;
            for (int it = bid; it < nit; it += G) hgrn_stepC(a, l, it >> 2, it & 3, lds, tid, lane, wave);
            if (l == 0) { __syncthreads(); moe_conv_range(a, MOE_SL4, MOE_SL5, 1040 - 4 * 256, lds, lane, wave, G, bid); }
            SEAM(pb + 4);
        }
        if (IN(pb + 5)) {
            PHASE_ROOTS();
            const float* modl = vec + VO_MOD + (l * 2 + 0) * 6144; const float* modc = vec + VO_MOD + (l * 2 + 1) * 6144;
            const int M = S_LAT;
            pg8::Gemm g{(const pg8::bf16_t*)(ws + WS_MIX), (const pg8::bf16_t*)(ws + WS_WOUT) + (size_t)l * DM * DM, M, DM, DM, 0, DM};
            pg8::StaticOrder S; S.init(M, DM, G, bid);
            if (l == 0) { pg8::EpiResidB<false> E{a->in[I_X], (pg8::bf16_t*)(ws + WS_XB), modl + 2048, DM};
                pg8::gemm_phase<pg8::EpiResidB<false>, pg8::StaticOrder, true, true>(lds, g, S, E, tid); }
            else { pg8::EpiResidB<true> E{ws + WS_XB, (pg8::bf16_t*)(ws + WS_XB), modl + 2048, DM};
                pg8::gemm_phase<pg8::EpiResidB<true>, pg8::StaticOrder, true, true>(lds, g, S, E, tid); }
            if (l == 0) {
                pg8::Gemm g2{(const pg8::bf16_t*)(ws + WS_MIX), (const pg8::bf16_t*)(ws + WS_WOUT), R_ALL, DM, 256, 0, DM};
                pg8::SplitKOrder S2{S_LAT / 256, 4, 4, 256, 16, bid, nullptr};
                pg8::EpiPart E2{(float*)(ws + WS_PART1), modc + 2048, S_LAT / 256, 256, DM};
                pg8::gemm_phase<pg8::EpiPart, pg8::SplitKOrder, false, true>(lds, g2, S2, E2, tid);
                moe_conv_range(a, MOE_SL5, MOE_SL6, 16, lds, lane, wave, G, bid);
            }
            SEAM(pb + 5);
        }
        if (l == 0) {
            if (IN(pb + 6)) { PHASE_ROOTS(); phase_norm(a, l, 1, R_ALL, (bf16*)(ws + WS_H), lane, wave, G, bid); SEAM(pb + 6); }
            if (IN(pb + 7)) {
                PHASE_ROOTS();
                pg8::Gemm g{(const pg8::bf16_t*)(ws + WS_H), (const pg8::bf16_t*)(ws + WS_WGU), R_ALL, 2 * FFN, DM, 0, DM};
                pg8::StaticOrder S; S.init(R_ALL, 2 * FFN, G, bid);
                pg8::EpiSwiGLU E{(pg8::bf16_t*)(ws + WS_HID), FFN, 1.0f};
                pg8::gemm_phase<pg8::EpiSwiGLU, pg8::StaticOrder, true, true>(lds, g, S, E, tid);
                moe_conv_range(a, MOE_SL1, MOE_SL2, 1430 - 5 * 256, lds, lane, wave, G, bid);
                SEAM(pb + 7);
            }
            if (IN(pb + 8)) {
                PHASE_ROOTS();
                const float* modl = vec + VO_MOD + (l * 2 + 0) * 6144; const float* modc = vec + VO_MOD + (l * 2 + 1) * 6144;
                pg8::Gemm g{(const pg8::bf16_t*)(ws + WS_HID), (const pg8::bf16_t*)(ws + WS_WD), S_LAT, DM, FFN, 0, FFN};
                pg8::StaticOrder S; S.init(S_LAT, DM, G, bid);
                pg8::EpiResidB<true> E{ws + WS_XB, (pg8::bf16_t*)(ws + WS_XB), modl + 5120, DM};
                pg8::gemm_phase<pg8::EpiResidB<true>, pg8::StaticOrder, true, true>(lds, g, S, E, tid);
                {
                    pg8::Gemm g2{(const pg8::bf16_t*)(ws + WS_HID), (const pg8::bf16_t*)(ws + WS_WD), R_ALL, DM, 256, 0, FFN};
                    pg8::SplitKOrder S2{S_LAT / 256, 4, 11, 256, 44, bid, nullptr};
                    pg8::EpiPart E2{(float*)(ws + WS_PART2), modc + 5120, S_LAT / 256, 256, DM};
                    pg8::gemm_phase<pg8::EpiPart, pg8::SplitKOrder, false, true>(lds, g2, S2, E2, tid);
                    moe_conv_range(a, MOE_SL6, MOE_SL7, 44, lds, lane, wave, G, bid);
                }
                if (IN(pb + 8) && IN(pb + 11)) GRIDBAR();
            }
        } else {
            if (IN(pb + 6)) { PHASE_ROOTS(); phase_norm_route(a, lds, tid, lane, wave, G, bid); SEAM(pb + 6); }
            if (IN(pb + 7)) { PHASE_ROOTS(); moe_gather(a, lds, tid, lane, wave, G, bid); SEAM(pb + 7); }
            if (IN(pb + 8)) {
                PHASE_ROOTS();
                const int* mi = (const int*)(ws + WS_VEC) + VO_MOE; const int nt = __builtin_amdgcn_readfirstlane(mi[0]);
                pg8::Gemm g{(const pg8::bf16_t*)(ws + WS_AS), (const pg8::bf16_t*)(ws + WS_MGU), nt * 256, 2 * EXD, DM / 2, (size_t)2 * EXD * DM, DM / 2};
                pg8::MoeOrder S; S.init(nt * 256, 2 * EXD, G, bid); S.load_bases(mi + 160);
                pg8::EpiSwiGLU8 E{(unsigned char*)(ws + WS_HIDM), EXD, 1.0f / (F8_WSCALE * F8_ASCALE), F8_HSCALE};
                pg8::gemm_phase<pg8::EpiSwiGLU8, pg8::MoeOrder, true, true, true>(lds, g, S, E, tid);
                SEAM(pb + 8);
            }
            if (IN(pb + 9)) {
                PHASE_ROOTS();
                const int* mi = (const int*)(ws + WS_VEC) + VO_MOE; const int nt = __builtin_amdgcn_readfirstlane(mi[0]); const int nm = nt < 128 ? nt : 128;
                pg8::Gemm g{(const pg8::bf16_t*)(ws + WS_HIDM), (const pg8::bf16_t*)(ws + WS_MD), nm * 256, DM, EXD / 2, (size_t)DM * EXD, EXD / 2};
                pg8::MoeOrder S; S.init(nm * 256, DM, G, bid); S.load_bases(mi + 160);
                pg8::EpiScaleBf16 E{(pg8::bf16_t*)(ws + WS_Y), DM, 1.0f / (F8_WSCALE * F8_HSCALE)};
                pg8::gemm_phase<pg8::EpiScaleBf16, pg8::MoeOrder, true, true, true>(lds, g, S, E, tid);
                if (nt > 128) {
                    pg8::Gemm g2{(const pg8::bf16_t*)(ws + WS_HIDM), (const pg8::bf16_t*)(ws + WS_MD), nt * 256, DM, 256, (size_t)DM * EXD, EXD / 2};
                    pg8::SplitKOrder S2{128, 4, 7, 256, (nt - 128) * 28, bid, mi + 16};
                    pg8::EpiAtomic E2{(float*)(ws + WS_YF), nullptr, 128, DM, 1.0f / (F8_WSCALE * F8_HSCALE)};
                    pg8::gemm_phase<pg8::EpiAtomic, pg8::SplitKOrder, false, true, true>(lds, g2, S2, E2, tid);
                }
                SEAM(pb + 9);
            }
            if (IN(pb + 10)) { PHASE_ROOTS(); moe_combine(a, lane, wave, G, bid); }
        }
    }
__global__ void __launch_bounds__(NTHR, 2) fwd_kernel(Args a_unused) {
    extern __shared__ __attribute__((aligned(16))) unsigned char lds_raw[];
    LAS unsigned char* lds = (LAS unsigned char*)lds_raw;
    const int tid0 = threadIdx.x;
    const int wv0 = __builtin_amdgcn_readfirstlane(tid0 >> 6);
    for (int u = tid0; u < (LDS_BYTES - LDSCTL_OFF) / 4; u += NTHR) ((LAS unsigned*)(lds + LDSCTL_OFF))[u] = 0u;
    __syncthreads();
    const int lo = KARGS()->ph_lo, hi = KARGS()->ph_hi;
    const bool fusedl = (hi - lo) > 1;
    if (fusedl) (void)xcd_barrier_post((unsigned*)(KARGS()->ws + WS_CTL) + CW_BAR, (volatile LAS unsigned*)(lds + MISC_OFF) + 8);
    if (IN(0)) { PHASE_ROOTS(); p0_prologue(a, lds, tid, lane, wave, G, bid); SEAM(0); }

    layer_body<0>(lo, hi, lds, wv0);
    layer_body<1>(lo, hi, lds, wv0);
}

extern "C" void kernel_launch(void* const* d_in, const int* in_sizes, int n_in, void* d_out, int out_size, void* d_ws, size_t ws_size, hipStream_t stream) {
    static int grid = 0;
    if (grid == 0) {
        if (n_in != 23 || in_sizes[0] != S_LAT * DM || out_size != S_LAT * DM || ws_size < WS_END) { fprintf(stderr, "kernel_launch: unexpected shapes / workspace (n_in %d, ws %zu, need %zu)\n", n_in, ws_size, (size_t)WS_END); grid = -1; return; }
        int dev = 0, cus = 0;
        if (hipGetDevice(&dev) != hipSuccess || hipDeviceGetAttribute(&cus, hipDeviceAttributeMultiprocessorCount, dev) != hipSuccess) { grid = -1; return; }
        if (hipFuncSetAttribute((const void*)fwd_kernel, hipFuncAttributeMaxDynamicSharedMemorySize, LDS_BYTES) != hipSuccess) { grid = -1; return; }
        int per_cu = 0;
        (void)hipOccupancyMaxActiveBlocksPerMultiprocessor(&per_cu, (const void*)fwd_kernel, NTHR, LDS_BYTES);
        (void)hipGetLastError();
        if (cus * NWAVES * 8 < S_LAT) { fprintf(stderr, "kernel_launch: needs at least %d compute units\n", S_LAT / (NWAVES * 8)); grid = -1; return; }
        grid = cus;
    }
    if (grid < 0) return;
    if (hipMemsetAsync((char*)d_ws + WS_CTL, 0, CTL_ZERO_BYTES, stream) != hipSuccess) return;
    Args a{};
    for (int i = 0; i < 23; ++i) a.in[i] = (const float*)d_in[i];
    a.out = (float*)d_out; a.ws = (unsigned char*)d_ws;
#if ONE_LAUNCH
    a.ph_lo = 0; a.ph_hi = NPH;
    hipLaunchKernelGGL(fwd_kernel, dim3(grid), dim3(NTHR), LDS_BYTES, stream, a);
#else
    for (int p = 0; p < NPH; ++p) {
        if (p == 10 || p == 11) continue;
        a.ph_lo = p; a.ph_hi = p + 1;
        hipLaunchKernelGGL(fwd_kernel, dim3(grid), dim3(NTHR), LDS_BYTES, stream, a);
    }
#endif
}
```

```cpp
#include <hip/hip_runtime.h>
#include <cstdio>
#include <cstdint>
#include <cmath>
#ifndef ONE_LAUNCH
#define ONE_LAUNCH 1
#endif
namespace pg8 {
#define PG8_LAS __attribute__((address_space(3)))
typedef unsigned short bf16_t;
typedef short bf16x8 __attribute__((ext_vector_type(8)));
typedef float f32x4 __attribute__((ext_vector_type(4)));
typedef unsigned u32x4 __attribute__((ext_vector_type(4)));
constexpr int BM = 256, BK = 64, HALF = 128, HTB = HALF * BK * 2  , STAGE_BYTES = 8 * HTB, NXCD = 8, WGM = 8;

__host__ __device__ __forceinline__ int lds_byte(int r, int c) { const int st = (r >> 4) * 2 + (c >> 5), rr = r & 15, cc = c & 31, ob = rr * 64 + cc * 2; return st * 1024 + (ob ^ (((ob >> 9) & 1) << 5)); }
__host__ __device__ __forceinline__ void stage_rc(int b, int& R, int& C) { const int st = b / 1024, sb = b % 1024, swz = sb ^ (((sb >> 9) & 1) << 5); R = (st >> 1) * 16 + swz / 64; C = (st & 1) * 32 + (swz % 64) / 2; }
__host__ __device__ __forceinline__ int perm32(int rho) { const int n = rho >> 4, i = rho & 15; return 8 * (i >> 2) + 4 * n + (i & 3); }

struct Unit { int pm, pn, eb, ko; };
struct Gemm { const bf16_t* A; const bf16_t* Bt; int M, N, K; size_t bstride; int ld; };

struct StaticOrder {
    int nM, nN, nwg, G, c;
    __host__ __device__ void init(int M, int N, int G_, int c_) { nM = M / BM; nN = N / BM; nwg = nM * nN; G = G_; c = c_; }
    __host__ __device__ bool next(int i, Unit& u) const {
        const long L = (long)i * G + c; if (L >= nwg) return false;
        int wgid = (int)L; { const int q = nwg / NXCD, r = nwg % NXCD, xcd = wgid % NXCD, off = wgid / NXCD; wgid = (xcd < r ? xcd * (q + 1) : r * (q + 1) + (xcd - r) * q) + off; }
        const int nig = WGM * nN, gid = wgid / nig, fm = gid * WGM, gsz = (nM - fm) < WGM ? (nM - fm) : WGM;
        u.pm = fm + ((wgid % nig) % gsz); u.pn = (wgid % nig) / gsz; u.eb = 0; u.ko = 0; return true;
    }
    __device__ __forceinline__ void a_ready(const Unit&) const {}
    __device__ __forceinline__ void done(const Unit&) const {}
};

__device__ __forceinline__ unsigned cvt_pk_bf16(float lo, float hi) { unsigned r; asm volatile("v_cvt_pk_bf16_f32 %0, %1, %2" : "=v"(r) : "v"(lo), "v"(hi)); return r; }
typedef float f32x2 __attribute__((ext_vector_type(2)));
__device__ __forceinline__ f32x2 gelu_pk(f32x2 v) {
    const f32x2 av = __builtin_elementwise_abs(v), d = av * 0.2316418882f + 1.0f;
    f32x2 t; t.x = __builtin_amdgcn_rcpf(d.x); t.y = __builtin_amdgcn_rcpf(d.y);
    f32x2 q = t * 0.5307027145f + (-0.7265760135f); q = q * t + 0.7107068705f; q = q * t + (-0.142248368f); q = q * t + 0.127414796f; q = q * t;
    const f32x2 s = (v * v) * (-0.72134752044f);
    f32x2 e; e.x = __builtin_amdgcn_exp2f(s.x); e.y = __builtin_amdgcn_exp2f(s.y);
    const f32x2 m = v * (q * e), r = v - m;
    f32x2 o; o.x = v.x < 0.f ? m.x : r.x; o.y = v.y < 0.f ? m.y : r.y; return o;
}

template <int ACT  > struct EpiBf16 {
    static constexpr bool PERM = true, AFTER_DRAIN = false; static_assert(ACT == 0 || ACT == 1, "EpiBf16: ACT is 0 (none) or 1 (gelu_pk)");
    bf16_t* O; int ldc; const float* bias; int split_cols; size_t split_stride; float scale0;
    __device__ __forceinline__ void operator()(const f32x4 (&acc)[2][2][4][2], const Unit& u, int wr, int wc, int fr, int fq) const {
        const int row0 = u.pm * BM + wr * 64 + fr; int colt = u.pn * BM; bf16_t* base = O;
        float sc = 1.f; if (split_cols) { const int t = colt / split_cols; base += (size_t)t * split_stride; colt -= t * split_cols; if (t == 0) sc = scale0; }
        const int col0 = colt + wc * 32 + 8 * fq, bcol0 = u.pn * BM + wc * 32 + 8 * fq;
        f32x4 bv[2][2];
#pragma unroll
        for (int bj = 0; bj < 2; ++bj)
#pragma unroll
            for (int n = 0; n < 2; ++n) bv[bj][n] = bias ? *(const f32x4*)(bias + bcol0 + bj * HALF + 4 * n) : (f32x4){0.f, 0.f, 0.f, 0.f};
#pragma unroll
        for (int ai = 0; ai < 2; ++ai)
#pragma unroll
            for (int m = 0; m < 4; ++m) { bf16_t* rowp = base + (size_t)(row0 + ai * HALF + m * 16) * ldc + col0;
#pragma unroll
                for (int bj = 0; bj < 2; ++bj) { f32x4 v0 = acc[ai][bj][m][0] + bv[bj][0], v1 = acc[ai][bj][m][1] + bv[bj][1];
                    if (ACT == 1) { f32x2 a = gelu_pk((f32x2){v0[0], v0[1]}), b = gelu_pk((f32x2){v0[2], v0[3]}), c = gelu_pk((f32x2){v1[0], v1[1]}), d = gelu_pk((f32x2){v1[2], v1[3]});
                        v0 = (f32x4){a.x, a.y, b.x, b.y}; v1 = (f32x4){c.x, c.y, d.x, d.y}; }
                    v0 = v0 * sc; v1 = v1 * sc; u32x4 w; w.x = cvt_pk_bf16(v0[0], v0[1]); w.y = cvt_pk_bf16(v0[2], v0[3]); w.z = cvt_pk_bf16(v1[0], v1[1]); w.w = cvt_pk_bf16(v1[2], v1[3]);
                    *(u32x4*)(rowp + bj * HALF) = w; } }
    }
};

__device__ __forceinline__ float silu_f(float x) { return x * __builtin_amdgcn_rcpf(1.0f + __builtin_amdgcn_exp2f(-1.4426950408889634f * x)); }
struct EpiResid {
    static constexpr bool PERM = false, AFTER_DRAIN = false;
    const float* base; float* out; const float* gate; const float* cbase; float* cout; const float* cgate; int mlat; int ldc;
    __device__ __forceinline__ void operator()(const f32x4 (&acc)[2][2][4][2], const Unit& u, int wr, int wc, int fr, int fq) const {
        const bool isc = u.pm >= mlat;
        const float* b = isc ? cbase : base; float* o = isc ? cout : out; const float* g = isc ? cgate : gate;
        const int row0 = (isc ? (u.pm - mlat) : u.pm) * BM + wr * 64 + fr, col0 = u.pn * BM + wc * 32 + 4 * fq;
        f32x4 gv[2][2];
#pragma unroll
        for (int bj = 0; bj < 2; ++bj)
#pragma unroll
            for (int n = 0; n < 2; ++n) gv[bj][n] = *(const f32x4*)(g + col0 + bj * HALF + n * 16);
#pragma unroll
        for (int ai = 0; ai < 2; ++ai)
#pragma unroll
            for (int m = 0; m < 4; ++m) { const size_t off = (size_t)(row0 + ai * HALF + m * 16) * ldc + col0;
#pragma unroll
                for (int bj = 0; bj < 2; ++bj)
#pragma unroll
                    for (int n = 0; n < 2; ++n) { const f32x4 bs = *(const f32x4*)(b + off + bj * HALF + n * 16); *(f32x4*)(o + off + bj * HALF + n * 16) = bs + gv[bj][n] * acc[ai][bj][m][n]; }
                if (m & 1) asm volatile("" ::: "memory"); }
    }
};
template <bool BFB> struct EpiResidB {
    static constexpr bool PERM = true, AFTER_DRAIN = false;
    const void* base; bf16_t* out; const float* gate; int ldc;
    __device__ __forceinline__ void operator()(const f32x4 (&acc)[2][2][4][2], const Unit& u, int wr, int wc, int fr, int fq) const {
        const int row0 = u.pm * BM + wr * 64 + fr, col0 = u.pn * BM + wc * 32 + 8 * fq;
        f32x4 gv[2][2];
#pragma unroll
        for (int bj = 0; bj < 2; ++bj)
#pragma unroll
            for (int n = 0; n < 2; ++n) gv[bj][n] = *(const f32x4*)(gate + col0 + bj * HALF + 4 * n);
#pragma unroll
        for (int ai = 0; ai < 2; ++ai)
#pragma unroll
            for (int m = 0; m < 4; ++m) { const size_t off = (size_t)(row0 + ai * HALF + m * 16) * ldc + col0;
#pragma unroll
                for (int bj = 0; bj < 2; ++bj) { f32x4 b0, b1;
                    if constexpr (BFB) { const u32x4 t = *(const u32x4*)((const bf16_t*)base + off + bj * HALF);
                        b0 = (f32x4){__builtin_bit_cast(float, t.x << 16), __builtin_bit_cast(float, t.x & 0xffff0000u), __builtin_bit_cast(float, t.y << 16), __builtin_bit_cast(float, t.y & 0xffff0000u)};
                        b1 = (f32x4){__builtin_bit_cast(float, t.z << 16), __builtin_bit_cast(float, t.z & 0xffff0000u), __builtin_bit_cast(float, t.w << 16), __builtin_bit_cast(float, t.w & 0xffff0000u)}; }
                    else { b0 = *(const f32x4*)((const float*)base + off + bj * HALF); b1 = *(const f32x4*)((const float*)base + off + bj * HALF + 4); }
                    const f32x4 v0 = b0 + gv[bj][0] * acc[ai][bj][m][0], v1 = b1 + gv[bj][1] * acc[ai][bj][m][1];
                    u32x4 w; w.x = cvt_pk_bf16(v0[0], v0[1]); w.y = cvt_pk_bf16(v0[2], v0[3]); w.z = cvt_pk_bf16(v1[0], v1[1]); w.w = cvt_pk_bf16(v1[2], v1[3]);
                    *(u32x4*)(out + off + bj * HALF) = w; }
                if (m & 1) asm volatile("" ::: "memory"); }
    }
};
struct EpiSwiGLU {
    static constexpr bool PERM = true, AFTER_DRAIN = false;
    bf16_t* O; int ldc; float ds;
    __device__ __forceinline__ void operator()(const f32x4 (&acc)[2][2][4][2], const Unit& u, int wr, int wc, int fr, int fq) const {
        const int row0 = u.pm * BM + wr * 64 + fr, col0 = u.pn * HALF + wc * 32 + 8 * fq;
#pragma unroll
        for (int ai = 0; ai < 2; ++ai)
#pragma unroll
            for (int m = 0; m < 4; ++m) { bf16_t* rowp = O + (size_t)(row0 + ai * HALF + m * 16) * ldc + col0;
                const f32x4 g0 = acc[ai][0][m][0] * ds, g1 = acc[ai][0][m][1] * ds, u0 = acc[ai][1][m][0] * ds, u1 = acc[ai][1][m][1] * ds;
                f32x4 h0, h1;
#pragma unroll
                for (int j = 0; j < 4; ++j) { h0[j] = silu_f(g0[j]) * u0[j]; h1[j] = silu_f(g1[j]) * u1[j]; }
                u32x4 w; w.x = cvt_pk_bf16(h0[0], h0[1]); w.y = cvt_pk_bf16(h0[2], h0[3]); w.z = cvt_pk_bf16(h1[0], h1[1]); w.w = cvt_pk_bf16(h1[2], h1[3]);
                *(u32x4*)rowp = w; }
    }
};
struct MoeOrder : StaticOrder {
    int tb[8];
    __device__ __forceinline__ void load_bases(const int* mi) {
#pragma unroll
        for (int e = 0; e < 8; ++e) tb[e] = __builtin_amdgcn_readfirstlane(mi[e]); }
    __device__ __forceinline__ int expert_of(int pm) const { int e = 0;
#pragma unroll
        for (int j = 0; j < 7; ++j) e += (pm >= tb[j]) ? 1 : 0;
        return e; }
    __device__ __forceinline__ bool next(int i, Unit& u) const { if (!StaticOrder::next(i, u)) return false; u.eb = expert_of(u.pm); return true; }
};

struct SplitKOrder {
    int pm0, nN, P, kp, total, c; const int* tile_e;
    __device__ __forceinline__ bool next(int i, Unit& u) const {
        if (i != 0 || c >= total) return false;
        const int p = c % P, t = c / P; u.pn = t % nN; u.pm = pm0 + t / nN; u.ko = p * kp; u.eb = tile_e ? __builtin_amdgcn_readfirstlane(tile_e[u.pm]) : 0; return true; }
    __device__ __forceinline__ void a_ready(const Unit&) const {}
    __device__ __forceinline__ void done(const Unit&) const {}
};
struct EpiPart {
    static constexpr bool PERM = false, AFTER_DRAIN = false;
    float* part; const float* scale; int pm_sub; int kp; int ldc;
    __device__ __forceinline__ void operator()(const f32x4 (&acc)[2][2][4][2], const Unit& u, int wr, int wc, int fr, int fq) const {
        float* o = part + (size_t)(u.ko / kp) * BM * ldc;
        const int row0 = (u.pm - pm_sub) * BM + wr * 64 + fr, col0 = u.pn * BM + wc * 32 + 4 * fq;
        f32x4 gv[2][2];
#pragma unroll
        for (int bj = 0; bj < 2; ++bj)
#pragma unroll
            for (int n = 0; n < 2; ++n) gv[bj][n] = *(const f32x4*)(scale + col0 + bj * HALF + n * 16);
#pragma unroll
        for (int ai = 0; ai < 2; ++ai)
#pragma unroll
            for (int m = 0; m < 4; ++m) { const size_t off = (size_t)(row0 + ai * HALF + m * 16) * ldc + col0;
#pragma unroll
                for (int bj = 0; bj < 2; ++bj)
#pragma unroll
                    for (int n = 0; n < 2; ++n) *(f32x4*)(o + off + bj * HALF + n * 16) = gv[bj][n] * acc[ai][bj][m][n]; }
    }
};
struct EpiAtomic {
    static constexpr bool PERM = false, AFTER_DRAIN = true;
    float* out; const float* scale; int pm_sub; int ldc; float ds;
    __device__ __forceinline__ void fused(f32x4 (&acc)[2][2][4][2], const Unit& u, int wr, int wc, int fr, int fq, PG8_LAS unsigned char* lds, int wid, int lane) const {
        PG8_LAS float* scr = (PG8_LAS float*)(lds + wid * 16384);
        const int rr = lane >> 5, cc = lane & 31;
#pragma unroll
        for (int ai = 0; ai < 2; ++ai)
#pragma unroll
            for (int bj = 0; bj < 2; ++bj) {
#pragma unroll
                for (int m = 0; m < 4; ++m)
#pragma unroll
                    for (int n = 0; n < 2; ++n) *(PG8_LAS f32x4*)(scr + (m * 16 + fr) * 36 + n * 16 + 4 * fq) = acc[ai][bj][m][n];
                asm volatile("s_waitcnt lgkmcnt(0)" ::: "memory");
                const int colg = u.pn * BM + bj * HALF + wc * 32 + cc; const float sc = (scale ? scale[colg] : 1.0f) * ds;
                float* op = out + (size_t)((u.pm - pm_sub) * BM + ai * HALF + wr * 64 + rr) * ldc + colg;
#pragma unroll 8
                for (int i = 0; i < 32; ++i) { const float v = scr[(2 * i + rr) * 36 + cc]; __hip_atomic_fetch_add(op + (size_t)(2 * i) * ldc, v * sc, __ATOMIC_RELAXED, __HIP_MEMORY_SCOPE_AGENT); }
                asm volatile("s_waitcnt lgkmcnt(0)" ::: "memory");
            }
    }
};

typedef int i32x4v __attribute__((ext_vector_type(4))); typedef int i32x8v __attribute__((ext_vector_type(8)));
struct FragB { bf16x8 k[2]; };
struct Frag8 { i32x8v v; };
template <bool F8> struct FragSel { typedef FragB type; };
template <> struct FragSel<true> { typedef Frag8 type; };
__device__ __forceinline__ void ld_frag(FragB& f, const PG8_LAS unsigned char* p) { f.k[0] = *(const PG8_LAS bf16x8*)p; f.k[1] = *(const PG8_LAS bf16x8*)(p + 1024); }
__device__ __forceinline__ void ld_frag(Frag8& f, const PG8_LAS unsigned char* p) { const i32x4v lo = *(const PG8_LAS i32x4v*)p, hi = *(const PG8_LAS i32x4v*)(p + 1024); f.v = __builtin_shufflevector(lo, hi, 0, 1, 2, 3, 4, 5, 6, 7); }
__device__ __forceinline__ f32x4 mma_frag(const FragB& b, const FragB& a, f32x4 c) { c = __builtin_amdgcn_mfma_f32_16x16x32_bf16(b.k[0], a.k[0], c, 0, 0, 0); return __builtin_amdgcn_mfma_f32_16x16x32_bf16(b.k[1], a.k[1], c, 0, 0, 0); }
__device__ __forceinline__ f32x4 mma_frag(const Frag8& b, const Frag8& a, f32x4 c) {
    asm volatile("v_mfma_scale_f32_16x16x128_f8f6f4 %0, %1, %2, %0, %3, %3 op_sel_hi:[0,0,0]" : "+v"(c) : "v"(b.v), "v"(a.v), "v"(0x7f7f7f7f));
    return c;
}

struct EpiSwiGLU8 {
    static constexpr bool PERM = true, AFTER_DRAIN = false;
    unsigned char* O; int ldc; float ds, hs;
    __device__ __forceinline__ void operator()(const f32x4 (&acc)[2][2][4][2], const Unit& u, int wr, int wc, int fr, int fq) const {
        const int row0 = u.pm * BM + wr * 64 + fr, col0 = u.pn * HALF + wc * 32 + 8 * fq;
        const float k1 = -1.4426950408889634f * ds, k2 = ds * ds * hs;
#pragma unroll
        for (int ai = 0; ai < 2; ++ai)
#pragma unroll
            for (int m = 0; m < 4; ++m) { unsigned char* rowp = O + (size_t)(row0 + ai * HALF + m * 16) * ldc + col0;
                const f32x4 g0 = acc[ai][0][m][0], g1 = acc[ai][0][m][1], u0 = acc[ai][1][m][0], u1 = acc[ai][1][m][1];
                float h[8];
#pragma unroll
                for (int j = 0; j < 4; ++j) {
                    h[j] = __builtin_amdgcn_fmed3f((g0[j] * u0[j]) * k2 * __builtin_amdgcn_rcpf(1.0f + __builtin_amdgcn_exp2f(g0[j] * k1)), -448.0f, 448.0f);
                    h[4 + j] = __builtin_amdgcn_fmed3f((g1[j] * u1[j]) * k2 * __builtin_amdgcn_rcpf(1.0f + __builtin_amdgcn_exp2f(g1[j] * k1)), -448.0f, 448.0f); }
                unsigned lo = 0u, hi = 0u;
                lo = __builtin_amdgcn_cvt_pk_fp8_f32(h[0], h[1], lo, false); lo = __builtin_amdgcn_cvt_pk_fp8_f32(h[2], h[3], lo, true);
                hi = __builtin_amdgcn_cvt_pk_fp8_f32(h[4], h[5], hi, false); hi = __builtin_amdgcn_cvt_pk_fp8_f32(h[6], h[7], hi, true);
                typedef unsigned u32x2 __attribute__((ext_vector_type(2)));
                *(u32x2*)rowp = (u32x2){lo, hi}; }
    }
};
struct EpiScaleBf16 {
    static constexpr bool PERM = true, AFTER_DRAIN = false;
    bf16_t* O; int ldc; float ds;
    __device__ __forceinline__ void operator()(const f32x4 (&acc)[2][2][4][2], const Unit& u, int wr, int wc, int fr, int fq) const {
        const int row0 = u.pm * BM + wr * 64 + fr, col0 = u.pn * BM + wc * 32 + 8 * fq;
#pragma unroll
        for (int ai = 0; ai < 2; ++ai)
#pragma unroll
            for (int m = 0; m < 4; ++m) { bf16_t* rowp = O + (size_t)(row0 + ai * HALF + m * 16) * ldc + col0;
#pragma unroll
                for (int bj = 0; bj < 2; ++bj) { const f32x4 v0 = acc[ai][bj][m][0] * ds, v1 = acc[ai][bj][m][1] * ds;
                    u32x4 w; w.x = cvt_pk_bf16(v0[0], v0[1]); w.y = cvt_pk_bf16(v0[2], v0[3]); w.z = cvt_pk_bf16(v1[0], v1[1]); w.w = cvt_pk_bf16(v1[2], v1[3]);
                    *(u32x4*)(rowp + bj * HALF) = w; } }
    }
};

template <class Epi, class Sched, bool ALIGN_EPI = false, bool SP2 = false, bool F8 = false>
__device__ __forceinline__ void gemm_phase(PG8_LAS unsigned char* lds, const Gemm g, const Sched& S, const Epi& E, int tid_in) {
    int tid_ = tid_in; asm volatile("" : "+v"(tid_));
    const int tid = tid_, wid = __builtin_amdgcn_readfirstlane(tid >> 6), lane = tid & 63, wr = wid >> 2, wc = wid & 3, fr = lane & 15, fq = lane >> 4;
    const int K = g.K, nt = K / BK, ld = g.ld;
    unsigned voffA[2], voffB[2];
#pragma unroll
    for (int i = 0; i < 2; ++i) { int R, C; stage_rc(tid * 16 + i * 8192, R, C); const int Rb = Epi::PERM ? ((R & ~31) + perm32(R & 31)) : R;
        voffA[i] = (unsigned)(R * ld + C) * 2u; voffB[i] = (unsigned)(Rb * ld + C) * 2u; }
    const size_t kstep = (size_t)(BK * 2);
    const size_t hstep = (size_t)HALF * ld * 2;
    const size_t tstep = 2 * hstep;
    const unsigned ldsw = (unsigned)wid * 1024u;
    const int aoff = lds_byte(wr * 64 + fr, fq * 8), boff = lds_byte(wc * 32 + fr, fq * 8);
#define PG8_SA(b, h) (((b) * 2 + (h)) * HTB)
#define PG8_SB(b, h) ((4 + (b) * 2 + (h)) * HTB)
#define PG8_STAGE(bufoff, gbase, voff) do { _Pragma("unroll") for (int _i = 0; _i < 2; ++_i) \
        __builtin_amdgcn_global_load_lds((const unsigned*)((const char*)(gbase) + (voff)[_i]), (PG8_LAS unsigned*)(lds + (bufoff) + ldsw + _i * 8192), 16, 0, 0); } while (0)
#define PG8_LDA(dst, b, h) do { _Pragma("unroll") for (int m = 0; m < 4; ++m) ld_frag(dst[m], lds + PG8_SA(b, h) + aoff + m * 2048); } while (0)
#define PG8_LDB(dst, b, h) do { _Pragma("unroll") for (int n = 0; n < 2; ++n) ld_frag(dst[n], lds + PG8_SB(b, h) + boff + n * 2048); } while (0)
#define PG8_MMA(ai, bj, At, Bt) do { __builtin_amdgcn_s_setprio(1); _Pragma("unroll") for (int m = 0; m < 4; ++m) _Pragma("unroll") for (int n = 0; n < 2; ++n) \
        acc[ai][bj][m][n] = mma_frag(Bt[n], At[m], acc[ai][bj][m][n]); __builtin_amdgcn_s_setprio(0); } while (0)
#define PG8_WAIT_V(n) asm volatile("s_waitcnt vmcnt(" #n ")" ::: "memory")
#define PG8_WAIT_L(n) asm volatile("s_waitcnt lgkmcnt(" #n ")" ::: "memory")
#define PG8_BAR __builtin_amdgcn_s_barrier()
#define PG8_SCHED __builtin_amdgcn_sched_barrier(0)
    Unit cur, nxt; int ui = 0;
    if (!S.next(0, cur)) return;
    float zacc = 0.f; asm volatile("" : "+v"(zacc));
    f32x4 acc[2][2][4][2];
#pragma unroll
    for (int a = 0; a < 2; ++a)
#pragma unroll
        for (int b = 0; b < 2; ++b)
#pragma unroll
            for (int m = 0; m < 4; ++m)
#pragma unroll
                for (int n = 0; n < 2; ++n) acc[a][b][m][n] = (f32x4){zacc, zacc, zacc, zacc};
    typedef typename FragSel<F8>::type Frag;
    Frag At[4], B0[2], B1[2];
    const char* cA = (const char*)g.A + (size_t)cur.pm * tstep + (size_t)cur.ko * 2; const char* cB = (const char*)g.Bt + (size_t)cur.eb * g.bstride + (size_t)cur.pn * tstep + (size_t)cur.ko * 2;
    S.a_ready(cur);
    if constexpr (SP2) {
        PG8_STAGE(PG8_SB(0, 0), cB, voffB); PG8_STAGE(PG8_SB(0, 1), cB + hstep, voffB); PG8_STAGE(PG8_SA(0, 0), cA, voffA); PG8_STAGE(PG8_SA(0, 1), cA + hstep, voffA);
        if (wr == 1) PG8_BAR;
        PG8_WAIT_V(2); PG8_BAR;
        PG8_STAGE(PG8_SB(1, 0), cB + kstep, voffB); PG8_STAGE(PG8_SA(1, 0), cA + kstep, voffA); PG8_STAGE(PG8_SB(1, 1), cB + hstep + kstep, voffB);
        PG8_WAIT_V(6); PG8_BAR;
    } else {
        PG8_STAGE(PG8_SB(0, 0), cB, voffB); PG8_STAGE(PG8_SA(0, 0), cA, voffA); PG8_STAGE(PG8_SB(0, 1), cB + hstep, voffB); PG8_STAGE(PG8_SA(0, 1), cA + hstep, voffA);
        if (wr == 1) PG8_BAR;
        PG8_WAIT_V(4); PG8_BAR;
        PG8_STAGE(PG8_SB(1, 0), cB + kstep, voffB); PG8_STAGE(PG8_SA(1, 0), cA + kstep, voffA); PG8_STAGE(PG8_SB(1, 1), cB + hstep + kstep, voffB);
        PG8_WAIT_V(6); PG8_BAR;
    }
    for (;;) {
        const bool has_next = S.next(ui + 1, nxt);
        const char* nA = has_next ? (const char*)g.A + (size_t)nxt.pm * tstep + (size_t)nxt.ko * 2 : cA; const char* nB = has_next ? (const char*)g.Bt + (size_t)nxt.eb * g.bstride + (size_t)nxt.pn * tstep + (size_t)nxt.ko * 2 : cB;
        for (int t = 0; t < nt; t += 2) {
            const bool last = (t == nt - 2);
            const char* a1 = cA + (size_t)(t + 1) * kstep;
            const char* a2 = last ? nA : cA + (size_t)(t + 2) * kstep; const char* b2 = last ? nB : cB + (size_t)(t + 2) * kstep;
            const char* a3 = a2 + kstep; const char* b3 = b2 + kstep;
            if (last && has_next) S.a_ready(nxt);
            if constexpr (SP2) {
            PG8_LDB(B0, 0, 0); PG8_LDB(B1, 0, 1); PG8_SCHED; PG8_LDA(At, 0, 0); PG8_STAGE(PG8_SA(1, 1), a1 + hstep, voffA);
            PG8_WAIT_V(8); PG8_WAIT_L(0); PG8_BAR; PG8_MMA(0, 0, At, B0); PG8_MMA(0, 1, At, B1); PG8_BAR; PG8_SCHED;
            PG8_LDA(At, 0, 1); PG8_STAGE(PG8_SB(0, 0), b2, voffB); PG8_STAGE(PG8_SB(0, 1), b2 + hstep, voffB); PG8_STAGE(PG8_SA(0, 0), a2, voffA);
            PG8_WAIT_V(8); PG8_WAIT_L(0); PG8_BAR; PG8_MMA(1, 0, At, B0); PG8_MMA(1, 1, At, B1); PG8_BAR; PG8_SCHED;
            PG8_LDB(B0, 1, 0); PG8_LDB(B1, 1, 1); PG8_SCHED; PG8_LDA(At, 1, 0); PG8_STAGE(PG8_SA(0, 1), a2 + hstep, voffA);
            PG8_WAIT_V(8); PG8_WAIT_L(0); PG8_BAR; PG8_MMA(0, 0, At, B0); PG8_MMA(0, 1, At, B1); PG8_BAR; PG8_SCHED;
            PG8_LDA(At, 1, 1); PG8_STAGE(PG8_SB(1, 0), b3, voffB); PG8_STAGE(PG8_SB(1, 1), b3 + hstep, voffB); PG8_STAGE(PG8_SA(1, 0), a3, voffA);
            PG8_WAIT_V(8); PG8_WAIT_L(0); PG8_BAR; PG8_MMA(1, 0, At, B0); PG8_MMA(1, 1, At, B1); PG8_BAR; PG8_SCHED;
            } else {
            PG8_LDB(B0, 0, 0); PG8_SCHED; PG8_LDA(At, 0, 0); PG8_STAGE(PG8_SA(1, 1), a1 + hstep, voffA);
            PG8_WAIT_L(8); PG8_BAR; PG8_WAIT_L(0); PG8_MMA(0, 0, At, B0); PG8_BAR; PG8_SCHED;
            PG8_LDB(B1, 0, 1); PG8_STAGE(PG8_SB(0, 0), b2, voffB);
            PG8_BAR; PG8_WAIT_L(0); PG8_MMA(0, 1, At, B1); PG8_BAR;
            PG8_LDA(At, 0, 1); PG8_STAGE(PG8_SA(0, 0), a2, voffA);
            PG8_BAR; PG8_WAIT_L(0); PG8_MMA(1, 0, At, B0); PG8_BAR; PG8_SCHED;
            PG8_STAGE(PG8_SB(0, 1), b2 + hstep, voffB);
            PG8_WAIT_V(6); PG8_BAR; PG8_MMA(1, 1, At, B1); PG8_BAR;
            PG8_LDB(B0, 1, 0); PG8_SCHED; PG8_LDA(At, 1, 0); PG8_STAGE(PG8_SA(0, 1), a2 + hstep, voffA);
            PG8_WAIT_L(8); PG8_BAR; PG8_WAIT_L(0); PG8_MMA(0, 0, At, B0); PG8_BAR; PG8_SCHED;
            PG8_LDB(B1, 1, 1); PG8_STAGE(PG8_SB(1, 0), b3, voffB);
            PG8_BAR; PG8_WAIT_L(0); PG8_MMA(0, 1, At, B1); PG8_BAR;
            PG8_LDA(At, 1, 1); PG8_STAGE(PG8_SA(1, 0), a3, voffA);
            PG8_BAR; PG8_WAIT_L(0); PG8_MMA(1, 0, At, B0); PG8_BAR; PG8_SCHED;
            PG8_STAGE(PG8_SB(1, 1), b3 + hstep, voffB);
            PG8_WAIT_V(6); PG8_BAR; PG8_MMA(1, 1, At, B1); PG8_BAR;
            }
        }
        if constexpr (ALIGN_EPI) { if (wr == 0) PG8_BAR; }
        if constexpr (F8) {
            asm volatile("s_nop 15\n\ts_nop 15" : "+v"(acc[1][1][0][0]), "+v"(acc[1][1][0][1]), "+v"(acc[1][1][1][0]), "+v"(acc[1][1][1][1]), "+v"(acc[1][1][2][0]), "+v"(acc[1][1][2][1]), "+v"(acc[1][1][3][0]), "+v"(acc[1][1][3][1])); }
        if constexpr (!Epi::AFTER_DRAIN) { E(acc, cur, wr, wc, fr, fq); S.done(cur); }
        if (!has_next) break;
#pragma unroll
        for (int a = 0; a < 2; ++a)
#pragma unroll
            for (int b = 0; b < 2; ++b)
#pragma unroll
                for (int m = 0; m < 4; ++m)
#pragma unroll
                    for (int n = 0; n < 2; ++n) acc[a][b][m][n] = (f32x4){zacc, zacc, zacc, zacc};
        cur = nxt; cA = nA; cB = nB; ++ui;
        if constexpr (ALIGN_EPI) { if (wr == 1) PG8_BAR; }
    }
    PG8_WAIT_V(0);
    if constexpr (!ALIGN_EPI) { if (wr == 0) PG8_BAR; }
    PG8_BAR;
    if constexpr (Epi::AFTER_DRAIN) { E.fused(acc, cur, wr, wc, fr, fq, lds, wid, lane); S.done(cur); }
#undef PG8_SA
#undef PG8_SB
#undef PG8_STAGE
#undef PG8_LDA
#undef PG8_LDB
#undef PG8_MMA
#undef PG8_WAIT_V
#undef PG8_WAIT_L
#undef PG8_BAR
#undef PG8_SCHED
}
}


constexpr int S_LAT = 16384, C_CTX = 256, R_ALL = S_LAT + C_CTX, DM = 1024;
constexpr int INW = 2560, FFN = 2816, EXD = 3584, NEXP = 8;
constexpr int COL_AQ = 0, COL_AK = 512, COL_AV = 640, COL_HQ = 768, COL_HFF = 1024, COL_HFB = 1280, COL_HI = 1536, COL_HG = 1792, COL_GU = 2048, COL_GV = 2304;
constexpr int MIX_AT = 0, MIX_HG = 512, MIX_GM = 768;
constexpr int MOE_MAXROWS = 34816;
constexpr float EPS = 1e-6f;
constexpr int NWAVES = 8, NTHR = 512;
constexpr int NPH = 23;

constexpr size_t MiB = 1u << 20;
constexpr size_t WS_CTL = 0, CTL_ZERO_BYTES = 1 * MiB;
constexpr size_t WS_VEC = 1 * MiB;
constexpr size_t WS_TOK = 2 * MiB;
constexpr size_t WS_WIN = 3 * MiB;
constexpr size_t WS_WOUT = 13 * MiB;
constexpr size_t WS_WGU = 17 * MiB;
constexpr size_t WS_WD = 28 * MiB;
constexpr size_t WS_MGU = 34 * MiB;
constexpr size_t WS_MD = 146 * MiB;
constexpr size_t WS_H = 202 * MiB;
constexpr size_t WS_PROJ = 235 * MiB;
constexpr size_t WS_MIX = 317 * MiB;
constexpr size_t WS_HGO = 350 * MiB;
constexpr size_t WS_CTXR = 383 * MiB;
constexpr size_t WS_HLT = WS_HGO;
constexpr size_t WS_HSP = 384 * MiB;
constexpr size_t WS_HDG = 402 * MiB;
constexpr size_t WS_VT = 403 * MiB;
constexpr size_t WS_HID = WS_PROJ;
constexpr size_t WS_AS = 202 * MiB;
constexpr size_t WS_HIDM = 270 * MiB;
constexpr size_t WS_H2B = 440 * MiB;
constexpr size_t WS_YF = WS_WIN;
constexpr size_t WS_Y = WS_MGU;
constexpr size_t WS_XB = 104 * MiB;
constexpr size_t WS_PART1 = 176 * MiB;
constexpr size_t WS_PART2 = 180 * MiB;
constexpr size_t WS_END = 508 * MiB;
static_assert(WS_HID + (size_t)R_ALL * FFN * 2 <= WS_HGO && WS_AS + (size_t)MOE_MAXROWS * DM * 2 <= WS_HIDM && WS_HIDM + (size_t)MOE_MAXROWS * EXD * 2 <= WS_END, "ws map");
static_assert(WS_PART1 >= WS_MD + (size_t)8 * DM * EXD && WS_PART1 + (size_t)4 * 256 * DM * 4 <= WS_PART2 && WS_PART2 + (size_t)11 * 256 * DM * 4 <= WS_H, "ws map 4");
static_assert(WS_XB >= WS_Y + (size_t)MOE_MAXROWS * DM * 2 && WS_XB >= WS_MGU + (size_t)8 * 2 * EXD * DM && WS_XB + (size_t)S_LAT * DM * 2 <= WS_MD, "ws map 3");
static_assert(WS_H2B >= WS_HIDM && WS_H2B + (size_t)S_LAT * DM * 2 <= WS_END && WS_H + (size_t)R_ALL * DM * 2 <= WS_PROJ && WS_PROJ + (size_t)R_ALL * INW * 2 <= WS_MIX && WS_MIX + (size_t)R_ALL * DM * 2 <= WS_HGO && WS_HGO + (size_t)2 * R_ALL * 256 * 4 <= WS_CTXR, "ws map 2");
constexpr int VO_MOD = 0;
constexpr int VO_ROPE = 32768;
constexpr int VO_MOE = 65536;
constexpr int CW_BAR = 4096;
constexpr int CW_QUEUE = 2048;
constexpr int CW_MOECNT = 1024;

constexpr int RING_BYTES = 131072;
constexpr int LDSCTL_OFF = 159744, MISC_OFF = LDSCTL_OFF + 320;
constexpr int LDS_BYTES = 163840;

#define GAS __attribute__((address_space(1)))
#define LAS __attribute__((address_space(3)))
typedef unsigned short bf16;
typedef unsigned v4u __attribute__((ext_vector_type(4)));
typedef unsigned v2u __attribute__((ext_vector_type(2)));
typedef float f32x4 __attribute__((ext_vector_type(4)));
typedef GAS unsigned gu32;
#define RLX_AGENT __ATOMIC_RELAXED, __HIP_MEMORY_SCOPE_AGENT
#define LDS_WAIT() asm volatile("s_waitcnt lgkmcnt(0)" ::: "memory")
typedef float f32x2_t __attribute__((ext_vector_type(2))); typedef __bf16 bf16x2_t __attribute__((ext_vector_type(2)));
__device__ __forceinline__ unsigned pk2(float lo, float hi) { const f32x2_t v = {lo, hi}; const bf16x2_t b = __builtin_convertvector(v, bf16x2_t); return __builtin_bit_cast(unsigned, b); }
__device__ __forceinline__ unsigned f2bf(float f) { return pk2(f, 0.f) & 0xffffu; }
__device__ __forceinline__ float bflo(unsigned w) { return __builtin_bit_cast(float, w << 16); }
__device__ __forceinline__ float bfhi(unsigned w) { return __builtin_bit_cast(float, w & 0xffff0000u); }
__device__ __forceinline__ float sigm1(float x) { return __builtin_amdgcn_rcpf(1.0f + __builtin_amdgcn_exp2f(-1.4426950408889634f * x)); }
__device__ __forceinline__ float silu1(float x) { return x * sigm1(x); }
__device__ __forceinline__ float gelu1(float x) { return 0.5f * x * (1.0f + erff(x * 0.70710678118654752f)); }
template <int X> __device__ __forceinline__ float sx(float v) { return __shfl_xor(v, X); }
__device__ __forceinline__ float sx32_add(float v) { return v + __shfl_xor(v, 32); }
__device__ __forceinline__ float sx32_max(float v) { return fmaxf(v, __shfl_xor(v, 32)); }
__device__ __forceinline__ float wave_sum(float v) { v += sx<1>(v); v += sx<2>(v); v += sx<4>(v); v += sx<8>(v); v += sx<16>(v); return sx32_add(v); }
__device__ __forceinline__ void unpack8(const v4u w, float* f) { f[0] = bflo(w.x); f[1] = bfhi(w.x); f[2] = bflo(w.y); f[3] = bfhi(w.y); f[4] = bflo(w.z); f[5] = bfhi(w.z); f[6] = bflo(w.w); f[7] = bfhi(w.w); }


__device__ __forceinline__ float clamp448(float x) { return fminf(fmaxf(x, -448.0f), 448.0f); }
__device__ __forceinline__ unsigned pk4_fp8(float a, float b, float c, float d) {
    unsigned w = 0u; w = __builtin_amdgcn_cvt_pk_fp8_f32(clamp448(a), clamp448(b), w, false); w = __builtin_amdgcn_cvt_pk_fp8_f32(clamp448(c), clamp448(d), w, true); return w; }
constexpr float F8_WSCALE = 128.0f;
constexpr float F8_ASCALE = 16.0f;
constexpr float F8_HSCALE = 8.0f;
#define XB_TMO      128
#define XB_XCNT(j)  (256  + 64 * (j))
#define XB_XSUB(j)  (1280 + 64 * (j))
#define XB_XGEN(j)  (2304 + 64 * (j))
#define XB_TOP      3328
#define XB_TOPGEN   3392
#define XCD_BAR_WORDS 3456
#define XB_SPIN_CAP (1u << 18)

__device__ __forceinline__ unsigned xb_ld(unsigned* p)              { return __hip_atomic_load(p, __ATOMIC_RELAXED, __HIP_MEMORY_SCOPE_AGENT); }
__device__ __forceinline__ unsigned xb_add(unsigned* p, unsigned v) { return __hip_atomic_fetch_add(p, v, __ATOMIC_RELAXED, __HIP_MEMORY_SCOPE_AGENT); }
__device__ __forceinline__ unsigned xb_xcc_id() { return (unsigned)__builtin_amdgcn_s_getreg((3 << 11) | 20) & 0xFu; }
#define XB_SPIN(cond, bar) do { unsigned _sp = 0; while (cond) { __builtin_amdgcn_s_sleep(1); \
    if ((++_sp & 255u) == 0u) { if (xb_ld(&(bar)[XB_TMO])) break; if (_sp > XB_SPIN_CAP) { atomicAdd(&(bar)[XB_TMO], 1u); break; } } } } while (0)

struct XcdBarrier {
    unsigned* bar; unsigned x;
    volatile LAS unsigned* st;
};

__device__ __forceinline__ XcdBarrier xcd_barrier_post(unsigned* bar, volatile LAS unsigned* st) {
    XcdBarrier b; b.bar = bar; b.x = xb_xcc_id(); b.st = st;
    if (threadIdx.x == 0) (void)xb_add(&bar[XB_XCNT(b.x)], 1u);
    return b;
}
__device__ __forceinline__ void xcd_barrier_complete(unsigned* bar, unsigned x, unsigned& nloc, unsigned& nx) {
    const unsigned G = gridDim.x * gridDim.y * gridDim.z;
    unsigned sum, cnt, mine, sp = 0u;
    for (;;) {
        sum = 0u; cnt = 0u; mine = 0u;
#pragma unroll
        for (unsigned j = 0; j < 16; ++j) { const unsigned c = xb_ld(&bar[XB_XCNT(j)]); sum += c; cnt += (c > 0u) ? 1u : 0u; mine = (j == x) ? c : mine; }
        if (sum == G) break;
        __builtin_amdgcn_s_sleep(1);
        if ((++sp & 255u) == 0u) { if (xb_ld(&bar[XB_TMO])) break; if (sp > XB_SPIN_CAP) { atomicAdd(&bar[XB_TMO], 1u); break; } }
    }
    nloc = mine > 0u ? mine : 1u; nx = cnt > 0u ? cnt : 1u;
}

__device__ __forceinline__ void xcd_barrier(const XcdBarrier& b, const int tid_in) {
    asm volatile("s_waitcnt vmcnt(0)" ::: "memory");
    __syncthreads();
    if (tid_in == 0) {
        unsigned* bar = b.bar;
        __builtin_amdgcn_s_waitcnt(0);
        unsigned nloc = b.st[0], nx = b.st[1];
        if (nloc == 0u) { xcd_barrier_complete(bar, b.x, nloc, nx); b.st[0] = nloc; b.st[1] = nx; }
        const unsigned old = xb_add(&bar[XB_XSUB(b.x)], 1u);
        const unsigned gen = old / nloc;
        if (old + 1u == (gen + 1u) * nloc) {
            __builtin_amdgcn_fence(__ATOMIC_RELEASE, "agent");
            asm volatile("s_waitcnt vmcnt(0)" ::: "memory");
            const unsigned og = xb_add(&bar[XB_TOP], 1u);
            const unsigned tg = og / nx;
            if (og + 1u == (tg + 1u) * nx) xb_add(&bar[XB_TOPGEN], 1u);
            else XB_SPIN(xb_ld(&bar[XB_TOPGEN]) == tg, bar);
            __builtin_amdgcn_fence(__ATOMIC_ACQUIRE, "agent");
            xb_add(&bar[XB_XGEN(b.x)], 1u);
            asm volatile("s_waitcnt vmcnt(0)" ::: "memory");
        } else {
            XB_SPIN(xb_ld(&bar[XB_XGEN(b.x)]) == gen, bar);
            __builtin_amdgcn_fence(__ATOMIC_ACQUIRE, "agent");
            asm volatile("s_waitcnt vmcnt(0)" ::: "memory");
        }
    }
    __syncthreads();
}


struct Args { const float* in[23]; float* out; unsigned char* ws; int ph_lo, ph_hi; };
typedef const __attribute__((address_space(4))) Args* KA;
#define KARGS() ({ KA p_ = (KA)__builtin_amdgcn_kernarg_segment_ptr(); asm volatile("" : "+s"(p_)); p_; })
enum { I_X = 0, I_C, I_CTX, I_CCTX, I_WADA, I_BADA, I_WIN, I_WOUT, I_QG, I_KG, I_SINK, I_HLB, I_HGAIN, I_GWS, I_GBS, I_GNG, I_FG, I_FU, I_FD, I_ROUTER, I_MG, I_MU, I_MDN };

__device__ __forceinline__ void transpose_item(const float* W, int K, int N, bf16* WT, int mode, LAS float* scr, int item, int lane) {
    const int nblk = N / 32, kb = item / nblk, nb = item % nblk, k0 = 64 * kb, n0 = 32 * nb;
    const float* wb = W + (size_t)k0 * N + n0; const int loff = (lane >> 5) * N + (lane & 31);
    float wv[32];
#pragma unroll
    for (int i = 0; i < 32; ++i) wv[i] = __builtin_nontemporal_load(wb + (size_t)(2 * i) * N + loff);
#pragma unroll
    for (int i = 0; i < 32; ++i) scr[(2 * i + (lane >> 5)) * 33 + (lane & 31)] = wv[i];
    LDS_WAIT(); asm volatile("" ::: "memory");
    const int c = lane & 7;
#pragma unroll
    for (int j = 0; j < 4; ++j) { const int n = (lane >> 3) + 8 * j; const LAS float* s = scr + (8 * c) * 33 + n;
        v4u o; o.x = pk2(s[0 * 33], s[1 * 33]); o.y = pk2(s[2 * 33], s[3 * 33]); o.z = pk2(s[4 * 33], s[5 * 33]); o.w = pk2(s[6 * 33], s[7 * 33]);
        const int ng = n0 + n; const int drow = (mode == 0) ? ng : (ng + 128 * (ng / 128) + (mode == 2 ? 128 : 0));
        *(GAS v4u*)(WT + (size_t)drow * K + k0 + 8 * c) = o; }
    LDS_WAIT(); asm volatile("" ::: "memory");
}
__device__ __forceinline__ void transpose_item8(const float* W, int K, int N, unsigned char* WT, int mode, LAS float* scr, int item, int lane) {
    const int nblk = N / 32, kb = item / nblk, nb = item % nblk, k0 = 64 * kb, n0 = 32 * nb;
    const float* wb = W + (size_t)k0 * N + n0; const int loff = (lane >> 5) * N + (lane & 31);
    float wv[32];
#pragma unroll
    for (int i = 0; i < 32; ++i) wv[i] = __builtin_nontemporal_load(wb + (size_t)(2 * i) * N + loff);
#pragma unroll
    for (int i = 0; i < 32; ++i) scr[(2 * i + (lane >> 5)) * 33 + (lane & 31)] = wv[i];
    LDS_WAIT(); asm volatile("" ::: "memory");
    const int c = lane & 7;
#pragma unroll
    for (int j = 0; j < 4; ++j) { const int n = (lane >> 3) + 8 * j; const LAS float* s = scr + (8 * c) * 33 + n;
        v2u o; o.x = pk4_fp8(s[0 * 33] * F8_WSCALE, s[1 * 33] * F8_WSCALE, s[2 * 33] * F8_WSCALE, s[3 * 33] * F8_WSCALE); o.y = pk4_fp8(s[4 * 33] * F8_WSCALE, s[5 * 33] * F8_WSCALE, s[6 * 33] * F8_WSCALE, s[7 * 33] * F8_WSCALE);
        const int ng = n0 + n; const int drow = (mode == 0) ? ng : (ng + 128 * (ng / 128) + (mode == 2 ? 128 : 0));
        *(GAS v2u*)(WT + (size_t)drow * K + k0 + 8 * c) = o; }
    LDS_WAIT(); asm volatile("" ::: "memory");
}
constexpr int MOE_ITEMS = 24 * 16 * 112;
constexpr int MOE_SL0 = 0, MOE_SL1 = 5376, MOE_SL2 = 10752, MOE_SL3 = 16128, MOE_SL4 = 19200, MOE_SL5 = 25344, MOE_SL6 = 29184, MOE_SL7 = 32576, MOE_DEFER = 34496;
__device__ __forceinline__ void moe_conv_item(KA a, int it, LAS float* scr, int lane) {
    constexpr int I_M = 16 * 112;
    unsigned char* ws = a->ws;
    const int idx = it / I_M, r = it % I_M;
    if (idx < 8) transpose_item8(a->in[I_MG] + (size_t)idx * DM * EXD, DM, EXD, (unsigned char*)(ws + WS_MGU) + (size_t)idx * 2 * EXD * DM, 1, scr, r, lane);
    else if (idx < 16) transpose_item8(a->in[I_MU] + (size_t)(idx - 8) * DM * EXD, DM, EXD, (unsigned char*)(ws + WS_MGU) + (size_t)(idx - 8) * 2 * EXD * DM, 2, scr, r, lane);
    else transpose_item8(a->in[I_MDN] + (size_t)(idx - 16) * EXD * DM, EXD, DM, (unsigned char*)(ws + WS_MD) + (size_t)(idx - 16) * DM * EXD, 0, scr, r, lane);
}
__device__ __forceinline__ void moe_conv_range(KA a, int lo, int hi, int first, LAS unsigned char* lds, int lane, int wave, int G, int bid) {
    if (bid < first) return;
    LAS float* scr = (LAS float*)(lds + wave * 8704);
    const int nw = (G - first) * NWAVES, w = (bid - first) * NWAVES + wave;
    for (int i = lo + w; i < hi; i += nw) moe_conv_item(a, i, scr, lane);
}
__device__ __forceinline__ void p0_prologue(KA a, LAS unsigned char* lds, int tid, int lane, int wave, int G, int bid) {
    unsigned char* ws = a->ws;
    LAS float* scr = (LAS float*)(lds + wave * 8704);
    const int gw = bid * NWAVES + wave, NGW = G * NWAVES;
    constexpr int I_IN = 16 * 80, I_OUT = 16 * 32, I_F = 16 * 88, I_FDN = 44 * 32, I_M = 16 * 112;
    constexpr int NIT = 2 * I_IN + 2 * I_OUT + 2 * I_F + I_FDN + 24 * I_M;
    LAS float* sil = (LAS float*)(lds + 69632);
    LAS float* part = (LAS float*)(lds + 69632 + 8192);
    float* vec = (float*)(ws + WS_VEC);
    const bool wada = bid < 192;
    if (wada) { for (int i = tid; i < 2048; i += NTHR) { const float v = (i < 1024) ? a->in[I_C][i] : a->in[I_CCTX][i - 1024]; sil[i] = silu1(v); } __syncthreads(); }
    const int l0 = bid / 96, col0 = (bid % 96) * 64 + lane;
    const float* w0 = a->in[I_WADA] + (size_t)l0 * DM * 6144 + col0;
    float a0 = 0.f, a1 = 0.f; int jb = 0;
    for (int it0 = gw; it0 < NIT || (wada && jb < 4); it0 += NGW) {
        float wv[32]; const bool wb = wada && jb < 4; const int k0 = wave * 128 + 32 * jb;
        if (wb) {
#pragma unroll
            for (int j = 0; j < 32; ++j) wv[j] = __builtin_nontemporal_load(&w0[(size_t)(k0 + j) * 6144]); }
        if (it0 < NIT) {
            int it = it0;
            if (it < 2 * I_IN) { const int l = it / I_IN, r = it % I_IN; transpose_item(a->in[I_WIN] + (size_t)l * DM * INW, DM, INW, (bf16*)(ws + WS_WIN) + (size_t)l * INW * DM, 0, scr, r, lane); }
            else if ((it -= 2 * I_IN) < 2 * I_OUT) { const int l = it / I_OUT, r = it % I_OUT; transpose_item(a->in[I_WOUT] + (size_t)l * DM * DM, DM, DM, (bf16*)(ws + WS_WOUT) + (size_t)l * DM * DM, 0, scr, r, lane); }
            else if ((it -= 2 * I_OUT) < I_F) transpose_item(a->in[I_FG], DM, FFN, (bf16*)(ws + WS_WGU), 1, scr, it, lane);
            else if ((it -= I_F) < I_F) transpose_item(a->in[I_FU], DM, FFN, (bf16*)(ws + WS_WGU), 2, scr, it, lane);
            else if ((it -= I_F) < I_FDN) transpose_item(a->in[I_FD], FFN, DM, (bf16*)(ws + WS_WD), 0, scr, it, lane);
            else if ((it -= I_FDN) >= MOE_DEFER) moe_conv_item(a, it, scr, lane);
        }
        if (wb) {
#pragma unroll
            for (int j = 0; j < 32; ++j) { a0 += sil[k0 + j] * wv[j]; a1 += sil[1024 + k0 + j] * wv[j]; }
            ++jb; }
    }
    if (wada) {
        for (int item = bid; item < 192; item += G) {
            const int l = item / 96, cb = item % 96, col = cb * 64 + lane;
            if (item != bid) {
                const float* w = a->in[I_WADA] + (size_t)l * DM * 6144 + col; a0 = 0.f; a1 = 0.f;
#pragma unroll 1
                for (int k0 = wave * 128; k0 < wave * 128 + 128; k0 += 32) { float wv[32];
#pragma unroll
                    for (int j = 0; j < 32; ++j) wv[j] = __builtin_nontemporal_load(&w[(size_t)(k0 + j) * 6144]);
#pragma unroll
                    for (int j = 0; j < 32; ++j) { a0 += sil[k0 + j] * wv[j]; a1 += sil[1024 + k0 + j] * wv[j]; } } }
            part[(wave * 2 + 0) * 64 + lane] = a0; part[(wave * 2 + 1) * 64 + lane] = a1;
            __syncthreads();
            if (wave == 0) { float s0 = 0.f, s1 = 0.f;
#pragma unroll
                for (int w8 = 0; w8 < 8; ++w8) { s0 += part[(w8 * 2 + 0) * 64 + lane]; s1 += part[(w8 * 2 + 1) * 64 + lane]; }
                const float b = a->in[I_BADA][l * 6144 + col];
                vec[VO_MOD + (l * 2 + 0) * 6144 + col] = s0 + b; vec[VO_MOD + (l * 2 + 1) * 6144 + col] = s1 + b; }
            __syncthreads();
        }
    }
    if (bid == G - 1) {
        for (int idx = tid; idx < 5120; idx += NTHR) {
            const int isc = idx >= 4096, j = isc ? idx - 4096 : idx, pos = j / 16, i = j % 16;
            const float inv = exp2f(-(float)i * 0.83048202372184059f);
            const float ang = (float)pos * inv;
            double r = (double)ang * 0.15915494309189535; r -= floor(r);
            const float rf = (float)r;
            const float cs = __builtin_amdgcn_cosf(rf), sn = __builtin_amdgcn_sinf(rf);
            float* t = vec + VO_ROPE + (isc ? 8192 : 0);
            const int n = isc ? 1024 : 4096;
            t[j] = cs; t[n + j] = sn;
        }
    }
}

template <bool STORE = true, bool BFX = false> __device__ __forceinline__ void norm_row(const void* xrow, const float* sc, const float* sh, bf16* orow, int lane, f32x4 (&h)[4]) {
    f32x4 v[4]; float s = 0.f;
    if constexpr (BFX) { const GAS v2u* xr = (const GAS v2u*)xrow + lane;
#pragma unroll
        for (int j = 0; j < 4; ++j) { const v2u t = xr[64 * j]; v[j] = (f32x4){bflo(t.x), bfhi(t.x), bflo(t.y), bfhi(t.y)}; } }
    else { const GAS f32x4* xr = (const GAS f32x4*)xrow + lane;
#pragma unroll
        for (int j = 0; j < 4; ++j) v[j] = xr[64 * j]; }
#pragma unroll
    for (int j = 0; j < 4; ++j) s += (v[j].x * v[j].x + v[j].y * v[j].y) + (v[j].z * v[j].z + v[j].w * v[j].w);
    const float rstd = __builtin_amdgcn_rsqf(wave_sum(s) * (1.0f / DM) + EPS);
    GAS v2u* o8 = (GAS v2u*)orow + lane;
#pragma unroll
    for (int j = 0; j < 4; ++j) { const f32x4 scv = *(const f32x4*)(sc + 4 * lane + 256 * j), shv = *(const f32x4*)(sh + 4 * lane + 256 * j);
        h[j] = v[j] * rstd * (scv + 1.0f) + shv;
        if constexpr (STORE) { v2u w; w.x = pk2(h[j].x, h[j].y); w.y = pk2(h[j].z, h[j].w); o8[64 * j] = w; } }
}
__device__ __forceinline__ void phase_norm(KA a, int l, int which, int nrows, bf16* H, int lane, int wave, int G, int bid) {
    const float* vec = (const float*)(a->ws + WS_VEC);
    const bool bfx = !(l == 0 && which == 0);
    const float* xl = a->in[I_X]; const bf16* xb = (const bf16*)(a->ws + WS_XB);
    const float* xc = (l == 0) ? a->in[I_CTX] : (const float*)(a->ws + WS_CTXR);
    const int nlat = nrows < S_LAT ? nrows : S_LAT;
    const float* ml = vec + VO_MOD + (l * 2 + 0) * 6144 + which * 3072;
    const float* mc = vec + VO_MOD + (l * 2 + 1) * 6144 + which * 3072;
    const int gw = bid * NWAVES + wave, NGW = G * NWAVES;
    f32x4 scl[4], shl[4], v[4];
#pragma unroll
    for (int j = 0; j < 4; ++j) { scl[j] = *(const f32x4*)(ml + 1024 + 4 * lane + 256 * j) + 1.0f; shl[j] = *(const f32x4*)(ml + 4 * lane + 256 * j); }
    if (gw < nlat) {
        if (bfx) { const GAS v2u* xr = (const GAS v2u*)(xb + (size_t)gw * DM) + lane;
#pragma unroll
            for (int j = 0; j < 4; ++j) { const v2u t = xr[64 * j]; v[j] = (f32x4){bflo(t.x), bfhi(t.x), bflo(t.y), bfhi(t.y)}; } }
        else { const GAS f32x4* xr = (const GAS f32x4*)(xl + (size_t)gw * DM) + lane;
#pragma unroll
            for (int j = 0; j < 4; ++j) v[j] = xr[64 * j]; } }
    for (int r = gw; r < nlat; r += NGW) {
        const int rn = r + NGW; f32x4 vn[4];
        if (rn < nlat) {
            if (bfx) { const GAS v2u* xr = (const GAS v2u*)(xb + (size_t)rn * DM) + lane;
#pragma unroll
                for (int j = 0; j < 4; ++j) { const v2u t = xr[64 * j]; vn[j] = (f32x4){bflo(t.x), bfhi(t.x), bflo(t.y), bfhi(t.y)}; } }
            else { const GAS f32x4* xr = (const GAS f32x4*)(xl + (size_t)rn * DM) + lane;
#pragma unroll
                for (int j = 0; j < 4; ++j) vn[j] = xr[64 * j]; } }
        float s = 0.f;
#pragma unroll
        for (int j = 0; j < 4; ++j) s += (v[j].x * v[j].x + v[j].y * v[j].y) + (v[j].z * v[j].z + v[j].w * v[j].w);
        const float rstd = __builtin_amdgcn_rsqf(wave_sum(s) * (1.0f / DM) + EPS);
        GAS v2u* o8 = (GAS v2u*)(H + (size_t)r * DM) + lane;
#pragma unroll
        for (int j = 0; j < 4; ++j) { const f32x4 h = v[j] * rstd * scl[j] + shl[j]; v2u w; w.x = pk2(h.x, h.y); w.y = pk2(h.z, h.w); o8[64 * j] = w; }
#pragma unroll
        for (int j = 0; j < 4; ++j) v[j] = vn[j];
    }
    const int npart = (l == 0 && which == 0) ? 0 : (l == 0 ? 4 : 11);
    const float* part = (const float*)(a->ws + (l == 0 ? WS_PART1 : WS_PART2));
    for (int r = S_LAT + (NGW - 1 - gw); r < nrows; r += NGW) {
        const int cr = r - S_LAT; f32x4 x[4];
        { const GAS f32x4* xr = (const GAS f32x4*)(xc + (size_t)cr * DM) + lane;
#pragma unroll
          for (int j = 0; j < 4; ++j) x[j] = xr[64 * j]; }
        for (int p = 0; p < npart; ++p) { const GAS f32x4* pr = (const GAS f32x4*)(part + ((size_t)p * 256 + cr) * DM) + lane;
#pragma unroll
            for (int j = 0; j < 4; ++j) x[j] = x[j] + pr[64 * j]; }
        if (npart && l == 0) { GAS f32x4* cw = (GAS f32x4*)((float*)(a->ws + WS_CTXR) + (size_t)cr * DM) + lane;
#pragma unroll
            for (int j = 0; j < 4; ++j) cw[64 * j] = x[j]; }
        float s = 0.f;
#pragma unroll
        for (int j = 0; j < 4; ++j) s += (x[j].x * x[j].x + x[j].y * x[j].y) + (x[j].z * x[j].z + x[j].w * x[j].w);
        const float rstd = __builtin_amdgcn_rsqf(wave_sum(s) * (1.0f / DM) + EPS);
        GAS v2u* o8 = (GAS v2u*)(H + (size_t)r * DM) + lane;
#pragma unroll
        for (int j = 0; j < 4; ++j) { const f32x4 scv = *(const f32x4*)(mc + 1024 + 4 * lane + 256 * j), shv = *(const f32x4*)(mc + 4 * lane + 256 * j);
            const f32x4 h = x[j] * rstd * (scv + 1.0f) + shv; v2u w; w.x = pk2(h.x, h.y); w.y = pk2(h.z, h.w); o8[64 * j] = w; }
    }
}
constexpr int ROUTE_ROWS_OFF = 36864;
__device__ __forceinline__ void phase_norm_route(KA a, LAS unsigned char* lds, int tid, int lane, int wave, int G, int bid) {
    const int l = 1;
    const float* vec = (const float*)(a->ws + WS_VEC);
    const float* ml = vec + VO_MOD + (l * 2 + 0) * 6144 + 3072;
    LAS float* rt = (LAS float*)lds;
    volatile LAS unsigned* lcnt = (volatile LAS unsigned*)(lds + 32768);
    for (int i = tid; i < 8192; i += NTHR) rt[i] = a->in[I_ROUTER][i];
    if (tid < 16) lcnt[tid] = 0u;
    __syncthreads();
    int* tokinfo = (int*)(a->ws + WS_TOK);
    unsigned* cnt = (unsigned*)(a->ws + WS_CTL) + CW_MOECNT;
    const int gw = bid * NWAVES + wave, NGW = G * NWAVES;
    unsigned keep = 0u, pk0 = 0u; int itn = 0;
    f32x4 scl[4], shl[4]; v2u nx[4];
#pragma unroll
    for (int j = 0; j < 4; ++j) { scl[j] = *(const f32x4*)(ml + 1024 + 4 * lane + 256 * j) + 1.0f; shl[j] = *(const f32x4*)(ml + 4 * lane + 256 * j); }
    if (gw < S_LAT) { const GAS v2u* xr = (const GAS v2u*)((const bf16*)(a->ws + WS_XB) + (size_t)gw * DM) + lane;
#pragma unroll
        for (int j = 0; j < 4; ++j) nx[j] = xr[64 * j]; }
    for (int r = gw; r < S_LAT; r += NGW) {
        f32x4 h[4];
        { v2u cu[4];
#pragma unroll
          for (int j = 0; j < 4; ++j) cu[j] = nx[j];
          if (r + NGW < S_LAT) { const GAS v2u* xr = (const GAS v2u*)((const bf16*)(a->ws + WS_XB) + (size_t)(r + NGW) * DM) + lane;
#pragma unroll
              for (int j = 0; j < 4; ++j) nx[j] = xr[64 * j]; }
          float s = 0.f;
#pragma unroll
          for (int j = 0; j < 4; ++j) { h[j] = (f32x4){bflo(cu[j].x), bfhi(cu[j].x), bflo(cu[j].y), bfhi(cu[j].y)}; s += (h[j].x * h[j].x + h[j].y * h[j].y) + (h[j].z * h[j].z + h[j].w * h[j].w); }
          const float rstd = __builtin_amdgcn_rsqf(wave_sum(s) * (1.0f / DM) + EPS);
#pragma unroll
          for (int j = 0; j < 4; ++j) h[j] = h[j] * rstd * scl[j] + shl[j]; }
#pragma unroll
        for (int j = 0; j < 4; ++j) ((LAS unsigned*)(lds + ROUTE_ROWS_OFF + wave * 8192 + itn * 1024))[lane + 64 * j] = pk4_fp8(h[j].x * F8_ASCALE, h[j].y * F8_ASCALE, h[j].z * F8_ASCALE, h[j].w * F8_ASCALE);
        float lg[8];
#pragma unroll
        for (int e = 0; e < 8; ++e) lg[e] = 0.f;
#pragma unroll
        for (int j = 0; j < 4; ++j)
#pragma unroll
            for (int i = 0; i < 4; ++i) { const int d = 4 * lane + 256 * j + i; const f32x4 r0 = *(const LAS f32x4*)(rt + d * 8), r1 = *(const LAS f32x4*)(rt + d * 8 + 4); const float hv = h[j][i];
                lg[0] += hv * r0.x; lg[1] += hv * r0.y; lg[2] += hv * r0.z; lg[3] += hv * r0.w; lg[4] += hv * r1.x; lg[5] += hv * r1.y; lg[6] += hv * r1.z; lg[7] += hv * r1.w; }
#pragma unroll
        for (int e = 0; e < 8; ++e) lg[e] = wave_sum(lg[e]);
        int i1 = 0; float v1 = lg[0];
#pragma unroll
        for (int e = 1; e < 8; ++e) if (lg[e] > v1) { v1 = lg[e]; i1 = e; }
        int i2 = -1; float v2 = -INFINITY;
#pragma unroll
        for (int e = 0; e < 8; ++e) if (e != i1 && lg[e] > v2) { v2 = lg[e]; i2 = e; }
        const float w1 = 1.0f / (1.0f + __expf(v2 - v1)), w2 = 1.0f - w1;
        if (lane == 0) {
            const unsigned r1 = __hip_atomic_fetch_add((LAS unsigned*)lcnt + i1, 1u, __ATOMIC_RELAXED, __HIP_MEMORY_SCOPE_WORKGROUP), r2 = __hip_atomic_fetch_add((LAS unsigned*)lcnt + i2, 1u, __ATOMIC_RELAXED, __HIP_MEMORY_SCOPE_WORKGROUP);
            int* ti = tokinfo + (size_t)r * 8;
            ti[0] = i1; ti[1] = i2; ti[4] = __builtin_bit_cast(int, w1); ti[5] = __builtin_bit_cast(int, w2);
            pk0 = (unsigned)i1 | ((unsigned)i2 << 3) | (r1 << 6) | (r2 << 19);
        }
        const unsigned pku = (unsigned)__builtin_amdgcn_readfirstlane((int)pk0);
        if (lane == itn) keep = pku;
        ++itn;
    }
    __syncthreads();
    if (tid < 8) lcnt[8 + tid] = __hip_atomic_fetch_add(cnt + 64 * tid, lcnt[tid], RLX_AGENT);
    __syncthreads();
    { const int r = gw + lane * NGW; if (lane < itn && r < S_LAT) { int* ti = tokinfo + (size_t)r * 8; const unsigned e1 = keep & 7u, e2 = (keep >> 3) & 7u; ti[2] = (int)(((keep >> 6) & 0x1fffu) + lcnt[8 + e1]); ti[3] = (int)((keep >> 19) + lcnt[8 + e2]); } }
}

__device__ __forceinline__ void qk_prep(KA a, int l, int first_thread, int nthreads) {
    bf16* PROJ = (bf16*)(a->ws + WS_PROJ);
    const float* rope = (const float*)(a->ws + WS_VEC) + VO_ROPE;
    for (int i = first_thread; i < R_ALL * 10; i += nthreads) {
        const int row = i / 10, hh = i % 10; const bool isq = hh < 8;
        bf16* p = PROJ + (size_t)row * INW + (isq ? hh * 64 : COL_AK + (hh - 8) * 64);
        const float* gain = (isq ? a->in[I_QG] : a->in[I_KG]) + l * 64;
        float x[64]; float ss = 0.f;
#pragma unroll
        for (int c = 0; c < 8; ++c) { const v4u w = *(const GAS v4u*)(p + 8 * c); unpack8(w, x + 8 * c); }
#pragma unroll
        for (int d = 0; d < 64; ++d) ss += x[d] * x[d];
        const float rstd = __builtin_amdgcn_rsqf(ss * (1.0f / 64.0f) + EPS);
        const f32x4* g4 = (const f32x4*)gain;
#pragma unroll
        for (int c = 0; c < 16; ++c) { const f32x4 gv = g4[c]; x[4 * c] *= rstd * gv.x; x[4 * c + 1] *= rstd * gv.y; x[4 * c + 2] *= rstd * gv.z; x[4 * c + 3] *= rstd * gv.w; }
        if (row < S_LAT) {
            const int gr = row >> 6, gc = row & 63;
            const f32x4* cr = (const f32x4*)(rope + gr * 16); const f32x4* sr = (const f32x4*)(rope + 4096 + gr * 16); const f32x4* cc = (const f32x4*)(rope + 8192 + gc * 16); const f32x4* sc = (const f32x4*)(rope + 8192 + 1024 + gc * 16);
#pragma unroll
            for (int j4 = 0; j4 < 4; ++j4) { const f32x4 cv = cr[j4], sv = sr[j4];
#pragma unroll
                for (int i = 0; i < 4; ++i) { const int j = 4 * j4 + i; const float x1 = x[j], x2 = x[16 + j]; x[j] = x1 * cv[i] - x2 * sv[i]; x[16 + j] = x1 * sv[i] + x2 * cv[i]; } }
#pragma unroll
            for (int j4 = 0; j4 < 4; ++j4) { const f32x4 cv = cc[j4], sv = sc[j4];
#pragma unroll
                for (int i = 0; i < 4; ++i) { const int j = 4 * j4 + i; const float x1 = x[32 + j], x2 = x[48 + j]; x[32 + j] = x1 * cv[i] - x2 * sv[i]; x[48 + j] = x1 * sv[i] + x2 * cv[i]; } }
        }
        const float qs = isq ? 0.125f * 1.4426950408889634f : 1.0f;
#pragma unroll
        for (int c = 0; c < 8; ++c) { v4u w; w.x = pk2(x[8 * c] * qs, x[8 * c + 1] * qs); w.y = pk2(x[8 * c + 2] * qs, x[8 * c + 3] * qs); w.z = pk2(x[8 * c + 4] * qs, x[8 * c + 5] * qs); w.w = pk2(x[8 * c + 6] * qs, x[8 * c + 7] * qs);
            *(GAS v4u*)(p + 8 * c) = w; }
    }
}
__device__ __forceinline__ void gmlp_unit(KA a, int l, int chunk, int g, LAS unsigned char* lds, int tid, int lane, int wave) {
    const bf16* PROJ = (const bf16*)(a->ws + WS_PROJ); bf16* MIX = (bf16*)(a->ws + WS_MIX);
    const int row0 = (chunk < 128) ? chunk * 128 : S_LAT + (chunk - 128) * 128;
    LAS float* vn = (LAS float*)lds;
    { const int pos = tid >> 2, part = tid & 3;
      const bf16* p = PROJ + (size_t)(row0 + pos) * INW + COL_GV + g * 64 + part * 16;
      float x[16]; unpack8(*(const GAS v4u*)p, x); unpack8(*(const GAS v4u*)(p + 8), x + 8);
      float ss = 0.f;
#pragma unroll
      for (int d = 0; d < 16; ++d) { x[d] = gelu1(x[d]); ss += x[d] * x[d]; }
      ss += sx<1>(ss); ss += sx<2>(ss);
      const float rstd = __builtin_amdgcn_rsqf(ss * (1.0f / 64.0f) + EPS);
      const float* gn = a->in[I_GNG] + l * 256 + g * 64 + part * 16;
#pragma unroll
      for (int d = 0; d < 16; ++d) vn[pos * 64 + part * 16 + d] = x[d] * rstd * gn[d]; }
    __syncthreads();
    const int c = lane, t0 = wave * 16;
    const float* W = a->in[I_GWS] + ((size_t)(l * 4 + g) * 128 + t0) * 128;
    float acc[16];
#pragma unroll
    for (int i = 0; i < 16; ++i) acc[i] = 0.f;
    for (int s = 0; s < 128; ++s) { const float v = vn[s * 64 + c];
#pragma unroll
        for (int i = 0; i < 16; ++i) acc[i] += W[i * 128 + s] * v; }
    const float* bs = a->in[I_GBS] + (l * 4 + g) * 128 + t0;
#pragma unroll
    for (int i = 0; i < 16; ++i) { const int row = row0 + t0 + i;
        const float u = gelu1(bflo((unsigned)PROJ[(size_t)row * INW + COL_GU + g * 64 + c]));
        MIX[(size_t)row * DM + MIX_GM + g * 64 + c] = (bf16)f2bf(u * (acc[i] + bs[i])); }
    __syncthreads();
}
__device__ __forceinline__ void hgrn_naive(KA a, int l, int dir, int head, LAS unsigned char* lds, int tid, int lane, int wave) {
    const bf16* PROJ = (const bf16*)(a->ws + WS_PROJ);
    float* HGO = (float*)(a->ws + WS_HGO) + (size_t)dir * R_ALL * 256;
    LAS float* Qs = (LAS float*)lds;
    LAS float* Fs = Qs + 4096; LAS float* Vs = Fs + 4096; LAS float* part = Vs + 4096;
    const int v = lane, kg = wave;
    float S[8];
#pragma unroll
    for (int i = 0; i < 8; ++i) S[i] = 0.f;
    const int tl = tid >> 3, c8 = tid & 7;
    float lb[8];
#pragma unroll
    for (int j = 0; j < 8; ++j) { float b = 0.f; if (l == 1) { const float p0 = a->in[I_HLB][dir * 512 + head * 64 + c8 * 8 + j], p1 = a->in[I_HLB][dir * 512 + 256 + head * 64 + c8 * 8 + j]; b = 1.0f / (1.0f + __expf(p0 - p1)); } lb[j] = b; }
    const int fcol = (dir == 0 ? COL_HFF : COL_HFB) + head * 64 + c8 * 8;
    for (int n0 = 0; n0 < R_ALL; n0 += 64) {
        { const int n = n0 + tl; int row;
          if (dir == 0) row = (n < C_CTX) ? S_LAT + n : n - C_CTX; else row = (n < C_CTX) ? S_LAT + (C_CTX - 1 - n) : (S_LAT - 1) - (n - C_CTX);
          const bf16* pr = PROJ + (size_t)row * INW;
          float q[8], f[8], vv[8];
          unpack8(*(const GAS v4u*)(pr + COL_HQ + head * 64 + c8 * 8), q); unpack8(*(const GAS v4u*)(pr + fcol), f); unpack8(*(const GAS v4u*)(pr + COL_HI + head * 64 + c8 * 8), vv);
#pragma unroll
          for (int j = 0; j < 8; ++j) { Qs[tl * 64 + c8 * 8 + j] = silu1(q[j]) * 0.125f; Fs[tl * 64 + c8 * 8 + j] = lb[j] + (1.0f - lb[j]) * sigm1(f[j]); Vs[tl * 64 + c8 * 8 + j] = vv[j]; } }
        __syncthreads();
        for (int t = 0; t < 64; ++t) {
            const float vt = Vs[t * 64 + v]; float po = 0.f;
#pragma unroll
            for (int i = 0; i < 8; ++i) { const float f = Fs[t * 64 + kg * 8 + i], q = Qs[t * 64 + kg * 8 + i]; S[i] = f * S[i] + (1.0f - f) * vt; po += S[i] * q; }
            part[((t & 1) * 8 + kg) * 64 + v] = po;
            __syncthreads();
            if (wave == 0) { float o = 0.f;
#pragma unroll
                for (int w8 = 0; w8 < 8; ++w8) o += part[((t & 1) * 8 + w8) * 64 + v];
                const int n = n0 + t; int row;
                if (dir == 0) row = (n < C_CTX) ? S_LAT + n : n - C_CTX; else row = (n < C_CTX) ? S_LAT + (C_CTX - 1 - n) : (S_LAT - 1) - (n - C_CTX);
                HGO[(size_t)row * 256 + head * 64 + v] = o; }
        }
        __syncthreads();
    }
}

typedef short bf16x8v __attribute__((ext_vector_type(8)));
constexpr int HST = 72;
__device__ __forceinline__ f32x4 mma16(const LAS bf16* MA, const LAS bf16* MBt, int k0, f32x4 c, int lane) {
    const bf16x8v av = *(const LAS bf16x8v*)(MA + (lane & 15) * HST + k0 + 8 * (lane >> 4));
    const bf16x8v bv = *(const LAS bf16x8v*)(MBt + (lane & 15) * HST + k0 + 8 * (lane >> 4));
    return __builtin_amdgcn_mfma_f32_16x16x32_bf16(av, bv, c, 0, 0, 0);
}
__device__ __forceinline__ int hg_base_row(int cpos) { return cpos < 256 ? 64 * cpos : S_LAT + 64 * (cpos - 256); }
__device__ __forceinline__ int hg_scan_idx(int dir, int cpos) { return dir == 0 ? (cpos < 256 ? 4 + cpos : cpos - 256) : (cpos < 256 ? 4 + (255 - cpos) : 3 - (cpos - 256)); }
__device__ __forceinline__ float hg_lb(KA a, int l, int dir, int head, int k) {
    if (l == 0) return 0.f;
    const float p0 = a->in[I_HLB][dir * 512 + head * 64 + k], p1 = a->in[I_HLB][dir * 512 + 256 + head * 64 + k];
    return 1.0f / (1.0f + __expf(p0 - p1));
}
__device__ __forceinline__ void hgrn_stepA(KA a, int l, int cpos, int head, LAS unsigned char* lds, int lane, int wave) {
    const bf16* PROJ = (const bf16*)(a->ws + WS_PROJ);
    const int dir = wave >> 2, I = wave & 3, base = hg_base_row(cpos), ci = hg_scan_idx(dir, cpos);
    LAS float* TOT = (LAS float*)lds;
    LAS bf16* KLT = (LAS bf16*)(lds + 2048) + dir * 64 * HST;
    LAS bf16* VT = (LAS bf16*)(lds + 2048 + 2 * 64 * HST * 2) + dir * 64 * HST;
    const float lb = hg_lb(a, l, dir, head, lane);
    const int fcol = (dir == 0 ? COL_HFF : COL_HFB) + head * 64 + lane, vcol = COL_HI + head * 64 + lane;
    float kk[16], cl[16]; float run = 0.f;
#pragma unroll
    for (int i = 0; i < 16; ++i) { const int n = 16 * I + i, row = base + (dir ? 63 - n : n);
        const float fl = bflo((unsigned)PROJ[(size_t)row * INW + fcol]);
        const unsigned short vb = PROJ[(size_t)row * INW + vcol];
        const float f = lb + (1.0f - lb) * sigm1(fl);
        run += __logf(f); cl[i] = run; kk[i] = 1.0f - f;
        VT[lane * HST + n] = vb; }
    TOT[(dir * 4 + I) * 64 + lane] = run;
    __syncthreads();
    float post = 0.f, all = 0.f;
#pragma unroll
    for (int J = 0; J < 4; ++J) { const float t = TOT[(dir * 4 + J) * 64 + lane]; all += t; if (J > I) post += t; }
#pragma unroll
    for (int i = 0; i < 16; ++i) KLT[lane * HST + 16 * I + i] = (bf16)f2bf(kk[i] * __expf(run - cl[i] + post));
    if (I == 0) ((float*)(a->ws + WS_HDG))[((size_t)(dir * 4 + head) * 260 + ci) * 64 + lane] = __expf(all);
    __syncthreads();
    float* LT = (float*)(a->ws + WS_HLT) + ((size_t)(dir * 4 + head) * 260 + ci) * 4096;
    float z0 = 0.f; asm volatile("" : "+v"(z0));
#pragma unroll
    for (int kb = 0; kb < 4; ++kb) { f32x4 acc = {z0, z0, z0, z0};
        acc = mma16(VT + 16 * I * HST, KLT + 16 * kb * HST, 0, acc, lane); acc = mma16(VT + 16 * I * HST, KLT + 16 * kb * HST, 32, acc, lane);
#pragma unroll
        for (int r = 0; r < 4; ++r) LT[(16 * I + 4 * (lane >> 4) + r) * 64 + 16 * kb + (lane & 15)] = acc[r]; }
    __syncthreads();
}
__device__ __forceinline__ void hgrn_stepB(KA a, int item, int tid) {
    const int dh = item >> 3, vb = item & 7, v = vb * 8 + (tid >> 6), k = tid & 63;
    const float* LT = (const float*)(a->ws + WS_HLT) + (size_t)dh * 260 * 4096 + v * 64 + k;
    const float* DG = (const float*)(a->ws + WS_HDG) + (size_t)dh * 260 * 64 + k;
    bf16* SP = (bf16*)(a->ws + WS_HSP) + (size_t)dh * 260 * 4096 + v * 64 + k;
    float S = 0.f;
#pragma unroll 1
    for (int c0 = 0; c0 < 260; c0 += 26) {
        float lt[26], dg[26];
#pragma unroll
        for (int j = 0; j < 26; ++j) { lt[j] = LT[(size_t)(c0 + j) * 4096]; dg[j] = DG[(c0 + j) * 64]; }
#pragma unroll
        for (int j = 0; j < 26; ++j) { SP[(size_t)(c0 + j) * 4096] = (bf16)f2bf(S); S = dg[j] * S + lt[j]; }
    }
}
__device__ __forceinline__ void hgrn_stepC(KA a, int l, int cpos, int head, LAS unsigned char* lds, int tid, int lane, int wave) {
    const bf16* PROJ = (const bf16*)(a->ws + WS_PROJ); bf16* MIX = (bf16*)(a->ws + WS_MIX);
    const int dir = wave >> 2, I = wave & 3, base = hg_base_row(cpos), ci = hg_scan_idx(dir, cpos);
    constexpr int MSZ = 64 * HST;
    LAS float* TOT = (LAS float*)lds;
    LAS bf16* img = (LAS bf16*)(lds + 2048);
    LAS bf16* QT = img + dir * MSZ;
    LAS bf16* QD = img + 2 * MSZ + dir * MSZ;
    LAS bf16* VT = img + 4 * MSZ + dir * MSZ;
    LAS bf16* ST = img + 6 * MSZ + dir * MSZ;
    LAS bf16* AS = img + 8 * MSZ + dir * MSZ + I * 16 * HST;
    LAS bf16* KT = img + 10 * MSZ + dir * (10 * 16 * HST);
    LAS float* OS = (LAS float*)(img + 10 * MSZ);
    const float lb = hg_lb(a, l, dir, head, lane);
    const int fcol = (dir == 0 ? COL_HFF : COL_HFB) + head * 64 + lane, qcol = COL_HQ + head * 64 + lane, vcol = COL_HI + head * 64 + lane;
    { const bf16* SP = (const bf16*)(a->ws + WS_HSP) + ((size_t)(dir * 4 + head) * 260 + ci) * 4096;
#pragma unroll
      for (int h2 = 0; h2 < 2; ++h2) { const int e = ((I * 2 + h2) * 64 + lane) * 8, vv = e >> 6, kk0 = e & 63;
          *(LAS v4u*)(ST + vv * HST + kk0) = *(const GAS v4u*)(SP + e); } }
    float kk[16], cl[16], qv[16]; float run = 0.f;
#pragma unroll
    for (int i = 0; i < 16; ++i) { const int n = 16 * I + i, row = base + (dir ? 63 - n : n);
        const float fl = bflo((unsigned)PROJ[(size_t)row * INW + fcol]), ql = bflo((unsigned)PROJ[(size_t)row * INW + qcol]);
        const unsigned short vb = PROJ[(size_t)row * INW + vcol];
        const float f = lb + (1.0f - lb) * sigm1(fl);
        run += __logf(f); cl[i] = run; kk[i] = 1.0f - f; qv[i] = silu1(ql) * 0.125f;
        VT[lane * HST + n] = vb; }
    TOT[(dir * 4 + I) * 64 + lane] = run;
    __syncthreads();
    float tj[4];
#pragma unroll
    for (int J = 0; J < 4; ++J) tj[J] = TOT[(dir * 4 + J) * 64 + lane];
    float pre = 0.f;
#pragma unroll
    for (int J = 0; J < 4; ++J) if (J < I) pre += tj[J];
    const float epre = __expf(pre); float kei[16];
#pragma unroll
    for (int i = 0; i < 16; ++i) { const float e = __expf(cl[i]); QT[(16 * I + i) * HST + lane] = (bf16)f2bf(qv[i] * e); QD[(16 * I + i) * HST + lane] = (bf16)f2bf(qv[i] * e * epre); kei[i] = kk[i] * fminf(__builtin_amdgcn_rcpf(e), 5.5e34f); }
    float eoff = 0.f;
#pragma unroll
    for (int I2 = 0; I2 < 4; ++I2) {
        if (I2 >= I) {
            if (I2 == I) eoff = 0.f; else if (I2 == I + 1) eoff = run; else eoff += tj[I2 - 1];
            LAS bf16* blk = KT + (I2 * (I2 + 1) / 2 + I) * 16 * HST;
            const float fo = __expf(eoff);
#pragma unroll
            for (int i = 0; i < 16; ++i) blk[i * HST + lane] = (bf16)f2bf(kei[i] * fo);
        }
    }
    __syncthreads();
    float z0 = 0.f; asm volatile("" : "+v"(z0));
    f32x4 sc[4];
#pragma unroll
    for (int J = 0; J < 4; ++J) { sc[J] = (f32x4){z0, z0, z0, z0};
        if (J <= I) { const LAS bf16* kb = KT + (I * (I + 1) / 2 + J) * 16 * HST;
            sc[J] = mma16(QT + 16 * I * HST, kb, 0, sc[J], lane); sc[J] = mma16(QT + 16 * I * HST, kb, 32, sc[J], lane);
            if (J == I) {
#pragma unroll
                for (int r = 0; r < 4; ++r) if ((lane & 15) > 4 * (lane >> 4) + r) sc[J][r] = z0; } } }
#pragma unroll
    for (int J = 0; J < 4; ++J)
#pragma unroll
        for (int r = 0; r < 4; ++r) AS[(4 * (lane >> 4) + r) * HST + 16 * J + (lane & 15)] = (bf16)f2bf(sc[J][r]);
    asm volatile("s_waitcnt lgkmcnt(0)" ::: "memory");
    f32x4 acc[4];
#pragma unroll
    for (int vb = 0; vb < 4; ++vb) { acc[vb] = (f32x4){z0, z0, z0, z0};
        acc[vb] = mma16(AS, VT + 16 * vb * HST, 0, acc[vb], lane); acc[vb] = mma16(AS, VT + 16 * vb * HST, 32, acc[vb], lane);
        acc[vb] = mma16(QD + 16 * I * HST, ST + 16 * vb * HST, 0, acc[vb], lane); acc[vb] = mma16(QD + 16 * I * HST, ST + 16 * vb * HST, 32, acc[vb], lane); }
    __syncthreads();
#pragma unroll
    for (int vb = 0; vb < 4; ++vb)
#pragma unroll
        for (int r = 0; r < 4; ++r) { const int n = 16 * I + 4 * (lane >> 4) + r, rl = dir ? 63 - n : n; OS[(dir * 64 + rl) * 68 + 16 * vb + (lane & 15)] = acc[vb][r]; }
    __syncthreads();
    { const int rl = tid >> 3, v8 = (tid & 7) * 8, row = base + rl;
      float o[8]; float ss = 0.f;
#pragma unroll
      for (int j = 0; j < 8; ++j) { o[j] = OS[rl * 68 + v8 + j] + OS[(64 + rl) * 68 + v8 + j]; ss += o[j] * o[j]; }
      ss += sx<1>(ss); ss += sx<2>(ss); ss += sx<4>(ss);
      const float rstd = __builtin_amdgcn_rsqf(ss * (1.0f / 64.0f) + EPS);
      float gt[8]; unpack8(*(const GAS v4u*)(PROJ + (size_t)row * INW + COL_HG + head * 64 + v8), gt);
      const float* gn = a->in[I_HGAIN] + l * 64 + v8;
      float y[8];
#pragma unroll
      for (int j = 0; j < 8; ++j) y[j] = o[j] * rstd * gn[j] * silu1(gt[j]);
      v4u w; w.x = pk2(y[0], y[1]); w.y = pk2(y[2], y[3]); w.z = pk2(y[4], y[5]); w.w = pk2(y[6], y[7]);
      *(GAS v4u*)(MIX + (size_t)row * DM + MIX_HG + head * 64 + v8) = w; }
    __syncthreads();
}

__device__ __forceinline__ void vt_item(KA a, int item, int lane) {
    const bf16* PROJ = (const bf16*)(a->ws + WS_PROJ); bf16* VTg = (bf16*)(a->ws + WS_VT);
    const int rb = item >> 1, hk = item & 1, row = rb * 64 + lane;
    const bf16* p = PROJ + (size_t)row * INW + COL_AV + hk * 64;
    unsigned w[32];
#pragma unroll
    for (int c = 0; c < 8; ++c) { const v4u t = *(const GAS v4u*)(p + 8 * c); w[4 * c] = t.x; w[4 * c + 1] = t.y; w[4 * c + 2] = t.z; w[4 * c + 3] = t.w; }
    bf16* o = VTg + (size_t)hk * 64 * R_ALL + row;
#pragma unroll
    for (int d2 = 0; d2 < 32; ++d2) { o[(size_t)(2 * d2) * R_ALL] = (bf16)(w[d2] & 0xffffu); o[(size_t)(2 * d2 + 1) * R_ALL] = (bf16)(w[d2] >> 16); }
}
__device__ __forceinline__ void attn_unit(KA a, int l, int u, LAS unsigned char* lds, int tid, int lane, int wave) {
    asm volatile("" : "+v"(tid), "+v"(lane));
    const bf16* PROJ = (const bf16*)(a->ws + WS_PROJ); const bf16* VTg = (const bf16*)(a->ws + WS_VT); bf16* MIX = (bf16*)(a->ws + WS_MIX);
    const bool isctx = u >= 256; const int uu = isctx ? u - 256 : u; const int n = uu >> 1, hk = uu & 1;
    const int qh = hk * 4 + (wave >> 1), half = wave & 1;
    const int qbase = (isctx ? S_LAT : 0) + n * 128 + half * 64, qpos0 = n * 128 + half * 64;
    const int c = lane & 15, g = lane >> 4;
    LAS bf16* Kt = (LAS bf16*)lds; LAS bf16* Vt = Kt + 64 * HST; LAS bf16* Qw = Vt + 64 * HST + wave * 64 * HST;
#pragma unroll
    for (int j = 0; j < 8; ++j) { const int qr = 8 * j + (lane >> 3), qc = (lane & 7) * 8;
        *(LAS v4u*)(Qw + qr * HST + qc) = *(const GAS v4u*)(PROJ + (size_t)(qbase + qr) * INW + qh * 64 + qc); }
    float z0 = 0.f; asm volatile("" : "+v"(z0));
    f32x4 o[4][4]; float ls[4];
    float gq = 0.f, gk = 0.f;
#pragma unroll 8
    for (int d = 0; d < 64; ++d) { gq = fmaxf(gq, fabsf(a->in[I_QG][l * 64 + d])); gk = fmaxf(gk, fabsf(a->in[I_KG][l * 64 + d])); }
    const float nbnd = -(8.0f * 1.4426950408889634f) * gq * gk;
    const f32x4 nb4 = {nbnd, nbnd, nbnd, nbnd};
    const float sink = a->in[I_SINK][l * 8 + qh] * 1.4426950408889634f;
#pragma unroll
    for (int qt = 0; qt < 4; ++qt) { ls[qt] = (g == 0) ? __builtin_amdgcn_exp2f(sink + nbnd) : z0;
#pragma unroll
        for (int dt = 0; dt < 4; ++dt) o[qt][dt] = (f32x4){z0, z0, z0, z0}; }
    const int first = (!isctx && n == 0) ? 2 : 0, nwin = isctx ? 0 : ((n == 0 || n == 127) ? 4 : 6), nt = nwin + 4;
    const int lr = tid >> 3, lc = (tid & 7) * 8;
    v4u kreg, vreg;
#define ATT_LOADT(i) do { const bool ct_ = (i) >= nwin; const int kb_ = ct_ ? S_LAT + 64 * ((i) - nwin) : (n - 1) * 128 + 64 * (first + (i)); \
        kreg = *(const GAS v4u*)(PROJ + (size_t)(kb_ + lr) * INW + COL_AK + hk * 64 + lc); vreg = *(const GAS v4u*)(VTg + ((size_t)hk * 64 + lr) * R_ALL + kb_ + lc); } while (0)
    ATT_LOADT(0);
#pragma unroll 1
    for (int i = 0; i < nt; ++i) {
        __syncthreads();
        *(LAS v4u*)(Kt + lr * HST + lc) = kreg; *(LAS v4u*)(Vt + lr * HST + lc) = vreg;
        __syncthreads();
        if (i + 1 < nt) ATT_LOADT(i + 1);
        const bool win = i < nwin; const int kb = (n - 1) * 128 + 64 * (first + i);
        const int rel = kb - qpos0;
        const bool maskw = win && (rel == 128 || rel == -128);
        if (win && (rel >= 192 || rel <= -192)) continue;
        bf16x8v kf[4][2], vf[4][2];
#pragma unroll
        for (int kt = 0; kt < 4; ++kt)
#pragma unroll
            for (int ks = 0; ks < 2; ++ks) kf[kt][ks] = *(const LAS bf16x8v*)(Kt + (16 * kt + c) * HST + 32 * ks + 8 * g);
#pragma unroll
        for (int dt = 0; dt < 4; ++dt)
#pragma unroll
            for (int s2 = 0; s2 < 2; ++s2) { const v2u lo = *(const LAS v2u*)(Vt + (16 * dt + c) * HST + 32 * s2 + 4 * g), hi = *(const LAS v2u*)(Vt + (16 * dt + c) * HST + 32 * s2 + 16 + 4 * g);
                const v4u t = {lo.x, lo.y, hi.x, hi.y}; vf[dt][s2] = __builtin_bit_cast(bf16x8v, t); }
        f32x4 sA[4], sB[4];
#define ATT_SCORES(QT, S_) do { const bf16x8v q0_ = *(const LAS bf16x8v*)(Qw + (16 * (QT) + c) * HST + 8 * g), q1_ = *(const LAS bf16x8v*)(Qw + (16 * (QT) + c) * HST + 32 + 8 * g); \
            _Pragma("unroll") for (int kt = 0; kt < 4; ++kt) { S_[kt] = __builtin_amdgcn_mfma_f32_16x16x32_bf16(kf[kt][0], q0_, nb4, 0, 0, 0); S_[kt] = __builtin_amdgcn_mfma_f32_16x16x32_bf16(kf[kt][1], q1_, S_[kt], 0, 0, 0); } } while (0)
#define ATT_REST(QT, S_) do { \
            if (maskw) { const int dq = qpos0 + 16 * (QT) + c - kb - 4 * g; \
                _Pragma("unroll") for (int kt = 0; kt < 4; ++kt) _Pragma("unroll") for (int r = 0; r < 4; ++r) { const int dl = dq - 16 * kt - r; if (dl > 128 || dl < -128) S_[kt][r] = -INFINITY; } } \
            float ps = 0.f; \
            _Pragma("unroll") for (int kt = 0; kt < 4; ++kt) _Pragma("unroll") for (int r = 0; r < 4; ++r) { S_[kt][r] = __builtin_amdgcn_exp2f(S_[kt][r]); ps += S_[kt][r]; } \
            ls[QT] += ps; \
            bf16x8v pb[2]; \
            _Pragma("unroll") for (int s2 = 0; s2 < 2; ++s2) { const v4u t = {pk2(S_[2 * s2][0], S_[2 * s2][1]), pk2(S_[2 * s2][2], S_[2 * s2][3]), pk2(S_[2 * s2 + 1][0], S_[2 * s2 + 1][1]), pk2(S_[2 * s2 + 1][2], S_[2 * s2 + 1][3])}; pb[s2] = __builtin_bit_cast(bf16x8v, t); } \
            _Pragma("unroll") for (int dt = 0; dt < 4; ++dt) { o[QT][dt] = __builtin_amdgcn_mfma_f32_16x16x32_bf16(vf[dt][0], pb[0], o[QT][dt], 0, 0, 0); o[QT][dt] = __builtin_amdgcn_mfma_f32_16x16x32_bf16(vf[dt][1], pb[1], o[QT][dt], 0, 0, 0); } } while (0)
        ATT_SCORES(0, sA);
        ATT_SCORES(1, sB); ATT_REST(0, sA);
        ATT_SCORES(2, sA); ATT_REST(1, sB);
        ATT_SCORES(3, sB); ATT_REST(2, sA);
        ATT_REST(3, sB);
#undef ATT_SCORES
#undef ATT_REST
    }
#undef ATT_LOADT
    int c2 = lane & 15, g2 = lane >> 4; asm volatile("" : "+v"(c2), "+v"(g2));
#pragma unroll
    for (int qt = 0; qt < 4; ++qt) { float lt = ls[qt]; lt += sx<16>(lt); lt = sx32_add(lt); const float inv = 1.0f / lt;
        bf16* op = (bf16*)(a->ws + WS_MIX) + (size_t)(qbase + 16 * qt + c2) * DM + MIX_AT + qh * 64 + 4 * g2;
#pragma unroll
        for (int dt = 0; dt < 4; ++dt) { v2u w; w.x = pk2(o[qt][dt][0] * inv, o[qt][dt][1] * inv); w.y = pk2(o[qt][dt][2] * inv, o[qt][dt][3] * inv); *(GAS v2u*)(op + 16 * dt) = w; } }
}

constexpr int GST = 136;
__device__ __forceinline__ f32x4 mma16g(const LAS bf16* MA, const LAS bf16* MBt, int k0, f32x4 c, int lane) {
    const bf16x8v av = *(const LAS bf16x8v*)(MA + (lane & 15) * GST + k0 + 8 * (lane >> 4));
    const bf16x8v bv = *(const LAS bf16x8v*)(MBt + (lane & 15) * GST + k0 + 8 * (lane >> 4));
    return __builtin_amdgcn_mfma_f32_16x16x32_bf16(av, bv, c, 0, 0, 0);
}
__device__ __forceinline__ float gelu_as(float v) {
    const float av = fabsf(v), t = __builtin_amdgcn_rcpf(av * 0.2316418882f + 1.0f);
    float q = t * 0.5307027145f + (-0.7265760135f); q = q * t + 0.7107068705f; q = q * t + (-0.142248368f); q = q * t + 0.127414796f; q = q * t;
    const float e = __builtin_amdgcn_exp2f((v * v) * (-0.72134752044f)), mm = v * (q * e);
    return v < 0.f ? mm : v - mm;
}
__device__ __forceinline__ void gmlp_unit_mma(KA a, int l, int chunk, int g, LAS unsigned char* lds, int tid, int lane, int wave) {
    const bf16* PROJ = (const bf16*)(a->ws + WS_PROJ); bf16* MIX = (bf16*)(a->ws + WS_MIX);
    const int row0 = (chunk < 128) ? chunk * 128 : S_LAT + (chunk - 128) * 128;
    LAS bf16* WA = (LAS bf16*)lds;
    LAS bf16* VNT = WA + 128 * GST;
    LAS float* OUT = (LAS float*)(VNT + 64 * GST);
    const int pos = tid >> 2, part = tid & 3;
    {
      const float* W = a->in[I_GWS] + ((size_t)(l * 4 + g) * 128 + pos) * 128 + part * 32;
#pragma unroll
      for (int j = 0; j < 4; ++j) { const f32x4 w0 = *(const GAS f32x4*)(W + 8 * j), w1 = *(const GAS f32x4*)(W + 8 * j + 4);
          v4u o; o.x = pk2(w0.x, w0.y); o.y = pk2(w0.z, w0.w); o.z = pk2(w1.x, w1.y); o.w = pk2(w1.z, w1.w);
          *(LAS v4u*)(WA + pos * GST + part * 32 + 8 * j) = o; } }
    { const bf16* p = PROJ + (size_t)(row0 + pos) * INW + COL_GV + g * 64 + part * 16;
      float x[16]; unpack8(*(const GAS v4u*)p, x); unpack8(*(const GAS v4u*)(p + 8), x + 8);
      float ss = 0.f;
#pragma unroll
      for (int d = 0; d < 16; ++d) { x[d] = gelu_as(x[d]); ss += x[d] * x[d]; }
      ss += sx<1>(ss); ss += sx<2>(ss);
      const float rstd = __builtin_amdgcn_rsqf(ss * (1.0f / 64.0f) + EPS);
      const float* gn = a->in[I_GNG] + l * 256 + g * 64 + part * 16;
#pragma unroll
      for (int d = 0; d < 16; ++d) VNT[(part * 16 + d) * GST + pos] = (bf16)f2bf(x[d] * rstd * gn[d]); }
    __syncthreads();
    float z0 = 0.f; asm volatile("" : "+v"(z0));
#pragma unroll
    for (int cb = 0; cb < 4; ++cb) { f32x4 acc = {z0, z0, z0, z0};
#pragma unroll
        for (int ks = 0; ks < 4; ++ks) acc = mma16g(WA + 16 * wave * GST, VNT + 16 * cb * GST, 32 * ks, acc, lane);
#pragma unroll
        for (int r = 0; r < 4; ++r) OUT[(16 * wave + 4 * (lane >> 4) + r) * 68 + 16 * cb + (lane & 15)] = acc[r]; }
    __syncthreads();
    { const int row = row0 + pos; const float bsv = a->in[I_GBS][(l * 4 + g) * 128 + pos];
      const bf16* pu = PROJ + (size_t)row * INW + COL_GU + g * 64 + part * 16;
      float u[16]; unpack8(*(const GAS v4u*)pu, u); unpack8(*(const GAS v4u*)(pu + 8), u + 8);
      float y[16];
#pragma unroll
      for (int d = 0; d < 16; ++d) y[d] = gelu_as(u[d]) * (OUT[pos * 68 + part * 16 + d] + bsv);
      bf16* po = MIX + (size_t)row * DM + MIX_GM + g * 64 + part * 16;
      v4u w; w.x = pk2(y[0], y[1]); w.y = pk2(y[2], y[3]); w.z = pk2(y[4], y[5]); w.w = pk2(y[6], y[7]); *(GAS v4u*)po = w;
      w.x = pk2(y[8], y[9]); w.y = pk2(y[10], y[11]); w.z = pk2(y[12], y[13]); w.w = pk2(y[14], y[15]); *(GAS v4u*)(po + 8) = w; }
    __syncthreads();
}
__device__ __forceinline__ void attn_naive(KA a, int l, int nrows, int lane, int wave, int G, int bid) {
    const bf16* PROJ = (const bf16*)(a->ws + WS_PROJ); bf16* MIX = (bf16*)(a->ws + WS_MIX);
    const int gw = bid * NWAVES + wave, NGW = G * NWAVES;
    for (int pair = gw; pair < nrows * 2; pair += NGW) {
        const int row = pair >> 1, hk = pair & 1; const bool isctx = row >= S_LAT;
        float q[4], o[4], m[4], ls[4];
#pragma unroll
        for (int g = 0; g < 4; ++g) { q[g] = bflo((unsigned)PROJ[(size_t)row * INW + (hk * 4 + g) * 64 + lane]); o[g] = 0.f; ls[g] = 1.0f; m[g] = a->in[I_SINK][l * 8 + hk * 4 + g] * 1.4426950408889634f; }
        int j0 = 0, j1 = -1;
        if (!isctx) { j0 = row - 128 < 0 ? 0 : row - 128; j1 = row + 128 > S_LAT - 1 ? S_LAT - 1 : row + 128; }
        const int nwin = j1 - j0 + 1;
        const int nk = nwin + C_CTX;
#pragma unroll 4
        for (int t = 0; t < nk; ++t) {
            const int krow = (t < nwin) ? j0 + t : S_LAT + (t - nwin);
            const float k = bflo((unsigned)PROJ[(size_t)krow * INW + COL_AK + hk * 64 + lane]);
            const float v = bflo((unsigned)PROJ[(size_t)krow * INW + COL_AV + hk * 64 + lane]);
#pragma unroll
            for (int g = 0; g < 4; ++g) { const float s = wave_sum(q[g] * k); const float mn = fmaxf(m[g], s);
                const float c = __builtin_amdgcn_exp2f(m[g] - mn), p = __builtin_amdgcn_exp2f(s - mn);
                ls[g] = ls[g] * c + p; o[g] = o[g] * c + p * v; m[g] = mn; }
        }
#pragma unroll
        for (int g = 0; g < 4; ++g) MIX[(size_t)row * DM + MIX_AT + (hk * 4 + g) * 64 + lane] = (bf16)f2bf(o[g] / ls[g]);
    }
}
__device__ __forceinline__ void hgrn_combine(KA a, int l, int nrows, int lane, int wave, int G, int bid) {
    const bf16* PROJ = (const bf16*)(a->ws + WS_PROJ); bf16* MIX = (bf16*)(a->ws + WS_MIX);
    const float* O0 = (const float*)(a->ws + WS_HGO); const float* O1 = O0 + (size_t)R_ALL * 256;
    const f32x4 gn = *(const f32x4*)(a->in[I_HGAIN] + l * 64 + (lane & 15) * 4);
    const int gw = bid * NWAVES + wave, NGW = G * NWAVES;
    for (int r = gw; r < nrows; r += NGW) {
        const f32x4 o = *(const GAS f32x4*)(O0 + (size_t)r * 256 + 4 * lane) + *(const GAS f32x4*)(O1 + (size_t)r * 256 + 4 * lane);
        float ss = (o.x * o.x + o.y * o.y) + (o.z * o.z + o.w * o.w);
        ss += sx<1>(ss); ss += sx<2>(ss); ss += sx<4>(ss); ss += sx<8>(ss);
        const float rstd = __builtin_amdgcn_rsqf(ss * (1.0f / 64.0f) + EPS);
        const v2u gw2 = *(const GAS v2u*)(PROJ + (size_t)r * INW + COL_HG + 4 * lane);
        const float g0 = bflo(gw2.x), g1 = bfhi(gw2.x), g2 = bflo(gw2.y), g3 = bfhi(gw2.y);
        v2u w; w.x = pk2(o.x * rstd * gn.x * silu1(g0), o.y * rstd * gn.y * silu1(g1)); w.y = pk2(o.z * rstd * gn.z * silu1(g2), o.w * rstd * gn.w * silu1(g3));
        *(GAS v2u*)(MIX + (size_t)r * DM + MIX_HG + 4 * lane) = w;
    }
}
__device__ __forceinline__ void moe_gather(KA a, LAS unsigned char* lds, int tid, int lane, int wave, int G, int bid) {
    LAS int* sb = (LAS int*)lds;
    const unsigned* cnt = (const unsigned*)(a->ws + WS_CTL) + CW_MOECNT;
    int* mi = (int*)(a->ws + WS_VEC) + VO_MOE;
    if (tid < 8) sb[16 + tid] = (int)__hip_atomic_load(cnt + 64 * tid, RLX_AGENT);
    __syncthreads();
    if (tid == 0) { int b = 0;
#pragma unroll
        for (int e = 0; e < 8; ++e) { sb[e] = b; b += ((sb[16 + e] + 255) >> 8) << 8; }
        sb[8] = b; }
    __syncthreads();
    if (bid == 0) {
        if (tid == 0) mi[0] = sb[8] >> 8;
        if (tid < 8) mi[160 + tid] = sb[tid + 1] >> 8;
        for (int t = tid; t < (sb[8] >> 8); t += NTHR) { int e = 0;
#pragma unroll
            for (int j = 1; j < 8; ++j) e += (t >= (sb[j] >> 8)) ? 1 : 0;
            mi[16 + t] = e; } }
    unsigned char* AS = (unsigned char*)(a->ws + WS_AS);
    const int* tokinfo = (const int*)(a->ws + WS_TOK); int* tokslot = (int*)(a->ws + WS_TOK) + S_LAT * 8;
    const int gw = bid * NWAVES + wave, NGW = G * NWAVES;
    int kq = 0;
    for (int t = gw; t < S_LAT; t += NGW, ++kq) {
        const int* ti = tokinfo + (size_t)t * 8;
        const int e1 = ti[0], e2 = ti[1], r1 = ti[2], r2 = ti[3];
        const int s1 = sb[e1] + r1, s2 = sb[e2] + r2;
        const v4u x0 = ((const LAS v4u*)(lds + ROUTE_ROWS_OFF + wave * 8192 + kq * 1024))[lane];
        ((GAS v4u*)(AS + (size_t)s1 * DM))[lane] = x0; ((GAS v4u*)(AS + (size_t)s2 * DM))[lane] = x0;
        if (lane == 0) { int* ts = tokslot + (size_t)t * 4; ts[0] = s1; ts[1] = s2; ts[2] = ti[4]; ts[3] = ti[5]; }
    }
    { const f32x4 z4 = {0.f, 0.f, 0.f, 0.f}; for (int i = bid * NTHR + tid; i < 8 * 256 * DM / 4; i += G * NTHR) ((GAS f32x4*)(a->ws + WS_YF))[i] = z4; }
    for (int e = 0; e < 8; ++e) { const int c = sb[16 + e], pe = (c + 255) & ~255, b = sb[e];
        for (int j = c + gw; j < pe; j += NGW) { const v4u z = {0u, 0u, 0u, 0u}; ((GAS v4u*)(AS + (size_t)(b + j) * DM))[lane] = z; } }
}
__device__ __forceinline__ void moe_combine(KA a, int lane, int wave, int G, int bid) {
    const float* gf = (const float*)(a->ws + WS_VEC) + VO_MOD + (1 * 2 + 0) * 6144 + 5 * 1024;
    const bf16* Y = (const bf16*)(a->ws + WS_Y); const int* tokslot = (const int*)(a->ws + WS_TOK) + S_LAT * 8; const float* YF = (const float*)(a->ws + WS_YF);
    const int gw = bid * NWAVES + wave, NGW = G * NWAVES;
    f32x4 gl[4];
#pragma unroll
    for (int j = 0; j < 4; ++j) gl[j] = *(const f32x4*)(gf + 4 * lane + 256 * j);
    int n0 = 0, n1 = 0, n2 = 0, n3 = 0;
    if (gw < S_LAT) { const int* ts = tokslot + (size_t)gw * 4; n0 = ts[0]; n1 = ts[1]; n2 = ts[2]; n3 = ts[3]; }
    for (int t = gw; t < S_LAT; t += NGW) {
        const int s1 = n0, s2 = n1; const float w1 = __builtin_bit_cast(float, n2), w2 = __builtin_bit_cast(float, n3);
        if (t + NGW < S_LAT) { const int* ts = tokslot + (size_t)(t + NGW) * 4; n0 = ts[0]; n1 = ts[1]; n2 = ts[2]; n3 = ts[3]; }
        GAS f32x4* xr = (GAS f32x4*)(a->out + (size_t)t * DM) + lane; const GAS v2u* xbr = (const GAS v2u*)((const bf16*)(a->ws + WS_XB) + (size_t)t * DM) + lane;
        v2u xt[4]; f32x4 p[4], q[4];
#pragma unroll
        for (int j = 0; j < 4; ++j) xt[j] = xbr[64 * j];
        if (s1 < 32768) { const GAS v2u* yr = (const GAS v2u*)(Y + (size_t)s1 * DM) + lane; v2u u[4];
#pragma unroll
            for (int j = 0; j < 4; ++j) u[j] = yr[64 * j];
#pragma unroll
            for (int j = 0; j < 4; ++j) p[j] = (f32x4){bflo(u[j].x), bfhi(u[j].x), bflo(u[j].y), bfhi(u[j].y)}; }
        else { const GAS f32x4* yr = (const GAS f32x4*)(YF + (size_t)(s1 - 32768) * DM) + lane;
#pragma unroll
            for (int j = 0; j < 4; ++j) p[j] = yr[64 * j]; }
        if (s2 < 32768) { const GAS v2u* yr = (const GAS v2u*)(Y + (size_t)s2 * DM) + lane; v2u u[4];
#pragma unroll
            for (int j = 0; j < 4; ++j) u[j] = yr[64 * j];
#pragma unroll
            for (int j = 0; j < 4; ++j) q[j] = (f32x4){bflo(u[j].x), bfhi(u[j].x), bflo(u[j].y), bfhi(u[j].y)}; }
        else { const GAS f32x4* yr = (const GAS f32x4*)(YF + (size_t)(s2 - 32768) * DM) + lane;
#pragma unroll
            for (int j = 0; j < 4; ++j) q[j] = yr[64 * j]; }
#pragma unroll
        for (int j = 0; j < 4; ++j) { f32x4 x = (f32x4){bflo(xt[j].x), bfhi(xt[j].x), bflo(xt[j].y), bfhi(xt[j].y)};
            x = x + gl[j] * (p[j] * w1 + q[j] * w2);
            __builtin_nontemporal_store(x, (f32x4*)(xr + 64 * j)); }
    }
}

#define IN(k) (lo <= (k) && (k) < hi)
#define GRIDBAR() do { XcdBarrier b2_; b2_.bar = (unsigned*)(KARGS()->ws + WS_CTL) + CW_BAR; b2_.x = xb_xcc_id(); b2_.st = (volatile LAS unsigned*)(lds + MISC_OFF) + 8; xcd_barrier(b2_, wv0 * 64 + (int)__builtin_amdgcn_mbcnt_hi(~0u, __builtin_amdgcn_mbcnt_lo(~0u, 0u))); } while (0)
#define SEAM(k) do { if (IN(k) && IN((k) + 1)) GRIDBAR(); } while (0)
#define PHASE_ROOTS() KA a = KARGS(); unsigned char* ws = a->ws; const float* vec = (const float*)(ws + WS_VEC); (void)vec; int bid = blockIdx.x, G = gridDim.x; asm volatile("" : "+s"(bid), "+s"(G)); int tid = wv0 * 64 + (int)__builtin_amdgcn_mbcnt_hi(~0u, __builtin_amdgcn_mbcnt_lo(~0u, 0u)); asm volatile("" : "+v"(tid)); const int lane = tid & 63, wave = __builtin_amdgcn_readfirstlane(tid >> 6); (void)lane; (void)wave

template <int l> __device__ __forceinline__ void layer_body(const int lo, const int hi, LAS unsigned char* lds, const int wv0) {
        const int pb = 1 + 11 * l;
        if (IN(pb + 0)) { PHASE_ROOTS(); phase_norm(a, l, 0, R_ALL, (bf16*)(ws + WS_H), lane, wave, G, bid); SEAM(pb + 0); }
        if (IN(pb + 1)) {
            PHASE_ROOTS();
            pg8::Gemm g{(const pg8::bf16_t*)(ws + WS_H), (const pg8::bf16_t*)(ws + WS_WIN) + (size_t)l * INW * DM, R_ALL, INW, DM, 0, DM};
            pg8::StaticOrder S; S.init(R_ALL, INW, G, bid);
            pg8::EpiBf16<0> E{(pg8::bf16_t*)(ws + WS_PROJ), INW, nullptr, 0, 0, 1.f};
            pg8::gemm_phase<pg8::EpiBf16<0>, pg8::StaticOrder, true, true>(lds, g, S, E, tid);
            moe_conv_range(a, l == 0 ? MOE_SL0 : MOE_SL2, l == 0 ? MOE_SL1 : MOE_SL3, 650 - 2 * 256, lds, lane, wave, G, bid);
            SEAM(pb + 1);
        }
        if (IN(pb + 2)) {
            PHASE_ROOTS();
            qk_prep(a, l, (G - 1 - bid) * NTHR + tid, G * NTHR);
            for (int it = ((bid + G - 80) % G) * NWAVES + wave; it < 520; it += G * NWAVES) vt_item(a, it, lane);
            for (int it = bid; it < 1040; it += G) hgrn_stepA(a, l, it >> 2, it & 3, lds, lane, wave);
            { __syncthreads(); moe_conv_range(a, l == 0 ? MOE_SL3 : MOE_SL7, l == 0 ? MOE_SL4 : MOE_DEFER, 1040 - 4 * 256, lds, lane, wave, G, bid); }
            SEAM(pb + 2);
        }
        if (IN(pb + 3)) {
            PHASE_ROOTS();
            if (bid < 64) hgrn_stepB(a, bid, tid);
            {
                const int nu = (l == 0) ? 260 : 256, ng = (l == 0) ? 520 : 512;
                unsigned* qctr = (unsigned*)(ws + WS_CTL) + CW_QUEUE + 64 * l;
                volatile LAS unsigned* qslot = (volatile LAS unsigned*)(lds + MISC_OFF) + 16;
                for (;;) {
                    __syncthreads();
                    if (tid == 0) qslot[0] = __hip_atomic_fetch_add(qctr, 1u, RLX_AGENT);
                    __syncthreads();
                    const int it = __builtin_amdgcn_readfirstlane((int)qslot[0]);
                    if (it >= nu + ng) break;
                    if (it < nu) attn_unit(a, l, it, lds, tid, lane, wave);
                    else gmlp_unit_mma(a, l, (it - nu) >> 2, (it - nu) & 3, lds, tid, lane, wave);
                }
            }
            SEAM(pb + 3);
        }
        if (IN(pb + 4)) {
            PHASE_ROOTS();
            const int nit = (l == 0) ? 1040 : 1024;
            for (int it = bid; it < nit; it += G) hgrn_stepC(a, l, it >> 2, it & 3, lds, tid, lane, wave);
            if (l == 0) { __syncthreads(); moe_conv_range(a, MOE_SL4, MOE_SL5, 1040 - 4 * 256, lds, lane, wave, G, bid); }
            SEAM(pb + 4);
        }
        if (IN(pb + 5)) {
            PHASE_ROOTS();
            const float* modl = vec + VO_MOD + (l * 2 + 0) * 6144; const float* modc = vec + VO_MOD + (l * 2 + 1) * 6144;
            const int M = S_LAT;
            pg8::Gemm g{(const pg8::bf16_t*)(ws + WS_MIX), (const pg8::bf16_t*)(ws + WS_WOUT) + (size_t)l * DM * DM, M, DM, DM, 0, DM};
            pg8::StaticOrder S; S.init(M, DM, G, bid);
            if (l == 0) { pg8::EpiResidB<false> E{a->in[I_X], (pg8::bf16_t*)(ws + WS_XB), modl + 2048, DM};
                pg8::gemm_phase<pg8::EpiResidB<false>, pg8::StaticOrder, true, true>(lds, g, S, E, tid); }
            else { pg8::EpiResidB<true> E{ws + WS_XB, (pg8::bf16_t*)(ws + WS_XB), modl + 2048, DM};
                pg8::gemm_phase<pg8::EpiResidB<true>, pg8::StaticOrder, true, true>(lds, g, S, E, tid); }
            if (l == 0) {
                pg8::Gemm g2{(const pg8::bf16_t*)(ws + WS_MIX), (const pg8::bf16_t*)(ws + WS_WOUT), R_ALL, DM, 256, 0, DM};
                pg8::SplitKOrder S2{S_LAT / 256, 4, 4, 256, 16, bid, nullptr};
                pg8::EpiPart E2{(float*)(ws + WS_PART1), modc + 2048, S_LAT / 256, 256, DM};
                pg8::gemm_phase<pg8::EpiPart, pg8::SplitKOrder, false, true>(lds, g2, S2, E2, tid);
                moe_conv_range(a, MOE_SL5, MOE_SL6, 16, lds, lane, wave, G, bid);
            }
            SEAM(pb + 5);
        }
        if (l == 0) {
            if (IN(pb + 6)) { PHASE_ROOTS(); phase_norm(a, l, 1, R_ALL, (bf16*)(ws + WS_H), lane, wave, G, bid); SEAM(pb + 6); }
            if (IN(pb + 7)) {
                PHASE_ROOTS();
                pg8::Gemm g{(const pg8::bf16_t*)(ws + WS_H), (const pg8::bf16_t*)(ws + WS_WGU), R_ALL, 2 * FFN, DM, 0, DM};
                pg8::StaticOrder S; S.init(R_ALL, 2 * FFN, G, bid);
                pg8::EpiSwiGLU E{(pg8::bf16_t*)(ws + WS_HID), FFN, 1.0f};
                pg8::gemm_phase<pg8::EpiSwiGLU, pg8::StaticOrder, true, true>(lds, g, S, E, tid);
                moe_conv_range(a, MOE_SL1, MOE_SL2, 1430 - 5 * 256, lds, lane, wave, G, bid);
                SEAM(pb + 7);
            }
            if (IN(pb + 8)) {
                PHASE_ROOTS();
                const float* modl = vec + VO_MOD + (l * 2 + 0) * 6144; const float* modc = vec + VO_MOD + (l * 2 + 1) * 6144;
                pg8::Gemm g{(const pg8::bf16_t*)(ws + WS_HID), (const pg8::bf16_t*)(ws + WS_WD), S_LAT, DM, FFN, 0, FFN};
                pg8::StaticOrder S; S.init(S_LAT, DM, G, bid);
                pg8::EpiResidB<true> E{ws + WS_XB, (pg8::bf16_t*)(ws + WS_XB), modl + 5120, DM};
                pg8::gemm_phase<pg8::EpiResidB<true>, pg8::StaticOrder, true, true>(lds, g, S, E, tid);
                {
                    pg8::Gemm g2{(const pg8::bf16_t*)(ws + WS_HID), (const pg8::bf16_t*)(ws + WS_WD), R_ALL, DM, 256, 0, FFN};
                    pg8::SplitKOrder S2{S_LAT / 256, 4, 11, 256, 44, bid, nullptr};
                    pg8::EpiPart E2{(float*)(ws + WS_PART2), modc + 5120, S_LAT / 256, 256, DM};
                    pg8::gemm_phase<pg8::EpiPart, pg8::SplitKOrder, false, true>(lds, g2, S2, E2, tid);
                    moe_conv_range(a, MOE_SL6, MOE_SL7, 44, lds, lane, wave, G, bid);
                }
                if (IN(pb + 8) && IN(pb + 11)) GRIDBAR();
            }
        } else {
            if (IN(pb + 6)) { PHASE_ROOTS(); phase_norm_route(a, lds, tid, lane, wave, G, bid); SEAM(pb + 6); }
            if (IN(pb + 7)) { PHASE_ROOTS(); moe_gather(a, lds, tid, lane, wave, G, bid); SEAM(pb + 7); }
            if (IN(pb + 8)) {
                PHASE_ROOTS();
                const int* mi = (const int*)(ws + WS_VEC) + VO_MOE; const int nt = __builtin_amdgcn_readfirstlane(mi[0]);
                pg8::Gemm g{(const pg8::bf16_t*)(ws + WS_AS), (const pg8::bf16_t*)(ws + WS_MGU), nt * 256, 2 * EXD, DM / 2, (size_t)2 * EXD * DM, DM / 2};
                pg8::MoeOrder S; S.init(nt * 256, 2 * EXD, G, bid); S.load_bases(mi + 160);
                pg8::EpiSwiGLU8 E{(unsigned char*)(ws + WS_HIDM), EXD, 1.0f / (F8_WSCALE * F8_ASCALE), F8_HSCALE};
                pg8::gemm_phase<pg8::EpiSwiGLU8, pg8::MoeOrder, true, true, true>(lds, g, S, E, tid);
                SEAM(pb + 8);
            }
            if (IN(pb + 9)) {
                PHASE_ROOTS();
                const int* mi = (const int*)(ws + WS_VEC) + VO_MOE; const int nt = __builtin_amdgcn_readfirstlane(mi[0]); const int nm = nt < 128 ? nt : 128;
                pg8::Gemm g{(const pg8::bf16_t*)(ws + WS_HIDM), (const pg8::bf16_t*)(ws + WS_MD), nm * 256, DM, EXD / 2, (size_t)DM * EXD, EXD / 2};
                pg8::MoeOrder S; S.init(nm * 256, DM, G, bid); S.load_bases(mi + 160);
                pg8::EpiScaleBf16 E{(pg8::bf16_t*)(ws + WS_Y), DM, 1.0f / (F8_WSCALE * F8_HSCALE)};
                pg8::gemm_phase<pg8::EpiScaleBf16, pg8::MoeOrder, true, true, true>(lds, g, S, E, tid);
                if (nt > 128) {
                    pg8::Gemm g2{(const pg8::bf16_t*)(ws + WS_HIDM), (const pg8::bf16_t*)(ws + WS_MD), nt * 256, DM, 256, (size_t)DM * EXD, EXD / 2};
                    pg8::SplitKOrder S2{128, 4, 7, 256, (nt - 128) * 28, bid, mi + 16};
                    pg8::EpiAtomic E2{(float*)(ws + WS_YF), nullptr, 128, DM, 1.0f / (F8_WSCALE * F8_HSCALE)};
                    pg8::gemm_phase<pg8::EpiAtomic, pg8::SplitKOrder, false, true, true>(lds, g2, S2, E2, tid);
                }
                SEAM(pb + 9);
            }
            if (IN(pb + 10)) { PHASE_ROOTS(); moe_combine(a, lane, wave, G, bid); }
        }
    }
__global__ void __launch_bounds__(NTHR, 2) fwd_kernel(Args a_unused) {
    extern __shared__ __attribute__((aligned(16))) unsigned char lds_raw[];
    LAS unsigned char* lds = (LAS unsigned char*)lds_raw;
    const int tid0 = threadIdx.x;
    const int wv0 = __builtin_amdgcn_readfirstlane(tid0 >> 6);
    for (int u = tid0; u < (LDS_BYTES - LDSCTL_OFF) / 4; u += NTHR) ((LAS unsigned*)(lds + LDSCTL_OFF))[u] = 0u;
    __syncthreads();
    const int lo = KARGS()->ph_lo, hi = KARGS()->ph_hi;
    const bool fusedl = (hi - lo) > 1;
    if (fusedl) (void)xcd_barrier_post((unsigned*)(KARGS()->ws + WS_CTL) + CW_BAR, (volatile LAS unsigned*)(lds + MISC_OFF) + 8);
    if (IN(0)) { PHASE_ROOTS(); p0_prologue(a, lds, tid, lane, wave, G, bid); SEAM(0); }

    layer_body<0>(lo, hi, lds, wv0);
    layer_body<1>(lo, hi, lds, wv0);
}

extern "C" void kernel_launch(void* const* d_in, const int* in_sizes, int n_in, void* d_out, int out_size, void* d_ws, size_t ws_size, hipStream_t stream) {
    static int grid = 0;
    if (grid == 0) {
        if (n_in != 23 || in_sizes[0] != S_LAT * DM || out_size != S_LAT * DM || ws_size < WS_END) { fprintf(stderr, "kernel_launch: unexpected shapes / workspace (n_in %d, ws %zu, need %zu)\n", n_in, ws_size, (size_t)WS_END); grid = -1; return; }
        int dev = 0, cus = 0;
        if (hipGetDevice(&dev) != hipSuccess || hipDeviceGetAttribute(&cus, hipDeviceAttributeMultiprocessorCount, dev) != hipSuccess) { grid = -1; return; }
        if (hipFuncSetAttribute((const void*)fwd_kernel, hipFuncAttributeMaxDynamicSharedMemorySize, LDS_BYTES) != hipSuccess) { grid = -1; return; }
        int per_cu = 0;
        (void)hipOccupancyMaxActiveBlocksPerMultiprocessor(&per_cu, (const void*)fwd_kernel, NTHR, LDS_BYTES);
        (void)hipGetLastError();
        if (cus * NWAVES * 8 < S_LAT) { fprintf(stderr, "kernel_launch: needs at least %d compute units\n", S_LAT / (NWAVES * 8)); grid = -1; return; }
        grid = cus;
    }
    if (grid < 0) return;
    if (hipMemsetAsync((char*)d_ws + WS_CTL, 0, CTL_ZERO_BYTES, stream) != hipSuccess) return;
    Args a{};
    for (int i = 0; i < 23; ++i) a.in[i] = (const float*)d_in[i];
    a.out = (float*)d_out; a.ws = (unsigned char*)d_ws;
#if ONE_LAUNCH
    a.ph_lo = 0; a.ph_hi = NPH;
    hipLaunchKernelGGL(fwd_kernel, dim3(grid), dim3(NTHR), LDS_BYTES, stream, a);
#else
    for (int p = 0; p < NPH; ++p) {
        if (p == 10 || p == 11) continue;
        a.ph_lo = p; a.ph_hi = p + 1;
        hipLaunchKernelGGL(fwd_kernel, dim3(grid), dim3(NTHR), LDS_BYTES, stream, a);
    }
#endif
}
```

```cpp
#include <hip/hip_runtime.h>
#include <cstdio>
#include <cstdint>
#include <cmath>
#ifndef ONE_LAUNCH
#define ONE_LAUNCH 1
#endif
namespace pg8 {
#define PG8_LAS __attribute__((address_space(3)))
typedef unsigned short bf16_t;
typedef short bf16x8 __attribute__((ext_vector_type(8)));
typedef float f32x4 __attribute__((ext_vector_type(4)));
typedef unsigned u32x4 __attribute__((ext_vector_type(4)));
constexpr int BM = 256, BK = 64, HALF = 128, HTB = HALF * BK * 2  , STAGE_BYTES = 8 * HTB, NXCD = 8, WGM = 8;

__host__ __device__ __forceinline__ int lds_byte(int r, int c) { const int st = (r >> 4) * 2 + (c >> 5), rr = r & 15, cc = c & 31, ob = rr * 64 + cc * 2; return st * 1024 + (ob ^ (((ob >> 9) & 1) << 5)); }
__host__ __device__ __forceinline__ void stage_rc(int b, int& R, int& C) { const int st = b / 1024, sb = b % 1024, swz = sb ^ (((sb >> 9) & 1) << 5); R = (st >> 1) * 16 + swz / 64; C = (st & 1) * 32 + (swz % 64) / 2; }
__host__ __device__ __forceinline__ int perm32(int rho) { const int n = rho >> 4, i = rho & 15; return 8 * (i >> 2) + 4 * n + (i & 3); }

struct Unit { int pm, pn, eb, ko; };
struct Gemm { const bf16_t* A; const bf16_t* Bt; int M, N, K; size_t bstride; int ld; };

struct StaticOrder {
    int nM, nN, nwg, G, c;
    __host__ __device__ void init(int M, int N, int G_, int c_) { nM = M / BM; nN = N / BM; nwg = nM * nN; G = G_; c = c_; }
    __host__ __device__ bool next(int i, Unit& u) const {
        const long L = (long)i * G + c; if (L >= nwg) return false;
        int wgid = (int)L; { const int q = nwg / NXCD, r = nwg % NXCD, xcd = wgid % NXCD, off = wgid / NXCD; wgid = (xcd < r ? xcd * (q + 1) : r * (q + 1) + (xcd - r) * q) + off; }
        const int nig = WGM * nN, gid = wgid / nig, fm = gid * WGM, gsz = (nM - fm) < WGM ? (nM - fm) : WGM;
        u.pm = fm + ((wgid % nig) % gsz); u.pn = (wgid % nig) / gsz; u.eb = 0; u.ko = 0; return true;
    }
    __device__ __forceinline__ void a_ready(const Unit&) const {}
    __device__ __forceinline__ void done(const Unit&) const {}
};

__device__ __forceinline__ unsigned cvt_pk_bf16(float lo, float hi) { unsigned r; asm volatile("v_cvt_pk_bf16_f32 %0, %1, %2" : "=v"(r) : "v"(lo), "v"(hi)); return r; }
typedef float f32x2 __attribute__((ext_vector_type(2)));
__device__ __forceinline__ f32x2 gelu_pk(f32x2 v) {
    const f32x2 av = __builtin_elementwise_abs(v), d = av * 0.2316418882f + 1.0f;
    f32x2 t; t.x = __builtin_amdgcn_rcpf(d.x); t.y = __builtin_amdgcn_rcpf(d.y);
    f32x2 q = t * 0.5307027145f + (-0.7265760135f); q = q * t + 0.7107068705f; q = q * t + (-0.142248368f); q = q * t + 0.127414796f; q = q * t;
    const f32x2 s = (v * v) * (-0.72134752044f);
    f32x2 e; e.x = __builtin_amdgcn_exp2f(s.x); e.y = __builtin_amdgcn_exp2f(s.y);
    const f32x2 m = v * (q * e), r = v - m;
    f32x2 o; o.x = v.x < 0.f ? m.x : r.x; o.y = v.y < 0.f ? m.y : r.y; return o;
}

template <int ACT  > struct EpiBf16 {
    static constexpr bool PERM = true, AFTER_DRAIN = false; static_assert(ACT == 0 || ACT == 1, "EpiBf16: ACT is 0 (none) or 1 (gelu_pk)");
    bf16_t* O; int ldc; const float* bias; int split_cols; size_t split_stride; float scale0;
    __device__ __forceinline__ void operator()(const f32x4 (&acc)[2][2][4][2], const Unit& u, int wr, int wc, int fr, int fq) const {
        const int row0 = u.pm * BM + wr * 64 + fr; int colt = u.pn * BM; bf16_t* base = O;
        float sc = 1.f; if (split_cols) { const int t = colt / split_cols; base += (size_t)t * split_stride; colt -= t * split_cols; if (t == 0) sc = scale0; }
        const int col0 = colt + wc * 32 + 8 * fq, bcol0 = u.pn * BM + wc * 32 + 8 * fq;
        f32x4 bv[2][2];
#pragma unroll
        for (int bj = 0; bj < 2; ++bj)
#pragma unroll
            for (int n = 0; n < 2; ++n) bv[bj][n] = bias ? *(const f32x4*)(bias + bcol0 + bj * HALF + 4 * n) : (f32x4){0.f, 0.f, 0.f, 0.f};
#pragma unroll
        for (int ai = 0; ai < 2; ++ai)
#pragma unroll
            for (int m = 0; m < 4; ++m) { bf16_t* rowp = base + (size_t)(row0 + ai * HALF + m * 16) * ldc + col0;
#pragma unroll
                for (int bj = 0; bj < 2; ++bj) { f32x4 v0 = acc[ai][bj][m][0] + bv[bj][0], v1 = acc[ai][bj][m][1] + bv[bj][1];
                    if (ACT == 1) { f32x2 a = gelu_pk((f32x2){v0[0], v0[1]}), b = gelu_pk((f32x2){v0[2], v0[3]}), c = gelu_pk((f32x2){v1[0], v1[1]}), d = gelu_pk((f32x2){v1[2], v1[3]});
                        v0 = (f32x4){a.x, a.y, b.x, b.y}; v1 = (f32x4){c.x, c.y, d.x, d.y}; }
                    v0 = v0 * sc; v1 = v1 * sc; u32x4 w; w.x = cvt_pk_bf16(v0[0], v0[1]); w.y = cvt_pk_bf16(v0[2], v0[3]); w.z = cvt_pk_bf16(v1[0], v1[1]); w.w = cvt_pk_bf16(v1[2], v1[3]);
                    *(u32x4*)(rowp + bj * HALF) = w; } }
    }
};

__device__ __forceinline__ float silu_f(float x) { return x * __builtin_amdgcn_rcpf(1.0f + __builtin_amdgcn_exp2f(-1.4426950408889634f * x)); }
struct EpiResid {
    static constexpr bool PERM = false, AFTER_DRAIN = false;
    const float* base; float* out; const float* gate; const float* cbase; float* cout; const float* cgate; int mlat; int ldc;
    __device__ __forceinline__ void operator()(const f32x4 (&acc)[2][2][4][2], const Unit& u, int wr, int wc, int fr, int fq) const {
        const bool isc = u.pm >= mlat;
        const float* b = isc ? cbase : base; float* o = isc ? cout : out; const float* g = isc ? cgate : gate;
        const int row0 = (isc ? (u.pm - mlat) : u.pm) * BM + wr * 64 + fr, col0 = u.pn * BM + wc * 32 + 4 * fq;
        f32x4 gv[2][2];
#pragma unroll
        for (int bj = 0; bj < 2; ++bj)
#pragma unroll
            for (int n = 0; n < 2; ++n) gv[bj][n] = *(const f32x4*)(g + col0 + bj * HALF + n * 16);
#pragma unroll
        for (int ai = 0; ai < 2; ++ai)
#pragma unroll
            for (int m = 0; m < 4; ++m) { const size_t off = (size_t)(row0 + ai * HALF + m * 16) * ldc + col0;
#pragma unroll
                for (int bj = 0; bj < 2; ++bj)
#pragma unroll
                    for (int n = 0; n < 2; ++n) { const f32x4 bs = *(const f32x4*)(b + off + bj * HALF + n * 16); *(f32x4*)(o + off + bj * HALF + n * 16) = bs + gv[bj][n] * acc[ai][bj][m][n]; }
                if (m & 1) asm volatile("" ::: "memory"); }
    }
};
template <bool BFB> struct EpiResidB {
    static constexpr bool PERM = true, AFTER_DRAIN = false;
    const void* base; bf16_t* out; const float* gate; int ldc;
    __device__ __forceinline__ void operator()(const f32x4 (&acc)[2][2][4][2], const Unit& u, int wr, int wc, int fr, int fq) const {
        const int row0 = u.pm * BM + wr * 64 + fr, col0 = u.pn * BM + wc * 32 + 8 * fq;
        f32x4 gv[2][2];
#pragma unroll
        for (int bj = 0; bj < 2; ++bj)
#pragma unroll
            for (int n = 0; n < 2; ++n) gv[bj][n] = *(const f32x4*)(gate + col0 + bj * HALF + 4 * n);
#pragma unroll
        for (int ai = 0; ai < 2; ++ai)
#pragma unroll
            for (int m = 0; m < 4; ++m) { const size_t off = (size_t)(row0 + ai * HALF + m * 16) * ldc + col0;
#pragma unroll
                for (int bj = 0; bj < 2; ++bj) { f32x4 b0, b1;
                    if constexpr (BFB) { const u32x4 t = *(const u32x4*)((const bf16_t*)base + off + bj * HALF);
                        b0 = (f32x4){__builtin_bit_cast(float, t.x << 16), __builtin_bit_cast(float, t.x & 0xffff0000u), __builtin_bit_cast(float, t.y << 16), __builtin_bit_cast(float, t.y & 0xffff0000u)};
                        b1 = (f32x4){__builtin_bit_cast(float, t.z << 16), __builtin_bit_cast(float, t.z & 0xffff0000u), __builtin_bit_cast(float, t.w << 16), __builtin_bit_cast(float, t.w & 0xffff0000u)}; }
                    else { b0 = *(const f32x4*)((const float*)base + off + bj * HALF); b1 = *(const f32x4*)((const float*)base + off + bj * HALF + 4); }
                    const f32x4 v0 = b0 + gv[bj][0] * acc[ai][bj][m][0], v1 = b1 + gv[bj][1] * acc[ai][bj][m][1];
                    u32x4 w; w.x = cvt_pk_bf16(v0[0], v0[1]); w.y = cvt_pk_bf16(v0[2], v0[3]); w.z = cvt_pk_bf16(v1[0], v1[1]); w.w = cvt_pk_bf16(v1[2], v1[3]);
                    *(u32x4*)(out + off + bj * HALF) = w; }
                if (m & 1) asm volatile("" ::: "memory"); }
    }
};
struct EpiSwiGLU {
    static constexpr bool PERM = true, AFTER_DRAIN = false;
    bf16_t* O; int ldc; float ds;
    __device__ __forceinline__ void operator()(const f32x4 (&acc)[2][2][4][2], const Unit& u, int wr, int wc, int fr, int fq) const {
        const int row0 = u.pm * BM + wr * 64 + fr, col0 = u.pn * HALF + wc * 32 + 8 * fq;
#pragma unroll
        for (int ai = 0; ai < 2; ++ai)
#pragma unroll
            for (int m = 0; m < 4; ++m) { bf16_t* rowp = O + (size_t)(row0 + ai * HALF + m * 16) * ldc + col0;
                const f32x4 g0 = acc[ai][0][m][0] * ds, g1 = acc[ai][0][m][1] * ds, u0 = acc[ai][1][m][0] * ds, u1 = acc[ai][1][m][1] * ds;
                f32x4 h0, h1;
#pragma unroll
                for (int j = 0; j < 4; ++j) { h0[j] = silu_f(g0[j]) * u0[j]; h1[j] = silu_f(g1[j]) * u1[j]; }
                u32x4 w; w.x = cvt_pk_bf16(h0[0], h0[1]); w.y = cvt_pk_bf16(h0[2], h0[3]); w.z = cvt_pk_bf16(h1[0], h1[1]); w.w = cvt_pk_bf16(h1[2], h1[3]);
                *(u32x4*)rowp = w; }
    }
};
struct MoeOrder : StaticOrder {
    int tb[8];
    __device__ __forceinline__ void load_bases(const int* mi) {
#pragma unroll
        for (int e = 0; e < 8; ++e) tb[e] = __builtin_amdgcn_readfirstlane(mi[e]); }
    __device__ __forceinline__ int expert_of(int pm) const { int e = 0;
#pragma unroll
        for (int j = 0; j < 7; ++j) e += (pm >= tb[j]) ? 1 : 0;
        return e; }
    __device__ __forceinline__ bool next(int i, Unit& u) const { if (!StaticOrder::next(i, u)) return false; u.eb = expert_of(u.pm); return true; }
};

struct SplitKOrder {
    int pm0, nN, P, kp, total, c; const int* tile_e;
    __device__ __forceinline__ bool next(int i, Unit& u) const {
        if (i != 0 || c >= total) return false;
        const int p = c % P, t = c / P; u.pn = t % nN; u.pm = pm0 + t / nN; u.ko = p * kp; u.eb = tile_e ? __builtin_amdgcn_readfirstlane(tile_e[u.pm]) : 0; return true; }
    __device__ __forceinline__ void a_ready(const Unit&) const {}
    __device__ __forceinline__ void done(const Unit&) const {}
};
struct EpiPart {
    static constexpr bool PERM = false, AFTER_DRAIN = false;
    float* part; const float* scale; int pm_sub; int kp; int ldc;
    __device__ __forceinline__ void operator()(const f32x4 (&acc)[2][2][4][2], const Unit& u, int wr, int wc, int fr, int fq) const {
        float* o = part + (size_t)(u.ko / kp) * BM * ldc;
        const int row0 = (u.pm - pm_sub) * BM + wr * 64 + fr, col0 = u.pn * BM + wc * 32 + 4 * fq;
        f32x4 gv[2][2];
#pragma unroll
        for (int bj = 0; bj < 2; ++bj)
#pragma unroll
            for (int n = 0; n < 2; ++n) gv[bj][n] = *(const f32x4*)(scale + col0 + bj * HALF + n * 16);
#pragma unroll
        for (int ai = 0; ai < 2; ++ai)
#pragma unroll
            for (int m = 0; m < 4; ++m) { const size_t off = (size_t)(row0 + ai * HALF + m * 16) * ldc + col0;
#pragma unroll
                for (int bj = 0; bj < 2; ++bj)
#pragma unroll
                    for (int n = 0; n < 2; ++n) *(f32x4*)(o + off + bj * HALF + n * 16) = gv[bj][n] * acc[ai][bj][m][n]; }
    }
};
struct EpiAtomic {
    static constexpr bool PERM = false, AFTER_DRAIN = true;
    float* out; const float* scale; int pm_sub; int ldc; float ds;
    __device__ __forceinline__ void fused(f32x4 (&acc)[2][2][4][2], const Unit& u, int wr, int wc, int fr, int fq, PG8_LAS unsigned char* lds, int wid, int lane) const {
        PG8_LAS float* scr = (PG8_LAS float*)(lds + wid * 16384);
        const int rr = lane >> 5, cc = lane & 31;
#pragma unroll
        for (int ai = 0; ai < 2; ++ai)
#pragma unroll
            for (int bj = 0; bj < 2; ++bj) {
#pragma unroll
                for (int m = 0; m < 4; ++m)
#pragma unroll
                    for (int n = 0; n < 2; ++n) *(PG8_LAS f32x4*)(scr + (m * 16 + fr) * 36 + n * 16 + 4 * fq) = acc[ai][bj][m][n];
                asm volatile("s_waitcnt lgkmcnt(0)" ::: "memory");
                const int colg = u.pn * BM + bj * HALF + wc * 32 + cc; const float sc = (scale ? scale[colg] : 1.0f) * ds;
                float* op = out + (size_t)((u.pm - pm_sub) * BM + ai * HALF + wr * 64 + rr) * ldc + colg;
#pragma unroll 8
                for (int i = 0; i < 32; ++i) { const float v = scr[(2 * i + rr) * 36 + cc]; __hip_atomic_fetch_add(op + (size_t)(2 * i) * ldc, v * sc, __ATOMIC_RELAXED, __HIP_MEMORY_SCOPE_AGENT); }
                asm volatile("s_waitcnt lgkmcnt(0)" ::: "memory");
            }
    }
};

typedef int i32x4v __attribute__((ext_vector_type(4))); typedef int i32x8v __attribute__((ext_vector_type(8)));
struct FragB { bf16x8 k[2]; };
struct Frag8 { i32x8v v; };
template <bool F8> struct FragSel { typedef FragB type; };
template <> struct FragSel<true> { typedef Frag8 type; };
__device__ __forceinline__ void ld_frag(FragB& f, const PG8_LAS unsigned char* p) { f.k[0] = *(const PG8_LAS bf16x8*)p; f.k[1] = *(const PG8_LAS bf16x8*)(p + 1024); }
__device__ __forceinline__ void ld_frag(Frag8& f, const PG8_LAS unsigned char* p) { const i32x4v lo = *(const PG8_LAS i32x4v*)p, hi = *(const PG8_LAS i32x4v*)(p + 1024); f.v = __builtin_shufflevector(lo, hi, 0, 1, 2, 3, 4, 5, 6, 7); }
__device__ __forceinline__ f32x4 mma_frag(const FragB& b, const FragB& a, f32x4 c) { c = __builtin_amdgcn_mfma_f32_16x16x32_bf16(b.k[0], a.k[0], c, 0, 0, 0); return __builtin_amdgcn_mfma_f32_16x16x32_bf16(b.k[1], a.k[1], c, 0, 0, 0); }
__device__ __forceinline__ f32x4 mma_frag(const Frag8& b, const Frag8& a, f32x4 c) {
    asm volatile("v_mfma_scale_f32_16x16x128_f8f6f4 %0, %1, %2, %0, %3, %3 op_sel_hi:[0,0,0]" : "+v"(c) : "v"(b.v), "v"(a.v), "v"(0x7f7f7f7f));
    return c;
}

struct EpiSwiGLU8 {
    static constexpr bool PERM = true, AFTER_DRAIN = false;
    unsigned char* O; int ldc; float ds, hs;
    __device__ __forceinline__ void operator()(const f32x4 (&acc)[2][2][4][2], const Unit& u, int wr, int wc, int fr, int fq) const {
        const int row0 = u.pm * BM + wr * 64 + fr, col0 = u.pn * HALF + wc * 32 + 8 * fq;
        const float k1 = -1.4426950408889634f * ds, k2 = ds * ds * hs;
#pragma unroll
        for (int ai = 0; ai < 2; ++ai)
#pragma unroll
            for (int m = 0; m < 4; ++m) { unsigned char* rowp = O + (size_t)(row0 + ai * HALF + m * 16) * ldc + col0;
                const f32x4 g0 = acc[ai][0][m][0], g1 = acc[ai][0][m][1], u0 = acc[ai][1][m][0], u1 = acc[ai][1][m][1];
                float h[8];
#pragma unroll
                for (int j = 0; j < 4; ++j) {
                    h[j] = __builtin_amdgcn_fmed3f((g0[j] * u0[j]) * k2 * __builtin_amdgcn_rcpf(1.0f + __builtin_amdgcn_exp2f(g0[j] * k1)), -448.0f, 448.0f);
                    h[4 + j] = __builtin_amdgcn_fmed3f((g1[j] * u1[j]) * k2 * __builtin_amdgcn_rcpf(1.0f + __builtin_amdgcn_exp2f(g1[j] * k1)), -448.0f, 448.0f); }
                unsigned lo = 0u, hi = 0u;
                lo = __builtin_amdgcn_cvt_pk_fp8_f32(h[0], h[1], lo, false); lo = __builtin_amdgcn_cvt_pk_fp8_f32(h[2], h[3], lo, true);
                hi = __builtin_amdgcn_cvt_pk_fp8_f32(h[4], h[5], hi, false); hi = __builtin_amdgcn_cvt_pk_fp8_f32(h[6], h[7], hi, true);
                typedef unsigned u32x2 __attribute__((ext_vector_type(2)));
                *(u32x2*)rowp = (u32x2){lo, hi}; }
    }
};
struct EpiScaleBf16 {
    static constexpr bool PERM = true, AFTER_DRAIN = false;
    bf16_t* O; int ldc; float ds;
    __device__ __forceinline__ void operator()(const f32x4 (&acc)[2][2][4][2], const Unit& u, int wr, int wc, int fr, int fq) const {
        const int row0 = u.pm * BM + wr * 64 + fr, col0 = u.pn * BM + wc * 32 + 8 * fq;
#pragma unroll
        for (int ai = 0; ai < 2; ++ai)
#pragma unroll
            for (int m = 0; m < 4; ++m) { bf16_t* rowp = O + (size_t)(row0 + ai * HALF + m * 16) * ldc + col0;
#pragma unroll
                for (int bj = 0; bj < 2; ++bj) { const f32x4 v0 = acc[ai][bj][m][0] * ds, v1 = acc[ai][bj][m][1] * ds;
                    u32x4 w; w.x = cvt_pk_bf16(v0[0], v0[1]); w.y = cvt_pk_bf16(v0[2], v0[3]); w.z = cvt_pk_bf16(v1[0], v1[1]); w.w = cvt_pk_bf16(v1[2], v1[3]);
                    *(u32x4*)(rowp + bj * HALF) = w; } }
    }
};

template <class Epi, class Sched, bool ALIGN_EPI = false, bool SP2 = false, bool F8 = false>
__device__ __forceinline__ void gemm_phase(PG8_LAS unsigned char* lds, const Gemm g, const Sched& S, const Epi& E, int tid_in) {
    int tid_ = tid_in; asm volatile("" : "+v"(tid_));
    const int tid = tid_, wid = __builtin_amdgcn_readfirstlane(tid >> 6), lane = tid & 63, wr = wid >> 2, wc = wid & 3, fr = lane & 15, fq = lane >> 4;
    const int K = g.K, nt = K / BK, ld = g.ld;
    unsigned voffA[2], voffB[2];
#pragma unroll
    for (int i = 0; i < 2; ++i) { int R, C; stage_rc(tid * 16 + i * 8192, R, C); const int Rb = Epi::PERM ? ((R & ~31) + perm32(R & 31)) : R;
        voffA[i] = (unsigned)(R * ld + C) * 2u; voffB[i] = (unsigned)(Rb * ld + C) * 2u; }
    const size_t kstep = (size_t)(BK * 2);
    const size_t hstep = (size_t)HALF * ld * 2;
    const size_t tstep = 2 * hstep;
    const unsigned ldsw = (unsigned)wid * 1024u;
    const int aoff = lds_byte(wr * 64 + fr, fq * 8), boff = lds_byte(wc * 32 + fr, fq * 8);
#define PG8_SA(b, h) (((b) * 2 + (h)) * HTB)
#define PG8_SB(b, h) ((4 + (b) * 2 + (h)) * HTB)
#define PG8_STAGE(bufoff, gbase, voff) do { _Pragma("unroll") for (int _i = 0; _i < 2; ++_i) \
        __builtin_amdgcn_global_load_lds((const unsigned*)((const char*)(gbase) + (voff)[_i]), (PG8_LAS unsigned*)(lds + (bufoff) + ldsw + _i * 8192), 16, 0, 0); } while (0)
#define PG8_LDA(dst, b, h) do { _Pragma("unroll") for (int m = 0; m < 4; ++m) ld_frag(dst[m], lds + PG8_SA(b, h) + aoff + m * 2048); } while (0)
#define PG8_LDB(dst, b, h) do { _Pragma("unroll") for (int n = 0; n < 2; ++n) ld_frag(dst[n], lds + PG8_SB(b, h) + boff + n * 2048); } while (0)
#define PG8_MMA(ai, bj, At, Bt) do { __builtin_amdgcn_s_setprio(1); _Pragma("unroll") for (int m = 0; m < 4; ++m) _Pragma("unroll") for (int n = 0; n < 2; ++n) \
        acc[ai][bj][m][n] = mma_frag(Bt[n], At[m], acc[ai][bj][m][n]); __builtin_amdgcn_s_setprio(0); } while (0)
#define PG8_WAIT_V(n) asm volatile("s_waitcnt vmcnt(" #n ")" ::: "memory")
#define PG8_WAIT_L(n) asm volatile("s_waitcnt lgkmcnt(" #n ")" ::: "memory")
#define PG8_BAR __builtin_amdgcn_s_barrier()
#define PG8_SCHED __builtin_amdgcn_sched_barrier(0)
    Unit cur, nxt; int ui = 0;
    if (!S.next(0, cur)) return;
    float zacc = 0.f; asm volatile("" : "+v"(zacc));
    f32x4 acc[2][2][4][2];
#pragma unroll
    for (int a = 0; a < 2; ++a)
#pragma unroll
        for (int b = 0; b < 2; ++b)
#pragma unroll
            for (int m = 0; m < 4; ++m)
#pragma unroll
                for (int n = 0; n < 2; ++n) acc[a][b][m][n] = (f32x4){zacc, zacc, zacc, zacc};
    typedef typename FragSel<F8>::type Frag;
    Frag At[4], B0[2], B1[2];
    const char* cA = (const char*)g.A + (size_t)cur.pm * tstep + (size_t)cur.ko * 2; const char* cB = (const char*)g.Bt + (size_t)cur.eb * g.bstride + (size_t)cur.pn * tstep + (size_t)cur.ko * 2;
    S.a_ready(cur);
    if constexpr (SP2) {
        PG8_STAGE(PG8_SB(0, 0), cB, voffB); PG8_STAGE(PG8_SB(0, 1), cB + hstep, voffB); PG8_STAGE(PG8_SA(0, 0), cA, voffA); PG8_STAGE(PG8_SA(0, 1), cA + hstep, voffA);
        if (wr == 1) PG8_BAR;
        PG8_WAIT_V(2); PG8_BAR;
        PG8_STAGE(PG8_SB(1, 0), cB + kstep, voffB); PG8_STAGE(PG8_SA(1, 0), cA + kstep, voffA); PG8_STAGE(PG8_SB(1, 1), cB + hstep + kstep, voffB);
        PG8_WAIT_V(6); PG8_BAR;
    } else {
        PG8_STAGE(PG8_SB(0, 0), cB, voffB); PG8_STAGE(PG8_SA(0, 0), cA, voffA); PG8_STAGE(PG8_SB(0, 1), cB + hstep, voffB); PG8_STAGE(PG8_SA(0, 1), cA + hstep, voffA);
        if (wr == 1) PG8_BAR;
        PG8_WAIT_V(4); PG8_BAR;
        PG8_STAGE(PG8_SB(1, 0), cB + kstep, voffB); PG8_STAGE(PG8_SA(1, 0), cA + kstep, voffA); PG8_STAGE(PG8_SB(1, 1), cB + hstep + kstep, voffB);
        PG8_WAIT_V(6); PG8_BAR;
    }
    for (;;) {
        const bool has_next = S.next(ui + 1, nxt);
        const char* nA = has_next ? (const char*)g.A + (size_t)nxt.pm * tstep + (size_t)nxt.ko * 2 : cA; const char* nB = has_next ? (const char*)g.Bt + (size_t)nxt.eb * g.bstride + (size_t)nxt.pn * tstep + (size_t)nxt.ko * 2 : cB;
        for (int t = 0; t < nt; t += 2) {
            const bool last = (t == nt - 2);
            const char* a1 = cA + (size_t)(t + 1) * kstep;
            const char* a2 = last ? nA : cA + (size_t)(t + 2) * kstep; const char* b2 = last ? nB : cB + (size_t)(t + 2) * kstep;
            const char* a3 = a2 + kstep; const char* b3 = b2 + kstep;
            if (last && has_next) S.a_ready(nxt);
            if constexpr (SP2) {
            PG8_LDB(B0, 0, 0); PG8_LDB(B1, 0, 1); PG8_SCHED; PG8_LDA(At, 0, 0); PG8_STAGE(PG8_SA(1, 1), a1 + hstep, voffA);
            PG8_WAIT_V(8); PG8_WAIT_L(0); PG8_BAR; PG8_MMA(0, 0, At, B0); PG8_MMA(0, 1, At, B1); PG8_BAR; PG8_SCHED;
            PG8_LDA(At, 0, 1); PG8_STAGE(PG8_SB(0, 0), b2, voffB); PG8_STAGE(PG8_SB(0, 1), b2 + hstep, voffB); PG8_STAGE(PG8_SA(0, 0), a2, voffA);
            PG8_WAIT_V(8); PG8_WAIT_L(0); PG8_BAR; PG8_MMA(1, 0, At, B0); PG8_MMA(1, 1, At, B1); PG8_BAR; PG8_SCHED;
            PG8_LDB(B0, 1, 0); PG8_LDB(B1, 1, 1); PG8_SCHED; PG8_LDA(At, 1, 0); PG8_STAGE(PG8_SA(0, 1), a2 + hstep, voffA);
            PG8_WAIT_V(8); PG8_WAIT_L(0); PG8_BAR; PG8_MMA(0, 0, At, B0); PG8_MMA(0, 1, At, B1); PG8_BAR; PG8_SCHED;
            PG8_LDA(At, 1, 1); PG8_STAGE(PG8_SB(1, 0), b3, voffB); PG8_STAGE(PG8_SB(1, 1), b3 + hstep, voffB); PG8_STAGE(PG8_SA(1, 0), a3, voffA);
            PG8_WAIT_V(8); PG8_WAIT_L(0); PG8_BAR; PG8_MMA(1, 0, At, B0); PG8_MMA(1, 1, At, B1); PG8_BAR; PG8_SCHED;
            } else {
            PG8_LDB(B0, 0, 0); PG8_SCHED; PG8_LDA(At, 0, 0); PG8_STAGE(PG8_SA(1, 1), a1 + hstep, voffA);
            PG8_WAIT_L(8); PG8_BAR; PG8_WAIT_L(0); PG8_MMA(0, 0, At, B0); PG8_BAR; PG8_SCHED;
            PG8_LDB(B1, 0, 1); PG8_STAGE(PG8_SB(0, 0), b2, voffB);
            PG8_BAR; PG8_WAIT_L(0); PG8_MMA(0, 1, At, B1); PG8_BAR;
            PG8_LDA(At, 0, 1); PG8_STAGE(PG8_SA(0, 0), a2, voffA);
            PG8_BAR; PG8_WAIT_L(0); PG8_MMA(1, 0, At, B0); PG8_BAR; PG8_SCHED;
            PG8_STAGE(PG8_SB(0, 1), b2 + hstep, voffB);
            PG8_WAIT_V(6); PG8_BAR; PG8_MMA(1, 1, At, B1); PG8_BAR;
            PG8_LDB(B0, 1, 0); PG8_SCHED; PG8_LDA(At, 1, 0); PG8_STAGE(PG8_SA(0, 1), a2 + hstep, voffA);
            PG8_WAIT_L(8); PG8_BAR; PG8_WAIT_L(0); PG8_MMA(0, 0, At, B0); PG8_BAR; PG8_SCHED;
            PG8_LDB(B1, 1, 1); PG8_STAGE(PG8_SB(1, 0), b3, voffB);
            PG8_BAR; PG8_WAIT_L(0); PG8_MMA(0, 1, At, B1); PG8_BAR;
            PG8_LDA(At, 1, 1); PG8_STAGE(PG8_SA(1, 0), a3, voffA);
            PG8_BAR; PG8_WAIT_L(0); PG8_MMA(1, 0, At, B0); PG8_BAR; PG8_SCHED;
            PG8_STAGE(PG8_SB(1, 1), b3 + hstep, voffB);
            PG8_WAIT_V(6); PG8_BAR; PG8_MMA(1, 1, At, B1); PG8_BAR;
            }
        }
        if constexpr (ALIGN_EPI) { if (wr == 0) PG8_BAR; }
        if constexpr (F8) {
            asm volatile("s_nop 15\n\ts_nop 15" : "+v"(acc[1][1][0][0]), "+v"(acc[1][1][0][1]), "+v"(acc[1][1][1][0]), "+v"(acc[1][1][1][1]), "+v"(acc[1][1][2][0]), "+v"(acc[1][1][2][1]), "+v"(acc[1][1][3][0]), "+v"(acc[1][1][3][1])); }
        if constexpr (!Epi::AFTER_DRAIN) { E(acc, cur, wr, wc, fr, fq); S.done(cur); }
        if (!has_next) break;
#pragma unroll
        for (int a = 0; a < 2; ++a)
#pragma unroll
            for (int b = 0; b < 2; ++b)
#pragma unroll
                for (int m = 0; m < 4; ++m)
#pragma unroll
                    for (int n = 0; n < 2; ++n) acc[a][b][m][n] = (f32x4){zacc, zacc, zacc, zacc};
        cur = nxt; cA = nA; cB = nB; ++ui;
        if constexpr (ALIGN_EPI) { if (wr == 1) PG8_BAR; }
    }
    PG8_WAIT_V(0);
    if constexpr (!ALIGN_EPI) { if (wr == 0) PG8_BAR; }
    PG8_BAR;
    if constexpr (Epi::AFTER_DRAIN) { E.fused(acc, cur, wr, wc, fr, fq, lds, wid, lane); S.done(cur); }
#undef PG8_SA
#undef PG8_SB
#undef PG8_STAGE
#undef PG8_LDA
#undef PG8_LDB
#undef PG8_MMA
#undef PG8_WAIT_V
#undef PG8_WAIT_L
#undef PG8_BAR
#undef PG8_SCHED
}
}


constexpr int S_LAT = 16384, C_CTX = 256, R_ALL = S_LAT + C_CTX, DM = 1024;
constexpr int INW = 2560, FFN = 2816, EXD = 3584, NEXP = 8;
constexpr int COL_AQ = 0, COL_AK = 512, COL_AV = 640, COL_HQ = 768, COL_HFF = 1024, COL_HFB = 1280, COL_HI = 1536, COL_HG = 1792, COL_GU = 2048, COL_GV = 2304;
constexpr int MIX_AT = 0, MIX_HG = 512, MIX_GM = 768;
constexpr int MOE_MAXROWS = 34816;
constexpr float EPS = 1e-6f;
constexpr int NWAVES = 8, NTHR = 512;
constexpr int NPH = 23;

constexpr size_t MiB = 1u << 20;
constexpr size_t WS_CTL = 0, CTL_ZERO_BYTES = 1 * MiB;
constexpr size_t WS_VEC = 1 * MiB;
constexpr size_t WS_TOK = 2 * MiB;
constexpr size_t WS_WIN = 3 * MiB;
constexpr size_t WS_WOUT = 13 * MiB;
constexpr size_t WS_WGU = 17 * MiB;
constexpr size_t WS_WD = 28 * MiB;
constexpr size_t WS_MGU = 34 * MiB;
constexpr size_t WS_MD = 146 * MiB;
constexpr size_t WS_H = 202 * MiB;
constexpr size_t WS_PROJ = 235 * MiB;
constexpr size_t WS_MIX = 317 * MiB;
constexpr size_t WS_HGO = 350 * MiB;
constexpr size_t WS_CTXR = 383 * MiB;
constexpr size_t WS_HLT = WS_HGO;
constexpr size_t WS_HSP = 384 * MiB;
constexpr size_t WS_HDG = 402 * MiB;
constexpr size_t WS_VT = 403 * MiB;
constexpr size_t WS_HID = WS_PROJ;
constexpr size_t WS_AS = 202 * MiB;
constexpr size_t WS_HIDM = 270 * MiB;
constexpr size_t WS_H2B = 440 * MiB;
constexpr size_t WS_YF = WS_WIN;
constexpr size_t WS_Y = WS_MGU;
constexpr size_t WS_XB = 104 * MiB;
constexpr size_t WS_PART1 = 176 * MiB;
constexpr size_t WS_PART2 = 180 * MiB;
constexpr size_t WS_END = 508 * MiB;
static_assert(WS_HID + (size_t)R_ALL * FFN * 2 <= WS_HGO && WS_AS + (size_t)MOE_MAXROWS * DM * 2 <= WS_HIDM && WS_HIDM + (size_t)MOE_MAXROWS * EXD * 2 <= WS_END, "ws map");
static_assert(WS_PART1 >= WS_MD + (size_t)8 * DM * EXD && WS_PART1 + (size_t)4 * 256 * DM * 4 <= WS_PART2 && WS_PART2 + (size_t)11 * 256 * DM * 4 <= WS_H, "ws map 4");
static_assert(WS_XB >= WS_Y + (size_t)MOE_MAXROWS * DM * 2 && WS_XB >= WS_MGU + (size_t)8 * 2 * EXD * DM && WS_XB + (size_t)S_LAT * DM * 2 <= WS_MD, "ws map 3");
static_assert(WS_H2B >= WS_HIDM && WS_H2B + (size_t)S_LAT * DM * 2 <= WS_END && WS_H + (size_t)R_ALL * DM * 2 <= WS_PROJ && WS_PROJ + (size_t)R_ALL * INW * 2 <= WS_MIX && WS_MIX + (size_t)R_ALL * DM * 2 <= WS_HGO && WS_HGO + (size_t)2 * R_ALL * 256 * 4 <= WS_CTXR, "ws map 2");
constexpr int VO_MOD = 0;
constexpr int VO_ROPE = 32768;
constexpr int VO_MOE = 65536;
constexpr int CW_BAR = 4096;
constexpr int CW_QUEUE = 2048;
constexpr int CW_MOECNT = 1024;

constexpr int RING_BYTES = 131072;
constexpr int LDSCTL_OFF = 159744, MISC_OFF = LDSCTL_OFF + 320;
constexpr int LDS_BYTES = 163840;

#define GAS __attribute__((address_space(1)))
#define LAS __attribute__((address_space(3)))
typedef unsigned short bf16;
typedef unsigned v4u __attribute__((ext_vector_type(4)));
typedef unsigned v2u __attribute__((ext_vector_type(2)));
typedef float f32x4 __attribute__((ext_vector_type(4)));
typedef GAS unsigned gu32;
#define RLX_AGENT __ATOMIC_RELAXED, __HIP_MEMORY_SCOPE_AGENT
#define LDS_WAIT() asm volatile("s_waitcnt lgkmcnt(0)" ::: "memory")
typedef float f32x2_t __attribute__((ext_vector_type(2))); typedef __bf16 bf16x2_t __attribute__((ext_vector_type(2)));
__device__ __forceinline__ unsigned pk2(float lo, float hi) { const f32x2_t v = {lo, hi}; const bf16x2_t b = __builtin_convertvector(v, bf16x2_t); return __builtin_bit_cast(unsigned, b); }
__device__ __forceinline__ unsigned f2bf(float f) { return pk2(f, 0.f) & 0xffffu; }
__device__ __forceinline__ float bflo(unsigned w) { return __builtin_bit_cast(float, w << 16); }
__device__ __forceinline__ float bfhi(unsigned w) { return __builtin_bit_cast(float, w & 0xffff0000u); }
__device__ __forceinline__ float sigm1(float x) { return __builtin_amdgcn_rcpf(1.0f + __builtin_amdgcn_exp2f(-1.4426950408889634f * x)); }
__device__ __forceinline__ float silu1(float x) { return x * sigm1(x); }
__device__ __forceinline__ float gelu1(float x) { return 0.5f * x * (1.0f + erff(x * 0.70710678118654752f)); }
template <int X> __device__ __forceinline__ float sx(float v) { return __shfl_xor(v, X); }
__device__ __forceinline__ float sx32_add(float v) { return v + __shfl_xor(v, 32); }
__device__ __forceinline__ float sx32_max(float v) { return fmaxf(v, __shfl_xor(v, 32)); }
__device__ __forceinline__ float wave_sum(float v) { v += sx<1>(v); v += sx<2>(v); v += sx<4>(v); v += sx<8>(v); v += sx<16>(v); return sx32_add(v); }
template <int CTRL, int RMASK> __device__ __forceinline__ float dpp_f(float v) { return __builtin_bit_cast(float, __builtin_amdgcn_update_dpp(0, __builtin_bit_cast(int, v), CTRL, RMASK, 0xF, false)); }
__device__ __forceinline__ float wave_sum_dpp(float v) {
    v += dpp_f<0xB1, 0xF>(v);
    v += dpp_f<0x4E, 0xF>(v);
    v += dpp_f<0x141, 0xF>(v);
    v += dpp_f<0x140, 0xF>(v);
    v += dpp_f<0x142, 0xA>(v);
    v += dpp_f<0x143, 0xC>(v);
    return __builtin_bit_cast(float, __builtin_amdgcn_readlane(__builtin_bit_cast(int, v), 63));
}
__device__ __forceinline__ void unpack8(const v4u w, float* f) { f[0] = bflo(w.x); f[1] = bfhi(w.x); f[2] = bflo(w.y); f[3] = bfhi(w.y); f[4] = bflo(w.z); f[5] = bfhi(w.z); f[6] = bflo(w.w); f[7] = bfhi(w.w); }


__device__ __forceinline__ float clamp448(float x) { return fminf(fmaxf(x, -448.0f), 448.0f); }
__device__ __forceinline__ unsigned pk4_fp8(float a, float b, float c, float d) {
    unsigned w = 0u; w = __builtin_amdgcn_cvt_pk_fp8_f32(clamp448(a), clamp448(b), w, false); w = __builtin_amdgcn_cvt_pk_fp8_f32(clamp448(c), clamp448(d), w, true); return w; }
constexpr float F8_WSCALE = 128.0f;
constexpr float F8_ASCALE = 16.0f;
constexpr float F8_HSCALE = 8.0f;
#define XB_TMO      128
#define XB_XCNT(j)  (256  + 64 * (j))
#define XB_XSUB(j)  (1280 + 64 * (j))
#define XB_XGEN(j)  (2304 + 64 * (j))
#define XB_TOP      3328
#define XB_TOPGEN   3392
#define XCD_BAR_WORDS 3456
#define XB_SPIN_CAP (1u << 18)

__device__ __forceinline__ unsigned xb_ld(unsigned* p)              { return __hip_atomic_load(p, __ATOMIC_RELAXED, __HIP_MEMORY_SCOPE_AGENT); }
__device__ __forceinline__ unsigned xb_add(unsigned* p, unsigned v) { return __hip_atomic_fetch_add(p, v, __ATOMIC_RELAXED, __HIP_MEMORY_SCOPE_AGENT); }
__device__ __forceinline__ unsigned xb_xcc_id() { return (unsigned)__builtin_amdgcn_s_getreg((3 << 11) | 20) & 0xFu; }
#define XB_SPIN(cond, bar) do { unsigned _sp = 0; while (cond) { __builtin_amdgcn_s_sleep(1); \
    if ((++_sp & 255u) == 0u) { if (xb_ld(&(bar)[XB_TMO])) break; if (_sp > XB_SPIN_CAP) { atomicAdd(&(bar)[XB_TMO], 1u); break; } } } } while (0)

struct XcdBarrier {
    unsigned* bar; unsigned x;
    volatile LAS unsigned* st;
};

__device__ __forceinline__ XcdBarrier xcd_barrier_post(unsigned* bar, volatile LAS unsigned* st) {
    XcdBarrier b; b.bar = bar; b.x = xb_xcc_id(); b.st = st;
    if (threadIdx.x == 0) (void)xb_add(&bar[XB_XCNT(b.x)], 1u);
    return b;
}
__device__ __forceinline__ void xcd_barrier_complete(unsigned* bar, unsigned x, unsigned& nloc, unsigned& nx) {
    const unsigned G = gridDim.x * gridDim.y * gridDim.z;
    unsigned sum, cnt, mine, sp = 0u;
    for (;;) {
        sum = 0u; cnt = 0u; mine = 0u;
#pragma unroll
        for (unsigned j = 0; j < 16; ++j) { const unsigned c = xb_ld(&bar[XB_XCNT(j)]); sum += c; cnt += (c > 0u) ? 1u : 0u; mine = (j == x) ? c : mine; }
        if (sum == G) break;
        __builtin_amdgcn_s_sleep(1);
        if ((++sp & 255u) == 0u) { if (xb_ld(&bar[XB_TMO])) break; if (sp > XB_SPIN_CAP) { atomicAdd(&bar[XB_TMO], 1u); break; } }
    }
    nloc = mine > 0u ? mine : 1u; nx = cnt > 0u ? cnt : 1u;
}

__device__ __forceinline__ void xcd_barrier(const XcdBarrier& b, const int tid_in) {
    asm volatile("s_waitcnt vmcnt(0)" ::: "memory");
    __syncthreads();
    if (tid_in == 0) {
        unsigned* bar = b.bar;
        __builtin_amdgcn_s_waitcnt(0);
        unsigned nloc = b.st[0], nx = b.st[1];
        if (nloc == 0u) { xcd_barrier_complete(bar, b.x, nloc, nx); b.st[0] = nloc; b.st[1] = nx; }
        const unsigned old = xb_add(&bar[XB_XSUB(b.x)], 1u);
        const unsigned gen = old / nloc;
        if (old + 1u == (gen + 1u) * nloc) {
            __builtin_amdgcn_fence(__ATOMIC_RELEASE, "agent");
            asm volatile("s_waitcnt vmcnt(0)" ::: "memory");
            const unsigned og = xb_add(&bar[XB_TOP], 1u);
            const unsigned tg = og / nx;
            if (og + 1u == (tg + 1u) * nx) xb_add(&bar[XB_TOPGEN], 1u);
            else XB_SPIN(xb_ld(&bar[XB_TOPGEN]) == tg, bar);
            __builtin_amdgcn_fence(__ATOMIC_ACQUIRE, "agent");
            xb_add(&bar[XB_XGEN(b.x)], 1u);
            asm volatile("s_waitcnt vmcnt(0)" ::: "memory");
        } else {
            XB_SPIN(xb_ld(&bar[XB_XGEN(b.x)]) == gen, bar);
            __builtin_amdgcn_fence(__ATOMIC_ACQUIRE, "agent");
            asm volatile("s_waitcnt vmcnt(0)" ::: "memory");
        }
    }
    __syncthreads();
}


struct Args { const float* in[23]; float* out; unsigned char* ws; int ph_lo, ph_hi; };
typedef const __attribute__((address_space(4))) Args* KA;
#define KARGS() ({ KA p_ = (KA)__builtin_amdgcn_kernarg_segment_ptr(); asm volatile("" : "+s"(p_)); p_; })
enum { I_X = 0, I_C, I_CTX, I_CCTX, I_WADA, I_BADA, I_WIN, I_WOUT, I_QG, I_KG, I_SINK, I_HLB, I_HGAIN, I_GWS, I_GBS, I_GNG, I_FG, I_FU, I_FD, I_ROUTER, I_MG, I_MU, I_MDN };

__device__ __forceinline__ void transpose_item(const float* W, int K, int N, bf16* WT, int mode, LAS float* scr, int item, int lane) {
    const int nblk = N / 32, kb = item / nblk, nb = item % nblk, k0 = 64 * kb, n0 = 32 * nb;
    const float* wb = W + (size_t)k0 * N + n0; const int loff = (lane >> 5) * N + (lane & 31);
    float wv[32];
#pragma unroll
    for (int i = 0; i < 32; ++i) wv[i] = __builtin_nontemporal_load(wb + (size_t)(2 * i) * N + loff);
#pragma unroll
    for (int i = 0; i < 32; ++i) scr[(2 * i + (lane >> 5)) * 33 + (lane & 31)] = wv[i];
    LDS_WAIT(); asm volatile("" ::: "memory");
    const int c = lane & 7;
#pragma unroll
    for (int j = 0; j < 4; ++j) { const int n = (lane >> 3) + 8 * j; const LAS float* s = scr + (8 * c) * 33 + n;
        v4u o; o.x = pk2(s[0 * 33], s[1 * 33]); o.y = pk2(s[2 * 33], s[3 * 33]); o.z = pk2(s[4 * 33], s[5 * 33]); o.w = pk2(s[6 * 33], s[7 * 33]);
        const int ng = n0 + n; const int drow = (mode == 0) ? ng : (ng + 128 * (ng / 128) + (mode == 2 ? 128 : 0));
        *(GAS v4u*)(WT + (size_t)drow * K + k0 + 8 * c) = o; }
    LDS_WAIT(); asm volatile("" ::: "memory");
}
__device__ __forceinline__ void transpose_item8(const float* W, int K, int N, unsigned char* WT, int mode, LAS float* scr, int item, int lane) {
    const int nblk = N / 32, kb = item / nblk, nb = item % nblk, k0 = 64 * kb, n0 = 32 * nb;
    const float* wb = W + (size_t)k0 * N + n0; const int loff = (lane >> 5) * N + (lane & 31);
    float wv[32];
#pragma unroll
    for (int i = 0; i < 32; ++i) wv[i] = __builtin_nontemporal_load(wb + (size_t)(2 * i) * N + loff);
#pragma unroll
    for (int i = 0; i < 32; ++i) scr[(2 * i + (lane >> 5)) * 33 + (lane & 31)] = wv[i];
    LDS_WAIT(); asm volatile("" ::: "memory");
    const int c = lane & 7;
#pragma unroll
    for (int j = 0; j < 4; ++j) { const int n = (lane >> 3) + 8 * j; const LAS float* s = scr + (8 * c) * 33 + n;
        v2u o; o.x = pk4_fp8(s[0 * 33] * F8_WSCALE, s[1 * 33] * F8_WSCALE, s[2 * 33] * F8_WSCALE, s[3 * 33] * F8_WSCALE); o.y = pk4_fp8(s[4 * 33] * F8_WSCALE, s[5 * 33] * F8_WSCALE, s[6 * 33] * F8_WSCALE, s[7 * 33] * F8_WSCALE);
        const int ng = n0 + n; const int drow = (mode == 0) ? ng : (ng + 128 * (ng / 128) + (mode == 2 ? 128 : 0));
        *(GAS v2u*)(WT + (size_t)drow * K + k0 + 8 * c) = o; }
    LDS_WAIT(); asm volatile("" ::: "memory");
}
constexpr int MOE_ITEMS = 24 * 16 * 112;
constexpr int MOE_SL0 = 0, MOE_SL1 = 5376, MOE_SL2 = 10752, MOE_SL3 = 16128, MOE_SL4 = 19200, MOE_SL5 = 25344, MOE_SL6 = 29184, MOE_SL7 = 32576, MOE_DEFER = 34496;
__device__ __forceinline__ void moe_conv_item(KA a, int it, LAS float* scr, int lane) {
    constexpr int I_M = 16 * 112;
    unsigned char* ws = a->ws;
    const int idx = it / I_M, r = it % I_M;
    if (idx < 8) transpose_item8(a->in[I_MG] + (size_t)idx * DM * EXD, DM, EXD, (unsigned char*)(ws + WS_MGU) + (size_t)idx * 2 * EXD * DM, 1, scr, r, lane);
    else if (idx < 16) transpose_item8(a->in[I_MU] + (size_t)(idx - 8) * DM * EXD, DM, EXD, (unsigned char*)(ws + WS_MGU) + (size_t)(idx - 8) * 2 * EXD * DM, 2, scr, r, lane);
    else transpose_item8(a->in[I_MDN] + (size_t)(idx - 16) * EXD * DM, EXD, DM, (unsigned char*)(ws + WS_MD) + (size_t)(idx - 16) * DM * EXD, 0, scr, r, lane);
}
__device__ __forceinline__ void moe_conv_range(KA a, int lo, int hi, int first, LAS unsigned char* lds, int lane, int wave, int G, int bid) {
    if (bid < first) return;
    LAS float* scr = (LAS float*)(lds + wave * 8704);
    const int nw = (G - first) * NWAVES, w = (bid - first) * NWAVES + wave;
    for (int i = lo + w; i < hi; i += nw) moe_conv_item(a, i, scr, lane);
}
__device__ __forceinline__ void p0_prologue(KA a, LAS unsigned char* lds, int tid, int lane, int wave, int G, int bid) {
    unsigned char* ws = a->ws;
    LAS float* scr = (LAS float*)(lds + wave * 8704);
    const int gw = bid * NWAVES + wave, NGW = G * NWAVES;
    constexpr int I_IN = 16 * 80, I_OUT = 16 * 32, I_F = 16 * 88, I_FDN = 44 * 32, I_M = 16 * 112;
    constexpr int NIT = 2 * I_IN + 2 * I_OUT + 2 * I_F + I_FDN + 24 * I_M;
    LAS float* sil = (LAS float*)(lds + 69632);
    LAS float* part = (LAS float*)(lds + 69632 + 8192);
    float* vec = (float*)(ws + WS_VEC);
    const bool wada = bid < 192;
    if (wada) { for (int i = tid; i < 2048; i += NTHR) { const float v = (i < 1024) ? a->in[I_C][i] : a->in[I_CCTX][i - 1024]; sil[i] = silu1(v); } __syncthreads(); }
    const int l0 = bid / 96, col0 = (bid % 96) * 64 + lane;
    const float* w0 = a->in[I_WADA] + (size_t)l0 * DM * 6144 + col0;
    float a0 = 0.f, a1 = 0.f; int jb = 0;
    for (int it0 = gw; it0 < NIT || (wada && jb < 4); it0 += NGW) {
        float wv[32]; const bool wb = wada && jb < 4; const int k0 = wave * 128 + 32 * jb;
        if (wb) {
#pragma unroll
            for (int j = 0; j < 32; ++j) wv[j] = __builtin_nontemporal_load(&w0[(size_t)(k0 + j) * 6144]); }
        if (it0 < NIT) {
            int it = it0;
            if (it < 2 * I_IN) { const int l = it / I_IN, r = it % I_IN; transpose_item(a->in[I_WIN] + (size_t)l * DM * INW, DM, INW, (bf16*)(ws + WS_WIN) + (size_t)l * INW * DM, 0, scr, r, lane); }
            else if ((it -= 2 * I_IN) < 2 * I_OUT) { const int l = it / I_OUT, r = it % I_OUT; transpose_item(a->in[I_WOUT] + (size_t)l * DM * DM, DM, DM, (bf16*)(ws + WS_WOUT) + (size_t)l * DM * DM, 0, scr, r, lane); }
            else if ((it -= 2 * I_OUT) < I_F) transpose_item(a->in[I_FG], DM, FFN, (bf16*)(ws + WS_WGU), 1, scr, it, lane);
            else if ((it -= I_F) < I_F) transpose_item(a->in[I_FU], DM, FFN, (bf16*)(ws + WS_WGU), 2, scr, it, lane);
            else if ((it -= I_F) < I_FDN) transpose_item(a->in[I_FD], FFN, DM, (bf16*)(ws + WS_WD), 0, scr, it, lane);
            else if ((it -= I_FDN) >= MOE_DEFER) moe_conv_item(a, it, scr, lane);
        }
        if (wb) {
#pragma unroll
            for (int j = 0; j < 32; ++j) { a0 += sil[k0 + j] * wv[j]; a1 += sil[1024 + k0 + j] * wv[j]; }
            ++jb; }
    }
    if (wada) {
        for (int item = bid; item < 192; item += G) {
            const int l = item / 96, cb = item % 96, col = cb * 64 + lane;
            if (item != bid) {
                const float* w = a->in[I_WADA] + (size_t)l * DM * 6144 + col; a0 = 0.f; a1 = 0.f;
#pragma unroll 1
                for (int k0 = wave * 128; k0 < wave * 128 + 128; k0 += 32) { float wv[32];
#pragma unroll
                    for (int j = 0; j < 32; ++j) wv[j] = __builtin_nontemporal_load(&w[(size_t)(k0 + j) * 6144]);
#pragma unroll
                    for (int j = 0; j < 32; ++j) { a0 += sil[k0 + j] * wv[j]; a1 += sil[1024 + k0 + j] * wv[j]; } } }
            part[(wave * 2 + 0) * 64 + lane] = a0; part[(wave * 2 + 1) * 64 + lane] = a1;
            __syncthreads();
            if (wave == 0) { float s0 = 0.f, s1 = 0.f;
#pragma unroll
                for (int w8 = 0; w8 < 8; ++w8) { s0 += part[(w8 * 2 + 0) * 64 + lane]; s1 += part[(w8 * 2 + 1) * 64 + lane]; }
                const float b = a->in[I_BADA][l * 6144 + col];
                vec[VO_MOD + (l * 2 + 0) * 6144 + col] = s0 + b; vec[VO_MOD + (l * 2 + 1) * 6144 + col] = s1 + b; }
            __syncthreads();
        }
    }
    if (bid == G - 1) {
        for (int idx = tid; idx < 5120; idx += NTHR) {
            const int isc = idx >= 4096, j = isc ? idx - 4096 : idx, pos = j / 16, i = j % 16;
            const float inv = exp2f(-(float)i * 0.83048202372184059f);
            const float ang = (float)pos * inv;
            double r = (double)ang * 0.15915494309189535; r -= floor(r);
            const float rf = (float)r;
            const float cs = __builtin_amdgcn_cosf(rf), sn = __builtin_amdgcn_sinf(rf);
            float* t = vec + VO_ROPE + (isc ? 8192 : 0);
            const int n = isc ? 1024 : 4096;
            t[j] = cs; t[n + j] = sn;
        }
    }
}

template <bool STORE = true, bool BFX = false> __device__ __forceinline__ void norm_row(const void* xrow, const float* sc, const float* sh, bf16* orow, int lane, f32x4 (&h)[4]) {
    f32x4 v[4]; float s = 0.f;
    if constexpr (BFX) { const GAS v2u* xr = (const GAS v2u*)xrow + lane;
#pragma unroll
        for (int j = 0; j < 4; ++j) { const v2u t = xr[64 * j]; v[j] = (f32x4){bflo(t.x), bfhi(t.x), bflo(t.y), bfhi(t.y)}; } }
    else { const GAS f32x4* xr = (const GAS f32x4*)xrow + lane;
#pragma unroll
        for (int j = 0; j < 4; ++j) v[j] = xr[64 * j]; }
#pragma unroll
    for (int j = 0; j < 4; ++j) s += (v[j].x * v[j].x + v[j].y * v[j].y) + (v[j].z * v[j].z + v[j].w * v[j].w);
    const float rstd = __builtin_amdgcn_rsqf(wave_sum_dpp(s) * (1.0f / DM) + EPS);
    GAS v2u* o8 = (GAS v2u*)orow + lane;
#pragma unroll
    for (int j = 0; j < 4; ++j) { const f32x4 scv = *(const f32x4*)(sc + 4 * lane + 256 * j), shv = *(const f32x4*)(sh + 4 * lane + 256 * j);
        h[j] = v[j] * rstd * (scv + 1.0f) + shv;
        if constexpr (STORE) { v2u w; w.x = pk2(h[j].x, h[j].y); w.y = pk2(h[j].z, h[j].w); o8[64 * j] = w; } }
}
__device__ __forceinline__ void phase_norm(KA a, int l, int which, int nrows, bf16* H, int lane, int wave, int G, int bid) {
    const float* vec = (const float*)(a->ws + WS_VEC);
    const bool bfx = !(l == 0 && which == 0);
    const float* xl = a->in[I_X]; const bf16* xb = (const bf16*)(a->ws + WS_XB);
    const float* xc = (l == 0) ? a->in[I_CTX] : (const float*)(a->ws + WS_CTXR);
    const int nlat = nrows < S_LAT ? nrows : S_LAT;
    const float* ml = vec + VO_MOD + (l * 2 + 0) * 6144 + which * 3072;
    const float* mc = vec + VO_MOD + (l * 2 + 1) * 6144 + which * 3072;
    const int gw = bid * NWAVES + wave, NGW = G * NWAVES;
    f32x4 scl[4], shl[4], v[4];
#pragma unroll
    for (int j = 0; j < 4; ++j) { scl[j] = *(const f32x4*)(ml + 1024 + 4 * lane + 256 * j) + 1.0f; shl[j] = *(const f32x4*)(ml + 4 * lane + 256 * j); }
    if (gw < nlat) {
        if (bfx) { const GAS v2u* xr = (const GAS v2u*)(xb + (size_t)gw * DM) + lane;
#pragma unroll
            for (int j = 0; j < 4; ++j) { const v2u t = xr[64 * j]; v[j] = (f32x4){bflo(t.x), bfhi(t.x), bflo(t.y), bfhi(t.y)}; } }
        else { const GAS f32x4* xr = (const GAS f32x4*)(xl + (size_t)gw * DM) + lane;
#pragma unroll
            for (int j = 0; j < 4; ++j) v[j] = xr[64 * j]; } }
    for (int r = gw; r < nlat; r += NGW) {
        const int rn = r + NGW; f32x4 vn[4];
        if (rn < nlat) {
            if (bfx) { const GAS v2u* xr = (const GAS v2u*)(xb + (size_t)rn * DM) + lane;
#pragma unroll
                for (int j = 0; j < 4; ++j) { const v2u t = xr[64 * j]; vn[j] = (f32x4){bflo(t.x), bfhi(t.x), bflo(t.y), bfhi(t.y)}; } }
            else { const GAS f32x4* xr = (const GAS f32x4*)(xl + (size_t)rn * DM) + lane;
#pragma unroll
                for (int j = 0; j < 4; ++j) vn[j] = xr[64 * j]; } }
        float s = 0.f;
#pragma unroll
        for (int j = 0; j < 4; ++j) s += (v[j].x * v[j].x + v[j].y * v[j].y) + (v[j].z * v[j].z + v[j].w * v[j].w);
        const float rstd = __builtin_amdgcn_rsqf(wave_sum_dpp(s) * (1.0f / DM) + EPS);
        GAS v2u* o8 = (GAS v2u*)(H + (size_t)r * DM) + lane;
#pragma unroll
        for (int j = 0; j < 4; ++j) { const f32x4 h = v[j] * rstd * scl[j] + shl[j]; v2u w; w.x = pk2(h.x, h.y); w.y = pk2(h.z, h.w); o8[64 * j] = w; }
#pragma unroll
        for (int j = 0; j < 4; ++j) v[j] = vn[j];
    }
    const int npart = (l == 0 && which == 0) ? 0 : (l == 0 ? 4 : 11);
    const float* part = (const float*)(a->ws + (l == 0 ? WS_PART1 : WS_PART2));
    for (int r = S_LAT + (NGW - 1 - gw); r < nrows; r += NGW) {
        const int cr = r - S_LAT; f32x4 x[4];
        { const GAS f32x4* xr = (const GAS f32x4*)(xc + (size_t)cr * DM) + lane;
#pragma unroll
          for (int j = 0; j < 4; ++j) x[j] = xr[64 * j]; }
        for (int p = 0; p < npart; ++p) { const GAS f32x4* pr = (const GAS f32x4*)(part + ((size_t)p * 256 + cr) * DM) + lane;
#pragma unroll
            for (int j = 0; j < 4; ++j) x[j] = x[j] + pr[64 * j]; }
        if (npart && l == 0) { GAS f32x4* cw = (GAS f32x4*)((float*)(a->ws + WS_CTXR) + (size_t)cr * DM) + lane;
#pragma unroll
            for (int j = 0; j < 4; ++j) cw[64 * j] = x[j]; }
        float s = 0.f;
#pragma unroll
        for (int j = 0; j < 4; ++j) s += (x[j].x * x[j].x + x[j].y * x[j].y) + (x[j].z * x[j].z + x[j].w * x[j].w);
        const float rstd = __builtin_amdgcn_rsqf(wave_sum_dpp(s) * (1.0f / DM) + EPS);
        GAS v2u* o8 = (GAS v2u*)(H + (size_t)r * DM) + lane;
#pragma unroll
        for (int j = 0; j < 4; ++j) { const f32x4 scv = *(const f32x4*)(mc + 1024 + 4 * lane + 256 * j), shv = *(const f32x4*)(mc + 4 * lane + 256 * j);
            const f32x4 h = x[j] * rstd * (scv + 1.0f) + shv; v2u w; w.x = pk2(h.x, h.y); w.y = pk2(h.z, h.w); o8[64 * j] = w; }
    }
}
constexpr int ROUTE_ROWS_OFF = 36864;
__device__ __forceinline__ void phase_norm_route(KA a, LAS unsigned char* lds, int tid, int lane, int wave, int G, int bid) {
    const int l = 1;
    const float* vec = (const float*)(a->ws + WS_VEC);
    const float* ml = vec + VO_MOD + (l * 2 + 0) * 6144 + 3072;
    LAS float* rt = (LAS float*)lds;
    volatile LAS unsigned* lcnt = (volatile LAS unsigned*)(lds + 32768);
    for (int i = tid; i < 8192; i += NTHR) rt[i] = a->in[I_ROUTER][i];
    if (tid < 16) lcnt[tid] = 0u;
    __syncthreads();
    int* tokinfo = (int*)(a->ws + WS_TOK);
    unsigned* cnt = (unsigned*)(a->ws + WS_CTL) + CW_MOECNT;
    const int gw = bid * NWAVES + wave, NGW = G * NWAVES;
    unsigned keep = 0u, pk0 = 0u; int itn = 0;
    f32x4 scl[4], shl[4]; v2u nx[4];
#pragma unroll
    for (int j = 0; j < 4; ++j) { scl[j] = *(const f32x4*)(ml + 1024 + 4 * lane + 256 * j) + 1.0f; shl[j] = *(const f32x4*)(ml + 4 * lane + 256 * j); }
    if (gw < S_LAT) { const GAS v2u* xr = (const GAS v2u*)((const bf16*)(a->ws + WS_XB) + (size_t)gw * DM) + lane;
#pragma unroll
        for (int j = 0; j < 4; ++j) nx[j] = xr[64 * j]; }
    for (int r = gw; r < S_LAT; r += NGW) {
        f32x4 h[4];
        { v2u cu[4];
#pragma unroll
          for (int j = 0; j < 4; ++j) cu[j] = nx[j];
          if (r + NGW < S_LAT) { const GAS v2u* xr = (const GAS v2u*)((const bf16*)(a->ws + WS_XB) + (size_t)(r + NGW) * DM) + lane;
#pragma unroll
              for (int j = 0; j < 4; ++j) nx[j] = xr[64 * j]; }
          float s = 0.f;
#pragma unroll
          for (int j = 0; j < 4; ++j) { h[j] = (f32x4){bflo(cu[j].x), bfhi(cu[j].x), bflo(cu[j].y), bfhi(cu[j].y)}; s += (h[j].x * h[j].x + h[j].y * h[j].y) + (h[j].z * h[j].z + h[j].w * h[j].w); }
          const float rstd = __builtin_amdgcn_rsqf(wave_sum_dpp(s) * (1.0f / DM) + EPS);
#pragma unroll
          for (int j = 0; j < 4; ++j) h[j] = h[j] * rstd * scl[j] + shl[j]; }
#pragma unroll
        for (int j = 0; j < 4; ++j) ((LAS unsigned*)(lds + ROUTE_ROWS_OFF + wave * 8192 + itn * 1024))[lane + 64 * j] = pk4_fp8(h[j].x * F8_ASCALE, h[j].y * F8_ASCALE, h[j].z * F8_ASCALE, h[j].w * F8_ASCALE);
        float lg[8];
#pragma unroll
        for (int e = 0; e < 8; ++e) lg[e] = 0.f;
#pragma unroll
        for (int j = 0; j < 4; ++j)
#pragma unroll
            for (int i = 0; i < 4; ++i) { const int d = 4 * lane + 256 * j + i; const f32x4 r0 = *(const LAS f32x4*)(rt + d * 8), r1 = *(const LAS f32x4*)(rt + d * 8 + 4); const float hv = h[j][i];
                lg[0] += hv * r0.x; lg[1] += hv * r0.y; lg[2] += hv * r0.z; lg[3] += hv * r0.w; lg[4] += hv * r1.x; lg[5] += hv * r1.y; lg[6] += hv * r1.z; lg[7] += hv * r1.w; }
#pragma unroll
        for (int e = 0; e < 8; ++e) lg[e] = wave_sum_dpp(lg[e]);
        int i1 = 0; float v1 = lg[0];
#pragma unroll
        for (int e = 1; e < 8; ++e) if (lg[e] > v1) { v1 = lg[e]; i1 = e; }
        int i2 = -1; float v2 = -INFINITY;
#pragma unroll
        for (int e = 0; e < 8; ++e) if (e != i1 && lg[e] > v2) { v2 = lg[e]; i2 = e; }
        const float w1 = 1.0f / (1.0f + __expf(v2 - v1)), w2 = 1.0f - w1;
        if (lane == 0) {
            const unsigned r1 = __hip_atomic_fetch_add((LAS unsigned*)lcnt + i1, 1u, __ATOMIC_RELAXED, __HIP_MEMORY_SCOPE_WORKGROUP), r2 = __hip_atomic_fetch_add((LAS unsigned*)lcnt + i2, 1u, __ATOMIC_RELAXED, __HIP_MEMORY_SCOPE_WORKGROUP);
            int* ti = tokinfo + (size_t)r * 8;
            ti[0] = i1; ti[1] = i2; ti[4] = __builtin_bit_cast(int, w1); ti[5] = __builtin_bit_cast(int, w2);
            pk0 = (unsigned)i1 | ((unsigned)i2 << 3) | (r1 << 6) | (r2 << 19);
        }
        const unsigned pku = (unsigned)__builtin_amdgcn_readfirstlane((int)pk0);
        if (lane == itn) keep = pku;
        ++itn;
    }
    __syncthreads();
    if (tid < 8) lcnt[8 + tid] = __hip_atomic_fetch_add(cnt + 64 * tid, lcnt[tid], RLX_AGENT);
    __syncthreads();
    { const int r = gw + lane * NGW; if (lane < itn && r < S_LAT) { int* ti = tokinfo + (size_t)r * 8; const unsigned e1 = keep & 7u, e2 = (keep >> 3) & 7u; ti[2] = (int)(((keep >> 6) & 0x1fffu) + lcnt[8 + e1]); ti[3] = (int)((keep >> 19) + lcnt[8 + e2]); } }
}

__device__ __forceinline__ void qk_prep(KA a, int l, int first_thread, int nthreads) {
    bf16* PROJ = (bf16*)(a->ws + WS_PROJ);
    const float* rope = (const float*)(a->ws + WS_VEC) + VO_ROPE;
    for (int i = first_thread; i < R_ALL * 10; i += nthreads) {
        const int row = i / 10, hh = i % 10; const bool isq = hh < 8;
        bf16* p = PROJ + (size_t)row * INW + (isq ? hh * 64 : COL_AK + (hh - 8) * 64);
        const float* gain = (isq ? a->in[I_QG] : a->in[I_KG]) + l * 64;
        float x[64]; float ss = 0.f;
#pragma unroll
        for (int c = 0; c < 8; ++c) { const v4u w = *(const GAS v4u*)(p + 8 * c); unpack8(w, x + 8 * c); }
#pragma unroll
        for (int d = 0; d < 64; ++d) ss += x[d] * x[d];
        const float rstd = __builtin_amdgcn_rsqf(ss * (1.0f / 64.0f) + EPS);
        const f32x4* g4 = (const f32x4*)gain;
#pragma unroll
        for (int c = 0; c < 16; ++c) { const f32x4 gv = g4[c]; x[4 * c] *= rstd * gv.x; x[4 * c + 1] *= rstd * gv.y; x[4 * c + 2] *= rstd * gv.z; x[4 * c + 3] *= rstd * gv.w; }
        if (row < S_LAT) {
            const int gr = row >> 6, gc = row & 63;
            const f32x4* cr = (const f32x4*)(rope + gr * 16); const f32x4* sr = (const f32x4*)(rope + 4096 + gr * 16); const f32x4* cc = (const f32x4*)(rope + 8192 + gc * 16); const f32x4* sc = (const f32x4*)(rope + 8192 + 1024 + gc * 16);
#pragma unroll
            for (int j4 = 0; j4 < 4; ++j4) { const f32x4 cv = cr[j4], sv = sr[j4];
#pragma unroll
                for (int i = 0; i < 4; ++i) { const int j = 4 * j4 + i; const float x1 = x[j], x2 = x[16 + j]; x[j] = x1 * cv[i] - x2 * sv[i]; x[16 + j] = x1 * sv[i] + x2 * cv[i]; } }
#pragma unroll
            for (int j4 = 0; j4 < 4; ++j4) { const f32x4 cv = cc[j4], sv = sc[j4];
#pragma unroll
                for (int i = 0; i < 4; ++i) { const int j = 4 * j4 + i; const float x1 = x[32 + j], x2 = x[48 + j]; x[32 + j] = x1 * cv[i] - x2 * sv[i]; x[48 + j] = x1 * sv[i] + x2 * cv[i]; } }
        }
        const float qs = isq ? 0.125f * 1.4426950408889634f : 1.0f;
#pragma unroll
        for (int c = 0; c < 8; ++c) { v4u w; w.x = pk2(x[8 * c] * qs, x[8 * c + 1] * qs); w.y = pk2(x[8 * c + 2] * qs, x[8 * c + 3] * qs); w.z = pk2(x[8 * c + 4] * qs, x[8 * c + 5] * qs); w.w = pk2(x[8 * c + 6] * qs, x[8 * c + 7] * qs);
            *(GAS v4u*)(p + 8 * c) = w; }
    }
}
__device__ __forceinline__ void gmlp_unit(KA a, int l, int chunk, int g, LAS unsigned char* lds, int tid, int lane, int wave) {
    const bf16* PROJ = (const bf16*)(a->ws + WS_PROJ); bf16* MIX = (bf16*)(a->ws + WS_MIX);
    const int row0 = (chunk < 128) ? chunk * 128 : S_LAT + (chunk - 128) * 128;
    LAS float* vn = (LAS float*)lds;
    { const int pos = tid >> 2, part = tid & 3;
      const bf16* p = PROJ + (size_t)(row0 + pos) * INW + COL_GV + g * 64 + part * 16;
      float x[16]; unpack8(*(const GAS v4u*)p, x); unpack8(*(const GAS v4u*)(p + 8), x + 8);
      float ss = 0.f;
#pragma unroll
      for (int d = 0; d < 16; ++d) { x[d] = gelu1(x[d]); ss += x[d] * x[d]; }
      ss += sx<1>(ss); ss += sx<2>(ss);
      const float rstd = __builtin_amdgcn_rsqf(ss * (1.0f / 64.0f) + EPS);
      const float* gn = a->in[I_GNG] + l * 256 + g * 64 + part * 16;
#pragma unroll
      for (int d = 0; d < 16; ++d) vn[pos * 64 + part * 16 + d] = x[d] * rstd * gn[d]; }
    __syncthreads();
    const int c = lane, t0 = wave * 16;
    const float* W = a->in[I_GWS] + ((size_t)(l * 4 + g) * 128 + t0) * 128;
    float acc[16];
#pragma unroll
    for (int i = 0; i < 16; ++i) acc[i] = 0.f;
    for (int s = 0; s < 128; ++s) { const float v = vn[s * 64 + c];
#pragma unroll
        for (int i = 0; i < 16; ++i) acc[i] += W[i * 128 + s] * v; }
    const float* bs = a->in[I_GBS] + (l * 4 + g) * 128 + t0;
#pragma unroll
    for (int i = 0; i < 16; ++i) { const int row = row0 + t0 + i;
        const float u = gelu1(bflo((unsigned)PROJ[(size_t)row * INW + COL_GU + g * 64 + c]));
        MIX[(size_t)row * DM + MIX_GM + g * 64 + c] = (bf16)f2bf(u * (acc[i] + bs[i])); }
    __syncthreads();
}
__device__ __forceinline__ void hgrn_naive(KA a, int l, int dir, int head, LAS unsigned char* lds, int tid, int lane, int wave) {
    const bf16* PROJ = (const bf16*)(a->ws + WS_PROJ);
    float* HGO = (float*)(a->ws + WS_HGO) + (size_t)dir * R_ALL * 256;
    LAS float* Qs = (LAS float*)lds;
    LAS float* Fs = Qs + 4096; LAS float* Vs = Fs + 4096; LAS float* part = Vs + 4096;
    const int v = lane, kg = wave;
    float S[8];
#pragma unroll
    for (int i = 0; i < 8; ++i) S[i] = 0.f;
    const int tl = tid >> 3, c8 = tid & 7;
    float lb[8];
#pragma unroll
    for (int j = 0; j < 8; ++j) { float b = 0.f; if (l == 1) { const float p0 = a->in[I_HLB][dir * 512 + head * 64 + c8 * 8 + j], p1 = a->in[I_HLB][dir * 512 + 256 + head * 64 + c8 * 8 + j]; b = 1.0f / (1.0f + __expf(p0 - p1)); } lb[j] = b; }
    const int fcol = (dir == 0 ? COL_HFF : COL_HFB) + head * 64 + c8 * 8;
    for (int n0 = 0; n0 < R_ALL; n0 += 64) {
        { const int n = n0 + tl; int row;
          if (dir == 0) row = (n < C_CTX) ? S_LAT + n : n - C_CTX; else row = (n < C_CTX) ? S_LAT + (C_CTX - 1 - n) : (S_LAT - 1) - (n - C_CTX);
          const bf16* pr = PROJ + (size_t)row * INW;
          float q[8], f[8], vv[8];
          unpack8(*(const GAS v4u*)(pr + COL_HQ + head * 64 + c8 * 8), q); unpack8(*(const GAS v4u*)(pr + fcol), f); unpack8(*(const GAS v4u*)(pr + COL_HI + head * 64 + c8 * 8), vv);
#pragma unroll
          for (int j = 0; j < 8; ++j) { Qs[tl * 64 + c8 * 8 + j] = silu1(q[j]) * 0.125f; Fs[tl * 64 + c8 * 8 + j] = lb[j] + (1.0f - lb[j]) * sigm1(f[j]); Vs[tl * 64 + c8 * 8 + j] = vv[j]; } }
        __syncthreads();
        for (int t = 0; t < 64; ++t) {
            const float vt = Vs[t * 64 + v]; float po = 0.f;
#pragma unroll
            for (int i = 0; i < 8; ++i) { const float f = Fs[t * 64 + kg * 8 + i], q = Qs[t * 64 + kg * 8 + i]; S[i] = f * S[i] + (1.0f - f) * vt; po += S[i] * q; }
            part[((t & 1) * 8 + kg) * 64 + v] = po;
            __syncthreads();
            if (wave == 0) { float o = 0.f;
#pragma unroll
                for (int w8 = 0; w8 < 8; ++w8) o += part[((t & 1) * 8 + w8) * 64 + v];
                const int n = n0 + t; int row;
                if (dir == 0) row = (n < C_CTX) ? S_LAT + n : n - C_CTX; else row = (n < C_CTX) ? S_LAT + (C_CTX - 1 - n) : (S_LAT - 1) - (n - C_CTX);
                HGO[(size_t)row * 256 + head * 64 + v] = o; }
        }
        __syncthreads();
    }
}

typedef short bf16x8v __attribute__((ext_vector_type(8)));
constexpr int HST = 72;
__device__ __forceinline__ f32x4 mma16(const LAS bf16* MA, const LAS bf16* MBt, int k0, f32x4 c, int lane) {
    const bf16x8v av = *(const LAS bf16x8v*)(MA + (lane & 15) * HST + k0 + 8 * (lane >> 4));
    const bf16x8v bv = *(const LAS bf16x8v*)(MBt + (lane & 15) * HST + k0 + 8 * (lane >> 4));
    return __builtin_amdgcn_mfma_f32_16x16x32_bf16(av, bv, c, 0, 0, 0);
}
__device__ __forceinline__ int hg_base_row(int cpos) { return cpos < 256 ? 64 * cpos : S_LAT + 64 * (cpos - 256); }
__device__ __forceinline__ int hg_scan_idx(int dir, int cpos) { return dir == 0 ? (cpos < 256 ? 4 + cpos : cpos - 256) : (cpos < 256 ? 4 + (255 - cpos) : 3 - (cpos - 256)); }
__device__ __forceinline__ float hg_lb(KA a, int l, int dir, int head, int k) {
    if (l == 0) return 0.f;
    const float p0 = a->in[I_HLB][dir * 512 + head * 64 + k], p1 = a->in[I_HLB][dir * 512 + 256 + head * 64 + k];
    return 1.0f / (1.0f + __expf(p0 - p1));
}
__device__ __forceinline__ void hgrn_stepA(KA a, int l, int cpos, int head, LAS unsigned char* lds, int lane, int wave) {
    const bf16* PROJ = (const bf16*)(a->ws + WS_PROJ);
    const int dir = wave >> 2, I = wave & 3, base = hg_base_row(cpos), ci = hg_scan_idx(dir, cpos);
    LAS float* TOT = (LAS float*)lds;
    LAS bf16* KLT = (LAS bf16*)(lds + 2048) + dir * 64 * HST;
    LAS bf16* VT = (LAS bf16*)(lds + 2048 + 2 * 64 * HST * 2) + dir * 64 * HST;
    const float lb = hg_lb(a, l, dir, head, lane);
    const int fcol = (dir == 0 ? COL_HFF : COL_HFB) + head * 64 + lane, vcol = COL_HI + head * 64 + lane;
    float kk[16], cl[16]; float run = 0.f;
#pragma unroll
    for (int i = 0; i < 16; ++i) { const int n = 16 * I + i, row = base + (dir ? 63 - n : n);
        const float fl = bflo((unsigned)PROJ[(size_t)row * INW + fcol]);
        const unsigned short vb = PROJ[(size_t)row * INW + vcol];
        const float f = lb + (1.0f - lb) * sigm1(fl);
        run += __logf(f); cl[i] = run; kk[i] = 1.0f - f;
        VT[lane * HST + n] = vb; }
    TOT[(dir * 4 + I) * 64 + lane] = run;
    __syncthreads();
    float post = 0.f, all = 0.f;
#pragma unroll
    for (int J = 0; J < 4; ++J) { const float t = TOT[(dir * 4 + J) * 64 + lane]; all += t; if (J > I) post += t; }
#pragma unroll
    for (int i = 0; i < 16; ++i) KLT[lane * HST + 16 * I + i] = (bf16)f2bf(kk[i] * __expf(run - cl[i] + post));
    if (I == 0) ((float*)(a->ws + WS_HDG))[((size_t)(dir * 4 + head) * 260 + ci) * 64 + lane] = __expf(all);
    __syncthreads();
    float* LT = (float*)(a->ws + WS_HLT) + ((size_t)(dir * 4 + head) * 260 + ci) * 4096;
    float z0 = 0.f; asm volatile("" : "+v"(z0));
#pragma unroll
    for (int kb = 0; kb < 4; ++kb) { f32x4 acc = {z0, z0, z0, z0};
        acc = mma16(VT + 16 * I * HST, KLT + 16 * kb * HST, 0, acc, lane); acc = mma16(VT + 16 * I * HST, KLT + 16 * kb * HST, 32, acc, lane);
#pragma unroll
        for (int r = 0; r < 4; ++r) LT[(16 * I + 4 * (lane >> 4) + r) * 64 + 16 * kb + (lane & 15)] = acc[r]; }
    __syncthreads();
}
__device__ __forceinline__ void hgrn_stepB(KA a, int item, int tid) {
    const int dh = item >> 3, vb = item & 7, v = vb * 8 + (tid >> 6), k = tid & 63;
    const float* LT = (const float*)(a->ws + WS_HLT) + (size_t)dh * 260 * 4096 + v * 64 + k;
    const float* DG = (const float*)(a->ws + WS_HDG) + (size_t)dh * 260 * 64 + k;
    bf16* SP = (bf16*)(a->ws + WS_HSP) + (size_t)dh * 260 * 4096 + v * 64 + k;
    float S = 0.f;
#pragma unroll 1
    for (int c0 = 0; c0 < 260; c0 += 26) {
        float lt[26], dg[26];
#pragma unroll
        for (int j = 0; j < 26; ++j) { lt[j] = LT[(size_t)(c0 + j) * 4096]; dg[j] = DG[(c0 + j) * 64]; }
#pragma unroll
        for (int j = 0; j < 26; ++j) { SP[(size_t)(c0 + j) * 4096] = (bf16)f2bf(S); S = dg[j] * S + lt[j]; }
    }
}
__device__ __forceinline__ void hgrn_stepC(KA a, int l, int cpos, int head, LAS unsigned char* lds, int tid, int lane, int wave) {
    const bf16* PROJ = (const bf16*)(a->ws + WS_PROJ); bf16* MIX = (bf16*)(a->ws + WS_MIX);
    const int dir = wave >> 2, I = wave & 3, base = hg_base_row(cpos), ci = hg_scan_idx(dir, cpos);
    constexpr int MSZ = 64 * HST;
    LAS float* TOT = (LAS float*)lds;
    LAS bf16* img = (LAS bf16*)(lds + 2048);
    LAS bf16* QT = img + dir * MSZ;
    LAS bf16* QD = img + 2 * MSZ + dir * MSZ;
    LAS bf16* VT = img + 4 * MSZ + dir * MSZ;
    LAS bf16* ST = img + 6 * MSZ + dir * MSZ;
    LAS bf16* AS = img + 8 * MSZ + dir * MSZ + I * 16 * HST;
    LAS bf16* KT = img + 10 * MSZ + dir * (10 * 16 * HST);
    LAS float* OS = (LAS float*)(img + 10 * MSZ);
    const float lb = hg_lb(a, l, dir, head, lane);
    const int fcol = (dir == 0 ? COL_HFF : COL_HFB) + head * 64 + lane, qcol = COL_HQ + head * 64 + lane, vcol = COL_HI + head * 64 + lane;
    { const bf16* SP = (const bf16*)(a->ws + WS_HSP) + ((size_t)(dir * 4 + head) * 260 + ci) * 4096;
#pragma unroll
      for (int h2 = 0; h2 < 2; ++h2) { const int e = ((I * 2 + h2) * 64 + lane) * 8, vv = e >> 6, kk0 = e & 63;
          *(LAS v4u*)(ST + vv * HST + kk0) = *(const GAS v4u*)(SP + e); } }
    float kk[16], cl[16], qv[16]; float run = 0.f;
#pragma unroll
    for (int i = 0; i < 16; ++i) { const int n = 16 * I + i, row = base + (dir ? 63 - n : n);
        const float fl = bflo((unsigned)PROJ[(size_t)row * INW + fcol]), ql = bflo((unsigned)PROJ[(size_t)row * INW + qcol]);
        const unsigned short vb = PROJ[(size_t)row * INW + vcol];
        const float f = lb + (1.0f - lb) * sigm1(fl);
        run += __logf(f); cl[i] = run; kk[i] = 1.0f - f; qv[i] = silu1(ql) * 0.125f;
        VT[lane * HST + n] = vb; }
    TOT[(dir * 4 + I) * 64 + lane] = run;
    __syncthreads();
    float tj[4];
#pragma unroll
    for (int J = 0; J < 4; ++J) tj[J] = TOT[(dir * 4 + J) * 64 + lane];
    float pre = 0.f;
#pragma unroll
    for (int J = 0; J < 4; ++J) if (J < I) pre += tj[J];
    const float epre = __expf(pre); float kei[16];
#pragma unroll
    for (int i = 0; i < 16; ++i) { const float e = __expf(cl[i]); QT[(16 * I + i) * HST + lane] = (bf16)f2bf(qv[i] * e); QD[(16 * I + i) * HST + lane] = (bf16)f2bf(qv[i] * e * epre); kei[i] = kk[i] * fminf(__builtin_amdgcn_rcpf(e), 5.5e34f); }
    float eoff = 0.f;
#pragma unroll
    for (int I2 = 0; I2 < 4; ++I2) {
        if (I2 >= I) {
            if (I2 == I) eoff = 0.f; else if (I2 == I + 1) eoff = run; else eoff += tj[I2 - 1];
            LAS bf16* blk = KT + (I2 * (I2 + 1) / 2 + I) * 16 * HST;
            const float fo = __expf(eoff);
#pragma unroll
            for (int i = 0; i < 16; ++i) blk[i * HST + lane] = (bf16)f2bf(kei[i] * fo);
        }
    }
    __syncthreads();
    float z0 = 0.f; asm volatile("" : "+v"(z0));
    f32x4 sc[4];
#pragma unroll
    for (int J = 0; J < 4; ++J) { sc[J] = (f32x4){z0, z0, z0, z0};
        if (J <= I) { const LAS bf16* kb = KT + (I * (I + 1) / 2 + J) * 16 * HST;
            sc[J] = mma16(QT + 16 * I * HST, kb, 0, sc[J], lane); sc[J] = mma16(QT + 16 * I * HST, kb, 32, sc[J], lane);
            if (J == I) {
#pragma unroll
                for (int r = 0; r < 4; ++r) if ((lane & 15) > 4 * (lane >> 4) + r) sc[J][r] = z0; } } }
#pragma unroll
    for (int J = 0; J < 4; ++J)
#pragma unroll
        for (int r = 0; r < 4; ++r) AS[(4 * (lane >> 4) + r) * HST + 16 * J + (lane & 15)] = (bf16)f2bf(sc[J][r]);
    asm volatile("s_waitcnt lgkmcnt(0)" ::: "memory");
    f32x4 acc[4];
#pragma unroll
    for (int vb = 0; vb < 4; ++vb) { acc[vb] = (f32x4){z0, z0, z0, z0};
        acc[vb] = mma16(AS, VT + 16 * vb * HST, 0, acc[vb], lane); acc[vb] = mma16(AS, VT + 16 * vb * HST, 32, acc[vb], lane);
        acc[vb] = mma16(QD + 16 * I * HST, ST + 16 * vb * HST, 0, acc[vb], lane); acc[vb] = mma16(QD + 16 * I * HST, ST + 16 * vb * HST, 32, acc[vb], lane); }
    __syncthreads();
#pragma unroll
    for (int vb = 0; vb < 4; ++vb)
#pragma unroll
        for (int r = 0; r < 4; ++r) { const int n = 16 * I + 4 * (lane >> 4) + r, rl = dir ? 63 - n : n; OS[(dir * 64 + rl) * 68 + 16 * vb + (lane & 15)] = acc[vb][r]; }
    __syncthreads();
    { const int rl = tid >> 3, v8 = (tid & 7) * 8, row = base + rl;
      float o[8]; float ss = 0.f;
#pragma unroll
      for (int j = 0; j < 8; ++j) { o[j] = OS[rl * 68 + v8 + j] + OS[(64 + rl) * 68 + v8 + j]; ss += o[j] * o[j]; }
      ss += sx<1>(ss); ss += sx<2>(ss); ss += sx<4>(ss);
      const float rstd = __builtin_amdgcn_rsqf(ss * (1.0f / 64.0f) + EPS);
      float gt[8]; unpack8(*(const GAS v4u*)(PROJ + (size_t)row * INW + COL_HG + head * 64 + v8), gt);
      const float* gn = a->in[I_HGAIN] + l * 64 + v8;
      float y[8];
#pragma unroll
      for (int j = 0; j < 8; ++j) y[j] = o[j] * rstd * gn[j] * silu1(gt[j]);
      v4u w; w.x = pk2(y[0], y[1]); w.y = pk2(y[2], y[3]); w.z = pk2(y[4], y[5]); w.w = pk2(y[6], y[7]);
      *(GAS v4u*)(MIX + (size_t)row * DM + MIX_HG + head * 64 + v8) = w; }
    __syncthreads();
}

__device__ __forceinline__ void vt_item(KA a, int item, int lane) {
    const bf16* PROJ = (const bf16*)(a->ws + WS_PROJ); bf16* VTg = (bf16*)(a->ws + WS_VT);
    const int rb = item >> 1, hk = item & 1, row = rb * 64 + lane;
    const bf16* p = PROJ + (size_t)row * INW + COL_AV + hk * 64;
    unsigned w[32];
#pragma unroll
    for (int c = 0; c < 8; ++c) { const v4u t = *(const GAS v4u*)(p + 8 * c); w[4 * c] = t.x; w[4 * c + 1] = t.y; w[4 * c + 2] = t.z; w[4 * c + 3] = t.w; }
    bf16* o = VTg + (size_t)hk * 64 * R_ALL + row;
#pragma unroll
    for (int d2 = 0; d2 < 32; ++d2) { o[(size_t)(2 * d2) * R_ALL] = (bf16)(w[d2] & 0xffffu); o[(size_t)(2 * d2 + 1) * R_ALL] = (bf16)(w[d2] >> 16); }
}
__device__ __forceinline__ void attn_unit(KA a, int l, int u, LAS unsigned char* lds, int tid, int lane, int wave) {
    asm volatile("" : "+v"(tid), "+v"(lane));
    const bf16* PROJ = (const bf16*)(a->ws + WS_PROJ); const bf16* VTg = (const bf16*)(a->ws + WS_VT); bf16* MIX = (bf16*)(a->ws + WS_MIX);
    const bool isctx = u >= 256; const int uu = isctx ? u - 256 : u; const int n = uu >> 1, hk = uu & 1;
    const int qh = hk * 4 + (wave >> 1), half = wave & 1;
    const int qbase = (isctx ? S_LAT : 0) + n * 128 + half * 64, qpos0 = n * 128 + half * 64;
    const int c = lane & 15, g = lane >> 4;
    LAS bf16* Kt = (LAS bf16*)lds; LAS bf16* Vt = Kt + 64 * HST; LAS bf16* Qw = Vt + 64 * HST + wave * 64 * HST;
#pragma unroll
    for (int j = 0; j < 8; ++j) { const int qr = 8 * j + (lane >> 3), qc = (lane & 7) * 8;
        *(LAS v4u*)(Qw + qr * HST + qc) = *(const GAS v4u*)(PROJ + (size_t)(qbase + qr) * INW + qh * 64 + qc); }
    float z0 = 0.f; asm volatile("" : "+v"(z0));
    f32x4 o[4][4]; float ls[4];
    float gq = 0.f, gk = 0.f;
#pragma unroll 8
    for (int d = 0; d < 64; ++d) { gq = fmaxf(gq, fabsf(a->in[I_QG][l * 64 + d])); gk = fmaxf(gk, fabsf(a->in[I_KG][l * 64 + d])); }
    const float nbnd = -(8.0f * 1.4426950408889634f) * gq * gk;
    const f32x4 nb4 = {nbnd, nbnd, nbnd, nbnd};
    const float sink = a->in[I_SINK][l * 8 + qh] * 1.4426950408889634f;
#pragma unroll
    for (int qt = 0; qt < 4; ++qt) { ls[qt] = (g == 0) ? __builtin_amdgcn_exp2f(sink + nbnd) : z0;
#pragma unroll
        for (int dt = 0; dt < 4; ++dt) o[qt][dt] = (f32x4){z0, z0, z0, z0}; }
    const int first = (!isctx && n == 0) ? 2 : 0, nwin = isctx ? 0 : ((n == 0 || n == 127) ? 4 : 6), nt = nwin + 4;
    const int lr = tid >> 3, lc = (tid & 7) * 8;
    v4u kreg, vreg;
#define ATT_LOADT(i) do { const bool ct_ = (i) >= nwin; const int kb_ = ct_ ? S_LAT + 64 * ((i) - nwin) : (n - 1) * 128 + 64 * (first + (i)); \
        kreg = *(const GAS v4u*)(PROJ + (size_t)(kb_ + lr) * INW + COL_AK + hk * 64 + lc); vreg = *(const GAS v4u*)(VTg + ((size_t)hk * 64 + lr) * R_ALL + kb_ + lc); } while (0)
    ATT_LOADT(0);
#pragma unroll 1
    for (int i = 0; i < nt; ++i) {
        __syncthreads();
        *(LAS v4u*)(Kt + lr * HST + lc) = kreg; *(LAS v4u*)(Vt + lr * HST + lc) = vreg;
        __syncthreads();
        if (i + 1 < nt) ATT_LOADT(i + 1);
        const bool win = i < nwin; const int kb = (n - 1) * 128 + 64 * (first + i);
        const int rel = kb - qpos0;
        const bool maskw = win && (rel == 128 || rel == -128);
        if (win && (rel >= 192 || rel <= -192)) continue;
        bf16x8v kf[4][2], vf[4][2];
#pragma unroll
        for (int kt = 0; kt < 4; ++kt)
#pragma unroll
            for (int ks = 0; ks < 2; ++ks) kf[kt][ks] = *(const LAS bf16x8v*)(Kt + (16 * kt + c) * HST + 32 * ks + 8 * g);
#pragma unroll
        for (int dt = 0; dt < 4; ++dt)
#pragma unroll
            for (int s2 = 0; s2 < 2; ++s2) { const v2u lo = *(const LAS v2u*)(Vt + (16 * dt + c) * HST + 32 * s2 + 4 * g), hi = *(const LAS v2u*)(Vt + (16 * dt + c) * HST + 32 * s2 + 16 + 4 * g);
                const v4u t = {lo.x, lo.y, hi.x, hi.y}; vf[dt][s2] = __builtin_bit_cast(bf16x8v, t); }
        f32x4 sA[4], sB[4];
#define ATT_SCORES(QT, S_) do { const bf16x8v q0_ = *(const LAS bf16x8v*)(Qw + (16 * (QT) + c) * HST + 8 * g), q1_ = *(const LAS bf16x8v*)(Qw + (16 * (QT) + c) * HST + 32 + 8 * g); \
            _Pragma("unroll") for (int kt = 0; kt < 4; ++kt) { S_[kt] = __builtin_amdgcn_mfma_f32_16x16x32_bf16(kf[kt][0], q0_, nb4, 0, 0, 0); S_[kt] = __builtin_amdgcn_mfma_f32_16x16x32_bf16(kf[kt][1], q1_, S_[kt], 0, 0, 0); } } while (0)
#define ATT_REST(QT, S_) do { \
            if (maskw) { const int dq = qpos0 + 16 * (QT) + c - kb - 4 * g; \
                _Pragma("unroll") for (int kt = 0; kt < 4; ++kt) _Pragma("unroll") for (int r = 0; r < 4; ++r) { const int dl = dq - 16 * kt - r; if (dl > 128 || dl < -128) S_[kt][r] = -INFINITY; } } \
            float ps = 0.f; \
            _Pragma("unroll") for (int kt = 0; kt < 4; ++kt) _Pragma("unroll") for (int r = 0; r < 4; ++r) { S_[kt][r] = __builtin_amdgcn_exp2f(S_[kt][r]); ps += S_[kt][r]; } \
            ls[QT] += ps; \
            bf16x8v pb[2]; \
            _Pragma("unroll") for (int s2 = 0; s2 < 2; ++s2) { const v4u t = {pk2(S_[2 * s2][0], S_[2 * s2][1]), pk2(S_[2 * s2][2], S_[2 * s2][3]), pk2(S_[2 * s2 + 1][0], S_[2 * s2 + 1][1]), pk2(S_[2 * s2 + 1][2], S_[2 * s2 + 1][3])}; pb[s2] = __builtin_bit_cast(bf16x8v, t); } \
            _Pragma("unroll") for (int dt = 0; dt < 4; ++dt) { o[QT][dt] = __builtin_amdgcn_mfma_f32_16x16x32_bf16(vf[dt][0], pb[0], o[QT][dt], 0, 0, 0); o[QT][dt] = __builtin_amdgcn_mfma_f32_16x16x32_bf16(vf[dt][1], pb[1], o[QT][dt], 0, 0, 0); } } while (0)
        ATT_SCORES(0, sA);
        ATT_SCORES(1, sB); ATT_REST(0, sA);
        ATT_SCORES(2, sA); ATT_REST(1, sB);
        ATT_SCORES(3, sB); ATT_REST(2, sA);
        ATT_REST(3, sB);
#undef ATT_SCORES
#undef ATT_REST
    }
#undef ATT_LOADT
    int c2 = lane & 15, g2 = lane >> 4; asm volatile("" : "+v"(c2), "+v"(g2));
#pragma unroll
    for (int qt = 0; qt < 4; ++qt) { float lt = ls[qt]; lt += sx<16>(lt); lt = sx32_add(lt); const float inv = 1.0f / lt;
        bf16* op = (bf16*)(a->ws + WS_MIX) + (size_t)(qbase + 16 * qt + c2) * DM + MIX_AT + qh * 64 + 4 * g2;
#pragma unroll
        for (int dt = 0; dt < 4; ++dt) { v2u w; w.x = pk2(o[qt][dt][0] * inv, o[qt][dt][1] * inv); w.y = pk2(o[qt][dt][2] * inv, o[qt][dt][3] * inv); *(GAS v2u*)(op + 16 * dt) = w; } }
}

constexpr int GST = 136;
__device__ __forceinline__ f32x4 mma16g(const LAS bf16* MA, const LAS bf16* MBt, int k0, f32x4 c, int lane) {
    const bf16x8v av = *(const LAS bf16x8v*)(MA + (lane & 15) * GST + k0 + 8 * (lane >> 4));
    const bf16x8v bv = *(const LAS bf16x8v*)(MBt + (lane & 15) * GST + k0 + 8 * (lane >> 4));
    return __builtin_amdgcn_mfma_f32_16x16x32_bf16(av, bv, c, 0, 0, 0);
}
__device__ __forceinline__ float gelu_as(float v) {
    const float av = fabsf(v), t = __builtin_amdgcn_rcpf(av * 0.2316418882f + 1.0f);
    float q = t * 0.5307027145f + (-0.7265760135f); q = q * t + 0.7107068705f; q = q * t + (-0.142248368f); q = q * t + 0.127414796f; q = q * t;
    const float e = __builtin_amdgcn_exp2f((v * v) * (-0.72134752044f)), mm = v * (q * e);
    return v < 0.f ? mm : v - mm;
}
__device__ __forceinline__ void gmlp_unit_mma(KA a, int l, int chunk, int g, LAS unsigned char* lds, int tid, int lane, int wave) {
    const bf16* PROJ = (const bf16*)(a->ws + WS_PROJ); bf16* MIX = (bf16*)(a->ws + WS_MIX);
    const int row0 = (chunk < 128) ? chunk * 128 : S_LAT + (chunk - 128) * 128;
    LAS bf16* WA = (LAS bf16*)lds;
    LAS bf16* VNT = WA + 128 * GST;
    LAS float* OUT = (LAS float*)(VNT + 64 * GST);
    const int pos = tid >> 2, part = tid & 3;
    {
      const float* W = a->in[I_GWS] + ((size_t)(l * 4 + g) * 128 + pos) * 128 + part * 32;
#pragma unroll
      for (int j = 0; j < 4; ++j) { const f32x4 w0 = *(const GAS f32x4*)(W + 8 * j), w1 = *(const GAS f32x4*)(W + 8 * j + 4);
          v4u o; o.x = pk2(w0.x, w0.y); o.y = pk2(w0.z, w0.w); o.z = pk2(w1.x, w1.y); o.w = pk2(w1.z, w1.w);
          *(LAS v4u*)(WA + pos * GST + part * 32 + 8 * j) = o; } }
    { const bf16* p = PROJ + (size_t)(row0 + pos) * INW + COL_GV + g * 64 + part * 16;
      float x[16]; unpack8(*(const GAS v4u*)p, x); unpack8(*(const GAS v4u*)(p + 8), x + 8);
      float ss = 0.f;
#pragma unroll
      for (int d = 0; d < 16; ++d) { x[d] = gelu_as(x[d]); ss += x[d] * x[d]; }
      ss += sx<1>(ss); ss += sx<2>(ss);
      const float rstd = __builtin_amdgcn_rsqf(ss * (1.0f / 64.0f) + EPS);
      const float* gn = a->in[I_GNG] + l * 256 + g * 64 + part * 16;
#pragma unroll
      for (int d = 0; d < 16; ++d) VNT[(part * 16 + d) * GST + pos] = (bf16)f2bf(x[d] * rstd * gn[d]); }
    __syncthreads();
    float z0 = 0.f; asm volatile("" : "+v"(z0));
#pragma unroll
    for (int cb = 0; cb < 4; ++cb) { f32x4 acc = {z0, z0, z0, z0};
#pragma unroll
        for (int ks = 0; ks < 4; ++ks) acc = mma16g(WA + 16 * wave * GST, VNT + 16 * cb * GST, 32 * ks, acc, lane);
#pragma unroll
        for (int r = 0; r < 4; ++r) OUT[(16 * wave + 4 * (lane >> 4) + r) * 68 + 16 * cb + (lane & 15)] = acc[r]; }
    __syncthreads();
    { const int row = row0 + pos; const float bsv = a->in[I_GBS][(l * 4 + g) * 128 + pos];
      const bf16* pu = PROJ + (size_t)row * INW + COL_GU + g * 64 + part * 16;
      float u[16]; unpack8(*(const GAS v4u*)pu, u); unpack8(*(const GAS v4u*)(pu + 8), u + 8);
      float y[16];
#pragma unroll
      for (int d = 0; d < 16; ++d) y[d] = gelu_as(u[d]) * (OUT[pos * 68 + part * 16 + d] + bsv);
      bf16* po = MIX + (size_t)row * DM + MIX_GM + g * 64 + part * 16;
      v4u w; w.x = pk2(y[0], y[1]); w.y = pk2(y[2], y[3]); w.z = pk2(y[4], y[5]); w.w = pk2(y[6], y[7]); *(GAS v4u*)po = w;
      w.x = pk2(y[8], y[9]); w.y = pk2(y[10], y[11]); w.z = pk2(y[12], y[13]); w.w = pk2(y[14], y[15]); *(GAS v4u*)(po + 8) = w; }
    __syncthreads();
}
__device__ __forceinline__ void attn_naive(KA a, int l, int nrows, int lane, int wave, int G, int bid) {
    const bf16* PROJ = (const bf16*)(a->ws + WS_PROJ); bf16* MIX = (bf16*)(a->ws + WS_MIX);
    const int gw = bid * NWAVES + wave, NGW = G * NWAVES;
    for (int pair = gw; pair < nrows * 2; pair += NGW) {
        const int row = pair >> 1, hk = pair & 1; const bool isctx = row >= S_LAT;
        float q[4], o[4], m[4], ls[4];
#pragma unroll
        for (int g = 0; g < 4; ++g) { q[g] = bflo((unsigned)PROJ[(size_t)row * INW + (hk * 4 + g) * 64 + lane]); o[g] = 0.f; ls[g] = 1.0f; m[g] = a->in[I_SINK][l * 8 + hk * 4 + g] * 1.4426950408889634f; }
        int j0 = 0, j1 = -1;
        if (!isctx) { j0 = row - 128 < 0 ? 0 : row - 128; j1 = row + 128 > S_LAT - 1 ? S_LAT - 1 : row + 128; }
        const int nwin = j1 - j0 + 1;
        const int nk = nwin + C_CTX;
#pragma unroll 4
        for (int t = 0; t < nk; ++t) {
            const int krow = (t < nwin) ? j0 + t : S_LAT + (t - nwin);
            const float k = bflo((unsigned)PROJ[(size_t)krow * INW + COL_AK + hk * 64 + lane]);
            const float v = bflo((unsigned)PROJ[(size_t)krow * INW + COL_AV + hk * 64 + lane]);
#pragma unroll
            for (int g = 0; g < 4; ++g) { const float s = wave_sum_dpp(q[g] * k); const float mn = fmaxf(m[g], s);
                const float c = __builtin_amdgcn_exp2f(m[g] - mn), p = __builtin_amdgcn_exp2f(s - mn);
                ls[g] = ls[g] * c + p; o[g] = o[g] * c + p * v; m[g] = mn; }
        }
#pragma unroll
        for (int g = 0; g < 4; ++g) MIX[(size_t)row * DM + MIX_AT + (hk * 4 + g) * 64 + lane] = (bf16)f2bf(o[g] / ls[g]);
    }
}
__device__ __forceinline__ void hgrn_combine(KA a, int l, int nrows, int lane, int wave, int G, int bid) {
    const bf16* PROJ = (const bf16*)(a->ws + WS_PROJ); bf16* MIX = (bf16*)(a->ws + WS_MIX);
    const float* O0 = (const float*)(a->ws + WS_HGO); const float* O1 = O0 + (size_t)R_ALL * 256;
    const f32x4 gn = *(const f32x4*)(a->in[I_HGAIN] + l * 64 + (lane & 15) * 4);
    const int gw = bid * NWAVES + wave, NGW = G * NWAVES;
    for (int r = gw; r < nrows; r += NGW) {
        const f32x4 o = *(const GAS f32x4*)(O0 + (size_t)r * 256 + 4 * lane) + *(const GAS f32x4*)(O1 + (size_t)r * 256 + 4 * lane);
        float ss = (o.x * o.x + o.y * o.y) + (o.z * o.z + o.w * o.w);
        ss += sx<1>(ss); ss += sx<2>(ss); ss += sx<4>(ss); ss += sx<8>(ss);
        const float rstd = __builtin_amdgcn_rsqf(ss * (1.0f / 64.0f) + EPS);
        const v2u gw2 = *(const GAS v2u*)(PROJ + (size_t)r * INW + COL_HG + 4 * lane);
        const float g0 = bflo(gw2.x), g1 = bfhi(gw2.x), g2 = bflo(gw2.y), g3 = bfhi(gw2.y);
        v2u w; w.x = pk2(o.x * rstd * gn.x * silu1(g0), o.y * rstd * gn.y * silu1(g1)); w.y = pk2(o.z * rstd * gn.z * silu1(g2), o.w * rstd * gn.w * silu1(g3));
        *(GAS v2u*)(MIX + (size_t)r * DM + MIX_HG + 4 * lane) = w;
    }
}
__device__ __forceinline__ void moe_gather(KA a, LAS unsigned char* lds, int tid, int lane, int wave, int G, int bid) {
    LAS int* sb = (LAS int*)lds;
    const unsigned* cnt = (const unsigned*)(a->ws + WS_CTL) + CW_MOECNT;
    int* mi = (int*)(a->ws + WS_VEC) + VO_MOE;
    if (tid < 8) sb[16 + tid] = (int)__hip_atomic_load(cnt + 64 * tid, RLX_AGENT);
    __syncthreads();
    if (tid == 0) { int b = 0;
#pragma unroll
        for (int e = 0; e < 8; ++e) { sb[e] = b; b += ((sb[16 + e] + 255) >> 8) << 8; }
        sb[8] = b; }
    __syncthreads();
    if (bid == 0) {
        if (tid == 0) mi[0] = sb[8] >> 8;
        if (tid < 8) mi[160 + tid] = sb[tid + 1] >> 8;
        for (int t = tid; t < (sb[8] >> 8); t += NTHR) { int e = 0;
#pragma unroll
            for (int j = 1; j < 8; ++j) e += (t >= (sb[j] >> 8)) ? 1 : 0;
            mi[16 + t] = e; } }
    unsigned char* AS = (unsigned char*)(a->ws + WS_AS);
    const int* tokinfo = (const int*)(a->ws + WS_TOK); int* tokslot = (int*)(a->ws + WS_TOK) + S_LAT * 8;
    const int gw = bid * NWAVES + wave, NGW = G * NWAVES;
    int kq = 0;
    for (int t = gw; t < S_LAT; t += NGW, ++kq) {
        const int* ti = tokinfo + (size_t)t * 8;
        const int e1 = ti[0], e2 = ti[1], r1 = ti[2], r2 = ti[3];
        const int s1 = sb[e1] + r1, s2 = sb[e2] + r2;
        const v4u x0 = ((const LAS v4u*)(lds + ROUTE_ROWS_OFF + wave * 8192 + kq * 1024))[lane];
        ((GAS v4u*)(AS + (size_t)s1 * DM))[lane] = x0; ((GAS v4u*)(AS + (size_t)s2 * DM))[lane] = x0;
        if (lane == 0) { int* ts = tokslot + (size_t)t * 4; ts[0] = s1; ts[1] = s2; ts[2] = ti[4]; ts[3] = ti[5]; }
    }
    { const f32x4 z4 = {0.f, 0.f, 0.f, 0.f}; for (int i = bid * NTHR + tid; i < 8 * 256 * DM / 4; i += G * NTHR) ((GAS f32x4*)(a->ws + WS_YF))[i] = z4; }
    for (int e = 0; e < 8; ++e) { const int c = sb[16 + e], pe = (c + 255) & ~255, b = sb[e];
        for (int j = c + gw; j < pe; j += NGW) { const v4u z = {0u, 0u, 0u, 0u}; ((GAS v4u*)(AS + (size_t)(b + j) * DM))[lane] = z; } }
}
__device__ __forceinline__ void moe_combine(KA a, int lane, int wave, int G, int bid) {
    const float* gf = (const float*)(a->ws + WS_VEC) + VO_MOD + (1 * 2 + 0) * 6144 + 5 * 1024;
    const bf16* Y = (const bf16*)(a->ws + WS_Y); const int* tokslot = (const int*)(a->ws + WS_TOK) + S_LAT * 8; const float* YF = (const float*)(a->ws + WS_YF);
    const int gw = bid * NWAVES + wave, NGW = G * NWAVES;
    f32x4 gl[4];
#pragma unroll
    for (int j = 0; j < 4; ++j) gl[j] = *(const f32x4*)(gf + 4 * lane + 256 * j);
    int n0 = 0, n1 = 0, n2 = 0, n3 = 0;
    if (gw < S_LAT) { const int* ts = tokslot + (size_t)gw * 4; n0 = ts[0]; n1 = ts[1]; n2 = ts[2]; n3 = ts[3]; }
    for (int t = gw; t < S_LAT; t += NGW) {
        const int s1 = n0, s2 = n1; const float w1 = __builtin_bit_cast(float, n2), w2 = __builtin_bit_cast(float, n3);
        if (t + NGW < S_LAT) { const int* ts = tokslot + (size_t)(t + NGW) * 4; n0 = ts[0]; n1 = ts[1]; n2 = ts[2]; n3 = ts[3]; }
        GAS f32x4* xr = (GAS f32x4*)(a->out + (size_t)t * DM) + lane; const GAS v2u* xbr = (const GAS v2u*)((const bf16*)(a->ws + WS_XB) + (size_t)t * DM) + lane;
        v2u xt[4]; f32x4 p[4], q[4];
#pragma unroll
        for (int j = 0; j < 4; ++j) xt[j] = xbr[64 * j];
        if (s1 < 32768) { const GAS v2u* yr = (const GAS v2u*)(Y + (size_t)s1 * DM) + lane; v2u u[4];
#pragma unroll
            for (int j = 0; j < 4; ++j) u[j] = yr[64 * j];
#pragma unroll
            for (int j = 0; j < 4; ++j) p[j] = (f32x4){bflo(u[j].x), bfhi(u[j].x), bflo(u[j].y), bfhi(u[j].y)}; }
        else { const GAS f32x4* yr = (const GAS f32x4*)(YF + (size_t)(s1 - 32768) * DM) + lane;
#pragma unroll
            for (int j = 0; j < 4; ++j) p[j] = yr[64 * j]; }
        if (s2 < 32768) { const GAS v2u* yr = (const GAS v2u*)(Y + (size_t)s2 * DM) + lane; v2u u[4];
#pragma unroll
            for (int j = 0; j < 4; ++j) u[j] = yr[64 * j];
#pragma unroll
            for (int j = 0; j < 4; ++j) q[j] = (f32x4){bflo(u[j].x), bfhi(u[j].x), bflo(u[j].y), bfhi(u[j].y)}; }
        else { const GAS f32x4* yr = (const GAS f32x4*)(YF + (size_t)(s2 - 32768) * DM) + lane;
#pragma unroll
            for (int j = 0; j < 4; ++j) q[j] = yr[64 * j]; }
#pragma unroll
        for (int j = 0; j < 4; ++j) { f32x4 x = (f32x4){bflo(xt[j].x), bfhi(xt[j].x), bflo(xt[j].y), bfhi(xt[j].y)};
            x = x + gl[j] * (p[j] * w1 + q[j] * w2);
            __builtin_nontemporal_store(x, (f32x4*)(xr + 64 * j)); }
    }
}

#define IN(k) (lo <= (k) && (k) < hi)
#define GRIDBAR() do { XcdBarrier b2_; b2_.bar = (unsigned*)(KARGS()->ws + WS_CTL) + CW_BAR; b2_.x = xb_xcc_id(); b2_.st = (volatile LAS unsigned*)(lds + MISC_OFF) + 8; xcd_barrier(b2_, wv0 * 64 + (int)__builtin_amdgcn_mbcnt_hi(~0u, __builtin_amdgcn_mbcnt_lo(~0u, 0u))); } while (0)
#define SEAM(k) do { if (IN(k) && IN((k) + 1)) GRIDBAR(); } while (0)
#define PHASE_ROOTS() KA a = KARGS(); unsigned char* ws = a->ws; const float* vec = (const float*)(ws + WS_VEC); (void)vec; int bid = blockIdx.x, G = gridDim.x; asm volatile("" : "+s"(bid), "+s"(G)); int tid = wv0 * 64 + (int)__builtin_amdgcn_mbcnt_hi(~0u, __builtin_amdgcn_mbcnt_lo(~0u, 0u)); asm volatile("" : "+v"(tid)); const int lane = tid & 63, wave = __builtin_amdgcn_readfirstlane(tid >> 6); (void)lane; (void)wave

template <int l> __device__ __forceinline__ void layer_body(const int lo, const int hi, LAS unsigned char* lds, const int wv0) {
        const int pb = 1 + 11 * l;
        if (IN(pb + 0)) { PHASE_ROOTS(); phase_norm(a, l, 0, R_ALL, (bf16*)(ws + WS_H), lane, wave, G, bid); SEAM(pb + 0); }
        if (IN(pb + 1)) {
            PHASE_ROOTS();
            pg8::Gemm g{(const pg8::bf16_t*)(ws + WS_H), (const pg8::bf16_t*)(ws + WS_WIN) + (size_t)l * INW * DM, R_ALL, INW, DM, 0, DM};
            pg8::StaticOrder S; S.init(R_ALL, INW, G, bid);
            pg8::EpiBf16<0> E{(pg8::bf16_t*)(ws + WS_PROJ), INW, nullptr, 0, 0, 1.f};
            pg8::gemm_phase<pg8::EpiBf16<0>, pg8::StaticOrder, true, true>(lds, g, S, E, tid);
            moe_conv_range(a, l == 0 ? MOE_SL0 : MOE_SL2, l == 0 ? MOE_SL1 : MOE_SL3, 650 - 2 * 256, lds, lane, wave, G, bid);
            SEAM(pb + 1);
        }
        if (IN(pb + 2)) {
            PHASE_ROOTS();
            qk_prep(a, l, (G - 1 - bid) * NTHR + tid, G * NTHR);
            for (int it = ((bid + G - 80) % G) * NWAVES + wave; it < 520; it += G * NWAVES) vt_item(a, it, lane);
            for (int it = bid; it < 1040; it += G) hgrn_stepA(a, l, it >> 2, it & 3, lds, lane, wave);
            { __syncthreads(); moe_conv_range(a, l == 0 ? MOE_SL3 : MOE_SL7, l == 0 ? MOE_SL4 : MOE_DEFER, 1040 - 4 * 256, lds, lane, wave, G, bid); }
            SEAM(pb + 2);
        }
        if (IN(pb + 3)) {
            PHASE_ROOTS();
            if (bid < 64) hgrn_stepB(a, bid, tid);
            {
                const int nu = (l == 0) ? 260 : 256, ng = (l == 0) ? 520 : 512;
                unsigned* qctr = (unsigned*)(ws + WS_CTL) + CW_QUEUE + 64 * l;
                volatile LAS unsigned* qslot = (volatile LAS unsigned*)(lds + MISC_OFF) + 16;
                for (;;) {
                    __syncthreads();
                    if (tid == 0) qslot[0] = __hip_atomic_fetch_add(qctr, 1u, RLX_AGENT);
                    __syncthreads();
                    const int it = __builtin_amdgcn_readfirstlane((int)qslot[0]);
                    if (it >= nu + ng) break;
                    if (it < nu) attn_unit(a, l, it, lds, tid, lane, wave);
                    else gmlp_unit_mma(a, l, (it - nu) >> 2, (it - nu) & 3, lds, tid, lane, wave);
                }
            }
            SEAM(pb + 3);
        }
        if (IN(pb + 4)) {
            PHASE_ROOTS();
            const int nit = (l == 0) ? 1040 : 1024;
            for (int it = bid; it < nit; it += G) hgrn_stepC(a, l, it >> 2, it & 3, lds, tid, lane, wave);
            if (l == 0) { __syncthreads(); moe_conv_range(a, MOE_SL4, MOE_SL5, 1040 - 4 * 256, lds, lane, wave, G, bid); }
            SEAM(pb + 4);
        }
        if (IN(pb + 5)) {
            PHASE_ROOTS();
            const float* modl = vec + VO_MOD + (l * 2 + 0) * 6144; const float* modc = vec + VO_MOD + (l * 2 + 1) * 6144;
            const int M = S_LAT;
            pg8::Gemm g{(const pg8::bf16_t*)(ws + WS_MIX), (const pg8::bf16_t*)(ws + WS_WOUT) + (size_t)l * DM * DM, M, DM, DM, 0, DM};
            pg8::StaticOrder S; S.init(M, DM, G, bid);
            if (l == 0) { pg8::EpiResidB<false> E{a->in[I_X], (pg8::bf16_t*)(ws + WS_XB), modl + 2048, DM};
                pg8::gemm_phase<pg8::EpiResidB<false>, pg8::StaticOrder, true, true>(lds, g, S, E, tid); }
            else { pg8::EpiResidB<true> E{ws + WS_XB, (pg8::bf16_t*)(ws + WS_XB), modl + 2048, DM};
                pg8::gemm_phase<pg8::EpiResidB<true>, pg8::StaticOrder, true, true>(lds, g, S, E, tid); }
            if (l == 0) {
                pg8::Gemm g2{(const pg8::bf16_t*)(ws + WS_MIX), (const pg8::bf16_t*)(ws + WS_WOUT), R_ALL, DM, 256, 0, DM};
                pg8::SplitKOrder S2{S_LAT / 256, 4, 4, 256, 16, bid, nullptr};
                pg8::EpiPart E2{(float*)(ws + WS_PART1), modc + 2048, S_LAT / 256, 256, DM};
                pg8::gemm_phase<pg8::EpiPart, pg8::SplitKOrder, false, true>(lds, g2, S2, E2, tid);
                moe_conv_range(a, MOE_SL5, MOE_SL6, 16, lds, lane, wave, G, bid);
            }
            SEAM(pb + 5);
        }
        if (l == 0) {
            if (IN(pb + 6)) { PHASE_ROOTS(); phase_norm(a, l, 1, R_ALL, (bf16*)(ws + WS_H), lane, wave, G, bid); SEAM(pb + 6); }
            if (IN(pb + 7)) {
                PHASE_ROOTS();
                pg8::Gemm g{(const pg8::bf16_t*)(ws + WS_H), (const pg8::bf16_t*)(ws + WS_WGU), R_ALL, 2 * FFN, DM, 0, DM};
                pg8::StaticOrder S; S.init(R_ALL, 2 * FFN, G, bid);
                pg8::EpiSwiGLU E{(pg8::bf16_t*)(ws + WS_HID), FFN, 1.0f};
                pg8::gemm_phase<pg8::EpiSwiGLU, pg8::StaticOrder, true, true>(lds, g, S, E, tid);
                moe_conv_range(a, MOE_SL1, MOE_SL2, 1430 - 5 * 256, lds, lane, wave, G, bid);
                SEAM(pb + 7);
            }
            if (IN(pb + 8)) {
                PHASE_ROOTS();
                const float* modl = vec + VO_MOD + (l * 2 + 0) * 6144; const float* modc = vec + VO_MOD + (l * 2 + 1) * 6144;
                pg8::Gemm g{(const pg8::bf16_t*)(ws + WS_HID), (const pg8::bf16_t*)(ws + WS_WD), S_LAT, DM, FFN, 0, FFN};
                pg8::StaticOrder S; S.init(S_LAT, DM, G, bid);
                pg8::EpiResidB<true> E{ws + WS_XB, (pg8::bf16_t*)(ws + WS_XB), modl + 5120, DM};
                pg8::gemm_phase<pg8::EpiResidB<true>, pg8::StaticOrder, true, true>(lds, g, S, E, tid);
                {
                    pg8::Gemm g2{(const pg8::bf16_t*)(ws + WS_HID), (const pg8::bf16_t*)(ws + WS_WD), R_ALL, DM, 256, 0, FFN};
                    pg8::SplitKOrder S2{S_LAT / 256, 4, 11, 256, 44, bid, nullptr};
                    pg8::EpiPart E2{(float*)(ws + WS_PART2), modc + 5120, S_LAT / 256, 256, DM};
                    pg8::gemm_phase<pg8::EpiPart, pg8::SplitKOrder, false, true>(lds, g2, S2, E2, tid);
                    moe_conv_range(a, MOE_SL6, MOE_SL7, 44, lds, lane, wave, G, bid);
                }
                if (IN(pb + 8) && IN(pb + 11)) GRIDBAR();
            }
        } else {
            if (IN(pb + 6)) { PHASE_ROOTS(); phase_norm_route(a, lds, tid, lane, wave, G, bid); SEAM(pb + 6); }
            if (IN(pb + 7)) { PHASE_ROOTS(); moe_gather(a, lds, tid, lane, wave, G, bid); SEAM(pb + 7); }
            if (IN(pb + 8)) {
                PHASE_ROOTS();
                const int* mi = (const int*)(ws + WS_VEC) + VO_MOE; const int nt = __builtin_amdgcn_readfirstlane(mi[0]);
                pg8::Gemm g{(const pg8::bf16_t*)(ws + WS_AS), (const pg8::bf16_t*)(ws + WS_MGU), nt * 256, 2 * EXD, DM / 2, (size_t)2 * EXD * DM, DM / 2};
                pg8::MoeOrder S; S.init(nt * 256, 2 * EXD, G, bid); S.load_bases(mi + 160);
                pg8::EpiSwiGLU8 E{(unsigned char*)(ws + WS_HIDM), EXD, 1.0f / (F8_WSCALE * F8_ASCALE), F8_HSCALE};
                pg8::gemm_phase<pg8::EpiSwiGLU8, pg8::MoeOrder, true, true, true>(lds, g, S, E, tid);
                SEAM(pb + 8);
            }
            if (IN(pb + 9)) {
                PHASE_ROOTS();
                const int* mi = (const int*)(ws + WS_VEC) + VO_MOE; const int nt = __builtin_amdgcn_readfirstlane(mi[0]); const int nm = nt < 128 ? nt : 128;
                pg8::Gemm g{(const pg8::bf16_t*)(ws + WS_HIDM), (const pg8::bf16_t*)(ws + WS_MD), nm * 256, DM, EXD / 2, (size_t)DM * EXD, EXD / 2};
                pg8::MoeOrder S; S.init(nm * 256, DM, G, bid); S.load_bases(mi + 160);
                pg8::EpiScaleBf16 E{(pg8::bf16_t*)(ws + WS_Y), DM, 1.0f / (F8_WSCALE * F8_HSCALE)};
                pg8::gemm_phase<pg8::EpiScaleBf16, pg8::MoeOrder, true, true, true>(lds, g, S, E, tid);
                if (nt > 128) {
                    pg8::Gemm g2{(const pg8::bf16_t*)(ws + WS_HIDM), (const pg8::bf16_t*)(ws + WS_MD), nt * 256, DM, 256, (size_t)DM * EXD, EXD / 2};
                    pg8::SplitKOrder S2{128, 4, 7, 256, (nt - 128) * 28, bid, mi + 16};
                    pg8::EpiAtomic E2{(float*)(ws + WS_YF), nullptr, 128, DM, 1.0f / (F8_WSCALE * F8_HSCALE)};
                    pg8::gemm_phase<pg8::EpiAtomic, pg8::SplitKOrder, false, true, true>(lds, g2, S2, E2, tid);
                }
                SEAM(pb + 9);
            }
            if (IN(pb + 10)) { PHASE_ROOTS(); moe_combine(a, lane, wave, G, bid); }
        }
    }
__global__ void __launch_bounds__(NTHR, 2) fwd_kernel(Args a_unused) {
    extern __shared__ __attribute__((aligned(16))) unsigned char lds_raw[];
    LAS unsigned char* lds = (LAS unsigned char*)lds_raw;
    const int tid0 = threadIdx.x;
    const int wv0 = __builtin_amdgcn_readfirstlane(tid0 >> 6);
    for (int u = tid0; u < (LDS_BYTES - LDSCTL_OFF) / 4; u += NTHR) ((LAS unsigned*)(lds + LDSCTL_OFF))[u] = 0u;
    __syncthreads();
    const int lo = KARGS()->ph_lo, hi = KARGS()->ph_hi;
    const bool fusedl = (hi - lo) > 1;
    if (fusedl) (void)xcd_barrier_post((unsigned*)(KARGS()->ws + WS_CTL) + CW_BAR, (volatile LAS unsigned*)(lds + MISC_OFF) + 8);
    if (IN(0)) { PHASE_ROOTS(); p0_prologue(a, lds, tid, lane, wave, G, bid); SEAM(0); }

    layer_body<0>(lo, hi, lds, wv0);
    layer_body<1>(lo, hi, lds, wv0);
}

extern "C" void kernel_launch(void* const* d_in, const int* in_sizes, int n_in, void* d_out, int out_size, void* d_ws, size_t ws_size, hipStream_t stream) {
    static int grid = 0;
    if (grid == 0) {
        if (n_in != 23 || in_sizes[0] != S_LAT * DM || out_size != S_LAT * DM || ws_size < WS_END) { fprintf(stderr, "kernel_launch: unexpected shapes / workspace (n_in %d, ws %zu, need %zu)\n", n_in, ws_size, (size_t)WS_END); grid = -1; return; }
        int dev = 0, cus = 0;
        if (hipGetDevice(&dev) != hipSuccess || hipDeviceGetAttribute(&cus, hipDeviceAttributeMultiprocessorCount, dev) != hipSuccess) { grid = -1; return; }
        if (hipFuncSetAttribute((const void*)fwd_kernel, hipFuncAttributeMaxDynamicSharedMemorySize, LDS_BYTES) != hipSuccess) { grid = -1; return; }
        int per_cu = 0;
        (void)hipOccupancyMaxActiveBlocksPerMultiprocessor(&per_cu, (const void*)fwd_kernel, NTHR, LDS_BYTES);
        (void)hipGetLastError();
        if (cus * NWAVES * 8 < S_LAT) { fprintf(stderr, "kernel_launch: needs at least %d compute units\n", S_LAT / (NWAVES * 8)); grid = -1; return; }
        grid = cus;
    }
    if (grid < 0) return;
    if (hipMemsetAsync((char*)d_ws + WS_CTL, 0, CTL_ZERO_BYTES, stream) != hipSuccess) return;
    Args a{};
    for (int i = 0; i < 23; ++i) a.in[i] = (const float*)d_in[i];
    a.out = (float*)d_out; a.ws = (unsigned char*)d_ws;
#if ONE_LAUNCH
    a.ph_lo = 0; a.ph_hi = NPH;
    hipLaunchKernelGGL(fwd_kernel, dim3(grid), dim3(NTHR), LDS_BYTES, stream, a);
#else
    for (int p = 0; p < NPH; ++p) {
        if (p == 10 || p == 11) continue;
        a.ph_lo = p; a.ph_hi = p + 1;
        hipLaunchKernelGGL(fwd_kernel, dim3(grid), dim3(NTHR), LDS_BYTES, stream, a);
    }
#endif
}
```

```cpp
#include <hip/hip_runtime.h>
#include <cstdio>
#include <cstdint>
#include <cmath>
#ifndef ONE_LAUNCH
#define ONE_LAUNCH 1
#endif
namespace pg8 {
#define PG8_LAS __attribute__((address_space(3)))
typedef unsigned short bf16_t;
typedef short bf16x8 __attribute__((ext_vector_type(8)));
typedef float f32x4 __attribute__((ext_vector_type(4)));
typedef unsigned u32x4 __attribute__((ext_vector_type(4)));
constexpr int BM = 256, BK = 64, HALF = 128, HTB = HALF * BK * 2  , STAGE_BYTES = 8 * HTB, NXCD = 8, WGM = 8;

__host__ __device__ __forceinline__ int lds_byte(int r, int c) { const int st = (r >> 4) * 2 + (c >> 5), rr = r & 15, cc = c & 31, ob = rr * 64 + cc * 2; return st * 1024 + (ob ^ (((ob >> 9) & 1) << 5)); }
__host__ __device__ __forceinline__ void stage_rc(int b, int& R, int& C) { const int st = b / 1024, sb = b % 1024, swz = sb ^ (((sb >> 9) & 1) << 5); R = (st >> 1) * 16 + swz / 64; C = (st & 1) * 32 + (swz % 64) / 2; }
__host__ __device__ __forceinline__ int perm32(int rho) { const int n = rho >> 4, i = rho & 15; return 8 * (i >> 2) + 4 * n + (i & 3); }

struct Unit { int pm, pn, eb, ko; };
struct Gemm { const bf16_t* A; const bf16_t* Bt; int M, N, K; size_t bstride; int ld; };

struct StaticOrder {
    int nM, nN, nwg, G, c;
    __host__ __device__ void init(int M, int N, int G_, int c_) { nM = M / BM; nN = N / BM; nwg = nM * nN; G = G_; c = c_; }
    __host__ __device__ bool next(int i, Unit& u) const {
        const long L = (long)i * G + c; if (L >= nwg) return false;
        int wgid = (int)L; { const int q = nwg / NXCD, r = nwg % NXCD, xcd = wgid % NXCD, off = wgid / NXCD; wgid = (xcd < r ? xcd * (q + 1) : r * (q + 1) + (xcd - r) * q) + off; }
        const int nig = WGM * nN, gid = wgid / nig, fm = gid * WGM, gsz = (nM - fm) < WGM ? (nM - fm) : WGM;
        u.pm = fm + ((wgid % nig) % gsz); u.pn = (wgid % nig) / gsz; u.eb = 0; u.ko = 0; return true;
    }
    __device__ __forceinline__ void a_ready(const Unit&) const {}
    __device__ __forceinline__ void done(const Unit&) const {}
};

__device__ __forceinline__ unsigned cvt_pk_bf16(float lo, float hi) { unsigned r; asm volatile("v_cvt_pk_bf16_f32 %0, %1, %2" : "=v"(r) : "v"(lo), "v"(hi)); return r; }
typedef float f32x2 __attribute__((ext_vector_type(2)));
__device__ __forceinline__ f32x2 gelu_pk(f32x2 v) {
    const f32x2 av = __builtin_elementwise_abs(v), d = av * 0.2316418882f + 1.0f;
    f32x2 t; t.x = __builtin_amdgcn_rcpf(d.x); t.y = __builtin_amdgcn_rcpf(d.y);
    f32x2 q = t * 0.5307027145f + (-0.7265760135f); q = q * t + 0.7107068705f; q = q * t + (-0.142248368f); q = q * t + 0.127414796f; q = q * t;
    const f32x2 s = (v * v) * (-0.72134752044f);
    f32x2 e; e.x = __builtin_amdgcn_exp2f(s.x); e.y = __builtin_amdgcn_exp2f(s.y);
    const f32x2 m = v * (q * e), r = v - m;
    f32x2 o; o.x = v.x < 0.f ? m.x : r.x; o.y = v.y < 0.f ? m.y : r.y; return o;
}

template <int ACT  > struct EpiBf16 {
    static constexpr bool PERM = true, AFTER_DRAIN = false; static_assert(ACT == 0 || ACT == 1, "EpiBf16: ACT is 0 (none) or 1 (gelu_pk)");
    bf16_t* O; int ldc; const float* bias; int split_cols; size_t split_stride; float scale0;
    __device__ __forceinline__ void operator()(const f32x4 (&acc)[2][2][4][2], const Unit& u, int wr, int wc, int fr, int fq) const {
        const int row0 = u.pm * BM + wr * 64 + fr; int colt = u.pn * BM; bf16_t* base = O;
        float sc = 1.f; if (split_cols) { const int t = colt / split_cols; base += (size_t)t * split_stride; colt -= t * split_cols; if (t == 0) sc = scale0; }
        const int col0 = colt + wc * 32 + 8 * fq, bcol0 = u.pn * BM + wc * 32 + 8 * fq;
        f32x4 bv[2][2];
#pragma unroll
        for (int bj = 0; bj < 2; ++bj)
#pragma unroll
            for (int n = 0; n < 2; ++n) bv[bj][n] = bias ? *(const f32x4*)(bias + bcol0 + bj * HALF + 4 * n) : (f32x4){0.f, 0.f, 0.f, 0.f};
#pragma unroll
        for (int ai = 0; ai < 2; ++ai)
#pragma unroll
            for (int m = 0; m < 4; ++m) { bf16_t* rowp = base + (size_t)(row0 + ai * HALF + m * 16) * ldc + col0;
#pragma unroll
                for (int bj = 0; bj < 2; ++bj) { f32x4 v0 = acc[ai][bj][m][0] + bv[bj][0], v1 = acc[ai][bj][m][1] + bv[bj][1];
                    if (ACT == 1) { f32x2 a = gelu_pk((f32x2){v0[0], v0[1]}), b = gelu_pk((f32x2){v0[2], v0[3]}), c = gelu_pk((f32x2){v1[0], v1[1]}), d = gelu_pk((f32x2){v1[2], v1[3]});
                        v0 = (f32x4){a.x, a.y, b.x, b.y}; v1 = (f32x4){c.x, c.y, d.x, d.y}; }
                    v0 = v0 * sc; v1 = v1 * sc; u32x4 w; w.x = cvt_pk_bf16(v0[0], v0[1]); w.y = cvt_pk_bf16(v0[2], v0[3]); w.z = cvt_pk_bf16(v1[0], v1[1]); w.w = cvt_pk_bf16(v1[2], v1[3]);
                    *(u32x4*)(rowp + bj * HALF) = w; } }
    }
};

__device__ __forceinline__ float silu_f(float x) { return x * __builtin_amdgcn_rcpf(1.0f + __builtin_amdgcn_exp2f(-1.4426950408889634f * x)); }
struct EpiResid {
    static constexpr bool PERM = false, AFTER_DRAIN = false;
    const float* base; float* out; const float* gate; const float* cbase; float* cout; const float* cgate; int mlat; int ldc;
    __device__ __forceinline__ void operator()(const f32x4 (&acc)[2][2][4][2], const Unit& u, int wr, int wc, int fr, int fq) const {
        const bool isc = u.pm >= mlat;
        const float* b = isc ? cbase : base; float* o = isc ? cout : out; const float* g = isc ? cgate : gate;
        const int row0 = (isc ? (u.pm - mlat) : u.pm) * BM + wr * 64 + fr, col0 = u.pn * BM + wc * 32 + 4 * fq;
        f32x4 gv[2][2];
#pragma unroll
        for (int bj = 0; bj < 2; ++bj)
#pragma unroll
            for (int n = 0; n < 2; ++n) gv[bj][n] = *(const f32x4*)(g + col0 + bj * HALF + n * 16);
#pragma unroll
        for (int ai = 0; ai < 2; ++ai)
#pragma unroll
            for (int m = 0; m < 4; ++m) { const size_t off = (size_t)(row0 + ai * HALF + m * 16) * ldc + col0;
#pragma unroll
                for (int bj = 0; bj < 2; ++bj)
#pragma unroll
                    for (int n = 0; n < 2; ++n) { const f32x4 bs = *(const f32x4*)(b + off + bj * HALF + n * 16); *(f32x4*)(o + off + bj * HALF + n * 16) = bs + gv[bj][n] * acc[ai][bj][m][n]; }
                if (m & 1) asm volatile("" ::: "memory"); }
    }
};
template <bool BFB> struct EpiResidB {
    static constexpr bool PERM = true, AFTER_DRAIN = false;
    const void* base; bf16_t* out; const float* gate; int ldc;
    __device__ __forceinline__ void operator()(const f32x4 (&acc)[2][2][4][2], const Unit& u, int wr, int wc, int fr, int fq) const {
        const int row0 = u.pm * BM + wr * 64 + fr, col0 = u.pn * BM + wc * 32 + 8 * fq;
        f32x4 gv[2][2];
#pragma unroll
        for (int bj = 0; bj < 2; ++bj)
#pragma unroll
            for (int n = 0; n < 2; ++n) gv[bj][n] = *(const f32x4*)(gate + col0 + bj * HALF + 4 * n);
#pragma unroll
        for (int ai = 0; ai < 2; ++ai)
#pragma unroll
            for (int m = 0; m < 4; ++m) { const size_t off = (size_t)(row0 + ai * HALF + m * 16) * ldc + col0;
#pragma unroll
                for (int bj = 0; bj < 2; ++bj) { f32x4 b0, b1;
                    if constexpr (BFB) { const u32x4 t = *(const u32x4*)((const bf16_t*)base + off + bj * HALF);
                        b0 = (f32x4){__builtin_bit_cast(float, t.x << 16), __builtin_bit_cast(float, t.x & 0xffff0000u), __builtin_bit_cast(float, t.y << 16), __builtin_bit_cast(float, t.y & 0xffff0000u)};
                        b1 = (f32x4){__builtin_bit_cast(float, t.z << 16), __builtin_bit_cast(float, t.z & 0xffff0000u), __builtin_bit_cast(float, t.w << 16), __builtin_bit_cast(float, t.w & 0xffff0000u)}; }
                    else { b0 = *(const f32x4*)((const float*)base + off + bj * HALF); b1 = *(const f32x4*)((const float*)base + off + bj * HALF + 4); }
                    const f32x4 v0 = b0 + gv[bj][0] * acc[ai][bj][m][0], v1 = b1 + gv[bj][1] * acc[ai][bj][m][1];
                    u32x4 w; w.x = cvt_pk_bf16(v0[0], v0[1]); w.y = cvt_pk_bf16(v0[2], v0[3]); w.z = cvt_pk_bf16(v1[0], v1[1]); w.w = cvt_pk_bf16(v1[2], v1[3]);
                    *(u32x4*)(out + off + bj * HALF) = w; }
                if (m & 1) asm volatile("" ::: "memory"); }
    }
};
struct EpiSwiGLU {
    static constexpr bool PERM = true, AFTER_DRAIN = false;
    bf16_t* O; int ldc; float ds;
    __device__ __forceinline__ void operator()(const f32x4 (&acc)[2][2][4][2], const Unit& u, int wr, int wc, int fr, int fq) const {
        const int row0 = u.pm * BM + wr * 64 + fr, col0 = u.pn * HALF + wc * 32 + 8 * fq;
#pragma unroll
        for (int ai = 0; ai < 2; ++ai)
#pragma unroll
            for (int m = 0; m < 4; ++m) { bf16_t* rowp = O + (size_t)(row0 + ai * HALF + m * 16) * ldc + col0;
                const f32x4 g0 = acc[ai][0][m][0] * ds, g1 = acc[ai][0][m][1] * ds, u0 = acc[ai][1][m][0] * ds, u1 = acc[ai][1][m][1] * ds;
                f32x4 h0, h1;
#pragma unroll
                for (int j = 0; j < 4; ++j) { h0[j] = silu_f(g0[j]) * u0[j]; h1[j] = silu_f(g1[j]) * u1[j]; }
                u32x4 w; w.x = cvt_pk_bf16(h0[0], h0[1]); w.y = cvt_pk_bf16(h0[2], h0[3]); w.z = cvt_pk_bf16(h1[0], h1[1]); w.w = cvt_pk_bf16(h1[2], h1[3]);
                *(u32x4*)rowp = w; }
    }
};
struct MoeOrder : StaticOrder {
    int tb[8];
    __device__ __forceinline__ void load_bases(const int* mi) {
#pragma unroll
        for (int e = 0; e < 8; ++e) tb[e] = __builtin_amdgcn_readfirstlane(mi[e]); }
    __device__ __forceinline__ int expert_of(int pm) const { int e = 0;
#pragma unroll
        for (int j = 0; j < 7; ++j) e += (pm >= tb[j]) ? 1 : 0;
        return e; }
    __device__ __forceinline__ bool next(int i, Unit& u) const { if (!StaticOrder::next(i, u)) return false; u.eb = expert_of(u.pm); return true; }
};

struct SplitKOrder {
    int pm0, nN, P, kp, total, c; const int* tile_e;
    __device__ __forceinline__ bool next(int i, Unit& u) const {
        if (i != 0 || c >= total) return false;
        const int p = c % P, t = c / P; u.pn = t % nN; u.pm = pm0 + t / nN; u.ko = p * kp; u.eb = tile_e ? __builtin_amdgcn_readfirstlane(tile_e[u.pm]) : 0; return true; }
    __device__ __forceinline__ void a_ready(const Unit&) const {}
    __device__ __forceinline__ void done(const Unit&) const {}
};
struct EpiPart {
    static constexpr bool PERM = false, AFTER_DRAIN = false;
    float* part; const float* scale; int pm_sub; int kp; int ldc;
    __device__ __forceinline__ void operator()(const f32x4 (&acc)[2][2][4][2], const Unit& u, int wr, int wc, int fr, int fq) const {
        float* o = part + (size_t)(u.ko / kp) * BM * ldc;
        const int row0 = (u.pm - pm_sub) * BM + wr * 64 + fr, col0 = u.pn * BM + wc * 32 + 4 * fq;
        f32x4 gv[2][2];
#pragma unroll
        for (int bj = 0; bj < 2; ++bj)
#pragma unroll
            for (int n = 0; n < 2; ++n) gv[bj][n] = *(const f32x4*)(scale + col0 + bj * HALF + n * 16);
#pragma unroll
        for (int ai = 0; ai < 2; ++ai)
#pragma unroll
            for (int m = 0; m < 4; ++m) { const size_t off = (size_t)(row0 + ai * HALF + m * 16) * ldc + col0;
#pragma unroll
                for (int bj = 0; bj < 2; ++bj)
#pragma unroll
                    for (int n = 0; n < 2; ++n) *(f32x4*)(o + off + bj * HALF + n * 16) = gv[bj][n] * acc[ai][bj][m][n]; }
    }
};
struct EpiAtomic {
    static constexpr bool PERM = false, AFTER_DRAIN = true;
    float* out; const float* scale; int pm_sub; int ldc; float ds;
    __device__ __forceinline__ void fused(f32x4 (&acc)[2][2][4][2], const Unit& u, int wr, int wc, int fr, int fq, PG8_LAS unsigned char* lds, int wid, int lane) const {
        PG8_LAS float* scr = (PG8_LAS float*)(lds + wid * 16384);
        const int rr = lane >> 5, cc = lane & 31;
#pragma unroll
        for (int ai = 0; ai < 2; ++ai)
#pragma unroll
            for (int bj = 0; bj < 2; ++bj) {
#pragma unroll
                for (int m = 0; m < 4; ++m)
#pragma unroll
                    for (int n = 0; n < 2; ++n) *(PG8_LAS f32x4*)(scr + (m * 16 + fr) * 36 + n * 16 + 4 * fq) = acc[ai][bj][m][n];
                asm volatile("s_waitcnt lgkmcnt(0)" ::: "memory");
                const int colg = u.pn * BM + bj * HALF + wc * 32 + cc; const float sc = (scale ? scale[colg] : 1.0f) * ds;
                float* op = out + (size_t)((u.pm - pm_sub) * BM + ai * HALF + wr * 64 + rr) * ldc + colg;
#pragma unroll 8
                for (int i = 0; i < 32; ++i) { const float v = scr[(2 * i + rr) * 36 + cc]; __hip_atomic_fetch_add(op + (size_t)(2 * i) * ldc, v * sc, __ATOMIC_RELAXED, __HIP_MEMORY_SCOPE_AGENT); }
                asm volatile("s_waitcnt lgkmcnt(0)" ::: "memory");
            }
    }
};

typedef int i32x4v __attribute__((ext_vector_type(4))); typedef int i32x8v __attribute__((ext_vector_type(8)));
struct FragB { bf16x8 k[2]; };
struct Frag8 { i32x8v v; };
template <bool F8> struct FragSel { typedef FragB type; };
template <> struct FragSel<true> { typedef Frag8 type; };
__device__ __forceinline__ void ld_frag(FragB& f, const PG8_LAS unsigned char* p) { f.k[0] = *(const PG8_LAS bf16x8*)p; f.k[1] = *(const PG8_LAS bf16x8*)(p + 1024); }
__device__ __forceinline__ void ld_frag(Frag8& f, const PG8_LAS unsigned char* p) { const i32x4v lo = *(const PG8_LAS i32x4v*)p, hi = *(const PG8_LAS i32x4v*)(p + 1024); f.v = __builtin_shufflevector(lo, hi, 0, 1, 2, 3, 4, 5, 6, 7); }
__device__ __forceinline__ f32x4 mma_frag(const FragB& b, const FragB& a, f32x4 c) { c = __builtin_amdgcn_mfma_f32_16x16x32_bf16(b.k[0], a.k[0], c, 0, 0, 0); return __builtin_amdgcn_mfma_f32_16x16x32_bf16(b.k[1], a.k[1], c, 0, 0, 0); }
__device__ __forceinline__ f32x4 mma_frag(const Frag8& b, const Frag8& a, f32x4 c) {
    asm volatile("v_mfma_scale_f32_16x16x128_f8f6f4 %0, %1, %2, %0, %3, %3 op_sel_hi:[0,0,0]" : "+v"(c) : "v"(b.v), "v"(a.v), "v"(0x7f7f7f7f));
    return c;
}

struct EpiSwiGLU8 {
    static constexpr bool PERM = true, AFTER_DRAIN = false;
    unsigned char* O; int ldc; float ds, hs;
    __device__ __forceinline__ void operator()(const f32x4 (&acc)[2][2][4][2], const Unit& u, int wr, int wc, int fr, int fq) const {
        const int row0 = u.pm * BM + wr * 64 + fr, col0 = u.pn * HALF + wc * 32 + 8 * fq;
        const float k1 = -1.4426950408889634f * ds, k2 = ds * ds * hs;
#pragma unroll
        for (int ai = 0; ai < 2; ++ai)
#pragma unroll
            for (int m = 0; m < 4; ++m) { unsigned char* rowp = O + (size_t)(row0 + ai * HALF + m * 16) * ldc + col0;
                const f32x4 g0 = acc[ai][0][m][0], g1 = acc[ai][0][m][1], u0 = acc[ai][1][m][0], u1 = acc[ai][1][m][1];
                float h[8];
#pragma unroll
                for (int j = 0; j < 4; ++j) {
                    h[j] = __builtin_amdgcn_fmed3f((g0[j] * u0[j]) * k2 * __builtin_amdgcn_rcpf(1.0f + __builtin_amdgcn_exp2f(g0[j] * k1)), -448.0f, 448.0f);
                    h[4 + j] = __builtin_amdgcn_fmed3f((g1[j] * u1[j]) * k2 * __builtin_amdgcn_rcpf(1.0f + __builtin_amdgcn_exp2f(g1[j] * k1)), -448.0f, 448.0f); }
                unsigned lo = 0u, hi = 0u;
                lo = __builtin_amdgcn_cvt_pk_fp8_f32(h[0], h[1], lo, false); lo = __builtin_amdgcn_cvt_pk_fp8_f32(h[2], h[3], lo, true);
                hi = __builtin_amdgcn_cvt_pk_fp8_f32(h[4], h[5], hi, false); hi = __builtin_amdgcn_cvt_pk_fp8_f32(h[6], h[7], hi, true);
                typedef unsigned u32x2 __attribute__((ext_vector_type(2)));
                *(u32x2*)rowp = (u32x2){lo, hi}; }
    }
};
struct EpiScaleBf16 {
    static constexpr bool PERM = true, AFTER_DRAIN = false;
    bf16_t* O; int ldc; float ds;
    __device__ __forceinline__ void operator()(const f32x4 (&acc)[2][2][4][2], const Unit& u, int wr, int wc, int fr, int fq) const {
        const int row0 = u.pm * BM + wr * 64 + fr, col0 = u.pn * BM + wc * 32 + 8 * fq;
#pragma unroll
        for (int ai = 0; ai < 2; ++ai)
#pragma unroll
            for (int m = 0; m < 4; ++m) { bf16_t* rowp = O + (size_t)(row0 + ai * HALF + m * 16) * ldc + col0;
#pragma unroll
                for (int bj = 0; bj < 2; ++bj) { const f32x4 v0 = acc[ai][bj][m][0] * ds, v1 = acc[ai][bj][m][1] * ds;
                    u32x4 w; w.x = cvt_pk_bf16(v0[0], v0[1]); w.y = cvt_pk_bf16(v0[2], v0[3]); w.z = cvt_pk_bf16(v1[0], v1[1]); w.w = cvt_pk_bf16(v1[2], v1[3]);
                    *(u32x4*)(rowp + bj * HALF) = w; } }
    }
};

template <class Epi, class Sched, bool ALIGN_EPI = false, bool SP2 = false, bool F8 = false>
__device__ __forceinline__ void gemm_phase(PG8_LAS unsigned char* lds, const Gemm g, const Sched& S, const Epi& E, int tid_in) {
    int tid_ = tid_in; asm volatile("" : "+v"(tid_));
    const int tid = tid_, wid = __builtin_amdgcn_readfirstlane(tid >> 6), lane = tid & 63, wr = wid >> 2, wc = wid & 3, fr = lane & 15, fq = lane >> 4;
    const int K = g.K, nt = K / BK, ld = g.ld;
    unsigned voffA[2], voffB[2];
#pragma unroll
    for (int i = 0; i < 2; ++i) { int R, C; stage_rc(tid * 16 + i * 8192, R, C); const int Rb = Epi::PERM ? ((R & ~31) + perm32(R & 31)) : R;
        voffA[i] = (unsigned)(R * ld + C) * 2u; voffB[i] = (unsigned)(Rb * ld + C) * 2u; }
    const size_t kstep = (size_t)(BK * 2);
    const size_t hstep = (size_t)HALF * ld * 2;
    const size_t tstep = 2 * hstep;
    const unsigned ldsw = (unsigned)wid * 1024u;
    const int aoff = lds_byte(wr * 64 + fr, fq * 8), boff = lds_byte(wc * 32 + fr, fq * 8);
#define PG8_SA(b, h) (((b) * 2 + (h)) * HTB)
#define PG8_SB(b, h) ((4 + (b) * 2 + (h)) * HTB)
#define PG8_STAGE(bufoff, gbase, voff) do { _Pragma("unroll") for (int _i = 0; _i < 2; ++_i) \
        __builtin_amdgcn_global_load_lds((const unsigned*)((const char*)(gbase) + (voff)[_i]), (PG8_LAS unsigned*)(lds + (bufoff) + ldsw + _i * 8192), 16, 0, 0); } while (0)
#define PG8_LDA(dst, b, h) do { _Pragma("unroll") for (int m = 0; m < 4; ++m) ld_frag(dst[m], lds + PG8_SA(b, h) + aoff + m * 2048); } while (0)
#define PG8_LDB(dst, b, h) do { _Pragma("unroll") for (int n = 0; n < 2; ++n) ld_frag(dst[n], lds + PG8_SB(b, h) + boff + n * 2048); } while (0)
#define PG8_MMA(ai, bj, At, Bt) do { __builtin_amdgcn_s_setprio(1); _Pragma("unroll") for (int m = 0; m < 4; ++m) _Pragma("unroll") for (int n = 0; n < 2; ++n) \
        acc[ai][bj][m][n] = mma_frag(Bt[n], At[m], acc[ai][bj][m][n]); __builtin_amdgcn_s_setprio(0); } while (0)
#define PG8_WAIT_V(n) asm volatile("s_waitcnt vmcnt(" #n ")" ::: "memory")
#define PG8_WAIT_L(n) asm volatile("s_waitcnt lgkmcnt(" #n ")" ::: "memory")
#define PG8_BAR __builtin_amdgcn_s_barrier()
#define PG8_SCHED __builtin_amdgcn_sched_barrier(0)
    Unit cur, nxt; int ui = 0;
    if (!S.next(0, cur)) return;
    float zacc = 0.f; asm volatile("" : "+v"(zacc));
    f32x4 acc[2][2][4][2];
#pragma unroll
    for (int a = 0; a < 2; ++a)
#pragma unroll
        for (int b = 0; b < 2; ++b)
#pragma unroll
            for (int m = 0; m < 4; ++m)
#pragma unroll
                for (int n = 0; n < 2; ++n) acc[a][b][m][n] = (f32x4){zacc, zacc, zacc, zacc};
    typedef typename FragSel<F8>::type Frag;
    Frag At[4], B0[2], B1[2];
    const char* cA = (const char*)g.A + (size_t)cur.pm * tstep + (size_t)cur.ko * 2; const char* cB = (const char*)g.Bt + (size_t)cur.eb * g.bstride + (size_t)cur.pn * tstep + (size_t)cur.ko * 2;
    S.a_ready(cur);
    if constexpr (SP2) {
        PG8_STAGE(PG8_SB(0, 0), cB, voffB); PG8_STAGE(PG8_SB(0, 1), cB + hstep, voffB); PG8_STAGE(PG8_SA(0, 0), cA, voffA); PG8_STAGE(PG8_SA(0, 1), cA + hstep, voffA);
        if (wr == 1) PG8_BAR;
        PG8_WAIT_V(2); PG8_BAR;
        PG8_STAGE(PG8_SB(1, 0), cB + kstep, voffB); PG8_STAGE(PG8_SA(1, 0), cA + kstep, voffA); PG8_STAGE(PG8_SB(1, 1), cB + hstep + kstep, voffB);
        PG8_WAIT_V(6); PG8_BAR;
    } else {
        PG8_STAGE(PG8_SB(0, 0), cB, voffB); PG8_STAGE(PG8_SA(0, 0), cA, voffA); PG8_STAGE(PG8_SB(0, 1), cB + hstep, voffB); PG8_STAGE(PG8_SA(0, 1), cA + hstep, voffA);
        if (wr == 1) PG8_BAR;
        PG8_WAIT_V(4); PG8_BAR;
        PG8_STAGE(PG8_SB(1, 0), cB + kstep, voffB); PG8_STAGE(PG8_SA(1, 0), cA + kstep, voffA); PG8_STAGE(PG8_SB(1, 1), cB + hstep + kstep, voffB);
        PG8_WAIT_V(6); PG8_BAR;
    }
    for (;;) {
        const bool has_next = S.next(ui + 1, nxt);
        const char* nA = has_next ? (const char*)g.A + (size_t)nxt.pm * tstep + (size_t)nxt.ko * 2 : cA; const char* nB = has_next ? (const char*)g.Bt + (size_t)nxt.eb * g.bstride + (size_t)nxt.pn * tstep + (size_t)nxt.ko * 2 : cB;
        for (int t = 0; t < nt; t += 2) {
            const bool last = (t == nt - 2);
            const char* a1 = cA + (size_t)(t + 1) * kstep;
            const char* a2 = last ? nA : cA + (size_t)(t + 2) * kstep; const char* b2 = last ? nB : cB + (size_t)(t + 2) * kstep;
            const char* a3 = a2 + kstep; const char* b3 = b2 + kstep;
            if (last && has_next) S.a_ready(nxt);
            if constexpr (SP2) {
            PG8_LDB(B0, 0, 0); PG8_LDB(B1, 0, 1); PG8_SCHED; PG8_LDA(At, 0, 0); PG8_STAGE(PG8_SA(1, 1), a1 + hstep, voffA);
            PG8_WAIT_V(8); PG8_WAIT_L(0); PG8_BAR; PG8_MMA(0, 0, At, B0); PG8_MMA(0, 1, At, B1); PG8_BAR; PG8_SCHED;
            PG8_LDA(At, 0, 1); PG8_STAGE(PG8_SB(0, 0), b2, voffB); PG8_STAGE(PG8_SB(0, 1), b2 + hstep, voffB); PG8_STAGE(PG8_SA(0, 0), a2, voffA);
            PG8_WAIT_V(8); PG8_WAIT_L(0); PG8_BAR; PG8_MMA(1, 0, At, B0); PG8_MMA(1, 1, At, B1); PG8_BAR; PG8_SCHED;
            PG8_LDB(B0, 1, 0); PG8_LDB(B1, 1, 1); PG8_SCHED; PG8_LDA(At, 1, 0); PG8_STAGE(PG8_SA(0, 1), a2 + hstep, voffA);
            PG8_WAIT_V(8); PG8_WAIT_L(0); PG8_BAR; PG8_MMA(0, 0, At, B0); PG8_MMA(0, 1, At, B1); PG8_BAR; PG8_SCHED;
            PG8_LDA(At, 1, 1); PG8_STAGE(PG8_SB(1, 0), b3, voffB); PG8_STAGE(PG8_SB(1, 1), b3 + hstep, voffB); PG8_STAGE(PG8_SA(1, 0), a3, voffA);
            PG8_WAIT_V(8); PG8_WAIT_L(0); PG8_BAR; PG8_MMA(1, 0, At, B0); PG8_MMA(1, 1, At, B1); PG8_BAR; PG8_SCHED;
            } else {
            PG8_LDB(B0, 0, 0); PG8_SCHED; PG8_LDA(At, 0, 0); PG8_STAGE(PG8_SA(1, 1), a1 + hstep, voffA);
            PG8_WAIT_L(8); PG8_BAR; PG8_WAIT_L(0); PG8_MMA(0, 0, At, B0); PG8_BAR; PG8_SCHED;
            PG8_LDB(B1, 0, 1); PG8_STAGE(PG8_SB(0, 0), b2, voffB);
            PG8_BAR; PG8_WAIT_L(0); PG8_MMA(0, 1, At, B1); PG8_BAR;
            PG8_LDA(At, 0, 1); PG8_STAGE(PG8_SA(0, 0), a2, voffA);
            PG8_BAR; PG8_WAIT_L(0); PG8_MMA(1, 0, At, B0); PG8_BAR; PG8_SCHED;
            PG8_STAGE(PG8_SB(0, 1), b2 + hstep, voffB);
            PG8_WAIT_V(6); PG8_BAR; PG8_MMA(1, 1, At, B1); PG8_BAR;
            PG8_LDB(B0, 1, 0); PG8_SCHED; PG8_LDA(At, 1, 0); PG8_STAGE(PG8_SA(0, 1), a2 + hstep, voffA);
            PG8_WAIT_L(8); PG8_BAR; PG8_WAIT_L(0); PG8_MMA(0, 0, At, B0); PG8_BAR; PG8_SCHED;
            PG8_LDB(B1, 1, 1); PG8_STAGE(PG8_SB(1, 0), b3, voffB);
            PG8_BAR; PG8_WAIT_L(0); PG8_MMA(0, 1, At, B1); PG8_BAR;
            PG8_LDA(At, 1, 1); PG8_STAGE(PG8_SA(1, 0), a3, voffA);
            PG8_BAR; PG8_WAIT_L(0); PG8_MMA(1, 0, At, B0); PG8_BAR; PG8_SCHED;
            PG8_STAGE(PG8_SB(1, 1), b3 + hstep, voffB);
            PG8_WAIT_V(6); PG8_BAR; PG8_MMA(1, 1, At, B1); PG8_BAR;
            }
        }
        if constexpr (ALIGN_EPI) { if (wr == 0) PG8_BAR; }
        if constexpr (F8) {
            asm volatile("s_nop 15\n\ts_nop 15" : "+v"(acc[1][1][0][0]), "+v"(acc[1][1][0][1]), "+v"(acc[1][1][1][0]), "+v"(acc[1][1][1][1]), "+v"(acc[1][1][2][0]), "+v"(acc[1][1][2][1]), "+v"(acc[1][1][3][0]), "+v"(acc[1][1][3][1])); }
        if constexpr (!Epi::AFTER_DRAIN) { E(acc, cur, wr, wc, fr, fq); S.done(cur); }
        if (!has_next) break;
#pragma unroll
        for (int a = 0; a < 2; ++a)
#pragma unroll
            for (int b = 0; b < 2; ++b)
#pragma unroll
                for (int m = 0; m < 4; ++m)
#pragma unroll
                    for (int n = 0; n < 2; ++n) acc[a][b][m][n] = (f32x4){zacc, zacc, zacc, zacc};
        cur = nxt; cA = nA; cB = nB; ++ui;
        if constexpr (ALIGN_EPI) { if (wr == 1) PG8_BAR; }
    }
    PG8_WAIT_V(0);
    if constexpr (!ALIGN_EPI) { if (wr == 0) PG8_BAR; }
    PG8_BAR;
    if constexpr (Epi::AFTER_DRAIN) { E.fused(acc, cur, wr, wc, fr, fq, lds, wid, lane); S.done(cur); }
#undef PG8_SA
#undef PG8_SB
#undef PG8_STAGE
#undef PG8_LDA
#undef PG8_LDB
#undef PG8_MMA
#undef PG8_WAIT_V
#undef PG8_WAIT_L
#undef PG8_BAR
#undef PG8_SCHED
}
}


constexpr int S_LAT = 16384, C_CTX = 256, R_ALL = S_LAT + C_CTX, DM = 1024;
constexpr int INW = 2560, FFN = 2816, EXD = 3584, NEXP = 8;
constexpr int COL_AQ = 0, COL_AK = 512, COL_AV = 640, COL_HQ = 768, COL_HFF = 1024, COL_HFB = 1280, COL_HI = 1536, COL_HG = 1792, COL_GU = 2048, COL_GV = 2304;
constexpr int MIX_AT = 0, MIX_HG = 512, MIX_GM = 768;
constexpr int MOE_MAXROWS = 34816;
constexpr float EPS = 1e-6f;
constexpr int NWAVES = 8, NTHR = 512;
constexpr int NPH = 23;

constexpr size_t MiB = 1u << 20;
constexpr size_t WS_CTL = 0, CTL_ZERO_BYTES = 1 * MiB;
constexpr size_t WS_VEC = 1 * MiB;
constexpr size_t WS_TOK = 2 * MiB;
constexpr size_t WS_WIN = 3 * MiB;
constexpr size_t WS_WOUT = 13 * MiB;
constexpr size_t WS_WGU = 17 * MiB;
constexpr size_t WS_WD = 28 * MiB;
constexpr size_t WS_MGU = 34 * MiB;
constexpr size_t WS_MD = 146 * MiB;
constexpr size_t WS_H = 202 * MiB;
constexpr size_t WS_PROJ = 235 * MiB;
constexpr size_t WS_MIX = 317 * MiB;
constexpr size_t WS_HGO = 350 * MiB;
constexpr size_t WS_CTXR = 383 * MiB;
constexpr size_t WS_HLT = WS_HGO;
constexpr size_t WS_HSP = 384 * MiB;
constexpr size_t WS_HDG = 402 * MiB;
constexpr size_t WS_VT = 403 * MiB;
constexpr size_t WS_HID = WS_PROJ;
constexpr size_t WS_AS = 202 * MiB;
constexpr size_t WS_HIDM = 270 * MiB;
constexpr size_t WS_H2B = 440 * MiB;
constexpr size_t WS_YF = WS_WIN;
constexpr size_t WS_Y = WS_MGU;
constexpr size_t WS_XB = 104 * MiB;
constexpr size_t WS_PART1 = 176 * MiB;
constexpr size_t WS_PART2 = 180 * MiB;
constexpr size_t WS_END = 508 * MiB;
static_assert(WS_HID + (size_t)R_ALL * FFN * 2 <= WS_HGO && WS_AS + (size_t)MOE_MAXROWS * DM * 2 <= WS_HIDM && WS_HIDM + (size_t)MOE_MAXROWS * EXD * 2 <= WS_END, "ws map");
static_assert(WS_PART1 >= WS_MD + (size_t)8 * DM * EXD && WS_PART1 + (size_t)4 * 256 * DM * 4 <= WS_PART2 && WS_PART2 + (size_t)11 * 256 * DM * 4 <= WS_H, "ws map 4");
static_assert(WS_XB >= WS_Y + (size_t)MOE_MAXROWS * DM * 2 && WS_XB >= WS_MGU + (size_t)8 * 2 * EXD * DM && WS_XB + (size_t)S_LAT * DM * 2 <= WS_MD, "ws map 3");
static_assert(WS_H2B >= WS_HIDM && WS_H2B + (size_t)S_LAT * DM * 2 <= WS_END && WS_H + (size_t)R_ALL * DM * 2 <= WS_PROJ && WS_PROJ + (size_t)R_ALL * INW * 2 <= WS_MIX && WS_MIX + (size_t)R_ALL * DM * 2 <= WS_HGO && WS_HGO + (size_t)2 * R_ALL * 256 * 4 <= WS_CTXR, "ws map 2");
constexpr int VO_MOD = 0;
constexpr int VO_ROPE = 32768;
constexpr int VO_NBND = 60000;
constexpr int VO_MOE = 65536;
constexpr int CW_BAR = 4096;
constexpr int CW_QUEUE = 2048;
constexpr int CW_MOECNT = 1024;

constexpr int RING_BYTES = 131072;
constexpr int LDSCTL_OFF = 159744, MISC_OFF = LDSCTL_OFF + 320;
constexpr int LDS_BYTES = 163840;

#define GAS __attribute__((address_space(1)))
#define LAS __attribute__((address_space(3)))
typedef unsigned short bf16;
typedef unsigned v4u __attribute__((ext_vector_type(4)));
typedef unsigned v2u __attribute__((ext_vector_type(2)));
typedef float f32x4 __attribute__((ext_vector_type(4)));
typedef GAS unsigned gu32;
#define RLX_AGENT __ATOMIC_RELAXED, __HIP_MEMORY_SCOPE_AGENT
#define LDS_WAIT() asm volatile("s_waitcnt lgkmcnt(0)" ::: "memory")
typedef float f32x2_t __attribute__((ext_vector_type(2))); typedef __bf16 bf16x2_t __attribute__((ext_vector_type(2)));
__device__ __forceinline__ unsigned pk2(float lo, float hi) { const f32x2_t v = {lo, hi}; const bf16x2_t b = __builtin_convertvector(v, bf16x2_t); return __builtin_bit_cast(unsigned, b); }
__device__ __forceinline__ unsigned f2bf(float f) { return pk2(f, 0.f) & 0xffffu; }
__device__ __forceinline__ float bflo(unsigned w) { return __builtin_bit_cast(float, w << 16); }
__device__ __forceinline__ float bfhi(unsigned w) { return __builtin_bit_cast(float, w & 0xffff0000u); }
__device__ __forceinline__ float sigm1(float x) { return __builtin_amdgcn_rcpf(1.0f + __builtin_amdgcn_exp2f(-1.4426950408889634f * x)); }
__device__ __forceinline__ float silu1(float x) { return x * sigm1(x); }
__device__ __forceinline__ float gelu1(float x) { return 0.5f * x * (1.0f + erff(x * 0.70710678118654752f)); }
template <int X> __device__ __forceinline__ float sx(float v) { return __shfl_xor(v, X); }
__device__ __forceinline__ float sx32_add(float v) { return v + __shfl_xor(v, 32); }
__device__ __forceinline__ float sx32_max(float v) { return fmaxf(v, __shfl_xor(v, 32)); }
__device__ __forceinline__ float wave_sum(float v) { v += sx<1>(v); v += sx<2>(v); v += sx<4>(v); v += sx<8>(v); v += sx<16>(v); return sx32_add(v); }
template <int CTRL, int RMASK> __device__ __forceinline__ float dpp_f(float v) { return __builtin_bit_cast(float, __builtin_amdgcn_update_dpp(0, __builtin_bit_cast(int, v), CTRL, RMASK, 0xF, false)); }
__device__ __forceinline__ float wave_sum_dpp(float v) {
    v += dpp_f<0xB1, 0xF>(v);
    v += dpp_f<0x4E, 0xF>(v);
    v += dpp_f<0x141, 0xF>(v);
    v += dpp_f<0x140, 0xF>(v);
    v += dpp_f<0x142, 0xA>(v);
    v += dpp_f<0x143, 0xC>(v);
    return __builtin_bit_cast(float, __builtin_amdgcn_readlane(__builtin_bit_cast(int, v), 63));
}
__device__ __forceinline__ void unpack8(const v4u w, float* f) { f[0] = bflo(w.x); f[1] = bfhi(w.x); f[2] = bflo(w.y); f[3] = bfhi(w.y); f[4] = bflo(w.z); f[5] = bfhi(w.z); f[6] = bflo(w.w); f[7] = bfhi(w.w); }


__device__ __forceinline__ float clamp448(float x) { return fminf(fmaxf(x, -448.0f), 448.0f); }
__device__ __forceinline__ unsigned pk4_fp8(float a, float b, float c, float d) {
    unsigned w = 0u; w = __builtin_amdgcn_cvt_pk_fp8_f32(clamp448(a), clamp448(b), w, false); w = __builtin_amdgcn_cvt_pk_fp8_f32(clamp448(c), clamp448(d), w, true); return w; }
constexpr float F8_WSCALE = 128.0f;
constexpr float F8_ASCALE = 16.0f;
constexpr float F8_HSCALE = 8.0f;
#define XB_TMO      128
#define XB_XCNT(j)  (256  + 64 * (j))
#define XB_XSUB(j)  (1280 + 64 * (j))
#define XB_XGEN(j)  (2304 + 64 * (j))
#define XB_TOP      3328
#define XB_TOPGEN   3392
#define XCD_BAR_WORDS 3456
#define XB_SPIN_CAP (1u << 18)

__device__ __forceinline__ unsigned xb_ld(unsigned* p)              { return __hip_atomic_load(p, __ATOMIC_RELAXED, __HIP_MEMORY_SCOPE_AGENT); }
__device__ __forceinline__ unsigned xb_add(unsigned* p, unsigned v) { return __hip_atomic_fetch_add(p, v, __ATOMIC_RELAXED, __HIP_MEMORY_SCOPE_AGENT); }
__device__ __forceinline__ unsigned xb_xcc_id() { return (unsigned)__builtin_amdgcn_s_getreg((3 << 11) | 20) & 0xFu; }
#define XB_SPIN(cond, bar) do { unsigned _sp = 0; while (cond) { __builtin_amdgcn_s_sleep(1); \
    if ((++_sp & 255u) == 0u) { if (xb_ld(&(bar)[XB_TMO])) break; if (_sp > XB_SPIN_CAP) { atomicAdd(&(bar)[XB_TMO], 1u); break; } } } } while (0)

struct XcdBarrier {
    unsigned* bar; unsigned x;
    volatile LAS unsigned* st;
};

__device__ __forceinline__ XcdBarrier xcd_barrier_post(unsigned* bar, volatile LAS unsigned* st) {
    XcdBarrier b; b.bar = bar; b.x = xb_xcc_id(); b.st = st;
    if (threadIdx.x == 0) (void)xb_add(&bar[XB_XCNT(b.x)], 1u);
    return b;
}
__device__ __forceinline__ void xcd_barrier_complete(unsigned* bar, unsigned x, unsigned& nloc, unsigned& nx) {
    const unsigned G = gridDim.x * gridDim.y * gridDim.z;
    unsigned sum, cnt, mine, sp = 0u;
    for (;;) {
        sum = 0u; cnt = 0u; mine = 0u;
#pragma unroll
        for (unsigned j = 0; j < 16; ++j) { const unsigned c = xb_ld(&bar[XB_XCNT(j)]); sum += c; cnt += (c > 0u) ? 1u : 0u; mine = (j == x) ? c : mine; }
        if (sum == G) break;
        __builtin_amdgcn_s_sleep(1);
        if ((++sp & 255u) == 0u) { if (xb_ld(&bar[XB_TMO])) break; if (sp > XB_SPIN_CAP) { atomicAdd(&bar[XB_TMO], 1u); break; } }
    }
    nloc = mine > 0u ? mine : 1u; nx = cnt > 0u ? cnt : 1u;
}

__device__ __forceinline__ void xcd_barrier(const XcdBarrier& b, const int tid_in) {
    asm volatile("s_waitcnt vmcnt(0)" ::: "memory");
    __syncthreads();
    if (tid_in == 0) {
        unsigned* bar = b.bar;
        __builtin_amdgcn_s_waitcnt(0);
        unsigned nloc = b.st[0], nx = b.st[1];
        if (nloc == 0u) { xcd_barrier_complete(bar, b.x, nloc, nx); b.st[0] = nloc; b.st[1] = nx; }
        const unsigned old = xb_add(&bar[XB_XSUB(b.x)], 1u);
        const unsigned gen = old / nloc;
        if (old + 1u == (gen + 1u) * nloc) {
            __builtin_amdgcn_fence(__ATOMIC_RELEASE, "agent");
            asm volatile("s_waitcnt vmcnt(0)" ::: "memory");
            const unsigned og = xb_add(&bar[XB_TOP], 1u);
            const unsigned tg = og / nx;
            if (og + 1u == (tg + 1u) * nx) xb_add(&bar[XB_TOPGEN], 1u);
            else XB_SPIN(xb_ld(&bar[XB_TOPGEN]) == tg, bar);
            __builtin_amdgcn_fence(__ATOMIC_ACQUIRE, "agent");
            xb_add(&bar[XB_XGEN(b.x)], 1u);
            asm volatile("s_waitcnt vmcnt(0)" ::: "memory");
        } else {
            XB_SPIN(xb_ld(&bar[XB_XGEN(b.x)]) == gen, bar);
            __builtin_amdgcn_fence(__ATOMIC_ACQUIRE, "agent");
            asm volatile("s_waitcnt vmcnt(0)" ::: "memory");
        }
    }
    __syncthreads();
}


struct Args { const float* in[23]; float* out; unsigned char* ws; int ph_lo, ph_hi; };
typedef const __attribute__((address_space(4))) Args* KA;
#define KARGS() ({ KA p_ = (KA)__builtin_amdgcn_kernarg_segment_ptr(); asm volatile("" : "+s"(p_)); p_; })
enum { I_X = 0, I_C, I_CTX, I_CCTX, I_WADA, I_BADA, I_WIN, I_WOUT, I_QG, I_KG, I_SINK, I_HLB, I_HGAIN, I_GWS, I_GBS, I_GNG, I_FG, I_FU, I_FD, I_ROUTER, I_MG, I_MU, I_MDN };

__device__ __forceinline__ void transpose_item(const float* W, int K, int N, bf16* WT, int mode, LAS float* scr, int item, int lane) {
    const int nblk = N / 32, kb = item / nblk, nb = item % nblk, k0 = 64 * kb, n0 = 32 * nb;
    const float* wb = W + (size_t)k0 * N + n0; const int loff = (lane >> 5) * N + (lane & 31);
    float wv[32];
#pragma unroll
    for (int i = 0; i < 32; ++i) wv[i] = __builtin_nontemporal_load(wb + (size_t)(2 * i) * N + loff);
#pragma unroll
    for (int i = 0; i < 32; ++i) scr[(2 * i + (lane >> 5)) * 33 + (lane & 31)] = wv[i];
    LDS_WAIT(); asm volatile("" ::: "memory");
    const int c = lane & 7;
#pragma unroll
    for (int j = 0; j < 4; ++j) { const int n = (lane >> 3) + 8 * j; const LAS float* s = scr + (8 * c) * 33 + n;
        v4u o; o.x = pk2(s[0 * 33], s[1 * 33]); o.y = pk2(s[2 * 33], s[3 * 33]); o.z = pk2(s[4 * 33], s[5 * 33]); o.w = pk2(s[6 * 33], s[7 * 33]);
        const int ng = n0 + n; const int drow = (mode == 0) ? ng : (ng + 128 * (ng / 128) + (mode == 2 ? 128 : 0));
        *(GAS v4u*)(WT + (size_t)drow * K + k0 + 8 * c) = o; }
    LDS_WAIT(); asm volatile("" ::: "memory");
}
__device__ __forceinline__ void transpose_item8(const float* W, int K, int N, unsigned char* WT, int mode, LAS float* scr, int item, int lane) {
    const int nblk = N / 32, kb = item / nblk, nb = item % nblk, k0 = 64 * kb, n0 = 32 * nb;
    const float* wb = W + (size_t)k0 * N + n0; const int loff = (lane >> 5) * N + (lane & 31);
    float wv[32];
#pragma unroll
    for (int i = 0; i < 32; ++i) wv[i] = __builtin_nontemporal_load(wb + (size_t)(2 * i) * N + loff);
#pragma unroll
    for (int i = 0; i < 32; ++i) scr[(2 * i + (lane >> 5)) * 33 + (lane & 31)] = wv[i];
    LDS_WAIT(); asm volatile("" ::: "memory");
    const int c = lane & 7;
#pragma unroll
    for (int j = 0; j < 4; ++j) { const int n = (lane >> 3) + 8 * j; const LAS float* s = scr + (8 * c) * 33 + n;
        v2u o; o.x = pk4_fp8(s[0 * 33] * F8_WSCALE, s[1 * 33] * F8_WSCALE, s[2 * 33] * F8_WSCALE, s[3 * 33] * F8_WSCALE); o.y = pk4_fp8(s[4 * 33] * F8_WSCALE, s[5 * 33] * F8_WSCALE, s[6 * 33] * F8_WSCALE, s[7 * 33] * F8_WSCALE);
        const int ng = n0 + n; const int drow = (mode == 0) ? ng : (ng + 128 * (ng / 128) + (mode == 2 ? 128 : 0));
        *(GAS v2u*)(WT + (size_t)drow * K + k0 + 8 * c) = o; }
    LDS_WAIT(); asm volatile("" ::: "memory");
}
constexpr int MOE_ITEMS = 24 * 16 * 112;
constexpr int MOE_SL0 = 0, MOE_SL1 = 5376, MOE_SL2 = 10752, MOE_SL3 = 16128, MOE_SL4 = 19200, MOE_SL5 = 25344, MOE_SL6 = 29184, MOE_SL7 = 32576, MOE_DEFER = 34496;
__device__ __forceinline__ void moe_conv_item(KA a, int it, LAS float* scr, int lane) {
    constexpr int I_M = 16 * 112;
    unsigned char* ws = a->ws;
    const int idx = it / I_M, r = it % I_M;
    if (idx < 8) transpose_item8(a->in[I_MG] + (size_t)idx * DM * EXD, DM, EXD, (unsigned char*)(ws + WS_MGU) + (size_t)idx * 2 * EXD * DM, 1, scr, r, lane);
    else if (idx < 16) transpose_item8(a->in[I_MU] + (size_t)(idx - 8) * DM * EXD, DM, EXD, (unsigned char*)(ws + WS_MGU) + (size_t)(idx - 8) * 2 * EXD * DM, 2, scr, r, lane);
    else transpose_item8(a->in[I_MDN] + (size_t)(idx - 16) * EXD * DM, EXD, DM, (unsigned char*)(ws + WS_MD) + (size_t)(idx - 16) * DM * EXD, 0, scr, r, lane);
}
__device__ __forceinline__ void moe_conv_range(KA a, int lo, int hi, int first, LAS unsigned char* lds, int lane, int wave, int G, int bid) {
    if (bid < first) return;
    LAS float* scr = (LAS float*)(lds + wave * 8704);
    const int nw = (G - first) * NWAVES, w = (bid - first) * NWAVES + wave;
    for (int i = lo + w; i < hi; i += nw) moe_conv_item(a, i, scr, lane);
}
__device__ __forceinline__ void p0_prologue(KA a, LAS unsigned char* lds, int tid, int lane, int wave, int G, int bid) {
    unsigned char* ws = a->ws;
    LAS float* scr = (LAS float*)(lds + wave * 8704);
    const int gw = bid * NWAVES + wave, NGW = G * NWAVES;
    constexpr int I_IN = 16 * 80, I_OUT = 16 * 32, I_F = 16 * 88, I_FDN = 44 * 32, I_M = 16 * 112;
    constexpr int NIT = 2 * I_IN + 2 * I_OUT + 2 * I_F + I_FDN + 24 * I_M;
    LAS float* sil = (LAS float*)(lds + 69632);
    LAS float* part = (LAS float*)(lds + 69632 + 8192);
    float* vec = (float*)(ws + WS_VEC);
    const bool wada = bid < 192;
    if (wada) { for (int i = tid; i < 2048; i += NTHR) { const float v = (i < 1024) ? a->in[I_C][i] : a->in[I_CCTX][i - 1024]; sil[i] = silu1(v); } __syncthreads(); }
    const int l0 = bid / 96, col0 = (bid % 96) * 64 + lane;
    const float* w0 = a->in[I_WADA] + (size_t)l0 * DM * 6144 + col0;
    float a0 = 0.f, a1 = 0.f; int jb = 0;
    for (int it0 = gw; it0 < NIT || (wada && jb < 4); it0 += NGW) {
        float wv[32]; const bool wb = wada && jb < 4; const int k0 = wave * 128 + 32 * jb;
        if (wb) {
#pragma unroll
            for (int j = 0; j < 32; ++j) wv[j] = __builtin_nontemporal_load(&w0[(size_t)(k0 + j) * 6144]); }
        if (it0 < NIT) {
            int it = it0;
            if (it < 2 * I_IN) { const int l = it / I_IN, r = it % I_IN; transpose_item(a->in[I_WIN] + (size_t)l * DM * INW, DM, INW, (bf16*)(ws + WS_WIN) + (size_t)l * INW * DM, 0, scr, r, lane); }
            else if ((it -= 2 * I_IN) < 2 * I_OUT) { const int l = it / I_OUT, r = it % I_OUT; transpose_item(a->in[I_WOUT] + (size_t)l * DM * DM, DM, DM, (bf16*)(ws + WS_WOUT) + (size_t)l * DM * DM, 0, scr, r, lane); }
            else if ((it -= 2 * I_OUT) < I_F) transpose_item(a->in[I_FG], DM, FFN, (bf16*)(ws + WS_WGU), 1, scr, it, lane);
            else if ((it -= I_F) < I_F) transpose_item(a->in[I_FU], DM, FFN, (bf16*)(ws + WS_WGU), 2, scr, it, lane);
            else if ((it -= I_F) < I_FDN) transpose_item(a->in[I_FD], FFN, DM, (bf16*)(ws + WS_WD), 0, scr, it, lane);
            else if ((it -= I_FDN) >= MOE_DEFER) moe_conv_item(a, it, scr, lane);
        }
        if (wb) {
#pragma unroll
            for (int j = 0; j < 32; ++j) { a0 += sil[k0 + j] * wv[j]; a1 += sil[1024 + k0 + j] * wv[j]; }
            ++jb; }
    }
    if (wada) {
        for (int item = bid; item < 192; item += G) {
            const int l = item / 96, cb = item % 96, col = cb * 64 + lane;
            if (item != bid) {
                const float* w = a->in[I_WADA] + (size_t)l * DM * 6144 + col; a0 = 0.f; a1 = 0.f;
#pragma unroll 1
                for (int k0 = wave * 128; k0 < wave * 128 + 128; k0 += 32) { float wv[32];
#pragma unroll
                    for (int j = 0; j < 32; ++j) wv[j] = __builtin_nontemporal_load(&w[(size_t)(k0 + j) * 6144]);
#pragma unroll
                    for (int j = 0; j < 32; ++j) { a0 += sil[k0 + j] * wv[j]; a1 += sil[1024 + k0 + j] * wv[j]; } } }
            part[(wave * 2 + 0) * 64 + lane] = a0; part[(wave * 2 + 1) * 64 + lane] = a1;
            __syncthreads();
            if (wave == 0) { float s0 = 0.f, s1 = 0.f;
#pragma unroll
                for (int w8 = 0; w8 < 8; ++w8) { s0 += part[(w8 * 2 + 0) * 64 + lane]; s1 += part[(w8 * 2 + 1) * 64 + lane]; }
                const float b = a->in[I_BADA][l * 6144 + col];
                vec[VO_MOD + (l * 2 + 0) * 6144 + col] = s0 + b; vec[VO_MOD + (l * 2 + 1) * 6144 + col] = s1 + b; }
            __syncthreads();
        }
    }
    if (bid == 0 && tid < 2) {
        float gq = 0.f, gk = 0.f;
        for (int d = 0; d < 64; ++d) { gq = fmaxf(gq, fabsf(a->in[I_QG][tid * 64 + d])); gk = fmaxf(gk, fabsf(a->in[I_KG][tid * 64 + d])); }
        vec[VO_NBND + tid] = -(8.0f * 1.4426950408889634f) * gq * gk; }
    if (bid == G - 1) {
        for (int idx = tid; idx < 5120; idx += NTHR) {
            const int isc = idx >= 4096, j = isc ? idx - 4096 : idx, pos = j / 16, i = j % 16;
            const float inv = exp2f(-(float)i * 0.83048202372184059f);
            const float ang = (float)pos * inv;
            double r = (double)ang * 0.15915494309189535; r -= floor(r);
            const float rf = (float)r;
            const float cs = __builtin_amdgcn_cosf(rf), sn = __builtin_amdgcn_sinf(rf);
            float* t = vec + VO_ROPE + (isc ? 8192 : 0);
            const int n = isc ? 1024 : 4096;
            t[j] = cs; t[n + j] = sn;
        }
    }
}

template <bool STORE = true, bool BFX = false> __device__ __forceinline__ void norm_row(const void* xrow, const float* sc, const float* sh, bf16* orow, int lane, f32x4 (&h)[4]) {
    f32x4 v[4]; float s = 0.f;
    if constexpr (BFX) { const GAS v2u* xr = (const GAS v2u*)xrow + lane;
#pragma unroll
        for (int j = 0; j < 4; ++j) { const v2u t = xr[64 * j]; v[j] = (f32x4){bflo(t.x), bfhi(t.x), bflo(t.y), bfhi(t.y)}; } }
    else { const GAS f32x4* xr = (const GAS f32x4*)xrow + lane;
#pragma unroll
        for (int j = 0; j < 4; ++j) v[j] = xr[64 * j]; }
#pragma unroll
    for (int j = 0; j < 4; ++j) s += (v[j].x * v[j].x + v[j].y * v[j].y) + (v[j].z * v[j].z + v[j].w * v[j].w);
    const float rstd = __builtin_amdgcn_rsqf(wave_sum_dpp(s) * (1.0f / DM) + EPS);
    GAS v2u* o8 = (GAS v2u*)orow + lane;
#pragma unroll
    for (int j = 0; j < 4; ++j) { const f32x4 scv = *(const f32x4*)(sc + 4 * lane + 256 * j), shv = *(const f32x4*)(sh + 4 * lane + 256 * j);
        h[j] = v[j] * rstd * (scv + 1.0f) + shv;
        if constexpr (STORE) { v2u w; w.x = pk2(h[j].x, h[j].y); w.y = pk2(h[j].z, h[j].w); o8[64 * j] = w; } }
}
__device__ __forceinline__ void phase_norm(KA a, int l, int which, int nrows, bf16* H, int lane, int wave, int G, int bid) {
    const float* vec = (const float*)(a->ws + WS_VEC);
    const bool bfx = !(l == 0 && which == 0);
    const float* xl = a->in[I_X]; const bf16* xb = (const bf16*)(a->ws + WS_XB);
    const float* xc = (l == 0) ? a->in[I_CTX] : (const float*)(a->ws + WS_CTXR);
    const int nlat = nrows < S_LAT ? nrows : S_LAT;
    const float* ml = vec + VO_MOD + (l * 2 + 0) * 6144 + which * 3072;
    const float* mc = vec + VO_MOD + (l * 2 + 1) * 6144 + which * 3072;
    const int gw = bid * NWAVES + wave, NGW = G * NWAVES;
    f32x4 scl[4], shl[4], v[4];
#pragma unroll
    for (int j = 0; j < 4; ++j) { scl[j] = *(const f32x4*)(ml + 1024 + 4 * lane + 256 * j) + 1.0f; shl[j] = *(const f32x4*)(ml + 4 * lane + 256 * j); }
    if (gw < nlat) {
        if (bfx) { const GAS v2u* xr = (const GAS v2u*)(xb + (size_t)gw * DM) + lane;
#pragma unroll
            for (int j = 0; j < 4; ++j) { const v2u t = xr[64 * j]; v[j] = (f32x4){bflo(t.x), bfhi(t.x), bflo(t.y), bfhi(t.y)}; } }
        else { const GAS f32x4* xr = (const GAS f32x4*)(xl + (size_t)gw * DM) + lane;
#pragma unroll
            for (int j = 0; j < 4; ++j) v[j] = xr[64 * j]; } }
    for (int r = gw; r < nlat; r += NGW) {
        const int rn = r + NGW; f32x4 vn[4];
        if (rn < nlat) {
            if (bfx) { const GAS v2u* xr = (const GAS v2u*)(xb + (size_t)rn * DM) + lane;
#pragma unroll
                for (int j = 0; j < 4; ++j) { const v2u t = xr[64 * j]; vn[j] = (f32x4){bflo(t.x), bfhi(t.x), bflo(t.y), bfhi(t.y)}; } }
            else { const GAS f32x4* xr = (const GAS f32x4*)(xl + (size_t)rn * DM) + lane;
#pragma unroll
                for (int j = 0; j < 4; ++j) vn[j] = xr[64 * j]; } }
        float s = 0.f;
#pragma unroll
        for (int j = 0; j < 4; ++j) s += (v[j].x * v[j].x + v[j].y * v[j].y) + (v[j].z * v[j].z + v[j].w * v[j].w);
        const float rstd = __builtin_amdgcn_rsqf(wave_sum_dpp(s) * (1.0f / DM) + EPS);
        GAS v2u* o8 = (GAS v2u*)(H + (size_t)r * DM) + lane;
#pragma unroll
        for (int j = 0; j < 4; ++j) { const f32x4 h = v[j] * rstd * scl[j] + shl[j]; v2u w; w.x = pk2(h.x, h.y); w.y = pk2(h.z, h.w); o8[64 * j] = w; }
#pragma unroll
        for (int j = 0; j < 4; ++j) v[j] = vn[j];
    }
    const int npart = (l == 0 && which == 0) ? 0 : (l == 0 ? 4 : 11);
    const float* part = (const float*)(a->ws + (l == 0 ? WS_PART1 : WS_PART2));
    for (int r = S_LAT + (NGW - 1 - gw); r < nrows; r += NGW) {
        const int cr = r - S_LAT; f32x4 x[4];
        { const GAS f32x4* xr = (const GAS f32x4*)(xc + (size_t)cr * DM) + lane;
#pragma unroll
          for (int j = 0; j < 4; ++j) x[j] = xr[64 * j]; }
        for (int p = 0; p < npart; ++p) { const GAS f32x4* pr = (const GAS f32x4*)(part + ((size_t)p * 256 + cr) * DM) + lane;
#pragma unroll
            for (int j = 0; j < 4; ++j) x[j] = x[j] + pr[64 * j]; }
        if (npart && l == 0) { GAS f32x4* cw = (GAS f32x4*)((float*)(a->ws + WS_CTXR) + (size_t)cr * DM) + lane;
#pragma unroll
            for (int j = 0; j < 4; ++j) cw[64 * j] = x[j]; }
        float s = 0.f;
#pragma unroll
        for (int j = 0; j < 4; ++j) s += (x[j].x * x[j].x + x[j].y * x[j].y) + (x[j].z * x[j].z + x[j].w * x[j].w);
        const float rstd = __builtin_amdgcn_rsqf(wave_sum_dpp(s) * (1.0f / DM) + EPS);
        GAS v2u* o8 = (GAS v2u*)(H + (size_t)r * DM) + lane;
#pragma unroll
        for (int j = 0; j < 4; ++j) { const f32x4 scv = *(const f32x4*)(mc + 1024 + 4 * lane + 256 * j), shv = *(const f32x4*)(mc + 4 * lane + 256 * j);
            const f32x4 h = x[j] * rstd * (scv + 1.0f) + shv; v2u w; w.x = pk2(h.x, h.y); w.y = pk2(h.z, h.w); o8[64 * j] = w; }
    }
}
constexpr int ROUTE_ROWS_OFF = 36864;
__device__ __forceinline__ void phase_norm_route(KA a, LAS unsigned char* lds, int tid, int lane, int wave, int G, int bid) {
    const int l = 1;
    const float* vec = (const float*)(a->ws + WS_VEC);
    const float* ml = vec + VO_MOD + (l * 2 + 0) * 6144 + 3072;
    LAS float* rt = (LAS float*)lds;
    volatile LAS unsigned* lcnt = (volatile LAS unsigned*)(lds + 32768);
    for (int i = tid; i < 8192; i += NTHR) rt[i] = a->in[I_ROUTER][i];
    if (tid < 16) lcnt[tid] = 0u;
    __syncthreads();
    int* tokinfo = (int*)(a->ws + WS_TOK);
    unsigned* cnt = (unsigned*)(a->ws + WS_CTL) + CW_MOECNT;
    const int gw = bid * NWAVES + wave, NGW = G * NWAVES;
    unsigned keep = 0u, pk0 = 0u; int itn = 0;
    f32x4 scl[4], shl[4]; v2u nx[4];
#pragma unroll
    for (int j = 0; j < 4; ++j) { scl[j] = *(const f32x4*)(ml + 1024 + 4 * lane + 256 * j) + 1.0f; shl[j] = *(const f32x4*)(ml + 4 * lane + 256 * j); }
    if (gw < S_LAT) { const GAS v2u* xr = (const GAS v2u*)((const bf16*)(a->ws + WS_XB) + (size_t)gw * DM) + lane;
#pragma unroll
        for (int j = 0; j < 4; ++j) nx[j] = xr[64 * j]; }
    for (int r = gw; r < S_LAT; r += NGW) {
        f32x4 h[4];
        { v2u cu[4];
#pragma unroll
          for (int j = 0; j < 4; ++j) cu[j] = nx[j];
          if (r + NGW < S_LAT) { const GAS v2u* xr = (const GAS v2u*)((const bf16*)(a->ws + WS_XB) + (size_t)(r + NGW) * DM) + lane;
#pragma unroll
              for (int j = 0; j < 4; ++j) nx[j] = xr[64 * j]; }
          float s = 0.f;
#pragma unroll
          for (int j = 0; j < 4; ++j) { h[j] = (f32x4){bflo(cu[j].x), bfhi(cu[j].x), bflo(cu[j].y), bfhi(cu[j].y)}; s += (h[j].x * h[j].x + h[j].y * h[j].y) + (h[j].z * h[j].z + h[j].w * h[j].w); }
          const float rstd = __builtin_amdgcn_rsqf(wave_sum_dpp(s) * (1.0f / DM) + EPS);
#pragma unroll
          for (int j = 0; j < 4; ++j) h[j] = h[j] * rstd * scl[j] + shl[j]; }
#pragma unroll
        for (int j = 0; j < 4; ++j) ((LAS unsigned*)(lds + ROUTE_ROWS_OFF + wave * 8192 + itn * 1024))[lane + 64 * j] = pk4_fp8(h[j].x * F8_ASCALE, h[j].y * F8_ASCALE, h[j].z * F8_ASCALE, h[j].w * F8_ASCALE);
        float lg[8];
#pragma unroll
        for (int e = 0; e < 8; ++e) lg[e] = 0.f;
#pragma unroll
        for (int j = 0; j < 4; ++j)
#pragma unroll
            for (int i = 0; i < 4; ++i) { const int d = 4 * lane + 256 * j + i; const f32x4 r0 = *(const LAS f32x4*)(rt + d * 8), r1 = *(const LAS f32x4*)(rt + d * 8 + 4); const float hv = h[j][i];
                lg[0] += hv * r0.x; lg[1] += hv * r0.y; lg[2] += hv * r0.z; lg[3] += hv * r0.w; lg[4] += hv * r1.x; lg[5] += hv * r1.y; lg[6] += hv * r1.z; lg[7] += hv * r1.w; }
#pragma unroll
        for (int e = 0; e < 8; ++e) lg[e] = wave_sum_dpp(lg[e]);
        int i1 = 0; float v1 = lg[0];
#pragma unroll
        for (int e = 1; e < 8; ++e) if (lg[e] > v1) { v1 = lg[e]; i1 = e; }
        int i2 = -1; float v2 = -INFINITY;
#pragma unroll
        for (int e = 0; e < 8; ++e) if (e != i1 && lg[e] > v2) { v2 = lg[e]; i2 = e; }
        const float w1 = 1.0f / (1.0f + __expf(v2 - v1)), w2 = 1.0f - w1;
        if (lane == 0) {
            const unsigned r1 = __hip_atomic_fetch_add((LAS unsigned*)lcnt + i1, 1u, __ATOMIC_RELAXED, __HIP_MEMORY_SCOPE_WORKGROUP), r2 = __hip_atomic_fetch_add((LAS unsigned*)lcnt + i2, 1u, __ATOMIC_RELAXED, __HIP_MEMORY_SCOPE_WORKGROUP);
            int* ti = tokinfo + (size_t)r * 8;
            ti[0] = i1; ti[1] = i2; ti[4] = __builtin_bit_cast(int, w1); ti[5] = __builtin_bit_cast(int, w2);
            pk0 = (unsigned)i1 | ((unsigned)i2 << 3) | (r1 << 6) | (r2 << 19);
        }
        const unsigned pku = (unsigned)__builtin_amdgcn_readfirstlane((int)pk0);
        if (lane == itn) keep = pku;
        ++itn;
    }
    __syncthreads();
    if (tid < 8) lcnt[8 + tid] = __hip_atomic_fetch_add(cnt + 64 * tid, lcnt[tid], RLX_AGENT);
    __syncthreads();
    { const int r = gw + lane * NGW; if (lane < itn && r < S_LAT) { int* ti = tokinfo + (size_t)r * 8; const unsigned e1 = keep & 7u, e2 = (keep >> 3) & 7u; ti[2] = (int)(((keep >> 6) & 0x1fffu) + lcnt[8 + e1]); ti[3] = (int)((keep >> 19) + lcnt[8 + e2]); } }
}

__device__ __forceinline__ void qk_prep(KA a, int l, int first_thread, int nthreads) {
    bf16* PROJ = (bf16*)(a->ws + WS_PROJ);
    const float* rope = (const float*)(a->ws + WS_VEC) + VO_ROPE;
    for (int i = first_thread; i < R_ALL * 10; i += nthreads) {
        const int row = i / 10, hh = i % 10; const bool isq = hh < 8;
        bf16* p = PROJ + (size_t)row * INW + (isq ? hh * 64 : COL_AK + (hh - 8) * 64);
        const float* gain = (isq ? a->in[I_QG] : a->in[I_KG]) + l * 64;
        float x[64]; float ss = 0.f;
#pragma unroll
        for (int c = 0; c < 8; ++c) { const v4u w = *(const GAS v4u*)(p + 8 * c); unpack8(w, x + 8 * c); }
#pragma unroll
        for (int d = 0; d < 64; ++d) ss += x[d] * x[d];
        const float rstd = __builtin_amdgcn_rsqf(ss * (1.0f / 64.0f) + EPS);
        const f32x4* g4 = (const f32x4*)gain;
#pragma unroll
        for (int c = 0; c < 16; ++c) { const f32x4 gv = g4[c]; x[4 * c] *= rstd * gv.x; x[4 * c + 1] *= rstd * gv.y; x[4 * c + 2] *= rstd * gv.z; x[4 * c + 3] *= rstd * gv.w; }
        if (row < S_LAT) {
            const int gr = row >> 6, gc = row & 63;
            const f32x4* cr = (const f32x4*)(rope + gr * 16); const f32x4* sr = (const f32x4*)(rope + 4096 + gr * 16); const f32x4* cc = (const f32x4*)(rope + 8192 + gc * 16); const f32x4* sc = (const f32x4*)(rope + 8192 + 1024 + gc * 16);
#pragma unroll
            for (int j4 = 0; j4 < 4; ++j4) { const f32x4 cv = cr[j4], sv = sr[j4];
#pragma unroll
                for (int i = 0; i < 4; ++i) { const int j = 4 * j4 + i; const float x1 = x[j], x2 = x[16 + j]; x[j] = x1 * cv[i] - x2 * sv[i]; x[16 + j] = x1 * sv[i] + x2 * cv[i]; } }
#pragma unroll
            for (int j4 = 0; j4 < 4; ++j4) { const f32x4 cv = cc[j4], sv = sc[j4];
#pragma unroll
                for (int i = 0; i < 4; ++i) { const int j = 4 * j4 + i; const float x1 = x[32 + j], x2 = x[48 + j]; x[32 + j] = x1 * cv[i] - x2 * sv[i]; x[48 + j] = x1 * sv[i] + x2 * cv[i]; } }
        }
        const float qs = isq ? 0.125f * 1.4426950408889634f : 1.0f;
#pragma unroll
        for (int c = 0; c < 8; ++c) { v4u w; w.x = pk2(x[8 * c] * qs, x[8 * c + 1] * qs); w.y = pk2(x[8 * c + 2] * qs, x[8 * c + 3] * qs); w.z = pk2(x[8 * c + 4] * qs, x[8 * c + 5] * qs); w.w = pk2(x[8 * c + 6] * qs, x[8 * c + 7] * qs);
            *(GAS v4u*)(p + 8 * c) = w; }
    }
}
__device__ __forceinline__ void gmlp_unit(KA a, int l, int chunk, int g, LAS unsigned char* lds, int tid, int lane, int wave) {
    const bf16* PROJ = (const bf16*)(a->ws + WS_PROJ); bf16* MIX = (bf16*)(a->ws + WS_MIX);
    const int row0 = (chunk < 128) ? chunk * 128 : S_LAT + (chunk - 128) * 128;
    LAS float* vn = (LAS float*)lds;
    { const int pos = tid >> 2, part = tid & 3;
      const bf16* p = PROJ + (size_t)(row0 + pos) * INW + COL_GV + g * 64 + part * 16;
      float x[16]; unpack8(*(const GAS v4u*)p, x); unpack8(*(const GAS v4u*)(p + 8), x + 8);
      float ss = 0.f;
#pragma unroll
      for (int d = 0; d < 16; ++d) { x[d] = gelu1(x[d]); ss += x[d] * x[d]; }
      ss += sx<1>(ss); ss += sx<2>(ss);
      const float rstd = __builtin_amdgcn_rsqf(ss * (1.0f / 64.0f) + EPS);
      const float* gn = a->in[I_GNG] + l * 256 + g * 64 + part * 16;
#pragma unroll
      for (int d = 0; d < 16; ++d) vn[pos * 64 + part * 16 + d] = x[d] * rstd * gn[d]; }
    __syncthreads();
    const int c = lane, t0 = wave * 16;
    const float* W = a->in[I_GWS] + ((size_t)(l * 4 + g) * 128 + t0) * 128;
    float acc[16];
#pragma unroll
    for (int i = 0; i < 16; ++i) acc[i] = 0.f;
    for (int s = 0; s < 128; ++s) { const float v = vn[s * 64 + c];
#pragma unroll
        for (int i = 0; i < 16; ++i) acc[i] += W[i * 128 + s] * v; }
    const float* bs = a->in[I_GBS] + (l * 4 + g) * 128 + t0;
#pragma unroll
    for (int i = 0; i < 16; ++i) { const int row = row0 + t0 + i;
        const float u = gelu1(bflo((unsigned)PROJ[(size_t)row * INW + COL_GU + g * 64 + c]));
        MIX[(size_t)row * DM + MIX_GM + g * 64 + c] = (bf16)f2bf(u * (acc[i] + bs[i])); }
    __syncthreads();
}
__device__ __forceinline__ void hgrn_naive(KA a, int l, int dir, int head, LAS unsigned char* lds, int tid, int lane, int wave) {
    const bf16* PROJ = (const bf16*)(a->ws + WS_PROJ);
    float* HGO = (float*)(a->ws + WS_HGO) + (size_t)dir * R_ALL * 256;
    LAS float* Qs = (LAS float*)lds;
    LAS float* Fs = Qs + 4096; LAS float* Vs = Fs + 4096; LAS float* part = Vs + 4096;
    const int v = lane, kg = wave;
    float S[8];
#pragma unroll
    for (int i = 0; i < 8; ++i) S[i] = 0.f;
    const int tl = tid >> 3, c8 = tid & 7;
    float lb[8];
#pragma unroll
    for (int j = 0; j < 8; ++j) { float b = 0.f; if (l == 1) { const float p0 = a->in[I_HLB][dir * 512 + head * 64 + c8 * 8 + j], p1 = a->in[I_HLB][dir * 512 + 256 + head * 64 + c8 * 8 + j]; b = 1.0f / (1.0f + __expf(p0 - p1)); } lb[j] = b; }
    const int fcol = (dir == 0 ? COL_HFF : COL_HFB) + head * 64 + c8 * 8;
    for (int n0 = 0; n0 < R_ALL; n0 += 64) {
        { const int n = n0 + tl; int row;
          if (dir == 0) row = (n < C_CTX) ? S_LAT + n : n - C_CTX; else row = (n < C_CTX) ? S_LAT + (C_CTX - 1 - n) : (S_LAT - 1) - (n - C_CTX);
          const bf16* pr = PROJ + (size_t)row * INW;
          float q[8], f[8], vv[8];
          unpack8(*(const GAS v4u*)(pr + COL_HQ + head * 64 + c8 * 8), q); unpack8(*(const GAS v4u*)(pr + fcol), f); unpack8(*(const GAS v4u*)(pr + COL_HI + head * 64 + c8 * 8), vv);
#pragma unroll
          for (int j = 0; j < 8; ++j) { Qs[tl * 64 + c8 * 8 + j] = silu1(q[j]) * 0.125f; Fs[tl * 64 + c8 * 8 + j] = lb[j] + (1.0f - lb[j]) * sigm1(f[j]); Vs[tl * 64 + c8 * 8 + j] = vv[j]; } }
        __syncthreads();
        for (int t = 0; t < 64; ++t) {
            const float vt = Vs[t * 64 + v]; float po = 0.f;
#pragma unroll
            for (int i = 0; i < 8; ++i) { const float f = Fs[t * 64 + kg * 8 + i], q = Qs[t * 64 + kg * 8 + i]; S[i] = f * S[i] + (1.0f - f) * vt; po += S[i] * q; }
            part[((t & 1) * 8 + kg) * 64 + v] = po;
            __syncthreads();
            if (wave == 0) { float o = 0.f;
#pragma unroll
                for (int w8 = 0; w8 < 8; ++w8) o += part[((t & 1) * 8 + w8) * 64 + v];
                const int n = n0 + t; int row;
                if (dir == 0) row = (n < C_CTX) ? S_LAT + n : n - C_CTX; else row = (n < C_CTX) ? S_LAT + (C_CTX - 1 - n) : (S_LAT - 1) - (n - C_CTX);
                HGO[(size_t)row * 256 + head * 64 + v] = o; }
        }
        __syncthreads();
    }
}

typedef short bf16x8v __attribute__((ext_vector_type(8)));
constexpr int HST = 72;
__device__ __forceinline__ f32x4 mma16(const LAS bf16* MA, const LAS bf16* MBt, int k0, f32x4 c, int lane) {
    const bf16x8v av = *(const LAS bf16x8v*)(MA + (lane & 15) * HST + k0 + 8 * (lane >> 4));
    const bf16x8v bv = *(const LAS bf16x8v*)(MBt + (lane & 15) * HST + k0 + 8 * (lane >> 4));
    return __builtin_amdgcn_mfma_f32_16x16x32_bf16(av, bv, c, 0, 0, 0);
}
__device__ __forceinline__ int hg_base_row(int cpos) { return cpos < 256 ? 64 * cpos : S_LAT + 64 * (cpos - 256); }
__device__ __forceinline__ int hg_scan_idx(int dir, int cpos) { return dir == 0 ? (cpos < 256 ? 4 + cpos : cpos - 256) : (cpos < 256 ? 4 + (255 - cpos) : 3 - (cpos - 256)); }
__device__ __forceinline__ float hg_lb(KA a, int l, int dir, int head, int k) {
    if (l == 0) return 0.f;
    const float p0 = a->in[I_HLB][dir * 512 + head * 64 + k], p1 = a->in[I_HLB][dir * 512 + 256 + head * 64 + k];
    return 1.0f / (1.0f + __expf(p0 - p1));
}
__device__ __forceinline__ void hgrn_stepA(KA a, int l, int cpos, int head, LAS unsigned char* lds, int lane, int wave) {
    const bf16* PROJ = (const bf16*)(a->ws + WS_PROJ);
    const int dir = wave >> 2, I = wave & 3, base = hg_base_row(cpos), ci = hg_scan_idx(dir, cpos);
    LAS float* TOT = (LAS float*)lds;
    LAS bf16* KLT = (LAS bf16*)(lds + 2048) + dir * 64 * HST;
    LAS bf16* VT = (LAS bf16*)(lds + 2048 + 2 * 64 * HST * 2) + dir * 64 * HST;
    const float lb = hg_lb(a, l, dir, head, lane);
    const int fcol = (dir == 0 ? COL_HFF : COL_HFB) + head * 64 + lane, vcol = COL_HI + head * 64 + lane;
    float kk[16], cl[16]; float run = 0.f;
#pragma unroll
    for (int i = 0; i < 16; ++i) { const int n = 16 * I + i, row = base + (dir ? 63 - n : n);
        const float fl = bflo((unsigned)PROJ[(size_t)row * INW + fcol]);
        const unsigned short vb = PROJ[(size_t)row * INW + vcol];
        const float f = lb + (1.0f - lb) * sigm1(fl);
        run += __logf(f); cl[i] = run; kk[i] = 1.0f - f;
        VT[lane * HST + n] = vb; }
    TOT[(dir * 4 + I) * 64 + lane] = run;
    __syncthreads();
    float post = 0.f, all = 0.f;
#pragma unroll
    for (int J = 0; J < 4; ++J) { const float t = TOT[(dir * 4 + J) * 64 + lane]; all += t; if (J > I) post += t; }
#pragma unroll
    for (int i = 0; i < 16; ++i) KLT[lane * HST + 16 * I + i] = (bf16)f2bf(kk[i] * __expf(run - cl[i] + post));
    if (I == 0) ((float*)(a->ws + WS_HDG))[((size_t)(dir * 4 + head) * 260 + ci) * 64 + lane] = __expf(all);
    __syncthreads();
    float* LT = (float*)(a->ws + WS_HLT) + ((size_t)(dir * 4 + head) * 260 + ci) * 4096;
    float z0 = 0.f; asm volatile("" : "+v"(z0));
#pragma unroll
    for (int kb = 0; kb < 4; ++kb) { f32x4 acc = {z0, z0, z0, z0};
        acc = mma16(VT + 16 * I * HST, KLT + 16 * kb * HST, 0, acc, lane); acc = mma16(VT + 16 * I * HST, KLT + 16 * kb * HST, 32, acc, lane);
#pragma unroll
        for (int r = 0; r < 4; ++r) LT[(16 * I + 4 * (lane >> 4) + r) * 64 + 16 * kb + (lane & 15)] = acc[r]; }
    __syncthreads();
}
__device__ __forceinline__ void hgrn_stepB(KA a, int item, int tid) {
    const int dh = item >> 3, vb = item & 7, v = vb * 8 + (tid >> 6), k = tid & 63;
    const float* LT = (const float*)(a->ws + WS_HLT) + (size_t)dh * 260 * 4096 + v * 64 + k;
    const float* DG = (const float*)(a->ws + WS_HDG) + (size_t)dh * 260 * 64 + k;
    bf16* SP = (bf16*)(a->ws + WS_HSP) + (size_t)dh * 260 * 4096 + v * 64 + k;
    float S = 0.f;
#pragma unroll 1
    for (int c0 = 0; c0 < 260; c0 += 26) {
        float lt[26], dg[26];
#pragma unroll
        for (int j = 0; j < 26; ++j) { lt[j] = LT[(size_t)(c0 + j) * 4096]; dg[j] = DG[(c0 + j) * 64]; }
#pragma unroll
        for (int j = 0; j < 26; ++j) { SP[(size_t)(c0 + j) * 4096] = (bf16)f2bf(S); S = dg[j] * S + lt[j]; }
    }
}
__device__ __forceinline__ void hgrn_stepC(KA a, int l, int cpos, int head, LAS unsigned char* lds, int tid, int lane, int wave) {
    const bf16* PROJ = (const bf16*)(a->ws + WS_PROJ); bf16* MIX = (bf16*)(a->ws + WS_MIX);
    const int dir = wave >> 2, I = wave & 3, base = hg_base_row(cpos), ci = hg_scan_idx(dir, cpos);
    constexpr int MSZ = 64 * HST;
    LAS float* TOT = (LAS float*)lds;
    LAS bf16* img = (LAS bf16*)(lds + 2048);
    LAS bf16* QT = img + dir * MSZ;
    LAS bf16* QD = img + 2 * MSZ + dir * MSZ;
    LAS bf16* VT = img + 4 * MSZ + dir * MSZ;
    LAS bf16* ST = img + 6 * MSZ + dir * MSZ;
    LAS bf16* AS = img + 8 * MSZ + dir * MSZ + I * 16 * HST;
    LAS bf16* KT = img + 10 * MSZ + dir * (10 * 16 * HST);
    LAS float* OS = (LAS float*)(img + 10 * MSZ);
    const float lb = hg_lb(a, l, dir, head, lane);
    const int fcol = (dir == 0 ? COL_HFF : COL_HFB) + head * 64 + lane, qcol = COL_HQ + head * 64 + lane, vcol = COL_HI + head * 64 + lane;
    { const bf16* SP = (const bf16*)(a->ws + WS_HSP) + ((size_t)(dir * 4 + head) * 260 + ci) * 4096;
#pragma unroll
      for (int h2 = 0; h2 < 2; ++h2) { const int e = ((I * 2 + h2) * 64 + lane) * 8, vv = e >> 6, kk0 = e & 63;
          *(LAS v4u*)(ST + vv * HST + kk0) = *(const GAS v4u*)(SP + e); } }
    float kk[16], cl[16], qv[16]; float run = 0.f;
#pragma unroll
    for (int i = 0; i < 16; ++i) { const int n = 16 * I + i, row = base + (dir ? 63 - n : n);
        const float fl = bflo((unsigned)PROJ[(size_t)row * INW + fcol]), ql = bflo((unsigned)PROJ[(size_t)row * INW + qcol]);
        const unsigned short vb = PROJ[(size_t)row * INW + vcol];
        const float f = lb + (1.0f - lb) * sigm1(fl);
        run += __logf(f); cl[i] = run; kk[i] = 1.0f - f; qv[i] = silu1(ql) * 0.125f;
        VT[lane * HST + n] = vb; }
    TOT[(dir * 4 + I) * 64 + lane] = run;
    __syncthreads();
    float tj[4];
#pragma unroll
    for (int J = 0; J < 4; ++J) tj[J] = TOT[(dir * 4 + J) * 64 + lane];
    float pre = 0.f;
#pragma unroll
    for (int J = 0; J < 4; ++J) if (J < I) pre += tj[J];
    const float epre = __expf(pre); float kei[16];
#pragma unroll
    for (int i = 0; i < 16; ++i) { const float e = __expf(cl[i]); QT[(16 * I + i) * HST + lane] = (bf16)f2bf(qv[i] * e); QD[(16 * I + i) * HST + lane] = (bf16)f2bf(qv[i] * e * epre); kei[i] = kk[i] * fminf(__builtin_amdgcn_rcpf(e), 5.5e34f); }
    float eoff = 0.f;
#pragma unroll
    for (int I2 = 0; I2 < 4; ++I2) {
        if (I2 >= I) {
            if (I2 == I) eoff = 0.f; else if (I2 == I + 1) eoff = run; else eoff += tj[I2 - 1];
            LAS bf16* blk = KT + (I2 * (I2 + 1) / 2 + I) * 16 * HST;
            const float fo = __expf(eoff);
#pragma unroll
            for (int i = 0; i < 16; ++i) blk[i * HST + lane] = (bf16)f2bf(kei[i] * fo);
        }
    }
    __syncthreads();
    float z0 = 0.f; asm volatile("" : "+v"(z0));
    f32x4 sc[4];
#pragma unroll
    for (int J = 0; J < 4; ++J) { sc[J] = (f32x4){z0, z0, z0, z0};
        if (J <= I) { const LAS bf16* kb = KT + (I * (I + 1) / 2 + J) * 16 * HST;
            sc[J] = mma16(QT + 16 * I * HST, kb, 0, sc[J], lane); sc[J] = mma16(QT + 16 * I * HST, kb, 32, sc[J], lane);
            if (J == I) {
#pragma unroll
                for (int r = 0; r < 4; ++r) if ((lane & 15) > 4 * (lane >> 4) + r) sc[J][r] = z0; } } }
#pragma unroll
    for (int J = 0; J < 4; ++J)
#pragma unroll
        for (int r = 0; r < 4; ++r) AS[(4 * (lane >> 4) + r) * HST + 16 * J + (lane & 15)] = (bf16)f2bf(sc[J][r]);
    asm volatile("s_waitcnt lgkmcnt(0)" ::: "memory");
    f32x4 acc[4];
#pragma unroll
    for (int vb = 0; vb < 4; ++vb) { acc[vb] = (f32x4){z0, z0, z0, z0};
        acc[vb] = mma16(AS, VT + 16 * vb * HST, 0, acc[vb], lane); acc[vb] = mma16(AS, VT + 16 * vb * HST, 32, acc[vb], lane);
        acc[vb] = mma16(QD + 16 * I * HST, ST + 16 * vb * HST, 0, acc[vb], lane); acc[vb] = mma16(QD + 16 * I * HST, ST + 16 * vb * HST, 32, acc[vb], lane); }
    __syncthreads();
#pragma unroll
    for (int vb = 0; vb < 4; ++vb)
#pragma unroll
        for (int r = 0; r < 4; ++r) { const int n = 16 * I + 4 * (lane >> 4) + r, rl = dir ? 63 - n : n; OS[(dir * 64 + rl) * 68 + 16 * vb + (lane & 15)] = acc[vb][r]; }
    __syncthreads();
    { const int rl = tid >> 3, v8 = (tid & 7) * 8, row = base + rl;
      float o[8]; float ss = 0.f;
#pragma unroll
      for (int j = 0; j < 8; ++j) { o[j] = OS[rl * 68 + v8 + j] + OS[(64 + rl) * 68 + v8 + j]; ss += o[j] * o[j]; }
      ss += sx<1>(ss); ss += sx<2>(ss); ss += sx<4>(ss);
      const float rstd = __builtin_amdgcn_rsqf(ss * (1.0f / 64.0f) + EPS);
      float gt[8]; unpack8(*(const GAS v4u*)(PROJ + (size_t)row * INW + COL_HG + head * 64 + v8), gt);
      const float* gn = a->in[I_HGAIN] + l * 64 + v8;
      float y[8];
#pragma unroll
      for (int j = 0; j < 8; ++j) y[j] = o[j] * rstd * gn[j] * silu1(gt[j]);
      v4u w; w.x = pk2(y[0], y[1]); w.y = pk2(y[2], y[3]); w.z = pk2(y[4], y[5]); w.w = pk2(y[6], y[7]);
      *(GAS v4u*)(MIX + (size_t)row * DM + MIX_HG + head * 64 + v8) = w; }
    __syncthreads();
}

__device__ __forceinline__ void vt_item(KA a, int item, int lane) {
    const bf16* PROJ = (const bf16*)(a->ws + WS_PROJ); bf16* VTg = (bf16*)(a->ws + WS_VT);
    const int rb = item >> 1, hk = item & 1, row = rb * 64 + lane;
    const bf16* p = PROJ + (size_t)row * INW + COL_AV + hk * 64;
    unsigned w[32];
#pragma unroll
    for (int c = 0; c < 8; ++c) { const v4u t = *(const GAS v4u*)(p + 8 * c); w[4 * c] = t.x; w[4 * c + 1] = t.y; w[4 * c + 2] = t.z; w[4 * c + 3] = t.w; }
    bf16* o = VTg + (size_t)hk * 64 * R_ALL + row;
#pragma unroll
    for (int d2 = 0; d2 < 32; ++d2) { o[(size_t)(2 * d2) * R_ALL] = (bf16)(w[d2] & 0xffffu); o[(size_t)(2 * d2 + 1) * R_ALL] = (bf16)(w[d2] >> 16); }
}
__device__ __forceinline__ void attn_unit(KA a, int l, int u, LAS unsigned char* lds, int tid, int lane, int wave) {
    asm volatile("" : "+v"(tid), "+v"(lane));
    const bf16* PROJ = (const bf16*)(a->ws + WS_PROJ); const bf16* VTg = (const bf16*)(a->ws + WS_VT); bf16* MIX = (bf16*)(a->ws + WS_MIX);
    const bool isctx = u >= 256; const int uu = isctx ? u - 256 : u; const int n = uu >> 1, hk = uu & 1;
    const int qh = hk * 4 + (wave >> 1), half = wave & 1;
    const int qbase = (isctx ? S_LAT : 0) + n * 128 + half * 64, qpos0 = n * 128 + half * 64;
    const int c = lane & 15, g = lane >> 4;
    LAS bf16* Kt = (LAS bf16*)lds; LAS bf16* Vt = Kt + 64 * HST; LAS bf16* Qw = Vt + 64 * HST + wave * 64 * HST;
#pragma unroll
    for (int j = 0; j < 8; ++j) { const int qr = 8 * j + (lane >> 3), qc = (lane & 7) * 8;
        *(LAS v4u*)(Qw + qr * HST + qc) = *(const GAS v4u*)(PROJ + (size_t)(qbase + qr) * INW + qh * 64 + qc); }
    float z0 = 0.f; asm volatile("" : "+v"(z0));
    f32x4 o[4][4]; float ls[4];
    const float nbnd = ((const float*)(a->ws + WS_VEC))[VO_NBND + l];
    const f32x4 nb4 = {nbnd, nbnd, nbnd, nbnd};
    const float sink = a->in[I_SINK][l * 8 + qh] * 1.4426950408889634f;
#pragma unroll
    for (int qt = 0; qt < 4; ++qt) { ls[qt] = (g == 0) ? __builtin_amdgcn_exp2f(sink + nbnd) : z0;
#pragma unroll
        for (int dt = 0; dt < 4; ++dt) o[qt][dt] = (f32x4){z0, z0, z0, z0}; }
    const int first = (!isctx && n == 0) ? 2 : 0, nwin = isctx ? 0 : ((n == 0 || n == 127) ? 4 : 6), nt = nwin + 4;
    const int lr = tid >> 3, lc = (tid & 7) * 8;
    v4u kreg, vreg;
#define ATT_LOADT(i) do { const bool ct_ = (i) >= nwin; const int kb_ = ct_ ? S_LAT + 64 * ((i) - nwin) : (n - 1) * 128 + 64 * (first + (i)); \
        kreg = *(const GAS v4u*)(PROJ + (size_t)(kb_ + lr) * INW + COL_AK + hk * 64 + lc); vreg = *(const GAS v4u*)(VTg + ((size_t)hk * 64 + lr) * R_ALL + kb_ + lc); } while (0)
    ATT_LOADT(0);
#pragma unroll 1
    for (int i = 0; i < nt; ++i) {
        __syncthreads();
        *(LAS v4u*)(Kt + lr * HST + lc) = kreg; *(LAS v4u*)(Vt + lr * HST + lc) = vreg;
        __syncthreads();
        if (i + 1 < nt) ATT_LOADT(i + 1);
        const bool win = i < nwin; const int kb = (n - 1) * 128 + 64 * (first + i);
        const int rel = kb - qpos0;
        const bool maskw = win && (rel == 128 || rel == -128);
        if (win && (rel >= 192 || rel <= -192)) continue;
        bf16x8v kf[4][2], vf[4][2];
#pragma unroll
        for (int kt = 0; kt < 4; ++kt)
#pragma unroll
            for (int ks = 0; ks < 2; ++ks) kf[kt][ks] = *(const LAS bf16x8v*)(Kt + (16 * kt + c) * HST + 32 * ks + 8 * g);
#pragma unroll
        for (int dt = 0; dt < 4; ++dt)
#pragma unroll
            for (int s2 = 0; s2 < 2; ++s2) { const v2u lo = *(const LAS v2u*)(Vt + (16 * dt + c) * HST + 32 * s2 + 4 * g), hi = *(const LAS v2u*)(Vt + (16 * dt + c) * HST + 32 * s2 + 16 + 4 * g);
                const v4u t = {lo.x, lo.y, hi.x, hi.y}; vf[dt][s2] = __builtin_bit_cast(bf16x8v, t); }
        f32x4 sA[4], sB[4];
#define ATT_SCORES(QT, S_) do { const bf16x8v q0_ = *(const LAS bf16x8v*)(Qw + (16 * (QT) + c) * HST + 8 * g), q1_ = *(const LAS bf16x8v*)(Qw + (16 * (QT) + c) * HST + 32 + 8 * g); \
            _Pragma("unroll") for (int kt = 0; kt < 4; ++kt) { S_[kt] = __builtin_amdgcn_mfma_f32_16x16x32_bf16(kf[kt][0], q0_, nb4, 0, 0, 0); S_[kt] = __builtin_amdgcn_mfma_f32_16x16x32_bf16(kf[kt][1], q1_, S_[kt], 0, 0, 0); } } while (0)
#define ATT_REST(QT, S_) do { \
            if (maskw) { const int dq = qpos0 + 16 * (QT) + c - kb - 4 * g; \
                _Pragma("unroll") for (int kt = 0; kt < 4; ++kt) _Pragma("unroll") for (int r = 0; r < 4; ++r) { const int dl = dq - 16 * kt - r; if (dl > 128 || dl < -128) S_[kt][r] = -INFINITY; } } \
            float ps = 0.f; \
            _Pragma("unroll") for (int kt = 0; kt < 4; ++kt) _Pragma("unroll") for (int r = 0; r < 4; ++r) { S_[kt][r] = __builtin_amdgcn_exp2f(S_[kt][r]); ps += S_[kt][r]; } \
            ls[QT] += ps; \
            bf16x8v pb[2]; \
            _Pragma("unroll") for (int s2 = 0; s2 < 2; ++s2) { const v4u t = {pk2(S_[2 * s2][0], S_[2 * s2][1]), pk2(S_[2 * s2][2], S_[2 * s2][3]), pk2(S_[2 * s2 + 1][0], S_[2 * s2 + 1][1]), pk2(S_[2 * s2 + 1][2], S_[2 * s2 + 1][3])}; pb[s2] = __builtin_bit_cast(bf16x8v, t); } \
            _Pragma("unroll") for (int dt = 0; dt < 4; ++dt) { o[QT][dt] = __builtin_amdgcn_mfma_f32_16x16x32_bf16(vf[dt][0], pb[0], o[QT][dt], 0, 0, 0); o[QT][dt] = __builtin_amdgcn_mfma_f32_16x16x32_bf16(vf[dt][1], pb[1], o[QT][dt], 0, 0, 0); } } while (0)
        ATT_SCORES(0, sA);
        ATT_SCORES(1, sB); ATT_REST(0, sA);
        ATT_SCORES(2, sA); ATT_REST(1, sB);
        ATT_SCORES(3, sB); ATT_REST(2, sA);
        ATT_REST(3, sB);
#undef ATT_SCORES
#undef ATT_REST
    }
#undef ATT_LOADT
    int c2 = lane & 15, g2 = lane >> 4; asm volatile("" : "+v"(c2), "+v"(g2));
#pragma unroll
    for (int qt = 0; qt < 4; ++qt) { float lt = ls[qt]; lt += sx<16>(lt); lt = sx32_add(lt); const float inv = 1.0f / lt;
        bf16* op = (bf16*)(a->ws + WS_MIX) + (size_t)(qbase + 16 * qt + c2) * DM + MIX_AT + qh * 64 + 4 * g2;
#pragma unroll
        for (int dt = 0; dt < 4; ++dt) { v2u w; w.x = pk2(o[qt][dt][0] * inv, o[qt][dt][1] * inv); w.y = pk2(o[qt][dt][2] * inv, o[qt][dt][3] * inv); *(GAS v2u*)(op + 16 * dt) = w; } }
}

constexpr int GST = 136;
__device__ __forceinline__ f32x4 mma16g(const LAS bf16* MA, const LAS bf16* MBt, int k0, f32x4 c, int lane) {
    const bf16x8v av = *(const LAS bf16x8v*)(MA + (lane & 15) * GST + k0 + 8 * (lane >> 4));
    const bf16x8v bv = *(const LAS bf16x8v*)(MBt + (lane & 15) * GST + k0 + 8 * (lane >> 4));
    return __builtin_amdgcn_mfma_f32_16x16x32_bf16(av, bv, c, 0, 0, 0);
}
__device__ __forceinline__ float gelu_as(float v) {
    const float av = fabsf(v), t = __builtin_amdgcn_rcpf(av * 0.2316418882f + 1.0f);
    float q = t * 0.5307027145f + (-0.7265760135f); q = q * t + 0.7107068705f; q = q * t + (-0.142248368f); q = q * t + 0.127414796f; q = q * t;
    const float e = __builtin_amdgcn_exp2f((v * v) * (-0.72134752044f)), mm = v * (q * e);
    return v < 0.f ? mm : v - mm;
}
__device__ __forceinline__ void gmlp_unit_mma(KA a, int l, int chunk, int g, LAS unsigned char* lds, int tid, int lane, int wave) {
    const bf16* PROJ = (const bf16*)(a->ws + WS_PROJ); bf16* MIX = (bf16*)(a->ws + WS_MIX);
    const int row0 = (chunk < 128) ? chunk * 128 : S_LAT + (chunk - 128) * 128;
    LAS bf16* WA = (LAS bf16*)lds;
    LAS bf16* VNT = WA + 128 * GST;
    LAS float* OUT = (LAS float*)(VNT + 64 * GST);
    const int pos = tid >> 2, part = tid & 3;
    {
      const float* W = a->in[I_GWS] + ((size_t)(l * 4 + g) * 128 + pos) * 128 + part * 32;
#pragma unroll
      for (int j = 0; j < 4; ++j) { const f32x4 w0 = *(const GAS f32x4*)(W + 8 * j), w1 = *(const GAS f32x4*)(W + 8 * j + 4);
          v4u o; o.x = pk2(w0.x, w0.y); o.y = pk2(w0.z, w0.w); o.z = pk2(w1.x, w1.y); o.w = pk2(w1.z, w1.w);
          *(LAS v4u*)(WA + pos * GST + part * 32 + 8 * j) = o; } }
    { const bf16* p = PROJ + (size_t)(row0 + pos) * INW + COL_GV + g * 64 + part * 16;
      float x[16]; unpack8(*(const GAS v4u*)p, x); unpack8(*(const GAS v4u*)(p + 8), x + 8);
      float ss = 0.f;
#pragma unroll
      for (int d = 0; d < 16; ++d) { x[d] = gelu_as(x[d]); ss += x[d] * x[d]; }
      ss += sx<1>(ss); ss += sx<2>(ss);
      const float rstd = __builtin_amdgcn_rsqf(ss * (1.0f / 64.0f) + EPS);
      const float* gn = a->in[I_GNG] + l * 256 + g * 64 + part * 16;
#pragma unroll
      for (int d = 0; d < 16; ++d) VNT[(part * 16 + d) * GST + pos] = (bf16)f2bf(x[d] * rstd * gn[d]); }
    __syncthreads();
    float z0 = 0.f; asm volatile("" : "+v"(z0));
#pragma unroll
    for (int cb = 0; cb < 4; ++cb) { f32x4 acc = {z0, z0, z0, z0};
#pragma unroll
        for (int ks = 0; ks < 4; ++ks) acc = mma16g(WA + 16 * wave * GST, VNT + 16 * cb * GST, 32 * ks, acc, lane);
#pragma unroll
        for (int r = 0; r < 4; ++r) OUT[(16 * wave + 4 * (lane >> 4) + r) * 68 + 16 * cb + (lane & 15)] = acc[r]; }
    __syncthreads();
    { const int row = row0 + pos; const float bsv = a->in[I_GBS][(l * 4 + g) * 128 + pos];
      const bf16* pu = PROJ + (size_t)row * INW + COL_GU + g * 64 + part * 16;
      float u[16]; unpack8(*(const GAS v4u*)pu, u); unpack8(*(const GAS v4u*)(pu + 8), u + 8);
      float y[16];
#pragma unroll
      for (int d = 0; d < 16; ++d) y[d] = gelu_as(u[d]) * (OUT[pos * 68 + part * 16 + d] + bsv);
      bf16* po = MIX + (size_t)row * DM + MIX_GM + g * 64 + part * 16;
      v4u w; w.x = pk2(y[0], y[1]); w.y = pk2(y[2], y[3]); w.z = pk2(y[4], y[5]); w.w = pk2(y[6], y[7]); *(GAS v4u*)po = w;
      w.x = pk2(y[8], y[9]); w.y = pk2(y[10], y[11]); w.z = pk2(y[12], y[13]); w.w = pk2(y[14], y[15]); *(GAS v4u*)(po + 8) = w; }
    __syncthreads();
}
__device__ __forceinline__ void attn_naive(KA a, int l, int nrows, int lane, int wave, int G, int bid) {
    const bf16* PROJ = (const bf16*)(a->ws + WS_PROJ); bf16* MIX = (bf16*)(a->ws + WS_MIX);
    const int gw = bid * NWAVES + wave, NGW = G * NWAVES;
    for (int pair = gw; pair < nrows * 2; pair += NGW) {
        const int row = pair >> 1, hk = pair & 1; const bool isctx = row >= S_LAT;
        float q[4], o[4], m[4], ls[4];
#pragma unroll
        for (int g = 0; g < 4; ++g) { q[g] = bflo((unsigned)PROJ[(size_t)row * INW + (hk * 4 + g) * 64 + lane]); o[g] = 0.f; ls[g] = 1.0f; m[g] = a->in[I_SINK][l * 8 + hk * 4 + g] * 1.4426950408889634f; }
        int j0 = 0, j1 = -1;
        if (!isctx) { j0 = row - 128 < 0 ? 0 : row - 128; j1 = row + 128 > S_LAT - 1 ? S_LAT - 1 : row + 128; }
        const int nwin = j1 - j0 + 1;
        const int nk = nwin + C_CTX;
#pragma unroll 4
        for (int t = 0; t < nk; ++t) {
            const int krow = (t < nwin) ? j0 + t : S_LAT + (t - nwin);
            const float k = bflo((unsigned)PROJ[(size_t)krow * INW + COL_AK + hk * 64 + lane]);
            const float v = bflo((unsigned)PROJ[(size_t)krow * INW + COL_AV + hk * 64 + lane]);
#pragma unroll
            for (int g = 0; g < 4; ++g) { const float s = wave_sum_dpp(q[g] * k); const float mn = fmaxf(m[g], s);
                const float c = __builtin_amdgcn_exp2f(m[g] - mn), p = __builtin_amdgcn_exp2f(s - mn);
                ls[g] = ls[g] * c + p; o[g] = o[g] * c + p * v; m[g] = mn; }
        }
#pragma unroll
        for (int g = 0; g < 4; ++g) MIX[(size_t)row * DM + MIX_AT + (hk * 4 + g) * 64 + lane] = (bf16)f2bf(o[g] / ls[g]);
    }
}
__device__ __forceinline__ void hgrn_combine(KA a, int l, int nrows, int lane, int wave, int G, int bid) {
    const bf16* PROJ = (const bf16*)(a->ws + WS_PROJ); bf16* MIX = (bf16*)(a->ws + WS_MIX);
    const float* O0 = (const float*)(a->ws + WS_HGO); const float* O1 = O0 + (size_t)R_ALL * 256;
    const f32x4 gn = *(const f32x4*)(a->in[I_HGAIN] + l * 64 + (lane & 15) * 4);
    const int gw = bid * NWAVES + wave, NGW = G * NWAVES;
    for (int r = gw; r < nrows; r += NGW) {
        const f32x4 o = *(const GAS f32x4*)(O0 + (size_t)r * 256 + 4 * lane) + *(const GAS f32x4*)(O1 + (size_t)r * 256 + 4 * lane);
        float ss = (o.x * o.x + o.y * o.y) + (o.z * o.z + o.w * o.w);
        ss += sx<1>(ss); ss += sx<2>(ss); ss += sx<4>(ss); ss += sx<8>(ss);
        const float rstd = __builtin_amdgcn_rsqf(ss * (1.0f / 64.0f) + EPS);
        const v2u gw2 = *(const GAS v2u*)(PROJ + (size_t)r * INW + COL_HG + 4 * lane);
        const float g0 = bflo(gw2.x), g1 = bfhi(gw2.x), g2 = bflo(gw2.y), g3 = bfhi(gw2.y);
        v2u w; w.x = pk2(o.x * rstd * gn.x * silu1(g0), o.y * rstd * gn.y * silu1(g1)); w.y = pk2(o.z * rstd * gn.z * silu1(g2), o.w * rstd * gn.w * silu1(g3));
        *(GAS v2u*)(MIX + (size_t)r * DM + MIX_HG + 4 * lane) = w;
    }
}
__device__ __forceinline__ void moe_gather(KA a, LAS unsigned char* lds, int tid, int lane, int wave, int G, int bid) {
    LAS int* sb = (LAS int*)lds;
    const unsigned* cnt = (const unsigned*)(a->ws + WS_CTL) + CW_MOECNT;
    int* mi = (int*)(a->ws + WS_VEC) + VO_MOE;
    if (tid < 8) sb[16 + tid] = (int)__hip_atomic_load(cnt + 64 * tid, RLX_AGENT);
    __syncthreads();
    if (tid == 0) { int b = 0;
#pragma unroll
        for (int e = 0; e < 8; ++e) { sb[e] = b; b += ((sb[16 + e] + 255) >> 8) << 8; }
        sb[8] = b; }
    __syncthreads();
    if (bid == 0) {
        if (tid == 0) mi[0] = sb[8] >> 8;
        if (tid < 8) mi[160 + tid] = sb[tid + 1] >> 8;
        for (int t = tid; t < (sb[8] >> 8); t += NTHR) { int e = 0;
#pragma unroll
            for (int j = 1; j < 8; ++j) e += (t >= (sb[j] >> 8)) ? 1 : 0;
            mi[16 + t] = e; } }
    unsigned char* AS = (unsigned char*)(a->ws + WS_AS);
    const int* tokinfo = (const int*)(a->ws + WS_TOK); int* tokslot = (int*)(a->ws + WS_TOK) + S_LAT * 8;
    const int gw = bid * NWAVES + wave, NGW = G * NWAVES;
    int kq = 0;
    for (int t = gw; t < S_LAT; t += NGW, ++kq) {
        const int* ti = tokinfo + (size_t)t * 8;
        const int e1 = ti[0], e2 = ti[1], r1 = ti[2], r2 = ti[3];
        const int s1 = sb[e1] + r1, s2 = sb[e2] + r2;
        const v4u x0 = ((const LAS v4u*)(lds + ROUTE_ROWS_OFF + wave * 8192 + kq * 1024))[lane];
        ((GAS v4u*)(AS + (size_t)s1 * DM))[lane] = x0; ((GAS v4u*)(AS + (size_t)s2 * DM))[lane] = x0;
        if (lane == 0) { int* ts = tokslot + (size_t)t * 4; ts[0] = s1; ts[1] = s2; ts[2] = ti[4]; ts[3] = ti[5]; }
    }
    { const f32x4 z4 = {0.f, 0.f, 0.f, 0.f}; for (int i = bid * NTHR + tid; i < 8 * 256 * DM / 4; i += G * NTHR) ((GAS f32x4*)(a->ws + WS_YF))[i] = z4; }
    for (int e = 0; e < 8; ++e) { const int c = sb[16 + e], pe = (c + 255) & ~255, b = sb[e];
        for (int j = c + gw; j < pe; j += NGW) { const v4u z = {0u, 0u, 0u, 0u}; ((GAS v4u*)(AS + (size_t)(b + j) * DM))[lane] = z; } }
}
__device__ __forceinline__ void moe_combine(KA a, int lane, int wave, int G, int bid) {
    const float* gf = (const float*)(a->ws + WS_VEC) + VO_MOD + (1 * 2 + 0) * 6144 + 5 * 1024;
    const bf16* Y = (const bf16*)(a->ws + WS_Y); const int* tokslot = (const int*)(a->ws + WS_TOK) + S_LAT * 8; const float* YF = (const float*)(a->ws + WS_YF);
    const int gw = bid * NWAVES + wave, NGW = G * NWAVES;
    f32x4 gl[4];
#pragma unroll
    for (int j = 0; j < 4; ++j) gl[j] = *(const f32x4*)(gf + 4 * lane + 256 * j);
    int n0 = 0, n1 = 0, n2 = 0, n3 = 0;
    if (gw < S_LAT) { const int* ts = tokslot + (size_t)gw * 4; n0 = ts[0]; n1 = ts[1]; n2 = ts[2]; n3 = ts[3]; }
    for (int t = gw; t < S_LAT; t += NGW) {
        const int s1 = n0, s2 = n1; const float w1 = __builtin_bit_cast(float, n2), w2 = __builtin_bit_cast(float, n3);
        if (t + NGW < S_LAT) { const int* ts = tokslot + (size_t)(t + NGW) * 4; n0 = ts[0]; n1 = ts[1]; n2 = ts[2]; n3 = ts[3]; }
        GAS f32x4* xr = (GAS f32x4*)(a->out + (size_t)t * DM) + lane; const GAS v2u* xbr = (const GAS v2u*)((const bf16*)(a->ws + WS_XB) + (size_t)t * DM) + lane;
        v2u xt[4]; f32x4 p[4], q[4];
#pragma unroll
        for (int j = 0; j < 4; ++j) xt[j] = xbr[64 * j];
        if (s1 < 32768) { const GAS v2u* yr = (const GAS v2u*)(Y + (size_t)s1 * DM) + lane; v2u u[4];
#pragma unroll
            for (int j = 0; j < 4; ++j) u[j] = yr[64 * j];
#pragma unroll
            for (int j = 0; j < 4; ++j) p[j] = (f32x4){bflo(u[j].x), bfhi(u[j].x), bflo(u[j].y), bfhi(u[j].y)}; }
        else { const GAS f32x4* yr = (const GAS f32x4*)(YF + (size_t)(s1 - 32768) * DM) + lane;
#pragma unroll
            for (int j = 0; j < 4; ++j) p[j] = yr[64 * j]; }
        if (s2 < 32768) { const GAS v2u* yr = (const GAS v2u*)(Y + (size_t)s2 * DM) + lane; v2u u[4];
#pragma unroll
            for (int j = 0; j < 4; ++j) u[j] = yr[64 * j];
#pragma unroll
            for (int j = 0; j < 4; ++j) q[j] = (f32x4){bflo(u[j].x), bfhi(u[j].x), bflo(u[j].y), bfhi(u[j].y)}; }
        else { const GAS f32x4* yr = (const GAS f32x4*)(YF + (size_t)(s2 - 32768) * DM) + lane;
#pragma unroll
            for (int j = 0; j < 4; ++j) q[j] = yr[64 * j]; }
#pragma unroll
        for (int j = 0; j < 4; ++j) { f32x4 x = (f32x4){bflo(xt[j].x), bfhi(xt[j].x), bflo(xt[j].y), bfhi(xt[j].y)};
            x = x + gl[j] * (p[j] * w1 + q[j] * w2);
            __builtin_nontemporal_store(x, (f32x4*)(xr + 64 * j)); }
    }
}

#define IN(k) (lo <= (k) && (k) < hi)
#define GRIDBAR() do { XcdBarrier b2_; b2_.bar = (unsigned*)(KARGS()->ws + WS_CTL) + CW_BAR; b2_.x = xb_xcc_id(); b2_.st = (volatile LAS unsigned*)(lds + MISC_OFF) + 8; xcd_barrier(b2_, wv0 * 64 + (int)__builtin_amdgcn_mbcnt_hi(~0u, __builtin_amdgcn_mbcnt_lo(~0u, 0u))); } while (0)
#define SEAM(k) do { if (IN(k) && IN((k) + 1)) GRIDBAR(); } while (0)
#define PHASE_ROOTS() KA a = KARGS(); unsigned char* ws = a->ws; const float* vec = (const float*)(ws + WS_VEC); (void)vec; int bid = blockIdx.x, G = gridDim.x; asm volatile("" : "+s"(bid), "+s"(G)); int tid = wv0 * 64 + (int)__builtin_amdgcn_mbcnt_hi(~0u, __builtin_amdgcn_mbcnt_lo(~0u, 0u)); asm volatile("" : "+v"(tid)); const int lane = tid & 63, wave = __builtin_amdgcn_readfirstlane(tid >> 6); (void)lane; (void)wave

template <int l> __device__ __forceinline__ void layer_body(const int lo, const int hi, LAS unsigned char* lds, const int wv0) {
        const int pb = 1 + 11 * l;
        if (IN(pb + 0)) { PHASE_ROOTS(); phase_norm(a, l, 0, R_ALL, (bf16*)(ws + WS_H), lane, wave, G, bid); SEAM(pb + 0); }
        if (IN(pb + 1)) {
            PHASE_ROOTS();
            pg8::Gemm g{(const pg8::bf16_t*)(ws + WS_H), (const pg8::bf16_t*)(ws + WS_WIN) + (size_t)l * INW * DM, R_ALL, INW, DM, 0, DM};
            pg8::StaticOrder S; S.init(R_ALL, INW, G, bid);
            pg8::EpiBf16<0> E{(pg8::bf16_t*)(ws + WS_PROJ), INW, nullptr, 0, 0, 1.f};
            pg8::gemm_phase<pg8::EpiBf16<0>, pg8::StaticOrder, true, true>(lds, g, S, E, tid);
            moe_conv_range(a, l == 0 ? MOE_SL0 : MOE_SL2, l == 0 ? MOE_SL1 : MOE_SL3, 650 - 2 * 256, lds, lane, wave, G, bid);
            SEAM(pb + 1);
        }
        if (IN(pb + 2)) {
            PHASE_ROOTS();
            qk_prep(a, l, (G - 1 - bid) * NTHR + tid, G * NTHR);
            for (int it = ((bid + G - 80) % G) * NWAVES + wave; it < 520; it += G * NWAVES) vt_item(a, it, lane);
            for (int it = bid; it < 1040; it += G) hgrn_stepA(a, l, it >> 2, it & 3, lds, lane, wave);
            { __syncthreads(); moe_conv_range(a, l == 0 ? MOE_SL3 : MOE_SL7, l == 0 ? MOE_SL4 : MOE_DEFER, 1040 - 4 * 256, lds, lane, wave, G, bid); }
            SEAM(pb + 2);
        }
        if (IN(pb + 3)) {
            PHASE_ROOTS();
            if (bid < 64) hgrn_stepB(a, bid, tid);
            {
                const int nu = (l == 0) ? 260 : 256, ng = (l == 0) ? 520 : 512;
                unsigned* qctr = (unsigned*)(ws + WS_CTL) + CW_QUEUE + 64 * l;
                volatile LAS unsigned* qslot = (volatile LAS unsigned*)(lds + MISC_OFF) + 16;
                for (;;) {
                    __syncthreads();
                    if (tid == 0) qslot[0] = __hip_atomic_fetch_add(qctr, 1u, RLX_AGENT);
                    __syncthreads();
                    const int it = __builtin_amdgcn_readfirstlane((int)qslot[0]);
                    if (it >= nu + ng) break;
                    if (it < nu) attn_unit(a, l, it, lds, tid, lane, wave);
                    else gmlp_unit_mma(a, l, (it - nu) >> 2, (it - nu) & 3, lds, tid, lane, wave);
                }
            }
            SEAM(pb + 3);
        }
        if (IN(pb + 4)) {
            PHASE_ROOTS();
            const int nit = (l == 0) ? 1040 : 1024;
            for (int it = bid; it < nit; it += G) hgrn_stepC(a, l, it >> 2, it & 3, lds, tid, lane, wave);
            if (l == 0) { __syncthreads(); moe_conv_range(a, MOE_SL4, MOE_SL5, 1040 - 4 * 256, lds, lane, wave, G, bid); }
            SEAM(pb + 4);
        }
        if (IN(pb + 5)) {
            PHASE_ROOTS();
            const float* modl = vec + VO_MOD + (l * 2 + 0) * 6144; const float* modc = vec + VO_MOD + (l * 2 + 1) * 6144;
            const int M = S_LAT;
            pg8::Gemm g{(const pg8::bf16_t*)(ws + WS_MIX), (const pg8::bf16_t*)(ws + WS_WOUT) + (size_t)l * DM * DM, M, DM, DM, 0, DM};
            pg8::StaticOrder S; S.init(M, DM, G, bid);
            if (l == 0) { pg8::EpiResidB<false> E{a->in[I_X], (pg8::bf16_t*)(ws + WS_XB), modl + 2048, DM};
                pg8::gemm_phase<pg8::EpiResidB<false>, pg8::StaticOrder, true, true>(lds, g, S, E, tid); }
            else { pg8::EpiResidB<true> E{ws + WS_XB, (pg8::bf16_t*)(ws + WS_XB), modl + 2048, DM};
                pg8::gemm_phase<pg8::EpiResidB<true>, pg8::StaticOrder, true, true>(lds, g, S, E, tid); }
            if (l == 0) {
                pg8::Gemm g2{(const pg8::bf16_t*)(ws + WS_MIX), (const pg8::bf16_t*)(ws + WS_WOUT), R_ALL, DM, 256, 0, DM};
                pg8::SplitKOrder S2{S_LAT / 256, 4, 4, 256, 16, bid, nullptr};
                pg8::EpiPart E2{(float*)(ws + WS_PART1), modc + 2048, S_LAT / 256, 256, DM};
                pg8::gemm_phase<pg8::EpiPart, pg8::SplitKOrder, false, true>(lds, g2, S2, E2, tid);
                moe_conv_range(a, MOE_SL5, MOE_SL6, 16, lds, lane, wave, G, bid);
            }
            SEAM(pb + 5);
        }
        if (l == 0) {
            if (IN(pb + 6)) { PHASE_ROOTS(); phase_norm(a, l, 1, R_ALL, (bf16*)(ws + WS_H), lane, wave, G, bid); SEAM(pb + 6); }
            if (IN(pb + 7)) {
                PHASE_ROOTS();
                pg8::Gemm g{(const pg8::bf16_t*)(ws + WS_H), (const pg8::bf16_t*)(ws + WS_WGU), R_ALL, 2 * FFN, DM, 0, DM};
                pg8::StaticOrder S; S.init(R_ALL, 2 * FFN, G, bid);
                pg8::EpiSwiGLU E{(pg8::bf16_t*)(ws + WS_HID), FFN, 1.0f};
                pg8::gemm_phase<pg8::EpiSwiGLU, pg8::StaticOrder, true, true>(lds, g, S, E, tid);
                moe_conv_range(a, MOE_SL1, MOE_SL2, 1430 - 5 * 256, lds, lane, wave, G, bid);
                SEAM(pb + 7);
            }
            if (IN(pb + 8)) {
                PHASE_ROOTS();
                const float* modl = vec + VO_MOD + (l * 2 + 0) * 6144; const float* modc = vec + VO_MOD + (l * 2 + 1) * 6144;
                pg8::Gemm g{(const pg8::bf16_t*)(ws + WS_HID), (const pg8::bf16_t*)(ws + WS_WD), S_LAT, DM, FFN, 0, FFN};
                pg8::StaticOrder S; S.init(S_LAT, DM, G, bid);
                pg8::EpiResidB<true> E{ws + WS_XB, (pg8::bf16_t*)(ws + WS_XB), modl + 5120, DM};
                pg8::gemm_phase<pg8::EpiResidB<true>, pg8::StaticOrder, true, true>(lds, g, S, E, tid);
                {
                    pg8::Gemm g2{(const pg8::bf16_t*)(ws + WS_HID), (const pg8::bf16_t*)(ws + WS_WD), R_ALL, DM, 256, 0, FFN};
                    pg8::SplitKOrder S2{S_LAT / 256, 4, 11, 256, 44, bid, nullptr};
                    pg8::EpiPart E2{(float*)(ws + WS_PART2), modc + 5120, S_LAT / 256, 256, DM};
                    pg8::gemm_phase<pg8::EpiPart, pg8::SplitKOrder, false, true>(lds, g2, S2, E2, tid);
                    moe_conv_range(a, MOE_SL6, MOE_SL7, 44, lds, lane, wave, G, bid);
                }
                if (IN(pb + 8) && IN(pb + 11)) GRIDBAR();
            }
        } else {
            if (IN(pb + 6)) { PHASE_ROOTS(); phase_norm_route(a, lds, tid, lane, wave, G, bid); SEAM(pb + 6); }
            if (IN(pb + 7)) { PHASE_ROOTS(); moe_gather(a, lds, tid, lane, wave, G, bid); SEAM(pb + 7); }
            if (IN(pb + 8)) {
                PHASE_ROOTS();
                const int* mi = (const int*)(ws + WS_VEC) + VO_MOE; const int nt = __builtin_amdgcn_readfirstlane(mi[0]);
                pg8::Gemm g{(const pg8::bf16_t*)(ws + WS_AS), (const pg8::bf16_t*)(ws + WS_MGU), nt * 256, 2 * EXD, DM / 2, (size_t)2 * EXD * DM, DM / 2};
                pg8::MoeOrder S; S.init(nt * 256, 2 * EXD, G, bid); S.load_bases(mi + 160);
                pg8::EpiSwiGLU8 E{(unsigned char*)(ws + WS_HIDM), EXD, 1.0f / (F8_WSCALE * F8_ASCALE), F8_HSCALE};
                pg8::gemm_phase<pg8::EpiSwiGLU8, pg8::MoeOrder, true, true, true>(lds, g, S, E, tid);
                SEAM(pb + 8);
            }
            if (IN(pb + 9)) {
                PHASE_ROOTS();
                const int* mi = (const int*)(ws + WS_VEC) + VO_MOE; const int nt = __builtin_amdgcn_readfirstlane(mi[0]); const int nm = nt < 128 ? nt : 128;
                pg8::Gemm g{(const pg8::bf16_t*)(ws + WS_HIDM), (const pg8::bf16_t*)(ws + WS_MD), nm * 256, DM, EXD / 2, (size_t)DM * EXD, EXD / 2};
                pg8::MoeOrder S; S.init(nm * 256, DM, G, bid); S.load_bases(mi + 160);
                pg8::EpiScaleBf16 E{(pg8::bf16_t*)(ws + WS_Y), DM, 1.0f / (F8_WSCALE * F8_HSCALE)};
                pg8::gemm_phase<pg8::EpiScaleBf16, pg8::MoeOrder, true, true, true>(lds, g, S, E, tid);
                if (nt > 128) {
                    pg8::Gemm g2{(const pg8::bf16_t*)(ws + WS_HIDM), (const pg8::bf16_t*)(ws + WS_MD), nt * 256, DM, 256, (size_t)DM * EXD, EXD / 2};
                    pg8::SplitKOrder S2{128, 4, 7, 256, (nt - 128) * 28, bid, mi + 16};
                    pg8::EpiAtomic E2{(float*)(ws + WS_YF), nullptr, 128, DM, 1.0f / (F8_WSCALE * F8_HSCALE)};
                    pg8::gemm_phase<pg8::EpiAtomic, pg8::SplitKOrder, false, true, true>(lds, g2, S2, E2, tid);
                }
                SEAM(pb + 9);
            }
            if (IN(pb + 10)) { PHASE_ROOTS(); moe_combine(a, lane, wave, G, bid); }
        }
    }
__global__ void __launch_bounds__(NTHR, 2) fwd_kernel(Args a_unused) {
    extern __shared__ __attribute__((aligned(16))) unsigned char lds_raw[];
    LAS unsigned char* lds = (LAS unsigned char*)lds_raw;
    const int tid0 = threadIdx.x;
    const int wv0 = __builtin_amdgcn_readfirstlane(tid0 >> 6);
    for (int u = tid0; u < (LDS_BYTES - LDSCTL_OFF) / 4; u += NTHR) ((LAS unsigned*)(lds + LDSCTL_OFF))[u] = 0u;
    __syncthreads();
    const int lo = KARGS()->ph_lo, hi = KARGS()->ph_hi;
    const bool fusedl = (hi - lo) > 1;
    if (fusedl) (void)xcd_barrier_post((unsigned*)(KARGS()->ws + WS_CTL) + CW_BAR, (volatile LAS unsigned*)(lds + MISC_OFF) + 8);
    if (IN(0)) { PHASE_ROOTS(); p0_prologue(a, lds, tid, lane, wave, G, bid); SEAM(0); }

    layer_body<0>(lo, hi, lds, wv0);
    layer_body<1>(lo, hi, lds, wv0);
}

extern "C" void kernel_launch(void* const* d_in, const int* in_sizes, int n_in, void* d_out, int out_size, void* d_ws, size_t ws_size, hipStream_t stream) {
    static int grid = 0;
    if (grid == 0) {
        if (n_in != 23 || in_sizes[0] != S_LAT * DM || out_size != S_LAT * DM || ws_size < WS_END) { fprintf(stderr, "kernel_launch: unexpected shapes / workspace (n_in %d, ws %zu, need %zu)\n", n_in, ws_size, (size_t)WS_END); grid = -1; return; }
        int dev = 0, cus = 0;
        if (hipGetDevice(&dev) != hipSuccess || hipDeviceGetAttribute(&cus, hipDeviceAttributeMultiprocessorCount, dev) != hipSuccess) { grid = -1; return; }
        if (hipFuncSetAttribute((const void*)fwd_kernel, hipFuncAttributeMaxDynamicSharedMemorySize, LDS_BYTES) != hipSuccess) { grid = -1; return; }
        int per_cu = 0;
        (void)hipOccupancyMaxActiveBlocksPerMultiprocessor(&per_cu, (const void*)fwd_kernel, NTHR, LDS_BYTES);
        (void)hipGetLastError();
        if (cus * NWAVES * 8 < S_LAT) { fprintf(stderr, "kernel_launch: needs at least %d compute units\n", S_LAT / (NWAVES * 8)); grid = -1; return; }
        grid = cus;
    }
    if (grid < 0) return;
    if (hipMemsetAsync((char*)d_ws + WS_CTL, 0, CTL_ZERO_BYTES, stream) != hipSuccess) return;
    Args a{};
    for (int i = 0; i < 23; ++i) a.in[i] = (const float*)d_in[i];
    a.out = (float*)d_out; a.ws = (unsigned char*)d_ws;
#if ONE_LAUNCH
    a.ph_lo = 0; a.ph_hi = NPH;
    hipLaunchKernelGGL(fwd_kernel, dim3(grid), dim3(NTHR), LDS_BYTES, stream, a);
#else
    for (int p = 0; p < NPH; ++p) {
        if (p == 10 || p == 11) continue;
        a.ph_lo = p; a.ph_hi = p + 1;
        hipLaunchKernelGGL(fwd_kernel, dim3(grid), dim3(NTHR), LDS_BYTES, stream, a);
    }
#endif
}
```

```cpp
#include <hip/hip_runtime.h>
#include <cstdio>
#include <cstdint>
#include <cmath>
#ifndef ONE_LAUNCH
#define ONE_LAUNCH 1
#endif
namespace pg8 {
#define PG8_LAS __attribute__((address_space(3)))
typedef unsigned short bf16_t;
typedef short bf16x8 __attribute__((ext_vector_type(8)));
typedef float f32x4 __attribute__((ext_vector_type(4)));
typedef unsigned u32x4 __attribute__((ext_vector_type(4)));
constexpr int BM = 256, BK = 64, HALF = 128, HTB = HALF * BK * 2  , STAGE_BYTES = 8 * HTB, NXCD = 8, WGM = 8;

__host__ __device__ __forceinline__ int lds_byte(int r, int c) { const int st = (r >> 4) * 2 + (c >> 5), rr = r & 15, cc = c & 31, ob = rr * 64 + cc * 2; return st * 1024 + (ob ^ (((ob >> 9) & 1) << 5)); }
__host__ __device__ __forceinline__ void stage_rc(int b, int& R, int& C) { const int st = b / 1024, sb = b % 1024, swz = sb ^ (((sb >> 9) & 1) << 5); R = (st >> 1) * 16 + swz / 64; C = (st & 1) * 32 + (swz % 64) / 2; }
__host__ __device__ __forceinline__ int perm32(int rho) { const int n = rho >> 4, i = rho & 15; return 8 * (i >> 2) + 4 * n + (i & 3); }

struct Unit { int pm, pn, eb, ko; };
struct Gemm { const bf16_t* A; const bf16_t* Bt; int M, N, K; size_t bstride; int ld; };

struct StaticOrder {
    int nM, nN, nwg, G, c;
    __host__ __device__ void init(int M, int N, int G_, int c_) { nM = M / BM; nN = N / BM; nwg = nM * nN; G = G_; c = c_; }
    __host__ __device__ bool next(int i, Unit& u) const {
        const long L = (long)i * G + c; if (L >= nwg) return false;
        int wgid = (int)L; { const int q = nwg / NXCD, r = nwg % NXCD, xcd = wgid % NXCD, off = wgid / NXCD; wgid = (xcd < r ? xcd * (q + 1) : r * (q + 1) + (xcd - r) * q) + off; }
        const int nig = WGM * nN, gid = wgid / nig, fm = gid * WGM, gsz = (nM - fm) < WGM ? (nM - fm) : WGM;
        u.pm = fm + ((wgid % nig) % gsz); u.pn = (wgid % nig) / gsz; u.eb = 0; u.ko = 0; return true;
    }
    __device__ __forceinline__ void a_ready(const Unit&) const {}
    __device__ __forceinline__ void done(const Unit&) const {}
};

__device__ __forceinline__ unsigned cvt_pk_bf16(float lo, float hi) { unsigned r; asm volatile("v_cvt_pk_bf16_f32 %0, %1, %2" : "=v"(r) : "v"(lo), "v"(hi)); return r; }
typedef float f32x2 __attribute__((ext_vector_type(2)));
__device__ __forceinline__ f32x2 gelu_pk(f32x2 v) {
    const f32x2 av = __builtin_elementwise_abs(v), d = av * 0.2316418882f + 1.0f;
    f32x2 t; t.x = __builtin_amdgcn_rcpf(d.x); t.y = __builtin_amdgcn_rcpf(d.y);
    f32x2 q = t * 0.5307027145f + (-0.7265760135f); q = q * t + 0.7107068705f; q = q * t + (-0.142248368f); q = q * t + 0.127414796f; q = q * t;
    const f32x2 s = (v * v) * (-0.72134752044f);
    f32x2 e; e.x = __builtin_amdgcn_exp2f(s.x); e.y = __builtin_amdgcn_exp2f(s.y);
    const f32x2 m = v * (q * e), r = v - m;
    f32x2 o; o.x = v.x < 0.f ? m.x : r.x; o.y = v.y < 0.f ? m.y : r.y; return o;
}

template <int ACT  > struct EpiBf16 {
    static constexpr bool PERM = true, AFTER_DRAIN = false; static_assert(ACT == 0 || ACT == 1, "EpiBf16: ACT is 0 (none) or 1 (gelu_pk)");
    bf16_t* O; int ldc; const float* bias; int split_cols; size_t split_stride; float scale0;
    __device__ __forceinline__ void operator()(const f32x4 (&acc)[2][2][4][2], const Unit& u, int wr, int wc, int fr, int fq) const {
        const int row0 = u.pm * BM + wr * 64 + fr; int colt = u.pn * BM; bf16_t* base = O;
        float sc = 1.f; if (split_cols) { const int t = colt / split_cols; base += (size_t)t * split_stride; colt -= t * split_cols; if (t == 0) sc = scale0; }
        const int col0 = colt + wc * 32 + 8 * fq, bcol0 = u.pn * BM + wc * 32 + 8 * fq;
        f32x4 bv[2][2];
#pragma unroll
        for (int bj = 0; bj < 2; ++bj)
#pragma unroll
            for (int n = 0; n < 2; ++n) bv[bj][n] = bias ? *(const f32x4*)(bias + bcol0 + bj * HALF + 4 * n) : (f32x4){0.f, 0.f, 0.f, 0.f};
#pragma unroll
        for (int ai = 0; ai < 2; ++ai)
#pragma unroll
            for (int m = 0; m < 4; ++m) { bf16_t* rowp = base + (size_t)(row0 + ai * HALF + m * 16) * ldc + col0;
#pragma unroll
                for (int bj = 0; bj < 2; ++bj) { f32x4 v0 = acc[ai][bj][m][0] + bv[bj][0], v1 = acc[ai][bj][m][1] + bv[bj][1];
                    if (ACT == 1) { f32x2 a = gelu_pk((f32x2){v0[0], v0[1]}), b = gelu_pk((f32x2){v0[2], v0[3]}), c = gelu_pk((f32x2){v1[0], v1[1]}), d = gelu_pk((f32x2){v1[2], v1[3]});
                        v0 = (f32x4){a.x, a.y, b.x, b.y}; v1 = (f32x4){c.x, c.y, d.x, d.y}; }
                    v0 = v0 * sc; v1 = v1 * sc; u32x4 w; w.x = cvt_pk_bf16(v0[0], v0[1]); w.y = cvt_pk_bf16(v0[2], v0[3]); w.z = cvt_pk_bf16(v1[0], v1[1]); w.w = cvt_pk_bf16(v1[2], v1[3]);
                    *(u32x4*)(rowp + bj * HALF) = w; } }
    }
};

__device__ __forceinline__ float silu_f(float x) { return x * __builtin_amdgcn_rcpf(1.0f + __builtin_amdgcn_exp2f(-1.4426950408889634f * x)); }
struct EpiResid {
    static constexpr bool PERM = false, AFTER_DRAIN = false;
    const float* base; float* out; const float* gate; const float* cbase; float* cout; const float* cgate; int mlat; int ldc;
    __device__ __forceinline__ void operator()(const f32x4 (&acc)[2][2][4][2], const Unit& u, int wr, int wc, int fr, int fq) const {
        const bool isc = u.pm >= mlat;
        const float* b = isc ? cbase : base; float* o = isc ? cout : out; const float* g = isc ? cgate : gate;
        const int row0 = (isc ? (u.pm - mlat) : u.pm) * BM + wr * 64 + fr, col0 = u.pn * BM + wc * 32 + 4 * fq;
        f32x4 gv[2][2];
#pragma unroll
        for (int bj = 0; bj < 2; ++bj)
#pragma unroll
            for (int n = 0; n < 2; ++n) gv[bj][n] = *(const f32x4*)(g + col0 + bj * HALF + n * 16);
#pragma unroll
        for (int ai = 0; ai < 2; ++ai)
#pragma unroll
            for (int m = 0; m < 4; ++m) { const size_t off = (size_t)(row0 + ai * HALF + m * 16) * ldc + col0;
#pragma unroll
                for (int bj = 0; bj < 2; ++bj)
#pragma unroll
                    for (int n = 0; n < 2; ++n) { const f32x4 bs = *(const f32x4*)(b + off + bj * HALF + n * 16); *(f32x4*)(o + off + bj * HALF + n * 16) = bs + gv[bj][n] * acc[ai][bj][m][n]; }
                if (m & 1) asm volatile("" ::: "memory"); }
    }
};
template <bool BFB> struct EpiResidB {
    static constexpr bool PERM = true, AFTER_DRAIN = false;
    const void* base; bf16_t* out; const float* gate; int ldc;
    __device__ __forceinline__ void operator()(const f32x4 (&acc)[2][2][4][2], const Unit& u, int wr, int wc, int fr, int fq) const {
        const int row0 = u.pm * BM + wr * 64 + fr, col0 = u.pn * BM + wc * 32 + 8 * fq;
        f32x4 gv[2][2];
#pragma unroll
        for (int bj = 0; bj < 2; ++bj)
#pragma unroll
            for (int n = 0; n < 2; ++n) gv[bj][n] = *(const f32x4*)(gate + col0 + bj * HALF + 4 * n);
#pragma unroll
        for (int ai = 0; ai < 2; ++ai)
#pragma unroll
            for (int m = 0; m < 4; ++m) { const size_t off = (size_t)(row0 + ai * HALF + m * 16) * ldc + col0;
#pragma unroll
                for (int bj = 0; bj < 2; ++bj) { f32x4 b0, b1;
                    if constexpr (BFB) { const u32x4 t = *(const u32x4*)((const bf16_t*)base + off + bj * HALF);
                        b0 = (f32x4){__builtin_bit_cast(float, t.x << 16), __builtin_bit_cast(float, t.x & 0xffff0000u), __builtin_bit_cast(float, t.y << 16), __builtin_bit_cast(float, t.y & 0xffff0000u)};
                        b1 = (f32x4){__builtin_bit_cast(float, t.z << 16), __builtin_bit_cast(float, t.z & 0xffff0000u), __builtin_bit_cast(float, t.w << 16), __builtin_bit_cast(float, t.w & 0xffff0000u)}; }
                    else { b0 = *(const f32x4*)((const float*)base + off + bj * HALF); b1 = *(const f32x4*)((const float*)base + off + bj * HALF + 4); }
                    const f32x4 v0 = b0 + gv[bj][0] * acc[ai][bj][m][0], v1 = b1 + gv[bj][1] * acc[ai][bj][m][1];
                    u32x4 w; w.x = cvt_pk_bf16(v0[0], v0[1]); w.y = cvt_pk_bf16(v0[2], v0[3]); w.z = cvt_pk_bf16(v1[0], v1[1]); w.w = cvt_pk_bf16(v1[2], v1[3]);
                    *(u32x4*)(out + off + bj * HALF) = w; }
                if (m & 1) asm volatile("" ::: "memory"); }
    }
};
struct EpiSwiGLU {
    static constexpr bool PERM = true, AFTER_DRAIN = false;
    bf16_t* O; int ldc; float ds;
    __device__ __forceinline__ void operator()(const f32x4 (&acc)[2][2][4][2], const Unit& u, int wr, int wc, int fr, int fq) const {
        const int row0 = u.pm * BM + wr * 64 + fr, col0 = u.pn * HALF + wc * 32 + 8 * fq;
#pragma unroll
        for (int ai = 0; ai < 2; ++ai)
#pragma unroll
            for (int m = 0; m < 4; ++m) { bf16_t* rowp = O + (size_t)(row0 + ai * HALF + m * 16) * ldc + col0;
                const f32x4 g0 = acc[ai][0][m][0] * ds, g1 = acc[ai][0][m][1] * ds, u0 = acc[ai][1][m][0] * ds, u1 = acc[ai][1][m][1] * ds;
                f32x4 h0, h1;
#pragma unroll
                for (int j = 0; j < 4; ++j) { h0[j] = (g0[j] * u0[j]) * __builtin_amdgcn_rcpf(1.0f + __builtin_amdgcn_exp2f(g0[j])); h1[j] = (g1[j] * u1[j]) * __builtin_amdgcn_rcpf(1.0f + __builtin_amdgcn_exp2f(g1[j])); }
                u32x4 w; w.x = cvt_pk_bf16(h0[0], h0[1]); w.y = cvt_pk_bf16(h0[2], h0[3]); w.z = cvt_pk_bf16(h1[0], h1[1]); w.w = cvt_pk_bf16(h1[2], h1[3]);
                *(u32x4*)rowp = w; }
    }
};
struct MoeOrder : StaticOrder {
    int tb[8];
    __device__ __forceinline__ void load_bases(const int* mi) {
#pragma unroll
        for (int e = 0; e < 8; ++e) tb[e] = __builtin_amdgcn_readfirstlane(mi[e]); }
    __device__ __forceinline__ int expert_of(int pm) const { int e = 0;
#pragma unroll
        for (int j = 0; j < 7; ++j) e += (pm >= tb[j]) ? 1 : 0;
        return e; }
    __device__ __forceinline__ bool next(int i, Unit& u) const { if (!StaticOrder::next(i, u)) return false; u.eb = expert_of(u.pm); return true; }
};

struct SplitKOrder {
    int pm0, nN, P, kp, total, c; const int* tile_e;
    __device__ __forceinline__ bool next(int i, Unit& u) const {
        if (i != 0 || c >= total) return false;
        const int p = c % P, t = c / P; u.pn = t % nN; u.pm = pm0 + t / nN; u.ko = p * kp; u.eb = tile_e ? __builtin_amdgcn_readfirstlane(tile_e[u.pm]) : 0; return true; }
    __device__ __forceinline__ void a_ready(const Unit&) const {}
    __device__ __forceinline__ void done(const Unit&) const {}
};
struct EpiPart {
    static constexpr bool PERM = false, AFTER_DRAIN = false;
    float* part; const float* scale; int pm_sub; int kp; int ldc;
    __device__ __forceinline__ void operator()(const f32x4 (&acc)[2][2][4][2], const Unit& u, int wr, int wc, int fr, int fq) const {
        float* o = part + (size_t)(u.ko / kp) * BM * ldc;
        const int row0 = (u.pm - pm_sub) * BM + wr * 64 + fr, col0 = u.pn * BM + wc * 32 + 4 * fq;
        f32x4 gv[2][2];
#pragma unroll
        for (int bj = 0; bj < 2; ++bj)
#pragma unroll
            for (int n = 0; n < 2; ++n) gv[bj][n] = *(const f32x4*)(scale + col0 + bj * HALF + n * 16);
#pragma unroll
        for (int ai = 0; ai < 2; ++ai)
#pragma unroll
            for (int m = 0; m < 4; ++m) { const size_t off = (size_t)(row0 + ai * HALF + m * 16) * ldc + col0;
#pragma unroll
                for (int bj = 0; bj < 2; ++bj)
#pragma unroll
                    for (int n = 0; n < 2; ++n) *(f32x4*)(o + off + bj * HALF + n * 16) = gv[bj][n] * acc[ai][bj][m][n]; }
    }
};
struct EpiAtomic {
    static constexpr bool PERM = false, AFTER_DRAIN = true; static constexpr unsigned SCW0 = 0x7f7f7f7fu, SCW1 = 0x7f7f7f7fu, SCA = 0x7f7f7f7fu;
    float* out; const float* scale; int pm_sub; int ldc; float ds;
    __device__ __forceinline__ void fused(f32x4 (&acc)[2][2][4][2], const Unit& u, int wr, int wc, int fr, int fq, PG8_LAS unsigned char* lds, int wid, int lane) const {
        PG8_LAS float* scr = (PG8_LAS float*)(lds + wid * 16384);
        const int rr = lane >> 5, cc = lane & 31;
#pragma unroll
        for (int ai = 0; ai < 2; ++ai)
#pragma unroll
            for (int bj = 0; bj < 2; ++bj) {
#pragma unroll
                for (int m = 0; m < 4; ++m)
#pragma unroll
                    for (int n = 0; n < 2; ++n) *(PG8_LAS f32x4*)(scr + (m * 16 + fr) * 36 + n * 16 + 4 * fq) = acc[ai][bj][m][n];
                asm volatile("s_waitcnt lgkmcnt(0)" ::: "memory");
                const int colg = u.pn * BM + bj * HALF + wc * 32 + cc; const float sc = (scale ? scale[colg] : 1.0f) * ds;
                float* op = out + (size_t)((u.pm - pm_sub) * BM + ai * HALF + wr * 64 + rr) * ldc + colg;
#pragma unroll 8
                for (int i = 0; i < 32; ++i) { const float v = scr[(2 * i + rr) * 36 + cc]; __hip_atomic_fetch_add(op + (size_t)(2 * i) * ldc, v * sc, __ATOMIC_RELAXED, __HIP_MEMORY_SCOPE_AGENT); }
                asm volatile("s_waitcnt lgkmcnt(0)" ::: "memory");
            }
    }
};

typedef int i32x4v __attribute__((ext_vector_type(4))); typedef int i32x8v __attribute__((ext_vector_type(8)));
struct FragB { bf16x8 k[2]; };
struct Frag8 { i32x8v v; };
template <bool F8> struct FragSel { typedef FragB type; };
template <> struct FragSel<true> { typedef Frag8 type; };
__device__ __forceinline__ void ld_frag(FragB& f, const PG8_LAS unsigned char* p) { f.k[0] = *(const PG8_LAS bf16x8*)p; f.k[1] = *(const PG8_LAS bf16x8*)(p + 1024); }
__device__ __forceinline__ void ld_frag(Frag8& f, const PG8_LAS unsigned char* p) { const i32x4v lo = *(const PG8_LAS i32x4v*)p, hi = *(const PG8_LAS i32x4v*)(p + 1024); f.v = __builtin_shufflevector(lo, hi, 0, 1, 2, 3, 4, 5, 6, 7); }
__device__ __forceinline__ f32x4 mma_frag(const FragB& b, const FragB& a, f32x4 c) { c = __builtin_amdgcn_mfma_f32_16x16x32_bf16(b.k[0], a.k[0], c, 0, 0, 0); return __builtin_amdgcn_mfma_f32_16x16x32_bf16(b.k[1], a.k[1], c, 0, 0, 0); }
__device__ __forceinline__ f32x4 mma_frag(const Frag8& b, const Frag8& a, f32x4 c) {
    asm volatile("v_mfma_scale_f32_16x16x128_f8f6f4 %0, %1, %2, %0, %3, %3 op_sel_hi:[0,0,0]" : "+v"(c) : "v"(b.v), "v"(a.v), "v"(0x7f7f7f7f));
    return c;
}
template <class Epi, int BJ> __device__ __forceinline__ f32x4 mma_frag_s(const FragB& b, const FragB& a, f32x4 c) { return mma_frag(b, a, c); }
template <class Epi, int BJ> __device__ __forceinline__ f32x4 mma_frag_s(const Frag8& b, const Frag8& a, f32x4 c) {
    asm volatile("v_mfma_scale_f32_16x16x128_f8f6f4 %0, %1, %2, %0, %3, %4 op_sel_hi:[0,0,0]" : "+v"(c) : "v"(b.v), "v"(a.v), "v"(BJ ? Epi::SCW1 : Epi::SCW0), "v"(Epi::SCA));
    return c;
}

struct EpiSwiGLU8 {
    static constexpr bool PERM = true, AFTER_DRAIN = false;
    static constexpr unsigned SCW0 = 0x78787878u, SCW1 = 0x7b7b7b7bu, SCA = 0x7b7b7b7bu;
    unsigned char* O; int ldc; float ds, hs;
    __device__ __forceinline__ void operator()(const f32x4 (&acc)[2][2][4][2], const Unit& u, int wr, int wc, int fr, int fq) const {
        const int row0 = u.pm * BM + wr * 64 + fr, col0 = u.pn * HALF + wc * 32 + 8 * fq;
#pragma unroll
        for (int ai = 0; ai < 2; ++ai)
#pragma unroll
            for (int m = 0; m < 4; ++m) { unsigned char* rowp = O + (size_t)(row0 + ai * HALF + m * 16) * ldc + col0;
                const f32x4 g0 = acc[ai][0][m][0], g1 = acc[ai][0][m][1], u0 = acc[ai][1][m][0], u1 = acc[ai][1][m][1];
                float h[8];
#pragma unroll
                for (int j = 0; j < 4; ++j) {
                    h[j] = __builtin_amdgcn_fmed3f((g0[j] * u0[j]) * __builtin_amdgcn_rcpf(1.0f + __builtin_amdgcn_exp2f(g0[j])), -448.0f, 448.0f);
                    h[4 + j] = __builtin_amdgcn_fmed3f((g1[j] * u1[j]) * __builtin_amdgcn_rcpf(1.0f + __builtin_amdgcn_exp2f(g1[j])), -448.0f, 448.0f); }
                unsigned lo = 0u, hi = 0u;
                lo = __builtin_amdgcn_cvt_pk_fp8_f32(h[0], h[1], lo, false); lo = __builtin_amdgcn_cvt_pk_fp8_f32(h[2], h[3], lo, true);
                hi = __builtin_amdgcn_cvt_pk_fp8_f32(h[4], h[5], hi, false); hi = __builtin_amdgcn_cvt_pk_fp8_f32(h[6], h[7], hi, true);
                typedef unsigned u32x2 __attribute__((ext_vector_type(2)));
                *(u32x2*)rowp = (u32x2){lo, hi}; }
    }
};
struct EpiScaleBf16 {
    static constexpr bool PERM = true, AFTER_DRAIN = false; static constexpr unsigned SCW0 = 0x7f7f7f7fu, SCW1 = 0x7f7f7f7fu, SCA = 0x7f7f7f7fu;
    bf16_t* O; int ldc; float ds;
    __device__ __forceinline__ void operator()(const f32x4 (&acc)[2][2][4][2], const Unit& u, int wr, int wc, int fr, int fq) const {
        const int row0 = u.pm * BM + wr * 64 + fr, col0 = u.pn * BM + wc * 32 + 8 * fq;
#pragma unroll
        for (int ai = 0; ai < 2; ++ai)
#pragma unroll
            for (int m = 0; m < 4; ++m) { bf16_t* rowp = O + (size_t)(row0 + ai * HALF + m * 16) * ldc + col0;
#pragma unroll
                for (int bj = 0; bj < 2; ++bj) { const f32x4 v0 = acc[ai][bj][m][0] * ds, v1 = acc[ai][bj][m][1] * ds;
                    u32x4 w; w.x = cvt_pk_bf16(v0[0], v0[1]); w.y = cvt_pk_bf16(v0[2], v0[3]); w.z = cvt_pk_bf16(v1[0], v1[1]); w.w = cvt_pk_bf16(v1[2], v1[3]);
                    *(u32x4*)(rowp + bj * HALF) = w; } }
    }
};

template <class Epi, class Sched, bool ALIGN_EPI = false, bool SP2 = false, bool F8 = false>
__device__ __forceinline__ void gemm_phase(PG8_LAS unsigned char* lds, const Gemm g, const Sched& S, const Epi& E, int tid_in) {
    int tid_ = tid_in; asm volatile("" : "+v"(tid_));
    const int tid = tid_, wid = __builtin_amdgcn_readfirstlane(tid >> 6), lane = tid & 63, wr = wid >> 2, wc = wid & 3, fr = lane & 15, fq = lane >> 4;
    const int K = g.K, nt = K / BK, ld = g.ld;
    unsigned voffA[2], voffB[2];
#pragma unroll
    for (int i = 0; i < 2; ++i) { int R, C; stage_rc(tid * 16 + i * 8192, R, C); const int Rb = Epi::PERM ? ((R & ~31) + perm32(R & 31)) : R;
        voffA[i] = (unsigned)(R * ld + C) * 2u; voffB[i] = (unsigned)(Rb * ld + C) * 2u; }
    const size_t kstep = (size_t)(BK * 2);
    const size_t hstep = (size_t)HALF * ld * 2;
    const size_t tstep = 2 * hstep;
    const unsigned ldsw = (unsigned)wid * 1024u;
    const int aoff = lds_byte(wr * 64 + fr, fq * 8), boff = lds_byte(wc * 32 + fr, fq * 8);
#define PG8_SA(b, h) (((b) * 2 + (h)) * HTB)
#define PG8_SB(b, h) ((4 + (b) * 2 + (h)) * HTB)
#define PG8_STAGE(bufoff, gbase, voff) do { _Pragma("unroll") for (int _i = 0; _i < 2; ++_i) \
        __builtin_amdgcn_global_load_lds((const unsigned*)((const char*)(gbase) + (voff)[_i]), (PG8_LAS unsigned*)(lds + (bufoff) + ldsw + _i * 8192), 16, 0, 0); } while (0)
#define PG8_LDA(dst, b, h) do { _Pragma("unroll") for (int m = 0; m < 4; ++m) ld_frag(dst[m], lds + PG8_SA(b, h) + aoff + m * 2048); } while (0)
#define PG8_LDB(dst, b, h) do { _Pragma("unroll") for (int n = 0; n < 2; ++n) ld_frag(dst[n], lds + PG8_SB(b, h) + boff + n * 2048); } while (0)
#define PG8_MMA(ai, bj, At, Bt) do { __builtin_amdgcn_s_setprio(1); _Pragma("unroll") for (int m = 0; m < 4; ++m) _Pragma("unroll") for (int n = 0; n < 2; ++n) \
        acc[ai][bj][m][n] = mma_frag_s<Epi, bj>(Bt[n], At[m], acc[ai][bj][m][n]); __builtin_amdgcn_s_setprio(0); } while (0)
#define PG8_WAIT_V(n) asm volatile("s_waitcnt vmcnt(" #n ")" ::: "memory")
#define PG8_WAIT_L(n) asm volatile("s_waitcnt lgkmcnt(" #n ")" ::: "memory")
#define PG8_BAR __builtin_amdgcn_s_barrier()
#define PG8_SCHED __builtin_amdgcn_sched_barrier(0)
    Unit cur, nxt; int ui = 0;
    if (!S.next(0, cur)) return;
    float zacc = 0.f; asm volatile("" : "+v"(zacc));
    f32x4 acc[2][2][4][2];
#pragma unroll
    for (int a = 0; a < 2; ++a)
#pragma unroll
        for (int b = 0; b < 2; ++b)
#pragma unroll
            for (int m = 0; m < 4; ++m)
#pragma unroll
                for (int n = 0; n < 2; ++n) acc[a][b][m][n] = (f32x4){zacc, zacc, zacc, zacc};
    typedef typename FragSel<F8>::type Frag;
    Frag At[4], B0[2], B1[2];
    const char* cA = (const char*)g.A + (size_t)cur.pm * tstep + (size_t)cur.ko * 2; const char* cB = (const char*)g.Bt + (size_t)cur.eb * g.bstride + (size_t)cur.pn * tstep + (size_t)cur.ko * 2;
    S.a_ready(cur);
    if constexpr (SP2) {
        PG8_STAGE(PG8_SB(0, 0), cB, voffB); PG8_STAGE(PG8_SB(0, 1), cB + hstep, voffB); PG8_STAGE(PG8_SA(0, 0), cA, voffA); PG8_STAGE(PG8_SA(0, 1), cA + hstep, voffA);
        if (wr == 1) PG8_BAR;
        PG8_WAIT_V(2); PG8_BAR;
        PG8_STAGE(PG8_SB(1, 0), cB + kstep, voffB); PG8_STAGE(PG8_SA(1, 0), cA + kstep, voffA); PG8_STAGE(PG8_SB(1, 1), cB + hstep + kstep, voffB);
        PG8_WAIT_V(6); PG8_BAR;
    } else {
        PG8_STAGE(PG8_SB(0, 0), cB, voffB); PG8_STAGE(PG8_SA(0, 0), cA, voffA); PG8_STAGE(PG8_SB(0, 1), cB + hstep, voffB); PG8_STAGE(PG8_SA(0, 1), cA + hstep, voffA);
        if (wr == 1) PG8_BAR;
        PG8_WAIT_V(4); PG8_BAR;
        PG8_STAGE(PG8_SB(1, 0), cB + kstep, voffB); PG8_STAGE(PG8_SA(1, 0), cA + kstep, voffA); PG8_STAGE(PG8_SB(1, 1), cB + hstep + kstep, voffB);
        PG8_WAIT_V(6); PG8_BAR;
    }
    for (;;) {
        const bool has_next = S.next(ui + 1, nxt);
        const char* nA = has_next ? (const char*)g.A + (size_t)nxt.pm * tstep + (size_t)nxt.ko * 2 : cA; const char* nB = has_next ? (const char*)g.Bt + (size_t)nxt.eb * g.bstride + (size_t)nxt.pn * tstep + (size_t)nxt.ko * 2 : cB;
        for (int t = 0; t < nt; t += 2) {
            const bool last = (t == nt - 2);
            const char* a1 = cA + (size_t)(t + 1) * kstep;
            const char* a2 = last ? nA : cA + (size_t)(t + 2) * kstep; const char* b2 = last ? nB : cB + (size_t)(t + 2) * kstep;
            const char* a3 = a2 + kstep; const char* b3 = b2 + kstep;
            if (last && has_next) S.a_ready(nxt);
            if constexpr (SP2) {
            PG8_LDB(B0, 0, 0); PG8_LDB(B1, 0, 1); PG8_SCHED; PG8_LDA(At, 0, 0); PG8_STAGE(PG8_SA(1, 1), a1 + hstep, voffA);
            PG8_WAIT_V(8); PG8_WAIT_L(0); PG8_BAR; PG8_MMA(0, 0, At, B0); PG8_MMA(0, 1, At, B1); PG8_BAR; PG8_SCHED;
            PG8_LDA(At, 0, 1); PG8_STAGE(PG8_SB(0, 0), b2, voffB); PG8_STAGE(PG8_SB(0, 1), b2 + hstep, voffB); PG8_STAGE(PG8_SA(0, 0), a2, voffA);
            PG8_WAIT_V(8); PG8_WAIT_L(0); PG8_BAR; PG8_MMA(1, 0, At, B0); PG8_MMA(1, 1, At, B1); PG8_BAR; PG8_SCHED;
            PG8_LDB(B0, 1, 0); PG8_LDB(B1, 1, 1); PG8_SCHED; PG8_LDA(At, 1, 0); PG8_STAGE(PG8_SA(0, 1), a2 + hstep, voffA);
            PG8_WAIT_V(8); PG8_WAIT_L(0); PG8_BAR; PG8_MMA(0, 0, At, B0); PG8_MMA(0, 1, At, B1); PG8_BAR; PG8_SCHED;
            PG8_LDA(At, 1, 1); PG8_STAGE(PG8_SB(1, 0), b3, voffB); PG8_STAGE(PG8_SB(1, 1), b3 + hstep, voffB); PG8_STAGE(PG8_SA(1, 0), a3, voffA);
            PG8_WAIT_V(8); PG8_WAIT_L(0); PG8_BAR; PG8_MMA(1, 0, At, B0); PG8_MMA(1, 1, At, B1); PG8_BAR; PG8_SCHED;
            } else {
            PG8_LDB(B0, 0, 0); PG8_SCHED; PG8_LDA(At, 0, 0); PG8_STAGE(PG8_SA(1, 1), a1 + hstep, voffA);
            PG8_WAIT_L(8); PG8_BAR; PG8_WAIT_L(0); PG8_MMA(0, 0, At, B0); PG8_BAR; PG8_SCHED;
            PG8_LDB(B1, 0, 1); PG8_STAGE(PG8_SB(0, 0), b2, voffB);
            PG8_BAR; PG8_WAIT_L(0); PG8_MMA(0, 1, At, B1); PG8_BAR;
            PG8_LDA(At, 0, 1); PG8_STAGE(PG8_SA(0, 0), a2, voffA);
            PG8_BAR; PG8_WAIT_L(0); PG8_MMA(1, 0, At, B0); PG8_BAR; PG8_SCHED;
            PG8_STAGE(PG8_SB(0, 1), b2 + hstep, voffB);
            PG8_WAIT_V(6); PG8_BAR; PG8_MMA(1, 1, At, B1); PG8_BAR;
            PG8_LDB(B0, 1, 0); PG8_SCHED; PG8_LDA(At, 1, 0); PG8_STAGE(PG8_SA(0, 1), a2 + hstep, voffA);
            PG8_WAIT_L(8); PG8_BAR; PG8_WAIT_L(0); PG8_MMA(0, 0, At, B0); PG8_BAR; PG8_SCHED;
            PG8_LDB(B1, 1, 1); PG8_STAGE(PG8_SB(1, 0), b3, voffB);
            PG8_BAR; PG8_WAIT_L(0); PG8_MMA(0, 1, At, B1); PG8_BAR;
            PG8_LDA(At, 1, 1); PG8_STAGE(PG8_SA(1, 0), a3, voffA);
            PG8_BAR; PG8_WAIT_L(0); PG8_MMA(1, 0, At, B0); PG8_BAR; PG8_SCHED;
            PG8_STAGE(PG8_SB(1, 1), b3 + hstep, voffB);
            PG8_WAIT_V(6); PG8_BAR; PG8_MMA(1, 1, At, B1); PG8_BAR;
            }
        }
        if constexpr (ALIGN_EPI) { if (wr == 0) PG8_BAR; }
        if constexpr (F8) {
            asm volatile("s_nop 15\n\ts_nop 15" : "+v"(acc[1][1][0][0]), "+v"(acc[1][1][0][1]), "+v"(acc[1][1][1][0]), "+v"(acc[1][1][1][1]), "+v"(acc[1][1][2][0]), "+v"(acc[1][1][2][1]), "+v"(acc[1][1][3][0]), "+v"(acc[1][1][3][1])); }
        if constexpr (!Epi::AFTER_DRAIN) { E(acc, cur, wr, wc, fr, fq); S.done(cur); }
        if (!has_next) break;
#pragma unroll
        for (int a = 0; a < 2; ++a)
#pragma unroll
            for (int b = 0; b < 2; ++b)
#pragma unroll
                for (int m = 0; m < 4; ++m)
#pragma unroll
                    for (int n = 0; n < 2; ++n) acc[a][b][m][n] = (f32x4){zacc, zacc, zacc, zacc};
        cur = nxt; cA = nA; cB = nB; ++ui;
        if constexpr (ALIGN_EPI) { if (wr == 1) PG8_BAR; }
    }
    PG8_WAIT_V(0);
    if constexpr (!ALIGN_EPI) { if (wr == 0) PG8_BAR; }
    PG8_BAR;
    if constexpr (Epi::AFTER_DRAIN) { E.fused(acc, cur, wr, wc, fr, fq, lds, wid, lane); S.done(cur); }
#undef PG8_SA
#undef PG8_SB
#undef PG8_STAGE
#undef PG8_LDA
#undef PG8_LDB
#undef PG8_MMA
#undef PG8_WAIT_V
#undef PG8_WAIT_L
#undef PG8_BAR
#undef PG8_SCHED
}
}


constexpr int S_LAT = 16384, C_CTX = 256, R_ALL = S_LAT + C_CTX, DM = 1024;
constexpr int INW = 2560, FFN = 2816, EXD = 3584, NEXP = 8;
constexpr int COL_AQ = 0, COL_AK = 512, COL_AV = 640, COL_HQ = 768, COL_HFF = 1024, COL_HFB = 1280, COL_HI = 1536, COL_HG = 1792, COL_GU = 2048, COL_GV = 2304;
constexpr int MIX_AT = 0, MIX_HG = 512, MIX_GM = 768;
constexpr int MOE_MAXROWS = 34816;
constexpr float EPS = 1e-6f;
constexpr int NWAVES = 8, NTHR = 512;
constexpr int NPH = 23;

constexpr size_t MiB = 1u << 20;
constexpr size_t WS_CTL = 0, CTL_ZERO_BYTES = 32768;
constexpr size_t WS_VEC = 1 * MiB;
constexpr size_t WS_TOK = 2 * MiB;
constexpr size_t WS_WIN = 3 * MiB;
constexpr size_t WS_WOUT = 13 * MiB;
constexpr size_t WS_WGU = 17 * MiB;
constexpr size_t WS_WD = 28 * MiB;
constexpr size_t WS_MGU = 34 * MiB;
constexpr size_t WS_MD = 146 * MiB;
constexpr size_t WS_H = 202 * MiB;
constexpr size_t WS_PROJ = 235 * MiB;
constexpr size_t WS_MIX = 317 * MiB;
constexpr size_t WS_HGO = 350 * MiB;
constexpr size_t WS_CTXR = 383 * MiB;
constexpr size_t WS_HLT = WS_HGO;
constexpr size_t WS_HSP = 384 * MiB;
constexpr size_t WS_HDG = 402 * MiB;
constexpr size_t WS_VT = 403 * MiB;
constexpr size_t WS_HID = WS_PROJ;
constexpr size_t WS_AS = 202 * MiB;
constexpr size_t WS_HIDM = 270 * MiB;
constexpr size_t WS_H2B = 440 * MiB;
constexpr size_t WS_YF = WS_WIN;
constexpr size_t WS_Y = WS_MGU;
constexpr size_t WS_XB = 104 * MiB;
constexpr size_t WS_PART1 = 176 * MiB;
constexpr size_t WS_PART2 = 180 * MiB;
constexpr size_t WS_END = 508 * MiB;
static_assert(WS_HID + (size_t)R_ALL * FFN * 2 <= WS_HGO && WS_AS + (size_t)MOE_MAXROWS * DM * 2 <= WS_HIDM && WS_HIDM + (size_t)MOE_MAXROWS * EXD * 2 <= WS_END, "ws map");
static_assert(WS_PART1 >= WS_MD + (size_t)8 * DM * EXD && WS_PART1 + (size_t)4 * 256 * DM * 4 <= WS_PART2 && WS_PART2 + (size_t)11 * 256 * DM * 4 <= WS_H, "ws map 4");
static_assert(WS_XB >= WS_Y + (size_t)MOE_MAXROWS * DM * 2 && WS_XB >= WS_MGU + (size_t)8 * 2 * EXD * DM && WS_XB + (size_t)S_LAT * DM * 2 <= WS_MD, "ws map 3");
static_assert(WS_H2B >= WS_HIDM && WS_H2B + (size_t)S_LAT * DM * 2 <= WS_END && WS_H + (size_t)R_ALL * DM * 2 <= WS_PROJ && WS_PROJ + (size_t)R_ALL * INW * 2 <= WS_MIX && WS_MIX + (size_t)R_ALL * DM * 2 <= WS_HGO && WS_HGO + (size_t)2 * R_ALL * 256 * 4 <= WS_CTXR, "ws map 2");
constexpr int VO_MOD = 0;
constexpr int VO_ROPE = 32768;
constexpr int VO_NBND = 60000;
constexpr int VO_MOE = 65536;
constexpr int CW_BAR = 4096;
constexpr int CW_QUEUE = 2048;
constexpr int CW_MOECNT = 1024;

constexpr int RING_BYTES = 131072;
constexpr int LDSCTL_OFF = 159744, MISC_OFF = LDSCTL_OFF + 320;
constexpr int LDS_BYTES = 163840;

#define GAS __attribute__((address_space(1)))
#define LAS __attribute__((address_space(3)))
typedef unsigned short bf16;
typedef unsigned v4u __attribute__((ext_vector_type(4)));
typedef unsigned v2u __attribute__((ext_vector_type(2)));
typedef float f32x4 __attribute__((ext_vector_type(4)));
typedef GAS unsigned gu32;
#define RLX_AGENT __ATOMIC_RELAXED, __HIP_MEMORY_SCOPE_AGENT
#define LDS_WAIT() asm volatile("s_waitcnt lgkmcnt(0)" ::: "memory")
typedef float f32x2_t __attribute__((ext_vector_type(2))); typedef __bf16 bf16x2_t __attribute__((ext_vector_type(2)));
__device__ __forceinline__ unsigned pk2(float lo, float hi) { const f32x2_t v = {lo, hi}; const bf16x2_t b = __builtin_convertvector(v, bf16x2_t); return __builtin_bit_cast(unsigned, b); }
__device__ __forceinline__ unsigned f2bf(float f) { return pk2(f, 0.f) & 0xffffu; }
__device__ __forceinline__ float bflo(unsigned w) { return __builtin_bit_cast(float, w << 16); }
__device__ __forceinline__ float bfhi(unsigned w) { return __builtin_bit_cast(float, w & 0xffff0000u); }
__device__ __forceinline__ float sigm1(float x) { return __builtin_amdgcn_rcpf(1.0f + __builtin_amdgcn_exp2f(-1.4426950408889634f * x)); }
__device__ __forceinline__ float silu1(float x) { return x * sigm1(x); }
__device__ __forceinline__ float exp_hw(float x) { return __builtin_amdgcn_exp2f(x * 1.4426950408889634f); }
__device__ __forceinline__ float log_hw(float x) { return __builtin_amdgcn_logf(fmaxf(x, 1e-30f)) * 0.6931471805599453f; }
__device__ __forceinline__ float gelu1(float x) { return 0.5f * x * (1.0f + erff(x * 0.70710678118654752f)); }
template <int X> __device__ __forceinline__ float sx(float v) { return __shfl_xor(v, X); }
__device__ __forceinline__ float sx32_add(float v) { return v + __shfl_xor(v, 32); }
__device__ __forceinline__ float sx32_max(float v) { return fmaxf(v, __shfl_xor(v, 32)); }
__device__ __forceinline__ float wave_sum(float v) { v += sx<1>(v); v += sx<2>(v); v += sx<4>(v); v += sx<8>(v); v += sx<16>(v); return sx32_add(v); }
template <int CTRL, int RMASK> __device__ __forceinline__ float dpp_f(float v) { return __builtin_bit_cast(float, __builtin_amdgcn_update_dpp(0, __builtin_bit_cast(int, v), CTRL, RMASK, 0xF, false)); }
__device__ __forceinline__ float wave_sum_dpp(float v) {
    v += dpp_f<0xB1, 0xF>(v);
    v += dpp_f<0x4E, 0xF>(v);
    v += dpp_f<0x141, 0xF>(v);
    v += dpp_f<0x140, 0xF>(v);
    v += dpp_f<0x142, 0xA>(v);
    v += dpp_f<0x143, 0xC>(v);
    return __builtin_bit_cast(float, __builtin_amdgcn_readlane(__builtin_bit_cast(int, v), 63));
}
__device__ __forceinline__ float wave_sum_l63(float v) {
    v += dpp_f<0xB1, 0xF>(v); v += dpp_f<0x4E, 0xF>(v); v += dpp_f<0x141, 0xF>(v); v += dpp_f<0x140, 0xF>(v); v += dpp_f<0x142, 0xA>(v); v += dpp_f<0x143, 0xC>(v);
    return v;
}
__device__ __forceinline__ void wave_sum8_l63(float& a0, float& a1, float& a2, float& a3, float& a4, float& a5, float& a6, float& a7) {
    asm("s_nop 1\n\t"
        "v_add_f32_dpp %0, %0, %0 quad_perm:[1,0,3,2] row_mask:0xf bank_mask:0xf\n\t"
        "v_add_f32_dpp %1, %1, %1 quad_perm:[1,0,3,2] row_mask:0xf bank_mask:0xf\n\t"
        "v_add_f32_dpp %2, %2, %2 quad_perm:[1,0,3,2] row_mask:0xf bank_mask:0xf\n\t"
        "v_add_f32_dpp %3, %3, %3 quad_perm:[1,0,3,2] row_mask:0xf bank_mask:0xf\n\t"
        "v_add_f32_dpp %4, %4, %4 quad_perm:[1,0,3,2] row_mask:0xf bank_mask:0xf\n\t"
        "v_add_f32_dpp %5, %5, %5 quad_perm:[1,0,3,2] row_mask:0xf bank_mask:0xf\n\t"
        "v_add_f32_dpp %6, %6, %6 quad_perm:[1,0,3,2] row_mask:0xf bank_mask:0xf\n\t"
        "v_add_f32_dpp %7, %7, %7 quad_perm:[1,0,3,2] row_mask:0xf bank_mask:0xf\n\t"
        "v_add_f32_dpp %0, %0, %0 quad_perm:[2,3,0,1] row_mask:0xf bank_mask:0xf\n\t"
        "v_add_f32_dpp %1, %1, %1 quad_perm:[2,3,0,1] row_mask:0xf bank_mask:0xf\n\t"
        "v_add_f32_dpp %2, %2, %2 quad_perm:[2,3,0,1] row_mask:0xf bank_mask:0xf\n\t"
        "v_add_f32_dpp %3, %3, %3 quad_perm:[2,3,0,1] row_mask:0xf bank_mask:0xf\n\t"
        "v_add_f32_dpp %4, %4, %4 quad_perm:[2,3,0,1] row_mask:0xf bank_mask:0xf\n\t"
        "v_add_f32_dpp %5, %5, %5 quad_perm:[2,3,0,1] row_mask:0xf bank_mask:0xf\n\t"
        "v_add_f32_dpp %6, %6, %6 quad_perm:[2,3,0,1] row_mask:0xf bank_mask:0xf\n\t"
        "v_add_f32_dpp %7, %7, %7 quad_perm:[2,3,0,1] row_mask:0xf bank_mask:0xf\n\t"
        "v_add_f32_dpp %0, %0, %0 row_half_mirror row_mask:0xf bank_mask:0xf\n\t"
        "v_add_f32_dpp %1, %1, %1 row_half_mirror row_mask:0xf bank_mask:0xf\n\t"
        "v_add_f32_dpp %2, %2, %2 row_half_mirror row_mask:0xf bank_mask:0xf\n\t"
        "v_add_f32_dpp %3, %3, %3 row_half_mirror row_mask:0xf bank_mask:0xf\n\t"
        "v_add_f32_dpp %4, %4, %4 row_half_mirror row_mask:0xf bank_mask:0xf\n\t"
        "v_add_f32_dpp %5, %5, %5 row_half_mirror row_mask:0xf bank_mask:0xf\n\t"
        "v_add_f32_dpp %6, %6, %6 row_half_mirror row_mask:0xf bank_mask:0xf\n\t"
        "v_add_f32_dpp %7, %7, %7 row_half_mirror row_mask:0xf bank_mask:0xf\n\t"
        "v_add_f32_dpp %0, %0, %0 row_mirror row_mask:0xf bank_mask:0xf\n\t"
        "v_add_f32_dpp %1, %1, %1 row_mirror row_mask:0xf bank_mask:0xf\n\t"
        "v_add_f32_dpp %2, %2, %2 row_mirror row_mask:0xf bank_mask:0xf\n\t"
        "v_add_f32_dpp %3, %3, %3 row_mirror row_mask:0xf bank_mask:0xf\n\t"
        "v_add_f32_dpp %4, %4, %4 row_mirror row_mask:0xf bank_mask:0xf\n\t"
        "v_add_f32_dpp %5, %5, %5 row_mirror row_mask:0xf bank_mask:0xf\n\t"
        "v_add_f32_dpp %6, %6, %6 row_mirror row_mask:0xf bank_mask:0xf\n\t"
        "v_add_f32_dpp %7, %7, %7 row_mirror row_mask:0xf bank_mask:0xf\n\t"
        "v_add_f32_dpp %0, %0, %0 row_bcast:15 row_mask:0xa bank_mask:0xf\n\t"
        "v_add_f32_dpp %1, %1, %1 row_bcast:15 row_mask:0xa bank_mask:0xf\n\t"
        "v_add_f32_dpp %2, %2, %2 row_bcast:15 row_mask:0xa bank_mask:0xf\n\t"
        "v_add_f32_dpp %3, %3, %3 row_bcast:15 row_mask:0xa bank_mask:0xf\n\t"
        "v_add_f32_dpp %4, %4, %4 row_bcast:15 row_mask:0xa bank_mask:0xf\n\t"
        "v_add_f32_dpp %5, %5, %5 row_bcast:15 row_mask:0xa bank_mask:0xf\n\t"
        "v_add_f32_dpp %6, %6, %6 row_bcast:15 row_mask:0xa bank_mask:0xf\n\t"
        "v_add_f32_dpp %7, %7, %7 row_bcast:15 row_mask:0xa bank_mask:0xf\n\t"
        "v_add_f32_dpp %0, %0, %0 row_bcast:31 row_mask:0xc bank_mask:0xf\n\t"
        "v_add_f32_dpp %1, %1, %1 row_bcast:31 row_mask:0xc bank_mask:0xf\n\t"
        "v_add_f32_dpp %2, %2, %2 row_bcast:31 row_mask:0xc bank_mask:0xf\n\t"
        "v_add_f32_dpp %3, %3, %3 row_bcast:31 row_mask:0xc bank_mask:0xf\n\t"
        "v_add_f32_dpp %4, %4, %4 row_bcast:31 row_mask:0xc bank_mask:0xf\n\t"
        "v_add_f32_dpp %5, %5, %5 row_bcast:31 row_mask:0xc bank_mask:0xf\n\t"
        "v_add_f32_dpp %6, %6, %6 row_bcast:31 row_mask:0xc bank_mask:0xf\n\t"
        "v_add_f32_dpp %7, %7, %7 row_bcast:31 row_mask:0xc bank_mask:0xf\n\t"
        : "+v"(a0), "+v"(a1), "+v"(a2), "+v"(a3), "+v"(a4), "+v"(a5), "+v"(a6), "+v"(a7));
}
__device__ __forceinline__ void unpack8(const v4u w, float* f) { f[0] = bflo(w.x); f[1] = bfhi(w.x); f[2] = bflo(w.y); f[3] = bfhi(w.y); f[4] = bflo(w.z); f[5] = bfhi(w.z); f[6] = bflo(w.w); f[7] = bfhi(w.w); }


__device__ __forceinline__ float clamp448(float x) { return fminf(fmaxf(x, -448.0f), 448.0f); }
__device__ __forceinline__ unsigned pk4_fp8(float a, float b, float c, float d) {
    unsigned w = 0u; w = __builtin_amdgcn_cvt_pk_fp8_f32(clamp448(a), clamp448(b), w, false); w = __builtin_amdgcn_cvt_pk_fp8_f32(clamp448(c), clamp448(d), w, true); return w; }
constexpr float F8_WSCALE = 128.0f;
constexpr float F8_ASCALE = 16.0f;
constexpr float F8_HSCALE = 8.0f;
#define XB_TMO      128
#define XB_XCNT(j)  (256  + 64 * (j))
#define XB_XSUB(j)  (1280 + 64 * (j))
#define XB_XGEN(j)  (2304 + 64 * (j))
#define XB_TOP      3328
#define XB_TOPGEN   3392
#define XCD_BAR_WORDS 3456
#define XB_SPIN_CAP (1u << 18)

__device__ __forceinline__ unsigned xb_ld(unsigned* p)              { return __hip_atomic_load(p, __ATOMIC_RELAXED, __HIP_MEMORY_SCOPE_AGENT); }
__device__ __forceinline__ unsigned xb_add(unsigned* p, unsigned v) { return __hip_atomic_fetch_add(p, v, __ATOMIC_RELAXED, __HIP_MEMORY_SCOPE_AGENT); }
__device__ __forceinline__ unsigned xb_xcc_id() { return (unsigned)__builtin_amdgcn_s_getreg((3 << 11) | 20) & 0xFu; }
#define XB_SPIN(cond, bar) do { unsigned _sp = 0; while (cond) { __builtin_amdgcn_s_sleep(1); \
    if ((++_sp & 255u) == 0u) { if (xb_ld(&(bar)[XB_TMO])) break; if (_sp > XB_SPIN_CAP) { atomicAdd(&(bar)[XB_TMO], 1u); break; } } } } while (0)

struct XcdBarrier {
    unsigned* bar; unsigned x;
    volatile LAS unsigned* st;
};

__device__ __forceinline__ XcdBarrier xcd_barrier_post(unsigned* bar, volatile LAS unsigned* st) {
    XcdBarrier b; b.bar = bar; b.x = xb_xcc_id(); b.st = st;
    if (threadIdx.x == 0) (void)xb_add(&bar[XB_XCNT(b.x)], 1u);
    return b;
}
__device__ __forceinline__ void xcd_barrier_complete(unsigned* bar, unsigned x, unsigned& nloc, unsigned& nx) {
    const unsigned G = gridDim.x * gridDim.y * gridDim.z;
    unsigned sum, cnt, mine, sp = 0u;
    for (;;) {
        sum = 0u; cnt = 0u; mine = 0u;
#pragma unroll
        for (unsigned j = 0; j < 16; ++j) { const unsigned c = xb_ld(&bar[XB_XCNT(j)]); sum += c; cnt += (c > 0u) ? 1u : 0u; mine = (j == x) ? c : mine; }
        if (sum == G) break;
        __builtin_amdgcn_s_sleep(1);
        if ((++sp & 255u) == 0u) { if (xb_ld(&bar[XB_TMO])) break; if (sp > XB_SPIN_CAP) { atomicAdd(&bar[XB_TMO], 1u); break; } }
    }
    nloc = mine > 0u ? mine : 1u; nx = cnt > 0u ? cnt : 1u;
}

__device__ __forceinline__ void xcd_barrier(const XcdBarrier& b, const int tid_in) {
    asm volatile("s_waitcnt vmcnt(0)" ::: "memory");
    __syncthreads();
    if (tid_in == 0) {
        unsigned* bar = b.bar;
        __builtin_amdgcn_s_waitcnt(0);
        unsigned nloc = b.st[0], nx = b.st[1];
        if (nloc == 0u) { xcd_barrier_complete(bar, b.x, nloc, nx); b.st[0] = nloc; b.st[1] = nx; }
        const unsigned old = xb_add(&bar[XB_XSUB(b.x)], 1u);
        const unsigned gen = old / nloc;
        if (old + 1u == (gen + 1u) * nloc) {
            __builtin_amdgcn_fence(__ATOMIC_RELEASE, "agent");
            asm volatile("s_waitcnt vmcnt(0)" ::: "memory");
            const unsigned og = xb_add(&bar[XB_TOP], 1u);
            const unsigned tg = og / nx;
            if (og + 1u == (tg + 1u) * nx) xb_add(&bar[XB_TOPGEN], 1u);
            else XB_SPIN(xb_ld(&bar[XB_TOPGEN]) == tg, bar);
            __builtin_amdgcn_fence(__ATOMIC_ACQUIRE, "agent");
            xb_add(&bar[XB_XGEN(b.x)], 1u);
            asm volatile("s_waitcnt vmcnt(0)" ::: "memory");
        } else {
            XB_SPIN(xb_ld(&bar[XB_XGEN(b.x)]) == gen, bar);
            __builtin_amdgcn_fence(__ATOMIC_ACQUIRE, "agent");
            asm volatile("s_waitcnt vmcnt(0)" ::: "memory");
        }
    }
    __syncthreads();
}


struct Args { const float* in[23]; float* out; unsigned char* ws; int ph_lo, ph_hi; };
typedef const __attribute__((address_space(4))) Args* KA;
#define KARGS() ({ KA p_ = (KA)__builtin_amdgcn_kernarg_segment_ptr(); asm volatile("" : "+s"(p_)); p_; })
enum { I_X = 0, I_C, I_CTX, I_CCTX, I_WADA, I_BADA, I_WIN, I_WOUT, I_QG, I_KG, I_SINK, I_HLB, I_HGAIN, I_GWS, I_GBS, I_GNG, I_FG, I_FU, I_FD, I_ROUTER, I_MG, I_MU, I_MDN };

__device__ __forceinline__ void transpose_item(const float* W, int K, int N, bf16* WT, int mode, LAS float* scr, int item, int lane) {
    const int nblk = N / 32, kb = item / nblk, nb = item % nblk, k0 = 64 * kb, n0 = 32 * nb;
    const float* wb = W + (size_t)k0 * N + n0; const int loff = (lane >> 5) * N + (lane & 31);
    float wv[32];
#pragma unroll
    for (int i = 0; i < 32; ++i) wv[i] = __builtin_nontemporal_load(wb + (size_t)(2 * i) * N + loff);
#pragma unroll
    for (int i = 0; i < 32; ++i) scr[(2 * i + (lane >> 5)) * 33 + (lane & 31)] = wv[i];
    LDS_WAIT(); asm volatile("" ::: "memory");
    const int c = lane & 7;
    const float wsc = (mode == 1) ? -1.4426950408889634f : (mode == 2 ? -0.6931471805599453f : 1.0f);
#pragma unroll
    for (int j = 0; j < 4; ++j) { const int n = (lane >> 3) + 8 * j; const LAS float* s = scr + (8 * c) * 33 + n;
        v4u o; o.x = pk2(s[0 * 33] * wsc, s[1 * 33] * wsc); o.y = pk2(s[2 * 33] * wsc, s[3 * 33] * wsc); o.z = pk2(s[4 * 33] * wsc, s[5 * 33] * wsc); o.w = pk2(s[6 * 33] * wsc, s[7 * 33] * wsc);
        const int ng = n0 + n; const int drow = (mode == 0) ? ng : (ng + 128 * (ng / 128) + (mode == 2 ? 128 : 0));
        *(GAS v4u*)(WT + (size_t)drow * K + k0 + 8 * c) = o; }
    LDS_WAIT(); asm volatile("" ::: "memory");
}
__device__ __forceinline__ void transpose_item8(const float* W, int K, int N, unsigned char* WT, int mode, LAS float* scr, int item, int lane) {
    const int nblk = N / 32, kb = item / nblk, nb = item % nblk, k0 = 64 * kb, n0 = 32 * nb;
    const float* wb = W + (size_t)k0 * N + n0; const int loff = (lane >> 5) * N + (lane & 31);
    float wv[32];
#pragma unroll
    for (int i = 0; i < 32; ++i) wv[i] = __builtin_nontemporal_load(wb + (size_t)(2 * i) * N + loff);
#pragma unroll
    for (int i = 0; i < 32; ++i) scr[(2 * i + (lane >> 5)) * 33 + (lane & 31)] = wv[i];
    LDS_WAIT(); asm volatile("" ::: "memory");
    const int c = lane & 7;
    const float wsc8 = F8_WSCALE * ((mode == 1) ? -1.4426950408889634f : (mode == 2 ? -0.6931471805599453f : 1.0f));
#pragma unroll
    for (int j = 0; j < 4; ++j) { const int n = (lane >> 3) + 8 * j; const LAS float* s = scr + (8 * c) * 33 + n;
        v2u o; o.x = pk4_fp8(s[0 * 33] * wsc8, s[1 * 33] * wsc8, s[2 * 33] * wsc8, s[3 * 33] * wsc8); o.y = pk4_fp8(s[4 * 33] * wsc8, s[5 * 33] * wsc8, s[6 * 33] * wsc8, s[7 * 33] * wsc8);
        const int ng = n0 + n; const int drow = (mode == 0) ? ng : (ng + 128 * (ng / 128) + (mode == 2 ? 128 : 0));
        *(GAS v2u*)(WT + (size_t)drow * K + k0 + 8 * c) = o; }
    LDS_WAIT(); asm volatile("" ::: "memory");
}
constexpr int MOE_ITEMS = 24 * 16 * 112;
constexpr int MOE_SL0 = 0, MOE_SL1 = 5376, MOE_SL2 = 10752, MOE_SL3 = 16128, MOE_SL4 = 18048, MOE_SL5 = 24192, MOE_SL6 = 28032, MOE_SL7 = 31424, MOE_DEFER = 33344;
__device__ __forceinline__ void moe_conv_item(KA a, int it, LAS float* scr, int lane) {
    constexpr int I_M = 16 * 112;
    unsigned char* ws = a->ws;
    const int idx = it / I_M, r = it % I_M;
    if (idx < 8) transpose_item8(a->in[I_MG] + (size_t)idx * DM * EXD, DM, EXD, (unsigned char*)(ws + WS_MGU) + (size_t)idx * 2 * EXD * DM, 1, scr, r, lane);
    else if (idx < 16) transpose_item8(a->in[I_MU] + (size_t)(idx - 8) * DM * EXD, DM, EXD, (unsigned char*)(ws + WS_MGU) + (size_t)(idx - 8) * 2 * EXD * DM, 2, scr, r, lane);
    else transpose_item8(a->in[I_MDN] + (size_t)(idx - 16) * EXD * DM, EXD, DM, (unsigned char*)(ws + WS_MD) + (size_t)(idx - 16) * DM * EXD, 0, scr, r, lane);
}
__device__ __forceinline__ void moe_conv_range(KA a, int lo, int hi, int first, LAS unsigned char* lds, int lane, int wave, int G, int bid) {
    if (bid < first) return;
    LAS float* scr = (LAS float*)(lds + wave * 8704);
    const int nw = (G - first) * NWAVES, w = (bid - first) * NWAVES + wave;
    for (int i = lo + w; i < hi; i += nw) moe_conv_item(a, i, scr, lane);
}
__device__ __forceinline__ void p0_prologue(KA a, LAS unsigned char* lds, int tid, int lane, int wave, int G, int bid) {
    unsigned char* ws = a->ws;
    LAS float* scr = (LAS float*)(lds + wave * 8704);
    const int gw = bid * NWAVES + wave, NGW = G * NWAVES;
    constexpr int I_IN = 16 * 80, I_OUT = 16 * 32, I_F = 16 * 88, I_FDN = 44 * 32, I_M = 16 * 112;
    constexpr int NIT = 2 * I_IN + 2 * I_OUT + 2 * I_F + I_FDN + 24 * I_M;
    LAS float* sil = (LAS float*)(lds + 69632);
    LAS float* part = (LAS float*)(lds + 69632 + 8192);
    float* vec = (float*)(ws + WS_VEC);
    const bool wada = bid < 192;
    if (wada) { for (int i = tid; i < 2048; i += NTHR) { const float v = (i < 1024) ? a->in[I_C][i] : a->in[I_CCTX][i - 1024]; sil[i] = silu1(v); } __syncthreads(); }
    const int l0 = bid / 96, col0 = (bid % 96) * 64 + lane;
    const float* w0 = a->in[I_WADA] + (size_t)l0 * DM * 6144 + col0;
    float a0 = 0.f, a1 = 0.f; int jb = 0;
    for (int it0 = gw; it0 < NIT || (wada && jb < 4); it0 += NGW) {
        float wv[32]; const bool wb = wada && jb < 4; const int k0 = wave * 128 + 32 * jb;
        if (wb) {
#pragma unroll
            for (int j = 0; j < 32; ++j) wv[j] = __builtin_nontemporal_load(&w0[(size_t)(k0 + j) * 6144]); }
        if (it0 < NIT) {
            int it = it0;
            if (it < 2 * I_IN) { const int l = it / I_IN, r = it % I_IN; transpose_item(a->in[I_WIN] + (size_t)l * DM * INW, DM, INW, (bf16*)(ws + WS_WIN) + (size_t)l * INW * DM, 0, scr, r, lane); }
            else if ((it -= 2 * I_IN) < 2 * I_OUT) { const int l = it / I_OUT, r = it % I_OUT; transpose_item(a->in[I_WOUT] + (size_t)l * DM * DM, DM, DM, (bf16*)(ws + WS_WOUT) + (size_t)l * DM * DM, 0, scr, r, lane); }
            else if ((it -= 2 * I_OUT) < I_F) transpose_item(a->in[I_FG], DM, FFN, (bf16*)(ws + WS_WGU), 1, scr, it, lane);
            else if ((it -= I_F) < I_F) transpose_item(a->in[I_FU], DM, FFN, (bf16*)(ws + WS_WGU), 2, scr, it, lane);
            else if ((it -= I_F) < I_FDN) transpose_item(a->in[I_FD], FFN, DM, (bf16*)(ws + WS_WD), 0, scr, it, lane);
            else if ((it -= I_FDN) >= MOE_DEFER) moe_conv_item(a, it, scr, lane);
        }
        if (wb) {
#pragma unroll
            for (int j = 0; j < 32; ++j) { a0 += sil[k0 + j] * wv[j]; a1 += sil[1024 + k0 + j] * wv[j]; }
            ++jb; }
    }
    if (wada) {
        for (int item = bid; item < 192; item += G) {
            const int l = item / 96, cb = item % 96, col = cb * 64 + lane;
            if (item != bid) {
                const float* w = a->in[I_WADA] + (size_t)l * DM * 6144 + col; a0 = 0.f; a1 = 0.f;
#pragma unroll 1
                for (int k0 = wave * 128; k0 < wave * 128 + 128; k0 += 32) { float wv[32];
#pragma unroll
                    for (int j = 0; j < 32; ++j) wv[j] = __builtin_nontemporal_load(&w[(size_t)(k0 + j) * 6144]);
#pragma unroll
                    for (int j = 0; j < 32; ++j) { a0 += sil[k0 + j] * wv[j]; a1 += sil[1024 + k0 + j] * wv[j]; } } }
            part[(wave * 2 + 0) * 64 + lane] = a0; part[(wave * 2 + 1) * 64 + lane] = a1;
            __syncthreads();
            if (wave == 0) { float s0 = 0.f, s1 = 0.f;
#pragma unroll
                for (int w8 = 0; w8 < 8; ++w8) { s0 += part[(w8 * 2 + 0) * 64 + lane]; s1 += part[(w8 * 2 + 1) * 64 + lane]; }
                const float b = a->in[I_BADA][l * 6144 + col];
                vec[VO_MOD + (l * 2 + 0) * 6144 + col] = s0 + b; vec[VO_MOD + (l * 2 + 1) * 6144 + col] = s1 + b; }
            __syncthreads();
        }
    }
    if (bid == 0 && tid < 2) {
        float gq = 0.f, gk = 0.f;
        for (int d = 0; d < 64; ++d) { gq = fmaxf(gq, fabsf(a->in[I_QG][tid * 64 + d])); gk = fmaxf(gk, fabsf(a->in[I_KG][tid * 64 + d])); }
        vec[VO_NBND + tid] = -(8.0f * 1.4426950408889634f) * gq * gk; }
    if (bid == G - 1) {
        for (int idx = tid; idx < 5120; idx += NTHR) {
            const int isc = idx >= 4096, j = isc ? idx - 4096 : idx, pos = j / 16, i = j % 16;
            const float inv = exp2f(-(float)i * 0.83048202372184059f);
            const float ang = (float)pos * inv;
            double r = (double)ang * 0.15915494309189535; r -= floor(r);
            const float rf = (float)r;
            const float cs = __builtin_amdgcn_cosf(rf), sn = __builtin_amdgcn_sinf(rf);
            float* t = vec + VO_ROPE + (isc ? 8192 : 0);
            const int n = isc ? 1024 : 4096;
            t[j] = cs; t[n + j] = sn;
        }
    }
}

template <bool STORE = true, bool BFX = false> __device__ __forceinline__ void norm_row(const void* xrow, const float* sc, const float* sh, bf16* orow, int lane, f32x4 (&h)[4]) {
    f32x4 v[4]; float s = 0.f;
    if constexpr (BFX) { const GAS v2u* xr = (const GAS v2u*)xrow + lane;
#pragma unroll
        for (int j = 0; j < 4; ++j) { const v2u t = xr[64 * j]; v[j] = (f32x4){bflo(t.x), bfhi(t.x), bflo(t.y), bfhi(t.y)}; } }
    else { const GAS f32x4* xr = (const GAS f32x4*)xrow + lane;
#pragma unroll
        for (int j = 0; j < 4; ++j) v[j] = xr[64 * j]; }
#pragma unroll
    for (int j = 0; j < 4; ++j) s += (v[j].x * v[j].x + v[j].y * v[j].y) + (v[j].z * v[j].z + v[j].w * v[j].w);
    const float rstd = __builtin_amdgcn_rsqf(wave_sum_dpp(s) * (1.0f / DM) + EPS);
    GAS v2u* o8 = (GAS v2u*)orow + lane;
#pragma unroll
    for (int j = 0; j < 4; ++j) { const f32x4 scv = *(const f32x4*)(sc + 4 * lane + 256 * j), shv = *(const f32x4*)(sh + 4 * lane + 256 * j);
        h[j] = v[j] * rstd * (scv + 1.0f) + shv;
        if constexpr (STORE) { v2u w; w.x = pk2(h[j].x, h[j].y); w.y = pk2(h[j].z, h[j].w); o8[64 * j] = w; } }
}
__device__ __forceinline__ void phase_norm(KA a, int l, int which, int nrows, bf16* H, int lane, int wave, int G, int bid) {
    const float* vec = (const float*)(a->ws + WS_VEC);
    const bool bfx = !(l == 0 && which == 0);
    const float* xl = a->in[I_X]; const bf16* xb = (const bf16*)(a->ws + WS_XB);
    const float* xc = (l == 0) ? a->in[I_CTX] : (const float*)(a->ws + WS_CTXR);
    const int nlat = nrows < S_LAT ? nrows : S_LAT;
    const float* ml = vec + VO_MOD + (l * 2 + 0) * 6144 + which * 3072;
    const float* mc = vec + VO_MOD + (l * 2 + 1) * 6144 + which * 3072;
    const int gw = bid * NWAVES + wave, NGW = G * NWAVES;
    f32x4 scl[4], shl[4], v[4];
#pragma unroll
    for (int j = 0; j < 4; ++j) { scl[j] = *(const f32x4*)(ml + 1024 + 4 * lane + 256 * j) + 1.0f; shl[j] = *(const f32x4*)(ml + 4 * lane + 256 * j); }
    if (gw < nlat) {
        if (bfx) { const GAS v2u* xr = (const GAS v2u*)(xb + (size_t)gw * DM) + lane;
#pragma unroll
            for (int j = 0; j < 4; ++j) { const v2u t = xr[64 * j]; v[j] = (f32x4){bflo(t.x), bfhi(t.x), bflo(t.y), bfhi(t.y)}; } }
        else { const GAS f32x4* xr = (const GAS f32x4*)(xl + (size_t)gw * DM) + lane;
#pragma unroll
            for (int j = 0; j < 4; ++j) v[j] = xr[64 * j]; } }
    for (int r = gw; r < nlat; r += NGW) {
        const int rn = r + NGW; f32x4 vn[4];
        if (rn < nlat) {
            if (bfx) { const GAS v2u* xr = (const GAS v2u*)(xb + (size_t)rn * DM) + lane;
#pragma unroll
                for (int j = 0; j < 4; ++j) { const v2u t = xr[64 * j]; vn[j] = (f32x4){bflo(t.x), bfhi(t.x), bflo(t.y), bfhi(t.y)}; } }
            else { const GAS f32x4* xr = (const GAS f32x4*)(xl + (size_t)rn * DM) + lane;
#pragma unroll
                for (int j = 0; j < 4; ++j) vn[j] = xr[64 * j]; } }
        float s = 0.f;
#pragma unroll
        for (int j = 0; j < 4; ++j) s += (v[j].x * v[j].x + v[j].y * v[j].y) + (v[j].z * v[j].z + v[j].w * v[j].w);
        const float rstd = __builtin_amdgcn_rsqf(wave_sum_dpp(s) * (1.0f / DM) + EPS);
        GAS v2u* o8 = (GAS v2u*)(H + (size_t)r * DM) + lane;
#pragma unroll
        for (int j = 0; j < 4; ++j) { const f32x4 h = v[j] * rstd * scl[j] + shl[j]; v2u w; w.x = pk2(h.x, h.y); w.y = pk2(h.z, h.w); o8[64 * j] = w; }
#pragma unroll
        for (int j = 0; j < 4; ++j) v[j] = vn[j];
    }
    const int npart = (l == 0 && which == 0) ? 0 : (l == 0 ? 4 : 11);
    const float* part = (const float*)(a->ws + (l == 0 ? WS_PART1 : WS_PART2));
    for (int r = S_LAT + (NGW - 1 - gw); r < nrows; r += NGW) {
        const int cr = r - S_LAT; f32x4 x[4];
        { const GAS f32x4* xr = (const GAS f32x4*)(xc + (size_t)cr * DM) + lane;
#pragma unroll
          for (int j = 0; j < 4; ++j) x[j] = xr[64 * j]; }
        for (int p = 0; p < npart; ++p) { const GAS f32x4* pr = (const GAS f32x4*)(part + ((size_t)p * 256 + cr) * DM) + lane;
#pragma unroll
            for (int j = 0; j < 4; ++j) x[j] = x[j] + pr[64 * j]; }
        if (npart && l == 0) { GAS f32x4* cw = (GAS f32x4*)((float*)(a->ws + WS_CTXR) + (size_t)cr * DM) + lane;
#pragma unroll
            for (int j = 0; j < 4; ++j) cw[64 * j] = x[j]; }
        float s = 0.f;
#pragma unroll
        for (int j = 0; j < 4; ++j) s += (x[j].x * x[j].x + x[j].y * x[j].y) + (x[j].z * x[j].z + x[j].w * x[j].w);
        const float rstd = __builtin_amdgcn_rsqf(wave_sum_dpp(s) * (1.0f / DM) + EPS);
        GAS v2u* o8 = (GAS v2u*)(H + (size_t)r * DM) + lane;
#pragma unroll
        for (int j = 0; j < 4; ++j) { const f32x4 scv = *(const f32x4*)(mc + 1024 + 4 * lane + 256 * j), shv = *(const f32x4*)(mc + 4 * lane + 256 * j);
            const f32x4 h = x[j] * rstd * (scv + 1.0f) + shv; v2u w; w.x = pk2(h.x, h.y); w.y = pk2(h.z, h.w); o8[64 * j] = w; }
    }
}
constexpr int ROUTE_ROWS_OFF = 36864;
__device__ __forceinline__ void phase_norm_route(KA a, LAS unsigned char* lds, int tid, int lane, int wave, int G, int bid) {
    const int l = 1;
    const float* vec = (const float*)(a->ws + WS_VEC);
    const float* ml = vec + VO_MOD + (l * 2 + 0) * 6144 + 3072;
    LAS float* rt = (LAS float*)lds;
    volatile LAS unsigned* lcnt = (volatile LAS unsigned*)(lds + 32768);
    for (int s = tid; s < 8192; s += NTHR) { const int d = s >> 3, e = s & 7; rt[(e >> 2) * 4096 + (((d >> 8) * 4 + (d & 3)) * 64 + ((d & 255) >> 2)) * 4 + (e & 3)] = a->in[I_ROUTER][s] * (1.0f / F8_ASCALE); }
    if (tid < 16) lcnt[tid] = 0u;
    __syncthreads();
    int* tokinfo = (int*)(a->ws + WS_TOK);
    unsigned* cnt = (unsigned*)(a->ws + WS_CTL) + CW_MOECNT;
    const int gw = bid * NWAVES + wave, NGW = G * NWAVES;
    unsigned keep = 0u, pk0 = 0u; int itn = 0;
    f32x4 scl[4], shl[4]; v2u nx[4];
#pragma unroll
    for (int j = 0; j < 4; ++j) { scl[j] = (*(const f32x4*)(ml + 1024 + 4 * lane + 256 * j) + 1.0f) * F8_ASCALE; shl[j] = *(const f32x4*)(ml + 4 * lane + 256 * j) * F8_ASCALE; }
    if (gw < S_LAT) { const GAS v2u* xr = (const GAS v2u*)((const bf16*)(a->ws + WS_XB) + (size_t)gw * DM) + lane;
#pragma unroll
        for (int j = 0; j < 4; ++j) nx[j] = xr[64 * j]; }
    for (int r = gw; r < S_LAT; r += NGW) {
        f32x4 h[4];
        { v2u cu[4];
#pragma unroll
          for (int j = 0; j < 4; ++j) cu[j] = nx[j];
          if (r + NGW < S_LAT) { const GAS v2u* xr = (const GAS v2u*)((const bf16*)(a->ws + WS_XB) + (size_t)(r + NGW) * DM) + lane;
#pragma unroll
              for (int j = 0; j < 4; ++j) nx[j] = xr[64 * j]; }
          float s = 0.f;
#pragma unroll
          for (int j = 0; j < 4; ++j) { h[j] = (f32x4){bflo(cu[j].x), bfhi(cu[j].x), bflo(cu[j].y), bfhi(cu[j].y)}; s += (h[j].x * h[j].x + h[j].y * h[j].y) + (h[j].z * h[j].z + h[j].w * h[j].w); }
          const float rstd = __builtin_amdgcn_rsqf(wave_sum_dpp(s) * (1.0f / DM) + EPS);
#pragma unroll
          for (int j = 0; j < 4; ++j) h[j] = h[j] * rstd * scl[j] + shl[j]; }
#pragma unroll
        for (int j = 0; j < 4; ++j) ((LAS unsigned*)(lds + ROUTE_ROWS_OFF + wave * 8192 + itn * 1024))[lane + 64 * j] = pk4_fp8(h[j].x, h[j].y, h[j].z, h[j].w);
        float lg[8];
#pragma unroll
        for (int e = 0; e < 8; ++e) lg[e] = 0.f;
#pragma unroll
        for (int j = 0; j < 4; ++j)
#pragma unroll
            for (int i = 0; i < 4; ++i) { const f32x4 r0 = *(const LAS f32x4*)(rt + ((j * 4 + i) * 64 + lane) * 4), r1 = *(const LAS f32x4*)(rt + 4096 + ((j * 4 + i) * 64 + lane) * 4); const float hv = h[j][i];
                lg[0] += hv * r0.x; lg[1] += hv * r0.y; lg[2] += hv * r0.z; lg[3] += hv * r0.w; lg[4] += hv * r1.x; lg[5] += hv * r1.y; lg[6] += hv * r1.z; lg[7] += hv * r1.w; }
        wave_sum8_l63(lg[0], lg[1], lg[2], lg[3], lg[4], lg[5], lg[6], lg[7]);
        int i1 = 0; float v1 = lg[0];
#pragma unroll
        for (int e = 1; e < 8; ++e) if (lg[e] > v1) { v1 = lg[e]; i1 = e; }
        int i2 = -1; float v2 = -INFINITY;
#pragma unroll
        for (int e = 0; e < 8; ++e) if (e != i1 && lg[e] > v2) { v2 = lg[e]; i2 = e; }
        const float w1 = __builtin_amdgcn_rcpf(1.0f + exp_hw(v2 - v1)), w2 = 1.0f - w1;
        if (lane == 63) {
            const unsigned r1 = __hip_atomic_fetch_add((LAS unsigned*)lcnt + i1, 1u, __ATOMIC_RELAXED, __HIP_MEMORY_SCOPE_WORKGROUP), r2 = __hip_atomic_fetch_add((LAS unsigned*)lcnt + i2, 1u, __ATOMIC_RELAXED, __HIP_MEMORY_SCOPE_WORKGROUP);
            int* ti = tokinfo + (size_t)r * 8;
            ti[0] = i1; ti[1] = i2; ti[4] = __builtin_bit_cast(int, w1); ti[5] = __builtin_bit_cast(int, w2);
            pk0 = (unsigned)i1 | ((unsigned)i2 << 3) | (r1 << 6) | (r2 << 19);
        }
        const unsigned pku = (unsigned)__builtin_amdgcn_readlane((int)pk0, 63);
        if (lane == itn) keep = pku;
        ++itn;
    }
    __syncthreads();
    if (tid < 8) lcnt[8 + tid] = __hip_atomic_fetch_add(cnt + 64 * tid, lcnt[tid], RLX_AGENT);
    __syncthreads();
    { const int r = gw + lane * NGW; if (lane < itn && r < S_LAT) { int* ti = tokinfo + (size_t)r * 8; const unsigned e1 = keep & 7u, e2 = (keep >> 3) & 7u; ti[2] = (int)(((keep >> 6) & 0x1fffu) + lcnt[8 + e1]); ti[3] = (int)((keep >> 19) + lcnt[8 + e2]); } }
}

__device__ __forceinline__ void qk_prep_one(KA a, int l, int row, int hh, const v4u (&w8)[8], bf16* PROJ, const float* rope, LAS bf16* qdst) {
    const bool isq = hh < 8;
    bf16* p = PROJ + (size_t)row * INW + (isq ? hh * 64 : COL_AK + (hh - 8) * 64);
    const float* gain = (isq ? a->in[I_QG] : a->in[I_KG]) + l * 64;
    float x[64]; float ss = 0.f;
#pragma unroll
    for (int c = 0; c < 8; ++c) unpack8(w8[c], x + 8 * c);
#pragma unroll
    for (int d = 0; d < 64; ++d) ss += x[d] * x[d];
    const float rstd = __builtin_amdgcn_rsqf(ss * (1.0f / 64.0f) + EPS) * (isq ? 0.125f * 1.4426950408889634f : 1.0f);
    const f32x4* g4 = (const f32x4*)gain;
#pragma unroll
    for (int c = 0; c < 16; ++c) { const f32x4 gv = g4[c]; x[4 * c] *= rstd * gv.x; x[4 * c + 1] *= rstd * gv.y; x[4 * c + 2] *= rstd * gv.z; x[4 * c + 3] *= rstd * gv.w; }
    if (row < S_LAT) {
        const int gr = row >> 6, gc = row & 63;
        const f32x4* cr = (const f32x4*)(rope + gr * 16); const f32x4* sr = (const f32x4*)(rope + 4096 + gr * 16); const f32x4* cc = (const f32x4*)(rope + 8192 + gc * 16); const f32x4* sc = (const f32x4*)(rope + 8192 + 1024 + gc * 16);
#pragma unroll
        for (int j4 = 0; j4 < 4; ++j4) { const f32x4 cv = cr[j4], sv = sr[j4];
#pragma unroll
            for (int i2 = 0; i2 < 4; ++i2) { const int j = 4 * j4 + i2; const float x1 = x[j], x2 = x[16 + j]; x[j] = x1 * cv[i2] - x2 * sv[i2]; x[16 + j] = x1 * sv[i2] + x2 * cv[i2]; } }
#pragma unroll
        for (int j4 = 0; j4 < 4; ++j4) { const f32x4 cv = cc[j4], sv = sc[j4];
#pragma unroll
            for (int i2 = 0; i2 < 4; ++i2) { const int j = 4 * j4 + i2; const float x1 = x[32 + j], x2 = x[48 + j]; x[32 + j] = x1 * cv[i2] - x2 * sv[i2]; x[48 + j] = x1 * sv[i2] + x2 * cv[i2]; } }
    }
#pragma unroll
    for (int c = 0; c < 8; ++c) { v4u w; w.x = pk2(x[8 * c], x[8 * c + 1]); w.y = pk2(x[8 * c + 2], x[8 * c + 3]); w.z = pk2(x[8 * c + 4], x[8 * c + 5]); w.w = pk2(x[8 * c + 6], x[8 * c + 7]);
        if (qdst) *(LAS v4u*)(qdst + 8 * c) = w; else *(GAS v4u*)(p + 8 * c) = w; }
}
__device__ __forceinline__ void qk_prep(KA a, int l, int first_thread, int nthreads) {
    bf16* PROJ = (bf16*)(a->ws + WS_PROJ);
    const float* rope = (const float*)(a->ws + WS_VEC) + VO_ROPE;
    for (int i = first_thread; i < R_ALL * 2; i += nthreads) {
        const int row = i >> 1, hh = 8 + (i & 1);
        v4u w0[8];
        { const bf16* p = PROJ + (size_t)row * INW + COL_AK + (hh - 8) * 64;
#pragma unroll
          for (int c = 0; c < 8; ++c) w0[c] = *(const GAS v4u*)(p + 8 * c); }
        qk_prep_one(a, l, row, hh, w0, PROJ, rope, nullptr);
    }
}
__device__ __forceinline__ void gmlp_unit(KA a, int l, int chunk, int g, LAS unsigned char* lds, int tid, int lane, int wave) {
    const bf16* PROJ = (const bf16*)(a->ws + WS_PROJ); bf16* MIX = (bf16*)(a->ws + WS_MIX);
    const int row0 = (chunk < 128) ? chunk * 128 : S_LAT + (chunk - 128) * 128;
    LAS float* vn = (LAS float*)lds;
    { const int pos = tid >> 2, part = tid & 3;
      const bf16* p = PROJ + (size_t)(row0 + pos) * INW + COL_GV + g * 64 + part * 16;
      float x[16]; unpack8(*(const GAS v4u*)p, x); unpack8(*(const GAS v4u*)(p + 8), x + 8);
      float ss = 0.f;
#pragma unroll
      for (int d = 0; d < 16; ++d) { x[d] = gelu1(x[d]); ss += x[d] * x[d]; }
      ss += sx<1>(ss); ss += sx<2>(ss);
      const float rstd = __builtin_amdgcn_rsqf(ss * (1.0f / 64.0f) + EPS);
      const float* gn = a->in[I_GNG] + l * 256 + g * 64 + part * 16;
#pragma unroll
      for (int d = 0; d < 16; ++d) vn[pos * 64 + part * 16 + d] = x[d] * rstd * gn[d]; }
    __syncthreads();
    const int c = lane, t0 = wave * 16;
    const float* W = a->in[I_GWS] + ((size_t)(l * 4 + g) * 128 + t0) * 128;
    float acc[16];
#pragma unroll
    for (int i = 0; i < 16; ++i) acc[i] = 0.f;
    for (int s = 0; s < 128; ++s) { const float v = vn[s * 64 + c];
#pragma unroll
        for (int i = 0; i < 16; ++i) acc[i] += W[i * 128 + s] * v; }
    const float* bs = a->in[I_GBS] + (l * 4 + g) * 128 + t0;
#pragma unroll
    for (int i = 0; i < 16; ++i) { const int row = row0 + t0 + i;
        const float u = gelu1(bflo((unsigned)PROJ[(size_t)row * INW + COL_GU + g * 64 + c]));
        MIX[(size_t)row * DM + MIX_GM + g * 64 + c] = (bf16)f2bf(u * (acc[i] + bs[i])); }
    __syncthreads();
}
__device__ __forceinline__ void hgrn_naive(KA a, int l, int dir, int head, LAS unsigned char* lds, int tid, int lane, int wave) {
    const bf16* PROJ = (const bf16*)(a->ws + WS_PROJ);
    float* HGO = (float*)(a->ws + WS_HGO) + (size_t)dir * R_ALL * 256;
    LAS float* Qs = (LAS float*)lds;
    LAS float* Fs = Qs + 4096; LAS float* Vs = Fs + 4096; LAS float* part = Vs + 4096;
    const int v = lane, kg = wave;
    float S[8];
#pragma unroll
    for (int i = 0; i < 8; ++i) S[i] = 0.f;
    const int tl = tid >> 3, c8 = tid & 7;
    float lb[8];
#pragma unroll
    for (int j = 0; j < 8; ++j) { float b = 0.f; if (l == 1) { const float p0 = a->in[I_HLB][dir * 512 + head * 64 + c8 * 8 + j], p1 = a->in[I_HLB][dir * 512 + 256 + head * 64 + c8 * 8 + j]; b = 1.0f / (1.0f + __expf(p0 - p1)); } lb[j] = b; }
    const int fcol = (dir == 0 ? COL_HFF : COL_HFB) + head * 64 + c8 * 8;
    for (int n0 = 0; n0 < R_ALL; n0 += 64) {
        { const int n = n0 + tl; int row;
          if (dir == 0) row = (n < C_CTX) ? S_LAT + n : n - C_CTX; else row = (n < C_CTX) ? S_LAT + (C_CTX - 1 - n) : (S_LAT - 1) - (n - C_CTX);
          const bf16* pr = PROJ + (size_t)row * INW;
          float q[8], f[8], vv[8];
          unpack8(*(const GAS v4u*)(pr + COL_HQ + head * 64 + c8 * 8), q); unpack8(*(const GAS v4u*)(pr + fcol), f); unpack8(*(const GAS v4u*)(pr + COL_HI + head * 64 + c8 * 8), vv);
#pragma unroll
          for (int j = 0; j < 8; ++j) { Qs[tl * 64 + c8 * 8 + j] = silu1(q[j]) * 0.125f; Fs[tl * 64 + c8 * 8 + j] = lb[j] + (1.0f - lb[j]) * sigm1(f[j]); Vs[tl * 64 + c8 * 8 + j] = vv[j]; } }
        __syncthreads();
        for (int t = 0; t < 64; ++t) {
            const float vt = Vs[t * 64 + v]; float po = 0.f;
#pragma unroll
            for (int i = 0; i < 8; ++i) { const float f = Fs[t * 64 + kg * 8 + i], q = Qs[t * 64 + kg * 8 + i]; S[i] = f * S[i] + (1.0f - f) * vt; po += S[i] * q; }
            part[((t & 1) * 8 + kg) * 64 + v] = po;
            __syncthreads();
            if (wave == 0) { float o = 0.f;
#pragma unroll
                for (int w8 = 0; w8 < 8; ++w8) o += part[((t & 1) * 8 + w8) * 64 + v];
                const int n = n0 + t; int row;
                if (dir == 0) row = (n < C_CTX) ? S_LAT + n : n - C_CTX; else row = (n < C_CTX) ? S_LAT + (C_CTX - 1 - n) : (S_LAT - 1) - (n - C_CTX);
                HGO[(size_t)row * 256 + head * 64 + v] = o; }
        }
        __syncthreads();
    }
}

typedef short bf16x8v __attribute__((ext_vector_type(8)));
constexpr int HST = 72;
__device__ __forceinline__ f32x4 mma16(const LAS bf16* MA, const LAS bf16* MBt, int k0, f32x4 c, int lane) {
    const bf16x8v av = *(const LAS bf16x8v*)(MA + (lane & 15) * HST + k0 + 8 * (lane >> 4));
    const bf16x8v bv = *(const LAS bf16x8v*)(MBt + (lane & 15) * HST + k0 + 8 * (lane >> 4));
    return __builtin_amdgcn_mfma_f32_16x16x32_bf16(av, bv, c, 0, 0, 0);
}
__device__ __forceinline__ int hg_base_row(int cpos) { return cpos < 256 ? 64 * cpos : S_LAT + 64 * (cpos - 256); }
__device__ __forceinline__ int hg_scan_idx(int dir, int cpos) { return dir == 0 ? (cpos < 256 ? 4 + cpos : cpos - 256) : (cpos < 256 ? 4 + (255 - cpos) : 3 - (cpos - 256)); }
__device__ __forceinline__ float hg_lb(KA a, int l, int dir, int head, int k) {
    if (l == 0) return 0.f;
    const float p0 = a->in[I_HLB][dir * 512 + head * 64 + k], p1 = a->in[I_HLB][dir * 512 + 256 + head * 64 + k];
    return __builtin_amdgcn_rcpf(1.0f + exp_hw(p0 - p1));
}
__device__ __forceinline__ void hgrn_stepA(KA a, int l, int cpos, int head, LAS unsigned char* lds, int lane, int wave) {
    const bf16* PROJ = (const bf16*)(a->ws + WS_PROJ);
    const int dir = wave >> 2, I = wave & 3, base = hg_base_row(cpos), ci = hg_scan_idx(dir, cpos);
    LAS float* TOT = (LAS float*)lds;
    LAS bf16* KLT = (LAS bf16*)(lds + 2048) + dir * 64 * HST;
    LAS bf16* VT = (LAS bf16*)(lds + 2048 + 2 * 64 * HST * 2) + dir * 64 * HST;
    const float lb = hg_lb(a, l, dir, head, lane);
    const int fcol = (dir == 0 ? COL_HFF : COL_HFB) + head * 64 + lane, vcol = COL_HI + head * 64 + lane;
    float kk[16], cl[16]; float run = 0.f;
#pragma unroll
    for (int i = 0; i < 16; ++i) { const int n = 16 * I + i, row = base + (dir ? 63 - n : n);
        const float fl = bflo((unsigned)PROJ[(size_t)row * INW + fcol]);
        const unsigned short vb = PROJ[(size_t)row * INW + vcol];
        const float f = lb + (1.0f - lb) * sigm1(fl);
        run += log_hw(f); cl[i] = run; kk[i] = 1.0f - f;
        VT[lane * HST + n] = vb; }
    TOT[(dir * 4 + I) * 64 + lane] = run;
    __syncthreads();
    float post = 0.f, all = 0.f;
#pragma unroll
    for (int J = 0; J < 4; ++J) { const float t = TOT[(dir * 4 + J) * 64 + lane]; all += t; if (J > I) post += t; }
#pragma unroll
    for (int i = 0; i < 16; ++i) KLT[lane * HST + 16 * I + i] = (bf16)f2bf(kk[i] * exp_hw(run - cl[i] + post));
    if (I == 0) ((float*)(a->ws + WS_HDG))[((size_t)(dir * 4 + head) * 260 + ci) * 64 + lane] = exp_hw(all);
    __syncthreads();
    float* LT = (float*)(a->ws + WS_HLT) + ((size_t)(dir * 4 + head) * 260 + ci) * 4096;
    float z0 = 0.f; asm volatile("" : "+v"(z0));
#pragma unroll
    for (int kb = 0; kb < 4; ++kb) { f32x4 acc = {z0, z0, z0, z0};
        acc = mma16(VT + 16 * I * HST, KLT + 16 * kb * HST, 0, acc, lane); acc = mma16(VT + 16 * I * HST, KLT + 16 * kb * HST, 32, acc, lane);
#pragma unroll
        for (int r = 0; r < 4; ++r) LT[(16 * I + 4 * (lane >> 4) + r) * 64 + 16 * kb + (lane & 15)] = acc[r]; }
    __syncthreads();
}
__device__ __forceinline__ void hgrn_stepB(KA a, int item, int tid) {
    const int dh = item >> 3, vb = item & 7, v = vb * 8 + (tid >> 6), k = tid & 63;
    const float* LT = (const float*)(a->ws + WS_HLT) + (size_t)dh * 260 * 4096 + v * 64 + k;
    const float* DG = (const float*)(a->ws + WS_HDG) + (size_t)dh * 260 * 64 + k;
    bf16* SP = (bf16*)(a->ws + WS_HSP) + (size_t)dh * 260 * 4096 + v * 64 + k;
    float S = 0.f;
#pragma unroll 1
    for (int c0 = 0; c0 < 260; c0 += 26) {
        float lt[26], dg[26];
#pragma unroll
        for (int j = 0; j < 26; ++j) { lt[j] = __builtin_nontemporal_load(&LT[(size_t)(c0 + j) * 4096]); dg[j] = DG[(c0 + j) * 64]; }
#pragma unroll
        for (int j = 0; j < 26; ++j) { SP[(size_t)(c0 + j) * 4096] = (bf16)f2bf(S); S = dg[j] * S + lt[j]; }
    }
}
__device__ __forceinline__ void hgrn_stepC(KA a, int l, int cpos, int head, LAS unsigned char* lds, int tid, int lane, int wave) {
    const bf16* PROJ = (const bf16*)(a->ws + WS_PROJ); bf16* MIX = (bf16*)(a->ws + WS_MIX);
    const int dir = wave >> 2, I = wave & 3, base = hg_base_row(cpos), ci = hg_scan_idx(dir, cpos);
    constexpr int MSZ = 64 * HST;
    LAS float* TOT = (LAS float*)lds;
    LAS bf16* img = (LAS bf16*)(lds + 2048);
    LAS bf16* QT = img + dir * MSZ;
    LAS bf16* QD = img + 2 * MSZ + dir * MSZ;
    LAS bf16* VT = img + 4 * MSZ + dir * MSZ;
    LAS bf16* ST = img + 6 * MSZ + dir * MSZ;
    LAS bf16* AS = img + 8 * MSZ + dir * MSZ + I * 16 * HST;
    LAS bf16* KT = img + 10 * MSZ + dir * (10 * 16 * HST);
    LAS float* OS = (LAS float*)(img + 10 * MSZ);
    const float lb = hg_lb(a, l, dir, head, lane);
    const int fcol = (dir == 0 ? COL_HFF : COL_HFB) + head * 64 + lane, qcol = COL_HQ + head * 64 + lane, vcol = COL_HI + head * 64 + lane;
    { const bf16* SP = (const bf16*)(a->ws + WS_HSP) + ((size_t)(dir * 4 + head) * 260 + ci) * 4096;
#pragma unroll
      for (int h2 = 0; h2 < 2; ++h2) { const int e = ((I * 2 + h2) * 64 + lane) * 8, vv = e >> 6, kk0 = e & 63;
          *(LAS v4u*)(ST + vv * HST + kk0) = *(const GAS v4u*)(SP + e); } }
    float kk[16], cl[16], qv[16]; float run = 0.f;
#pragma unroll
    for (int i = 0; i < 16; ++i) { const int n = 16 * I + i, row = base + (dir ? 63 - n : n);
        const float fl = bflo((unsigned)PROJ[(size_t)row * INW + fcol]), ql = bflo((unsigned)PROJ[(size_t)row * INW + qcol]);
        const unsigned short vb = PROJ[(size_t)row * INW + vcol];
        const float f = lb + (1.0f - lb) * sigm1(fl);
        run += log_hw(f); cl[i] = run; kk[i] = 1.0f - f; qv[i] = silu1(ql) * 0.125f;
        VT[lane * HST + n] = vb; }
    TOT[(dir * 4 + I) * 64 + lane] = run;
    __syncthreads();
    float tj[4];
#pragma unroll
    for (int J = 0; J < 4; ++J) tj[J] = TOT[(dir * 4 + J) * 64 + lane];
    float pre = 0.f;
#pragma unroll
    for (int J = 0; J < 4; ++J) if (J < I) pre += tj[J];
    const float epre = exp_hw(pre); float kei[16];
#pragma unroll
    for (int i = 0; i < 16; ++i) { const float e = exp_hw(cl[i]); QT[(16 * I + i) * HST + lane] = (bf16)f2bf(qv[i] * e); QD[(16 * I + i) * HST + lane] = (bf16)f2bf(qv[i] * e * epre); kei[i] = kk[i] * fminf(__builtin_amdgcn_rcpf(e), 5.5e34f); }
    float eoff = 0.f;
#pragma unroll
    for (int I2 = 0; I2 < 4; ++I2) {
        if (I2 >= I) {
            if (I2 == I) eoff = 0.f; else if (I2 == I + 1) eoff = run; else eoff += tj[I2 - 1];
            LAS bf16* blk = KT + (I2 * (I2 + 1) / 2 + I) * 16 * HST;
            const float fo = exp_hw(eoff);
#pragma unroll
            for (int i = 0; i < 16; ++i) blk[i * HST + lane] = (bf16)f2bf(kei[i] * fo);
        }
    }
    __syncthreads();
    float z0 = 0.f; asm volatile("" : "+v"(z0));
    f32x4 sc[4];
#pragma unroll
    for (int J = 0; J < 4; ++J) { sc[J] = (f32x4){z0, z0, z0, z0};
        if (J <= I) { const LAS bf16* kb = KT + (I * (I + 1) / 2 + J) * 16 * HST;
            sc[J] = mma16(QT + 16 * I * HST, kb, 0, sc[J], lane); sc[J] = mma16(QT + 16 * I * HST, kb, 32, sc[J], lane);
            if (J == I) {
#pragma unroll
                for (int r = 0; r < 4; ++r) if ((lane & 15) > 4 * (lane >> 4) + r) sc[J][r] = z0; } } }
#pragma unroll
    for (int J = 0; J < 4; ++J)
#pragma unroll
        for (int r = 0; r < 4; ++r) AS[(4 * (lane >> 4) + r) * HST + 16 * J + (lane & 15)] = (bf16)f2bf(sc[J][r]);
    asm volatile("s_waitcnt lgkmcnt(0)" ::: "memory");
    f32x4 acc[4];
#pragma unroll
    for (int vb = 0; vb < 4; ++vb) { acc[vb] = (f32x4){z0, z0, z0, z0};
        acc[vb] = mma16(AS, VT + 16 * vb * HST, 0, acc[vb], lane); acc[vb] = mma16(AS, VT + 16 * vb * HST, 32, acc[vb], lane);
        acc[vb] = mma16(QD + 16 * I * HST, ST + 16 * vb * HST, 0, acc[vb], lane); acc[vb] = mma16(QD + 16 * I * HST, ST + 16 * vb * HST, 32, acc[vb], lane); }
    __syncthreads();
#pragma unroll
    for (int vb = 0; vb < 4; ++vb)
#pragma unroll
        for (int r = 0; r < 4; ++r) { const int n = 16 * I + 4 * (lane >> 4) + r, rl = dir ? 63 - n : n; OS[(dir * 64 + rl) * 68 + 16 * vb + (lane & 15)] = acc[vb][r]; }
    __syncthreads();
    { const int rl = tid >> 3, v8 = (tid & 7) * 8, row = base + rl;
      float o[8]; float ss = 0.f;
#pragma unroll
      for (int j = 0; j < 8; ++j) { o[j] = OS[rl * 68 + v8 + j] + OS[(64 + rl) * 68 + v8 + j]; ss += o[j] * o[j]; }
      ss += sx<1>(ss); ss += sx<2>(ss); ss += sx<4>(ss);
      const float rstd = __builtin_amdgcn_rsqf(ss * (1.0f / 64.0f) + EPS);
      float gt[8]; unpack8(*(const GAS v4u*)(PROJ + (size_t)row * INW + COL_HG + head * 64 + v8), gt);
      const float* gn = a->in[I_HGAIN] + l * 64 + v8;
      float y[8];
#pragma unroll
      for (int j = 0; j < 8; ++j) y[j] = o[j] * rstd * gn[j] * silu1(gt[j]);
      v4u w; w.x = pk2(y[0], y[1]); w.y = pk2(y[2], y[3]); w.z = pk2(y[4], y[5]); w.w = pk2(y[6], y[7]);
      *(GAS v4u*)(MIX + (size_t)row * DM + MIX_HG + head * 64 + v8) = w; }
    __syncthreads();
}

__device__ __forceinline__ void vt_item(KA a, int item, int lane) {
    const bf16* PROJ = (const bf16*)(a->ws + WS_PROJ); bf16* VTg = (bf16*)(a->ws + WS_VT);
    const int rb = item >> 1, hk = item & 1, row = rb * 64 + lane;
    const bf16* p = PROJ + (size_t)row * INW + COL_AV + hk * 64;
    unsigned w[32];
#pragma unroll
    for (int c = 0; c < 8; ++c) { const v4u t = *(const GAS v4u*)(p + 8 * c); w[4 * c] = t.x; w[4 * c + 1] = t.y; w[4 * c + 2] = t.z; w[4 * c + 3] = t.w; }
    bf16* o = VTg + (size_t)hk * 64 * R_ALL + row;
#pragma unroll
    for (int d2 = 0; d2 < 32; ++d2) { o[(size_t)(2 * d2) * R_ALL] = (bf16)(w[d2] & 0xffffu); o[(size_t)(2 * d2 + 1) * R_ALL] = (bf16)(w[d2] >> 16); }
}
__device__ __forceinline__ void attn_unit(KA a, int l, int u, LAS unsigned char* lds, int tid, int lane, int wave, unsigned* qctr, unsigned& nxt) {
    asm volatile("" : "+v"(tid), "+v"(lane));
    const bf16* PROJ = (const bf16*)(a->ws + WS_PROJ); const bf16* VTg = (const bf16*)(a->ws + WS_VT); bf16* MIX = (bf16*)(a->ws + WS_MIX);
    const bool isctx = u >= 256; const int uu = isctx ? u - 256 : u; const int n = uu >> 1, hk = uu & 1;
    const int qh = hk * 4 + (wave >> 1), half = wave & 1;
    const int qbase = (isctx ? S_LAT : 0) + n * 128 + half * 64, qpos0 = n * 128 + half * 64;
    const int c = lane & 15, g = lane >> 4;
    LAS bf16* Kt = (LAS bf16*)lds; LAS bf16* Vt = Kt + 64 * HST; LAS bf16* Qw = Vt + 64 * HST + wave * 64 * HST;
#pragma unroll
    for (int j = 0; j < 0; ++j) {}
    const int first = (!isctx && n == 0) ? 2 : 0, nwin = isctx ? 0 : ((n == 0 || n == 127) ? 4 : 6), nt = nwin + 4;
    const int lr = tid >> 3, lc = (tid & 7) * 8;
    v4u kreg, vreg;
#define ATT_LOADT(i) do { const bool ct_ = (i) >= nwin; const int kb_ = ct_ ? S_LAT + 64 * ((i) - nwin) : (n - 1) * 128 + 64 * (first + (i)); \
        kreg = *(const GAS v4u*)(PROJ + (size_t)(kb_ + lr) * INW + COL_AK + hk * 64 + lc); vreg = *(const GAS v4u*)(VTg + ((size_t)hk * 64 + lr) * R_ALL + kb_ + lc); } while (0)
    ATT_LOADT(0);
    {
        v4u qraw[8]; const bf16* qp = PROJ + (size_t)(qbase + lane) * INW + qh * 64;
#pragma unroll
        for (int c8 = 0; c8 < 8; ++c8) qraw[c8] = *(const GAS v4u*)(qp + 8 * c8);
        qk_prep_one(a, l, qbase + lane, qh, qraw, (bf16*)(a->ws + WS_PROJ), (const float*)(a->ws + WS_VEC) + VO_ROPE, Qw + lane * HST);
    }
    float z0 = 0.f; asm volatile("" : "+v"(z0));
    f32x4 o[4][4], osum[4];
    const float nbnd = ((const float*)(a->ws + WS_VEC))[VO_NBND + l];
    const f32x4 nb4 = {nbnd, nbnd, nbnd, nbnd};
    const float sink = a->in[I_SINK][l * 8 + qh] * 1.4426950408889634f;
    const float esink = __builtin_amdgcn_exp2f(sink + nbnd);
    const bf16x8v ones8 = {(short)0x3F80, (short)0x3F80, (short)0x3F80, (short)0x3F80, (short)0x3F80, (short)0x3F80, (short)0x3F80, (short)0x3F80};
#pragma unroll
    for (int qt = 0; qt < 4; ++qt) { osum[qt] = (f32x4){esink + z0, esink + z0, esink + z0, esink + z0};
#pragma unroll
        for (int dt = 0; dt < 4; ++dt) o[qt][dt] = (f32x4){z0, z0, z0, z0}; }
#define ATT_LOADT_UNUSED_(i) do { const bool ct_ = (i) >= nwin; const int kb_ = ct_ ? S_LAT + 64 * ((i) - nwin) : (n - 1) * 128 + 64 * (first + (i)); \
        kreg = *(const GAS v4u*)(PROJ + (size_t)(kb_ + lr) * INW + COL_AK + hk * 64 + lc); vreg = *(const GAS v4u*)(VTg + ((size_t)hk * 64 + lr) * R_ALL + kb_ + lc); } while (0)
#undef ATT_LOADT_UNUSED_
#pragma unroll 1
    for (int i = 0; i < nt; ++i) {
        __syncthreads();
        *(LAS v4u*)(Kt + lr * HST + lc) = kreg; *(LAS v4u*)(Vt + lr * HST + lc) = vreg;
        __syncthreads();
        if (i + 1 < nt) ATT_LOADT(i + 1);
        const bool win = i < nwin; const int kb = (n - 1) * 128 + 64 * (first + i);
        const int rel = kb - qpos0;
        const bool maskw = win && (rel == 128 || rel == -128);
        if (win && (rel >= 192 || rel <= -192)) continue;
        bf16x8v kf[4][2], vf[4][2];
#pragma unroll
        for (int kt = 0; kt < 4; ++kt)
#pragma unroll
            for (int ks = 0; ks < 2; ++ks) kf[kt][ks] = *(const LAS bf16x8v*)(Kt + (16 * kt + c) * HST + 32 * ks + 8 * g);
#pragma unroll
        for (int dt = 0; dt < 4; ++dt)
#pragma unroll
            for (int s2 = 0; s2 < 2; ++s2) { const v2u lo = *(const LAS v2u*)(Vt + (16 * dt + c) * HST + 32 * s2 + 4 * g), hi = *(const LAS v2u*)(Vt + (16 * dt + c) * HST + 32 * s2 + 16 + 4 * g);
                const v4u t = {lo.x, lo.y, hi.x, hi.y}; vf[dt][s2] = __builtin_bit_cast(bf16x8v, t); }
        f32x4 sA[4], sB[4];
#define ATT_SCORES(QT, S_) do { const bf16x8v q0_ = *(const LAS bf16x8v*)(Qw + (16 * (QT) + c) * HST + 8 * g), q1_ = *(const LAS bf16x8v*)(Qw + (16 * (QT) + c) * HST + 32 + 8 * g); \
            _Pragma("unroll") for (int kt = 0; kt < 4; ++kt) S_[kt] = __builtin_amdgcn_mfma_f32_16x16x32_bf16(kf[kt][0], q0_, nb4, 0, 0, 0); \
            _Pragma("unroll") for (int kt = 0; kt < 4; ++kt) S_[kt] = __builtin_amdgcn_mfma_f32_16x16x32_bf16(kf[kt][1], q1_, S_[kt], 0, 0, 0); } while (0)
#define ATT_REST(QT, S_) do { \
            if (maskw) { int d0 = c - 4 * g; asm volatile("" : "+v"(d0));        \
                if (rel > 0) { _Pragma("unroll") for (int kt = 0; kt < 4; ++kt) { if (kt > (QT)) S_[kt] = (f32x4){-INFINITY, -INFINITY, -INFINITY, -INFINITY}; \
                        else if (kt == (QT)) { _Pragma("unroll") for (int r = 0; r < 4; ++r) if (r > d0) S_[kt][r] = -INFINITY; } } } \
                else { _Pragma("unroll") for (int kt = 0; kt < 4; ++kt) { if (kt < (QT)) S_[kt] = (f32x4){-INFINITY, -INFINITY, -INFINITY, -INFINITY}; \
                        else if (kt == (QT)) { _Pragma("unroll") for (int r = 0; r < 4; ++r) if (r < d0) S_[kt][r] = -INFINITY; } } } } \
            _Pragma("unroll") for (int kt = 0; kt < 4; ++kt) _Pragma("unroll") for (int r = 0; r < 4; ++r) S_[kt][r] = __builtin_amdgcn_exp2f(S_[kt][r]); \
            bf16x8v pb[2]; \
            _Pragma("unroll") for (int s2 = 0; s2 < 2; ++s2) { const v4u t = {pk2(S_[2 * s2][0], S_[2 * s2][1]), pk2(S_[2 * s2][2], S_[2 * s2][3]), pk2(S_[2 * s2 + 1][0], S_[2 * s2 + 1][1]), pk2(S_[2 * s2 + 1][2], S_[2 * s2 + 1][3])}; pb[s2] = __builtin_bit_cast(bf16x8v, t); } \
            _Pragma("unroll") for (int dt = 0; dt < 4; ++dt) o[QT][dt] = __builtin_amdgcn_mfma_f32_16x16x32_bf16(vf[dt][0], pb[0], o[QT][dt], 0, 0, 0); \
            osum[QT] = __builtin_amdgcn_mfma_f32_16x16x32_bf16(ones8, pb[0], osum[QT], 0, 0, 0); \
            _Pragma("unroll") for (int dt = 0; dt < 4; ++dt) o[QT][dt] = __builtin_amdgcn_mfma_f32_16x16x32_bf16(vf[dt][1], pb[1], o[QT][dt], 0, 0, 0); \
            osum[QT] = __builtin_amdgcn_mfma_f32_16x16x32_bf16(ones8, pb[1], osum[QT], 0, 0, 0); } while (0)
        ATT_SCORES(0, sA);
        ATT_SCORES(1, sB); ATT_REST(0, sA);
        ATT_SCORES(2, sA); ATT_REST(1, sB);
        ATT_SCORES(3, sB); ATT_REST(2, sA);
        ATT_REST(3, sB);
#undef ATT_SCORES
#undef ATT_REST
    }
#undef ATT_LOADT
    if (tid == 0) nxt = __hip_atomic_fetch_add(qctr, 1u, RLX_AGENT);
    int c2 = lane & 15, g2 = lane >> 4; asm volatile("" : "+v"(c2), "+v"(g2));
#pragma unroll
    for (int qt = 0; qt < 4; ++qt) { const float inv = __builtin_amdgcn_rcpf(osum[qt][0]);
        bf16* op = (bf16*)(a->ws + WS_MIX) + (size_t)(qbase + 16 * qt + c2) * DM + MIX_AT + qh * 64 + 4 * g2;
#pragma unroll
        for (int dt = 0; dt < 4; ++dt) { v2u w; w.x = pk2(o[qt][dt][0] * inv, o[qt][dt][1] * inv); w.y = pk2(o[qt][dt][2] * inv, o[qt][dt][3] * inv); *(GAS v2u*)(op + 16 * dt) = w; } }
}

constexpr int GST = 136;
__device__ __forceinline__ f32x4 mma16g(const LAS bf16* MA, const LAS bf16* MBt, int k0, f32x4 c, int lane) {
    const bf16x8v av = *(const LAS bf16x8v*)(MA + (lane & 15) * GST + k0 + 8 * (lane >> 4));
    const bf16x8v bv = *(const LAS bf16x8v*)(MBt + (lane & 15) * GST + k0 + 8 * (lane >> 4));
    return __builtin_amdgcn_mfma_f32_16x16x32_bf16(av, bv, c, 0, 0, 0);
}
__device__ __forceinline__ float gelu_as(float v) {
    const float av = fabsf(v), t = __builtin_amdgcn_rcpf(av * 0.2316418882f + 1.0f);
    float q = t * 0.5307027145f + (-0.7265760135f); q = q * t + 0.7107068705f; q = q * t + (-0.142248368f); q = q * t + 0.127414796f; q = q * t;
    const float e = __builtin_amdgcn_exp2f((v * v) * (-0.72134752044f)), h = q * e;
    return fmaxf(v, 0.f) - av * h;
}
__device__ __forceinline__ void gmlp_unit_mma(KA a, int l, int chunk, int g, LAS unsigned char* lds, int tid, int lane, int wave, unsigned* qctr, unsigned& nxt) {
    const bf16* PROJ = (const bf16*)(a->ws + WS_PROJ); bf16* MIX = (bf16*)(a->ws + WS_MIX);
    const int row0 = (chunk < 128) ? chunk * 128 : S_LAT + (chunk - 128) * 128;
    LAS bf16* WA = (LAS bf16*)lds;
    LAS bf16* VNT = WA + 128 * GST;
    LAS float* OUT = (LAS float*)(VNT + 64 * GST);
    const int pos = tid >> 2, part = tid & 3;
    {
      const float* W = a->in[I_GWS] + ((size_t)(l * 4 + g) * 128 + pos) * 128 + part * 32;
#pragma unroll
      for (int j = 0; j < 4; ++j) { const f32x4 w0 = *(const GAS f32x4*)(W + 8 * j), w1 = *(const GAS f32x4*)(W + 8 * j + 4);
          v4u o; o.x = pk2(w0.x, w0.y); o.y = pk2(w0.z, w0.w); o.z = pk2(w1.x, w1.y); o.w = pk2(w1.z, w1.w);
          *(LAS v4u*)(WA + pos * GST + part * 32 + 8 * j) = o; } }
    { const bf16* p = PROJ + (size_t)(row0 + pos) * INW + COL_GV + g * 64 + part * 16;
      float x[16]; unpack8(*(const GAS v4u*)p, x); unpack8(*(const GAS v4u*)(p + 8), x + 8);
      float ss = 0.f;
#pragma unroll
      for (int d = 0; d < 16; ++d) { x[d] = gelu_as(x[d]); ss += x[d] * x[d]; }
      ss += sx<1>(ss); ss += sx<2>(ss);
      const float rstd = __builtin_amdgcn_rsqf(ss * (1.0f / 64.0f) + EPS);
      const float* gn = a->in[I_GNG] + l * 256 + g * 64 + part * 16;
#pragma unroll
      for (int d = 0; d < 16; ++d) VNT[(part * 16 + d) * GST + pos] = (bf16)f2bf(x[d] * rstd * gn[d]); }
    __syncthreads();
    float z0 = 0.f; asm volatile("" : "+v"(z0));
#pragma unroll
    for (int cb = 0; cb < 4; ++cb) { f32x4 acc = {z0, z0, z0, z0};
#pragma unroll
        for (int ks = 0; ks < 4; ++ks) acc = mma16g(WA + 16 * wave * GST, VNT + 16 * cb * GST, 32 * ks, acc, lane);
#pragma unroll
        for (int r = 0; r < 4; ++r) OUT[(16 * wave + 4 * (lane >> 4) + r) * 68 + 16 * cb + (lane & 15)] = acc[r]; }
    __syncthreads();
    if (tid == 0) nxt = __hip_atomic_fetch_add(qctr, 1u, RLX_AGENT);
    { const int row = row0 + pos; const float bsv = a->in[I_GBS][(l * 4 + g) * 128 + pos];
      const bf16* pu = PROJ + (size_t)row * INW + COL_GU + g * 64 + part * 16;
      float u[16]; unpack8(*(const GAS v4u*)pu, u); unpack8(*(const GAS v4u*)(pu + 8), u + 8);
      float y[16];
#pragma unroll
      for (int d = 0; d < 16; ++d) y[d] = gelu_as(u[d]) * (OUT[pos * 68 + part * 16 + d] + bsv);
      bf16* po = MIX + (size_t)row * DM + MIX_GM + g * 64 + part * 16;
      v4u w; w.x = pk2(y[0], y[1]); w.y = pk2(y[2], y[3]); w.z = pk2(y[4], y[5]); w.w = pk2(y[6], y[7]); *(GAS v4u*)po = w;
      w.x = pk2(y[8], y[9]); w.y = pk2(y[10], y[11]); w.z = pk2(y[12], y[13]); w.w = pk2(y[14], y[15]); *(GAS v4u*)(po + 8) = w; }
    __syncthreads();
}
__device__ __forceinline__ void attn_naive(KA a, int l, int nrows, int lane, int wave, int G, int bid) {
    const bf16* PROJ = (const bf16*)(a->ws + WS_PROJ); bf16* MIX = (bf16*)(a->ws + WS_MIX);
    const int gw = bid * NWAVES + wave, NGW = G * NWAVES;
    for (int pair = gw; pair < nrows * 2; pair += NGW) {
        const int row = pair >> 1, hk = pair & 1; const bool isctx = row >= S_LAT;
        float q[4], o[4], m[4], ls[4];
#pragma unroll
        for (int g = 0; g < 4; ++g) { q[g] = bflo((unsigned)PROJ[(size_t)row * INW + (hk * 4 + g) * 64 + lane]); o[g] = 0.f; ls[g] = 1.0f; m[g] = a->in[I_SINK][l * 8 + hk * 4 + g] * 1.4426950408889634f; }
        int j0 = 0, j1 = -1;
        if (!isctx) { j0 = row - 128 < 0 ? 0 : row - 128; j1 = row + 128 > S_LAT - 1 ? S_LAT - 1 : row + 128; }
        const int nwin = j1 - j0 + 1;
        const int nk = nwin + C_CTX;
#pragma unroll 4
        for (int t = 0; t < nk; ++t) {
            const int krow = (t < nwin) ? j0 + t : S_LAT + (t - nwin);
            const float k = bflo((unsigned)PROJ[(size_t)krow * INW + COL_AK + hk * 64 + lane]);
            const float v = bflo((unsigned)PROJ[(size_t)krow * INW + COL_AV + hk * 64 + lane]);
#pragma unroll
            for (int g = 0; g < 4; ++g) { const float s = wave_sum_dpp(q[g] * k); const float mn = fmaxf(m[g], s);
                const float c = __builtin_amdgcn_exp2f(m[g] - mn), p = __builtin_amdgcn_exp2f(s - mn);
                ls[g] = ls[g] * c + p; o[g] = o[g] * c + p * v; m[g] = mn; }
        }
#pragma unroll
        for (int g = 0; g < 4; ++g) MIX[(size_t)row * DM + MIX_AT + (hk * 4 + g) * 64 + lane] = (bf16)f2bf(o[g] / ls[g]);
    }
}
__device__ __forceinline__ void hgrn_combine(KA a, int l, int nrows, int lane, int wave, int G, int bid) {
    const bf16* PROJ = (const bf16*)(a->ws + WS_PROJ); bf16* MIX = (bf16*)(a->ws + WS_MIX);
    const float* O0 = (const float*)(a->ws + WS_HGO); const float* O1 = O0 + (size_t)R_ALL * 256;
    const f32x4 gn = *(const f32x4*)(a->in[I_HGAIN] + l * 64 + (lane & 15) * 4);
    const int gw = bid * NWAVES + wave, NGW = G * NWAVES;
    for (int r = gw; r < nrows; r += NGW) {
        const f32x4 o = *(const GAS f32x4*)(O0 + (size_t)r * 256 + 4 * lane) + *(const GAS f32x4*)(O1 + (size_t)r * 256 + 4 * lane);
        float ss = (o.x * o.x + o.y * o.y) + (o.z * o.z + o.w * o.w);
        ss += sx<1>(ss); ss += sx<2>(ss); ss += sx<4>(ss); ss += sx<8>(ss);
        const float rstd = __builtin_amdgcn_rsqf(ss * (1.0f / 64.0f) + EPS);
        const v2u gw2 = *(const GAS v2u*)(PROJ + (size_t)r * INW + COL_HG + 4 * lane);
        const float g0 = bflo(gw2.x), g1 = bfhi(gw2.x), g2 = bflo(gw2.y), g3 = bfhi(gw2.y);
        v2u w; w.x = pk2(o.x * rstd * gn.x * silu1(g0), o.y * rstd * gn.y * silu1(g1)); w.y = pk2(o.z * rstd * gn.z * silu1(g2), o.w * rstd * gn.w * silu1(g3));
        *(GAS v2u*)(MIX + (size_t)r * DM + MIX_HG + 4 * lane) = w;
    }
}
__device__ __forceinline__ void moe_gather(KA a, LAS unsigned char* lds, int tid, int lane, int wave, int G, int bid) {
    LAS int* sb = (LAS int*)lds;
    const unsigned* cnt = (const unsigned*)(a->ws + WS_CTL) + CW_MOECNT;
    int* mi = (int*)(a->ws + WS_VEC) + VO_MOE;
    if (tid < 8) sb[16 + tid] = (int)__hip_atomic_load(cnt + 64 * tid, RLX_AGENT);
    __syncthreads();
    if (tid == 0) { int b = 0;
#pragma unroll
        for (int e = 0; e < 8; ++e) { sb[e] = b; b += ((sb[16 + e] + 255) >> 8) << 8; }
        sb[8] = b; }
    __syncthreads();
    if (bid == 0) {
        if (tid == 0) mi[0] = sb[8] >> 8;
        if (tid < 8) mi[160 + tid] = sb[tid + 1] >> 8;
        for (int t = tid; t < (sb[8] >> 8); t += NTHR) { int e = 0;
#pragma unroll
            for (int j = 1; j < 8; ++j) e += (t >= (sb[j] >> 8)) ? 1 : 0;
            mi[16 + t] = e; } }
    unsigned char* AS = (unsigned char*)(a->ws + WS_AS);
    const int* tokinfo = (const int*)(a->ws + WS_TOK); int* tokslot = (int*)(a->ws + WS_TOK) + S_LAT * 8;
    const int gw = bid * NWAVES + wave, NGW = G * NWAVES;
    int kq = 0;
    for (int t = gw; t < S_LAT; t += NGW, ++kq) {
        const int* ti = tokinfo + (size_t)t * 8;
        const int e1 = ti[0], e2 = ti[1], r1 = ti[2], r2 = ti[3];
        const int s1 = sb[e1] + r1, s2 = sb[e2] + r2;
        const v4u x0 = ((const LAS v4u*)(lds + ROUTE_ROWS_OFF + wave * 8192 + kq * 1024))[lane];
        ((GAS v4u*)(AS + (size_t)s1 * DM))[lane] = x0; ((GAS v4u*)(AS + (size_t)s2 * DM))[lane] = x0;
        if (lane == 0) { int* ts = tokslot + (size_t)t * 4; ts[0] = s1; ts[1] = s2; ts[2] = ti[4]; ts[3] = ti[5]; }
    }
    { const f32x4 z4 = {0.f, 0.f, 0.f, 0.f}; for (int i = bid * NTHR + tid; i < 8 * 256 * DM / 4; i += G * NTHR) ((GAS f32x4*)(a->ws + WS_YF))[i] = z4; }
    for (int e = 0; e < 8; ++e) { const int c = sb[16 + e], pe = (c + 255) & ~255, b = sb[e];
        for (int j = c + gw; j < pe; j += NGW) { const v4u z = {0u, 0u, 0u, 0u}; ((GAS v4u*)(AS + (size_t)(b + j) * DM))[lane] = z; } }
}
__device__ __forceinline__ void moe_combine(KA a, int lane, int wave, int G, int bid) {
    const float* gf = (const float*)(a->ws + WS_VEC) + VO_MOD + (1 * 2 + 0) * 6144 + 5 * 1024;
    const bf16* Y = (const bf16*)(a->ws + WS_Y); const int* tokslot = (const int*)(a->ws + WS_TOK) + S_LAT * 8; const float* YF = (const float*)(a->ws + WS_YF);
    const int gw = bid * NWAVES + wave, NGW = G * NWAVES;
    f32x4 gl[4];
#pragma unroll
    for (int j = 0; j < 4; ++j) gl[j] = *(const f32x4*)(gf + 4 * lane + 256 * j);
    int n0 = 0, n1 = 0, n2 = 0, n3 = 0;
    if (gw < S_LAT) { const int* ts = tokslot + (size_t)gw * 4; n0 = ts[0]; n1 = ts[1]; n2 = ts[2]; n3 = ts[3]; }
    for (int t = gw; t < S_LAT; t += NGW) {
        const int s1 = n0, s2 = n1; const float w1 = __builtin_bit_cast(float, n2), w2 = __builtin_bit_cast(float, n3);
        if (t + NGW < S_LAT) { const int* ts = tokslot + (size_t)(t + NGW) * 4; n0 = ts[0]; n1 = ts[1]; n2 = ts[2]; n3 = ts[3]; }
        GAS f32x4* xr = (GAS f32x4*)(a->out + (size_t)t * DM) + lane; const GAS v2u* xbr = (const GAS v2u*)((const bf16*)(a->ws + WS_XB) + (size_t)t * DM) + lane;
        v2u xt[4]; f32x4 p[4], q[4];
#pragma unroll
        for (int j = 0; j < 4; ++j) xt[j] = xbr[64 * j];
        if (s1 < 32768) { const GAS v2u* yr = (const GAS v2u*)(Y + (size_t)s1 * DM) + lane; v2u u[4];
#pragma unroll
            for (int j = 0; j < 4; ++j) u[j] = yr[64 * j];
#pragma unroll
            for (int j = 0; j < 4; ++j) p[j] = (f32x4){bflo(u[j].x), bfhi(u[j].x), bflo(u[j].y), bfhi(u[j].y)}; }
        else { const GAS f32x4* yr = (const GAS f32x4*)(YF + (size_t)(s1 - 32768) * DM) + lane;
#pragma unroll
            for (int j = 0; j < 4; ++j) p[j] = yr[64 * j]; }
        if (s2 < 32768) { const GAS v2u* yr = (const GAS v2u*)(Y + (size_t)s2 * DM) + lane; v2u u[4];
#pragma unroll
            for (int j = 0; j < 4; ++j) u[j] = yr[64 * j];
#pragma unroll
            for (int j = 0; j < 4; ++j) q[j] = (f32x4){bflo(u[j].x), bfhi(u[j].x), bflo(u[j].y), bfhi(u[j].y)}; }
        else { const GAS f32x4* yr = (const GAS f32x4*)(YF + (size_t)(s2 - 32768) * DM) + lane;
#pragma unroll
            for (int j = 0; j < 4; ++j) q[j] = yr[64 * j]; }
#pragma unroll
        for (int j = 0; j < 4; ++j) { f32x4 x = (f32x4){bflo(xt[j].x), bfhi(xt[j].x), bflo(xt[j].y), bfhi(xt[j].y)};
            x = x + gl[j] * (p[j] * w1 + q[j] * w2);
            __builtin_nontemporal_store(x, (f32x4*)(xr + 64 * j)); }
    }
}

#define IN(k) (lo <= (k) && (k) < hi)
#define GRIDBAR() do { XcdBarrier b2_; b2_.bar = (unsigned*)(KARGS()->ws + WS_CTL) + CW_BAR; b2_.x = xb_xcc_id(); b2_.st = (volatile LAS unsigned*)(lds + MISC_OFF) + 8; xcd_barrier(b2_, wv0 * 64 + (int)__builtin_amdgcn_mbcnt_hi(~0u, __builtin_amdgcn_mbcnt_lo(~0u, 0u))); } while (0)
#define SEAM(k) do { if (IN(k) && IN((k) + 1)) GRIDBAR(); } while (0)
#define PHASE_ROOTS() KA a = KARGS(); unsigned char* ws = a->ws; const float* vec = (const float*)(ws + WS_VEC); (void)vec; int bid = blockIdx.x, G = gridDim.x; asm volatile("" : "+s"(bid), "+s"(G)); int tid = wv0 * 64 + (int)__builtin_amdgcn_mbcnt_hi(~0u, __builtin_amdgcn_mbcnt_lo(~0u, 0u)); asm volatile("" : "+v"(tid)); const int lane = tid & 63, wave = __builtin_amdgcn_readfirstlane(tid >> 6); (void)lane; (void)wave

template <int l> __device__ __forceinline__ void layer_body(const int lo, const int hi, LAS unsigned char* lds, const int wv0) {
        const int pb = 1 + 11 * l;
        if (IN(pb + 0)) { PHASE_ROOTS(); phase_norm(a, l, 0, R_ALL, (bf16*)(ws + WS_H), lane, wave, G, bid); SEAM(pb + 0); }
        if (IN(pb + 1)) {
            PHASE_ROOTS();
            pg8::Gemm g{(const pg8::bf16_t*)(ws + WS_H), (const pg8::bf16_t*)(ws + WS_WIN) + (size_t)l * INW * DM, R_ALL, INW, DM, 0, DM};
            pg8::StaticOrder S; S.init(R_ALL, INW, G, bid);
            pg8::EpiBf16<0> E{(pg8::bf16_t*)(ws + WS_PROJ), INW, nullptr, 0, 0, 1.f};
            pg8::gemm_phase<pg8::EpiBf16<0>, pg8::StaticOrder, true, true>(lds, g, S, E, tid);
            moe_conv_range(a, l == 0 ? MOE_SL0 : MOE_SL2, l == 0 ? MOE_SL1 : MOE_SL3, 650 - 2 * 256, lds, lane, wave, G, bid);
            SEAM(pb + 1);
        }
        if (IN(pb + 2)) {
            PHASE_ROOTS();
            qk_prep(a, l, (G - 1 - bid) * NTHR + tid, G * NTHR);
            for (int it = ((bid + G - 80) % G) * NWAVES + wave; it < 520; it += G * NWAVES) vt_item(a, it, lane);
            for (int it = bid; it < 1040; it += G) hgrn_stepA(a, l, it >> 2, it & 3, lds, lane, wave);
            { __syncthreads(); moe_conv_range(a, l == 0 ? MOE_SL3 : MOE_SL7, l == 0 ? MOE_SL4 : MOE_DEFER, 1040 - 4 * 256, lds, lane, wave, G, bid); }
            SEAM(pb + 2);
        }
        if (IN(pb + 3)) {
            PHASE_ROOTS();
            if (bid < 64) hgrn_stepB(a, bid, tid);
            {
                const int nu = (l == 0) ? 260 : 256, ng = (l == 0) ? 520 : 512;
                unsigned* qctr = (unsigned*)(ws + WS_CTL) + CW_QUEUE + 64 * l;
                volatile LAS unsigned* qslot = (volatile LAS unsigned*)(lds + MISC_OFF) + 16;
                unsigned nxt = 0u;
                if (tid == 0) nxt = __hip_atomic_fetch_add(qctr, 1u, RLX_AGENT);
                for (;;) {
                    __syncthreads();
                    if (tid == 0) qslot[0] = nxt;
                    __syncthreads();
                    const int it = __builtin_amdgcn_readfirstlane((int)qslot[0]);
                    if (it >= nu + ng) break;
                    if (it < nu) attn_unit(a, l, it, lds, tid, lane, wave, qctr, nxt);
                    else gmlp_unit_mma(a, l, (it - nu) >> 2, (it - nu) & 3, lds, tid, lane, wave, qctr, nxt);
                }
            }
            SEAM(pb + 3);
        }
        if (IN(pb + 4)) {
            PHASE_ROOTS();
            const int nit = (l == 0) ? 1040 : 1024;
            for (int it = bid; it < nit; it += G) hgrn_stepC(a, l, it >> 2, it & 3, lds, tid, lane, wave);
            if (l == 0) { __syncthreads(); moe_conv_range(a, MOE_SL4, MOE_SL5, 1040 - 4 * 256, lds, lane, wave, G, bid); }
            SEAM(pb + 4);
        }
        if (IN(pb + 5)) {
            PHASE_ROOTS();
            const float* modl = vec + VO_MOD + (l * 2 + 0) * 6144; const float* modc = vec + VO_MOD + (l * 2 + 1) * 6144;
            const int M = S_LAT;
            pg8::Gemm g{(const pg8::bf16_t*)(ws + WS_MIX), (const pg8::bf16_t*)(ws + WS_WOUT) + (size_t)l * DM * DM, M, DM, DM, 0, DM};
            pg8::StaticOrder S; S.init(M, DM, G, bid);
            if (l == 0) { pg8::EpiResidB<false> E{a->in[I_X], (pg8::bf16_t*)(ws + WS_XB), modl + 2048, DM};
                pg8::gemm_phase<pg8::EpiResidB<false>, pg8::StaticOrder, true, true>(lds, g, S, E, tid); }
            else { pg8::EpiResidB<true> E{ws + WS_XB, (pg8::bf16_t*)(ws + WS_XB), modl + 2048, DM};
                pg8::gemm_phase<pg8::EpiResidB<true>, pg8::StaticOrder, true, true>(lds, g, S, E, tid); }
            if (l == 0) {
                pg8::Gemm g2{(const pg8::bf16_t*)(ws + WS_MIX), (const pg8::bf16_t*)(ws + WS_WOUT), R_ALL, DM, 256, 0, DM};
                pg8::SplitKOrder S2{S_LAT / 256, 4, 4, 256, 16, bid, nullptr};
                pg8::EpiPart E2{(float*)(ws + WS_PART1), modc + 2048, S_LAT / 256, 256, DM};
                pg8::gemm_phase<pg8::EpiPart, pg8::SplitKOrder, false, true>(lds, g2, S2, E2, tid);
                moe_conv_range(a, MOE_SL5, MOE_SL6, 16, lds, lane, wave, G, bid);
            }
            SEAM(pb + 5);
        }
        if (l == 0) {
            if (IN(pb + 6)) { PHASE_ROOTS(); phase_norm(a, l, 1, R_ALL, (bf16*)(ws + WS_H), lane, wave, G, bid); SEAM(pb + 6); }
            if (IN(pb + 7)) {
                PHASE_ROOTS();
                pg8::Gemm g{(const pg8::bf16_t*)(ws + WS_H), (const pg8::bf16_t*)(ws + WS_WGU), R_ALL, 2 * FFN, DM, 0, DM};
                pg8::StaticOrder S; S.init(R_ALL, 2 * FFN, G, bid);
                pg8::EpiSwiGLU E{(pg8::bf16_t*)(ws + WS_HID), FFN, 1.0f};
                pg8::gemm_phase<pg8::EpiSwiGLU, pg8::StaticOrder, true, true>(lds, g, S, E, tid);
                moe_conv_range(a, MOE_SL1, MOE_SL2, 1430 - 5 * 256, lds, lane, wave, G, bid);
                SEAM(pb + 7);
            }
            if (IN(pb + 8)) {
                PHASE_ROOTS();
                const float* modl = vec + VO_MOD + (l * 2 + 0) * 6144; const float* modc = vec + VO_MOD + (l * 2 + 1) * 6144;
                pg8::Gemm g{(const pg8::bf16_t*)(ws + WS_HID), (const pg8::bf16_t*)(ws + WS_WD), S_LAT, DM, FFN, 0, FFN};
                pg8::StaticOrder S; S.init(S_LAT, DM, G, bid);
                pg8::EpiResidB<true> E{ws + WS_XB, (pg8::bf16_t*)(ws + WS_XB), modl + 5120, DM};
                pg8::gemm_phase<pg8::EpiResidB<true>, pg8::StaticOrder, true, true>(lds, g, S, E, tid);
                {
                    pg8::Gemm g2{(const pg8::bf16_t*)(ws + WS_HID), (const pg8::bf16_t*)(ws + WS_WD), R_ALL, DM, 256, 0, FFN};
                    pg8::SplitKOrder S2{S_LAT / 256, 4, 11, 256, 44, bid, nullptr};
                    pg8::EpiPart E2{(float*)(ws + WS_PART2), modc + 5120, S_LAT / 256, 256, DM};
                    pg8::gemm_phase<pg8::EpiPart, pg8::SplitKOrder, false, true>(lds, g2, S2, E2, tid);
                    moe_conv_range(a, MOE_SL6, MOE_SL7, 44, lds, lane, wave, G, bid);
                }
                if (IN(pb + 8) && IN(pb + 11)) GRIDBAR();
            }
        } else {
            if (IN(pb + 6)) { PHASE_ROOTS(); phase_norm_route(a, lds, tid, lane, wave, G, bid); SEAM(pb + 6); }
            if (IN(pb + 7)) { PHASE_ROOTS(); moe_gather(a, lds, tid, lane, wave, G, bid); SEAM(pb + 7); }
            if (IN(pb + 8)) {
                PHASE_ROOTS();
                const int* mi = (const int*)(ws + WS_VEC) + VO_MOE; const int nt = __builtin_amdgcn_readfirstlane(mi[0]);
                pg8::Gemm g{(const pg8::bf16_t*)(ws + WS_AS), (const pg8::bf16_t*)(ws + WS_MGU), nt * 256, 2 * EXD, DM / 2, (size_t)2 * EXD * DM, DM / 2};
                pg8::MoeOrder S; S.init(nt * 256, 2 * EXD, G, bid); S.load_bases(mi + 160);
                pg8::EpiSwiGLU8 E{(unsigned char*)(ws + WS_HIDM), EXD, 1.0f / (F8_WSCALE * F8_ASCALE), F8_HSCALE};
                pg8::gemm_phase<pg8::EpiSwiGLU8, pg8::MoeOrder, true, true, true>(lds, g, S, E, tid);
                SEAM(pb + 8);
            }
            if (IN(pb + 9)) {
                PHASE_ROOTS();
                const int* mi = (const int*)(ws + WS_VEC) + VO_MOE; const int nt = __builtin_amdgcn_readfirstlane(mi[0]); const int nm = nt < 128 ? nt : 128;
                pg8::Gemm g{(const pg8::bf16_t*)(ws + WS_HIDM), (const pg8::bf16_t*)(ws + WS_MD), nm * 256, DM, EXD / 2, (size_t)DM * EXD, EXD / 2};
                pg8::MoeOrder S; S.init(nm * 256, DM, G, bid); S.load_bases(mi + 160);
                pg8::EpiScaleBf16 E{(pg8::bf16_t*)(ws + WS_Y), DM, 1.0f / (F8_WSCALE * F8_HSCALE)};
                pg8::gemm_phase<pg8::EpiScaleBf16, pg8::MoeOrder, true, true, true>(lds, g, S, E, tid);
                if (nt > 128) {
                    pg8::Gemm g2{(const pg8::bf16_t*)(ws + WS_HIDM), (const pg8::bf16_t*)(ws + WS_MD), nt * 256, DM, 256, (size_t)DM * EXD, EXD / 2};
                    pg8::SplitKOrder S2{128, 4, 7, 256, (nt - 128) * 28, bid, mi + 16};
                    pg8::EpiAtomic E2{(float*)(ws + WS_YF), nullptr, 128, DM, 1.0f / (F8_WSCALE * F8_HSCALE)};
                    pg8::gemm_phase<pg8::EpiAtomic, pg8::SplitKOrder, false, true, true>(lds, g2, S2, E2, tid);
                }
                SEAM(pb + 9);
            }
            if (IN(pb + 10)) { PHASE_ROOTS(); moe_combine(a, lane, wave, G, bid); }
        }
    }
__global__ void __launch_bounds__(NTHR, 2) fwd_kernel(Args a_unused) {
    extern __shared__ __attribute__((aligned(16))) unsigned char lds_raw[];
    LAS unsigned char* lds = (LAS unsigned char*)lds_raw;
    const int tid0 = threadIdx.x;
    const int wv0 = __builtin_amdgcn_readfirstlane(tid0 >> 6);
    for (int u = tid0; u < (LDS_BYTES - LDSCTL_OFF) / 4; u += NTHR) ((LAS unsigned*)(lds + LDSCTL_OFF))[u] = 0u;
    __syncthreads();
    const int lo = KARGS()->ph_lo, hi = KARGS()->ph_hi;
    const bool fusedl = (hi - lo) > 1;
    if (fusedl) (void)xcd_barrier_post((unsigned*)(KARGS()->ws + WS_CTL) + CW_BAR, (volatile LAS unsigned*)(lds + MISC_OFF) + 8);
    if (IN(0)) { PHASE_ROOTS(); p0_prologue(a, lds, tid, lane, wave, G, bid); SEAM(0); }

    layer_body<0>(lo, hi, lds, wv0);
    layer_body<1>(lo, hi, lds, wv0);
}

extern "C" void kernel_launch(void* const* d_in, const int* in_sizes, int n_in, void* d_out, int out_size, void* d_ws, size_t ws_size, hipStream_t stream) {
    static int grid = 0;
    if (grid == 0) {
        if (n_in != 23 || in_sizes[0] != S_LAT * DM || out_size != S_LAT * DM || ws_size < WS_END) { fprintf(stderr, "kernel_launch: unexpected shapes / workspace (n_in %d, ws %zu, need %zu)\n", n_in, ws_size, (size_t)WS_END); grid = -1; return; }
        int dev = 0, cus = 0;
        if (hipGetDevice(&dev) != hipSuccess || hipDeviceGetAttribute(&cus, hipDeviceAttributeMultiprocessorCount, dev) != hipSuccess) { grid = -1; return; }
        if (hipFuncSetAttribute((const void*)fwd_kernel, hipFuncAttributeMaxDynamicSharedMemorySize, LDS_BYTES) != hipSuccess) { grid = -1; return; }
        int per_cu = 0;
        (void)hipOccupancyMaxActiveBlocksPerMultiprocessor(&per_cu, (const void*)fwd_kernel, NTHR, LDS_BYTES);
        (void)hipGetLastError();
        if (cus * NWAVES * 8 < S_LAT) { fprintf(stderr, "kernel_launch: needs at least %d compute units\n", S_LAT / (NWAVES * 8)); grid = -1; return; }
        grid = cus;
    }
    if (grid < 0) return;
    if (hipMemsetAsync((char*)d_ws + WS_CTL, 0, CTL_ZERO_BYTES, stream) != hipSuccess) return;
    Args a{};
    for (int i = 0; i < 23; ++i) a.in[i] = (const float*)d_in[i];
    a.out = (float*)d_out; a.ws = (unsigned char*)d_ws;
#if ONE_LAUNCH
    a.ph_lo = 0; a.ph_hi = NPH;
    hipLaunchKernelGGL(fwd_kernel, dim3(grid), dim3(NTHR), LDS_BYTES, stream, a);
#else
    for (int p = 0; p < NPH; ++p) {
        if (p == 10 || p == 11) continue;
        a.ph_lo = p; a.ph_hi = p + 1;
        hipLaunchKernelGGL(fwd_kernel, dim3(grid), dim3(NTHR), LDS_BYTES, stream, a);
    }
#endif
}
```
